# Optimizing an MI355X kernel written in HIP

```python
import math
import jax
import jax.numpy as jnp
from jax import lax
import numpy as np

D_MODEL = 1024
BATCH = 8
SEQ = 4096
DEPTH = 2

N_MIXERS = 4
D_MIX = D_MODEL
D_GROUP = D_MIX // N_MIXERS
HEAD_DIM = 64
N_HEADS = D_GROUP // HEAD_DIM
Q_BLOCK = 128
NEG_INF = -1e30
EPS = 1e-6

NSA_CMP_BLOCK = 32
NSA_CMP_STRIDE = 16
NSA_SEL_BLOCK = 64
NSA_TOP_N = 16
NSA_WINDOW = 512
NSA_CMP_HIDDEN = 128
NSA_FORCED_SCORE = 1e4

DIFF_QK_DIM = HEAD_DIM // 2

SSM_STATE = 64
SSM_GROUPS = 2
SSM_CHUNK = 128
SSM_XBC = D_GROUP + 2 * SSM_GROUPS * SSM_STATE
CONV_WIDTH = 4

MLSTM_CHUNK = 128

IN_SPLITS = (
    D_GROUP, HEAD_DIM, HEAD_DIM, HEAD_DIM, HEAD_DIM, HEAD_DIM, HEAD_DIM, 3 * N_HEADS, D_GROUP,
    D_GROUP, D_GROUP, D_GROUP, D_GROUP,
    D_GROUP, SSM_XBC, N_HEADS,
    2 * D_GROUP, D_GROUP, 2 * N_HEADS, D_GROUP, D_GROUP,
)
D_IN_PROJ = sum(IN_SPLITS)

kernel_name = "hybrid_parallel_nsa_diff_ssd_mlstm"


def rmsnorm(x, g):
    xf = x.astype(jnp.float32)
    y = xf * lax.rsqrt(jnp.mean(xf * xf, axis=-1, keepdims=True) + EPS)
    return (y * g).astype(x.dtype)


def causal_dwconv(x, w, b):
    width, ch = w.shape
    y = lax.conv_general_dilated(x, w[:, None, :], window_strides=(1,), padding=((width - 1, 0),),
                                 dimension_numbers=('NWC', 'WIO', 'NWC'), feature_group_count=ch)
    return y + b


def masked_softmax(s, valid):
    return jax.nn.softmax(jnp.where(valid, s, NEG_INF), axis=-1) * valid


def nsa_attention(q, kc, vc, ks, vs, kw, vw, gates, cmp_pos, ck_w1, ck_w2, cv_w1, cv_w2):
    bsz, seq, n_h, dh = q.shape
    scale = dh ** -0.5
    n_cmp = (seq - NSA_CMP_BLOCK) // NSA_CMP_STRIDE + 1
    n_sel = seq // NSA_SEL_BLOCK
    top_n = min(NSA_TOP_N, n_sel)
    n_qb = seq // Q_BLOCK
    span = NSA_WINDOW + Q_BLOCK

    cmp_idx = np.arange(n_cmp)[:, None] * NSA_CMP_STRIDE + np.arange(NSA_CMP_BLOCK)[None, :]
    cmp_end = jnp.asarray(cmp_idx[:, -1], jnp.int32)
    sel_start = np.arange(n_sel) * NSA_SEL_BLOCK
    overlap = np.clip(np.minimum(cmp_idx[:, -1:] + 1, sel_start[None, :] + NSA_SEL_BLOCK)
                      - np.maximum(cmp_idx[:, :1], sel_start[None, :]), 0, None)
    cmp_to_sel = jnp.asarray(overlap / NSA_CMP_BLOCK, jnp.float32)

    def compress(src, w1, w2):
        blk = src[:, cmp_idx] + cmp_pos
        hid = jax.nn.silu(blk.reshape(bsz, n_cmp, NSA_CMP_BLOCK * dh) @ w1)
        return hid @ w2

    k_cmp = compress(kc, ck_w1, ck_w2)
    v_cmp = compress(vc, cv_w1, cv_w2)
    ks_blk = ks.reshape(bsz, n_sel, NSA_SEL_BLOCK, dh)
    vs_blk = vs.reshape(bsz, n_sel, NSA_SEL_BLOCK, dh)
    kw_pad = jnp.pad(kw, ((0, 0), (NSA_WINDOW, 0), (0, 0)))
    vw_pad = jnp.pad(vw, ((0, 0), (NSA_WINDOW, 0), (0, 0)))
    b_idx = jnp.arange(bsz)[:, None, None]
    sel_ids = jnp.arange(n_sel)
    sel_off = jnp.arange(NSA_SEL_BLOCK)
    win_off = jnp.arange(span)

    def block(args):
        qi, q_blk, g_blk = args
        q0 = qi * Q_BLOCK
        t = q0 + jnp.arange(Q_BLOCK)
        s_c = jnp.einsum('bqhd,bnd->bhqn', q_blk, k_cmp).astype(jnp.float32) * scale
        p_c = masked_softmax(s_c, cmp_end[None, :] <= t[:, None])
        o_c = jnp.einsum('bhqn,bnd->bqhd', p_c.astype(v_cmp.dtype), v_cmp)
        imp = jnp.einsum('bhqn,ns->bqs', p_c, cmp_to_sel)
        cur = t // NSA_SEL_BLOCK
        forced = (sel_ids[None, :] == cur[:, None]) | (sel_ids[None, :] == 0)
        allowed = sel_ids[None, :] <= cur[:, None]
        imp = jnp.where(forced, NSA_FORCED_SCORE, jnp.where(allowed, imp, -1.0))
        _, top_idx = lax.top_k(imp, top_n)
        k_sel = ks_blk[b_idx, top_idx]
        v_sel = vs_blk[b_idx, top_idx]
        kpos = top_idx[..., None] * NSA_SEL_BLOCK + sel_off
        valid_s = (kpos <= t[None, :, None, None]).reshape(bsz, 1, Q_BLOCK, top_n * NSA_SEL_BLOCK)
        s_s = jnp.einsum('bqhd,bqnld->bhqnl', q_blk, k_sel).astype(jnp.float32) * scale
        p_s = masked_softmax(s_s.reshape(bsz, n_h, Q_BLOCK, top_n * NSA_SEL_BLOCK), valid_s)
        p_s = p_s.reshape(bsz, n_h, Q_BLOCK, top_n, NSA_SEL_BLOCK).astype(v_sel.dtype)
        o_s = jnp.einsum('bhqnl,bqnld->bqhd', p_s, v_sel)
        k_w = lax.dynamic_slice_in_dim(kw_pad, q0, span, axis=1)
        v_w = lax.dynamic_slice_in_dim(vw_pad, q0, span, axis=1)
        kpos_w = q0 - NSA_WINDOW + win_off
        valid_w = ((kpos_w[None, :] <= t[:, None]) & (kpos_w[None, :] > t[:, None] - NSA_WINDOW)
                   & (kpos_w[None, :] >= 0))
        s_w = jnp.einsum('bqhd,bkd->bhqk', q_blk, k_w).astype(jnp.float32) * scale
        p_w = masked_softmax(s_w, valid_w)
        o_w = jnp.einsum('bhqk,bkd->bqhd', p_w.astype(v_w.dtype), v_w)
        return g_blk[..., 0:1] * o_c + g_blk[..., 1:2] * o_s + g_blk[..., 2:3] * o_w

    q_blocks = jnp.moveaxis(q.reshape(bsz, n_qb, Q_BLOCK, n_h, dh), 1, 0)
    g_blocks = jnp.moveaxis(gates.reshape(bsz, n_qb, Q_BLOCK, n_h, 3), 1, 0)
    out = lax.map(block, (jnp.arange(n_qb), q_blocks, g_blocks))
    return jnp.moveaxis(out, 0, 1).reshape(bsz, seq, n_h, dh)


def diff_attention(q, k, v, lam, norm_g, layer_idx):
    bsz, seq, n_h = q.shape[:3]
    n_qb = seq // Q_BLOCK
    lambda_init = 0.8 - 0.6 * math.exp(-0.3 * layer_idx)
    lam = lam.astype(jnp.float32)
    lam_full = jnp.exp(jnp.sum(lam[0] * lam[1])) - jnp.exp(jnp.sum(lam[2] * lam[3])) + lambda_init
    scale = DIFF_QK_DIM ** -0.5
    kpos = jnp.arange(seq)

    def block(args):
        qi, q_blk = args
        t = qi * Q_BLOCK + jnp.arange(Q_BLOCK)
        s = jnp.einsum('bqhcd,bkhcd->bhcqk', q_blk, k).astype(jnp.float32) * scale
        p = jax.nn.softmax(jnp.where(kpos[None, :] <= t[:, None], s, NEG_INF), axis=-1)
        a = p[:, :, 0] - lam_full * p[:, :, 1]
        return jnp.einsum('bhqk,bkhd->bqhd', a.astype(v.dtype), v)

    q_blocks = jnp.moveaxis(q.reshape(bsz, n_qb, Q_BLOCK, n_h, 2, DIFF_QK_DIM), 1, 0)
    out = lax.map(block, (jnp.arange(n_qb), q_blocks))
    out = jnp.moveaxis(out, 0, 1).reshape(bsz, seq, n_h, -1)
    return rmsnorm(out, norm_g) * (1.0 - lambda_init)


def ssd_chunked(x, dt, a, bm, cm):
    bsz, seq, n_h, p = x.shape
    L = SSM_CHUNK
    nc = seq // L
    xdt = (x * dt[..., None]).reshape(bsz, nc, L, n_h, p)
    bc = bm.reshape(bsz, nc, L, n_h, SSM_STATE)
    cc = cm.reshape(bsz, nc, L, n_h, SSM_STATE)
    a_cs = jnp.cumsum((dt * a).reshape(bsz, nc, L, n_h), axis=2)
    causal = jnp.tril(jnp.ones((L, L), bool))[None, None, :, :, None]
    decay = jnp.exp(jnp.where(causal, a_cs[:, :, :, None, :] - a_cs[:, :, None, :, :], -jnp.inf))
    scores = jnp.einsum('bcthn,bcshn->bctsh', cc, bc) * decay
    y_diag = jnp.einsum('bctsh,bcshp->bcthp', scores, xdt)
    decay_end = jnp.exp(a_cs[:, :, -1:, :] - a_cs)
    states = jnp.einsum('bcshn,bcsh,bcshp->bchpn', bc, decay_end, xdt)
    chunk_decay = jnp.exp(a_cs[:, :, -1, :])

    def step(h, inp):
        st, dec = inp
        return dec[..., None, None] * h + st, h

    _, prev = lax.scan(step, jnp.zeros((bsz, n_h, p, SSM_STATE), jnp.float32),
                       (jnp.moveaxis(states, 1, 0), jnp.moveaxis(chunk_decay, 1, 0)))
    prev = jnp.moveaxis(prev, 0, 1)
    y_off = jnp.einsum('bcthn,bchpn,bcth->bcthp', cc, prev, jnp.exp(a_cs))
    return (y_diag + y_off).reshape(bsz, seq, n_h, p)


def ssd_mixer(xbc, dt_raw, z, conv_w, conv_b, dt_bias, a_log, d_skip, norm_g):
    bsz, seq, _ = xbc.shape
    xbc = jax.nn.silu(causal_dwconv(xbc, conv_w, conv_b))
    xs, bm, cm = jnp.split(xbc, [D_GROUP, D_GROUP + SSM_GROUPS * SSM_STATE], axis=-1)
    rep = N_HEADS // SSM_GROUPS
    xs = xs.reshape(bsz, seq, N_HEADS, HEAD_DIM).astype(jnp.float32)
    bm = jnp.repeat(bm.reshape(bsz, seq, SSM_GROUPS, SSM_STATE), rep, axis=2).astype(jnp.float32)
    cm = jnp.repeat(cm.reshape(bsz, seq, SSM_GROUPS, SSM_STATE), rep, axis=2).astype(jnp.float32)
    dt = jax.nn.softplus(dt_raw.astype(jnp.float32) + dt_bias.astype(jnp.float32))
    a = -jnp.exp(a_log.astype(jnp.float32))
    y = ssd_chunked(xs, dt, a, bm, cm) + d_skip.astype(jnp.float32)[:, None] * xs
    y = y.reshape(bsz, seq, D_GROUP).astype(z.dtype) * jax.nn.silu(z)
    y = rmsnorm(y.reshape(bsz, seq, SSM_GROUPS, -1), norm_g.reshape(SSM_GROUPS, -1))
    return y.reshape(bsz, seq, D_GROUP)


def mlstm_chunked(q, k, v, i_pre, f_pre):
    bsz, seq, n_h, dh = q.shape
    L = MLSTM_CHUNK
    nc = seq // L
    k = k * dh ** -0.5
    q = q.reshape(bsz, nc, L, n_h, dh)
    k = k.reshape(bsz, nc, L, n_h, dh)
    v = v.reshape(bsz, nc, L, n_h, dh)
    ig = i_pre.reshape(bsz, nc, L, n_h)
    b = jnp.cumsum(jax.nn.log_sigmoid(f_pre).reshape(bsz, nc, L, n_h), axis=2)
    causal = jnp.tril(jnp.ones((L, L), bool))[None, None, :, :, None]
    d_log = jnp.where(causal, b[:, :, :, None, :] - b[:, :, None, :, :] + ig[:, :, None, :, :], -jnp.inf)
    b_last = b[:, :, -1, :]
    g_end = b_last[:, :, None, :] - b + ig
    m_loc = jnp.max(g_end, axis=2)
    w_end = jnp.exp(g_end - m_loc[:, :, None, :])
    c_loc = jnp.einsum('bcsh,bcshd,bcshe->bchde', w_end, v, k)
    n_loc = jnp.einsum('bcsh,bcshe->bche', w_end, k)

    def step(carry, inp):
        c_st, n_st, m_st = carry
        c_l, n_l, m_l, b_l = inp
        m_new = jnp.maximum(b_l + m_st, m_l)
        a_prev = jnp.exp(b_l + m_st - m_new)
        a_loc = jnp.exp(m_l - m_new)
        c_new = a_prev[..., None, None] * c_st + a_loc[..., None, None] * c_l
        n_new = a_prev[..., None] * n_st + a_loc[..., None] * n_l
        return (c_new, n_new, m_new), (c_st, n_st, m_st)

    init = (jnp.zeros((bsz, n_h, dh, dh), jnp.float32), jnp.zeros((bsz, n_h, dh), jnp.float32),
            jnp.zeros((bsz, n_h), jnp.float32))
    xs = (jnp.moveaxis(c_loc, 1, 0), jnp.moveaxis(n_loc, 1, 0), jnp.moveaxis(m_loc, 1, 0),
          jnp.moveaxis(b_last, 1, 0))
    _, (c_prev, n_prev, m_prev) = lax.scan(step, init, xs)
    c_prev = jnp.moveaxis(c_prev, 0, 1)
    n_prev = jnp.moveaxis(n_prev, 0, 1)
    m_prev = jnp.moveaxis(m_prev, 0, 1)
    a_inter = b + m_prev[:, :, None, :]
    m_t = jnp.maximum(a_inter, jnp.max(d_log, axis=3))
    w_intra = jnp.exp(d_log - m_t[:, :, :, None, :])
    s_qk = jnp.einsum('bcthd,bcshd->bctsh', q, k) * w_intra
    w_inter = jnp.exp(a_inter - m_t)
    num = (jnp.einsum('bctsh,bcshd->bcthd', s_qk, v)
           + w_inter[..., None] * jnp.einsum('bcthe,bchde->bcthd', q, c_prev))
    den = jnp.sum(s_qk, axis=3) + w_inter * jnp.einsum('bcthe,bche->bcth', q, n_prev)
    h = num / jnp.maximum(jnp.abs(den), jnp.exp(-m_t))[..., None]
    return h.reshape(bsz, seq, n_h, dh)


def hybrid_layer(x, c_act, layer_idx, norm_g, ada_w, ada_b, w_in, w_out,
                 nsa_cmp_pos, nsa_ck_w1, nsa_ck_w2, nsa_cv_w1, nsa_cv_w2, nsa_norm_g,
                 diff_lam, diff_norm_g,
                 ssm_conv_w, ssm_conv_b, ssm_dt_bias, ssm_a_log, ssm_d, ssm_norm_g,
                 ml_conv_w, ml_conv_b, ml_if_b, ml_norm_g):
    bsz, seq, _ = x.shape
    shift, scale, gate = jnp.split(c_act @ ada_w + ada_b, 3, axis=-1)
    h = rmsnorm(x, norm_g) * (1.0 + scale[:, None, :]) + shift[:, None, :]
    offsets = [int(o) for o in np.cumsum(IN_SPLITS)[:-1]]
    (a_q, a_kc, a_vc, a_ks, a_vs, a_kw, a_vw, a_g, a_z,
     b_q, b_k, b_v, b_z,
     c_z, c_xbc, c_dt,
     d_qk, d_v, d_if, d_o, d_z) = jnp.split(h @ w_in, offsets, axis=-1)

    def heads(t):
        return t.reshape(bsz, seq, N_HEADS, -1)

    y_a = nsa_attention(heads(a_q), a_kc, a_vc, a_ks, a_vs, a_kw, a_vw,
                        jax.nn.sigmoid(a_g.reshape(bsz, seq, N_HEADS, 3)),
                        nsa_cmp_pos, nsa_ck_w1, nsa_ck_w2, nsa_cv_w1, nsa_cv_w2)
    y_a = rmsnorm(y_a, nsa_norm_g).reshape(bsz, seq, D_GROUP) * jax.nn.silu(a_z)
    y_b = diff_attention(b_q.reshape(bsz, seq, N_HEADS, 2, DIFF_QK_DIM),
                         b_k.reshape(bsz, seq, N_HEADS, 2, DIFF_QK_DIM),
                         heads(b_v), diff_lam, diff_norm_g, layer_idx)
    y_b = y_b.reshape(bsz, seq, D_GROUP) * jax.nn.silu(b_z)
    y_c = ssd_mixer(c_xbc, c_dt, c_z, ssm_conv_w, ssm_conv_b, ssm_dt_bias, ssm_a_log, ssm_d, ssm_norm_g)
    qk = jax.nn.silu(causal_dwconv(d_qk, ml_conv_w, ml_conv_b))
    m_q, m_k = jnp.split(qk, 2, axis=-1)
    i_pre, f_pre = jnp.split((d_if + ml_if_b).astype(jnp.float32), 2, axis=-1)
    h_m = mlstm_chunked(heads(m_q).astype(jnp.float32), heads(m_k).astype(jnp.float32),
                        heads(d_v).astype(jnp.float32), i_pre, f_pre).astype(x.dtype)
    h_m = jax.nn.sigmoid(heads(d_o)) * h_m
    y_d = rmsnorm(h_m, ml_norm_g).reshape(bsz, seq, D_GROUP) * jax.nn.silu(d_z)
    y = jnp.concatenate([y_a, y_b, y_c, y_d], axis=-1) @ w_out
    return x + gate[:, None, :] * y


def setup_inputs(seed: int = 0) -> dict:
    key = jax.random.key(seed)
    keys = iter(jax.random.split(key, 40))

    def nrm(shape, s):
        return s * jax.random.normal(next(keys), shape, jnp.float32)

    def unif(shape, lo, hi):
        return jax.random.uniform(next(keys), shape, jnp.float32, lo, hi)

    x = nrm((BATCH, SEQ, D_MODEL), 1.0)
    c = nrm((BATCH, D_MODEL), 1.0)
    norm_g = 1.0 + nrm((DEPTH, D_MODEL), 0.05)
    ada_w = nrm((DEPTH, D_MODEL, 3 * D_MODEL), D_MODEL ** -0.5)
    ada_b = nrm((DEPTH, 3 * D_MODEL), 0.02)
    w_in = nrm((DEPTH, D_MODEL, D_IN_PROJ), D_MODEL ** -0.5)
    w_out = nrm((DEPTH, D_MIX, D_MODEL), D_MIX ** -0.5)
    nsa_cmp_pos = nrm((DEPTH, NSA_CMP_BLOCK, HEAD_DIM), 0.1)
    cmp_in = NSA_CMP_BLOCK * HEAD_DIM
    nsa_ck_w1 = nrm((DEPTH, cmp_in, NSA_CMP_HIDDEN), cmp_in ** -0.5)
    nsa_ck_w2 = nrm((DEPTH, NSA_CMP_HIDDEN, HEAD_DIM), NSA_CMP_HIDDEN ** -0.5)
    nsa_cv_w1 = nrm((DEPTH, cmp_in, NSA_CMP_HIDDEN), cmp_in ** -0.5)
    nsa_cv_w2 = nrm((DEPTH, NSA_CMP_HIDDEN, HEAD_DIM), NSA_CMP_HIDDEN ** -0.5)
    nsa_norm_g = 1.0 + nrm((DEPTH, HEAD_DIM), 0.05)
    diff_lam = nrm((DEPTH, 4, DIFF_QK_DIM), 0.1)
    diff_norm_g = 1.0 + nrm((DEPTH, HEAD_DIM), 0.05)
    ssm_conv_w = nrm((DEPTH, CONV_WIDTH, SSM_XBC), CONV_WIDTH ** -0.5)
    ssm_conv_b = nrm((DEPTH, SSM_XBC), 0.02)
    dt0 = jnp.exp(unif((DEPTH, N_HEADS), math.log(1e-3), math.log(1e-1)))
    ssm_dt_bias = dt0 + jnp.log(-jnp.expm1(-dt0))
    ssm_a_log = jnp.log(unif((DEPTH, N_HEADS), 1.0, 16.0))
    ssm_d = 1.0 + nrm((DEPTH, N_HEADS), 0.1)
    ssm_norm_g = 1.0 + nrm((DEPTH, D_GROUP), 0.05)
    ml_conv_w = nrm((DEPTH, CONV_WIDTH, 2 * D_GROUP), CONV_WIDTH ** -0.5)
    ml_conv_b = nrm((DEPTH, 2 * D_GROUP), 0.02)
    f_bias = jnp.broadcast_to(jnp.linspace(3.0, 6.0, N_HEADS), (DEPTH, N_HEADS)) + nrm((DEPTH, N_HEADS), 0.1)
    ml_if_b = jnp.concatenate([nrm((DEPTH, N_HEADS), 0.1), f_bias], axis=-1)
    ml_norm_g = 1.0 + nrm((DEPTH, HEAD_DIM), 0.05)
    final_g = 1.0 + nrm((D_MODEL,), 0.05)
    return {'x': x, 'c': c, 'norm_g': norm_g, 'ada_w': ada_w, 'ada_b': ada_b, 'w_in': w_in, 'w_out': w_out,
            'nsa_cmp_pos': nsa_cmp_pos, 'nsa_ck_w1': nsa_ck_w1, 'nsa_ck_w2': nsa_ck_w2,
            'nsa_cv_w1': nsa_cv_w1, 'nsa_cv_w2': nsa_cv_w2, 'nsa_norm_g': nsa_norm_g,
            'diff_lam': diff_lam, 'diff_norm_g': diff_norm_g,
            'ssm_conv_w': ssm_conv_w, 'ssm_conv_b': ssm_conv_b, 'ssm_dt_bias': ssm_dt_bias,
            'ssm_a_log': ssm_a_log, 'ssm_d': ssm_d, 'ssm_norm_g': ssm_norm_g,
            'ml_conv_w': ml_conv_w, 'ml_conv_b': ml_conv_b, 'ml_if_b': ml_if_b, 'ml_norm_g': ml_norm_g,
            'final_g': final_g}


def reference(x, c, norm_g, ada_w, ada_b, w_in, w_out,
              nsa_cmp_pos, nsa_ck_w1, nsa_ck_w2, nsa_cv_w1, nsa_cv_w2, nsa_norm_g,
              diff_lam, diff_norm_g,
              ssm_conv_w, ssm_conv_b, ssm_dt_bias, ssm_a_log, ssm_d, ssm_norm_g,
              ml_conv_w, ml_conv_b, ml_if_b, ml_norm_g, final_g):
    c_act = jax.nn.silu(c)
    for l in range(DEPTH):
        x = hybrid_layer(x, c_act, l, norm_g[l], ada_w[l], ada_b[l], w_in[l], w_out[l],
                         nsa_cmp_pos[l], nsa_ck_w1[l], nsa_ck_w2[l], nsa_cv_w1[l], nsa_cv_w2[l], nsa_norm_g[l],
                         diff_lam[l], diff_norm_g[l],
                         ssm_conv_w[l], ssm_conv_b[l], ssm_dt_bias[l], ssm_a_log[l], ssm_d[l], ssm_norm_g[l],
                         ml_conv_w[l], ml_conv_b[l], ml_if_b[l], ml_norm_g[l])
    return rmsnorm(x, final_g)
```

```cpp
#include <hip/hip_runtime.h>
#include <hip/hip_cooperative_groups.h>
#include <cstdio>
#include <cstdint>
#define DEBUG_CHECK 0
#define DEBUG_STAGE 1
namespace cg = cooperative_groups;

typedef unsigned short u16;
typedef short bf16x8 __attribute__((ext_vector_type(8)));
typedef short s16x4 __attribute__((ext_vector_type(4)));
typedef float f32x4 __attribute__((ext_vector_type(4)));
typedef float f32x2 __attribute__((ext_vector_type(2)));
typedef unsigned u32x4 __attribute__((ext_vector_type(4)));
typedef unsigned u32x2 __attribute__((ext_vector_type(2)));
typedef __bf16 bf16x2_t __attribute__((ext_vector_type(2)));
#define DI __device__ __forceinline__
#define LDSP __attribute__((address_space(3)))

constexpr int D_MODEL = 1024, BATCH = 8, SEQ = 4096, NTOK = BATCH * SEQ;
constexpr int D_IN = 3992;
constexpr int NP = 3968, NPAD = 4096, NSMALL = 32;
constexpr int PA_Q = 0, PA_KC = 256, PA_VC = 320, PA_KS = 384, PA_VS = 448, PA_KW = 512, PA_VW = 576, PA_Z = 640;
constexpr int PB_Q = 896, PB_K = 1152, PB_V = 1408, PB_Z = 1664;
constexpr int PC_Z = 1920, PC_XBC = 2176;
constexpr int PD_QK = 2688, PD_V = 3200, PD_O = 3456, PD_Z = 3712;
constexpr int SM_G = 0, SM_DT = 12, SM_IF = 16;
constexpr int Y_A = 0, Y_B = 256, Y_C = 512, Y_D = 768;

constexpr size_t MiB = 1024 * 1024;
constexpr size_t OFF_WINT = 0;
constexpr size_t OFF_WOUTT = 16 * MiB;
constexpr size_t OFF_W1T = 20 * MiB;
constexpr size_t OFF_W2T = 22 * MiB;
constexpr size_t OFF_BIAS1 = 22 * MiB + 64 * 1024;
constexpr size_t OFF_ADAP = 22 * MiB + 128 * 1024;
constexpr size_t OFF_KCMP = 24 * MiB;
constexpr size_t OFF_VCMP = 24 * MiB + 256 * 1024;
constexpr size_t OFF_CNT = 24 * MiB + 512 * 1024;
constexpr size_t OFF_SMALL = 25 * MiB;
constexpr size_t OFF_SSQ = 29 * MiB;
constexpr size_t OFF_H = 32 * MiB;
constexpr size_t OFF_PROJ = 96 * MiB;
constexpr size_t WS_NEEDED = 96 * MiB + (size_t)NTOK * NP * 2;

struct Params {
  const float* x; const float* c; const float* norm_g; const float* ada_w; const float* ada_b;
  const float* w_in; const float* w_out;
  const float* nsa_cmp_pos; const float* nsa_ck_w1; const float* nsa_ck_w2; const float* nsa_cv_w1; const float* nsa_cv_w2; const float* nsa_norm_g;
  const float* diff_lam; const float* diff_norm_g;
  const float* ssm_conv_w; const float* ssm_conv_b; const float* ssm_dt_bias; const float* ssm_a_log; const float* ssm_d; const float* ssm_norm_g;
  const float* ml_conv_w; const float* ml_conv_b; const float* ml_if_b; const float* ml_norm_g; const float* final_g;
  float* out; unsigned char* ws;
};

DI int otid() { int t = threadIdx.x; asm volatile("" : "+v"(t)); return t; }
DI unsigned pack2(float a, float b) { f32x2 v = {a, b}; bf16x2_t r = __builtin_convertvector(v, bf16x2_t); return __builtin_bit_cast(unsigned, r); }
DI u16 f2bf(float a) { return (u16)(pack2(a, 0.f) & 0xffffu); }
DI float bf2f(u16 h) { return __uint_as_float(((unsigned)h) << 16); }
DI float bflo(unsigned u) { return __uint_as_float(u << 16); }
DI float bfhi(unsigned u) { return __uint_as_float(u & 0xffff0000u); }
DI f32x4 mfma16(bf16x8 a, bf16x8 b, f32x4 c) { return __builtin_amdgcn_mfma_f32_16x16x32_bf16(a, b, c, 0, 0, 0); }
DI float wave_sum(float v) {
#pragma unroll
  for (int o = 32; o > 0; o >>= 1) v += __shfl_xor(v, o);
  return v;
}
DI float siluf(float v) { return v / (1.f + __expf(-v)); }
DI float sigmoidf_(float v) { return 1.f / (1.f + __expf(-v)); }
DI float exp2_(float v) { return __builtin_amdgcn_exp2f(v); }
DI s16x4 tr_read(const u16* p) { return __builtin_amdgcn_ds_read_tr16_b64_v4i16((LDSP s16x4*)p); }
DI bf16x8 cat4(s16x4 a, s16x4 b) { bf16x8 r; r[0] = a[0]; r[1] = a[1]; r[2] = a[2]; r[3] = a[3]; r[4] = b[0]; r[5] = b[1]; r[6] = b[2]; r[7] = b[3]; return r; }
DI bf16x8 ldfrag(const u16* p) { return *(const bf16x8*)p; }

DI int colmap(int n) {
  if (n < 640) return n;
  if (n < 896) return 652 + (n - 640);
  if (n < 1920) return 908 + (n - 896);
  if (n < 2688) return 1932 + (n - 1920);
  if (n < 3456) return 2704 + (n - 2688);
  if (n < 3968) return 3480 + (n - 3456);
  if (n < 3980) return 640 + (n - 3968);
  if (n < 3984) return 2700 + (n - 3980);
  if (n < 3992) return 3472 + (n - 3984);
  return -1;
}

DI void tconv_tile(const float* __restrict__ src, int ldsrc, int k0, int n0, u16* __restrict__ dst, int ldd, bool use_map, unsigned char* smem) {
  float* tile = (float*)smem;
  const int tid = otid();
  __syncthreads();
  {
    const int nn = tid & 63; int col = n0 + nn; if (use_map) col = colmap(col);
#pragma unroll
    for (int i = 0; i < 16; ++i) { const int kk = i * 4 + (tid >> 6); tile[kk * 65 + nn] = col >= 0 ? src[(size_t)(k0 + kk) * ldsrc + col] : 0.f; }
  }
  __syncthreads();
#pragma unroll
  for (int i = 0; i < 2; ++i) {
    const int item = tid + 256 * i, nn = item >> 3, kc = item & 7;
    u32x4 w;
    w.x = pack2(tile[(kc * 8 + 0) * 65 + nn], tile[(kc * 8 + 1) * 65 + nn]);
    w.y = pack2(tile[(kc * 8 + 2) * 65 + nn], tile[(kc * 8 + 3) * 65 + nn]);
    w.z = pack2(tile[(kc * 8 + 4) * 65 + nn], tile[(kc * 8 + 5) * 65 + nn]);
    w.w = pack2(tile[(kc * 8 + 6) * 65 + nn], tile[(kc * 8 + 7) * 65 + nn]);
    *(u32x4*)(dst + (size_t)(n0 + nn) * ldd + k0 + kc * 8) = w;
  }
}

constexpr int T0_WIN = 2 * 16 * 64, T0_WOUT = 2 * 16 * 16, T0_W1 = 4 * 32 * 2, T0_W2 = 4 * 2, T0_ADA = 2 * 12 * 8, T0_B1 = 4;
constexpr int T0_TOTAL = T0_WIN + T0_WOUT + T0_W1 + T0_W2 + T0_ADA + T0_B1;

DI void phase0_task(const Params& p, int t, unsigned char* smem) {
  const int tid = otid();
  if (t < T0_WIN) {
    const int l = t / 1024, r = t % 1024, kt = r / 64, nt = r % 64;
    tconv_tile(p.w_in + (size_t)l * D_MODEL * D_IN, D_IN, kt * 64, nt * 64, (u16*)(p.ws + OFF_WINT) + (size_t)l * NPAD * 1024, 1024, true, smem);
    return;
  }
  t -= T0_WIN;
  if (t < T0_WOUT) {
    const int l = t / 256, r = t % 256, kt = r / 16, nt = r % 16;
    tconv_tile(p.w_out + (size_t)l * 1024 * 1024, 1024, kt * 64, nt * 64, (u16*)(p.ws + OFF_WOUTT) + (size_t)l * 1024 * 1024, 1024, false, smem);
    return;
  }
  t -= T0_WOUT;
  if (t < T0_W1) {
    const int m = t / 64, r = t % 64, kt = r / 2, nt = r % 2, l = m >> 1, kv = m & 1;
    const float* src = (kv ? p.nsa_cv_w1 : p.nsa_ck_w1) + (size_t)l * 2048 * 128;
    tconv_tile(src, 128, kt * 64, nt * 64, (u16*)(p.ws + OFF_W1T) + (size_t)m * 128 * 2048, 2048, false, smem);
    return;
  }
  t -= T0_W1;
  if (t < T0_W2) {
    const int m = t / 2, kt = t % 2, l = m >> 1, kv = m & 1;
    const float* src = (kv ? p.nsa_cv_w2 : p.nsa_ck_w2) + (size_t)l * 128 * 64;
    tconv_tile(src, 64, kt * 64, 0, (u16*)(p.ws + OFF_W2T) + (size_t)m * 64 * 128, 128, false, smem);
    return;
  }
  t -= T0_W2;
  if (t < T0_ADA) {
    const int l = t / 96, r = t % 96, nc = r / 8, kc = r % 8;
    float* cact = (float*)smem;
    __syncthreads();
    for (int i = tid; i < 1024; i += 256) { const int b = i >> 7, kk = i & 127; const float v = p.c[b * 1024 + kc * 128 + kk]; cact[i] = siluf(v); }
    __syncthreads();
    const int n = nc * 256 + tid;
    float acc[8];
#pragma unroll
    for (int b = 0; b < 8; ++b) acc[b] = 0.f;
    const float* w = p.ada_w + ((size_t)l * 1024 + kc * 128) * 3072 + n;
    for (int kk = 0; kk < 128; ++kk) {
      const float wv = w[(size_t)kk * 3072];
#pragma unroll
      for (int b = 0; b < 8; ++b) acc[b] += cact[b * 128 + kk] * wv;
    }
    float* adap = (float*)(p.ws + OFF_ADAP);
    const float bias = kc == 0 ? p.ada_b[l * 3072 + n] : 0.f;
#pragma unroll
    for (int b = 0; b < 8; ++b) adap[(((size_t)kc * 2 + l) * 8 + b) * 3072 + n] = acc[b] + bias;
    return;
  }
  t -= T0_ADA;
  {
    const int l = t >> 1, kv = t & 1;
    const float* w1 = (kv ? p.nsa_cv_w1 : p.nsa_ck_w1) + (size_t)l * 2048 * 128;
    const float* pos = p.nsa_cmp_pos + (size_t)l * 2048;
    const int n = tid & 127, half = tid >> 7;
    float acc = 0.f;
    for (int k = half * 1024; k < half * 1024 + 1024; ++k) acc += pos[k] * w1[(size_t)k * 128 + n];
    float* red = (float*)smem;
    __syncthreads();
    red[tid] = acc;
    __syncthreads();
    if (tid < 128) ((float*)(p.ws + OFF_BIAS1))[t * 128 + tid] = red[tid] + red[tid + 128];
  }
}

DI void phase1_task(const Params& p, int layer, const float* xin, int grp, unsigned char* smem) {
  const int tid = otid(), lane = tid & 63, wid = tid >> 6;
  const int b = grp >> 6;
  float* mul = (float*)smem;
  float* sh = mul + 1024;
  const float* adap = (const float*)(p.ws + OFF_ADAP);
  __syncthreads();
  for (int c = tid; c < 1024; c += 256) {
    float s0 = 0.f, s1 = 0.f;
#pragma unroll
    for (int kc = 0; kc < 8; ++kc) { const float* a = adap + (((size_t)kc * 2 + layer) * 8 + b) * 3072; s0 += a[c]; s1 += a[1024 + c]; }
    mul[c] = p.norm_g[layer * 1024 + c] * (1.f + s1); sh[c] = s0;
  }
  __syncthreads();
  u16* H = (u16*)(p.ws + OFF_H);
  for (int rr = wid; rr < 64; rr += 4) {
    const int row = grp * 64 + rr;
    const float4* xr = (const float4*)(xin + (size_t)row * D_MODEL);
    float4 v[4]; float ss = 0.f;
#pragma unroll
    for (int i = 0; i < 4; ++i) { v[i] = xr[lane + 64 * i]; ss += v[i].x * v[i].x + v[i].y * v[i].y + v[i].z * v[i].z + v[i].w * v[i].w; }
    ss = wave_sum(ss);
    const float r = rsqrtf(ss * (1.f / D_MODEL) + 1e-6f);
#pragma unroll
    for (int i = 0; i < 4; ++i) {
      const int c = (lane + 64 * i) * 4;
      u32x2 w;
      w.x = pack2(v[i].x * r * mul[c] + sh[c], v[i].y * r * mul[c + 1] + sh[c + 1]);
      w.y = pack2(v[i].z * r * mul[c + 2] + sh[c + 2], v[i].w * r * mul[c + 3] + sh[c + 3]);
      *(u32x2*)(H + (size_t)row * 1024 + c) = w;
    }
  }
}

constexpr int GLD = 72;
DI void gemm_mainloop(const u16* __restrict__ A, int lda, const u16* __restrict__ Bt, int ldb, int K, int m0, int n0, unsigned char* smem, f32x4 (&acc)[4][4]) {
  u16* As = (u16*)smem; u16* Bs = As + 128 * GLD;
  const int tid = otid(), lane = tid & 63, wid = tid >> 6, wr = wid >> 1, wc = wid & 1, l15 = lane & 15, g = lane >> 4;
#pragma unroll
  for (int j = 0; j < 4; ++j)
#pragma unroll
    for (int i = 0; i < 4; ++i) acc[j][i] = (f32x4){0.f, 0.f, 0.f, 0.f};
  u32x4 ra[4], rb[4];
  const int lrow = tid >> 3, lch = tid & 7;
  const u16* ap = A + (size_t)(m0 + lrow) * lda + lch * 8;
  const u16* bp = Bt + (size_t)(n0 + lrow) * ldb + lch * 8;
#pragma unroll
  for (int i = 0; i < 4; ++i) { ra[i] = *(const u32x4*)(ap + (size_t)(32 * i) * lda); rb[i] = *(const u32x4*)(bp + (size_t)(32 * i) * ldb); }
  const int nk = K / 64;
  for (int kt = 0; kt < nk; ++kt) {
    __syncthreads();
#pragma unroll
    for (int i = 0; i < 4; ++i) { *(u32x4*)(As + (lrow + 32 * i) * GLD + lch * 8) = ra[i]; *(u32x4*)(Bs + (lrow + 32 * i) * GLD + lch * 8) = rb[i]; }
    __syncthreads();
    if (kt + 1 < nk) {
      const int k1 = (kt + 1) * 64;
#pragma unroll
      for (int i = 0; i < 4; ++i) { ra[i] = *(const u32x4*)(ap + (size_t)(32 * i) * lda + k1); rb[i] = *(const u32x4*)(bp + (size_t)(32 * i) * ldb + k1); }
    }
#pragma unroll
    for (int ks = 0; ks < 2; ++ks) {
      bf16x8 af[4], bfr[4];
#pragma unroll
      for (int i = 0; i < 4; ++i) af[i] = ldfrag(As + (wr * 64 + i * 16 + l15) * GLD + ks * 32 + 8 * g);
#pragma unroll
      for (int j = 0; j < 4; ++j) bfr[j] = ldfrag(Bs + (wc * 64 + j * 16 + l15) * GLD + ks * 32 + 8 * g);
#pragma unroll
      for (int j = 0; j < 4; ++j)
#pragma unroll
        for (int i = 0; i < 4; ++i) acc[j][i] = mfma16(bfr[j], af[i], acc[j][i]);
    }
  }
}

DI void gemm_inproj_tile(const Params& p, int layer, int tile, unsigned char* smem) {
  const int mt = tile >> 5, nt = tile & 31, m0 = mt * 128, n0 = nt * 128;
  const int tid = otid(), lane = tid & 63, wid = tid >> 6, wr = wid >> 1, wc = wid & 1, l15 = lane & 15, g = lane >> 4;
  f32x4 acc[4][4];
  gemm_mainloop((const u16*)(p.ws + OFF_H), 1024, (const u16*)(p.ws + OFF_WINT) + (size_t)layer * NPAD * 1024, 1024, 1024, m0, n0, smem, acc);
  if (nt == 31) {
    if (wc == 0) {
      float* sm = (float*)(p.ws + OFF_SMALL);
#pragma unroll
      for (int j = 0; j < 2; ++j)
#pragma unroll
        for (int i = 0; i < 4; ++i) {
          const int m = m0 + wr * 64 + i * 16 + l15, n = j * 16 + 4 * g;
          *(f32x4*)(sm + (size_t)m * NSMALL + n) = acc[j][i];
        }
    }
    return;
  }
  constexpr int CLD = 136;
  u16* Cs = (u16*)smem;
  __syncthreads();
#pragma unroll
  for (int j = 0; j < 4; ++j)
#pragma unroll
    for (int i = 0; i < 4; ++i) {
      const int ml = wr * 64 + i * 16 + l15, nl = wc * 64 + j * 16 + 4 * g;
      u32x2 w; w.x = pack2(acc[j][i][0], acc[j][i][1]); w.y = pack2(acc[j][i][2], acc[j][i][3]);
      *(u32x2*)(Cs + ml * CLD + nl) = w;
    }
  __syncthreads();
  u16* proj = (u16*)(p.ws + OFF_PROJ);
#pragma unroll
  for (int i = 0; i < 8; ++i) {
    const int id = tid + 256 * i, row = id >> 4, ch = id & 15;
    *(u32x4*)(proj + (size_t)(m0 + row) * NP + n0 + ch * 8) = *(const u32x4*)(Cs + row * CLD + ch * 8);
  }
}

DI void gemm_outproj_tile(const Params& p, int layer, const float* xin, float* xout, int tile, unsigned char* smem) {
  const int mt = tile >> 3, nt = tile & 7, m0 = mt * 128, n0 = nt * 128;
  const int tid = otid(), lane = tid & 63, wid = tid >> 6, wr = wid >> 1, wc = wid & 1, l15 = lane & 15, g = lane >> 4;
  f32x4 acc[4][4];
  gemm_mainloop((const u16*)(p.ws + OFF_H), 1024, (const u16*)(p.ws + OFF_WOUTT) + (size_t)layer * 1024 * 1024, 1024, 1024, m0, n0, smem, acc);
  const int b = m0 >> 12;
  const float* adap = (const float*)(p.ws + OFF_ADAP);
#pragma unroll
  for (int j = 0; j < 4; ++j) {
    const int n = n0 + wc * 64 + j * 16 + 4 * g;
    f32x4 gt = {0.f, 0.f, 0.f, 0.f};
#pragma unroll
    for (int kc = 0; kc < 8; ++kc) gt += *(const f32x4*)(adap + (((size_t)kc * 2 + layer) * 8 + b) * 3072 + 2048 + n);
#pragma unroll
    for (int i = 0; i < 4; ++i) {
      const int m = m0 + wr * 64 + i * 16 + l15;
      const f32x4 xv = *(const f32x4*)(xin + (size_t)m * 1024 + n);
      *(f32x4*)(xout + (size_t)m * 1024 + n) = xv + gt * acc[j][i];
    }
  }
}

constexpr int KLD = 72;
struct KVRegs { u32x4 k[2], v[2]; };
DI void kv_load(const u16* kbase, const u16* vbase, int ldk, int ldv, int key0, KVRegs& r) {
  const int tid = otid();
#pragma unroll
  for (int i = 0; i < 2; ++i) {
    const int id = tid + 256 * i, row = id >> 3, ch = id & 7;
    r.k[i] = *(const u32x4*)(kbase + (size_t)(key0 + row) * ldk + ch * 8);
    r.v[i] = *(const u32x4*)(vbase + (size_t)(key0 + row) * ldv + ch * 8);
  }
}
DI void kv_store(u16* Ks, u16* Vs, const KVRegs& r) {
  const int tid = otid();
#pragma unroll
  for (int i = 0; i < 2; ++i) {
    const int id = tid + 256 * i, row = id >> 3, ch = id & 7;
    *(u32x4*)(Ks + row * KLD + ch * 8) = r.k[i];
    *(u32x4*)(Vs + row * KLD + ch * 8) = r.v[i];
  }
}
struct AttnAcc { f32x4 o[4][2]; float m[2], l[2]; };
DI void attn_init(AttnAcc& a) {
#pragma unroll
  for (int d = 0; d < 4; ++d) { a.o[d][0] = (f32x4){0.f, 0.f, 0.f, 0.f}; a.o[d][1] = (f32x4){0.f, 0.f, 0.f, 0.f}; }
  a.m[0] = a.m[1] = -1e30f; a.l[0] = a.l[1] = 0.f;
}
template <int NKS>
DI void qk_tile(const u16* Ks, int dofs, const bf16x8 (&qf)[2][NKS], f32x4 (&s)[4][2], int l15, int g) {
#pragma unroll
  for (int kt = 0; kt < 4; ++kt) {
    s[kt][0] = (f32x4){0.f, 0.f, 0.f, 0.f}; s[kt][1] = (f32x4){0.f, 0.f, 0.f, 0.f};
#pragma unroll
    for (int ks = 0; ks < NKS; ++ks) {
      const bf16x8 a = ldfrag(Ks + (kt * 16 + l15) * KLD + dofs + ks * 32 + 8 * g);
      s[kt][0] = mfma16(a, qf[0][ks], s[kt][0]);
      s[kt][1] = mfma16(a, qf[1][ks], s[kt][1]);
    }
  }
}
DI void pv_accum(const bf16x8 (&pf)[2][2], const u16* Vs, f32x4 (&o)[4][2], int l15, int g) {
  const int tq = l15 >> 2, tp = l15 & 3;
#pragma unroll
  for (int kk = 0; kk < 2; ++kk)
#pragma unroll
    for (int d = 0; d < 4; ++d) {
      const bf16x8 vf = cat4(tr_read(Vs + (kk * 32 + 4 * g + tq) * KLD + d * 16 + 4 * tp), tr_read(Vs + (kk * 32 + 16 + 4 * g + tq) * KLD + d * 16 + 4 * tp));
      o[d][0] = mfma16(vf, pf[0][kk], o[d][0]);
      o[d][1] = mfma16(vf, pf[1][kk], o[d][1]);
    }
}
DI void pack_p(const f32x4 (&s)[4][2], bf16x8 (&pf)[2][2]) {
#pragma unroll
  for (int qt = 0; qt < 2; ++qt)
#pragma unroll
    for (int kk = 0; kk < 2; ++kk) {
      u32x4 w;
      w.x = pack2(s[2 * kk][qt][0], s[2 * kk][qt][1]); w.y = pack2(s[2 * kk][qt][2], s[2 * kk][qt][3]);
      w.z = pack2(s[2 * kk + 1][qt][0], s[2 * kk + 1][qt][1]); w.w = pack2(s[2 * kk + 1][qt][2], s[2 * kk + 1][qt][3]);
      pf[qt][kk] = __builtin_bit_cast(bf16x8, w);
    }
}
template <class VF>
DI void softmax_pv(f32x4 (&s)[4][2], AttnAcc& a, const u16* Vs, float sc, int l15, int g, VF valid) {
  bf16x8 pf[2][2];
#pragma unroll
  for (int qt = 0; qt < 2; ++qt) {
    float mx = -1e30f;
#pragma unroll
    for (int kt = 0; kt < 4; ++kt)
#pragma unroll
      for (int r = 0; r < 4; ++r) { const float v = valid(kt, r, qt) ? s[kt][qt][r] * sc : -1e30f; s[kt][qt][r] = v; mx = fmaxf(mx, v); }
    mx = fmaxf(mx, __shfl_xor(mx, 16)); mx = fmaxf(mx, __shfl_xor(mx, 32));
    const float mn = fmaxf(a.m[qt], mx), alpha = exp2_(a.m[qt] - mn);
    a.m[qt] = mn;
    float ls = 0.f;
#pragma unroll
    for (int kt = 0; kt < 4; ++kt)
#pragma unroll
      for (int r = 0; r < 4; ++r) { const float v = s[kt][qt][r]; const float pv = v > -1e29f ? exp2_(v - mn) : 0.f; s[kt][qt][r] = pv; ls += pv; }
    a.l[qt] = a.l[qt] * alpha + ls;
#pragma unroll
    for (int d = 0; d < 4; ++d) a.o[d][qt] *= alpha;
#pragma unroll
    for (int kk = 0; kk < 2; ++kk) {
      u32x4 w;
      w.x = pack2(s[2 * kk][qt][0], s[2 * kk][qt][1]); w.y = pack2(s[2 * kk][qt][2], s[2 * kk][qt][3]);
      w.z = pack2(s[2 * kk + 1][qt][0], s[2 * kk + 1][qt][1]); w.w = pack2(s[2 * kk + 1][qt][2], s[2 * kk + 1][qt][3]);
      pf[qt][kk] = __builtin_bit_cast(bf16x8, w);
    }
  }
  pv_accum(pf, Vs, a.o, l15, g);
}
DI float group_sum4(float v) { v += __shfl_xor(v, 16); v += __shfl_xor(v, 32); return v; }

DI void diff_attn_task(const Params& p, int layer, int b, int h, int qb, unsigned char* smem) {
  u16* Ks = (u16*)smem; u16* Vs = Ks + 64 * KLD;
  const int tid = otid(), lane = tid & 63, wid = tid >> 6, l15 = lane & 15, g = lane >> 4;
  const u16* proj = (const u16*)(p.ws + OFF_PROJ) + (size_t)b * SEQ * NP;
  const int q0w = qb * 128 + wid * 32;
  const float* lam = p.diff_lam + layer * 128;
  float s01 = 0.f, s23 = 0.f;
  for (int i = 0; i < 32; ++i) { s01 += lam[i] * lam[32 + i]; s23 += lam[64 + i] * lam[96 + i]; }
  const float lam_init = 0.8f - 0.6f * __expf(-0.3f * (float)layer);
  const float lam_full = __expf(s01) - __expf(s23) + lam_init;
  const float sc = 0.17677669529663687f * 1.4426950408889634f;
  const int ntile = 2 * qb + 2;
  const u16* vbase = proj + PB_V + h * 64;
  f32x4 res[4][2];
#pragma unroll 1
  for (int c = 0; c < 2; ++c) {
    const u16* kbase = proj + PB_K + h * 64 + c * 32;
    bf16x8 qf[2][1];
#pragma unroll
    for (int qt = 0; qt < 2; ++qt) qf[qt][0] = ldfrag(proj + (size_t)(q0w + qt * 16 + l15) * NP + PB_Q + h * 64 + c * 32 + 8 * g);
    AttnAcc a; attn_init(a);
    KVRegs kr; kv_load(kbase, vbase, NP, NP, 0, kr);
    for (int j = 0; j < ntile; ++j) {
      __syncthreads();
      kv_store(Ks, Vs, kr);
      __syncthreads();
      if (j + 1 < ntile) kv_load(kbase, vbase, NP, NP, (j + 1) * 64, kr);
      const int key0 = j * 64;
      if (key0 <= q0w + 31) {
        f32x4 s[4][2];
        auto valid = [&](int kt, int r, int qt) { return key0 + kt * 16 + 4 * g + r <= q0w + qt * 16 + l15; };
        qk_tile<1>(Ks, 0, qf, s, l15, g);
        softmax_pv(s, a, Vs, sc, l15, g, valid);
      }
    }
#pragma unroll
    for (int qt = 0; qt < 2; ++qt) {
      const float lt = group_sum4(a.l[qt]);
      const float inv = c == 0 ? 1.f / lt : -lam_full / lt;
#pragma unroll
      for (int d = 0; d < 4; ++d) res[d][qt] = c == 0 ? a.o[d][qt] * inv : res[d][qt] + a.o[d][qt] * inv;
    }
  }
  u16* Y = (u16*)(p.ws + OFF_H);
  const float* ng = p.diff_norm_g + layer * 64;
#pragma unroll
  for (int qt = 0; qt < 2; ++qt) {
    float ss = 0.f;
#pragma unroll
    for (int d = 0; d < 4; ++d) { const f32x4 v = res[d][qt]; ss += v[0] * v[0] + v[1] * v[1] + v[2] * v[2] + v[3] * v[3]; }
    ss = group_sum4(ss);
    const float rn = rsqrtf(ss * (1.f / 64.f) + 1e-6f) * (1.f - lam_init);
    const int t = q0w + qt * 16 + l15;
    const size_t row = (size_t)b * SEQ + t;
#pragma unroll
    for (int d = 0; d < 4; ++d) {
      const int dd = d * 16 + 4 * g;
      const f32x4 v = res[d][qt];
      const u32x2 zz = *(const u32x2*)(proj + (size_t)t * NP + PB_Z + h * 64 + dd);
      const f32x4 gg = *(const f32x4*)(ng + dd);
      u32x2 w;
      w.x = pack2(v[0] * rn * gg[0] * siluf(bflo(zz.x)), v[1] * rn * gg[1] * siluf(bfhi(zz.x)));
      w.y = pack2(v[2] * rn * gg[2] * siluf(bflo(zz.y)), v[3] * rn * gg[3] * siluf(bfhi(zz.y)));
      *(u32x2*)(Y + row * 1024 + Y_B + h * 64 + dd) = w;
    }
  }
}

DI void conv_silu_stage(const u16* projb, int col0, const float* cw, const float* cb, int chan0, int nchan, int t0, u16* dst, const float* rowscale, float cscale) {
  const int tid = otid(), ch = (tid & 7) * 8;
  float w[4][8], bias[8];
#pragma unroll
  for (int j = 0; j < 4; ++j)
#pragma unroll
    for (int i = 0; i < 8; ++i) w[j][i] = cw[j * nchan + chan0 + ch + i];
#pragma unroll
  for (int i = 0; i < 8; ++i) bias[i] = cb[chan0 + ch + i];
#pragma unroll 1
  for (int ps = 0; ps < 4; ++ps) {
    const int row = ps * 32 + (tid >> 3), t = t0 + row;
    float acc[8];
#pragma unroll
    for (int i = 0; i < 8; ++i) acc[i] = bias[i];
#pragma unroll
    for (int j = 0; j < 4; ++j) {
      const int tt = t - 3 + j;
      if (tt >= 0) {
        const u32x4 v = *(const u32x4*)(projb + (size_t)tt * NP + col0 + ch);
        acc[0] += w[j][0] * bflo(v.x); acc[1] += w[j][1] * bfhi(v.x); acc[2] += w[j][2] * bflo(v.y); acc[3] += w[j][3] * bfhi(v.y);
        acc[4] += w[j][4] * bflo(v.z); acc[5] += w[j][5] * bfhi(v.z); acc[6] += w[j][6] * bflo(v.w); acc[7] += w[j][7] * bfhi(v.w);
      }
    }
    const float rs = (rowscale ? rowscale[row] : 1.f) * cscale;
#pragma unroll
    for (int i = 0; i < 8; ++i) acc[i] = siluf(acc[i]) * rs;
    u32x4 o; o.x = pack2(acc[0], acc[1]); o.y = pack2(acc[2], acc[3]); o.z = pack2(acc[4], acc[5]); o.w = pack2(acc[6], acc[7]);
    *(u32x4*)(dst + row * KLD + ch) = o;
  }
}
DI float block_scan128_add(float v, float* tmp) {
  const int tid = otid(), lane = tid & 63;
  float x = v;
#pragma unroll
  for (int o = 1; o < 64; o <<= 1) { const float y = __shfl_up(x, o); if (lane >= o) x += y; }
  __syncthreads();
  if (tid == 63) tmp[0] = x;
  __syncthreads();
  if ((tid >> 6) == 1) x += tmp[0];
  return x;
}
DI float block_scan128_max(float v, float* tmp) {
  const int tid = otid(), lane = tid & 63;
  float x = v;
#pragma unroll
  for (int o = 1; o < 64; o <<= 1) { const float y = __shfl_up(x, o); if (lane >= o) x = fmaxf(x, y); }
  __syncthreads();
  if (tid == 63) tmp[0] = x;
  __syncthreads();
  if ((tid >> 6) == 1) x = fmaxf(x, tmp[0]);
  return x;
}
DI void scale_rows(u16* A, const float* rs) {
  const int tid = otid(), ch = (tid & 7) * 8;
#pragma unroll
  for (int ps = 0; ps < 4; ++ps) {
    const int row = ps * 32 + (tid >> 3);
    const float f = rs[row];
    u32x4 v = *(u32x4*)(A + row * KLD + ch);
    v.x = pack2(bflo(v.x) * f, bfhi(v.x) * f); v.y = pack2(bflo(v.y) * f, bfhi(v.y) * f);
    v.z = pack2(bflo(v.z) * f, bfhi(v.z) * f); v.w = pack2(bflo(v.w) * f, bfhi(v.w) * f);
    *(u32x4*)(A + row * KLD + ch) = v;
  }
}
DI void state_update(const u16* Xs, const u16* Bs, f32x4 (&acc)[4], int w, int l15, int g) {
  const int tq = l15 >> 2, tp = l15 & 3;
#pragma unroll
  for (int kk = 0; kk < 4; ++kk) {
    const bf16x8 af = cat4(tr_read(Xs + (kk * 32 + 4 * g + tq) * KLD + w * 16 + 4 * tp), tr_read(Xs + (kk * 32 + 16 + 4 * g + tq) * KLD + w * 16 + 4 * tp));
#pragma unroll
    for (int nt = 0; nt < 4; ++nt) {
      const bf16x8 bfr = cat4(tr_read(Bs + (kk * 32 + 4 * g + tq) * KLD + nt * 16 + 4 * tp), tr_read(Bs + (kk * 32 + 16 + 4 * g + tq) * KLD + nt * 16 + 4 * tp));
      acc[nt] = mfma16(af, bfr, acc[nt]);
    }
  }
}
DI void state_to_lds(u16* Ss, const f32x4 (&acc)[4], int w, int l15, int g) {
#pragma unroll
  for (int nt = 0; nt < 4; ++nt)
#pragma unroll
    for (int r = 0; r < 4; ++r) Ss[(w * 16 + 4 * g + r) * KLD + nt * 16 + l15] = f2bf(acc[nt][r]);
}

constexpr int SEQ_LDS_A = 0, SEQ_LDS_B = 128 * KLD * 2, SEQ_LDS_C = 2 * 128 * KLD * 2, SEQ_LDS_S = 3 * 128 * KLD * 2, SEQ_LDS_F = SEQ_LDS_S + 64 * KLD * 2;
DI void ssd_task(const Params& p, int layer, int b, int h, unsigned char* smem) {
  u16* Cs = (u16*)(smem + SEQ_LDS_A); u16* Bs = (u16*)(smem + SEQ_LDS_B); u16* Xs = (u16*)(smem + SEQ_LDS_C); u16* Ss = (u16*)(smem + SEQ_LDS_S);
  float* fl = (float*)(smem + SEQ_LDS_F);
  float* dts = fl; float* acs = fl + 128; float* wend = fl + 256; float* tmp = fl + 384;
  const int tid = otid(), lane = tid & 63, w = tid >> 6, l15 = lane & 15, g = lane >> 4;
  const int gi = h >> 1;
  const u16* projb = (const u16*)(p.ws + OFF_PROJ) + (size_t)b * SEQ * NP;
  const float* smb = (const float*)(p.ws + OFF_SMALL) + (size_t)b * SEQ * NSMALL;
  const float* cw = p.ssm_conv_w + layer * 4 * 512; const float* cb = p.ssm_conv_b + layer * 512;
  u16* Y = (u16*)(p.ws + OFF_H);
  float* ssq = (float*)(p.ws + OFF_SSQ);
  const float a_h = -__expf(p.ssm_a_log[layer * 4 + h]), d_h = p.ssm_d[layer * 4 + h], dtb = p.ssm_dt_bias[layer * 4 + h];
  f32x4 st[4];
#pragma unroll
  for (int nt = 0; nt < 4; ++nt) st[nt] = (f32x4){0.f, 0.f, 0.f, 0.f};
#pragma unroll 1
  for (int c = 0; c < 32; ++c) {
    const int t0 = c * 128;
    float dtv = 0.f;
    if (tid < 128) { const float xr = smb[(size_t)(t0 + tid) * NSMALL + SM_DT + h] + dtb; dtv = xr > 20.f ? xr : log1pf(__expf(xr)); }
    const float cs = block_scan128_add(dtv * a_h, tmp);
    __syncthreads();
    if (tid < 128) { dts[tid] = dtv; acs[tid] = cs; }
    conv_silu_stage(projb, PC_XBC + 256 + gi * 64, cw, cb, 256 + gi * 64, 512, t0, Bs, nullptr, 1.f);
    conv_silu_stage(projb, PC_XBC + 384 + gi * 64, cw, cb, 384 + gi * 64, 512, t0, Cs, nullptr, 1.f);
    __syncthreads();
    if (tid < 128) wend[tid] = __expf(acs[127] - acs[tid]);
    conv_silu_stage(projb, PC_XBC + h * 64, cw, cb, h * 64, 512, t0, Xs, dts, 1.f);
    state_to_lds(Ss, st, w, l15, g);
    __syncthreads();
    {
      bf16x8 cf[2][2];
#pragma unroll
      for (int qt = 0; qt < 2; ++qt)
#pragma unroll
        for (int ks = 0; ks < 2; ++ks) cf[qt][ks] = ldfrag(Cs + (32 * w + qt * 16 + l15) * KLD + ks * 32 + 8 * g);
      f32x4 y[4][2];
#pragma unroll
      for (int d = 0; d < 4; ++d) { y[d][0] = (f32x4){0.f, 0.f, 0.f, 0.f}; y[d][1] = (f32x4){0.f, 0.f, 0.f, 0.f}; }
      float at[2];
#pragma unroll
      for (int qt = 0; qt < 2; ++qt) at[qt] = acs[32 * w + qt * 16 + l15];
#pragma unroll
      for (int stl = 0; stl < 2; ++stl) {
        if (stl * 64 <= 32 * w + 31) {
          f32x4 sc[4][2];
          qk_tile<2>(Bs + stl * 64 * KLD, 0, cf, sc, l15, g);
#pragma unroll
          for (int kt = 0; kt < 4; ++kt) {
            const f32x4 as = *(const f32x4*)(acs + stl * 64 + kt * 16 + 4 * g);
#pragma unroll
            for (int qt = 0; qt < 2; ++qt)
#pragma unroll
              for (int r = 0; r < 4; ++r) {
                const bool ok = stl * 64 + kt * 16 + 4 * g + r <= 32 * w + qt * 16 + l15;
                sc[kt][qt][r] = ok ? sc[kt][qt][r] * __expf(at[qt] - as[r]) : 0.f;
              }
          }
          bf16x8 pf[2][2];
          pack_p(sc, pf);
          pv_accum(pf, Xs + stl * 64 * KLD, y, l15, g);
        }
      }
#pragma unroll
      for (int d = 0; d < 4; ++d) {
        f32x4 yo0 = (f32x4){0.f, 0.f, 0.f, 0.f}, yo1 = (f32x4){0.f, 0.f, 0.f, 0.f};
#pragma unroll
        for (int ks = 0; ks < 2; ++ks) {
          const bf16x8 a = ldfrag(Ss + (d * 16 + l15) * KLD + ks * 32 + 8 * g);
          yo0 = mfma16(a, cf[0][ks], yo0);
          yo1 = mfma16(a, cf[1][ks], yo1);
        }
        y[d][0] += yo0 * __expf(at[0]); y[d][1] += yo1 * __expf(at[1]);
      }
#pragma unroll
      for (int qt = 0; qt < 2; ++qt) {
        const int tl = 32 * w + qt * 16 + l15;
        const float dsk = d_h / dts[tl];
        const size_t row = (size_t)b * SEQ + t0 + tl;
        float sq = 0.f;
#pragma unroll
        for (int d = 0; d < 4; ++d) {
          const u32x2 xv = *(const u32x2*)(Xs + tl * KLD + d * 16 + 4 * g);
          const u32x2 zv = *(const u32x2*)(projb + (size_t)(t0 + tl) * NP + PC_Z + h * 64 + d * 16 + 4 * g);
          f32x4 v = y[d][qt];
          v[0] = (v[0] + dsk * bflo(xv.x)) * siluf(bflo(zv.x)); v[1] = (v[1] + dsk * bfhi(xv.x)) * siluf(bfhi(zv.x));
          v[2] = (v[2] + dsk * bflo(xv.y)) * siluf(bflo(zv.y)); v[3] = (v[3] + dsk * bfhi(xv.y)) * siluf(bfhi(zv.y));
          sq += v[0] * v[0] + v[1] * v[1] + v[2] * v[2] + v[3] * v[3];
          u32x2 o; o.x = pack2(v[0], v[1]); o.y = pack2(v[2], v[3]);
          *(u32x2*)(Y + row * 1024 + Y_C + h * 64 + d * 16 + 4 * g) = o;
        }
        sq = group_sum4(sq);
        if (g == 0) ssq[row * 4 + h] = sq;
      }
    }
    __syncthreads();
    scale_rows(Xs, wend);
    __syncthreads();
    const float cd = __expf(acs[127]);
#pragma unroll
    for (int nt = 0; nt < 4; ++nt) st[nt] *= cd;
    state_update(Xs, Bs, st, w, l15, g);
  }
}
DI void ssd_norm_fix(const Params& p, int layer, int r0, int nrows) {
  u16* Y = (u16*)(p.ws + OFF_H);
  const float* ssq = (const float*)(p.ws + OFF_SSQ);
  const float* ng = p.ssm_norm_g + layer * 256;
  const int tid = otid();
  for (int i = tid; i < nrows * 32; i += 256) {
    const int row = r0 + (i >> 5), ch = (i & 31) * 8, gi = ch >> 7;
    const float rn = rsqrtf((ssq[(size_t)row * 4 + 2 * gi] + ssq[(size_t)row * 4 + 2 * gi + 1]) * (1.f / 128.f) + 1e-6f);
    u32x4 v = *(u32x4*)(Y + (size_t)row * 1024 + Y_C + ch);
    const f32x4 g0 = *(const f32x4*)(ng + ch), g1 = *(const f32x4*)(ng + ch + 4);
    v.x = pack2(bflo(v.x) * rn * g0[0], bfhi(v.x) * rn * g0[1]); v.y = pack2(bflo(v.y) * rn * g0[2], bfhi(v.y) * rn * g0[3]);
    v.z = pack2(bflo(v.z) * rn * g1[0], bfhi(v.z) * rn * g1[1]); v.w = pack2(bflo(v.w) * rn * g1[2], bfhi(v.w) * rn * g1[3]);
    *(u32x4*)(Y + (size_t)row * 1024 + Y_C + ch) = v;
  }
}

DI void mlstm_task(const Params& p, int layer, int b, int h, unsigned char* smem) {
  u16* Qs = (u16*)(smem + SEQ_LDS_A); u16* Ks2 = (u16*)(smem + SEQ_LDS_B); u16* Vs2 = (u16*)(smem + SEQ_LDS_C); u16* Cst = (u16*)(smem + SEQ_LDS_S);
  float* fl = (float*)(smem + SEQ_LDS_F);
  float* bcs = fl; float* us = fl + 128; float* pms = fl + 256; float* wend = fl + 384; float* nst = fl + 512; float* npart = fl + 576; float* tmp = fl + 832;
  const int tid = otid(), lane = tid & 63, w = tid >> 6, l15 = lane & 15, g = lane >> 4;
  const u16* projb = (const u16*)(p.ws + OFF_PROJ) + (size_t)b * SEQ * NP;
  const float* smb = (const float*)(p.ws + OFF_SMALL) + (size_t)b * SEQ * NSMALL;
  const float* cw = p.ml_conv_w + layer * 4 * 512; const float* cb = p.ml_conv_b + layer * 512;
  const float ib = p.ml_if_b[layer * 8 + h], fb = p.ml_if_b[layer * 8 + 4 + h];
  u16* Y = (u16*)(p.ws + OFF_H);
  f32x4 st[4];
#pragma unroll
  for (int nt = 0; nt < 4; ++nt) st[nt] = (f32x4){0.f, 0.f, 0.f, 0.f};
  float m_prev = 0.f;
  __syncthreads();
  if (tid < 64) nst[tid] = 0.f;
#pragma unroll 1
  for (int c = 0; c < 32; ++c) {
    const int t0 = c * 128;
    float ip = 0.f, lf = 0.f;
    if (tid < 128) {
      const float* sr = smb + (size_t)(t0 + tid) * NSMALL + SM_IF;
      ip = sr[h] + ib; const float fp = sr[4 + h] + fb;
      lf = fminf(fp, 0.f) - log1pf(__expf(-fabsf(fp)));
    }
    const float bc = block_scan128_add(lf, tmp);
    const float u = ip - bc;
    const float pm = block_scan128_max(tid < 128 ? u : -1e30f, tmp);
    __syncthreads();
    if (tid < 128) { bcs[tid] = bc; us[tid] = u; pms[tid] = pm; }
    conv_silu_stage(projb, PD_QK + h * 64, cw, cb, h * 64, 512, t0, Qs, nullptr, 1.f);
    conv_silu_stage(projb, PD_QK + 256 + h * 64, cw, cb, 256 + h * 64, 512, t0, Ks2, nullptr, 0.125f);
#pragma unroll
    for (int i = 0; i < 4; ++i) {
      const int id = tid + 256 * i, row = id >> 3, ch = (id & 7) * 8;
      *(u32x4*)(Vs2 + row * KLD + ch) = *(const u32x4*)(projb + (size_t)(t0 + row) * NP + PD_V + h * 64 + ch);
    }
    state_to_lds(Cst, st, w, l15, g);
    __syncthreads();
    const float blast = bcs[127];
    const float m_new = blast + fmaxf(m_prev, pms[127]);
    if (tid < 128) wend[tid] = __expf(blast - m_new + us[tid]);
    bf16x8 qf[2][2];
#pragma unroll
    for (int qt = 0; qt < 2; ++qt)
#pragma unroll
      for (int ks = 0; ks < 2; ++ks) qf[qt][ks] = ldfrag(Qs + (32 * w + qt * 16 + l15) * KLD + ks * 32 + 8 * g);
    f32x4 num[4][2];
#pragma unroll
    for (int d = 0; d < 4; ++d) { num[d][0] = (f32x4){0.f, 0.f, 0.f, 0.f}; num[d][1] = (f32x4){0.f, 0.f, 0.f, 0.f}; }
    float bt[2], mt[2], den[2];
#pragma unroll
    for (int qt = 0; qt < 2; ++qt) { const int tl = 32 * w + qt * 16 + l15; bt[qt] = bcs[tl]; mt[qt] = bt[qt] + fmaxf(m_prev, pms[tl]); den[qt] = 0.f; }
#pragma unroll
    for (int stl = 0; stl < 2; ++stl) {
      if (stl * 64 <= 32 * w + 31) {
        f32x4 sc[4][2];
        qk_tile<2>(Ks2 + stl * 64 * KLD, 0, qf, sc, l15, g);
#pragma unroll
        for (int kt = 0; kt < 4; ++kt) {
          const f32x4 uu = *(const f32x4*)(us + stl * 64 + kt * 16 + 4 * g);
#pragma unroll
          for (int qt = 0; qt < 2; ++qt)
#pragma unroll
            for (int r = 0; r < 4; ++r) {
              const bool ok = stl * 64 + kt * 16 + 4 * g + r <= 32 * w + qt * 16 + l15;
              const float v = ok ? sc[kt][qt][r] * __expf(bt[qt] - mt[qt] + uu[r]) : 0.f;
              sc[kt][qt][r] = v; den[qt] += v;
            }
        }
        bf16x8 pf[2][2];
        pack_p(sc, pf);
        pv_accum(pf, Vs2 + stl * 64 * KLD, num, l15, g);
      }
    }
    {
      f32x4 ni[4][2];
#pragma unroll
      for (int d = 0; d < 4; ++d) {
        ni[d][0] = (f32x4){0.f, 0.f, 0.f, 0.f}; ni[d][1] = (f32x4){0.f, 0.f, 0.f, 0.f};
#pragma unroll
        for (int ks = 0; ks < 2; ++ks) {
          const bf16x8 a = ldfrag(Cst + (d * 16 + l15) * KLD + ks * 32 + 8 * g);
          ni[d][0] = mfma16(a, qf[0][ks], ni[d][0]);
          ni[d][1] = mfma16(a, qf[1][ks], ni[d][1]);
        }
      }
      const float* ng = p.ml_norm_g + layer * 64;
#pragma unroll
      for (int qt = 0; qt < 2; ++qt) {
        const int tl = 32 * w + qt * 16 + l15;
        const float wi = __expf(bt[qt] + m_prev - mt[qt]);
        float qn = 0.f;
#pragma unroll
        for (int ks = 0; ks < 2; ++ks)
#pragma unroll
          for (int j = 0; j < 8; ++j) qn += bf2f((u16)qf[qt][ks][j]) * nst[ks * 32 + 8 * g + j];
        qn = group_sum4(qn);
        const float dn = group_sum4(den[qt]) + wi * qn;
        const float inv = 1.f / fmaxf(fabsf(dn), __expf(-mt[qt]));
        f32x4 hv[4]; float sq = 0.f;
#pragma unroll
        for (int d = 0; d < 4; ++d) {
          const u32x2 ov = *(const u32x2*)(projb + (size_t)(t0 + tl) * NP + PD_O + h * 64 + d * 16 + 4 * g);
          f32x4 v = (num[d][qt] + ni[d][qt] * wi) * inv;
          v[0] *= sigmoidf_(bflo(ov.x)); v[1] *= sigmoidf_(bfhi(ov.x)); v[2] *= sigmoidf_(bflo(ov.y)); v[3] *= sigmoidf_(bfhi(ov.y));
          hv[d] = v; sq += v[0] * v[0] + v[1] * v[1] + v[2] * v[2] + v[3] * v[3];
        }
        sq = group_sum4(sq);
        const float rn = rsqrtf(sq * (1.f / 64.f) + 1e-6f);
        const size_t row = (size_t)b * SEQ + t0 + tl;
#pragma unroll
        for (int d = 0; d < 4; ++d) {
          const int dd = d * 16 + 4 * g;
          const u32x2 zv = *(const u32x2*)(projb + (size_t)(t0 + tl) * NP + PD_Z + h * 64 + dd);
          const f32x4 gg = *(const f32x4*)(ng + dd);
          u32x2 o;
          o.x = pack2(hv[d][0] * rn * gg[0] * siluf(bflo(zv.x)), hv[d][1] * rn * gg[1] * siluf(bfhi(zv.x)));
          o.y = pack2(hv[d][2] * rn * gg[2] * siluf(bflo(zv.y)), hv[d][3] * rn * gg[3] * siluf(bfhi(zv.y)));
          *(u32x2*)(Y + row * 1024 + Y_D + h * 64 + dd) = o;
        }
      }
    }
    __syncthreads();
    scale_rows(Ks2, wend);
    __syncthreads();
    const float fprev = __expf(blast + m_prev - m_new);
#pragma unroll
    for (int nt = 0; nt < 4; ++nt) st[nt] *= fprev;
    state_update(Vs2, Ks2, st, w, l15, g);
    {
      const int e = tid & 63, part = tid >> 6;
      float a = 0.f;
      for (int s2 = part * 32; s2 < part * 32 + 32; ++s2) a += bf2f(Ks2[s2 * KLD + e]);
      npart[part * 64 + e] = a;
    }
    __syncthreads();
    if (tid < 64) nst[tid] = nst[tid] * fprev + npart[tid] + npart[64 + tid] + npart[128 + tid] + npart[192 + tid];
    m_prev = m_new;
  }
}

DI void compress_task(const Params& p, int layer, int b, int kv, int rb, unsigned char* smem) {
  constexpr int HLD = 136;
  u16* Hs = (u16*)smem;
  const int tid = otid(), lane = tid & 63, w = tid >> 6, l15 = lane & 15, g = lane >> 4;
  const u16* projb = (const u16*)(p.ws + OFF_PROJ) + (size_t)b * SEQ * NP + (kv ? PA_VC : PA_KC);
  const int mi = layer * 2 + kv;
  const u16* W1T = (const u16*)(p.ws + OFF_W1T) + (size_t)mi * 128 * 2048;
  const u16* W2T = (const u16*)(p.ws + OFF_W2T) + (size_t)mi * 64 * 128;
  const float* bias1 = (const float*)(p.ws + OFF_BIAS1) + mi * 128;
  f32x4 acc[2][2];
#pragma unroll
  for (int nt = 0; nt < 2; ++nt) { acc[nt][0] = (f32x4){0.f, 0.f, 0.f, 0.f}; acc[nt][1] = (f32x4){0.f, 0.f, 0.f, 0.f}; }
  int tok[2];
#pragma unroll
  for (int mt = 0; mt < 2; ++mt) { int i = rb * 32 + mt * 16 + l15; if (i > 254) i = 254; tok[mt] = 16 * i; }
#pragma unroll 4
  for (int ks = 0; ks < 64; ++ks) {
    const int j = ks >> 1, d0 = (ks & 1) * 32;
    bf16x8 af[2], wf[2];
#pragma unroll
    for (int mt = 0; mt < 2; ++mt) af[mt] = ldfrag(projb + (size_t)(tok[mt] + j) * NP + d0 + 8 * g);
#pragma unroll
    for (int nt = 0; nt < 2; ++nt) wf[nt] = ldfrag(W1T + (size_t)(w * 32 + nt * 16 + l15) * 2048 + ks * 32 + 8 * g);
#pragma unroll
    for (int nt = 0; nt < 2; ++nt)
#pragma unroll
      for (int mt = 0; mt < 2; ++mt) acc[nt][mt] = mfma16(wf[nt], af[mt], acc[nt][mt]);
  }
  __syncthreads();
#pragma unroll
  for (int nt = 0; nt < 2; ++nt) {
    const int n = w * 32 + nt * 16 + 4 * g;
    const f32x4 bb = *(const f32x4*)(bias1 + n);
#pragma unroll
    for (int mt = 0; mt < 2; ++mt) {
      const f32x4 v = acc[nt][mt] + bb;
      u32x2 o; o.x = pack2(siluf(v[0]), siluf(v[1])); o.y = pack2(siluf(v[2]), siluf(v[3]));
      *(u32x2*)(Hs + (mt * 16 + l15) * HLD + n) = o;
    }
  }
  __syncthreads();
  f32x4 acc2[2] = {(f32x4){0.f, 0.f, 0.f, 0.f}, (f32x4){0.f, 0.f, 0.f, 0.f}};
#pragma unroll
  for (int ks = 0; ks < 4; ++ks) {
    const bf16x8 wf = ldfrag(W2T + (size_t)(w * 16 + l15) * 128 + ks * 32 + 8 * g);
#pragma unroll
    for (int mt = 0; mt < 2; ++mt) acc2[mt] = mfma16(wf, ldfrag(Hs + (mt * 16 + l15) * HLD + ks * 32 + 8 * g), acc2[mt]);
  }
  u16* dst = (u16*)(p.ws + (kv ? OFF_VCMP : OFF_KCMP)) + (size_t)b * 256 * 64;
#pragma unroll
  for (int mt = 0; mt < 2; ++mt) {
    const int i = rb * 32 + mt * 16 + l15;
    u32x2 o; o.x = pack2(acc2[mt][0], acc2[mt][1]); o.y = pack2(acc2[mt][2], acc2[mt][3]);
    if (i > 254) { o.x = 0u; o.y = 0u; }
    *(u32x2*)(dst + (size_t)i * 64 + w * 16 + 4 * g) = o;
  }
}

DI void nsa_task(const Params& p, int layer, int b, int qi, unsigned char* smem) {
  u16* Ks = (u16*)smem; u16* Vs = Ks + 64 * KLD;
  float* T = (float*)(smem + 2 * 64 * KLD * 2);
  unsigned long long* selm = (unsigned long long*)(smem + 2 * 64 * KLD * 2 + 4 * 32 * 65 * 4);
  const int tid = otid(), lane = tid & 63, h = tid >> 6, l15 = lane & 15, g = lane >> 4;
  const int q0 = qi * 32;
  const u16* projb = (const u16*)(p.ws + OFF_PROJ) + (size_t)b * SEQ * NP;
  const float* smb = (const float*)(p.ws + OFF_SMALL) + (size_t)b * SEQ * NSMALL;
  const u16* kcmp = (const u16*)(p.ws + OFF_KCMP) + (size_t)b * 256 * 64;
  const u16* vcmp = (const u16*)(p.ws + OFF_VCMP) + (size_t)b * 256 * 64;
  bf16x8 qf[2][2];
#pragma unroll
  for (int qt = 0; qt < 2; ++qt)
#pragma unroll
    for (int ks = 0; ks < 2; ++ks) qf[qt][ks] = ldfrag(projb + (size_t)(q0 + qt * 16 + l15) * NP + PA_Q + h * 64 + ks * 32 + 8 * g);
  const float sc = 0.125f * 1.4426950408889634f;
  f32x4 outacc[4][2];
  AttnAcc a;
  KVRegs kr;
  const int ntc = (q0 >> 10) + 1;
  attn_init(a);
  __syncthreads();
  for (int i = tid; i < 4 * 32 * 65; i += 256) T[i] = 0.f;
  for (int j = 0; j < ntc; ++j) {
    __syncthreads();
    kv_load(kcmp, vcmp, 64, 64, j * 64, kr); kv_store(Ks, Vs, kr);
    __syncthreads();
    f32x4 s[4][2];
    auto valid = [&](int kt, int r, int qt) { return 16 * (j * 64 + kt * 16 + 4 * g + r) + 31 <= q0 + qt * 16 + l15; };
    qk_tile<2>(Ks, 0, qf, s, l15, g);
    softmax_pv(s, a, Vs, sc, l15, g, valid);
  }
  float cinv[2];
#pragma unroll
  for (int qt = 0; qt < 2; ++qt) {
    const float lt = group_sum4(a.l[qt]);
    cinv[qt] = lt > 0.f ? 1.f / lt : 0.f;
    const float gt = sigmoidf_(smb[(size_t)(q0 + qt * 16 + l15) * NSMALL + SM_G + h * 3 + 0]) * cinv[qt];
#pragma unroll
    for (int d = 0; d < 4; ++d) outacc[d][qt] = a.o[d][qt] * gt;
  }
  float carry[2] = {0.f, 0.f};
  for (int j = 0; j < ntc; ++j) {
    __syncthreads();
    kv_load(kcmp, vcmp, 64, 64, j * 64, kr); kv_store(Ks, Vs, kr);
    __syncthreads();
    f32x4 s[4][2];
    qk_tile<2>(Ks, 0, qf, s, l15, g);
#pragma unroll
    for (int qt = 0; qt < 2; ++qt) {
      float prev3 = carry[qt];
#pragma unroll
      for (int kt = 0; kt < 4; ++kt) {
        float pr[4];
#pragma unroll
        for (int r = 0; r < 4; ++r) {
          const bool ok = 16 * (j * 64 + kt * 16 + 4 * g + r) + 31 <= q0 + qt * 16 + l15;
          pr[r] = ok ? exp2_(s[kt][qt][r] * sc - a.m[qt]) * cinv[qt] : 0.f;
        }
        const float below = __shfl_up(pr[3], 16);
        const float wrap = __shfl(prev3, l15 + 48);
        const float nb = g > 0 ? below : wrap;
        T[(h * 32 + qt * 16 + l15) * 65 + j * 16 + kt * 4 + g] = (pr[0] + pr[1]) + (pr[2] + 0.5f * pr[3]) + 0.5f * nb;
        prev3 = pr[3];
      }
      carry[qt] = prev3;
    }
  }
  __syncthreads();
#pragma unroll 1
  for (int qq = 0; qq < 8; ++qq) {
    const int q = h * 8 + qq, t = q0 + q, cur = t >> 6;
    const float imp = ((T[(0 * 32 + q) * 65 + lane] + T[(1 * 32 + q) * 65 + lane]) + T[(2 * 32 + q) * 65 + lane]) + T[(3 * 32 + q) * 65 + lane];
    const float val = (lane == cur || lane == 0) ? 1e4f : (lane <= cur ? imp : -1.f);
    int rank = 0;
#pragma unroll
    for (int k = 0; k < 64; ++k) {
      const float vk = __int_as_float(__builtin_amdgcn_readlane(__float_as_int(val), k));
      rank += (vk > val || (vk == val && k < lane)) ? 1 : 0;
    }
    const unsigned long long m = __ballot(rank < 16);
    if (lane == 0) selm[q] = m;
  }
  __syncthreads();
  unsigned long long mq[2], anym = 0ull;
#pragma unroll
  for (int qt = 0; qt < 2; ++qt) mq[qt] = selm[qt * 16 + l15];
  for (int i = 0; i < 32; ++i) anym |= selm[i];
  const int jhi = (q0 + 31) >> 6;
  attn_init(a);
  for (int j = 0; j <= jhi; ++j) {
    if (!((anym >> j) & 1ull)) continue;
    __syncthreads();
    kv_load(projb + PA_KS, projb + PA_VS, NP, NP, j * 64, kr); kv_store(Ks, Vs, kr);
    __syncthreads();
    f32x4 s[4][2];
    auto valid = [&](int kt, int r, int qt) { return ((mq[qt] >> j) & 1ull) && (j * 64 + kt * 16 + 4 * g + r <= q0 + qt * 16 + l15); };
    qk_tile<2>(Ks, 0, qf, s, l15, g);
    softmax_pv(s, a, Vs, sc, l15, g, valid);
  }
#pragma unroll
  for (int qt = 0; qt < 2; ++qt) {
    const float lt = group_sum4(a.l[qt]);
    const float gt = sigmoidf_(smb[(size_t)(q0 + qt * 16 + l15) * NSMALL + SM_G + h * 3 + 1]) * (lt > 0.f ? 1.f / lt : 0.f);
#pragma unroll
    for (int d = 0; d < 4; ++d) outacc[d][qt] += a.o[d][qt] * gt;
  }
  attn_init(a);
  const int jlo = q0 >= 511 ? (q0 - 511) >> 6 : 0;
  for (int j = jlo; j <= jhi; ++j) {
    __syncthreads();
    kv_load(projb + PA_KW, projb + PA_VW, NP, NP, j * 64, kr); kv_store(Ks, Vs, kr);
    __syncthreads();
    f32x4 s[4][2];
    auto valid = [&](int kt, int r, int qt) { const int key = j * 64 + kt * 16 + 4 * g + r, t = q0 + qt * 16 + l15; return key <= t && key + 512 > t; };
    qk_tile<2>(Ks, 0, qf, s, l15, g);
    softmax_pv(s, a, Vs, sc, l15, g, valid);
  }
  u16* Y = (u16*)(p.ws + OFF_H);
  const float* ng = p.nsa_norm_g + layer * 64;
#pragma unroll
  for (int qt = 0; qt < 2; ++qt) {
    const int t = q0 + qt * 16 + l15;
    const float lt = group_sum4(a.l[qt]);
    const float gt = sigmoidf_(smb[(size_t)t * NSMALL + SM_G + h * 3 + 2]) * (lt > 0.f ? 1.f / lt : 0.f);
    f32x4 v[4]; float ss = 0.f;
#pragma unroll
    for (int d = 0; d < 4; ++d) { v[d] = outacc[d][qt] + a.o[d][qt] * gt; ss += v[d][0] * v[d][0] + v[d][1] * v[d][1] + v[d][2] * v[d][2] + v[d][3] * v[d][3]; }
    ss = group_sum4(ss);
    const float rn = rsqrtf(ss * (1.f / 64.f) + 1e-6f);
    const size_t row = (size_t)b * SEQ + t;
#pragma unroll
    for (int d = 0; d < 4; ++d) {
      const int dd = d * 16 + 4 * g;
      const u32x2 zz = *(const u32x2*)(projb + (size_t)t * NP + PA_Z + h * 64 + dd);
      const f32x4 gg = *(const f32x4*)(ng + dd);
      u32x2 o;
      o.x = pack2(v[d][0] * rn * gg[0] * siluf(bflo(zz.x)), v[d][1] * rn * gg[1] * siluf(bfhi(zz.x)));
      o.y = pack2(v[d][2] * rn * gg[2] * siluf(bflo(zz.y)), v[d][3] * rn * gg[3] * siluf(bfhi(zz.y)));
      *(u32x2*)(Y + row * 1024 + Y_A + h * 64 + dd) = o;
    }
  }
}

DI void zero_y_cols(const Params& p, int c0, int ncols, int gtid, int gthreads) {
  u16* Y = (u16*)(p.ws + OFF_H);
  const int per_row = ncols / 8;
  for (size_t i = gtid; i < (size_t)NTOK * per_row; i += gthreads) {
    const size_t row = i / per_row; const int ch = (int)(i % per_row);
    *(u32x4*)(Y + row * 1024 + c0 + ch * 8) = (u32x4){0u, 0u, 0u, 0u};
  }
}

DI void final_norm_rows(const Params& p, int gw, int nw, int lane) {
  for (int row = gw; row < NTOK; row += nw) {
    float4* xr = (float4*)(p.out + (size_t)row * D_MODEL);
    float4 v[4]; float ss = 0.f;
#pragma unroll
    for (int i = 0; i < 4; ++i) { v[i] = xr[lane + 64 * i]; ss += v[i].x * v[i].x + v[i].y * v[i].y + v[i].z * v[i].z + v[i].w * v[i].w; }
    ss = wave_sum(ss);
    const float r = rsqrtf(ss * (1.f / D_MODEL) + 1e-6f);
    const float4* gp = (const float4*)p.final_g;
#pragma unroll
    for (int i = 0; i < 4; ++i) { const float4 gg = gp[lane + 64 * i]; float4 w; w.x = v[i].x * r * gg.x; w.y = v[i].y * r * gg.y; w.z = v[i].z * r * gg.z; w.w = v[i].w * r * gg.w; xr[lane + 64 * i] = w; }
  }
}

#ifndef DEBUG_CHECK
#define DEBUG_CHECK 0
#endif
#if DEBUG_CHECK
constexpr int NCHK = 12;
DI float block_sum(float v, float* red) {
  v = wave_sum(v);
  __syncthreads();
  if ((threadIdx.x & 63) == 0) red[threadIdx.x >> 6] = v;
  __syncthreads();
  return red[0] + red[1] + red[2] + red[3];
}
DI float block_max(float v, float* red) {
#pragma unroll
  for (int o = 32; o > 0; o >>= 1) v = fmaxf(v, __shfl_xor(v, o));
  __syncthreads();
  if ((threadIdx.x & 63) == 0) red[threadIdx.x >> 6] = v;
  __syncthreads();
  return fmaxf(fmaxf(red[0], red[1]), fmaxf(red[2], red[3]));
}
DI float bfr(float v) { return bf2f(f2bf(v)); }
struct Chk { float num[NCHK], den[NCHK]; };
DI void chk_add(Chk& c, int id, float got, float ref) { const float d = got - ref; c.num[id] += d * d; c.den[id] += ref * ref; }

DI void dbg_diff_attn(const Params& p, int layer, int b, int t, int h, Chk& c, int id, unsigned char* smem) {
  float* p1 = (float*)smem; float* p2 = p1 + 4096; float* red = p2 + 4096;
  const int tid = otid();
  const u16* proj = (const u16*)(p.ws + OFF_PROJ) + (size_t)b * SEQ * NP;
  const u16* q = proj + (size_t)t * NP + PB_Q + h * 64;
  const float scale = 0.17677669529663687f;
  float m1 = -1e30f, m2 = -1e30f;
  for (int s = tid; s <= t; s += 256) {
    const u16* k = proj + (size_t)s * NP + PB_K + h * 64;
    float a1 = 0.f, a2 = 0.f;
    for (int d = 0; d < 32; ++d) { a1 += bf2f(q[d]) * bf2f(k[d]); a2 += bf2f(q[32 + d]) * bf2f(k[32 + d]); }
    a1 *= scale; a2 *= scale; p1[s] = a1; p2[s] = a2; m1 = fmaxf(m1, a1); m2 = fmaxf(m2, a2);
  }
  m1 = block_max(m1, red); m2 = block_max(m2, red);
  float l1 = 0.f, l2 = 0.f;
  for (int s = tid; s <= t; s += 256) { const float e1 = __expf(p1[s] - m1), e2 = __expf(p2[s] - m2); p1[s] = e1; p2[s] = e2; l1 += e1; l2 += e2; }
  l1 = block_sum(l1, red); l2 = block_sum(l2, red);
  const float* lam = p.diff_lam + layer * 128;
  float s01 = 0.f, s23 = 0.f;
  for (int i = 0; i < 32; ++i) { s01 += lam[i] * lam[32 + i]; s23 += lam[64 + i] * lam[96 + i]; }
  const float lam_init = 0.8f - 0.6f * expf(-0.3f * (float)layer);
  const float lam_full = expf(s01) - expf(s23) + lam_init;
  __syncthreads();
  float o = 0.f;
  if (tid < 64) for (int s = 0; s <= t; ++s) o += (p1[s] / l1 - lam_full * p2[s] / l2) * bf2f(proj[(size_t)s * NP + PB_V + h * 64 + tid]);
  float ss = block_sum(tid < 64 ? o * o : 0.f, red);
  if (tid < 64) {
    const float z = bf2f(proj[(size_t)t * NP + PB_Z + h * 64 + tid]);
    const float ref = o * rsqrtf(ss / 64.f + 1e-6f) * p.diff_norm_g[layer * 64 + tid] * (1.f - lam_init) * (z / (1.f + expf(-z)));
    const float got = bf2f(((const u16*)(p.ws + OFF_H))[((size_t)b * SEQ + t) * 1024 + Y_B + h * 64 + tid]);
    const float d = got - ref;
    o = d * d; ss = ref * ref;
  } else { o = 0.f; ss = 0.f; }
  c.num[id] += block_sum(o, red); c.den[id] += block_sum(ss, red);
}

DI float dbg_conv(const u16* projb, int t, int pcol, const float* cw, const float* cb, int ch, int nch) {
  float a = cb[ch];
  for (int j = 0; j < 4; ++j) { const int tt = t - 3 + j; if (tt >= 0) a += cw[j * nch + ch] * bf2f(projb[(size_t)tt * NP + pcol]); }
  return a / (1.f + expf(-a));
}
constexpr int DBG_NS = 11, DBG_T = 300;
DI int dbg_sample_idx(int t) {
  const int TS[DBG_NS] = {0, 1, 2, 3, 64, 127, 128, 129, 255, 256, 299};
  for (int i = 0; i < DBG_NS; ++i) if (TS[i] == t) return i;
  return -1;
}
DI int dbg_sample_t(int i) { const int TS[DBG_NS] = {0, 1, 2, 3, 64, 127, 128, 129, 255, 256, 299}; return TS[i]; }
DI void dbg_ssd(const Params& p, int layer, int b, int gi, Chk& c, int id, unsigned char* smem) {
  float* ybuf = (float*)smem;
  float* red = ybuf + DBG_NS * 128;
  const int tid = threadIdx.x, pp = tid >> 2, nq = tid & 3;
  const u16* projb = (const u16*)(p.ws + OFF_PROJ) + (size_t)b * SEQ * NP;
  const float* smb = (const float*)(p.ws + OFF_SMALL) + (size_t)b * SEQ * NSMALL;
  const float* cw = p.ssm_conv_w + layer * 4 * 512; const float* cb = p.ssm_conv_b + layer * 512;
  __syncthreads();
  for (int hh = 0; hh < 2; ++hh) {
    const int h = gi * 2 + hh;
    const float a_h = -expf(p.ssm_a_log[layer * 4 + h]), d_h = p.ssm_d[layer * 4 + h], dtb = p.ssm_dt_bias[layer * 4 + h];
    float hst[16];
    for (int i = 0; i < 16; ++i) hst[i] = 0.f;
    for (int t = 0; t < DBG_T; ++t) {
      const float xr = smb[(size_t)t * NSMALL + SM_DT + h] + dtb;
      const float dt = xr > 20.f ? xr : log1pf(expf(xr));
      const float dA = expf(dt * a_h);
      const float xp = dbg_conv(projb, t, PC_XBC + h * 64 + pp, cw, cb, h * 64 + pp, 512);
      float y = 0.f;
      for (int i = 0; i < 16; ++i) {
        const int n = nq * 16 + i;
        const float Bn = dbg_conv(projb, t, PC_XBC + 256 + gi * 64 + n, cw, cb, 256 + gi * 64 + n, 512);
        const float Cn = dbg_conv(projb, t, PC_XBC + 384 + gi * 64 + n, cw, cb, 384 + gi * 64 + n, 512);
        hst[i] = dA * hst[i] + dt * xp * Bn;
        y += Cn * hst[i];
      }
      y += __shfl_xor(y, 1); y += __shfl_xor(y, 2);
      y += d_h * xp;
      const int si = dbg_sample_idx(t);
      if (si >= 0 && nq == 0) { const float z = bf2f(projb[(size_t)t * NP + PC_Z + h * 64 + pp]); ybuf[si * 128 + hh * 64 + pp] = y * (z / (1.f + expf(-z))); }
    }
  }
  __syncthreads();
  for (int si = 0; si < DBG_NS; ++si) {
    const float v = tid < 128 ? ybuf[si * 128 + tid] : 0.f;
    const float ss = block_sum(v * v, red);
    float e2 = 0.f, r2 = 0.f;
    if (tid < 128) {
      const float ref = v * rsqrtf(ss / 128.f + 1e-6f) * p.ssm_norm_g[layer * 256 + gi * 128 + tid];
      const float got = bf2f(((const u16*)(p.ws + OFF_H))[((size_t)b * SEQ + dbg_sample_t(si)) * 1024 + Y_C + gi * 128 + tid]);
      e2 = (got - ref) * (got - ref); r2 = ref * ref;
    }
    c.num[id] += block_sum(e2, red); c.den[id] += block_sum(r2, red);
  }
}
DI void dbg_mlstm(const Params& p, int layer, int b, int h, Chk& c, int id, unsigned char* smem) {
  float* ybuf = (float*)smem;
  float* red = ybuf + DBG_NS * 128;
  const int tid = threadIdx.x, dd = tid >> 2, eq = tid & 3;
  const u16* projb = (const u16*)(p.ws + OFF_PROJ) + (size_t)b * SEQ * NP;
  const float* smb = (const float*)(p.ws + OFF_SMALL) + (size_t)b * SEQ * NSMALL;
  const float* cw = p.ml_conv_w + layer * 4 * 512; const float* cb = p.ml_conv_b + layer * 512;
  const float ib = p.ml_if_b[layer * 8 + h], fb = p.ml_if_b[layer * 8 + 4 + h];
  __syncthreads();
  float Cst[16], nst[16];
  for (int i = 0; i < 16; ++i) { Cst[i] = 0.f; nst[i] = 0.f; }
  float m = 0.f;
  for (int t = 0; t < DBG_T; ++t) {
    const float ip = smb[(size_t)t * NSMALL + SM_IF + h] + ib, fp = smb[(size_t)t * NSMALL + SM_IF + 4 + h] + fb;
    const float lf = fminf(fp, 0.f) - log1pf(expf(-fabsf(fp)));
    const float mn = fmaxf(lf + m, ip), fs = expf(lf + m - mn), is = expf(ip - mn);
    const float vd = bf2f(projb[(size_t)t * NP + PD_V + h * 64 + dd]);
    float num = 0.f, den = 0.f;
    for (int i = 0; i < 16; ++i) {
      const int e = eq * 16 + i;
      const float qe = dbg_conv(projb, t, PD_QK + h * 64 + e, cw, cb, h * 64 + e, 512);
      const float ke = 0.125f * dbg_conv(projb, t, PD_QK + 256 + h * 64 + e, cw, cb, 256 + h * 64 + e, 512);
      Cst[i] = fs * Cst[i] + is * vd * ke; nst[i] = fs * nst[i] + is * ke;
      num += Cst[i] * qe; den += nst[i] * qe;
    }
    num += __shfl_xor(num, 1); num += __shfl_xor(num, 2); den += __shfl_xor(den, 1); den += __shfl_xor(den, 2);
    const float hv = num / fmaxf(fabsf(den), expf(-mn));
    m = mn;
    const int si = dbg_sample_idx(t);
    if (si >= 0 && eq == 0) { const float o = bf2f(projb[(size_t)t * NP + PD_O + h * 64 + dd]); ybuf[si * 64 + dd] = hv / (1.f + expf(-o)); }
  }
  __syncthreads();
  for (int si = 0; si < DBG_NS; ++si) {
    const float v = tid < 64 ? ybuf[si * 64 + tid] : 0.f;
    const float ss = block_sum(v * v, red);
    float e2 = 0.f, r2 = 0.f;
    if (tid < 64) {
      const int t = dbg_sample_t(si);
      const float z = bf2f(projb[(size_t)t * NP + PD_Z + h * 64 + tid]);
      const float ref = v * rsqrtf(ss / 64.f + 1e-6f) * p.ml_norm_g[layer * 64 + tid] * (z / (1.f + expf(-z)));
      const float got = bf2f(((const u16*)(p.ws + OFF_H))[((size_t)b * SEQ + t) * 1024 + Y_D + h * 64 + tid]);
      e2 = (got - ref) * (got - ref); r2 = ref * ref;
    }
    c.num[id] += block_sum(e2, red); c.den[id] += block_sum(r2, red);
  }
}

DI void debug_checks(const Params& p, unsigned char* smem) {
  const int tid = otid();
  float* red = (float*)(smem + 36 * 1024);
  Chk c;
  for (int i = 0; i < NCHK; ++i) { c.num[i] = 0.f; c.den[i] = 0.f; }
  const float* adap = (const float*)(p.ws + OFF_ADAP);
  const u16* H = (const u16*)(p.ws + OFF_H);
  const u16* proj = (const u16*)(p.ws + OFF_PROJ);
  const float* sm = (const float*)(p.ws + OFF_SMALL);
#if DEBUG_CHECK == 1
  {
    const int bs[2] = {0, 5}; const int ns[4] = {3, 1024 + 77, 2048 + 500, 3071};
    for (int bi = 0; bi < 2; ++bi) for (int ni = 0; ni < 4; ++ni) {
      const int b = bs[bi], n = ns[ni];
      float a = 0.f;
      for (int k = tid; k < 1024; k += 256) { const float v = p.c[b * 1024 + k]; a += (v / (1.f + expf(-v))) * p.ada_w[(size_t)k * 3072 + n]; }
      const float ref = block_sum(a, red) + p.ada_b[n];
      float got = 0.f; for (int kc = 0; kc < 8; ++kc) got += adap[(((size_t)kc * 2 + 0) * 8 + b) * 3072 + n];
      chk_add(c, 1, got, ref);
    }
  }
  {
    const int ms[3] = {1, 9000, 32767};
    const int ns[14] = {0, 300, 700, 900, 1500, 2000, 2300, 2693, 3300, 3500, 3967, 3970, 3981, 3990};
    for (int mi = 0; mi < 3; ++mi) {
      const int m = ms[mi], b = m >> 12;
      float ss = 0.f;
      for (int k = tid; k < 1024; k += 256) { const float v = p.x[(size_t)m * 1024 + k]; ss += v * v; }
      ss = block_sum(ss, red);
      const float rstd = rsqrtf(ss / 1024.f + 1e-6f);
      for (int ni = 0; ni < 14; ++ni) {
        const int n = ns[ni], col = colmap(n);
        float a = 0.f, herr = 0.f, href = 0.f;
        for (int k = tid; k < 1024; k += 256) {
          float shf = 0.f, scl = 0.f;
          for (int kc = 0; kc < 8; ++kc) { const float* ap = adap + (((size_t)kc * 2 + 0) * 8 + b) * 3072; shf += ap[k]; scl += ap[1024 + k]; }
          const float hv = p.x[(size_t)m * 1024 + k] * rstd * p.norm_g[k] * (1.f + scl) + shf;
          const float hg = bf2f(H[(size_t)m * 1024 + k]);
          herr += (hg - hv) * (hg - hv); href += hv * hv;
          a += hv * p.w_in[(size_t)k * D_IN + col];
        }
        const float ref = block_sum(a, red);
        herr = block_sum(herr, red); href = block_sum(href, red);
        if (ni == 0 && DEBUG_STAGE == 1) { c.num[3] += herr; c.den[3] += href; }
        const float got = n < NP ? bf2f(proj[(size_t)m * NP + n]) : sm[(size_t)m * NSMALL + (n - NP)];
        chk_add(c, 2, got, ref);
      }
    }
  }
#endif
#if DEBUG_CHECK == 2
  dbg_diff_attn(p, 0, 0, 5, 0, c, 4, smem);
  dbg_diff_attn(p, 0, 1, 200, 3, c, 4, smem);
  dbg_diff_attn(p, 0, 3, 1500, 2, c, 4, smem);
  dbg_diff_attn(p, 0, 7, 4095, 1, c, 4, smem);
  {
    const int ms[3] = {2, 12345, 32766}; const int ns[3] = {0, 513, 1023};
    const u16* Y = (const u16*)(p.ws + OFF_H);
    for (int mi = 0; mi < 3; ++mi) for (int ni = 0; ni < 3; ++ni) {
      const int m = ms[mi], n = ns[ni], b = m >> 12;
      float a = 0.f;
      for (int k = tid; k < 1024; k += 256) a += bf2f(Y[(size_t)m * 1024 + k]) * p.w_out[(size_t)k * 1024 + n];
      a = block_sum(a, red);
      float gate = 0.f; for (int kc = 0; kc < 8; ++kc) gate += adap[(((size_t)kc * 2 + 0) * 8 + b) * 3072 + 2048 + n];
      chk_add(c, 5, p.out[(size_t)m * 1024 + n] - p.x[(size_t)m * 1024 + n], gate * a);
    }
  }
#endif
#if DEBUG_CHECK == 3
  dbg_ssd(p, 0, 0, 0, c, 6, smem);
  dbg_ssd(p, 0, 5, 1, c, 6, smem);
  dbg_mlstm(p, 0, 0, 0, c, 7, smem);
  dbg_mlstm(p, 0, 6, 3, c, 7, smem);
#endif
  __syncthreads();
  if (tid == 0) {
    int wid_ = 0, wcls = 99;
    for (int i = 1; i < NCHK; ++i) if (c.den[i] > 0.f) {
      const float rel = sqrtf(c.num[i] / c.den[i]);
      int cls = rel >= 1.f ? 0 : (int)floorf(-log10f(fmaxf(rel, 1e-9f)));
      if (cls > 9) cls = 9;
      if (!(rel == rel)) cls = 0;
      if (cls < wcls) { wcls = cls; wid_ = i; }
    }
    p.out[0] = 1e5f * ((float)wid_ + 0.1f * (float)wcls);
  }
}
#endif

constexpr int SMEM_BYTES = 70 * 1024;
__global__ void __launch_bounds__(256, 2) fwd_megakernel(Params p) {
  cg::grid_group grid = cg::this_grid();
  __shared__ __attribute__((aligned(16))) unsigned char smem[SMEM_BYTES];
  const int tid = otid(), lane = tid & 63, wid = tid >> 6;
  const int G = gridDim.x, bid = blockIdx.x;
  for (int t = bid; t < T0_TOTAL; t += G) phase0_task(p, t, smem);
  grid.sync();
  for (int layer = 0; layer < 2; ++layer) {
    const float* xin = layer == 0 ? p.x : p.out;
    for (int t = bid; t < NTOK / 64; t += G) phase1_task(p, layer, xin, t, smem);
    grid.sync();
    for (int t = bid; t < 256 * 32; t += G) gemm_inproj_tile(p, layer, t, smem);
    grid.sync();
#if DEBUG_CHECK == 1
    if (bid == 0) debug_checks(p, smem);
    return;
#endif
    if (bid < 32) ssd_task(p, layer, bid >> 2, bid & 3, smem);
    else if (bid < 64) mlstm_task(p, layer, (bid - 32) >> 2, (bid - 32) & 3, smem);
    for (int u = (bid + G - 64) % G; u < 1024 + 128; u += G) {
      if (u < 1024) { const int qb = 31 - (u >> 5), bh = u & 31; diff_attn_task(p, layer, bh >> 2, bh & 3, qb, smem); }
      else { const int v = u - 1024; compress_task(p, layer, v >> 4, (v >> 3) & 1, v & 7, smem); }
    }
    grid.sync();
    for (int t = bid; t < NTOK / 64; t += G) ssd_norm_fix(p, layer, t * 64, 64);
    for (int u = bid; u < 1024; u += G) nsa_task(p, layer, u & 7, 127 - (u >> 3), smem);
    grid.sync();
    for (int t = bid; t < 256 * 8; t += G) gemm_outproj_tile(p, layer, xin, p.out, t, smem);
    grid.sync();
#if DEBUG_CHECK >= 2
    if (bid == 0) debug_checks(p, smem);
    return;
#endif
  }
  final_norm_rows(p, bid * 4 + wid, G * 4, lane);
}

extern "C" void kernel_launch(void* const* d_in, const int* in_sizes, int n_in, void* d_out, int out_size, void* d_ws, size_t ws_size,
                              hipStream_t stream) {
  static int grid_blocks = 0;
  if (!grid_blocks) {
    int dev = 0, cus = 0, per_cu = 0;
    (void)hipGetDevice(&dev);
    (void)hipDeviceGetAttribute(&cus, hipDeviceAttributeMultiprocessorCount, dev);
    (void)hipOccupancyMaxActiveBlocksPerMultiprocessor(&per_cu, fwd_megakernel, 256, 0);
    if (per_cu > 2) per_cu = 2;
    if (per_cu < 1) per_cu = 1;
    grid_blocks = cus * per_cu;
  }
  if (ws_size < WS_NEEDED) { fprintf(stderr, "workspace too small: %zu < %zu\n", ws_size, WS_NEEDED); return; }
  Params p{};
  const float** pp = (const float**)&p;
  for (int i = 0; i < 26; ++i) pp[i] = (const float*)d_in[i];
  p.out = (float*)d_out; p.ws = (unsigned char*)d_ws;
  void* args[] = {&p};
  hipError_t e = hipLaunchCooperativeKernel((void*)fwd_megakernel, dim3(grid_blocks), dim3(256), args, 0, stream);
  if (e != hipSuccess) fprintf(stderr, "cooperative launch failed: %s (grid %d)\n", hipGetErrorString(e), grid_blocks);
}
```

```cpp
#include <hip/hip_runtime.h>
#include <hip/hip_cooperative_groups.h>
#include <cstdio>
#include <cstdint>
#define DEBUG_CHECK 0
#define DEBUG_STAGE 1
#define REP_P1 1
#define REP_P2 1
#define REP_SEQ 1
#define REP_DIFF 1
#define REP_NSA 1
#define REP_P4 1
#define REP_P0 1
namespace cg = cooperative_groups;

typedef unsigned short u16;
typedef short bf16x8 __attribute__((ext_vector_type(8)));
typedef short s16x4 __attribute__((ext_vector_type(4)));
typedef float f32x4 __attribute__((ext_vector_type(4)));
typedef float f32x2 __attribute__((ext_vector_type(2)));
typedef unsigned u32x4 __attribute__((ext_vector_type(4)));
typedef unsigned u32x2 __attribute__((ext_vector_type(2)));
typedef __bf16 bf16x2_t __attribute__((ext_vector_type(2)));
#define DI __device__ __forceinline__
#define LDSP __attribute__((address_space(3)))

constexpr int D_MODEL = 1024, BATCH = 8, SEQ = 4096, NTOK = BATCH * SEQ;
constexpr int D_IN = 3992;
constexpr int NP = 3968, NPAD = 4096, NSMALL = 32;
constexpr int PA_Q = 0, PA_KC = 256, PA_VC = 320, PA_KS = 384, PA_VS = 448, PA_KW = 512, PA_VW = 576, PA_Z = 640;
constexpr int PB_Q = 896, PB_K = 1152, PB_V = 1408, PB_Z = 1664;
constexpr int PC_Z = 1920, PC_XBC = 2176;
constexpr int PD_QK = 2688, PD_V = 3200, PD_O = 3456, PD_Z = 3712;
constexpr int SM_G = 0, SM_DT = 12, SM_IF = 16;
constexpr int Y_A = 0, Y_B = 256, Y_C = 512, Y_D = 768;

constexpr size_t MiB = 1024 * 1024;
constexpr size_t OFF_WINT = 0;
constexpr size_t OFF_WOUTT = 16 * MiB;
constexpr size_t OFF_W1T = 20 * MiB;
constexpr size_t OFF_W2T = 22 * MiB;
constexpr size_t OFF_BIAS1 = 22 * MiB + 64 * 1024;
constexpr size_t OFF_ADAP = 22 * MiB + 128 * 1024;
constexpr size_t OFF_KCMP = 24 * MiB;
constexpr size_t OFF_VCMP = 24 * MiB + 256 * 1024;
constexpr size_t OFF_CNT = 24 * MiB + 512 * 1024;
constexpr size_t OFF_SMALL = 25 * MiB;
constexpr size_t OFF_SSQ = 29 * MiB;
constexpr size_t OFF_H = 32 * MiB;
constexpr size_t OFF_PROJ = 96 * MiB;
constexpr size_t WS_NEEDED = 96 * MiB + (size_t)NTOK * NP * 2;

struct Params {
  const float* x; const float* c; const float* norm_g; const float* ada_w; const float* ada_b;
  const float* w_in; const float* w_out;
  const float* nsa_cmp_pos; const float* nsa_ck_w1; const float* nsa_ck_w2; const float* nsa_cv_w1; const float* nsa_cv_w2; const float* nsa_norm_g;
  const float* diff_lam; const float* diff_norm_g;
  const float* ssm_conv_w; const float* ssm_conv_b; const float* ssm_dt_bias; const float* ssm_a_log; const float* ssm_d; const float* ssm_norm_g;
  const float* ml_conv_w; const float* ml_conv_b; const float* ml_if_b; const float* ml_norm_g; const float* final_g;
  float* out; unsigned char* ws;
};

DI int otid() { int t = threadIdx.x; asm volatile("" : "+v"(t)); return t; }
DI unsigned pack2(float a, float b) { f32x2 v = {a, b}; bf16x2_t r = __builtin_convertvector(v, bf16x2_t); return __builtin_bit_cast(unsigned, r); }
DI u16 f2bf(float a) { return (u16)(pack2(a, 0.f) & 0xffffu); }
DI float bf2f(u16 h) { return __uint_as_float(((unsigned)h) << 16); }
DI float bflo(unsigned u) { return __uint_as_float(u << 16); }
DI float bfhi(unsigned u) { return __uint_as_float(u & 0xffff0000u); }
DI f32x4 mfma16(bf16x8 a, bf16x8 b, f32x4 c) { return __builtin_amdgcn_mfma_f32_16x16x32_bf16(a, b, c, 0, 0, 0); }
DI float wave_sum(float v) {
#pragma unroll
  for (int o = 32; o > 0; o >>= 1) v += __shfl_xor(v, o);
  return v;
}
DI float siluf(float v) { return v / (1.f + __expf(-v)); }
DI float sigmoidf_(float v) { return 1.f / (1.f + __expf(-v)); }
DI float exp2_(float v) { return __builtin_amdgcn_exp2f(v); }
DI s16x4 tr_read(const u16* p) { return __builtin_amdgcn_ds_read_tr16_b64_v4i16((LDSP s16x4*)p); }
DI bf16x8 cat4(s16x4 a, s16x4 b) { bf16x8 r; r[0] = a[0]; r[1] = a[1]; r[2] = a[2]; r[3] = a[3]; r[4] = b[0]; r[5] = b[1]; r[6] = b[2]; r[7] = b[3]; return r; }
DI bf16x8 ldfrag(const u16* p) { return *(const bf16x8*)p; }

DI int colmap(int n) {
  if (n < 640) return n;
  if (n < 896) return 652 + (n - 640);
  if (n < 1920) return 908 + (n - 896);
  if (n < 2688) return 1932 + (n - 1920);
  if (n < 3456) return 2704 + (n - 2688);
  if (n < 3968) return 3480 + (n - 3456);
  if (n < 3980) return 640 + (n - 3968);
  if (n < 3984) return 2700 + (n - 3980);
  if (n < 3992) return 3472 + (n - 3984);
  return -1;
}

DI void tconv_tile(const float* __restrict__ src, int ldsrc, int k0, int n0, u16* __restrict__ dst, int ldd, bool use_map, unsigned char* smem) {
  float* tile = (float*)smem;
  const int tid = otid();
  __syncthreads();
  {
    const int nn = tid & 63; int col = n0 + nn; if (use_map) col = colmap(col);
#pragma unroll
    for (int i = 0; i < 16; ++i) { const int kk = i * 4 + (tid >> 6); tile[kk * 65 + nn] = col >= 0 ? src[(size_t)(k0 + kk) * ldsrc + col] : 0.f; }
  }
  __syncthreads();
#pragma unroll
  for (int i = 0; i < 2; ++i) {
    const int item = tid + 256 * i, nn = item >> 3, kc = item & 7;
    u32x4 w;
    w.x = pack2(tile[(kc * 8 + 0) * 65 + nn], tile[(kc * 8 + 1) * 65 + nn]);
    w.y = pack2(tile[(kc * 8 + 2) * 65 + nn], tile[(kc * 8 + 3) * 65 + nn]);
    w.z = pack2(tile[(kc * 8 + 4) * 65 + nn], tile[(kc * 8 + 5) * 65 + nn]);
    w.w = pack2(tile[(kc * 8 + 6) * 65 + nn], tile[(kc * 8 + 7) * 65 + nn]);
    *(u32x4*)(dst + (size_t)(n0 + nn) * ldd + k0 + kc * 8) = w;
  }
}

constexpr int T0_WIN = 2 * 16 * 64, T0_WOUT = 2 * 16 * 16, T0_W1 = 4 * 32 * 2, T0_W2 = 4 * 2, T0_ADA = 2 * 12 * 8, T0_B1 = 4;
constexpr int T0_TOTAL = T0_WIN + T0_WOUT + T0_W1 + T0_W2 + T0_ADA + T0_B1;

DI void phase0_task(const Params& p, int t, unsigned char* smem) {
  const int tid = otid();
  if (t < T0_WIN) {
    const int l = t / 1024, r = t % 1024, kt = r / 64, nt = r % 64;
    tconv_tile(p.w_in + (size_t)l * D_MODEL * D_IN, D_IN, kt * 64, nt * 64, (u16*)(p.ws + OFF_WINT) + (size_t)l * NPAD * 1024, 1024, true, smem);
    return;
  }
  t -= T0_WIN;
  if (t < T0_WOUT) {
    const int l = t / 256, r = t % 256, kt = r / 16, nt = r % 16;
    tconv_tile(p.w_out + (size_t)l * 1024 * 1024, 1024, kt * 64, nt * 64, (u16*)(p.ws + OFF_WOUTT) + (size_t)l * 1024 * 1024, 1024, false, smem);
    return;
  }
  t -= T0_WOUT;
  if (t < T0_W1) {
    const int m = t / 64, r = t % 64, kt = r / 2, nt = r % 2, l = m >> 1, kv = m & 1;
    const float* src = (kv ? p.nsa_cv_w1 : p.nsa_ck_w1) + (size_t)l * 2048 * 128;
    tconv_tile(src, 128, kt * 64, nt * 64, (u16*)(p.ws + OFF_W1T) + (size_t)m * 128 * 2048, 2048, false, smem);
    return;
  }
  t -= T0_W1;
  if (t < T0_W2) {
    const int m = t / 2, kt = t % 2, l = m >> 1, kv = m & 1;
    const float* src = (kv ? p.nsa_cv_w2 : p.nsa_ck_w2) + (size_t)l * 128 * 64;
    tconv_tile(src, 64, kt * 64, 0, (u16*)(p.ws + OFF_W2T) + (size_t)m * 64 * 128, 128, false, smem);
    return;
  }
  t -= T0_W2;
  if (t < T0_ADA) {
    const int l = t / 96, r = t % 96, nc = r / 8, kc = r % 8;
    float* cact = (float*)smem;
    __syncthreads();
    for (int i = tid; i < 1024; i += 256) { const int b = i >> 7, kk = i & 127; const float v = p.c[b * 1024 + kc * 128 + kk]; cact[i] = siluf(v); }
    __syncthreads();
    const int n = nc * 256 + tid;
    float acc[8];
#pragma unroll
    for (int b = 0; b < 8; ++b) acc[b] = 0.f;
    const float* w = p.ada_w + ((size_t)l * 1024 + kc * 128) * 3072 + n;
    for (int kk = 0; kk < 128; ++kk) {
      const float wv = w[(size_t)kk * 3072];
#pragma unroll
      for (int b = 0; b < 8; ++b) acc[b] += cact[b * 128 + kk] * wv;
    }
    float* adap = (float*)(p.ws + OFF_ADAP);
    const float bias = kc == 0 ? p.ada_b[l * 3072 + n] : 0.f;
#pragma unroll
    for (int b = 0; b < 8; ++b) adap[(((size_t)kc * 2 + l) * 8 + b) * 3072 + n] = acc[b] + bias;
    return;
  }
  t -= T0_ADA;
  {
    const int l = t >> 1, kv = t & 1;
    const float* w1 = (kv ? p.nsa_cv_w1 : p.nsa_ck_w1) + (size_t)l * 2048 * 128;
    const float* pos = p.nsa_cmp_pos + (size_t)l * 2048;
    const int n = tid & 127, half = tid >> 7;
    float acc = 0.f;
    for (int k = half * 1024; k < half * 1024 + 1024; ++k) acc += pos[k] * w1[(size_t)k * 128 + n];
    float* red = (float*)smem;
    __syncthreads();
    red[tid] = acc;
    __syncthreads();
    if (tid < 128) ((float*)(p.ws + OFF_BIAS1))[t * 128 + tid] = red[tid] + red[tid + 128];
  }
}

DI void phase1_task(const Params& p, int layer, const float* xin, int grp, unsigned char* smem) {
  const int tid = otid(), lane = tid & 63, wid = tid >> 6;
  const int b = grp >> 6;
  float* mul = (float*)smem;
  float* sh = mul + 1024;
  const float* adap = (const float*)(p.ws + OFF_ADAP);
  __syncthreads();
  for (int c = tid; c < 1024; c += 256) {
    float s0 = 0.f, s1 = 0.f;
#pragma unroll
    for (int kc = 0; kc < 8; ++kc) { const float* a = adap + (((size_t)kc * 2 + layer) * 8 + b) * 3072; s0 += a[c]; s1 += a[1024 + c]; }
    mul[c] = p.norm_g[layer * 1024 + c] * (1.f + s1); sh[c] = s0;
  }
  __syncthreads();
  u16* H = (u16*)(p.ws + OFF_H);
  for (int rr = wid; rr < 64; rr += 4) {
    const int row = grp * 64 + rr;
    const float4* xr = (const float4*)(xin + (size_t)row * D_MODEL);
    float4 v[4]; float ss = 0.f;
#pragma unroll
    for (int i = 0; i < 4; ++i) { v[i] = xr[lane + 64 * i]; ss += v[i].x * v[i].x + v[i].y * v[i].y + v[i].z * v[i].z + v[i].w * v[i].w; }
    ss = wave_sum(ss);
    const float r = rsqrtf(ss * (1.f / D_MODEL) + 1e-6f);
#pragma unroll
    for (int i = 0; i < 4; ++i) {
      const int c = (lane + 64 * i) * 4;
      u32x2 w;
      w.x = pack2(v[i].x * r * mul[c] + sh[c], v[i].y * r * mul[c + 1] + sh[c + 1]);
      w.y = pack2(v[i].z * r * mul[c + 2] + sh[c + 2], v[i].w * r * mul[c + 3] + sh[c + 3]);
      *(u32x2*)(H + (size_t)row * 1024 + c) = w;
    }
  }
}

constexpr int GLD = 72;
DI void gemm_mainloop(const u16* __restrict__ A, int lda, const u16* __restrict__ Bt, int ldb, int K, int m0, int n0, unsigned char* smem, f32x4 (&acc)[4][4]) {
  u16* As = (u16*)smem; u16* Bs = As + 128 * GLD;
  const int tid = otid(), lane = tid & 63, wid = tid >> 6, wr = wid >> 1, wc = wid & 1, l15 = lane & 15, g = lane >> 4;
#pragma unroll
  for (int j = 0; j < 4; ++j)
#pragma unroll
    for (int i = 0; i < 4; ++i) acc[j][i] = (f32x4){0.f, 0.f, 0.f, 0.f};
  u32x4 ra[4], rb[4];
  const int lrow = tid >> 3, lch = tid & 7;
  const u16* ap = A + (size_t)(m0 + lrow) * lda + lch * 8;
  const u16* bp = Bt + (size_t)(n0 + lrow) * ldb + lch * 8;
#pragma unroll
  for (int i = 0; i < 4; ++i) { ra[i] = *(const u32x4*)(ap + (size_t)(32 * i) * lda); rb[i] = *(const u32x4*)(bp + (size_t)(32 * i) * ldb); }
  const int nk = K / 64;
  for (int kt = 0; kt < nk; ++kt) {
    __syncthreads();
#pragma unroll
    for (int i = 0; i < 4; ++i) { *(u32x4*)(As + (lrow + 32 * i) * GLD + lch * 8) = ra[i]; *(u32x4*)(Bs + (lrow + 32 * i) * GLD + lch * 8) = rb[i]; }
    __syncthreads();
    if (kt + 1 < nk) {
      const int k1 = (kt + 1) * 64;
#pragma unroll
      for (int i = 0; i < 4; ++i) { ra[i] = *(const u32x4*)(ap + (size_t)(32 * i) * lda + k1); rb[i] = *(const u32x4*)(bp + (size_t)(32 * i) * ldb + k1); }
    }
#pragma unroll
    for (int ks = 0; ks < 2; ++ks) {
      bf16x8 af[4], bfr[4];
#pragma unroll
      for (int i = 0; i < 4; ++i) af[i] = ldfrag(As + (wr * 64 + i * 16 + l15) * GLD + ks * 32 + 8 * g);
#pragma unroll
      for (int j = 0; j < 4; ++j) bfr[j] = ldfrag(Bs + (wc * 64 + j * 16 + l15) * GLD + ks * 32 + 8 * g);
#pragma unroll
      for (int j = 0; j < 4; ++j)
#pragma unroll
        for (int i = 0; i < 4; ++i) acc[j][i] = mfma16(bfr[j], af[i], acc[j][i]);
    }
  }
}

DI void gemm_inproj_tile(const Params& p, int layer, int tile, unsigned char* smem) {
  const int mt = tile >> 5, nt = tile & 31, m0 = mt * 128, n0 = nt * 128;
  const int tid = otid(), lane = tid & 63, wid = tid >> 6, wr = wid >> 1, wc = wid & 1, l15 = lane & 15, g = lane >> 4;
  f32x4 acc[4][4];
  gemm_mainloop((const u16*)(p.ws + OFF_H), 1024, (const u16*)(p.ws + OFF_WINT) + (size_t)layer * NPAD * 1024, 1024, 1024, m0, n0, smem, acc);
  if (nt == 31) {
    if (wc == 0) {
      float* sm = (float*)(p.ws + OFF_SMALL);
#pragma unroll
      for (int j = 0; j < 2; ++j)
#pragma unroll
        for (int i = 0; i < 4; ++i) {
          const int m = m0 + wr * 64 + i * 16 + l15, n = j * 16 + 4 * g;
          *(f32x4*)(sm + (size_t)m * NSMALL + n) = acc[j][i];
        }
    }
    return;
  }
  constexpr int CLD = 136;
  u16* Cs = (u16*)smem;
  __syncthreads();
#pragma unroll
  for (int j = 0; j < 4; ++j)
#pragma unroll
    for (int i = 0; i < 4; ++i) {
      const int ml = wr * 64 + i * 16 + l15, nl = wc * 64 + j * 16 + 4 * g;
      u32x2 w; w.x = pack2(acc[j][i][0], acc[j][i][1]); w.y = pack2(acc[j][i][2], acc[j][i][3]);
      *(u32x2*)(Cs + ml * CLD + nl) = w;
    }
  __syncthreads();
  u16* proj = (u16*)(p.ws + OFF_PROJ);
#pragma unroll
  for (int i = 0; i < 8; ++i) {
    const int id = tid + 256 * i, row = id >> 4, ch = id & 15;
    *(u32x4*)(proj + (size_t)(m0 + row) * NP + n0 + ch * 8) = *(const u32x4*)(Cs + row * CLD + ch * 8);
  }
}

DI void gemm_outproj_tile(const Params& p, int layer, const float* xin, float* xout, int tile, unsigned char* smem) {
  const int mt = tile >> 3, nt = tile & 7, m0 = mt * 128, n0 = nt * 128;
  const int tid = otid(), lane = tid & 63, wid = tid >> 6, wr = wid >> 1, wc = wid & 1, l15 = lane & 15, g = lane >> 4;
  f32x4 acc[4][4];
  gemm_mainloop((const u16*)(p.ws + OFF_H), 1024, (const u16*)(p.ws + OFF_WOUTT) + (size_t)layer * 1024 * 1024, 1024, 1024, m0, n0, smem, acc);
  const int b = m0 >> 12;
  const float* adap = (const float*)(p.ws + OFF_ADAP);
#pragma unroll
  for (int j = 0; j < 4; ++j) {
    const int n = n0 + wc * 64 + j * 16 + 4 * g;
    f32x4 gt = {0.f, 0.f, 0.f, 0.f};
#pragma unroll
    for (int kc = 0; kc < 8; ++kc) gt += *(const f32x4*)(adap + (((size_t)kc * 2 + layer) * 8 + b) * 3072 + 2048 + n);
#pragma unroll
    for (int i = 0; i < 4; ++i) {
      const int m = m0 + wr * 64 + i * 16 + l15;
      const f32x4 xv = *(const f32x4*)(xin + (size_t)m * 1024 + n);
      *(f32x4*)(xout + (size_t)m * 1024 + n) = xv + gt * acc[j][i];
    }
  }
}

constexpr int KLD = 72;
struct KVRegs { u32x4 k[2], v[2]; };
DI void kv_load(const u16* kbase, const u16* vbase, int ldk, int ldv, int key0, KVRegs& r) {
  const int tid = otid();
#pragma unroll
  for (int i = 0; i < 2; ++i) {
    const int id = tid + 256 * i, row = id >> 3, ch = id & 7;
    r.k[i] = *(const u32x4*)(kbase + (size_t)(key0 + row) * ldk + ch * 8);
    r.v[i] = *(const u32x4*)(vbase + (size_t)(key0 + row) * ldv + ch * 8);
  }
}
DI void kv_store(u16* Ks, u16* Vs, const KVRegs& r) {
  const int tid = otid();
#pragma unroll
  for (int i = 0; i < 2; ++i) {
    const int id = tid + 256 * i, row = id >> 3, ch = id & 7;
    *(u32x4*)(Ks + row * KLD + ch * 8) = r.k[i];
    *(u32x4*)(Vs + row * KLD + ch * 8) = r.v[i];
  }
}
struct AttnAcc { f32x4 o[4][2]; float m[2], l[2]; };
DI void attn_init(AttnAcc& a) {
#pragma unroll
  for (int d = 0; d < 4; ++d) { a.o[d][0] = (f32x4){0.f, 0.f, 0.f, 0.f}; a.o[d][1] = (f32x4){0.f, 0.f, 0.f, 0.f}; }
  a.m[0] = a.m[1] = -1e30f; a.l[0] = a.l[1] = 0.f;
}
template <int NKS>
DI void qk_tile(const u16* Ks, int dofs, const bf16x8 (&qf)[2][NKS], f32x4 (&s)[4][2], int l15, int g) {
#pragma unroll
  for (int kt = 0; kt < 4; ++kt) {
    s[kt][0] = (f32x4){0.f, 0.f, 0.f, 0.f}; s[kt][1] = (f32x4){0.f, 0.f, 0.f, 0.f};
#pragma unroll
    for (int ks = 0; ks < NKS; ++ks) {
      const bf16x8 a = ldfrag(Ks + (kt * 16 + l15) * KLD + dofs + ks * 32 + 8 * g);
      s[kt][0] = mfma16(a, qf[0][ks], s[kt][0]);
      s[kt][1] = mfma16(a, qf[1][ks], s[kt][1]);
    }
  }
}
DI void pv_accum(const bf16x8 (&pf)[2][2], const u16* Vs, f32x4 (&o)[4][2], int l15, int g) {
  const int tq = l15 >> 2, tp = l15 & 3;
#pragma unroll
  for (int kk = 0; kk < 2; ++kk)
#pragma unroll
    for (int d = 0; d < 4; ++d) {
      const bf16x8 vf = cat4(tr_read(Vs + (kk * 32 + 4 * g + tq) * KLD + d * 16 + 4 * tp), tr_read(Vs + (kk * 32 + 16 + 4 * g + tq) * KLD + d * 16 + 4 * tp));
      o[d][0] = mfma16(vf, pf[0][kk], o[d][0]);
      o[d][1] = mfma16(vf, pf[1][kk], o[d][1]);
    }
}
DI void pack_p(const f32x4 (&s)[4][2], bf16x8 (&pf)[2][2]) {
#pragma unroll
  for (int qt = 0; qt < 2; ++qt)
#pragma unroll
    for (int kk = 0; kk < 2; ++kk) {
      u32x4 w;
      w.x = pack2(s[2 * kk][qt][0], s[2 * kk][qt][1]); w.y = pack2(s[2 * kk][qt][2], s[2 * kk][qt][3]);
      w.z = pack2(s[2 * kk + 1][qt][0], s[2 * kk + 1][qt][1]); w.w = pack2(s[2 * kk + 1][qt][2], s[2 * kk + 1][qt][3]);
      pf[qt][kk] = __builtin_bit_cast(bf16x8, w);
    }
}
template <class VF>
DI void softmax_pv(f32x4 (&s)[4][2], AttnAcc& a, const u16* Vs, float sc, int l15, int g, VF valid) {
  bf16x8 pf[2][2];
#pragma unroll
  for (int qt = 0; qt < 2; ++qt) {
    float mx = -1e30f;
#pragma unroll
    for (int kt = 0; kt < 4; ++kt)
#pragma unroll
      for (int r = 0; r < 4; ++r) { const float v = valid(kt, r, qt) ? s[kt][qt][r] * sc : -1e30f; s[kt][qt][r] = v; mx = fmaxf(mx, v); }
    mx = fmaxf(mx, __shfl_xor(mx, 16)); mx = fmaxf(mx, __shfl_xor(mx, 32));
    const float mn = fmaxf(a.m[qt], mx), alpha = exp2_(a.m[qt] - mn);
    a.m[qt] = mn;
    float ls = 0.f;
#pragma unroll
    for (int kt = 0; kt < 4; ++kt)
#pragma unroll
      for (int r = 0; r < 4; ++r) { const float v = s[kt][qt][r]; const float pv = v > -1e29f ? exp2_(v - mn) : 0.f; s[kt][qt][r] = pv; ls += pv; }
    a.l[qt] = a.l[qt] * alpha + ls;
#pragma unroll
    for (int d = 0; d < 4; ++d) a.o[d][qt] *= alpha;
#pragma unroll
    for (int kk = 0; kk < 2; ++kk) {
      u32x4 w;
      w.x = pack2(s[2 * kk][qt][0], s[2 * kk][qt][1]); w.y = pack2(s[2 * kk][qt][2], s[2 * kk][qt][3]);
      w.z = pack2(s[2 * kk + 1][qt][0], s[2 * kk + 1][qt][1]); w.w = pack2(s[2 * kk + 1][qt][2], s[2 * kk + 1][qt][3]);
      pf[qt][kk] = __builtin_bit_cast(bf16x8, w);
    }
  }
  pv_accum(pf, Vs, a.o, l15, g);
}
DI float group_sum4(float v) { v += __shfl_xor(v, 16); v += __shfl_xor(v, 32); return v; }

DI void diff_attn_task(const Params& p, int layer, int b, int h, int qb, unsigned char* smem) {
  u16* Ks = (u16*)smem; u16* Vs = Ks + 64 * KLD;
  const int tid = otid(), lane = tid & 63, wid = tid >> 6, l15 = lane & 15, g = lane >> 4;
  const u16* proj = (const u16*)(p.ws + OFF_PROJ) + (size_t)b * SEQ * NP;
  const int q0w = qb * 128 + wid * 32;
  const float* lam = p.diff_lam + layer * 128;
  float s01 = 0.f, s23 = 0.f;
  for (int i = 0; i < 32; ++i) { s01 += lam[i] * lam[32 + i]; s23 += lam[64 + i] * lam[96 + i]; }
  const float lam_init = 0.8f - 0.6f * __expf(-0.3f * (float)layer);
  const float lam_full = __expf(s01) - __expf(s23) + lam_init;
  const float sc = 0.17677669529663687f * 1.4426950408889634f;
  const int ntile = 2 * qb + 2;
  const u16* vbase = proj + PB_V + h * 64;
  f32x4 res[4][2];
#pragma unroll 1
  for (int c = 0; c < 2; ++c) {
    const u16* kbase = proj + PB_K + h * 64 + c * 32;
    bf16x8 qf[2][1];
#pragma unroll
    for (int qt = 0; qt < 2; ++qt) qf[qt][0] = ldfrag(proj + (size_t)(q0w + qt * 16 + l15) * NP + PB_Q + h * 64 + c * 32 + 8 * g);
    AttnAcc a; attn_init(a);
    KVRegs kr; kv_load(kbase, vbase, NP, NP, 0, kr);
    for (int j = 0; j < ntile; ++j) {
      __syncthreads();
      kv_store(Ks, Vs, kr);
      __syncthreads();
      if (j + 1 < ntile) kv_load(kbase, vbase, NP, NP, (j + 1) * 64, kr);
      const int key0 = j * 64;
      if (key0 <= q0w + 31) {
        f32x4 s[4][2];
        auto valid = [&](int kt, int r, int qt) { return key0 + kt * 16 + 4 * g + r <= q0w + qt * 16 + l15; };
        qk_tile<1>(Ks, 0, qf, s, l15, g);
        softmax_pv(s, a, Vs, sc, l15, g, valid);
      }
    }
#pragma unroll
    for (int qt = 0; qt < 2; ++qt) {
      const float lt = group_sum4(a.l[qt]);
      const float inv = c == 0 ? 1.f / lt : -lam_full / lt;
#pragma unroll
      for (int d = 0; d < 4; ++d) res[d][qt] = c == 0 ? a.o[d][qt] * inv : res[d][qt] + a.o[d][qt] * inv;
    }
  }
  u16* Y = (u16*)(p.ws + OFF_H);
  const float* ng = p.diff_norm_g + layer * 64;
#pragma unroll
  for (int qt = 0; qt < 2; ++qt) {
    float ss = 0.f;
#pragma unroll
    for (int d = 0; d < 4; ++d) { const f32x4 v = res[d][qt]; ss += v[0] * v[0] + v[1] * v[1] + v[2] * v[2] + v[3] * v[3]; }
    ss = group_sum4(ss);
    const float rn = rsqrtf(ss * (1.f / 64.f) + 1e-6f) * (1.f - lam_init);
    const int t = q0w + qt * 16 + l15;
    const size_t row = (size_t)b * SEQ + t;
#pragma unroll
    for (int d = 0; d < 4; ++d) {
      const int dd = d * 16 + 4 * g;
      const f32x4 v = res[d][qt];
      const u32x2 zz = *(const u32x2*)(proj + (size_t)t * NP + PB_Z + h * 64 + dd);
      const f32x4 gg = *(const f32x4*)(ng + dd);
      u32x2 w;
      w.x = pack2(v[0] * rn * gg[0] * siluf(bflo(zz.x)), v[1] * rn * gg[1] * siluf(bfhi(zz.x)));
      w.y = pack2(v[2] * rn * gg[2] * siluf(bflo(zz.y)), v[3] * rn * gg[3] * siluf(bfhi(zz.y)));
      *(u32x2*)(Y + row * 1024 + Y_B + h * 64 + dd) = w;
    }
  }
}

DI void conv_silu_stage(const u16* projb, int col0, const float* cw, const float* cb, int chan0, int nchan, int t0, u16* dst, const float* rowscale, float cscale) {
  const int tid = otid(), ch = (tid & 7) * 8;
  float w[4][8], bias[8];
#pragma unroll
  for (int j = 0; j < 4; ++j)
#pragma unroll
    for (int i = 0; i < 8; ++i) w[j][i] = cw[j * nchan + chan0 + ch + i];
#pragma unroll
  for (int i = 0; i < 8; ++i) bias[i] = cb[chan0 + ch + i];
#pragma unroll 1
  for (int ps = 0; ps < 4; ++ps) {
    const int row = ps * 32 + (tid >> 3), t = t0 + row;
    float acc[8];
#pragma unroll
    for (int i = 0; i < 8; ++i) acc[i] = bias[i];
#pragma unroll
    for (int j = 0; j < 4; ++j) {
      const int tt = t - 3 + j;
      if (tt >= 0) {
        const u32x4 v = *(const u32x4*)(projb + (size_t)tt * NP + col0 + ch);
        acc[0] += w[j][0] * bflo(v.x); acc[1] += w[j][1] * bfhi(v.x); acc[2] += w[j][2] * bflo(v.y); acc[3] += w[j][3] * bfhi(v.y);
        acc[4] += w[j][4] * bflo(v.z); acc[5] += w[j][5] * bfhi(v.z); acc[6] += w[j][6] * bflo(v.w); acc[7] += w[j][7] * bfhi(v.w);
      }
    }
    const float rs = (rowscale ? rowscale[row] : 1.f) * cscale;
#pragma unroll
    for (int i = 0; i < 8; ++i) acc[i] = siluf(acc[i]) * rs;
    u32x4 o; o.x = pack2(acc[0], acc[1]); o.y = pack2(acc[2], acc[3]); o.z = pack2(acc[4], acc[5]); o.w = pack2(acc[6], acc[7]);
    *(u32x4*)(dst + row * KLD + ch) = o;
  }
}
DI float block_scan128_add(float v, float* tmp) {
  const int tid = otid(), lane = tid & 63;
  float x = v;
#pragma unroll
  for (int o = 1; o < 64; o <<= 1) { const float y = __shfl_up(x, o); if (lane >= o) x += y; }
  __syncthreads();
  if (tid == 63) tmp[0] = x;
  __syncthreads();
  if ((tid >> 6) == 1) x += tmp[0];
  return x;
}
DI float block_scan128_max(float v, float* tmp) {
  const int tid = otid(), lane = tid & 63;
  float x = v;
#pragma unroll
  for (int o = 1; o < 64; o <<= 1) { const float y = __shfl_up(x, o); if (lane >= o) x = fmaxf(x, y); }
  __syncthreads();
  if (tid == 63) tmp[0] = x;
  __syncthreads();
  if ((tid >> 6) == 1) x = fmaxf(x, tmp[0]);
  return x;
}
DI void scale_rows(u16* A, const float* rs) {
  const int tid = otid(), ch = (tid & 7) * 8;
#pragma unroll
  for (int ps = 0; ps < 4; ++ps) {
    const int row = ps * 32 + (tid >> 3);
    const float f = rs[row];
    u32x4 v = *(u32x4*)(A + row * KLD + ch);
    v.x = pack2(bflo(v.x) * f, bfhi(v.x) * f); v.y = pack2(bflo(v.y) * f, bfhi(v.y) * f);
    v.z = pack2(bflo(v.z) * f, bfhi(v.z) * f); v.w = pack2(bflo(v.w) * f, bfhi(v.w) * f);
    *(u32x4*)(A + row * KLD + ch) = v;
  }
}
DI void state_update(const u16* Xs, const u16* Bs, f32x4 (&acc)[4], int w, int l15, int g) {
  const int tq = l15 >> 2, tp = l15 & 3;
#pragma unroll
  for (int kk = 0; kk < 4; ++kk) {
    const bf16x8 af = cat4(tr_read(Xs + (kk * 32 + 4 * g + tq) * KLD + w * 16 + 4 * tp), tr_read(Xs + (kk * 32 + 16 + 4 * g + tq) * KLD + w * 16 + 4 * tp));
#pragma unroll
    for (int nt = 0; nt < 4; ++nt) {
      const bf16x8 bfr = cat4(tr_read(Bs + (kk * 32 + 4 * g + tq) * KLD + nt * 16 + 4 * tp), tr_read(Bs + (kk * 32 + 16 + 4 * g + tq) * KLD + nt * 16 + 4 * tp));
      acc[nt] = mfma16(af, bfr, acc[nt]);
    }
  }
}
DI void state_to_lds(u16* Ss, const f32x4 (&acc)[4], int w, int l15, int g) {
#pragma unroll
  for (int nt = 0; nt < 4; ++nt)
#pragma unroll
    for (int r = 0; r < 4; ++r) Ss[(w * 16 + 4 * g + r) * KLD + nt * 16 + l15] = f2bf(acc[nt][r]);
}

constexpr int SEQ_LDS_A = 0, SEQ_LDS_B = 128 * KLD * 2, SEQ_LDS_C = 2 * 128 * KLD * 2, SEQ_LDS_S = 3 * 128 * KLD * 2, SEQ_LDS_F = SEQ_LDS_S + 64 * KLD * 2;
constexpr int SEQ_LDS_HALO = SEQ_LDS_F + 4096;
constexpr int SEQ_LDS_CW = SEQ_LDS_HALO + 2 * 3 * 3 * 64 * 2;
struct RawRegs { u32x4 r[4]; };
DI void raw_load(const u16* projb, int col0, int t0, RawRegs& rr, int tid) {
#pragma unroll
  for (int i = 0; i < 4; ++i) rr.r[i] = *(const u32x4*)(projb + (size_t)(t0 + (tid >> 3) + 32 * i) * NP + col0 + (tid & 7) * 8);
}
DI void raw_store(u16* dst, u16* halo_next, const RawRegs& rr, int tid) {
#pragma unroll
  for (int i = 0; i < 4; ++i) *(u32x4*)(dst + ((tid >> 3) + 32 * i) * KLD + (tid & 7) * 8) = rr.r[i];
  if (halo_next && tid >= 232) *(u32x4*)(halo_next + ((tid >> 3) - 29) * 64 + (tid & 7) * 8) = rr.r[3];
}
DI void conv_from_lds(const u16* raw, const u16* halo, const float* wl, const float* rowscale, float cscale, u32x4 (&out)[4], int tid) {
  const int q = tid >> 3, ch = (tid & 7) * 8;
  u32x4 v[7];
#pragma unroll
  for (int k = 0; k < 7; ++k) { const int r = 4 * q - 3 + k; v[k] = r >= 0 ? *(const u32x4*)(raw + r * KLD + ch) : *(const u32x4*)(halo + (r + 3) * 64 + ch); }
  float w[5][8];
#pragma unroll
  for (int j = 0; j < 5; ++j) { const f32x4 w0 = *(const f32x4*)(wl + j * 64 + ch), w1 = *(const f32x4*)(wl + j * 64 + ch + 4);
    w[j][0] = w0[0]; w[j][1] = w0[1]; w[j][2] = w0[2]; w[j][3] = w0[3]; w[j][4] = w1[0]; w[j][5] = w1[1]; w[j][6] = w1[2]; w[j][7] = w1[3]; }
#pragma unroll
  for (int o = 0; o < 4; ++o) {
    float acc[8];
#pragma unroll
    for (int i = 0; i < 8; ++i) acc[i] = w[4][i];
#pragma unroll
    for (int j = 0; j < 4; ++j) {
      const u32x4 x = v[o + j];
      acc[0] += w[j][0] * bflo(x.x); acc[1] += w[j][1] * bfhi(x.x); acc[2] += w[j][2] * bflo(x.y); acc[3] += w[j][3] * bfhi(x.y);
      acc[4] += w[j][4] * bflo(x.z); acc[5] += w[j][5] * bfhi(x.z); acc[6] += w[j][6] * bflo(x.w); acc[7] += w[j][7] * bfhi(x.w);
    }
    const float rs = (rowscale ? rowscale[4 * q + o] : 1.f) * cscale;
#pragma unroll
    for (int i = 0; i < 8; ++i) acc[i] = siluf(acc[i]) * rs;
    out[o].x = pack2(acc[0], acc[1]); out[o].y = pack2(acc[2], acc[3]); out[o].z = pack2(acc[4], acc[5]); out[o].w = pack2(acc[6], acc[7]);
  }
}
DI void conv_write(u16* dst, const u32x4 (&out)[4], int tid) {
  const int q = tid >> 3, ch = (tid & 7) * 8;
#pragma unroll
  for (int o = 0; o < 4; ++o) *(u32x4*)(dst + (4 * q + o) * KLD + ch) = out[o];
}
DI void stage_conv_w(float* wl, const float* cw, const float* cb, int chan0, int nchan, int tid) {
  for (int i = tid; i < 320; i += 256) { const int j = i >> 6, cc = i & 63; wl[i] = j < 4 ? cw[j * nchan + chan0 + cc] : cb[chan0 + cc]; }
}
DI float wave_scan_add(float x, int lane) {
#pragma unroll
  for (int o = 1; o < 64; o <<= 1) { const float y = __shfl_up(x, o); if (lane >= o) x += y; }
  return x;
}
DI float wave_scan_max(float x, int lane) {
#pragma unroll
  for (int o = 1; o < 64; o <<= 1) { const float y = __shfl_up(x, o); if (lane >= o) x = fmaxf(x, y); }
  return x;
}

DI void ssd_task(const Params& p, int layer, int b, int h, unsigned char* smem) {
  u16* Cs = (u16*)(smem + SEQ_LDS_A); u16* Bs = (u16*)(smem + SEQ_LDS_B); u16* Xs = (u16*)(smem + SEQ_LDS_C); u16* Ss = (u16*)(smem + SEQ_LDS_S);
  float* fl = (float*)(smem + SEQ_LDS_F);
  float* dts = fl; float* acs = fl + 128; float* wend = fl + 256; float* tmp = fl + 384;
  u16* halo = (u16*)(smem + SEQ_LDS_HALO); float* cwl = (float*)(smem + SEQ_LDS_CW);
  int tid = otid(), lane = tid & 63, w = tid >> 6, l15 = lane & 15, g = lane >> 4;
  const int gi = h >> 1;
  const u16* projb = (const u16*)(p.ws + OFF_PROJ) + (size_t)b * SEQ * NP;
  const float* smb = (const float*)(p.ws + OFF_SMALL) + (size_t)b * SEQ * NSMALL;
  const float* cw = p.ssm_conv_w + layer * 4 * 512; const float* cb = p.ssm_conv_b + layer * 512;
  u16* Y = (u16*)(p.ws + OFF_H);
  float* ssq = (float*)(p.ws + OFF_SSQ);
  const float a_h = -__expf(p.ssm_a_log[layer * 4 + h]), d_h = p.ssm_d[layer * 4 + h], dtb = p.ssm_dt_bias[layer * 4 + h];
  const int colB = PC_XBC + 256 + gi * 64, colC = PC_XBC + 384 + gi * 64, colX = PC_XBC + h * 64;
  f32x4 st[4];
#pragma unroll
  for (int nt = 0; nt < 4; ++nt) st[nt] = (f32x4){0.f, 0.f, 0.f, 0.f};
  __syncthreads();
  stage_conv_w(cwl, cw, cb, 256 + gi * 64, 512, tid);
  stage_conv_w(cwl + 320, cw, cb, 384 + gi * 64, 512, tid);
  stage_conv_w(cwl + 640, cw, cb, h * 64, 512, tid);
  for (int i = tid; i < 3 * 3 * 64; i += 256) halo[i] = 0;
  RawRegs rB, rC, rX; float dtraw = 0.f;
  raw_load(projb, colB, 0, rB, tid); raw_load(projb, colC, 0, rC, tid); raw_load(projb, colX, 0, rX, tid);
  if (tid < 128) dtraw = smb[(size_t)tid * NSMALL + SM_DT + h];
#pragma unroll 1
  for (int c = 0; c < 32; ++c) {
    const int t0 = c * 128;
    asm volatile("" : "+v"(tid)); lane = tid & 63; w = tid >> 6; l15 = lane & 15; g = lane >> 4;
    u16* hcur = halo + (c & 1) * 576; u16* hnext = halo + ((c + 1) & 1) * 576;
    float dtv = 0.f;
    if (tid < 128) { const float xr = dtraw + dtb; dtv = xr > 20.f ? xr : log1pf(__expf(xr)); }
    float cs = wave_scan_add(dtv * a_h, lane);
    if (tid == 63) tmp[0] = cs;
    __syncthreads();
    if (w == 1) cs += tmp[0];
    if (tid < 128) { dts[tid] = dtv; acs[tid] = cs; }
    raw_store(Bs, hnext, rB, tid); raw_store(Cs, hnext + 192, rC, tid); raw_store(Xs, hnext + 384, rX, tid);
    __syncthreads();
    if (c + 1 < 32) {
      raw_load(projb, colB, t0 + 128, rB, tid); raw_load(projb, colC, t0 + 128, rC, tid);
      if (tid < 128) dtraw = smb[(size_t)(t0 + 128 + tid) * NSMALL + SM_DT + h];
    }
    {
      u32x4 o1[4], o2[4];
      conv_from_lds(Bs, hcur, cwl, nullptr, 1.f, o1, tid);
      __syncthreads();
      conv_write(Bs, o1, tid);
      conv_from_lds(Cs, hcur + 192, cwl + 320, nullptr, 1.f, o2, tid);
      __syncthreads();
      conv_write(Cs, o2, tid);
      conv_from_lds(Xs, hcur + 384, cwl + 640, dts, 1.f, o1, tid);
      __syncthreads();
      conv_write(Xs, o1, tid);
    }
    if (tid < 128) wend[tid] = __expf(acs[127] - acs[tid]);
    state_to_lds(Ss, st, w, l15, g);
    __syncthreads();
    {
      bf16x8 cf[2][2];
#pragma unroll
      for (int qt = 0; qt < 2; ++qt)
#pragma unroll
        for (int ks = 0; ks < 2; ++ks) cf[qt][ks] = ldfrag(Cs + (32 * w + qt * 16 + l15) * KLD + ks * 32 + 8 * g);
      f32x4 y[4][2];
#pragma unroll
      for (int d = 0; d < 4; ++d) { y[d][0] = (f32x4){0.f, 0.f, 0.f, 0.f}; y[d][1] = (f32x4){0.f, 0.f, 0.f, 0.f}; }
      float at[2];
#pragma unroll
      for (int qt = 0; qt < 2; ++qt) at[qt] = acs[32 * w + qt * 16 + l15];
#pragma unroll
      for (int stl = 0; stl < 2; ++stl) {
        if (stl * 64 <= 32 * w + 31) {
          f32x4 sc[4][2];
          qk_tile<2>(Bs + stl * 64 * KLD, 0, cf, sc, l15, g);
#pragma unroll
          for (int kt = 0; kt < 4; ++kt) {
            const f32x4 as = *(const f32x4*)(acs + stl * 64 + kt * 16 + 4 * g);
#pragma unroll
            for (int qt = 0; qt < 2; ++qt)
#pragma unroll
              for (int r = 0; r < 4; ++r) {
                const bool ok = stl * 64 + kt * 16 + 4 * g + r <= 32 * w + qt * 16 + l15;
                sc[kt][qt][r] = ok ? sc[kt][qt][r] * __expf(at[qt] - as[r]) : 0.f;
              }
          }
          bf16x8 pf[2][2];
          pack_p(sc, pf);
          pv_accum(pf, Xs + stl * 64 * KLD, y, l15, g);
        }
      }
#pragma unroll
      for (int d = 0; d < 4; ++d) {
        f32x4 yo0 = (f32x4){0.f, 0.f, 0.f, 0.f}, yo1 = (f32x4){0.f, 0.f, 0.f, 0.f};
#pragma unroll
        for (int ks = 0; ks < 2; ++ks) {
          const bf16x8 a = ldfrag(Ss + (d * 16 + l15) * KLD + ks * 32 + 8 * g);
          yo0 = mfma16(a, cf[0][ks], yo0);
          yo1 = mfma16(a, cf[1][ks], yo1);
        }
        y[d][0] += yo0 * __expf(at[0]); y[d][1] += yo1 * __expf(at[1]);
      }
#pragma unroll
      for (int qt = 0; qt < 2; ++qt) {
        const int tl = 32 * w + qt * 16 + l15;
        const float dsk = d_h / dts[tl];
        const size_t row = (size_t)b * SEQ + t0 + tl;
        float sq = 0.f;
#pragma unroll
        for (int d = 0; d < 4; ++d) {
          const u32x2 xv = *(const u32x2*)(Xs + tl * KLD + d * 16 + 4 * g);
          const u32x2 zv = *(const u32x2*)(projb + (size_t)(t0 + tl) * NP + PC_Z + h * 64 + d * 16 + 4 * g);
          f32x4 v = y[d][qt];
          v[0] = (v[0] + dsk * bflo(xv.x)) * siluf(bflo(zv.x)); v[1] = (v[1] + dsk * bfhi(xv.x)) * siluf(bfhi(zv.x));
          v[2] = (v[2] + dsk * bflo(xv.y)) * siluf(bflo(zv.y)); v[3] = (v[3] + dsk * bfhi(xv.y)) * siluf(bfhi(zv.y));
          sq += v[0] * v[0] + v[1] * v[1] + v[2] * v[2] + v[3] * v[3];
          u32x2 o; o.x = pack2(v[0], v[1]); o.y = pack2(v[2], v[3]);
          *(u32x2*)(Y + row * 1024 + Y_C + h * 64 + d * 16 + 4 * g) = o;
        }
        sq = group_sum4(sq);
        if (g == 0) ssq[row * 4 + h] = sq;
      }
    }
    if (c + 1 < 32) raw_load(projb, colX, t0 + 128, rX, tid);
    __syncthreads();
    scale_rows(Xs, wend);
    __syncthreads();
    const float cd = __expf(acs[127]);
#pragma unroll
    for (int nt = 0; nt < 4; ++nt) st[nt] *= cd;
    state_update(Xs, Bs, st, w, l15, g);
  }
}
DI void ssd_norm_fix(const Params& p, int layer, int r0, int nrows) {
  u16* Y = (u16*)(p.ws + OFF_H);
  const float* ssq = (const float*)(p.ws + OFF_SSQ);
  const float* ng = p.ssm_norm_g + layer * 256;
  const int tid = otid();
  for (int i = tid; i < nrows * 32; i += 256) {
    const int row = r0 + (i >> 5), ch = (i & 31) * 8, gi = ch >> 7;
    const float rn = rsqrtf((ssq[(size_t)row * 4 + 2 * gi] + ssq[(size_t)row * 4 + 2 * gi + 1]) * (1.f / 128.f) + 1e-6f);
    u32x4 v = *(u32x4*)(Y + (size_t)row * 1024 + Y_C + ch);
    const f32x4 g0 = *(const f32x4*)(ng + ch), g1 = *(const f32x4*)(ng + ch + 4);
    v.x = pack2(bflo(v.x) * rn * g0[0], bfhi(v.x) * rn * g0[1]); v.y = pack2(bflo(v.y) * rn * g0[2], bfhi(v.y) * rn * g0[3]);
    v.z = pack2(bflo(v.z) * rn * g1[0], bfhi(v.z) * rn * g1[1]); v.w = pack2(bflo(v.w) * rn * g1[2], bfhi(v.w) * rn * g1[3]);
    *(u32x4*)(Y + (size_t)row * 1024 + Y_C + ch) = v;
  }
}

DI void mlstm_task(const Params& p, int layer, int b, int h, unsigned char* smem) {
  u16* Qs = (u16*)(smem + SEQ_LDS_A); u16* Ks2 = (u16*)(smem + SEQ_LDS_B); u16* Vs2 = (u16*)(smem + SEQ_LDS_C); u16* Cst = (u16*)(smem + SEQ_LDS_S);
  float* fl = (float*)(smem + SEQ_LDS_F);
  float* bcs = fl; float* us = fl + 128; float* pms = fl + 256; float* wend = fl + 384; float* nst = fl + 512; float* npart = fl + 576; float* tmp = fl + 832;
  u16* halo = (u16*)(smem + SEQ_LDS_HALO); float* cwl = (float*)(smem + SEQ_LDS_CW);
  int tid = otid(), lane = tid & 63, w = tid >> 6, l15 = lane & 15, g = lane >> 4;
  const u16* projb = (const u16*)(p.ws + OFF_PROJ) + (size_t)b * SEQ * NP;
  const float* smb = (const float*)(p.ws + OFF_SMALL) + (size_t)b * SEQ * NSMALL;
  const float* cw = p.ml_conv_w + layer * 4 * 512; const float* cb = p.ml_conv_b + layer * 512;
  const float ib = p.ml_if_b[layer * 8 + h], fb = p.ml_if_b[layer * 8 + 4 + h];
  u16* Y = (u16*)(p.ws + OFF_H);
  const int colQ = PD_QK + h * 64, colK = PD_QK + 256 + h * 64, colV = PD_V + h * 64;
  f32x4 st[4];
#pragma unroll
  for (int nt = 0; nt < 4; ++nt) st[nt] = (f32x4){0.f, 0.f, 0.f, 0.f};
  float m_prev = 0.f;
  __syncthreads();
  if (tid < 64) nst[tid] = 0.f;
  stage_conv_w(cwl, cw, cb, h * 64, 512, tid);
  stage_conv_w(cwl + 320, cw, cb, 256 + h * 64, 512, tid);
  for (int i = tid; i < 3 * 3 * 64; i += 256) halo[i] = 0;
  RawRegs rQ, rK, rV; float iraw = 0.f, fraw = 0.f;
  raw_load(projb, colQ, 0, rQ, tid); raw_load(projb, colK, 0, rK, tid); raw_load(projb, colV, 0, rV, tid);
  if (tid < 128) { iraw = smb[(size_t)tid * NSMALL + SM_IF + h]; fraw = smb[(size_t)tid * NSMALL + SM_IF + 4 + h]; }
#pragma unroll 1
  for (int c = 0; c < 32; ++c) {
    const int t0 = c * 128;
    asm volatile("" : "+v"(tid)); lane = tid & 63; w = tid >> 6; l15 = lane & 15; g = lane >> 4;
    u16* hcur = halo + (c & 1) * 576; u16* hnext = halo + ((c + 1) & 1) * 576;
    float ip = 0.f, lf = 0.f;
    if (tid < 128) { ip = iraw + ib; const float fp = fraw + fb; lf = fminf(fp, 0.f) - log1pf(__expf(-fabsf(fp))); }
    float bc = wave_scan_add(lf, lane);
    if (tid == 63) tmp[0] = bc;
    __syncthreads();
    if (w == 1) bc += tmp[0];
    const float u = tid < 128 ? ip - bc : -1e30f;
    float pm = wave_scan_max(u, lane);
    if (tid == 63) tmp[1] = pm;
    raw_store(Qs, hnext, rQ, tid); raw_store(Ks2, hnext + 192, rK, tid); raw_store(Vs2, nullptr, rV, tid);
    __syncthreads();
    if (w == 1) pm = fmaxf(pm, tmp[1]);
    if (tid < 128) { bcs[tid] = bc; us[tid] = u; pms[tid] = pm; }
    if (c + 1 < 32) {
      raw_load(projb, colQ, t0 + 128, rQ, tid); raw_load(projb, colK, t0 + 128, rK, tid);
      if (tid < 128) { iraw = smb[(size_t)(t0 + 128 + tid) * NSMALL + SM_IF + h]; fraw = smb[(size_t)(t0 + 128 + tid) * NSMALL + SM_IF + 4 + h]; }
    }
    u32x4 oQ[4], oK[4];
    conv_from_lds(Qs, hcur, cwl, nullptr, 1.f, oQ, tid);
    __builtin_amdgcn_sched_barrier(0);
    conv_from_lds(Ks2, hcur + 192, cwl + 320, nullptr, 0.125f, oK, tid);
    __builtin_amdgcn_sched_barrier(0);
    __syncthreads();
    conv_write(Qs, oQ, tid); conv_write(Ks2, oK, tid);
    state_to_lds(Cst, st, w, l15, g);
    const float blast = bcs[127];
    const float m_new = blast + fmaxf(m_prev, pms[127]);
    if (tid < 128) wend[tid] = __expf(blast - m_new + us[tid]);
    __syncthreads();
    {
      bf16x8 qf[2][2];
#pragma unroll
      for (int qt = 0; qt < 2; ++qt)
#pragma unroll
        for (int ks = 0; ks < 2; ++ks) qf[qt][ks] = ldfrag(Qs + (32 * w + qt * 16 + l15) * KLD + ks * 32 + 8 * g);
      f32x4 num[4][2];
#pragma unroll
      for (int d = 0; d < 4; ++d) { num[d][0] = (f32x4){0.f, 0.f, 0.f, 0.f}; num[d][1] = (f32x4){0.f, 0.f, 0.f, 0.f}; }
      float bt[2], mt[2], den[2];
#pragma unroll
      for (int qt = 0; qt < 2; ++qt) { const int tl = 32 * w + qt * 16 + l15; bt[qt] = bcs[tl]; mt[qt] = bt[qt] + fmaxf(m_prev, pms[tl]); den[qt] = 0.f; }
#pragma unroll
      for (int stl = 0; stl < 2; ++stl) {
        if (stl * 64 <= 32 * w + 31) {
          f32x4 sc[4][2];
          qk_tile<2>(Ks2 + stl * 64 * KLD, 0, qf, sc, l15, g);
#pragma unroll
          for (int kt = 0; kt < 4; ++kt) {
            const f32x4 uu = *(const f32x4*)(us + stl * 64 + kt * 16 + 4 * g);
#pragma unroll
            for (int qt = 0; qt < 2; ++qt)
#pragma unroll
              for (int r = 0; r < 4; ++r) {
                const bool ok = stl * 64 + kt * 16 + 4 * g + r <= 32 * w + qt * 16 + l15;
                const float v = ok ? sc[kt][qt][r] * __expf(bt[qt] - mt[qt] + uu[r]) : 0.f;
                sc[kt][qt][r] = v; den[qt] += v;
              }
          }
          bf16x8 pf[2][2];
          pack_p(sc, pf);
          pv_accum(pf, Vs2 + stl * 64 * KLD, num, l15, g);
        }
      }
      const float* ng = p.ml_norm_g + layer * 64;
#pragma unroll
      for (int qt = 0; qt < 2; ++qt) {
        const int tl = 32 * w + qt * 16 + l15;
        const float wi = __expf(bt[qt] + m_prev - mt[qt]);
        float qn = 0.f;
#pragma unroll
        for (int ks = 0; ks < 2; ++ks)
#pragma unroll
          for (int j = 0; j < 8; ++j) qn += bf2f((u16)qf[qt][ks][j]) * nst[ks * 32 + 8 * g + j];
        qn = group_sum4(qn);
        const float dn = group_sum4(den[qt]) + wi * qn;
        const float inv = 1.f / fmaxf(fabsf(dn), __expf(-mt[qt]));
        f32x4 hv[4]; float sq = 0.f;
#pragma unroll
        for (int d = 0; d < 4; ++d) {
          f32x4 ni = (f32x4){0.f, 0.f, 0.f, 0.f};
#pragma unroll
          for (int ks = 0; ks < 2; ++ks) ni = mfma16(ldfrag(Cst + (d * 16 + l15) * KLD + ks * 32 + 8 * g), qf[qt][ks], ni);
          const u32x2 ov = *(const u32x2*)(projb + (size_t)(t0 + tl) * NP + PD_O + h * 64 + d * 16 + 4 * g);
          f32x4 v = (num[d][qt] + ni * wi) * inv;
          v[0] *= sigmoidf_(bflo(ov.x)); v[1] *= sigmoidf_(bfhi(ov.x)); v[2] *= sigmoidf_(bflo(ov.y)); v[3] *= sigmoidf_(bfhi(ov.y));
          hv[d] = v; sq += v[0] * v[0] + v[1] * v[1] + v[2] * v[2] + v[3] * v[3];
        }
        sq = group_sum4(sq);
        const float rn = rsqrtf(sq * (1.f / 64.f) + 1e-6f);
        const size_t row = (size_t)b * SEQ + t0 + tl;
#pragma unroll
        for (int d = 0; d < 4; ++d) {
          const int dd = d * 16 + 4 * g;
          const u32x2 zv = *(const u32x2*)(projb + (size_t)(t0 + tl) * NP + PD_Z + h * 64 + dd);
          const f32x4 gg = *(const f32x4*)(ng + dd);
          u32x2 o;
          o.x = pack2(hv[d][0] * rn * gg[0] * siluf(bflo(zv.x)), hv[d][1] * rn * gg[1] * siluf(bfhi(zv.x)));
          o.y = pack2(hv[d][2] * rn * gg[2] * siluf(bflo(zv.y)), hv[d][3] * rn * gg[3] * siluf(bfhi(zv.y)));
          *(u32x2*)(Y + row * 1024 + Y_D + h * 64 + dd) = o;
        }
      }
    }
    if (c + 1 < 32) raw_load(projb, colV, t0 + 128, rV, tid);
    __syncthreads();
    scale_rows(Ks2, wend);
    __syncthreads();
    const float fprev = __expf(blast + m_prev - m_new);
#pragma unroll
    for (int nt = 0; nt < 4; ++nt) st[nt] *= fprev;
    state_update(Vs2, Ks2, st, w, l15, g);
    {
      const int e = tid & 63, part = tid >> 6;
      float a = 0.f;
      for (int s2 = part * 32; s2 < part * 32 + 32; ++s2) a += bf2f(Ks2[s2 * KLD + e]);
      npart[part * 64 + e] = a;
    }
    __syncthreads();
    if (tid < 64) nst[tid] = nst[tid] * fprev + npart[tid] + npart[64 + tid] + npart[128 + tid] + npart[192 + tid];
    m_prev = m_new;
  }
}

DI void compress_task(const Params& p, int layer, int b, int kv, int rb, unsigned char* smem) {
  constexpr int HLD = 136;
  u16* Hs = (u16*)smem;
  const int tid = otid(), lane = tid & 63, w = tid >> 6, l15 = lane & 15, g = lane >> 4;
  const u16* projb = (const u16*)(p.ws + OFF_PROJ) + (size_t)b * SEQ * NP + (kv ? PA_VC : PA_KC);
  const int mi = layer * 2 + kv;
  const u16* W1T = (const u16*)(p.ws + OFF_W1T) + (size_t)mi * 128 * 2048;
  const u16* W2T = (const u16*)(p.ws + OFF_W2T) + (size_t)mi * 64 * 128;
  const float* bias1 = (const float*)(p.ws + OFF_BIAS1) + mi * 128;
  f32x4 acc[2][2];
#pragma unroll
  for (int nt = 0; nt < 2; ++nt) { acc[nt][0] = (f32x4){0.f, 0.f, 0.f, 0.f}; acc[nt][1] = (f32x4){0.f, 0.f, 0.f, 0.f}; }
  int tok[2];
#pragma unroll
  for (int mt = 0; mt < 2; ++mt) { int i = rb * 32 + mt * 16 + l15; if (i > 254) i = 254; tok[mt] = 16 * i; }
#pragma unroll 4
  for (int ks = 0; ks < 64; ++ks) {
    const int j = ks >> 1, d0 = (ks & 1) * 32;
    bf16x8 af[2], wf[2];
#pragma unroll
    for (int mt = 0; mt < 2; ++mt) af[mt] = ldfrag(projb + (size_t)(tok[mt] + j) * NP + d0 + 8 * g);
#pragma unroll
    for (int nt = 0; nt < 2; ++nt) wf[nt] = ldfrag(W1T + (size_t)(w * 32 + nt * 16 + l15) * 2048 + ks * 32 + 8 * g);
#pragma unroll
    for (int nt = 0; nt < 2; ++nt)
#pragma unroll
      for (int mt = 0; mt < 2; ++mt) acc[nt][mt] = mfma16(wf[nt], af[mt], acc[nt][mt]);
  }
  __syncthreads();
#pragma unroll
  for (int nt = 0; nt < 2; ++nt) {
    const int n = w * 32 + nt * 16 + 4 * g;
    const f32x4 bb = *(const f32x4*)(bias1 + n);
#pragma unroll
    for (int mt = 0; mt < 2; ++mt) {
      const f32x4 v = acc[nt][mt] + bb;
      u32x2 o; o.x = pack2(siluf(v[0]), siluf(v[1])); o.y = pack2(siluf(v[2]), siluf(v[3]));
      *(u32x2*)(Hs + (mt * 16 + l15) * HLD + n) = o;
    }
  }
  __syncthreads();
  f32x4 acc2[2] = {(f32x4){0.f, 0.f, 0.f, 0.f}, (f32x4){0.f, 0.f, 0.f, 0.f}};
#pragma unroll
  for (int ks = 0; ks < 4; ++ks) {
    const bf16x8 wf = ldfrag(W2T + (size_t)(w * 16 + l15) * 128 + ks * 32 + 8 * g);
#pragma unroll
    for (int mt = 0; mt < 2; ++mt) acc2[mt] = mfma16(wf, ldfrag(Hs + (mt * 16 + l15) * HLD + ks * 32 + 8 * g), acc2[mt]);
  }
  u16* dst = (u16*)(p.ws + (kv ? OFF_VCMP : OFF_KCMP)) + (size_t)b * 256 * 64;
#pragma unroll
  for (int mt = 0; mt < 2; ++mt) {
    const int i = rb * 32 + mt * 16 + l15;
    u32x2 o; o.x = pack2(acc2[mt][0], acc2[mt][1]); o.y = pack2(acc2[mt][2], acc2[mt][3]);
    if (i > 254) { o.x = 0u; o.y = 0u; }
    *(u32x2*)(dst + (size_t)i * 64 + w * 16 + 4 * g) = o;
  }
}

DI void nsa_task(const Params& p, int layer, int b, int qi, unsigned char* smem) {
  u16* Ks = (u16*)smem; u16* Vs = Ks + 64 * KLD;
  float* T = (float*)(smem + 2 * 64 * KLD * 2);
  unsigned long long* selm = (unsigned long long*)(smem + 2 * 64 * KLD * 2 + 4 * 32 * 65 * 4);
  const int tid = otid(), lane = tid & 63, h = tid >> 6, l15 = lane & 15, g = lane >> 4;
  const int q0 = qi * 32;
  const u16* projb = (const u16*)(p.ws + OFF_PROJ) + (size_t)b * SEQ * NP;
  const float* smb = (const float*)(p.ws + OFF_SMALL) + (size_t)b * SEQ * NSMALL;
  const u16* kcmp = (const u16*)(p.ws + OFF_KCMP) + (size_t)b * 256 * 64;
  const u16* vcmp = (const u16*)(p.ws + OFF_VCMP) + (size_t)b * 256 * 64;
  bf16x8 qf[2][2];
#pragma unroll
  for (int qt = 0; qt < 2; ++qt)
#pragma unroll
    for (int ks = 0; ks < 2; ++ks) qf[qt][ks] = ldfrag(projb + (size_t)(q0 + qt * 16 + l15) * NP + PA_Q + h * 64 + ks * 32 + 8 * g);
  const float sc = 0.125f * 1.4426950408889634f;
  f32x4 outacc[4][2];
  AttnAcc a;
  KVRegs kr;
  const int ntc = (q0 >> 10) + 1;
  attn_init(a);
  __syncthreads();
  for (int i = tid; i < 4 * 32 * 65; i += 256) T[i] = 0.f;
  for (int j = 0; j < ntc; ++j) {
    __syncthreads();
    kv_load(kcmp, vcmp, 64, 64, j * 64, kr); kv_store(Ks, Vs, kr);
    __syncthreads();
    f32x4 s[4][2];
    auto valid = [&](int kt, int r, int qt) { return 16 * (j * 64 + kt * 16 + 4 * g + r) + 31 <= q0 + qt * 16 + l15; };
    qk_tile<2>(Ks, 0, qf, s, l15, g);
    softmax_pv(s, a, Vs, sc, l15, g, valid);
  }
  float cinv[2];
#pragma unroll
  for (int qt = 0; qt < 2; ++qt) {
    const float lt = group_sum4(a.l[qt]);
    cinv[qt] = lt > 0.f ? 1.f / lt : 0.f;
    const float gt = sigmoidf_(smb[(size_t)(q0 + qt * 16 + l15) * NSMALL + SM_G + h * 3 + 0]) * cinv[qt];
#pragma unroll
    for (int d = 0; d < 4; ++d) outacc[d][qt] = a.o[d][qt] * gt;
  }
  float carry[2] = {0.f, 0.f};
  for (int j = 0; j < ntc; ++j) {
    __syncthreads();
    kv_load(kcmp, vcmp, 64, 64, j * 64, kr); kv_store(Ks, Vs, kr);
    __syncthreads();
    f32x4 s[4][2];
    qk_tile<2>(Ks, 0, qf, s, l15, g);
#pragma unroll
    for (int qt = 0; qt < 2; ++qt) {
      float prev3 = carry[qt];
#pragma unroll
      for (int kt = 0; kt < 4; ++kt) {
        float pr[4];
#pragma unroll
        for (int r = 0; r < 4; ++r) {
          const bool ok = 16 * (j * 64 + kt * 16 + 4 * g + r) + 31 <= q0 + qt * 16 + l15;
          pr[r] = ok ? exp2_(s[kt][qt][r] * sc - a.m[qt]) * cinv[qt] : 0.f;
        }
        const float below = __shfl_up(pr[3], 16);
        const float wrap = __shfl(prev3, l15 + 48);
        const float nb = g > 0 ? below : wrap;
        T[(h * 32 + qt * 16 + l15) * 65 + j * 16 + kt * 4 + g] = (pr[0] + pr[1]) + (pr[2] + 0.5f * pr[3]) + 0.5f * nb;
        prev3 = pr[3];
      }
      carry[qt] = prev3;
    }
  }
  __syncthreads();
#pragma unroll 1
  for (int qq = 0; qq < 8; ++qq) {
    const int q = h * 8 + qq, t = q0 + q, cur = t >> 6;
    const float imp = ((T[(0 * 32 + q) * 65 + lane] + T[(1 * 32 + q) * 65 + lane]) + T[(2 * 32 + q) * 65 + lane]) + T[(3 * 32 + q) * 65 + lane];
    const float val = (lane == cur || lane == 0) ? 1e4f : (lane <= cur ? imp : -1.f);
    int rank = 0;
#pragma unroll
    for (int k = 0; k < 64; ++k) {
      const float vk = __int_as_float(__builtin_amdgcn_readlane(__float_as_int(val), k));
      rank += (vk > val || (vk == val && k < lane)) ? 1 : 0;
    }
    const unsigned long long m = __ballot(rank < 16);
    if (lane == 0) selm[q] = m;
  }
  __syncthreads();
  unsigned long long mq[2], anym = 0ull;
#pragma unroll
  for (int qt = 0; qt < 2; ++qt) mq[qt] = selm[qt * 16 + l15];
  for (int i = 0; i < 32; ++i) anym |= selm[i];
  const int jhi = (q0 + 31) >> 6;
  attn_init(a);
  for (int j = 0; j <= jhi; ++j) {
    if (!((anym >> j) & 1ull)) continue;
    __syncthreads();
    kv_load(projb + PA_KS, projb + PA_VS, NP, NP, j * 64, kr); kv_store(Ks, Vs, kr);
    __syncthreads();
    f32x4 s[4][2];
    auto valid = [&](int kt, int r, int qt) { return ((mq[qt] >> j) & 1ull) && (j * 64 + kt * 16 + 4 * g + r <= q0 + qt * 16 + l15); };
    qk_tile<2>(Ks, 0, qf, s, l15, g);
    softmax_pv(s, a, Vs, sc, l15, g, valid);
  }
#pragma unroll
  for (int qt = 0; qt < 2; ++qt) {
    const float lt = group_sum4(a.l[qt]);
    const float gt = sigmoidf_(smb[(size_t)(q0 + qt * 16 + l15) * NSMALL + SM_G + h * 3 + 1]) * (lt > 0.f ? 1.f / lt : 0.f);
#pragma unroll
    for (int d = 0; d < 4; ++d) outacc[d][qt] += a.o[d][qt] * gt;
  }
  attn_init(a);
  const int jlo = q0 >= 511 ? (q0 - 511) >> 6 : 0;
  for (int j = jlo; j <= jhi; ++j) {
    __syncthreads();
    kv_load(projb + PA_KW, projb + PA_VW, NP, NP, j * 64, kr); kv_store(Ks, Vs, kr);
    __syncthreads();
    f32x4 s[4][2];
    auto valid = [&](int kt, int r, int qt) { const int key = j * 64 + kt * 16 + 4 * g + r, t = q0 + qt * 16 + l15; return key <= t && key + 512 > t; };
    qk_tile<2>(Ks, 0, qf, s, l15, g);
    softmax_pv(s, a, Vs, sc, l15, g, valid);
  }
  u16* Y = (u16*)(p.ws + OFF_H);
  const float* ng = p.nsa_norm_g + layer * 64;
#pragma unroll
  for (int qt = 0; qt < 2; ++qt) {
    const int t = q0 + qt * 16 + l15;
    const float lt = group_sum4(a.l[qt]);
    const float gt = sigmoidf_(smb[(size_t)t * NSMALL + SM_G + h * 3 + 2]) * (lt > 0.f ? 1.f / lt : 0.f);
    f32x4 v[4]; float ss = 0.f;
#pragma unroll
    for (int d = 0; d < 4; ++d) { v[d] = outacc[d][qt] + a.o[d][qt] * gt; ss += v[d][0] * v[d][0] + v[d][1] * v[d][1] + v[d][2] * v[d][2] + v[d][3] * v[d][3]; }
    ss = group_sum4(ss);
    const float rn = rsqrtf(ss * (1.f / 64.f) + 1e-6f);
    const size_t row = (size_t)b * SEQ + t;
#pragma unroll
    for (int d = 0; d < 4; ++d) {
      const int dd = d * 16 + 4 * g;
      const u32x2 zz = *(const u32x2*)(projb + (size_t)t * NP + PA_Z + h * 64 + dd);
      const f32x4 gg = *(const f32x4*)(ng + dd);
      u32x2 o;
      o.x = pack2(v[d][0] * rn * gg[0] * siluf(bflo(zz.x)), v[d][1] * rn * gg[1] * siluf(bfhi(zz.x)));
      o.y = pack2(v[d][2] * rn * gg[2] * siluf(bflo(zz.y)), v[d][3] * rn * gg[3] * siluf(bfhi(zz.y)));
      *(u32x2*)(Y + row * 1024 + Y_A + h * 64 + dd) = o;
    }
  }
}

DI void zero_y_cols(const Params& p, int c0, int ncols, int gtid, int gthreads) {
  u16* Y = (u16*)(p.ws + OFF_H);
  const int per_row = ncols / 8;
  for (size_t i = gtid; i < (size_t)NTOK * per_row; i += gthreads) {
    const size_t row = i / per_row; const int ch = (int)(i % per_row);
    *(u32x4*)(Y + row * 1024 + c0 + ch * 8) = (u32x4){0u, 0u, 0u, 0u};
  }
}

DI void final_norm_rows(const Params& p, int gw, int nw, int lane) {
  for (int row = gw; row < NTOK; row += nw) {
    float4* xr = (float4*)(p.out + (size_t)row * D_MODEL);
    float4 v[4]; float ss = 0.f;
#pragma unroll
    for (int i = 0; i < 4; ++i) { v[i] = xr[lane + 64 * i]; ss += v[i].x * v[i].x + v[i].y * v[i].y + v[i].z * v[i].z + v[i].w * v[i].w; }
    ss = wave_sum(ss);
    const float r = rsqrtf(ss * (1.f / D_MODEL) + 1e-6f);
    const float4* gp = (const float4*)p.final_g;
#pragma unroll
    for (int i = 0; i < 4; ++i) { const float4 gg = gp[lane + 64 * i]; float4 w; w.x = v[i].x * r * gg.x; w.y = v[i].y * r * gg.y; w.z = v[i].z * r * gg.z; w.w = v[i].w * r * gg.w; xr[lane + 64 * i] = w; }
  }
}

#ifndef DEBUG_CHECK
#define DEBUG_CHECK 0
#endif
#if DEBUG_CHECK
constexpr int NCHK = 12;
DI float block_sum(float v, float* red) {
  v = wave_sum(v);
  __syncthreads();
  if ((threadIdx.x & 63) == 0) red[threadIdx.x >> 6] = v;
  __syncthreads();
  return red[0] + red[1] + red[2] + red[3];
}
DI float block_max(float v, float* red) {
#pragma unroll
  for (int o = 32; o > 0; o >>= 1) v = fmaxf(v, __shfl_xor(v, o));
  __syncthreads();
  if ((threadIdx.x & 63) == 0) red[threadIdx.x >> 6] = v;
  __syncthreads();
  return fmaxf(fmaxf(red[0], red[1]), fmaxf(red[2], red[3]));
}
DI float bfr(float v) { return bf2f(f2bf(v)); }
struct Chk { float num[NCHK], den[NCHK]; };
DI void chk_add(Chk& c, int id, float got, float ref) { const float d = got - ref; c.num[id] += d * d; c.den[id] += ref * ref; }

DI void dbg_diff_attn(const Params& p, int layer, int b, int t, int h, Chk& c, int id, unsigned char* smem) {
  float* p1 = (float*)smem; float* p2 = p1 + 4096; float* red = p2 + 4096;
  const int tid = otid();
  const u16* proj = (const u16*)(p.ws + OFF_PROJ) + (size_t)b * SEQ * NP;
  const u16* q = proj + (size_t)t * NP + PB_Q + h * 64;
  const float scale = 0.17677669529663687f;
  float m1 = -1e30f, m2 = -1e30f;
  for (int s = tid; s <= t; s += 256) {
    const u16* k = proj + (size_t)s * NP + PB_K + h * 64;
    float a1 = 0.f, a2 = 0.f;
    for (int d = 0; d < 32; ++d) { a1 += bf2f(q[d]) * bf2f(k[d]); a2 += bf2f(q[32 + d]) * bf2f(k[32 + d]); }
    a1 *= scale; a2 *= scale; p1[s] = a1; p2[s] = a2; m1 = fmaxf(m1, a1); m2 = fmaxf(m2, a2);
  }
  m1 = block_max(m1, red); m2 = block_max(m2, red);
  float l1 = 0.f, l2 = 0.f;
  for (int s = tid; s <= t; s += 256) { const float e1 = __expf(p1[s] - m1), e2 = __expf(p2[s] - m2); p1[s] = e1; p2[s] = e2; l1 += e1; l2 += e2; }
  l1 = block_sum(l1, red); l2 = block_sum(l2, red);
  const float* lam = p.diff_lam + layer * 128;
  float s01 = 0.f, s23 = 0.f;
  for (int i = 0; i < 32; ++i) { s01 += lam[i] * lam[32 + i]; s23 += lam[64 + i] * lam[96 + i]; }
  const float lam_init = 0.8f - 0.6f * expf(-0.3f * (float)layer);
  const float lam_full = expf(s01) - expf(s23) + lam_init;
  __syncthreads();
  float o = 0.f;
  if (tid < 64) for (int s = 0; s <= t; ++s) o += (p1[s] / l1 - lam_full * p2[s] / l2) * bf2f(proj[(size_t)s * NP + PB_V + h * 64 + tid]);
  float ss = block_sum(tid < 64 ? o * o : 0.f, red);
  if (tid < 64) {
    const float z = bf2f(proj[(size_t)t * NP + PB_Z + h * 64 + tid]);
    const float ref = o * rsqrtf(ss / 64.f + 1e-6f) * p.diff_norm_g[layer * 64 + tid] * (1.f - lam_init) * (z / (1.f + expf(-z)));
    const float got = bf2f(((const u16*)(p.ws + OFF_H))[((size_t)b * SEQ + t) * 1024 + Y_B + h * 64 + tid]);
    const float d = got - ref;
    o = d * d; ss = ref * ref;
  } else { o = 0.f; ss = 0.f; }
  c.num[id] += block_sum(o, red); c.den[id] += block_sum(ss, red);
}

DI float dbg_conv(const u16* projb, int t, int pcol, const float* cw, const float* cb, int ch, int nch) {
  float a = cb[ch];
  for (int j = 0; j < 4; ++j) { const int tt = t - 3 + j; if (tt >= 0) a += cw[j * nch + ch] * bf2f(projb[(size_t)tt * NP + pcol]); }
  return a / (1.f + expf(-a));
}
constexpr int DBG_NS = 11, DBG_T = 300;
DI int dbg_sample_idx(int t) {
  const int TS[DBG_NS] = {0, 1, 2, 3, 64, 127, 128, 129, 255, 256, 299};
  for (int i = 0; i < DBG_NS; ++i) if (TS[i] == t) return i;
  return -1;
}
DI int dbg_sample_t(int i) { const int TS[DBG_NS] = {0, 1, 2, 3, 64, 127, 128, 129, 255, 256, 299}; return TS[i]; }
DI void dbg_ssd(const Params& p, int layer, int b, int gi, Chk& c, int id, unsigned char* smem) {
  float* ybuf = (float*)smem;
  float* red = ybuf + DBG_NS * 128;
  const int tid = threadIdx.x, pp = tid >> 2, nq = tid & 3;
  const u16* projb = (const u16*)(p.ws + OFF_PROJ) + (size_t)b * SEQ * NP;
  const float* smb = (const float*)(p.ws + OFF_SMALL) + (size_t)b * SEQ * NSMALL;
  const float* cw = p.ssm_conv_w + layer * 4 * 512; const float* cb = p.ssm_conv_b + layer * 512;
  __syncthreads();
  for (int hh = 0; hh < 2; ++hh) {
    const int h = gi * 2 + hh;
    const float a_h = -expf(p.ssm_a_log[layer * 4 + h]), d_h = p.ssm_d[layer * 4 + h], dtb = p.ssm_dt_bias[layer * 4 + h];
    float hst[16];
    for (int i = 0; i < 16; ++i) hst[i] = 0.f;
    for (int t = 0; t < DBG_T; ++t) {
      const float xr = smb[(size_t)t * NSMALL + SM_DT + h] + dtb;
      const float dt = xr > 20.f ? xr : log1pf(expf(xr));
      const float dA = expf(dt * a_h);
      const float xp = dbg_conv(projb, t, PC_XBC + h * 64 + pp, cw, cb, h * 64 + pp, 512);
      float y = 0.f;
      for (int i = 0; i < 16; ++i) {
        const int n = nq * 16 + i;
        const float Bn = dbg_conv(projb, t, PC_XBC + 256 + gi * 64 + n, cw, cb, 256 + gi * 64 + n, 512);
        const float Cn = dbg_conv(projb, t, PC_XBC + 384 + gi * 64 + n, cw, cb, 384 + gi * 64 + n, 512);
        hst[i] = dA * hst[i] + dt * xp * Bn;
        y += Cn * hst[i];
      }
      y += __shfl_xor(y, 1); y += __shfl_xor(y, 2);
      y += d_h * xp;
      const int si = dbg_sample_idx(t);
      if (si >= 0 && nq == 0) { const float z = bf2f(projb[(size_t)t * NP + PC_Z + h * 64 + pp]); ybuf[si * 128 + hh * 64 + pp] = y * (z / (1.f + expf(-z))); }
    }
  }
  __syncthreads();
  for (int si = 0; si < DBG_NS; ++si) {
    const float v = tid < 128 ? ybuf[si * 128 + tid] : 0.f;
    const float ss = block_sum(v * v, red);
    float e2 = 0.f, r2 = 0.f;
    if (tid < 128) {
      const float ref = v * rsqrtf(ss / 128.f + 1e-6f) * p.ssm_norm_g[layer * 256 + gi * 128 + tid];
      const float got = bf2f(((const u16*)(p.ws + OFF_H))[((size_t)b * SEQ + dbg_sample_t(si)) * 1024 + Y_C + gi * 128 + tid]);
      e2 = (got - ref) * (got - ref); r2 = ref * ref;
    }
    c.num[id] += block_sum(e2, red); c.den[id] += block_sum(r2, red);
  }
}
DI void dbg_mlstm(const Params& p, int layer, int b, int h, Chk& c, int id, unsigned char* smem) {
  float* ybuf = (float*)smem;
  float* red = ybuf + DBG_NS * 128;
  const int tid = threadIdx.x, dd = tid >> 2, eq = tid & 3;
  const u16* projb = (const u16*)(p.ws + OFF_PROJ) + (size_t)b * SEQ * NP;
  const float* smb = (const float*)(p.ws + OFF_SMALL) + (size_t)b * SEQ * NSMALL;
  const float* cw = p.ml_conv_w + layer * 4 * 512; const float* cb = p.ml_conv_b + layer * 512;
  const float ib = p.ml_if_b[layer * 8 + h], fb = p.ml_if_b[layer * 8 + 4 + h];
  __syncthreads();
  float Cst[16], nst[16];
  for (int i = 0; i < 16; ++i) { Cst[i] = 0.f; nst[i] = 0.f; }
  float m = 0.f;
  for (int t = 0; t < DBG_T; ++t) {
    const float ip = smb[(size_t)t * NSMALL + SM_IF + h] + ib, fp = smb[(size_t)t * NSMALL + SM_IF + 4 + h] + fb;
    const float lf = fminf(fp, 0.f) - log1pf(expf(-fabsf(fp)));
    const float mn = fmaxf(lf + m, ip), fs = expf(lf + m - mn), is = expf(ip - mn);
    const float vd = bf2f(projb[(size_t)t * NP + PD_V + h * 64 + dd]);
    float num = 0.f, den = 0.f;
    for (int i = 0; i < 16; ++i) {
      const int e = eq * 16 + i;
      const float qe = dbg_conv(projb, t, PD_QK + h * 64 + e, cw, cb, h * 64 + e, 512);
      const float ke = 0.125f * dbg_conv(projb, t, PD_QK + 256 + h * 64 + e, cw, cb, 256 + h * 64 + e, 512);
      Cst[i] = fs * Cst[i] + is * vd * ke; nst[i] = fs * nst[i] + is * ke;
      num += Cst[i] * qe; den += nst[i] * qe;
    }
    num += __shfl_xor(num, 1); num += __shfl_xor(num, 2); den += __shfl_xor(den, 1); den += __shfl_xor(den, 2);
    const float hv = num / fmaxf(fabsf(den), expf(-mn));
    m = mn;
    const int si = dbg_sample_idx(t);
    if (si >= 0 && eq == 0) { const float o = bf2f(projb[(size_t)t * NP + PD_O + h * 64 + dd]); ybuf[si * 64 + dd] = hv / (1.f + expf(-o)); }
  }
  __syncthreads();
  for (int si = 0; si < DBG_NS; ++si) {
    const float v = tid < 64 ? ybuf[si * 64 + tid] : 0.f;
    const float ss = block_sum(v * v, red);
    float e2 = 0.f, r2 = 0.f;
    if (tid < 64) {
      const int t = dbg_sample_t(si);
      const float z = bf2f(projb[(size_t)t * NP + PD_Z + h * 64 + tid]);
      const float ref = v * rsqrtf(ss / 64.f + 1e-6f) * p.ml_norm_g[layer * 64 + tid] * (z / (1.f + expf(-z)));
      const float got = bf2f(((const u16*)(p.ws + OFF_H))[((size_t)b * SEQ + t) * 1024 + Y_D + h * 64 + tid]);
      e2 = (got - ref) * (got - ref); r2 = ref * ref;
    }
    c.num[id] += block_sum(e2, red); c.den[id] += block_sum(r2, red);
  }
}

DI void debug_checks(const Params& p, unsigned char* smem) {
  const int tid = otid();
  float* red = (float*)(smem + 36 * 1024);
  Chk c;
  for (int i = 0; i < NCHK; ++i) { c.num[i] = 0.f; c.den[i] = 0.f; }
  const float* adap = (const float*)(p.ws + OFF_ADAP);
  const u16* H = (const u16*)(p.ws + OFF_H);
  const u16* proj = (const u16*)(p.ws + OFF_PROJ);
  const float* sm = (const float*)(p.ws + OFF_SMALL);
#if DEBUG_CHECK == 1
  {
    const int bs[2] = {0, 5}; const int ns[4] = {3, 1024 + 77, 2048 + 500, 3071};
    for (int bi = 0; bi < 2; ++bi) for (int ni = 0; ni < 4; ++ni) {
      const int b = bs[bi], n = ns[ni];
      float a = 0.f;
      for (int k = tid; k < 1024; k += 256) { const float v = p.c[b * 1024 + k]; a += (v / (1.f + expf(-v))) * p.ada_w[(size_t)k * 3072 + n]; }
      const float ref = block_sum(a, red) + p.ada_b[n];
      float got = 0.f; for (int kc = 0; kc < 8; ++kc) got += adap[(((size_t)kc * 2 + 0) * 8 + b) * 3072 + n];
      chk_add(c, 1, got, ref);
    }
  }
  {
    const int ms[3] = {1, 9000, 32767};
    const int ns[14] = {0, 300, 700, 900, 1500, 2000, 2300, 2693, 3300, 3500, 3967, 3970, 3981, 3990};
    for (int mi = 0; mi < 3; ++mi) {
      const int m = ms[mi], b = m >> 12;
      float ss = 0.f;
      for (int k = tid; k < 1024; k += 256) { const float v = p.x[(size_t)m * 1024 + k]; ss += v * v; }
      ss = block_sum(ss, red);
      const float rstd = rsqrtf(ss / 1024.f + 1e-6f);
      for (int ni = 0; ni < 14; ++ni) {
        const int n = ns[ni], col = colmap(n);
        float a = 0.f, herr = 0.f, href = 0.f;
        for (int k = tid; k < 1024; k += 256) {
          float shf = 0.f, scl = 0.f;
          for (int kc = 0; kc < 8; ++kc) { const float* ap = adap + (((size_t)kc * 2 + 0) * 8 + b) * 3072; shf += ap[k]; scl += ap[1024 + k]; }
          const float hv = p.x[(size_t)m * 1024 + k] * rstd * p.norm_g[k] * (1.f + scl) + shf;
          const float hg = bf2f(H[(size_t)m * 1024 + k]);
          herr += (hg - hv) * (hg - hv); href += hv * hv;
          a += hv * p.w_in[(size_t)k * D_IN + col];
        }
        const float ref = block_sum(a, red);
        herr = block_sum(herr, red); href = block_sum(href, red);
        if (ni == 0 && DEBUG_STAGE == 1) { c.num[3] += herr; c.den[3] += href; }
        const float got = n < NP ? bf2f(proj[(size_t)m * NP + n]) : sm[(size_t)m * NSMALL + (n - NP)];
        chk_add(c, 2, got, ref);
      }
    }
  }
#endif
#if DEBUG_CHECK == 2
  dbg_diff_attn(p, 0, 0, 5, 0, c, 4, smem);
  dbg_diff_attn(p, 0, 1, 200, 3, c, 4, smem);
  dbg_diff_attn(p, 0, 3, 1500, 2, c, 4, smem);
  dbg_diff_attn(p, 0, 7, 4095, 1, c, 4, smem);
  {
    const int ms[3] = {2, 12345, 32766}; const int ns[3] = {0, 513, 1023};
    const u16* Y = (const u16*)(p.ws + OFF_H);
    for (int mi = 0; mi < 3; ++mi) for (int ni = 0; ni < 3; ++ni) {
      const int m = ms[mi], n = ns[ni], b = m >> 12;
      float a = 0.f;
      for (int k = tid; k < 1024; k += 256) a += bf2f(Y[(size_t)m * 1024 + k]) * p.w_out[(size_t)k * 1024 + n];
      a = block_sum(a, red);
      float gate = 0.f; for (int kc = 0; kc < 8; ++kc) gate += adap[(((size_t)kc * 2 + 0) * 8 + b) * 3072 + 2048 + n];
      chk_add(c, 5, p.out[(size_t)m * 1024 + n] - p.x[(size_t)m * 1024 + n], gate * a);
    }
  }
#endif
#if DEBUG_CHECK == 3
  dbg_ssd(p, 0, 0, 0, c, 6, smem);
  dbg_ssd(p, 0, 5, 1, c, 6, smem);
  dbg_mlstm(p, 0, 0, 0, c, 7, smem);
  dbg_mlstm(p, 0, 6, 3, c, 7, smem);
#endif
  __syncthreads();
  if (tid == 0) {
    int wid_ = 0, wcls = 99;
    for (int i = 1; i < NCHK; ++i) if (c.den[i] > 0.f) {
      const float rel = sqrtf(c.num[i] / c.den[i]);
      int cls = rel >= 1.f ? 0 : (int)floorf(-log10f(fmaxf(rel, 1e-9f)));
      if (cls > 9) cls = 9;
      if (!(rel == rel)) cls = 0;
      if (cls < wcls) { wcls = cls; wid_ = i; }
    }
    p.out[0] = 1e5f * ((float)wid_ + 0.1f * (float)wcls);
  }
}
#endif

constexpr int SMEM_BYTES = 76 * 1024;
__global__ void __launch_bounds__(256, 2) fwd_megakernel(Params p) {
  cg::grid_group grid = cg::this_grid();
  __shared__ __attribute__((aligned(16))) unsigned char smem[SMEM_BYTES];
  const int tid = otid(), lane = tid & 63, wid = tid >> 6;
  const int G = gridDim.x, bid = blockIdx.x;
  for (int rep = 0; rep < REP_P0; ++rep) {
  for (int t = bid; t < T0_TOTAL; t += G) phase0_task(p, t, smem);
  grid.sync(); }
  for (int layer = 0; layer < 2; ++layer) {
    const float* xin = layer == 0 ? p.x : p.out;
    for (int rep = 0; rep < REP_P1; ++rep) {
    for (int t = bid; t < NTOK / 64; t += G) phase1_task(p, layer, xin, t, smem);
    grid.sync(); }
    for (int rep = 0; rep < REP_P2; ++rep) {
    for (int t = bid; t < 256 * 32; t += G) gemm_inproj_tile(p, layer, t, smem);
    grid.sync(); }
#if DEBUG_CHECK == 1
    if (bid == 0) debug_checks(p, smem);
    return;
#endif
    {
      for (int rep = 0; rep < REP_SEQ; ++rep) {
        if (bid < 32) ssd_task(p, layer, bid >> 2, bid & 3, smem);
        else if (bid < 64) mlstm_task(p, layer, (bid - 32) >> 2, (bid - 32) & 3, smem);
      }
      if (bid >= 64)
        for (int rep = 0; rep < REP_DIFF; ++rep)
          for (int u = bid - 64; u < 1024 + 128; u += G - 64) {
            if (u < 1024) { const int qb = 31 - (u >> 5), bh = u & 31; diff_attn_task(p, layer, bh >> 2, bh & 3, qb, smem); }
            else { const int v = u - 1024; compress_task(p, layer, v >> 4, (v >> 3) & 1, v & 7, smem); }
          }
    }
    grid.sync();
    for (int t = bid; t < NTOK / 64; t += G) ssd_norm_fix(p, layer, t * 64, 64);
    for (int rep = 0; rep < REP_NSA; ++rep) {
    for (int u = bid; u < 1024; u += G) nsa_task(p, layer, u & 7, 127 - (u >> 3), smem);
    grid.sync(); }
    for (int rep = 0; rep < (layer == 0 ? REP_P4 : 1); ++rep) {
    for (int t = bid; t < 256 * 8; t += G) gemm_outproj_tile(p, layer, xin, p.out, t, smem);
    grid.sync(); }
#if DEBUG_CHECK >= 2
    if (bid == 0) debug_checks(p, smem);
    return;
#endif
  }
  final_norm_rows(p, bid * 4 + wid, G * 4, lane);
}

extern "C" void kernel_launch(void* const* d_in, const int* in_sizes, int n_in, void* d_out, int out_size, void* d_ws, size_t ws_size,
                              hipStream_t stream) {
  static int grid_blocks = 0;
  if (!grid_blocks) {
    int dev = 0, cus = 0, per_cu = 0;
    (void)hipGetDevice(&dev);
    (void)hipDeviceGetAttribute(&cus, hipDeviceAttributeMultiprocessorCount, dev);
    (void)hipOccupancyMaxActiveBlocksPerMultiprocessor(&per_cu, fwd_megakernel, 256, 0);
    if (per_cu > 2) per_cu = 2;
    if (per_cu < 1) per_cu = 1;
    grid_blocks = cus * per_cu;
  }
  if (grid_blocks < 128) { fprintf(stderr, "grid too small: %d\n", grid_blocks); return; }
  if (ws_size < WS_NEEDED) { fprintf(stderr, "workspace too small: %zu < %zu\n", ws_size, WS_NEEDED); return; }
  Params p{};
  const float** pp = (const float**)&p;
  for (int i = 0; i < 26; ++i) pp[i] = (const float*)d_in[i];
  p.out = (float*)d_out; p.ws = (unsigned char*)d_ws;
  void* args[] = {&p};
  hipError_t e = hipLaunchCooperativeKernel((void*)fwd_megakernel, dim3(grid_blocks), dim3(256), args, 0, stream);
  if (e != hipSuccess) fprintf(stderr, "cooperative launch failed: %s (grid %d)\n", hipGetErrorString(e), grid_blocks);
}
```

```cpp
#include <hip/hip_runtime.h>
#include <hip/hip_cooperative_groups.h>
#include <cstdio>
#include <cstdint>
#define DEBUG_CHECK 0
#define DEBUG_STAGE 1
#define REP_P1 1
#define REP_P2 1
#define REP_SEQ 1
#define REP_DIFF 1
#define REP_NSA 1
#define REP_P4 1
#define REP_P0 1
namespace cg = cooperative_groups;

typedef unsigned short u16;
typedef short bf16x8 __attribute__((ext_vector_type(8)));
typedef short s16x4 __attribute__((ext_vector_type(4)));
typedef float f32x4 __attribute__((ext_vector_type(4)));
typedef float f32x2 __attribute__((ext_vector_type(2)));
typedef unsigned u32x4 __attribute__((ext_vector_type(4)));
typedef unsigned u32x2 __attribute__((ext_vector_type(2)));
typedef __bf16 bf16x2_t __attribute__((ext_vector_type(2)));
#define DI __device__ __forceinline__
#define LDSP __attribute__((address_space(3)))

constexpr int D_MODEL = 1024, BATCH = 8, SEQ = 4096, NTOK = BATCH * SEQ;
constexpr int D_IN = 3992;
constexpr int NP = 3968, NPAD = 4096, NSMALL = 32;
constexpr int PA_Q = 0, PA_KC = 256, PA_VC = 320, PA_KS = 384, PA_VS = 448, PA_KW = 512, PA_VW = 576, PA_Z = 640;
constexpr int PB_Q = 896, PB_K = 1152, PB_V = 1408, PB_Z = 1664;
constexpr int PC_Z = 1920, PC_XBC = 2176;
constexpr int PD_QK = 2688, PD_V = 3200, PD_O = 3456, PD_Z = 3712;
constexpr int SM_G = 0, SM_DT = 12, SM_IF = 16;
constexpr int Y_A = 0, Y_B = 256, Y_C = 512, Y_D = 768;

constexpr size_t MiB = 1024 * 1024;
constexpr size_t OFF_WINT = 0;
constexpr size_t OFF_WOUTT = 16 * MiB;
constexpr size_t OFF_W1T = 20 * MiB;
constexpr size_t OFF_W2T = 22 * MiB;
constexpr size_t OFF_BIAS1 = 22 * MiB + 64 * 1024;
constexpr size_t OFF_ADAP = 22 * MiB + 128 * 1024;
constexpr size_t OFF_KCMP = 24 * MiB;
constexpr size_t OFF_VCMP = 24 * MiB + 256 * 1024;
constexpr size_t OFF_CNT = 24 * MiB + 512 * 1024;
constexpr size_t OFF_SMALL = 25 * MiB;
constexpr size_t OFF_SSQ = 29 * MiB;
constexpr size_t OFF_H = 32 * MiB;
constexpr size_t OFF_PROJ = 96 * MiB;
constexpr size_t WS_NEEDED = 96 * MiB + (size_t)NTOK * NP * 2;

struct Params {
  const float* x; const float* c; const float* norm_g; const float* ada_w; const float* ada_b;
  const float* w_in; const float* w_out;
  const float* nsa_cmp_pos; const float* nsa_ck_w1; const float* nsa_ck_w2; const float* nsa_cv_w1; const float* nsa_cv_w2; const float* nsa_norm_g;
  const float* diff_lam; const float* diff_norm_g;
  const float* ssm_conv_w; const float* ssm_conv_b; const float* ssm_dt_bias; const float* ssm_a_log; const float* ssm_d; const float* ssm_norm_g;
  const float* ml_conv_w; const float* ml_conv_b; const float* ml_if_b; const float* ml_norm_g; const float* final_g;
  float* out; unsigned char* ws;
};

DI void lds_barrier() { asm volatile("s_waitcnt lgkmcnt(0)" ::: "memory"); __builtin_amdgcn_s_barrier(); asm volatile("" ::: "memory"); }
DI int otid() { int t = threadIdx.x; asm volatile("" : "+v"(t)); return t; }
DI unsigned pack2(float a, float b) { f32x2 v = {a, b}; bf16x2_t r = __builtin_convertvector(v, bf16x2_t); return __builtin_bit_cast(unsigned, r); }
DI u16 f2bf(float a) { return (u16)(pack2(a, 0.f) & 0xffffu); }
DI float bf2f(u16 h) { return __uint_as_float(((unsigned)h) << 16); }
DI float bflo(unsigned u) { return __uint_as_float(u << 16); }
DI float bfhi(unsigned u) { return __uint_as_float(u & 0xffff0000u); }
DI f32x4 mfma16(bf16x8 a, bf16x8 b, f32x4 c) { return __builtin_amdgcn_mfma_f32_16x16x32_bf16(a, b, c, 0, 0, 0); }
DI float wave_sum(float v) {
#pragma unroll
  for (int o = 32; o > 0; o >>= 1) v += __shfl_xor(v, o);
  return v;
}
DI float siluf(float v) { return v * __builtin_amdgcn_rcpf(1.f + __expf(-v)); }
DI float sigmoidf_(float v) { return __builtin_amdgcn_rcpf(1.f + __expf(-v)); }
DI float exp2_(float v) { return __builtin_amdgcn_exp2f(v); }
DI s16x4 tr_read(const u16* p) { return __builtin_amdgcn_ds_read_tr16_b64_v4i16((LDSP s16x4*)p); }
DI bf16x8 cat4(s16x4 a, s16x4 b) { bf16x8 r; r[0] = a[0]; r[1] = a[1]; r[2] = a[2]; r[3] = a[3]; r[4] = b[0]; r[5] = b[1]; r[6] = b[2]; r[7] = b[3]; return r; }
DI bf16x8 ldfrag(const u16* p) { return *(const bf16x8*)p; }

DI int colmap(int n) {
  if (n < 640) return n;
  if (n < 896) return 652 + (n - 640);
  if (n < 1920) return 908 + (n - 896);
  if (n < 2688) return 1932 + (n - 1920);
  if (n < 3456) return 2704 + (n - 2688);
  if (n < 3968) return 3480 + (n - 3456);
  if (n < 3980) return 640 + (n - 3968);
  if (n < 3984) return 2700 + (n - 3980);
  if (n < 3992) return 3472 + (n - 3984);
  return -1;
}

DI void tconv_tile(const float* __restrict__ src, int ldsrc, int k0, int n0, u16* __restrict__ dst, int ldd, bool use_map, unsigned char* smem) {
  float* tile = (float*)smem;
  const int tid = otid();
  lds_barrier();
  {
    const int nn = tid & 63; int col = n0 + nn; if (use_map) col = colmap(col);
#pragma unroll
    for (int i = 0; i < 16; ++i) { const int kk = i * 4 + (tid >> 6); tile[kk * 65 + nn] = col >= 0 ? src[(size_t)(k0 + kk) * ldsrc + col] : 0.f; }
  }
  lds_barrier();
#pragma unroll
  for (int i = 0; i < 2; ++i) {
    const int item = tid + 256 * i, nn = item >> 3, kc = item & 7;
    u32x4 w;
    w.x = pack2(tile[(kc * 8 + 0) * 65 + nn], tile[(kc * 8 + 1) * 65 + nn]);
    w.y = pack2(tile[(kc * 8 + 2) * 65 + nn], tile[(kc * 8 + 3) * 65 + nn]);
    w.z = pack2(tile[(kc * 8 + 4) * 65 + nn], tile[(kc * 8 + 5) * 65 + nn]);
    w.w = pack2(tile[(kc * 8 + 6) * 65 + nn], tile[(kc * 8 + 7) * 65 + nn]);
    *(u32x4*)(dst + (size_t)(n0 + nn) * ldd + k0 + kc * 8) = w;
  }
}

constexpr int T0_WIN = 2 * 16 * 64, T0_WOUT = 2 * 16 * 16, T0_W1 = 4 * 32 * 2, T0_W2 = 4 * 2, T0_ADA = 2 * 12 * 8, T0_B1 = 64;
constexpr int T0_TOTAL = T0_WIN + T0_WOUT + T0_W1 + T0_W2 + T0_ADA + T0_B1;

DI void phase0_task(const Params& p, int t, unsigned char* smem) {
  const int tid = otid();
  if (t < T0_WIN) {
    const int l = t / 1024, r = t % 1024, kt = r / 64, nt = r % 64;
    tconv_tile(p.w_in + (size_t)l * D_MODEL * D_IN, D_IN, kt * 64, nt * 64, (u16*)(p.ws + OFF_WINT) + (size_t)l * NPAD * 1024, 1024, true, smem);
    return;
  }
  t -= T0_WIN;
  if (t < T0_WOUT) {
    const int l = t / 256, r = t % 256, kt = r / 16, nt = r % 16;
    tconv_tile(p.w_out + (size_t)l * 1024 * 1024, 1024, kt * 64, nt * 64, (u16*)(p.ws + OFF_WOUTT) + (size_t)l * 1024 * 1024, 1024, false, smem);
    return;
  }
  t -= T0_WOUT;
  if (t < T0_W1) {
    const int m = t / 64, r = t % 64, kt = r / 2, nt = r % 2, l = m >> 1, kv = m & 1;
    const float* src = (kv ? p.nsa_cv_w1 : p.nsa_ck_w1) + (size_t)l * 2048 * 128;
    tconv_tile(src, 128, kt * 64, nt * 64, (u16*)(p.ws + OFF_W1T) + (size_t)m * 128 * 2048, 2048, false, smem);
    return;
  }
  t -= T0_W1;
  if (t < T0_W2) {
    const int m = t / 2, kt = t % 2, l = m >> 1, kv = m & 1;
    const float* src = (kv ? p.nsa_cv_w2 : p.nsa_ck_w2) + (size_t)l * 128 * 64;
    tconv_tile(src, 64, kt * 64, 0, (u16*)(p.ws + OFF_W2T) + (size_t)m * 64 * 128, 128, false, smem);
    return;
  }
  t -= T0_W2;
  if (t < T0_ADA) {
    const int l = t / 96, r = t % 96, nc = r / 8, kc = r % 8;
    float* cact = (float*)smem;
    lds_barrier();
    for (int i = tid; i < 1024; i += 256) { const int b = i >> 7, kk = i & 127; const float v = p.c[b * 1024 + kc * 128 + kk]; cact[i] = siluf(v); }
    lds_barrier();
    const int n = nc * 256 + tid;
    float acc[8];
#pragma unroll
    for (int b = 0; b < 8; ++b) acc[b] = 0.f;
    const float* w = p.ada_w + ((size_t)l * 1024 + kc * 128) * 3072 + n;
#pragma unroll 16
    for (int kk = 0; kk < 128; ++kk) {
      const float wv = w[(size_t)kk * 3072];
#pragma unroll
      for (int b = 0; b < 8; ++b) acc[b] += cact[b * 128 + kk] * wv;
    }
    float* adap = (float*)(p.ws + OFF_ADAP);
    const float bias = kc == 0 ? p.ada_b[l * 3072 + n] : 0.f;
#pragma unroll
    for (int b = 0; b < 8; ++b) adap[(((size_t)kc * 2 + l) * 8 + b) * 3072 + n] = acc[b] + bias;
    return;
  }
  t -= T0_ADA;
  {
    const int m = t >> 4, kc = t & 15, l = m >> 1, kv = m & 1;
    const float* w1 = (kv ? p.nsa_cv_w1 : p.nsa_ck_w1) + (size_t)l * 2048 * 128;
    const float* pos = p.nsa_cmp_pos + (size_t)l * 2048;
    const int n = tid & 127, half = tid >> 7;
    float acc = 0.f;
    const int k0 = kc * 128 + half * 64;
#pragma unroll 16
    for (int k = 0; k < 64; ++k) acc += pos[k0 + k] * w1[(size_t)(k0 + k) * 128 + n];
    float* red = (float*)smem;
    lds_barrier();
    red[tid] = acc;
    lds_barrier();
    if (tid < 128) ((float*)(p.ws + OFF_BIAS1))[(m * 16 + kc) * 128 + tid] = red[tid] + red[tid + 128];
  }
}

DI void phase1_task(const Params& p, int layer, const float* xin, int grp, unsigned char* smem) {
  const int tid = otid(), lane = tid & 63, wid = tid >> 6;
  const int b = grp >> 6;
  float* mul = (float*)smem;
  float* sh = mul + 1024;
  const float* adap = (const float*)(p.ws + OFF_ADAP);
  lds_barrier();
  for (int c = tid; c < 1024; c += 256) {
    float s0 = 0.f, s1 = 0.f;
#pragma unroll
    for (int kc = 0; kc < 8; ++kc) { const float* a = adap + (((size_t)kc * 2 + layer) * 8 + b) * 3072; s0 += a[c]; s1 += a[1024 + c]; }
    mul[c] = p.norm_g[layer * 1024 + c] * (1.f + s1); sh[c] = s0;
  }
  lds_barrier();
  u16* H = (u16*)(p.ws + OFF_H);
#pragma unroll 1
  for (int it = 0; it < 4; ++it) {
    float4 v[4][4]; float ss[4];
#pragma unroll
    for (int j = 0; j < 4; ++j) {
      const int row = grp * 64 + wid * 16 + it * 4 + j;
      const float4* xr = (const float4*)(xin + (size_t)row * D_MODEL);
#pragma unroll
      for (int i = 0; i < 4; ++i) v[j][i] = xr[lane + 64 * i];
    }
#pragma unroll
    for (int j = 0; j < 4; ++j) {
      float a = 0.f;
#pragma unroll
      for (int i = 0; i < 4; ++i) a += v[j][i].x * v[j][i].x + v[j][i].y * v[j][i].y + v[j][i].z * v[j][i].z + v[j][i].w * v[j][i].w;
      ss[j] = wave_sum(a);
    }
#pragma unroll
    for (int j = 0; j < 4; ++j) {
      const int row = grp * 64 + wid * 16 + it * 4 + j;
      const float r = rsqrtf(ss[j] * (1.f / D_MODEL) + 1e-6f);
#pragma unroll
      for (int i = 0; i < 4; ++i) {
        const int c = (lane + 64 * i) * 4;
        u32x2 w;
        w.x = pack2(v[j][i].x * r * mul[c] + sh[c], v[j][i].y * r * mul[c + 1] + sh[c + 1]);
        w.y = pack2(v[j][i].z * r * mul[c + 2] + sh[c + 2], v[j][i].w * r * mul[c + 3] + sh[c + 3]);
        *(u32x2*)(H + (size_t)row * 1024 + c) = w;
      }
    }
  }
}

constexpr int GLD = 72;
DI void gemm_mainloop(const u16* __restrict__ A, int lda, const u16* __restrict__ Bt, int ldb, int K, int m0, int n0, unsigned char* smem, f32x4 (&acc)[4][4]) {
  u16* As = (u16*)smem; u16* Bs = As + 128 * GLD;
  const int tid = otid(), lane = tid & 63, wid = tid >> 6, wr = wid >> 1, wc = wid & 1, l15 = lane & 15, g = lane >> 4;
#pragma unroll
  for (int j = 0; j < 4; ++j)
#pragma unroll
    for (int i = 0; i < 4; ++i) acc[j][i] = (f32x4){0.f, 0.f, 0.f, 0.f};
  u32x4 ra[4], rb[4];
  const int lrow = tid >> 3, lch = tid & 7;
  const u16* ap = A + (size_t)(m0 + lrow) * lda + lch * 8;
  const u16* bp = Bt + (size_t)(n0 + lrow) * ldb + lch * 8;
#pragma unroll
  for (int i = 0; i < 4; ++i) { ra[i] = *(const u32x4*)(ap + (size_t)(32 * i) * lda); rb[i] = *(const u32x4*)(bp + (size_t)(32 * i) * ldb); }
  const int nk = K / 64;
  for (int kt = 0; kt < nk; ++kt) {
    lds_barrier();
#pragma unroll
    for (int i = 0; i < 4; ++i) { *(u32x4*)(As + (lrow + 32 * i) * GLD + lch * 8) = ra[i]; *(u32x4*)(Bs + (lrow + 32 * i) * GLD + lch * 8) = rb[i]; }
    lds_barrier();
    if (kt + 1 < nk) {
      const int k1 = (kt + 1) * 64;
#pragma unroll
      for (int i = 0; i < 4; ++i) { ra[i] = *(const u32x4*)(ap + (size_t)(32 * i) * lda + k1); rb[i] = *(const u32x4*)(bp + (size_t)(32 * i) * ldb + k1); }
    }
#pragma unroll
    for (int ks = 0; ks < 2; ++ks) {
      bf16x8 af[4], bfr[4];
#pragma unroll
      for (int i = 0; i < 4; ++i) af[i] = ldfrag(As + (wr * 64 + i * 16 + l15) * GLD + ks * 32 + 8 * g);
#pragma unroll
      for (int j = 0; j < 4; ++j) bfr[j] = ldfrag(Bs + (wc * 64 + j * 16 + l15) * GLD + ks * 32 + 8 * g);
#pragma unroll
      for (int j = 0; j < 4; ++j)
#pragma unroll
        for (int i = 0; i < 4; ++i) acc[j][i] = mfma16(bfr[j], af[i], acc[j][i]);
    }
  }
}

DI void gemm_inproj_tile(const Params& p, int layer, int tile, unsigned char* smem) {
  const int mt = tile >> 5, nt = tile & 31, m0 = mt * 128, n0 = nt * 128;
  const int tid = otid(), lane = tid & 63, wid = tid >> 6, wr = wid >> 1, wc = wid & 1, l15 = lane & 15, g = lane >> 4;
  f32x4 acc[4][4];
  gemm_mainloop((const u16*)(p.ws + OFF_H), 1024, (const u16*)(p.ws + OFF_WINT) + (size_t)layer * NPAD * 1024, 1024, 1024, m0, n0, smem, acc);
  if (nt == 31) {
    if (wc == 0) {
      float* sm = (float*)(p.ws + OFF_SMALL);
#pragma unroll
      for (int j = 0; j < 2; ++j)
#pragma unroll
        for (int i = 0; i < 4; ++i) {
          const int m = m0 + wr * 64 + i * 16 + l15, n = j * 16 + 4 * g;
          *(f32x4*)(sm + (size_t)m * NSMALL + n) = acc[j][i];
        }
    }
    return;
  }
  constexpr int CLD = 136;
  u16* Cs = (u16*)smem;
  lds_barrier();
#pragma unroll
  for (int j = 0; j < 4; ++j)
#pragma unroll
    for (int i = 0; i < 4; ++i) {
      const int ml = wr * 64 + i * 16 + l15, nl = wc * 64 + j * 16 + 4 * g;
      u32x2 w; w.x = pack2(acc[j][i][0], acc[j][i][1]); w.y = pack2(acc[j][i][2], acc[j][i][3]);
      *(u32x2*)(Cs + ml * CLD + nl) = w;
    }
  lds_barrier();
  u16* proj = (u16*)(p.ws + OFF_PROJ);
#pragma unroll
  for (int i = 0; i < 8; ++i) {
    const int id = tid + 256 * i, row = id >> 4, ch = id & 15;
    *(u32x4*)(proj + (size_t)(m0 + row) * NP + n0 + ch * 8) = *(const u32x4*)(Cs + row * CLD + ch * 8);
  }
}

DI void gemm_outproj_tile(const Params& p, int layer, const float* xin, float* xout, int tile, unsigned char* smem) {
  const int mt = tile >> 3, nt = tile & 7, m0 = mt * 128, n0 = nt * 128;
  const int tid = otid(), lane = tid & 63, wid = tid >> 6, wr = wid >> 1, wc = wid & 1, l15 = lane & 15, g = lane >> 4;
  f32x4 acc[4][4];
  gemm_mainloop((const u16*)(p.ws + OFF_H), 1024, (const u16*)(p.ws + OFF_WOUTT) + (size_t)layer * 1024 * 1024, 1024, 1024, m0, n0, smem, acc);
  const int b = m0 >> 12;
  const float* adap = (const float*)(p.ws + OFF_ADAP);
#pragma unroll
  for (int j = 0; j < 4; ++j) {
    const int n = n0 + wc * 64 + j * 16 + 4 * g;
    f32x4 gt = {0.f, 0.f, 0.f, 0.f};
#pragma unroll
    for (int kc = 0; kc < 8; ++kc) gt += *(const f32x4*)(adap + (((size_t)kc * 2 + layer) * 8 + b) * 3072 + 2048 + n);
#pragma unroll
    for (int i = 0; i < 4; ++i) {
      const int m = m0 + wr * 64 + i * 16 + l15;
      const f32x4 xv = *(const f32x4*)(xin + (size_t)m * 1024 + n);
      *(f32x4*)(xout + (size_t)m * 1024 + n) = xv + gt * acc[j][i];
    }
  }
}

constexpr int KLD = 72;
struct KVRegs { u32x4 k[2], v[2]; };
DI void kv_load(const u16* kbase, const u16* vbase, int ldk, int ldv, int key0, KVRegs& r) {
  const int tid = otid();
#pragma unroll
  for (int i = 0; i < 2; ++i) {
    const int id = tid + 256 * i, row = id >> 3, ch = id & 7;
    r.k[i] = *(const u32x4*)(kbase + (size_t)(key0 + row) * ldk + ch * 8);
    r.v[i] = *(const u32x4*)(vbase + (size_t)(key0 + row) * ldv + ch * 8);
  }
}
DI void kv_store(u16* Ks, u16* Vs, const KVRegs& r) {
  const int tid = otid();
#pragma unroll
  for (int i = 0; i < 2; ++i) {
    const int id = tid + 256 * i, row = id >> 3, ch = id & 7;
    *(u32x4*)(Ks + row * KLD + ch * 8) = r.k[i];
    *(u32x4*)(Vs + row * KLD + ch * 8) = r.v[i];
  }
}
struct AttnAcc { f32x4 o[4][2]; float m[2], l[2]; };
DI void attn_init(AttnAcc& a) {
#pragma unroll
  for (int d = 0; d < 4; ++d) { a.o[d][0] = (f32x4){0.f, 0.f, 0.f, 0.f}; a.o[d][1] = (f32x4){0.f, 0.f, 0.f, 0.f}; }
  a.m[0] = a.m[1] = -1e30f; a.l[0] = a.l[1] = 0.f;
}
template <int NKS>
DI void qk_tile(const u16* Ks, int dofs, const bf16x8 (&qf)[2][NKS], f32x4 (&s)[4][2], int l15, int g) {
#pragma unroll
  for (int kt = 0; kt < 4; ++kt) {
    s[kt][0] = (f32x4){0.f, 0.f, 0.f, 0.f}; s[kt][1] = (f32x4){0.f, 0.f, 0.f, 0.f};
#pragma unroll
    for (int ks = 0; ks < NKS; ++ks) {
      const bf16x8 a = ldfrag(Ks + (kt * 16 + l15) * KLD + dofs + ks * 32 + 8 * g);
      s[kt][0] = mfma16(a, qf[0][ks], s[kt][0]);
      s[kt][1] = mfma16(a, qf[1][ks], s[kt][1]);
    }
  }
}
DI void pv_accum(const bf16x8 (&pf)[2][2], const u16* Vs, f32x4 (&o)[4][2], int l15, int g) {
  const int tq = l15 >> 2, tp = l15 & 3;
#pragma unroll
  for (int kk = 0; kk < 2; ++kk)
#pragma unroll
    for (int d = 0; d < 4; ++d) {
      const bf16x8 vf = cat4(tr_read(Vs + (kk * 32 + 4 * g + tq) * KLD + d * 16 + 4 * tp), tr_read(Vs + (kk * 32 + 16 + 4 * g + tq) * KLD + d * 16 + 4 * tp));
      o[d][0] = mfma16(vf, pf[0][kk], o[d][0]);
      o[d][1] = mfma16(vf, pf[1][kk], o[d][1]);
    }
}
DI void pack_p(const f32x4 (&s)[4][2], bf16x8 (&pf)[2][2]) {
#pragma unroll
  for (int qt = 0; qt < 2; ++qt)
#pragma unroll
    for (int kk = 0; kk < 2; ++kk) {
      u32x4 w;
      w.x = pack2(s[2 * kk][qt][0], s[2 * kk][qt][1]); w.y = pack2(s[2 * kk][qt][2], s[2 * kk][qt][3]);
      w.z = pack2(s[2 * kk + 1][qt][0], s[2 * kk + 1][qt][1]); w.w = pack2(s[2 * kk + 1][qt][2], s[2 * kk + 1][qt][3]);
      pf[qt][kk] = __builtin_bit_cast(bf16x8, w);
    }
}
template <class VF>
DI void softmax_pv(f32x4 (&s)[4][2], AttnAcc& a, const u16* Vs, float sc, int l15, int g, VF valid) {
  bf16x8 pf[2][2];
#pragma unroll
  for (int qt = 0; qt < 2; ++qt) {
    float mx = -1e30f;
#pragma unroll
    for (int kt = 0; kt < 4; ++kt)
#pragma unroll
      for (int r = 0; r < 4; ++r) { const float v = valid(kt, r, qt) ? s[kt][qt][r] * sc : -1e30f; s[kt][qt][r] = v; mx = fmaxf(mx, v); }
    mx = fmaxf(mx, __shfl_xor(mx, 16)); mx = fmaxf(mx, __shfl_xor(mx, 32));
    const float mn = fmaxf(a.m[qt], mx), alpha = exp2_(a.m[qt] - mn);
    a.m[qt] = mn;
    float ls = 0.f;
#pragma unroll
    for (int kt = 0; kt < 4; ++kt)
#pragma unroll
      for (int r = 0; r < 4; ++r) { const float v = s[kt][qt][r]; const float pv = v > -1e29f ? exp2_(v - mn) : 0.f; s[kt][qt][r] = pv; ls += pv; }
    a.l[qt] = a.l[qt] * alpha + ls;
#pragma unroll
    for (int d = 0; d < 4; ++d) a.o[d][qt] *= alpha;
#pragma unroll
    for (int kk = 0; kk < 2; ++kk) {
      u32x4 w;
      w.x = pack2(s[2 * kk][qt][0], s[2 * kk][qt][1]); w.y = pack2(s[2 * kk][qt][2], s[2 * kk][qt][3]);
      w.z = pack2(s[2 * kk + 1][qt][0], s[2 * kk + 1][qt][1]); w.w = pack2(s[2 * kk + 1][qt][2], s[2 * kk + 1][qt][3]);
      pf[qt][kk] = __builtin_bit_cast(bf16x8, w);
    }
  }
  pv_accum(pf, Vs, a.o, l15, g);
}
DI float group_sum4(float v) { v += __shfl_xor(v, 16); v += __shfl_xor(v, 32); return v; }

DI void diff_attn_task(const Params& p, int layer, int b, int h, int qb, unsigned char* smem) {
  u16* Ks = (u16*)smem; u16* Vs = Ks + 64 * KLD;
  const int tid = otid(), lane = tid & 63, wid = tid >> 6, l15 = lane & 15, g = lane >> 4;
  const u16* proj = (const u16*)(p.ws + OFF_PROJ) + (size_t)b * SEQ * NP;
  const int q0w = qb * 128 + wid * 32;
  const float* lam = p.diff_lam + layer * 128;
  float s01 = 0.f, s23 = 0.f;
  for (int i = 0; i < 32; ++i) { s01 += lam[i] * lam[32 + i]; s23 += lam[64 + i] * lam[96 + i]; }
  const float lam_init = 0.8f - 0.6f * __expf(-0.3f * (float)layer);
  const float lam_full = __expf(s01) - __expf(s23) + lam_init;
  const float sc = 0.17677669529663687f * 1.4426950408889634f;
  const int ntile = 2 * qb + 2;
  const u16* vbase = proj + PB_V + h * 64;
  f32x4 res[4][2];
#pragma unroll 1
  for (int c = 0; c < 2; ++c) {
    const u16* kbase = proj + PB_K + h * 64 + c * 32;
    bf16x8 qf[2][1];
#pragma unroll
    for (int qt = 0; qt < 2; ++qt) qf[qt][0] = ldfrag(proj + (size_t)(q0w + qt * 16 + l15) * NP + PB_Q + h * 64 + c * 32 + 8 * g);
    AttnAcc a; attn_init(a);
    KVRegs kr; kv_load(kbase, vbase, NP, NP, 0, kr);
    for (int j = 0; j < ntile; ++j) {
      lds_barrier();
      kv_store(Ks, Vs, kr);
      lds_barrier();
      if (j + 1 < ntile) kv_load(kbase, vbase, NP, NP, (j + 1) * 64, kr);
      const int key0 = j * 64;
      if (key0 <= q0w + 31) {
        f32x4 s[4][2];
        auto valid = [&](int kt, int r, int qt) { return key0 + kt * 16 + 4 * g + r <= q0w + qt * 16 + l15; };
        qk_tile<1>(Ks, 0, qf, s, l15, g);
        softmax_pv(s, a, Vs, sc, l15, g, valid);
      }
    }
#pragma unroll
    for (int qt = 0; qt < 2; ++qt) {
      const float lt = group_sum4(a.l[qt]);
      const float inv = c == 0 ? 1.f / lt : -lam_full / lt;
#pragma unroll
      for (int d = 0; d < 4; ++d) res[d][qt] = c == 0 ? a.o[d][qt] * inv : res[d][qt] + a.o[d][qt] * inv;
    }
  }
  u16* Y = (u16*)(p.ws + OFF_H);
  const float* ng = p.diff_norm_g + layer * 64;
#pragma unroll
  for (int qt = 0; qt < 2; ++qt) {
    float ss = 0.f;
#pragma unroll
    for (int d = 0; d < 4; ++d) { const f32x4 v = res[d][qt]; ss += v[0] * v[0] + v[1] * v[1] + v[2] * v[2] + v[3] * v[3]; }
    ss = group_sum4(ss);
    const float rn = rsqrtf(ss * (1.f / 64.f) + 1e-6f) * (1.f - lam_init);
    const int t = q0w + qt * 16 + l15;
    const size_t row = (size_t)b * SEQ + t;
#pragma unroll
    for (int d = 0; d < 4; ++d) {
      const int dd = d * 16 + 4 * g;
      const f32x4 v = res[d][qt];
      const u32x2 zz = *(const u32x2*)(proj + (size_t)t * NP + PB_Z + h * 64 + dd);
      const f32x4 gg = *(const f32x4*)(ng + dd);
      u32x2 w;
      w.x = pack2(v[0] * rn * gg[0] * siluf(bflo(zz.x)), v[1] * rn * gg[1] * siluf(bfhi(zz.x)));
      w.y = pack2(v[2] * rn * gg[2] * siluf(bflo(zz.y)), v[3] * rn * gg[3] * siluf(bfhi(zz.y)));
      *(u32x2*)(Y + row * 1024 + Y_B + h * 64 + dd) = w;
    }
  }
}

template <int NKS>
DI void qk_tile1(const u16* Ks, const bf16x8 (&qf)[NKS], f32x4 (&s)[4], int l15, int g) {
#pragma unroll
  for (int kt = 0; kt < 4; ++kt) {
    s[kt] = (f32x4){0.f, 0.f, 0.f, 0.f};
#pragma unroll
    for (int ks = 0; ks < NKS; ++ks) s[kt] = mfma16(ldfrag(Ks + (kt * 16 + l15) * KLD + ks * 32 + 8 * g), qf[ks], s[kt]);
  }
}
DI void pv_accum1(const f32x4 (&s)[4], const u16* Vs, f32x4 (&o)[4], int l15, int g) {
  const int tq = l15 >> 2, tp = l15 & 3;
#pragma unroll
  for (int kk = 0; kk < 2; ++kk) {
    u32x4 w;
    w.x = pack2(s[2 * kk][0], s[2 * kk][1]); w.y = pack2(s[2 * kk][2], s[2 * kk][3]);
    w.z = pack2(s[2 * kk + 1][0], s[2 * kk + 1][1]); w.w = pack2(s[2 * kk + 1][2], s[2 * kk + 1][3]);
    const bf16x8 pf = __builtin_bit_cast(bf16x8, w);
#pragma unroll
    for (int d = 0; d < 4; ++d) {
      const bf16x8 vf = cat4(tr_read(Vs + (kk * 32 + 4 * g + tq) * KLD + d * 16 + 4 * tp), tr_read(Vs + (kk * 32 + 16 + 4 * g + tq) * KLD + d * 16 + 4 * tp));
      o[d] = mfma16(vf, pf, o[d]);
    }
  }
}
DI void conv_silu_stage(const u16* projb, int col0, const float* cw, const float* cb, int chan0, int nchan, int t0, u16* dst, const float* rowscale, float cscale) {
  const int tid = otid(), ch = (tid & 7) * 8;
  float w[4][8], bias[8];
#pragma unroll
  for (int j = 0; j < 4; ++j)
#pragma unroll
    for (int i = 0; i < 8; ++i) w[j][i] = cw[j * nchan + chan0 + ch + i];
#pragma unroll
  for (int i = 0; i < 8; ++i) bias[i] = cb[chan0 + ch + i];
#pragma unroll 1
  for (int ps = 0; ps < 4; ++ps) {
    const int row = ps * 32 + (tid >> 3), t = t0 + row;
    float acc[8];
#pragma unroll
    for (int i = 0; i < 8; ++i) acc[i] = bias[i];
#pragma unroll
    for (int j = 0; j < 4; ++j) {
      const int tt = t - 3 + j;
      if (tt >= 0) {
        const u32x4 v = *(const u32x4*)(projb + (size_t)tt * NP + col0 + ch);
        acc[0] += w[j][0] * bflo(v.x); acc[1] += w[j][1] * bfhi(v.x); acc[2] += w[j][2] * bflo(v.y); acc[3] += w[j][3] * bfhi(v.y);
        acc[4] += w[j][4] * bflo(v.z); acc[5] += w[j][5] * bfhi(v.z); acc[6] += w[j][6] * bflo(v.w); acc[7] += w[j][7] * bfhi(v.w);
      }
    }
    const float rs = (rowscale ? rowscale[row] : 1.f) * cscale;
#pragma unroll
    for (int i = 0; i < 8; ++i) acc[i] = siluf(acc[i]) * rs;
    u32x4 o; o.x = pack2(acc[0], acc[1]); o.y = pack2(acc[2], acc[3]); o.z = pack2(acc[4], acc[5]); o.w = pack2(acc[6], acc[7]);
    *(u32x4*)(dst + row * KLD + ch) = o;
  }
}
DI float block_scan128_add(float v, float* tmp) {
  const int tid = otid(), lane = tid & 63;
  float x = v;
#pragma unroll
  for (int o = 1; o < 64; o <<= 1) { const float y = __shfl_up(x, o); if (lane >= o) x += y; }
  lds_barrier();
  if (tid == 63) tmp[0] = x;
  lds_barrier();
  if ((tid >> 6) == 1) x += tmp[0];
  return x;
}
DI float block_scan128_max(float v, float* tmp) {
  const int tid = otid(), lane = tid & 63;
  float x = v;
#pragma unroll
  for (int o = 1; o < 64; o <<= 1) { const float y = __shfl_up(x, o); if (lane >= o) x = fmaxf(x, y); }
  lds_barrier();
  if (tid == 63) tmp[0] = x;
  lds_barrier();
  if ((tid >> 6) == 1) x = fmaxf(x, tmp[0]);
  return x;
}
DI void scale_rows(u16* A, const float* rs) {
  const int tid = otid(), ch = (tid & 7) * 8;
#pragma unroll
  for (int ps = 0; ps < 4; ++ps) {
    const int row = ps * 32 + (tid >> 3);
    const float f = rs[row];
    u32x4 v = *(u32x4*)(A + row * KLD + ch);
    v.x = pack2(bflo(v.x) * f, bfhi(v.x) * f); v.y = pack2(bflo(v.y) * f, bfhi(v.y) * f);
    v.z = pack2(bflo(v.z) * f, bfhi(v.z) * f); v.w = pack2(bflo(v.w) * f, bfhi(v.w) * f);
    *(u32x4*)(A + row * KLD + ch) = v;
  }
}
DI void state_update(const u16* Xs, const u16* Bs, f32x4 (&acc)[4], int w, int l15, int g) {
  const int tq = l15 >> 2, tp = l15 & 3;
#pragma unroll
  for (int kk = 0; kk < 4; ++kk) {
    const bf16x8 af = cat4(tr_read(Xs + (kk * 32 + 4 * g + tq) * KLD + w * 16 + 4 * tp), tr_read(Xs + (kk * 32 + 16 + 4 * g + tq) * KLD + w * 16 + 4 * tp));
#pragma unroll
    for (int nt = 0; nt < 4; ++nt) {
      const bf16x8 bfr = cat4(tr_read(Bs + (kk * 32 + 4 * g + tq) * KLD + nt * 16 + 4 * tp), tr_read(Bs + (kk * 32 + 16 + 4 * g + tq) * KLD + nt * 16 + 4 * tp));
      acc[nt] = mfma16(af, bfr, acc[nt]);
    }
  }
}
DI void state_to_lds(u16* Ss, const f32x4 (&acc)[4], int w, int l15, int g) {
#pragma unroll
  for (int nt = 0; nt < 4; ++nt)
#pragma unroll
    for (int r = 0; r < 4; ++r) Ss[(w * 16 + 4 * g + r) * KLD + nt * 16 + l15] = f2bf(acc[nt][r]);
}

constexpr int SEQ_LDS_A = 0, SEQ_LDS_B = 128 * KLD * 2, SEQ_LDS_C = 2 * 128 * KLD * 2, SEQ_LDS_S = 3 * 128 * KLD * 2, SEQ_LDS_F = SEQ_LDS_S + 64 * KLD * 2;
constexpr int SEQ_LDS_HALO = SEQ_LDS_F + 4096;
constexpr int SEQ_LDS_CW = SEQ_LDS_HALO + 2 * 3 * 3 * 64 * 2;
struct RawRegs { u32x4 r[4]; };
DI void raw_load(const u16* projb, int col0, int t0, RawRegs& rr, int tid) {
#pragma unroll
  for (int i = 0; i < 4; ++i) rr.r[i] = *(const u32x4*)(projb + (size_t)(t0 + (tid >> 3) + 32 * i) * NP + col0 + (tid & 7) * 8);
}
DI void raw_store(u16* dst, u16* halo_next, const RawRegs& rr, int tid) {
#pragma unroll
  for (int i = 0; i < 4; ++i) *(u32x4*)(dst + ((tid >> 3) + 32 * i) * KLD + (tid & 7) * 8) = rr.r[i];
  if (halo_next && tid >= 232) *(u32x4*)(halo_next + ((tid >> 3) - 29) * 64 + (tid & 7) * 8) = rr.r[3];
}
DI void conv_from_lds(const u16* raw, const u16* halo, const float* wl, const float* rowscale, float cscale, u32x4 (&out)[4], int tid) {
  const int q = tid >> 3, ch = (tid & 7) * 8;
  u32x4 v[7];
#pragma unroll
  for (int k = 0; k < 7; ++k) { const int r = 4 * q - 3 + k; v[k] = r >= 0 ? *(const u32x4*)(raw + r * KLD + ch) : *(const u32x4*)(halo + (r + 3) * 64 + ch); }
  float w[5][8];
#pragma unroll
  for (int j = 0; j < 5; ++j) { const f32x4 w0 = *(const f32x4*)(wl + j * 64 + ch), w1 = *(const f32x4*)(wl + j * 64 + ch + 4);
    w[j][0] = w0[0]; w[j][1] = w0[1]; w[j][2] = w0[2]; w[j][3] = w0[3]; w[j][4] = w1[0]; w[j][5] = w1[1]; w[j][6] = w1[2]; w[j][7] = w1[3]; }
#pragma unroll
  for (int o = 0; o < 4; ++o) {
    float acc[8];
#pragma unroll
    for (int i = 0; i < 8; ++i) acc[i] = w[4][i];
#pragma unroll
    for (int j = 0; j < 4; ++j) {
      const u32x4 x = v[o + j];
      acc[0] += w[j][0] * bflo(x.x); acc[1] += w[j][1] * bfhi(x.x); acc[2] += w[j][2] * bflo(x.y); acc[3] += w[j][3] * bfhi(x.y);
      acc[4] += w[j][4] * bflo(x.z); acc[5] += w[j][5] * bfhi(x.z); acc[6] += w[j][6] * bflo(x.w); acc[7] += w[j][7] * bfhi(x.w);
    }
    const float rs = (rowscale ? rowscale[4 * q + o] : 1.f) * cscale;
#pragma unroll
    for (int i = 0; i < 8; ++i) acc[i] = siluf(acc[i]) * rs;
    out[o].x = pack2(acc[0], acc[1]); out[o].y = pack2(acc[2], acc[3]); out[o].z = pack2(acc[4], acc[5]); out[o].w = pack2(acc[6], acc[7]);
  }
}
DI void conv_write(u16* dst, const u32x4 (&out)[4], int tid) {
  const int q = tid >> 3, ch = (tid & 7) * 8;
#pragma unroll
  for (int o = 0; o < 4; ++o) *(u32x4*)(dst + (4 * q + o) * KLD + ch) = out[o];
}
DI void stage_conv_w(float* wl, const float* cw, const float* cb, int chan0, int nchan, int tid) {
  for (int i = tid; i < 320; i += 256) { const int j = i >> 6, cc = i & 63; wl[i] = j < 4 ? cw[j * nchan + chan0 + cc] : cb[chan0 + cc]; }
}
DI float wave_scan_add(float x, int lane) {
#pragma unroll
  for (int o = 1; o < 64; o <<= 1) { const float y = __shfl_up(x, o); if (lane >= o) x += y; }
  return x;
}
DI float wave_scan_max(float x, int lane) {
#pragma unroll
  for (int o = 1; o < 64; o <<= 1) { const float y = __shfl_up(x, o); if (lane >= o) x = fmaxf(x, y); }
  return x;
}

DI void ssd_task(const Params& p, int layer, int b, int h, unsigned char* smem) {
  u16* Cs = (u16*)(smem + SEQ_LDS_A); u16* Bs = (u16*)(smem + SEQ_LDS_B); u16* Xs = (u16*)(smem + SEQ_LDS_C); u16* Ss = (u16*)(smem + SEQ_LDS_S);
  float* fl = (float*)(smem + SEQ_LDS_F);
  float* dts = fl; float* acs = fl + 128; float* wend = fl + 256; float* tmp = fl + 384;
  u16* halo = (u16*)(smem + SEQ_LDS_HALO); float* cwl = (float*)(smem + SEQ_LDS_CW);
  int tid = otid(), lane = tid & 63, w = tid >> 6, l15 = lane & 15, g = lane >> 4;
  const int gi = h >> 1;
  const u16* projb = (const u16*)(p.ws + OFF_PROJ) + (size_t)b * SEQ * NP;
  const float* smb = (const float*)(p.ws + OFF_SMALL) + (size_t)b * SEQ * NSMALL;
  const float* cw = p.ssm_conv_w + layer * 4 * 512; const float* cb = p.ssm_conv_b + layer * 512;
  u16* Y = (u16*)(p.ws + OFF_H);
  const float a_h = -__expf(p.ssm_a_log[layer * 4 + h]), d_h = p.ssm_d[layer * 4 + h], dtb = p.ssm_dt_bias[layer * 4 + h];
  const int colB = PC_XBC + 256 + gi * 64, colC = PC_XBC + 384 + gi * 64, colX = PC_XBC + h * 64;
  f32x4 st[4];
#pragma unroll
  for (int nt = 0; nt < 4; ++nt) st[nt] = (f32x4){0.f, 0.f, 0.f, 0.f};
  lds_barrier();
  stage_conv_w(cwl, cw, cb, 256 + gi * 64, 512, tid);
  stage_conv_w(cwl + 320, cw, cb, 384 + gi * 64, 512, tid);
  stage_conv_w(cwl + 640, cw, cb, h * 64, 512, tid);
  for (int i = tid; i < 3 * 3 * 64; i += 256) halo[i] = 0;
  RawRegs rB, rC, rX; float dtraw = 0.f;
  raw_load(projb, colB, 0, rB, tid); raw_load(projb, colC, 0, rC, tid); raw_load(projb, colX, 0, rX, tid);
  if (tid < 128) dtraw = smb[(size_t)tid * NSMALL + SM_DT + h];
#pragma unroll 1
  for (int c = 0; c < 32; ++c) {
    const int t0 = c * 128;
    asm volatile("" : "+v"(tid)); lane = tid & 63; w = tid >> 6; l15 = lane & 15; g = lane >> 4;
    u16* hcur = halo + (c & 1) * 576; u16* hnext = halo + ((c + 1) & 1) * 576;
    float dtv = 0.f;
    if (tid < 128) { const float xr = dtraw + dtb; dtv = xr > 20.f ? xr : log1pf(__expf(xr)); }
    float cs = wave_scan_add(dtv * a_h, lane);
    if (tid == 63) tmp[0] = cs;
    lds_barrier();
    if (w == 1) cs += tmp[0];
    if (tid < 128) { dts[tid] = dtv; acs[tid] = cs; }
    raw_store(Bs, hnext, rB, tid); raw_store(Cs, hnext + 192, rC, tid); raw_store(Xs, hnext + 384, rX, tid);
    lds_barrier();
    if (c + 1 < 32) {
      raw_load(projb, colB, t0 + 128, rB, tid); raw_load(projb, colC, t0 + 128, rC, tid);
      if (tid < 128) dtraw = smb[(size_t)(t0 + 128 + tid) * NSMALL + SM_DT + h];
    }
    {
      u32x4 o1[4], o2[4];
      conv_from_lds(Bs, hcur, cwl, nullptr, 1.f, o1, tid);
      lds_barrier();
      conv_write(Bs, o1, tid);
      conv_from_lds(Cs, hcur + 192, cwl + 320, nullptr, 1.f, o2, tid);
      lds_barrier();
      conv_write(Cs, o2, tid);
      conv_from_lds(Xs, hcur + 384, cwl + 640, dts, 1.f, o1, tid);
      lds_barrier();
      conv_write(Xs, o1, tid);
    }
    if (tid < 128) wend[tid] = __expf(acs[127] - acs[tid]);
    state_to_lds(Ss, st, w, l15, g);
    lds_barrier();
#pragma unroll 1
    for (int qt = 0; qt < 2; ++qt) {
      const int tl = 32 * w + qt * 16 + l15;
      bf16x8 cf[2];
#pragma unroll
      for (int ks = 0; ks < 2; ++ks) cf[ks] = ldfrag(Cs + tl * KLD + ks * 32 + 8 * g);
      f32x4 y[4];
#pragma unroll
      for (int d = 0; d < 4; ++d) y[d] = (f32x4){0.f, 0.f, 0.f, 0.f};
      const float at = acs[tl];
#pragma unroll 1
      for (int stl = 0; stl < 2; ++stl) {
        if (stl * 64 <= 32 * w + qt * 16 + 15) {
          f32x4 sc[4];
          qk_tile1<2>(Bs + stl * 64 * KLD, cf, sc, l15, g);
#pragma unroll
          for (int kt = 0; kt < 4; ++kt) {
            const f32x4 as = *(const f32x4*)(acs + stl * 64 + kt * 16 + 4 * g);
#pragma unroll
            for (int r = 0; r < 4; ++r) {
              const bool ok = stl * 64 + kt * 16 + 4 * g + r <= tl;
              sc[kt][r] = ok ? sc[kt][r] * __expf(at - as[r]) : 0.f;
            }
          }
          pv_accum1(sc, Xs + stl * 64 * KLD, y, l15, g);
        }
      }
      const float ea = __expf(at), dsk = d_h / dts[tl];
      const size_t row = (size_t)b * SEQ + t0 + tl;
#pragma unroll
      for (int d = 0; d < 4; ++d) {
        f32x4 yo = (f32x4){0.f, 0.f, 0.f, 0.f};
#pragma unroll
        for (int ks = 0; ks < 2; ++ks) yo = mfma16(ldfrag(Ss + (d * 16 + l15) * KLD + ks * 32 + 8 * g), cf[ks], yo);
        const u32x2 xv = *(const u32x2*)(Xs + tl * KLD + d * 16 + 4 * g);
        const f32x4 v = y[d] + yo * ea;
        u32x2 o; o.x = pack2(v[0] + dsk * bflo(xv.x), v[1] + dsk * bfhi(xv.x)); o.y = pack2(v[2] + dsk * bflo(xv.y), v[3] + dsk * bfhi(xv.y));
        *(u32x2*)(Y + row * 1024 + Y_C + h * 64 + d * 16 + 4 * g) = o;
      }
    }
    if (c + 1 < 32) raw_load(projb, colX, t0 + 128, rX, tid);
    lds_barrier();
    scale_rows(Xs, wend);
    lds_barrier();
    const float cd = __expf(acs[127]);
#pragma unroll
    for (int nt = 0; nt < 4; ++nt) st[nt] *= cd;
    state_update(Xs, Bs, st, w, l15, g);
  }
}
DI void seq_fix_rows(const Params& p, int layer, int r0, int nrows) {
  u16* Y = (u16*)(p.ws + OFF_H);
  const u16* proj = (const u16*)(p.ws + OFF_PROJ);
  const int tid = otid(), lane = tid & 63, wv = tid >> 6;
  const bool ml = lane >= 32;
  const int ch = (lane & 31) * 8;
  const float* ng = ml ? p.ml_norm_g + layer * 64 + (ch & 63) : p.ssm_norm_g + layer * 256 + ch;
  const f32x4 g0 = *(const f32x4*)ng, g1 = *(const f32x4*)(ng + 4);
  for (int rr = wv; rr < nrows; rr += 4) {
    const size_t row = (size_t)(r0 + rr);
    u16* yp = Y + row * 1024 + (ml ? Y_D : Y_C) + ch;
    const u32x4 yv = *(const u32x4*)yp;
    const u32x4 zv = *(const u32x4*)(proj + row * NP + (ml ? PD_Z : PC_Z) + ch);
    float v[8] = {bflo(yv.x), bfhi(yv.x), bflo(yv.y), bfhi(yv.y), bflo(yv.z), bfhi(yv.z), bflo(yv.w), bfhi(yv.w)};
    float z[8] = {bflo(zv.x), bfhi(zv.x), bflo(zv.y), bfhi(zv.y), bflo(zv.z), bfhi(zv.z), bflo(zv.w), bfhi(zv.w)};
    float ss = 0.f;
    if (ml) {
      const u32x4 ov = *(const u32x4*)(proj + row * NP + PD_O + ch);
      const float o[8] = {bflo(ov.x), bfhi(ov.x), bflo(ov.y), bfhi(ov.y), bflo(ov.z), bfhi(ov.z), bflo(ov.w), bfhi(ov.w)};
#pragma unroll
      for (int i = 0; i < 8; ++i) { v[i] *= sigmoidf_(o[i]); ss += v[i] * v[i]; }
    } else {
#pragma unroll
      for (int i = 0; i < 8; ++i) { v[i] *= siluf(z[i]); ss += v[i] * v[i]; }
    }
    ss += __shfl_xor(ss, 1); ss += __shfl_xor(ss, 2); ss += __shfl_xor(ss, 4);
    const float ss16 = ss + __shfl_xor(ss, 8);
    const float rn = ml ? rsqrtf(ss * (1.f / 64.f) + 1e-6f) : rsqrtf(ss16 * (1.f / 128.f) + 1e-6f);
    float o8[8];
#pragma unroll
    for (int i = 0; i < 8; ++i) { const float gg = i < 4 ? g0[i & 3] : g1[i & 3]; o8[i] = v[i] * rn * gg * (ml ? siluf(z[i]) : 1.f); }
    u32x4 w; w.x = pack2(o8[0], o8[1]); w.y = pack2(o8[2], o8[3]); w.z = pack2(o8[4], o8[5]); w.w = pack2(o8[6], o8[7]);
    *(u32x4*)yp = w;
  }
}

DI void mlstm_task(const Params& p, int layer, int b, int h, unsigned char* smem) {
  u16* Qs = (u16*)(smem + SEQ_LDS_A); u16* Ks2 = (u16*)(smem + SEQ_LDS_B); u16* Vs2 = (u16*)(smem + SEQ_LDS_C); u16* Cst = (u16*)(smem + SEQ_LDS_S);
  float* fl = (float*)(smem + SEQ_LDS_F);
  float* bcs = fl; float* us = fl + 128; float* pms = fl + 256; float* wend = fl + 384; float* nst = fl + 512; float* npart = fl + 576; float* tmp = fl + 832;
  u16* halo = (u16*)(smem + SEQ_LDS_HALO); float* cwl = (float*)(smem + SEQ_LDS_CW);
  int tid = otid(), lane = tid & 63, w = tid >> 6, l15 = lane & 15, g = lane >> 4;
  const u16* projb = (const u16*)(p.ws + OFF_PROJ) + (size_t)b * SEQ * NP;
  const float* smb = (const float*)(p.ws + OFF_SMALL) + (size_t)b * SEQ * NSMALL;
  const float* cw = p.ml_conv_w + layer * 4 * 512; const float* cb = p.ml_conv_b + layer * 512;
  const float ib = p.ml_if_b[layer * 8 + h], fb = p.ml_if_b[layer * 8 + 4 + h];
  u16* Y = (u16*)(p.ws + OFF_H);
  const int colQ = PD_QK + h * 64, colK = PD_QK + 256 + h * 64, colV = PD_V + h * 64;
  f32x4 st[4];
#pragma unroll
  for (int nt = 0; nt < 4; ++nt) st[nt] = (f32x4){0.f, 0.f, 0.f, 0.f};
  float m_prev = 0.f;
  lds_barrier();
  if (tid < 64) nst[tid] = 0.f;
  stage_conv_w(cwl, cw, cb, h * 64, 512, tid);
  stage_conv_w(cwl + 320, cw, cb, 256 + h * 64, 512, tid);
  for (int i = tid; i < 3 * 3 * 64; i += 256) halo[i] = 0;
  RawRegs rQ, rK, rV; float iraw = 0.f, fraw = 0.f;
  raw_load(projb, colQ, 0, rQ, tid); raw_load(projb, colK, 0, rK, tid); raw_load(projb, colV, 0, rV, tid);
  if (tid < 128) { iraw = smb[(size_t)tid * NSMALL + SM_IF + h]; fraw = smb[(size_t)tid * NSMALL + SM_IF + 4 + h]; }
#pragma unroll 1
  for (int c = 0; c < 32; ++c) {
    const int t0 = c * 128;
    asm volatile("" : "+v"(tid)); lane = tid & 63; w = tid >> 6; l15 = lane & 15; g = lane >> 4;
    u16* hcur = halo + (c & 1) * 576; u16* hnext = halo + ((c + 1) & 1) * 576;
    float ip = 0.f, lf = 0.f;
    if (tid < 128) { ip = iraw + ib; const float fp = fraw + fb; lf = fminf(fp, 0.f) - log1pf(__expf(-fabsf(fp))); }
    float bc = wave_scan_add(lf, lane);
    if (tid == 63) tmp[0] = bc;
    lds_barrier();
    if (w == 1) bc += tmp[0];
    const float u = tid < 128 ? ip - bc : -1e30f;
    float pm = wave_scan_max(u, lane);
    if (tid == 63) tmp[1] = pm;
    raw_store(Qs, hnext, rQ, tid); raw_store(Ks2, hnext + 192, rK, tid); raw_store(Vs2, nullptr, rV, tid);
    lds_barrier();
    if (w == 1) pm = fmaxf(pm, tmp[1]);
    if (tid < 128) { bcs[tid] = bc; us[tid] = u; pms[tid] = pm; }
    if (c + 1 < 32) {
      raw_load(projb, colQ, t0 + 128, rQ, tid);
      if (tid < 128) { iraw = smb[(size_t)(t0 + 128 + tid) * NSMALL + SM_IF + h]; fraw = smb[(size_t)(t0 + 128 + tid) * NSMALL + SM_IF + 4 + h]; }
    }
    u32x4 oQ[4], oK[4];
    conv_from_lds(Qs, hcur, cwl, nullptr, 1.f, oQ, tid);
    __builtin_amdgcn_sched_barrier(0);
    conv_from_lds(Ks2, hcur + 192, cwl + 320, nullptr, 0.125f, oK, tid);
    __builtin_amdgcn_sched_barrier(0);
    lds_barrier();
    conv_write(Qs, oQ, tid); conv_write(Ks2, oK, tid);
    state_to_lds(Cst, st, w, l15, g);
    const float blast = bcs[127];
    const float m_new = blast + fmaxf(m_prev, pms[127]);
    if (tid < 128) wend[tid] = __expf(blast - m_new + us[tid]);
    lds_barrier();
#pragma unroll 1
    for (int qt = 0; qt < 2; ++qt) {
      const int tl = 32 * w + qt * 16 + l15;
      bf16x8 qf[2];
#pragma unroll
      for (int ks = 0; ks < 2; ++ks) qf[ks] = ldfrag(Qs + tl * KLD + ks * 32 + 8 * g);
      f32x4 num[4];
#pragma unroll
      for (int d = 0; d < 4; ++d) num[d] = (f32x4){0.f, 0.f, 0.f, 0.f};
      const float bt = bcs[tl], mt = bt + fmaxf(m_prev, pms[tl]);
      float den = 0.f;
#pragma unroll 1
      for (int stl = 0; stl < 2; ++stl) {
        if (stl * 64 <= 32 * w + qt * 16 + 15) {
          f32x4 sc[4];
          qk_tile1<2>(Ks2 + stl * 64 * KLD, qf, sc, l15, g);
#pragma unroll
          for (int kt = 0; kt < 4; ++kt) {
            const f32x4 uu = *(const f32x4*)(us + stl * 64 + kt * 16 + 4 * g);
#pragma unroll
            for (int r = 0; r < 4; ++r) {
              const bool ok = stl * 64 + kt * 16 + 4 * g + r <= tl;
              const float v = ok ? sc[kt][r] * __expf(bt - mt + uu[r]) : 0.f;
              sc[kt][r] = v; den += v;
            }
          }
          pv_accum1(sc, Vs2 + stl * 64 * KLD, num, l15, g);
        }
      }
      const float wi = __expf(bt + m_prev - mt);
      float qn = 0.f;
#pragma unroll
      for (int ks = 0; ks < 2; ++ks)
#pragma unroll
        for (int j = 0; j < 8; ++j) qn += bf2f((u16)qf[ks][j]) * nst[ks * 32 + 8 * g + j];
      qn = group_sum4(qn);
      const float dn = group_sum4(den) + wi * qn;
      const float inv = __builtin_amdgcn_rcpf(fmaxf(fabsf(dn), __expf(-mt)));
      const size_t row = (size_t)b * SEQ + t0 + tl;
#pragma unroll
      for (int d = 0; d < 4; ++d) {
        f32x4 ni = (f32x4){0.f, 0.f, 0.f, 0.f};
#pragma unroll
        for (int ks = 0; ks < 2; ++ks) ni = mfma16(ldfrag(Cst + (d * 16 + l15) * KLD + ks * 32 + 8 * g), qf[ks], ni);
        const f32x4 v = (num[d] + ni * wi) * inv;
        u32x2 o; o.x = pack2(v[0], v[1]); o.y = pack2(v[2], v[3]);
        *(u32x2*)(Y + row * 1024 + Y_D + h * 64 + d * 16 + 4 * g) = o;
      }
    }
    if (c + 1 < 32) { raw_load(projb, colK, t0 + 128, rK, tid); raw_load(projb, colV, t0 + 128, rV, tid); }
    lds_barrier();
    scale_rows(Ks2, wend);
    lds_barrier();
    const float fprev = __expf(blast + m_prev - m_new);
#pragma unroll
    for (int nt = 0; nt < 4; ++nt) st[nt] *= fprev;
    state_update(Vs2, Ks2, st, w, l15, g);
    {
      const int e = tid & 63, part = tid >> 6;
      float a = 0.f;
      for (int s2 = part * 32; s2 < part * 32 + 32; ++s2) a += bf2f(Ks2[s2 * KLD + e]);
      npart[part * 64 + e] = a;
    }
    lds_barrier();
    if (tid < 64) nst[tid] = nst[tid] * fprev + npart[tid] + npart[64 + tid] + npart[128 + tid] + npart[192 + tid];
    m_prev = m_new;
  }
}

DI void compress_task(const Params& p, int layer, int b, int kv, int rb, unsigned char* smem) {
  constexpr int HLD = 136;
  u16* Hs = (u16*)smem;
  const int tid = otid(), lane = tid & 63, w = tid >> 6, l15 = lane & 15, g = lane >> 4;
  const u16* projb = (const u16*)(p.ws + OFF_PROJ) + (size_t)b * SEQ * NP + (kv ? PA_VC : PA_KC);
  const int mi = layer * 2 + kv;
  const u16* W1T = (const u16*)(p.ws + OFF_W1T) + (size_t)mi * 128 * 2048;
  const u16* W2T = (const u16*)(p.ws + OFF_W2T) + (size_t)mi * 64 * 128;
  const float* bias1 = (const float*)(p.ws + OFF_BIAS1) + mi * 16 * 128;
  f32x4 acc[2][2];
#pragma unroll
  for (int nt = 0; nt < 2; ++nt) { acc[nt][0] = (f32x4){0.f, 0.f, 0.f, 0.f}; acc[nt][1] = (f32x4){0.f, 0.f, 0.f, 0.f}; }
  int tok[2];
#pragma unroll
  for (int mt = 0; mt < 2; ++mt) { int i = rb * 32 + mt * 16 + l15; if (i > 254) i = 254; tok[mt] = 16 * i; }
#pragma unroll 4
  for (int ks = 0; ks < 64; ++ks) {
    const int j = ks >> 1, d0 = (ks & 1) * 32;
    bf16x8 af[2], wf[2];
#pragma unroll
    for (int mt = 0; mt < 2; ++mt) af[mt] = ldfrag(projb + (size_t)(tok[mt] + j) * NP + d0 + 8 * g);
#pragma unroll
    for (int nt = 0; nt < 2; ++nt) wf[nt] = ldfrag(W1T + (size_t)(w * 32 + nt * 16 + l15) * 2048 + ks * 32 + 8 * g);
#pragma unroll
    for (int nt = 0; nt < 2; ++nt)
#pragma unroll
      for (int mt = 0; mt < 2; ++mt) acc[nt][mt] = mfma16(wf[nt], af[mt], acc[nt][mt]);
  }
  lds_barrier();
#pragma unroll
  for (int nt = 0; nt < 2; ++nt) {
    const int n = w * 32 + nt * 16 + 4 * g;
    f32x4 bb = *(const f32x4*)(bias1 + n);
#pragma unroll
    for (int pc = 1; pc < 16; ++pc) bb += *(const f32x4*)(bias1 + pc * 128 + n);
#pragma unroll
    for (int mt = 0; mt < 2; ++mt) {
      const f32x4 v = acc[nt][mt] + bb;
      u32x2 o; o.x = pack2(siluf(v[0]), siluf(v[1])); o.y = pack2(siluf(v[2]), siluf(v[3]));
      *(u32x2*)(Hs + (mt * 16 + l15) * HLD + n) = o;
    }
  }
  lds_barrier();
  f32x4 acc2[2] = {(f32x4){0.f, 0.f, 0.f, 0.f}, (f32x4){0.f, 0.f, 0.f, 0.f}};
#pragma unroll
  for (int ks = 0; ks < 4; ++ks) {
    const bf16x8 wf = ldfrag(W2T + (size_t)(w * 16 + l15) * 128 + ks * 32 + 8 * g);
#pragma unroll
    for (int mt = 0; mt < 2; ++mt) acc2[mt] = mfma16(wf, ldfrag(Hs + (mt * 16 + l15) * HLD + ks * 32 + 8 * g), acc2[mt]);
  }
  u16* dst = (u16*)(p.ws + (kv ? OFF_VCMP : OFF_KCMP)) + (size_t)b * 256 * 64;
#pragma unroll
  for (int mt = 0; mt < 2; ++mt) {
    const int i = rb * 32 + mt * 16 + l15;
    u32x2 o; o.x = pack2(acc2[mt][0], acc2[mt][1]); o.y = pack2(acc2[mt][2], acc2[mt][3]);
    if (i > 254) { o.x = 0u; o.y = 0u; }
    *(u32x2*)(dst + (size_t)i * 64 + w * 16 + 4 * g) = o;
  }
}

DI void nsa_task(const Params& p, int layer, int b, int qi, unsigned char* smem) {
  u16* Ks = (u16*)smem; u16* Vs = Ks + 64 * KLD;
  float* T = (float*)(smem + 2 * 64 * KLD * 2);
  unsigned long long* selm = (unsigned long long*)(smem + 2 * 64 * KLD * 2 + 4 * 32 * 65 * 4);
  const int tid = otid(), lane = tid & 63, h = tid >> 6, l15 = lane & 15, g = lane >> 4;
  const int q0 = qi * 32;
  const u16* projb = (const u16*)(p.ws + OFF_PROJ) + (size_t)b * SEQ * NP;
  const float* smb = (const float*)(p.ws + OFF_SMALL) + (size_t)b * SEQ * NSMALL;
  const u16* kcmp = (const u16*)(p.ws + OFF_KCMP) + (size_t)b * 256 * 64;
  const u16* vcmp = (const u16*)(p.ws + OFF_VCMP) + (size_t)b * 256 * 64;
  bf16x8 qf[2][2];
#pragma unroll
  for (int qt = 0; qt < 2; ++qt)
#pragma unroll
    for (int ks = 0; ks < 2; ++ks) qf[qt][ks] = ldfrag(projb + (size_t)(q0 + qt * 16 + l15) * NP + PA_Q + h * 64 + ks * 32 + 8 * g);
  const float sc = 0.125f * 1.4426950408889634f;
  f32x4 outacc[4][2];
  AttnAcc a;
  KVRegs kr;
  const int ntc = (q0 >> 10) + 1;
  attn_init(a);
  lds_barrier();
  for (int i = tid; i < 4 * 32 * 65; i += 256) T[i] = 0.f;
  for (int j = 0; j < ntc; ++j) {
    lds_barrier();
    kv_load(kcmp, vcmp, 64, 64, j * 64, kr); kv_store(Ks, Vs, kr);
    lds_barrier();
    f32x4 s[4][2];
    auto valid = [&](int kt, int r, int qt) { return 16 * (j * 64 + kt * 16 + 4 * g + r) + 31 <= q0 + qt * 16 + l15; };
    qk_tile<2>(Ks, 0, qf, s, l15, g);
    softmax_pv(s, a, Vs, sc, l15, g, valid);
  }
  float cinv[2];
#pragma unroll
  for (int qt = 0; qt < 2; ++qt) {
    const float lt = group_sum4(a.l[qt]);
    cinv[qt] = lt > 0.f ? 1.f / lt : 0.f;
    const float gt = sigmoidf_(smb[(size_t)(q0 + qt * 16 + l15) * NSMALL + SM_G + h * 3 + 0]) * cinv[qt];
#pragma unroll
    for (int d = 0; d < 4; ++d) outacc[d][qt] = a.o[d][qt] * gt;
  }
  float carry[2] = {0.f, 0.f};
  for (int j = 0; j < ntc; ++j) {
    lds_barrier();
    kv_load(kcmp, vcmp, 64, 64, j * 64, kr); kv_store(Ks, Vs, kr);
    lds_barrier();
    f32x4 s[4][2];
    qk_tile<2>(Ks, 0, qf, s, l15, g);
#pragma unroll
    for (int qt = 0; qt < 2; ++qt) {
      float prev3 = carry[qt];
#pragma unroll
      for (int kt = 0; kt < 4; ++kt) {
        float pr[4];
#pragma unroll
        for (int r = 0; r < 4; ++r) {
          const bool ok = 16 * (j * 64 + kt * 16 + 4 * g + r) + 31 <= q0 + qt * 16 + l15;
          pr[r] = ok ? exp2_(s[kt][qt][r] * sc - a.m[qt]) * cinv[qt] : 0.f;
        }
        const float below = __shfl_up(pr[3], 16);
        const float wrap = __shfl(prev3, l15 + 48);
        const float nb = g > 0 ? below : wrap;
        T[(h * 32 + qt * 16 + l15) * 65 + j * 16 + kt * 4 + g] = (pr[0] + pr[1]) + (pr[2] + 0.5f * pr[3]) + 0.5f * nb;
        prev3 = pr[3];
      }
      carry[qt] = prev3;
    }
  }
  lds_barrier();
#pragma unroll 1
  for (int qq = 0; qq < 8; ++qq) {
    const int q = h * 8 + qq, t = q0 + q, cur = t >> 6;
    const float imp = ((T[(0 * 32 + q) * 65 + lane] + T[(1 * 32 + q) * 65 + lane]) + T[(2 * 32 + q) * 65 + lane]) + T[(3 * 32 + q) * 65 + lane];
    const float val = (lane == cur || lane == 0) ? 1e4f : (lane <= cur ? imp : -1.f);
    int rank = 0;
#pragma unroll
    for (int k = 0; k < 64; ++k) {
      const float vk = __int_as_float(__builtin_amdgcn_readlane(__float_as_int(val), k));
      rank += (vk > val || (vk == val && k < lane)) ? 1 : 0;
    }
    const unsigned long long m = __ballot(rank < 16);
    if (lane == 0) selm[q] = m;
  }
  lds_barrier();
  f32x4* park = (f32x4*)T + (h * 8) * 64 + lane;
#pragma unroll
  for (int d = 0; d < 4; ++d) { park[(d * 2 + 0) * 64] = outacc[d][0]; park[(d * 2 + 1) * 64] = outacc[d][1]; }
  unsigned long long mq[2], anym = 0ull;
#pragma unroll
  for (int qt = 0; qt < 2; ++qt) mq[qt] = selm[qt * 16 + l15];
  for (int i = 0; i < 32; ++i) anym |= selm[i];
  const int jhi = (q0 + 31) >> 6;
  attn_init(a);
  for (int j = 0; j <= jhi; ++j) {
    if (!((anym >> j) & 1ull)) continue;
    lds_barrier();
    kv_load(projb + PA_KS, projb + PA_VS, NP, NP, j * 64, kr); kv_store(Ks, Vs, kr);
    lds_barrier();
    f32x4 s[4][2];
    auto valid = [&](int kt, int r, int qt) { return ((mq[qt] >> j) & 1ull) && (j * 64 + kt * 16 + 4 * g + r <= q0 + qt * 16 + l15); };
    qk_tile<2>(Ks, 0, qf, s, l15, g);
    softmax_pv(s, a, Vs, sc, l15, g, valid);
  }
#pragma unroll
  for (int qt = 0; qt < 2; ++qt) {
    const float lt = group_sum4(a.l[qt]);
    const float gt = sigmoidf_(smb[(size_t)(q0 + qt * 16 + l15) * NSMALL + SM_G + h * 3 + 1]) * (lt > 0.f ? 1.f / lt : 0.f);
#pragma unroll
    for (int d = 0; d < 4; ++d) park[(d * 2 + qt) * 64] += a.o[d][qt] * gt;
  }
  attn_init(a);
  const int jlo = q0 >= 511 ? (q0 - 511) >> 6 : 0;
  for (int j = jlo; j <= jhi; ++j) {
    lds_barrier();
    kv_load(projb + PA_KW, projb + PA_VW, NP, NP, j * 64, kr); kv_store(Ks, Vs, kr);
    lds_barrier();
    f32x4 s[4][2];
    auto valid = [&](int kt, int r, int qt) { const int key = j * 64 + kt * 16 + 4 * g + r, t = q0 + qt * 16 + l15; return key <= t && key + 512 > t; };
    qk_tile<2>(Ks, 0, qf, s, l15, g);
    softmax_pv(s, a, Vs, sc, l15, g, valid);
  }
  u16* Y = (u16*)(p.ws + OFF_H);
  const float* ng = p.nsa_norm_g + layer * 64;
#pragma unroll
  for (int qt = 0; qt < 2; ++qt) {
    const int t = q0 + qt * 16 + l15;
    const float lt = group_sum4(a.l[qt]);
    const float gt = sigmoidf_(smb[(size_t)t * NSMALL + SM_G + h * 3 + 2]) * (lt > 0.f ? 1.f / lt : 0.f);
    f32x4 v[4]; float ss = 0.f;
#pragma unroll
    for (int d = 0; d < 4; ++d) { v[d] = park[(d * 2 + qt) * 64] + a.o[d][qt] * gt; ss += v[d][0] * v[d][0] + v[d][1] * v[d][1] + v[d][2] * v[d][2] + v[d][3] * v[d][3]; }
    ss = group_sum4(ss);
    const float rn = rsqrtf(ss * (1.f / 64.f) + 1e-6f);
    const size_t row = (size_t)b * SEQ + t;
#pragma unroll
    for (int d = 0; d < 4; ++d) {
      const int dd = d * 16 + 4 * g;
      const u32x2 zz = *(const u32x2*)(projb + (size_t)t * NP + PA_Z + h * 64 + dd);
      const f32x4 gg = *(const f32x4*)(ng + dd);
      u32x2 o;
      o.x = pack2(v[d][0] * rn * gg[0] * siluf(bflo(zz.x)), v[d][1] * rn * gg[1] * siluf(bfhi(zz.x)));
      o.y = pack2(v[d][2] * rn * gg[2] * siluf(bflo(zz.y)), v[d][3] * rn * gg[3] * siluf(bfhi(zz.y)));
      *(u32x2*)(Y + row * 1024 + Y_A + h * 64 + dd) = o;
    }
  }
}

DI void zero_y_cols(const Params& p, int c0, int ncols, int gtid, int gthreads) {
  u16* Y = (u16*)(p.ws + OFF_H);
  const int per_row = ncols / 8;
  for (size_t i = gtid; i < (size_t)NTOK * per_row; i += gthreads) {
    const size_t row = i / per_row; const int ch = (int)(i % per_row);
    *(u32x4*)(Y + row * 1024 + c0 + ch * 8) = (u32x4){0u, 0u, 0u, 0u};
  }
}

DI void final_norm_rows(const Params& p, int gw, int nw, int lane) {
  for (int row = gw; row < NTOK; row += nw) {
    float4* xr = (float4*)(p.out + (size_t)row * D_MODEL);
    float4 v[4]; float ss = 0.f;
#pragma unroll
    for (int i = 0; i < 4; ++i) { v[i] = xr[lane + 64 * i]; ss += v[i].x * v[i].x + v[i].y * v[i].y + v[i].z * v[i].z + v[i].w * v[i].w; }
    ss = wave_sum(ss);
    const float r = rsqrtf(ss * (1.f / D_MODEL) + 1e-6f);
    const float4* gp = (const float4*)p.final_g;
#pragma unroll
    for (int i = 0; i < 4; ++i) { const float4 gg = gp[lane + 64 * i]; float4 w; w.x = v[i].x * r * gg.x; w.y = v[i].y * r * gg.y; w.z = v[i].z * r * gg.z; w.w = v[i].w * r * gg.w; xr[lane + 64 * i] = w; }
  }
}

#ifndef DEBUG_CHECK
#define DEBUG_CHECK 0
#endif
#if DEBUG_CHECK
constexpr int NCHK = 12;
DI float block_sum(float v, float* red) {
  v = wave_sum(v);
  lds_barrier();
  if ((threadIdx.x & 63) == 0) red[threadIdx.x >> 6] = v;
  lds_barrier();
  return red[0] + red[1] + red[2] + red[3];
}
DI float block_max(float v, float* red) {
#pragma unroll
  for (int o = 32; o > 0; o >>= 1) v = fmaxf(v, __shfl_xor(v, o));
  lds_barrier();
  if ((threadIdx.x & 63) == 0) red[threadIdx.x >> 6] = v;
  lds_barrier();
  return fmaxf(fmaxf(red[0], red[1]), fmaxf(red[2], red[3]));
}
DI float bfr(float v) { return bf2f(f2bf(v)); }
struct Chk { float num[NCHK], den[NCHK]; };
DI void chk_add(Chk& c, int id, float got, float ref) { const float d = got - ref; c.num[id] += d * d; c.den[id] += ref * ref; }

DI void dbg_diff_attn(const Params& p, int layer, int b, int t, int h, Chk& c, int id, unsigned char* smem) {
  float* p1 = (float*)smem; float* p2 = p1 + 4096; float* red = p2 + 4096;
  const int tid = otid();
  const u16* proj = (const u16*)(p.ws + OFF_PROJ) + (size_t)b * SEQ * NP;
  const u16* q = proj + (size_t)t * NP + PB_Q + h * 64;
  const float scale = 0.17677669529663687f;
  float m1 = -1e30f, m2 = -1e30f;
  for (int s = tid; s <= t; s += 256) {
    const u16* k = proj + (size_t)s * NP + PB_K + h * 64;
    float a1 = 0.f, a2 = 0.f;
    for (int d = 0; d < 32; ++d) { a1 += bf2f(q[d]) * bf2f(k[d]); a2 += bf2f(q[32 + d]) * bf2f(k[32 + d]); }
    a1 *= scale; a2 *= scale; p1[s] = a1; p2[s] = a2; m1 = fmaxf(m1, a1); m2 = fmaxf(m2, a2);
  }
  m1 = block_max(m1, red); m2 = block_max(m2, red);
  float l1 = 0.f, l2 = 0.f;
  for (int s = tid; s <= t; s += 256) { const float e1 = __expf(p1[s] - m1), e2 = __expf(p2[s] - m2); p1[s] = e1; p2[s] = e2; l1 += e1; l2 += e2; }
  l1 = block_sum(l1, red); l2 = block_sum(l2, red);
  const float* lam = p.diff_lam + layer * 128;
  float s01 = 0.f, s23 = 0.f;
  for (int i = 0; i < 32; ++i) { s01 += lam[i] * lam[32 + i]; s23 += lam[64 + i] * lam[96 + i]; }
  const float lam_init = 0.8f - 0.6f * expf(-0.3f * (float)layer);
  const float lam_full = expf(s01) - expf(s23) + lam_init;
  lds_barrier();
  float o = 0.f;
  if (tid < 64) for (int s = 0; s <= t; ++s) o += (p1[s] / l1 - lam_full * p2[s] / l2) * bf2f(proj[(size_t)s * NP + PB_V + h * 64 + tid]);
  float ss = block_sum(tid < 64 ? o * o : 0.f, red);
  if (tid < 64) {
    const float z = bf2f(proj[(size_t)t * NP + PB_Z + h * 64 + tid]);
    const float ref = o * rsqrtf(ss / 64.f + 1e-6f) * p.diff_norm_g[layer * 64 + tid] * (1.f - lam_init) * (z / (1.f + expf(-z)));
    const float got = bf2f(((const u16*)(p.ws + OFF_H))[((size_t)b * SEQ + t) * 1024 + Y_B + h * 64 + tid]);
    const float d = got - ref;
    o = d * d; ss = ref * ref;
  } else { o = 0.f; ss = 0.f; }
  c.num[id] += block_sum(o, red); c.den[id] += block_sum(ss, red);
}

DI float dbg_conv(const u16* projb, int t, int pcol, const float* cw, const float* cb, int ch, int nch) {
  float a = cb[ch];
  for (int j = 0; j < 4; ++j) { const int tt = t - 3 + j; if (tt >= 0) a += cw[j * nch + ch] * bf2f(projb[(size_t)tt * NP + pcol]); }
  return a / (1.f + expf(-a));
}
constexpr int DBG_NS = 11, DBG_T = 300;
DI int dbg_sample_idx(int t) {
  const int TS[DBG_NS] = {0, 1, 2, 3, 64, 127, 128, 129, 255, 256, 299};
  for (int i = 0; i < DBG_NS; ++i) if (TS[i] == t) return i;
  return -1;
}
DI int dbg_sample_t(int i) { const int TS[DBG_NS] = {0, 1, 2, 3, 64, 127, 128, 129, 255, 256, 299}; return TS[i]; }
DI void dbg_ssd(const Params& p, int layer, int b, int gi, Chk& c, int id, unsigned char* smem) {
  float* ybuf = (float*)smem;
  float* red = ybuf + DBG_NS * 128;
  const int tid = threadIdx.x, pp = tid >> 2, nq = tid & 3;
  const u16* projb = (const u16*)(p.ws + OFF_PROJ) + (size_t)b * SEQ * NP;
  const float* smb = (const float*)(p.ws + OFF_SMALL) + (size_t)b * SEQ * NSMALL;
  const float* cw = p.ssm_conv_w + layer * 4 * 512; const float* cb = p.ssm_conv_b + layer * 512;
  lds_barrier();
  for (int hh = 0; hh < 2; ++hh) {
    const int h = gi * 2 + hh;
    const float a_h = -expf(p.ssm_a_log[layer * 4 + h]), d_h = p.ssm_d[layer * 4 + h], dtb = p.ssm_dt_bias[layer * 4 + h];
    float hst[16];
    for (int i = 0; i < 16; ++i) hst[i] = 0.f;
    for (int t = 0; t < DBG_T; ++t) {
      const float xr = smb[(size_t)t * NSMALL + SM_DT + h] + dtb;
      const float dt = xr > 20.f ? xr : log1pf(expf(xr));
      const float dA = expf(dt * a_h);
      const float xp = dbg_conv(projb, t, PC_XBC + h * 64 + pp, cw, cb, h * 64 + pp, 512);
      float y = 0.f;
      for (int i = 0; i < 16; ++i) {
        const int n = nq * 16 + i;
        const float Bn = dbg_conv(projb, t, PC_XBC + 256 + gi * 64 + n, cw, cb, 256 + gi * 64 + n, 512);
        const float Cn = dbg_conv(projb, t, PC_XBC + 384 + gi * 64 + n, cw, cb, 384 + gi * 64 + n, 512);
        hst[i] = dA * hst[i] + dt * xp * Bn;
        y += Cn * hst[i];
      }
      y += __shfl_xor(y, 1); y += __shfl_xor(y, 2);
      y += d_h * xp;
      const int si = dbg_sample_idx(t);
      if (si >= 0 && nq == 0) { const float z = bf2f(projb[(size_t)t * NP + PC_Z + h * 64 + pp]); ybuf[si * 128 + hh * 64 + pp] = y * (z / (1.f + expf(-z))); }
    }
  }
  lds_barrier();
  for (int si = 0; si < DBG_NS; ++si) {
    const float v = tid < 128 ? ybuf[si * 128 + tid] : 0.f;
    const float ss = block_sum(v * v, red);
    float e2 = 0.f, r2 = 0.f;
    if (tid < 128) {
      const float ref = v * rsqrtf(ss / 128.f + 1e-6f) * p.ssm_norm_g[layer * 256 + gi * 128 + tid];
      const float got = bf2f(((const u16*)(p.ws + OFF_H))[((size_t)b * SEQ + dbg_sample_t(si)) * 1024 + Y_C + gi * 128 + tid]);
      e2 = (got - ref) * (got - ref); r2 = ref * ref;
    }
    c.num[id] += block_sum(e2, red); c.den[id] += block_sum(r2, red);
  }
}
DI void dbg_mlstm(const Params& p, int layer, int b, int h, Chk& c, int id, unsigned char* smem) {
  float* ybuf = (float*)smem;
  float* red = ybuf + DBG_NS * 128;
  const int tid = threadIdx.x, dd = tid >> 2, eq = tid & 3;
  const u16* projb = (const u16*)(p.ws + OFF_PROJ) + (size_t)b * SEQ * NP;
  const float* smb = (const float*)(p.ws + OFF_SMALL) + (size_t)b * SEQ * NSMALL;
  const float* cw = p.ml_conv_w + layer * 4 * 512; const float* cb = p.ml_conv_b + layer * 512;
  const float ib = p.ml_if_b[layer * 8 + h], fb = p.ml_if_b[layer * 8 + 4 + h];
  lds_barrier();
  float Cst[16], nst[16];
  for (int i = 0; i < 16; ++i) { Cst[i] = 0.f; nst[i] = 0.f; }
  float m = 0.f;
  for (int t = 0; t < DBG_T; ++t) {
    const float ip = smb[(size_t)t * NSMALL + SM_IF + h] + ib, fp = smb[(size_t)t * NSMALL + SM_IF + 4 + h] + fb;
    const float lf = fminf(fp, 0.f) - log1pf(expf(-fabsf(fp)));
    const float mn = fmaxf(lf + m, ip), fs = expf(lf + m - mn), is = expf(ip - mn);
    const float vd = bf2f(projb[(size_t)t * NP + PD_V + h * 64 + dd]);
    float num = 0.f, den = 0.f;
    for (int i = 0; i < 16; ++i) {
      const int e = eq * 16 + i;
      const float qe = dbg_conv(projb, t, PD_QK + h * 64 + e, cw, cb, h * 64 + e, 512);
      const float ke = 0.125f * dbg_conv(projb, t, PD_QK + 256 + h * 64 + e, cw, cb, 256 + h * 64 + e, 512);
      Cst[i] = fs * Cst[i] + is * vd * ke; nst[i] = fs * nst[i] + is * ke;
      num += Cst[i] * qe; den += nst[i] * qe;
    }
    num += __shfl_xor(num, 1); num += __shfl_xor(num, 2); den += __shfl_xor(den, 1); den += __shfl_xor(den, 2);
    const float hv = num / fmaxf(fabsf(den), expf(-mn));
    m = mn;
    const int si = dbg_sample_idx(t);
    if (si >= 0 && eq == 0) { const float o = bf2f(projb[(size_t)t * NP + PD_O + h * 64 + dd]); ybuf[si * 64 + dd] = hv / (1.f + expf(-o)); }
  }
  lds_barrier();
  for (int si = 0; si < DBG_NS; ++si) {
    const float v = tid < 64 ? ybuf[si * 64 + tid] : 0.f;
    const float ss = block_sum(v * v, red);
    float e2 = 0.f, r2 = 0.f;
    if (tid < 64) {
      const int t = dbg_sample_t(si);
      const float z = bf2f(projb[(size_t)t * NP + PD_Z + h * 64 + tid]);
      const float ref = v * rsqrtf(ss / 64.f + 1e-6f) * p.ml_norm_g[layer * 64 + tid] * (z / (1.f + expf(-z)));
      const float got = bf2f(((const u16*)(p.ws + OFF_H))[((size_t)b * SEQ + t) * 1024 + Y_D + h * 64 + tid]);
      e2 = (got - ref) * (got - ref); r2 = ref * ref;
    }
    c.num[id] += block_sum(e2, red); c.den[id] += block_sum(r2, red);
  }
}

DI void debug_checks(const Params& p, unsigned char* smem) {
  const int tid = otid();
  float* red = (float*)(smem + 36 * 1024);
  Chk c;
  for (int i = 0; i < NCHK; ++i) { c.num[i] = 0.f; c.den[i] = 0.f; }
  const float* adap = (const float*)(p.ws + OFF_ADAP);
  const u16* H = (const u16*)(p.ws + OFF_H);
  const u16* proj = (const u16*)(p.ws + OFF_PROJ);
  const float* sm = (const float*)(p.ws + OFF_SMALL);
#if DEBUG_CHECK == 1
  {
    const int bs[2] = {0, 5}; const int ns[4] = {3, 1024 + 77, 2048 + 500, 3071};
    for (int bi = 0; bi < 2; ++bi) for (int ni = 0; ni < 4; ++ni) {
      const int b = bs[bi], n = ns[ni];
      float a = 0.f;
      for (int k = tid; k < 1024; k += 256) { const float v = p.c[b * 1024 + k]; a += (v / (1.f + expf(-v))) * p.ada_w[(size_t)k * 3072 + n]; }
      const float ref = block_sum(a, red) + p.ada_b[n];
      float got = 0.f; for (int kc = 0; kc < 8; ++kc) got += adap[(((size_t)kc * 2 + 0) * 8 + b) * 3072 + n];
      chk_add(c, 1, got, ref);
    }
  }
  {
    const int ms[3] = {1, 9000, 32767};
    const int ns[14] = {0, 300, 700, 900, 1500, 2000, 2300, 2693, 3300, 3500, 3967, 3970, 3981, 3990};
    for (int mi = 0; mi < 3; ++mi) {
      const int m = ms[mi], b = m >> 12;
      float ss = 0.f;
      for (int k = tid; k < 1024; k += 256) { const float v = p.x[(size_t)m * 1024 + k]; ss += v * v; }
      ss = block_sum(ss, red);
      const float rstd = rsqrtf(ss / 1024.f + 1e-6f);
      for (int ni = 0; ni < 14; ++ni) {
        const int n = ns[ni], col = colmap(n);
        float a = 0.f, herr = 0.f, href = 0.f;
        for (int k = tid; k < 1024; k += 256) {
          float shf = 0.f, scl = 0.f;
          for (int kc = 0; kc < 8; ++kc) { const float* ap = adap + (((size_t)kc * 2 + 0) * 8 + b) * 3072; shf += ap[k]; scl += ap[1024 + k]; }
          const float hv = p.x[(size_t)m * 1024 + k] * rstd * p.norm_g[k] * (1.f + scl) + shf;
          const float hg = bf2f(H[(size_t)m * 1024 + k]);
          herr += (hg - hv) * (hg - hv); href += hv * hv;
          a += hv * p.w_in[(size_t)k * D_IN + col];
        }
        const float ref = block_sum(a, red);
        herr = block_sum(herr, red); href = block_sum(href, red);
        if (ni == 0 && DEBUG_STAGE == 1) { c.num[3] += herr; c.den[3] += href; }
        const float got = n < NP ? bf2f(proj[(size_t)m * NP + n]) : sm[(size_t)m * NSMALL + (n - NP)];
        chk_add(c, 2, got, ref);
      }
    }
  }
#endif
#if DEBUG_CHECK == 2
  dbg_diff_attn(p, 0, 0, 5, 0, c, 4, smem);
  dbg_diff_attn(p, 0, 1, 200, 3, c, 4, smem);
  dbg_diff_attn(p, 0, 3, 1500, 2, c, 4, smem);
  dbg_diff_attn(p, 0, 7, 4095, 1, c, 4, smem);
  {
    const int ms[3] = {2, 12345, 32766}; const int ns[3] = {0, 513, 1023};
    const u16* Y = (const u16*)(p.ws + OFF_H);
    for (int mi = 0; mi < 3; ++mi) for (int ni = 0; ni < 3; ++ni) {
      const int m = ms[mi], n = ns[ni], b = m >> 12;
      float a = 0.f;
      for (int k = tid; k < 1024; k += 256) a += bf2f(Y[(size_t)m * 1024 + k]) * p.w_out[(size_t)k * 1024 + n];
      a = block_sum(a, red);
      float gate = 0.f; for (int kc = 0; kc < 8; ++kc) gate += adap[(((size_t)kc * 2 + 0) * 8 + b) * 3072 + 2048 + n];
      chk_add(c, 5, p.out[(size_t)m * 1024 + n] - p.x[(size_t)m * 1024 + n], gate * a);
    }
  }
#endif
#if DEBUG_CHECK == 3
  dbg_ssd(p, 0, 0, 0, c, 6, smem);
  dbg_ssd(p, 0, 5, 1, c, 6, smem);
  dbg_mlstm(p, 0, 0, 0, c, 7, smem);
  dbg_mlstm(p, 0, 6, 3, c, 7, smem);
#endif
  lds_barrier();
  if (tid == 0) {
    int wid_ = 0, wcls = 99;
    for (int i = 1; i < NCHK; ++i) if (c.den[i] > 0.f) {
      const float rel = sqrtf(c.num[i] / c.den[i]);
      int cls = rel >= 1.f ? 0 : (int)floorf(-log10f(fmaxf(rel, 1e-9f)));
      if (cls > 9) cls = 9;
      if (!(rel == rel)) cls = 0;
      if (cls < wcls) { wcls = cls; wid_ = i; }
    }
    p.out[0] = 1e5f * ((float)wid_ + 0.1f * (float)wcls);
  }
}
#endif

constexpr int SMEM_BYTES = 76 * 1024;
__global__ void __launch_bounds__(256, 2) fwd_megakernel(Params p) {
  cg::grid_group grid = cg::this_grid();
  __shared__ __attribute__((aligned(16))) unsigned char smem[SMEM_BYTES];
  const int tid = otid(), lane = tid & 63, wid = tid >> 6;
  const int G = gridDim.x, bid = blockIdx.x;
  for (int rep = 0; rep < REP_P0; ++rep) {
  for (int t = bid; t < T0_TOTAL; t += G) phase0_task(p, t, smem);
  grid.sync(); }
  for (int layer = 0; layer < 2; ++layer) {
    const float* xin = layer == 0 ? p.x : p.out;
    for (int rep = 0; rep < REP_P1; ++rep) {
    for (int t = bid; t < NTOK / 64; t += G) phase1_task(p, layer, xin, t, smem);
    grid.sync(); }
    for (int rep = 0; rep < REP_P2; ++rep) {
    for (int t = bid; t < 256 * 32; t += G) gemm_inproj_tile(p, layer, t, smem);
    grid.sync(); }
#if DEBUG_CHECK == 1
    if (bid == 0) debug_checks(p, smem);
    return;
#endif
    {
      for (int rep = 0; rep < REP_SEQ; ++rep) {
        if (bid < 32) ssd_task(p, layer, bid >> 2, bid & 3, smem);
        else if (bid < 64) mlstm_task(p, layer, (bid - 32) >> 2, (bid - 32) & 3, smem);
      }
      if (bid >= 64)
        for (int rep = 0; rep < REP_DIFF; ++rep)
          for (int u = bid - 64; u < 1024 + 128; u += G - 64) {
            if (u < 1024) { const int qb = 31 - (u >> 5), bh = u & 31; diff_attn_task(p, layer, bh >> 2, bh & 3, qb, smem); }
            else { const int v = u - 1024; compress_task(p, layer, v >> 4, (v >> 3) & 1, v & 7, smem); }
          }
    }
    grid.sync();
    for (int t = bid; t < NTOK / 64; t += G) seq_fix_rows(p, layer, t * 64, 64);
    for (int rep = 0; rep < REP_NSA; ++rep) {
    for (int u = bid; u < 1024; u += G) nsa_task(p, layer, u & 7, 127 - (u >> 3), smem);
    grid.sync(); }
    for (int rep = 0; rep < (layer == 0 ? REP_P4 : 1); ++rep) {
    for (int t = bid; t < 256 * 8; t += G) gemm_outproj_tile(p, layer, xin, p.out, t, smem);
    grid.sync(); }
#if DEBUG_CHECK >= 2
    if (bid == 0) debug_checks(p, smem);
    return;
#endif
  }
  final_norm_rows(p, bid * 4 + wid, G * 4, lane);
}

extern "C" void kernel_launch(void* const* d_in, const int* in_sizes, int n_in, void* d_out, int out_size, void* d_ws, size_t ws_size,
                              hipStream_t stream) {
  static int grid_blocks = 0;
  if (!grid_blocks) {
    int dev = 0, cus = 0, per_cu = 0;
    (void)hipGetDevice(&dev);
    (void)hipDeviceGetAttribute(&cus, hipDeviceAttributeMultiprocessorCount, dev);
    (void)hipOccupancyMaxActiveBlocksPerMultiprocessor(&per_cu, fwd_megakernel, 256, 0);
    if (per_cu > 2) per_cu = 2;
    if (per_cu < 1) per_cu = 1;
    grid_blocks = cus * per_cu;
  }
  if (grid_blocks < 128) { fprintf(stderr, "grid too small: %d\n", grid_blocks); return; }
  if (ws_size < WS_NEEDED) { fprintf(stderr, "workspace too small: %zu < %zu\n", ws_size, WS_NEEDED); return; }
  Params p{};
  const float** pp = (const float**)&p;
  for (int i = 0; i < 26; ++i) pp[i] = (const float*)d_in[i];
  p.out = (float*)d_out; p.ws = (unsigned char*)d_ws;
  void* args[] = {&p};
  hipError_t e = hipLaunchCooperativeKernel((void*)fwd_megakernel, dim3(grid_blocks), dim3(256), args, 0, stream);
  if (e != hipSuccess) fprintf(stderr, "cooperative launch failed: %s (grid %d)\n", hipGetErrorString(e), grid_blocks);
}
```

```cpp
#include <hip/hip_runtime.h>
#include <hip/hip_cooperative_groups.h>
#include <cstdio>
#include <cstdint>
#define DEBUG_CHECK 0
#define DEBUG_STAGE 1
#define REP_P1 1
#define REP_P2 1
#define REP_SEQ 1
#define REP_DIFF 1
#define REP_NSA 1
#define REP_P4 1
#define REP_P0 1
namespace cg = cooperative_groups;

typedef unsigned short u16;
typedef short bf16x8 __attribute__((ext_vector_type(8)));
typedef short s16x4 __attribute__((ext_vector_type(4)));
typedef float f32x4 __attribute__((ext_vector_type(4)));
typedef float f32x2 __attribute__((ext_vector_type(2)));
typedef unsigned u32x4 __attribute__((ext_vector_type(4)));
typedef unsigned u32x2 __attribute__((ext_vector_type(2)));
typedef __bf16 bf16x2_t __attribute__((ext_vector_type(2)));
#define DI __device__ __forceinline__
#define LDSP __attribute__((address_space(3)))

constexpr int D_MODEL = 1024, BATCH = 8, SEQ = 4096, NTOK = BATCH * SEQ;
constexpr int D_IN = 3992;
constexpr int NP = 3968, NPAD = 4096, NSMALL = 32;
constexpr int PA_Q = 0, PA_KC = 256, PA_VC = 320, PA_KS = 384, PA_VS = 448, PA_KW = 512, PA_VW = 576, PA_Z = 640;
constexpr int PB_Q = 896, PB_K = 1152, PB_V = 1408, PB_Z = 1664;
constexpr int PC_Z = 1920, PC_XBC = 2176;
constexpr int PD_QK = 2688, PD_V = 3200, PD_O = 3456, PD_Z = 3712;
constexpr int SM_G = 0, SM_DT = 12, SM_IF = 16;
constexpr int Y_A = 0, Y_B = 256, Y_C = 512, Y_D = 768;

constexpr size_t MiB = 1024 * 1024;
constexpr size_t OFF_WINT = 0;
constexpr size_t OFF_WOUTT = 16 * MiB;
constexpr size_t OFF_W1T = 20 * MiB;
constexpr size_t OFF_W2T = 22 * MiB;
constexpr size_t OFF_BIAS1 = 22 * MiB + 64 * 1024;
constexpr size_t OFF_ADAP = 22 * MiB + 128 * 1024;
constexpr size_t OFF_KCMP = 24 * MiB;
constexpr size_t OFF_VCMP = 24 * MiB + 256 * 1024;
constexpr size_t OFF_CNT = 24 * MiB + 512 * 1024;
constexpr size_t OFF_SMALL = 25 * MiB;
constexpr size_t OFF_SSQ = 29 * MiB;
constexpr size_t OFF_H = 32 * MiB;
constexpr size_t OFF_PROJ = 96 * MiB;
constexpr size_t WS_NEEDED = 96 * MiB + (size_t)NTOK * NP * 2;

struct Params {
  const float* x; const float* c; const float* norm_g; const float* ada_w; const float* ada_b;
  const float* w_in; const float* w_out;
  const float* nsa_cmp_pos; const float* nsa_ck_w1; const float* nsa_ck_w2; const float* nsa_cv_w1; const float* nsa_cv_w2; const float* nsa_norm_g;
  const float* diff_lam; const float* diff_norm_g;
  const float* ssm_conv_w; const float* ssm_conv_b; const float* ssm_dt_bias; const float* ssm_a_log; const float* ssm_d; const float* ssm_norm_g;
  const float* ml_conv_w; const float* ml_conv_b; const float* ml_if_b; const float* ml_norm_g; const float* final_g;
  float* out; unsigned char* ws;
};

DI void lds_barrier() { asm volatile("s_waitcnt lgkmcnt(0)" ::: "memory"); __builtin_amdgcn_s_barrier(); asm volatile("" ::: "memory"); }
DI int otid() { int t = threadIdx.x & 255; asm volatile("" : "+v"(t)); return t; }
DI int otid512() { int t = threadIdx.x; asm volatile("" : "+v"(t)); return t; }
DI unsigned pack2(float a, float b) { f32x2 v = {a, b}; bf16x2_t r = __builtin_convertvector(v, bf16x2_t); return __builtin_bit_cast(unsigned, r); }
DI u16 f2bf(float a) { return (u16)(pack2(a, 0.f) & 0xffffu); }
DI float bf2f(u16 h) { return __uint_as_float(((unsigned)h) << 16); }
DI float bflo(unsigned u) { return __uint_as_float(u << 16); }
DI float bfhi(unsigned u) { return __uint_as_float(u & 0xffff0000u); }
DI f32x4 mfma16(bf16x8 a, bf16x8 b, f32x4 c) { return __builtin_amdgcn_mfma_f32_16x16x32_bf16(a, b, c, 0, 0, 0); }
DI float wave_sum(float v) {
#pragma unroll
  for (int o = 32; o > 0; o >>= 1) v += __shfl_xor(v, o);
  return v;
}
DI float siluf(float v) { return v * __builtin_amdgcn_rcpf(1.f + __expf(-v)); }
DI float sigmoidf_(float v) { return __builtin_amdgcn_rcpf(1.f + __expf(-v)); }
DI float exp2_(float v) { return __builtin_amdgcn_exp2f(v); }
DI s16x4 tr_read(const u16* p) { return __builtin_amdgcn_ds_read_tr16_b64_v4i16((LDSP s16x4*)p); }
DI bf16x8 cat4(s16x4 a, s16x4 b) { bf16x8 r; r[0] = a[0]; r[1] = a[1]; r[2] = a[2]; r[3] = a[3]; r[4] = b[0]; r[5] = b[1]; r[6] = b[2]; r[7] = b[3]; return r; }
DI bf16x8 ldfrag(const u16* p) { return *(const bf16x8*)p; }

DI int colmap(int n) {
  if (n < 640) return n;
  if (n < 896) return 652 + (n - 640);
  if (n < 1920) return 908 + (n - 896);
  if (n < 2688) return 1932 + (n - 1920);
  if (n < 3456) return 2704 + (n - 2688);
  if (n < 3968) return 3480 + (n - 3456);
  if (n < 3980) return 640 + (n - 3968);
  if (n < 3984) return 2700 + (n - 3980);
  if (n < 3992) return 3472 + (n - 3984);
  return -1;
}

DI void tconv_tile(const float* __restrict__ src, int ldsrc, int k0, int n0, u16* __restrict__ dst, int ldd, bool use_map, unsigned char* smem) {
  float* tile = (float*)smem;
  const int tid = otid();
  lds_barrier();
  {
    const int nn = tid & 63; int col = n0 + nn; if (use_map) col = colmap(col);
#pragma unroll
    for (int i = 0; i < 16; ++i) { const int kk = i * 4 + (tid >> 6); tile[kk * 65 + nn] = col >= 0 ? src[(size_t)(k0 + kk) * ldsrc + col] : 0.f; }
  }
  lds_barrier();
#pragma unroll
  for (int i = 0; i < 2; ++i) {
    const int item = tid + 256 * i, nn = item >> 3, kc = item & 7;
    u32x4 w;
    w.x = pack2(tile[(kc * 8 + 0) * 65 + nn], tile[(kc * 8 + 1) * 65 + nn]);
    w.y = pack2(tile[(kc * 8 + 2) * 65 + nn], tile[(kc * 8 + 3) * 65 + nn]);
    w.z = pack2(tile[(kc * 8 + 4) * 65 + nn], tile[(kc * 8 + 5) * 65 + nn]);
    w.w = pack2(tile[(kc * 8 + 6) * 65 + nn], tile[(kc * 8 + 7) * 65 + nn]);
    *(u32x4*)(dst + (size_t)(n0 + nn) * ldd + k0 + kc * 8) = w;
  }
}

constexpr int T0_WIN = 2 * 16 * 64, T0_WOUT = 2 * 16 * 16, T0_W1 = 4 * 32 * 2, T0_W2 = 4 * 2, T0_ADA = 2 * 12 * 8, T0_B1 = 64;
constexpr int T0_TOTAL = T0_WIN + T0_WOUT + T0_W1 + T0_W2 + T0_ADA + T0_B1;

DI void phase0_task(const Params& p, int t, unsigned char* smem) {
  const int tid = otid();
  if (t < T0_WIN) {
    const int l = t / 1024, r = t % 1024, kt = r / 64, nt = r % 64;
    tconv_tile(p.w_in + (size_t)l * D_MODEL * D_IN, D_IN, kt * 64, nt * 64, (u16*)(p.ws + OFF_WINT) + (size_t)l * NPAD * 1024, 1024, true, smem);
    return;
  }
  t -= T0_WIN;
  if (t < T0_WOUT) {
    const int l = t / 256, r = t % 256, kt = r / 16, nt = r % 16;
    tconv_tile(p.w_out + (size_t)l * 1024 * 1024, 1024, kt * 64, nt * 64, (u16*)(p.ws + OFF_WOUTT) + (size_t)l * 1024 * 1024, 1024, false, smem);
    return;
  }
  t -= T0_WOUT;
  if (t < T0_W1) {
    const int m = t / 64, r = t % 64, kt = r / 2, nt = r % 2, l = m >> 1, kv = m & 1;
    const float* src = (kv ? p.nsa_cv_w1 : p.nsa_ck_w1) + (size_t)l * 2048 * 128;
    tconv_tile(src, 128, kt * 64, nt * 64, (u16*)(p.ws + OFF_W1T) + (size_t)m * 128 * 2048, 2048, false, smem);
    return;
  }
  t -= T0_W1;
  if (t < T0_W2) {
    const int m = t / 2, kt = t % 2, l = m >> 1, kv = m & 1;
    const float* src = (kv ? p.nsa_cv_w2 : p.nsa_ck_w2) + (size_t)l * 128 * 64;
    tconv_tile(src, 64, kt * 64, 0, (u16*)(p.ws + OFF_W2T) + (size_t)m * 64 * 128, 128, false, smem);
    return;
  }
  t -= T0_W2;
  if (t < T0_ADA) {
    const int l = t / 96, r = t % 96, nc = r / 8, kc = r % 8;
    float* cact = (float*)smem;
    lds_barrier();
    for (int i = tid; i < 1024; i += 256) { const int b = i >> 7, kk = i & 127; const float v = p.c[b * 1024 + kc * 128 + kk]; cact[i] = siluf(v); }
    lds_barrier();
    const int n = nc * 256 + tid;
    float acc[8];
#pragma unroll
    for (int b = 0; b < 8; ++b) acc[b] = 0.f;
    const float* w = p.ada_w + ((size_t)l * 1024 + kc * 128) * 3072 + n;
#pragma unroll 16
    for (int kk = 0; kk < 128; ++kk) {
      const float wv = w[(size_t)kk * 3072];
#pragma unroll
      for (int b = 0; b < 8; ++b) acc[b] += cact[b * 128 + kk] * wv;
    }
    float* adap = (float*)(p.ws + OFF_ADAP);
    const float bias = kc == 0 ? p.ada_b[l * 3072 + n] : 0.f;
#pragma unroll
    for (int b = 0; b < 8; ++b) adap[(((size_t)kc * 2 + l) * 8 + b) * 3072 + n] = acc[b] + bias;
    return;
  }
  t -= T0_ADA;
  {
    const int m = t >> 4, kc = t & 15, l = m >> 1, kv = m & 1;
    const float* w1 = (kv ? p.nsa_cv_w1 : p.nsa_ck_w1) + (size_t)l * 2048 * 128;
    const float* pos = p.nsa_cmp_pos + (size_t)l * 2048;
    const int n = tid & 127, half = tid >> 7;
    float acc = 0.f;
    const int k0 = kc * 128 + half * 64;
#pragma unroll 16
    for (int k = 0; k < 64; ++k) acc += pos[k0 + k] * w1[(size_t)(k0 + k) * 128 + n];
    float* red = (float*)smem;
    lds_barrier();
    red[tid] = acc;
    lds_barrier();
    if (tid < 128) ((float*)(p.ws + OFF_BIAS1))[(m * 16 + kc) * 128 + tid] = red[tid] + red[tid + 128];
  }
}

DI void phase1_task(const Params& p, int layer, const float* xin, int grp, unsigned char* smem) {
  const int tid = otid(), lane = tid & 63, wid = tid >> 6;
  const int b = grp >> 6;
  float* mul = (float*)smem;
  float* sh = mul + 1024;
  const float* adap = (const float*)(p.ws + OFF_ADAP);
  lds_barrier();
  for (int c = tid; c < 1024; c += 256) {
    float s0 = 0.f, s1 = 0.f;
#pragma unroll
    for (int kc = 0; kc < 8; ++kc) { const float* a = adap + (((size_t)kc * 2 + layer) * 8 + b) * 3072; s0 += a[c]; s1 += a[1024 + c]; }
    mul[c] = p.norm_g[layer * 1024 + c] * (1.f + s1); sh[c] = s0;
  }
  lds_barrier();
  u16* H = (u16*)(p.ws + OFF_H);
#pragma unroll 1
  for (int it = 0; it < 4; ++it) {
    float4 v[4][4]; float ss[4];
#pragma unroll
    for (int j = 0; j < 4; ++j) {
      const int row = grp * 64 + wid * 16 + it * 4 + j;
      const float4* xr = (const float4*)(xin + (size_t)row * D_MODEL);
#pragma unroll
      for (int i = 0; i < 4; ++i) v[j][i] = xr[lane + 64 * i];
    }
#pragma unroll
    for (int j = 0; j < 4; ++j) {
      float a = 0.f;
#pragma unroll
      for (int i = 0; i < 4; ++i) a += v[j][i].x * v[j][i].x + v[j][i].y * v[j][i].y + v[j][i].z * v[j][i].z + v[j][i].w * v[j][i].w;
      ss[j] = wave_sum(a);
    }
#pragma unroll
    for (int j = 0; j < 4; ++j) {
      const int row = grp * 64 + wid * 16 + it * 4 + j;
      const float r = rsqrtf(ss[j] * (1.f / D_MODEL) + 1e-6f);
#pragma unroll
      for (int i = 0; i < 4; ++i) {
        const int c = (lane + 64 * i) * 4;
        u32x2 w;
        w.x = pack2(v[j][i].x * r * mul[c] + sh[c], v[j][i].y * r * mul[c + 1] + sh[c + 1]);
        w.y = pack2(v[j][i].z * r * mul[c + 2] + sh[c + 2], v[j][i].w * r * mul[c + 3] + sh[c + 3]);
        *(u32x2*)(H + (size_t)row * 1024 + c) = w;
      }
    }
  }
}

namespace g8 {
constexpr int BM = 256, BK = 64, HALF = 128, HT = HALF * BK;
constexpr int LDS_BYTES = 8 * HT * 2;
DI int lds_byte(int r, int c) { const int st = (r >> 4) * 2 + (c >> 5), rr = r & 15, cc = c & 31, ob = rr * 64 + cc * 2; return st * 1024 + (ob ^ (((ob >> 9) & 1) << 5)); }
DI void stage_rc(int b, int& R, int& C) { const int st = b / 1024, sb = b % 1024, swz = sb ^ (((sb >> 9) & 1) << 5); R = (st >> 1) * 16 + swz / 64; C = (st & 1) * 32 + (swz % 64) / 2; }

DI void kloop(const u16* __restrict__ A, const u16* __restrict__ Bt, int K, int brow, int bcol, unsigned char* smem, f32x4 (&acc)[2][2][4][2]) {
  u16* shm = (u16*)smem;
  const int tid = otid512();
#define SA(b, h) (shm + ((b) * 2 + (h)) * HT)
#define SB(b, h) (shm + (4 + (b) * 2 + (h)) * HT)
#define STAGE(P, BASE, br, kt) do { const u16* _gb = BASE + ((long)(br) * K + (long)(kt) * BK); \
      __builtin_amdgcn_global_load_lds((const unsigned*)(_gb + soff0), (LDSP unsigned*)((LDSP char*)(P) + tid * 16), 16, 0, 0); \
      __builtin_amdgcn_global_load_lds((const unsigned*)(_gb + soff1), (LDSP unsigned*)((LDSP char*)(P) + tid * 16 + 8192), 16, 0, 0); } while (0)
#define LDA(dst, b, h) _Pragma("unroll") for (int m = 0; m < 4; ++m) _Pragma("unroll") for (int k = 0; k < 2; ++k) \
    dst[m][k] = *reinterpret_cast<const bf16x8*>((const char*)SA(b, h) + lds_byte(wr * 64 + m * 16 + fr, k * 32 + fq * 8))
#define LDB(dst, b, h) _Pragma("unroll") for (int n = 0; n < 2; ++n) _Pragma("unroll") for (int k = 0; k < 2; ++k) \
    dst[n][k] = *reinterpret_cast<const bf16x8*>((const char*)SB(b, h) + lds_byte(wc * 32 + n * 16 + fr, k * 32 + fq * 8))
#define MMA(ai, bj, At_, Bt_) do { __builtin_amdgcn_s_setprio(1); \
    _Pragma("unroll") for (int m = 0; m < 4; ++m) _Pragma("unroll") for (int n = 0; n < 2; ++n) _Pragma("unroll") for (int k = 0; k < 2; ++k) \
      acc[ai][bj][m][n] = __builtin_amdgcn_mfma_f32_16x16x32_bf16(Bt_[n][k], At_[m][k], acc[ai][bj][m][n], 0, 0, 0); \
    __builtin_amdgcn_s_setprio(0); } while (0)
#define WAIT_V(n) asm volatile("s_waitcnt vmcnt(" #n ")" ::: "memory")
#define WAIT_L(n) asm volatile("s_waitcnt lgkmcnt(" #n ")" ::: "memory")
#define BAR __builtin_amdgcn_s_barrier()
#define SCHED __builtin_amdgcn_sched_barrier(0)
  const int wid = __builtin_amdgcn_readfirstlane(tid >> 6), lane = tid & 63, wr = wid >> 2, wc = wid & 3, fr = lane & 15, fq = lane >> 4;
#pragma unroll
  for (int a = 0; a < 2; ++a)
#pragma unroll
    for (int b = 0; b < 2; ++b)
#pragma unroll
      for (int m = 0; m < 4; ++m) { acc[a][b][m][0] = (f32x4){0.f, 0.f, 0.f, 0.f}; acc[a][b][m][1] = (f32x4){0.f, 0.f, 0.f, 0.f}; }
  bf16x8 At[4][2], B0[2][2], B1[2][2];
  const int nt = K / BK;
  int soff0, soff1;
  { int r_, c_; stage_rc(tid * 16, r_, c_); soff0 = r_ * K + c_; stage_rc(tid * 16 + 8192, r_, c_); soff1 = r_ * K + c_; }
  STAGE(SB(0, 0), Bt, bcol, 0); STAGE(SA(0, 0), A, brow, 0);
  STAGE(SB(0, 1), Bt, bcol + HALF, 0); STAGE(SA(0, 1), A, brow + HALF, 0);
  if (wr == 1) BAR;
  WAIT_V(4); BAR;
  STAGE(SB(1, 0), Bt, bcol, 1); STAGE(SA(1, 0), A, brow, 1); STAGE(SB(1, 1), Bt, bcol + HALF, 1);
  WAIT_V(6); BAR;
#pragma unroll 1
  for (int t = 0; t < nt - 2; t += 2) {
    asm volatile("" : "+v"(soff0), "+v"(soff1));
    LDB(B0, 0, 0); SCHED; LDA(At, 0, 0); STAGE(SA(1, 1), A, brow + HALF, t + 1);
    WAIT_L(8); BAR; WAIT_L(0); MMA(0, 0, At, B0); BAR; SCHED;
    LDB(B1, 0, 1); STAGE(SB(0, 0), Bt, bcol, t + 2);
    BAR; WAIT_L(0); MMA(0, 1, At, B1); BAR;
    LDA(At, 0, 1); STAGE(SA(0, 0), A, brow, t + 2);
    BAR; WAIT_L(0); MMA(1, 0, At, B0); BAR; SCHED;
    STAGE(SB(0, 1), Bt, bcol + HALF, t + 2);
    WAIT_V(6); BAR; MMA(1, 1, At, B1); BAR;
    LDB(B0, 1, 0); SCHED; LDA(At, 1, 0); STAGE(SA(0, 1), A, brow + HALF, t + 2);
    WAIT_L(8); BAR; WAIT_L(0); MMA(0, 0, At, B0); BAR; SCHED;
    LDB(B1, 1, 1); STAGE(SB(1, 0), Bt, bcol, t + 3);
    BAR; WAIT_L(0); MMA(0, 1, At, B1); BAR;
    LDA(At, 1, 1); STAGE(SA(1, 0), A, brow, t + 3);
    BAR; WAIT_L(0); MMA(1, 0, At, B0); BAR; SCHED;
    STAGE(SB(1, 1), Bt, bcol + HALF, t + 3);
    WAIT_V(6); BAR; MMA(1, 1, At, B1); BAR;
  }
  { LDB(B0, 0, 0); LDA(At, 0, 0); STAGE(SA(1, 1), A, brow + HALF, nt - 1);
    BAR; WAIT_L(0); MMA(0, 0, At, B0); BAR;
    LDB(B1, 0, 1); BAR; WAIT_L(0); MMA(0, 1, At, B1); BAR;
    LDA(At, 0, 1); WAIT_V(4); BAR; WAIT_L(0); MMA(1, 0, At, B0); MMA(1, 1, At, B1); BAR; }
  { LDB(B0, 1, 0); LDA(At, 1, 0); WAIT_V(2); BAR; WAIT_L(0); MMA(0, 0, At, B0); BAR;
    LDB(B1, 1, 1); WAIT_V(0); BAR; WAIT_L(0); MMA(0, 1, At, B1); BAR;
    LDA(At, 1, 1); BAR; WAIT_L(0); MMA(1, 0, At, B0); MMA(1, 1, At, B1); BAR; }
  if (wr == 0) BAR;
#undef SA
#undef SB
#undef STAGE
#undef LDA
#undef LDB
#undef MMA
#undef WAIT_V
#undef WAIT_L
#undef BAR
#undef SCHED
}
DI void tile_map(int wgid, int nM, int nN, int& pm, int& pn) {
  const int nwg = nM * nN, NXCD = 8, WGM = 8;
  { const int q = nwg / NXCD, r = nwg % NXCD, xcd = wgid % NXCD, off = wgid / NXCD; wgid = (xcd < r ? xcd * (q + 1) : r * (q + 1) + (xcd - r) * q) + off; }
  const int nig = WGM * nN, gid = wgid / nig, fm = gid * WGM, gsz = (nM - fm) < WGM ? (nM - fm) : WGM;
  pm = fm + ((wgid % nig) % gsz); pn = (wgid % nig) / gsz;
}
}

DI void gemm_inproj_tile(const Params& p, int layer, int tile, unsigned char* smem) {
  int pm, pn; g8::tile_map(tile, NTOK / 256, NPAD / 256, pm, pn);
  const int brow = pm * 256, bcol = pn * 256;
  f32x4 acc[2][2][4][2];
  g8::kloop((const u16*)(p.ws + OFF_H), (const u16*)(p.ws + OFF_WINT) + (size_t)layer * NPAD * 1024, 1024, brow, bcol, smem, acc);
  const int tid = otid512(), wid = __builtin_amdgcn_readfirstlane(tid >> 6), lane = tid & 63, wr = wid >> 2, wc = wid & 3, fr = lane & 15, fq = lane >> 4;
  u16* proj = (u16*)(p.ws + OFF_PROJ);
  if (pn == 15 && wc == 0) {
    float* sm = (float*)(p.ws + OFF_SMALL);
#pragma unroll
    for (int ai = 0; ai < 2; ++ai)
#pragma unroll
      for (int m = 0; m < 4; ++m)
#pragma unroll
        for (int n = 0; n < 2; ++n) {
          const int mr = brow + ai * 128 + wr * 64 + m * 16 + fr;
          *(f32x4*)(sm + (size_t)mr * NSMALL + n * 16 + 4 * fq) = acc[ai][1][m][n];
        }
  }
  constexpr int CLD = 264;
  u16* Cs = (u16*)smem;
#pragma unroll
  for (int ai = 0; ai < 2; ++ai) {
    lds_barrier();
#pragma unroll
    for (int bj = 0; bj < 2; ++bj)
#pragma unroll
      for (int m = 0; m < 4; ++m)
#pragma unroll
        for (int n = 0; n < 2; ++n) {
          const f32x4 v = acc[ai][bj][m][n];
          u32x2 w; w.x = pack2(v[0], v[1]); w.y = pack2(v[2], v[3]);
          *(u32x2*)(Cs + (wr * 64 + m * 16 + fr) * CLD + bj * 128 + wc * 32 + n * 16 + 4 * fq) = w;
        }
    lds_barrier();
#pragma unroll
    for (int i = 0; i < 8; ++i) {
      const int id = tid + 512 * i, row = id >> 5, ch = id & 31;
      if (bcol + ch * 8 < NP) *(u32x4*)(proj + (size_t)(brow + ai * 128 + row) * NP + bcol + ch * 8) = *(const u32x4*)(Cs + row * CLD + ch * 8);
    }
  }
  asm volatile("s_waitcnt vmcnt(0)" ::: "memory");
  lds_barrier();
}

DI void gemm_outproj_tile(const Params& p, int layer, const float* xin, float* xout, int tile, unsigned char* smem) {
  int pm, pn; g8::tile_map(tile, NTOK / 256, 4, pm, pn);
  const int brow = pm * 256, bcol = pn * 256;
  f32x4 acc[2][2][4][2];
  g8::kloop((const u16*)(p.ws + OFF_H), (const u16*)(p.ws + OFF_WOUTT) + (size_t)layer * 1024 * 1024, 1024, brow, bcol, smem, acc);
  const int tid = otid512(), wid = __builtin_amdgcn_readfirstlane(tid >> 6), lane = tid & 63, wr = wid >> 2, wc = wid & 3, fr = lane & 15, fq = lane >> 4;
  const int b = brow >> 12;
  const float* adap = (const float*)(p.ws + OFF_ADAP);
#pragma unroll
  for (int bj = 0; bj < 2; ++bj)
#pragma unroll
    for (int n = 0; n < 2; ++n) {
      const int nc = bcol + bj * 128 + wc * 32 + n * 16 + 4 * fq;
      f32x4 gt = {0.f, 0.f, 0.f, 0.f};
#pragma unroll
      for (int kc = 0; kc < 8; ++kc) gt += *(const f32x4*)(adap + (((size_t)kc * 2 + layer) * 8 + b) * 3072 + 2048 + nc);
#pragma unroll
      for (int ai = 0; ai < 2; ++ai)
#pragma unroll
        for (int m = 0; m < 4; ++m) {
          const int mr = brow + ai * 128 + wr * 64 + m * 16 + fr;
          const f32x4 xv = *(const f32x4*)(xin + (size_t)mr * 1024 + nc);
          *(f32x4*)(xout + (size_t)mr * 1024 + nc) = xv + gt * acc[ai][bj][m][n];
        }
    }
  asm volatile("s_waitcnt vmcnt(0)" ::: "memory");
  lds_barrier();
}

constexpr int KLD = 72;
struct KVRegs { u32x4 k[2], v[2]; };
DI void kv_load(const u16* kbase, const u16* vbase, int ldk, int ldv, int key0, KVRegs& r) {
  const int tid = otid();
#pragma unroll
  for (int i = 0; i < 2; ++i) {
    const int id = tid + 256 * i, row = id >> 3, ch = id & 7;
    r.k[i] = *(const u32x4*)(kbase + (size_t)(key0 + row) * ldk + ch * 8);
    r.v[i] = *(const u32x4*)(vbase + (size_t)(key0 + row) * ldv + ch * 8);
  }
}
DI void kv_store(u16* Ks, u16* Vs, const KVRegs& r) {
  const int tid = otid();
#pragma unroll
  for (int i = 0; i < 2; ++i) {
    const int id = tid + 256 * i, row = id >> 3, ch = id & 7;
    *(u32x4*)(Ks + row * KLD + ch * 8) = r.k[i];
    *(u32x4*)(Vs + row * KLD + ch * 8) = r.v[i];
  }
}
struct AttnAcc { f32x4 o[4][2]; float m[2], l[2]; };
DI void attn_init(AttnAcc& a) {
#pragma unroll
  for (int d = 0; d < 4; ++d) { a.o[d][0] = (f32x4){0.f, 0.f, 0.f, 0.f}; a.o[d][1] = (f32x4){0.f, 0.f, 0.f, 0.f}; }
  a.m[0] = a.m[1] = -1e30f; a.l[0] = a.l[1] = 0.f;
}
template <int NKS>
DI void qk_tile(const u16* Ks, int dofs, const bf16x8 (&qf)[2][NKS], f32x4 (&s)[4][2], int l15, int g) {
#pragma unroll
  for (int kt = 0; kt < 4; ++kt) {
    s[kt][0] = (f32x4){0.f, 0.f, 0.f, 0.f}; s[kt][1] = (f32x4){0.f, 0.f, 0.f, 0.f};
#pragma unroll
    for (int ks = 0; ks < NKS; ++ks) {
      const bf16x8 a = ldfrag(Ks + (kt * 16 + l15) * KLD + dofs + ks * 32 + 8 * g);
      s[kt][0] = mfma16(a, qf[0][ks], s[kt][0]);
      s[kt][1] = mfma16(a, qf[1][ks], s[kt][1]);
    }
  }
}
DI void pv_accum(const bf16x8 (&pf)[2][2], const u16* Vs, f32x4 (&o)[4][2], int l15, int g) {
  const int tq = l15 >> 2, tp = l15 & 3;
#pragma unroll
  for (int kk = 0; kk < 2; ++kk)
#pragma unroll
    for (int d = 0; d < 4; ++d) {
      const bf16x8 vf = cat4(tr_read(Vs + (kk * 32 + 4 * g + tq) * KLD + d * 16 + 4 * tp), tr_read(Vs + (kk * 32 + 16 + 4 * g + tq) * KLD + d * 16 + 4 * tp));
      o[d][0] = mfma16(vf, pf[0][kk], o[d][0]);
      o[d][1] = mfma16(vf, pf[1][kk], o[d][1]);
    }
}
DI void pack_p(const f32x4 (&s)[4][2], bf16x8 (&pf)[2][2]) {
#pragma unroll
  for (int qt = 0; qt < 2; ++qt)
#pragma unroll
    for (int kk = 0; kk < 2; ++kk) {
      u32x4 w;
      w.x = pack2(s[2 * kk][qt][0], s[2 * kk][qt][1]); w.y = pack2(s[2 * kk][qt][2], s[2 * kk][qt][3]);
      w.z = pack2(s[2 * kk + 1][qt][0], s[2 * kk + 1][qt][1]); w.w = pack2(s[2 * kk + 1][qt][2], s[2 * kk + 1][qt][3]);
      pf[qt][kk] = __builtin_bit_cast(bf16x8, w);
    }
}
template <class VF>
DI void softmax_pv(f32x4 (&s)[4][2], AttnAcc& a, const u16* Vs, float sc, int l15, int g, VF valid) {
  bf16x8 pf[2][2];
#pragma unroll
  for (int qt = 0; qt < 2; ++qt) {
    float mx = -1e30f;
#pragma unroll
    for (int kt = 0; kt < 4; ++kt)
#pragma unroll
      for (int r = 0; r < 4; ++r) { const float v = valid(kt, r, qt) ? s[kt][qt][r] * sc : -1e30f; s[kt][qt][r] = v; mx = fmaxf(mx, v); }
    mx = fmaxf(mx, __shfl_xor(mx, 16)); mx = fmaxf(mx, __shfl_xor(mx, 32));
    const float mn = fmaxf(a.m[qt], mx), alpha = exp2_(a.m[qt] - mn);
    a.m[qt] = mn;
    float ls = 0.f;
#pragma unroll
    for (int kt = 0; kt < 4; ++kt)
#pragma unroll
      for (int r = 0; r < 4; ++r) { const float v = s[kt][qt][r]; const float pv = v > -1e29f ? exp2_(v - mn) : 0.f; s[kt][qt][r] = pv; ls += pv; }
    a.l[qt] = a.l[qt] * alpha + ls;
#pragma unroll
    for (int d = 0; d < 4; ++d) a.o[d][qt] *= alpha;
#pragma unroll
    for (int kk = 0; kk < 2; ++kk) {
      u32x4 w;
      w.x = pack2(s[2 * kk][qt][0], s[2 * kk][qt][1]); w.y = pack2(s[2 * kk][qt][2], s[2 * kk][qt][3]);
      w.z = pack2(s[2 * kk + 1][qt][0], s[2 * kk + 1][qt][1]); w.w = pack2(s[2 * kk + 1][qt][2], s[2 * kk + 1][qt][3]);
      pf[qt][kk] = __builtin_bit_cast(bf16x8, w);
    }
  }
  pv_accum(pf, Vs, a.o, l15, g);
}
DI float group_sum4(float v) { v += __shfl_xor(v, 16); v += __shfl_xor(v, 32); return v; }

DI void diff_attn_task(const Params& p, int layer, int b, int h, int qb, unsigned char* smem) {
  u16* Ks = (u16*)smem; u16* Vs = Ks + 64 * KLD;
  const int tid = otid(), lane = tid & 63, wid = tid >> 6, l15 = lane & 15, g = lane >> 4;
  const u16* proj = (const u16*)(p.ws + OFF_PROJ) + (size_t)b * SEQ * NP;
  const int q0w = qb * 128 + wid * 32;
  const float* lam = p.diff_lam + layer * 128;
  float s01 = 0.f, s23 = 0.f;
  for (int i = 0; i < 32; ++i) { s01 += lam[i] * lam[32 + i]; s23 += lam[64 + i] * lam[96 + i]; }
  const float lam_init = 0.8f - 0.6f * __expf(-0.3f * (float)layer);
  const float lam_full = __expf(s01) - __expf(s23) + lam_init;
  const float sc = 0.17677669529663687f * 1.4426950408889634f;
  const int ntile = 2 * qb + 2;
  const u16* vbase = proj + PB_V + h * 64;
  f32x4 res[4][2];
#pragma unroll 1
  for (int c = 0; c < 2; ++c) {
    const u16* kbase = proj + PB_K + h * 64 + c * 32;
    bf16x8 qf[2][1];
#pragma unroll
    for (int qt = 0; qt < 2; ++qt) qf[qt][0] = ldfrag(proj + (size_t)(q0w + qt * 16 + l15) * NP + PB_Q + h * 64 + c * 32 + 8 * g);
    AttnAcc a; attn_init(a);
    KVRegs kr; kv_load(kbase, vbase, NP, NP, 0, kr);
    for (int j = 0; j < ntile; ++j) {
      lds_barrier();
      kv_store(Ks, Vs, kr);
      lds_barrier();
      if (j + 1 < ntile) kv_load(kbase, vbase, NP, NP, (j + 1) * 64, kr);
      const int key0 = j * 64;
      if (key0 <= q0w + 31) {
        f32x4 s[4][2];
        auto valid = [&](int kt, int r, int qt) { return key0 + kt * 16 + 4 * g + r <= q0w + qt * 16 + l15; };
        qk_tile<1>(Ks, 0, qf, s, l15, g);
        softmax_pv(s, a, Vs, sc, l15, g, valid);
      }
    }
#pragma unroll
    for (int qt = 0; qt < 2; ++qt) {
      const float lt = group_sum4(a.l[qt]);
      const float inv = c == 0 ? 1.f / lt : -lam_full / lt;
#pragma unroll
      for (int d = 0; d < 4; ++d) res[d][qt] = c == 0 ? a.o[d][qt] * inv : res[d][qt] + a.o[d][qt] * inv;
    }
  }
  u16* Y = (u16*)(p.ws + OFF_H);
  const float* ng = p.diff_norm_g + layer * 64;
#pragma unroll
  for (int qt = 0; qt < 2; ++qt) {
    float ss = 0.f;
#pragma unroll
    for (int d = 0; d < 4; ++d) { const f32x4 v = res[d][qt]; ss += v[0] * v[0] + v[1] * v[1] + v[2] * v[2] + v[3] * v[3]; }
    ss = group_sum4(ss);
    const float rn = rsqrtf(ss * (1.f / 64.f) + 1e-6f) * (1.f - lam_init);
    const int t = q0w + qt * 16 + l15;
    const size_t row = (size_t)b * SEQ + t;
#pragma unroll
    for (int d = 0; d < 4; ++d) {
      const int dd = d * 16 + 4 * g;
      const f32x4 v = res[d][qt];
      const u32x2 zz = *(const u32x2*)(proj + (size_t)t * NP + PB_Z + h * 64 + dd);
      const f32x4 gg = *(const f32x4*)(ng + dd);
      u32x2 w;
      w.x = pack2(v[0] * rn * gg[0] * siluf(bflo(zz.x)), v[1] * rn * gg[1] * siluf(bfhi(zz.x)));
      w.y = pack2(v[2] * rn * gg[2] * siluf(bflo(zz.y)), v[3] * rn * gg[3] * siluf(bfhi(zz.y)));
      *(u32x2*)(Y + row * 1024 + Y_B + h * 64 + dd) = w;
    }
  }
}

template <int NKS>
DI void qk_tile1(const u16* Ks, const bf16x8 (&qf)[NKS], f32x4 (&s)[4], int l15, int g) {
#pragma unroll
  for (int kt = 0; kt < 4; ++kt) {
    s[kt] = (f32x4){0.f, 0.f, 0.f, 0.f};
#pragma unroll
    for (int ks = 0; ks < NKS; ++ks) s[kt] = mfma16(ldfrag(Ks + (kt * 16 + l15) * KLD + ks * 32 + 8 * g), qf[ks], s[kt]);
  }
}
DI void pv_accum1(const f32x4 (&s)[4], const u16* Vs, f32x4 (&o)[4], int l15, int g) {
  const int tq = l15 >> 2, tp = l15 & 3;
#pragma unroll
  for (int kk = 0; kk < 2; ++kk) {
    u32x4 w;
    w.x = pack2(s[2 * kk][0], s[2 * kk][1]); w.y = pack2(s[2 * kk][2], s[2 * kk][3]);
    w.z = pack2(s[2 * kk + 1][0], s[2 * kk + 1][1]); w.w = pack2(s[2 * kk + 1][2], s[2 * kk + 1][3]);
    const bf16x8 pf = __builtin_bit_cast(bf16x8, w);
#pragma unroll
    for (int d = 0; d < 4; ++d) {
      const bf16x8 vf = cat4(tr_read(Vs + (kk * 32 + 4 * g + tq) * KLD + d * 16 + 4 * tp), tr_read(Vs + (kk * 32 + 16 + 4 * g + tq) * KLD + d * 16 + 4 * tp));
      o[d] = mfma16(vf, pf, o[d]);
    }
  }
}
DI void conv_silu_stage(const u16* projb, int col0, const float* cw, const float* cb, int chan0, int nchan, int t0, u16* dst, const float* rowscale, float cscale) {
  const int tid = otid(), ch = (tid & 7) * 8;
  float w[4][8], bias[8];
#pragma unroll
  for (int j = 0; j < 4; ++j)
#pragma unroll
    for (int i = 0; i < 8; ++i) w[j][i] = cw[j * nchan + chan0 + ch + i];
#pragma unroll
  for (int i = 0; i < 8; ++i) bias[i] = cb[chan0 + ch + i];
#pragma unroll 1
  for (int ps = 0; ps < 4; ++ps) {
    const int row = ps * 32 + (tid >> 3), t = t0 + row;
    float acc[8];
#pragma unroll
    for (int i = 0; i < 8; ++i) acc[i] = bias[i];
#pragma unroll
    for (int j = 0; j < 4; ++j) {
      const int tt = t - 3 + j;
      if (tt >= 0) {
        const u32x4 v = *(const u32x4*)(projb + (size_t)tt * NP + col0 + ch);
        acc[0] += w[j][0] * bflo(v.x); acc[1] += w[j][1] * bfhi(v.x); acc[2] += w[j][2] * bflo(v.y); acc[3] += w[j][3] * bfhi(v.y);
        acc[4] += w[j][4] * bflo(v.z); acc[5] += w[j][5] * bfhi(v.z); acc[6] += w[j][6] * bflo(v.w); acc[7] += w[j][7] * bfhi(v.w);
      }
    }
    const float rs = (rowscale ? rowscale[row] : 1.f) * cscale;
#pragma unroll
    for (int i = 0; i < 8; ++i) acc[i] = siluf(acc[i]) * rs;
    u32x4 o; o.x = pack2(acc[0], acc[1]); o.y = pack2(acc[2], acc[3]); o.z = pack2(acc[4], acc[5]); o.w = pack2(acc[6], acc[7]);
    *(u32x4*)(dst + row * KLD + ch) = o;
  }
}
DI float block_scan128_add(float v, float* tmp) {
  const int tid = otid(), lane = tid & 63;
  float x = v;
#pragma unroll
  for (int o = 1; o < 64; o <<= 1) { const float y = __shfl_up(x, o); if (lane >= o) x += y; }
  lds_barrier();
  if (tid == 63) tmp[0] = x;
  lds_barrier();
  if ((tid >> 6) == 1) x += tmp[0];
  return x;
}
DI float block_scan128_max(float v, float* tmp) {
  const int tid = otid(), lane = tid & 63;
  float x = v;
#pragma unroll
  for (int o = 1; o < 64; o <<= 1) { const float y = __shfl_up(x, o); if (lane >= o) x = fmaxf(x, y); }
  lds_barrier();
  if (tid == 63) tmp[0] = x;
  lds_barrier();
  if ((tid >> 6) == 1) x = fmaxf(x, tmp[0]);
  return x;
}
DI void scale_rows(u16* A, const float* rs) {
  const int tid = otid(), ch = (tid & 7) * 8;
#pragma unroll
  for (int ps = 0; ps < 4; ++ps) {
    const int row = ps * 32 + (tid >> 3);
    const float f = rs[row];
    u32x4 v = *(u32x4*)(A + row * KLD + ch);
    v.x = pack2(bflo(v.x) * f, bfhi(v.x) * f); v.y = pack2(bflo(v.y) * f, bfhi(v.y) * f);
    v.z = pack2(bflo(v.z) * f, bfhi(v.z) * f); v.w = pack2(bflo(v.w) * f, bfhi(v.w) * f);
    *(u32x4*)(A + row * KLD + ch) = v;
  }
}
DI void state_update(const u16* Xs, const u16* Bs, f32x4 (&acc)[4], int w, int l15, int g) {
  const int tq = l15 >> 2, tp = l15 & 3;
#pragma unroll
  for (int kk = 0; kk < 4; ++kk) {
    const bf16x8 af = cat4(tr_read(Xs + (kk * 32 + 4 * g + tq) * KLD + w * 16 + 4 * tp), tr_read(Xs + (kk * 32 + 16 + 4 * g + tq) * KLD + w * 16 + 4 * tp));
#pragma unroll
    for (int nt = 0; nt < 4; ++nt) {
      const bf16x8 bfr = cat4(tr_read(Bs + (kk * 32 + 4 * g + tq) * KLD + nt * 16 + 4 * tp), tr_read(Bs + (kk * 32 + 16 + 4 * g + tq) * KLD + nt * 16 + 4 * tp));
      acc[nt] = mfma16(af, bfr, acc[nt]);
    }
  }
}
DI void state_to_lds(u16* Ss, const f32x4 (&acc)[4], int w, int l15, int g) {
#pragma unroll
  for (int nt = 0; nt < 4; ++nt)
#pragma unroll
    for (int r = 0; r < 4; ++r) Ss[(w * 16 + 4 * g + r) * KLD + nt * 16 + l15] = f2bf(acc[nt][r]);
}

constexpr int SEQ_LDS_A = 0, SEQ_LDS_B = 128 * KLD * 2, SEQ_LDS_C = 2 * 128 * KLD * 2, SEQ_LDS_S = 3 * 128 * KLD * 2, SEQ_LDS_F = SEQ_LDS_S + 64 * KLD * 2;
constexpr int SEQ_LDS_HALO = SEQ_LDS_F + 4096;
constexpr int SEQ_LDS_CW = SEQ_LDS_HALO + 2 * 3 * 3 * 64 * 2;
struct RawRegs { u32x4 r[4]; };
DI void raw_load(const u16* projb, int col0, int t0, RawRegs& rr, int tid) {
#pragma unroll
  for (int i = 0; i < 4; ++i) rr.r[i] = *(const u32x4*)(projb + (size_t)(t0 + (tid >> 3) + 32 * i) * NP + col0 + (tid & 7) * 8);
}
DI void raw_store(u16* dst, u16* halo_next, const RawRegs& rr, int tid) {
#pragma unroll
  for (int i = 0; i < 4; ++i) *(u32x4*)(dst + ((tid >> 3) + 32 * i) * KLD + (tid & 7) * 8) = rr.r[i];
  if (halo_next && tid >= 232) *(u32x4*)(halo_next + ((tid >> 3) - 29) * 64 + (tid & 7) * 8) = rr.r[3];
}
DI void conv_from_lds(const u16* raw, const u16* halo, const float* wl, const float* rowscale, float cscale, u32x4 (&out)[4], int tid) {
  const int q = tid >> 3, ch = (tid & 7) * 8;
  u32x4 v[7];
#pragma unroll
  for (int k = 0; k < 7; ++k) { const int r = 4 * q - 3 + k; v[k] = r >= 0 ? *(const u32x4*)(raw + r * KLD + ch) : *(const u32x4*)(halo + (r + 3) * 64 + ch); }
  float w[5][8];
#pragma unroll
  for (int j = 0; j < 5; ++j) { const f32x4 w0 = *(const f32x4*)(wl + j * 64 + ch), w1 = *(const f32x4*)(wl + j * 64 + ch + 4);
    w[j][0] = w0[0]; w[j][1] = w0[1]; w[j][2] = w0[2]; w[j][3] = w0[3]; w[j][4] = w1[0]; w[j][5] = w1[1]; w[j][6] = w1[2]; w[j][7] = w1[3]; }
#pragma unroll
  for (int o = 0; o < 4; ++o) {
    float acc[8];
#pragma unroll
    for (int i = 0; i < 8; ++i) acc[i] = w[4][i];
#pragma unroll
    for (int j = 0; j < 4; ++j) {
      const u32x4 x = v[o + j];
      acc[0] += w[j][0] * bflo(x.x); acc[1] += w[j][1] * bfhi(x.x); acc[2] += w[j][2] * bflo(x.y); acc[3] += w[j][3] * bfhi(x.y);
      acc[4] += w[j][4] * bflo(x.z); acc[5] += w[j][5] * bfhi(x.z); acc[6] += w[j][6] * bflo(x.w); acc[7] += w[j][7] * bfhi(x.w);
    }
    const float rs = (rowscale ? rowscale[4 * q + o] : 1.f) * cscale;
#pragma unroll
    for (int i = 0; i < 8; ++i) acc[i] = siluf(acc[i]) * rs;
    out[o].x = pack2(acc[0], acc[1]); out[o].y = pack2(acc[2], acc[3]); out[o].z = pack2(acc[4], acc[5]); out[o].w = pack2(acc[6], acc[7]);
  }
}
DI void conv_write(u16* dst, const u32x4 (&out)[4], int tid) {
  const int q = tid >> 3, ch = (tid & 7) * 8;
#pragma unroll
  for (int o = 0; o < 4; ++o) *(u32x4*)(dst + (4 * q + o) * KLD + ch) = out[o];
}
DI void stage_conv_w(float* wl, const float* cw, const float* cb, int chan0, int nchan, int tid) {
  for (int i = tid; i < 320; i += 256) { const int j = i >> 6, cc = i & 63; wl[i] = j < 4 ? cw[j * nchan + chan0 + cc] : cb[chan0 + cc]; }
}
DI float wave_scan_add(float x, int lane) {
#pragma unroll
  for (int o = 1; o < 64; o <<= 1) { const float y = __shfl_up(x, o); if (lane >= o) x += y; }
  return x;
}
DI float wave_scan_max(float x, int lane) {
#pragma unroll
  for (int o = 1; o < 64; o <<= 1) { const float y = __shfl_up(x, o); if (lane >= o) x = fmaxf(x, y); }
  return x;
}

DI void ssd_task(const Params& p, int layer, int b, int h, unsigned char* smem) {
  u16* Cs = (u16*)(smem + SEQ_LDS_A); u16* Bs = (u16*)(smem + SEQ_LDS_B); u16* Xs = (u16*)(smem + SEQ_LDS_C); u16* Ss = (u16*)(smem + SEQ_LDS_S);
  float* fl = (float*)(smem + SEQ_LDS_F);
  float* dts = fl; float* acs = fl + 128; float* wend = fl + 256; float* tmp = fl + 384;
  u16* halo = (u16*)(smem + SEQ_LDS_HALO); float* cwl = (float*)(smem + SEQ_LDS_CW);
  int tid = otid(), lane = tid & 63, w = tid >> 6, l15 = lane & 15, g = lane >> 4;
  const int gi = h >> 1;
  const u16* projb = (const u16*)(p.ws + OFF_PROJ) + (size_t)b * SEQ * NP;
  const float* smb = (const float*)(p.ws + OFF_SMALL) + (size_t)b * SEQ * NSMALL;
  const float* cw = p.ssm_conv_w + layer * 4 * 512; const float* cb = p.ssm_conv_b + layer * 512;
  u16* Y = (u16*)(p.ws + OFF_H);
  const float a_h = -__expf(p.ssm_a_log[layer * 4 + h]), d_h = p.ssm_d[layer * 4 + h], dtb = p.ssm_dt_bias[layer * 4 + h];
  const int colB = PC_XBC + 256 + gi * 64, colC = PC_XBC + 384 + gi * 64, colX = PC_XBC + h * 64;
  f32x4 st[4];
#pragma unroll
  for (int nt = 0; nt < 4; ++nt) st[nt] = (f32x4){0.f, 0.f, 0.f, 0.f};
  lds_barrier();
  stage_conv_w(cwl, cw, cb, 256 + gi * 64, 512, tid);
  stage_conv_w(cwl + 320, cw, cb, 384 + gi * 64, 512, tid);
  stage_conv_w(cwl + 640, cw, cb, h * 64, 512, tid);
  for (int i = tid; i < 3 * 3 * 64; i += 256) halo[i] = 0;
  RawRegs rB, rC, rX; float dtraw = 0.f;
  raw_load(projb, colB, 0, rB, tid); raw_load(projb, colC, 0, rC, tid); raw_load(projb, colX, 0, rX, tid);
  if (tid < 128) dtraw = smb[(size_t)tid * NSMALL + SM_DT + h];
#pragma unroll 1
  for (int c = 0; c < 32; ++c) {
    const int t0 = c * 128;
    asm volatile("" : "+v"(tid)); lane = tid & 63; w = tid >> 6; l15 = lane & 15; g = lane >> 4;
    u16* hcur = halo + (c & 1) * 576; u16* hnext = halo + ((c + 1) & 1) * 576;
    float dtv = 0.f;
    if (tid < 128) { const float xr = dtraw + dtb; dtv = xr > 15.f ? xr : __logf(1.f + __expf(xr)); }
    float cs = wave_scan_add(dtv * a_h, lane);
    if (tid == 63) tmp[0] = cs;
    lds_barrier();
    if (w == 1) cs += tmp[0];
    if (tid < 128) { dts[tid] = dtv; acs[tid] = cs; }
    raw_store(Bs, hnext, rB, tid); raw_store(Cs, hnext + 192, rC, tid); raw_store(Xs, hnext + 384, rX, tid);
    lds_barrier();
    if (c + 1 < 32) {
      raw_load(projb, colB, t0 + 128, rB, tid); raw_load(projb, colC, t0 + 128, rC, tid);
      if (tid < 128) dtraw = smb[(size_t)(t0 + 128 + tid) * NSMALL + SM_DT + h];
    }
    {
      u32x4 o1[4], o2[4];
      conv_from_lds(Bs, hcur, cwl, nullptr, 1.f, o1, tid);
      lds_barrier();
      conv_write(Bs, o1, tid);
      conv_from_lds(Cs, hcur + 192, cwl + 320, nullptr, 1.f, o2, tid);
      lds_barrier();
      conv_write(Cs, o2, tid);
      conv_from_lds(Xs, hcur + 384, cwl + 640, dts, 1.f, o1, tid);
      lds_barrier();
      conv_write(Xs, o1, tid);
    }
    if (tid < 128) wend[tid] = __expf(acs[127] - acs[tid]);
    state_to_lds(Ss, st, w, l15, g);
    lds_barrier();
#pragma unroll 1
    for (int qt = 0; qt < 2; ++qt) {
      const int tl = 32 * w + qt * 16 + l15;
      bf16x8 cf[2];
#pragma unroll
      for (int ks = 0; ks < 2; ++ks) cf[ks] = ldfrag(Cs + tl * KLD + ks * 32 + 8 * g);
      f32x4 y[4];
#pragma unroll
      for (int d = 0; d < 4; ++d) y[d] = (f32x4){0.f, 0.f, 0.f, 0.f};
      const float at = acs[tl];
#pragma unroll 1
      for (int stl = 0; stl < 2; ++stl) {
        if (stl * 64 <= 32 * w + qt * 16 + 15) {
          f32x4 sc[4];
          qk_tile1<2>(Bs + stl * 64 * KLD, cf, sc, l15, g);
#pragma unroll
          for (int kt = 0; kt < 4; ++kt) {
            const f32x4 as = *(const f32x4*)(acs + stl * 64 + kt * 16 + 4 * g);
#pragma unroll
            for (int r = 0; r < 4; ++r) {
              const bool ok = stl * 64 + kt * 16 + 4 * g + r <= tl;
              sc[kt][r] = ok ? sc[kt][r] * __expf(at - as[r]) : 0.f;
            }
          }
          pv_accum1(sc, Xs + stl * 64 * KLD, y, l15, g);
        }
      }
      const float ea = __expf(at), dsk = d_h / dts[tl];
      const size_t row = (size_t)b * SEQ + t0 + tl;
#pragma unroll
      for (int d = 0; d < 4; ++d) {
        f32x4 yo = (f32x4){0.f, 0.f, 0.f, 0.f};
#pragma unroll
        for (int ks = 0; ks < 2; ++ks) yo = mfma16(ldfrag(Ss + (d * 16 + l15) * KLD + ks * 32 + 8 * g), cf[ks], yo);
        const u32x2 xv = *(const u32x2*)(Xs + tl * KLD + d * 16 + 4 * g);
        const f32x4 v = y[d] + yo * ea;
        u32x2 o; o.x = pack2(v[0] + dsk * bflo(xv.x), v[1] + dsk * bfhi(xv.x)); o.y = pack2(v[2] + dsk * bflo(xv.y), v[3] + dsk * bfhi(xv.y));
        *(u32x2*)(Y + row * 1024 + Y_C + h * 64 + d * 16 + 4 * g) = o;
      }
    }
    if (c + 1 < 32) raw_load(projb, colX, t0 + 128, rX, tid);
    lds_barrier();
    scale_rows(Xs, wend);
    lds_barrier();
    const float cd = __expf(acs[127]);
#pragma unroll
    for (int nt = 0; nt < 4; ++nt) st[nt] *= cd;
    state_update(Xs, Bs, st, w, l15, g);
  }
}
DI void seq_fix_rows(const Params& p, int layer, int r0, int nrows) {
  u16* Y = (u16*)(p.ws + OFF_H);
  const u16* proj = (const u16*)(p.ws + OFF_PROJ);
  const int tid = otid(), lane = tid & 63, wv = tid >> 6;
  const bool ml = lane >= 32;
  const int ch = (lane & 31) * 8;
  const float* ng = ml ? p.ml_norm_g + layer * 64 + (ch & 63) : p.ssm_norm_g + layer * 256 + ch;
  const f32x4 g0 = *(const f32x4*)ng, g1 = *(const f32x4*)(ng + 4);
  for (int rr = wv; rr < nrows; rr += 4) {
    const size_t row = (size_t)(r0 + rr);
    u16* yp = Y + row * 1024 + (ml ? Y_D : Y_C) + ch;
    const u32x4 yv = *(const u32x4*)yp;
    const u32x4 zv = *(const u32x4*)(proj + row * NP + (ml ? PD_Z : PC_Z) + ch);
    float v[8] = {bflo(yv.x), bfhi(yv.x), bflo(yv.y), bfhi(yv.y), bflo(yv.z), bfhi(yv.z), bflo(yv.w), bfhi(yv.w)};
    float z[8] = {bflo(zv.x), bfhi(zv.x), bflo(zv.y), bfhi(zv.y), bflo(zv.z), bfhi(zv.z), bflo(zv.w), bfhi(zv.w)};
    float ss = 0.f;
    if (ml) {
      const u32x4 ov = *(const u32x4*)(proj + row * NP + PD_O + ch);
      const float o[8] = {bflo(ov.x), bfhi(ov.x), bflo(ov.y), bfhi(ov.y), bflo(ov.z), bfhi(ov.z), bflo(ov.w), bfhi(ov.w)};
#pragma unroll
      for (int i = 0; i < 8; ++i) { v[i] *= sigmoidf_(o[i]); ss += v[i] * v[i]; }
    } else {
#pragma unroll
      for (int i = 0; i < 8; ++i) { v[i] *= siluf(z[i]); ss += v[i] * v[i]; }
    }
    ss += __shfl_xor(ss, 1); ss += __shfl_xor(ss, 2); ss += __shfl_xor(ss, 4);
    const float ss16 = ss + __shfl_xor(ss, 8);
    const float rn = ml ? rsqrtf(ss * (1.f / 64.f) + 1e-6f) : rsqrtf(ss16 * (1.f / 128.f) + 1e-6f);
    float o8[8];
#pragma unroll
    for (int i = 0; i < 8; ++i) { const float gg = i < 4 ? g0[i & 3] : g1[i & 3]; o8[i] = v[i] * rn * gg * (ml ? siluf(z[i]) : 1.f); }
    u32x4 w; w.x = pack2(o8[0], o8[1]); w.y = pack2(o8[2], o8[3]); w.z = pack2(o8[4], o8[5]); w.w = pack2(o8[6], o8[7]);
    *(u32x4*)yp = w;
  }
}

DI void mlstm_task(const Params& p, int layer, int b, int h, unsigned char* smem) {
  u16* Qs = (u16*)(smem + SEQ_LDS_A); u16* Ks2 = (u16*)(smem + SEQ_LDS_B); u16* Vs2 = (u16*)(smem + SEQ_LDS_C); u16* Cst = (u16*)(smem + SEQ_LDS_S);
  float* fl = (float*)(smem + SEQ_LDS_F);
  float* bcs = fl; float* us = fl + 128; float* pms = fl + 256; float* wend = fl + 384; float* nst = fl + 512; float* npart = fl + 576; float* tmp = fl + 832;
  u16* halo = (u16*)(smem + SEQ_LDS_HALO); float* cwl = (float*)(smem + SEQ_LDS_CW);
  int tid = otid(), lane = tid & 63, w = tid >> 6, l15 = lane & 15, g = lane >> 4;
  const u16* projb = (const u16*)(p.ws + OFF_PROJ) + (size_t)b * SEQ * NP;
  const float* smb = (const float*)(p.ws + OFF_SMALL) + (size_t)b * SEQ * NSMALL;
  const float* cw = p.ml_conv_w + layer * 4 * 512; const float* cb = p.ml_conv_b + layer * 512;
  const float ib = p.ml_if_b[layer * 8 + h], fb = p.ml_if_b[layer * 8 + 4 + h];
  u16* Y = (u16*)(p.ws + OFF_H);
  const int colQ = PD_QK + h * 64, colK = PD_QK + 256 + h * 64, colV = PD_V + h * 64;
  f32x4 st[4];
#pragma unroll
  for (int nt = 0; nt < 4; ++nt) st[nt] = (f32x4){0.f, 0.f, 0.f, 0.f};
  float m_prev = 0.f;
  lds_barrier();
  if (tid < 64) nst[tid] = 0.f;
  stage_conv_w(cwl, cw, cb, h * 64, 512, tid);
  stage_conv_w(cwl + 320, cw, cb, 256 + h * 64, 512, tid);
  for (int i = tid; i < 3 * 3 * 64; i += 256) halo[i] = 0;
  RawRegs rQ, rK, rV; float iraw = 0.f, fraw = 0.f;
  raw_load(projb, colQ, 0, rQ, tid); raw_load(projb, colK, 0, rK, tid); raw_load(projb, colV, 0, rV, tid);
  if (tid < 128) { iraw = smb[(size_t)tid * NSMALL + SM_IF + h]; fraw = smb[(size_t)tid * NSMALL + SM_IF + 4 + h]; }
#pragma unroll 1
  for (int c = 0; c < 32; ++c) {
    const int t0 = c * 128;
    asm volatile("" : "+v"(tid)); lane = tid & 63; w = tid >> 6; l15 = lane & 15; g = lane >> 4;
    u16* hcur = halo + (c & 1) * 576; u16* hnext = halo + ((c + 1) & 1) * 576;
    float ip = 0.f, lf = 0.f;
    if (tid < 128) { ip = iraw + ib; const float fp = fraw + fb; lf = fminf(fp, 0.f) - __logf(1.f + __expf(-fabsf(fp))); }
    float bc = wave_scan_add(lf, lane);
    if (tid == 63) tmp[0] = bc;
    lds_barrier();
    if (w == 1) bc += tmp[0];
    const float u = tid < 128 ? ip - bc : -1e30f;
    float pm = wave_scan_max(u, lane);
    if (tid == 63) tmp[1] = pm;
    raw_store(Qs, hnext, rQ, tid); raw_store(Ks2, hnext + 192, rK, tid); raw_store(Vs2, nullptr, rV, tid);
    lds_barrier();
    if (w == 1) pm = fmaxf(pm, tmp[1]);
    if (tid < 128) { bcs[tid] = bc; us[tid] = u; pms[tid] = pm; }
    if (c + 1 < 32) {
      raw_load(projb, colQ, t0 + 128, rQ, tid);
      if (tid < 128) { iraw = smb[(size_t)(t0 + 128 + tid) * NSMALL + SM_IF + h]; fraw = smb[(size_t)(t0 + 128 + tid) * NSMALL + SM_IF + 4 + h]; }
    }
    u32x4 oQ[4], oK[4];
    conv_from_lds(Qs, hcur, cwl, nullptr, 1.f, oQ, tid);
    __builtin_amdgcn_sched_barrier(0);
    conv_from_lds(Ks2, hcur + 192, cwl + 320, nullptr, 0.125f, oK, tid);
    __builtin_amdgcn_sched_barrier(0);
    lds_barrier();
    conv_write(Qs, oQ, tid); conv_write(Ks2, oK, tid);
    state_to_lds(Cst, st, w, l15, g);
    const float blast = bcs[127];
    const float m_new = blast + fmaxf(m_prev, pms[127]);
    if (tid < 128) wend[tid] = __expf(blast - m_new + us[tid]);
    lds_barrier();
#pragma unroll 1
    for (int qt = 0; qt < 2; ++qt) {
      const int tl = 32 * w + qt * 16 + l15;
      bf16x8 qf[2];
#pragma unroll
      for (int ks = 0; ks < 2; ++ks) qf[ks] = ldfrag(Qs + tl * KLD + ks * 32 + 8 * g);
      f32x4 num[4];
#pragma unroll
      for (int d = 0; d < 4; ++d) num[d] = (f32x4){0.f, 0.f, 0.f, 0.f};
      const float bt = bcs[tl], mt = bt + fmaxf(m_prev, pms[tl]);
      float den = 0.f;
#pragma unroll 1
      for (int stl = 0; stl < 2; ++stl) {
        if (stl * 64 <= 32 * w + qt * 16 + 15) {
          f32x4 sc[4];
          qk_tile1<2>(Ks2 + stl * 64 * KLD, qf, sc, l15, g);
#pragma unroll
          for (int kt = 0; kt < 4; ++kt) {
            const f32x4 uu = *(const f32x4*)(us + stl * 64 + kt * 16 + 4 * g);
#pragma unroll
            for (int r = 0; r < 4; ++r) {
              const bool ok = stl * 64 + kt * 16 + 4 * g + r <= tl;
              const float v = ok ? sc[kt][r] * __expf(bt - mt + uu[r]) : 0.f;
              sc[kt][r] = v; den += v;
            }
          }
          pv_accum1(sc, Vs2 + stl * 64 * KLD, num, l15, g);
        }
      }
      const float wi = __expf(bt + m_prev - mt);
      float qn = 0.f;
#pragma unroll
      for (int ks = 0; ks < 2; ++ks)
#pragma unroll
        for (int j = 0; j < 8; ++j) qn += bf2f((u16)qf[ks][j]) * nst[ks * 32 + 8 * g + j];
      qn = group_sum4(qn);
      const float dn = group_sum4(den) + wi * qn;
      const float inv = __builtin_amdgcn_rcpf(fmaxf(fabsf(dn), __expf(-mt)));
      const size_t row = (size_t)b * SEQ + t0 + tl;
#pragma unroll
      for (int d = 0; d < 4; ++d) {
        f32x4 ni = (f32x4){0.f, 0.f, 0.f, 0.f};
#pragma unroll
        for (int ks = 0; ks < 2; ++ks) ni = mfma16(ldfrag(Cst + (d * 16 + l15) * KLD + ks * 32 + 8 * g), qf[ks], ni);
        const f32x4 v = (num[d] + ni * wi) * inv;
        u32x2 o; o.x = pack2(v[0], v[1]); o.y = pack2(v[2], v[3]);
        *(u32x2*)(Y + row * 1024 + Y_D + h * 64 + d * 16 + 4 * g) = o;
      }
    }
    if (c + 1 < 32) { raw_load(projb, colK, t0 + 128, rK, tid); raw_load(projb, colV, t0 + 128, rV, tid); }
    lds_barrier();
    scale_rows(Ks2, wend);
    lds_barrier();
    const float fprev = __expf(blast + m_prev - m_new);
#pragma unroll
    for (int nt = 0; nt < 4; ++nt) st[nt] *= fprev;
    state_update(Vs2, Ks2, st, w, l15, g);
    {
      const int e = tid & 63, part = tid >> 6;
      float a = 0.f;
      for (int s2 = part * 32; s2 < part * 32 + 32; ++s2) a += bf2f(Ks2[s2 * KLD + e]);
      npart[part * 64 + e] = a;
    }
    lds_barrier();
    if (tid < 64) nst[tid] = nst[tid] * fprev + npart[tid] + npart[64 + tid] + npart[128 + tid] + npart[192 + tid];
    m_prev = m_new;
  }
}

DI void compress_task(const Params& p, int layer, int b, int kv, int rb, unsigned char* smem) {
  constexpr int HLD = 136;
  u16* Hs = (u16*)smem;
  const int tid = otid(), lane = tid & 63, w = tid >> 6, l15 = lane & 15, g = lane >> 4;
  const u16* projb = (const u16*)(p.ws + OFF_PROJ) + (size_t)b * SEQ * NP + (kv ? PA_VC : PA_KC);
  const int mi = layer * 2 + kv;
  const u16* W1T = (const u16*)(p.ws + OFF_W1T) + (size_t)mi * 128 * 2048;
  const u16* W2T = (const u16*)(p.ws + OFF_W2T) + (size_t)mi * 64 * 128;
  const float* bias1 = (const float*)(p.ws + OFF_BIAS1) + mi * 16 * 128;
  f32x4 acc[2][2];
#pragma unroll
  for (int nt = 0; nt < 2; ++nt) { acc[nt][0] = (f32x4){0.f, 0.f, 0.f, 0.f}; acc[nt][1] = (f32x4){0.f, 0.f, 0.f, 0.f}; }
  int tok[2];
#pragma unroll
  for (int mt = 0; mt < 2; ++mt) { int i = rb * 32 + mt * 16 + l15; if (i > 254) i = 254; tok[mt] = 16 * i; }
#pragma unroll 4
  for (int ks = 0; ks < 64; ++ks) {
    const int j = ks >> 1, d0 = (ks & 1) * 32;
    bf16x8 af[2], wf[2];
#pragma unroll
    for (int mt = 0; mt < 2; ++mt) af[mt] = ldfrag(projb + (size_t)(tok[mt] + j) * NP + d0 + 8 * g);
#pragma unroll
    for (int nt = 0; nt < 2; ++nt) wf[nt] = ldfrag(W1T + (size_t)(w * 32 + nt * 16 + l15) * 2048 + ks * 32 + 8 * g);
#pragma unroll
    for (int nt = 0; nt < 2; ++nt)
#pragma unroll
      for (int mt = 0; mt < 2; ++mt) acc[nt][mt] = mfma16(wf[nt], af[mt], acc[nt][mt]);
  }
  lds_barrier();
#pragma unroll
  for (int nt = 0; nt < 2; ++nt) {
    const int n = w * 32 + nt * 16 + 4 * g;
    f32x4 bb = *(const f32x4*)(bias1 + n);
#pragma unroll
    for (int pc = 1; pc < 16; ++pc) bb += *(const f32x4*)(bias1 + pc * 128 + n);
#pragma unroll
    for (int mt = 0; mt < 2; ++mt) {
      const f32x4 v = acc[nt][mt] + bb;
      u32x2 o; o.x = pack2(siluf(v[0]), siluf(v[1])); o.y = pack2(siluf(v[2]), siluf(v[3]));
      *(u32x2*)(Hs + (mt * 16 + l15) * HLD + n) = o;
    }
  }
  lds_barrier();
  f32x4 acc2[2] = {(f32x4){0.f, 0.f, 0.f, 0.f}, (f32x4){0.f, 0.f, 0.f, 0.f}};
#pragma unroll
  for (int ks = 0; ks < 4; ++ks) {
    const bf16x8 wf = ldfrag(W2T + (size_t)(w * 16 + l15) * 128 + ks * 32 + 8 * g);
#pragma unroll
    for (int mt = 0; mt < 2; ++mt) acc2[mt] = mfma16(wf, ldfrag(Hs + (mt * 16 + l15) * HLD + ks * 32 + 8 * g), acc2[mt]);
  }
  u16* dst = (u16*)(p.ws + (kv ? OFF_VCMP : OFF_KCMP)) + (size_t)b * 256 * 64;
#pragma unroll
  for (int mt = 0; mt < 2; ++mt) {
    const int i = rb * 32 + mt * 16 + l15;
    u32x2 o; o.x = pack2(acc2[mt][0], acc2[mt][1]); o.y = pack2(acc2[mt][2], acc2[mt][3]);
    if (i > 254) { o.x = 0u; o.y = 0u; }
    *(u32x2*)(dst + (size_t)i * 64 + w * 16 + 4 * g) = o;
  }
}

DI void nsa_task(const Params& p, int layer, int b, int qi, unsigned char* smem) {
  u16* Ks = (u16*)smem; u16* Vs = Ks + 64 * KLD;
  float* T = (float*)(smem + 2 * 64 * KLD * 2);
  unsigned long long* selm = (unsigned long long*)(smem + 2 * 64 * KLD * 2 + 4 * 32 * 65 * 4);
  const int tid = otid(), lane = tid & 63, h = tid >> 6, l15 = lane & 15, g = lane >> 4;
  const int q0 = qi * 32;
  const u16* projb = (const u16*)(p.ws + OFF_PROJ) + (size_t)b * SEQ * NP;
  const float* smb = (const float*)(p.ws + OFF_SMALL) + (size_t)b * SEQ * NSMALL;
  const u16* kcmp = (const u16*)(p.ws + OFF_KCMP) + (size_t)b * 256 * 64;
  const u16* vcmp = (const u16*)(p.ws + OFF_VCMP) + (size_t)b * 256 * 64;
  bf16x8 qf[2][2];
#pragma unroll
  for (int qt = 0; qt < 2; ++qt)
#pragma unroll
    for (int ks = 0; ks < 2; ++ks) qf[qt][ks] = ldfrag(projb + (size_t)(q0 + qt * 16 + l15) * NP + PA_Q + h * 64 + ks * 32 + 8 * g);
  const float sc = 0.125f * 1.4426950408889634f;
  f32x4 outacc[4][2];
  AttnAcc a;
  KVRegs kr;
  const int ntc = (q0 >> 10) + 1;
  attn_init(a);
  lds_barrier();
  for (int i = tid; i < 4 * 32 * 65; i += 256) T[i] = 0.f;
  for (int j = 0; j < ntc; ++j) {
    lds_barrier();
    kv_load(kcmp, vcmp, 64, 64, j * 64, kr); kv_store(Ks, Vs, kr);
    lds_barrier();
    f32x4 s[4][2];
    auto valid = [&](int kt, int r, int qt) { return 16 * (j * 64 + kt * 16 + 4 * g + r) + 31 <= q0 + qt * 16 + l15; };
    qk_tile<2>(Ks, 0, qf, s, l15, g);
    softmax_pv(s, a, Vs, sc, l15, g, valid);
  }
  float cinv[2];
#pragma unroll
  for (int qt = 0; qt < 2; ++qt) {
    const float lt = group_sum4(a.l[qt]);
    cinv[qt] = lt > 0.f ? 1.f / lt : 0.f;
    const float gt = sigmoidf_(smb[(size_t)(q0 + qt * 16 + l15) * NSMALL + SM_G + h * 3 + 0]) * cinv[qt];
#pragma unroll
    for (int d = 0; d < 4; ++d) outacc[d][qt] = a.o[d][qt] * gt;
  }
  float carry[2] = {0.f, 0.f};
  for (int j = 0; j < ntc; ++j) {
    lds_barrier();
    kv_load(kcmp, vcmp, 64, 64, j * 64, kr); kv_store(Ks, Vs, kr);
    lds_barrier();
    f32x4 s[4][2];
    qk_tile<2>(Ks, 0, qf, s, l15, g);
#pragma unroll
    for (int qt = 0; qt < 2; ++qt) {
      float prev3 = carry[qt];
#pragma unroll
      for (int kt = 0; kt < 4; ++kt) {
        float pr[4];
#pragma unroll
        for (int r = 0; r < 4; ++r) {
          const bool ok = 16 * (j * 64 + kt * 16 + 4 * g + r) + 31 <= q0 + qt * 16 + l15;
          pr[r] = ok ? exp2_(s[kt][qt][r] * sc - a.m[qt]) * cinv[qt] : 0.f;
        }
        const float below = __shfl_up(pr[3], 16);
        const float wrap = __shfl(prev3, l15 + 48);
        const float nb = g > 0 ? below : wrap;
        T[(h * 32 + qt * 16 + l15) * 65 + j * 16 + kt * 4 + g] = (pr[0] + pr[1]) + (pr[2] + 0.5f * pr[3]) + 0.5f * nb;
        prev3 = pr[3];
      }
      carry[qt] = prev3;
    }
  }
  lds_barrier();
#pragma unroll 1
  for (int qq = 0; qq < 8; ++qq) {
    const int q = h * 8 + qq, t = q0 + q, cur = t >> 6;
    const float imp = ((T[(0 * 32 + q) * 65 + lane] + T[(1 * 32 + q) * 65 + lane]) + T[(2 * 32 + q) * 65 + lane]) + T[(3 * 32 + q) * 65 + lane];
    const float val = (lane == cur || lane == 0) ? 1e4f : (lane <= cur ? imp : -1.f);
    int rank = 0;
#pragma unroll
    for (int k = 0; k < 64; ++k) {
      const float vk = __int_as_float(__builtin_amdgcn_readlane(__float_as_int(val), k));
      rank += (vk > val || (vk == val && k < lane)) ? 1 : 0;
    }
    const unsigned long long m = __ballot(rank < 16);
    if (lane == 0) selm[q] = m;
  }
  lds_barrier();
  f32x4* park = (f32x4*)T + (h * 8) * 64 + lane;
#pragma unroll
  for (int d = 0; d < 4; ++d) { park[(d * 2 + 0) * 64] = outacc[d][0]; park[(d * 2 + 1) * 64] = outacc[d][1]; }
  unsigned long long mq[2], anym = 0ull;
#pragma unroll
  for (int qt = 0; qt < 2; ++qt) mq[qt] = selm[qt * 16 + l15];
  for (int i = 0; i < 32; ++i) anym |= selm[i];
  const int jhi = (q0 + 31) >> 6;
  attn_init(a);
  for (int j = 0; j <= jhi; ++j) {
    const bool used = (anym >> j) & 1ull;
    lds_barrier();
    if (used) { kv_load(projb + PA_KS, projb + PA_VS, NP, NP, j * 64, kr); kv_store(Ks, Vs, kr); }
    lds_barrier();
    if (!used) continue;
    f32x4 s[4][2];
    auto valid = [&](int kt, int r, int qt) { return ((mq[qt] >> j) & 1ull) && (j * 64 + kt * 16 + 4 * g + r <= q0 + qt * 16 + l15); };
    qk_tile<2>(Ks, 0, qf, s, l15, g);
    softmax_pv(s, a, Vs, sc, l15, g, valid);
  }
#pragma unroll
  for (int qt = 0; qt < 2; ++qt) {
    const float lt = group_sum4(a.l[qt]);
    const float gt = sigmoidf_(smb[(size_t)(q0 + qt * 16 + l15) * NSMALL + SM_G + h * 3 + 1]) * (lt > 0.f ? 1.f / lt : 0.f);
#pragma unroll
    for (int d = 0; d < 4; ++d) park[(d * 2 + qt) * 64] += a.o[d][qt] * gt;
  }
  attn_init(a);
  const int jlo = q0 >= 511 ? (q0 - 511) >> 6 : 0;
  for (int j = jlo; j <= jhi; ++j) {
    lds_barrier();
    kv_load(projb + PA_KW, projb + PA_VW, NP, NP, j * 64, kr); kv_store(Ks, Vs, kr);
    lds_barrier();
    f32x4 s[4][2];
    auto valid = [&](int kt, int r, int qt) { const int key = j * 64 + kt * 16 + 4 * g + r, t = q0 + qt * 16 + l15; return key <= t && key + 512 > t; };
    qk_tile<2>(Ks, 0, qf, s, l15, g);
    softmax_pv(s, a, Vs, sc, l15, g, valid);
  }
  u16* Y = (u16*)(p.ws + OFF_H);
  const float* ng = p.nsa_norm_g + layer * 64;
#pragma unroll
  for (int qt = 0; qt < 2; ++qt) {
    const int t = q0 + qt * 16 + l15;
    const float lt = group_sum4(a.l[qt]);
    const float gt = sigmoidf_(smb[(size_t)t * NSMALL + SM_G + h * 3 + 2]) * (lt > 0.f ? 1.f / lt : 0.f);
    f32x4 v[4]; float ss = 0.f;
#pragma unroll
    for (int d = 0; d < 4; ++d) { v[d] = park[(d * 2 + qt) * 64] + a.o[d][qt] * gt; ss += v[d][0] * v[d][0] + v[d][1] * v[d][1] + v[d][2] * v[d][2] + v[d][3] * v[d][3]; }
    ss = group_sum4(ss);
    const float rn = rsqrtf(ss * (1.f / 64.f) + 1e-6f);
    const size_t row = (size_t)b * SEQ + t;
#pragma unroll
    for (int d = 0; d < 4; ++d) {
      const int dd = d * 16 + 4 * g;
      const u32x2 zz = *(const u32x2*)(projb + (size_t)t * NP + PA_Z + h * 64 + dd);
      const f32x4 gg = *(const f32x4*)(ng + dd);
      u32x2 o;
      o.x = pack2(v[d][0] * rn * gg[0] * siluf(bflo(zz.x)), v[d][1] * rn * gg[1] * siluf(bfhi(zz.x)));
      o.y = pack2(v[d][2] * rn * gg[2] * siluf(bflo(zz.y)), v[d][3] * rn * gg[3] * siluf(bfhi(zz.y)));
      *(u32x2*)(Y + row * 1024 + Y_A + h * 64 + dd) = o;
    }
  }
}

DI void zero_y_cols(const Params& p, int c0, int ncols, int gtid, int gthreads) {
  u16* Y = (u16*)(p.ws + OFF_H);
  const int per_row = ncols / 8;
  for (size_t i = gtid; i < (size_t)NTOK * per_row; i += gthreads) {
    const size_t row = i / per_row; const int ch = (int)(i % per_row);
    *(u32x4*)(Y + row * 1024 + c0 + ch * 8) = (u32x4){0u, 0u, 0u, 0u};
  }
}

DI void final_norm_rows(const Params& p, int gw, int nw, int lane) {
  for (int row = gw; row < NTOK; row += nw) {
    float4* xr = (float4*)(p.out + (size_t)row * D_MODEL);
    float4 v[4]; float ss = 0.f;
#pragma unroll
    for (int i = 0; i < 4; ++i) { v[i] = xr[lane + 64 * i]; ss += v[i].x * v[i].x + v[i].y * v[i].y + v[i].z * v[i].z + v[i].w * v[i].w; }
    ss = wave_sum(ss);
    const float r = rsqrtf(ss * (1.f / D_MODEL) + 1e-6f);
    const float4* gp = (const float4*)p.final_g;
#pragma unroll
    for (int i = 0; i < 4; ++i) { const float4 gg = gp[lane + 64 * i]; float4 w; w.x = v[i].x * r * gg.x; w.y = v[i].y * r * gg.y; w.z = v[i].z * r * gg.z; w.w = v[i].w * r * gg.w; xr[lane + 64 * i] = w; }
  }
}

#ifndef DEBUG_CHECK
#define DEBUG_CHECK 0
#endif
#if DEBUG_CHECK
constexpr int NCHK = 12;
DI float block_sum(float v, float* red) {
  v = wave_sum(v);
  lds_barrier();
  if ((threadIdx.x & 63) == 0) red[threadIdx.x >> 6] = v;
  lds_barrier();
  return red[0] + red[1] + red[2] + red[3];
}
DI float block_max(float v, float* red) {
#pragma unroll
  for (int o = 32; o > 0; o >>= 1) v = fmaxf(v, __shfl_xor(v, o));
  lds_barrier();
  if ((threadIdx.x & 63) == 0) red[threadIdx.x >> 6] = v;
  lds_barrier();
  return fmaxf(fmaxf(red[0], red[1]), fmaxf(red[2], red[3]));
}
DI float bfr(float v) { return bf2f(f2bf(v)); }
struct Chk { float num[NCHK], den[NCHK]; };
DI void chk_add(Chk& c, int id, float got, float ref) { const float d = got - ref; c.num[id] += d * d; c.den[id] += ref * ref; }

DI void dbg_diff_attn(const Params& p, int layer, int b, int t, int h, Chk& c, int id, unsigned char* smem) {
  float* p1 = (float*)smem; float* p2 = p1 + 4096; float* red = p2 + 4096;
  const int tid = otid();
  const u16* proj = (const u16*)(p.ws + OFF_PROJ) + (size_t)b * SEQ * NP;
  const u16* q = proj + (size_t)t * NP + PB_Q + h * 64;
  const float scale = 0.17677669529663687f;
  float m1 = -1e30f, m2 = -1e30f;
  for (int s = tid; s <= t; s += 256) {
    const u16* k = proj + (size_t)s * NP + PB_K + h * 64;
    float a1 = 0.f, a2 = 0.f;
    for (int d = 0; d < 32; ++d) { a1 += bf2f(q[d]) * bf2f(k[d]); a2 += bf2f(q[32 + d]) * bf2f(k[32 + d]); }
    a1 *= scale; a2 *= scale; p1[s] = a1; p2[s] = a2; m1 = fmaxf(m1, a1); m2 = fmaxf(m2, a2);
  }
  m1 = block_max(m1, red); m2 = block_max(m2, red);
  float l1 = 0.f, l2 = 0.f;
  for (int s = tid; s <= t; s += 256) { const float e1 = __expf(p1[s] - m1), e2 = __expf(p2[s] - m2); p1[s] = e1; p2[s] = e2; l1 += e1; l2 += e2; }
  l1 = block_sum(l1, red); l2 = block_sum(l2, red);
  const float* lam = p.diff_lam + layer * 128;
  float s01 = 0.f, s23 = 0.f;
  for (int i = 0; i < 32; ++i) { s01 += lam[i] * lam[32 + i]; s23 += lam[64 + i] * lam[96 + i]; }
  const float lam_init = 0.8f - 0.6f * expf(-0.3f * (float)layer);
  const float lam_full = expf(s01) - expf(s23) + lam_init;
  lds_barrier();
  float o = 0.f;
  if (tid < 64) for (int s = 0; s <= t; ++s) o += (p1[s] / l1 - lam_full * p2[s] / l2) * bf2f(proj[(size_t)s * NP + PB_V + h * 64 + tid]);
  float ss = block_sum(tid < 64 ? o * o : 0.f, red);
  if (tid < 64) {
    const float z = bf2f(proj[(size_t)t * NP + PB_Z + h * 64 + tid]);
    const float ref = o * rsqrtf(ss / 64.f + 1e-6f) * p.diff_norm_g[layer * 64 + tid] * (1.f - lam_init) * (z / (1.f + expf(-z)));
    const float got = bf2f(((const u16*)(p.ws + OFF_H))[((size_t)b * SEQ + t) * 1024 + Y_B + h * 64 + tid]);
    const float d = got - ref;
    o = d * d; ss = ref * ref;
  } else { o = 0.f; ss = 0.f; }
  c.num[id] += block_sum(o, red); c.den[id] += block_sum(ss, red);
}

DI float dbg_conv(const u16* projb, int t, int pcol, const float* cw, const float* cb, int ch, int nch) {
  float a = cb[ch];
  for (int j = 0; j < 4; ++j) { const int tt = t - 3 + j; if (tt >= 0) a += cw[j * nch + ch] * bf2f(projb[(size_t)tt * NP + pcol]); }
  return a / (1.f + expf(-a));
}
constexpr int DBG_NS = 11, DBG_T = 300;
DI int dbg_sample_idx(int t) {
  const int TS[DBG_NS] = {0, 1, 2, 3, 64, 127, 128, 129, 255, 256, 299};
  for (int i = 0; i < DBG_NS; ++i) if (TS[i] == t) return i;
  return -1;
}
DI int dbg_sample_t(int i) { const int TS[DBG_NS] = {0, 1, 2, 3, 64, 127, 128, 129, 255, 256, 299}; return TS[i]; }
DI void dbg_ssd(const Params& p, int layer, int b, int gi, Chk& c, int id, unsigned char* smem) {
  float* ybuf = (float*)smem;
  float* red = ybuf + DBG_NS * 128;
  const int tid = threadIdx.x, pp = tid >> 2, nq = tid & 3;
  const u16* projb = (const u16*)(p.ws + OFF_PROJ) + (size_t)b * SEQ * NP;
  const float* smb = (const float*)(p.ws + OFF_SMALL) + (size_t)b * SEQ * NSMALL;
  const float* cw = p.ssm_conv_w + layer * 4 * 512; const float* cb = p.ssm_conv_b + layer * 512;
  lds_barrier();
  for (int hh = 0; hh < 2; ++hh) {
    const int h = gi * 2 + hh;
    const float a_h = -expf(p.ssm_a_log[layer * 4 + h]), d_h = p.ssm_d[layer * 4 + h], dtb = p.ssm_dt_bias[layer * 4 + h];
    float hst[16];
    for (int i = 0; i < 16; ++i) hst[i] = 0.f;
    for (int t = 0; t < DBG_T; ++t) {
      const float xr = smb[(size_t)t * NSMALL + SM_DT + h] + dtb;
      const float dt = xr > 20.f ? xr : log1pf(expf(xr));
      const float dA = expf(dt * a_h);
      const float xp = dbg_conv(projb, t, PC_XBC + h * 64 + pp, cw, cb, h * 64 + pp, 512);
      float y = 0.f;
      for (int i = 0; i < 16; ++i) {
        const int n = nq * 16 + i;
        const float Bn = dbg_conv(projb, t, PC_XBC + 256 + gi * 64 + n, cw, cb, 256 + gi * 64 + n, 512);
        const float Cn = dbg_conv(projb, t, PC_XBC + 384 + gi * 64 + n, cw, cb, 384 + gi * 64 + n, 512);
        hst[i] = dA * hst[i] + dt * xp * Bn;
        y += Cn * hst[i];
      }
      y += __shfl_xor(y, 1); y += __shfl_xor(y, 2);
      y += d_h * xp;
      const int si = dbg_sample_idx(t);
      if (si >= 0 && nq == 0) { const float z = bf2f(projb[(size_t)t * NP + PC_Z + h * 64 + pp]); ybuf[si * 128 + hh * 64 + pp] = y * (z / (1.f + expf(-z))); }
    }
  }
  lds_barrier();
  for (int si = 0; si < DBG_NS; ++si) {
    const float v = tid < 128 ? ybuf[si * 128 + tid] : 0.f;
    const float ss = block_sum(v * v, red);
    float e2 = 0.f, r2 = 0.f;
    if (tid < 128) {
      const float ref = v * rsqrtf(ss / 128.f + 1e-6f) * p.ssm_norm_g[layer * 256 + gi * 128 + tid];
      const float got = bf2f(((const u16*)(p.ws + OFF_H))[((size_t)b * SEQ + dbg_sample_t(si)) * 1024 + Y_C + gi * 128 + tid]);
      e2 = (got - ref) * (got - ref); r2 = ref * ref;
    }
    c.num[id] += block_sum(e2, red); c.den[id] += block_sum(r2, red);
  }
}
DI void dbg_mlstm(const Params& p, int layer, int b, int h, Chk& c, int id, unsigned char* smem) {
  float* ybuf = (float*)smem;
  float* red = ybuf + DBG_NS * 128;
  const int tid = threadIdx.x, dd = tid >> 2, eq = tid & 3;
  const u16* projb = (const u16*)(p.ws + OFF_PROJ) + (size_t)b * SEQ * NP;
  const float* smb = (const float*)(p.ws + OFF_SMALL) + (size_t)b * SEQ * NSMALL;
  const float* cw = p.ml_conv_w + layer * 4 * 512; const float* cb = p.ml_conv_b + layer * 512;
  const float ib = p.ml_if_b[layer * 8 + h], fb = p.ml_if_b[layer * 8 + 4 + h];
  lds_barrier();
  float Cst[16], nst[16];
  for (int i = 0; i < 16; ++i) { Cst[i] = 0.f; nst[i] = 0.f; }
  float m = 0.f;
  for (int t = 0; t < DBG_T; ++t) {
    const float ip = smb[(size_t)t * NSMALL + SM_IF + h] + ib, fp = smb[(size_t)t * NSMALL + SM_IF + 4 + h] + fb;
    const float lf = fminf(fp, 0.f) - log1pf(expf(-fabsf(fp)));
    const float mn = fmaxf(lf + m, ip), fs = expf(lf + m - mn), is = expf(ip - mn);
    const float vd = bf2f(projb[(size_t)t * NP + PD_V + h * 64 + dd]);
    float num = 0.f, den = 0.f;
    for (int i = 0; i < 16; ++i) {
      const int e = eq * 16 + i;
      const float qe = dbg_conv(projb, t, PD_QK + h * 64 + e, cw, cb, h * 64 + e, 512);
      const float ke = 0.125f * dbg_conv(projb, t, PD_QK + 256 + h * 64 + e, cw, cb, 256 + h * 64 + e, 512);
      Cst[i] = fs * Cst[i] + is * vd * ke; nst[i] = fs * nst[i] + is * ke;
      num += Cst[i] * qe; den += nst[i] * qe;
    }
    num += __shfl_xor(num, 1); num += __shfl_xor(num, 2); den += __shfl_xor(den, 1); den += __shfl_xor(den, 2);
    const float hv = num / fmaxf(fabsf(den), expf(-mn));
    m = mn;
    const int si = dbg_sample_idx(t);
    if (si >= 0 && eq == 0) { const float o = bf2f(projb[(size_t)t * NP + PD_O + h * 64 + dd]); ybuf[si * 64 + dd] = hv / (1.f + expf(-o)); }
  }
  lds_barrier();
  for (int si = 0; si < DBG_NS; ++si) {
    const float v = tid < 64 ? ybuf[si * 64 + tid] : 0.f;
    const float ss = block_sum(v * v, red);
    float e2 = 0.f, r2 = 0.f;
    if (tid < 64) {
      const int t = dbg_sample_t(si);
      const float z = bf2f(projb[(size_t)t * NP + PD_Z + h * 64 + tid]);
      const float ref = v * rsqrtf(ss / 64.f + 1e-6f) * p.ml_norm_g[layer * 64 + tid] * (z / (1.f + expf(-z)));
      const float got = bf2f(((const u16*)(p.ws + OFF_H))[((size_t)b * SEQ + t) * 1024 + Y_D + h * 64 + tid]);
      e2 = (got - ref) * (got - ref); r2 = ref * ref;
    }
    c.num[id] += block_sum(e2, red); c.den[id] += block_sum(r2, red);
  }
}

DI void debug_checks(const Params& p, unsigned char* smem) {
  const int tid = otid();
  float* red = (float*)(smem + 36 * 1024);
  Chk c;
  for (int i = 0; i < NCHK; ++i) { c.num[i] = 0.f; c.den[i] = 0.f; }
  const float* adap = (const float*)(p.ws + OFF_ADAP);
  const u16* H = (const u16*)(p.ws + OFF_H);
  const u16* proj = (const u16*)(p.ws + OFF_PROJ);
  const float* sm = (const float*)(p.ws + OFF_SMALL);
#if DEBUG_CHECK == 1
  {
    const int bs[2] = {0, 5}; const int ns[4] = {3, 1024 + 77, 2048 + 500, 3071};
    for (int bi = 0; bi < 2; ++bi) for (int ni = 0; ni < 4; ++ni) {
      const int b = bs[bi], n = ns[ni];
      float a = 0.f;
      for (int k = tid; k < 1024; k += 256) { const float v = p.c[b * 1024 + k]; a += (v / (1.f + expf(-v))) * p.ada_w[(size_t)k * 3072 + n]; }
      const float ref = block_sum(a, red) + p.ada_b[n];
      float got = 0.f; for (int kc = 0; kc < 8; ++kc) got += adap[(((size_t)kc * 2 + 0) * 8 + b) * 3072 + n];
      chk_add(c, 1, got, ref);
    }
  }
  {
    const int ms[3] = {1, 9000, 32767};
    const int ns[14] = {0, 300, 700, 900, 1500, 2000, 2300, 2693, 3300, 3500, 3967, 3970, 3981, 3990};
    for (int mi = 0; mi < 3; ++mi) {
      const int m = ms[mi], b = m >> 12;
      float ss = 0.f;
      for (int k = tid; k < 1024; k += 256) { const float v = p.x[(size_t)m * 1024 + k]; ss += v * v; }
      ss = block_sum(ss, red);
      const float rstd = rsqrtf(ss / 1024.f + 1e-6f);
      for (int ni = 0; ni < 14; ++ni) {
        const int n = ns[ni], col = colmap(n);
        float a = 0.f, herr = 0.f, href = 0.f;
        for (int k = tid; k < 1024; k += 256) {
          float shf = 0.f, scl = 0.f;
          for (int kc = 0; kc < 8; ++kc) { const float* ap = adap + (((size_t)kc * 2 + 0) * 8 + b) * 3072; shf += ap[k]; scl += ap[1024 + k]; }
          const float hv = p.x[(size_t)m * 1024 + k] * rstd * p.norm_g[k] * (1.f + scl) + shf;
          const float hg = bf2f(H[(size_t)m * 1024 + k]);
          herr += (hg - hv) * (hg - hv); href += hv * hv;
          a += hv * p.w_in[(size_t)k * D_IN + col];
        }
        const float ref = block_sum(a, red);
        herr = block_sum(herr, red); href = block_sum(href, red);
        if (ni == 0 && DEBUG_STAGE == 1) { c.num[3] += herr; c.den[3] += href; }
        const float got = n < NP ? bf2f(proj[(size_t)m * NP + n]) : sm[(size_t)m * NSMALL + (n - NP)];
        chk_add(c, 2, got, ref);
      }
    }
  }
#endif
#if DEBUG_CHECK == 2
  dbg_diff_attn(p, 0, 0, 5, 0, c, 4, smem);
  dbg_diff_attn(p, 0, 1, 200, 3, c, 4, smem);
  dbg_diff_attn(p, 0, 3, 1500, 2, c, 4, smem);
  dbg_diff_attn(p, 0, 7, 4095, 1, c, 4, smem);
  {
    const int ms[3] = {2, 12345, 32766}; const int ns[3] = {0, 513, 1023};
    const u16* Y = (const u16*)(p.ws + OFF_H);
    for (int mi = 0; mi < 3; ++mi) for (int ni = 0; ni < 3; ++ni) {
      const int m = ms[mi], n = ns[ni], b = m >> 12;
      float a = 0.f;
      for (int k = tid; k < 1024; k += 256) a += bf2f(Y[(size_t)m * 1024 + k]) * p.w_out[(size_t)k * 1024 + n];
      a = block_sum(a, red);
      float gate = 0.f; for (int kc = 0; kc < 8; ++kc) gate += adap[(((size_t)kc * 2 + 0) * 8 + b) * 3072 + 2048 + n];
      chk_add(c, 5, p.out[(size_t)m * 1024 + n] - p.x[(size_t)m * 1024 + n], gate * a);
    }
  }
#endif
#if DEBUG_CHECK == 3
  dbg_ssd(p, 0, 0, 0, c, 6, smem);
  dbg_ssd(p, 0, 5, 1, c, 6, smem);
  dbg_mlstm(p, 0, 0, 0, c, 7, smem);
  dbg_mlstm(p, 0, 6, 3, c, 7, smem);
#endif
  lds_barrier();
  if (tid == 0) {
    int wid_ = 0, wcls = 99;
    for (int i = 1; i < NCHK; ++i) if (c.den[i] > 0.f) {
      const float rel = sqrtf(c.num[i] / c.den[i]);
      int cls = rel >= 1.f ? 0 : (int)floorf(-log10f(fmaxf(rel, 1e-9f)));
      if (cls > 9) cls = 9;
      if (!(rel == rel)) cls = 0;
      if (cls < wcls) { wcls = cls; wid_ = i; }
    }
    p.out[0] = 1e5f * ((float)wid_ + 0.1f * (float)wcls);
  }
}
#endif

constexpr int HALF_LDS = 76 * 1024;
constexpr int SMEM_BYTES = 2 * HALF_LDS;
__global__ void __launch_bounds__(512, 2) fwd_megakernel(Params p) {
  cg::grid_group grid = cg::this_grid();
  __shared__ __attribute__((aligned(16))) unsigned char smem[SMEM_BYTES];
  const int half = __builtin_amdgcn_readfirstlane(threadIdx.x >> 8);
  unsigned char* hsm = smem + half * HALF_LDS;
  const int G = gridDim.x, bid = blockIdx.x;
  const int slot = bid * 2 + half, NS = 2 * G;
  for (int t = slot; t < ((T0_TOTAL + NS - 1) / NS) * NS; t += NS) phase0_task(p, t < T0_TOTAL ? t : T0_TOTAL - 1, hsm);
  grid.sync();
  for (int layer = 0; layer < 2; ++layer) {
    const float* xin = layer == 0 ? p.x : p.out;
    for (int t = slot; t < ((NTOK / 64 + NS - 1) / NS) * NS; t += NS) phase1_task(p, layer, xin, t < NTOK / 64 ? t : NTOK / 64 - 1, hsm);
    grid.sync();
    for (int t = bid; t < (NTOK / 256) * (NPAD / 256); t += G) gemm_inproj_tile(p, layer, t, smem);
    grid.sync();
#if DEBUG_CHECK == 1
    if (bid == 0 && half == 0) debug_checks(p, smem);
    return;
#endif
    if (bid < 16) ssd_task(p, layer, slot >> 2, slot & 3, hsm);
    else if (bid < 32) mlstm_task(p, layer, (slot - 32) >> 2, (slot - 32) & 3, hsm);
    else {
      const int NA = NS - 64;
      for (int u = slot - 64; u < ((1024 + 128 + NA - 1) / NA) * NA; u += NA) {
        const int uu = u < 1024 + 128 ? u : (1024 + 128 - 2 + (u & 1));
        if (uu < 1024) { const int qb = 31 - (uu >> 5), bh = uu & 31; diff_attn_task(p, layer, bh >> 2, bh & 3, qb, hsm); }
        else { const int v = uu - 1024; compress_task(p, layer, v >> 4, (v >> 3) & 1, v & 7, hsm); }
      }
    }
    grid.sync();
    for (int t = slot; t < NTOK / 64; t += NS) seq_fix_rows(p, layer, t * 64, 64);
    for (int u = slot; u < ((1024 + NS - 1) / NS) * NS; u += NS) { const int uu = u < 1024 ? u : (1024 - 2 + (u & 1)); nsa_task(p, layer, uu & 7, 127 - (uu >> 3), hsm); }
    grid.sync();
    for (int t = bid; t < (NTOK / 256) * 4; t += G) gemm_outproj_tile(p, layer, xin, p.out, t, smem);
    grid.sync();
#if DEBUG_CHECK >= 2
    if (bid == 0 && half == 0) debug_checks(p, smem);
    return;
#endif
  }
  { const int t5 = otid512(); final_norm_rows(p, bid * 8 + (t5 >> 6), G * 8, t5 & 63); }
}

extern "C" void kernel_launch(void* const* d_in, const int* in_sizes, int n_in, void* d_out, int out_size, void* d_ws, size_t ws_size,
                              hipStream_t stream) {
  static int grid_blocks = 0;
  if (!grid_blocks) {
    int dev = 0, cus = 0, per_cu = 0;
    (void)hipGetDevice(&dev);
    (void)hipDeviceGetAttribute(&cus, hipDeviceAttributeMultiprocessorCount, dev);
    (void)hipOccupancyMaxActiveBlocksPerMultiprocessor(&per_cu, fwd_megakernel, 512, 0);
    if (per_cu > 1) per_cu = 1;
    if (per_cu < 1) per_cu = 1;
    grid_blocks = cus * per_cu;
  }
  if (grid_blocks < 64 || (grid_blocks & 3)) { fprintf(stderr, "grid too small: %d\n", grid_blocks); return; }
  if (ws_size < WS_NEEDED) { fprintf(stderr, "workspace too small: %zu < %zu\n", ws_size, WS_NEEDED); return; }
  Params p{};
  const float** pp = (const float**)&p;
  for (int i = 0; i < 26; ++i) pp[i] = (const float*)d_in[i];
  p.out = (float*)d_out; p.ws = (unsigned char*)d_ws;
  void* args[] = {&p};
  hipError_t e = hipLaunchCooperativeKernel((void*)fwd_megakernel, dim3(grid_blocks), dim3(512), args, 0, stream);
  if (e != hipSuccess) fprintf(stderr, "cooperative launch failed: %s (grid %d)\n", hipGetErrorString(e), grid_blocks);
}
```

```cpp
#include <hip/hip_runtime.h>
#include <hip/hip_cooperative_groups.h>
#include <cstdio>
#include <cstdint>
#define DEBUG_CHECK 0
#define DEBUG_STAGE 1
#define REP_P1 1
#define REP_P2 1
#define REP_SEQ 1
#define REP_DIFF 1
#define REP_NSA 1
#define REP_P4 1
#define REP_P0 1
namespace cg = cooperative_groups;

typedef unsigned short u16;
typedef short bf16x8 __attribute__((ext_vector_type(8)));
typedef short s16x4 __attribute__((ext_vector_type(4)));
typedef float f32x4 __attribute__((ext_vector_type(4)));
typedef float f32x2 __attribute__((ext_vector_type(2)));
typedef unsigned u32x4 __attribute__((ext_vector_type(4)));
typedef unsigned u32x2 __attribute__((ext_vector_type(2)));
typedef __bf16 bf16x2_t __attribute__((ext_vector_type(2)));
#define DI __device__ __forceinline__
#define LDSP __attribute__((address_space(3)))

constexpr int D_MODEL = 1024, BATCH = 8, SEQ = 4096, NTOK = BATCH * SEQ;
constexpr int D_IN = 3992;
constexpr int NP = 3968, NPAD = 4096, NSMALL = 32;
constexpr int PA_Q = 0, PA_KC = 256, PA_VC = 320, PA_KS = 384, PA_VS = 448, PA_KW = 512, PA_VW = 576, PA_Z = 640;
constexpr int PB_Q = 896, PB_K = 1152, PB_V = 1408, PB_Z = 1664;
constexpr int PC_Z = 1920, PC_XBC = 2176;
constexpr int PD_QK = 2688, PD_V = 3200, PD_O = 3456, PD_Z = 3712;
constexpr int SM_G = 0, SM_DT = 12, SM_IF = 16;
constexpr int Y_A = 0, Y_B = 256, Y_C = 512, Y_D = 768;

constexpr size_t MiB = 1024 * 1024;
constexpr size_t OFF_WINT = 0;
constexpr size_t OFF_WOUTT = 16 * MiB;
constexpr size_t OFF_W1T = 20 * MiB;
constexpr size_t OFF_W2T = 22 * MiB;
constexpr size_t OFF_BIAS1 = 22 * MiB + 64 * 1024;
constexpr size_t OFF_ADAP = 22 * MiB + 128 * 1024;
constexpr size_t OFF_KCMP = 24 * MiB;
constexpr size_t OFF_VCMP = 24 * MiB + 256 * 1024;
constexpr size_t OFF_CNT = 29 * MiB;
constexpr size_t OFF_SMALL = 25 * MiB;
constexpr size_t OFF_SSQ = 29 * MiB;
constexpr size_t OFF_H = 32 * MiB;
constexpr size_t OFF_PROJ = 96 * MiB;
constexpr size_t WS_NEEDED = 96 * MiB + (size_t)NTOK * NP * 2;

struct Params {
  const float* x; const float* c; const float* norm_g; const float* ada_w; const float* ada_b;
  const float* w_in; const float* w_out;
  const float* nsa_cmp_pos; const float* nsa_ck_w1; const float* nsa_ck_w2; const float* nsa_cv_w1; const float* nsa_cv_w2; const float* nsa_norm_g;
  const float* diff_lam; const float* diff_norm_g;
  const float* ssm_conv_w; const float* ssm_conv_b; const float* ssm_dt_bias; const float* ssm_a_log; const float* ssm_d; const float* ssm_norm_g;
  const float* ml_conv_w; const float* ml_conv_b; const float* ml_if_b; const float* ml_norm_g; const float* final_g;
  float* out; unsigned char* ws;
};

DI void lds_barrier() { asm volatile("s_waitcnt lgkmcnt(0)" ::: "memory"); __builtin_amdgcn_s_barrier(); asm volatile("" ::: "memory"); }
DI int otid() { int t = threadIdx.x & 255; asm volatile("" : "+v"(t)); return t; }
DI int otid512() { int t = threadIdx.x; asm volatile("" : "+v"(t)); return t; }
DI unsigned pack2(float a, float b) { f32x2 v = {a, b}; bf16x2_t r = __builtin_convertvector(v, bf16x2_t); return __builtin_bit_cast(unsigned, r); }
DI u16 f2bf(float a) { return (u16)(pack2(a, 0.f) & 0xffffu); }
DI float bf2f(u16 h) { return __uint_as_float(((unsigned)h) << 16); }
DI float bflo(unsigned u) { return __uint_as_float(u << 16); }
DI float bfhi(unsigned u) { return __uint_as_float(u & 0xffff0000u); }
DI f32x4 mfma16(bf16x8 a, bf16x8 b, f32x4 c) { return __builtin_amdgcn_mfma_f32_16x16x32_bf16(a, b, c, 0, 0, 0); }
DI float wave_sum(float v) {
#pragma unroll
  for (int o = 32; o > 0; o >>= 1) v += __shfl_xor(v, o);
  return v;
}
DI float siluf(float v) { return v * __builtin_amdgcn_rcpf(1.f + __expf(-v)); }
DI float sigmoidf_(float v) { return __builtin_amdgcn_rcpf(1.f + __expf(-v)); }
DI float exp2_(float v) { return __builtin_amdgcn_exp2f(v); }
DI s16x4 tr_read(const u16* p) { return __builtin_amdgcn_ds_read_tr16_b64_v4i16((LDSP s16x4*)p); }
DI bf16x8 cat4(s16x4 a, s16x4 b) { bf16x8 r; r[0] = a[0]; r[1] = a[1]; r[2] = a[2]; r[3] = a[3]; r[4] = b[0]; r[5] = b[1]; r[6] = b[2]; r[7] = b[3]; return r; }
DI bf16x8 ldfrag(const u16* p) { return *(const bf16x8*)p; }

DI int colmap(int n) {
  if (n < 640) return n;
  if (n < 896) return 652 + (n - 640);
  if (n < 1920) return 908 + (n - 896);
  if (n < 2688) return 1932 + (n - 1920);
  if (n < 3456) return 2704 + (n - 2688);
  if (n < 3968) return 3480 + (n - 3456);
  if (n < 3980) return 640 + (n - 3968);
  if (n < 3984) return 2700 + (n - 3980);
  if (n < 3992) return 3472 + (n - 3984);
  return -1;
}

DI void tconv_tile(const float* __restrict__ src, int ldsrc, int k0, int n0, u16* __restrict__ dst, int ldd, bool use_map, unsigned char* smem) {
  float* tile = (float*)smem;
  const int tid = otid();
  lds_barrier();
  {
    const int nn = tid & 63; int col = n0 + nn; if (use_map) col = colmap(col);
#pragma unroll
    for (int i = 0; i < 16; ++i) { const int kk = i * 4 + (tid >> 6); tile[kk * 65 + nn] = col >= 0 ? src[(size_t)(k0 + kk) * ldsrc + col] : 0.f; }
  }
  lds_barrier();
#pragma unroll
  for (int i = 0; i < 2; ++i) {
    const int item = tid + 256 * i, nn = item >> 3, kc = item & 7;
    u32x4 w;
    w.x = pack2(tile[(kc * 8 + 0) * 65 + nn], tile[(kc * 8 + 1) * 65 + nn]);
    w.y = pack2(tile[(kc * 8 + 2) * 65 + nn], tile[(kc * 8 + 3) * 65 + nn]);
    w.z = pack2(tile[(kc * 8 + 4) * 65 + nn], tile[(kc * 8 + 5) * 65 + nn]);
    w.w = pack2(tile[(kc * 8 + 6) * 65 + nn], tile[(kc * 8 + 7) * 65 + nn]);
    *(u32x4*)(dst + (size_t)(n0 + nn) * ldd + k0 + kc * 8) = w;
  }
}

constexpr int T0_WIN = 2 * 16 * 64, T0_WOUT = 2 * 16 * 16, T0_W1 = 4 * 32 * 2, T0_W2 = 4 * 2, T0_ADA = 2 * 12 * 8, T0_B1 = 64;
constexpr int T0_TOTAL = T0_WIN + T0_WOUT + T0_W1 + T0_W2 + T0_ADA + T0_B1;

DI void phase0_task(const Params& p, int t, unsigned char* smem) {
  const int tid = otid();
  if (t < T0_WIN) {
    const int l = t / 1024, r = t % 1024, kt = r / 64, nt = r % 64;
    tconv_tile(p.w_in + (size_t)l * D_MODEL * D_IN, D_IN, kt * 64, nt * 64, (u16*)(p.ws + OFF_WINT) + (size_t)l * NPAD * 1024, 1024, true, smem);
    return;
  }
  t -= T0_WIN;
  if (t < T0_WOUT) {
    const int l = t / 256, r = t % 256, kt = r / 16, nt = r % 16;
    tconv_tile(p.w_out + (size_t)l * 1024 * 1024, 1024, kt * 64, nt * 64, (u16*)(p.ws + OFF_WOUTT) + (size_t)l * 1024 * 1024, 1024, false, smem);
    return;
  }
  t -= T0_WOUT;
  if (t < T0_W1) {
    const int m = t / 64, r = t % 64, kt = r / 2, nt = r % 2, l = m >> 1, kv = m & 1;
    const float* src = (kv ? p.nsa_cv_w1 : p.nsa_ck_w1) + (size_t)l * 2048 * 128;
    tconv_tile(src, 128, kt * 64, nt * 64, (u16*)(p.ws + OFF_W1T) + (size_t)m * 128 * 2048, 2048, false, smem);
    return;
  }
  t -= T0_W1;
  if (t < T0_W2) {
    const int m = t / 2, kt = t % 2, l = m >> 1, kv = m & 1;
    const float* src = (kv ? p.nsa_cv_w2 : p.nsa_ck_w2) + (size_t)l * 128 * 64;
    tconv_tile(src, 64, kt * 64, 0, (u16*)(p.ws + OFF_W2T) + (size_t)m * 64 * 128, 128, false, smem);
    return;
  }
  t -= T0_W2;
  if (t < T0_ADA) {
    const int l = t / 96, r = t % 96, nc = r / 8, kc = r % 8;
    float* cact = (float*)smem;
    lds_barrier();
    for (int i = tid; i < 1024; i += 256) { const int b = i >> 7, kk = i & 127; const float v = p.c[b * 1024 + kc * 128 + kk]; cact[i] = siluf(v); }
    lds_barrier();
    const int n = nc * 256 + tid;
    float acc[8];
#pragma unroll
    for (int b = 0; b < 8; ++b) acc[b] = 0.f;
    const float* w = p.ada_w + ((size_t)l * 1024 + kc * 128) * 3072 + n;
#pragma unroll 16
    for (int kk = 0; kk < 128; ++kk) {
      const float wv = w[(size_t)kk * 3072];
#pragma unroll
      for (int b = 0; b < 8; ++b) acc[b] += cact[b * 128 + kk] * wv;
    }
    float* adap = (float*)(p.ws + OFF_ADAP);
    const float bias = kc == 0 ? p.ada_b[l * 3072 + n] : 0.f;
#pragma unroll
    for (int b = 0; b < 8; ++b) adap[(((size_t)kc * 2 + l) * 8 + b) * 3072 + n] = acc[b] + bias;
    return;
  }
  t -= T0_ADA;
  {
    const int m = t >> 4, kc = t & 15, l = m >> 1, kv = m & 1;
    const float* w1 = (kv ? p.nsa_cv_w1 : p.nsa_ck_w1) + (size_t)l * 2048 * 128;
    const float* pos = p.nsa_cmp_pos + (size_t)l * 2048;
    const int n = tid & 127, half = tid >> 7;
    float acc = 0.f;
    const int k0 = kc * 128 + half * 64;
#pragma unroll 16
    for (int k = 0; k < 64; ++k) acc += pos[k0 + k] * w1[(size_t)(k0 + k) * 128 + n];
    float* red = (float*)smem;
    lds_barrier();
    red[tid] = acc;
    lds_barrier();
    if (tid < 128) ((float*)(p.ws + OFF_BIAS1))[(m * 16 + kc) * 128 + tid] = red[tid] + red[tid + 128];
  }
}

DI void phase1_task(const Params& p, int layer, const float* xin, int grp, unsigned char* smem) {
  const int tid = otid(), lane = tid & 63, wid = tid >> 6;
  const int b = grp >> 6;
  float* mul = (float*)smem;
  float* sh = mul + 1024;
  const float* adap = (const float*)(p.ws + OFF_ADAP);
  lds_barrier();
  for (int c = tid; c < 1024; c += 256) {
    float s0 = 0.f, s1 = 0.f;
#pragma unroll
    for (int kc = 0; kc < 8; ++kc) { const float* a = adap + (((size_t)kc * 2 + layer) * 8 + b) * 3072; s0 += a[c]; s1 += a[1024 + c]; }
    mul[c] = p.norm_g[layer * 1024 + c] * (1.f + s1); sh[c] = s0;
  }
  lds_barrier();
  u16* H = (u16*)(p.ws + OFF_H);
#pragma unroll 1
  for (int it = 0; it < 4; ++it) {
    float4 v[4][4]; float ss[4];
#pragma unroll
    for (int j = 0; j < 4; ++j) {
      const int row = grp * 64 + wid * 16 + it * 4 + j;
      const float4* xr = (const float4*)(xin + (size_t)row * D_MODEL);
#pragma unroll
      for (int i = 0; i < 4; ++i) v[j][i] = xr[lane + 64 * i];
    }
#pragma unroll
    for (int j = 0; j < 4; ++j) {
      float a = 0.f;
#pragma unroll
      for (int i = 0; i < 4; ++i) a += v[j][i].x * v[j][i].x + v[j][i].y * v[j][i].y + v[j][i].z * v[j][i].z + v[j][i].w * v[j][i].w;
      ss[j] = wave_sum(a);
    }
#pragma unroll
    for (int j = 0; j < 4; ++j) {
      const int row = grp * 64 + wid * 16 + it * 4 + j;
      const float r = rsqrtf(ss[j] * (1.f / D_MODEL) + 1e-6f);
#pragma unroll
      for (int i = 0; i < 4; ++i) {
        const int c = (lane + 64 * i) * 4;
        u32x2 w;
        w.x = pack2(v[j][i].x * r * mul[c] + sh[c], v[j][i].y * r * mul[c + 1] + sh[c + 1]);
        w.y = pack2(v[j][i].z * r * mul[c + 2] + sh[c + 2], v[j][i].w * r * mul[c + 3] + sh[c + 3]);
        *(u32x2*)(H + (size_t)row * 1024 + c) = w;
      }
    }
  }
}

namespace g8 {
constexpr int BM = 256, BK = 64, HALF = 128, HT = HALF * BK;
constexpr int LDS_BYTES = 8 * HT * 2;
DI int lds_byte(int r, int c) { const int st = (r >> 4) * 2 + (c >> 5), rr = r & 15, cc = c & 31, ob = rr * 64 + cc * 2; return st * 1024 + (ob ^ (((ob >> 9) & 1) << 5)); }
DI void stage_rc(int b, int& R, int& C) { const int st = b / 1024, sb = b % 1024, swz = sb ^ (((sb >> 9) & 1) << 5); R = (st >> 1) * 16 + swz / 64; C = (st & 1) * 32 + (swz % 64) / 2; }

DI void kloop(const u16* __restrict__ A, const u16* __restrict__ Bt, int K, int brow, int bcol, unsigned char* smem, f32x4 (&acc)[2][2][4][2]) {
  u16* shm = (u16*)smem;
  const int tid = otid512();
#define SA(b, h) (shm + ((b) * 2 + (h)) * HT)
#define SB(b, h) (shm + (4 + (b) * 2 + (h)) * HT)
#define STAGE(P, BASE, br, kt) do { const u16* _gb = BASE + ((long)(br) * K + (long)(kt) * BK); \
      __builtin_amdgcn_global_load_lds((const unsigned*)(_gb + soff0), (LDSP unsigned*)((LDSP char*)(P) + tid * 16), 16, 0, 0); \
      __builtin_amdgcn_global_load_lds((const unsigned*)(_gb + soff1), (LDSP unsigned*)((LDSP char*)(P) + tid * 16 + 8192), 16, 0, 0); } while (0)
#define LDA(dst, b, h) _Pragma("unroll") for (int m = 0; m < 4; ++m) _Pragma("unroll") for (int k = 0; k < 2; ++k) \
    dst[m][k] = *reinterpret_cast<const bf16x8*>((const char*)SA(b, h) + lds_byte(wr * 64 + m * 16 + fr, k * 32 + fq * 8))
#define LDB(dst, b, h) _Pragma("unroll") for (int n = 0; n < 2; ++n) _Pragma("unroll") for (int k = 0; k < 2; ++k) \
    dst[n][k] = *reinterpret_cast<const bf16x8*>((const char*)SB(b, h) + lds_byte(wc * 32 + n * 16 + fr, k * 32 + fq * 8))
#define MMA(ai, bj, At_, Bt_) do { __builtin_amdgcn_s_setprio(1); \
    _Pragma("unroll") for (int m = 0; m < 4; ++m) _Pragma("unroll") for (int n = 0; n < 2; ++n) _Pragma("unroll") for (int k = 0; k < 2; ++k) \
      acc[ai][bj][m][n] = __builtin_amdgcn_mfma_f32_16x16x32_bf16(Bt_[n][k], At_[m][k], acc[ai][bj][m][n], 0, 0, 0); \
    __builtin_amdgcn_s_setprio(0); } while (0)
#define WAIT_V(n) asm volatile("s_waitcnt vmcnt(" #n ")" ::: "memory")
#define WAIT_L(n) asm volatile("s_waitcnt lgkmcnt(" #n ")" ::: "memory")
#define BAR __builtin_amdgcn_s_barrier()
#define SCHED __builtin_amdgcn_sched_barrier(0)
  const int wid = __builtin_amdgcn_readfirstlane(tid >> 6), lane = tid & 63, wr = wid >> 2, wc = wid & 3, fr = lane & 15, fq = lane >> 4;
#pragma unroll
  for (int a = 0; a < 2; ++a)
#pragma unroll
    for (int b = 0; b < 2; ++b)
#pragma unroll
      for (int m = 0; m < 4; ++m) { acc[a][b][m][0] = (f32x4){0.f, 0.f, 0.f, 0.f}; acc[a][b][m][1] = (f32x4){0.f, 0.f, 0.f, 0.f}; }
  bf16x8 At[4][2], B0[2][2], B1[2][2];
  const int nt = K / BK;
  int soff0, soff1;
  { int r_, c_; stage_rc(tid * 16, r_, c_); soff0 = r_ * K + c_; stage_rc(tid * 16 + 8192, r_, c_); soff1 = r_ * K + c_; }
  STAGE(SB(0, 0), Bt, bcol, 0); STAGE(SA(0, 0), A, brow, 0);
  STAGE(SB(0, 1), Bt, bcol + HALF, 0); STAGE(SA(0, 1), A, brow + HALF, 0);
  if (wr == 1) BAR;
  WAIT_V(4); BAR;
  STAGE(SB(1, 0), Bt, bcol, 1); STAGE(SA(1, 0), A, brow, 1); STAGE(SB(1, 1), Bt, bcol + HALF, 1);
  WAIT_V(6); BAR;
#pragma unroll 1
  for (int t = 0; t < nt - 2; t += 2) {
    asm volatile("" : "+v"(soff0), "+v"(soff1));
    LDB(B0, 0, 0); SCHED; LDA(At, 0, 0); STAGE(SA(1, 1), A, brow + HALF, t + 1);
    WAIT_L(8); BAR; WAIT_L(0); MMA(0, 0, At, B0); BAR; SCHED;
    LDB(B1, 0, 1); STAGE(SB(0, 0), Bt, bcol, t + 2);
    BAR; WAIT_L(0); MMA(0, 1, At, B1); BAR;
    LDA(At, 0, 1); STAGE(SA(0, 0), A, brow, t + 2);
    BAR; WAIT_L(0); MMA(1, 0, At, B0); BAR; SCHED;
    STAGE(SB(0, 1), Bt, bcol + HALF, t + 2);
    WAIT_V(6); BAR; MMA(1, 1, At, B1); BAR;
    LDB(B0, 1, 0); SCHED; LDA(At, 1, 0); STAGE(SA(0, 1), A, brow + HALF, t + 2);
    WAIT_L(8); BAR; WAIT_L(0); MMA(0, 0, At, B0); BAR; SCHED;
    LDB(B1, 1, 1); STAGE(SB(1, 0), Bt, bcol, t + 3);
    BAR; WAIT_L(0); MMA(0, 1, At, B1); BAR;
    LDA(At, 1, 1); STAGE(SA(1, 0), A, brow, t + 3);
    BAR; WAIT_L(0); MMA(1, 0, At, B0); BAR; SCHED;
    STAGE(SB(1, 1), Bt, bcol + HALF, t + 3);
    WAIT_V(6); BAR; MMA(1, 1, At, B1); BAR;
  }
  { LDB(B0, 0, 0); LDA(At, 0, 0); STAGE(SA(1, 1), A, brow + HALF, nt - 1);
    BAR; WAIT_L(0); MMA(0, 0, At, B0); BAR;
    LDB(B1, 0, 1); BAR; WAIT_L(0); MMA(0, 1, At, B1); BAR;
    LDA(At, 0, 1); WAIT_V(4); BAR; WAIT_L(0); MMA(1, 0, At, B0); MMA(1, 1, At, B1); BAR; }
  { LDB(B0, 1, 0); LDA(At, 1, 0); WAIT_V(2); BAR; WAIT_L(0); MMA(0, 0, At, B0); BAR;
    LDB(B1, 1, 1); WAIT_V(0); BAR; WAIT_L(0); MMA(0, 1, At, B1); BAR;
    LDA(At, 1, 1); BAR; WAIT_L(0); MMA(1, 0, At, B0); MMA(1, 1, At, B1); BAR; }
  if (wr == 0) BAR;
#undef SA
#undef SB
#undef STAGE
#undef LDA
#undef LDB
#undef MMA
#undef WAIT_V
#undef WAIT_L
#undef BAR
#undef SCHED
}
DI void tile_map(int wgid, int nM, int nN, int& pm, int& pn) {
  const int nwg = nM * nN, NXCD = 8, WGM = 8;
  { const int q = nwg / NXCD, r = nwg % NXCD, xcd = wgid % NXCD, off = wgid / NXCD; wgid = (xcd < r ? xcd * (q + 1) : r * (q + 1) + (xcd - r) * q) + off; }
  const int nig = WGM * nN, gid = wgid / nig, fm = gid * WGM, gsz = (nM - fm) < WGM ? (nM - fm) : WGM;
  pm = fm + ((wgid % nig) % gsz); pn = (wgid % nig) / gsz;
}
}

DI void gemm_inproj_tile(const Params& p, int layer, int tile, unsigned char* smem) {
  int pm, pn; g8::tile_map(tile, NTOK / 256, NPAD / 256, pm, pn);
  const int brow = pm * 256, bcol = pn * 256;
  f32x4 acc[2][2][4][2];
  g8::kloop((const u16*)(p.ws + OFF_H), (const u16*)(p.ws + OFF_WINT) + (size_t)layer * NPAD * 1024, 1024, brow, bcol, smem, acc);
  const int tid = otid512(), wid = __builtin_amdgcn_readfirstlane(tid >> 6), lane = tid & 63, wr = wid >> 2, wc = wid & 3, fr = lane & 15, fq = lane >> 4;
  u16* proj = (u16*)(p.ws + OFF_PROJ);
  if (pn == 15 && wc == 0) {
    float* sm = (float*)(p.ws + OFF_SMALL);
#pragma unroll
    for (int ai = 0; ai < 2; ++ai)
#pragma unroll
      for (int m = 0; m < 4; ++m)
#pragma unroll
        for (int n = 0; n < 2; ++n) {
          const int mr = brow + ai * 128 + wr * 64 + m * 16 + fr;
          *(f32x4*)(sm + (size_t)mr * NSMALL + n * 16 + 4 * fq) = acc[ai][1][m][n];
        }
  }
  constexpr int CLD = 264;
  u16* Cs = (u16*)smem;
#pragma unroll
  for (int ai = 0; ai < 2; ++ai) {
    lds_barrier();
#pragma unroll
    for (int bj = 0; bj < 2; ++bj)
#pragma unroll
      for (int m = 0; m < 4; ++m)
#pragma unroll
        for (int n = 0; n < 2; ++n) {
          const f32x4 v = acc[ai][bj][m][n];
          u32x2 w; w.x = pack2(v[0], v[1]); w.y = pack2(v[2], v[3]);
          *(u32x2*)(Cs + (wr * 64 + m * 16 + fr) * CLD + bj * 128 + wc * 32 + n * 16 + 4 * fq) = w;
        }
    lds_barrier();
#pragma unroll
    for (int i = 0; i < 8; ++i) {
      const int id = tid + 512 * i, row = id >> 5, ch = id & 31;
      if (bcol + ch * 8 < NP) *(u32x4*)(proj + (size_t)(brow + ai * 128 + row) * NP + bcol + ch * 8) = *(const u32x4*)(Cs + row * CLD + ch * 8);
    }
  }
  asm volatile("s_waitcnt vmcnt(0)" ::: "memory");
  lds_barrier();
}

DI void gemm_outproj_tile(const Params& p, int layer, const float* xin, float* xout, int tile, unsigned char* smem) {
  int pm, pn; g8::tile_map(tile, NTOK / 256, 4, pm, pn);
  const int brow = pm * 256, bcol = pn * 256;
  f32x4 acc[2][2][4][2];
  g8::kloop((const u16*)(p.ws + OFF_H), (const u16*)(p.ws + OFF_WOUTT) + (size_t)layer * 1024 * 1024, 1024, brow, bcol, smem, acc);
  const int tid = otid512(), wid = __builtin_amdgcn_readfirstlane(tid >> 6), lane = tid & 63, wr = wid >> 2, wc = wid & 3, fr = lane & 15, fq = lane >> 4;
  const int b = brow >> 12;
  const float* adap = (const float*)(p.ws + OFF_ADAP);
  constexpr int CLD = 132;
  float* Cs = (float*)smem;
#pragma unroll
  for (int ai = 0; ai < 2; ++ai)
#pragma unroll
    for (int bj = 0; bj < 2; ++bj) {
      lds_barrier();
#pragma unroll
      for (int m = 0; m < 4; ++m)
#pragma unroll
        for (int n = 0; n < 2; ++n) *(f32x4*)(Cs + (wr * 64 + m * 16 + fr) * CLD + wc * 32 + n * 16 + 4 * fq) = acc[ai][bj][m][n];
      lds_barrier();
      const int ch = tid & 31, nc = bcol + bj * 128 + ch * 4;
      f32x4 gt = {0.f, 0.f, 0.f, 0.f};
#pragma unroll
      for (int kc = 0; kc < 8; ++kc) gt += *(const f32x4*)(adap + (((size_t)kc * 2 + layer) * 8 + b) * 3072 + 2048 + nc);
#pragma unroll
      for (int i = 0; i < 8; ++i) {
        const int row = (tid >> 5) + 16 * i;
        const size_t off = (size_t)(brow + ai * 128 + row) * 1024 + nc;
        const f32x4 xv = *(const f32x4*)(xin + off);
        *(f32x4*)(xout + off) = xv + gt * *(const f32x4*)(Cs + row * CLD + ch * 4);
      }
    }
  asm volatile("s_waitcnt vmcnt(0)" ::: "memory");
  lds_barrier();
}

constexpr int KLD = 72;
struct KVRegs { u32x4 k[2], v[2]; };
DI void kv_load(const u16* kbase, const u16* vbase, int ldk, int ldv, int key0, KVRegs& r) {
  const int tid = otid();
#pragma unroll
  for (int i = 0; i < 2; ++i) {
    const int id = tid + 256 * i, row = id >> 3, ch = id & 7;
    r.k[i] = *(const u32x4*)(kbase + (size_t)(key0 + row) * ldk + ch * 8);
    r.v[i] = *(const u32x4*)(vbase + (size_t)(key0 + row) * ldv + ch * 8);
  }
}
DI void kv_store(u16* Ks, u16* Vs, const KVRegs& r) {
  const int tid = otid();
#pragma unroll
  for (int i = 0; i < 2; ++i) {
    const int id = tid + 256 * i, row = id >> 3, ch = id & 7;
    *(u32x4*)(Ks + row * KLD + ch * 8) = r.k[i];
    *(u32x4*)(Vs + row * KLD + ch * 8) = r.v[i];
  }
}
struct AttnAcc { f32x4 o[4][2]; float m[2], l[2]; };
DI void attn_init(AttnAcc& a) {
#pragma unroll
  for (int d = 0; d < 4; ++d) { a.o[d][0] = (f32x4){0.f, 0.f, 0.f, 0.f}; a.o[d][1] = (f32x4){0.f, 0.f, 0.f, 0.f}; }
  a.m[0] = a.m[1] = -1e30f; a.l[0] = a.l[1] = 0.f;
}
template <int NKS>
DI void qk_tile(const u16* Ks, int dofs, const bf16x8 (&qf)[2][NKS], f32x4 (&s)[4][2], int l15, int g) {
#pragma unroll
  for (int kt = 0; kt < 4; ++kt) {
    s[kt][0] = (f32x4){0.f, 0.f, 0.f, 0.f}; s[kt][1] = (f32x4){0.f, 0.f, 0.f, 0.f};
#pragma unroll
    for (int ks = 0; ks < NKS; ++ks) {
      const bf16x8 a = ldfrag(Ks + (kt * 16 + l15) * KLD + dofs + ks * 32 + 8 * g);
      s[kt][0] = mfma16(a, qf[0][ks], s[kt][0]);
      s[kt][1] = mfma16(a, qf[1][ks], s[kt][1]);
    }
  }
}
DI void pv_accum(const bf16x8 (&pf)[2][2], const u16* Vs, f32x4 (&o)[4][2], int l15, int g) {
  const int tq = l15 >> 2, tp = l15 & 3;
#pragma unroll
  for (int kk = 0; kk < 2; ++kk)
#pragma unroll
    for (int d = 0; d < 4; ++d) {
      const bf16x8 vf = cat4(tr_read(Vs + (kk * 32 + 4 * g + tq) * KLD + d * 16 + 4 * tp), tr_read(Vs + (kk * 32 + 16 + 4 * g + tq) * KLD + d * 16 + 4 * tp));
      o[d][0] = mfma16(vf, pf[0][kk], o[d][0]);
      o[d][1] = mfma16(vf, pf[1][kk], o[d][1]);
    }
}
DI void pack_p(const f32x4 (&s)[4][2], bf16x8 (&pf)[2][2]) {
#pragma unroll
  for (int qt = 0; qt < 2; ++qt)
#pragma unroll
    for (int kk = 0; kk < 2; ++kk) {
      u32x4 w;
      w.x = pack2(s[2 * kk][qt][0], s[2 * kk][qt][1]); w.y = pack2(s[2 * kk][qt][2], s[2 * kk][qt][3]);
      w.z = pack2(s[2 * kk + 1][qt][0], s[2 * kk + 1][qt][1]); w.w = pack2(s[2 * kk + 1][qt][2], s[2 * kk + 1][qt][3]);
      pf[qt][kk] = __builtin_bit_cast(bf16x8, w);
    }
}
template <class VF>
DI void softmax_pv(f32x4 (&s)[4][2], AttnAcc& a, const u16* Vs, float sc, int l15, int g, VF valid) {
  bf16x8 pf[2][2];
#pragma unroll
  for (int qt = 0; qt < 2; ++qt) {
    float mx = -1e30f;
#pragma unroll
    for (int kt = 0; kt < 4; ++kt)
#pragma unroll
      for (int r = 0; r < 4; ++r) { const float v = valid(kt, r, qt) ? s[kt][qt][r] * sc : -1e30f; s[kt][qt][r] = v; mx = fmaxf(mx, v); }
    mx = fmaxf(mx, __shfl_xor(mx, 16)); mx = fmaxf(mx, __shfl_xor(mx, 32));
    const float mn = fmaxf(a.m[qt], mx), alpha = exp2_(a.m[qt] - mn);
    a.m[qt] = mn;
    float ls = 0.f;
#pragma unroll
    for (int kt = 0; kt < 4; ++kt)
#pragma unroll
      for (int r = 0; r < 4; ++r) { const float v = s[kt][qt][r]; const float pv = v > -1e29f ? exp2_(v - mn) : 0.f; s[kt][qt][r] = pv; ls += pv; }
    a.l[qt] = a.l[qt] * alpha + ls;
#pragma unroll
    for (int d = 0; d < 4; ++d) a.o[d][qt] *= alpha;
#pragma unroll
    for (int kk = 0; kk < 2; ++kk) {
      u32x4 w;
      w.x = pack2(s[2 * kk][qt][0], s[2 * kk][qt][1]); w.y = pack2(s[2 * kk][qt][2], s[2 * kk][qt][3]);
      w.z = pack2(s[2 * kk + 1][qt][0], s[2 * kk + 1][qt][1]); w.w = pack2(s[2 * kk + 1][qt][2], s[2 * kk + 1][qt][3]);
      pf[qt][kk] = __builtin_bit_cast(bf16x8, w);
    }
  }
  pv_accum(pf, Vs, a.o, l15, g);
}
DI void softmax_pv_nomask(f32x4 (&s)[4][2], AttnAcc& a, const u16* Vs, float sc, int l15, int g) {
  bf16x8 pf[2][2];
#pragma unroll
  for (int qt = 0; qt < 2; ++qt) {
    float mx = s[0][qt][0];
#pragma unroll
    for (int kt = 0; kt < 4; ++kt)
#pragma unroll
      for (int r = 0; r < 4; ++r) mx = fmaxf(mx, s[kt][qt][r]);
    mx = fmaxf(mx, __shfl_xor(mx, 16)); mx = fmaxf(mx, __shfl_xor(mx, 32));
    const float mn = fmaxf(a.m[qt], mx * sc), alpha = exp2_(a.m[qt] - mn);
    a.m[qt] = mn;
    float ls = 0.f;
#pragma unroll
    for (int kt = 0; kt < 4; ++kt)
#pragma unroll
      for (int r = 0; r < 4; ++r) { const float pv = exp2_(__builtin_fmaf(s[kt][qt][r], sc, -mn)); s[kt][qt][r] = pv; ls += pv; }
    a.l[qt] = a.l[qt] * alpha + ls;
#pragma unroll
    for (int d = 0; d < 4; ++d) a.o[d][qt] *= alpha;
#pragma unroll
    for (int kk = 0; kk < 2; ++kk) {
      u32x4 w;
      w.x = pack2(s[2 * kk][qt][0], s[2 * kk][qt][1]); w.y = pack2(s[2 * kk][qt][2], s[2 * kk][qt][3]);
      w.z = pack2(s[2 * kk + 1][qt][0], s[2 * kk + 1][qt][1]); w.w = pack2(s[2 * kk + 1][qt][2], s[2 * kk + 1][qt][3]);
      pf[qt][kk] = __builtin_bit_cast(bf16x8, w);
    }
  }
  pv_accum(pf, Vs, a.o, l15, g);
}
DI float group_sum4(float v) { v += __shfl_xor(v, 16); v += __shfl_xor(v, 32); return v; }

DI void diff_attn_task(const Params& p, int layer, int b, int h, int qb, unsigned char* smem) {
  u16* Ks = (u16*)smem; u16* Vs = Ks + 64 * KLD;
  const int tid = otid(), lane = tid & 63, wid = tid >> 6, l15 = lane & 15, g = lane >> 4;
  const u16* proj = (const u16*)(p.ws + OFF_PROJ) + (size_t)b * SEQ * NP;
  const int q0w = qb * 128 + wid * 32;
  const float* lam = p.diff_lam + layer * 128;
  float s01 = 0.f, s23 = 0.f;
  for (int i = 0; i < 32; ++i) { s01 += lam[i] * lam[32 + i]; s23 += lam[64 + i] * lam[96 + i]; }
  const float lam_init = 0.8f - 0.6f * __expf(-0.3f * (float)layer);
  const float lam_full = __expf(s01) - __expf(s23) + lam_init;
  const float sc = 0.17677669529663687f * 1.4426950408889634f;
  const int ntile = 2 * qb + 2;
  const u16* vbase = proj + PB_V + h * 64;
  f32x4 res[4][2];
#pragma unroll 1
  for (int c = 0; c < 2; ++c) {
    const u16* kbase = proj + PB_K + h * 64 + c * 32;
    bf16x8 qf[2][1];
#pragma unroll
    for (int qt = 0; qt < 2; ++qt) qf[qt][0] = ldfrag(proj + (size_t)(q0w + qt * 16 + l15) * NP + PB_Q + h * 64 + c * 32 + 8 * g);
    AttnAcc a; attn_init(a);
    KVRegs kr; kv_load(kbase, vbase, NP, NP, 0, kr);
    for (int j = 0; j < ntile; ++j) {
      lds_barrier();
      kv_store(Ks, Vs, kr);
      lds_barrier();
      if (j + 1 < ntile) kv_load(kbase, vbase, NP, NP, (j + 1) * 64, kr);
      const int key0 = j * 64;
      if (key0 <= q0w + 31) {
        f32x4 s[4][2];
        auto valid = [&](int kt, int r, int qt) { return key0 + kt * 16 + 4 * g + r <= q0w + qt * 16 + l15; };
        qk_tile<1>(Ks, 0, qf, s, l15, g);
        if (key0 + 63 <= q0w) softmax_pv_nomask(s, a, Vs, sc, l15, g);
        else softmax_pv(s, a, Vs, sc, l15, g, valid);
      }
    }
#pragma unroll
    for (int qt = 0; qt < 2; ++qt) {
      const float lt = group_sum4(a.l[qt]);
      const float inv = c == 0 ? 1.f / lt : -lam_full / lt;
#pragma unroll
      for (int d = 0; d < 4; ++d) res[d][qt] = c == 0 ? a.o[d][qt] * inv : res[d][qt] + a.o[d][qt] * inv;
    }
  }
  u16* Y = (u16*)(p.ws + OFF_H);
  const float* ng = p.diff_norm_g + layer * 64;
#pragma unroll
  for (int qt = 0; qt < 2; ++qt) {
    float ss = 0.f;
#pragma unroll
    for (int d = 0; d < 4; ++d) { const f32x4 v = res[d][qt]; ss += v[0] * v[0] + v[1] * v[1] + v[2] * v[2] + v[3] * v[3]; }
    ss = group_sum4(ss);
    const float rn = rsqrtf(ss * (1.f / 64.f) + 1e-6f) * (1.f - lam_init);
    const int t = q0w + qt * 16 + l15;
    const size_t row = (size_t)b * SEQ + t;
#pragma unroll
    for (int d = 0; d < 4; ++d) {
      const int dd = d * 16 + 4 * g;
      const f32x4 v = res[d][qt];
      const u32x2 zz = *(const u32x2*)(proj + (size_t)t * NP + PB_Z + h * 64 + dd);
      const f32x4 gg = *(const f32x4*)(ng + dd);
      u32x2 w;
      w.x = pack2(v[0] * rn * gg[0] * siluf(bflo(zz.x)), v[1] * rn * gg[1] * siluf(bfhi(zz.x)));
      w.y = pack2(v[2] * rn * gg[2] * siluf(bflo(zz.y)), v[3] * rn * gg[3] * siluf(bfhi(zz.y)));
      *(u32x2*)(Y + row * 1024 + Y_B + h * 64 + dd) = w;
    }
  }
}

template <int NKS>
DI void qk_tile1(const u16* Ks, const bf16x8 (&qf)[NKS], f32x4 (&s)[4], int l15, int g) {
#pragma unroll
  for (int kt = 0; kt < 4; ++kt) {
    s[kt] = (f32x4){0.f, 0.f, 0.f, 0.f};
#pragma unroll
    for (int ks = 0; ks < NKS; ++ks) s[kt] = mfma16(ldfrag(Ks + (kt * 16 + l15) * KLD + ks * 32 + 8 * g), qf[ks], s[kt]);
  }
}
DI void pv_accum1(const f32x4 (&s)[4], const u16* Vs, f32x4 (&o)[4], int l15, int g) {
  const int tq = l15 >> 2, tp = l15 & 3;
#pragma unroll
  for (int kk = 0; kk < 2; ++kk) {
    u32x4 w;
    w.x = pack2(s[2 * kk][0], s[2 * kk][1]); w.y = pack2(s[2 * kk][2], s[2 * kk][3]);
    w.z = pack2(s[2 * kk + 1][0], s[2 * kk + 1][1]); w.w = pack2(s[2 * kk + 1][2], s[2 * kk + 1][3]);
    const bf16x8 pf = __builtin_bit_cast(bf16x8, w);
#pragma unroll
    for (int d = 0; d < 4; ++d) {
      const bf16x8 vf = cat4(tr_read(Vs + (kk * 32 + 4 * g + tq) * KLD + d * 16 + 4 * tp), tr_read(Vs + (kk * 32 + 16 + 4 * g + tq) * KLD + d * 16 + 4 * tp));
      o[d] = mfma16(vf, pf, o[d]);
    }
  }
}
DI void conv_silu_stage(const u16* projb, int col0, const float* cw, const float* cb, int chan0, int nchan, int t0, u16* dst, const float* rowscale, float cscale) {
  const int tid = otid(), ch = (tid & 7) * 8;
  float w[4][8], bias[8];
#pragma unroll
  for (int j = 0; j < 4; ++j)
#pragma unroll
    for (int i = 0; i < 8; ++i) w[j][i] = cw[j * nchan + chan0 + ch + i];
#pragma unroll
  for (int i = 0; i < 8; ++i) bias[i] = cb[chan0 + ch + i];
#pragma unroll 1
  for (int ps = 0; ps < 4; ++ps) {
    const int row = ps * 32 + (tid >> 3), t = t0 + row;
    float acc[8];
#pragma unroll
    for (int i = 0; i < 8; ++i) acc[i] = bias[i];
#pragma unroll
    for (int j = 0; j < 4; ++j) {
      const int tt = t - 3 + j;
      if (tt >= 0) {
        const u32x4 v = *(const u32x4*)(projb + (size_t)tt * NP + col0 + ch);
        acc[0] += w[j][0] * bflo(v.x); acc[1] += w[j][1] * bfhi(v.x); acc[2] += w[j][2] * bflo(v.y); acc[3] += w[j][3] * bfhi(v.y);
        acc[4] += w[j][4] * bflo(v.z); acc[5] += w[j][5] * bfhi(v.z); acc[6] += w[j][6] * bflo(v.w); acc[7] += w[j][7] * bfhi(v.w);
      }
    }
    const float rs = (rowscale ? rowscale[row] : 1.f) * cscale;
#pragma unroll
    for (int i = 0; i < 8; ++i) acc[i] = siluf(acc[i]) * rs;
    u32x4 o; o.x = pack2(acc[0], acc[1]); o.y = pack2(acc[2], acc[3]); o.z = pack2(acc[4], acc[5]); o.w = pack2(acc[6], acc[7]);
    *(u32x4*)(dst + row * KLD + ch) = o;
  }
}
DI float block_scan128_add(float v, float* tmp) {
  const int tid = otid(), lane = tid & 63;
  float x = v;
#pragma unroll
  for (int o = 1; o < 64; o <<= 1) { const float y = __shfl_up(x, o); if (lane >= o) x += y; }
  lds_barrier();
  if (tid == 63) tmp[0] = x;
  lds_barrier();
  if ((tid >> 6) == 1) x += tmp[0];
  return x;
}
DI float block_scan128_max(float v, float* tmp) {
  const int tid = otid(), lane = tid & 63;
  float x = v;
#pragma unroll
  for (int o = 1; o < 64; o <<= 1) { const float y = __shfl_up(x, o); if (lane >= o) x = fmaxf(x, y); }
  lds_barrier();
  if (tid == 63) tmp[0] = x;
  lds_barrier();
  if ((tid >> 6) == 1) x = fmaxf(x, tmp[0]);
  return x;
}
DI void scale_rows(u16* A, const float* rs) {
  const int tid = otid(), ch = (tid & 7) * 8;
#pragma unroll
  for (int ps = 0; ps < 4; ++ps) {
    const int row = ps * 32 + (tid >> 3);
    const float f = rs[row];
    u32x4 v = *(u32x4*)(A + row * KLD + ch);
    v.x = pack2(bflo(v.x) * f, bfhi(v.x) * f); v.y = pack2(bflo(v.y) * f, bfhi(v.y) * f);
    v.z = pack2(bflo(v.z) * f, bfhi(v.z) * f); v.w = pack2(bflo(v.w) * f, bfhi(v.w) * f);
    *(u32x4*)(A + row * KLD + ch) = v;
  }
}
DI void state_update(const u16* Xs, const u16* Bs, f32x4 (&acc)[4], int w, int l15, int g) {
  const int tq = l15 >> 2, tp = l15 & 3;
#pragma unroll
  for (int kk = 0; kk < 4; ++kk) {
    const bf16x8 af = cat4(tr_read(Xs + (kk * 32 + 4 * g + tq) * KLD + w * 16 + 4 * tp), tr_read(Xs + (kk * 32 + 16 + 4 * g + tq) * KLD + w * 16 + 4 * tp));
#pragma unroll
    for (int nt = 0; nt < 4; ++nt) {
      const bf16x8 bfr = cat4(tr_read(Bs + (kk * 32 + 4 * g + tq) * KLD + nt * 16 + 4 * tp), tr_read(Bs + (kk * 32 + 16 + 4 * g + tq) * KLD + nt * 16 + 4 * tp));
      acc[nt] = mfma16(af, bfr, acc[nt]);
    }
  }
}
DI void state_to_lds(u16* Ss, const f32x4 (&acc)[4], int w, int l15, int g) {
#pragma unroll
  for (int nt = 0; nt < 4; ++nt)
#pragma unroll
    for (int r = 0; r < 4; ++r) Ss[(w * 16 + 4 * g + r) * KLD + nt * 16 + l15] = f2bf(acc[nt][r]);
}

constexpr int SEQ_LDS_A = 0, SEQ_LDS_B = 128 * KLD * 2, SEQ_LDS_C = 2 * 128 * KLD * 2, SEQ_LDS_S = 3 * 128 * KLD * 2, SEQ_LDS_F = SEQ_LDS_S + 64 * KLD * 2;
constexpr int SEQ_LDS_HALO = SEQ_LDS_F + 4096;
constexpr int SEQ_LDS_CW = SEQ_LDS_HALO + 2 * 3 * 3 * 64 * 2;
struct RawRegs { u32x4 r[4]; };
DI void raw_load(const u16* projb, int col0, int t0, RawRegs& rr, int tid) {
#pragma unroll
  for (int i = 0; i < 4; ++i) rr.r[i] = *(const u32x4*)(projb + (size_t)(t0 + (tid >> 3) + 32 * i) * NP + col0 + (tid & 7) * 8);
}
DI void raw_store(u16* dst, u16* halo_next, const RawRegs& rr, int tid) {
#pragma unroll
  for (int i = 0; i < 4; ++i) *(u32x4*)(dst + ((tid >> 3) + 32 * i) * KLD + (tid & 7) * 8) = rr.r[i];
  if (halo_next && tid >= 232) *(u32x4*)(halo_next + ((tid >> 3) - 29) * 64 + (tid & 7) * 8) = rr.r[3];
}
DI void conv_from_lds(const u16* raw, const u16* halo, const float* wl, const float* rowscale, float cscale, u32x4 (&out)[4], int tid) {
  const int q = tid >> 3, ch = (tid & 7) * 8;
  u32x4 v[7];
#pragma unroll
  for (int k = 0; k < 7; ++k) { const int r = 4 * q - 3 + k; v[k] = r >= 0 ? *(const u32x4*)(raw + r * KLD + ch) : *(const u32x4*)(halo + (r + 3) * 64 + ch); }
  float w[5][8];
#pragma unroll
  for (int j = 0; j < 5; ++j) { const f32x4 w0 = *(const f32x4*)(wl + j * 64 + ch), w1 = *(const f32x4*)(wl + j * 64 + ch + 4);
    w[j][0] = w0[0]; w[j][1] = w0[1]; w[j][2] = w0[2]; w[j][3] = w0[3]; w[j][4] = w1[0]; w[j][5] = w1[1]; w[j][6] = w1[2]; w[j][7] = w1[3]; }
#pragma unroll
  for (int o = 0; o < 4; ++o) {
    float acc[8];
#pragma unroll
    for (int i = 0; i < 8; ++i) acc[i] = w[4][i];
#pragma unroll
    for (int j = 0; j < 4; ++j) {
      const u32x4 x = v[o + j];
      acc[0] += w[j][0] * bflo(x.x); acc[1] += w[j][1] * bfhi(x.x); acc[2] += w[j][2] * bflo(x.y); acc[3] += w[j][3] * bfhi(x.y);
      acc[4] += w[j][4] * bflo(x.z); acc[5] += w[j][5] * bfhi(x.z); acc[6] += w[j][6] * bflo(x.w); acc[7] += w[j][7] * bfhi(x.w);
    }
    const float rs = (rowscale ? rowscale[4 * q + o] : 1.f) * cscale;
#pragma unroll
    for (int i = 0; i < 8; ++i) acc[i] = siluf(acc[i]) * rs;
    out[o].x = pack2(acc[0], acc[1]); out[o].y = pack2(acc[2], acc[3]); out[o].z = pack2(acc[4], acc[5]); out[o].w = pack2(acc[6], acc[7]);
  }
}
DI void conv_write(u16* dst, const u32x4 (&out)[4], int tid) {
  const int q = tid >> 3, ch = (tid & 7) * 8;
#pragma unroll
  for (int o = 0; o < 4; ++o) *(u32x4*)(dst + (4 * q + o) * KLD + ch) = out[o];
}
DI void stage_conv_w(float* wl, const float* cw, const float* cb, int chan0, int nchan, int tid) {
  for (int i = tid; i < 320; i += 256) { const int j = i >> 6, cc = i & 63; wl[i] = j < 4 ? cw[j * nchan + chan0 + cc] : cb[chan0 + cc]; }
}
DI float wave_scan_add(float x, int lane) {
#pragma unroll
  for (int o = 1; o < 64; o <<= 1) { const float y = __shfl_up(x, o); if (lane >= o) x += y; }
  return x;
}
DI float wave_scan_max(float x, int lane) {
#pragma unroll
  for (int o = 1; o < 64; o <<= 1) { const float y = __shfl_up(x, o); if (lane >= o) x = fmaxf(x, y); }
  return x;
}

DI void ssd_task(const Params& p, int layer, int b, int h, unsigned char* smem) {
  u16* Cs = (u16*)(smem + SEQ_LDS_A); u16* Bs = (u16*)(smem + SEQ_LDS_B); u16* Xs = (u16*)(smem + SEQ_LDS_C); u16* Ss = (u16*)(smem + SEQ_LDS_S);
  float* fl = (float*)(smem + SEQ_LDS_F);
  float* dts = fl; float* acs = fl + 128; float* wend = fl + 256; float* tmp = fl + 384;
  u16* halo = (u16*)(smem + SEQ_LDS_HALO); float* cwl = (float*)(smem + SEQ_LDS_CW);
  int tid = otid(), lane = tid & 63, w = tid >> 6, l15 = lane & 15, g = lane >> 4;
  const int gi = h >> 1;
  const u16* projb = (const u16*)(p.ws + OFF_PROJ) + (size_t)b * SEQ * NP;
  const float* smb = (const float*)(p.ws + OFF_SMALL) + (size_t)b * SEQ * NSMALL;
  const float* cw = p.ssm_conv_w + layer * 4 * 512; const float* cb = p.ssm_conv_b + layer * 512;
  u16* Y = (u16*)(p.ws + OFF_H);
  const float a_h = -__expf(p.ssm_a_log[layer * 4 + h]), d_h = p.ssm_d[layer * 4 + h], dtb = p.ssm_dt_bias[layer * 4 + h];
  const int colB = PC_XBC + 256 + gi * 64, colC = PC_XBC + 384 + gi * 64, colX = PC_XBC + h * 64;
  f32x4 st[4];
#pragma unroll
  for (int nt = 0; nt < 4; ++nt) st[nt] = (f32x4){0.f, 0.f, 0.f, 0.f};
  lds_barrier();
  stage_conv_w(cwl, cw, cb, 256 + gi * 64, 512, tid);
  stage_conv_w(cwl + 320, cw, cb, 384 + gi * 64, 512, tid);
  stage_conv_w(cwl + 640, cw, cb, h * 64, 512, tid);
  for (int i = tid; i < 3 * 3 * 64; i += 256) halo[i] = 0;
  RawRegs rB, rC, rX; float dtraw = 0.f;
  raw_load(projb, colB, 0, rB, tid); raw_load(projb, colC, 0, rC, tid); raw_load(projb, colX, 0, rX, tid);
  if (tid < 128) dtraw = smb[(size_t)tid * NSMALL + SM_DT + h];
#pragma unroll 1
  for (int c = 0; c < 32; ++c) {
    const int t0 = c * 128;
    asm volatile("" : "+v"(tid)); lane = tid & 63; w = tid >> 6; l15 = lane & 15; g = lane >> 4;
    u16* hcur = halo + (c & 1) * 576; u16* hnext = halo + ((c + 1) & 1) * 576;
    float dtv = 0.f;
    if (tid < 128) { const float xr = dtraw + dtb; dtv = xr > 15.f ? xr : __logf(1.f + __expf(xr)); }
    float cs = wave_scan_add(dtv * a_h, lane);
    if (tid == 63) tmp[0] = cs;
    lds_barrier();
    if (w == 1) cs += tmp[0];
    if (tid < 128) { dts[tid] = dtv; acs[tid] = cs; }
    raw_store(Bs, hnext, rB, tid); raw_store(Cs, hnext + 192, rC, tid); raw_store(Xs, hnext + 384, rX, tid);
    lds_barrier();
    if (c + 1 < 32) {
      raw_load(projb, colB, t0 + 128, rB, tid); raw_load(projb, colC, t0 + 128, rC, tid);
      if (tid < 128) dtraw = smb[(size_t)(t0 + 128 + tid) * NSMALL + SM_DT + h];
    }
    {
      u32x4 o1[4], o2[4];
      conv_from_lds(Bs, hcur, cwl, nullptr, 1.f, o1, tid);
      lds_barrier();
      conv_write(Bs, o1, tid);
      conv_from_lds(Cs, hcur + 192, cwl + 320, nullptr, 1.f, o2, tid);
      lds_barrier();
      conv_write(Cs, o2, tid);
      conv_from_lds(Xs, hcur + 384, cwl + 640, dts, 1.f, o1, tid);
      lds_barrier();
      conv_write(Xs, o1, tid);
    }
    if (tid < 128) wend[tid] = __expf(acs[127] - acs[tid]);
    state_to_lds(Ss, st, w, l15, g);
    lds_barrier();
#pragma unroll 1
    for (int qt = 0; qt < 2; ++qt) {
      const int tl = 32 * w + qt * 16 + l15;
      bf16x8 cf[2];
#pragma unroll
      for (int ks = 0; ks < 2; ++ks) cf[ks] = ldfrag(Cs + tl * KLD + ks * 32 + 8 * g);
      f32x4 y[4];
#pragma unroll
      for (int d = 0; d < 4; ++d) y[d] = (f32x4){0.f, 0.f, 0.f, 0.f};
      const float at = acs[tl];
#pragma unroll 1
      for (int stl = 0; stl < 2; ++stl) {
        if (stl * 64 <= 32 * w + qt * 16 + 15) {
          f32x4 sc[4];
          qk_tile1<2>(Bs + stl * 64 * KLD, cf, sc, l15, g);
#pragma unroll
          for (int kt = 0; kt < 4; ++kt) {
            const f32x4 as = *(const f32x4*)(acs + stl * 64 + kt * 16 + 4 * g);
#pragma unroll
            for (int r = 0; r < 4; ++r) {
              const bool ok = stl * 64 + kt * 16 + 4 * g + r <= tl;
              sc[kt][r] = ok ? sc[kt][r] * __expf(at - as[r]) : 0.f;
            }
          }
          pv_accum1(sc, Xs + stl * 64 * KLD, y, l15, g);
        }
      }
      const float ea = __expf(at), dsk = d_h / dts[tl];
      const size_t row = (size_t)b * SEQ + t0 + tl;
#pragma unroll
      for (int d = 0; d < 4; ++d) {
        f32x4 yo = (f32x4){0.f, 0.f, 0.f, 0.f};
#pragma unroll
        for (int ks = 0; ks < 2; ++ks) yo = mfma16(ldfrag(Ss + (d * 16 + l15) * KLD + ks * 32 + 8 * g), cf[ks], yo);
        const u32x2 xv = *(const u32x2*)(Xs + tl * KLD + d * 16 + 4 * g);
        const f32x4 v = y[d] + yo * ea;
        u32x2 o; o.x = pack2(v[0] + dsk * bflo(xv.x), v[1] + dsk * bfhi(xv.x)); o.y = pack2(v[2] + dsk * bflo(xv.y), v[3] + dsk * bfhi(xv.y));
        *(u32x2*)(Y + row * 1024 + Y_C + h * 64 + d * 16 + 4 * g) = o;
      }
    }
    if (c + 1 < 32) raw_load(projb, colX, t0 + 128, rX, tid);
    lds_barrier();
    scale_rows(Xs, wend);
    lds_barrier();
    const float cd = __expf(acs[127]);
#pragma unroll
    for (int nt = 0; nt < 4; ++nt) st[nt] *= cd;
    state_update(Xs, Bs, st, w, l15, g);
  }
}
DI void seq_fix_rows(const Params& p, int layer, int r0, int nrows) {
  u16* Y = (u16*)(p.ws + OFF_H);
  const u16* proj = (const u16*)(p.ws + OFF_PROJ);
  const int tid = otid(), lane = tid & 63, wv = tid >> 6;
  const bool ml = lane >= 32;
  const int ch = (lane & 31) * 8;
  const float* ng = ml ? p.ml_norm_g + layer * 64 + (ch & 63) : p.ssm_norm_g + layer * 256 + ch;
  const f32x4 g0 = *(const f32x4*)ng, g1 = *(const f32x4*)(ng + 4);
  for (int rr = wv; rr < nrows; rr += 4) {
    const size_t row = (size_t)(r0 + rr);
    u16* yp = Y + row * 1024 + (ml ? Y_D : Y_C) + ch;
    const u32x4 yv = *(const u32x4*)yp;
    const u32x4 zv = *(const u32x4*)(proj + row * NP + (ml ? PD_Z : PC_Z) + ch);
    float v[8] = {bflo(yv.x), bfhi(yv.x), bflo(yv.y), bfhi(yv.y), bflo(yv.z), bfhi(yv.z), bflo(yv.w), bfhi(yv.w)};
    float z[8] = {bflo(zv.x), bfhi(zv.x), bflo(zv.y), bfhi(zv.y), bflo(zv.z), bfhi(zv.z), bflo(zv.w), bfhi(zv.w)};
    float ss = 0.f;
    if (ml) {
      const u32x4 ov = *(const u32x4*)(proj + row * NP + PD_O + ch);
      const float o[8] = {bflo(ov.x), bfhi(ov.x), bflo(ov.y), bfhi(ov.y), bflo(ov.z), bfhi(ov.z), bflo(ov.w), bfhi(ov.w)};
#pragma unroll
      for (int i = 0; i < 8; ++i) { v[i] *= sigmoidf_(o[i]); ss += v[i] * v[i]; }
    } else {
#pragma unroll
      for (int i = 0; i < 8; ++i) { v[i] *= siluf(z[i]); ss += v[i] * v[i]; }
    }
    ss += __shfl_xor(ss, 1); ss += __shfl_xor(ss, 2); ss += __shfl_xor(ss, 4);
    const float ss16 = ss + __shfl_xor(ss, 8);
    const float rn = ml ? rsqrtf(ss * (1.f / 64.f) + 1e-6f) : rsqrtf(ss16 * (1.f / 128.f) + 1e-6f);
    float o8[8];
#pragma unroll
    for (int i = 0; i < 8; ++i) { const float gg = i < 4 ? g0[i & 3] : g1[i & 3]; o8[i] = v[i] * rn * gg * (ml ? siluf(z[i]) : 1.f); }
    u32x4 w; w.x = pack2(o8[0], o8[1]); w.y = pack2(o8[2], o8[3]); w.z = pack2(o8[4], o8[5]); w.w = pack2(o8[6], o8[7]);
    *(u32x4*)yp = w;
  }
}

DI void mlstm_task(const Params& p, int layer, int b, int h, unsigned char* smem) {
  u16* Qs = (u16*)(smem + SEQ_LDS_A); u16* Ks2 = (u16*)(smem + SEQ_LDS_B); u16* Vs2 = (u16*)(smem + SEQ_LDS_C); u16* Cst = (u16*)(smem + SEQ_LDS_S);
  float* fl = (float*)(smem + SEQ_LDS_F);
  float* bcs = fl; float* us = fl + 128; float* pms = fl + 256; float* wend = fl + 384; float* nst = fl + 512; float* npart = fl + 576; float* tmp = fl + 832;
  u16* halo = (u16*)(smem + SEQ_LDS_HALO); float* cwl = (float*)(smem + SEQ_LDS_CW);
  int tid = otid(), lane = tid & 63, w = tid >> 6, l15 = lane & 15, g = lane >> 4;
  const u16* projb = (const u16*)(p.ws + OFF_PROJ) + (size_t)b * SEQ * NP;
  const float* smb = (const float*)(p.ws + OFF_SMALL) + (size_t)b * SEQ * NSMALL;
  const float* cw = p.ml_conv_w + layer * 4 * 512; const float* cb = p.ml_conv_b + layer * 512;
  const float ib = p.ml_if_b[layer * 8 + h], fb = p.ml_if_b[layer * 8 + 4 + h];
  u16* Y = (u16*)(p.ws + OFF_H);
  const int colQ = PD_QK + h * 64, colK = PD_QK + 256 + h * 64, colV = PD_V + h * 64;
  f32x4 st[4];
#pragma unroll
  for (int nt = 0; nt < 4; ++nt) st[nt] = (f32x4){0.f, 0.f, 0.f, 0.f};
  float m_prev = 0.f;
  lds_barrier();
  if (tid < 64) nst[tid] = 0.f;
  stage_conv_w(cwl, cw, cb, h * 64, 512, tid);
  stage_conv_w(cwl + 320, cw, cb, 256 + h * 64, 512, tid);
  for (int i = tid; i < 3 * 3 * 64; i += 256) halo[i] = 0;
  RawRegs rQ, rK, rV; float iraw = 0.f, fraw = 0.f;
  raw_load(projb, colQ, 0, rQ, tid); raw_load(projb, colK, 0, rK, tid); raw_load(projb, colV, 0, rV, tid);
  if (tid < 128) { iraw = smb[(size_t)tid * NSMALL + SM_IF + h]; fraw = smb[(size_t)tid * NSMALL + SM_IF + 4 + h]; }
#pragma unroll 1
  for (int c = 0; c < 32; ++c) {
    const int t0 = c * 128;
    asm volatile("" : "+v"(tid)); lane = tid & 63; w = tid >> 6; l15 = lane & 15; g = lane >> 4;
    u16* hcur = halo + (c & 1) * 576; u16* hnext = halo + ((c + 1) & 1) * 576;
    float ip = 0.f, lf = 0.f;
    if (tid < 128) { ip = iraw + ib; const float fp = fraw + fb; lf = fminf(fp, 0.f) - __logf(1.f + __expf(-fabsf(fp))); }
    float bc = wave_scan_add(lf, lane);
    if (tid == 63) tmp[0] = bc;
    lds_barrier();
    if (w == 1) bc += tmp[0];
    const float u = tid < 128 ? ip - bc : -1e30f;
    float pm = wave_scan_max(u, lane);
    if (tid == 63) tmp[1] = pm;
    raw_store(Qs, hnext, rQ, tid); raw_store(Ks2, hnext + 192, rK, tid); raw_store(Vs2, nullptr, rV, tid);
    lds_barrier();
    if (w == 1) pm = fmaxf(pm, tmp[1]);
    if (tid < 128) { bcs[tid] = bc; us[tid] = u; pms[tid] = pm; }
    if (c + 1 < 32) {
      raw_load(projb, colQ, t0 + 128, rQ, tid);
      if (tid < 128) { iraw = smb[(size_t)(t0 + 128 + tid) * NSMALL + SM_IF + h]; fraw = smb[(size_t)(t0 + 128 + tid) * NSMALL + SM_IF + 4 + h]; }
    }
    u32x4 oQ[4], oK[4];
    conv_from_lds(Qs, hcur, cwl, nullptr, 1.f, oQ, tid);
    __builtin_amdgcn_sched_barrier(0);
    conv_from_lds(Ks2, hcur + 192, cwl + 320, nullptr, 0.125f, oK, tid);
    __builtin_amdgcn_sched_barrier(0);
    lds_barrier();
    conv_write(Qs, oQ, tid); conv_write(Ks2, oK, tid);
    state_to_lds(Cst, st, w, l15, g);
    const float blast = bcs[127];
    const float m_new = blast + fmaxf(m_prev, pms[127]);
    if (tid < 128) wend[tid] = __expf(blast - m_new + us[tid]);
    lds_barrier();
#pragma unroll 1
    for (int qt = 0; qt < 2; ++qt) {
      const int tl = 32 * w + qt * 16 + l15;
      bf16x8 qf[2];
#pragma unroll
      for (int ks = 0; ks < 2; ++ks) qf[ks] = ldfrag(Qs + tl * KLD + ks * 32 + 8 * g);
      f32x4 num[4];
#pragma unroll
      for (int d = 0; d < 4; ++d) num[d] = (f32x4){0.f, 0.f, 0.f, 0.f};
      const float bt = bcs[tl], mt = bt + fmaxf(m_prev, pms[tl]);
      float den = 0.f;
#pragma unroll 1
      for (int stl = 0; stl < 2; ++stl) {
        if (stl * 64 <= 32 * w + qt * 16 + 15) {
          f32x4 sc[4];
          qk_tile1<2>(Ks2 + stl * 64 * KLD, qf, sc, l15, g);
#pragma unroll
          for (int kt = 0; kt < 4; ++kt) {
            const f32x4 uu = *(const f32x4*)(us + stl * 64 + kt * 16 + 4 * g);
#pragma unroll
            for (int r = 0; r < 4; ++r) {
              const bool ok = stl * 64 + kt * 16 + 4 * g + r <= tl;
              const float v = ok ? sc[kt][r] * __expf(bt - mt + uu[r]) : 0.f;
              sc[kt][r] = v; den += v;
            }
          }
          pv_accum1(sc, Vs2 + stl * 64 * KLD, num, l15, g);
        }
      }
      const float wi = __expf(bt + m_prev - mt);
      float qn = 0.f;
#pragma unroll
      for (int ks = 0; ks < 2; ++ks)
#pragma unroll
        for (int j = 0; j < 8; ++j) qn += bf2f((u16)qf[ks][j]) * nst[ks * 32 + 8 * g + j];
      qn = group_sum4(qn);
      const float dn = group_sum4(den) + wi * qn;
      const float inv = __builtin_amdgcn_rcpf(fmaxf(fabsf(dn), __expf(-mt)));
      const size_t row = (size_t)b * SEQ + t0 + tl;
#pragma unroll
      for (int d = 0; d < 4; ++d) {
        f32x4 ni = (f32x4){0.f, 0.f, 0.f, 0.f};
#pragma unroll
        for (int ks = 0; ks < 2; ++ks) ni = mfma16(ldfrag(Cst + (d * 16 + l15) * KLD + ks * 32 + 8 * g), qf[ks], ni);
        const f32x4 v = (num[d] + ni * wi) * inv;
        u32x2 o; o.x = pack2(v[0], v[1]); o.y = pack2(v[2], v[3]);
        *(u32x2*)(Y + row * 1024 + Y_D + h * 64 + d * 16 + 4 * g) = o;
      }
    }
    if (c + 1 < 32) { raw_load(projb, colK, t0 + 128, rK, tid); raw_load(projb, colV, t0 + 128, rV, tid); }
    lds_barrier();
    scale_rows(Ks2, wend);
    lds_barrier();
    const float fprev = __expf(blast + m_prev - m_new);
#pragma unroll
    for (int nt = 0; nt < 4; ++nt) st[nt] *= fprev;
    state_update(Vs2, Ks2, st, w, l15, g);
    {
      const int e = tid & 63, part = tid >> 6;
      float a = 0.f;
      for (int s2 = part * 32; s2 < part * 32 + 32; ++s2) a += bf2f(Ks2[s2 * KLD + e]);
      npart[part * 64 + e] = a;
    }
    lds_barrier();
    if (tid < 64) nst[tid] = nst[tid] * fprev + npart[tid] + npart[64 + tid] + npart[128 + tid] + npart[192 + tid];
    m_prev = m_new;
  }
}

DI void compress_task(const Params& p, int layer, int b, int kv, int rb, unsigned char* smem) {
  constexpr int HLD = 136;
  u16* Hs = (u16*)smem;
  const int tid = otid(), lane = tid & 63, w = tid >> 6, l15 = lane & 15, g = lane >> 4;
  const u16* projb = (const u16*)(p.ws + OFF_PROJ) + (size_t)b * SEQ * NP + (kv ? PA_VC : PA_KC);
  const int mi = layer * 2 + kv;
  const u16* W1T = (const u16*)(p.ws + OFF_W1T) + (size_t)mi * 128 * 2048;
  const u16* W2T = (const u16*)(p.ws + OFF_W2T) + (size_t)mi * 64 * 128;
  const float* bias1 = (const float*)(p.ws + OFF_BIAS1) + mi * 16 * 128;
  f32x4 acc[2][2];
#pragma unroll
  for (int nt = 0; nt < 2; ++nt) { acc[nt][0] = (f32x4){0.f, 0.f, 0.f, 0.f}; acc[nt][1] = (f32x4){0.f, 0.f, 0.f, 0.f}; }
  int tok[2];
#pragma unroll
  for (int mt = 0; mt < 2; ++mt) { int i = rb * 32 + mt * 16 + l15; if (i > 254) i = 254; tok[mt] = 16 * i; }
#pragma unroll 4
  for (int ks = 0; ks < 64; ++ks) {
    const int j = ks >> 1, d0 = (ks & 1) * 32;
    bf16x8 af[2], wf[2];
#pragma unroll
    for (int mt = 0; mt < 2; ++mt) af[mt] = ldfrag(projb + (size_t)(tok[mt] + j) * NP + d0 + 8 * g);
#pragma unroll
    for (int nt = 0; nt < 2; ++nt) wf[nt] = ldfrag(W1T + (size_t)(w * 32 + nt * 16 + l15) * 2048 + ks * 32 + 8 * g);
#pragma unroll
    for (int nt = 0; nt < 2; ++nt)
#pragma unroll
      for (int mt = 0; mt < 2; ++mt) acc[nt][mt] = mfma16(wf[nt], af[mt], acc[nt][mt]);
  }
  lds_barrier();
#pragma unroll
  for (int nt = 0; nt < 2; ++nt) {
    const int n = w * 32 + nt * 16 + 4 * g;
    f32x4 bb = *(const f32x4*)(bias1 + n);
#pragma unroll
    for (int pc = 1; pc < 16; ++pc) bb += *(const f32x4*)(bias1 + pc * 128 + n);
#pragma unroll
    for (int mt = 0; mt < 2; ++mt) {
      const f32x4 v = acc[nt][mt] + bb;
      u32x2 o; o.x = pack2(siluf(v[0]), siluf(v[1])); o.y = pack2(siluf(v[2]), siluf(v[3]));
      *(u32x2*)(Hs + (mt * 16 + l15) * HLD + n) = o;
    }
  }
  lds_barrier();
  f32x4 acc2[2] = {(f32x4){0.f, 0.f, 0.f, 0.f}, (f32x4){0.f, 0.f, 0.f, 0.f}};
#pragma unroll
  for (int ks = 0; ks < 4; ++ks) {
    const bf16x8 wf = ldfrag(W2T + (size_t)(w * 16 + l15) * 128 + ks * 32 + 8 * g);
#pragma unroll
    for (int mt = 0; mt < 2; ++mt) acc2[mt] = mfma16(wf, ldfrag(Hs + (mt * 16 + l15) * HLD + ks * 32 + 8 * g), acc2[mt]);
  }
  u16* dst = (u16*)(p.ws + (kv ? OFF_VCMP : OFF_KCMP) + (size_t)layer * 512 * 1024) + (size_t)b * 256 * 64;
#pragma unroll
  for (int mt = 0; mt < 2; ++mt) {
    const int i = rb * 32 + mt * 16 + l15;
    u32x2 o; o.x = pack2(acc2[mt][0], acc2[mt][1]); o.y = pack2(acc2[mt][2], acc2[mt][3]);
    if (i > 254) { o.x = 0u; o.y = 0u; }
    *(u32x2*)(dst + (size_t)i * 64 + w * 16 + 4 * g) = o;
  }
}

DI void nsa_task(const Params& p, int layer, int b, int qi, unsigned char* smem) {
  u16* Ks = (u16*)smem; u16* Vs = Ks + 64 * KLD;
  float* T = (float*)(smem + 2 * 64 * KLD * 2);
  unsigned long long* selm = (unsigned long long*)(smem + 2 * 64 * KLD * 2 + 4 * 32 * 65 * 4);
  const int tid = otid(), lane = tid & 63, h = tid >> 6, l15 = lane & 15, g = lane >> 4;
  const int q0 = qi * 32;
  const u16* projb = (const u16*)(p.ws + OFF_PROJ) + (size_t)b * SEQ * NP;
  const float* smb = (const float*)(p.ws + OFF_SMALL) + (size_t)b * SEQ * NSMALL;
  const u16* kcmp = (const u16*)(p.ws + OFF_KCMP + (size_t)layer * 512 * 1024) + (size_t)b * 256 * 64;
  const u16* vcmp = (const u16*)(p.ws + OFF_VCMP + (size_t)layer * 512 * 1024) + (size_t)b * 256 * 64;
  bf16x8 qf[2][2];
#pragma unroll
  for (int qt = 0; qt < 2; ++qt)
#pragma unroll
    for (int ks = 0; ks < 2; ++ks) qf[qt][ks] = ldfrag(projb + (size_t)(q0 + qt * 16 + l15) * NP + PA_Q + h * 64 + ks * 32 + 8 * g);
  const float sc = 0.125f * 1.4426950408889634f;
  f32x4 outacc[4][2];
  AttnAcc a;
  KVRegs kr;
  const int ntc = (q0 >> 10) + 1;
  attn_init(a);
  lds_barrier();
  for (int i = tid; i < 4 * 32 * 65; i += 256) T[i] = 0.f;
  for (int j = 0; j < ntc; ++j) {
    lds_barrier();
    kv_load(kcmp, vcmp, 64, 64, j * 64, kr); kv_store(Ks, Vs, kr);
    lds_barrier();
    f32x4 s[4][2];
    auto valid = [&](int kt, int r, int qt) { return 16 * (j * 64 + kt * 16 + 4 * g + r) + 31 <= q0 + qt * 16 + l15; };
    qk_tile<2>(Ks, 0, qf, s, l15, g);
    softmax_pv(s, a, Vs, sc, l15, g, valid);
  }
  float cinv[2];
#pragma unroll
  for (int qt = 0; qt < 2; ++qt) {
    const float lt = group_sum4(a.l[qt]);
    cinv[qt] = lt > 0.f ? 1.f / lt : 0.f;
    const float gt = sigmoidf_(smb[(size_t)(q0 + qt * 16 + l15) * NSMALL + SM_G + h * 3 + 0]) * cinv[qt];
#pragma unroll
    for (int d = 0; d < 4; ++d) outacc[d][qt] = a.o[d][qt] * gt;
  }
  float carry[2] = {0.f, 0.f};
  for (int j = 0; j < ntc; ++j) {
    lds_barrier();
    kv_load(kcmp, vcmp, 64, 64, j * 64, kr); kv_store(Ks, Vs, kr);
    lds_barrier();
    f32x4 s[4][2];
    qk_tile<2>(Ks, 0, qf, s, l15, g);
#pragma unroll
    for (int qt = 0; qt < 2; ++qt) {
      float prev3 = carry[qt];
#pragma unroll
      for (int kt = 0; kt < 4; ++kt) {
        float pr[4];
#pragma unroll
        for (int r = 0; r < 4; ++r) {
          const bool ok = 16 * (j * 64 + kt * 16 + 4 * g + r) + 31 <= q0 + qt * 16 + l15;
          pr[r] = ok ? exp2_(s[kt][qt][r] * sc - a.m[qt]) * cinv[qt] : 0.f;
        }
        const float below = __shfl_up(pr[3], 16);
        const float wrap = __shfl(prev3, l15 + 48);
        const float nb = g > 0 ? below : wrap;
        T[(h * 32 + qt * 16 + l15) * 65 + j * 16 + kt * 4 + g] = (pr[0] + pr[1]) + (pr[2] + 0.5f * pr[3]) + 0.5f * nb;
        prev3 = pr[3];
      }
      carry[qt] = prev3;
    }
  }
  lds_barrier();
#pragma unroll 1
  for (int qq = 0; qq < 8; ++qq) {
    const int q = h * 8 + qq, t = q0 + q, cur = t >> 6;
    const float imp = ((T[(0 * 32 + q) * 65 + lane] + T[(1 * 32 + q) * 65 + lane]) + T[(2 * 32 + q) * 65 + lane]) + T[(3 * 32 + q) * 65 + lane];
    const float val = (lane == cur || lane == 0) ? 1e4f : (lane <= cur ? imp : -1.f);
    int rank = 0;
#pragma unroll
    for (int k = 0; k < 64; ++k) {
      const float vk = __int_as_float(__builtin_amdgcn_readlane(__float_as_int(val), k));
      rank += (vk > val || (vk == val && k < lane)) ? 1 : 0;
    }
    const unsigned long long m = __ballot(rank < 16);
    if (lane == 0) selm[q] = m;
  }
  lds_barrier();
  f32x4* park = (f32x4*)T + (h * 8) * 64 + lane;
#pragma unroll
  for (int d = 0; d < 4; ++d) { park[(d * 2 + 0) * 64] = outacc[d][0]; park[(d * 2 + 1) * 64] = outacc[d][1]; }
  unsigned long long mq[2], anym = 0ull;
#pragma unroll
  for (int qt = 0; qt < 2; ++qt) mq[qt] = selm[qt * 16 + l15];
  for (int i = 0; i < 32; ++i) anym |= selm[i];
  const int jhi = (q0 + 31) >> 6;
  attn_init(a);
  for (int j = 0; j <= jhi; ++j) {
    const bool used = (anym >> j) & 1ull;
    lds_barrier();
    if (used) { kv_load(projb + PA_KS, projb + PA_VS, NP, NP, j * 64, kr); kv_store(Ks, Vs, kr); }
    lds_barrier();
    if (!used) continue;
    f32x4 s[4][2];
    auto valid = [&](int kt, int r, int qt) { return ((mq[qt] >> j) & 1ull) && (j * 64 + kt * 16 + 4 * g + r <= q0 + qt * 16 + l15); };
    qk_tile<2>(Ks, 0, qf, s, l15, g);
    softmax_pv(s, a, Vs, sc, l15, g, valid);
  }
#pragma unroll
  for (int qt = 0; qt < 2; ++qt) {
    const float lt = group_sum4(a.l[qt]);
    const float gt = sigmoidf_(smb[(size_t)(q0 + qt * 16 + l15) * NSMALL + SM_G + h * 3 + 1]) * (lt > 0.f ? 1.f / lt : 0.f);
#pragma unroll
    for (int d = 0; d < 4; ++d) park[(d * 2 + qt) * 64] += a.o[d][qt] * gt;
  }
  attn_init(a);
  const int jlo = q0 >= 511 ? (q0 - 511) >> 6 : 0;
  for (int j = jlo; j <= jhi; ++j) {
    lds_barrier();
    kv_load(projb + PA_KW, projb + PA_VW, NP, NP, j * 64, kr); kv_store(Ks, Vs, kr);
    lds_barrier();
    f32x4 s[4][2];
    auto valid = [&](int kt, int r, int qt) { const int key = j * 64 + kt * 16 + 4 * g + r, t = q0 + qt * 16 + l15; return key <= t && key + 512 > t; };
    qk_tile<2>(Ks, 0, qf, s, l15, g);
    if (j * 64 + 63 <= q0 && j * 64 + 512 > q0 + 31) softmax_pv_nomask(s, a, Vs, sc, l15, g);
    else softmax_pv(s, a, Vs, sc, l15, g, valid);
  }
  u16* Y = (u16*)(p.ws + OFF_H);
  const float* ng = p.nsa_norm_g + layer * 64;
#pragma unroll
  for (int qt = 0; qt < 2; ++qt) {
    const int t = q0 + qt * 16 + l15;
    const float lt = group_sum4(a.l[qt]);
    const float gt = sigmoidf_(smb[(size_t)t * NSMALL + SM_G + h * 3 + 2]) * (lt > 0.f ? 1.f / lt : 0.f);
    f32x4 v[4]; float ss = 0.f;
#pragma unroll
    for (int d = 0; d < 4; ++d) { v[d] = park[(d * 2 + qt) * 64] + a.o[d][qt] * gt; ss += v[d][0] * v[d][0] + v[d][1] * v[d][1] + v[d][2] * v[d][2] + v[d][3] * v[d][3]; }
    ss = group_sum4(ss);
    const float rn = rsqrtf(ss * (1.f / 64.f) + 1e-6f);
    const size_t row = (size_t)b * SEQ + t;
#pragma unroll
    for (int d = 0; d < 4; ++d) {
      const int dd = d * 16 + 4 * g;
      const u32x2 zz = *(const u32x2*)(projb + (size_t)t * NP + PA_Z + h * 64 + dd);
      const f32x4 gg = *(const f32x4*)(ng + dd);
      u32x2 o;
      o.x = pack2(v[d][0] * rn * gg[0] * siluf(bflo(zz.x)), v[d][1] * rn * gg[1] * siluf(bfhi(zz.x)));
      o.y = pack2(v[d][2] * rn * gg[2] * siluf(bflo(zz.y)), v[d][3] * rn * gg[3] * siluf(bfhi(zz.y)));
      *(u32x2*)(Y + row * 1024 + Y_A + h * 64 + dd) = o;
    }
  }
}

DI void zero_y_cols(const Params& p, int c0, int ncols, int gtid, int gthreads) {
  u16* Y = (u16*)(p.ws + OFF_H);
  const int per_row = ncols / 8;
  for (size_t i = gtid; i < (size_t)NTOK * per_row; i += gthreads) {
    const size_t row = i / per_row; const int ch = (int)(i % per_row);
    *(u32x4*)(Y + row * 1024 + c0 + ch * 8) = (u32x4){0u, 0u, 0u, 0u};
  }
}

DI void final_norm_rows(const Params& p, int gw, int nw, int lane) {
  for (int row = gw; row < NTOK; row += nw) {
    float4* xr = (float4*)(p.out + (size_t)row * D_MODEL);
    float4 v[4]; float ss = 0.f;
#pragma unroll
    for (int i = 0; i < 4; ++i) { v[i] = xr[lane + 64 * i]; ss += v[i].x * v[i].x + v[i].y * v[i].y + v[i].z * v[i].z + v[i].w * v[i].w; }
    ss = wave_sum(ss);
    const float r = rsqrtf(ss * (1.f / D_MODEL) + 1e-6f);
    const float4* gp = (const float4*)p.final_g;
#pragma unroll
    for (int i = 0; i < 4; ++i) { const float4 gg = gp[lane + 64 * i]; float4 w; w.x = v[i].x * r * gg.x; w.y = v[i].y * r * gg.y; w.z = v[i].z * r * gg.z; w.w = v[i].w * r * gg.w; xr[lane + 64 * i] = w; }
  }
}

#ifndef DEBUG_CHECK
#define DEBUG_CHECK 0
#endif
#if DEBUG_CHECK
constexpr int NCHK = 12;
DI float block_sum(float v, float* red) {
  v = wave_sum(v);
  lds_barrier();
  if ((threadIdx.x & 63) == 0) red[threadIdx.x >> 6] = v;
  lds_barrier();
  return red[0] + red[1] + red[2] + red[3];
}
DI float block_max(float v, float* red) {
#pragma unroll
  for (int o = 32; o > 0; o >>= 1) v = fmaxf(v, __shfl_xor(v, o));
  lds_barrier();
  if ((threadIdx.x & 63) == 0) red[threadIdx.x >> 6] = v;
  lds_barrier();
  return fmaxf(fmaxf(red[0], red[1]), fmaxf(red[2], red[3]));
}
DI float bfr(float v) { return bf2f(f2bf(v)); }
struct Chk { float num[NCHK], den[NCHK]; };
DI void chk_add(Chk& c, int id, float got, float ref) { const float d = got - ref; c.num[id] += d * d; c.den[id] += ref * ref; }

DI void dbg_diff_attn(const Params& p, int layer, int b, int t, int h, Chk& c, int id, unsigned char* smem) {
  float* p1 = (float*)smem; float* p2 = p1 + 4096; float* red = p2 + 4096;
  const int tid = otid();
  const u16* proj = (const u16*)(p.ws + OFF_PROJ) + (size_t)b * SEQ * NP;
  const u16* q = proj + (size_t)t * NP + PB_Q + h * 64;
  const float scale = 0.17677669529663687f;
  float m1 = -1e30f, m2 = -1e30f;
  for (int s = tid; s <= t; s += 256) {
    const u16* k = proj + (size_t)s * NP + PB_K + h * 64;
    float a1 = 0.f, a2 = 0.f;
    for (int d = 0; d < 32; ++d) { a1 += bf2f(q[d]) * bf2f(k[d]); a2 += bf2f(q[32 + d]) * bf2f(k[32 + d]); }
    a1 *= scale; a2 *= scale; p1[s] = a1; p2[s] = a2; m1 = fmaxf(m1, a1); m2 = fmaxf(m2, a2);
  }
  m1 = block_max(m1, red); m2 = block_max(m2, red);
  float l1 = 0.f, l2 = 0.f;
  for (int s = tid; s <= t; s += 256) { const float e1 = __expf(p1[s] - m1), e2 = __expf(p2[s] - m2); p1[s] = e1; p2[s] = e2; l1 += e1; l2 += e2; }
  l1 = block_sum(l1, red); l2 = block_sum(l2, red);
  const float* lam = p.diff_lam + layer * 128;
  float s01 = 0.f, s23 = 0.f;
  for (int i = 0; i < 32; ++i) { s01 += lam[i] * lam[32 + i]; s23 += lam[64 + i] * lam[96 + i]; }
  const float lam_init = 0.8f - 0.6f * expf(-0.3f * (float)layer);
  const float lam_full = expf(s01) - expf(s23) + lam_init;
  lds_barrier();
  float o = 0.f;
  if (tid < 64) for (int s = 0; s <= t; ++s) o += (p1[s] / l1 - lam_full * p2[s] / l2) * bf2f(proj[(size_t)s * NP + PB_V + h * 64 + tid]);
  float ss = block_sum(tid < 64 ? o * o : 0.f, red);
  if (tid < 64) {
    const float z = bf2f(proj[(size_t)t * NP + PB_Z + h * 64 + tid]);
    const float ref = o * rsqrtf(ss / 64.f + 1e-6f) * p.diff_norm_g[layer * 64 + tid] * (1.f - lam_init) * (z / (1.f + expf(-z)));
    const float got = bf2f(((const u16*)(p.ws + OFF_H))[((size_t)b * SEQ + t) * 1024 + Y_B + h * 64 + tid]);
    const float d = got - ref;
    o = d * d; ss = ref * ref;
  } else { o = 0.f; ss = 0.f; }
  c.num[id] += block_sum(o, red); c.den[id] += block_sum(ss, red);
}

DI float dbg_conv(const u16* projb, int t, int pcol, const float* cw, const float* cb, int ch, int nch) {
  float a = cb[ch];
  for (int j = 0; j < 4; ++j) { const int tt = t - 3 + j; if (tt >= 0) a += cw[j * nch + ch] * bf2f(projb[(size_t)tt * NP + pcol]); }
  return a / (1.f + expf(-a));
}
constexpr int DBG_NS = 11, DBG_T = 300;
DI int dbg_sample_idx(int t) {
  const int TS[DBG_NS] = {0, 1, 2, 3, 64, 127, 128, 129, 255, 256, 299};
  for (int i = 0; i < DBG_NS; ++i) if (TS[i] == t) return i;
  return -1;
}
DI int dbg_sample_t(int i) { const int TS[DBG_NS] = {0, 1, 2, 3, 64, 127, 128, 129, 255, 256, 299}; return TS[i]; }
DI void dbg_ssd(const Params& p, int layer, int b, int gi, Chk& c, int id, unsigned char* smem) {
  float* ybuf = (float*)smem;
  float* red = ybuf + DBG_NS * 128;
  const int tid = threadIdx.x, pp = tid >> 2, nq = tid & 3;
  const u16* projb = (const u16*)(p.ws + OFF_PROJ) + (size_t)b * SEQ * NP;
  const float* smb = (const float*)(p.ws + OFF_SMALL) + (size_t)b * SEQ * NSMALL;
  const float* cw = p.ssm_conv_w + layer * 4 * 512; const float* cb = p.ssm_conv_b + layer * 512;
  lds_barrier();
  for (int hh = 0; hh < 2; ++hh) {
    const int h = gi * 2 + hh;
    const float a_h = -expf(p.ssm_a_log[layer * 4 + h]), d_h = p.ssm_d[layer * 4 + h], dtb = p.ssm_dt_bias[layer * 4 + h];
    float hst[16];
    for (int i = 0; i < 16; ++i) hst[i] = 0.f;
    for (int t = 0; t < DBG_T; ++t) {
      const float xr = smb[(size_t)t * NSMALL + SM_DT + h] + dtb;
      const float dt = xr > 20.f ? xr : log1pf(expf(xr));
      const float dA = expf(dt * a_h);
      const float xp = dbg_conv(projb, t, PC_XBC + h * 64 + pp, cw, cb, h * 64 + pp, 512);
      float y = 0.f;
      for (int i = 0; i < 16; ++i) {
        const int n = nq * 16 + i;
        const float Bn = dbg_conv(projb, t, PC_XBC + 256 + gi * 64 + n, cw, cb, 256 + gi * 64 + n, 512);
        const float Cn = dbg_conv(projb, t, PC_XBC + 384 + gi * 64 + n, cw, cb, 384 + gi * 64 + n, 512);
        hst[i] = dA * hst[i] + dt * xp * Bn;
        y += Cn * hst[i];
      }
      y += __shfl_xor(y, 1); y += __shfl_xor(y, 2);
      y += d_h * xp;
      const int si = dbg_sample_idx(t);
      if (si >= 0 && nq == 0) { const float z = bf2f(projb[(size_t)t * NP + PC_Z + h * 64 + pp]); ybuf[si * 128 + hh * 64 + pp] = y * (z / (1.f + expf(-z))); }
    }
  }
  lds_barrier();
  for (int si = 0; si < DBG_NS; ++si) {
    const float v = tid < 128 ? ybuf[si * 128 + tid] : 0.f;
    const float ss = block_sum(v * v, red);
    float e2 = 0.f, r2 = 0.f;
    if (tid < 128) {
      const float ref = v * rsqrtf(ss / 128.f + 1e-6f) * p.ssm_norm_g[layer * 256 + gi * 128 + tid];
      const float got = bf2f(((const u16*)(p.ws + OFF_H))[((size_t)b * SEQ + dbg_sample_t(si)) * 1024 + Y_C + gi * 128 + tid]);
      e2 = (got - ref) * (got - ref); r2 = ref * ref;
    }
    c.num[id] += block_sum(e2, red); c.den[id] += block_sum(r2, red);
  }
}
DI void dbg_mlstm(const Params& p, int layer, int b, int h, Chk& c, int id, unsigned char* smem) {
  float* ybuf = (float*)smem;
  float* red = ybuf + DBG_NS * 128;
  const int tid = threadIdx.x, dd = tid >> 2, eq = tid & 3;
  const u16* projb = (const u16*)(p.ws + OFF_PROJ) + (size_t)b * SEQ * NP;
  const float* smb = (const float*)(p.ws + OFF_SMALL) + (size_t)b * SEQ * NSMALL;
  const float* cw = p.ml_conv_w + layer * 4 * 512; const float* cb = p.ml_conv_b + layer * 512;
  const float ib = p.ml_if_b[layer * 8 + h], fb = p.ml_if_b[layer * 8 + 4 + h];
  lds_barrier();
  float Cst[16], nst[16];
  for (int i = 0; i < 16; ++i) { Cst[i] = 0.f; nst[i] = 0.f; }
  float m = 0.f;
  for (int t = 0; t < DBG_T; ++t) {
    const float ip = smb[(size_t)t * NSMALL + SM_IF + h] + ib, fp = smb[(size_t)t * NSMALL + SM_IF + 4 + h] + fb;
    const float lf = fminf(fp, 0.f) - log1pf(expf(-fabsf(fp)));
    const float mn = fmaxf(lf + m, ip), fs = expf(lf + m - mn), is = expf(ip - mn);
    const float vd = bf2f(projb[(size_t)t * NP + PD_V + h * 64 + dd]);
    float num = 0.f, den = 0.f;
    for (int i = 0; i < 16; ++i) {
      const int e = eq * 16 + i;
      const float qe = dbg_conv(projb, t, PD_QK + h * 64 + e, cw, cb, h * 64 + e, 512);
      const float ke = 0.125f * dbg_conv(projb, t, PD_QK + 256 + h * 64 + e, cw, cb, 256 + h * 64 + e, 512);
      Cst[i] = fs * Cst[i] + is * vd * ke; nst[i] = fs * nst[i] + is * ke;
      num += Cst[i] * qe; den += nst[i] * qe;
    }
    num += __shfl_xor(num, 1); num += __shfl_xor(num, 2); den += __shfl_xor(den, 1); den += __shfl_xor(den, 2);
    const float hv = num / fmaxf(fabsf(den), expf(-mn));
    m = mn;
    const int si = dbg_sample_idx(t);
    if (si >= 0 && eq == 0) { const float o = bf2f(projb[(size_t)t * NP + PD_O + h * 64 + dd]); ybuf[si * 64 + dd] = hv / (1.f + expf(-o)); }
  }
  lds_barrier();
  for (int si = 0; si < DBG_NS; ++si) {
    const float v = tid < 64 ? ybuf[si * 64 + tid] : 0.f;
    const float ss = block_sum(v * v, red);
    float e2 = 0.f, r2 = 0.f;
    if (tid < 64) {
      const int t = dbg_sample_t(si);
      const float z = bf2f(projb[(size_t)t * NP + PD_Z + h * 64 + tid]);
      const float ref = v * rsqrtf(ss / 64.f + 1e-6f) * p.ml_norm_g[layer * 64 + tid] * (z / (1.f + expf(-z)));
      const float got = bf2f(((const u16*)(p.ws + OFF_H))[((size_t)b * SEQ + t) * 1024 + Y_D + h * 64 + tid]);
      e2 = (got - ref) * (got - ref); r2 = ref * ref;
    }
    c.num[id] += block_sum(e2, red); c.den[id] += block_sum(r2, red);
  }
}

DI void debug_checks(const Params& p, unsigned char* smem) {
  const int tid = otid();
  float* red = (float*)(smem + 36 * 1024);
  Chk c;
  for (int i = 0; i < NCHK; ++i) { c.num[i] = 0.f; c.den[i] = 0.f; }
  const float* adap = (const float*)(p.ws + OFF_ADAP);
  const u16* H = (const u16*)(p.ws + OFF_H);
  const u16* proj = (const u16*)(p.ws + OFF_PROJ);
  const float* sm = (const float*)(p.ws + OFF_SMALL);
#if DEBUG_CHECK == 1
  {
    const int bs[2] = {0, 5}; const int ns[4] = {3, 1024 + 77, 2048 + 500, 3071};
    for (int bi = 0; bi < 2; ++bi) for (int ni = 0; ni < 4; ++ni) {
      const int b = bs[bi], n = ns[ni];
      float a = 0.f;
      for (int k = tid; k < 1024; k += 256) { const float v = p.c[b * 1024 + k]; a += (v / (1.f + expf(-v))) * p.ada_w[(size_t)k * 3072 + n]; }
      const float ref = block_sum(a, red) + p.ada_b[n];
      float got = 0.f; for (int kc = 0; kc < 8; ++kc) got += adap[(((size_t)kc * 2 + 0) * 8 + b) * 3072 + n];
      chk_add(c, 1, got, ref);
    }
  }
  {
    const int ms[3] = {1, 9000, 32767};
    const int ns[14] = {0, 300, 700, 900, 1500, 2000, 2300, 2693, 3300, 3500, 3967, 3970, 3981, 3990};
    for (int mi = 0; mi < 3; ++mi) {
      const int m = ms[mi], b = m >> 12;
      float ss = 0.f;
      for (int k = tid; k < 1024; k += 256) { const float v = p.x[(size_t)m * 1024 + k]; ss += v * v; }
      ss = block_sum(ss, red);
      const float rstd = rsqrtf(ss / 1024.f + 1e-6f);
      for (int ni = 0; ni < 14; ++ni) {
        const int n = ns[ni], col = colmap(n);
        float a = 0.f, herr = 0.f, href = 0.f;
        for (int k = tid; k < 1024; k += 256) {
          float shf = 0.f, scl = 0.f;
          for (int kc = 0; kc < 8; ++kc) { const float* ap = adap + (((size_t)kc * 2 + 0) * 8 + b) * 3072; shf += ap[k]; scl += ap[1024 + k]; }
          const float hv = p.x[(size_t)m * 1024 + k] * rstd * p.norm_g[k] * (1.f + scl) + shf;
          const float hg = bf2f(H[(size_t)m * 1024 + k]);
          herr += (hg - hv) * (hg - hv); href += hv * hv;
          a += hv * p.w_in[(size_t)k * D_IN + col];
        }
        const float ref = block_sum(a, red);
        herr = block_sum(herr, red); href = block_sum(href, red);
        if (ni == 0 && DEBUG_STAGE == 1) { c.num[3] += herr; c.den[3] += href; }
        const float got = n < NP ? bf2f(proj[(size_t)m * NP + n]) : sm[(size_t)m * NSMALL + (n - NP)];
        chk_add(c, 2, got, ref);
      }
    }
  }
#endif
#if DEBUG_CHECK == 2
  dbg_diff_attn(p, 0, 0, 5, 0, c, 4, smem);
  dbg_diff_attn(p, 0, 1, 200, 3, c, 4, smem);
  dbg_diff_attn(p, 0, 3, 1500, 2, c, 4, smem);
  dbg_diff_attn(p, 0, 7, 4095, 1, c, 4, smem);
  {
    const int ms[3] = {2, 12345, 32766}; const int ns[3] = {0, 513, 1023};
    const u16* Y = (const u16*)(p.ws + OFF_H);
    for (int mi = 0; mi < 3; ++mi) for (int ni = 0; ni < 3; ++ni) {
      const int m = ms[mi], n = ns[ni], b = m >> 12;
      float a = 0.f;
      for (int k = tid; k < 1024; k += 256) a += bf2f(Y[(size_t)m * 1024 + k]) * p.w_out[(size_t)k * 1024 + n];
      a = block_sum(a, red);
      float gate = 0.f; for (int kc = 0; kc < 8; ++kc) gate += adap[(((size_t)kc * 2 + 0) * 8 + b) * 3072 + 2048 + n];
      chk_add(c, 5, p.out[(size_t)m * 1024 + n] - p.x[(size_t)m * 1024 + n], gate * a);
    }
  }
#endif
#if DEBUG_CHECK == 3
  dbg_ssd(p, 0, 0, 0, c, 6, smem);
  dbg_ssd(p, 0, 5, 1, c, 6, smem);
  dbg_mlstm(p, 0, 0, 0, c, 7, smem);
  dbg_mlstm(p, 0, 6, 3, c, 7, smem);
#endif
  lds_barrier();
  if (tid == 0) {
    int wid_ = 0, wcls = 99;
    for (int i = 1; i < NCHK; ++i) if (c.den[i] > 0.f) {
      const float rel = sqrtf(c.num[i] / c.den[i]);
      int cls = rel >= 1.f ? 0 : (int)floorf(-log10f(fmaxf(rel, 1e-9f)));
      if (cls > 9) cls = 9;
      if (!(rel == rel)) cls = 0;
      if (cls < wcls) { wcls = cls; wid_ = i; }
    }
    p.out[0] = 1e5f * ((float)wid_ + 0.1f * (float)wcls);
  }
}
#endif

constexpr int HALF_LDS = 76 * 1024;
constexpr int SMEM_BYTES = 2 * HALF_LDS;
__global__ void __launch_bounds__(512, 2) fwd_megakernel(Params p) {
  cg::grid_group grid = cg::this_grid();
  __shared__ __attribute__((aligned(16))) unsigned char smem[SMEM_BYTES];
  const int half = __builtin_amdgcn_readfirstlane(threadIdx.x >> 8);
  unsigned char* hsm = smem + half * HALF_LDS;
  const int G = gridDim.x, bid = blockIdx.x;
  const int slot = bid * 2 + half, NS = 2 * G;
  for (int t = slot; t < ((T0_TOTAL + NS - 1) / NS) * NS; t += NS) phase0_task(p, t < T0_TOTAL ? t : T0_TOTAL - 1, hsm);
  grid.sync();
  for (int layer = 0; layer < 2; ++layer) {
    Params q = p;
    asm volatile("" : "+s"(q.ws));
    const float* xin = layer == 0 ? q.x : q.out;
    for (int t = slot; t < ((NTOK / 64 + NS - 1) / NS) * NS; t += NS) phase1_task(q, layer, xin, t < NTOK / 64 ? t : NTOK / 64 - 1, hsm);
    grid.sync();
    for (int t = bid; t < (NTOK / 256) * (NPAD / 256); t += G) gemm_inproj_tile(q, layer, t, smem);
    grid.sync();
#if DEBUG_CHECK == 1
    if (bid == 0 && half == 0) debug_checks(q, smem);
    return;
#endif
    {
      unsigned* cnt = (unsigned*)(q.ws + OFF_CNT);
      int* s_pair = (int*)(smem + SMEM_BYTES - 16);
      if (bid < 16) ssd_task(q, layer, slot >> 2, slot & 3, hsm);
      else if (bid < 32) mlstm_task(q, layer, (slot - 32) >> 2, (slot - 32) & 3, hsm);
      constexpr int NPAIR_C = 64, NPAIR_D = 512, NPAIR_N = 512, NPAIR = NPAIR_C + NPAIR_D + NPAIR_N;
      for (;;) {
        const int t512 = otid512();
        lds_barrier();
        if (t512 == 0) *s_pair = (int)atomicAdd(cnt + layer, 1u);
        lds_barrier();
        const int pair = *s_pair;
        if (pair >= NPAIR) break;
        if (pair < NPAIR_C) {
          const int v = pair * 2 + half;
          compress_task(q, layer, v >> 4, (v >> 3) & 1, v & 7, hsm);
          asm volatile("s_waitcnt vmcnt(0)" ::: "memory");
          lds_barrier();
          if (t512 == 0) {
            __builtin_amdgcn_fence(__ATOMIC_RELEASE, "agent");
            asm volatile("s_waitcnt vmcnt(0)" ::: "memory");
            __hip_atomic_fetch_add(cnt + 2 + layer, 1u, __ATOMIC_RELAXED, __HIP_MEMORY_SCOPE_AGENT);
          }
        } else if (pair < NPAIR_C + NPAIR_D) {
          const int u = (pair - NPAIR_C) * 2 + half, qb = 31 - (u >> 5), bh = u & 31;
          diff_attn_task(q, layer, bh >> 2, bh & 3, qb, hsm);
        } else {
          if (t512 == 0) {
            while (__hip_atomic_load(cnt + 2 + layer, __ATOMIC_RELAXED, __HIP_MEMORY_SCOPE_AGENT) < (unsigned)NPAIR_C) __builtin_amdgcn_s_sleep(16);
            __builtin_amdgcn_fence(__ATOMIC_ACQUIRE, "agent");
            asm volatile("s_waitcnt vmcnt(0)" ::: "memory");
          }
          lds_barrier();
          const int u = (pair - NPAIR_C - NPAIR_D) * 2 + half;
          nsa_task(q, layer, u & 7, 127 - (u >> 3), hsm);
        }
      }
    }
    grid.sync();
    for (int t = slot; t < NTOK / 64; t += NS) seq_fix_rows(q, layer, t * 64, 64);
    grid.sync();
    for (int t = bid; t < (NTOK / 256) * 4; t += G) gemm_outproj_tile(q, layer, xin, q.out, t, smem);
    grid.sync();
#if DEBUG_CHECK >= 2
    if (bid == 0 && half == 0) debug_checks(q, smem);
    return;
#endif
  }
  { const int t5 = otid512(); final_norm_rows(p, bid * 8 + (t5 >> 6), G * 8, t5 & 63); }
}

extern "C" void kernel_launch(void* const* d_in, const int* in_sizes, int n_in, void* d_out, int out_size, void* d_ws, size_t ws_size,
                              hipStream_t stream) {
  static int grid_blocks = 0;
  if (!grid_blocks) {
    int dev = 0, cus = 0, per_cu = 0;
    (void)hipGetDevice(&dev);
    (void)hipDeviceGetAttribute(&cus, hipDeviceAttributeMultiprocessorCount, dev);
    (void)hipOccupancyMaxActiveBlocksPerMultiprocessor(&per_cu, fwd_megakernel, 512, 0);
    if (per_cu > 1) per_cu = 1;
    if (per_cu < 1) per_cu = 1;
    grid_blocks = cus * per_cu;
  }
  if (grid_blocks < 64 || (grid_blocks & 3)) { fprintf(stderr, "grid too small: %d\n", grid_blocks); return; }
  if (ws_size < WS_NEEDED) { fprintf(stderr, "workspace too small: %zu < %zu\n", ws_size, WS_NEEDED); return; }
  Params p{};
  const float** pp = (const float**)&p;
  for (int i = 0; i < 26; ++i) pp[i] = (const float*)d_in[i];
  p.out = (float*)d_out; p.ws = (unsigned char*)d_ws;
  (void)hipMemsetAsync((unsigned char*)d_ws + OFF_CNT, 0, 64, stream);
  void* args[] = {&p};
  hipError_t e = hipLaunchCooperativeKernel((void*)fwd_megakernel, dim3(grid_blocks), dim3(512), args, 0, stream);
  if (e != hipSuccess) fprintf(stderr, "cooperative launch failed: %s (grid %d)\n", hipGetErrorString(e), grid_blocks);
}
```

```cpp
#include <hip/hip_runtime.h>
#include <hip/hip_cooperative_groups.h>
#include <cstdio>
#include <cstdint>
#define DEBUG_CHECK 0
#define DEBUG_STAGE 1
#define REP_P1 1
#define REP_P2 1
#define REP_SEQ 1
#define REP_DIFF 1
#define REP_NSA 1
#define REP_P4 1
#define REP_P0 1
namespace cg = cooperative_groups;

typedef unsigned short u16;
typedef short bf16x8 __attribute__((ext_vector_type(8)));
typedef short s16x4 __attribute__((ext_vector_type(4)));
typedef float f32x4 __attribute__((ext_vector_type(4)));
typedef float f32x2 __attribute__((ext_vector_type(2)));
typedef unsigned u32x4 __attribute__((ext_vector_type(4)));
typedef unsigned u32x2 __attribute__((ext_vector_type(2)));
typedef __bf16 bf16x2_t __attribute__((ext_vector_type(2)));
#define DI __device__ __forceinline__
#define LDSP __attribute__((address_space(3)))

constexpr int D_MODEL = 1024, BATCH = 8, SEQ = 4096, NTOK = BATCH * SEQ;
constexpr int D_IN = 3992;
constexpr int NP = 3968, NPAD = 4096, NSMALL = 32;
constexpr int PA_Q = 0, PA_KC = 256, PA_VC = 320, PA_KS = 384, PA_VS = 448, PA_KW = 512, PA_VW = 576, PA_Z = 640;
constexpr int PB_Q = 896, PB_K = 1152, PB_V = 1408, PB_Z = 1664;
constexpr int PC_Z = 1920, PC_XBC = 2176;
constexpr int PD_QK = 2688, PD_V = 3200, PD_O = 3456, PD_Z = 3712;
constexpr int SM_G = 0, SM_DT = 12, SM_IF = 16;
constexpr int Y_A = 0, Y_B = 256, Y_C = 512, Y_D = 768;

constexpr size_t MiB = 1024 * 1024;
constexpr size_t OFF_WINT = 0;
constexpr size_t OFF_WOUTT = 16 * MiB;
constexpr size_t OFF_W1T = 20 * MiB;
constexpr size_t OFF_W2T = 22 * MiB;
constexpr size_t OFF_BIAS1 = 22 * MiB + 64 * 1024;
constexpr size_t OFF_ADAP = 22 * MiB + 128 * 1024;
constexpr size_t OFF_KCMP = 24 * MiB;
constexpr size_t OFF_VCMP = 24 * MiB + 256 * 1024;
constexpr size_t OFF_CNT = 29 * MiB;
constexpr size_t OFF_SMALL = 25 * MiB;
constexpr size_t OFF_SSQ = 29 * MiB;
constexpr size_t OFF_H = 32 * MiB;
constexpr size_t OFF_PROJ = 96 * MiB;
constexpr size_t WS_NEEDED = 96 * MiB + (size_t)NTOK * NP * 2;

struct Params {
  const float* x; const float* c; const float* norm_g; const float* ada_w; const float* ada_b;
  const float* w_in; const float* w_out;
  const float* nsa_cmp_pos; const float* nsa_ck_w1; const float* nsa_ck_w2; const float* nsa_cv_w1; const float* nsa_cv_w2; const float* nsa_norm_g;
  const float* diff_lam; const float* diff_norm_g;
  const float* ssm_conv_w; const float* ssm_conv_b; const float* ssm_dt_bias; const float* ssm_a_log; const float* ssm_d; const float* ssm_norm_g;
  const float* ml_conv_w; const float* ml_conv_b; const float* ml_if_b; const float* ml_norm_g; const float* final_g;
  float* out; unsigned char* ws;
};

DI void lds_barrier() { asm volatile("s_waitcnt lgkmcnt(0)" ::: "memory"); __builtin_amdgcn_s_barrier(); asm volatile("" ::: "memory"); }
DI int otid() { int t = threadIdx.x & 255; asm volatile("" : "+v"(t)); return t; }
DI int otid512() { int t = threadIdx.x; asm volatile("" : "+v"(t)); return t; }
DI unsigned pack2(float a, float b) { f32x2 v = {a, b}; bf16x2_t r = __builtin_convertvector(v, bf16x2_t); return __builtin_bit_cast(unsigned, r); }
DI u16 f2bf(float a) { return (u16)(pack2(a, 0.f) & 0xffffu); }
DI float bf2f(u16 h) { return __uint_as_float(((unsigned)h) << 16); }
DI float bflo(unsigned u) { return __uint_as_float(u << 16); }
DI float bfhi(unsigned u) { return __uint_as_float(u & 0xffff0000u); }
DI f32x4 mfma16(bf16x8 a, bf16x8 b, f32x4 c) { return __builtin_amdgcn_mfma_f32_16x16x32_bf16(a, b, c, 0, 0, 0); }
DI float wave_sum(float v) {
#pragma unroll
  for (int o = 32; o > 0; o >>= 1) v += __shfl_xor(v, o);
  return v;
}
DI float siluf(float v) { return v * __builtin_amdgcn_rcpf(1.f + __expf(-v)); }
DI float sigmoidf_(float v) { return __builtin_amdgcn_rcpf(1.f + __expf(-v)); }
DI float exp2_(float v) { return __builtin_amdgcn_exp2f(v); }
DI s16x4 tr_read(const u16* p) { return __builtin_amdgcn_ds_read_tr16_b64_v4i16((LDSP s16x4*)p); }
DI bf16x8 cat4(s16x4 a, s16x4 b) { bf16x8 r; r[0] = a[0]; r[1] = a[1]; r[2] = a[2]; r[3] = a[3]; r[4] = b[0]; r[5] = b[1]; r[6] = b[2]; r[7] = b[3]; return r; }
DI bf16x8 ldfrag(const u16* p) { return *(const bf16x8*)p; }

DI int colmap(int n) {
  if (n < 640) return n;
  if (n < 896) return 652 + (n - 640);
  if (n < 1920) return 908 + (n - 896);
  if (n < 2688) return 1932 + (n - 1920);
  if (n < 3456) return 2704 + (n - 2688);
  if (n < 3968) return 3480 + (n - 3456);
  if (n < 3980) return 640 + (n - 3968);
  if (n < 3984) return 2700 + (n - 3980);
  if (n < 3992) return 3472 + (n - 3984);
  return -1;
}

DI void tconv_tile(const float* __restrict__ src, int ldsrc, int k0, int n0, u16* __restrict__ dst, int ldd, bool use_map, unsigned char* smem) {
  float* tile = (float*)smem;
  const int tid = otid();
  lds_barrier();
  {
    const int nn = tid & 63; int col = n0 + nn; if (use_map) col = colmap(col);
#pragma unroll
    for (int i = 0; i < 16; ++i) { const int kk = i * 4 + (tid >> 6); tile[kk * 65 + nn] = col >= 0 ? src[(size_t)(k0 + kk) * ldsrc + col] : 0.f; }
  }
  lds_barrier();
#pragma unroll
  for (int i = 0; i < 2; ++i) {
    const int item = tid + 256 * i, nn = item >> 3, kc = item & 7;
    u32x4 w;
    w.x = pack2(tile[(kc * 8 + 0) * 65 + nn], tile[(kc * 8 + 1) * 65 + nn]);
    w.y = pack2(tile[(kc * 8 + 2) * 65 + nn], tile[(kc * 8 + 3) * 65 + nn]);
    w.z = pack2(tile[(kc * 8 + 4) * 65 + nn], tile[(kc * 8 + 5) * 65 + nn]);
    w.w = pack2(tile[(kc * 8 + 6) * 65 + nn], tile[(kc * 8 + 7) * 65 + nn]);
    *(u32x4*)(dst + (size_t)(n0 + nn) * ldd + k0 + kc * 8) = w;
  }
}

constexpr int T0_WIN = 2 * 16 * 64, T0_WOUT = 2 * 16 * 16, T0_W1 = 4 * 32 * 2, T0_W2 = 4 * 2, T0_ADA = 2 * 12 * 8, T0_B1 = 64;
constexpr int T0_TOTAL = T0_WIN + T0_WOUT + T0_W1 + T0_W2 + T0_ADA + T0_B1;

DI void phase0_task(const Params& p, int t, unsigned char* smem) {
  const int tid = otid();
  if (t < T0_WIN) {
    const int l = t / 1024, r = t % 1024, kt = r / 64, nt = r % 64;
    tconv_tile(p.w_in + (size_t)l * D_MODEL * D_IN, D_IN, kt * 64, nt * 64, (u16*)(p.ws + OFF_WINT) + (size_t)l * NPAD * 1024, 1024, true, smem);
    return;
  }
  t -= T0_WIN;
  if (t < T0_WOUT) {
    const int l = t / 256, r = t % 256, kt = r / 16, nt = r % 16;
    tconv_tile(p.w_out + (size_t)l * 1024 * 1024, 1024, kt * 64, nt * 64, (u16*)(p.ws + OFF_WOUTT) + (size_t)l * 1024 * 1024, 1024, false, smem);
    return;
  }
  t -= T0_WOUT;
  if (t < T0_W1) {
    const int m = t / 64, r = t % 64, kt = r / 2, nt = r % 2, l = m >> 1, kv = m & 1;
    const float* src = (kv ? p.nsa_cv_w1 : p.nsa_ck_w1) + (size_t)l * 2048 * 128;
    tconv_tile(src, 128, kt * 64, nt * 64, (u16*)(p.ws + OFF_W1T) + (size_t)m * 128 * 2048, 2048, false, smem);
    return;
  }
  t -= T0_W1;
  if (t < T0_W2) {
    const int m = t / 2, kt = t % 2, l = m >> 1, kv = m & 1;
    const float* src = (kv ? p.nsa_cv_w2 : p.nsa_ck_w2) + (size_t)l * 128 * 64;
    tconv_tile(src, 64, kt * 64, 0, (u16*)(p.ws + OFF_W2T) + (size_t)m * 64 * 128, 128, false, smem);
    return;
  }
  t -= T0_W2;
  if (t < T0_ADA) {
    const int l = t / 96, r = t % 96, nc = r / 8, kc = r % 8;
    float* cact = (float*)smem;
    lds_barrier();
    for (int i = tid; i < 1024; i += 256) { const int b = i >> 7, kk = i & 127; const float v = p.c[b * 1024 + kc * 128 + kk]; cact[i] = siluf(v); }
    lds_barrier();
    const int n = nc * 256 + tid;
    float acc[8];
#pragma unroll
    for (int b = 0; b < 8; ++b) acc[b] = 0.f;
    const float* w = p.ada_w + ((size_t)l * 1024 + kc * 128) * 3072 + n;
#pragma unroll 16
    for (int kk = 0; kk < 128; ++kk) {
      const float wv = w[(size_t)kk * 3072];
#pragma unroll
      for (int b = 0; b < 8; ++b) acc[b] += cact[b * 128 + kk] * wv;
    }
    float* adap = (float*)(p.ws + OFF_ADAP);
    const float bias = kc == 0 ? p.ada_b[l * 3072 + n] : 0.f;
#pragma unroll
    for (int b = 0; b < 8; ++b) adap[(((size_t)kc * 2 + l) * 8 + b) * 3072 + n] = acc[b] + bias;
    return;
  }
  t -= T0_ADA;
  {
    const int m = t >> 4, kc = t & 15, l = m >> 1, kv = m & 1;
    const float* w1 = (kv ? p.nsa_cv_w1 : p.nsa_ck_w1) + (size_t)l * 2048 * 128;
    const float* pos = p.nsa_cmp_pos + (size_t)l * 2048;
    const int n = tid & 127, half = tid >> 7;
    float acc = 0.f;
    const int k0 = kc * 128 + half * 64;
#pragma unroll 16
    for (int k = 0; k < 64; ++k) acc += pos[k0 + k] * w1[(size_t)(k0 + k) * 128 + n];
    float* red = (float*)smem;
    lds_barrier();
    red[tid] = acc;
    lds_barrier();
    if (tid < 128) ((float*)(p.ws + OFF_BIAS1))[(m * 16 + kc) * 128 + tid] = red[tid] + red[tid + 128];
  }
}

DI void phase1_task(const Params& p, int layer, const float* xin, int grp, unsigned char* smem) {
  const int tid = otid(), lane = tid & 63, wid = tid >> 6;
  const int b = grp >> 6;
  float* mul = (float*)smem;
  float* sh = mul + 1024;
  const float* adap = (const float*)(p.ws + OFF_ADAP);
  lds_barrier();
  for (int c = tid; c < 1024; c += 256) {
    float s0 = 0.f, s1 = 0.f;
#pragma unroll
    for (int kc = 0; kc < 8; ++kc) { const float* a = adap + (((size_t)kc * 2 + layer) * 8 + b) * 3072; s0 += a[c]; s1 += a[1024 + c]; }
    mul[c] = p.norm_g[layer * 1024 + c] * (1.f + s1); sh[c] = s0;
  }
  lds_barrier();
  u16* H = (u16*)(p.ws + OFF_H);
#pragma unroll 1
  for (int it = 0; it < 4; ++it) {
    float4 v[4][4]; float ss[4];
#pragma unroll
    for (int j = 0; j < 4; ++j) {
      const int row = grp * 64 + wid * 16 + it * 4 + j;
      const float4* xr = (const float4*)(xin + (size_t)row * D_MODEL);
#pragma unroll
      for (int i = 0; i < 4; ++i) v[j][i] = xr[lane + 64 * i];
    }
#pragma unroll
    for (int j = 0; j < 4; ++j) {
      float a = 0.f;
#pragma unroll
      for (int i = 0; i < 4; ++i) a += v[j][i].x * v[j][i].x + v[j][i].y * v[j][i].y + v[j][i].z * v[j][i].z + v[j][i].w * v[j][i].w;
      ss[j] = wave_sum(a);
    }
#pragma unroll
    for (int j = 0; j < 4; ++j) {
      const int row = grp * 64 + wid * 16 + it * 4 + j;
      const float r = rsqrtf(ss[j] * (1.f / D_MODEL) + 1e-6f);
#pragma unroll
      for (int i = 0; i < 4; ++i) {
        const int c = (lane + 64 * i) * 4;
        u32x2 w;
        w.x = pack2(v[j][i].x * r * mul[c] + sh[c], v[j][i].y * r * mul[c + 1] + sh[c + 1]);
        w.y = pack2(v[j][i].z * r * mul[c + 2] + sh[c + 2], v[j][i].w * r * mul[c + 3] + sh[c + 3]);
        *(u32x2*)(H + (size_t)row * 1024 + c) = w;
      }
    }
  }
}

namespace g8 {
constexpr int BM = 256, BK = 64, HALF = 128, HT = HALF * BK;
constexpr int LDS_BYTES = 8 * HT * 2;
DI int lds_byte(int r, int c) { const int st = (r >> 4) * 2 + (c >> 5), rr = r & 15, cc = c & 31, ob = rr * 64 + cc * 2; return st * 1024 + (ob ^ (((ob >> 9) & 1) << 5)); }
DI void stage_rc(int b, int& R, int& C) { const int st = b / 1024, sb = b % 1024, swz = sb ^ (((sb >> 9) & 1) << 5); R = (st >> 1) * 16 + swz / 64; C = (st & 1) * 32 + (swz % 64) / 2; }

DI void kloop(const u16* __restrict__ A, const u16* __restrict__ Bt, int K, int brow, int bcol, unsigned char* smem, f32x4 (&acc)[2][2][4][2]) {
  u16* shm = (u16*)smem;
  const int tid = otid512();
#define SA(b, h) (shm + ((b) * 2 + (h)) * HT)
#define SB(b, h) (shm + (4 + (b) * 2 + (h)) * HT)
#define STAGE(P, BASE, br, kt) do { const u16* _gb = BASE + ((long)(br) * K + (long)(kt) * BK); \
      __builtin_amdgcn_global_load_lds((const unsigned*)(_gb + soff0), (LDSP unsigned*)((LDSP char*)(P) + tid * 16), 16, 0, 0); \
      __builtin_amdgcn_global_load_lds((const unsigned*)(_gb + soff1), (LDSP unsigned*)((LDSP char*)(P) + tid * 16 + 8192), 16, 0, 0); } while (0)
#define LDA(dst, b, h) _Pragma("unroll") for (int m = 0; m < 4; ++m) _Pragma("unroll") for (int k = 0; k < 2; ++k) \
    dst[m][k] = *reinterpret_cast<const bf16x8*>((const char*)SA(b, h) + lds_byte(wr * 64 + m * 16 + fr, k * 32 + fq * 8))
#define LDB(dst, b, h) _Pragma("unroll") for (int n = 0; n < 2; ++n) _Pragma("unroll") for (int k = 0; k < 2; ++k) \
    dst[n][k] = *reinterpret_cast<const bf16x8*>((const char*)SB(b, h) + lds_byte(wc * 32 + n * 16 + fr, k * 32 + fq * 8))
#define MMA(ai, bj, At_, Bt_) do { __builtin_amdgcn_s_setprio(1); \
    _Pragma("unroll") for (int m = 0; m < 4; ++m) _Pragma("unroll") for (int n = 0; n < 2; ++n) _Pragma("unroll") for (int k = 0; k < 2; ++k) \
      acc[ai][bj][m][n] = __builtin_amdgcn_mfma_f32_16x16x32_bf16(Bt_[n][k], At_[m][k], acc[ai][bj][m][n], 0, 0, 0); \
    __builtin_amdgcn_s_setprio(0); } while (0)
#define WAIT_V(n) asm volatile("s_waitcnt vmcnt(" #n ")" ::: "memory")
#define WAIT_L(n) asm volatile("s_waitcnt lgkmcnt(" #n ")" ::: "memory")
#define BAR __builtin_amdgcn_s_barrier()
#define SCHED __builtin_amdgcn_sched_barrier(0)
  const int wid = __builtin_amdgcn_readfirstlane(tid >> 6), lane = tid & 63, wr = wid >> 2, wc = wid & 3, fr = lane & 15, fq = lane >> 4;
#pragma unroll
  for (int a = 0; a < 2; ++a)
#pragma unroll
    for (int b = 0; b < 2; ++b)
#pragma unroll
      for (int m = 0; m < 4; ++m) { acc[a][b][m][0] = (f32x4){0.f, 0.f, 0.f, 0.f}; acc[a][b][m][1] = (f32x4){0.f, 0.f, 0.f, 0.f}; }
  bf16x8 At[4][2], B0[2][2], B1[2][2];
  const int nt = K / BK;
  int soff0, soff1;
  { int r_, c_; stage_rc(tid * 16, r_, c_); soff0 = r_ * K + c_; stage_rc(tid * 16 + 8192, r_, c_); soff1 = r_ * K + c_; }
  STAGE(SB(0, 0), Bt, bcol, 0); STAGE(SA(0, 0), A, brow, 0);
  STAGE(SB(0, 1), Bt, bcol + HALF, 0); STAGE(SA(0, 1), A, brow + HALF, 0);
  if (wr == 1) BAR;
  WAIT_V(4); BAR;
  STAGE(SB(1, 0), Bt, bcol, 1); STAGE(SA(1, 0), A, brow, 1); STAGE(SB(1, 1), Bt, bcol + HALF, 1);
  WAIT_V(6); BAR;
#pragma unroll 1
  for (int t = 0; t < nt - 2; t += 2) {
    asm volatile("" : "+v"(soff0), "+v"(soff1));
    LDB(B0, 0, 0); SCHED; LDA(At, 0, 0); STAGE(SA(1, 1), A, brow + HALF, t + 1);
    WAIT_L(8); BAR; WAIT_L(0); MMA(0, 0, At, B0); BAR; SCHED;
    LDB(B1, 0, 1); STAGE(SB(0, 0), Bt, bcol, t + 2);
    BAR; WAIT_L(0); MMA(0, 1, At, B1); BAR;
    LDA(At, 0, 1); STAGE(SA(0, 0), A, brow, t + 2);
    BAR; WAIT_L(0); MMA(1, 0, At, B0); BAR; SCHED;
    STAGE(SB(0, 1), Bt, bcol + HALF, t + 2);
    WAIT_V(6); BAR; MMA(1, 1, At, B1); BAR;
    LDB(B0, 1, 0); SCHED; LDA(At, 1, 0); STAGE(SA(0, 1), A, brow + HALF, t + 2);
    WAIT_L(8); BAR; WAIT_L(0); MMA(0, 0, At, B0); BAR; SCHED;
    LDB(B1, 1, 1); STAGE(SB(1, 0), Bt, bcol, t + 3);
    BAR; WAIT_L(0); MMA(0, 1, At, B1); BAR;
    LDA(At, 1, 1); STAGE(SA(1, 0), A, brow, t + 3);
    BAR; WAIT_L(0); MMA(1, 0, At, B0); BAR; SCHED;
    STAGE(SB(1, 1), Bt, bcol + HALF, t + 3);
    WAIT_V(6); BAR; MMA(1, 1, At, B1); BAR;
  }
  { LDB(B0, 0, 0); LDA(At, 0, 0); STAGE(SA(1, 1), A, brow + HALF, nt - 1);
    BAR; WAIT_L(0); MMA(0, 0, At, B0); BAR;
    LDB(B1, 0, 1); BAR; WAIT_L(0); MMA(0, 1, At, B1); BAR;
    LDA(At, 0, 1); WAIT_V(4); BAR; WAIT_L(0); MMA(1, 0, At, B0); MMA(1, 1, At, B1); BAR; }
  { LDB(B0, 1, 0); LDA(At, 1, 0); WAIT_V(2); BAR; WAIT_L(0); MMA(0, 0, At, B0); BAR;
    LDB(B1, 1, 1); WAIT_V(0); BAR; WAIT_L(0); MMA(0, 1, At, B1); BAR;
    LDA(At, 1, 1); BAR; WAIT_L(0); MMA(1, 0, At, B0); MMA(1, 1, At, B1); BAR; }
  if (wr == 0) BAR;
#undef SA
#undef SB
#undef STAGE
#undef LDA
#undef LDB
#undef MMA
#undef WAIT_V
#undef WAIT_L
#undef BAR
#undef SCHED
}
DI void tile_map(int wgid, int nM, int nN, int& pm, int& pn) {
  const int nwg = nM * nN, NXCD = 8, WGM = 8;
  { const int q = nwg / NXCD, r = nwg % NXCD, xcd = wgid % NXCD, off = wgid / NXCD; wgid = (xcd < r ? xcd * (q + 1) : r * (q + 1) + (xcd - r) * q) + off; }
  const int nig = WGM * nN, gid = wgid / nig, fm = gid * WGM, gsz = (nM - fm) < WGM ? (nM - fm) : WGM;
  pm = fm + ((wgid % nig) % gsz); pn = (wgid % nig) / gsz;
}
}

DI void gemm_inproj_tile(const Params& p, int layer, int tile, unsigned char* smem) {
  int pm, pn; g8::tile_map(tile, NTOK / 256, NPAD / 256, pm, pn);
  const int brow = pm * 256, bcol = pn * 256;
  f32x4 acc[2][2][4][2];
  g8::kloop((const u16*)(p.ws + OFF_H), (const u16*)(p.ws + OFF_WINT) + (size_t)layer * NPAD * 1024, 1024, brow, bcol, smem, acc);
  const int tid = otid512(), wid = __builtin_amdgcn_readfirstlane(tid >> 6), lane = tid & 63, wr = wid >> 2, wc = wid & 3, fr = lane & 15, fq = lane >> 4;
  u16* proj = (u16*)(p.ws + OFF_PROJ);
  if (pn == 15 && wc == 0) {
    float* sm = (float*)(p.ws + OFF_SMALL);
#pragma unroll
    for (int ai = 0; ai < 2; ++ai)
#pragma unroll
      for (int m = 0; m < 4; ++m)
#pragma unroll
        for (int n = 0; n < 2; ++n) {
          const int mr = brow + ai * 128 + wr * 64 + m * 16 + fr;
          *(f32x4*)(sm + (size_t)mr * NSMALL + n * 16 + 4 * fq) = acc[ai][1][m][n];
        }
  }
  constexpr int CLD = 264;
  u16* Cs = (u16*)smem;
#pragma unroll
  for (int ai = 0; ai < 2; ++ai) {
    lds_barrier();
#pragma unroll
    for (int bj = 0; bj < 2; ++bj)
#pragma unroll
      for (int m = 0; m < 4; ++m)
#pragma unroll
        for (int n = 0; n < 2; ++n) {
          const f32x4 v = acc[ai][bj][m][n];
          u32x2 w; w.x = pack2(v[0], v[1]); w.y = pack2(v[2], v[3]);
          *(u32x2*)(Cs + (wr * 64 + m * 16 + fr) * CLD + bj * 128 + wc * 32 + n * 16 + 4 * fq) = w;
        }
    lds_barrier();
#pragma unroll
    for (int i = 0; i < 8; ++i) {
      const int id = tid + 512 * i, row = id >> 5, ch = id & 31;
      if (bcol + ch * 8 < NP) *(u32x4*)(proj + (size_t)(brow + ai * 128 + row) * NP + bcol + ch * 8) = *(const u32x4*)(Cs + row * CLD + ch * 8);
    }
  }
  asm volatile("s_waitcnt vmcnt(0)" ::: "memory");
  lds_barrier();
}

DI void gemm_outproj_tile(const Params& p, int layer, const float* xin, float* xout, int tile, unsigned char* smem) {
  int pm, pn; g8::tile_map(tile, NTOK / 256, 4, pm, pn);
  const int brow = pm * 256, bcol = pn * 256;
  f32x4 acc[2][2][4][2];
  g8::kloop((const u16*)(p.ws + OFF_H), (const u16*)(p.ws + OFF_WOUTT) + (size_t)layer * 1024 * 1024, 1024, brow, bcol, smem, acc);
  const int tid = otid512(), wid = __builtin_amdgcn_readfirstlane(tid >> 6), lane = tid & 63, wr = wid >> 2, wc = wid & 3, fr = lane & 15, fq = lane >> 4;
  const int b = brow >> 12;
  const float* adap = (const float*)(p.ws + OFF_ADAP);
  constexpr int CLD = 132;
  float* Cs = (float*)smem;
#pragma unroll
  for (int ai = 0; ai < 2; ++ai)
#pragma unroll
    for (int bj = 0; bj < 2; ++bj) {
      lds_barrier();
#pragma unroll
      for (int m = 0; m < 4; ++m)
#pragma unroll
        for (int n = 0; n < 2; ++n) *(f32x4*)(Cs + (wr * 64 + m * 16 + fr) * CLD + wc * 32 + n * 16 + 4 * fq) = acc[ai][bj][m][n];
      lds_barrier();
      const int ch = tid & 31, nc = bcol + bj * 128 + ch * 4;
      f32x4 gt = {0.f, 0.f, 0.f, 0.f};
#pragma unroll
      for (int kc = 0; kc < 8; ++kc) gt += *(const f32x4*)(adap + (((size_t)kc * 2 + layer) * 8 + b) * 3072 + 2048 + nc);
      f32x4 xv[8];
#pragma unroll
      for (int i = 0; i < 8; ++i) xv[i] = *(const f32x4*)(xin + (size_t)(brow + ai * 128 + (tid >> 5) + 16 * i) * 1024 + nc);
#pragma unroll
      for (int i = 0; i < 8; ++i) {
        const int row = (tid >> 5) + 16 * i;
        *(f32x4*)(xout + (size_t)(brow + ai * 128 + row) * 1024 + nc) = xv[i] + gt * *(const f32x4*)(Cs + row * CLD + ch * 4);
      }
    }
  asm volatile("s_waitcnt vmcnt(0)" ::: "memory");
  lds_barrier();
}

constexpr int KLD = 72;
struct KVRegs { u32x4 k[2], v[2]; };
DI void kv_load(const u16* kbase, const u16* vbase, int ldk, int ldv, int key0, KVRegs& r) {
  const int tid = otid();
#pragma unroll
  for (int i = 0; i < 2; ++i) {
    const int id = tid + 256 * i, row = id >> 3, ch = id & 7;
    r.k[i] = *(const u32x4*)(kbase + (size_t)(key0 + row) * ldk + ch * 8);
    r.v[i] = *(const u32x4*)(vbase + (size_t)(key0 + row) * ldv + ch * 8);
  }
}
DI void kv_store(u16* Ks, u16* Vs, const KVRegs& r) {
  const int tid = otid();
#pragma unroll
  for (int i = 0; i < 2; ++i) {
    const int id = tid + 256 * i, row = id >> 3, ch = id & 7;
    *(u32x4*)(Ks + row * KLD + ch * 8) = r.k[i];
    *(u32x4*)(Vs + row * KLD + ch * 8) = r.v[i];
  }
}
constexpr int KVBUF = 2 * 64 * KLD;
template <class UseF, class LoadF, class CompF>
DI void kv_pipeline(int j0, int j1, u16* buf, UseF use, LoadF load, CompF comp) {
  KVRegs kr;
  if (use(j0)) load(j0, kr);
  lds_barrier();
  if (use(j0)) kv_store(buf, buf + 64 * KLD, kr);
  if (j0 + 1 < j1 && use(j0 + 1)) load(j0 + 1, kr);
  lds_barrier();
  for (int j = j0; j < j1; ++j) {
    u16* cur = buf + ((j - j0) & 1) * KVBUF; u16* nxt = buf + (((j - j0) & 1) ^ 1) * KVBUF;
    if (j + 1 < j1 && use(j + 1)) kv_store(nxt, nxt + 64 * KLD, kr);
    if (j + 2 < j1 && use(j + 2)) load(j + 2, kr);
    if (use(j)) comp(j, cur, cur + 64 * KLD);
    lds_barrier();
  }
}
struct AttnAcc { f32x4 o[4][2]; float m[2], l[2]; };
DI void attn_init(AttnAcc& a) {
#pragma unroll
  for (int d = 0; d < 4; ++d) { a.o[d][0] = (f32x4){0.f, 0.f, 0.f, 0.f}; a.o[d][1] = (f32x4){0.f, 0.f, 0.f, 0.f}; }
  a.m[0] = a.m[1] = -1e30f; a.l[0] = a.l[1] = 0.f;
}
template <int NKS>
DI void qk_tile(const u16* Ks, int dofs, const bf16x8 (&qf)[2][NKS], f32x4 (&s)[4][2], int l15, int g) {
#pragma unroll
  for (int kt = 0; kt < 4; ++kt) {
    s[kt][0] = (f32x4){0.f, 0.f, 0.f, 0.f}; s[kt][1] = (f32x4){0.f, 0.f, 0.f, 0.f};
#pragma unroll
    for (int ks = 0; ks < NKS; ++ks) {
      const bf16x8 a = ldfrag(Ks + (kt * 16 + l15) * KLD + dofs + ks * 32 + 8 * g);
      s[kt][0] = mfma16(a, qf[0][ks], s[kt][0]);
      s[kt][1] = mfma16(a, qf[1][ks], s[kt][1]);
    }
  }
}
DI void pv_accum(const bf16x8 (&pf)[2][2], const u16* Vs, f32x4 (&o)[4][2], int l15, int g) {
  const int tq = l15 >> 2, tp = l15 & 3;
#pragma unroll
  for (int kk = 0; kk < 2; ++kk)
#pragma unroll
    for (int d = 0; d < 4; ++d) {
      const bf16x8 vf = cat4(tr_read(Vs + (kk * 32 + 4 * g + tq) * KLD + d * 16 + 4 * tp), tr_read(Vs + (kk * 32 + 16 + 4 * g + tq) * KLD + d * 16 + 4 * tp));
      o[d][0] = mfma16(vf, pf[0][kk], o[d][0]);
      o[d][1] = mfma16(vf, pf[1][kk], o[d][1]);
    }
}
DI void pack_p(const f32x4 (&s)[4][2], bf16x8 (&pf)[2][2]) {
#pragma unroll
  for (int qt = 0; qt < 2; ++qt)
#pragma unroll
    for (int kk = 0; kk < 2; ++kk) {
      u32x4 w;
      w.x = pack2(s[2 * kk][qt][0], s[2 * kk][qt][1]); w.y = pack2(s[2 * kk][qt][2], s[2 * kk][qt][3]);
      w.z = pack2(s[2 * kk + 1][qt][0], s[2 * kk + 1][qt][1]); w.w = pack2(s[2 * kk + 1][qt][2], s[2 * kk + 1][qt][3]);
      pf[qt][kk] = __builtin_bit_cast(bf16x8, w);
    }
}
template <class VF>
DI void softmax_pv(f32x4 (&s)[4][2], AttnAcc& a, const u16* Vs, float sc, int l15, int g, VF valid) {
  bf16x8 pf[2][2];
#pragma unroll
  for (int qt = 0; qt < 2; ++qt) {
    float mx = -1e30f;
#pragma unroll
    for (int kt = 0; kt < 4; ++kt)
#pragma unroll
      for (int r = 0; r < 4; ++r) { const float v = valid(kt, r, qt) ? s[kt][qt][r] * sc : -1e30f; s[kt][qt][r] = v; mx = fmaxf(mx, v); }
    mx = fmaxf(mx, __shfl_xor(mx, 16)); mx = fmaxf(mx, __shfl_xor(mx, 32));
    const float mn = fmaxf(a.m[qt], mx), alpha = exp2_(a.m[qt] - mn);
    a.m[qt] = mn;
    float ls = 0.f;
#pragma unroll
    for (int kt = 0; kt < 4; ++kt)
#pragma unroll
      for (int r = 0; r < 4; ++r) { const float v = s[kt][qt][r]; const float pv = v > -1e29f ? exp2_(v - mn) : 0.f; s[kt][qt][r] = pv; ls += pv; }
    a.l[qt] = a.l[qt] * alpha + ls;
#pragma unroll
    for (int d = 0; d < 4; ++d) a.o[d][qt] *= alpha;
#pragma unroll
    for (int kk = 0; kk < 2; ++kk) {
      u32x4 w;
      w.x = pack2(s[2 * kk][qt][0], s[2 * kk][qt][1]); w.y = pack2(s[2 * kk][qt][2], s[2 * kk][qt][3]);
      w.z = pack2(s[2 * kk + 1][qt][0], s[2 * kk + 1][qt][1]); w.w = pack2(s[2 * kk + 1][qt][2], s[2 * kk + 1][qt][3]);
      pf[qt][kk] = __builtin_bit_cast(bf16x8, w);
    }
  }
  pv_accum(pf, Vs, a.o, l15, g);
}
DI void softmax_pv_nomask(f32x4 (&s)[4][2], AttnAcc& a, const u16* Vs, float sc, int l15, int g) {
  bf16x8 pf[2][2];
#pragma unroll
  for (int qt = 0; qt < 2; ++qt) {
    float mx = s[0][qt][0];
#pragma unroll
    for (int kt = 0; kt < 4; ++kt)
#pragma unroll
      for (int r = 0; r < 4; ++r) mx = fmaxf(mx, s[kt][qt][r]);
    mx = fmaxf(mx, __shfl_xor(mx, 16)); mx = fmaxf(mx, __shfl_xor(mx, 32));
    const float mn = fmaxf(a.m[qt], mx * sc), alpha = exp2_(a.m[qt] - mn);
    a.m[qt] = mn;
    float ls = 0.f;
#pragma unroll
    for (int kt = 0; kt < 4; ++kt)
#pragma unroll
      for (int r = 0; r < 4; ++r) { const float pv = exp2_(__builtin_fmaf(s[kt][qt][r], sc, -mn)); s[kt][qt][r] = pv; ls += pv; }
    a.l[qt] = a.l[qt] * alpha + ls;
#pragma unroll
    for (int d = 0; d < 4; ++d) a.o[d][qt] *= alpha;
#pragma unroll
    for (int kk = 0; kk < 2; ++kk) {
      u32x4 w;
      w.x = pack2(s[2 * kk][qt][0], s[2 * kk][qt][1]); w.y = pack2(s[2 * kk][qt][2], s[2 * kk][qt][3]);
      w.z = pack2(s[2 * kk + 1][qt][0], s[2 * kk + 1][qt][1]); w.w = pack2(s[2 * kk + 1][qt][2], s[2 * kk + 1][qt][3]);
      pf[qt][kk] = __builtin_bit_cast(bf16x8, w);
    }
  }
  pv_accum(pf, Vs, a.o, l15, g);
}
DI float group_sum4(float v) { v += __shfl_xor(v, 16); v += __shfl_xor(v, 32); return v; }

DI void diff_attn_task(const Params& p, int layer, int b, int h, int qb, unsigned char* smem) {
  u16* Ks = (u16*)smem; u16* Vs = Ks + 64 * KLD;
  const int tid = otid(), lane = tid & 63, wid = tid >> 6, l15 = lane & 15, g = lane >> 4;
  const u16* proj = (const u16*)(p.ws + OFF_PROJ) + (size_t)b * SEQ * NP;
  const int q0w = qb * 128 + wid * 32;
  const float* lam = p.diff_lam + layer * 128;
  float s01 = 0.f, s23 = 0.f;
  for (int i = 0; i < 32; ++i) { s01 += lam[i] * lam[32 + i]; s23 += lam[64 + i] * lam[96 + i]; }
  const float lam_init = 0.8f - 0.6f * __expf(-0.3f * (float)layer);
  const float lam_full = __expf(s01) - __expf(s23) + lam_init;
  const float sc = 0.17677669529663687f * 1.4426950408889634f;
  const int ntile = 2 * qb + 2;
  const u16* vbase = proj + PB_V + h * 64;
  f32x4 res[4][2];
#pragma unroll 1
  for (int c = 0; c < 2; ++c) {
    const u16* kbase = proj + PB_K + h * 64 + c * 32;
    bf16x8 qf[2][1];
#pragma unroll
    for (int qt = 0; qt < 2; ++qt) qf[qt][0] = ldfrag(proj + (size_t)(q0w + qt * 16 + l15) * NP + PB_Q + h * 64 + c * 32 + 8 * g);
    AttnAcc a; attn_init(a);
    kv_pipeline(0, ntile, Ks,
      [&](int) { return true; },
      [&](int j, KVRegs& kr) { kv_load(kbase, vbase, NP, NP, j * 64, kr); },
      [&](int j, const u16* Kt, const u16* Vt) {
        const int key0 = j * 64;
        if (key0 <= q0w + 31) {
          f32x4 s[4][2];
          auto valid = [&](int kt, int r, int qt) { return key0 + kt * 16 + 4 * g + r <= q0w + qt * 16 + l15; };
          qk_tile<1>(Kt, 0, qf, s, l15, g);
          if (key0 + 63 <= q0w) softmax_pv_nomask(s, a, Vt, sc, l15, g);
          else softmax_pv(s, a, Vt, sc, l15, g, valid);
        }
      });
#pragma unroll
    for (int qt = 0; qt < 2; ++qt) {
      const float lt = group_sum4(a.l[qt]);
      const float inv = c == 0 ? 1.f / lt : -lam_full / lt;
#pragma unroll
      for (int d = 0; d < 4; ++d) res[d][qt] = c == 0 ? a.o[d][qt] * inv : res[d][qt] + a.o[d][qt] * inv;
    }
  }
  u16* Y = (u16*)(p.ws + OFF_H);
  const float* ng = p.diff_norm_g + layer * 64;
#pragma unroll
  for (int qt = 0; qt < 2; ++qt) {
    float ss = 0.f;
#pragma unroll
    for (int d = 0; d < 4; ++d) { const f32x4 v = res[d][qt]; ss += v[0] * v[0] + v[1] * v[1] + v[2] * v[2] + v[3] * v[3]; }
    ss = group_sum4(ss);
    const float rn = rsqrtf(ss * (1.f / 64.f) + 1e-6f) * (1.f - lam_init);
    const int t = q0w + qt * 16 + l15;
    const size_t row = (size_t)b * SEQ + t;
#pragma unroll
    for (int d = 0; d < 4; ++d) {
      const int dd = d * 16 + 4 * g;
      const f32x4 v = res[d][qt];
      const u32x2 zz = *(const u32x2*)(proj + (size_t)t * NP + PB_Z + h * 64 + dd);
      const f32x4 gg = *(const f32x4*)(ng + dd);
      u32x2 w;
      w.x = pack2(v[0] * rn * gg[0] * siluf(bflo(zz.x)), v[1] * rn * gg[1] * siluf(bfhi(zz.x)));
      w.y = pack2(v[2] * rn * gg[2] * siluf(bflo(zz.y)), v[3] * rn * gg[3] * siluf(bfhi(zz.y)));
      *(u32x2*)(Y + row * 1024 + Y_B + h * 64 + dd) = w;
    }
  }
}

template <int NKS>
DI void qk_tile1(const u16* Ks, const bf16x8 (&qf)[NKS], f32x4 (&s)[4], int l15, int g) {
#pragma unroll
  for (int kt = 0; kt < 4; ++kt) {
    s[kt] = (f32x4){0.f, 0.f, 0.f, 0.f};
#pragma unroll
    for (int ks = 0; ks < NKS; ++ks) s[kt] = mfma16(ldfrag(Ks + (kt * 16 + l15) * KLD + ks * 32 + 8 * g), qf[ks], s[kt]);
  }
}
DI void pv_accum1(const f32x4 (&s)[4], const u16* Vs, f32x4 (&o)[4], int l15, int g) {
  const int tq = l15 >> 2, tp = l15 & 3;
#pragma unroll
  for (int kk = 0; kk < 2; ++kk) {
    u32x4 w;
    w.x = pack2(s[2 * kk][0], s[2 * kk][1]); w.y = pack2(s[2 * kk][2], s[2 * kk][3]);
    w.z = pack2(s[2 * kk + 1][0], s[2 * kk + 1][1]); w.w = pack2(s[2 * kk + 1][2], s[2 * kk + 1][3]);
    const bf16x8 pf = __builtin_bit_cast(bf16x8, w);
#pragma unroll
    for (int d = 0; d < 4; ++d) {
      const bf16x8 vf = cat4(tr_read(Vs + (kk * 32 + 4 * g + tq) * KLD + d * 16 + 4 * tp), tr_read(Vs + (kk * 32 + 16 + 4 * g + tq) * KLD + d * 16 + 4 * tp));
      o[d] = mfma16(vf, pf, o[d]);
    }
  }
}
DI void conv_silu_stage(const u16* projb, int col0, const float* cw, const float* cb, int chan0, int nchan, int t0, u16* dst, const float* rowscale, float cscale) {
  const int tid = otid(), ch = (tid & 7) * 8;
  float w[4][8], bias[8];
#pragma unroll
  for (int j = 0; j < 4; ++j)
#pragma unroll
    for (int i = 0; i < 8; ++i) w[j][i] = cw[j * nchan + chan0 + ch + i];
#pragma unroll
  for (int i = 0; i < 8; ++i) bias[i] = cb[chan0 + ch + i];
#pragma unroll 1
  for (int ps = 0; ps < 4; ++ps) {
    const int row = ps * 32 + (tid >> 3), t = t0 + row;
    float acc[8];
#pragma unroll
    for (int i = 0; i < 8; ++i) acc[i] = bias[i];
#pragma unroll
    for (int j = 0; j < 4; ++j) {
      const int tt = t - 3 + j;
      if (tt >= 0) {
        const u32x4 v = *(const u32x4*)(projb + (size_t)tt * NP + col0 + ch);
        acc[0] += w[j][0] * bflo(v.x); acc[1] += w[j][1] * bfhi(v.x); acc[2] += w[j][2] * bflo(v.y); acc[3] += w[j][3] * bfhi(v.y);
        acc[4] += w[j][4] * bflo(v.z); acc[5] += w[j][5] * bfhi(v.z); acc[6] += w[j][6] * bflo(v.w); acc[7] += w[j][7] * bfhi(v.w);
      }
    }
    const float rs = (rowscale ? rowscale[row] : 1.f) * cscale;
#pragma unroll
    for (int i = 0; i < 8; ++i) acc[i] = siluf(acc[i]) * rs;
    u32x4 o; o.x = pack2(acc[0], acc[1]); o.y = pack2(acc[2], acc[3]); o.z = pack2(acc[4], acc[5]); o.w = pack2(acc[6], acc[7]);
    *(u32x4*)(dst + row * KLD + ch) = o;
  }
}
DI float block_scan128_add(float v, float* tmp) {
  const int tid = otid(), lane = tid & 63;
  float x = v;
#pragma unroll
  for (int o = 1; o < 64; o <<= 1) { const float y = __shfl_up(x, o); if (lane >= o) x += y; }
  lds_barrier();
  if (tid == 63) tmp[0] = x;
  lds_barrier();
  if ((tid >> 6) == 1) x += tmp[0];
  return x;
}
DI float block_scan128_max(float v, float* tmp) {
  const int tid = otid(), lane = tid & 63;
  float x = v;
#pragma unroll
  for (int o = 1; o < 64; o <<= 1) { const float y = __shfl_up(x, o); if (lane >= o) x = fmaxf(x, y); }
  lds_barrier();
  if (tid == 63) tmp[0] = x;
  lds_barrier();
  if ((tid >> 6) == 1) x = fmaxf(x, tmp[0]);
  return x;
}
DI void scale_rows(u16* A, const float* rs) {
  const int tid = otid(), ch = (tid & 7) * 8;
#pragma unroll
  for (int ps = 0; ps < 4; ++ps) {
    const int row = ps * 32 + (tid >> 3);
    const float f = rs[row];
    u32x4 v = *(u32x4*)(A + row * KLD + ch);
    v.x = pack2(bflo(v.x) * f, bfhi(v.x) * f); v.y = pack2(bflo(v.y) * f, bfhi(v.y) * f);
    v.z = pack2(bflo(v.z) * f, bfhi(v.z) * f); v.w = pack2(bflo(v.w) * f, bfhi(v.w) * f);
    *(u32x4*)(A + row * KLD + ch) = v;
  }
}
DI void state_update(const u16* Xs, const u16* Bs, f32x4 (&acc)[4], int w, int l15, int g) {
  const int tq = l15 >> 2, tp = l15 & 3;
#pragma unroll
  for (int kk = 0; kk < 4; ++kk) {
    const bf16x8 af = cat4(tr_read(Xs + (kk * 32 + 4 * g + tq) * KLD + w * 16 + 4 * tp), tr_read(Xs + (kk * 32 + 16 + 4 * g + tq) * KLD + w * 16 + 4 * tp));
#pragma unroll
    for (int nt = 0; nt < 4; ++nt) {
      const bf16x8 bfr = cat4(tr_read(Bs + (kk * 32 + 4 * g + tq) * KLD + nt * 16 + 4 * tp), tr_read(Bs + (kk * 32 + 16 + 4 * g + tq) * KLD + nt * 16 + 4 * tp));
      acc[nt] = mfma16(af, bfr, acc[nt]);
    }
  }
}
DI void state_to_lds(u16* Ss, const f32x4 (&acc)[4], int w, int l15, int g) {
#pragma unroll
  for (int nt = 0; nt < 4; ++nt)
#pragma unroll
    for (int r = 0; r < 4; ++r) Ss[(w * 16 + 4 * g + r) * KLD + nt * 16 + l15] = f2bf(acc[nt][r]);
}

constexpr int SEQ_LDS_A = 0, SEQ_LDS_B = 128 * KLD * 2, SEQ_LDS_C = 2 * 128 * KLD * 2, SEQ_LDS_S = 3 * 128 * KLD * 2, SEQ_LDS_F = SEQ_LDS_S + 64 * KLD * 2;
constexpr int SEQ_LDS_HALO = SEQ_LDS_F + 4096;
constexpr int SEQ_LDS_CW = SEQ_LDS_HALO + 2 * 3 * 3 * 64 * 2;
struct RawRegs { u32x4 r[4]; };
DI void raw_load(const u16* projb, int col0, int t0, RawRegs& rr, int tid) {
#pragma unroll
  for (int i = 0; i < 4; ++i) rr.r[i] = *(const u32x4*)(projb + (size_t)(t0 + (tid >> 3) + 32 * i) * NP + col0 + (tid & 7) * 8);
}
DI void raw_store(u16* dst, u16* halo_next, const RawRegs& rr, int tid) {
#pragma unroll
  for (int i = 0; i < 4; ++i) *(u32x4*)(dst + ((tid >> 3) + 32 * i) * KLD + (tid & 7) * 8) = rr.r[i];
  if (halo_next && tid >= 232) *(u32x4*)(halo_next + ((tid >> 3) - 29) * 64 + (tid & 7) * 8) = rr.r[3];
}
DI void conv_from_lds(const u16* raw, const u16* halo, const float* wl, const float* rowscale, float cscale, u32x4 (&out)[4], int tid) {
  const int q = tid >> 3, ch = (tid & 7) * 8;
  u32x4 v[7];
#pragma unroll
  for (int k = 0; k < 7; ++k) { const int r = 4 * q - 3 + k; v[k] = r >= 0 ? *(const u32x4*)(raw + r * KLD + ch) : *(const u32x4*)(halo + (r + 3) * 64 + ch); }
  float w[5][8];
#pragma unroll
  for (int j = 0; j < 5; ++j) { const f32x4 w0 = *(const f32x4*)(wl + j * 64 + ch), w1 = *(const f32x4*)(wl + j * 64 + ch + 4);
    w[j][0] = w0[0]; w[j][1] = w0[1]; w[j][2] = w0[2]; w[j][3] = w0[3]; w[j][4] = w1[0]; w[j][5] = w1[1]; w[j][6] = w1[2]; w[j][7] = w1[3]; }
#pragma unroll
  for (int o = 0; o < 4; ++o) {
    float acc[8];
#pragma unroll
    for (int i = 0; i < 8; ++i) acc[i] = w[4][i];
#pragma unroll
    for (int j = 0; j < 4; ++j) {
      const u32x4 x = v[o + j];
      acc[0] += w[j][0] * bflo(x.x); acc[1] += w[j][1] * bfhi(x.x); acc[2] += w[j][2] * bflo(x.y); acc[3] += w[j][3] * bfhi(x.y);
      acc[4] += w[j][4] * bflo(x.z); acc[5] += w[j][5] * bfhi(x.z); acc[6] += w[j][6] * bflo(x.w); acc[7] += w[j][7] * bfhi(x.w);
    }
    const float rs = (rowscale ? rowscale[4 * q + o] : 1.f) * cscale;
#pragma unroll
    for (int i = 0; i < 8; ++i) acc[i] = siluf(acc[i]) * rs;
    out[o].x = pack2(acc[0], acc[1]); out[o].y = pack2(acc[2], acc[3]); out[o].z = pack2(acc[4], acc[5]); out[o].w = pack2(acc[6], acc[7]);
  }
}
DI void conv_write(u16* dst, const u32x4 (&out)[4], int tid) {
  const int q = tid >> 3, ch = (tid & 7) * 8;
#pragma unroll
  for (int o = 0; o < 4; ++o) *(u32x4*)(dst + (4 * q + o) * KLD + ch) = out[o];
}
DI void stage_conv_w(float* wl, const float* cw, const float* cb, int chan0, int nchan, int tid) {
  for (int i = tid; i < 320; i += 256) { const int j = i >> 6, cc = i & 63; wl[i] = j < 4 ? cw[j * nchan + chan0 + cc] : cb[chan0 + cc]; }
}
DI float wave_scan_add(float x, int lane) {
#pragma unroll
  for (int o = 1; o < 64; o <<= 1) { const float y = __shfl_up(x, o); if (lane >= o) x += y; }
  return x;
}
DI float wave_scan_max(float x, int lane) {
#pragma unroll
  for (int o = 1; o < 64; o <<= 1) { const float y = __shfl_up(x, o); if (lane >= o) x = fmaxf(x, y); }
  return x;
}

DI void ssd_task(const Params& p, int layer, int b, int h, unsigned char* smem) {
  u16* Cs = (u16*)(smem + SEQ_LDS_A); u16* Bs = (u16*)(smem + SEQ_LDS_B); u16* Xs = (u16*)(smem + SEQ_LDS_C); u16* Ss = (u16*)(smem + SEQ_LDS_S);
  float* fl = (float*)(smem + SEQ_LDS_F);
  float* dts = fl; float* acs = fl + 128; float* wend = fl + 256; float* tmp = fl + 384;
  u16* halo = (u16*)(smem + SEQ_LDS_HALO); float* cwl = (float*)(smem + SEQ_LDS_CW);
  int tid = otid(), lane = tid & 63, w = tid >> 6, l15 = lane & 15, g = lane >> 4;
  const int gi = h >> 1;
  const u16* projb = (const u16*)(p.ws + OFF_PROJ) + (size_t)b * SEQ * NP;
  const float* smb = (const float*)(p.ws + OFF_SMALL) + (size_t)b * SEQ * NSMALL;
  const float* cw = p.ssm_conv_w + layer * 4 * 512; const float* cb = p.ssm_conv_b + layer * 512;
  u16* Y = (u16*)(p.ws + OFF_H);
  const float a_h = -__expf(p.ssm_a_log[layer * 4 + h]), d_h = p.ssm_d[layer * 4 + h], dtb = p.ssm_dt_bias[layer * 4 + h];
  const int colB = PC_XBC + 256 + gi * 64, colC = PC_XBC + 384 + gi * 64, colX = PC_XBC + h * 64;
  f32x4 st[4];
#pragma unroll
  for (int nt = 0; nt < 4; ++nt) st[nt] = (f32x4){0.f, 0.f, 0.f, 0.f};
  lds_barrier();
  stage_conv_w(cwl, cw, cb, 256 + gi * 64, 512, tid);
  stage_conv_w(cwl + 320, cw, cb, 384 + gi * 64, 512, tid);
  stage_conv_w(cwl + 640, cw, cb, h * 64, 512, tid);
  for (int i = tid; i < 3 * 3 * 64; i += 256) halo[i] = 0;
  RawRegs rB, rC, rX; float dtraw = 0.f;
  raw_load(projb, colB, 0, rB, tid); raw_load(projb, colC, 0, rC, tid); raw_load(projb, colX, 0, rX, tid);
  if (tid < 128) dtraw = smb[(size_t)tid * NSMALL + SM_DT + h];
#pragma unroll 1
  for (int c = 0; c < 32; ++c) {
    const int t0 = c * 128;
    asm volatile("" : "+v"(tid)); lane = tid & 63; w = tid >> 6; l15 = lane & 15; g = lane >> 4;
    u16* hcur = halo + (c & 1) * 576; u16* hnext = halo + ((c + 1) & 1) * 576;
    float dtv = 0.f;
    if (tid < 128) { const float xr = dtraw + dtb; dtv = xr > 15.f ? xr : __logf(1.f + __expf(xr)); }
    float cs = wave_scan_add(dtv * a_h, lane);
    if (tid == 63) tmp[0] = cs;
    lds_barrier();
    if (w == 1) cs += tmp[0];
    if (tid < 128) { dts[tid] = dtv; acs[tid] = cs; }
    raw_store(Bs, hnext, rB, tid); raw_store(Cs, hnext + 192, rC, tid); raw_store(Xs, hnext + 384, rX, tid);
    lds_barrier();
    if (c + 1 < 32) {
      raw_load(projb, colB, t0 + 128, rB, tid); raw_load(projb, colC, t0 + 128, rC, tid);
      if (tid < 128) dtraw = smb[(size_t)(t0 + 128 + tid) * NSMALL + SM_DT + h];
    }
    {
      u32x4 o1[4], o2[4];
      conv_from_lds(Bs, hcur, cwl, nullptr, 1.f, o1, tid);
      lds_barrier();
      conv_write(Bs, o1, tid);
      conv_from_lds(Cs, hcur + 192, cwl + 320, nullptr, 1.f, o2, tid);
      lds_barrier();
      conv_write(Cs, o2, tid);
      conv_from_lds(Xs, hcur + 384, cwl + 640, dts, 1.f, o1, tid);
      lds_barrier();
      conv_write(Xs, o1, tid);
    }
    if (tid < 128) wend[tid] = __expf(acs[127] - acs[tid]);
    state_to_lds(Ss, st, w, l15, g);
    lds_barrier();
#pragma unroll 1
    for (int qt = 0; qt < 2; ++qt) {
      const int tl = 32 * w + qt * 16 + l15;
      bf16x8 cf[2];
#pragma unroll
      for (int ks = 0; ks < 2; ++ks) cf[ks] = ldfrag(Cs + tl * KLD + ks * 32 + 8 * g);
      f32x4 y[4];
#pragma unroll
      for (int d = 0; d < 4; ++d) y[d] = (f32x4){0.f, 0.f, 0.f, 0.f};
      const float at = acs[tl];
#pragma unroll 1
      for (int stl = 0; stl < 2; ++stl) {
        if (stl * 64 <= 32 * w + qt * 16 + 15) {
          f32x4 sc[4];
          qk_tile1<2>(Bs + stl * 64 * KLD, cf, sc, l15, g);
#pragma unroll
          for (int kt = 0; kt < 4; ++kt) {
            const f32x4 as = *(const f32x4*)(acs + stl * 64 + kt * 16 + 4 * g);
#pragma unroll
            for (int r = 0; r < 4; ++r) {
              const bool ok = stl * 64 + kt * 16 + 4 * g + r <= tl;
              sc[kt][r] = ok ? sc[kt][r] * __expf(at - as[r]) : 0.f;
            }
          }
          pv_accum1(sc, Xs + stl * 64 * KLD, y, l15, g);
        }
      }
      const float ea = __expf(at), dsk = d_h / dts[tl];
      const size_t row = (size_t)b * SEQ + t0 + tl;
#pragma unroll
      for (int d = 0; d < 4; ++d) {
        f32x4 yo = (f32x4){0.f, 0.f, 0.f, 0.f};
#pragma unroll
        for (int ks = 0; ks < 2; ++ks) yo = mfma16(ldfrag(Ss + (d * 16 + l15) * KLD + ks * 32 + 8 * g), cf[ks], yo);
        const u32x2 xv = *(const u32x2*)(Xs + tl * KLD + d * 16 + 4 * g);
        const f32x4 v = y[d] + yo * ea;
        u32x2 o; o.x = pack2(v[0] + dsk * bflo(xv.x), v[1] + dsk * bfhi(xv.x)); o.y = pack2(v[2] + dsk * bflo(xv.y), v[3] + dsk * bfhi(xv.y));
        *(u32x2*)(Y + row * 1024 + Y_C + h * 64 + d * 16 + 4 * g) = o;
      }
    }
    if (c + 1 < 32) raw_load(projb, colX, t0 + 128, rX, tid);
    lds_barrier();
    scale_rows(Xs, wend);
    lds_barrier();
    const float cd = __expf(acs[127]);
#pragma unroll
    for (int nt = 0; nt < 4; ++nt) st[nt] *= cd;
    state_update(Xs, Bs, st, w, l15, g);
  }
}
DI void seq_fix_rows(const Params& p, int layer, int r0, int nrows) {
  u16* Y = (u16*)(p.ws + OFF_H);
  const u16* proj = (const u16*)(p.ws + OFF_PROJ);
  const int tid = otid(), lane = tid & 63, wv = tid >> 6;
  const bool ml = lane >= 32;
  const int ch = (lane & 31) * 8;
  const float* ng = ml ? p.ml_norm_g + layer * 64 + (ch & 63) : p.ssm_norm_g + layer * 256 + ch;
  const f32x4 g0 = *(const f32x4*)ng, g1 = *(const f32x4*)(ng + 4);
  for (int rb = wv * 4; rb < nrows; rb += 16) {
    u32x4 yv4[4], zv4[4], ov4[4];
#pragma unroll
    for (int j = 0; j < 4; ++j) {
      const size_t row = (size_t)(r0 + rb + j);
      yv4[j] = *(const u32x4*)(Y + row * 1024 + (ml ? Y_D : Y_C) + ch);
      zv4[j] = *(const u32x4*)(proj + row * NP + (ml ? PD_Z : PC_Z) + ch);
      ov4[j] = ml ? *(const u32x4*)(proj + row * NP + PD_O + ch) : (u32x4){0u, 0u, 0u, 0u};
    }
#pragma unroll
    for (int j = 0; j < 4; ++j) {
      const size_t row = (size_t)(r0 + rb + j);
      u16* yp = Y + row * 1024 + (ml ? Y_D : Y_C) + ch;
      const u32x4 yv = yv4[j], zv = zv4[j], ov = ov4[j];
      float v[8] = {bflo(yv.x), bfhi(yv.x), bflo(yv.y), bfhi(yv.y), bflo(yv.z), bfhi(yv.z), bflo(yv.w), bfhi(yv.w)};
      float z[8] = {bflo(zv.x), bfhi(zv.x), bflo(zv.y), bfhi(zv.y), bflo(zv.z), bfhi(zv.z), bflo(zv.w), bfhi(zv.w)};
      float ss = 0.f;
      if (ml) {
        const float o[8] = {bflo(ov.x), bfhi(ov.x), bflo(ov.y), bfhi(ov.y), bflo(ov.z), bfhi(ov.z), bflo(ov.w), bfhi(ov.w)};
#pragma unroll
        for (int i = 0; i < 8; ++i) { v[i] *= sigmoidf_(o[i]); ss += v[i] * v[i]; }
      } else {
#pragma unroll
        for (int i = 0; i < 8; ++i) { v[i] *= siluf(z[i]); ss += v[i] * v[i]; }
      }
      ss += __shfl_xor(ss, 1); ss += __shfl_xor(ss, 2); ss += __shfl_xor(ss, 4);
      const float ss16 = ss + __shfl_xor(ss, 8);
      const float rn = ml ? rsqrtf(ss * (1.f / 64.f) + 1e-6f) : rsqrtf(ss16 * (1.f / 128.f) + 1e-6f);
      float o8[8];
#pragma unroll
      for (int i = 0; i < 8; ++i) { const float gg = i < 4 ? g0[i & 3] : g1[i & 3]; o8[i] = v[i] * rn * gg * (ml ? siluf(z[i]) : 1.f); }
      u32x4 w; w.x = pack2(o8[0], o8[1]); w.y = pack2(o8[2], o8[3]); w.z = pack2(o8[4], o8[5]); w.w = pack2(o8[6], o8[7]);
      *(u32x4*)yp = w;
    }
  }
}

DI void mlstm_task(const Params& p, int layer, int b, int h, unsigned char* smem) {
  u16* Qs = (u16*)(smem + SEQ_LDS_A); u16* Ks2 = (u16*)(smem + SEQ_LDS_B); u16* Vs2 = (u16*)(smem + SEQ_LDS_C); u16* Cst = (u16*)(smem + SEQ_LDS_S);
  float* fl = (float*)(smem + SEQ_LDS_F);
  float* bcs = fl; float* us = fl + 128; float* pms = fl + 256; float* wend = fl + 384; float* nst = fl + 512; float* npart = fl + 576; float* tmp = fl + 832;
  u16* halo = (u16*)(smem + SEQ_LDS_HALO); float* cwl = (float*)(smem + SEQ_LDS_CW);
  int tid = otid(), lane = tid & 63, w = tid >> 6, l15 = lane & 15, g = lane >> 4;
  const u16* projb = (const u16*)(p.ws + OFF_PROJ) + (size_t)b * SEQ * NP;
  const float* smb = (const float*)(p.ws + OFF_SMALL) + (size_t)b * SEQ * NSMALL;
  const float* cw = p.ml_conv_w + layer * 4 * 512; const float* cb = p.ml_conv_b + layer * 512;
  const float ib = p.ml_if_b[layer * 8 + h], fb = p.ml_if_b[layer * 8 + 4 + h];
  u16* Y = (u16*)(p.ws + OFF_H);
  const int colQ = PD_QK + h * 64, colK = PD_QK + 256 + h * 64, colV = PD_V + h * 64;
  f32x4 st[4];
#pragma unroll
  for (int nt = 0; nt < 4; ++nt) st[nt] = (f32x4){0.f, 0.f, 0.f, 0.f};
  float m_prev = 0.f;
  lds_barrier();
  if (tid < 64) nst[tid] = 0.f;
  stage_conv_w(cwl, cw, cb, h * 64, 512, tid);
  stage_conv_w(cwl + 320, cw, cb, 256 + h * 64, 512, tid);
  for (int i = tid; i < 3 * 3 * 64; i += 256) halo[i] = 0;
  RawRegs rQ, rK, rV; float iraw = 0.f, fraw = 0.f;
  raw_load(projb, colQ, 0, rQ, tid); raw_load(projb, colK, 0, rK, tid); raw_load(projb, colV, 0, rV, tid);
  if (tid < 128) { iraw = smb[(size_t)tid * NSMALL + SM_IF + h]; fraw = smb[(size_t)tid * NSMALL + SM_IF + 4 + h]; }
#pragma unroll 1
  for (int c = 0; c < 32; ++c) {
    const int t0 = c * 128;
    asm volatile("" : "+v"(tid)); lane = tid & 63; w = tid >> 6; l15 = lane & 15; g = lane >> 4;
    u16* hcur = halo + (c & 1) * 576; u16* hnext = halo + ((c + 1) & 1) * 576;
    float ip = 0.f, lf = 0.f;
    if (tid < 128) { ip = iraw + ib; const float fp = fraw + fb; lf = fminf(fp, 0.f) - __logf(1.f + __expf(-fabsf(fp))); }
    float bc = wave_scan_add(lf, lane);
    if (tid == 63) tmp[0] = bc;
    lds_barrier();
    if (w == 1) bc += tmp[0];
    const float u = tid < 128 ? ip - bc : -1e30f;
    float pm = wave_scan_max(u, lane);
    if (tid == 63) tmp[1] = pm;
    raw_store(Qs, hnext, rQ, tid); raw_store(Ks2, hnext + 192, rK, tid); raw_store(Vs2, nullptr, rV, tid);
    lds_barrier();
    if (w == 1) pm = fmaxf(pm, tmp[1]);
    if (tid < 128) { bcs[tid] = bc; us[tid] = u; pms[tid] = pm; }
    if (c + 1 < 32) {
      raw_load(projb, colQ, t0 + 128, rQ, tid);
      if (tid < 128) { iraw = smb[(size_t)(t0 + 128 + tid) * NSMALL + SM_IF + h]; fraw = smb[(size_t)(t0 + 128 + tid) * NSMALL + SM_IF + 4 + h]; }
    }
    u32x4 oQ[4], oK[4];
    conv_from_lds(Qs, hcur, cwl, nullptr, 1.f, oQ, tid);
    __builtin_amdgcn_sched_barrier(0);
    conv_from_lds(Ks2, hcur + 192, cwl + 320, nullptr, 0.125f, oK, tid);
    __builtin_amdgcn_sched_barrier(0);
    lds_barrier();
    conv_write(Qs, oQ, tid); conv_write(Ks2, oK, tid);
    state_to_lds(Cst, st, w, l15, g);
    const float blast = bcs[127];
    const float m_new = blast + fmaxf(m_prev, pms[127]);
    if (tid < 128) wend[tid] = __expf(blast - m_new + us[tid]);
    lds_barrier();
#pragma unroll 1
    for (int qt = 0; qt < 2; ++qt) {
      const int tl = 32 * w + qt * 16 + l15;
      bf16x8 qf[2];
#pragma unroll
      for (int ks = 0; ks < 2; ++ks) qf[ks] = ldfrag(Qs + tl * KLD + ks * 32 + 8 * g);
      f32x4 num[4];
#pragma unroll
      for (int d = 0; d < 4; ++d) num[d] = (f32x4){0.f, 0.f, 0.f, 0.f};
      const float bt = bcs[tl], mt = bt + fmaxf(m_prev, pms[tl]);
      float den = 0.f;
#pragma unroll 1
      for (int stl = 0; stl < 2; ++stl) {
        if (stl * 64 <= 32 * w + qt * 16 + 15) {
          f32x4 sc[4];
          qk_tile1<2>(Ks2 + stl * 64 * KLD, qf, sc, l15, g);
#pragma unroll
          for (int kt = 0; kt < 4; ++kt) {
            const f32x4 uu = *(const f32x4*)(us + stl * 64 + kt * 16 + 4 * g);
#pragma unroll
            for (int r = 0; r < 4; ++r) {
              const bool ok = stl * 64 + kt * 16 + 4 * g + r <= tl;
              const float v = ok ? sc[kt][r] * __expf(bt - mt + uu[r]) : 0.f;
              sc[kt][r] = v; den += v;
            }
          }
          pv_accum1(sc, Vs2 + stl * 64 * KLD, num, l15, g);
        }
      }
      const float wi = __expf(bt + m_prev - mt);
      float qn = 0.f;
#pragma unroll
      for (int ks = 0; ks < 2; ++ks)
#pragma unroll
        for (int j = 0; j < 8; ++j) qn += bf2f((u16)qf[ks][j]) * nst[ks * 32 + 8 * g + j];
      qn = group_sum4(qn);
      const float dn = group_sum4(den) + wi * qn;
      const float inv = __builtin_amdgcn_rcpf(fmaxf(fabsf(dn), __expf(-mt)));
      const size_t row = (size_t)b * SEQ + t0 + tl;
#pragma unroll
      for (int d = 0; d < 4; ++d) {
        f32x4 ni = (f32x4){0.f, 0.f, 0.f, 0.f};
#pragma unroll
        for (int ks = 0; ks < 2; ++ks) ni = mfma16(ldfrag(Cst + (d * 16 + l15) * KLD + ks * 32 + 8 * g), qf[ks], ni);
        const f32x4 v = (num[d] + ni * wi) * inv;
        u32x2 o; o.x = pack2(v[0], v[1]); o.y = pack2(v[2], v[3]);
        *(u32x2*)(Y + row * 1024 + Y_D + h * 64 + d * 16 + 4 * g) = o;
      }
    }
    if (c + 1 < 32) { raw_load(projb, colK, t0 + 128, rK, tid); raw_load(projb, colV, t0 + 128, rV, tid); }
    lds_barrier();
    scale_rows(Ks2, wend);
    lds_barrier();
    const float fprev = __expf(blast + m_prev - m_new);
#pragma unroll
    for (int nt = 0; nt < 4; ++nt) st[nt] *= fprev;
    state_update(Vs2, Ks2, st, w, l15, g);
    {
      const int e = tid & 63, part = tid >> 6;
      float a = 0.f;
      for (int s2 = part * 32; s2 < part * 32 + 32; ++s2) a += bf2f(Ks2[s2 * KLD + e]);
      npart[part * 64 + e] = a;
    }
    lds_barrier();
    if (tid < 64) nst[tid] = nst[tid] * fprev + npart[tid] + npart[64 + tid] + npart[128 + tid] + npart[192 + tid];
    m_prev = m_new;
  }
}

DI void compress_task(const Params& p, int layer, int b, int kv, int rb, unsigned char* smem) {
  constexpr int HLD = 136;
  u16* Hs = (u16*)smem;
  const int tid = otid(), lane = tid & 63, w = tid >> 6, l15 = lane & 15, g = lane >> 4;
  const u16* projb = (const u16*)(p.ws + OFF_PROJ) + (size_t)b * SEQ * NP + (kv ? PA_VC : PA_KC);
  const int mi = layer * 2 + kv;
  const u16* W1T = (const u16*)(p.ws + OFF_W1T) + (size_t)mi * 128 * 2048;
  const u16* W2T = (const u16*)(p.ws + OFF_W2T) + (size_t)mi * 64 * 128;
  const float* bias1 = (const float*)(p.ws + OFF_BIAS1) + mi * 16 * 128;
  f32x4 acc[2][2];
#pragma unroll
  for (int nt = 0; nt < 2; ++nt) { acc[nt][0] = (f32x4){0.f, 0.f, 0.f, 0.f}; acc[nt][1] = (f32x4){0.f, 0.f, 0.f, 0.f}; }
  int tok[2];
#pragma unroll
  for (int mt = 0; mt < 2; ++mt) { int i = rb * 32 + mt * 16 + l15; if (i > 254) i = 254; tok[mt] = 16 * i; }
#pragma unroll 4
  for (int ks = 0; ks < 64; ++ks) {
    const int j = ks >> 1, d0 = (ks & 1) * 32;
    bf16x8 af[2], wf[2];
#pragma unroll
    for (int mt = 0; mt < 2; ++mt) af[mt] = ldfrag(projb + (size_t)(tok[mt] + j) * NP + d0 + 8 * g);
#pragma unroll
    for (int nt = 0; nt < 2; ++nt) wf[nt] = ldfrag(W1T + (size_t)(w * 32 + nt * 16 + l15) * 2048 + ks * 32 + 8 * g);
#pragma unroll
    for (int nt = 0; nt < 2; ++nt)
#pragma unroll
      for (int mt = 0; mt < 2; ++mt) acc[nt][mt] = mfma16(wf[nt], af[mt], acc[nt][mt]);
  }
  lds_barrier();
#pragma unroll
  for (int nt = 0; nt < 2; ++nt) {
    const int n = w * 32 + nt * 16 + 4 * g;
    f32x4 bb = *(const f32x4*)(bias1 + n);
#pragma unroll
    for (int pc = 1; pc < 16; ++pc) bb += *(const f32x4*)(bias1 + pc * 128 + n);
#pragma unroll
    for (int mt = 0; mt < 2; ++mt) {
      const f32x4 v = acc[nt][mt] + bb;
      u32x2 o; o.x = pack2(siluf(v[0]), siluf(v[1])); o.y = pack2(siluf(v[2]), siluf(v[3]));
      *(u32x2*)(Hs + (mt * 16 + l15) * HLD + n) = o;
    }
  }
  lds_barrier();
  f32x4 acc2[2] = {(f32x4){0.f, 0.f, 0.f, 0.f}, (f32x4){0.f, 0.f, 0.f, 0.f}};
#pragma unroll
  for (int ks = 0; ks < 4; ++ks) {
    const bf16x8 wf = ldfrag(W2T + (size_t)(w * 16 + l15) * 128 + ks * 32 + 8 * g);
#pragma unroll
    for (int mt = 0; mt < 2; ++mt) acc2[mt] = mfma16(wf, ldfrag(Hs + (mt * 16 + l15) * HLD + ks * 32 + 8 * g), acc2[mt]);
  }
  u16* dst = (u16*)(p.ws + (kv ? OFF_VCMP : OFF_KCMP) + (size_t)layer * 512 * 1024) + (size_t)b * 256 * 64;
#pragma unroll
  for (int mt = 0; mt < 2; ++mt) {
    const int i = rb * 32 + mt * 16 + l15;
    u32x2 o; o.x = pack2(acc2[mt][0], acc2[mt][1]); o.y = pack2(acc2[mt][2], acc2[mt][3]);
    if (i > 254) { o.x = 0u; o.y = 0u; }
    *(u32x2*)(dst + (size_t)i * 64 + w * 16 + 4 * g) = o;
  }
}

DI void nsa_task(const Params& p, int layer, int b, int qi, unsigned char* smem) {
  u16* Ks = (u16*)smem; u16* Vs = Ks + 64 * KLD;
  float* T = (float*)(smem + 2 * KVBUF * 2);
  unsigned long long* selm = (unsigned long long*)(smem + 2 * KVBUF * 2 + 4 * 32 * 65 * 4);
  const int tid = otid(), lane = tid & 63, h = tid >> 6, l15 = lane & 15, g = lane >> 4;
  const int q0 = qi * 32;
  const u16* projb = (const u16*)(p.ws + OFF_PROJ) + (size_t)b * SEQ * NP;
  const float* smb = (const float*)(p.ws + OFF_SMALL) + (size_t)b * SEQ * NSMALL;
  const u16* kcmp = (const u16*)(p.ws + OFF_KCMP + (size_t)layer * 512 * 1024) + (size_t)b * 256 * 64;
  const u16* vcmp = (const u16*)(p.ws + OFF_VCMP + (size_t)layer * 512 * 1024) + (size_t)b * 256 * 64;
  bf16x8 qf[2][2];
#pragma unroll
  for (int qt = 0; qt < 2; ++qt)
#pragma unroll
    for (int ks = 0; ks < 2; ++ks) qf[qt][ks] = ldfrag(projb + (size_t)(q0 + qt * 16 + l15) * NP + PA_Q + h * 64 + ks * 32 + 8 * g);
  const float sc = 0.125f * 1.4426950408889634f;
  f32x4 outacc[4][2];
  AttnAcc a;
  const int ntc = (q0 >> 10) + 1;
  attn_init(a);
  lds_barrier();
  for (int i = tid; i < 4 * 32 * 65; i += 256) T[i] = 0.f;
  kv_pipeline(0, ntc, Ks,
    [&](int) { return true; },
    [&](int j, KVRegs& kr) { kv_load(kcmp, vcmp, 64, 64, j * 64, kr); },
    [&](int j, const u16* Kt, const u16* Vt) {
      f32x4 s[4][2];
      auto valid = [&](int kt, int r, int qt) { return 16 * (j * 64 + kt * 16 + 4 * g + r) + 31 <= q0 + qt * 16 + l15; };
      qk_tile<2>(Kt, 0, qf, s, l15, g);
      softmax_pv(s, a, Vt, sc, l15, g, valid);
    });
  float cinv[2];
#pragma unroll
  for (int qt = 0; qt < 2; ++qt) {
    const float lt = group_sum4(a.l[qt]);
    cinv[qt] = lt > 0.f ? 1.f / lt : 0.f;
    const float gt = sigmoidf_(smb[(size_t)(q0 + qt * 16 + l15) * NSMALL + SM_G + h * 3 + 0]) * cinv[qt];
#pragma unroll
    for (int d = 0; d < 4; ++d) outacc[d][qt] = a.o[d][qt] * gt;
  }
  float carry[2] = {0.f, 0.f};
  kv_pipeline(0, ntc, Ks,
    [&](int) { return true; },
    [&](int j, KVRegs& kr) { kv_load(kcmp, vcmp, 64, 64, j * 64, kr); },
    [&](int j, const u16* Kt, const u16*) {
      f32x4 s[4][2];
      qk_tile<2>(Kt, 0, qf, s, l15, g);
#pragma unroll
      for (int qt = 0; qt < 2; ++qt) {
        float prev3 = carry[qt];
#pragma unroll
        for (int kt = 0; kt < 4; ++kt) {
          float pr[4];
#pragma unroll
          for (int r = 0; r < 4; ++r) {
            const bool ok = 16 * (j * 64 + kt * 16 + 4 * g + r) + 31 <= q0 + qt * 16 + l15;
            pr[r] = ok ? exp2_(s[kt][qt][r] * sc - a.m[qt]) * cinv[qt] : 0.f;
          }
          const float below = __shfl_up(pr[3], 16);
          const float wrap = __shfl(prev3, l15 + 48);
          const float nb = g > 0 ? below : wrap;
          T[(h * 32 + qt * 16 + l15) * 65 + j * 16 + kt * 4 + g] = (pr[0] + pr[1]) + (pr[2] + 0.5f * pr[3]) + 0.5f * nb;
          prev3 = pr[3];
        }
        carry[qt] = prev3;
      }
    });
  lds_barrier();
#pragma unroll 1
  for (int qq = 0; qq < 8; ++qq) {
    const int q = h * 8 + qq, t = q0 + q, cur = t >> 6;
    const float imp = ((T[(0 * 32 + q) * 65 + lane] + T[(1 * 32 + q) * 65 + lane]) + T[(2 * 32 + q) * 65 + lane]) + T[(3 * 32 + q) * 65 + lane];
    const float val = (lane == cur || lane == 0) ? 1e4f : (lane <= cur ? imp : -1.f);
    int rank = 0;
#pragma unroll
    for (int k = 0; k < 64; ++k) {
      const float vk = __int_as_float(__builtin_amdgcn_readlane(__float_as_int(val), k));
      rank += (vk > val || (vk == val && k < lane)) ? 1 : 0;
    }
    const unsigned long long m = __ballot(rank < 16);
    if (lane == 0) selm[q] = m;
  }
  lds_barrier();
  f32x4* park = (f32x4*)T + (h * 8) * 64 + lane;
#pragma unroll
  for (int d = 0; d < 4; ++d) { park[(d * 2 + 0) * 64] = outacc[d][0]; park[(d * 2 + 1) * 64] = outacc[d][1]; }
  unsigned long long mq[2], anym = 0ull;
#pragma unroll
  for (int qt = 0; qt < 2; ++qt) mq[qt] = selm[qt * 16 + l15];
  for (int i = 0; i < 32; ++i) anym |= selm[i];
  const int jhi = (q0 + 31) >> 6;
  attn_init(a);
  kv_pipeline(0, jhi + 1, Ks,
    [&](int j) { return (bool)((anym >> j) & 1ull); },
    [&](int j, KVRegs& kr) { kv_load(projb + PA_KS, projb + PA_VS, NP, NP, j * 64, kr); },
    [&](int j, const u16* Kt, const u16* Vt) {
      f32x4 s[4][2];
      auto valid = [&](int kt, int r, int qt) { return ((mq[qt] >> j) & 1ull) && (j * 64 + kt * 16 + 4 * g + r <= q0 + qt * 16 + l15); };
      qk_tile<2>(Kt, 0, qf, s, l15, g);
      softmax_pv(s, a, Vt, sc, l15, g, valid);
    });
#pragma unroll
  for (int qt = 0; qt < 2; ++qt) {
    const float lt = group_sum4(a.l[qt]);
    const float gt = sigmoidf_(smb[(size_t)(q0 + qt * 16 + l15) * NSMALL + SM_G + h * 3 + 1]) * (lt > 0.f ? 1.f / lt : 0.f);
#pragma unroll
    for (int d = 0; d < 4; ++d) park[(d * 2 + qt) * 64] += a.o[d][qt] * gt;
  }
  attn_init(a);
  const int jlo = q0 >= 511 ? (q0 - 511) >> 6 : 0;
  kv_pipeline(jlo, jhi + 1, Ks,
    [&](int) { return true; },
    [&](int j, KVRegs& kr) { kv_load(projb + PA_KW, projb + PA_VW, NP, NP, j * 64, kr); },
    [&](int j, const u16* Kt, const u16* Vt) {
      f32x4 s[4][2];
      auto valid = [&](int kt, int r, int qt) { const int key = j * 64 + kt * 16 + 4 * g + r, t = q0 + qt * 16 + l15; return key <= t && key + 512 > t; };
      qk_tile<2>(Kt, 0, qf, s, l15, g);
      if (j * 64 + 63 <= q0 && j * 64 + 512 > q0 + 31) softmax_pv_nomask(s, a, Vt, sc, l15, g);
      else softmax_pv(s, a, Vt, sc, l15, g, valid);
    });
  u16* Y = (u16*)(p.ws + OFF_H);
  const float* ng = p.nsa_norm_g + layer * 64;
#pragma unroll
  for (int qt = 0; qt < 2; ++qt) {
    const int t = q0 + qt * 16 + l15;
    const float lt = group_sum4(a.l[qt]);
    const float gt = sigmoidf_(smb[(size_t)t * NSMALL + SM_G + h * 3 + 2]) * (lt > 0.f ? 1.f / lt : 0.f);
    f32x4 v[4]; float ss = 0.f;
#pragma unroll
    for (int d = 0; d < 4; ++d) { v[d] = park[(d * 2 + qt) * 64] + a.o[d][qt] * gt; ss += v[d][0] * v[d][0] + v[d][1] * v[d][1] + v[d][2] * v[d][2] + v[d][3] * v[d][3]; }
    ss = group_sum4(ss);
    const float rn = rsqrtf(ss * (1.f / 64.f) + 1e-6f);
    const size_t row = (size_t)b * SEQ + t;
#pragma unroll
    for (int d = 0; d < 4; ++d) {
      const int dd = d * 16 + 4 * g;
      const u32x2 zz = *(const u32x2*)(projb + (size_t)t * NP + PA_Z + h * 64 + dd);
      const f32x4 gg = *(const f32x4*)(ng + dd);
      u32x2 o;
      o.x = pack2(v[d][0] * rn * gg[0] * siluf(bflo(zz.x)), v[d][1] * rn * gg[1] * siluf(bfhi(zz.x)));
      o.y = pack2(v[d][2] * rn * gg[2] * siluf(bflo(zz.y)), v[d][3] * rn * gg[3] * siluf(bfhi(zz.y)));
      *(u32x2*)(Y + row * 1024 + Y_A + h * 64 + dd) = o;
    }
  }
}

DI void zero_y_cols(const Params& p, int c0, int ncols, int gtid, int gthreads) {
  u16* Y = (u16*)(p.ws + OFF_H);
  const int per_row = ncols / 8;
  for (size_t i = gtid; i < (size_t)NTOK * per_row; i += gthreads) {
    const size_t row = i / per_row; const int ch = (int)(i % per_row);
    *(u32x4*)(Y + row * 1024 + c0 + ch * 8) = (u32x4){0u, 0u, 0u, 0u};
  }
}

DI void final_norm_rows(const Params& p, int gw, int nw, int lane) {
  const float4* gp = (const float4*)p.final_g;
  float4 gg[4];
#pragma unroll
  for (int i = 0; i < 4; ++i) gg[i] = gp[lane + 64 * i];
  for (int row0 = gw * 4; row0 < NTOK; row0 += nw * 4) {
    float4 v[4][4]; float ss[4];
#pragma unroll
    for (int j = 0; j < 4; ++j) {
      const float4* xr = (const float4*)(p.out + (size_t)(row0 + j) * D_MODEL);
#pragma unroll
      for (int i = 0; i < 4; ++i) v[j][i] = xr[lane + 64 * i];
    }
#pragma unroll
    for (int j = 0; j < 4; ++j) {
      float a = 0.f;
#pragma unroll
      for (int i = 0; i < 4; ++i) a += v[j][i].x * v[j][i].x + v[j][i].y * v[j][i].y + v[j][i].z * v[j][i].z + v[j][i].w * v[j][i].w;
      ss[j] = wave_sum(a);
    }
#pragma unroll
    for (int j = 0; j < 4; ++j) {
      float4* xr = (float4*)(p.out + (size_t)(row0 + j) * D_MODEL);
      const float r = rsqrtf(ss[j] * (1.f / D_MODEL) + 1e-6f);
#pragma unroll
      for (int i = 0; i < 4; ++i) { float4 w; w.x = v[j][i].x * r * gg[i].x; w.y = v[j][i].y * r * gg[i].y; w.z = v[j][i].z * r * gg[i].z; w.w = v[j][i].w * r * gg[i].w; xr[lane + 64 * i] = w; }
    }
  }
}

#ifndef DEBUG_CHECK
#define DEBUG_CHECK 0
#endif
#if DEBUG_CHECK
constexpr int NCHK = 12;
DI float block_sum(float v, float* red) {
  v = wave_sum(v);
  lds_barrier();
  if ((threadIdx.x & 63) == 0) red[threadIdx.x >> 6] = v;
  lds_barrier();
  return red[0] + red[1] + red[2] + red[3];
}
DI float block_max(float v, float* red) {
#pragma unroll
  for (int o = 32; o > 0; o >>= 1) v = fmaxf(v, __shfl_xor(v, o));
  lds_barrier();
  if ((threadIdx.x & 63) == 0) red[threadIdx.x >> 6] = v;
  lds_barrier();
  return fmaxf(fmaxf(red[0], red[1]), fmaxf(red[2], red[3]));
}
DI float bfr(float v) { return bf2f(f2bf(v)); }
struct Chk { float num[NCHK], den[NCHK]; };
DI void chk_add(Chk& c, int id, float got, float ref) { const float d = got - ref; c.num[id] += d * d; c.den[id] += ref * ref; }

DI void dbg_diff_attn(const Params& p, int layer, int b, int t, int h, Chk& c, int id, unsigned char* smem) {
  float* p1 = (float*)smem; float* p2 = p1 + 4096; float* red = p2 + 4096;
  const int tid = otid();
  const u16* proj = (const u16*)(p.ws + OFF_PROJ) + (size_t)b * SEQ * NP;
  const u16* q = proj + (size_t)t * NP + PB_Q + h * 64;
  const float scale = 0.17677669529663687f;
  float m1 = -1e30f, m2 = -1e30f;
  for (int s = tid; s <= t; s += 256) {
    const u16* k = proj + (size_t)s * NP + PB_K + h * 64;
    float a1 = 0.f, a2 = 0.f;
    for (int d = 0; d < 32; ++d) { a1 += bf2f(q[d]) * bf2f(k[d]); a2 += bf2f(q[32 + d]) * bf2f(k[32 + d]); }
    a1 *= scale; a2 *= scale; p1[s] = a1; p2[s] = a2; m1 = fmaxf(m1, a1); m2 = fmaxf(m2, a2);
  }
  m1 = block_max(m1, red); m2 = block_max(m2, red);
  float l1 = 0.f, l2 = 0.f;
  for (int s = tid; s <= t; s += 256) { const float e1 = __expf(p1[s] - m1), e2 = __expf(p2[s] - m2); p1[s] = e1; p2[s] = e2; l1 += e1; l2 += e2; }
  l1 = block_sum(l1, red); l2 = block_sum(l2, red);
  const float* lam = p.diff_lam + layer * 128;
  float s01 = 0.f, s23 = 0.f;
  for (int i = 0; i < 32; ++i) { s01 += lam[i] * lam[32 + i]; s23 += lam[64 + i] * lam[96 + i]; }
  const float lam_init = 0.8f - 0.6f * expf(-0.3f * (float)layer);
  const float lam_full = expf(s01) - expf(s23) + lam_init;
  lds_barrier();
  float o = 0.f;
  if (tid < 64) for (int s = 0; s <= t; ++s) o += (p1[s] / l1 - lam_full * p2[s] / l2) * bf2f(proj[(size_t)s * NP + PB_V + h * 64 + tid]);
  float ss = block_sum(tid < 64 ? o * o : 0.f, red);
  if (tid < 64) {
    const float z = bf2f(proj[(size_t)t * NP + PB_Z + h * 64 + tid]);
    const float ref = o * rsqrtf(ss / 64.f + 1e-6f) * p.diff_norm_g[layer * 64 + tid] * (1.f - lam_init) * (z / (1.f + expf(-z)));
    const float got = bf2f(((const u16*)(p.ws + OFF_H))[((size_t)b * SEQ + t) * 1024 + Y_B + h * 64 + tid]);
    const float d = got - ref;
    o = d * d; ss = ref * ref;
  } else { o = 0.f; ss = 0.f; }
  c.num[id] += block_sum(o, red); c.den[id] += block_sum(ss, red);
}

DI float dbg_conv(const u16* projb, int t, int pcol, const float* cw, const float* cb, int ch, int nch) {
  float a = cb[ch];
  for (int j = 0; j < 4; ++j) { const int tt = t - 3 + j; if (tt >= 0) a += cw[j * nch + ch] * bf2f(projb[(size_t)tt * NP + pcol]); }
  return a / (1.f + expf(-a));
}
constexpr int DBG_NS = 11, DBG_T = 300;
DI int dbg_sample_idx(int t) {
  const int TS[DBG_NS] = {0, 1, 2, 3, 64, 127, 128, 129, 255, 256, 299};
  for (int i = 0; i < DBG_NS; ++i) if (TS[i] == t) return i;
  return -1;
}
DI int dbg_sample_t(int i) { const int TS[DBG_NS] = {0, 1, 2, 3, 64, 127, 128, 129, 255, 256, 299}; return TS[i]; }
DI void dbg_ssd(const Params& p, int layer, int b, int gi, Chk& c, int id, unsigned char* smem) {
  float* ybuf = (float*)smem;
  float* red = ybuf + DBG_NS * 128;
  const int tid = threadIdx.x, pp = tid >> 2, nq = tid & 3;
  const u16* projb = (const u16*)(p.ws + OFF_PROJ) + (size_t)b * SEQ * NP;
  const float* smb = (const float*)(p.ws + OFF_SMALL) + (size_t)b * SEQ * NSMALL;
  const float* cw = p.ssm_conv_w + layer * 4 * 512; const float* cb = p.ssm_conv_b + layer * 512;
  lds_barrier();
  for (int hh = 0; hh < 2; ++hh) {
    const int h = gi * 2 + hh;
    const float a_h = -expf(p.ssm_a_log[layer * 4 + h]), d_h = p.ssm_d[layer * 4 + h], dtb = p.ssm_dt_bias[layer * 4 + h];
    float hst[16];
    for (int i = 0; i < 16; ++i) hst[i] = 0.f;
    for (int t = 0; t < DBG_T; ++t) {
      const float xr = smb[(size_t)t * NSMALL + SM_DT + h] + dtb;
      const float dt = xr > 20.f ? xr : log1pf(expf(xr));
      const float dA = expf(dt * a_h);
      const float xp = dbg_conv(projb, t, PC_XBC + h * 64 + pp, cw, cb, h * 64 + pp, 512);
      float y = 0.f;
      for (int i = 0; i < 16; ++i) {
        const int n = nq * 16 + i;
        const float Bn = dbg_conv(projb, t, PC_XBC + 256 + gi * 64 + n, cw, cb, 256 + gi * 64 + n, 512);
        const float Cn = dbg_conv(projb, t, PC_XBC + 384 + gi * 64 + n, cw, cb, 384 + gi * 64 + n, 512);
        hst[i] = dA * hst[i] + dt * xp * Bn;
        y += Cn * hst[i];
      }
      y += __shfl_xor(y, 1); y += __shfl_xor(y, 2);
      y += d_h * xp;
      const int si = dbg_sample_idx(t);
      if (si >= 0 && nq == 0) { const float z = bf2f(projb[(size_t)t * NP + PC_Z + h * 64 + pp]); ybuf[si * 128 + hh * 64 + pp] = y * (z / (1.f + expf(-z))); }
    }
  }
  lds_barrier();
  for (int si = 0; si < DBG_NS; ++si) {
    const float v = tid < 128 ? ybuf[si * 128 + tid] : 0.f;
    const float ss = block_sum(v * v, red);
    float e2 = 0.f, r2 = 0.f;
    if (tid < 128) {
      const float ref = v * rsqrtf(ss / 128.f + 1e-6f) * p.ssm_norm_g[layer * 256 + gi * 128 + tid];
      const float got = bf2f(((const u16*)(p.ws + OFF_H))[((size_t)b * SEQ + dbg_sample_t(si)) * 1024 + Y_C + gi * 128 + tid]);
      e2 = (got - ref) * (got - ref); r2 = ref * ref;
    }
    c.num[id] += block_sum(e2, red); c.den[id] += block_sum(r2, red);
  }
}
DI void dbg_mlstm(const Params& p, int layer, int b, int h, Chk& c, int id, unsigned char* smem) {
  float* ybuf = (float*)smem;
  float* red = ybuf + DBG_NS * 128;
  const int tid = threadIdx.x, dd = tid >> 2, eq = tid & 3;
  const u16* projb = (const u16*)(p.ws + OFF_PROJ) + (size_t)b * SEQ * NP;
  const float* smb = (const float*)(p.ws + OFF_SMALL) + (size_t)b * SEQ * NSMALL;
  const float* cw = p.ml_conv_w + layer * 4 * 512; const float* cb = p.ml_conv_b + layer * 512;
  const float ib = p.ml_if_b[layer * 8 + h], fb = p.ml_if_b[layer * 8 + 4 + h];
  lds_barrier();
  float Cst[16], nst[16];
  for (int i = 0; i < 16; ++i) { Cst[i] = 0.f; nst[i] = 0.f; }
  float m = 0.f;
  for (int t = 0; t < DBG_T; ++t) {
    const float ip = smb[(size_t)t * NSMALL + SM_IF + h] + ib, fp = smb[(size_t)t * NSMALL + SM_IF + 4 + h] + fb;
    const float lf = fminf(fp, 0.f) - log1pf(expf(-fabsf(fp)));
    const float mn = fmaxf(lf + m, ip), fs = expf(lf + m - mn), is = expf(ip - mn);
    const float vd = bf2f(projb[(size_t)t * NP + PD_V + h * 64 + dd]);
    float num = 0.f, den = 0.f;
    for (int i = 0; i < 16; ++i) {
      const int e = eq * 16 + i;
      const float qe = dbg_conv(projb, t, PD_QK + h * 64 + e, cw, cb, h * 64 + e, 512);
      const float ke = 0.125f * dbg_conv(projb, t, PD_QK + 256 + h * 64 + e, cw, cb, 256 + h * 64 + e, 512);
      Cst[i] = fs * Cst[i] + is * vd * ke; nst[i] = fs * nst[i] + is * ke;
      num += Cst[i] * qe; den += nst[i] * qe;
    }
    num += __shfl_xor(num, 1); num += __shfl_xor(num, 2); den += __shfl_xor(den, 1); den += __shfl_xor(den, 2);
    const float hv = num / fmaxf(fabsf(den), expf(-mn));
    m = mn;
    const int si = dbg_sample_idx(t);
    if (si >= 0 && eq == 0) { const float o = bf2f(projb[(size_t)t * NP + PD_O + h * 64 + dd]); ybuf[si * 64 + dd] = hv / (1.f + expf(-o)); }
  }
  lds_barrier();
  for (int si = 0; si < DBG_NS; ++si) {
    const float v = tid < 64 ? ybuf[si * 64 + tid] : 0.f;
    const float ss = block_sum(v * v, red);
    float e2 = 0.f, r2 = 0.f;
    if (tid < 64) {
      const int t = dbg_sample_t(si);
      const float z = bf2f(projb[(size_t)t * NP + PD_Z + h * 64 + tid]);
      const float ref = v * rsqrtf(ss / 64.f + 1e-6f) * p.ml_norm_g[layer * 64 + tid] * (z / (1.f + expf(-z)));
      const float got = bf2f(((const u16*)(p.ws + OFF_H))[((size_t)b * SEQ + t) * 1024 + Y_D + h * 64 + tid]);
      e2 = (got - ref) * (got - ref); r2 = ref * ref;
    }
    c.num[id] += block_sum(e2, red); c.den[id] += block_sum(r2, red);
  }
}

DI void debug_checks(const Params& p, unsigned char* smem) {
  const int tid = otid();
  float* red = (float*)(smem + 36 * 1024);
  Chk c;
  for (int i = 0; i < NCHK; ++i) { c.num[i] = 0.f; c.den[i] = 0.f; }
  const float* adap = (const float*)(p.ws + OFF_ADAP);
  const u16* H = (const u16*)(p.ws + OFF_H);
  const u16* proj = (const u16*)(p.ws + OFF_PROJ);
  const float* sm = (const float*)(p.ws + OFF_SMALL);
#if DEBUG_CHECK == 1
  {
    const int bs[2] = {0, 5}; const int ns[4] = {3, 1024 + 77, 2048 + 500, 3071};
    for (int bi = 0; bi < 2; ++bi) for (int ni = 0; ni < 4; ++ni) {
      const int b = bs[bi], n = ns[ni];
      float a = 0.f;
      for (int k = tid; k < 1024; k += 256) { const float v = p.c[b * 1024 + k]; a += (v / (1.f + expf(-v))) * p.ada_w[(size_t)k * 3072 + n]; }
      const float ref = block_sum(a, red) + p.ada_b[n];
      float got = 0.f; for (int kc = 0; kc < 8; ++kc) got += adap[(((size_t)kc * 2 + 0) * 8 + b) * 3072 + n];
      chk_add(c, 1, got, ref);
    }
  }
  {
    const int ms[3] = {1, 9000, 32767};
    const int ns[14] = {0, 300, 700, 900, 1500, 2000, 2300, 2693, 3300, 3500, 3967, 3970, 3981, 3990};
    for (int mi = 0; mi < 3; ++mi) {
      const int m = ms[mi], b = m >> 12;
      float ss = 0.f;
      for (int k = tid; k < 1024; k += 256) { const float v = p.x[(size_t)m * 1024 + k]; ss += v * v; }
      ss = block_sum(ss, red);
      const float rstd = rsqrtf(ss / 1024.f + 1e-6f);
      for (int ni = 0; ni < 14; ++ni) {
        const int n = ns[ni], col = colmap(n);
        float a = 0.f, herr = 0.f, href = 0.f;
        for (int k = tid; k < 1024; k += 256) {
          float shf = 0.f, scl = 0.f;
          for (int kc = 0; kc < 8; ++kc) { const float* ap = adap + (((size_t)kc * 2 + 0) * 8 + b) * 3072; shf += ap[k]; scl += ap[1024 + k]; }
          const float hv = p.x[(size_t)m * 1024 + k] * rstd * p.norm_g[k] * (1.f + scl) + shf;
          const float hg = bf2f(H[(size_t)m * 1024 + k]);
          herr += (hg - hv) * (hg - hv); href += hv * hv;
          a += hv * p.w_in[(size_t)k * D_IN + col];
        }
        const float ref = block_sum(a, red);
        herr = block_sum(herr, red); href = block_sum(href, red);
        if (ni == 0 && DEBUG_STAGE == 1) { c.num[3] += herr; c.den[3] += href; }
        const float got = n < NP ? bf2f(proj[(size_t)m * NP + n]) : sm[(size_t)m * NSMALL + (n - NP)];
        chk_add(c, 2, got, ref);
      }
    }
  }
#endif
#if DEBUG_CHECK == 2
  dbg_diff_attn(p, 0, 0, 5, 0, c, 4, smem);
  dbg_diff_attn(p, 0, 1, 200, 3, c, 4, smem);
  dbg_diff_attn(p, 0, 3, 1500, 2, c, 4, smem);
  dbg_diff_attn(p, 0, 7, 4095, 1, c, 4, smem);
  {
    const int ms[3] = {2, 12345, 32766}; const int ns[3] = {0, 513, 1023};
    const u16* Y = (const u16*)(p.ws + OFF_H);
    for (int mi = 0; mi < 3; ++mi) for (int ni = 0; ni < 3; ++ni) {
      const int m = ms[mi], n = ns[ni], b = m >> 12;
      float a = 0.f;
      for (int k = tid; k < 1024; k += 256) a += bf2f(Y[(size_t)m * 1024 + k]) * p.w_out[(size_t)k * 1024 + n];
      a = block_sum(a, red);
      float gate = 0.f; for (int kc = 0; kc < 8; ++kc) gate += adap[(((size_t)kc * 2 + 0) * 8 + b) * 3072 + 2048 + n];
      chk_add(c, 5, p.out[(size_t)m * 1024 + n] - p.x[(size_t)m * 1024 + n], gate * a);
    }
  }
#endif
#if DEBUG_CHECK == 3
  dbg_ssd(p, 0, 0, 0, c, 6, smem);
  dbg_ssd(p, 0, 5, 1, c, 6, smem);
  dbg_mlstm(p, 0, 0, 0, c, 7, smem);
  dbg_mlstm(p, 0, 6, 3, c, 7, smem);
#endif
  lds_barrier();
  if (tid == 0) {
    int wid_ = 0, wcls = 99;
    for (int i = 1; i < NCHK; ++i) if (c.den[i] > 0.f) {
      const float rel = sqrtf(c.num[i] / c.den[i]);
      int cls = rel >= 1.f ? 0 : (int)floorf(-log10f(fmaxf(rel, 1e-9f)));
      if (cls > 9) cls = 9;
      if (!(rel == rel)) cls = 0;
      if (cls < wcls) { wcls = cls; wid_ = i; }
    }
    p.out[0] = 1e5f * ((float)wid_ + 0.1f * (float)wcls);
  }
}
#endif

constexpr int HALF_LDS = 76 * 1024;
constexpr int SMEM_BYTES = 2 * HALF_LDS;
__global__ void __launch_bounds__(512, 2) fwd_megakernel(Params p) {
  cg::grid_group grid = cg::this_grid();
  __shared__ __attribute__((aligned(16))) unsigned char smem[SMEM_BYTES];
  const int half = __builtin_amdgcn_readfirstlane(threadIdx.x >> 8);
  unsigned char* hsm = smem + half * HALF_LDS;
  const int G = gridDim.x, bid = blockIdx.x;
  const int slot = bid * 2 + half, NS = 2 * G;
  for (int t = slot; t < ((T0_TOTAL + NS - 1) / NS) * NS; t += NS) phase0_task(p, t < T0_TOTAL ? t : T0_TOTAL - 1, hsm);
  grid.sync();
  for (int layer = 0; layer < 2; ++layer) {
    Params q = p;
    asm volatile("" : "+s"(q.ws));
    const float* xin = layer == 0 ? q.x : q.out;
    for (int t = slot; t < ((NTOK / 64 + NS - 1) / NS) * NS; t += NS) phase1_task(q, layer, xin, t < NTOK / 64 ? t : NTOK / 64 - 1, hsm);
    grid.sync();
    for (int t = bid; t < (NTOK / 256) * (NPAD / 256); t += G) gemm_inproj_tile(q, layer, t, smem);
    grid.sync();
#if DEBUG_CHECK == 1
    if (bid == 0 && half == 0) debug_checks(q, smem);
    return;
#endif
    {
      unsigned* cnt = (unsigned*)(q.ws + OFF_CNT);
      int* s_pair = (int*)(smem + SMEM_BYTES - 16);
      if (bid < 16) ssd_task(q, layer, slot >> 2, slot & 3, hsm);
      else if (bid < 32) mlstm_task(q, layer, (slot - 32) >> 2, (slot - 32) & 3, hsm);
      constexpr int NPAIR_C = 64, NPAIR_D = 512, NPAIR_N = 512, NPAIR = NPAIR_C + NPAIR_D + NPAIR_N;
      for (;;) {
        const int t512 = otid512();
        lds_barrier();
        if (t512 == 0) *s_pair = (int)atomicAdd(cnt + layer, 1u);
        lds_barrier();
        const int pair = *s_pair;
        if (pair >= NPAIR) break;
        if (pair < NPAIR_C) {
          const int v = pair * 2 + half;
          compress_task(q, layer, v >> 4, (v >> 3) & 1, v & 7, hsm);
          asm volatile("s_waitcnt vmcnt(0)" ::: "memory");
          lds_barrier();
          if (t512 == 0) {
            __builtin_amdgcn_fence(__ATOMIC_RELEASE, "agent");
            asm volatile("s_waitcnt vmcnt(0)" ::: "memory");
            __hip_atomic_fetch_add(cnt + 2 + layer, 1u, __ATOMIC_RELAXED, __HIP_MEMORY_SCOPE_AGENT);
          }
        } else if (pair < NPAIR_C + NPAIR_D) {
          const int u = (pair - NPAIR_C) * 2 + half, qb = 31 - (u >> 5), bh = u & 31;
          diff_attn_task(q, layer, bh >> 2, bh & 3, qb, hsm);
        } else {
          if (t512 == 0) {
            while (__hip_atomic_load(cnt + 2 + layer, __ATOMIC_RELAXED, __HIP_MEMORY_SCOPE_AGENT) < (unsigned)NPAIR_C) __builtin_amdgcn_s_sleep(16);
            __builtin_amdgcn_fence(__ATOMIC_ACQUIRE, "agent");
            asm volatile("s_waitcnt vmcnt(0)" ::: "memory");
          }
          lds_barrier();
          const int u = (pair - NPAIR_C - NPAIR_D) * 2 + half;
          nsa_task(q, layer, u & 7, 127 - (u >> 3), hsm);
        }
      }
    }
    grid.sync();
    for (int t = slot; t < NTOK / 64; t += NS) seq_fix_rows(q, layer, t * 64, 64);
    grid.sync();
    for (int t = bid; t < (NTOK / 256) * 4; t += G) gemm_outproj_tile(q, layer, xin, q.out, t, smem);
    grid.sync();
#if DEBUG_CHECK >= 2
    if (bid == 0 && half == 0) debug_checks(q, smem);
    return;
#endif
  }
  { const int t5 = otid512(); final_norm_rows(p, bid * 8 + (t5 >> 6), G * 8, t5 & 63); }
}

extern "C" void kernel_launch(void* const* d_in, const int* in_sizes, int n_in, void* d_out, int out_size, void* d_ws, size_t ws_size,
                              hipStream_t stream) {
  static int grid_blocks = 0;
  if (!grid_blocks) {
    int dev = 0, cus = 0, per_cu = 0;
    (void)hipGetDevice(&dev);
    (void)hipDeviceGetAttribute(&cus, hipDeviceAttributeMultiprocessorCount, dev);
    (void)hipOccupancyMaxActiveBlocksPerMultiprocessor(&per_cu, fwd_megakernel, 512, 0);
    if (per_cu > 1) per_cu = 1;
    if (per_cu < 1) per_cu = 1;
    grid_blocks = cus * per_cu;
  }
  if (grid_blocks < 64 || (grid_blocks & 3)) { fprintf(stderr, "grid too small: %d\n", grid_blocks); return; }
  if (ws_size < WS_NEEDED) { fprintf(stderr, "workspace too small: %zu < %zu\n", ws_size, WS_NEEDED); return; }
  Params p{};
  const float** pp = (const float**)&p;
  for (int i = 0; i < 26; ++i) pp[i] = (const float*)d_in[i];
  p.out = (float*)d_out; p.ws = (unsigned char*)d_ws;
  (void)hipMemsetAsync((unsigned char*)d_ws + OFF_CNT, 0, 64, stream);
  void* args[] = {&p};
  hipError_t e = hipLaunchCooperativeKernel((void*)fwd_megakernel, dim3(grid_blocks), dim3(512), args, 0, stream);
  if (e != hipSuccess) fprintf(stderr, "cooperative launch failed: %s (grid %d)\n", hipGetErrorString(e), grid_blocks);
}
```

```cpp
#include <hip/hip_runtime.h>
#include <hip/hip_cooperative_groups.h>
#include <cstdio>
#include <cstdint>
#define DEBUG_CHECK 0
#define DEBUG_STAGE 1
#define REP_P1 1
#define REP_P2 1
#define REP_SEQ 1
#define REP_DIFF 1
#define REP_NSA 1
#define REP_P4 1
#define REP_P0 1
namespace cg = cooperative_groups;

typedef unsigned short u16;
typedef short bf16x8 __attribute__((ext_vector_type(8)));
typedef short s16x4 __attribute__((ext_vector_type(4)));
typedef float f32x4 __attribute__((ext_vector_type(4)));
typedef float f32x2 __attribute__((ext_vector_type(2)));
typedef unsigned u32x4 __attribute__((ext_vector_type(4)));
typedef unsigned u32x2 __attribute__((ext_vector_type(2)));
typedef __bf16 bf16x2_t __attribute__((ext_vector_type(2)));
#define DI __device__ __forceinline__
#define LDSP __attribute__((address_space(3)))

constexpr int D_MODEL = 1024, BATCH = 8, SEQ = 4096, NTOK = BATCH * SEQ;
constexpr int D_IN = 3992;
constexpr int NP = 3968, NPAD = 4096, NSMALL = 32;
constexpr int PA_Q = 0, PA_KC = 256, PA_VC = 320, PA_KS = 384, PA_VS = 448, PA_KW = 512, PA_VW = 576, PA_Z = 640;
constexpr int PB_Q = 896, PB_K = 1152, PB_V = 1408, PB_Z = 1664;
constexpr int PC_Z = 1920, PC_XBC = 2176;
constexpr int PD_QK = 2688, PD_V = 3200, PD_O = 3456, PD_Z = 3712;
constexpr int SM_G = 0, SM_DT = 12, SM_IF = 16;
constexpr int Y_A = 0, Y_B = 256, Y_C = 512, Y_D = 768;

constexpr size_t MiB = 1024 * 1024;
constexpr size_t OFF_WINT = 0;
constexpr size_t OFF_WOUTT = 16 * MiB;
constexpr size_t OFF_W1T = 20 * MiB;
constexpr size_t OFF_W2T = 22 * MiB;
constexpr size_t OFF_BIAS1 = 22 * MiB + 64 * 1024;
constexpr size_t OFF_ADAP = 22 * MiB + 128 * 1024;
constexpr size_t OFF_KCMP = 24 * MiB;
constexpr size_t OFF_VCMP = 24 * MiB + 256 * 1024;
constexpr size_t OFF_CNT = 29 * MiB;
constexpr size_t OFF_SMALL = 25 * MiB;
constexpr size_t OFF_SSQ = 29 * MiB;
constexpr size_t OFF_H = 32 * MiB;
constexpr size_t OFF_PROJ = 96 * MiB;
constexpr size_t WS_NEEDED = 96 * MiB + (size_t)NTOK * NP * 2;

struct Params {
  const float* x; const float* c; const float* norm_g; const float* ada_w; const float* ada_b;
  const float* w_in; const float* w_out;
  const float* nsa_cmp_pos; const float* nsa_ck_w1; const float* nsa_ck_w2; const float* nsa_cv_w1; const float* nsa_cv_w2; const float* nsa_norm_g;
  const float* diff_lam; const float* diff_norm_g;
  const float* ssm_conv_w; const float* ssm_conv_b; const float* ssm_dt_bias; const float* ssm_a_log; const float* ssm_d; const float* ssm_norm_g;
  const float* ml_conv_w; const float* ml_conv_b; const float* ml_if_b; const float* ml_norm_g; const float* final_g;
  float* out; unsigned char* ws;
};

DI void lds_barrier() { asm volatile("s_waitcnt lgkmcnt(0)" ::: "memory"); __builtin_amdgcn_s_barrier(); asm volatile("" ::: "memory"); }
DI int otid() { int t = threadIdx.x & 255; asm volatile("" : "+v"(t)); return t; }
DI int otid512() { int t = threadIdx.x; asm volatile("" : "+v"(t)); return t; }
DI unsigned pack2(float a, float b) { f32x2 v = {a, b}; bf16x2_t r = __builtin_convertvector(v, bf16x2_t); return __builtin_bit_cast(unsigned, r); }
DI u16 f2bf(float a) { return (u16)(pack2(a, 0.f) & 0xffffu); }
DI float bf2f(u16 h) { return __uint_as_float(((unsigned)h) << 16); }
DI float bflo(unsigned u) { return __uint_as_float(u << 16); }
DI float bfhi(unsigned u) { return __uint_as_float(u & 0xffff0000u); }
DI f32x4 mfma16(bf16x8 a, bf16x8 b, f32x4 c) { return __builtin_amdgcn_mfma_f32_16x16x32_bf16(a, b, c, 0, 0, 0); }
DI float wave_sum(float v) {
#pragma unroll
  for (int o = 32; o > 0; o >>= 1) v += __shfl_xor(v, o);
  return v;
}
DI float siluf(float v) { return v * __builtin_amdgcn_rcpf(1.f + __expf(-v)); }
DI float sigmoidf_(float v) { return __builtin_amdgcn_rcpf(1.f + __expf(-v)); }
DI float exp2_(float v) { return __builtin_amdgcn_exp2f(v); }
DI s16x4 tr_read(const u16* p) { return __builtin_amdgcn_ds_read_tr16_b64_v4i16((LDSP s16x4*)p); }
DI bf16x8 cat4(s16x4 a, s16x4 b) { bf16x8 r; r[0] = a[0]; r[1] = a[1]; r[2] = a[2]; r[3] = a[3]; r[4] = b[0]; r[5] = b[1]; r[6] = b[2]; r[7] = b[3]; return r; }
DI bf16x8 ldfrag(const u16* p) { return *(const bf16x8*)p; }

DI int colmap(int n) {
  if (n < 640) return n;
  if (n < 896) return 652 + (n - 640);
  if (n < 1920) return 908 + (n - 896);
  if (n < 2688) return 1932 + (n - 1920);
  if (n < 3456) return 2704 + (n - 2688);
  if (n < 3968) return 3480 + (n - 3456);
  if (n < 3980) return 640 + (n - 3968);
  if (n < 3984) return 2700 + (n - 3980);
  if (n < 3992) return 3472 + (n - 3984);
  return -1;
}

DI void tconv_tile(const float* __restrict__ src, int ldsrc, int k0, int n0, u16* __restrict__ dst, int ldd, bool use_map, unsigned char* smem) {
  float* tile = (float*)smem;
  const int tid = otid();
  lds_barrier();
  {
    const int nn = tid & 63; int col = n0 + nn; if (use_map) col = colmap(col);
#pragma unroll
    for (int i = 0; i < 16; ++i) { const int kk = i * 4 + (tid >> 6); tile[kk * 65 + nn] = col >= 0 ? src[(size_t)(k0 + kk) * ldsrc + col] : 0.f; }
  }
  lds_barrier();
#pragma unroll
  for (int i = 0; i < 2; ++i) {
    const int item = tid + 256 * i, nn = item >> 3, kc = item & 7;
    u32x4 w;
    w.x = pack2(tile[(kc * 8 + 0) * 65 + nn], tile[(kc * 8 + 1) * 65 + nn]);
    w.y = pack2(tile[(kc * 8 + 2) * 65 + nn], tile[(kc * 8 + 3) * 65 + nn]);
    w.z = pack2(tile[(kc * 8 + 4) * 65 + nn], tile[(kc * 8 + 5) * 65 + nn]);
    w.w = pack2(tile[(kc * 8 + 6) * 65 + nn], tile[(kc * 8 + 7) * 65 + nn]);
    *(u32x4*)(dst + (size_t)(n0 + nn) * ldd + k0 + kc * 8) = w;
  }
}

constexpr int T0_WIN = 2 * 16 * 64, T0_WOUT = 2 * 16 * 16, T0_W1 = 4 * 32 * 2, T0_W2 = 4 * 2, T0_ADA = 2 * 12 * 8, T0_B1 = 64;
constexpr int T0_TOTAL = T0_WIN + T0_WOUT + T0_W1 + T0_W2 + T0_ADA + T0_B1;

DI void phase0_task(const Params& p, int t, unsigned char* smem) {
  const int tid = otid();
  if (t < T0_WIN) {
    const int l = t / 1024, r = t % 1024, kt = r / 64, nt = r % 64;
    tconv_tile(p.w_in + (size_t)l * D_MODEL * D_IN, D_IN, kt * 64, nt * 64, (u16*)(p.ws + OFF_WINT) + (size_t)l * NPAD * 1024, 1024, true, smem);
    return;
  }
  t -= T0_WIN;
  if (t < T0_WOUT) {
    const int l = t / 256, r = t % 256, kt = r / 16, nt = r % 16;
    tconv_tile(p.w_out + (size_t)l * 1024 * 1024, 1024, kt * 64, nt * 64, (u16*)(p.ws + OFF_WOUTT) + (size_t)l * 1024 * 1024, 1024, false, smem);
    return;
  }
  t -= T0_WOUT;
  if (t < T0_W1) {
    const int m = t / 64, r = t % 64, kt = r / 2, nt = r % 2, l = m >> 1, kv = m & 1;
    const float* src = (kv ? p.nsa_cv_w1 : p.nsa_ck_w1) + (size_t)l * 2048 * 128;
    tconv_tile(src, 128, kt * 64, nt * 64, (u16*)(p.ws + OFF_W1T) + (size_t)m * 128 * 2048, 2048, false, smem);
    return;
  }
  t -= T0_W1;
  if (t < T0_W2) {
    const int m = t / 2, kt = t % 2, l = m >> 1, kv = m & 1;
    const float* src = (kv ? p.nsa_cv_w2 : p.nsa_ck_w2) + (size_t)l * 128 * 64;
    tconv_tile(src, 64, kt * 64, 0, (u16*)(p.ws + OFF_W2T) + (size_t)m * 64 * 128, 128, false, smem);
    return;
  }
  t -= T0_W2;
  if (t < T0_ADA) {
    const int l = t / 96, r = t % 96, nc = r / 8, kc = r % 8;
    float* cact = (float*)smem;
    lds_barrier();
    for (int i = tid; i < 1024; i += 256) { const int b = i >> 7, kk = i & 127; const float v = p.c[b * 1024 + kc * 128 + kk]; cact[i] = siluf(v); }
    lds_barrier();
    const int n = nc * 256 + tid;
    float acc[8];
#pragma unroll
    for (int b = 0; b < 8; ++b) acc[b] = 0.f;
    const float* w = p.ada_w + ((size_t)l * 1024 + kc * 128) * 3072 + n;
#pragma unroll 16
    for (int kk = 0; kk < 128; ++kk) {
      const float wv = w[(size_t)kk * 3072];
#pragma unroll
      for (int b = 0; b < 8; ++b) acc[b] += cact[b * 128 + kk] * wv;
    }
    float* adap = (float*)(p.ws + OFF_ADAP);
    const float bias = kc == 0 ? p.ada_b[l * 3072 + n] : 0.f;
#pragma unroll
    for (int b = 0; b < 8; ++b) adap[(((size_t)kc * 2 + l) * 8 + b) * 3072 + n] = acc[b] + bias;
    return;
  }
  t -= T0_ADA;
  {
    const int m = t >> 4, kc = t & 15, l = m >> 1, kv = m & 1;
    const float* w1 = (kv ? p.nsa_cv_w1 : p.nsa_ck_w1) + (size_t)l * 2048 * 128;
    const float* pos = p.nsa_cmp_pos + (size_t)l * 2048;
    const int n = tid & 127, half = tid >> 7;
    float acc = 0.f;
    const int k0 = kc * 128 + half * 64;
#pragma unroll 16
    for (int k = 0; k < 64; ++k) acc += pos[k0 + k] * w1[(size_t)(k0 + k) * 128 + n];
    float* red = (float*)smem;
    lds_barrier();
    red[tid] = acc;
    lds_barrier();
    if (tid < 128) ((float*)(p.ws + OFF_BIAS1))[(m * 16 + kc) * 128 + tid] = red[tid] + red[tid + 128];
  }
}

DI void phase1_task(const Params& p, int layer, const float* xin, int grp, unsigned char* smem) {
  const int tid = otid(), lane = tid & 63, wid = tid >> 6;
  const int b = grp >> 6;
  float* mul = (float*)smem;
  float* sh = mul + 1024;
  const float* adap = (const float*)(p.ws + OFF_ADAP);
  lds_barrier();
  for (int c = tid; c < 1024; c += 256) {
    float s0 = 0.f, s1 = 0.f;
#pragma unroll
    for (int kc = 0; kc < 8; ++kc) { const float* a = adap + (((size_t)kc * 2 + layer) * 8 + b) * 3072; s0 += a[c]; s1 += a[1024 + c]; }
    mul[c] = p.norm_g[layer * 1024 + c] * (1.f + s1); sh[c] = s0;
  }
  lds_barrier();
  u16* H = (u16*)(p.ws + OFF_H);
#pragma unroll 1
  for (int it = 0; it < 4; ++it) {
    float4 v[4][4]; float ss[4];
#pragma unroll
    for (int j = 0; j < 4; ++j) {
      const int row = grp * 64 + wid * 16 + it * 4 + j;
      const float4* xr = (const float4*)(xin + (size_t)row * D_MODEL);
#pragma unroll
      for (int i = 0; i < 4; ++i) v[j][i] = xr[lane + 64 * i];
    }
#pragma unroll
    for (int j = 0; j < 4; ++j) {
      float a = 0.f;
#pragma unroll
      for (int i = 0; i < 4; ++i) a += v[j][i].x * v[j][i].x + v[j][i].y * v[j][i].y + v[j][i].z * v[j][i].z + v[j][i].w * v[j][i].w;
      ss[j] = wave_sum(a);
    }
#pragma unroll
    for (int j = 0; j < 4; ++j) {
      const int row = grp * 64 + wid * 16 + it * 4 + j;
      const float r = rsqrtf(ss[j] * (1.f / D_MODEL) + 1e-6f);
#pragma unroll
      for (int i = 0; i < 4; ++i) {
        const int c = (lane + 64 * i) * 4;
        u32x2 w;
        w.x = pack2(v[j][i].x * r * mul[c] + sh[c], v[j][i].y * r * mul[c + 1] + sh[c + 1]);
        w.y = pack2(v[j][i].z * r * mul[c + 2] + sh[c + 2], v[j][i].w * r * mul[c + 3] + sh[c + 3]);
        *(u32x2*)(H + (size_t)row * 1024 + c) = w;
      }
    }
  }
}

namespace g8 {
constexpr int BM = 256, BK = 64, HALF = 128, HT = HALF * BK;
constexpr int LDS_BYTES = 8 * HT * 2;
DI int lds_byte(int r, int c) { const int st = (r >> 4) * 2 + (c >> 5), rr = r & 15, cc = c & 31, ob = rr * 64 + cc * 2; return st * 1024 + (ob ^ (((ob >> 9) & 1) << 5)); }
DI void stage_rc(int b, int& R, int& C) { const int st = b / 1024, sb = b % 1024, swz = sb ^ (((sb >> 9) & 1) << 5); R = (st >> 1) * 16 + swz / 64; C = (st & 1) * 32 + (swz % 64) / 2; }

DI void kloop(const u16* __restrict__ A, const u16* __restrict__ Bt, int K, int brow, int bcol, unsigned char* smem, f32x4 (&acc)[2][2][4][2]) {
  u16* shm = (u16*)smem;
  const int tid = otid512();
#define SA(b, h) (shm + ((b) * 2 + (h)) * HT)
#define SB(b, h) (shm + (4 + (b) * 2 + (h)) * HT)
#define STAGE(P, BASE, br, kt) do { const u16* _gb = BASE + ((long)(br) * K + (long)(kt) * BK); \
      __builtin_amdgcn_global_load_lds((const unsigned*)(_gb + soff0), (LDSP unsigned*)((LDSP char*)(P) + tid * 16), 16, 0, 0); \
      __builtin_amdgcn_global_load_lds((const unsigned*)(_gb + soff1), (LDSP unsigned*)((LDSP char*)(P) + tid * 16 + 8192), 16, 0, 0); } while (0)
#define LDA(dst, b, h) _Pragma("unroll") for (int m = 0; m < 4; ++m) _Pragma("unroll") for (int k = 0; k < 2; ++k) \
    dst[m][k] = *reinterpret_cast<const bf16x8*>((const char*)SA(b, h) + lds_byte(wr * 64 + m * 16 + fr, k * 32 + fq * 8))
#define LDB(dst, b, h) _Pragma("unroll") for (int n = 0; n < 2; ++n) _Pragma("unroll") for (int k = 0; k < 2; ++k) \
    dst[n][k] = *reinterpret_cast<const bf16x8*>((const char*)SB(b, h) + lds_byte(wc * 32 + n * 16 + fr, k * 32 + fq * 8))
#define MMA(ai, bj, At_, Bt_) do { __builtin_amdgcn_s_setprio(1); \
    _Pragma("unroll") for (int m = 0; m < 4; ++m) _Pragma("unroll") for (int n = 0; n < 2; ++n) _Pragma("unroll") for (int k = 0; k < 2; ++k) \
      acc[ai][bj][m][n] = __builtin_amdgcn_mfma_f32_16x16x32_bf16(Bt_[n][k], At_[m][k], acc[ai][bj][m][n], 0, 0, 0); \
    __builtin_amdgcn_s_setprio(0); } while (0)
#define WAIT_V(n) asm volatile("s_waitcnt vmcnt(" #n ")" ::: "memory")
#define WAIT_L(n) asm volatile("s_waitcnt lgkmcnt(" #n ")" ::: "memory")
#define BAR __builtin_amdgcn_s_barrier()
#define SCHED __builtin_amdgcn_sched_barrier(0)
  const int wid = __builtin_amdgcn_readfirstlane(tid >> 6), lane = tid & 63, wr = wid >> 2, wc = wid & 3, fr = lane & 15, fq = lane >> 4;
#pragma unroll
  for (int a = 0; a < 2; ++a)
#pragma unroll
    for (int b = 0; b < 2; ++b)
#pragma unroll
      for (int m = 0; m < 4; ++m) { acc[a][b][m][0] = (f32x4){0.f, 0.f, 0.f, 0.f}; acc[a][b][m][1] = (f32x4){0.f, 0.f, 0.f, 0.f}; }
  bf16x8 At[4][2], B0[2][2], B1[2][2];
  const int nt = K / BK;
  int soff0, soff1;
  { int r_, c_; stage_rc(tid * 16, r_, c_); soff0 = r_ * K + c_; stage_rc(tid * 16 + 8192, r_, c_); soff1 = r_ * K + c_; }
  STAGE(SB(0, 0), Bt, bcol, 0); STAGE(SA(0, 0), A, brow, 0);
  STAGE(SB(0, 1), Bt, bcol + HALF, 0); STAGE(SA(0, 1), A, brow + HALF, 0);
  if (wr == 1) BAR;
  WAIT_V(4); BAR;
  STAGE(SB(1, 0), Bt, bcol, 1); STAGE(SA(1, 0), A, brow, 1); STAGE(SB(1, 1), Bt, bcol + HALF, 1);
  WAIT_V(6); BAR;
#pragma unroll 1
  for (int t = 0; t < nt - 2; t += 2) {
    asm volatile("" : "+v"(soff0), "+v"(soff1));
    LDB(B0, 0, 0); SCHED; LDA(At, 0, 0); STAGE(SA(1, 1), A, brow + HALF, t + 1);
    WAIT_L(8); BAR; WAIT_L(0); MMA(0, 0, At, B0); BAR; SCHED;
    LDB(B1, 0, 1); STAGE(SB(0, 0), Bt, bcol, t + 2);
    BAR; WAIT_L(0); MMA(0, 1, At, B1); BAR;
    LDA(At, 0, 1); STAGE(SA(0, 0), A, brow, t + 2);
    BAR; WAIT_L(0); MMA(1, 0, At, B0); BAR; SCHED;
    STAGE(SB(0, 1), Bt, bcol + HALF, t + 2);
    WAIT_V(6); BAR; MMA(1, 1, At, B1); BAR;
    LDB(B0, 1, 0); SCHED; LDA(At, 1, 0); STAGE(SA(0, 1), A, brow + HALF, t + 2);
    WAIT_L(8); BAR; WAIT_L(0); MMA(0, 0, At, B0); BAR; SCHED;
    LDB(B1, 1, 1); STAGE(SB(1, 0), Bt, bcol, t + 3);
    BAR; WAIT_L(0); MMA(0, 1, At, B1); BAR;
    LDA(At, 1, 1); STAGE(SA(1, 0), A, brow, t + 3);
    BAR; WAIT_L(0); MMA(1, 0, At, B0); BAR; SCHED;
    STAGE(SB(1, 1), Bt, bcol + HALF, t + 3);
    WAIT_V(6); BAR; MMA(1, 1, At, B1); BAR;
  }
  { LDB(B0, 0, 0); LDA(At, 0, 0); STAGE(SA(1, 1), A, brow + HALF, nt - 1);
    BAR; WAIT_L(0); MMA(0, 0, At, B0); BAR;
    LDB(B1, 0, 1); BAR; WAIT_L(0); MMA(0, 1, At, B1); BAR;
    LDA(At, 0, 1); WAIT_V(4); BAR; WAIT_L(0); MMA(1, 0, At, B0); MMA(1, 1, At, B1); BAR; }
  { LDB(B0, 1, 0); LDA(At, 1, 0); WAIT_V(2); BAR; WAIT_L(0); MMA(0, 0, At, B0); BAR;
    LDB(B1, 1, 1); WAIT_V(0); BAR; WAIT_L(0); MMA(0, 1, At, B1); BAR;
    LDA(At, 1, 1); BAR; WAIT_L(0); MMA(1, 0, At, B0); MMA(1, 1, At, B1); BAR; }
  if (wr == 0) BAR;
#undef SA
#undef SB
#undef STAGE
#undef LDA
#undef LDB
#undef MMA
#undef WAIT_V
#undef WAIT_L
#undef BAR
#undef SCHED
}
DI void tile_map(int wgid, int nM, int nN, int& pm, int& pn) {
  const int nwg = nM * nN, NXCD = 8, WGM = 8;
  { const int q = nwg / NXCD, r = nwg % NXCD, xcd = wgid % NXCD, off = wgid / NXCD; wgid = (xcd < r ? xcd * (q + 1) : r * (q + 1) + (xcd - r) * q) + off; }
  const int nig = WGM * nN, gid = wgid / nig, fm = gid * WGM, gsz = (nM - fm) < WGM ? (nM - fm) : WGM;
  pm = fm + ((wgid % nig) % gsz); pn = (wgid % nig) / gsz;
}
}

DI void gemm_inproj_tile(const Params& p, int layer, int tile, unsigned char* smem) {
  int pm, pn; g8::tile_map(tile, NTOK / 256, NPAD / 256, pm, pn);
  const int brow = pm * 256, bcol = pn * 256;
  f32x4 acc[2][2][4][2];
  g8::kloop((const u16*)(p.ws + OFF_H), (const u16*)(p.ws + OFF_WINT) + (size_t)layer * NPAD * 1024, 1024, brow, bcol, smem, acc);
  const int tid = otid512(), wid = __builtin_amdgcn_readfirstlane(tid >> 6), lane = tid & 63, wr = wid >> 2, wc = wid & 3, fr = lane & 15, fq = lane >> 4;
  u16* proj = (u16*)(p.ws + OFF_PROJ);
  if (pn == 15 && wc == 0) {
    float* sm = (float*)(p.ws + OFF_SMALL);
#pragma unroll
    for (int ai = 0; ai < 2; ++ai)
#pragma unroll
      for (int m = 0; m < 4; ++m)
#pragma unroll
        for (int n = 0; n < 2; ++n) {
          const int mr = brow + ai * 128 + wr * 64 + m * 16 + fr;
          *(f32x4*)(sm + (size_t)mr * NSMALL + n * 16 + 4 * fq) = acc[ai][1][m][n];
        }
  }
  constexpr int CLD = 264;
  u16* Cs = (u16*)smem;
#pragma unroll
  for (int ai = 0; ai < 2; ++ai) {
    lds_barrier();
#pragma unroll
    for (int bj = 0; bj < 2; ++bj)
#pragma unroll
      for (int m = 0; m < 4; ++m)
#pragma unroll
        for (int n = 0; n < 2; ++n) {
          const f32x4 v = acc[ai][bj][m][n];
          u32x2 w; w.x = pack2(v[0], v[1]); w.y = pack2(v[2], v[3]);
          *(u32x2*)(Cs + (wr * 64 + m * 16 + fr) * CLD + bj * 128 + wc * 32 + n * 16 + 4 * fq) = w;
        }
    lds_barrier();
#pragma unroll
    for (int i = 0; i < 8; ++i) {
      const int id = tid + 512 * i, row = id >> 5, ch = id & 31;
      if (bcol + ch * 8 < NP) *(u32x4*)(proj + (size_t)(brow + ai * 128 + row) * NP + bcol + ch * 8) = *(const u32x4*)(Cs + row * CLD + ch * 8);
    }
  }
  asm volatile("s_waitcnt vmcnt(0)" ::: "memory");
  lds_barrier();
}

DI void gemm_outproj_tile(const Params& p, int layer, const float* xin, float* xout, int tile, unsigned char* smem) {
  int pm, pn; g8::tile_map(tile, NTOK / 256, 4, pm, pn);
  const int brow = pm * 256, bcol = pn * 256;
  f32x4 acc[2][2][4][2];
  g8::kloop((const u16*)(p.ws + OFF_H), (const u16*)(p.ws + OFF_WOUTT) + (size_t)layer * 1024 * 1024, 1024, brow, bcol, smem, acc);
  const int tid = otid512(), wid = __builtin_amdgcn_readfirstlane(tid >> 6), lane = tid & 63, wr = wid >> 2, wc = wid & 3, fr = lane & 15, fq = lane >> 4;
  const int b = brow >> 12;
  const float* adap = (const float*)(p.ws + OFF_ADAP);
  constexpr int CLD = 132;
  float* Cs = (float*)smem;
#pragma unroll
  for (int ai = 0; ai < 2; ++ai)
#pragma unroll
    for (int bj = 0; bj < 2; ++bj) {
      lds_barrier();
#pragma unroll
      for (int m = 0; m < 4; ++m)
#pragma unroll
        for (int n = 0; n < 2; ++n) *(f32x4*)(Cs + (wr * 64 + m * 16 + fr) * CLD + wc * 32 + n * 16 + 4 * fq) = acc[ai][bj][m][n];
      lds_barrier();
      const int ch = tid & 31, nc = bcol + bj * 128 + ch * 4;
      f32x4 gt = {0.f, 0.f, 0.f, 0.f};
#pragma unroll
      for (int kc = 0; kc < 8; ++kc) gt += *(const f32x4*)(adap + (((size_t)kc * 2 + layer) * 8 + b) * 3072 + 2048 + nc);
      f32x4 xv[8];
#pragma unroll
      for (int i = 0; i < 8; ++i) xv[i] = *(const f32x4*)(xin + (size_t)(brow + ai * 128 + (tid >> 5) + 16 * i) * 1024 + nc);
#pragma unroll
      for (int i = 0; i < 8; ++i) {
        const int row = (tid >> 5) + 16 * i;
        *(f32x4*)(xout + (size_t)(brow + ai * 128 + row) * 1024 + nc) = xv[i] + gt * *(const f32x4*)(Cs + row * CLD + ch * 4);
      }
    }
  asm volatile("s_waitcnt vmcnt(0)" ::: "memory");
  lds_barrier();
}

constexpr int KLD = 72;
struct KVRegs { u32x4 k[2], v[2]; };
DI void kv_load(const u16* kbase, const u16* vbase, int ldk, int ldv, int key0, KVRegs& r) {
  const int tid = otid();
#pragma unroll
  for (int i = 0; i < 2; ++i) {
    const int id = tid + 256 * i, row = id >> 3, ch = id & 7;
    r.k[i] = *(const u32x4*)(kbase + (size_t)(key0 + row) * ldk + ch * 8);
    r.v[i] = *(const u32x4*)(vbase + (size_t)(key0 + row) * ldv + ch * 8);
  }
}
DI void kv_store(u16* Ks, u16* Vs, const KVRegs& r) {
  const int tid = otid();
#pragma unroll
  for (int i = 0; i < 2; ++i) {
    const int id = tid + 256 * i, row = id >> 3, ch = id & 7;
    *(u32x4*)(Ks + row * KLD + ch * 8) = r.k[i];
    *(u32x4*)(Vs + row * KLD + ch * 8) = r.v[i];
  }
}
constexpr int KVBUF = 2 * 64 * KLD;
template <class UseF, class LoadF, class CompF>
DI void kv_pipeline(int j0, int j1, u16* buf, UseF use, LoadF load, CompF comp) {
  KVRegs kr;
  if (use(j0)) load(j0, kr);
  lds_barrier();
  if (use(j0)) kv_store(buf, buf + 64 * KLD, kr);
  if (j0 + 1 < j1 && use(j0 + 1)) load(j0 + 1, kr);
  lds_barrier();
  for (int j = j0; j < j1; ++j) {
    u16* cur = buf + ((j - j0) & 1) * KVBUF; u16* nxt = buf + (((j - j0) & 1) ^ 1) * KVBUF;
    if (j + 1 < j1 && use(j + 1)) kv_store(nxt, nxt + 64 * KLD, kr);
    if (j + 2 < j1 && use(j + 2)) load(j + 2, kr);
    if (use(j)) comp(j, cur, cur + 64 * KLD);
    lds_barrier();
  }
}
struct AttnAcc { f32x4 o[4][2]; float m[2], l[2]; };
DI void attn_init(AttnAcc& a) {
#pragma unroll
  for (int d = 0; d < 4; ++d) { a.o[d][0] = (f32x4){0.f, 0.f, 0.f, 0.f}; a.o[d][1] = (f32x4){0.f, 0.f, 0.f, 0.f}; }
  a.m[0] = a.m[1] = -1e30f; a.l[0] = a.l[1] = 0.f;
}
template <int NKS>
DI void qk_tile(const u16* Ks, int dofs, const bf16x8 (&qf)[2][NKS], f32x4 (&s)[4][2], int l15, int g) {
#pragma unroll
  for (int kt = 0; kt < 4; ++kt) {
    s[kt][0] = (f32x4){0.f, 0.f, 0.f, 0.f}; s[kt][1] = (f32x4){0.f, 0.f, 0.f, 0.f};
#pragma unroll
    for (int ks = 0; ks < NKS; ++ks) {
      const bf16x8 a = ldfrag(Ks + (kt * 16 + l15) * KLD + dofs + ks * 32 + 8 * g);
      s[kt][0] = mfma16(a, qf[0][ks], s[kt][0]);
      s[kt][1] = mfma16(a, qf[1][ks], s[kt][1]);
    }
  }
}
DI void pv_accum(const bf16x8 (&pf)[2][2], const u16* Vs, f32x4 (&o)[4][2], int l15, int g) {
  const int tq = l15 >> 2, tp = l15 & 3;
#pragma unroll
  for (int kk = 0; kk < 2; ++kk)
#pragma unroll
    for (int d = 0; d < 4; ++d) {
      const bf16x8 vf = cat4(tr_read(Vs + (kk * 32 + 4 * g + tq) * KLD + d * 16 + 4 * tp), tr_read(Vs + (kk * 32 + 16 + 4 * g + tq) * KLD + d * 16 + 4 * tp));
      o[d][0] = mfma16(vf, pf[0][kk], o[d][0]);
      o[d][1] = mfma16(vf, pf[1][kk], o[d][1]);
    }
}
DI void pack_p(const f32x4 (&s)[4][2], bf16x8 (&pf)[2][2]) {
#pragma unroll
  for (int qt = 0; qt < 2; ++qt)
#pragma unroll
    for (int kk = 0; kk < 2; ++kk) {
      u32x4 w;
      w.x = pack2(s[2 * kk][qt][0], s[2 * kk][qt][1]); w.y = pack2(s[2 * kk][qt][2], s[2 * kk][qt][3]);
      w.z = pack2(s[2 * kk + 1][qt][0], s[2 * kk + 1][qt][1]); w.w = pack2(s[2 * kk + 1][qt][2], s[2 * kk + 1][qt][3]);
      pf[qt][kk] = __builtin_bit_cast(bf16x8, w);
    }
}
constexpr float DEFER_THR = 5.f;
template <class VF>
DI void softmax_pv(f32x4 (&s)[4][2], AttnAcc& a, const u16* Vs, float sc, int l15, int g, VF valid) {
  bf16x8 pf[2][2];
  float mxl[2];
#pragma unroll
  for (int qt = 0; qt < 2; ++qt) {
    float mx = -1e30f;
#pragma unroll
    for (int kt = 0; kt < 4; ++kt)
#pragma unroll
      for (int r = 0; r < 4; ++r) { const float v = valid(kt, r, qt) ? s[kt][qt][r] * sc : -1e30f; s[kt][qt][r] = v; mx = fmaxf(mx, v); }
    mxl[qt] = mx;
  }
  if (__any((mxl[0] > a.m[0] + DEFER_THR) || (mxl[1] > a.m[1] + DEFER_THR))) {
#pragma unroll
    for (int qt = 0; qt < 2; ++qt) {
      float mx = mxl[qt];
      mx = fmaxf(mx, __shfl_xor(mx, 16)); mx = fmaxf(mx, __shfl_xor(mx, 32));
      const float mn = fmaxf(a.m[qt], mx), alpha = exp2_(a.m[qt] - mn);
      a.m[qt] = mn; a.l[qt] *= alpha;
#pragma unroll
      for (int d = 0; d < 4; ++d) a.o[d][qt] *= alpha;
    }
  }
#pragma unroll
  for (int qt = 0; qt < 2; ++qt) {
    const float mn = a.m[qt];
    float ls = 0.f;
#pragma unroll
    for (int kt = 0; kt < 4; ++kt)
#pragma unroll
      for (int r = 0; r < 4; ++r) { const float v = s[kt][qt][r]; const float pv = v > -1e29f ? exp2_(v - mn) : 0.f; s[kt][qt][r] = pv; ls += pv; }
    a.l[qt] += ls;
  }
  pack_p(s, pf);
  pv_accum(pf, Vs, a.o, l15, g);
}
DI void softmax_pv_nomask(f32x4 (&s)[4][2], AttnAcc& a, const u16* Vs, float sc, int l15, int g) {
  bf16x8 pf[2][2];
  float mxl[2];
#pragma unroll
  for (int qt = 0; qt < 2; ++qt) {
    float mx = s[0][qt][0];
#pragma unroll
    for (int kt = 0; kt < 4; ++kt)
#pragma unroll
      for (int r = 0; r < 4; ++r) mx = fmaxf(mx, s[kt][qt][r]);
    mxl[qt] = mx * sc;
  }
  if (__any((mxl[0] > a.m[0] + DEFER_THR) || (mxl[1] > a.m[1] + DEFER_THR))) {
#pragma unroll
    for (int qt = 0; qt < 2; ++qt) {
      float mx = mxl[qt];
      mx = fmaxf(mx, __shfl_xor(mx, 16)); mx = fmaxf(mx, __shfl_xor(mx, 32));
      const float mn = fmaxf(a.m[qt], mx), alpha = exp2_(a.m[qt] - mn);
      a.m[qt] = mn; a.l[qt] *= alpha;
#pragma unroll
      for (int d = 0; d < 4; ++d) a.o[d][qt] *= alpha;
    }
  }
#pragma unroll
  for (int qt = 0; qt < 2; ++qt) {
    const float mn = a.m[qt];
    float ls = 0.f;
#pragma unroll
    for (int kt = 0; kt < 4; ++kt)
#pragma unroll
      for (int r = 0; r < 4; ++r) { const float pv = exp2_(__builtin_fmaf(s[kt][qt][r], sc, -mn)); s[kt][qt][r] = pv; ls += pv; }
    a.l[qt] += ls;
  }
  pack_p(s, pf);
  pv_accum(pf, Vs, a.o, l15, g);
}
template <class VF>
DI void softmax_p(f32x4 (&s)[4][2], AttnAcc& a, float sc, bf16x8 (&pf)[2][2], bool nomask, VF valid) {
  float mxl[2];
#pragma unroll
  for (int qt = 0; qt < 2; ++qt) {
    float mx = -1e30f;
#pragma unroll
    for (int kt = 0; kt < 4; ++kt)
#pragma unroll
      for (int r = 0; r < 4; ++r) { const float v = (nomask || valid(kt, r, qt)) ? s[kt][qt][r] * sc : -1e30f; s[kt][qt][r] = v; mx = fmaxf(mx, v); }
    mxl[qt] = mx;
  }
  if (__any((mxl[0] > a.m[0] + DEFER_THR) || (mxl[1] > a.m[1] + DEFER_THR))) {
#pragma unroll
    for (int qt = 0; qt < 2; ++qt) {
      float mx = mxl[qt];
      mx = fmaxf(mx, __shfl_xor(mx, 16)); mx = fmaxf(mx, __shfl_xor(mx, 32));
      const float mn = fmaxf(a.m[qt], mx), alpha = exp2_(a.m[qt] - mn);
      a.m[qt] = mn; a.l[qt] *= alpha;
#pragma unroll
      for (int d = 0; d < 4; ++d) a.o[d][qt] *= alpha;
    }
  }
#pragma unroll
  for (int qt = 0; qt < 2; ++qt) {
    const float mn = a.m[qt];
    float ls = 0.f;
#pragma unroll
    for (int kt = 0; kt < 4; ++kt)
#pragma unroll
      for (int r = 0; r < 4; ++r) { const float v = s[kt][qt][r]; const float pv = v > -1e29f ? exp2_(v - mn) : 0.f; s[kt][qt][r] = pv; ls += pv; }
    a.l[qt] += ls;
  }
  pack_p(s, pf);
}
DI void softmax_p_nomask(f32x4 (&s)[4][2], AttnAcc& a, float sc, bf16x8 (&pf)[2][2]) {
  float mxl[2];
#pragma unroll
  for (int qt = 0; qt < 2; ++qt) {
    float mx = s[0][qt][0];
#pragma unroll
    for (int kt = 0; kt < 4; ++kt)
#pragma unroll
      for (int r = 0; r < 4; ++r) mx = fmaxf(mx, s[kt][qt][r]);
    mxl[qt] = mx * sc;
  }
  if (__any((mxl[0] > a.m[0] + DEFER_THR) || (mxl[1] > a.m[1] + DEFER_THR))) {
#pragma unroll
    for (int qt = 0; qt < 2; ++qt) {
      float mx = mxl[qt];
      mx = fmaxf(mx, __shfl_xor(mx, 16)); mx = fmaxf(mx, __shfl_xor(mx, 32));
      const float mn = fmaxf(a.m[qt], mx), alpha = exp2_(a.m[qt] - mn);
      a.m[qt] = mn; a.l[qt] *= alpha;
#pragma unroll
      for (int d = 0; d < 4; ++d) a.o[d][qt] *= alpha;
    }
  }
#pragma unroll
  for (int qt = 0; qt < 2; ++qt) {
    const float mn = a.m[qt];
    float ls = 0.f;
#pragma unroll
    for (int kt = 0; kt < 4; ++kt)
#pragma unroll
      for (int r = 0; r < 4; ++r) { const float pv = exp2_(__builtin_fmaf(s[kt][qt][r], sc, -mn)); s[kt][qt][r] = pv; ls += pv; }
    a.l[qt] += ls;
  }
  pack_p(s, pf);
}
template <class LoadF, class CompF>
DI void kv_pipeline3(int j0, int j1, u16* buf, LoadF load, CompF comp) {
  KVRegs kr;
  load(j0, kr);
  lds_barrier();
  kv_store(buf, buf + 64 * KLD, kr);
  if (j0 + 1 < j1) load(j0 + 1, kr);
  lds_barrier();
  int cb = 0;
  for (int j = j0; j < j1; ++j) {
    const int nb = cb == 2 ? 0 : cb + 1, pb = cb == 0 ? 2 : cb - 1;
    if (j + 1 < j1) kv_store(buf + nb * KVBUF, buf + nb * KVBUF + 64 * KLD, kr);
    if (j + 2 < j1) load(j + 2, kr);
    comp(j, buf + cb * KVBUF, buf + pb * KVBUF);
    lds_barrier();
    cb = nb;
  }
}
DI float group_sum4(float v) { v += __shfl_xor(v, 16); v += __shfl_xor(v, 32); return v; }

DI void diff_attn_task(const Params& p, int layer, int b, int h, int qb, unsigned char* smem, bool skew) {
  u16* Ks = (u16*)smem; u16* Vs = Ks + 64 * KLD;
  const int tid = otid(), lane = tid & 63, wid = tid >> 6, l15 = lane & 15, g = lane >> 4;
  const u16* proj = (const u16*)(p.ws + OFF_PROJ) + (size_t)b * SEQ * NP;
  const int q0w = qb * 128 + wid * 32;
  const float* lam = p.diff_lam + layer * 128;
  float s01 = 0.f, s23 = 0.f;
  for (int i = 0; i < 32; ++i) { s01 += lam[i] * lam[32 + i]; s23 += lam[64 + i] * lam[96 + i]; }
  const float lam_init = 0.8f - 0.6f * __expf(-0.3f * (float)layer);
  const float lam_full = __expf(s01) - __expf(s23) + lam_init;
  const float sc = 0.17677669529663687f * 1.4426950408889634f;
  const int ntile = 2 * qb + 2;
  const u16* vbase = proj + PB_V + h * 64;
  f32x4 res[4][2];
#pragma unroll 1
  for (int c = 0; c < 2; ++c) {
    const u16* kbase = proj + PB_K + h * 64 + c * 32;
    bf16x8 qf[2][1];
#pragma unroll
    for (int qt = 0; qt < 2; ++qt) qf[qt][0] = ldfrag(proj + (size_t)(q0w + qt * 16 + l15) * NP + PB_Q + h * 64 + c * 32 + 8 * g);
    AttnAcc a; attn_init(a);
    bf16x8 pfs[2][2]; bool havepf = false;
    kv_pipeline3(0, ntile, Ks,
      [&](int j, KVRegs& kr) { kv_load(kbase, vbase, NP, NP, j * 64, kr); },
      [&](int j, const u16* cur, const u16* prev) {
        const int key0 = j * 64;
        if (skew && havepf) { pv_accum(pfs, prev + 64 * KLD, a.o, l15, g); havepf = false; }
        if (key0 <= q0w + 31) {
          f32x4 s[4][2];
          auto valid = [&](int kt, int r, int qt) { return key0 + kt * 16 + 4 * g + r <= q0w + qt * 16 + l15; };
          qk_tile<1>(cur, 0, qf, s, l15, g);
          if (key0 + 63 <= q0w) softmax_p_nomask(s, a, sc, pfs); else softmax_p(s, a, sc, pfs, false, valid);
          if (skew) havepf = true; else pv_accum(pfs, cur + 64 * KLD, a.o, l15, g);
        }
      });
    if (skew && havepf) pv_accum(pfs, Ks + ((ntile - 1) % 3) * KVBUF + 64 * KLD, a.o, l15, g);
#pragma unroll
    for (int qt = 0; qt < 2; ++qt) {
      const float lt = group_sum4(a.l[qt]);
      const float inv = c == 0 ? 1.f / lt : -lam_full / lt;
#pragma unroll
      for (int d = 0; d < 4; ++d) res[d][qt] = c == 0 ? a.o[d][qt] * inv : res[d][qt] + a.o[d][qt] * inv;
    }
  }
  u16* Y = (u16*)(p.ws + OFF_H);
  const float* ng = p.diff_norm_g + layer * 64;
#pragma unroll
  for (int qt = 0; qt < 2; ++qt) {
    float ss = 0.f;
#pragma unroll
    for (int d = 0; d < 4; ++d) { const f32x4 v = res[d][qt]; ss += v[0] * v[0] + v[1] * v[1] + v[2] * v[2] + v[3] * v[3]; }
    ss = group_sum4(ss);
    const float rn = rsqrtf(ss * (1.f / 64.f) + 1e-6f) * (1.f - lam_init);
    const int t = q0w + qt * 16 + l15;
    const size_t row = (size_t)b * SEQ + t;
#pragma unroll
    for (int d = 0; d < 4; ++d) {
      const int dd = d * 16 + 4 * g;
      const f32x4 v = res[d][qt];
      const u32x2 zz = *(const u32x2*)(proj + (size_t)t * NP + PB_Z + h * 64 + dd);
      const f32x4 gg = *(const f32x4*)(ng + dd);
      u32x2 w;
      w.x = pack2(v[0] * rn * gg[0] * siluf(bflo(zz.x)), v[1] * rn * gg[1] * siluf(bfhi(zz.x)));
      w.y = pack2(v[2] * rn * gg[2] * siluf(bflo(zz.y)), v[3] * rn * gg[3] * siluf(bfhi(zz.y)));
      *(u32x2*)(Y + row * 1024 + Y_B + h * 64 + dd) = w;
    }
  }
}

template <int NKS>
DI void qk_tile1(const u16* Ks, const bf16x8 (&qf)[NKS], f32x4 (&s)[4], int l15, int g) {
#pragma unroll
  for (int kt = 0; kt < 4; ++kt) {
    s[kt] = (f32x4){0.f, 0.f, 0.f, 0.f};
#pragma unroll
    for (int ks = 0; ks < NKS; ++ks) s[kt] = mfma16(ldfrag(Ks + (kt * 16 + l15) * KLD + ks * 32 + 8 * g), qf[ks], s[kt]);
  }
}
DI void pv_accum1(const f32x4 (&s)[4], const u16* Vs, f32x4 (&o)[4], int l15, int g) {
  const int tq = l15 >> 2, tp = l15 & 3;
#pragma unroll
  for (int kk = 0; kk < 2; ++kk) {
    u32x4 w;
    w.x = pack2(s[2 * kk][0], s[2 * kk][1]); w.y = pack2(s[2 * kk][2], s[2 * kk][3]);
    w.z = pack2(s[2 * kk + 1][0], s[2 * kk + 1][1]); w.w = pack2(s[2 * kk + 1][2], s[2 * kk + 1][3]);
    const bf16x8 pf = __builtin_bit_cast(bf16x8, w);
#pragma unroll
    for (int d = 0; d < 4; ++d) {
      const bf16x8 vf = cat4(tr_read(Vs + (kk * 32 + 4 * g + tq) * KLD + d * 16 + 4 * tp), tr_read(Vs + (kk * 32 + 16 + 4 * g + tq) * KLD + d * 16 + 4 * tp));
      o[d] = mfma16(vf, pf, o[d]);
    }
  }
}
DI void conv_silu_stage(const u16* projb, int col0, const float* cw, const float* cb, int chan0, int nchan, int t0, u16* dst, const float* rowscale, float cscale) {
  const int tid = otid(), ch = (tid & 7) * 8;
  float w[4][8], bias[8];
#pragma unroll
  for (int j = 0; j < 4; ++j)
#pragma unroll
    for (int i = 0; i < 8; ++i) w[j][i] = cw[j * nchan + chan0 + ch + i];
#pragma unroll
  for (int i = 0; i < 8; ++i) bias[i] = cb[chan0 + ch + i];
#pragma unroll 1
  for (int ps = 0; ps < 4; ++ps) {
    const int row = ps * 32 + (tid >> 3), t = t0 + row;
    float acc[8];
#pragma unroll
    for (int i = 0; i < 8; ++i) acc[i] = bias[i];
#pragma unroll
    for (int j = 0; j < 4; ++j) {
      const int tt = t - 3 + j;
      if (tt >= 0) {
        const u32x4 v = *(const u32x4*)(projb + (size_t)tt * NP + col0 + ch);
        acc[0] += w[j][0] * bflo(v.x); acc[1] += w[j][1] * bfhi(v.x); acc[2] += w[j][2] * bflo(v.y); acc[3] += w[j][3] * bfhi(v.y);
        acc[4] += w[j][4] * bflo(v.z); acc[5] += w[j][5] * bfhi(v.z); acc[6] += w[j][6] * bflo(v.w); acc[7] += w[j][7] * bfhi(v.w);
      }
    }
    const float rs = (rowscale ? rowscale[row] : 1.f) * cscale;
#pragma unroll
    for (int i = 0; i < 8; ++i) acc[i] = siluf(acc[i]) * rs;
    u32x4 o; o.x = pack2(acc[0], acc[1]); o.y = pack2(acc[2], acc[3]); o.z = pack2(acc[4], acc[5]); o.w = pack2(acc[6], acc[7]);
    *(u32x4*)(dst + row * KLD + ch) = o;
  }
}
DI float block_scan128_add(float v, float* tmp) {
  const int tid = otid(), lane = tid & 63;
  float x = v;
#pragma unroll
  for (int o = 1; o < 64; o <<= 1) { const float y = __shfl_up(x, o); if (lane >= o) x += y; }
  lds_barrier();
  if (tid == 63) tmp[0] = x;
  lds_barrier();
  if ((tid >> 6) == 1) x += tmp[0];
  return x;
}
DI float block_scan128_max(float v, float* tmp) {
  const int tid = otid(), lane = tid & 63;
  float x = v;
#pragma unroll
  for (int o = 1; o < 64; o <<= 1) { const float y = __shfl_up(x, o); if (lane >= o) x = fmaxf(x, y); }
  lds_barrier();
  if (tid == 63) tmp[0] = x;
  lds_barrier();
  if ((tid >> 6) == 1) x = fmaxf(x, tmp[0]);
  return x;
}
DI void scale_rows(u16* A, const float* rs) {
  const int tid = otid(), ch = (tid & 7) * 8;
#pragma unroll
  for (int ps = 0; ps < 4; ++ps) {
    const int row = ps * 32 + (tid >> 3);
    const float f = rs[row];
    u32x4 v = *(u32x4*)(A + row * KLD + ch);
    v.x = pack2(bflo(v.x) * f, bfhi(v.x) * f); v.y = pack2(bflo(v.y) * f, bfhi(v.y) * f);
    v.z = pack2(bflo(v.z) * f, bfhi(v.z) * f); v.w = pack2(bflo(v.w) * f, bfhi(v.w) * f);
    *(u32x4*)(A + row * KLD + ch) = v;
  }
}
DI void state_update(const u16* Xs, const u16* Bs, f32x4 (&acc)[4], int w, int l15, int g) {
  const int tq = l15 >> 2, tp = l15 & 3;
#pragma unroll
  for (int kk = 0; kk < 4; ++kk) {
    const bf16x8 af = cat4(tr_read(Xs + (kk * 32 + 4 * g + tq) * KLD + w * 16 + 4 * tp), tr_read(Xs + (kk * 32 + 16 + 4 * g + tq) * KLD + w * 16 + 4 * tp));
#pragma unroll
    for (int nt = 0; nt < 4; ++nt) {
      const bf16x8 bfr = cat4(tr_read(Bs + (kk * 32 + 4 * g + tq) * KLD + nt * 16 + 4 * tp), tr_read(Bs + (kk * 32 + 16 + 4 * g + tq) * KLD + nt * 16 + 4 * tp));
      acc[nt] = mfma16(af, bfr, acc[nt]);
    }
  }
}
DI void state_to_lds(u16* Ss, const f32x4 (&acc)[4], int w, int l15, int g) {
#pragma unroll
  for (int nt = 0; nt < 4; ++nt)
#pragma unroll
    for (int r = 0; r < 4; ++r) Ss[(w * 16 + 4 * g + r) * KLD + nt * 16 + l15] = f2bf(acc[nt][r]);
}

constexpr int SEQ_LDS_A = 0, SEQ_LDS_B = 128 * KLD * 2, SEQ_LDS_C = 2 * 128 * KLD * 2, SEQ_LDS_S = 3 * 128 * KLD * 2, SEQ_LDS_F = SEQ_LDS_S + 64 * KLD * 2;
constexpr int SEQ_LDS_HALO = SEQ_LDS_F + 4096;
constexpr int SEQ_LDS_CW = SEQ_LDS_HALO + 2 * 3 * 3 * 64 * 2;
struct RawRegs { u32x4 r[4]; };
DI void raw_load(const u16* projb, int col0, int t0, RawRegs& rr, int tid) {
#pragma unroll
  for (int i = 0; i < 4; ++i) rr.r[i] = *(const u32x4*)(projb + (size_t)(t0 + (tid >> 3) + 32 * i) * NP + col0 + (tid & 7) * 8);
}
DI void raw_store(u16* dst, u16* halo_next, const RawRegs& rr, int tid) {
#pragma unroll
  for (int i = 0; i < 4; ++i) *(u32x4*)(dst + ((tid >> 3) + 32 * i) * KLD + (tid & 7) * 8) = rr.r[i];
  if (halo_next && tid >= 232) *(u32x4*)(halo_next + ((tid >> 3) - 29) * 64 + (tid & 7) * 8) = rr.r[3];
}
DI void conv_from_lds(const u16* raw, const u16* halo, const float* wl, const float* rowscale, float cscale, u32x4 (&out)[4], int tid) {
  const int q = tid >> 3, ch = (tid & 7) * 8;
  u32x4 v[7];
#pragma unroll
  for (int k = 0; k < 7; ++k) { const int r = 4 * q - 3 + k; v[k] = r >= 0 ? *(const u32x4*)(raw + r * KLD + ch) : *(const u32x4*)(halo + (r + 3) * 64 + ch); }
  float w[5][8];
#pragma unroll
  for (int j = 0; j < 5; ++j) { const f32x4 w0 = *(const f32x4*)(wl + j * 64 + ch), w1 = *(const f32x4*)(wl + j * 64 + ch + 4);
    w[j][0] = w0[0]; w[j][1] = w0[1]; w[j][2] = w0[2]; w[j][3] = w0[3]; w[j][4] = w1[0]; w[j][5] = w1[1]; w[j][6] = w1[2]; w[j][7] = w1[3]; }
#pragma unroll
  for (int o = 0; o < 4; ++o) {
    float acc[8];
#pragma unroll
    for (int i = 0; i < 8; ++i) acc[i] = w[4][i];
#pragma unroll
    for (int j = 0; j < 4; ++j) {
      const u32x4 x = v[o + j];
      acc[0] += w[j][0] * bflo(x.x); acc[1] += w[j][1] * bfhi(x.x); acc[2] += w[j][2] * bflo(x.y); acc[3] += w[j][3] * bfhi(x.y);
      acc[4] += w[j][4] * bflo(x.z); acc[5] += w[j][5] * bfhi(x.z); acc[6] += w[j][6] * bflo(x.w); acc[7] += w[j][7] * bfhi(x.w);
    }
    const float rs = (rowscale ? rowscale[4 * q + o] : 1.f) * cscale;
#pragma unroll
    for (int i = 0; i < 8; ++i) acc[i] = siluf(acc[i]) * rs;
    out[o].x = pack2(acc[0], acc[1]); out[o].y = pack2(acc[2], acc[3]); out[o].z = pack2(acc[4], acc[5]); out[o].w = pack2(acc[6], acc[7]);
  }
}
DI void conv_write(u16* dst, const u32x4 (&out)[4], int tid) {
  const int q = tid >> 3, ch = (tid & 7) * 8;
#pragma unroll
  for (int o = 0; o < 4; ++o) *(u32x4*)(dst + (4 * q + o) * KLD + ch) = out[o];
}
DI void stage_conv_w(float* wl, const float* cw, const float* cb, int chan0, int nchan, int tid) {
  for (int i = tid; i < 320; i += 256) { const int j = i >> 6, cc = i & 63; wl[i] = j < 4 ? cw[j * nchan + chan0 + cc] : cb[chan0 + cc]; }
}
DI float wave_scan_add(float x, int lane) {
#pragma unroll
  for (int o = 1; o < 64; o <<= 1) { const float y = __shfl_up(x, o); if (lane >= o) x += y; }
  return x;
}
DI float wave_scan_max(float x, int lane) {
#pragma unroll
  for (int o = 1; o < 64; o <<= 1) { const float y = __shfl_up(x, o); if (lane >= o) x = fmaxf(x, y); }
  return x;
}

DI void ssd_task(const Params& p, int layer, int b, int h, unsigned char* smem) {
  u16* Cs = (u16*)(smem + SEQ_LDS_A); u16* Bs = (u16*)(smem + SEQ_LDS_B); u16* Xs = (u16*)(smem + SEQ_LDS_C); u16* Ss = (u16*)(smem + SEQ_LDS_S);
  float* fl = (float*)(smem + SEQ_LDS_F);
  float* dts = fl; float* acs = fl + 128; float* wend = fl + 256; float* tmp = fl + 384;
  u16* halo = (u16*)(smem + SEQ_LDS_HALO); float* cwl = (float*)(smem + SEQ_LDS_CW);
  int tid = otid(), lane = tid & 63, w = tid >> 6, l15 = lane & 15, g = lane >> 4;
  const int gi = h >> 1;
  const u16* projb = (const u16*)(p.ws + OFF_PROJ) + (size_t)b * SEQ * NP;
  const float* smb = (const float*)(p.ws + OFF_SMALL) + (size_t)b * SEQ * NSMALL;
  const float* cw = p.ssm_conv_w + layer * 4 * 512; const float* cb = p.ssm_conv_b + layer * 512;
  u16* Y = (u16*)(p.ws + OFF_H);
  const float a_h = -__expf(p.ssm_a_log[layer * 4 + h]), d_h = p.ssm_d[layer * 4 + h], dtb = p.ssm_dt_bias[layer * 4 + h];
  const int colB = PC_XBC + 256 + gi * 64, colC = PC_XBC + 384 + gi * 64, colX = PC_XBC + h * 64;
  f32x4 st[4];
#pragma unroll
  for (int nt = 0; nt < 4; ++nt) st[nt] = (f32x4){0.f, 0.f, 0.f, 0.f};
  lds_barrier();
  stage_conv_w(cwl, cw, cb, 256 + gi * 64, 512, tid);
  stage_conv_w(cwl + 320, cw, cb, 384 + gi * 64, 512, tid);
  stage_conv_w(cwl + 640, cw, cb, h * 64, 512, tid);
  for (int i = tid; i < 3 * 3 * 64; i += 256) halo[i] = 0;
  RawRegs rB, rC, rX; float dtraw = 0.f;
  raw_load(projb, colB, 0, rB, tid); raw_load(projb, colC, 0, rC, tid); raw_load(projb, colX, 0, rX, tid);
  if (tid < 128) dtraw = smb[(size_t)tid * NSMALL + SM_DT + h];
#pragma unroll 1
  for (int c = 0; c < 32; ++c) {
    const int t0 = c * 128;
    asm volatile("" : "+v"(tid)); lane = tid & 63; w = tid >> 6; l15 = lane & 15; g = lane >> 4;
    u16* hcur = halo + (c & 1) * 576; u16* hnext = halo + ((c + 1) & 1) * 576;
    float dtv = 0.f;
    if (tid < 128) { const float xr = dtraw + dtb; dtv = xr > 15.f ? xr : __logf(1.f + __expf(xr)); }
    float cs = wave_scan_add(dtv * a_h, lane);
    if (tid == 63) tmp[0] = cs;
    lds_barrier();
    if (w == 1) cs += tmp[0];
    if (tid < 128) { dts[tid] = dtv; acs[tid] = cs; }
    raw_store(Bs, hnext, rB, tid); raw_store(Cs, hnext + 192, rC, tid); raw_store(Xs, hnext + 384, rX, tid);
    lds_barrier();
    if (c + 1 < 32) {
      raw_load(projb, colB, t0 + 128, rB, tid); raw_load(projb, colC, t0 + 128, rC, tid);
      if (tid < 128) dtraw = smb[(size_t)(t0 + 128 + tid) * NSMALL + SM_DT + h];
    }
    {
      u32x4 o1[4], o2[4];
      conv_from_lds(Bs, hcur, cwl, nullptr, 1.f, o1, tid);
      lds_barrier();
      conv_write(Bs, o1, tid);
      conv_from_lds(Cs, hcur + 192, cwl + 320, nullptr, 1.f, o2, tid);
      lds_barrier();
      conv_write(Cs, o2, tid);
      conv_from_lds(Xs, hcur + 384, cwl + 640, dts, 1.f, o1, tid);
      lds_barrier();
      conv_write(Xs, o1, tid);
    }
    if (tid < 128) wend[tid] = __expf(acs[127] - acs[tid]);
    state_to_lds(Ss, st, w, l15, g);
    lds_barrier();
#pragma unroll 1
    for (int qt = 0; qt < 2; ++qt) {
      const int tl = 32 * w + qt * 16 + l15;
      bf16x8 cf[2];
#pragma unroll
      for (int ks = 0; ks < 2; ++ks) cf[ks] = ldfrag(Cs + tl * KLD + ks * 32 + 8 * g);
      f32x4 y[4];
#pragma unroll
      for (int d = 0; d < 4; ++d) y[d] = (f32x4){0.f, 0.f, 0.f, 0.f};
      const float at = acs[tl];
#pragma unroll 1
      for (int stl = 0; stl < 2; ++stl) {
        if (stl * 64 <= 32 * w + qt * 16 + 15) {
          f32x4 sc[4];
          qk_tile1<2>(Bs + stl * 64 * KLD, cf, sc, l15, g);
#pragma unroll
          for (int kt = 0; kt < 4; ++kt) {
            const f32x4 as = *(const f32x4*)(acs + stl * 64 + kt * 16 + 4 * g);
#pragma unroll
            for (int r = 0; r < 4; ++r) {
              const bool ok = stl * 64 + kt * 16 + 4 * g + r <= tl;
              sc[kt][r] = ok ? sc[kt][r] * __expf(at - as[r]) : 0.f;
            }
          }
          pv_accum1(sc, Xs + stl * 64 * KLD, y, l15, g);
        }
      }
      const float ea = __expf(at), dsk = d_h / dts[tl];
      const size_t row = (size_t)b * SEQ + t0 + tl;
#pragma unroll
      for (int d = 0; d < 4; ++d) {
        f32x4 yo = (f32x4){0.f, 0.f, 0.f, 0.f};
#pragma unroll
        for (int ks = 0; ks < 2; ++ks) yo = mfma16(ldfrag(Ss + (d * 16 + l15) * KLD + ks * 32 + 8 * g), cf[ks], yo);
        const u32x2 xv = *(const u32x2*)(Xs + tl * KLD + d * 16 + 4 * g);
        const f32x4 v = y[d] + yo * ea;
        u32x2 o; o.x = pack2(v[0] + dsk * bflo(xv.x), v[1] + dsk * bfhi(xv.x)); o.y = pack2(v[2] + dsk * bflo(xv.y), v[3] + dsk * bfhi(xv.y));
        *(u32x2*)(Y + row * 1024 + Y_C + h * 64 + d * 16 + 4 * g) = o;
      }
    }
    if (c + 1 < 32) raw_load(projb, colX, t0 + 128, rX, tid);
    lds_barrier();
    scale_rows(Xs, wend);
    lds_barrier();
    const float cd = __expf(acs[127]);
#pragma unroll
    for (int nt = 0; nt < 4; ++nt) st[nt] *= cd;
    state_update(Xs, Bs, st, w, l15, g);
  }
}
DI void seq_fix_rows(const Params& p, int layer, int r0, int nrows) {
  u16* Y = (u16*)(p.ws + OFF_H);
  const u16* proj = (const u16*)(p.ws + OFF_PROJ);
  const int tid = otid(), lane = tid & 63, wv = tid >> 6;
  const bool ml = lane >= 32;
  const int ch = (lane & 31) * 8;
  const float* ng = ml ? p.ml_norm_g + layer * 64 + (ch & 63) : p.ssm_norm_g + layer * 256 + ch;
  const f32x4 g0 = *(const f32x4*)ng, g1 = *(const f32x4*)(ng + 4);
  for (int rb = wv * 4; rb < nrows; rb += 16) {
    u32x4 yv4[4], zv4[4], ov4[4];
#pragma unroll
    for (int j = 0; j < 4; ++j) {
      const size_t row = (size_t)(r0 + rb + j);
      yv4[j] = *(const u32x4*)(Y + row * 1024 + (ml ? Y_D : Y_C) + ch);
      zv4[j] = *(const u32x4*)(proj + row * NP + (ml ? PD_Z : PC_Z) + ch);
      ov4[j] = ml ? *(const u32x4*)(proj + row * NP + PD_O + ch) : (u32x4){0u, 0u, 0u, 0u};
    }
#pragma unroll
    for (int j = 0; j < 4; ++j) {
      const size_t row = (size_t)(r0 + rb + j);
      u16* yp = Y + row * 1024 + (ml ? Y_D : Y_C) + ch;
      const u32x4 yv = yv4[j], zv = zv4[j], ov = ov4[j];
      float v[8] = {bflo(yv.x), bfhi(yv.x), bflo(yv.y), bfhi(yv.y), bflo(yv.z), bfhi(yv.z), bflo(yv.w), bfhi(yv.w)};
      float z[8] = {bflo(zv.x), bfhi(zv.x), bflo(zv.y), bfhi(zv.y), bflo(zv.z), bfhi(zv.z), bflo(zv.w), bfhi(zv.w)};
      float ss = 0.f;
      if (ml) {
        const float o[8] = {bflo(ov.x), bfhi(ov.x), bflo(ov.y), bfhi(ov.y), bflo(ov.z), bfhi(ov.z), bflo(ov.w), bfhi(ov.w)};
#pragma unroll
        for (int i = 0; i < 8; ++i) { v[i] *= sigmoidf_(o[i]); ss += v[i] * v[i]; }
      } else {
#pragma unroll
        for (int i = 0; i < 8; ++i) { v[i] *= siluf(z[i]); ss += v[i] * v[i]; }
      }
      ss += __shfl_xor(ss, 1); ss += __shfl_xor(ss, 2); ss += __shfl_xor(ss, 4);
      const float ss16 = ss + __shfl_xor(ss, 8);
      const float rn = ml ? rsqrtf(ss * (1.f / 64.f) + 1e-6f) : rsqrtf(ss16 * (1.f / 128.f) + 1e-6f);
      float o8[8];
#pragma unroll
      for (int i = 0; i < 8; ++i) { const float gg = i < 4 ? g0[i & 3] : g1[i & 3]; o8[i] = v[i] * rn * gg * (ml ? siluf(z[i]) : 1.f); }
      u32x4 w; w.x = pack2(o8[0], o8[1]); w.y = pack2(o8[2], o8[3]); w.z = pack2(o8[4], o8[5]); w.w = pack2(o8[6], o8[7]);
      *(u32x4*)yp = w;
    }
  }
}

DI void mlstm_task(const Params& p, int layer, int b, int h, unsigned char* smem) {
  u16* Qs = (u16*)(smem + SEQ_LDS_A); u16* Ks2 = (u16*)(smem + SEQ_LDS_B); u16* Vs2 = (u16*)(smem + SEQ_LDS_C); u16* Cst = (u16*)(smem + SEQ_LDS_S);
  float* fl = (float*)(smem + SEQ_LDS_F);
  float* bcs = fl; float* us = fl + 128; float* pms = fl + 256; float* wend = fl + 384; float* nst = fl + 512; float* npart = fl + 576; float* tmp = fl + 832;
  u16* halo = (u16*)(smem + SEQ_LDS_HALO); float* cwl = (float*)(smem + SEQ_LDS_CW);
  int tid = otid(), lane = tid & 63, w = tid >> 6, l15 = lane & 15, g = lane >> 4;
  const u16* projb = (const u16*)(p.ws + OFF_PROJ) + (size_t)b * SEQ * NP;
  const float* smb = (const float*)(p.ws + OFF_SMALL) + (size_t)b * SEQ * NSMALL;
  const float* cw = p.ml_conv_w + layer * 4 * 512; const float* cb = p.ml_conv_b + layer * 512;
  const float ib = p.ml_if_b[layer * 8 + h], fb = p.ml_if_b[layer * 8 + 4 + h];
  u16* Y = (u16*)(p.ws + OFF_H);
  const int colQ = PD_QK + h * 64, colK = PD_QK + 256 + h * 64, colV = PD_V + h * 64;
  f32x4 st[4];
#pragma unroll
  for (int nt = 0; nt < 4; ++nt) st[nt] = (f32x4){0.f, 0.f, 0.f, 0.f};
  float m_prev = 0.f;
  lds_barrier();
  if (tid < 64) nst[tid] = 0.f;
  stage_conv_w(cwl, cw, cb, h * 64, 512, tid);
  stage_conv_w(cwl + 320, cw, cb, 256 + h * 64, 512, tid);
  for (int i = tid; i < 3 * 3 * 64; i += 256) halo[i] = 0;
  RawRegs rQ, rK, rV; float iraw = 0.f, fraw = 0.f;
  raw_load(projb, colQ, 0, rQ, tid); raw_load(projb, colK, 0, rK, tid); raw_load(projb, colV, 0, rV, tid);
  if (tid < 128) { iraw = smb[(size_t)tid * NSMALL + SM_IF + h]; fraw = smb[(size_t)tid * NSMALL + SM_IF + 4 + h]; }
#pragma unroll 1
  for (int c = 0; c < 32; ++c) {
    const int t0 = c * 128;
    asm volatile("" : "+v"(tid)); lane = tid & 63; w = tid >> 6; l15 = lane & 15; g = lane >> 4;
    u16* hcur = halo + (c & 1) * 576; u16* hnext = halo + ((c + 1) & 1) * 576;
    float ip = 0.f, lf = 0.f;
    if (tid < 128) { ip = iraw + ib; const float fp = fraw + fb; lf = fminf(fp, 0.f) - __logf(1.f + __expf(-fabsf(fp))); }
    float bc = wave_scan_add(lf, lane);
    if (tid == 63) tmp[0] = bc;
    lds_barrier();
    if (w == 1) bc += tmp[0];
    const float u = tid < 128 ? ip - bc : -1e30f;
    float pm = wave_scan_max(u, lane);
    if (tid == 63) tmp[1] = pm;
    raw_store(Qs, hnext, rQ, tid); raw_store(Ks2, hnext + 192, rK, tid); raw_store(Vs2, nullptr, rV, tid);
    lds_barrier();
    if (w == 1) pm = fmaxf(pm, tmp[1]);
    if (tid < 128) { bcs[tid] = bc; us[tid] = u; pms[tid] = pm; }
    if (c + 1 < 32) {
      raw_load(projb, colQ, t0 + 128, rQ, tid);
      if (tid < 128) { iraw = smb[(size_t)(t0 + 128 + tid) * NSMALL + SM_IF + h]; fraw = smb[(size_t)(t0 + 128 + tid) * NSMALL + SM_IF + 4 + h]; }
    }
    u32x4 oQ[4], oK[4];
    conv_from_lds(Qs, hcur, cwl, nullptr, 1.f, oQ, tid);
    __builtin_amdgcn_sched_barrier(0);
    conv_from_lds(Ks2, hcur + 192, cwl + 320, nullptr, 0.125f, oK, tid);
    __builtin_amdgcn_sched_barrier(0);
    lds_barrier();
    conv_write(Qs, oQ, tid); conv_write(Ks2, oK, tid);
    state_to_lds(Cst, st, w, l15, g);
    const float blast = bcs[127];
    const float m_new = blast + fmaxf(m_prev, pms[127]);
    if (tid < 128) wend[tid] = __expf(blast - m_new + us[tid]);
    lds_barrier();
#pragma unroll 1
    for (int qt = 0; qt < 2; ++qt) {
      const int tl = 32 * w + qt * 16 + l15;
      bf16x8 qf[2];
#pragma unroll
      for (int ks = 0; ks < 2; ++ks) qf[ks] = ldfrag(Qs + tl * KLD + ks * 32 + 8 * g);
      f32x4 num[4];
#pragma unroll
      for (int d = 0; d < 4; ++d) num[d] = (f32x4){0.f, 0.f, 0.f, 0.f};
      const float bt = bcs[tl], mt = bt + fmaxf(m_prev, pms[tl]);
      float den = 0.f;
#pragma unroll 1
      for (int stl = 0; stl < 2; ++stl) {
        if (stl * 64 <= 32 * w + qt * 16 + 15) {
          f32x4 sc[4];
          qk_tile1<2>(Ks2 + stl * 64 * KLD, qf, sc, l15, g);
#pragma unroll
          for (int kt = 0; kt < 4; ++kt) {
            const f32x4 uu = *(const f32x4*)(us + stl * 64 + kt * 16 + 4 * g);
#pragma unroll
            for (int r = 0; r < 4; ++r) {
              const bool ok = stl * 64 + kt * 16 + 4 * g + r <= tl;
              const float v = ok ? sc[kt][r] * __expf(bt - mt + uu[r]) : 0.f;
              sc[kt][r] = v; den += v;
            }
          }
          pv_accum1(sc, Vs2 + stl * 64 * KLD, num, l15, g);
        }
      }
      const float wi = __expf(bt + m_prev - mt);
      float qn = 0.f;
#pragma unroll
      for (int ks = 0; ks < 2; ++ks)
#pragma unroll
        for (int j = 0; j < 8; ++j) qn += bf2f((u16)qf[ks][j]) * nst[ks * 32 + 8 * g + j];
      qn = group_sum4(qn);
      const float dn = group_sum4(den) + wi * qn;
      const float inv = __builtin_amdgcn_rcpf(fmaxf(fabsf(dn), __expf(-mt)));
      const size_t row = (size_t)b * SEQ + t0 + tl;
#pragma unroll
      for (int d = 0; d < 4; ++d) {
        f32x4 ni = (f32x4){0.f, 0.f, 0.f, 0.f};
#pragma unroll
        for (int ks = 0; ks < 2; ++ks) ni = mfma16(ldfrag(Cst + (d * 16 + l15) * KLD + ks * 32 + 8 * g), qf[ks], ni);
        const f32x4 v = (num[d] + ni * wi) * inv;
        u32x2 o; o.x = pack2(v[0], v[1]); o.y = pack2(v[2], v[3]);
        *(u32x2*)(Y + row * 1024 + Y_D + h * 64 + d * 16 + 4 * g) = o;
      }
    }
    if (c + 1 < 32) { raw_load(projb, colK, t0 + 128, rK, tid); raw_load(projb, colV, t0 + 128, rV, tid); }
    lds_barrier();
    scale_rows(Ks2, wend);
    lds_barrier();
    const float fprev = __expf(blast + m_prev - m_new);
#pragma unroll
    for (int nt = 0; nt < 4; ++nt) st[nt] *= fprev;
    state_update(Vs2, Ks2, st, w, l15, g);
    {
      const int e = tid & 63, part = tid >> 6;
      float a = 0.f;
      for (int s2 = part * 32; s2 < part * 32 + 32; ++s2) a += bf2f(Ks2[s2 * KLD + e]);
      npart[part * 64 + e] = a;
    }
    lds_barrier();
    if (tid < 64) nst[tid] = nst[tid] * fprev + npart[tid] + npart[64 + tid] + npart[128 + tid] + npart[192 + tid];
    m_prev = m_new;
  }
}

DI void compress_task(const Params& p, int layer, int b, int kv, int rb, unsigned char* smem) {
  constexpr int HLD = 136;
  u16* Hs = (u16*)smem;
  const int tid = otid(), lane = tid & 63, w = tid >> 6, l15 = lane & 15, g = lane >> 4;
  const u16* projb = (const u16*)(p.ws + OFF_PROJ) + (size_t)b * SEQ * NP + (kv ? PA_VC : PA_KC);
  const int mi = layer * 2 + kv;
  const u16* W1T = (const u16*)(p.ws + OFF_W1T) + (size_t)mi * 128 * 2048;
  const u16* W2T = (const u16*)(p.ws + OFF_W2T) + (size_t)mi * 64 * 128;
  const float* bias1 = (const float*)(p.ws + OFF_BIAS1) + mi * 16 * 128;
  f32x4 acc[2][2];
#pragma unroll
  for (int nt = 0; nt < 2; ++nt) { acc[nt][0] = (f32x4){0.f, 0.f, 0.f, 0.f}; acc[nt][1] = (f32x4){0.f, 0.f, 0.f, 0.f}; }
  int tok[2];
#pragma unroll
  for (int mt = 0; mt < 2; ++mt) { int i = rb * 32 + mt * 16 + l15; if (i > 254) i = 254; tok[mt] = 16 * i; }
#pragma unroll 4
  for (int ks = 0; ks < 64; ++ks) {
    const int j = ks >> 1, d0 = (ks & 1) * 32;
    bf16x8 af[2], wf[2];
#pragma unroll
    for (int mt = 0; mt < 2; ++mt) af[mt] = ldfrag(projb + (size_t)(tok[mt] + j) * NP + d0 + 8 * g);
#pragma unroll
    for (int nt = 0; nt < 2; ++nt) wf[nt] = ldfrag(W1T + (size_t)(w * 32 + nt * 16 + l15) * 2048 + ks * 32 + 8 * g);
#pragma unroll
    for (int nt = 0; nt < 2; ++nt)
#pragma unroll
      for (int mt = 0; mt < 2; ++mt) acc[nt][mt] = mfma16(wf[nt], af[mt], acc[nt][mt]);
  }
  lds_barrier();
#pragma unroll
  for (int nt = 0; nt < 2; ++nt) {
    const int n = w * 32 + nt * 16 + 4 * g;
    f32x4 bb = *(const f32x4*)(bias1 + n);
#pragma unroll
    for (int pc = 1; pc < 16; ++pc) bb += *(const f32x4*)(bias1 + pc * 128 + n);
#pragma unroll
    for (int mt = 0; mt < 2; ++mt) {
      const f32x4 v = acc[nt][mt] + bb;
      u32x2 o; o.x = pack2(siluf(v[0]), siluf(v[1])); o.y = pack2(siluf(v[2]), siluf(v[3]));
      *(u32x2*)(Hs + (mt * 16 + l15) * HLD + n) = o;
    }
  }
  lds_barrier();
  f32x4 acc2[2] = {(f32x4){0.f, 0.f, 0.f, 0.f}, (f32x4){0.f, 0.f, 0.f, 0.f}};
#pragma unroll
  for (int ks = 0; ks < 4; ++ks) {
    const bf16x8 wf = ldfrag(W2T + (size_t)(w * 16 + l15) * 128 + ks * 32 + 8 * g);
#pragma unroll
    for (int mt = 0; mt < 2; ++mt) acc2[mt] = mfma16(wf, ldfrag(Hs + (mt * 16 + l15) * HLD + ks * 32 + 8 * g), acc2[mt]);
  }
  u16* dst = (u16*)(p.ws + (kv ? OFF_VCMP : OFF_KCMP) + (size_t)layer * 512 * 1024) + (size_t)b * 256 * 64;
#pragma unroll
  for (int mt = 0; mt < 2; ++mt) {
    const int i = rb * 32 + mt * 16 + l15;
    u32x2 o; o.x = pack2(acc2[mt][0], acc2[mt][1]); o.y = pack2(acc2[mt][2], acc2[mt][3]);
    if (i > 254) { o.x = 0u; o.y = 0u; }
    *(u32x2*)(dst + (size_t)i * 64 + w * 16 + 4 * g) = o;
  }
}

DI void nsa_task(const Params& p, int layer, int b, int qi, unsigned char* smem) {
  u16* Ks = (u16*)smem; u16* Vs = Ks + 64 * KLD;
  float* T = (float*)(smem + 2 * KVBUF * 2);
  unsigned long long* selm = (unsigned long long*)(smem + 2 * KVBUF * 2 + 4 * 32 * 65 * 4);
  const int tid = otid(), lane = tid & 63, h = tid >> 6, l15 = lane & 15, g = lane >> 4;
  const int q0 = qi * 32;
  const u16* projb = (const u16*)(p.ws + OFF_PROJ) + (size_t)b * SEQ * NP;
  const float* smb = (const float*)(p.ws + OFF_SMALL) + (size_t)b * SEQ * NSMALL;
  const u16* kcmp = (const u16*)(p.ws + OFF_KCMP + (size_t)layer * 512 * 1024) + (size_t)b * 256 * 64;
  const u16* vcmp = (const u16*)(p.ws + OFF_VCMP + (size_t)layer * 512 * 1024) + (size_t)b * 256 * 64;
  bf16x8 qf[2][2];
#pragma unroll
  for (int qt = 0; qt < 2; ++qt)
#pragma unroll
    for (int ks = 0; ks < 2; ++ks) qf[qt][ks] = ldfrag(projb + (size_t)(q0 + qt * 16 + l15) * NP + PA_Q + h * 64 + ks * 32 + 8 * g);
  const float sc = 0.125f * 1.4426950408889634f;
  f32x4 outacc[4][2];
  AttnAcc a;
  const int ntc = (q0 >> 10) + 1;
  attn_init(a);
  lds_barrier();
  for (int i = tid; i < 4 * 32 * 65; i += 256) T[i] = 0.f;
  kv_pipeline(0, ntc, Ks,
    [&](int) { return true; },
    [&](int j, KVRegs& kr) { kv_load(kcmp, vcmp, 64, 64, j * 64, kr); },
    [&](int j, const u16* Kt, const u16* Vt) {
      f32x4 s[4][2];
      auto valid = [&](int kt, int r, int qt) { return 16 * (j * 64 + kt * 16 + 4 * g + r) + 31 <= q0 + qt * 16 + l15; };
      qk_tile<2>(Kt, 0, qf, s, l15, g);
      softmax_pv(s, a, Vt, sc, l15, g, valid);
    });
  float cinv[2];
#pragma unroll
  for (int qt = 0; qt < 2; ++qt) {
    const float lt = group_sum4(a.l[qt]);
    cinv[qt] = lt > 0.f ? 1.f / lt : 0.f;
    const float gt = sigmoidf_(smb[(size_t)(q0 + qt * 16 + l15) * NSMALL + SM_G + h * 3 + 0]) * cinv[qt];
#pragma unroll
    for (int d = 0; d < 4; ++d) outacc[d][qt] = a.o[d][qt] * gt;
  }
  float carry[2] = {0.f, 0.f};
  kv_pipeline(0, ntc, Ks,
    [&](int) { return true; },
    [&](int j, KVRegs& kr) { kv_load(kcmp, vcmp, 64, 64, j * 64, kr); },
    [&](int j, const u16* Kt, const u16*) {
      f32x4 s[4][2];
      qk_tile<2>(Kt, 0, qf, s, l15, g);
#pragma unroll
      for (int qt = 0; qt < 2; ++qt) {
        float prev3 = carry[qt];
#pragma unroll
        for (int kt = 0; kt < 4; ++kt) {
          float pr[4];
#pragma unroll
          for (int r = 0; r < 4; ++r) {
            const bool ok = 16 * (j * 64 + kt * 16 + 4 * g + r) + 31 <= q0 + qt * 16 + l15;
            pr[r] = ok ? exp2_(s[kt][qt][r] * sc - a.m[qt]) * cinv[qt] : 0.f;
          }
          const float below = __shfl_up(pr[3], 16);
          const float wrap = __shfl(prev3, l15 + 48);
          const float nb = g > 0 ? below : wrap;
          T[(h * 32 + qt * 16 + l15) * 65 + j * 16 + kt * 4 + g] = (pr[0] + pr[1]) + (pr[2] + 0.5f * pr[3]) + 0.5f * nb;
          prev3 = pr[3];
        }
        carry[qt] = prev3;
      }
    });
  lds_barrier();
#pragma unroll 1
  for (int qq = 0; qq < 8; ++qq) {
    const int q = h * 8 + qq, t = q0 + q, cur = t >> 6;
    const float imp = ((T[(0 * 32 + q) * 65 + lane] + T[(1 * 32 + q) * 65 + lane]) + T[(2 * 32 + q) * 65 + lane]) + T[(3 * 32 + q) * 65 + lane];
    const float val = (lane == cur || lane == 0) ? 1e4f : (lane <= cur ? imp : -1.f);
    int rank = 0;
#pragma unroll
    for (int k = 0; k < 64; ++k) {
      const float vk = __int_as_float(__builtin_amdgcn_readlane(__float_as_int(val), k));
      rank += (vk > val || (vk == val && k < lane)) ? 1 : 0;
    }
    const unsigned long long m = __ballot(rank < 16);
    if (lane == 0) selm[q] = m;
  }
  lds_barrier();
  f32x4* park = (f32x4*)T + (h * 8) * 64 + lane;
#pragma unroll
  for (int d = 0; d < 4; ++d) { park[(d * 2 + 0) * 64] = outacc[d][0]; park[(d * 2 + 1) * 64] = outacc[d][1]; }
  unsigned long long mq[2], anym = 0ull;
#pragma unroll
  for (int qt = 0; qt < 2; ++qt) mq[qt] = selm[qt * 16 + l15];
  for (int i = 0; i < 32; ++i) anym |= selm[i];
  const int jhi = (q0 + 31) >> 6;
  attn_init(a);
  kv_pipeline(0, jhi + 1, Ks,
    [&](int j) { return (bool)((anym >> j) & 1ull); },
    [&](int j, KVRegs& kr) { kv_load(projb + PA_KS, projb + PA_VS, NP, NP, j * 64, kr); },
    [&](int j, const u16* Kt, const u16* Vt) {
      f32x4 s[4][2];
      auto valid = [&](int kt, int r, int qt) { return ((mq[qt] >> j) & 1ull) && (j * 64 + kt * 16 + 4 * g + r <= q0 + qt * 16 + l15); };
      qk_tile<2>(Kt, 0, qf, s, l15, g);
      softmax_pv(s, a, Vt, sc, l15, g, valid);
    });
#pragma unroll
  for (int qt = 0; qt < 2; ++qt) {
    const float lt = group_sum4(a.l[qt]);
    const float gt = sigmoidf_(smb[(size_t)(q0 + qt * 16 + l15) * NSMALL + SM_G + h * 3 + 1]) * (lt > 0.f ? 1.f / lt : 0.f);
#pragma unroll
    for (int d = 0; d < 4; ++d) park[(d * 2 + qt) * 64] += a.o[d][qt] * gt;
  }
  attn_init(a);
  const int jlo = q0 >= 511 ? (q0 - 511) >> 6 : 0;
  kv_pipeline(jlo, jhi + 1, Ks,
    [&](int) { return true; },
    [&](int j, KVRegs& kr) { kv_load(projb + PA_KW, projb + PA_VW, NP, NP, j * 64, kr); },
    [&](int j, const u16* Kt, const u16* Vt) {
      f32x4 s[4][2];
      auto valid = [&](int kt, int r, int qt) { const int key = j * 64 + kt * 16 + 4 * g + r, t = q0 + qt * 16 + l15; return key <= t && key + 512 > t; };
      qk_tile<2>(Kt, 0, qf, s, l15, g);
      if (j * 64 + 63 <= q0 && j * 64 + 512 > q0 + 31) softmax_pv_nomask(s, a, Vt, sc, l15, g);
      else softmax_pv(s, a, Vt, sc, l15, g, valid);
    });
  u16* Y = (u16*)(p.ws + OFF_H);
  const float* ng = p.nsa_norm_g + layer * 64;
#pragma unroll
  for (int qt = 0; qt < 2; ++qt) {
    const int t = q0 + qt * 16 + l15;
    const float lt = group_sum4(a.l[qt]);
    const float gt = sigmoidf_(smb[(size_t)t * NSMALL + SM_G + h * 3 + 2]) * (lt > 0.f ? 1.f / lt : 0.f);
    f32x4 v[4]; float ss = 0.f;
#pragma unroll
    for (int d = 0; d < 4; ++d) { v[d] = park[(d * 2 + qt) * 64] + a.o[d][qt] * gt; ss += v[d][0] * v[d][0] + v[d][1] * v[d][1] + v[d][2] * v[d][2] + v[d][3] * v[d][3]; }
    ss = group_sum4(ss);
    const float rn = rsqrtf(ss * (1.f / 64.f) + 1e-6f);
    const size_t row = (size_t)b * SEQ + t;
#pragma unroll
    for (int d = 0; d < 4; ++d) {
      const int dd = d * 16 + 4 * g;
      const u32x2 zz = *(const u32x2*)(projb + (size_t)t * NP + PA_Z + h * 64 + dd);
      const f32x4 gg = *(const f32x4*)(ng + dd);
      u32x2 o;
      o.x = pack2(v[d][0] * rn * gg[0] * siluf(bflo(zz.x)), v[d][1] * rn * gg[1] * siluf(bfhi(zz.x)));
      o.y = pack2(v[d][2] * rn * gg[2] * siluf(bflo(zz.y)), v[d][3] * rn * gg[3] * siluf(bfhi(zz.y)));
      *(u32x2*)(Y + row * 1024 + Y_A + h * 64 + dd) = o;
    }
  }
}

DI void zero_y_cols(const Params& p, int c0, int ncols, int gtid, int gthreads) {
  u16* Y = (u16*)(p.ws + OFF_H);
  const int per_row = ncols / 8;
  for (size_t i = gtid; i < (size_t)NTOK * per_row; i += gthreads) {
    const size_t row = i / per_row; const int ch = (int)(i % per_row);
    *(u32x4*)(Y + row * 1024 + c0 + ch * 8) = (u32x4){0u, 0u, 0u, 0u};
  }
}

DI void final_norm_rows(const Params& p, int gw, int nw, int lane) {
  const float4* gp = (const float4*)p.final_g;
  float4 gg[4];
#pragma unroll
  for (int i = 0; i < 4; ++i) gg[i] = gp[lane + 64 * i];
  for (int row0 = gw * 4; row0 < NTOK; row0 += nw * 4) {
    float4 v[4][4]; float ss[4];
#pragma unroll
    for (int j = 0; j < 4; ++j) {
      const float4* xr = (const float4*)(p.out + (size_t)(row0 + j) * D_MODEL);
#pragma unroll
      for (int i = 0; i < 4; ++i) v[j][i] = xr[lane + 64 * i];
    }
#pragma unroll
    for (int j = 0; j < 4; ++j) {
      float a = 0.f;
#pragma unroll
      for (int i = 0; i < 4; ++i) a += v[j][i].x * v[j][i].x + v[j][i].y * v[j][i].y + v[j][i].z * v[j][i].z + v[j][i].w * v[j][i].w;
      ss[j] = wave_sum(a);
    }
#pragma unroll
    for (int j = 0; j < 4; ++j) {
      float4* xr = (float4*)(p.out + (size_t)(row0 + j) * D_MODEL);
      const float r = rsqrtf(ss[j] * (1.f / D_MODEL) + 1e-6f);
#pragma unroll
      for (int i = 0; i < 4; ++i) { float4 w; w.x = v[j][i].x * r * gg[i].x; w.y = v[j][i].y * r * gg[i].y; w.z = v[j][i].z * r * gg[i].z; w.w = v[j][i].w * r * gg[i].w; xr[lane + 64 * i] = w; }
    }
  }
}

#ifndef DEBUG_CHECK
#define DEBUG_CHECK 0
#endif
#if DEBUG_CHECK
constexpr int NCHK = 12;
DI float block_sum(float v, float* red) {
  v = wave_sum(v);
  lds_barrier();
  if ((threadIdx.x & 63) == 0) red[threadIdx.x >> 6] = v;
  lds_barrier();
  return red[0] + red[1] + red[2] + red[3];
}
DI float block_max(float v, float* red) {
#pragma unroll
  for (int o = 32; o > 0; o >>= 1) v = fmaxf(v, __shfl_xor(v, o));
  lds_barrier();
  if ((threadIdx.x & 63) == 0) red[threadIdx.x >> 6] = v;
  lds_barrier();
  return fmaxf(fmaxf(red[0], red[1]), fmaxf(red[2], red[3]));
}
DI float bfr(float v) { return bf2f(f2bf(v)); }
struct Chk { float num[NCHK], den[NCHK]; };
DI void chk_add(Chk& c, int id, float got, float ref) { const float d = got - ref; c.num[id] += d * d; c.den[id] += ref * ref; }

DI void dbg_diff_attn(const Params& p, int layer, int b, int t, int h, Chk& c, int id, unsigned char* smem) {
  float* p1 = (float*)smem; float* p2 = p1 + 4096; float* red = p2 + 4096;
  const int tid = otid();
  const u16* proj = (const u16*)(p.ws + OFF_PROJ) + (size_t)b * SEQ * NP;
  const u16* q = proj + (size_t)t * NP + PB_Q + h * 64;
  const float scale = 0.17677669529663687f;
  float m1 = -1e30f, m2 = -1e30f;
  for (int s = tid; s <= t; s += 256) {
    const u16* k = proj + (size_t)s * NP + PB_K + h * 64;
    float a1 = 0.f, a2 = 0.f;
    for (int d = 0; d < 32; ++d) { a1 += bf2f(q[d]) * bf2f(k[d]); a2 += bf2f(q[32 + d]) * bf2f(k[32 + d]); }
    a1 *= scale; a2 *= scale; p1[s] = a1; p2[s] = a2; m1 = fmaxf(m1, a1); m2 = fmaxf(m2, a2);
  }
  m1 = block_max(m1, red); m2 = block_max(m2, red);
  float l1 = 0.f, l2 = 0.f;
  for (int s = tid; s <= t; s += 256) { const float e1 = __expf(p1[s] - m1), e2 = __expf(p2[s] - m2); p1[s] = e1; p2[s] = e2; l1 += e1; l2 += e2; }
  l1 = block_sum(l1, red); l2 = block_sum(l2, red);
  const float* lam = p.diff_lam + layer * 128;
  float s01 = 0.f, s23 = 0.f;
  for (int i = 0; i < 32; ++i) { s01 += lam[i] * lam[32 + i]; s23 += lam[64 + i] * lam[96 + i]; }
  const float lam_init = 0.8f - 0.6f * expf(-0.3f * (float)layer);
  const float lam_full = expf(s01) - expf(s23) + lam_init;
  lds_barrier();
  float o = 0.f;
  if (tid < 64) for (int s = 0; s <= t; ++s) o += (p1[s] / l1 - lam_full * p2[s] / l2) * bf2f(proj[(size_t)s * NP + PB_V + h * 64 + tid]);
  float ss = block_sum(tid < 64 ? o * o : 0.f, red);
  if (tid < 64) {
    const float z = bf2f(proj[(size_t)t * NP + PB_Z + h * 64 + tid]);
    const float ref = o * rsqrtf(ss / 64.f + 1e-6f) * p.diff_norm_g[layer * 64 + tid] * (1.f - lam_init) * (z / (1.f + expf(-z)));
    const float got = bf2f(((const u16*)(p.ws + OFF_H))[((size_t)b * SEQ + t) * 1024 + Y_B + h * 64 + tid]);
    const float d = got - ref;
    o = d * d; ss = ref * ref;
  } else { o = 0.f; ss = 0.f; }
  c.num[id] += block_sum(o, red); c.den[id] += block_sum(ss, red);
}

DI float dbg_conv(const u16* projb, int t, int pcol, const float* cw, const float* cb, int ch, int nch) {
  float a = cb[ch];
  for (int j = 0; j < 4; ++j) { const int tt = t - 3 + j; if (tt >= 0) a += cw[j * nch + ch] * bf2f(projb[(size_t)tt * NP + pcol]); }
  return a / (1.f + expf(-a));
}
constexpr int DBG_NS = 11, DBG_T = 300;
DI int dbg_sample_idx(int t) {
  const int TS[DBG_NS] = {0, 1, 2, 3, 64, 127, 128, 129, 255, 256, 299};
  for (int i = 0; i < DBG_NS; ++i) if (TS[i] == t) return i;
  return -1;
}
DI int dbg_sample_t(int i) { const int TS[DBG_NS] = {0, 1, 2, 3, 64, 127, 128, 129, 255, 256, 299}; return TS[i]; }
DI void dbg_ssd(const Params& p, int layer, int b, int gi, Chk& c, int id, unsigned char* smem) {
  float* ybuf = (float*)smem;
  float* red = ybuf + DBG_NS * 128;
  const int tid = threadIdx.x, pp = tid >> 2, nq = tid & 3;
  const u16* projb = (const u16*)(p.ws + OFF_PROJ) + (size_t)b * SEQ * NP;
  const float* smb = (const float*)(p.ws + OFF_SMALL) + (size_t)b * SEQ * NSMALL;
  const float* cw = p.ssm_conv_w + layer * 4 * 512; const float* cb = p.ssm_conv_b + layer * 512;
  lds_barrier();
  for (int hh = 0; hh < 2; ++hh) {
    const int h = gi * 2 + hh;
    const float a_h = -expf(p.ssm_a_log[layer * 4 + h]), d_h = p.ssm_d[layer * 4 + h], dtb = p.ssm_dt_bias[layer * 4 + h];
    float hst[16];
    for (int i = 0; i < 16; ++i) hst[i] = 0.f;
    for (int t = 0; t < DBG_T; ++t) {
      const float xr = smb[(size_t)t * NSMALL + SM_DT + h] + dtb;
      const float dt = xr > 20.f ? xr : log1pf(expf(xr));
      const float dA = expf(dt * a_h);
      const float xp = dbg_conv(projb, t, PC_XBC + h * 64 + pp, cw, cb, h * 64 + pp, 512);
      float y = 0.f;
      for (int i = 0; i < 16; ++i) {
        const int n = nq * 16 + i;
        const float Bn = dbg_conv(projb, t, PC_XBC + 256 + gi * 64 + n, cw, cb, 256 + gi * 64 + n, 512);
        const float Cn = dbg_conv(projb, t, PC_XBC + 384 + gi * 64 + n, cw, cb, 384 + gi * 64 + n, 512);
        hst[i] = dA * hst[i] + dt * xp * Bn;
        y += Cn * hst[i];
      }
      y += __shfl_xor(y, 1); y += __shfl_xor(y, 2);
      y += d_h * xp;
      const int si = dbg_sample_idx(t);
      if (si >= 0 && nq == 0) { const float z = bf2f(projb[(size_t)t * NP + PC_Z + h * 64 + pp]); ybuf[si * 128 + hh * 64 + pp] = y * (z / (1.f + expf(-z))); }
    }
  }
  lds_barrier();
  for (int si = 0; si < DBG_NS; ++si) {
    const float v = tid < 128 ? ybuf[si * 128 + tid] : 0.f;
    const float ss = block_sum(v * v, red);
    float e2 = 0.f, r2 = 0.f;
    if (tid < 128) {
      const float ref = v * rsqrtf(ss / 128.f + 1e-6f) * p.ssm_norm_g[layer * 256 + gi * 128 + tid];
      const float got = bf2f(((const u16*)(p.ws + OFF_H))[((size_t)b * SEQ + dbg_sample_t(si)) * 1024 + Y_C + gi * 128 + tid]);
      e2 = (got - ref) * (got - ref); r2 = ref * ref;
    }
    c.num[id] += block_sum(e2, red); c.den[id] += block_sum(r2, red);
  }
}
DI void dbg_mlstm(const Params& p, int layer, int b, int h, Chk& c, int id, unsigned char* smem) {
  float* ybuf = (float*)smem;
  float* red = ybuf + DBG_NS * 128;
  const int tid = threadIdx.x, dd = tid >> 2, eq = tid & 3;
  const u16* projb = (const u16*)(p.ws + OFF_PROJ) + (size_t)b * SEQ * NP;
  const float* smb = (const float*)(p.ws + OFF_SMALL) + (size_t)b * SEQ * NSMALL;
  const float* cw = p.ml_conv_w + layer * 4 * 512; const float* cb = p.ml_conv_b + layer * 512;
  const float ib = p.ml_if_b[layer * 8 + h], fb = p.ml_if_b[layer * 8 + 4 + h];
  lds_barrier();
  float Cst[16], nst[16];
  for (int i = 0; i < 16; ++i) { Cst[i] = 0.f; nst[i] = 0.f; }
  float m = 0.f;
  for (int t = 0; t < DBG_T; ++t) {
    const float ip = smb[(size_t)t * NSMALL + SM_IF + h] + ib, fp = smb[(size_t)t * NSMALL + SM_IF + 4 + h] + fb;
    const float lf = fminf(fp, 0.f) - log1pf(expf(-fabsf(fp)));
    const float mn = fmaxf(lf + m, ip), fs = expf(lf + m - mn), is = expf(ip - mn);
    const float vd = bf2f(projb[(size_t)t * NP + PD_V + h * 64 + dd]);
    float num = 0.f, den = 0.f;
    for (int i = 0; i < 16; ++i) {
      const int e = eq * 16 + i;
      const float qe = dbg_conv(projb, t, PD_QK + h * 64 + e, cw, cb, h * 64 + e, 512);
      const float ke = 0.125f * dbg_conv(projb, t, PD_QK + 256 + h * 64 + e, cw, cb, 256 + h * 64 + e, 512);
      Cst[i] = fs * Cst[i] + is * vd * ke; nst[i] = fs * nst[i] + is * ke;
      num += Cst[i] * qe; den += nst[i] * qe;
    }
    num += __shfl_xor(num, 1); num += __shfl_xor(num, 2); den += __shfl_xor(den, 1); den += __shfl_xor(den, 2);
    const float hv = num / fmaxf(fabsf(den), expf(-mn));
    m = mn;
    const int si = dbg_sample_idx(t);
    if (si >= 0 && eq == 0) { const float o = bf2f(projb[(size_t)t * NP + PD_O + h * 64 + dd]); ybuf[si * 64 + dd] = hv / (1.f + expf(-o)); }
  }
  lds_barrier();
  for (int si = 0; si < DBG_NS; ++si) {
    const float v = tid < 64 ? ybuf[si * 64 + tid] : 0.f;
    const float ss = block_sum(v * v, red);
    float e2 = 0.f, r2 = 0.f;
    if (tid < 64) {
      const int t = dbg_sample_t(si);
      const float z = bf2f(projb[(size_t)t * NP + PD_Z + h * 64 + tid]);
      const float ref = v * rsqrtf(ss / 64.f + 1e-6f) * p.ml_norm_g[layer * 64 + tid] * (z / (1.f + expf(-z)));
      const float got = bf2f(((const u16*)(p.ws + OFF_H))[((size_t)b * SEQ + t) * 1024 + Y_D + h * 64 + tid]);
      e2 = (got - ref) * (got - ref); r2 = ref * ref;
    }
    c.num[id] += block_sum(e2, red); c.den[id] += block_sum(r2, red);
  }
}

DI void debug_checks(const Params& p, unsigned char* smem) {
  const int tid = otid();
  float* red = (float*)(smem + 36 * 1024);
  Chk c;
  for (int i = 0; i < NCHK; ++i) { c.num[i] = 0.f; c.den[i] = 0.f; }
  const float* adap = (const float*)(p.ws + OFF_ADAP);
  const u16* H = (const u16*)(p.ws + OFF_H);
  const u16* proj = (const u16*)(p.ws + OFF_PROJ);
  const float* sm = (const float*)(p.ws + OFF_SMALL);
#if DEBUG_CHECK == 1
  {
    const int bs[2] = {0, 5}; const int ns[4] = {3, 1024 + 77, 2048 + 500, 3071};
    for (int bi = 0; bi < 2; ++bi) for (int ni = 0; ni < 4; ++ni) {
      const int b = bs[bi], n = ns[ni];
      float a = 0.f;
      for (int k = tid; k < 1024; k += 256) { const float v = p.c[b * 1024 + k]; a += (v / (1.f + expf(-v))) * p.ada_w[(size_t)k * 3072 + n]; }
      const float ref = block_sum(a, red) + p.ada_b[n];
      float got = 0.f; for (int kc = 0; kc < 8; ++kc) got += adap[(((size_t)kc * 2 + 0) * 8 + b) * 3072 + n];
      chk_add(c, 1, got, ref);
    }
  }
  {
    const int ms[3] = {1, 9000, 32767};
    const int ns[14] = {0, 300, 700, 900, 1500, 2000, 2300, 2693, 3300, 3500, 3967, 3970, 3981, 3990};
    for (int mi = 0; mi < 3; ++mi) {
      const int m = ms[mi], b = m >> 12;
      float ss = 0.f;
      for (int k = tid; k < 1024; k += 256) { const float v = p.x[(size_t)m * 1024 + k]; ss += v * v; }
      ss = block_sum(ss, red);
      const float rstd = rsqrtf(ss / 1024.f + 1e-6f);
      for (int ni = 0; ni < 14; ++ni) {
        const int n = ns[ni], col = colmap(n);
        float a = 0.f, herr = 0.f, href = 0.f;
        for (int k = tid; k < 1024; k += 256) {
          float shf = 0.f, scl = 0.f;
          for (int kc = 0; kc < 8; ++kc) { const float* ap = adap + (((size_t)kc * 2 + 0) * 8 + b) * 3072; shf += ap[k]; scl += ap[1024 + k]; }
          const float hv = p.x[(size_t)m * 1024 + k] * rstd * p.norm_g[k] * (1.f + scl) + shf;
          const float hg = bf2f(H[(size_t)m * 1024 + k]);
          herr += (hg - hv) * (hg - hv); href += hv * hv;
          a += hv * p.w_in[(size_t)k * D_IN + col];
        }
        const float ref = block_sum(a, red);
        herr = block_sum(herr, red); href = block_sum(href, red);
        if (ni == 0 && DEBUG_STAGE == 1) { c.num[3] += herr; c.den[3] += href; }
        const float got = n < NP ? bf2f(proj[(size_t)m * NP + n]) : sm[(size_t)m * NSMALL + (n - NP)];
        chk_add(c, 2, got, ref);
      }
    }
  }
#endif
#if DEBUG_CHECK == 2
  dbg_diff_attn(p, 0, 0, 5, 0, c, 4, smem);
  dbg_diff_attn(p, 0, 1, 200, 3, c, 4, smem);
  dbg_diff_attn(p, 0, 3, 1500, 2, c, 4, smem);
  dbg_diff_attn(p, 0, 7, 4095, 1, c, 4, smem);
  {
    const int ms[3] = {2, 12345, 32766}; const int ns[3] = {0, 513, 1023};
    const u16* Y = (const u16*)(p.ws + OFF_H);
    for (int mi = 0; mi < 3; ++mi) for (int ni = 0; ni < 3; ++ni) {
      const int m = ms[mi], n = ns[ni], b = m >> 12;
      float a = 0.f;
      for (int k = tid; k < 1024; k += 256) a += bf2f(Y[(size_t)m * 1024 + k]) * p.w_out[(size_t)k * 1024 + n];
      a = block_sum(a, red);
      float gate = 0.f; for (int kc = 0; kc < 8; ++kc) gate += adap[(((size_t)kc * 2 + 0) * 8 + b) * 3072 + 2048 + n];
      chk_add(c, 5, p.out[(size_t)m * 1024 + n] - p.x[(size_t)m * 1024 + n], gate * a);
    }
  }
#endif
#if DEBUG_CHECK == 3
  dbg_ssd(p, 0, 0, 0, c, 6, smem);
  dbg_ssd(p, 0, 5, 1, c, 6, smem);
  dbg_mlstm(p, 0, 0, 0, c, 7, smem);
  dbg_mlstm(p, 0, 6, 3, c, 7, smem);
#endif
  lds_barrier();
  if (tid == 0) {
    int wid_ = 0, wcls = 99;
    for (int i = 1; i < NCHK; ++i) if (c.den[i] > 0.f) {
      const float rel = sqrtf(c.num[i] / c.den[i]);
      int cls = rel >= 1.f ? 0 : (int)floorf(-log10f(fmaxf(rel, 1e-9f)));
      if (cls > 9) cls = 9;
      if (!(rel == rel)) cls = 0;
      if (cls < wcls) { wcls = cls; wid_ = i; }
    }
    p.out[0] = 1e5f * ((float)wid_ + 0.1f * (float)wcls);
  }
}
#endif

constexpr int HALF_LDS = 76 * 1024;
constexpr int SMEM_BYTES = 2 * HALF_LDS;
__global__ void __launch_bounds__(512, 2) fwd_megakernel(Params p) {
  cg::grid_group grid = cg::this_grid();
  __shared__ __attribute__((aligned(16))) unsigned char smem[SMEM_BYTES];
  const int half = __builtin_amdgcn_readfirstlane(threadIdx.x >> 8);
  unsigned char* hsm = smem + half * HALF_LDS;
  const int G = gridDim.x, bid = blockIdx.x;
  const int slot = bid * 2 + half, NS = 2 * G;
  for (int t = slot; t < ((T0_TOTAL + NS - 1) / NS) * NS; t += NS) phase0_task(p, t < T0_TOTAL ? t : T0_TOTAL - 1, hsm);
  grid.sync();
  for (int layer = 0; layer < 2; ++layer) {
    Params q = p;
    asm volatile("" : "+s"(q.ws));
    const float* xin = layer == 0 ? q.x : q.out;
    for (int t = slot; t < ((NTOK / 64 + NS - 1) / NS) * NS; t += NS) phase1_task(q, layer, xin, t < NTOK / 64 ? t : NTOK / 64 - 1, hsm);
    grid.sync();
    for (int t = bid; t < (NTOK / 256) * (NPAD / 256); t += G) gemm_inproj_tile(q, layer, t, smem);
    grid.sync();
#if DEBUG_CHECK == 1
    if (bid == 0 && half == 0) debug_checks(q, smem);
    return;
#endif
    {
      unsigned* cnt = (unsigned*)(q.ws + OFF_CNT);
      int* s_pair = (int*)(smem + SMEM_BYTES - 16);
      if (bid < 16) ssd_task(q, layer, slot >> 2, slot & 3, hsm);
      else if (bid < 32) mlstm_task(q, layer, (slot - 32) >> 2, (slot - 32) & 3, hsm);
      if (bid < 32) {
        asm volatile("s_waitcnt vmcnt(0)" ::: "memory");
        lds_barrier();
        if (otid512() == 0) {
          __builtin_amdgcn_fence(__ATOMIC_RELEASE, "agent");
          asm volatile("s_waitcnt vmcnt(0)" ::: "memory");
          __hip_atomic_fetch_add(cnt + 4 + layer, 1u, __ATOMIC_RELAXED, __HIP_MEMORY_SCOPE_AGENT);
        }
      }
      constexpr int NPAIR_C = 64, NPAIR_D = 512, NPAIR_N = 512, NPAIR_F = NTOK / 128, NPAIR = NPAIR_C + NPAIR_D + NPAIR_N + NPAIR_F;
      for (;;) {
        const int t512 = otid512();
        lds_barrier();
        if (t512 == 0) *s_pair = (int)atomicAdd(cnt + layer, 1u);
        lds_barrier();
        const int pair = *s_pair;
        if (pair >= NPAIR) break;
        if (pair < NPAIR_C) {
          const int v = pair * 2 + half;
          compress_task(q, layer, v >> 4, (v >> 3) & 1, v & 7, hsm);
          asm volatile("s_waitcnt vmcnt(0)" ::: "memory");
          lds_barrier();
          if (t512 == 0) {
            __builtin_amdgcn_fence(__ATOMIC_RELEASE, "agent");
            asm volatile("s_waitcnt vmcnt(0)" ::: "memory");
            __hip_atomic_fetch_add(cnt + 2 + layer, 1u, __ATOMIC_RELAXED, __HIP_MEMORY_SCOPE_AGENT);
          }
        } else if (pair < NPAIR_C + NPAIR_D) {
          const int u = (pair - NPAIR_C) * 2 + half, qb = 31 - (u >> 5), bh = u & 31;
          diff_attn_task(q, layer, bh >> 2, bh & 3, qb, hsm, half != 0);
        } else if (pair >= NPAIR_C + NPAIR_D + NPAIR_N) {
          if (t512 == 0) {
            while (__hip_atomic_load(cnt + 4 + layer, __ATOMIC_RELAXED, __HIP_MEMORY_SCOPE_AGENT) < 32u) __builtin_amdgcn_s_sleep(16);
            __builtin_amdgcn_fence(__ATOMIC_ACQUIRE, "agent");
            asm volatile("s_waitcnt vmcnt(0)" ::: "memory");
          }
          lds_barrier();
          seq_fix_rows(q, layer, ((pair - NPAIR_C - NPAIR_D - NPAIR_N) * 2 + half) * 64, 64);
        } else {
          if (t512 == 0) {
            while (__hip_atomic_load(cnt + 2 + layer, __ATOMIC_RELAXED, __HIP_MEMORY_SCOPE_AGENT) < (unsigned)NPAIR_C) __builtin_amdgcn_s_sleep(16);
            __builtin_amdgcn_fence(__ATOMIC_ACQUIRE, "agent");
            asm volatile("s_waitcnt vmcnt(0)" ::: "memory");
          }
          lds_barrier();
          const int u = (pair - NPAIR_C - NPAIR_D) * 2 + half;
          nsa_task(q, layer, u & 7, 127 - (u >> 3), hsm);
        }
      }
    }
    grid.sync();
    for (int t = bid; t < (NTOK / 256) * 4; t += G) gemm_outproj_tile(q, layer, xin, q.out, t, smem);
    grid.sync();
#if DEBUG_CHECK >= 2
    if (bid == 0 && half == 0) debug_checks(q, smem);
    return;
#endif
  }
  { const int t5 = otid512(); final_norm_rows(p, bid * 8 + (t5 >> 6), G * 8, t5 & 63); }
}

extern "C" void kernel_launch(void* const* d_in, const int* in_sizes, int n_in, void* d_out, int out_size, void* d_ws, size_t ws_size,
                              hipStream_t stream) {
  static int grid_blocks = 0;
  if (!grid_blocks) {
    int dev = 0, cus = 0, per_cu = 0;
    (void)hipGetDevice(&dev);
    (void)hipDeviceGetAttribute(&cus, hipDeviceAttributeMultiprocessorCount, dev);
    (void)hipOccupancyMaxActiveBlocksPerMultiprocessor(&per_cu, fwd_megakernel, 512, 0);
    if (per_cu > 1) per_cu = 1;
    if (per_cu < 1) per_cu = 1;
    grid_blocks = cus * per_cu;
  }
  if (grid_blocks < 64 || (grid_blocks & 3)) { fprintf(stderr, "grid too small: %d\n", grid_blocks); return; }
  if (ws_size < WS_NEEDED) { fprintf(stderr, "workspace too small: %zu < %zu\n", ws_size, WS_NEEDED); return; }
  Params p{};
  const float** pp = (const float**)&p;
  for (int i = 0; i < 26; ++i) pp[i] = (const float*)d_in[i];
  p.out = (float*)d_out; p.ws = (unsigned char*)d_ws;
  (void)hipMemsetAsync((unsigned char*)d_ws + OFF_CNT, 0, 64, stream);
  void* args[] = {&p};
  hipError_t e = hipLaunchCooperativeKernel((void*)fwd_megakernel, dim3(grid_blocks), dim3(512), args, 0, stream);
  if (e != hipSuccess) fprintf(stderr, "cooperative launch failed: %s (grid %d)\n", hipGetErrorString(e), grid_blocks);
}
```

```cpp
#include <hip/hip_runtime.h>
#include <hip/hip_cooperative_groups.h>
#include <cstdio>
#include <cstdint>
#define DEBUG_CHECK 0
#define DEBUG_STAGE 1
#define REP_P1 1
#define REP_P2 1
#define REP_SEQ 1
#define REP_DIFF 1
#define REP_NSA 1
#define REP_P4 1
#define REP_P0 1
namespace cg = cooperative_groups;

typedef unsigned short u16;
typedef short bf16x8 __attribute__((ext_vector_type(8)));
typedef short s16x4 __attribute__((ext_vector_type(4)));
typedef float f32x4 __attribute__((ext_vector_type(4)));
typedef float f32x2 __attribute__((ext_vector_type(2)));
typedef unsigned u32x4 __attribute__((ext_vector_type(4)));
typedef unsigned u32x2 __attribute__((ext_vector_type(2)));
typedef __bf16 bf16x2_t __attribute__((ext_vector_type(2)));
#define DI __device__ __forceinline__
#define LDSP __attribute__((address_space(3)))

constexpr int D_MODEL = 1024, BATCH = 8, SEQ = 4096, NTOK = BATCH * SEQ;
constexpr int D_IN = 3992;
constexpr int NP = 3968, NPAD = 4096, NSMALL = 32;
constexpr int PA_Q = 0, PA_KC = 256, PA_VC = 320, PA_KS = 384, PA_VS = 448, PA_KW = 512, PA_VW = 576, PA_Z = 640;
constexpr int PB_Q = 896, PB_K = 1152, PB_V = 1408, PB_Z = 1664;
constexpr int PC_Z = 1920, PC_XBC = 2176;
constexpr int PD_QK = 2688, PD_V = 3200, PD_O = 3456, PD_Z = 3712;
constexpr int SM_G = 0, SM_DT = 12, SM_IF = 16;
constexpr int Y_A = 0, Y_B = 256, Y_C = 512, Y_D = 768;

constexpr size_t MiB = 1024 * 1024;
constexpr size_t OFF_WINT = 0;
constexpr size_t OFF_WOUTT = 16 * MiB;
constexpr size_t OFF_W1T = 20 * MiB;
constexpr size_t OFF_W2T = 22 * MiB;
constexpr size_t OFF_BIAS1 = 22 * MiB + 64 * 1024;
constexpr size_t OFF_ADAP = 22 * MiB + 128 * 1024;
constexpr size_t OFF_KCMP = 24 * MiB;
constexpr size_t OFF_VCMP = 24 * MiB + 256 * 1024;
constexpr size_t OFF_CNT = 29 * MiB;
constexpr size_t OFF_SMALL = 25 * MiB;
constexpr size_t OFF_SSQ = 29 * MiB;
constexpr size_t OFF_H = 32 * MiB;
constexpr size_t OFF_PROJ = 96 * MiB;
constexpr size_t WS_NEEDED = 96 * MiB + (size_t)NTOK * NP * 2;

struct Params {
  const float* x; const float* c; const float* norm_g; const float* ada_w; const float* ada_b;
  const float* w_in; const float* w_out;
  const float* nsa_cmp_pos; const float* nsa_ck_w1; const float* nsa_ck_w2; const float* nsa_cv_w1; const float* nsa_cv_w2; const float* nsa_norm_g;
  const float* diff_lam; const float* diff_norm_g;
  const float* ssm_conv_w; const float* ssm_conv_b; const float* ssm_dt_bias; const float* ssm_a_log; const float* ssm_d; const float* ssm_norm_g;
  const float* ml_conv_w; const float* ml_conv_b; const float* ml_if_b; const float* ml_norm_g; const float* final_g;
  float* out; unsigned char* ws;
};

DI void lds_barrier() { asm volatile("s_waitcnt lgkmcnt(0)" ::: "memory"); __builtin_amdgcn_s_barrier(); asm volatile("" ::: "memory"); }
DI int otid() { int t = threadIdx.x & 255; asm volatile("" : "+v"(t)); return t; }
DI int otid512() { int t = threadIdx.x; asm volatile("" : "+v"(t)); return t; }
DI unsigned pack2(float a, float b) { f32x2 v = {a, b}; bf16x2_t r = __builtin_convertvector(v, bf16x2_t); return __builtin_bit_cast(unsigned, r); }
DI u16 f2bf(float a) { return (u16)(pack2(a, 0.f) & 0xffffu); }
DI float bf2f(u16 h) { return __uint_as_float(((unsigned)h) << 16); }
DI float bflo(unsigned u) { return __uint_as_float(u << 16); }
DI float bfhi(unsigned u) { return __uint_as_float(u & 0xffff0000u); }
DI f32x4 mfma16(bf16x8 a, bf16x8 b, f32x4 c) { return __builtin_amdgcn_mfma_f32_16x16x32_bf16(a, b, c, 0, 0, 0); }
DI float wave_sum(float v) {
#pragma unroll
  for (int o = 32; o > 0; o >>= 1) v += __shfl_xor(v, o);
  return v;
}
DI float siluf(float v) { return v * __builtin_amdgcn_rcpf(1.f + __expf(-v)); }
DI float sigmoidf_(float v) { return __builtin_amdgcn_rcpf(1.f + __expf(-v)); }
DI float exp2_(float v) { return __builtin_amdgcn_exp2f(v); }
DI float sgprf(float v) { return __int_as_float(__builtin_amdgcn_readfirstlane(__float_as_int(v))); }
DI s16x4 tr_read(const u16* p) { return __builtin_amdgcn_ds_read_tr16_b64_v4i16((LDSP s16x4*)p); }
DI bf16x8 cat4(s16x4 a, s16x4 b) { bf16x8 r; r[0] = a[0]; r[1] = a[1]; r[2] = a[2]; r[3] = a[3]; r[4] = b[0]; r[5] = b[1]; r[6] = b[2]; r[7] = b[3]; return r; }
DI bf16x8 ldfrag(const u16* p) { return *(const bf16x8*)p; }

DI int colmap(int n) {
  if (n < 640) return n;
  if (n < 896) return 652 + (n - 640);
  if (n < 1920) return 908 + (n - 896);
  if (n < 2688) return 1932 + (n - 1920);
  if (n < 3456) return 2704 + (n - 2688);
  if (n < 3968) return 3480 + (n - 3456);
  if (n < 3980) return 640 + (n - 3968);
  if (n < 3984) return 2700 + (n - 3980);
  if (n < 3992) return 3472 + (n - 3984);
  return -1;
}

DI void tconv_tile(const float* __restrict__ src, int ldsrc, int k0, int n0, u16* __restrict__ dst, int ldd, bool use_map, unsigned char* smem) {
  float* tile = (float*)smem;
  const int tid = otid();
  lds_barrier();
  {
    const int nn = tid & 63; int col = n0 + nn; if (use_map) col = colmap(col);
#pragma unroll
    for (int i = 0; i < 16; ++i) { const int kk = i * 4 + (tid >> 6); tile[kk * 65 + nn] = col >= 0 ? src[(size_t)(k0 + kk) * ldsrc + col] : 0.f; }
  }
  lds_barrier();
#pragma unroll
  for (int i = 0; i < 2; ++i) {
    const int item = tid + 256 * i, nn = item >> 3, kc = item & 7;
    u32x4 w;
    w.x = pack2(tile[(kc * 8 + 0) * 65 + nn], tile[(kc * 8 + 1) * 65 + nn]);
    w.y = pack2(tile[(kc * 8 + 2) * 65 + nn], tile[(kc * 8 + 3) * 65 + nn]);
    w.z = pack2(tile[(kc * 8 + 4) * 65 + nn], tile[(kc * 8 + 5) * 65 + nn]);
    w.w = pack2(tile[(kc * 8 + 6) * 65 + nn], tile[(kc * 8 + 7) * 65 + nn]);
    *(u32x4*)(dst + (size_t)(n0 + nn) * ldd + k0 + kc * 8) = w;
  }
}

constexpr int T0_WIN = 2 * 16 * 64, T0_WOUT = 2 * 16 * 16, T0_W1 = 4 * 32 * 2, T0_W2 = 4 * 2, T0_ADA = 2 * 12 * 8, T0_B1 = 64;
constexpr int T0_TOTAL = T0_WIN + T0_WOUT + T0_W1 + T0_W2 + T0_ADA + T0_B1;

DI void phase0_task(const Params& p, int t, unsigned char* smem) {
  const int tid = otid();
  if (t < T0_WIN) {
    const int l = t / 1024, r = t % 1024, kt = r / 64, nt = r % 64;
    tconv_tile(p.w_in + (size_t)l * D_MODEL * D_IN, D_IN, kt * 64, nt * 64, (u16*)(p.ws + OFF_WINT) + (size_t)l * NPAD * 1024, 1024, true, smem);
    return;
  }
  t -= T0_WIN;
  if (t < T0_WOUT) {
    const int l = t / 256, r = t % 256, kt = r / 16, nt = r % 16;
    tconv_tile(p.w_out + (size_t)l * 1024 * 1024, 1024, kt * 64, nt * 64, (u16*)(p.ws + OFF_WOUTT) + (size_t)l * 1024 * 1024, 1024, false, smem);
    return;
  }
  t -= T0_WOUT;
  if (t < T0_W1) {
    const int m = t / 64, r = t % 64, kt = r / 2, nt = r % 2, l = m >> 1, kv = m & 1;
    const float* src = (kv ? p.nsa_cv_w1 : p.nsa_ck_w1) + (size_t)l * 2048 * 128;
    tconv_tile(src, 128, kt * 64, nt * 64, (u16*)(p.ws + OFF_W1T) + (size_t)m * 128 * 2048, 2048, false, smem);
    return;
  }
  t -= T0_W1;
  if (t < T0_W2) {
    const int m = t / 2, kt = t % 2, l = m >> 1, kv = m & 1;
    const float* src = (kv ? p.nsa_cv_w2 : p.nsa_ck_w2) + (size_t)l * 128 * 64;
    tconv_tile(src, 64, kt * 64, 0, (u16*)(p.ws + OFF_W2T) + (size_t)m * 64 * 128, 128, false, smem);
    return;
  }
  t -= T0_W2;
  if (t < T0_ADA) {
    const int l = t / 96, r = t % 96, nc = r / 8, kc = r % 8;
    float* cact = (float*)smem;
    lds_barrier();
    for (int i = tid; i < 1024; i += 256) { const int b = i >> 7, kk = i & 127; const float v = p.c[b * 1024 + kc * 128 + kk]; cact[i] = siluf(v); }
    lds_barrier();
    const int n = nc * 256 + tid;
    float acc[8];
#pragma unroll
    for (int b = 0; b < 8; ++b) acc[b] = 0.f;
    const float* w = p.ada_w + ((size_t)l * 1024 + kc * 128) * 3072 + n;
#pragma unroll 16
    for (int kk = 0; kk < 128; ++kk) {
      const float wv = w[(size_t)kk * 3072];
#pragma unroll
      for (int b = 0; b < 8; ++b) acc[b] += cact[b * 128 + kk] * wv;
    }
    float* adap = (float*)(p.ws + OFF_ADAP);
    const float bias = kc == 0 ? p.ada_b[l * 3072 + n] : 0.f;
#pragma unroll
    for (int b = 0; b < 8; ++b) adap[(((size_t)kc * 2 + l) * 8 + b) * 3072 + n] = acc[b] + bias;
    return;
  }
  t -= T0_ADA;
  {
    const int m = t >> 4, kc = t & 15, l = m >> 1, kv = m & 1;
    const float* w1 = (kv ? p.nsa_cv_w1 : p.nsa_ck_w1) + (size_t)l * 2048 * 128;
    const float* pos = p.nsa_cmp_pos + (size_t)l * 2048;
    const int n = tid & 127, half = tid >> 7;
    float acc = 0.f;
    const int k0 = kc * 128 + half * 64;
#pragma unroll 16
    for (int k = 0; k < 64; ++k) acc += pos[k0 + k] * w1[(size_t)(k0 + k) * 128 + n];
    float* red = (float*)smem;
    lds_barrier();
    red[tid] = acc;
    lds_barrier();
    if (tid < 128) ((float*)(p.ws + OFF_BIAS1))[(m * 16 + kc) * 128 + tid] = red[tid] + red[tid + 128];
  }
}

DI void phase1_task(const Params& p, int layer, const float* xin, int grp, unsigned char* smem) {
  const int tid = otid(), lane = tid & 63, wid = tid >> 6;
  const int b = grp >> 6;
  float* mul = (float*)smem;
  float* sh = mul + 1024;
  const float* adap = (const float*)(p.ws + OFF_ADAP);
  lds_barrier();
  for (int c = tid; c < 1024; c += 256) {
    float s0 = 0.f, s1 = 0.f;
#pragma unroll
    for (int kc = 0; kc < 8; ++kc) { const float* a = adap + (((size_t)kc * 2 + layer) * 8 + b) * 3072; s0 += a[c]; s1 += a[1024 + c]; }
    mul[c] = p.norm_g[layer * 1024 + c] * (1.f + s1); sh[c] = s0;
  }
  lds_barrier();
  u16* H = (u16*)(p.ws + OFF_H);
#pragma unroll 1
  for (int it = 0; it < 4; ++it) {
    float4 v[4][4]; float ss[4];
#pragma unroll
    for (int j = 0; j < 4; ++j) {
      const int row = grp * 64 + wid * 16 + it * 4 + j;
      const float4* xr = (const float4*)(xin + (size_t)row * D_MODEL);
#pragma unroll
      for (int i = 0; i < 4; ++i) v[j][i] = xr[lane + 64 * i];
    }
#pragma unroll
    for (int j = 0; j < 4; ++j) {
      float a = 0.f;
#pragma unroll
      for (int i = 0; i < 4; ++i) a += v[j][i].x * v[j][i].x + v[j][i].y * v[j][i].y + v[j][i].z * v[j][i].z + v[j][i].w * v[j][i].w;
      ss[j] = wave_sum(a);
    }
#pragma unroll
    for (int j = 0; j < 4; ++j) {
      const int row = grp * 64 + wid * 16 + it * 4 + j;
      const float r = rsqrtf(ss[j] * (1.f / D_MODEL) + 1e-6f);
#pragma unroll
      for (int i = 0; i < 4; ++i) {
        const int c = (lane + 64 * i) * 4;
        u32x2 w;
        w.x = pack2(v[j][i].x * r * mul[c] + sh[c], v[j][i].y * r * mul[c + 1] + sh[c + 1]);
        w.y = pack2(v[j][i].z * r * mul[c + 2] + sh[c + 2], v[j][i].w * r * mul[c + 3] + sh[c + 3]);
        *(u32x2*)(H + (size_t)row * 1024 + c) = w;
      }
    }
  }
}

namespace g8 {
constexpr int BM = 256, BK = 64, HALF = 128, HT = HALF * BK;
constexpr int LDS_BYTES = 8 * HT * 2;
DI int lds_byte(int r, int c) { const int st = (r >> 4) * 2 + (c >> 5), rr = r & 15, cc = c & 31, ob = rr * 64 + cc * 2; return st * 1024 + (ob ^ (((ob >> 9) & 1) << 5)); }
DI void stage_rc(int b, int& R, int& C) { const int st = b / 1024, sb = b % 1024, swz = sb ^ (((sb >> 9) & 1) << 5); R = (st >> 1) * 16 + swz / 64; C = (st & 1) * 32 + (swz % 64) / 2; }

DI void kloop(const u16* __restrict__ A, const u16* __restrict__ Bt, int K, int brow, int bcol, unsigned char* smem, f32x4 (&acc)[2][2][4][2]) {
  u16* shm = (u16*)smem;
  const int tid = otid512();
#define SA(b, h) (shm + ((b) * 2 + (h)) * HT)
#define SB(b, h) (shm + (4 + (b) * 2 + (h)) * HT)
#define STAGE(P, BASE, br, kt) do { const u16* _gb = BASE + ((long)(br) * K + (long)(kt) * BK); \
      __builtin_amdgcn_global_load_lds((const unsigned*)(_gb + soff0), (LDSP unsigned*)((LDSP char*)(P) + tid * 16), 16, 0, 0); \
      __builtin_amdgcn_global_load_lds((const unsigned*)(_gb + soff1), (LDSP unsigned*)((LDSP char*)(P) + tid * 16 + 8192), 16, 0, 0); } while (0)
#define LDA(dst, b, h) _Pragma("unroll") for (int m = 0; m < 4; ++m) _Pragma("unroll") for (int k = 0; k < 2; ++k) \
    dst[m][k] = *reinterpret_cast<const bf16x8*>((const char*)SA(b, h) + lds_byte(wr * 64 + m * 16 + fr, k * 32 + fq * 8))
#define LDB(dst, b, h) _Pragma("unroll") for (int n = 0; n < 2; ++n) _Pragma("unroll") for (int k = 0; k < 2; ++k) \
    dst[n][k] = *reinterpret_cast<const bf16x8*>((const char*)SB(b, h) + lds_byte(wc * 32 + n * 16 + fr, k * 32 + fq * 8))
#define MMA(ai, bj, At_, Bt_) do { __builtin_amdgcn_s_setprio(1); \
    _Pragma("unroll") for (int m = 0; m < 4; ++m) _Pragma("unroll") for (int n = 0; n < 2; ++n) _Pragma("unroll") for (int k = 0; k < 2; ++k) \
      acc[ai][bj][m][n] = __builtin_amdgcn_mfma_f32_16x16x32_bf16(Bt_[n][k], At_[m][k], acc[ai][bj][m][n], 0, 0, 0); \
    __builtin_amdgcn_s_setprio(0); } while (0)
#define WAIT_V(n) asm volatile("s_waitcnt vmcnt(" #n ")" ::: "memory")
#define WAIT_L(n) asm volatile("s_waitcnt lgkmcnt(" #n ")" ::: "memory")
#define BAR __builtin_amdgcn_s_barrier()
#define SCHED __builtin_amdgcn_sched_barrier(0)
  const int wid = __builtin_amdgcn_readfirstlane(tid >> 6), lane = tid & 63, wr = wid >> 2, wc = wid & 3, fr = lane & 15, fq = lane >> 4;
#pragma unroll
  for (int a = 0; a < 2; ++a)
#pragma unroll
    for (int b = 0; b < 2; ++b)
#pragma unroll
      for (int m = 0; m < 4; ++m) { acc[a][b][m][0] = (f32x4){0.f, 0.f, 0.f, 0.f}; acc[a][b][m][1] = (f32x4){0.f, 0.f, 0.f, 0.f}; }
  bf16x8 At[4][2], B0[2][2], B1[2][2];
  const int nt = K / BK;
  int soff0, soff1;
  { int r_, c_; stage_rc(tid * 16, r_, c_); soff0 = r_ * K + c_; stage_rc(tid * 16 + 8192, r_, c_); soff1 = r_ * K + c_; }
  STAGE(SB(0, 0), Bt, bcol, 0); STAGE(SA(0, 0), A, brow, 0);
  STAGE(SB(0, 1), Bt, bcol + HALF, 0); STAGE(SA(0, 1), A, brow + HALF, 0);
  if (wr == 1) BAR;
  WAIT_V(4); BAR;
  STAGE(SB(1, 0), Bt, bcol, 1); STAGE(SA(1, 0), A, brow, 1); STAGE(SB(1, 1), Bt, bcol + HALF, 1);
  WAIT_V(6); BAR;
#pragma unroll 1
  for (int t = 0; t < nt - 2; t += 2) {
    asm volatile("" : "+v"(soff0), "+v"(soff1));
    LDB(B0, 0, 0); SCHED; LDA(At, 0, 0); STAGE(SA(1, 1), A, brow + HALF, t + 1);
    WAIT_L(8); BAR; WAIT_L(0); MMA(0, 0, At, B0); BAR; SCHED;
    LDB(B1, 0, 1); STAGE(SB(0, 0), Bt, bcol, t + 2);
    BAR; WAIT_L(0); MMA(0, 1, At, B1); BAR;
    LDA(At, 0, 1); STAGE(SA(0, 0), A, brow, t + 2);
    BAR; WAIT_L(0); MMA(1, 0, At, B0); BAR; SCHED;
    STAGE(SB(0, 1), Bt, bcol + HALF, t + 2);
    WAIT_V(6); BAR; MMA(1, 1, At, B1); BAR;
    LDB(B0, 1, 0); SCHED; LDA(At, 1, 0); STAGE(SA(0, 1), A, brow + HALF, t + 2);
    WAIT_L(8); BAR; WAIT_L(0); MMA(0, 0, At, B0); BAR; SCHED;
    LDB(B1, 1, 1); STAGE(SB(1, 0), Bt, bcol, t + 3);
    BAR; WAIT_L(0); MMA(0, 1, At, B1); BAR;
    LDA(At, 1, 1); STAGE(SA(1, 0), A, brow, t + 3);
    BAR; WAIT_L(0); MMA(1, 0, At, B0); BAR; SCHED;
    STAGE(SB(1, 1), Bt, bcol + HALF, t + 3);
    WAIT_V(6); BAR; MMA(1, 1, At, B1); BAR;
  }
  { LDB(B0, 0, 0); LDA(At, 0, 0); STAGE(SA(1, 1), A, brow + HALF, nt - 1);
    BAR; WAIT_L(0); MMA(0, 0, At, B0); BAR;
    LDB(B1, 0, 1); BAR; WAIT_L(0); MMA(0, 1, At, B1); BAR;
    LDA(At, 0, 1); WAIT_V(4); BAR; WAIT_L(0); MMA(1, 0, At, B0); MMA(1, 1, At, B1); BAR; }
  { LDB(B0, 1, 0); LDA(At, 1, 0); WAIT_V(2); BAR; WAIT_L(0); MMA(0, 0, At, B0); BAR;
    LDB(B1, 1, 1); WAIT_V(0); BAR; WAIT_L(0); MMA(0, 1, At, B1); BAR;
    LDA(At, 1, 1); BAR; WAIT_L(0); MMA(1, 0, At, B0); MMA(1, 1, At, B1); BAR; }
  if (wr == 0) BAR;
#undef SA
#undef SB
#undef STAGE
#undef LDA
#undef LDB
#undef MMA
#undef WAIT_V
#undef WAIT_L
#undef BAR
#undef SCHED
}
DI void tile_map(int wgid, int nM, int nN, int& pm, int& pn) {
  const int nwg = nM * nN, NXCD = 8, WGM = 8;
  { const int q = nwg / NXCD, r = nwg % NXCD, xcd = wgid % NXCD, off = wgid / NXCD; wgid = (xcd < r ? xcd * (q + 1) : r * (q + 1) + (xcd - r) * q) + off; }
  const int nig = WGM * nN, gid = wgid / nig, fm = gid * WGM, gsz = (nM - fm) < WGM ? (nM - fm) : WGM;
  pm = fm + ((wgid % nig) % gsz); pn = (wgid % nig) / gsz;
}
}

DI void gemm_inproj_tile(const Params& p, int layer, int tile, unsigned char* smem) {
  int pm, pn; g8::tile_map(tile, NTOK / 256, NPAD / 256, pm, pn);
  const int brow = pm * 256, bcol = pn * 256;
  f32x4 acc[2][2][4][2];
  g8::kloop((const u16*)(p.ws + OFF_H), (const u16*)(p.ws + OFF_WINT) + (size_t)layer * NPAD * 1024, 1024, brow, bcol, smem, acc);
  const int tid = otid512(), wid = __builtin_amdgcn_readfirstlane(tid >> 6), lane = tid & 63, wr = wid >> 2, wc = wid & 3, fr = lane & 15, fq = lane >> 4;
  u16* proj = (u16*)(p.ws + OFF_PROJ);
  if (pn == 15 && wc == 0) {
    float* sm = (float*)(p.ws + OFF_SMALL);
#pragma unroll
    for (int ai = 0; ai < 2; ++ai)
#pragma unroll
      for (int m = 0; m < 4; ++m)
#pragma unroll
        for (int n = 0; n < 2; ++n) {
          const int mr = brow + ai * 128 + wr * 64 + m * 16 + fr;
          *(f32x4*)(sm + (size_t)mr * NSMALL + n * 16 + 4 * fq) = acc[ai][1][m][n];
        }
  }
  constexpr int CLD = 264;
  u16* Cs = (u16*)smem;
#pragma unroll
  for (int ai = 0; ai < 2; ++ai) {
    lds_barrier();
#pragma unroll
    for (int bj = 0; bj < 2; ++bj)
#pragma unroll
      for (int m = 0; m < 4; ++m)
#pragma unroll
        for (int n = 0; n < 2; ++n) {
          const f32x4 v = acc[ai][bj][m][n];
          u32x2 w; w.x = pack2(v[0], v[1]); w.y = pack2(v[2], v[3]);
          *(u32x2*)(Cs + (wr * 64 + m * 16 + fr) * CLD + bj * 128 + wc * 32 + n * 16 + 4 * fq) = w;
        }
    lds_barrier();
#pragma unroll
    for (int i = 0; i < 8; ++i) {
      const int id = tid + 512 * i, row = id >> 5, ch = id & 31;
      if (bcol + ch * 8 < NP) *(u32x4*)(proj + (size_t)(brow + ai * 128 + row) * NP + bcol + ch * 8) = *(const u32x4*)(Cs + row * CLD + ch * 8);
    }
  }
  asm volatile("s_waitcnt vmcnt(0)" ::: "memory");
  lds_barrier();
}

DI void gemm_outproj_tile(const Params& p, int layer, const float* xin, float* xout, int tile, unsigned char* smem) {
  int pm, pn; g8::tile_map(tile, NTOK / 256, 4, pm, pn);
  const int brow = pm * 256, bcol = pn * 256;
  f32x4 acc[2][2][4][2];
  g8::kloop((const u16*)(p.ws + OFF_H), (const u16*)(p.ws + OFF_WOUTT) + (size_t)layer * 1024 * 1024, 1024, brow, bcol, smem, acc);
  const int tid = otid512(), wid = __builtin_amdgcn_readfirstlane(tid >> 6), lane = tid & 63, wr = wid >> 2, wc = wid & 3, fr = lane & 15, fq = lane >> 4;
  const int b = brow >> 12;
  const float* adap = (const float*)(p.ws + OFF_ADAP);
  constexpr int CLD = 132;
  float* Cs = (float*)smem;
#pragma unroll
  for (int ai = 0; ai < 2; ++ai)
#pragma unroll
    for (int bj = 0; bj < 2; ++bj) {
      lds_barrier();
#pragma unroll
      for (int m = 0; m < 4; ++m)
#pragma unroll
        for (int n = 0; n < 2; ++n) *(f32x4*)(Cs + (wr * 64 + m * 16 + fr) * CLD + wc * 32 + n * 16 + 4 * fq) = acc[ai][bj][m][n];
      lds_barrier();
      const int ch = tid & 31, nc = bcol + bj * 128 + ch * 4;
      f32x4 gt = {0.f, 0.f, 0.f, 0.f};
#pragma unroll
      for (int kc = 0; kc < 8; ++kc) gt += *(const f32x4*)(adap + (((size_t)kc * 2 + layer) * 8 + b) * 3072 + 2048 + nc);
      f32x4 xv[8];
#pragma unroll
      for (int i = 0; i < 8; ++i) xv[i] = *(const f32x4*)(xin + (size_t)(brow + ai * 128 + (tid >> 5) + 16 * i) * 1024 + nc);
#pragma unroll
      for (int i = 0; i < 8; ++i) {
        const int row = (tid >> 5) + 16 * i;
        *(f32x4*)(xout + (size_t)(brow + ai * 128 + row) * 1024 + nc) = xv[i] + gt * *(const f32x4*)(Cs + row * CLD + ch * 4);
      }
    }
  asm volatile("s_waitcnt vmcnt(0)" ::: "memory");
  lds_barrier();
}

constexpr int KLD = 72;
struct KVRegs { u32x4 k[2], v[2]; };
DI void kv_load(const u16* kbase, const u16* vbase, int ldk, int ldv, int key0, KVRegs& r) {
  const int tid = otid();
#pragma unroll
  for (int i = 0; i < 2; ++i) {
    const int id = tid + 256 * i, row = id >> 3, ch = id & 7;
    r.k[i] = *(const u32x4*)(kbase + (size_t)(key0 + row) * ldk + ch * 8);
    r.v[i] = *(const u32x4*)(vbase + (size_t)(key0 + row) * ldv + ch * 8);
  }
}
DI void kv_store(u16* Ks, u16* Vs, const KVRegs& r) {
  const int tid = otid();
#pragma unroll
  for (int i = 0; i < 2; ++i) {
    const int id = tid + 256 * i, row = id >> 3, ch = id & 7;
    *(u32x4*)(Ks + row * KLD + ch * 8) = r.k[i];
    *(u32x4*)(Vs + row * KLD + ch * 8) = r.v[i];
  }
}
constexpr int KVBUF = 2 * 64 * KLD;
template <class UseF, class LoadF, class CompF>
DI void kv_pipeline(int j0, int j1, u16* buf, UseF use, LoadF load, CompF comp) {
  KVRegs kr;
  if (use(j0)) load(j0, kr);
  lds_barrier();
  if (use(j0)) kv_store(buf, buf + 64 * KLD, kr);
  if (j0 + 1 < j1 && use(j0 + 1)) load(j0 + 1, kr);
  lds_barrier();
  for (int j = j0; j < j1; ++j) {
    u16* cur = buf + ((j - j0) & 1) * KVBUF; u16* nxt = buf + (((j - j0) & 1) ^ 1) * KVBUF;
    if (j + 1 < j1 && use(j + 1)) kv_store(nxt, nxt + 64 * KLD, kr);
    if (j + 2 < j1 && use(j + 2)) load(j + 2, kr);
    if (use(j)) comp(j, cur, cur + 64 * KLD);
    lds_barrier();
  }
}
struct AttnAcc { f32x4 o[4][2]; float m[2], l[2]; };
DI void attn_init(AttnAcc& a) {
#pragma unroll
  for (int d = 0; d < 4; ++d) { a.o[d][0] = (f32x4){0.f, 0.f, 0.f, 0.f}; a.o[d][1] = (f32x4){0.f, 0.f, 0.f, 0.f}; }
  a.m[0] = a.m[1] = -1e30f; a.l[0] = a.l[1] = 0.f;
}
template <int NKS>
DI void qk_tile(const u16* Ks, int dofs, const bf16x8 (&qf)[2][NKS], f32x4 (&s)[4][2], int l15, int g) {
#pragma unroll
  for (int kt = 0; kt < 4; ++kt) {
    s[kt][0] = (f32x4){0.f, 0.f, 0.f, 0.f}; s[kt][1] = (f32x4){0.f, 0.f, 0.f, 0.f};
#pragma unroll
    for (int ks = 0; ks < NKS; ++ks) {
      const bf16x8 a = ldfrag(Ks + (kt * 16 + l15) * KLD + dofs + ks * 32 + 8 * g);
      s[kt][0] = mfma16(a, qf[0][ks], s[kt][0]);
      s[kt][1] = mfma16(a, qf[1][ks], s[kt][1]);
    }
  }
}
DI void pv_accum(const bf16x8 (&pf)[2][2], const u16* Vs, f32x4 (&o)[4][2], int l15, int g) {
  const int tq = l15 >> 2, tp = l15 & 3;
#pragma unroll
  for (int kk = 0; kk < 2; ++kk)
#pragma unroll
    for (int d = 0; d < 4; ++d) {
      const bf16x8 vf = cat4(tr_read(Vs + (kk * 32 + 4 * g + tq) * KLD + d * 16 + 4 * tp), tr_read(Vs + (kk * 32 + 16 + 4 * g + tq) * KLD + d * 16 + 4 * tp));
      o[d][0] = mfma16(vf, pf[0][kk], o[d][0]);
      o[d][1] = mfma16(vf, pf[1][kk], o[d][1]);
    }
}
DI void pack_p(const f32x4 (&s)[4][2], bf16x8 (&pf)[2][2]) {
#pragma unroll
  for (int qt = 0; qt < 2; ++qt)
#pragma unroll
    for (int kk = 0; kk < 2; ++kk) {
      u32x4 w;
      w.x = pack2(s[2 * kk][qt][0], s[2 * kk][qt][1]); w.y = pack2(s[2 * kk][qt][2], s[2 * kk][qt][3]);
      w.z = pack2(s[2 * kk + 1][qt][0], s[2 * kk + 1][qt][1]); w.w = pack2(s[2 * kk + 1][qt][2], s[2 * kk + 1][qt][3]);
      pf[qt][kk] = __builtin_bit_cast(bf16x8, w);
    }
}
constexpr float DEFER_THR = 5.f;
template <class VF>
DI void softmax_pv(f32x4 (&s)[4][2], AttnAcc& a, const u16* Vs, float sc, int l15, int g, VF valid) {
  bf16x8 pf[2][2];
  float mxl[2];
#pragma unroll
  for (int qt = 0; qt < 2; ++qt) {
    float mx = -1e30f;
#pragma unroll
    for (int kt = 0; kt < 4; ++kt)
#pragma unroll
      for (int r = 0; r < 4; ++r) { const float v = valid(kt, r, qt) ? s[kt][qt][r] * sc : -1e30f; s[kt][qt][r] = v; mx = fmaxf(mx, v); }
    mxl[qt] = mx;
  }
  if (__any((mxl[0] > a.m[0] + DEFER_THR) || (mxl[1] > a.m[1] + DEFER_THR))) {
#pragma unroll
    for (int qt = 0; qt < 2; ++qt) {
      float mx = mxl[qt];
      mx = fmaxf(mx, __shfl_xor(mx, 16)); mx = fmaxf(mx, __shfl_xor(mx, 32));
      const float mn = fmaxf(a.m[qt], mx), alpha = exp2_(a.m[qt] - mn);
      a.m[qt] = mn; a.l[qt] *= alpha;
#pragma unroll
      for (int d = 0; d < 4; ++d) a.o[d][qt] *= alpha;
    }
  }
#pragma unroll
  for (int qt = 0; qt < 2; ++qt) {
    const float mn = a.m[qt];
    float ls = 0.f;
#pragma unroll
    for (int kt = 0; kt < 4; ++kt)
#pragma unroll
      for (int r = 0; r < 4; ++r) { const float v = s[kt][qt][r]; const float pv = v > -1e29f ? exp2_(v - mn) : 0.f; s[kt][qt][r] = pv; ls += pv; }
    a.l[qt] += ls;
  }
  pack_p(s, pf);
  pv_accum(pf, Vs, a.o, l15, g);
}
DI void softmax_pv_nomask(f32x4 (&s)[4][2], AttnAcc& a, const u16* Vs, float sc, int l15, int g) {
  bf16x8 pf[2][2];
  float mxl[2];
#pragma unroll
  for (int qt = 0; qt < 2; ++qt) {
    float mx = s[0][qt][0];
#pragma unroll
    for (int kt = 0; kt < 4; ++kt)
#pragma unroll
      for (int r = 0; r < 4; ++r) mx = fmaxf(mx, s[kt][qt][r]);
    mxl[qt] = mx * sc;
  }
  if (__any((mxl[0] > a.m[0] + DEFER_THR) || (mxl[1] > a.m[1] + DEFER_THR))) {
#pragma unroll
    for (int qt = 0; qt < 2; ++qt) {
      float mx = mxl[qt];
      mx = fmaxf(mx, __shfl_xor(mx, 16)); mx = fmaxf(mx, __shfl_xor(mx, 32));
      const float mn = fmaxf(a.m[qt], mx), alpha = exp2_(a.m[qt] - mn);
      a.m[qt] = mn; a.l[qt] *= alpha;
#pragma unroll
      for (int d = 0; d < 4; ++d) a.o[d][qt] *= alpha;
    }
  }
#pragma unroll
  for (int qt = 0; qt < 2; ++qt) {
    const float mn = a.m[qt];
    float ls = 0.f;
#pragma unroll
    for (int kt = 0; kt < 4; ++kt)
#pragma unroll
      for (int r = 0; r < 4; ++r) { const float pv = exp2_(__builtin_fmaf(s[kt][qt][r], sc, -mn)); s[kt][qt][r] = pv; ls += pv; }
    a.l[qt] += ls;
  }
  pack_p(s, pf);
  pv_accum(pf, Vs, a.o, l15, g);
}
template <class VF>
DI void softmax_p(f32x4 (&s)[4][2], AttnAcc& a, float sc, bf16x8 (&pf)[2][2], bool nomask, VF valid) {
  float mxl[2];
#pragma unroll
  for (int qt = 0; qt < 2; ++qt) {
    float mx = -1e30f;
#pragma unroll
    for (int kt = 0; kt < 4; ++kt)
#pragma unroll
      for (int r = 0; r < 4; ++r) { const float v = (nomask || valid(kt, r, qt)) ? s[kt][qt][r] * sc : -1e30f; s[kt][qt][r] = v; mx = fmaxf(mx, v); }
    mxl[qt] = mx;
  }
  if (__any((mxl[0] > a.m[0] + DEFER_THR) || (mxl[1] > a.m[1] + DEFER_THR))) {
#pragma unroll
    for (int qt = 0; qt < 2; ++qt) {
      float mx = mxl[qt];
      mx = fmaxf(mx, __shfl_xor(mx, 16)); mx = fmaxf(mx, __shfl_xor(mx, 32));
      const float mn = fmaxf(a.m[qt], mx), alpha = exp2_(a.m[qt] - mn);
      a.m[qt] = mn; a.l[qt] *= alpha;
#pragma unroll
      for (int d = 0; d < 4; ++d) a.o[d][qt] *= alpha;
    }
  }
#pragma unroll
  for (int qt = 0; qt < 2; ++qt) {
    const float mn = a.m[qt];
    float ls = 0.f;
#pragma unroll
    for (int kt = 0; kt < 4; ++kt)
#pragma unroll
      for (int r = 0; r < 4; ++r) { const float v = s[kt][qt][r]; const float pv = v > -1e29f ? exp2_(v - mn) : 0.f; s[kt][qt][r] = pv; ls += pv; }
    a.l[qt] += ls;
  }
  pack_p(s, pf);
}
DI void softmax_p_nomask(f32x4 (&s)[4][2], AttnAcc& a, float sc, bf16x8 (&pf)[2][2]) {
  float mxl[2];
#pragma unroll
  for (int qt = 0; qt < 2; ++qt) {
    float mx = s[0][qt][0];
#pragma unroll
    for (int kt = 0; kt < 4; ++kt)
#pragma unroll
      for (int r = 0; r < 4; ++r) mx = fmaxf(mx, s[kt][qt][r]);
    mxl[qt] = mx * sc;
  }
  if (__any((mxl[0] > a.m[0] + DEFER_THR) || (mxl[1] > a.m[1] + DEFER_THR))) {
#pragma unroll
    for (int qt = 0; qt < 2; ++qt) {
      float mx = mxl[qt];
      mx = fmaxf(mx, __shfl_xor(mx, 16)); mx = fmaxf(mx, __shfl_xor(mx, 32));
      const float mn = fmaxf(a.m[qt], mx), alpha = exp2_(a.m[qt] - mn);
      a.m[qt] = mn; a.l[qt] *= alpha;
#pragma unroll
      for (int d = 0; d < 4; ++d) a.o[d][qt] *= alpha;
    }
  }
#pragma unroll
  for (int qt = 0; qt < 2; ++qt) {
    const float mn = a.m[qt];
    float ls = 0.f;
#pragma unroll
    for (int kt = 0; kt < 4; ++kt)
#pragma unroll
      for (int r = 0; r < 4; ++r) { const float pv = exp2_(__builtin_fmaf(s[kt][qt][r], sc, -mn)); s[kt][qt][r] = pv; ls += pv; }
    a.l[qt] += ls;
  }
  pack_p(s, pf);
}
DI float group_sum4_(float v) { v += __shfl_xor(v, 16); v += __shfl_xor(v, 32); return v; }
DI bf16x8 scale_frag(bf16x8 f, float sc) {
  u32x4 w = __builtin_bit_cast(u32x4, f);
  w.x = pack2(bflo(w.x) * sc, bfhi(w.x) * sc); w.y = pack2(bflo(w.y) * sc, bfhi(w.y) * sc);
  w.z = pack2(bflo(w.z) * sc, bfhi(w.z) * sc); w.w = pack2(bflo(w.w) * sc, bfhi(w.w) * sc);
  return __builtin_bit_cast(bf16x8, w);
}
DI void attn_init_rel(AttnAcc& a) { attn_init(a); a.m[0] = a.m[1] = 0.f; }
template <int NKS>
DI void qk_tile_rel(const u16* Ks, int dofs, const bf16x8 (&qf)[2][NKS], const AttnAcc& a, f32x4 (&s)[4][2], int l15, int g) {
  const float n0 = -a.m[0], n1 = -a.m[1];
#pragma unroll
  for (int kt = 0; kt < 4; ++kt) {
    s[kt][0] = (f32x4){n0, n0, n0, n0}; s[kt][1] = (f32x4){n1, n1, n1, n1};
#pragma unroll
    for (int ks = 0; ks < NKS; ++ks) {
      const bf16x8 k = ldfrag(Ks + (kt * 16 + l15) * KLD + dofs + ks * 32 + 8 * g);
      s[kt][0] = mfma16(k, qf[0][ks], s[kt][0]);
      s[kt][1] = mfma16(k, qf[1][ks], s[kt][1]);
    }
  }
}
template <bool MASKED, class VF>
DI void softmax_rel(f32x4 (&s)[4][2], AttnAcc& a, bf16x8 (&pf)[2][2], VF valid) {
  float mxl[2];
#pragma unroll
  for (int qt = 0; qt < 2; ++qt) {
    float mx = -1e30f;
#pragma unroll
    for (int kt = 0; kt < 4; ++kt)
#pragma unroll
      for (int r = 0; r < 4; ++r) { if (MASKED) s[kt][qt][r] = valid(kt, r, qt) ? s[kt][qt][r] : -1e30f; mx = fmaxf(mx, s[kt][qt][r]); }
    mxl[qt] = mx;
  }
  if (__any(mxl[0] > DEFER_THR || mxl[1] > DEFER_THR || (a.l[0] == 0.f && mxl[0] > -1e29f) || (a.l[1] == 0.f && mxl[1] > -1e29f))) {
#pragma unroll
    for (int qt = 0; qt < 2; ++qt) {
      float mx = mxl[qt];
      mx = fmaxf(mx, __shfl_xor(mx, 16)); mx = fmaxf(mx, __shfl_xor(mx, 32));
      const bool fresh = group_sum4_(a.l[qt]) == 0.f;
      const float dl = mx < -1e29f ? 0.f : (fresh ? mx : fmaxf(mx, 0.f)), alpha = exp2_(-dl);
      a.m[qt] += dl; a.l[qt] *= alpha;
#pragma unroll
      for (int d = 0; d < 4; ++d) a.o[d][qt] *= alpha;
#pragma unroll
      for (int kt = 0; kt < 4; ++kt)
#pragma unroll
        for (int r = 0; r < 4; ++r) s[kt][qt][r] -= dl;
    }
  }
#pragma unroll
  for (int qt = 0; qt < 2; ++qt) {
    float ls = 0.f;
#pragma unroll
    for (int kt = 0; kt < 4; ++kt)
#pragma unroll
      for (int r = 0; r < 4; ++r) { const float pv = exp2_(s[kt][qt][r]); s[kt][qt][r] = pv; ls += pv; }
    a.l[qt] += ls;
  }
  pack_p(s, pf);
}
template <class LoadF, class CompF>
DI void kv_pipeline3(int j0, int j1, u16* buf, LoadF load, CompF comp) {
  KVRegs kr;
  load(j0, kr);
  lds_barrier();
  kv_store(buf, buf + 64 * KLD, kr);
  if (j0 + 1 < j1) load(j0 + 1, kr);
  lds_barrier();
  int cb = 0;
  for (int j = j0; j < j1; ++j) {
    const int nb = cb == 2 ? 0 : cb + 1, pb = cb == 0 ? 2 : cb - 1;
    if (j + 1 < j1) kv_store(buf + nb * KVBUF, buf + nb * KVBUF + 64 * KLD, kr);
    if (j + 2 < j1) load(j + 2, kr);
    comp(j, buf + cb * KVBUF, buf + pb * KVBUF);
    lds_barrier();
    cb = nb;
  }
}
DI float group_sum4(float v) { v += __shfl_xor(v, 16); v += __shfl_xor(v, 32); return v; }

DI void diff_attn_task(const Params& p, int layer, int b, int h, int qb, unsigned char* smem, bool skew) {
  u16* Ks = (u16*)smem; u16* Vs = Ks + 64 * KLD;
  const int tid = otid(), lane = tid & 63, wid = tid >> 6, l15 = lane & 15, g = lane >> 4;
  const u16* proj = (const u16*)(p.ws + OFF_PROJ) + (size_t)b * SEQ * NP;
  const int q0w = qb * 128 + wid * 32;
  const float* lam = p.diff_lam + layer * 128;
  float s01 = 0.f, s23 = 0.f;
  for (int i = 0; i < 32; ++i) { s01 += lam[i] * lam[32 + i]; s23 += lam[64 + i] * lam[96 + i]; }
  const float lam_init = 0.8f - 0.6f * __expf(-0.3f * (float)layer);
  const float lam_full = __expf(s01) - __expf(s23) + lam_init;
  const float sc = 0.17677669529663687f * 1.4426950408889634f;
  const int ntile = 2 * qb + 2;
  const u16* vbase = proj + PB_V + h * 64;
  f32x4 res[4][2];
#pragma unroll 1
  for (int c = 0; c < 2; ++c) {
    const u16* kbase = proj + PB_K + h * 64 + c * 32;
    bf16x8 qf[2][1];
#pragma unroll
    for (int qt = 0; qt < 2; ++qt) qf[qt][0] = scale_frag(ldfrag(proj + (size_t)(q0w + qt * 16 + l15) * NP + PB_Q + h * 64 + c * 32 + 8 * g), sc);
    AttnAcc a; attn_init_rel(a);
    bf16x8 pfs[2][2]; bool havepf = false;
    kv_pipeline3(0, ntile, Ks,
      [&](int j, KVRegs& kr) { kv_load(kbase, vbase, NP, NP, j * 64, kr); },
      [&](int j, const u16* cur, const u16* prev) {
        const int key0 = j * 64;
        if (skew && havepf) { pv_accum(pfs, prev + 64 * KLD, a.o, l15, g); havepf = false; }
        if (key0 <= q0w + 31) {
          f32x4 s[4][2];
          auto valid = [&](int kt, int r, int qt) { return key0 + kt * 16 + 4 * g + r <= q0w + qt * 16 + l15; };
          qk_tile_rel<1>(cur, 0, qf, a, s, l15, g);
          if (key0 + 63 <= q0w) softmax_rel<false>(s, a, pfs, valid); else softmax_rel<true>(s, a, pfs, valid);
          if (skew) havepf = true; else pv_accum(pfs, cur + 64 * KLD, a.o, l15, g);
        }
      });
    if (skew && havepf) pv_accum(pfs, Ks + ((ntile - 1) % 3) * KVBUF + 64 * KLD, a.o, l15, g);
#pragma unroll
    for (int qt = 0; qt < 2; ++qt) {
      const float lt = group_sum4(a.l[qt]);
      const float inv = c == 0 ? 1.f / lt : -lam_full / lt;
#pragma unroll
      for (int d = 0; d < 4; ++d) res[d][qt] = c == 0 ? a.o[d][qt] * inv : res[d][qt] + a.o[d][qt] * inv;
    }
  }
  u16* Y = (u16*)(p.ws + OFF_H);
  const float* ng = p.diff_norm_g + layer * 64;
#pragma unroll
  for (int qt = 0; qt < 2; ++qt) {
    float ss = 0.f;
#pragma unroll
    for (int d = 0; d < 4; ++d) { const f32x4 v = res[d][qt]; ss += v[0] * v[0] + v[1] * v[1] + v[2] * v[2] + v[3] * v[3]; }
    ss = group_sum4(ss);
    const float rn = rsqrtf(ss * (1.f / 64.f) + 1e-6f) * (1.f - lam_init);
    const int t = q0w + qt * 16 + l15;
    const size_t row = (size_t)b * SEQ + t;
#pragma unroll
    for (int d = 0; d < 4; ++d) {
      const int dd = d * 16 + 4 * g;
      const f32x4 v = res[d][qt];
      const u32x2 zz = *(const u32x2*)(proj + (size_t)t * NP + PB_Z + h * 64 + dd);
      const f32x4 gg = *(const f32x4*)(ng + dd);
      u32x2 w;
      w.x = pack2(v[0] * rn * gg[0] * siluf(bflo(zz.x)), v[1] * rn * gg[1] * siluf(bfhi(zz.x)));
      w.y = pack2(v[2] * rn * gg[2] * siluf(bflo(zz.y)), v[3] * rn * gg[3] * siluf(bfhi(zz.y)));
      *(u32x2*)(Y + row * 1024 + Y_B + h * 64 + dd) = w;
    }
  }
}

template <int NKS>
DI void qk_tile1(const u16* Ks, const bf16x8 (&qf)[NKS], f32x4 (&s)[4], int l15, int g) {
#pragma unroll
  for (int kt = 0; kt < 4; ++kt) {
    s[kt] = (f32x4){0.f, 0.f, 0.f, 0.f};
#pragma unroll
    for (int ks = 0; ks < NKS; ++ks) s[kt] = mfma16(ldfrag(Ks + (kt * 16 + l15) * KLD + ks * 32 + 8 * g), qf[ks], s[kt]);
  }
}
DI void pv_accum1(const f32x4 (&s)[4], const u16* Vs, f32x4 (&o)[4], int l15, int g) {
  const int tq = l15 >> 2, tp = l15 & 3;
#pragma unroll
  for (int kk = 0; kk < 2; ++kk) {
    u32x4 w;
    w.x = pack2(s[2 * kk][0], s[2 * kk][1]); w.y = pack2(s[2 * kk][2], s[2 * kk][3]);
    w.z = pack2(s[2 * kk + 1][0], s[2 * kk + 1][1]); w.w = pack2(s[2 * kk + 1][2], s[2 * kk + 1][3]);
    const bf16x8 pf = __builtin_bit_cast(bf16x8, w);
#pragma unroll
    for (int d = 0; d < 4; ++d) {
      const bf16x8 vf = cat4(tr_read(Vs + (kk * 32 + 4 * g + tq) * KLD + d * 16 + 4 * tp), tr_read(Vs + (kk * 32 + 16 + 4 * g + tq) * KLD + d * 16 + 4 * tp));
      o[d] = mfma16(vf, pf, o[d]);
    }
  }
}
DI void conv_silu_stage(const u16* projb, int col0, const float* cw, const float* cb, int chan0, int nchan, int t0, u16* dst, const float* rowscale, float cscale) {
  const int tid = otid(), ch = (tid & 7) * 8;
  float w[4][8], bias[8];
#pragma unroll
  for (int j = 0; j < 4; ++j)
#pragma unroll
    for (int i = 0; i < 8; ++i) w[j][i] = cw[j * nchan + chan0 + ch + i];
#pragma unroll
  for (int i = 0; i < 8; ++i) bias[i] = cb[chan0 + ch + i];
#pragma unroll 1
  for (int ps = 0; ps < 4; ++ps) {
    const int row = ps * 32 + (tid >> 3), t = t0 + row;
    float acc[8];
#pragma unroll
    for (int i = 0; i < 8; ++i) acc[i] = bias[i];
#pragma unroll
    for (int j = 0; j < 4; ++j) {
      const int tt = t - 3 + j;
      if (tt >= 0) {
        const u32x4 v = *(const u32x4*)(projb + (size_t)tt * NP + col0 + ch);
        acc[0] += w[j][0] * bflo(v.x); acc[1] += w[j][1] * bfhi(v.x); acc[2] += w[j][2] * bflo(v.y); acc[3] += w[j][3] * bfhi(v.y);
        acc[4] += w[j][4] * bflo(v.z); acc[5] += w[j][5] * bfhi(v.z); acc[6] += w[j][6] * bflo(v.w); acc[7] += w[j][7] * bfhi(v.w);
      }
    }
    const float rs = (rowscale ? rowscale[row] : 1.f) * cscale;
#pragma unroll
    for (int i = 0; i < 8; ++i) acc[i] = siluf(acc[i]) * rs;
    u32x4 o; o.x = pack2(acc[0], acc[1]); o.y = pack2(acc[2], acc[3]); o.z = pack2(acc[4], acc[5]); o.w = pack2(acc[6], acc[7]);
    *(u32x4*)(dst + row * KLD + ch) = o;
  }
}
DI float block_scan128_add(float v, float* tmp) {
  const int tid = otid(), lane = tid & 63;
  float x = v;
#pragma unroll
  for (int o = 1; o < 64; o <<= 1) { const float y = __shfl_up(x, o); if (lane >= o) x += y; }
  lds_barrier();
  if (tid == 63) tmp[0] = x;
  lds_barrier();
  if ((tid >> 6) == 1) x += tmp[0];
  return x;
}
DI float block_scan128_max(float v, float* tmp) {
  const int tid = otid(), lane = tid & 63;
  float x = v;
#pragma unroll
  for (int o = 1; o < 64; o <<= 1) { const float y = __shfl_up(x, o); if (lane >= o) x = fmaxf(x, y); }
  lds_barrier();
  if (tid == 63) tmp[0] = x;
  lds_barrier();
  if ((tid >> 6) == 1) x = fmaxf(x, tmp[0]);
  return x;
}
DI void scale_rows(u16* A, const float* rs) {
  const int tid = otid(), ch = (tid & 7) * 8;
#pragma unroll
  for (int ps = 0; ps < 4; ++ps) {
    const int row = ps * 32 + (tid >> 3);
    const float f = rs[row];
    u32x4 v = *(u32x4*)(A + row * KLD + ch);
    v.x = pack2(bflo(v.x) * f, bfhi(v.x) * f); v.y = pack2(bflo(v.y) * f, bfhi(v.y) * f);
    v.z = pack2(bflo(v.z) * f, bfhi(v.z) * f); v.w = pack2(bflo(v.w) * f, bfhi(v.w) * f);
    *(u32x4*)(A + row * KLD + ch) = v;
  }
}
DI void state_update(const u16* Xs, const u16* Bs, f32x4 (&acc)[4], int w, int l15, int g) {
  const int tq = l15 >> 2, tp = l15 & 3;
#pragma unroll
  for (int kk = 0; kk < 4; ++kk) {
    const bf16x8 af = cat4(tr_read(Xs + (kk * 32 + 4 * g + tq) * KLD + w * 16 + 4 * tp), tr_read(Xs + (kk * 32 + 16 + 4 * g + tq) * KLD + w * 16 + 4 * tp));
#pragma unroll
    for (int nt = 0; nt < 4; ++nt) {
      const bf16x8 bfr = cat4(tr_read(Bs + (kk * 32 + 4 * g + tq) * KLD + nt * 16 + 4 * tp), tr_read(Bs + (kk * 32 + 16 + 4 * g + tq) * KLD + nt * 16 + 4 * tp));
      acc[nt] = mfma16(af, bfr, acc[nt]);
    }
  }
}
DI void state_to_lds(u16* Ss, const f32x4 (&acc)[4], int w, int l15, int g) {
#pragma unroll
  for (int nt = 0; nt < 4; ++nt)
#pragma unroll
    for (int r = 0; r < 4; ++r) Ss[(w * 16 + 4 * g + r) * KLD + nt * 16 + l15] = f2bf(acc[nt][r]);
}

constexpr int SEQ_LDS_A = 0, SEQ_LDS_B = 128 * KLD * 2, SEQ_LDS_C = 2 * 128 * KLD * 2, SEQ_LDS_S = 3 * 128 * KLD * 2, SEQ_LDS_F = SEQ_LDS_S + 64 * KLD * 2;
constexpr int SEQ_LDS_HALO = SEQ_LDS_F + 4096;
constexpr int SEQ_LDS_CW = SEQ_LDS_HALO + 2 * 3 * 3 * 64 * 2;
struct RawRegs { u32x4 r[4]; };
DI void raw_load(const u16* projb, int col0, int t0, RawRegs& rr, int tid) {
#pragma unroll
  for (int i = 0; i < 4; ++i) rr.r[i] = *(const u32x4*)(projb + (size_t)(t0 + (tid >> 3) + 32 * i) * NP + col0 + (tid & 7) * 8);
}
DI void raw_store(u16* dst, u16* halo_next, const RawRegs& rr, int tid) {
#pragma unroll
  for (int i = 0; i < 4; ++i) *(u32x4*)(dst + ((tid >> 3) + 32 * i) * KLD + (tid & 7) * 8) = rr.r[i];
  if (halo_next && tid >= 232) *(u32x4*)(halo_next + ((tid >> 3) - 29) * 64 + (tid & 7) * 8) = rr.r[3];
}
DI void conv_from_lds(const u16* raw, const u16* halo, const float* wl, const float* rowscale, float cscale, u32x4 (&out)[4], int tid) {
  const int q = tid >> 3, ch = (tid & 7) * 8;
  u32x4 v[7];
#pragma unroll
  for (int k = 0; k < 7; ++k) { const int r = 4 * q - 3 + k; v[k] = r >= 0 ? *(const u32x4*)(raw + r * KLD + ch) : *(const u32x4*)(halo + (r + 3) * 64 + ch); }
  float w[5][8];
#pragma unroll
  for (int j = 0; j < 5; ++j) { const f32x4 w0 = *(const f32x4*)(wl + j * 64 + ch), w1 = *(const f32x4*)(wl + j * 64 + ch + 4);
    w[j][0] = w0[0]; w[j][1] = w0[1]; w[j][2] = w0[2]; w[j][3] = w0[3]; w[j][4] = w1[0]; w[j][5] = w1[1]; w[j][6] = w1[2]; w[j][7] = w1[3]; }
#pragma unroll
  for (int o = 0; o < 4; ++o) {
    float acc[8];
#pragma unroll
    for (int i = 0; i < 8; ++i) acc[i] = w[4][i];
#pragma unroll
    for (int j = 0; j < 4; ++j) {
      const u32x4 x = v[o + j];
      acc[0] += w[j][0] * bflo(x.x); acc[1] += w[j][1] * bfhi(x.x); acc[2] += w[j][2] * bflo(x.y); acc[3] += w[j][3] * bfhi(x.y);
      acc[4] += w[j][4] * bflo(x.z); acc[5] += w[j][5] * bfhi(x.z); acc[6] += w[j][6] * bflo(x.w); acc[7] += w[j][7] * bfhi(x.w);
    }
    const float rs = (rowscale ? rowscale[4 * q + o] : 1.f) * cscale;
#pragma unroll
    for (int i = 0; i < 8; ++i) acc[i] = siluf(acc[i]) * rs;
    out[o].x = pack2(acc[0], acc[1]); out[o].y = pack2(acc[2], acc[3]); out[o].z = pack2(acc[4], acc[5]); out[o].w = pack2(acc[6], acc[7]);
  }
}
DI void conv_write(u16* dst, const u32x4 (&out)[4], int tid) {
  const int q = tid >> 3, ch = (tid & 7) * 8;
#pragma unroll
  for (int o = 0; o < 4; ++o) *(u32x4*)(dst + (4 * q + o) * KLD + ch) = out[o];
}
DI void stage_conv_w(float* wl, const float* cw, const float* cb, int chan0, int nchan, int tid) {
  for (int i = tid; i < 320; i += 256) { const int j = i >> 6, cc = i & 63; wl[i] = j < 4 ? cw[j * nchan + chan0 + cc] : cb[chan0 + cc]; }
}
DI float wave_scan_add(float x, int lane) {
#pragma unroll
  for (int o = 1; o < 64; o <<= 1) { const float y = __shfl_up(x, o); if (lane >= o) x += y; }
  return x;
}
DI float wave_scan_max(float x, int lane) {
#pragma unroll
  for (int o = 1; o < 64; o <<= 1) { const float y = __shfl_up(x, o); if (lane >= o) x = fmaxf(x, y); }
  return x;
}

DI void ssd_task(const Params& p, int layer, int b, int h, unsigned char* smem) {
  u16* Cs = (u16*)(smem + SEQ_LDS_A); u16* Bs = (u16*)(smem + SEQ_LDS_B); u16* Xs = (u16*)(smem + SEQ_LDS_C); u16* Ss = (u16*)(smem + SEQ_LDS_S);
  float* fl = (float*)(smem + SEQ_LDS_F);
  float* dts = fl; float* acs = fl + 128; float* wend = fl + 256; float* tmp = fl + 384;
  u16* halo = (u16*)(smem + SEQ_LDS_HALO); float* cwl = (float*)(smem + SEQ_LDS_CW);
  int tid = otid(), lane = tid & 63, w = tid >> 6, l15 = lane & 15, g = lane >> 4;
  const int gi = h >> 1;
  const u16* projb = (const u16*)(p.ws + OFF_PROJ) + (size_t)b * SEQ * NP;
  const float* smb = (const float*)(p.ws + OFF_SMALL) + (size_t)b * SEQ * NSMALL;
  const float* cw = p.ssm_conv_w + layer * 4 * 512; const float* cb = p.ssm_conv_b + layer * 512;
  u16* Y = (u16*)(p.ws + OFF_H);
  const float a_h = -__expf(p.ssm_a_log[layer * 4 + h]), d_h = p.ssm_d[layer * 4 + h], dtb = p.ssm_dt_bias[layer * 4 + h];
  const int colB = PC_XBC + 256 + gi * 64, colC = PC_XBC + 384 + gi * 64, colX = PC_XBC + h * 64;
  f32x4 st[4];
#pragma unroll
  for (int nt = 0; nt < 4; ++nt) st[nt] = (f32x4){0.f, 0.f, 0.f, 0.f};
  lds_barrier();
  stage_conv_w(cwl, cw, cb, 256 + gi * 64, 512, tid);
  stage_conv_w(cwl + 320, cw, cb, 384 + gi * 64, 512, tid);
  stage_conv_w(cwl + 640, cw, cb, h * 64, 512, tid);
  for (int i = tid; i < 3 * 3 * 64; i += 256) halo[i] = 0;
  RawRegs rB, rC, rX; float dtraw = 0.f;
  raw_load(projb, colB, 0, rB, tid); raw_load(projb, colC, 0, rC, tid); raw_load(projb, colX, 0, rX, tid);
  if (tid < 128) dtraw = smb[(size_t)tid * NSMALL + SM_DT + h];
#pragma unroll 1
  for (int c = 0; c < 32; ++c) {
    const int t0 = c * 128;
    asm volatile("" : "+v"(tid)); lane = tid & 63; w = tid >> 6; l15 = lane & 15; g = lane >> 4;
    u16* hcur = halo + (c & 1) * 576; u16* hnext = halo + ((c + 1) & 1) * 576;
    float dtv = 0.f;
    if (tid < 128) { const float xr = dtraw + dtb; dtv = xr > 15.f ? xr : __logf(1.f + __expf(xr)); }
    float cs = wave_scan_add(dtv * a_h, lane);
    if (tid == 63) tmp[0] = cs;
    lds_barrier();
    if (w == 1) cs += tmp[0];
    if (tid < 128) { dts[tid] = dtv; acs[tid] = cs; }
    raw_store(Bs, hnext, rB, tid); raw_store(Cs, hnext + 192, rC, tid); raw_store(Xs, hnext + 384, rX, tid);
    lds_barrier();
    if (c + 1 < 32) {
      raw_load(projb, colB, t0 + 128, rB, tid); raw_load(projb, colC, t0 + 128, rC, tid);
      if (tid < 128) dtraw = smb[(size_t)(t0 + 128 + tid) * NSMALL + SM_DT + h];
    }
    {
      u32x4 o1[4], o2[4];
      conv_from_lds(Bs, hcur, cwl, nullptr, 1.f, o1, tid);
      lds_barrier();
      conv_write(Bs, o1, tid);
      conv_from_lds(Cs, hcur + 192, cwl + 320, nullptr, 1.f, o2, tid);
      lds_barrier();
      conv_write(Cs, o2, tid);
      conv_from_lds(Xs, hcur + 384, cwl + 640, dts, 1.f, o1, tid);
      lds_barrier();
      conv_write(Xs, o1, tid);
    }
    if (tid < 128) wend[tid] = __expf(acs[127] - acs[tid]);
    state_to_lds(Ss, st, w, l15, g);
    lds_barrier();
#pragma unroll 1
    for (int qt = 0; qt < 2; ++qt) {
      const int tl = 32 * w + qt * 16 + l15;
      bf16x8 cf[2];
#pragma unroll
      for (int ks = 0; ks < 2; ++ks) cf[ks] = ldfrag(Cs + tl * KLD + ks * 32 + 8 * g);
      f32x4 y[4];
#pragma unroll
      for (int d = 0; d < 4; ++d) y[d] = (f32x4){0.f, 0.f, 0.f, 0.f};
      const float at = acs[tl];
#pragma unroll 1
      for (int stl = 0; stl < 2; ++stl) {
        if (stl * 64 <= 32 * w + qt * 16 + 15) {
          f32x4 sc[4];
          qk_tile1<2>(Bs + stl * 64 * KLD, cf, sc, l15, g);
#pragma unroll
          for (int kt = 0; kt < 4; ++kt) {
            const f32x4 as = *(const f32x4*)(acs + stl * 64 + kt * 16 + 4 * g);
#pragma unroll
            for (int r = 0; r < 4; ++r) {
              const bool ok = stl * 64 + kt * 16 + 4 * g + r <= tl;
              sc[kt][r] = ok ? sc[kt][r] * __expf(at - as[r]) : 0.f;
            }
          }
          pv_accum1(sc, Xs + stl * 64 * KLD, y, l15, g);
        }
      }
      const float ea = __expf(at), dsk = d_h / dts[tl];
      const size_t row = (size_t)b * SEQ + t0 + tl;
#pragma unroll
      for (int d = 0; d < 4; ++d) {
        f32x4 yo = (f32x4){0.f, 0.f, 0.f, 0.f};
#pragma unroll
        for (int ks = 0; ks < 2; ++ks) yo = mfma16(ldfrag(Ss + (d * 16 + l15) * KLD + ks * 32 + 8 * g), cf[ks], yo);
        const u32x2 xv = *(const u32x2*)(Xs + tl * KLD + d * 16 + 4 * g);
        const f32x4 v = y[d] + yo * ea;
        u32x2 o; o.x = pack2(v[0] + dsk * bflo(xv.x), v[1] + dsk * bfhi(xv.x)); o.y = pack2(v[2] + dsk * bflo(xv.y), v[3] + dsk * bfhi(xv.y));
        *(u32x2*)(Y + row * 1024 + Y_C + h * 64 + d * 16 + 4 * g) = o;
      }
    }
    if (c + 1 < 32) raw_load(projb, colX, t0 + 128, rX, tid);
    lds_barrier();
    scale_rows(Xs, wend);
    lds_barrier();
    const float cd = __expf(acs[127]);
#pragma unroll
    for (int nt = 0; nt < 4; ++nt) st[nt] *= cd;
    state_update(Xs, Bs, st, w, l15, g);
  }
}
DI void seq_fix_rows(const Params& p, int layer, int r0, int nrows) {
  u16* Y = (u16*)(p.ws + OFF_H);
  const u16* proj = (const u16*)(p.ws + OFF_PROJ);
  const int tid = otid(), lane = tid & 63, wv = tid >> 6;
  const bool ml = lane >= 32;
  const int ch = (lane & 31) * 8;
  const float* ng = ml ? p.ml_norm_g + layer * 64 + (ch & 63) : p.ssm_norm_g + layer * 256 + ch;
  const f32x4 g0 = *(const f32x4*)ng, g1 = *(const f32x4*)(ng + 4);
  for (int rb = wv * 4; rb < nrows; rb += 16) {
    u32x4 yv4[4], zv4[4], ov4[4];
#pragma unroll
    for (int j = 0; j < 4; ++j) {
      const size_t row = (size_t)(r0 + rb + j);
      yv4[j] = *(const u32x4*)(Y + row * 1024 + (ml ? Y_D : Y_C) + ch);
      zv4[j] = *(const u32x4*)(proj + row * NP + (ml ? PD_Z : PC_Z) + ch);
      ov4[j] = ml ? *(const u32x4*)(proj + row * NP + PD_O + ch) : (u32x4){0u, 0u, 0u, 0u};
    }
#pragma unroll
    for (int j = 0; j < 4; ++j) {
      const size_t row = (size_t)(r0 + rb + j);
      u16* yp = Y + row * 1024 + (ml ? Y_D : Y_C) + ch;
      const u32x4 yv = yv4[j], zv = zv4[j], ov = ov4[j];
      float v[8] = {bflo(yv.x), bfhi(yv.x), bflo(yv.y), bfhi(yv.y), bflo(yv.z), bfhi(yv.z), bflo(yv.w), bfhi(yv.w)};
      float z[8] = {bflo(zv.x), bfhi(zv.x), bflo(zv.y), bfhi(zv.y), bflo(zv.z), bfhi(zv.z), bflo(zv.w), bfhi(zv.w)};
      float ss = 0.f;
      if (ml) {
        const float o[8] = {bflo(ov.x), bfhi(ov.x), bflo(ov.y), bfhi(ov.y), bflo(ov.z), bfhi(ov.z), bflo(ov.w), bfhi(ov.w)};
#pragma unroll
        for (int i = 0; i < 8; ++i) { v[i] *= sigmoidf_(o[i]); ss += v[i] * v[i]; }
      } else {
#pragma unroll
        for (int i = 0; i < 8; ++i) { v[i] *= siluf(z[i]); ss += v[i] * v[i]; }
      }
      ss += __shfl_xor(ss, 1); ss += __shfl_xor(ss, 2); ss += __shfl_xor(ss, 4);
      const float ss16 = ss + __shfl_xor(ss, 8);
      const float rn = ml ? rsqrtf(ss * (1.f / 64.f) + 1e-6f) : rsqrtf(ss16 * (1.f / 128.f) + 1e-6f);
      float o8[8];
#pragma unroll
      for (int i = 0; i < 8; ++i) { const float gg = i < 4 ? g0[i & 3] : g1[i & 3]; o8[i] = v[i] * rn * gg * (ml ? siluf(z[i]) : 1.f); }
      u32x4 w; w.x = pack2(o8[0], o8[1]); w.y = pack2(o8[2], o8[3]); w.z = pack2(o8[4], o8[5]); w.w = pack2(o8[6], o8[7]);
      *(u32x4*)yp = w;
    }
  }
}

DI void mlstm_task(const Params& p, int layer, int b, int h, unsigned char* smem) {
  u16* Qs = (u16*)(smem + SEQ_LDS_A); u16* Ks2 = (u16*)(smem + SEQ_LDS_B); u16* Vs2 = (u16*)(smem + SEQ_LDS_C); u16* Cst = (u16*)(smem + SEQ_LDS_S);
  float* fl = (float*)(smem + SEQ_LDS_F);
  float* bcs = fl; float* us = fl + 128; float* pms = fl + 256; float* wend = fl + 384; float* nst = fl + 512; float* npart = fl + 576; float* tmp = fl + 832;
  u16* halo = (u16*)(smem + SEQ_LDS_HALO); float* cwl = (float*)(smem + SEQ_LDS_CW);
  int tid = otid(), lane = tid & 63, w = tid >> 6, l15 = lane & 15, g = lane >> 4;
  const u16* projb = (const u16*)(p.ws + OFF_PROJ) + (size_t)b * SEQ * NP;
  const float* smb = (const float*)(p.ws + OFF_SMALL) + (size_t)b * SEQ * NSMALL;
  const float* cw = p.ml_conv_w + layer * 4 * 512; const float* cb = p.ml_conv_b + layer * 512;
  const float ib = p.ml_if_b[layer * 8 + h], fb = p.ml_if_b[layer * 8 + 4 + h];
  u16* Y = (u16*)(p.ws + OFF_H);
  const int colQ = PD_QK + h * 64, colK = PD_QK + 256 + h * 64, colV = PD_V + h * 64;
  f32x4 st[4];
#pragma unroll
  for (int nt = 0; nt < 4; ++nt) st[nt] = (f32x4){0.f, 0.f, 0.f, 0.f};
  float m_prev = 0.f;
  lds_barrier();
  if (tid < 64) nst[tid] = 0.f;
  stage_conv_w(cwl, cw, cb, h * 64, 512, tid);
  stage_conv_w(cwl + 320, cw, cb, 256 + h * 64, 512, tid);
  for (int i = tid; i < 3 * 3 * 64; i += 256) halo[i] = 0;
  RawRegs rQ, rK, rV; float iraw = 0.f, fraw = 0.f;
  raw_load(projb, colQ, 0, rQ, tid); raw_load(projb, colK, 0, rK, tid); raw_load(projb, colV, 0, rV, tid);
  if (tid < 128) { iraw = smb[(size_t)tid * NSMALL + SM_IF + h]; fraw = smb[(size_t)tid * NSMALL + SM_IF + 4 + h]; }
#pragma unroll 1
  for (int c = 0; c < 32; ++c) {
    const int t0 = c * 128;
    asm volatile("" : "+v"(tid)); lane = tid & 63; w = tid >> 6; l15 = lane & 15; g = lane >> 4;
    u16* hcur = halo + (c & 1) * 576; u16* hnext = halo + ((c + 1) & 1) * 576;
    float ip = 0.f, lf = 0.f;
    if (tid < 128) { ip = iraw + ib; const float fp = fraw + fb; lf = fminf(fp, 0.f) - __logf(1.f + __expf(-fabsf(fp))); }
    float bc = wave_scan_add(lf, lane);
    if (tid == 63) tmp[0] = bc;
    lds_barrier();
    if (w == 1) bc += tmp[0];
    const float u = tid < 128 ? ip - bc : -1e30f;
    float pm = wave_scan_max(u, lane);
    if (tid == 63) tmp[1] = pm;
    raw_store(Qs, hnext, rQ, tid); raw_store(Ks2, hnext + 192, rK, tid); raw_store(Vs2, nullptr, rV, tid);
    lds_barrier();
    if (w == 1) pm = fmaxf(pm, tmp[1]);
    if (tid < 128) { bcs[tid] = bc; us[tid] = u; pms[tid] = pm; }
    if (c + 1 < 32) {
      raw_load(projb, colQ, t0 + 128, rQ, tid);
      if (tid < 128) { iraw = smb[(size_t)(t0 + 128 + tid) * NSMALL + SM_IF + h]; fraw = smb[(size_t)(t0 + 128 + tid) * NSMALL + SM_IF + 4 + h]; }
    }
    u32x4 oQ[4], oK[4];
    conv_from_lds(Qs, hcur, cwl, nullptr, 1.f, oQ, tid);
    __builtin_amdgcn_sched_barrier(0);
    conv_from_lds(Ks2, hcur + 192, cwl + 320, nullptr, 0.125f, oK, tid);
    __builtin_amdgcn_sched_barrier(0);
    lds_barrier();
    conv_write(Qs, oQ, tid); conv_write(Ks2, oK, tid);
    state_to_lds(Cst, st, w, l15, g);
    const float blast = bcs[127];
    const float m_new = blast + fmaxf(m_prev, pms[127]);
    if (tid < 128) wend[tid] = __expf(blast - m_new + us[tid]);
    lds_barrier();
#pragma unroll 1
    for (int qt = 0; qt < 2; ++qt) {
      const int tl = 32 * w + qt * 16 + l15;
      bf16x8 qf[2];
#pragma unroll
      for (int ks = 0; ks < 2; ++ks) qf[ks] = ldfrag(Qs + tl * KLD + ks * 32 + 8 * g);
      f32x4 num[4];
#pragma unroll
      for (int d = 0; d < 4; ++d) num[d] = (f32x4){0.f, 0.f, 0.f, 0.f};
      const float bt = bcs[tl], mt = bt + fmaxf(m_prev, pms[tl]);
      float den = 0.f;
#pragma unroll 1
      for (int stl = 0; stl < 2; ++stl) {
        if (stl * 64 <= 32 * w + qt * 16 + 15) {
          f32x4 sc[4];
          qk_tile1<2>(Ks2 + stl * 64 * KLD, qf, sc, l15, g);
#pragma unroll
          for (int kt = 0; kt < 4; ++kt) {
            const f32x4 uu = *(const f32x4*)(us + stl * 64 + kt * 16 + 4 * g);
#pragma unroll
            for (int r = 0; r < 4; ++r) {
              const bool ok = stl * 64 + kt * 16 + 4 * g + r <= tl;
              const float v = ok ? sc[kt][r] * __expf(bt - mt + uu[r]) : 0.f;
              sc[kt][r] = v; den += v;
            }
          }
          pv_accum1(sc, Vs2 + stl * 64 * KLD, num, l15, g);
        }
      }
      const float wi = __expf(bt + m_prev - mt);
      float qn = 0.f;
#pragma unroll
      for (int ks = 0; ks < 2; ++ks)
#pragma unroll
        for (int j = 0; j < 8; ++j) qn += bf2f((u16)qf[ks][j]) * nst[ks * 32 + 8 * g + j];
      qn = group_sum4(qn);
      const float dn = group_sum4(den) + wi * qn;
      const float inv = __builtin_amdgcn_rcpf(fmaxf(fabsf(dn), __expf(-mt)));
      const size_t row = (size_t)b * SEQ + t0 + tl;
#pragma unroll
      for (int d = 0; d < 4; ++d) {
        f32x4 ni = (f32x4){0.f, 0.f, 0.f, 0.f};
#pragma unroll
        for (int ks = 0; ks < 2; ++ks) ni = mfma16(ldfrag(Cst + (d * 16 + l15) * KLD + ks * 32 + 8 * g), qf[ks], ni);
        const f32x4 v = (num[d] + ni * wi) * inv;
        u32x2 o; o.x = pack2(v[0], v[1]); o.y = pack2(v[2], v[3]);
        *(u32x2*)(Y + row * 1024 + Y_D + h * 64 + d * 16 + 4 * g) = o;
      }
    }
    if (c + 1 < 32) { raw_load(projb, colK, t0 + 128, rK, tid); raw_load(projb, colV, t0 + 128, rV, tid); }
    lds_barrier();
    scale_rows(Ks2, wend);
    lds_barrier();
    const float fprev = __expf(blast + m_prev - m_new);
#pragma unroll
    for (int nt = 0; nt < 4; ++nt) st[nt] *= fprev;
    state_update(Vs2, Ks2, st, w, l15, g);
    {
      const int e = tid & 63, part = tid >> 6;
      float a = 0.f;
      for (int s2 = part * 32; s2 < part * 32 + 32; ++s2) a += bf2f(Ks2[s2 * KLD + e]);
      npart[part * 64 + e] = a;
    }
    lds_barrier();
    if (tid < 64) nst[tid] = nst[tid] * fprev + npart[tid] + npart[64 + tid] + npart[128 + tid] + npart[192 + tid];
    m_prev = m_new;
  }
}

constexpr int SEQ8_LDS_F = SEQ_LDS_S + 64 * KLD * 2;
constexpr int SEQ8_LDS_HALO = SEQ8_LDS_F + 8192;
constexpr int SEQ8_LDS_CW = SEQ8_LDS_HALO + 2 * 3 * 3 * 64 * 2;
struct RawRegs2 { u32x4 r[2]; };
DI void raw_load8(const u16* projb, int col0, int t0, RawRegs2& rr, int tid) {
#pragma unroll
  for (int i = 0; i < 2; ++i) rr.r[i] = *(const u32x4*)(projb + (size_t)(t0 + (tid >> 3) + 64 * i) * NP + col0 + (tid & 7) * 8);
}
DI void raw_store8(u16* dst, u16* halo_next, const RawRegs2& rr, int tid) {
#pragma unroll
  for (int i = 0; i < 2; ++i) *(u32x4*)(dst + ((tid >> 3) + 64 * i) * KLD + (tid & 7) * 8) = rr.r[i];
  if (halo_next && tid >= 488) *(u32x4*)(halo_next + ((tid >> 3) - 61) * 64 + (tid & 7) * 8) = rr.r[1];
}
DI void conv_from_lds8(const u16* raw, const u16* halo, const float* wl, const float* rowscale, float cscale, u32x4 (&out)[2], int tid) {
  const int q = tid >> 3, ch = (tid & 7) * 8;
  u32x4 v[5];
#pragma unroll
  for (int k = 0; k < 5; ++k) { const int r = 2 * q - 3 + k; v[k] = r >= 0 ? *(const u32x4*)(raw + r * KLD + ch) : *(const u32x4*)(halo + (r + 3) * 64 + ch); }
  float w[5][8];
#pragma unroll
  for (int j = 0; j < 5; ++j) { const f32x4 w0 = *(const f32x4*)(wl + j * 64 + ch), w1 = *(const f32x4*)(wl + j * 64 + ch + 4);
    w[j][0] = w0[0]; w[j][1] = w0[1]; w[j][2] = w0[2]; w[j][3] = w0[3]; w[j][4] = w1[0]; w[j][5] = w1[1]; w[j][6] = w1[2]; w[j][7] = w1[3]; }
#pragma unroll
  for (int o = 0; o < 2; ++o) {
    float acc[8];
#pragma unroll
    for (int i = 0; i < 8; ++i) acc[i] = w[4][i];
#pragma unroll
    for (int j = 0; j < 4; ++j) {
      const u32x4 x = v[o + j];
      acc[0] += w[j][0] * bflo(x.x); acc[1] += w[j][1] * bfhi(x.x); acc[2] += w[j][2] * bflo(x.y); acc[3] += w[j][3] * bfhi(x.y);
      acc[4] += w[j][4] * bflo(x.z); acc[5] += w[j][5] * bfhi(x.z); acc[6] += w[j][6] * bflo(x.w); acc[7] += w[j][7] * bfhi(x.w);
    }
    const float rs = (rowscale ? rowscale[2 * q + o] : 1.f) * cscale;
#pragma unroll
    for (int i = 0; i < 8; ++i) acc[i] = siluf(acc[i]) * rs;
    out[o].x = pack2(acc[0], acc[1]); out[o].y = pack2(acc[2], acc[3]); out[o].z = pack2(acc[4], acc[5]); out[o].w = pack2(acc[6], acc[7]);
  }
}
DI void conv_write8(u16* dst, const u32x4 (&out)[2], int tid) {
  const int q = tid >> 3, ch = (tid & 7) * 8;
#pragma unroll
  for (int o = 0; o < 2; ++o) *(u32x4*)(dst + (2 * q + o) * KLD + ch) = out[o];
}
DI void stage_conv_w8(float* wl, const float* cw, const float* cb, int chan0, int nchan, int tid) {
  if (tid < 320) { const int j = tid >> 6, cc = tid & 63; wl[tid] = j < 4 ? cw[j * nchan + chan0 + cc] : cb[chan0 + cc]; }
}
DI void scale_rows8(u16* A, const float* rs, int tid) {
  const int ch = (tid & 7) * 8;
#pragma unroll
  for (int i = 0; i < 2; ++i) {
    const int row = (tid >> 3) + 64 * i;
    const float f = rs[row];
    u32x4 v = *(u32x4*)(A + row * KLD + ch);
    v.x = pack2(bflo(v.x) * f, bfhi(v.x) * f); v.y = pack2(bflo(v.y) * f, bfhi(v.y) * f);
    v.z = pack2(bflo(v.z) * f, bfhi(v.z) * f); v.w = pack2(bflo(v.w) * f, bfhi(v.w) * f);
    *(u32x4*)(A + row * KLD + ch) = v;
  }
}
DI void state_update8(const u16* Xs, const u16* Bs, f32x4 (&acc)[2], int w8, int l15, int g) {
  const int tq = l15 >> 2, tp = l15 & 3, pt = w8 >> 1, nt0 = (w8 & 1) * 2;
#pragma unroll
  for (int kk = 0; kk < 4; ++kk) {
    const bf16x8 af = cat4(tr_read(Xs + (kk * 32 + 4 * g + tq) * KLD + pt * 16 + 4 * tp), tr_read(Xs + (kk * 32 + 16 + 4 * g + tq) * KLD + pt * 16 + 4 * tp));
#pragma unroll
    for (int n = 0; n < 2; ++n) {
      const bf16x8 bfr = cat4(tr_read(Bs + (kk * 32 + 4 * g + tq) * KLD + (nt0 + n) * 16 + 4 * tp), tr_read(Bs + (kk * 32 + 16 + 4 * g + tq) * KLD + (nt0 + n) * 16 + 4 * tp));
      acc[n] = mfma16(af, bfr, acc[n]);
    }
  }
}
DI void state_to_lds8(u16* Ss, const f32x4 (&acc)[2], int w8, int l15, int g) {
  const int pt = w8 >> 1, nt0 = (w8 & 1) * 2;
#pragma unroll
  for (int n = 0; n < 2; ++n)
#pragma unroll
    for (int r = 0; r < 4; ++r) Ss[(pt * 16 + 4 * g + r) * KLD + (nt0 + n) * 16 + l15] = f2bf(acc[n][r]);
}

constexpr int SEQ8_LDS_ZERO = SEQ8_LDS_CW + 3 * 320 * 4;
constexpr int SEQ8_LDS_RAW = ((SEQ8_LDS_ZERO + 3 * 128 + 255) / 256) * 256;
DI void raw_dma8(const u16* projb, int col0, int t0, u16* raw, int tid) {
#pragma unroll
  for (int i = 0; i < 2; ++i) {
    const int chunk = tid + 512 * i;
    __builtin_amdgcn_global_load_lds((const unsigned*)(projb + (size_t)(t0 + (chunk >> 3)) * NP + col0 + (chunk & 7) * 8), (LDSP unsigned*)((LDSP char*)raw + chunk * 16), 16, 0, 0);
  }
}
DI void conv_raw8(const u16* raw, const u16* halo, const float* wl, const float* rowscale, float cscale, u16* dst, int tid) {
  const int q = tid >> 3, ch = (tid & 7) * 8;
  u32x4 v[5];
#pragma unroll
  for (int k = 0; k < 5; ++k) { const int r = 2 * q - 3 + k; v[k] = r >= 0 ? *(const u32x4*)(raw + r * 64 + ch) : *(const u32x4*)(halo + (r + 3) * 64 + ch); }
  float w[5][8];
#pragma unroll
  for (int j = 0; j < 5; ++j) { const f32x4 w0 = *(const f32x4*)(wl + j * 64 + ch), w1 = *(const f32x4*)(wl + j * 64 + ch + 4);
    w[j][0] = w0[0]; w[j][1] = w0[1]; w[j][2] = w0[2]; w[j][3] = w0[3]; w[j][4] = w1[0]; w[j][5] = w1[1]; w[j][6] = w1[2]; w[j][7] = w1[3]; }
#pragma unroll
  for (int o = 0; o < 2; ++o) {
    float acc[8];
#pragma unroll
    for (int i = 0; i < 8; ++i) acc[i] = w[4][i];
#pragma unroll
    for (int j = 0; j < 4; ++j) {
      const u32x4 x = v[o + j];
      acc[0] += w[j][0] * bflo(x.x); acc[1] += w[j][1] * bfhi(x.x); acc[2] += w[j][2] * bflo(x.y); acc[3] += w[j][3] * bfhi(x.y);
      acc[4] += w[j][4] * bflo(x.z); acc[5] += w[j][5] * bfhi(x.z); acc[6] += w[j][6] * bflo(x.w); acc[7] += w[j][7] * bfhi(x.w);
    }
    const float rs = (rowscale ? rowscale[2 * q + o] : 1.f) * cscale;
#pragma unroll
    for (int i = 0; i < 8; ++i) acc[i] = siluf(acc[i]) * rs;
    u32x4 ov; ov.x = pack2(acc[0], acc[1]); ov.y = pack2(acc[2], acc[3]); ov.z = pack2(acc[4], acc[5]); ov.w = pack2(acc[6], acc[7]);
    *(u32x4*)(dst + (2 * q + o) * KLD + ch) = ov;
  }
}
DI void save_halo8(const u16* raw, u16* halo, int tid) {
  if (tid < 72) { const int arr = tid / 24, rem = tid % 24; *(u32x4*)(halo + arr * 192 + rem * 8) = *(const u32x4*)(raw + arr * 8192 + 125 * 64 + rem * 8); }
}

DI void ssd_task8(const Params& p, int layer, int b, int h, unsigned char* smem) {
  u16* Cs = (u16*)(smem + SEQ_LDS_A); u16* Bs = (u16*)(smem + SEQ_LDS_B); u16* Xs = (u16*)(smem + SEQ_LDS_C); u16* Ss = (u16*)(smem + SEQ_LDS_S);
  float* fl = (float*)(smem + SEQ8_LDS_F);
  float* dts = fl; float* acs = fl + 128; float* wend = fl + 256; float* tmp = fl + 384;
  u16* halo = (u16*)(smem + SEQ8_LDS_HALO); float* cwl = (float*)(smem + SEQ8_LDS_CW); u16* zero3 = (u16*)(smem + SEQ8_LDS_ZERO);
  u16* raw = (u16*)(smem + SEQ8_LDS_RAW);
  int tid = otid512(), lane = tid & 63, w = tid >> 6, l15 = lane & 15, g = lane >> 4;
  const int gi = h >> 1;
  const u16* projb = (const u16*)(p.ws + OFF_PROJ) + (size_t)b * SEQ * NP;
  const float* smb = (const float*)(p.ws + OFF_SMALL) + (size_t)b * SEQ * NSMALL;
  const float* cw = p.ssm_conv_w + layer * 4 * 512; const float* cb = p.ssm_conv_b + layer * 512;
  u16* Y = (u16*)(p.ws + OFF_H);
  const float a_h = sgprf(-__expf(p.ssm_a_log[layer * 4 + h])), d_h = sgprf(p.ssm_d[layer * 4 + h]), dtb = sgprf(p.ssm_dt_bias[layer * 4 + h]);
  const int colB = PC_XBC + 256 + gi * 64, colC = PC_XBC + 384 + gi * 64, colX = PC_XBC + h * 64;
  f32x4 st[2] = {(f32x4){0.f, 0.f, 0.f, 0.f}, (f32x4){0.f, 0.f, 0.f, 0.f}};
  lds_barrier();
  stage_conv_w8(cwl, cw, cb, 256 + gi * 64, 512, tid);
  stage_conv_w8(cwl + 320, cw, cb, 384 + gi * 64, 512, tid);
  stage_conv_w8(cwl + 640, cw, cb, h * 64, 512, tid);
  if (tid < 96) ((unsigned*)zero3)[tid] = 0u;
  raw_dma8(projb, colB, 0, raw, tid); raw_dma8(projb, colC, 0, raw + 8192, tid); raw_dma8(projb, colX, 0, raw + 16384, tid);
  float dtraw = 0.f;
  if (tid < 128) dtraw = smb[(size_t)tid * NSMALL + SM_DT + h];
#pragma unroll 1
  for (int c = 0; c < 32; ++c) {
    const int t0 = c * 128;
    asm volatile("" : "+v"(tid)); lane = tid & 63; w = tid >> 6; l15 = lane & 15; g = lane >> 4;
    float dtv = 0.f;
    if (tid < 128) { const float xr = dtraw + dtb; dtv = xr > 15.f ? xr : __logf(1.f + __expf(xr)); }
    float cs = wave_scan_add(dtv * a_h, lane);
    if (tid == 63) tmp[0] = cs;
    asm volatile("s_waitcnt vmcnt(0)" ::: "memory");
    lds_barrier();
    if (w == 1) cs += tmp[0];
    if (tid < 128) { dts[tid] = dtv; acs[tid] = cs; }
    if (c + 1 < 32 && tid < 128) dtraw = smb[(size_t)(t0 + 128 + tid) * NSMALL + SM_DT + h];
    lds_barrier();
    {
      const u16* hc = halo + (c & 1) * 576;
      const u16* hB = c == 0 ? zero3 : hc; const u16* hC = c == 0 ? zero3 : hc + 192; const u16* hX = c == 0 ? zero3 : hc + 384;
      conv_raw8(raw, hB, cwl, nullptr, 1.f, Bs, tid);
      conv_raw8(raw + 8192, hC, cwl + 320, nullptr, 1.f, Cs, tid);
      conv_raw8(raw + 16384, hX, cwl + 640, dts, 1.f, Xs, tid);
      save_halo8(raw, halo + ((c + 1) & 1) * 576, tid);
    }
    if (tid < 128) wend[tid] = __expf(acs[127] - acs[tid]);
    state_to_lds8(Ss, st, w, l15, g);
    lds_barrier();
    if (c + 1 < 32) { raw_dma8(projb, colB, t0 + 128, raw, tid); raw_dma8(projb, colC, t0 + 128, raw + 8192, tid); raw_dma8(projb, colX, t0 + 128, raw + 16384, tid); }
    {
      const int tl = 16 * w + l15;
      bf16x8 cf[2];
#pragma unroll
      for (int ks = 0; ks < 2; ++ks) cf[ks] = ldfrag(Cs + tl * KLD + ks * 32 + 8 * g);
      f32x4 y[4];
#pragma unroll
      for (int d = 0; d < 4; ++d) y[d] = (f32x4){0.f, 0.f, 0.f, 0.f};
      const float at = acs[tl];
#pragma unroll 1
      for (int stl = 0; stl < 2; ++stl) {
        if (stl * 64 <= 16 * w + 15) {
          f32x4 sc[4];
          qk_tile1<2>(Bs + stl * 64 * KLD, cf, sc, l15, g);
#pragma unroll
          for (int kt = 0; kt < 4; ++kt) {
            const f32x4 as = *(const f32x4*)(acs + stl * 64 + kt * 16 + 4 * g);
#pragma unroll
            for (int r = 0; r < 4; ++r) {
              const bool ok = stl * 64 + kt * 16 + 4 * g + r <= tl;
              sc[kt][r] = ok ? sc[kt][r] * __expf(at - as[r]) : 0.f;
            }
          }
          pv_accum1(sc, Xs + stl * 64 * KLD, y, l15, g);
        }
      }
      const float ea = __expf(at), dsk = d_h / dts[tl];
      const size_t row = (size_t)b * SEQ + t0 + tl;
#pragma unroll
      for (int d = 0; d < 4; ++d) {
        f32x4 yo = (f32x4){0.f, 0.f, 0.f, 0.f};
#pragma unroll
        for (int ks = 0; ks < 2; ++ks) yo = mfma16(ldfrag(Ss + (d * 16 + l15) * KLD + ks * 32 + 8 * g), cf[ks], yo);
        const u32x2 xv = *(const u32x2*)(Xs + tl * KLD + d * 16 + 4 * g);
        const f32x4 v = y[d] + yo * ea;
        u32x2 o; o.x = pack2(v[0] + dsk * bflo(xv.x), v[1] + dsk * bfhi(xv.x)); o.y = pack2(v[2] + dsk * bflo(xv.y), v[3] + dsk * bfhi(xv.y));
        *(u32x2*)(Y + row * 1024 + Y_C + h * 64 + d * 16 + 4 * g) = o;
      }
    }
    lds_barrier();
    scale_rows8(Xs, wend, tid);
    lds_barrier();
    const float cd = __expf(acs[127]);
    st[0] *= cd; st[1] *= cd;
    state_update8(Xs, Bs, st, w, l15, g);
  }
  asm volatile("s_waitcnt vmcnt(0)" ::: "memory");
}

DI void mlstm_task8(const Params& p, int layer, int b, int h, unsigned char* smem) {
  u16* Qs = (u16*)(smem + SEQ_LDS_A); u16* Ks2 = (u16*)(smem + SEQ_LDS_B); u16* Vs2 = (u16*)(smem + SEQ_LDS_C); u16* Cst = (u16*)(smem + SEQ_LDS_S);
  float* fl = (float*)(smem + SEQ8_LDS_F);
  float* bcs = fl; float* us = fl + 128; float* pms = fl + 256; float* wend = fl + 384; float* nst = fl + 512; float* tmp = fl + 576; float* npart = fl + 640;
  u16* halo = (u16*)(smem + SEQ8_LDS_HALO); float* cwl = (float*)(smem + SEQ8_LDS_CW); u16* zero3 = (u16*)(smem + SEQ8_LDS_ZERO);
  u16* raw = (u16*)(smem + SEQ8_LDS_RAW);
  int tid = otid512(), lane = tid & 63, w = tid >> 6, l15 = lane & 15, g = lane >> 4;
  const u16* projb = (const u16*)(p.ws + OFF_PROJ) + (size_t)b * SEQ * NP;
  const float* smb = (const float*)(p.ws + OFF_SMALL) + (size_t)b * SEQ * NSMALL;
  const float* cw = p.ml_conv_w + layer * 4 * 512; const float* cb = p.ml_conv_b + layer * 512;
  const float ib = sgprf(p.ml_if_b[layer * 8 + h]), fb = sgprf(p.ml_if_b[layer * 8 + 4 + h]);
  u16* Y = (u16*)(p.ws + OFF_H);
  const int colQ = PD_QK + h * 64, colK = PD_QK + 256 + h * 64, colV = PD_V + h * 64;
  f32x4 st[2] = {(f32x4){0.f, 0.f, 0.f, 0.f}, (f32x4){0.f, 0.f, 0.f, 0.f}};
  float m_prev = 0.f;
  lds_barrier();
  if (tid < 64) nst[tid] = 0.f;
  stage_conv_w8(cwl, cw, cb, h * 64, 512, tid);
  stage_conv_w8(cwl + 320, cw, cb, 256 + h * 64, 512, tid);
  if (tid < 96) ((unsigned*)zero3)[tid] = 0u;
  raw_dma8(projb, colQ, 0, raw, tid); raw_dma8(projb, colK, 0, raw + 8192, tid); raw_dma8(projb, colV, 0, raw + 16384, tid);
  float iraw = 0.f, fraw = 0.f;
  if (tid < 128) { iraw = smb[(size_t)tid * NSMALL + SM_IF + h]; fraw = smb[(size_t)tid * NSMALL + SM_IF + 4 + h]; }
#pragma unroll 1
  for (int c = 0; c < 32; ++c) {
    const int t0 = c * 128;
    asm volatile("" : "+v"(tid)); lane = tid & 63; w = tid >> 6; l15 = lane & 15; g = lane >> 4;
    float ip = 0.f, lf = 0.f;
    if (tid < 128) { ip = iraw + ib; const float fp = fraw + fb; lf = fminf(fp, 0.f) - __logf(1.f + __expf(-fabsf(fp))); }
    float bc = wave_scan_add(lf, lane);
    if (tid == 63) tmp[0] = bc;
    asm volatile("s_waitcnt vmcnt(0)" ::: "memory");
    lds_barrier();
    if (w == 1) bc += tmp[0];
    const float u = tid < 128 ? ip - bc : -1e30f;
    float pm = wave_scan_max(u, lane);
    if (tid == 63) tmp[1] = pm;
    if (c + 1 < 32 && tid < 128) { iraw = smb[(size_t)(t0 + 128 + tid) * NSMALL + SM_IF + h]; fraw = smb[(size_t)(t0 + 128 + tid) * NSMALL + SM_IF + 4 + h]; }
    {
      const u16* hc = halo + (c & 1) * 576;
      const u16* hQ = c == 0 ? zero3 : hc; const u16* hK = c == 0 ? zero3 : hc + 192;
      conv_raw8(raw, hQ, cwl, nullptr, 1.f, Qs, tid);
      conv_raw8(raw + 8192, hK, cwl + 320, nullptr, 0.125f, Ks2, tid);
      save_halo8(raw, halo + ((c + 1) & 1) * 576, tid);
#pragma unroll
      for (int i = 0; i < 2; ++i) { const int chunk = tid + 512 * i; *(u32x4*)(Vs2 + (chunk >> 3) * KLD + (chunk & 7) * 8) = *(const u32x4*)(raw + 16384 + chunk * 8); }
    }
    state_to_lds8(Cst, st, w, l15, g);
    lds_barrier();
    if (w == 1) pm = fmaxf(pm, tmp[1]);
    if (tid < 128) { bcs[tid] = bc; us[tid] = u; pms[tid] = pm; }
    if (c + 1 < 32) { raw_dma8(projb, colQ, t0 + 128, raw, tid); raw_dma8(projb, colK, t0 + 128, raw + 8192, tid); raw_dma8(projb, colV, t0 + 128, raw + 16384, tid); }
    lds_barrier();
    const float blast = bcs[127];
    const float m_new = blast + fmaxf(m_prev, pms[127]);
    if (tid < 128) wend[tid] = __expf(blast - m_new + us[tid]);
    {
      const int tl = 16 * w + l15;
      bf16x8 qf[2];
#pragma unroll
      for (int ks = 0; ks < 2; ++ks) qf[ks] = ldfrag(Qs + tl * KLD + ks * 32 + 8 * g);
      f32x4 num[4];
#pragma unroll
      for (int d = 0; d < 4; ++d) num[d] = (f32x4){0.f, 0.f, 0.f, 0.f};
      const float bt = bcs[tl], mt = bt + fmaxf(m_prev, pms[tl]);
      float den = 0.f;
#pragma unroll 1
      for (int stl = 0; stl < 2; ++stl) {
        if (stl * 64 <= 16 * w + 15) {
          f32x4 sc[4];
          qk_tile1<2>(Ks2 + stl * 64 * KLD, qf, sc, l15, g);
#pragma unroll
          for (int kt = 0; kt < 4; ++kt) {
            const f32x4 uu = *(const f32x4*)(us + stl * 64 + kt * 16 + 4 * g);
#pragma unroll
            for (int r = 0; r < 4; ++r) {
              const bool ok = stl * 64 + kt * 16 + 4 * g + r <= tl;
              const float v = ok ? sc[kt][r] * __expf(bt - mt + uu[r]) : 0.f;
              sc[kt][r] = v; den += v;
            }
          }
          pv_accum1(sc, Vs2 + stl * 64 * KLD, num, l15, g);
        }
      }
      const float wi = __expf(bt + m_prev - mt);
      float qn = 0.f;
#pragma unroll
      for (int ks = 0; ks < 2; ++ks)
#pragma unroll
        for (int j = 0; j < 8; ++j) qn += bf2f((u16)qf[ks][j]) * nst[ks * 32 + 8 * g + j];
      qn = group_sum4(qn);
      const float dn = group_sum4(den) + wi * qn;
      const float inv = __builtin_amdgcn_rcpf(fmaxf(fabsf(dn), __expf(-mt)));
      const size_t row = (size_t)b * SEQ + t0 + tl;
#pragma unroll
      for (int d = 0; d < 4; ++d) {
        f32x4 ni = (f32x4){0.f, 0.f, 0.f, 0.f};
#pragma unroll
        for (int ks = 0; ks < 2; ++ks) ni = mfma16(ldfrag(Cst + (d * 16 + l15) * KLD + ks * 32 + 8 * g), qf[ks], ni);
        const f32x4 v = (num[d] + ni * wi) * inv;
        u32x2 o; o.x = pack2(v[0], v[1]); o.y = pack2(v[2], v[3]);
        *(u32x2*)(Y + row * 1024 + Y_D + h * 64 + d * 16 + 4 * g) = o;
      }
    }
    lds_barrier();
    scale_rows8(Ks2, wend, tid);
    lds_barrier();
    const float fprev = __expf(blast + m_prev - m_new);
    st[0] *= fprev; st[1] *= fprev;
    state_update8(Vs2, Ks2, st, w, l15, g);
    {
      const int e = tid & 63, part = tid >> 6;
      float a = 0.f;
#pragma unroll
      for (int s2 = 0; s2 < 16; ++s2) a += bf2f(Ks2[(part * 16 + s2) * KLD + e]);
      npart[part * 64 + e] = a;
    }
    lds_barrier();
    if (tid < 64) {
      float a = nst[tid] * fprev;
#pragma unroll
      for (int pp = 0; pp < 8; ++pp) a += npart[pp * 64 + tid];
      nst[tid] = a;
    }
    m_prev = m_new;
  }
  asm volatile("s_waitcnt vmcnt(0)" ::: "memory");
}

DI void compress_task(const Params& p, int layer, int b, int kv, int rb, unsigned char* smem) {
  constexpr int HLD = 136;
  u16* Hs = (u16*)smem;
  const int tid = otid(), lane = tid & 63, w = tid >> 6, l15 = lane & 15, g = lane >> 4;
  const u16* projb = (const u16*)(p.ws + OFF_PROJ) + (size_t)b * SEQ * NP + (kv ? PA_VC : PA_KC);
  const int mi = layer * 2 + kv;
  const u16* W1T = (const u16*)(p.ws + OFF_W1T) + (size_t)mi * 128 * 2048;
  const u16* W2T = (const u16*)(p.ws + OFF_W2T) + (size_t)mi * 64 * 128;
  const float* bias1 = (const float*)(p.ws + OFF_BIAS1) + mi * 16 * 128;
  f32x4 acc[2][2];
#pragma unroll
  for (int nt = 0; nt < 2; ++nt) { acc[nt][0] = (f32x4){0.f, 0.f, 0.f, 0.f}; acc[nt][1] = (f32x4){0.f, 0.f, 0.f, 0.f}; }
  int tok[2];
#pragma unroll
  for (int mt = 0; mt < 2; ++mt) { int i = rb * 32 + mt * 16 + l15; if (i > 254) i = 254; tok[mt] = 16 * i; }
#pragma unroll 4
  for (int ks = 0; ks < 64; ++ks) {
    const int j = ks >> 1, d0 = (ks & 1) * 32;
    bf16x8 af[2], wf[2];
#pragma unroll
    for (int mt = 0; mt < 2; ++mt) af[mt] = ldfrag(projb + (size_t)(tok[mt] + j) * NP + d0 + 8 * g);
#pragma unroll
    for (int nt = 0; nt < 2; ++nt) wf[nt] = ldfrag(W1T + (size_t)(w * 32 + nt * 16 + l15) * 2048 + ks * 32 + 8 * g);
#pragma unroll
    for (int nt = 0; nt < 2; ++nt)
#pragma unroll
      for (int mt = 0; mt < 2; ++mt) acc[nt][mt] = mfma16(wf[nt], af[mt], acc[nt][mt]);
  }
  lds_barrier();
#pragma unroll
  for (int nt = 0; nt < 2; ++nt) {
    const int n = w * 32 + nt * 16 + 4 * g;
    f32x4 bb = *(const f32x4*)(bias1 + n);
#pragma unroll
    for (int pc = 1; pc < 16; ++pc) bb += *(const f32x4*)(bias1 + pc * 128 + n);
#pragma unroll
    for (int mt = 0; mt < 2; ++mt) {
      const f32x4 v = acc[nt][mt] + bb;
      u32x2 o; o.x = pack2(siluf(v[0]), siluf(v[1])); o.y = pack2(siluf(v[2]), siluf(v[3]));
      *(u32x2*)(Hs + (mt * 16 + l15) * HLD + n) = o;
    }
  }
  lds_barrier();
  f32x4 acc2[2] = {(f32x4){0.f, 0.f, 0.f, 0.f}, (f32x4){0.f, 0.f, 0.f, 0.f}};
#pragma unroll
  for (int ks = 0; ks < 4; ++ks) {
    const bf16x8 wf = ldfrag(W2T + (size_t)(w * 16 + l15) * 128 + ks * 32 + 8 * g);
#pragma unroll
    for (int mt = 0; mt < 2; ++mt) acc2[mt] = mfma16(wf, ldfrag(Hs + (mt * 16 + l15) * HLD + ks * 32 + 8 * g), acc2[mt]);
  }
  u16* dst = (u16*)(p.ws + (kv ? OFF_VCMP : OFF_KCMP) + (size_t)layer * 512 * 1024) + (size_t)b * 256 * 64;
#pragma unroll
  for (int mt = 0; mt < 2; ++mt) {
    const int i = rb * 32 + mt * 16 + l15;
    u32x2 o; o.x = pack2(acc2[mt][0], acc2[mt][1]); o.y = pack2(acc2[mt][2], acc2[mt][3]);
    if (i > 254) { o.x = 0u; o.y = 0u; }
    *(u32x2*)(dst + (size_t)i * 64 + w * 16 + 4 * g) = o;
  }
}

DI void nsa_task(const Params& p, int layer, int b, int qi, unsigned char* smem) {
  u16* Ks = (u16*)smem; u16* Vs = Ks + 64 * KLD;
  float* T = (float*)(smem + 2 * KVBUF * 2);
  unsigned long long* selm = (unsigned long long*)(smem + 2 * KVBUF * 2 + 4 * 32 * 65 * 4);
  const int tid = otid(), lane = tid & 63, h = tid >> 6, l15 = lane & 15, g = lane >> 4;
  const int q0 = qi * 32;
  const u16* projb = (const u16*)(p.ws + OFF_PROJ) + (size_t)b * SEQ * NP;
  const float* smb = (const float*)(p.ws + OFF_SMALL) + (size_t)b * SEQ * NSMALL;
  const u16* kcmp = (const u16*)(p.ws + OFF_KCMP + (size_t)layer * 512 * 1024) + (size_t)b * 256 * 64;
  const u16* vcmp = (const u16*)(p.ws + OFF_VCMP + (size_t)layer * 512 * 1024) + (size_t)b * 256 * 64;
  bf16x8 qf[2][2];
#pragma unroll
  for (int qt = 0; qt < 2; ++qt)
#pragma unroll
    for (int ks = 0; ks < 2; ++ks) qf[qt][ks] = ldfrag(projb + (size_t)(q0 + qt * 16 + l15) * NP + PA_Q + h * 64 + ks * 32 + 8 * g);
  const float sc = 0.125f * 1.4426950408889634f;
  f32x4 outacc[4][2];
  AttnAcc a;
  const int ntc = (q0 >> 10) + 1;
  attn_init(a);
  lds_barrier();
  for (int i = tid; i < 4 * 32 * 65; i += 256) T[i] = 0.f;
  kv_pipeline(0, ntc, Ks,
    [&](int) { return true; },
    [&](int j, KVRegs& kr) { kv_load(kcmp, vcmp, 64, 64, j * 64, kr); },
    [&](int j, const u16* Kt, const u16* Vt) {
      f32x4 s[4][2];
      auto valid = [&](int kt, int r, int qt) { return 16 * (j * 64 + kt * 16 + 4 * g + r) + 31 <= q0 + qt * 16 + l15; };
      qk_tile<2>(Kt, 0, qf, s, l15, g);
      softmax_pv(s, a, Vt, sc, l15, g, valid);
    });
  float cinv[2];
#pragma unroll
  for (int qt = 0; qt < 2; ++qt) {
    const float lt = group_sum4(a.l[qt]);
    cinv[qt] = lt > 0.f ? 1.f / lt : 0.f;
    const float gt = sigmoidf_(smb[(size_t)(q0 + qt * 16 + l15) * NSMALL + SM_G + h * 3 + 0]) * cinv[qt];
#pragma unroll
    for (int d = 0; d < 4; ++d) outacc[d][qt] = a.o[d][qt] * gt;
  }
  float carry[2] = {0.f, 0.f};
  kv_pipeline(0, ntc, Ks,
    [&](int) { return true; },
    [&](int j, KVRegs& kr) { kv_load(kcmp, vcmp, 64, 64, j * 64, kr); },
    [&](int j, const u16* Kt, const u16*) {
      f32x4 s[4][2];
      qk_tile<2>(Kt, 0, qf, s, l15, g);
#pragma unroll
      for (int qt = 0; qt < 2; ++qt) {
        float prev3 = carry[qt];
#pragma unroll
        for (int kt = 0; kt < 4; ++kt) {
          float pr[4];
#pragma unroll
          for (int r = 0; r < 4; ++r) {
            const bool ok = 16 * (j * 64 + kt * 16 + 4 * g + r) + 31 <= q0 + qt * 16 + l15;
            pr[r] = ok ? exp2_(s[kt][qt][r] * sc - a.m[qt]) * cinv[qt] : 0.f;
          }
          const float below = __shfl_up(pr[3], 16);
          const float wrap = __shfl(prev3, l15 + 48);
          const float nb = g > 0 ? below : wrap;
          T[(h * 32 + qt * 16 + l15) * 65 + j * 16 + kt * 4 + g] = (pr[0] + pr[1]) + (pr[2] + 0.5f * pr[3]) + 0.5f * nb;
          prev3 = pr[3];
        }
        carry[qt] = prev3;
      }
    });
  lds_barrier();
#pragma unroll 1
  for (int qq = 0; qq < 8; ++qq) {
    const int q = h * 8 + qq, t = q0 + q, cur = t >> 6;
    const float imp = ((T[(0 * 32 + q) * 65 + lane] + T[(1 * 32 + q) * 65 + lane]) + T[(2 * 32 + q) * 65 + lane]) + T[(3 * 32 + q) * 65 + lane];
    const float val = (lane == cur || lane == 0) ? 1e4f : (lane <= cur ? imp : -1.f);
    int rank = 0;
#pragma unroll
    for (int k = 0; k < 64; ++k) {
      const float vk = __int_as_float(__builtin_amdgcn_readlane(__float_as_int(val), k));
      rank += (vk > val || (vk == val && k < lane)) ? 1 : 0;
    }
    const unsigned long long m = __ballot(rank < 16);
    if (lane == 0) selm[q] = m;
  }
  lds_barrier();
  f32x4* park = (f32x4*)T + (h * 8) * 64 + lane;
#pragma unroll
  for (int d = 0; d < 4; ++d) { park[(d * 2 + 0) * 64] = outacc[d][0]; park[(d * 2 + 1) * 64] = outacc[d][1]; }
  unsigned long long mq[2], anym = 0ull;
#pragma unroll
  for (int qt = 0; qt < 2; ++qt) mq[qt] = selm[qt * 16 + l15];
  for (int i = 0; i < 32; ++i) anym |= selm[i];
  const int jhi = (q0 + 31) >> 6;
#pragma unroll
  for (int qt = 0; qt < 2; ++qt)
#pragma unroll
    for (int ks = 0; ks < 2; ++ks) qf[qt][ks] = scale_frag(qf[qt][ks], sc);
  attn_init_rel(a);
  kv_pipeline(0, jhi + 1, Ks,
    [&](int j) { return (bool)((anym >> j) & 1ull); },
    [&](int j, KVRegs& kr) { kv_load(projb + PA_KS, projb + PA_VS, NP, NP, j * 64, kr); },
    [&](int j, const u16* Kt, const u16* Vt) {
      f32x4 s[4][2];
      auto valid = [&](int kt, int r, int qt) { return ((mq[qt] >> j) & 1ull) && (j * 64 + kt * 16 + 4 * g + r <= q0 + qt * 16 + l15); };
      bf16x8 pf[2][2];
      qk_tile_rel<2>(Kt, 0, qf, a, s, l15, g);
      softmax_rel<true>(s, a, pf, valid);
      pv_accum(pf, Vt, a.o, l15, g);
    });
#pragma unroll
  for (int qt = 0; qt < 2; ++qt) {
    const float lt = group_sum4(a.l[qt]);
    const float gt = sigmoidf_(smb[(size_t)(q0 + qt * 16 + l15) * NSMALL + SM_G + h * 3 + 1]) * (lt > 0.f ? 1.f / lt : 0.f);
#pragma unroll
    for (int d = 0; d < 4; ++d) park[(d * 2 + qt) * 64] += a.o[d][qt] * gt;
  }
  attn_init_rel(a);
  const int jlo = q0 >= 511 ? (q0 - 511) >> 6 : 0;
  kv_pipeline(jlo, jhi + 1, Ks,
    [&](int) { return true; },
    [&](int j, KVRegs& kr) { kv_load(projb + PA_KW, projb + PA_VW, NP, NP, j * 64, kr); },
    [&](int j, const u16* Kt, const u16* Vt) {
      f32x4 s[4][2];
      auto valid = [&](int kt, int r, int qt) { const int key = j * 64 + kt * 16 + 4 * g + r, t = q0 + qt * 16 + l15; return key <= t && key + 512 > t; };
      bf16x8 pf[2][2];
      qk_tile_rel<2>(Kt, 0, qf, a, s, l15, g);
      if (j * 64 + 63 <= q0 && j * 64 + 512 > q0 + 31) softmax_rel<false>(s, a, pf, valid);
      else softmax_rel<true>(s, a, pf, valid);
      pv_accum(pf, Vt, a.o, l15, g);
    });
  u16* Y = (u16*)(p.ws + OFF_H);
  const float* ng = p.nsa_norm_g + layer * 64;
#pragma unroll
  for (int qt = 0; qt < 2; ++qt) {
    const int t = q0 + qt * 16 + l15;
    const float lt = group_sum4(a.l[qt]);
    const float gt = sigmoidf_(smb[(size_t)t * NSMALL + SM_G + h * 3 + 2]) * (lt > 0.f ? 1.f / lt : 0.f);
    f32x4 v[4]; float ss = 0.f;
#pragma unroll
    for (int d = 0; d < 4; ++d) { v[d] = park[(d * 2 + qt) * 64] + a.o[d][qt] * gt; ss += v[d][0] * v[d][0] + v[d][1] * v[d][1] + v[d][2] * v[d][2] + v[d][3] * v[d][3]; }
    ss = group_sum4(ss);
    const float rn = rsqrtf(ss * (1.f / 64.f) + 1e-6f);
    const size_t row = (size_t)b * SEQ + t;
#pragma unroll
    for (int d = 0; d < 4; ++d) {
      const int dd = d * 16 + 4 * g;
      const u32x2 zz = *(const u32x2*)(projb + (size_t)t * NP + PA_Z + h * 64 + dd);
      const f32x4 gg = *(const f32x4*)(ng + dd);
      u32x2 o;
      o.x = pack2(v[d][0] * rn * gg[0] * siluf(bflo(zz.x)), v[d][1] * rn * gg[1] * siluf(bfhi(zz.x)));
      o.y = pack2(v[d][2] * rn * gg[2] * siluf(bflo(zz.y)), v[d][3] * rn * gg[3] * siluf(bfhi(zz.y)));
      *(u32x2*)(Y + row * 1024 + Y_A + h * 64 + dd) = o;
    }
  }
}

DI void zero_y_cols(const Params& p, int c0, int ncols, int gtid, int gthreads) {
  u16* Y = (u16*)(p.ws + OFF_H);
  const int per_row = ncols / 8;
  for (size_t i = gtid; i < (size_t)NTOK * per_row; i += gthreads) {
    const size_t row = i / per_row; const int ch = (int)(i % per_row);
    *(u32x4*)(Y + row * 1024 + c0 + ch * 8) = (u32x4){0u, 0u, 0u, 0u};
  }
}

DI void final_norm_rows(const Params& p, int gw, int nw, int lane) {
  const float4* gp = (const float4*)p.final_g;
  float4 gg[4];
#pragma unroll
  for (int i = 0; i < 4; ++i) gg[i] = gp[lane + 64 * i];
  for (int row0 = gw * 4; row0 < NTOK; row0 += nw * 4) {
    float4 v[4][4]; float ss[4];
#pragma unroll
    for (int j = 0; j < 4; ++j) {
      const float4* xr = (const float4*)(p.out + (size_t)(row0 + j) * D_MODEL);
#pragma unroll
      for (int i = 0; i < 4; ++i) v[j][i] = xr[lane + 64 * i];
    }
#pragma unroll
    for (int j = 0; j < 4; ++j) {
      float a = 0.f;
#pragma unroll
      for (int i = 0; i < 4; ++i) a += v[j][i].x * v[j][i].x + v[j][i].y * v[j][i].y + v[j][i].z * v[j][i].z + v[j][i].w * v[j][i].w;
      ss[j] = wave_sum(a);
    }
#pragma unroll
    for (int j = 0; j < 4; ++j) {
      float4* xr = (float4*)(p.out + (size_t)(row0 + j) * D_MODEL);
      const float r = rsqrtf(ss[j] * (1.f / D_MODEL) + 1e-6f);
#pragma unroll
      for (int i = 0; i < 4; ++i) { float4 w; w.x = v[j][i].x * r * gg[i].x; w.y = v[j][i].y * r * gg[i].y; w.z = v[j][i].z * r * gg[i].z; w.w = v[j][i].w * r * gg[i].w; xr[lane + 64 * i] = w; }
    }
  }
}

#ifndef DEBUG_CHECK
#define DEBUG_CHECK 0
#endif
#if DEBUG_CHECK
constexpr int NCHK = 12;
DI float block_sum(float v, float* red) {
  v = wave_sum(v);
  lds_barrier();
  if ((threadIdx.x & 63) == 0) red[threadIdx.x >> 6] = v;
  lds_barrier();
  return red[0] + red[1] + red[2] + red[3];
}
DI float block_max(float v, float* red) {
#pragma unroll
  for (int o = 32; o > 0; o >>= 1) v = fmaxf(v, __shfl_xor(v, o));
  lds_barrier();
  if ((threadIdx.x & 63) == 0) red[threadIdx.x >> 6] = v;
  lds_barrier();
  return fmaxf(fmaxf(red[0], red[1]), fmaxf(red[2], red[3]));
}
DI float bfr(float v) { return bf2f(f2bf(v)); }
struct Chk { float num[NCHK], den[NCHK]; };
DI void chk_add(Chk& c, int id, float got, float ref) { const float d = got - ref; c.num[id] += d * d; c.den[id] += ref * ref; }

DI void dbg_diff_attn(const Params& p, int layer, int b, int t, int h, Chk& c, int id, unsigned char* smem) {
  float* p1 = (float*)smem; float* p2 = p1 + 4096; float* red = p2 + 4096;
  const int tid = otid();
  const u16* proj = (const u16*)(p.ws + OFF_PROJ) + (size_t)b * SEQ * NP;
  const u16* q = proj + (size_t)t * NP + PB_Q + h * 64;
  const float scale = 0.17677669529663687f;
  float m1 = -1e30f, m2 = -1e30f;
  for (int s = tid; s <= t; s += 256) {
    const u16* k = proj + (size_t)s * NP + PB_K + h * 64;
    float a1 = 0.f, a2 = 0.f;
    for (int d = 0; d < 32; ++d) { a1 += bf2f(q[d]) * bf2f(k[d]); a2 += bf2f(q[32 + d]) * bf2f(k[32 + d]); }
    a1 *= scale; a2 *= scale; p1[s] = a1; p2[s] = a2; m1 = fmaxf(m1, a1); m2 = fmaxf(m2, a2);
  }
  m1 = block_max(m1, red); m2 = block_max(m2, red);
  float l1 = 0.f, l2 = 0.f;
  for (int s = tid; s <= t; s += 256) { const float e1 = __expf(p1[s] - m1), e2 = __expf(p2[s] - m2); p1[s] = e1; p2[s] = e2; l1 += e1; l2 += e2; }
  l1 = block_sum(l1, red); l2 = block_sum(l2, red);
  const float* lam = p.diff_lam + layer * 128;
  float s01 = 0.f, s23 = 0.f;
  for (int i = 0; i < 32; ++i) { s01 += lam[i] * lam[32 + i]; s23 += lam[64 + i] * lam[96 + i]; }
  const float lam_init = 0.8f - 0.6f * expf(-0.3f * (float)layer);
  const float lam_full = expf(s01) - expf(s23) + lam_init;
  lds_barrier();
  float o = 0.f;
  if (tid < 64) for (int s = 0; s <= t; ++s) o += (p1[s] / l1 - lam_full * p2[s] / l2) * bf2f(proj[(size_t)s * NP + PB_V + h * 64 + tid]);
  float ss = block_sum(tid < 64 ? o * o : 0.f, red);
  if (tid < 64) {
    const float z = bf2f(proj[(size_t)t * NP + PB_Z + h * 64 + tid]);
    const float ref = o * rsqrtf(ss / 64.f + 1e-6f) * p.diff_norm_g[layer * 64 + tid] * (1.f - lam_init) * (z / (1.f + expf(-z)));
    const float got = bf2f(((const u16*)(p.ws + OFF_H))[((size_t)b * SEQ + t) * 1024 + Y_B + h * 64 + tid]);
    const float d = got - ref;
    o = d * d; ss = ref * ref;
  } else { o = 0.f; ss = 0.f; }
  c.num[id] += block_sum(o, red); c.den[id] += block_sum(ss, red);
}

DI float dbg_conv(const u16* projb, int t, int pcol, const float* cw, const float* cb, int ch, int nch) {
  float a = cb[ch];
  for (int j = 0; j < 4; ++j) { const int tt = t - 3 + j; if (tt >= 0) a += cw[j * nch + ch] * bf2f(projb[(size_t)tt * NP + pcol]); }
  return a / (1.f + expf(-a));
}
constexpr int DBG_NS = 11, DBG_T = 300;
DI int dbg_sample_idx(int t) {
  const int TS[DBG_NS] = {0, 1, 2, 3, 64, 127, 128, 129, 255, 256, 299};
  for (int i = 0; i < DBG_NS; ++i) if (TS[i] == t) return i;
  return -1;
}
DI int dbg_sample_t(int i) { const int TS[DBG_NS] = {0, 1, 2, 3, 64, 127, 128, 129, 255, 256, 299}; return TS[i]; }
DI void dbg_ssd(const Params& p, int layer, int b, int gi, Chk& c, int id, unsigned char* smem) {
  float* ybuf = (float*)smem;
  float* red = ybuf + DBG_NS * 128;
  const int tid = threadIdx.x, pp = tid >> 2, nq = tid & 3;
  const u16* projb = (const u16*)(p.ws + OFF_PROJ) + (size_t)b * SEQ * NP;
  const float* smb = (const float*)(p.ws + OFF_SMALL) + (size_t)b * SEQ * NSMALL;
  const float* cw = p.ssm_conv_w + layer * 4 * 512; const float* cb = p.ssm_conv_b + layer * 512;
  lds_barrier();
  for (int hh = 0; hh < 2; ++hh) {
    const int h = gi * 2 + hh;
    const float a_h = -expf(p.ssm_a_log[layer * 4 + h]), d_h = p.ssm_d[layer * 4 + h], dtb = p.ssm_dt_bias[layer * 4 + h];
    float hst[16];
    for (int i = 0; i < 16; ++i) hst[i] = 0.f;
    for (int t = 0; t < DBG_T; ++t) {
      const float xr = smb[(size_t)t * NSMALL + SM_DT + h] + dtb;
      const float dt = xr > 20.f ? xr : log1pf(expf(xr));
      const float dA = expf(dt * a_h);
      const float xp = dbg_conv(projb, t, PC_XBC + h * 64 + pp, cw, cb, h * 64 + pp, 512);
      float y = 0.f;
      for (int i = 0; i < 16; ++i) {
        const int n = nq * 16 + i;
        const float Bn = dbg_conv(projb, t, PC_XBC + 256 + gi * 64 + n, cw, cb, 256 + gi * 64 + n, 512);
        const float Cn = dbg_conv(projb, t, PC_XBC + 384 + gi * 64 + n, cw, cb, 384 + gi * 64 + n, 512);
        hst[i] = dA * hst[i] + dt * xp * Bn;
        y += Cn * hst[i];
      }
      y += __shfl_xor(y, 1); y += __shfl_xor(y, 2);
      y += d_h * xp;
      const int si = dbg_sample_idx(t);
      if (si >= 0 && nq == 0) { const float z = bf2f(projb[(size_t)t * NP + PC_Z + h * 64 + pp]); ybuf[si * 128 + hh * 64 + pp] = y * (z / (1.f + expf(-z))); }
    }
  }
  lds_barrier();
  for (int si = 0; si < DBG_NS; ++si) {
    const float v = tid < 128 ? ybuf[si * 128 + tid] : 0.f;
    const float ss = block_sum(v * v, red);
    float e2 = 0.f, r2 = 0.f;
    if (tid < 128) {
      const float ref = v * rsqrtf(ss / 128.f + 1e-6f) * p.ssm_norm_g[layer * 256 + gi * 128 + tid];
      const float got = bf2f(((const u16*)(p.ws + OFF_H))[((size_t)b * SEQ + dbg_sample_t(si)) * 1024 + Y_C + gi * 128 + tid]);
      e2 = (got - ref) * (got - ref); r2 = ref * ref;
    }
    c.num[id] += block_sum(e2, red); c.den[id] += block_sum(r2, red);
  }
}
DI void dbg_mlstm(const Params& p, int layer, int b, int h, Chk& c, int id, unsigned char* smem) {
  float* ybuf = (float*)smem;
  float* red = ybuf + DBG_NS * 128;
  const int tid = threadIdx.x, dd = tid >> 2, eq = tid & 3;
  const u16* projb = (const u16*)(p.ws + OFF_PROJ) + (size_t)b * SEQ * NP;
  const float* smb = (const float*)(p.ws + OFF_SMALL) + (size_t)b * SEQ * NSMALL;
  const float* cw = p.ml_conv_w + layer * 4 * 512; const float* cb = p.ml_conv_b + layer * 512;
  const float ib = p.ml_if_b[layer * 8 + h], fb = p.ml_if_b[layer * 8 + 4 + h];
  lds_barrier();
  float Cst[16], nst[16];
  for (int i = 0; i < 16; ++i) { Cst[i] = 0.f; nst[i] = 0.f; }
  float m = 0.f;
  for (int t = 0; t < DBG_T; ++t) {
    const float ip = smb[(size_t)t * NSMALL + SM_IF + h] + ib, fp = smb[(size_t)t * NSMALL + SM_IF + 4 + h] + fb;
    const float lf = fminf(fp, 0.f) - log1pf(expf(-fabsf(fp)));
    const float mn = fmaxf(lf + m, ip), fs = expf(lf + m - mn), is = expf(ip - mn);
    const float vd = bf2f(projb[(size_t)t * NP + PD_V + h * 64 + dd]);
    float num = 0.f, den = 0.f;
    for (int i = 0; i < 16; ++i) {
      const int e = eq * 16 + i;
      const float qe = dbg_conv(projb, t, PD_QK + h * 64 + e, cw, cb, h * 64 + e, 512);
      const float ke = 0.125f * dbg_conv(projb, t, PD_QK + 256 + h * 64 + e, cw, cb, 256 + h * 64 + e, 512);
      Cst[i] = fs * Cst[i] + is * vd * ke; nst[i] = fs * nst[i] + is * ke;
      num += Cst[i] * qe; den += nst[i] * qe;
    }
    num += __shfl_xor(num, 1); num += __shfl_xor(num, 2); den += __shfl_xor(den, 1); den += __shfl_xor(den, 2);
    const float hv = num / fmaxf(fabsf(den), expf(-mn));
    m = mn;
    const int si = dbg_sample_idx(t);
    if (si >= 0 && eq == 0) { const float o = bf2f(projb[(size_t)t * NP + PD_O + h * 64 + dd]); ybuf[si * 64 + dd] = hv / (1.f + expf(-o)); }
  }
  lds_barrier();
  for (int si = 0; si < DBG_NS; ++si) {
    const float v = tid < 64 ? ybuf[si * 64 + tid] : 0.f;
    const float ss = block_sum(v * v, red);
    float e2 = 0.f, r2 = 0.f;
    if (tid < 64) {
      const int t = dbg_sample_t(si);
      const float z = bf2f(projb[(size_t)t * NP + PD_Z + h * 64 + tid]);
      const float ref = v * rsqrtf(ss / 64.f + 1e-6f) * p.ml_norm_g[layer * 64 + tid] * (z / (1.f + expf(-z)));
      const float got = bf2f(((const u16*)(p.ws + OFF_H))[((size_t)b * SEQ + t) * 1024 + Y_D + h * 64 + tid]);
      e2 = (got - ref) * (got - ref); r2 = ref * ref;
    }
    c.num[id] += block_sum(e2, red); c.den[id] += block_sum(r2, red);
  }
}

DI void debug_checks(const Params& p, unsigned char* smem) {
  const int tid = otid();
  float* red = (float*)(smem + 36 * 1024);
  Chk c;
  for (int i = 0; i < NCHK; ++i) { c.num[i] = 0.f; c.den[i] = 0.f; }
  const float* adap = (const float*)(p.ws + OFF_ADAP);
  const u16* H = (const u16*)(p.ws + OFF_H);
  const u16* proj = (const u16*)(p.ws + OFF_PROJ);
  const float* sm = (const float*)(p.ws + OFF_SMALL);
#if DEBUG_CHECK == 1
  {
    const int bs[2] = {0, 5}; const int ns[4] = {3, 1024 + 77, 2048 + 500, 3071};
    for (int bi = 0; bi < 2; ++bi) for (int ni = 0; ni < 4; ++ni) {
      const int b = bs[bi], n = ns[ni];
      float a = 0.f;
      for (int k = tid; k < 1024; k += 256) { const float v = p.c[b * 1024 + k]; a += (v / (1.f + expf(-v))) * p.ada_w[(size_t)k * 3072 + n]; }
      const float ref = block_sum(a, red) + p.ada_b[n];
      float got = 0.f; for (int kc = 0; kc < 8; ++kc) got += adap[(((size_t)kc * 2 + 0) * 8 + b) * 3072 + n];
      chk_add(c, 1, got, ref);
    }
  }
  {
    const int ms[3] = {1, 9000, 32767};
    const int ns[14] = {0, 300, 700, 900, 1500, 2000, 2300, 2693, 3300, 3500, 3967, 3970, 3981, 3990};
    for (int mi = 0; mi < 3; ++mi) {
      const int m = ms[mi], b = m >> 12;
      float ss = 0.f;
      for (int k = tid; k < 1024; k += 256) { const float v = p.x[(size_t)m * 1024 + k]; ss += v * v; }
      ss = block_sum(ss, red);
      const float rstd = rsqrtf(ss / 1024.f + 1e-6f);
      for (int ni = 0; ni < 14; ++ni) {
        const int n = ns[ni], col = colmap(n);
        float a = 0.f, herr = 0.f, href = 0.f;
        for (int k = tid; k < 1024; k += 256) {
          float shf = 0.f, scl = 0.f;
          for (int kc = 0; kc < 8; ++kc) { const float* ap = adap + (((size_t)kc * 2 + 0) * 8 + b) * 3072; shf += ap[k]; scl += ap[1024 + k]; }
          const float hv = p.x[(size_t)m * 1024 + k] * rstd * p.norm_g[k] * (1.f + scl) + shf;
          const float hg = bf2f(H[(size_t)m * 1024 + k]);
          herr += (hg - hv) * (hg - hv); href += hv * hv;
          a += hv * p.w_in[(size_t)k * D_IN + col];
        }
        const float ref = block_sum(a, red);
        herr = block_sum(herr, red); href = block_sum(href, red);
        if (ni == 0 && DEBUG_STAGE == 1) { c.num[3] += herr; c.den[3] += href; }
        const float got = n < NP ? bf2f(proj[(size_t)m * NP + n]) : sm[(size_t)m * NSMALL + (n - NP)];
        chk_add(c, 2, got, ref);
      }
    }
  }
#endif
#if DEBUG_CHECK == 2
  dbg_diff_attn(p, 0, 0, 5, 0, c, 4, smem);
  dbg_diff_attn(p, 0, 1, 200, 3, c, 4, smem);
  dbg_diff_attn(p, 0, 3, 1500, 2, c, 4, smem);
  dbg_diff_attn(p, 0, 7, 4095, 1, c, 4, smem);
  {
    const int ms[3] = {2, 12345, 32766}; const int ns[3] = {0, 513, 1023};
    const u16* Y = (const u16*)(p.ws + OFF_H);
    for (int mi = 0; mi < 3; ++mi) for (int ni = 0; ni < 3; ++ni) {
      const int m = ms[mi], n = ns[ni], b = m >> 12;
      float a = 0.f;
      for (int k = tid; k < 1024; k += 256) a += bf2f(Y[(size_t)m * 1024 + k]) * p.w_out[(size_t)k * 1024 + n];
      a = block_sum(a, red);
      float gate = 0.f; for (int kc = 0; kc < 8; ++kc) gate += adap[(((size_t)kc * 2 + 0) * 8 + b) * 3072 + 2048 + n];
      chk_add(c, 5, p.out[(size_t)m * 1024 + n] - p.x[(size_t)m * 1024 + n], gate * a);
    }
  }
#endif
#if DEBUG_CHECK == 3
  dbg_ssd(p, 0, 0, 0, c, 6, smem);
  dbg_ssd(p, 0, 5, 1, c, 6, smem);
  dbg_mlstm(p, 0, 0, 0, c, 7, smem);
  dbg_mlstm(p, 0, 6, 3, c, 7, smem);
#endif
  lds_barrier();
  if (tid == 0) {
    int wid_ = 0, wcls = 99;
    for (int i = 1; i < NCHK; ++i) if (c.den[i] > 0.f) {
      const float rel = sqrtf(c.num[i] / c.den[i]);
      int cls = rel >= 1.f ? 0 : (int)floorf(-log10f(fmaxf(rel, 1e-9f)));
      if (cls > 9) cls = 9;
      if (!(rel == rel)) cls = 0;
      if (cls < wcls) { wcls = cls; wid_ = i; }
    }
    p.out[0] = 1e5f * ((float)wid_ + 0.1f * (float)wcls);
  }
}
#endif

constexpr int HALF_LDS = 76 * 1024;
constexpr int SMEM_BYTES = 2 * HALF_LDS;
__global__ void __launch_bounds__(512, 2) fwd_megakernel(Params p) {
  cg::grid_group grid = cg::this_grid();
  __shared__ __attribute__((aligned(16))) unsigned char smem[SMEM_BYTES];
  const int half = __builtin_amdgcn_readfirstlane(threadIdx.x >> 8);
  unsigned char* hsm = smem + half * HALF_LDS;
  const int G = gridDim.x, bid = blockIdx.x;
  const int slot = bid * 2 + half, NS = 2 * G;
  for (int t = slot; t < ((T0_TOTAL + NS - 1) / NS) * NS; t += NS) phase0_task(p, t < T0_TOTAL ? t : T0_TOTAL - 1, hsm);
  grid.sync();
  for (int layer = 0; layer < 2; ++layer) {
    Params q = p;
    { size_t zoff = 0; asm volatile("" : "+s"(zoff)); q.ws = p.ws + zoff; }
    const float* xin = layer == 0 ? q.x : q.out;
    for (int t = slot; t < ((NTOK / 64 + NS - 1) / NS) * NS; t += NS) phase1_task(q, layer, xin, t < NTOK / 64 ? t : NTOK / 64 - 1, hsm);
    grid.sync();
    for (int t = bid; t < (NTOK / 256) * (NPAD / 256); t += G) gemm_inproj_tile(q, layer, t, smem);
    grid.sync();
#if DEBUG_CHECK == 1
    if (bid == 0 && half == 0) debug_checks(q, smem);
    return;
#endif
    {
      unsigned* cnt = (unsigned*)(q.ws + OFF_CNT);
      int* s_pair = (int*)(smem + SMEM_BYTES - 16);
      if (bid < 32) ssd_task8(q, layer, bid >> 2, bid & 3, smem);
      else if (bid < 64) mlstm_task8(q, layer, (bid - 32) >> 2, (bid - 32) & 3, smem);
      if (bid < 64) {
        asm volatile("s_waitcnt vmcnt(0)" ::: "memory");
        lds_barrier();
        if (otid512() == 0) {
          __builtin_amdgcn_fence(__ATOMIC_RELEASE, "agent");
          asm volatile("s_waitcnt vmcnt(0)" ::: "memory");
          __hip_atomic_fetch_add(cnt + 4 + layer, 1u, __ATOMIC_RELAXED, __HIP_MEMORY_SCOPE_AGENT);
        }
      }
      constexpr int NPAIR_C = 64, NPAIR_D = 512, NPAIR_N = 512, NPAIR_F = NTOK / 128, NPAIR = NPAIR_C + NPAIR_D + NPAIR_N + NPAIR_F;
      for (;;) {
        const int t512 = otid512();
        lds_barrier();
        if (t512 == 0) *s_pair = (int)atomicAdd(cnt + layer, 1u);
        lds_barrier();
        const int pair = *s_pair;
        if (pair >= NPAIR) break;
        if (pair < NPAIR_C) {
          const int v = pair * 2 + half;
          compress_task(q, layer, v >> 4, (v >> 3) & 1, v & 7, hsm);
          asm volatile("s_waitcnt vmcnt(0)" ::: "memory");
          lds_barrier();
          if (t512 == 0) {
            __builtin_amdgcn_fence(__ATOMIC_RELEASE, "agent");
            asm volatile("s_waitcnt vmcnt(0)" ::: "memory");
            __hip_atomic_fetch_add(cnt + 2 + layer, 1u, __ATOMIC_RELAXED, __HIP_MEMORY_SCOPE_AGENT);
          }
        } else if (pair < NPAIR_C + NPAIR_D) {
          const int u = (pair - NPAIR_C) * 2 + half, qb = 31 - (u >> 5), bh = u & 31;
          diff_attn_task(q, layer, bh >> 2, bh & 3, qb, hsm, half != 0);
        } else if (pair >= NPAIR_C + NPAIR_D + NPAIR_N) {
          if (t512 == 0) {
            while (__hip_atomic_load(cnt + 4 + layer, __ATOMIC_RELAXED, __HIP_MEMORY_SCOPE_AGENT) < 64u) __builtin_amdgcn_s_sleep(16);
            __builtin_amdgcn_fence(__ATOMIC_ACQUIRE, "agent");
            asm volatile("s_waitcnt vmcnt(0)" ::: "memory");
          }
          lds_barrier();
          seq_fix_rows(q, layer, ((pair - NPAIR_C - NPAIR_D - NPAIR_N) * 2 + half) * 64, 64);
        } else {
          if (t512 == 0) {
            while (__hip_atomic_load(cnt + 2 + layer, __ATOMIC_RELAXED, __HIP_MEMORY_SCOPE_AGENT) < (unsigned)NPAIR_C) __builtin_amdgcn_s_sleep(16);
            __builtin_amdgcn_fence(__ATOMIC_ACQUIRE, "agent");
            asm volatile("s_waitcnt vmcnt(0)" ::: "memory");
          }
          lds_barrier();
          const int u = (pair - NPAIR_C - NPAIR_D) * 2 + half;
          nsa_task(q, layer, u & 7, 127 - (u >> 3), hsm);
        }
      }
    }
    grid.sync();
    for (int t = bid; t < (NTOK / 256) * 4; t += G) gemm_outproj_tile(q, layer, xin, q.out, t, smem);
    grid.sync();
#if DEBUG_CHECK >= 2
    if (bid == 0 && half == 0) debug_checks(q, smem);
    return;
#endif
  }
  { const int t5 = otid512(); final_norm_rows(p, bid * 8 + (t5 >> 6), G * 8, t5 & 63); }
}

extern "C" void kernel_launch(void* const* d_in, const int* in_sizes, int n_in, void* d_out, int out_size, void* d_ws, size_t ws_size,
                              hipStream_t stream) {
  static int grid_blocks = 0;
  if (!grid_blocks) {
    int dev = 0, cus = 0, per_cu = 0;
    (void)hipGetDevice(&dev);
    (void)hipDeviceGetAttribute(&cus, hipDeviceAttributeMultiprocessorCount, dev);
    (void)hipOccupancyMaxActiveBlocksPerMultiprocessor(&per_cu, fwd_megakernel, 512, 0);
    if (per_cu > 1) per_cu = 1;
    if (per_cu < 1) per_cu = 1;
    grid_blocks = cus * per_cu;
  }
  if (grid_blocks < 64 || (grid_blocks & 3)) { fprintf(stderr, "grid too small: %d\n", grid_blocks); return; }
  if (ws_size < WS_NEEDED) { fprintf(stderr, "workspace too small: %zu < %zu\n", ws_size, WS_NEEDED); return; }
  Params p{};
  const float** pp = (const float**)&p;
  for (int i = 0; i < 26; ++i) pp[i] = (const float*)d_in[i];
  p.out = (float*)d_out; p.ws = (unsigned char*)d_ws;
  (void)hipMemsetAsync((unsigned char*)d_ws + OFF_CNT, 0, 64, stream);
  void* args[] = {&p};
  hipError_t e = hipLaunchCooperativeKernel((void*)fwd_megakernel, dim3(grid_blocks), dim3(512), args, 0, stream);
  if (e != hipSuccess) fprintf(stderr, "cooperative launch failed: %s (grid %d)\n", hipGetErrorString(e), grid_blocks);
}
```

```cpp
#include <hip/hip_runtime.h>
#include <hip/hip_cooperative_groups.h>
#include <cstdio>
#include <cstdint>
#define DEBUG_CHECK 0
#define DEBUG_STAGE 1
#define REP_P1 1
#define REP_P2 1
#define REP_SEQ 1
#define REP_DIFF 1
#define REP_NSA 1
#define REP_P4 1
#define REP_P0 1
namespace cg = cooperative_groups;

typedef unsigned short u16;
typedef short bf16x8 __attribute__((ext_vector_type(8)));
typedef short s16x4 __attribute__((ext_vector_type(4)));
typedef float f32x4 __attribute__((ext_vector_type(4)));
typedef float f32x2 __attribute__((ext_vector_type(2)));
typedef unsigned u32x4 __attribute__((ext_vector_type(4)));
typedef unsigned u32x2 __attribute__((ext_vector_type(2)));
typedef __bf16 bf16x2_t __attribute__((ext_vector_type(2)));
#define DI __device__ __forceinline__
#define LDSP __attribute__((address_space(3)))

constexpr int D_MODEL = 1024, BATCH = 8, SEQ = 4096, NTOK = BATCH * SEQ;
constexpr int D_IN = 3992;
constexpr int NP = 3968, NPAD = 4096, NSMALL = 32;
constexpr int PA_Q = 0, PA_KC = 256, PA_VC = 320, PA_KS = 384, PA_VS = 448, PA_KW = 512, PA_VW = 576, PA_Z = 640;
constexpr int PB_Q = 896, PB_K = 1152, PB_V = 1408, PB_Z = 1664;
constexpr int PC_Z = 1920, PC_XBC = 2176;
constexpr int PD_QK = 2688, PD_V = 3200, PD_O = 3456, PD_Z = 3712;
constexpr int SM_G = 0, SM_DT = 12, SM_IF = 16;
constexpr int Y_A = 0, Y_B = 256, Y_C = 512, Y_D = 768;

constexpr size_t MiB = 1024 * 1024;
constexpr size_t OFF_WINT = 0;
constexpr size_t OFF_WOUTT = 16 * MiB;
constexpr size_t OFF_W1T = 20 * MiB;
constexpr size_t OFF_W2T = 22 * MiB;
constexpr size_t OFF_BIAS1 = 22 * MiB + 64 * 1024;
constexpr size_t OFF_ADAP = 22 * MiB + 128 * 1024;
constexpr size_t OFF_KCMP = 24 * MiB;
constexpr size_t OFF_VCMP = 24 * MiB + 256 * 1024;
constexpr size_t OFF_CNT = 29 * MiB;
constexpr size_t OFF_SMALL = 25 * MiB;
constexpr size_t OFF_SSQ = 29 * MiB;
constexpr size_t OFF_H = 32 * MiB;
constexpr size_t OFF_PROJ = 96 * MiB;
constexpr size_t WS_NEEDED = 96 * MiB + (size_t)NTOK * NP * 2;

struct Params {
  const float* x; const float* c; const float* norm_g; const float* ada_w; const float* ada_b;
  const float* w_in; const float* w_out;
  const float* nsa_cmp_pos; const float* nsa_ck_w1; const float* nsa_ck_w2; const float* nsa_cv_w1; const float* nsa_cv_w2; const float* nsa_norm_g;
  const float* diff_lam; const float* diff_norm_g;
  const float* ssm_conv_w; const float* ssm_conv_b; const float* ssm_dt_bias; const float* ssm_a_log; const float* ssm_d; const float* ssm_norm_g;
  const float* ml_conv_w; const float* ml_conv_b; const float* ml_if_b; const float* ml_norm_g; const float* final_g;
  float* out; unsigned char* ws;
};

DI void lds_barrier() { asm volatile("s_waitcnt lgkmcnt(0)" ::: "memory"); __builtin_amdgcn_s_barrier(); asm volatile("" ::: "memory"); }
DI int otid() { int t = threadIdx.x & 255; asm volatile("" : "+v"(t)); return t; }
DI int otid512() { int t = threadIdx.x; asm volatile("" : "+v"(t)); return t; }
DI unsigned pack2(float a, float b) { f32x2 v = {a, b}; bf16x2_t r = __builtin_convertvector(v, bf16x2_t); return __builtin_bit_cast(unsigned, r); }
DI u16 f2bf(float a) { return (u16)(pack2(a, 0.f) & 0xffffu); }
DI float bf2f(u16 h) { return __uint_as_float(((unsigned)h) << 16); }
DI float bflo(unsigned u) { return __uint_as_float(u << 16); }
DI float bfhi(unsigned u) { return __uint_as_float(u & 0xffff0000u); }
DI f32x4 mfma16(bf16x8 a, bf16x8 b, f32x4 c) { return __builtin_amdgcn_mfma_f32_16x16x32_bf16(a, b, c, 0, 0, 0); }
DI float wave_sum(float v) {
#pragma unroll
  for (int o = 32; o > 0; o >>= 1) v += __shfl_xor(v, o);
  return v;
}
DI float siluf(float v) { return v * __builtin_amdgcn_rcpf(1.f + __expf(-v)); }
DI float sigmoidf_(float v) { return __builtin_amdgcn_rcpf(1.f + __expf(-v)); }
DI float exp2_(float v) { return __builtin_amdgcn_exp2f(v); }
DI float sgprf(float v) { return __int_as_float(__builtin_amdgcn_readfirstlane(__float_as_int(v))); }
DI s16x4 tr_read(const u16* p) { return __builtin_amdgcn_ds_read_tr16_b64_v4i16((LDSP s16x4*)p); }
DI bf16x8 cat4(s16x4 a, s16x4 b) { bf16x8 r; r[0] = a[0]; r[1] = a[1]; r[2] = a[2]; r[3] = a[3]; r[4] = b[0]; r[5] = b[1]; r[6] = b[2]; r[7] = b[3]; return r; }
DI bf16x8 ldfrag(const u16* p) { return *(const bf16x8*)p; }

DI int colmap(int n) {
  if (n < 640) return n;
  if (n < 896) return 652 + (n - 640);
  if (n < 1920) return 908 + (n - 896);
  if (n < 2688) return 1932 + (n - 1920);
  if (n < 3456) return 2704 + (n - 2688);
  if (n < 3968) return 3480 + (n - 3456);
  if (n < 3980) return 640 + (n - 3968);
  if (n < 3984) return 2700 + (n - 3980);
  if (n < 3992) return 3472 + (n - 3984);
  return -1;
}

DI void tconv_tile(const float* __restrict__ src, int ldsrc, int k0, int n0, u16* __restrict__ dst, int ldd, bool use_map, unsigned char* smem) {
  float* tile = (float*)smem;
  const int tid = otid();
  lds_barrier();
  {
    const int nn = tid & 63; int col = n0 + nn; if (use_map) col = colmap(col);
#pragma unroll
    for (int i = 0; i < 16; ++i) { const int kk = i * 4 + (tid >> 6); tile[kk * 65 + nn] = col >= 0 ? src[(size_t)(k0 + kk) * ldsrc + col] : 0.f; }
  }
  lds_barrier();
#pragma unroll
  for (int i = 0; i < 2; ++i) {
    const int item = tid + 256 * i, nn = item >> 3, kc = item & 7;
    u32x4 w;
    w.x = pack2(tile[(kc * 8 + 0) * 65 + nn], tile[(kc * 8 + 1) * 65 + nn]);
    w.y = pack2(tile[(kc * 8 + 2) * 65 + nn], tile[(kc * 8 + 3) * 65 + nn]);
    w.z = pack2(tile[(kc * 8 + 4) * 65 + nn], tile[(kc * 8 + 5) * 65 + nn]);
    w.w = pack2(tile[(kc * 8 + 6) * 65 + nn], tile[(kc * 8 + 7) * 65 + nn]);
    *(u32x4*)(dst + (size_t)(n0 + nn) * ldd + k0 + kc * 8) = w;
  }
}

constexpr int T0_WIN = 2 * 16 * 64, T0_WOUT = 2 * 16 * 16, T0_W1 = 4 * 32 * 2, T0_W2 = 4 * 2, T0_ADA = 2 * 12 * 8, T0_B1 = 64;
constexpr int T0_TOTAL = T0_WIN + T0_WOUT + T0_W1 + T0_W2 + T0_ADA + T0_B1;

DI void phase0_task(const Params& p, int t, unsigned char* smem) {
  const int tid = otid();
  if (t < T0_WIN) {
    const int l = t / 1024, r = t % 1024, kt = r / 64, nt = r % 64;
    tconv_tile(p.w_in + (size_t)l * D_MODEL * D_IN, D_IN, kt * 64, nt * 64, (u16*)(p.ws + OFF_WINT) + (size_t)l * NPAD * 1024, 1024, true, smem);
    return;
  }
  t -= T0_WIN;
  if (t < T0_WOUT) {
    const int l = t / 256, r = t % 256, kt = r / 16, nt = r % 16;
    tconv_tile(p.w_out + (size_t)l * 1024 * 1024, 1024, kt * 64, nt * 64, (u16*)(p.ws + OFF_WOUTT) + (size_t)l * 1024 * 1024, 1024, false, smem);
    return;
  }
  t -= T0_WOUT;
  if (t < T0_W1) {
    const int m = t / 64, r = t % 64, kt = r / 2, nt = r % 2, l = m >> 1, kv = m & 1;
    const float* src = (kv ? p.nsa_cv_w1 : p.nsa_ck_w1) + (size_t)l * 2048 * 128;
    tconv_tile(src, 128, kt * 64, nt * 64, (u16*)(p.ws + OFF_W1T) + (size_t)m * 128 * 2048, 2048, false, smem);
    return;
  }
  t -= T0_W1;
  if (t < T0_W2) {
    const int m = t / 2, kt = t % 2, l = m >> 1, kv = m & 1;
    const float* src = (kv ? p.nsa_cv_w2 : p.nsa_ck_w2) + (size_t)l * 128 * 64;
    tconv_tile(src, 64, kt * 64, 0, (u16*)(p.ws + OFF_W2T) + (size_t)m * 64 * 128, 128, false, smem);
    return;
  }
  t -= T0_W2;
  if (t < T0_ADA) {
    const int l = t / 96, r = t % 96, nc = r / 8, kc = r % 8;
    float* cact = (float*)smem;
    lds_barrier();
    for (int i = tid; i < 1024; i += 256) { const int b = i >> 7, kk = i & 127; const float v = p.c[b * 1024 + kc * 128 + kk]; cact[i] = siluf(v); }
    lds_barrier();
    const int n = nc * 256 + tid;
    float acc[8];
#pragma unroll
    for (int b = 0; b < 8; ++b) acc[b] = 0.f;
    const float* w = p.ada_w + ((size_t)l * 1024 + kc * 128) * 3072 + n;
#pragma unroll 16
    for (int kk = 0; kk < 128; ++kk) {
      const float wv = w[(size_t)kk * 3072];
#pragma unroll
      for (int b = 0; b < 8; ++b) acc[b] += cact[b * 128 + kk] * wv;
    }
    float* adap = (float*)(p.ws + OFF_ADAP);
    const float bias = kc == 0 ? p.ada_b[l * 3072 + n] : 0.f;
#pragma unroll
    for (int b = 0; b < 8; ++b) adap[(((size_t)kc * 2 + l) * 8 + b) * 3072 + n] = acc[b] + bias;
    return;
  }
  t -= T0_ADA;
  {
    const int m = t >> 4, kc = t & 15, l = m >> 1, kv = m & 1;
    const float* w1 = (kv ? p.nsa_cv_w1 : p.nsa_ck_w1) + (size_t)l * 2048 * 128;
    const float* pos = p.nsa_cmp_pos + (size_t)l * 2048;
    const int n = tid & 127, half = tid >> 7;
    float acc = 0.f;
    const int k0 = kc * 128 + half * 64;
#pragma unroll 16
    for (int k = 0; k < 64; ++k) acc += pos[k0 + k] * w1[(size_t)(k0 + k) * 128 + n];
    float* red = (float*)smem;
    lds_barrier();
    red[tid] = acc;
    lds_barrier();
    if (tid < 128) ((float*)(p.ws + OFF_BIAS1))[(m * 16 + kc) * 128 + tid] = red[tid] + red[tid + 128];
  }
}

DI void phase1_task(const Params& p, int layer, const float* xin, int grp, unsigned char* smem) {
  const int tid = otid(), lane = tid & 63, wid = tid >> 6;
  const int b = grp >> 6;
  float* mul = (float*)smem;
  float* sh = mul + 1024;
  const float* adap = (const float*)(p.ws + OFF_ADAP);
  lds_barrier();
  for (int c = tid; c < 1024; c += 256) {
    float s0 = 0.f, s1 = 0.f;
#pragma unroll
    for (int kc = 0; kc < 8; ++kc) { const float* a = adap + (((size_t)kc * 2 + layer) * 8 + b) * 3072; s0 += a[c]; s1 += a[1024 + c]; }
    mul[c] = p.norm_g[layer * 1024 + c] * (1.f + s1); sh[c] = s0;
  }
  lds_barrier();
  u16* H = (u16*)(p.ws + OFF_H);
#pragma unroll 1
  for (int it = 0; it < 4; ++it) {
    float4 v[4][4]; float ss[4];
#pragma unroll
    for (int j = 0; j < 4; ++j) {
      const int row = grp * 64 + wid * 16 + it * 4 + j;
      const float4* xr = (const float4*)(xin + (size_t)row * D_MODEL);
#pragma unroll
      for (int i = 0; i < 4; ++i) v[j][i] = xr[lane + 64 * i];
    }
#pragma unroll
    for (int j = 0; j < 4; ++j) {
      float a = 0.f;
#pragma unroll
      for (int i = 0; i < 4; ++i) a += v[j][i].x * v[j][i].x + v[j][i].y * v[j][i].y + v[j][i].z * v[j][i].z + v[j][i].w * v[j][i].w;
      ss[j] = wave_sum(a);
    }
#pragma unroll
    for (int j = 0; j < 4; ++j) {
      const int row = grp * 64 + wid * 16 + it * 4 + j;
      const float r = rsqrtf(ss[j] * (1.f / D_MODEL) + 1e-6f);
#pragma unroll
      for (int i = 0; i < 4; ++i) {
        const int c = (lane + 64 * i) * 4;
        u32x2 w;
        w.x = pack2(v[j][i].x * r * mul[c] + sh[c], v[j][i].y * r * mul[c + 1] + sh[c + 1]);
        w.y = pack2(v[j][i].z * r * mul[c + 2] + sh[c + 2], v[j][i].w * r * mul[c + 3] + sh[c + 3]);
        *(u32x2*)(H + (size_t)row * 1024 + c) = w;
      }
    }
  }
}

namespace g8 {
constexpr int BM = 256, BK = 64, HALF = 128, HT = HALF * BK;
constexpr int LDS_BYTES = 8 * HT * 2;
DI int lds_byte(int r, int c) { const int st = (r >> 4) * 2 + (c >> 5), rr = r & 15, cc = c & 31, ob = rr * 64 + cc * 2; return st * 1024 + (ob ^ (((ob >> 9) & 1) << 5)); }
DI void stage_rc(int b, int& R, int& C) { const int st = b / 1024, sb = b % 1024, swz = sb ^ (((sb >> 9) & 1) << 5); R = (st >> 1) * 16 + swz / 64; C = (st & 1) * 32 + (swz % 64) / 2; }

DI void kloop(const u16* __restrict__ A, const u16* __restrict__ Bt, int K, int brow, int bcol, unsigned char* smem, f32x4 (&acc)[2][2][4][2]) {
  u16* shm = (u16*)smem;
  const int tid = otid512();
#define SA(b, h) (shm + ((b) * 2 + (h)) * HT)
#define SB(b, h) (shm + (4 + (b) * 2 + (h)) * HT)
#define STAGE(P, BASE, br, kt) do { const u16* _gb = BASE + ((long)(br) * K + (long)(kt) * BK); \
      __builtin_amdgcn_global_load_lds((const unsigned*)(_gb + soff0), (LDSP unsigned*)((LDSP char*)(P) + tid * 16), 16, 0, 0); \
      __builtin_amdgcn_global_load_lds((const unsigned*)(_gb + soff1), (LDSP unsigned*)((LDSP char*)(P) + tid * 16 + 8192), 16, 0, 0); } while (0)
#define LDA(dst, b, h) _Pragma("unroll") for (int m = 0; m < 4; ++m) _Pragma("unroll") for (int k = 0; k < 2; ++k) \
    dst[m][k] = *reinterpret_cast<const bf16x8*>((const char*)SA(b, h) + lds_byte(wr * 64 + m * 16 + fr, k * 32 + fq * 8))
#define LDB(dst, b, h) _Pragma("unroll") for (int n = 0; n < 2; ++n) _Pragma("unroll") for (int k = 0; k < 2; ++k) \
    dst[n][k] = *reinterpret_cast<const bf16x8*>((const char*)SB(b, h) + lds_byte(wc * 32 + n * 16 + fr, k * 32 + fq * 8))
#define MMA(ai, bj, At_, Bt_) do { __builtin_amdgcn_s_setprio(1); \
    _Pragma("unroll") for (int m = 0; m < 4; ++m) _Pragma("unroll") for (int n = 0; n < 2; ++n) _Pragma("unroll") for (int k = 0; k < 2; ++k) \
      acc[ai][bj][m][n] = __builtin_amdgcn_mfma_f32_16x16x32_bf16(Bt_[n][k], At_[m][k], acc[ai][bj][m][n], 0, 0, 0); \
    __builtin_amdgcn_s_setprio(0); } while (0)
#define WAIT_V(n) asm volatile("s_waitcnt vmcnt(" #n ")" ::: "memory")
#define WAIT_L(n) asm volatile("s_waitcnt lgkmcnt(" #n ")" ::: "memory")
#define BAR __builtin_amdgcn_s_barrier()
#define SCHED __builtin_amdgcn_sched_barrier(0)
  const int wid = __builtin_amdgcn_readfirstlane(tid >> 6), lane = tid & 63, wr = wid >> 2, wc = wid & 3, fr = lane & 15, fq = lane >> 4;
#pragma unroll
  for (int a = 0; a < 2; ++a)
#pragma unroll
    for (int b = 0; b < 2; ++b)
#pragma unroll
      for (int m = 0; m < 4; ++m) { acc[a][b][m][0] = (f32x4){0.f, 0.f, 0.f, 0.f}; acc[a][b][m][1] = (f32x4){0.f, 0.f, 0.f, 0.f}; }
  bf16x8 At[4][2], B0[2][2], B1[2][2];
  const int nt = K / BK;
  int soff0, soff1;
  { int r_, c_; stage_rc(tid * 16, r_, c_); soff0 = r_ * K + c_; stage_rc(tid * 16 + 8192, r_, c_); soff1 = r_ * K + c_; }
  STAGE(SB(0, 0), Bt, bcol, 0); STAGE(SA(0, 0), A, brow, 0);
  STAGE(SB(0, 1), Bt, bcol + HALF, 0); STAGE(SA(0, 1), A, brow + HALF, 0);
  if (wr == 1) BAR;
  WAIT_V(4); BAR;
  STAGE(SB(1, 0), Bt, bcol, 1); STAGE(SA(1, 0), A, brow, 1); STAGE(SB(1, 1), Bt, bcol + HALF, 1);
  WAIT_V(6); BAR;
#pragma unroll 1
  for (int t = 0; t < nt - 2; t += 2) {
    asm volatile("" : "+v"(soff0), "+v"(soff1));
    LDB(B0, 0, 0); SCHED; LDA(At, 0, 0); STAGE(SA(1, 1), A, brow + HALF, t + 1);
    WAIT_L(8); BAR; WAIT_L(0); MMA(0, 0, At, B0); BAR; SCHED;
    LDB(B1, 0, 1); STAGE(SB(0, 0), Bt, bcol, t + 2);
    BAR; WAIT_L(0); MMA(0, 1, At, B1); BAR;
    LDA(At, 0, 1); STAGE(SA(0, 0), A, brow, t + 2);
    BAR; WAIT_L(0); MMA(1, 0, At, B0); BAR; SCHED;
    STAGE(SB(0, 1), Bt, bcol + HALF, t + 2);
    WAIT_V(6); BAR; MMA(1, 1, At, B1); BAR;
    LDB(B0, 1, 0); SCHED; LDA(At, 1, 0); STAGE(SA(0, 1), A, brow + HALF, t + 2);
    WAIT_L(8); BAR; WAIT_L(0); MMA(0, 0, At, B0); BAR; SCHED;
    LDB(B1, 1, 1); STAGE(SB(1, 0), Bt, bcol, t + 3);
    BAR; WAIT_L(0); MMA(0, 1, At, B1); BAR;
    LDA(At, 1, 1); STAGE(SA(1, 0), A, brow, t + 3);
    BAR; WAIT_L(0); MMA(1, 0, At, B0); BAR; SCHED;
    STAGE(SB(1, 1), Bt, bcol + HALF, t + 3);
    WAIT_V(6); BAR; MMA(1, 1, At, B1); BAR;
  }
  { LDB(B0, 0, 0); LDA(At, 0, 0); STAGE(SA(1, 1), A, brow + HALF, nt - 1);
    BAR; WAIT_L(0); MMA(0, 0, At, B0); BAR;
    LDB(B1, 0, 1); BAR; WAIT_L(0); MMA(0, 1, At, B1); BAR;
    LDA(At, 0, 1); WAIT_V(4); BAR; WAIT_L(0); MMA(1, 0, At, B0); MMA(1, 1, At, B1); BAR; }
  { LDB(B0, 1, 0); LDA(At, 1, 0); WAIT_V(2); BAR; WAIT_L(0); MMA(0, 0, At, B0); BAR;
    LDB(B1, 1, 1); WAIT_V(0); BAR; WAIT_L(0); MMA(0, 1, At, B1); BAR;
    LDA(At, 1, 1); BAR; WAIT_L(0); MMA(1, 0, At, B0); MMA(1, 1, At, B1); BAR; }
  if (wr == 0) BAR;
#undef SA
#undef SB
#undef STAGE
#undef LDA
#undef LDB
#undef MMA
#undef WAIT_V
#undef WAIT_L
#undef BAR
#undef SCHED
}
DI void tile_map(int wgid, int nM, int nN, int& pm, int& pn) {
  const int nwg = nM * nN, NXCD = 8, WGM = 8;
  { const int q = nwg / NXCD, r = nwg % NXCD, xcd = wgid % NXCD, off = wgid / NXCD; wgid = (xcd < r ? xcd * (q + 1) : r * (q + 1) + (xcd - r) * q) + off; }
  const int nig = WGM * nN, gid = wgid / nig, fm = gid * WGM, gsz = (nM - fm) < WGM ? (nM - fm) : WGM;
  pm = fm + ((wgid % nig) % gsz); pn = (wgid % nig) / gsz;
}
}

DI void gemm_inproj_tile(const Params& p, int layer, int tile, unsigned char* smem) {
  int pm, pn; g8::tile_map(tile, NTOK / 256, NPAD / 256, pm, pn);
  const int brow = pm * 256, bcol = pn * 256;
  f32x4 acc[2][2][4][2];
  g8::kloop((const u16*)(p.ws + OFF_H), (const u16*)(p.ws + OFF_WINT) + (size_t)layer * NPAD * 1024, 1024, brow, bcol, smem, acc);
  const int tid = otid512(), wid = __builtin_amdgcn_readfirstlane(tid >> 6), lane = tid & 63, wr = wid >> 2, wc = wid & 3, fr = lane & 15, fq = lane >> 4;
  u16* proj = (u16*)(p.ws + OFF_PROJ);
  if (pn == 15 && wc == 0) {
    float* sm = (float*)(p.ws + OFF_SMALL);
#pragma unroll
    for (int ai = 0; ai < 2; ++ai)
#pragma unroll
      for (int m = 0; m < 4; ++m)
#pragma unroll
        for (int n = 0; n < 2; ++n) {
          const int mr = brow + ai * 128 + wr * 64 + m * 16 + fr;
          *(f32x4*)(sm + (size_t)mr * NSMALL + n * 16 + 4 * fq) = acc[ai][1][m][n];
        }
  }
  constexpr int CLD = 264;
  u16* Cs = (u16*)smem;
#pragma unroll
  for (int ai = 0; ai < 2; ++ai) {
    lds_barrier();
#pragma unroll
    for (int bj = 0; bj < 2; ++bj)
#pragma unroll
      for (int m = 0; m < 4; ++m)
#pragma unroll
        for (int n = 0; n < 2; ++n) {
          const f32x4 v = acc[ai][bj][m][n];
          u32x2 w; w.x = pack2(v[0], v[1]); w.y = pack2(v[2], v[3]);
          *(u32x2*)(Cs + (wr * 64 + m * 16 + fr) * CLD + bj * 128 + wc * 32 + n * 16 + 4 * fq) = w;
        }
    lds_barrier();
#pragma unroll
    for (int i = 0; i < 8; ++i) {
      const int id = tid + 512 * i, row = id >> 5, ch = id & 31;
      if (bcol + ch * 8 < NP) *(u32x4*)(proj + (size_t)(brow + ai * 128 + row) * NP + bcol + ch * 8) = *(const u32x4*)(Cs + row * CLD + ch * 8);
    }
  }
  asm volatile("s_waitcnt vmcnt(0)" ::: "memory");
  lds_barrier();
}

DI void gemm_outproj_tile(const Params& p, int layer, const float* xin, float* xout, int tile, unsigned char* smem) {
  int pm, pn; g8::tile_map(tile, NTOK / 256, 4, pm, pn);
  const int brow = pm * 256, bcol = pn * 256;
  f32x4 acc[2][2][4][2];
  g8::kloop((const u16*)(p.ws + OFF_H), (const u16*)(p.ws + OFF_WOUTT) + (size_t)layer * 1024 * 1024, 1024, brow, bcol, smem, acc);
  const int tid = otid512(), wid = __builtin_amdgcn_readfirstlane(tid >> 6), lane = tid & 63, wr = wid >> 2, wc = wid & 3, fr = lane & 15, fq = lane >> 4;
  const int b = brow >> 12;
  const float* adap = (const float*)(p.ws + OFF_ADAP);
  constexpr int CLD = 132;
  float* Cs = (float*)smem;
#pragma unroll
  for (int ai = 0; ai < 2; ++ai)
#pragma unroll
    for (int bj = 0; bj < 2; ++bj) {
      lds_barrier();
#pragma unroll
      for (int m = 0; m < 4; ++m)
#pragma unroll
        for (int n = 0; n < 2; ++n) *(f32x4*)(Cs + (wr * 64 + m * 16 + fr) * CLD + wc * 32 + n * 16 + 4 * fq) = acc[ai][bj][m][n];
      lds_barrier();
      const int ch = tid & 31, nc = bcol + bj * 128 + ch * 4;
      f32x4 gt = {0.f, 0.f, 0.f, 0.f};
#pragma unroll
      for (int kc = 0; kc < 8; ++kc) gt += *(const f32x4*)(adap + (((size_t)kc * 2 + layer) * 8 + b) * 3072 + 2048 + nc);
      f32x4 xv[8];
#pragma unroll
      for (int i = 0; i < 8; ++i) xv[i] = *(const f32x4*)(xin + (size_t)(brow + ai * 128 + (tid >> 5) + 16 * i) * 1024 + nc);
#pragma unroll
      for (int i = 0; i < 8; ++i) {
        const int row = (tid >> 5) + 16 * i;
        *(f32x4*)(xout + (size_t)(brow + ai * 128 + row) * 1024 + nc) = xv[i] + gt * *(const f32x4*)(Cs + row * CLD + ch * 4);
      }
    }
  asm volatile("s_waitcnt vmcnt(0)" ::: "memory");
  lds_barrier();
}

constexpr int KLD = 72;
struct KVRegs { u32x4 k[2], v[2]; };
DI void kv_load(const u16* kbase, const u16* vbase, int ldk, int ldv, int key0, KVRegs& r) {
  const int tid = otid();
#pragma unroll
  for (int i = 0; i < 2; ++i) {
    const int id = tid + 256 * i, row = id >> 3, ch = id & 7;
    r.k[i] = *(const u32x4*)(kbase + (size_t)(key0 + row) * ldk + ch * 8);
    r.v[i] = *(const u32x4*)(vbase + (size_t)(key0 + row) * ldv + ch * 8);
  }
}
DI void kv_store(u16* Ks, u16* Vs, const KVRegs& r) {
  const int tid = otid();
#pragma unroll
  for (int i = 0; i < 2; ++i) {
    const int id = tid + 256 * i, row = id >> 3, ch = id & 7;
    *(u32x4*)(Ks + row * KLD + ch * 8) = r.k[i];
    *(u32x4*)(Vs + row * KLD + ch * 8) = r.v[i];
  }
}
constexpr int KVBUF = 2 * 64 * KLD;
template <class UseF, class LoadF, class CompF>
DI void kv_pipeline(int j0, int j1, u16* buf, UseF use, LoadF load, CompF comp) {
  KVRegs kr;
  if (use(j0)) load(j0, kr);
  lds_barrier();
  if (use(j0)) kv_store(buf, buf + 64 * KLD, kr);
  if (j0 + 1 < j1 && use(j0 + 1)) load(j0 + 1, kr);
  lds_barrier();
  for (int j = j0; j < j1; ++j) {
    u16* cur = buf + ((j - j0) & 1) * KVBUF; u16* nxt = buf + (((j - j0) & 1) ^ 1) * KVBUF;
    if (j + 1 < j1 && use(j + 1)) kv_store(nxt, nxt + 64 * KLD, kr);
    if (j + 2 < j1 && use(j + 2)) load(j + 2, kr);
    if (use(j)) comp(j, cur, cur + 64 * KLD);
    lds_barrier();
  }
}
struct AttnAcc { f32x4 o[4][2]; float m[2], l[2]; f32x4 os[2]; int fresh; };
DI void attn_init(AttnAcc& a) {
#pragma unroll
  for (int d = 0; d < 4; ++d) { a.o[d][0] = (f32x4){0.f, 0.f, 0.f, 0.f}; a.o[d][1] = (f32x4){0.f, 0.f, 0.f, 0.f}; }
  a.m[0] = a.m[1] = -1e30f; a.l[0] = a.l[1] = 0.f;
}
template <int NKS>
DI void qk_tile(const u16* Ks, int dofs, const bf16x8 (&qf)[2][NKS], f32x4 (&s)[4][2], int l15, int g) {
#pragma unroll
  for (int kt = 0; kt < 4; ++kt) {
    s[kt][0] = (f32x4){0.f, 0.f, 0.f, 0.f}; s[kt][1] = (f32x4){0.f, 0.f, 0.f, 0.f};
#pragma unroll
    for (int ks = 0; ks < NKS; ++ks) {
      const bf16x8 a = ldfrag(Ks + (kt * 16 + l15) * KLD + dofs + ks * 32 + 8 * g);
      s[kt][0] = mfma16(a, qf[0][ks], s[kt][0]);
      s[kt][1] = mfma16(a, qf[1][ks], s[kt][1]);
    }
  }
}
DI void pv_accum(const bf16x8 (&pf)[2][2], const u16* Vs, f32x4 (&o)[4][2], int l15, int g) {
  const int tq = l15 >> 2, tp = l15 & 3;
#pragma unroll
  for (int kk = 0; kk < 2; ++kk)
#pragma unroll
    for (int d = 0; d < 4; ++d) {
      const bf16x8 vf = cat4(tr_read(Vs + (kk * 32 + 4 * g + tq) * KLD + d * 16 + 4 * tp), tr_read(Vs + (kk * 32 + 16 + 4 * g + tq) * KLD + d * 16 + 4 * tp));
      o[d][0] = mfma16(vf, pf[0][kk], o[d][0]);
      o[d][1] = mfma16(vf, pf[1][kk], o[d][1]);
    }
}
DI void pack_p(const f32x4 (&s)[4][2], bf16x8 (&pf)[2][2]) {
#pragma unroll
  for (int qt = 0; qt < 2; ++qt)
#pragma unroll
    for (int kk = 0; kk < 2; ++kk) {
      u32x4 w;
      w.x = pack2(s[2 * kk][qt][0], s[2 * kk][qt][1]); w.y = pack2(s[2 * kk][qt][2], s[2 * kk][qt][3]);
      w.z = pack2(s[2 * kk + 1][qt][0], s[2 * kk + 1][qt][1]); w.w = pack2(s[2 * kk + 1][qt][2], s[2 * kk + 1][qt][3]);
      pf[qt][kk] = __builtin_bit_cast(bf16x8, w);
    }
}
constexpr float DEFER_THR = 5.f;
template <class VF>
DI void softmax_pv(f32x4 (&s)[4][2], AttnAcc& a, const u16* Vs, float sc, int l15, int g, VF valid) {
  bf16x8 pf[2][2];
  float mxl[2];
#pragma unroll
  for (int qt = 0; qt < 2; ++qt) {
    float mx = -1e30f;
#pragma unroll
    for (int kt = 0; kt < 4; ++kt)
#pragma unroll
      for (int r = 0; r < 4; ++r) { const float v = valid(kt, r, qt) ? s[kt][qt][r] * sc : -1e30f; s[kt][qt][r] = v; mx = fmaxf(mx, v); }
    mxl[qt] = mx;
  }
  if (__any((mxl[0] > a.m[0] + DEFER_THR) || (mxl[1] > a.m[1] + DEFER_THR))) {
#pragma unroll
    for (int qt = 0; qt < 2; ++qt) {
      float mx = mxl[qt];
      mx = fmaxf(mx, __shfl_xor(mx, 16)); mx = fmaxf(mx, __shfl_xor(mx, 32));
      const float mn = fmaxf(a.m[qt], mx), alpha = exp2_(a.m[qt] - mn);
      a.m[qt] = mn; a.l[qt] *= alpha;
#pragma unroll
      for (int d = 0; d < 4; ++d) a.o[d][qt] *= alpha;
    }
  }
#pragma unroll
  for (int qt = 0; qt < 2; ++qt) {
    const float mn = a.m[qt];
    float ls = 0.f;
#pragma unroll
    for (int kt = 0; kt < 4; ++kt)
#pragma unroll
      for (int r = 0; r < 4; ++r) { const float v = s[kt][qt][r]; const float pv = v > -1e29f ? exp2_(v - mn) : 0.f; s[kt][qt][r] = pv; ls += pv; }
    a.l[qt] += ls;
  }
  pack_p(s, pf);
  pv_accum(pf, Vs, a.o, l15, g);
}
DI void softmax_pv_nomask(f32x4 (&s)[4][2], AttnAcc& a, const u16* Vs, float sc, int l15, int g) {
  bf16x8 pf[2][2];
  float mxl[2];
#pragma unroll
  for (int qt = 0; qt < 2; ++qt) {
    float mx = s[0][qt][0];
#pragma unroll
    for (int kt = 0; kt < 4; ++kt)
#pragma unroll
      for (int r = 0; r < 4; ++r) mx = fmaxf(mx, s[kt][qt][r]);
    mxl[qt] = mx * sc;
  }
  if (__any((mxl[0] > a.m[0] + DEFER_THR) || (mxl[1] > a.m[1] + DEFER_THR))) {
#pragma unroll
    for (int qt = 0; qt < 2; ++qt) {
      float mx = mxl[qt];
      mx = fmaxf(mx, __shfl_xor(mx, 16)); mx = fmaxf(mx, __shfl_xor(mx, 32));
      const float mn = fmaxf(a.m[qt], mx), alpha = exp2_(a.m[qt] - mn);
      a.m[qt] = mn; a.l[qt] *= alpha;
#pragma unroll
      for (int d = 0; d < 4; ++d) a.o[d][qt] *= alpha;
    }
  }
#pragma unroll
  for (int qt = 0; qt < 2; ++qt) {
    const float mn = a.m[qt];
    float ls = 0.f;
#pragma unroll
    for (int kt = 0; kt < 4; ++kt)
#pragma unroll
      for (int r = 0; r < 4; ++r) { const float pv = exp2_(__builtin_fmaf(s[kt][qt][r], sc, -mn)); s[kt][qt][r] = pv; ls += pv; }
    a.l[qt] += ls;
  }
  pack_p(s, pf);
  pv_accum(pf, Vs, a.o, l15, g);
}
template <class VF>
DI void softmax_p(f32x4 (&s)[4][2], AttnAcc& a, float sc, bf16x8 (&pf)[2][2], bool nomask, VF valid) {
  float mxl[2];
#pragma unroll
  for (int qt = 0; qt < 2; ++qt) {
    float mx = -1e30f;
#pragma unroll
    for (int kt = 0; kt < 4; ++kt)
#pragma unroll
      for (int r = 0; r < 4; ++r) { const float v = (nomask || valid(kt, r, qt)) ? s[kt][qt][r] * sc : -1e30f; s[kt][qt][r] = v; mx = fmaxf(mx, v); }
    mxl[qt] = mx;
  }
  if (__any((mxl[0] > a.m[0] + DEFER_THR) || (mxl[1] > a.m[1] + DEFER_THR))) {
#pragma unroll
    for (int qt = 0; qt < 2; ++qt) {
      float mx = mxl[qt];
      mx = fmaxf(mx, __shfl_xor(mx, 16)); mx = fmaxf(mx, __shfl_xor(mx, 32));
      const float mn = fmaxf(a.m[qt], mx), alpha = exp2_(a.m[qt] - mn);
      a.m[qt] = mn; a.l[qt] *= alpha;
#pragma unroll
      for (int d = 0; d < 4; ++d) a.o[d][qt] *= alpha;
    }
  }
#pragma unroll
  for (int qt = 0; qt < 2; ++qt) {
    const float mn = a.m[qt];
    float ls = 0.f;
#pragma unroll
    for (int kt = 0; kt < 4; ++kt)
#pragma unroll
      for (int r = 0; r < 4; ++r) { const float v = s[kt][qt][r]; const float pv = v > -1e29f ? exp2_(v - mn) : 0.f; s[kt][qt][r] = pv; ls += pv; }
    a.l[qt] += ls;
  }
  pack_p(s, pf);
}
DI void softmax_p_nomask(f32x4 (&s)[4][2], AttnAcc& a, float sc, bf16x8 (&pf)[2][2]) {
  float mxl[2];
#pragma unroll
  for (int qt = 0; qt < 2; ++qt) {
    float mx = s[0][qt][0];
#pragma unroll
    for (int kt = 0; kt < 4; ++kt)
#pragma unroll
      for (int r = 0; r < 4; ++r) mx = fmaxf(mx, s[kt][qt][r]);
    mxl[qt] = mx * sc;
  }
  if (__any((mxl[0] > a.m[0] + DEFER_THR) || (mxl[1] > a.m[1] + DEFER_THR))) {
#pragma unroll
    for (int qt = 0; qt < 2; ++qt) {
      float mx = mxl[qt];
      mx = fmaxf(mx, __shfl_xor(mx, 16)); mx = fmaxf(mx, __shfl_xor(mx, 32));
      const float mn = fmaxf(a.m[qt], mx), alpha = exp2_(a.m[qt] - mn);
      a.m[qt] = mn; a.l[qt] *= alpha;
#pragma unroll
      for (int d = 0; d < 4; ++d) a.o[d][qt] *= alpha;
    }
  }
#pragma unroll
  for (int qt = 0; qt < 2; ++qt) {
    const float mn = a.m[qt];
    float ls = 0.f;
#pragma unroll
    for (int kt = 0; kt < 4; ++kt)
#pragma unroll
      for (int r = 0; r < 4; ++r) { const float pv = exp2_(__builtin_fmaf(s[kt][qt][r], sc, -mn)); s[kt][qt][r] = pv; ls += pv; }
    a.l[qt] += ls;
  }
  pack_p(s, pf);
}
DI float group_sum4_(float v) { v += __shfl_xor(v, 16); v += __shfl_xor(v, 32); return v; }
DI bf16x8 scale_frag(bf16x8 f, float sc) {
  u32x4 w = __builtin_bit_cast(u32x4, f);
  w.x = pack2(bflo(w.x) * sc, bfhi(w.x) * sc); w.y = pack2(bflo(w.y) * sc, bfhi(w.y) * sc);
  w.z = pack2(bflo(w.z) * sc, bfhi(w.z) * sc); w.w = pack2(bflo(w.w) * sc, bfhi(w.w) * sc);
  return __builtin_bit_cast(bf16x8, w);
}
DI void attn_init_rel(AttnAcc& a) { attn_init(a); a.m[0] = a.m[1] = 0.f; a.os[0] = (f32x4){0.f, 0.f, 0.f, 0.f}; a.os[1] = (f32x4){0.f, 0.f, 0.f, 0.f}; a.fresh = 1; }
DI void rowsum_accum(const bf16x8 (&pf)[2][2], AttnAcc& a, int l15) {
  const short one = l15 == 0 ? (short)0x3F80 : (short)0;
  const bf16x8 ones = {one, one, one, one, one, one, one, one};
#pragma unroll
  for (int kk = 0; kk < 2; ++kk) { a.os[0] = mfma16(ones, pf[0][kk], a.os[0]); a.os[1] = mfma16(ones, pf[1][kk], a.os[1]); }
}
DI float rel_rowsum(const AttnAcc& a, int qt, int l15) { return __shfl(a.os[qt][0], l15); }
template <int NKS>
DI void qk_tile_rel(const u16* Ks, int dofs, const bf16x8 (&qf)[2][NKS], const AttnAcc& a, f32x4 (&s)[4][2], int l15, int g) {
  const float n0 = -a.m[0], n1 = -a.m[1];
#pragma unroll
  for (int kt = 0; kt < 4; ++kt) {
    s[kt][0] = (f32x4){n0, n0, n0, n0}; s[kt][1] = (f32x4){n1, n1, n1, n1};
#pragma unroll
    for (int ks = 0; ks < NKS; ++ks) {
      const bf16x8 k = ldfrag(Ks + (kt * 16 + l15) * KLD + dofs + ks * 32 + 8 * g);
      s[kt][0] = mfma16(k, qf[0][ks], s[kt][0]);
      s[kt][1] = mfma16(k, qf[1][ks], s[kt][1]);
    }
  }
}
template <int MODE, class VF>
DI void softmax_rel(f32x4 (&s)[4][2], AttnAcc& a, bf16x8 (&pf)[2][2], int l15_, VF valid, bool ok0 = true, bool ok1 = true) {
  float mxl[2];
#pragma unroll
  for (int qt = 0; qt < 2; ++qt) {
    float mx = -1e30f;
    const bool okq = qt == 0 ? ok0 : ok1;
#pragma unroll
    for (int kt = 0; kt < 4; ++kt)
#pragma unroll
      for (int r = 0; r < 4; ++r) {
        if (MODE == 1) s[kt][qt][r] = valid(kt, r, qt) ? s[kt][qt][r] : -1e30f;
        if (MODE == 2) s[kt][qt][r] = okq ? s[kt][qt][r] : -1e30f;
        mx = fmaxf(mx, s[kt][qt][r]);
      }
    mxl[qt] = mx;
  }
  if (a.fresh || __any(mxl[0] > DEFER_THR || mxl[1] > DEFER_THR)) {
    bool still = false;
#pragma unroll
    for (int qt = 0; qt < 2; ++qt) {
      float mx = mxl[qt];
      mx = fmaxf(mx, __shfl_xor(mx, 16)); mx = fmaxf(mx, __shfl_xor(mx, 32));
      const bool fresh = rel_rowsum(a, qt, l15_) == 0.f;
      const float dl = mx < -1e29f ? 0.f : (fresh ? mx : fmaxf(mx, 0.f)), alpha = exp2_(-dl);
      still = still || (fresh && mx < -1e29f);
      a.m[qt] += dl; a.os[qt] *= alpha;
#pragma unroll
      for (int d = 0; d < 4; ++d) a.o[d][qt] *= alpha;
#pragma unroll
      for (int kt = 0; kt < 4; ++kt)
#pragma unroll
        for (int r = 0; r < 4; ++r) s[kt][qt][r] -= dl;
    }
    a.fresh = __any(still) ? 1 : 0;
  }
#pragma unroll
  for (int qt = 0; qt < 2; ++qt)
#pragma unroll
    for (int kt = 0; kt < 4; ++kt)
#pragma unroll
      for (int r = 0; r < 4; ++r) s[kt][qt][r] = exp2_(s[kt][qt][r]);
  pack_p(s, pf);
}
template <class LoadF, class CompF>
DI void kv_pipeline3(int j0, int j1, u16* buf, LoadF load, CompF comp) {
  KVRegs kr;
  load(j0, kr);
  lds_barrier();
  kv_store(buf, buf + 64 * KLD, kr);
  if (j0 + 1 < j1) load(j0 + 1, kr);
  lds_barrier();
  int cb = 0;
  for (int j = j0; j < j1; ++j) {
    const int nb = cb == 2 ? 0 : cb + 1, pb = cb == 0 ? 2 : cb - 1;
    if (j + 1 < j1) kv_store(buf + nb * KVBUF, buf + nb * KVBUF + 64 * KLD, kr);
    if (j + 2 < j1) load(j + 2, kr);
    comp(j, buf + cb * KVBUF, buf + pb * KVBUF);
    lds_barrier();
    cb = nb;
  }
}
DI float group_sum4(float v) { v += __shfl_xor(v, 16); v += __shfl_xor(v, 32); return v; }

constexpr int DSTAGE = 2 * 128 * 64;
DI int fKs(int row) { return (row >> 1) & 7; }
DI int fVs(int row) { return ((row >> 1) & 3) << 1; }
DI void kv_dma128(const u16* kbase, const u16* vbase, int ld, int key0, u16* stage, int tid) {
#pragma unroll
  for (int i = 0; i < 4; ++i) {
    const int id = tid + 256 * i, row = id >> 3, c8 = id & 7;
    __builtin_amdgcn_global_load_lds((const unsigned*)(kbase + (size_t)(key0 + row) * ld + ((c8 ^ fKs(row)) * 8)), (LDSP unsigned*)((LDSP char*)stage + id * 16), 16, 0, 0);
  }
#pragma unroll
  for (int i = 0; i < 4; ++i) {
    const int id = tid + 256 * i, row = id >> 3, c8 = id & 7;
    __builtin_amdgcn_global_load_lds((const unsigned*)(vbase + (size_t)(key0 + row) * ld + ((c8 ^ fVs(row)) * 8)), (LDSP unsigned*)((LDSP char*)(stage + 128 * 64) + id * 16), 16, 0, 0);
  }
}
template <int NKS>
DI void qk_tile_rel_sw(const u16* Kh, int dofs, const bf16x8 (&qf)[2][NKS], const AttnAcc& a, f32x4 (&s)[4][2], int l15, int g) {
  const float n0 = -a.m[0], n1 = -a.m[1];
  const int sw = (l15 >> 1) & 7;
#pragma unroll
  for (int kt = 0; kt < 4; ++kt) {
    s[kt][0] = (f32x4){n0, n0, n0, n0}; s[kt][1] = (f32x4){n1, n1, n1, n1};
#pragma unroll
    for (int ks = 0; ks < NKS; ++ks) {
      const bf16x8 k = ldfrag(Kh + (kt * 16 + l15) * 64 + ((((dofs >> 3) + ks * 4 + g) ^ sw) * 8));
      s[kt][0] = mfma16(k, qf[0][ks], s[kt][0]);
      s[kt][1] = mfma16(k, qf[1][ks], s[kt][1]);
    }
  }
}
DI void pv_accum_sw(const bf16x8 (&pf)[2][2], const u16* Vh, f32x4 (&o)[4][2], int l15, int g) {
  const int tq = l15 >> 2, tp = l15 & 3;
#pragma unroll
  for (int kk = 0; kk < 2; ++kk) {
    const int r0 = kk * 32 + 4 * g + tq, r1 = r0 + 16;
    const int f0 = fVs(r0), f1 = fVs(r1);
#pragma unroll
    for (int d = 0; d < 4; ++d) {
      const int lc = d * 2 + (tp >> 1);
      const bf16x8 vf = cat4(tr_read(Vh + r0 * 64 + ((lc ^ f0) * 8) + (tp & 1) * 4), tr_read(Vh + r1 * 64 + ((lc ^ f1) * 8) + (tp & 1) * 4));
      o[d][0] = mfma16(vf, pf[0][kk], o[d][0]);
      o[d][1] = mfma16(vf, pf[1][kk], o[d][1]);
    }
  }
}
DI void diff_attn_task(const Params& p, int layer, int b, int h, int qb, unsigned char* smem, bool skew) {
  u16* Ks = (u16*)smem; u16* Vs = Ks + 64 * KLD;
  const int tid = otid(), lane = tid & 63, wid = tid >> 6, l15 = lane & 15, g = lane >> 4;
  const u16* proj = (const u16*)(p.ws + OFF_PROJ) + (size_t)b * SEQ * NP;
  const int q0w = qb * 128 + wid * 32;
  const float* lam = p.diff_lam + layer * 128;
  float s01 = 0.f, s23 = 0.f;
  for (int i = 0; i < 32; ++i) { s01 += lam[i] * lam[32 + i]; s23 += lam[64 + i] * lam[96 + i]; }
  const float lam_init = 0.8f - 0.6f * __expf(-0.3f * (float)layer);
  const float lam_full = __expf(s01) - __expf(s23) + lam_init;
  const float sc = 0.17677669529663687f * 1.4426950408889634f;
  const int ntile = 2 * qb + 2;
  const u16* vbase = proj + PB_V + h * 64;
  f32x4 res[4][2];
#pragma unroll 1
  for (int c = 0; c < 2; ++c) {
    const u16* kbase = proj + PB_K + h * 64;
    bf16x8 qf[2][1];
#pragma unroll
    for (int qt = 0; qt < 2; ++qt) qf[qt][0] = scale_frag(ldfrag(proj + (size_t)(q0w + qt * 16 + l15) * NP + PB_Q + h * 64 + c * 32 + 8 * g), sc);
    AttnAcc a; attn_init_rel(a);
    const int nst = qb + 1;
    asm volatile("s_waitcnt vmcnt(0)" ::: "memory");
    lds_barrier();
    kv_dma128(kbase, vbase, NP, 0, Ks, tid);
    asm volatile("s_waitcnt vmcnt(0)" ::: "memory");
    lds_barrier();
    for (int js = 0; js < nst; ++js) {
      const u16* st = Ks + (js & 1) * DSTAGE;
      if (js + 1 < nst) kv_dma128(kbase, vbase, NP, (js + 1) * 128, Ks + ((js + 1) & 1) * DSTAGE, tid);
#pragma unroll 1
      for (int hf = 0; hf < 2; ++hf) {
        const int key0 = js * 128 + hf * 64;
        if (key0 <= q0w + 31) {
          f32x4 s[4][2]; bf16x8 pf[2][2];
          auto valid = [&](int kt, int r, int qt) { return key0 + kt * 16 + 4 * g + r <= q0w + qt * 16 + l15; };
          qk_tile_rel_sw<1>(st + hf * 64 * 64, c * 32, qf, a, s, l15, g);
          if (key0 + 63 <= q0w) softmax_rel<0>(s, a, pf, l15, valid); else softmax_rel<1>(s, a, pf, l15, valid);
          pv_accum_sw(pf, st + 128 * 64 + hf * 64 * 64, a.o, l15, g);
          rowsum_accum(pf, a, l15);
        }
      }
      asm volatile("s_waitcnt vmcnt(0)" ::: "memory");
      lds_barrier();
    }
#pragma unroll
    for (int qt = 0; qt < 2; ++qt) {
      const float lt = rel_rowsum(a, qt, l15);
      const float inv = c == 0 ? 1.f / lt : -lam_full / lt;
#pragma unroll
      for (int d = 0; d < 4; ++d) res[d][qt] = c == 0 ? a.o[d][qt] * inv : res[d][qt] + a.o[d][qt] * inv;
    }
  }
  u16* Y = (u16*)(p.ws + OFF_H);
  const float* ng = p.diff_norm_g + layer * 64;
#pragma unroll
  for (int qt = 0; qt < 2; ++qt) {
    float ss = 0.f;
#pragma unroll
    for (int d = 0; d < 4; ++d) { const f32x4 v = res[d][qt]; ss += v[0] * v[0] + v[1] * v[1] + v[2] * v[2] + v[3] * v[3]; }
    ss = group_sum4(ss);
    const float rn = rsqrtf(ss * (1.f / 64.f) + 1e-6f) * (1.f - lam_init);
    const int t = q0w + qt * 16 + l15;
    const size_t row = (size_t)b * SEQ + t;
#pragma unroll
    for (int d = 0; d < 4; ++d) {
      const int dd = d * 16 + 4 * g;
      const f32x4 v = res[d][qt];
      const u32x2 zz = *(const u32x2*)(proj + (size_t)t * NP + PB_Z + h * 64 + dd);
      const f32x4 gg = *(const f32x4*)(ng + dd);
      u32x2 w;
      w.x = pack2(v[0] * rn * gg[0] * siluf(bflo(zz.x)), v[1] * rn * gg[1] * siluf(bfhi(zz.x)));
      w.y = pack2(v[2] * rn * gg[2] * siluf(bflo(zz.y)), v[3] * rn * gg[3] * siluf(bfhi(zz.y)));
      *(u32x2*)(Y + row * 1024 + Y_B + h * 64 + dd) = w;
    }
  }
}

template <int NKS>
DI void qk_tile1(const u16* Ks, const bf16x8 (&qf)[NKS], f32x4 (&s)[4], int l15, int g) {
#pragma unroll
  for (int kt = 0; kt < 4; ++kt) {
    s[kt] = (f32x4){0.f, 0.f, 0.f, 0.f};
#pragma unroll
    for (int ks = 0; ks < NKS; ++ks) s[kt] = mfma16(ldfrag(Ks + (kt * 16 + l15) * KLD + ks * 32 + 8 * g), qf[ks], s[kt]);
  }
}
DI void pv_accum1(const f32x4 (&s)[4], const u16* Vs, f32x4 (&o)[4], int l15, int g) {
  const int tq = l15 >> 2, tp = l15 & 3;
#pragma unroll
  for (int kk = 0; kk < 2; ++kk) {
    u32x4 w;
    w.x = pack2(s[2 * kk][0], s[2 * kk][1]); w.y = pack2(s[2 * kk][2], s[2 * kk][3]);
    w.z = pack2(s[2 * kk + 1][0], s[2 * kk + 1][1]); w.w = pack2(s[2 * kk + 1][2], s[2 * kk + 1][3]);
    const bf16x8 pf = __builtin_bit_cast(bf16x8, w);
#pragma unroll
    for (int d = 0; d < 4; ++d) {
      const bf16x8 vf = cat4(tr_read(Vs + (kk * 32 + 4 * g + tq) * KLD + d * 16 + 4 * tp), tr_read(Vs + (kk * 32 + 16 + 4 * g + tq) * KLD + d * 16 + 4 * tp));
      o[d] = mfma16(vf, pf, o[d]);
    }
  }
}
DI void conv_silu_stage(const u16* projb, int col0, const float* cw, const float* cb, int chan0, int nchan, int t0, u16* dst, const float* rowscale, float cscale) {
  const int tid = otid(), ch = (tid & 7) * 8;
  float w[4][8], bias[8];
#pragma unroll
  for (int j = 0; j < 4; ++j)
#pragma unroll
    for (int i = 0; i < 8; ++i) w[j][i] = cw[j * nchan + chan0 + ch + i];
#pragma unroll
  for (int i = 0; i < 8; ++i) bias[i] = cb[chan0 + ch + i];
#pragma unroll 1
  for (int ps = 0; ps < 4; ++ps) {
    const int row = ps * 32 + (tid >> 3), t = t0 + row;
    float acc[8];
#pragma unroll
    for (int i = 0; i < 8; ++i) acc[i] = bias[i];
#pragma unroll
    for (int j = 0; j < 4; ++j) {
      const int tt = t - 3 + j;
      if (tt >= 0) {
        const u32x4 v = *(const u32x4*)(projb + (size_t)tt * NP + col0 + ch);
        acc[0] += w[j][0] * bflo(v.x); acc[1] += w[j][1] * bfhi(v.x); acc[2] += w[j][2] * bflo(v.y); acc[3] += w[j][3] * bfhi(v.y);
        acc[4] += w[j][4] * bflo(v.z); acc[5] += w[j][5] * bfhi(v.z); acc[6] += w[j][6] * bflo(v.w); acc[7] += w[j][7] * bfhi(v.w);
      }
    }
    const float rs = (rowscale ? rowscale[row] : 1.f) * cscale;
#pragma unroll
    for (int i = 0; i < 8; ++i) acc[i] = siluf(acc[i]) * rs;
    u32x4 o; o.x = pack2(acc[0], acc[1]); o.y = pack2(acc[2], acc[3]); o.z = pack2(acc[4], acc[5]); o.w = pack2(acc[6], acc[7]);
    *(u32x4*)(dst + row * KLD + ch) = o;
  }
}
DI float block_scan128_add(float v, float* tmp) {
  const int tid = otid(), lane = tid & 63;
  float x = v;
#pragma unroll
  for (int o = 1; o < 64; o <<= 1) { const float y = __shfl_up(x, o); if (lane >= o) x += y; }
  lds_barrier();
  if (tid == 63) tmp[0] = x;
  lds_barrier();
  if ((tid >> 6) == 1) x += tmp[0];
  return x;
}
DI float block_scan128_max(float v, float* tmp) {
  const int tid = otid(), lane = tid & 63;
  float x = v;
#pragma unroll
  for (int o = 1; o < 64; o <<= 1) { const float y = __shfl_up(x, o); if (lane >= o) x = fmaxf(x, y); }
  lds_barrier();
  if (tid == 63) tmp[0] = x;
  lds_barrier();
  if ((tid >> 6) == 1) x = fmaxf(x, tmp[0]);
  return x;
}
DI void scale_rows(u16* A, const float* rs) {
  const int tid = otid(), ch = (tid & 7) * 8;
#pragma unroll
  for (int ps = 0; ps < 4; ++ps) {
    const int row = ps * 32 + (tid >> 3);
    const float f = rs[row];
    u32x4 v = *(u32x4*)(A + row * KLD + ch);
    v.x = pack2(bflo(v.x) * f, bfhi(v.x) * f); v.y = pack2(bflo(v.y) * f, bfhi(v.y) * f);
    v.z = pack2(bflo(v.z) * f, bfhi(v.z) * f); v.w = pack2(bflo(v.w) * f, bfhi(v.w) * f);
    *(u32x4*)(A + row * KLD + ch) = v;
  }
}
DI void state_update(const u16* Xs, const u16* Bs, f32x4 (&acc)[4], int w, int l15, int g) {
  const int tq = l15 >> 2, tp = l15 & 3;
#pragma unroll
  for (int kk = 0; kk < 4; ++kk) {
    const bf16x8 af = cat4(tr_read(Xs + (kk * 32 + 4 * g + tq) * KLD + w * 16 + 4 * tp), tr_read(Xs + (kk * 32 + 16 + 4 * g + tq) * KLD + w * 16 + 4 * tp));
#pragma unroll
    for (int nt = 0; nt < 4; ++nt) {
      const bf16x8 bfr = cat4(tr_read(Bs + (kk * 32 + 4 * g + tq) * KLD + nt * 16 + 4 * tp), tr_read(Bs + (kk * 32 + 16 + 4 * g + tq) * KLD + nt * 16 + 4 * tp));
      acc[nt] = mfma16(af, bfr, acc[nt]);
    }
  }
}
DI void state_to_lds(u16* Ss, const f32x4 (&acc)[4], int w, int l15, int g) {
#pragma unroll
  for (int nt = 0; nt < 4; ++nt)
#pragma unroll
    for (int r = 0; r < 4; ++r) Ss[(w * 16 + 4 * g + r) * KLD + nt * 16 + l15] = f2bf(acc[nt][r]);
}

constexpr int SEQ_LDS_A = 0, SEQ_LDS_B = 128 * KLD * 2, SEQ_LDS_C = 2 * 128 * KLD * 2, SEQ_LDS_S = 3 * 128 * KLD * 2, SEQ_LDS_F = SEQ_LDS_S + 64 * KLD * 2;
constexpr int SEQ_LDS_HALO = SEQ_LDS_F + 4096;
constexpr int SEQ_LDS_CW = SEQ_LDS_HALO + 2 * 3 * 3 * 64 * 2;
struct RawRegs { u32x4 r[4]; };
DI void raw_load(const u16* projb, int col0, int t0, RawRegs& rr, int tid) {
#pragma unroll
  for (int i = 0; i < 4; ++i) rr.r[i] = *(const u32x4*)(projb + (size_t)(t0 + (tid >> 3) + 32 * i) * NP + col0 + (tid & 7) * 8);
}
DI void raw_store(u16* dst, u16* halo_next, const RawRegs& rr, int tid) {
#pragma unroll
  for (int i = 0; i < 4; ++i) *(u32x4*)(dst + ((tid >> 3) + 32 * i) * KLD + (tid & 7) * 8) = rr.r[i];
  if (halo_next && tid >= 232) *(u32x4*)(halo_next + ((tid >> 3) - 29) * 64 + (tid & 7) * 8) = rr.r[3];
}
DI void conv_from_lds(const u16* raw, const u16* halo, const float* wl, const float* rowscale, float cscale, u32x4 (&out)[4], int tid) {
  const int q = tid >> 3, ch = (tid & 7) * 8;
  u32x4 v[7];
#pragma unroll
  for (int k = 0; k < 7; ++k) { const int r = 4 * q - 3 + k; v[k] = r >= 0 ? *(const u32x4*)(raw + r * KLD + ch) : *(const u32x4*)(halo + (r + 3) * 64 + ch); }
  float w[5][8];
#pragma unroll
  for (int j = 0; j < 5; ++j) { const f32x4 w0 = *(const f32x4*)(wl + j * 64 + ch), w1 = *(const f32x4*)(wl + j * 64 + ch + 4);
    w[j][0] = w0[0]; w[j][1] = w0[1]; w[j][2] = w0[2]; w[j][3] = w0[3]; w[j][4] = w1[0]; w[j][5] = w1[1]; w[j][6] = w1[2]; w[j][7] = w1[3]; }
#pragma unroll
  for (int o = 0; o < 4; ++o) {
    float acc[8];
#pragma unroll
    for (int i = 0; i < 8; ++i) acc[i] = w[4][i];
#pragma unroll
    for (int j = 0; j < 4; ++j) {
      const u32x4 x = v[o + j];
      acc[0] += w[j][0] * bflo(x.x); acc[1] += w[j][1] * bfhi(x.x); acc[2] += w[j][2] * bflo(x.y); acc[3] += w[j][3] * bfhi(x.y);
      acc[4] += w[j][4] * bflo(x.z); acc[5] += w[j][5] * bfhi(x.z); acc[6] += w[j][6] * bflo(x.w); acc[7] += w[j][7] * bfhi(x.w);
    }
    const float rs = (rowscale ? rowscale[4 * q + o] : 1.f) * cscale;
#pragma unroll
    for (int i = 0; i < 8; ++i) acc[i] = siluf(acc[i]) * rs;
    out[o].x = pack2(acc[0], acc[1]); out[o].y = pack2(acc[2], acc[3]); out[o].z = pack2(acc[4], acc[5]); out[o].w = pack2(acc[6], acc[7]);
  }
}
DI void conv_write(u16* dst, const u32x4 (&out)[4], int tid) {
  const int q = tid >> 3, ch = (tid & 7) * 8;
#pragma unroll
  for (int o = 0; o < 4; ++o) *(u32x4*)(dst + (4 * q + o) * KLD + ch) = out[o];
}
DI void stage_conv_w(float* wl, const float* cw, const float* cb, int chan0, int nchan, int tid) {
  for (int i = tid; i < 320; i += 256) { const int j = i >> 6, cc = i & 63; wl[i] = j < 4 ? cw[j * nchan + chan0 + cc] : cb[chan0 + cc]; }
}
DI float wave_scan_add(float x, int lane) {
#pragma unroll
  for (int o = 1; o < 64; o <<= 1) { const float y = __shfl_up(x, o); if (lane >= o) x += y; }
  return x;
}
DI float wave_scan_max(float x, int lane) {
#pragma unroll
  for (int o = 1; o < 64; o <<= 1) { const float y = __shfl_up(x, o); if (lane >= o) x = fmaxf(x, y); }
  return x;
}

DI void ssd_task(const Params& p, int layer, int b, int h, unsigned char* smem) {
  u16* Cs = (u16*)(smem + SEQ_LDS_A); u16* Bs = (u16*)(smem + SEQ_LDS_B); u16* Xs = (u16*)(smem + SEQ_LDS_C); u16* Ss = (u16*)(smem + SEQ_LDS_S);
  float* fl = (float*)(smem + SEQ_LDS_F);
  float* dts = fl; float* acs = fl + 128; float* wend = fl + 256; float* tmp = fl + 384;
  u16* halo = (u16*)(smem + SEQ_LDS_HALO); float* cwl = (float*)(smem + SEQ_LDS_CW);
  int tid = otid(), lane = tid & 63, w = tid >> 6, l15 = lane & 15, g = lane >> 4;
  const int gi = h >> 1;
  const u16* projb = (const u16*)(p.ws + OFF_PROJ) + (size_t)b * SEQ * NP;
  const float* smb = (const float*)(p.ws + OFF_SMALL) + (size_t)b * SEQ * NSMALL;
  const float* cw = p.ssm_conv_w + layer * 4 * 512; const float* cb = p.ssm_conv_b + layer * 512;
  u16* Y = (u16*)(p.ws + OFF_H);
  const float a_h = -__expf(p.ssm_a_log[layer * 4 + h]), d_h = p.ssm_d[layer * 4 + h], dtb = p.ssm_dt_bias[layer * 4 + h];
  const int colB = PC_XBC + 256 + gi * 64, colC = PC_XBC + 384 + gi * 64, colX = PC_XBC + h * 64;
  f32x4 st[4];
#pragma unroll
  for (int nt = 0; nt < 4; ++nt) st[nt] = (f32x4){0.f, 0.f, 0.f, 0.f};
  lds_barrier();
  stage_conv_w(cwl, cw, cb, 256 + gi * 64, 512, tid);
  stage_conv_w(cwl + 320, cw, cb, 384 + gi * 64, 512, tid);
  stage_conv_w(cwl + 640, cw, cb, h * 64, 512, tid);
  for (int i = tid; i < 3 * 3 * 64; i += 256) halo[i] = 0;
  RawRegs rB, rC, rX; float dtraw = 0.f;
  raw_load(projb, colB, 0, rB, tid); raw_load(projb, colC, 0, rC, tid); raw_load(projb, colX, 0, rX, tid);
  if (tid < 128) dtraw = smb[(size_t)tid * NSMALL + SM_DT + h];
#pragma unroll 1
  for (int c = 0; c < 32; ++c) {
    const int t0 = c * 128;
    asm volatile("" : "+v"(tid)); lane = tid & 63; w = tid >> 6; l15 = lane & 15; g = lane >> 4;
    u16* hcur = halo + (c & 1) * 576; u16* hnext = halo + ((c + 1) & 1) * 576;
    float dtv = 0.f;
    if (tid < 128) { const float xr = dtraw + dtb; dtv = xr > 15.f ? xr : __logf(1.f + __expf(xr)); }
    float cs = wave_scan_add(dtv * a_h, lane);
    if (tid == 63) tmp[0] = cs;
    lds_barrier();
    if (w == 1) cs += tmp[0];
    if (tid < 128) { dts[tid] = dtv; acs[tid] = cs; }
    raw_store(Bs, hnext, rB, tid); raw_store(Cs, hnext + 192, rC, tid); raw_store(Xs, hnext + 384, rX, tid);
    lds_barrier();
    if (c + 1 < 32) {
      raw_load(projb, colB, t0 + 128, rB, tid); raw_load(projb, colC, t0 + 128, rC, tid);
      if (tid < 128) dtraw = smb[(size_t)(t0 + 128 + tid) * NSMALL + SM_DT + h];
    }
    {
      u32x4 o1[4], o2[4];
      conv_from_lds(Bs, hcur, cwl, nullptr, 1.f, o1, tid);
      lds_barrier();
      conv_write(Bs, o1, tid);
      conv_from_lds(Cs, hcur + 192, cwl + 320, nullptr, 1.f, o2, tid);
      lds_barrier();
      conv_write(Cs, o2, tid);
      conv_from_lds(Xs, hcur + 384, cwl + 640, dts, 1.f, o1, tid);
      lds_barrier();
      conv_write(Xs, o1, tid);
    }
    if (tid < 128) wend[tid] = __expf(acs[127] - acs[tid]);
    state_to_lds(Ss, st, w, l15, g);
    lds_barrier();
#pragma unroll 1
    for (int qt = 0; qt < 2; ++qt) {
      const int tl = 32 * w + qt * 16 + l15;
      bf16x8 cf[2];
#pragma unroll
      for (int ks = 0; ks < 2; ++ks) cf[ks] = ldfrag(Cs + tl * KLD + ks * 32 + 8 * g);
      f32x4 y[4];
#pragma unroll
      for (int d = 0; d < 4; ++d) y[d] = (f32x4){0.f, 0.f, 0.f, 0.f};
      const float at = acs[tl];
#pragma unroll 1
      for (int stl = 0; stl < 2; ++stl) {
        if (stl * 64 <= 32 * w + qt * 16 + 15) {
          f32x4 sc[4];
          qk_tile1<2>(Bs + stl * 64 * KLD, cf, sc, l15, g);
#pragma unroll
          for (int kt = 0; kt < 4; ++kt) {
            const f32x4 as = *(const f32x4*)(acs + stl * 64 + kt * 16 + 4 * g);
#pragma unroll
            for (int r = 0; r < 4; ++r) {
              const bool ok = stl * 64 + kt * 16 + 4 * g + r <= tl;
              sc[kt][r] = ok ? sc[kt][r] * __expf(at - as[r]) : 0.f;
            }
          }
          pv_accum1(sc, Xs + stl * 64 * KLD, y, l15, g);
        }
      }
      const float ea = __expf(at), dsk = d_h / dts[tl];
      const size_t row = (size_t)b * SEQ + t0 + tl;
#pragma unroll
      for (int d = 0; d < 4; ++d) {
        f32x4 yo = (f32x4){0.f, 0.f, 0.f, 0.f};
#pragma unroll
        for (int ks = 0; ks < 2; ++ks) yo = mfma16(ldfrag(Ss + (d * 16 + l15) * KLD + ks * 32 + 8 * g), cf[ks], yo);
        const u32x2 xv = *(const u32x2*)(Xs + tl * KLD + d * 16 + 4 * g);
        const f32x4 v = y[d] + yo * ea;
        u32x2 o; o.x = pack2(v[0] + dsk * bflo(xv.x), v[1] + dsk * bfhi(xv.x)); o.y = pack2(v[2] + dsk * bflo(xv.y), v[3] + dsk * bfhi(xv.y));
        *(u32x2*)(Y + row * 1024 + Y_C + h * 64 + d * 16 + 4 * g) = o;
      }
    }
    if (c + 1 < 32) raw_load(projb, colX, t0 + 128, rX, tid);
    lds_barrier();
    scale_rows(Xs, wend);
    lds_barrier();
    const float cd = __expf(acs[127]);
#pragma unroll
    for (int nt = 0; nt < 4; ++nt) st[nt] *= cd;
    state_update(Xs, Bs, st, w, l15, g);
  }
}
DI void seq_fix_rows(const Params& p, int layer, int r0, int nrows) {
  u16* Y = (u16*)(p.ws + OFF_H);
  const u16* proj = (const u16*)(p.ws + OFF_PROJ);
  const int tid = otid(), lane = tid & 63, wv = tid >> 6;
  const bool ml = lane >= 32;
  const int ch = (lane & 31) * 8;
  const float* ng = ml ? p.ml_norm_g + layer * 64 + (ch & 63) : p.ssm_norm_g + layer * 256 + ch;
  const f32x4 g0 = *(const f32x4*)ng, g1 = *(const f32x4*)(ng + 4);
  for (int rb = wv * 4; rb < nrows; rb += 16) {
    u32x4 yv4[4], zv4[4], ov4[4];
#pragma unroll
    for (int j = 0; j < 4; ++j) {
      const size_t row = (size_t)(r0 + rb + j);
      yv4[j] = *(const u32x4*)(Y + row * 1024 + (ml ? Y_D : Y_C) + ch);
      zv4[j] = *(const u32x4*)(proj + row * NP + (ml ? PD_Z : PC_Z) + ch);
      ov4[j] = ml ? *(const u32x4*)(proj + row * NP + PD_O + ch) : (u32x4){0u, 0u, 0u, 0u};
    }
#pragma unroll
    for (int j = 0; j < 4; ++j) {
      const size_t row = (size_t)(r0 + rb + j);
      u16* yp = Y + row * 1024 + (ml ? Y_D : Y_C) + ch;
      const u32x4 yv = yv4[j], zv = zv4[j], ov = ov4[j];
      float v[8] = {bflo(yv.x), bfhi(yv.x), bflo(yv.y), bfhi(yv.y), bflo(yv.z), bfhi(yv.z), bflo(yv.w), bfhi(yv.w)};
      float z[8] = {bflo(zv.x), bfhi(zv.x), bflo(zv.y), bfhi(zv.y), bflo(zv.z), bfhi(zv.z), bflo(zv.w), bfhi(zv.w)};
      float ss = 0.f;
      if (ml) {
        const float o[8] = {bflo(ov.x), bfhi(ov.x), bflo(ov.y), bfhi(ov.y), bflo(ov.z), bfhi(ov.z), bflo(ov.w), bfhi(ov.w)};
#pragma unroll
        for (int i = 0; i < 8; ++i) { v[i] *= sigmoidf_(o[i]); ss += v[i] * v[i]; }
      } else {
#pragma unroll
        for (int i = 0; i < 8; ++i) { v[i] *= siluf(z[i]); ss += v[i] * v[i]; }
      }
      ss += __shfl_xor(ss, 1); ss += __shfl_xor(ss, 2); ss += __shfl_xor(ss, 4);
      const float ss16 = ss + __shfl_xor(ss, 8);
      const float rn = ml ? rsqrtf(ss * (1.f / 64.f) + 1e-6f) : rsqrtf(ss16 * (1.f / 128.f) + 1e-6f);
      float o8[8];
#pragma unroll
      for (int i = 0; i < 8; ++i) { const float gg = i < 4 ? g0[i & 3] : g1[i & 3]; o8[i] = v[i] * rn * gg * (ml ? siluf(z[i]) : 1.f); }
      u32x4 w; w.x = pack2(o8[0], o8[1]); w.y = pack2(o8[2], o8[3]); w.z = pack2(o8[4], o8[5]); w.w = pack2(o8[6], o8[7]);
      *(u32x4*)yp = w;
    }
  }
}

DI void mlstm_task(const Params& p, int layer, int b, int h, unsigned char* smem) {
  u16* Qs = (u16*)(smem + SEQ_LDS_A); u16* Ks2 = (u16*)(smem + SEQ_LDS_B); u16* Vs2 = (u16*)(smem + SEQ_LDS_C); u16* Cst = (u16*)(smem + SEQ_LDS_S);
  float* fl = (float*)(smem + SEQ_LDS_F);
  float* bcs = fl; float* us = fl + 128; float* pms = fl + 256; float* wend = fl + 384; float* nst = fl + 512; float* npart = fl + 576; float* tmp = fl + 832;
  u16* halo = (u16*)(smem + SEQ_LDS_HALO); float* cwl = (float*)(smem + SEQ_LDS_CW);
  int tid = otid(), lane = tid & 63, w = tid >> 6, l15 = lane & 15, g = lane >> 4;
  const u16* projb = (const u16*)(p.ws + OFF_PROJ) + (size_t)b * SEQ * NP;
  const float* smb = (const float*)(p.ws + OFF_SMALL) + (size_t)b * SEQ * NSMALL;
  const float* cw = p.ml_conv_w + layer * 4 * 512; const float* cb = p.ml_conv_b + layer * 512;
  const float ib = p.ml_if_b[layer * 8 + h], fb = p.ml_if_b[layer * 8 + 4 + h];
  u16* Y = (u16*)(p.ws + OFF_H);
  const int colQ = PD_QK + h * 64, colK = PD_QK + 256 + h * 64, colV = PD_V + h * 64;
  f32x4 st[4];
#pragma unroll
  for (int nt = 0; nt < 4; ++nt) st[nt] = (f32x4){0.f, 0.f, 0.f, 0.f};
  float m_prev = 0.f;
  lds_barrier();
  if (tid < 64) nst[tid] = 0.f;
  stage_conv_w(cwl, cw, cb, h * 64, 512, tid);
  stage_conv_w(cwl + 320, cw, cb, 256 + h * 64, 512, tid);
  for (int i = tid; i < 3 * 3 * 64; i += 256) halo[i] = 0;
  RawRegs rQ, rK, rV; float iraw = 0.f, fraw = 0.f;
  raw_load(projb, colQ, 0, rQ, tid); raw_load(projb, colK, 0, rK, tid); raw_load(projb, colV, 0, rV, tid);
  if (tid < 128) { iraw = smb[(size_t)tid * NSMALL + SM_IF + h]; fraw = smb[(size_t)tid * NSMALL + SM_IF + 4 + h]; }
#pragma unroll 1
  for (int c = 0; c < 32; ++c) {
    const int t0 = c * 128;
    asm volatile("" : "+v"(tid)); lane = tid & 63; w = tid >> 6; l15 = lane & 15; g = lane >> 4;
    u16* hcur = halo + (c & 1) * 576; u16* hnext = halo + ((c + 1) & 1) * 576;
    float ip = 0.f, lf = 0.f;
    if (tid < 128) { ip = iraw + ib; const float fp = fraw + fb; lf = fminf(fp, 0.f) - __logf(1.f + __expf(-fabsf(fp))); }
    float bc = wave_scan_add(lf, lane);
    if (tid == 63) tmp[0] = bc;
    lds_barrier();
    if (w == 1) bc += tmp[0];
    const float u = tid < 128 ? ip - bc : -1e30f;
    float pm = wave_scan_max(u, lane);
    if (tid == 63) tmp[1] = pm;
    raw_store(Qs, hnext, rQ, tid); raw_store(Ks2, hnext + 192, rK, tid); raw_store(Vs2, nullptr, rV, tid);
    lds_barrier();
    if (w == 1) pm = fmaxf(pm, tmp[1]);
    if (tid < 128) { bcs[tid] = bc; us[tid] = u; pms[tid] = pm; }
    if (c + 1 < 32) {
      raw_load(projb, colQ, t0 + 128, rQ, tid);
      if (tid < 128) { iraw = smb[(size_t)(t0 + 128 + tid) * NSMALL + SM_IF + h]; fraw = smb[(size_t)(t0 + 128 + tid) * NSMALL + SM_IF + 4 + h]; }
    }
    u32x4 oQ[4], oK[4];
    conv_from_lds(Qs, hcur, cwl, nullptr, 1.f, oQ, tid);
    __builtin_amdgcn_sched_barrier(0);
    conv_from_lds(Ks2, hcur + 192, cwl + 320, nullptr, 0.125f, oK, tid);
    __builtin_amdgcn_sched_barrier(0);
    lds_barrier();
    conv_write(Qs, oQ, tid); conv_write(Ks2, oK, tid);
    state_to_lds(Cst, st, w, l15, g);
    const float blast = bcs[127];
    const float m_new = blast + fmaxf(m_prev, pms[127]);
    if (tid < 128) wend[tid] = __expf(blast - m_new + us[tid]);
    lds_barrier();
#pragma unroll 1
    for (int qt = 0; qt < 2; ++qt) {
      const int tl = 32 * w + qt * 16 + l15;
      bf16x8 qf[2];
#pragma unroll
      for (int ks = 0; ks < 2; ++ks) qf[ks] = ldfrag(Qs + tl * KLD + ks * 32 + 8 * g);
      f32x4 num[4];
#pragma unroll
      for (int d = 0; d < 4; ++d) num[d] = (f32x4){0.f, 0.f, 0.f, 0.f};
      const float bt = bcs[tl], mt = bt + fmaxf(m_prev, pms[tl]);
      float den = 0.f;
#pragma unroll 1
      for (int stl = 0; stl < 2; ++stl) {
        if (stl * 64 <= 32 * w + qt * 16 + 15) {
          f32x4 sc[4];
          qk_tile1<2>(Ks2 + stl * 64 * KLD, qf, sc, l15, g);
#pragma unroll
          for (int kt = 0; kt < 4; ++kt) {
            const f32x4 uu = *(const f32x4*)(us + stl * 64 + kt * 16 + 4 * g);
#pragma unroll
            for (int r = 0; r < 4; ++r) {
              const bool ok = stl * 64 + kt * 16 + 4 * g + r <= tl;
              const float v = ok ? sc[kt][r] * __expf(bt - mt + uu[r]) : 0.f;
              sc[kt][r] = v; den += v;
            }
          }
          pv_accum1(sc, Vs2 + stl * 64 * KLD, num, l15, g);
        }
      }
      const float wi = __expf(bt + m_prev - mt);
      float qn = 0.f;
#pragma unroll
      for (int ks = 0; ks < 2; ++ks)
#pragma unroll
        for (int j = 0; j < 8; ++j) qn += bf2f((u16)qf[ks][j]) * nst[ks * 32 + 8 * g + j];
      qn = group_sum4(qn);
      const float dn = group_sum4(den) + wi * qn;
      const float inv = __builtin_amdgcn_rcpf(fmaxf(fabsf(dn), __expf(-mt)));
      const size_t row = (size_t)b * SEQ + t0 + tl;
#pragma unroll
      for (int d = 0; d < 4; ++d) {
        f32x4 ni = (f32x4){0.f, 0.f, 0.f, 0.f};
#pragma unroll
        for (int ks = 0; ks < 2; ++ks) ni = mfma16(ldfrag(Cst + (d * 16 + l15) * KLD + ks * 32 + 8 * g), qf[ks], ni);
        const f32x4 v = (num[d] + ni * wi) * inv;
        u32x2 o; o.x = pack2(v[0], v[1]); o.y = pack2(v[2], v[3]);
        *(u32x2*)(Y + row * 1024 + Y_D + h * 64 + d * 16 + 4 * g) = o;
      }
    }
    if (c + 1 < 32) { raw_load(projb, colK, t0 + 128, rK, tid); raw_load(projb, colV, t0 + 128, rV, tid); }
    lds_barrier();
    scale_rows(Ks2, wend);
    lds_barrier();
    const float fprev = __expf(blast + m_prev - m_new);
#pragma unroll
    for (int nt = 0; nt < 4; ++nt) st[nt] *= fprev;
    state_update(Vs2, Ks2, st, w, l15, g);
    {
      const int e = tid & 63, part = tid >> 6;
      float a = 0.f;
      for (int s2 = part * 32; s2 < part * 32 + 32; ++s2) a += bf2f(Ks2[s2 * KLD + e]);
      npart[part * 64 + e] = a;
    }
    lds_barrier();
    if (tid < 64) nst[tid] = nst[tid] * fprev + npart[tid] + npart[64 + tid] + npart[128 + tid] + npart[192 + tid];
    m_prev = m_new;
  }
}

constexpr int SEQ8_LDS_F = SEQ_LDS_S + 64 * KLD * 2;
constexpr int SEQ8_LDS_HALO = SEQ8_LDS_F + 8192;
constexpr int SEQ8_LDS_CW = SEQ8_LDS_HALO + 2 * 3 * 3 * 64 * 2;
struct RawRegs2 { u32x4 r[2]; };
DI void raw_load8(const u16* projb, int col0, int t0, RawRegs2& rr, int tid) {
#pragma unroll
  for (int i = 0; i < 2; ++i) rr.r[i] = *(const u32x4*)(projb + (size_t)(t0 + (tid >> 3) + 64 * i) * NP + col0 + (tid & 7) * 8);
}
DI void raw_store8(u16* dst, u16* halo_next, const RawRegs2& rr, int tid) {
#pragma unroll
  for (int i = 0; i < 2; ++i) *(u32x4*)(dst + ((tid >> 3) + 64 * i) * KLD + (tid & 7) * 8) = rr.r[i];
  if (halo_next && tid >= 488) *(u32x4*)(halo_next + ((tid >> 3) - 61) * 64 + (tid & 7) * 8) = rr.r[1];
}
DI void conv_from_lds8(const u16* raw, const u16* halo, const float* wl, const float* rowscale, float cscale, u32x4 (&out)[2], int tid) {
  const int q = tid >> 3, ch = (tid & 7) * 8;
  u32x4 v[5];
#pragma unroll
  for (int k = 0; k < 5; ++k) { const int r = 2 * q - 3 + k; v[k] = r >= 0 ? *(const u32x4*)(raw + r * KLD + ch) : *(const u32x4*)(halo + (r + 3) * 64 + ch); }
  float w[5][8];
#pragma unroll
  for (int j = 0; j < 5; ++j) { const f32x4 w0 = *(const f32x4*)(wl + j * 64 + ch), w1 = *(const f32x4*)(wl + j * 64 + ch + 4);
    w[j][0] = w0[0]; w[j][1] = w0[1]; w[j][2] = w0[2]; w[j][3] = w0[3]; w[j][4] = w1[0]; w[j][5] = w1[1]; w[j][6] = w1[2]; w[j][7] = w1[3]; }
#pragma unroll
  for (int o = 0; o < 2; ++o) {
    float acc[8];
#pragma unroll
    for (int i = 0; i < 8; ++i) acc[i] = w[4][i];
#pragma unroll
    for (int j = 0; j < 4; ++j) {
      const u32x4 x = v[o + j];
      acc[0] += w[j][0] * bflo(x.x); acc[1] += w[j][1] * bfhi(x.x); acc[2] += w[j][2] * bflo(x.y); acc[3] += w[j][3] * bfhi(x.y);
      acc[4] += w[j][4] * bflo(x.z); acc[5] += w[j][5] * bfhi(x.z); acc[6] += w[j][6] * bflo(x.w); acc[7] += w[j][7] * bfhi(x.w);
    }
    const float rs = (rowscale ? rowscale[2 * q + o] : 1.f) * cscale;
#pragma unroll
    for (int i = 0; i < 8; ++i) acc[i] = siluf(acc[i]) * rs;
    out[o].x = pack2(acc[0], acc[1]); out[o].y = pack2(acc[2], acc[3]); out[o].z = pack2(acc[4], acc[5]); out[o].w = pack2(acc[6], acc[7]);
  }
}
DI void conv_write8(u16* dst, const u32x4 (&out)[2], int tid) {
  const int q = tid >> 3, ch = (tid & 7) * 8;
#pragma unroll
  for (int o = 0; o < 2; ++o) *(u32x4*)(dst + (2 * q + o) * KLD + ch) = out[o];
}
DI void stage_conv_w8(float* wl, const float* cw, const float* cb, int chan0, int nchan, int tid) {
  if (tid < 320) { const int j = tid >> 6, cc = tid & 63; wl[tid] = j < 4 ? cw[j * nchan + chan0 + cc] : cb[chan0 + cc]; }
}
DI void scale_rows8(u16* A, const float* rs, int tid) {
  const int ch = (tid & 7) * 8;
#pragma unroll
  for (int i = 0; i < 2; ++i) {
    const int row = (tid >> 3) + 64 * i;
    const float f = rs[row];
    u32x4 v = *(u32x4*)(A + row * KLD + ch);
    v.x = pack2(bflo(v.x) * f, bfhi(v.x) * f); v.y = pack2(bflo(v.y) * f, bfhi(v.y) * f);
    v.z = pack2(bflo(v.z) * f, bfhi(v.z) * f); v.w = pack2(bflo(v.w) * f, bfhi(v.w) * f);
    *(u32x4*)(A + row * KLD + ch) = v;
  }
}
DI void state_update8(const u16* Xs, const u16* Bs, f32x4 (&acc)[2], int w8, int l15, int g) {
  const int tq = l15 >> 2, tp = l15 & 3, pt = w8 >> 1, nt0 = (w8 & 1) * 2;
#pragma unroll
  for (int kk = 0; kk < 4; ++kk) {
    const bf16x8 af = cat4(tr_read(Xs + (kk * 32 + 4 * g + tq) * KLD + pt * 16 + 4 * tp), tr_read(Xs + (kk * 32 + 16 + 4 * g + tq) * KLD + pt * 16 + 4 * tp));
#pragma unroll
    for (int n = 0; n < 2; ++n) {
      const bf16x8 bfr = cat4(tr_read(Bs + (kk * 32 + 4 * g + tq) * KLD + (nt0 + n) * 16 + 4 * tp), tr_read(Bs + (kk * 32 + 16 + 4 * g + tq) * KLD + (nt0 + n) * 16 + 4 * tp));
      acc[n] = mfma16(af, bfr, acc[n]);
    }
  }
}
DI void state_to_lds8(u16* Ss, const f32x4 (&acc)[2], int w8, int l15, int g) {
  const int pt = w8 >> 1, nt0 = (w8 & 1) * 2;
#pragma unroll
  for (int n = 0; n < 2; ++n)
#pragma unroll
    for (int r = 0; r < 4; ++r) Ss[(pt * 16 + 4 * g + r) * KLD + (nt0 + n) * 16 + l15] = f2bf(acc[n][r]);
}

constexpr int SEQ8_LDS_ZERO = SEQ8_LDS_CW + 3 * 320 * 4;
constexpr int SEQ8_LDS_RAW = ((SEQ8_LDS_ZERO + 3 * 128 + 255) / 256) * 256;
DI void raw_dma8(const u16* projb, int col0, int t0, u16* raw, int tid) {
#pragma unroll
  for (int i = 0; i < 2; ++i) {
    const int chunk = tid + 512 * i;
    __builtin_amdgcn_global_load_lds((const unsigned*)(projb + (size_t)(t0 + (chunk >> 3)) * NP + col0 + (chunk & 7) * 8), (LDSP unsigned*)((LDSP char*)raw + chunk * 16), 16, 0, 0);
  }
}
DI void conv_raw8(const u16* raw, const u16* halo, const float* wl, const float* rowscale, float cscale, u16* dst, int tid) {
  const int q = tid >> 3, ch = (tid & 7) * 8;
  u32x4 v[5];
#pragma unroll
  for (int k = 0; k < 5; ++k) { const int r = 2 * q - 3 + k; v[k] = r >= 0 ? *(const u32x4*)(raw + r * 64 + ch) : *(const u32x4*)(halo + (r + 3) * 64 + ch); }
  float w[5][8];
#pragma unroll
  for (int j = 0; j < 5; ++j) { const f32x4 w0 = *(const f32x4*)(wl + j * 64 + ch), w1 = *(const f32x4*)(wl + j * 64 + ch + 4);
    w[j][0] = w0[0]; w[j][1] = w0[1]; w[j][2] = w0[2]; w[j][3] = w0[3]; w[j][4] = w1[0]; w[j][5] = w1[1]; w[j][6] = w1[2]; w[j][7] = w1[3]; }
#pragma unroll
  for (int o = 0; o < 2; ++o) {
    float acc[8];
#pragma unroll
    for (int i = 0; i < 8; ++i) acc[i] = w[4][i];
#pragma unroll
    for (int j = 0; j < 4; ++j) {
      const u32x4 x = v[o + j];
      acc[0] += w[j][0] * bflo(x.x); acc[1] += w[j][1] * bfhi(x.x); acc[2] += w[j][2] * bflo(x.y); acc[3] += w[j][3] * bfhi(x.y);
      acc[4] += w[j][4] * bflo(x.z); acc[5] += w[j][5] * bfhi(x.z); acc[6] += w[j][6] * bflo(x.w); acc[7] += w[j][7] * bfhi(x.w);
    }
    const float rs = (rowscale ? rowscale[2 * q + o] : 1.f) * cscale;
#pragma unroll
    for (int i = 0; i < 8; ++i) acc[i] = siluf(acc[i]) * rs;
    u32x4 ov; ov.x = pack2(acc[0], acc[1]); ov.y = pack2(acc[2], acc[3]); ov.z = pack2(acc[4], acc[5]); ov.w = pack2(acc[6], acc[7]);
    *(u32x4*)(dst + (2 * q + o) * KLD + ch) = ov;
  }
}
DI void save_halo8(const u16* raw, u16* halo, int tid) {
  if (tid < 72) { const int arr = tid / 24, rem = tid % 24; *(u32x4*)(halo + arr * 192 + rem * 8) = *(const u32x4*)(raw + arr * 8192 + 125 * 64 + rem * 8); }
}

DI void ssd_task8(const Params& p, int layer, int b, int h, unsigned char* smem) {
  u16* Cs = (u16*)(smem + SEQ_LDS_A); u16* Bs = (u16*)(smem + SEQ_LDS_B); u16* Xs = (u16*)(smem + SEQ_LDS_C); u16* Ss = (u16*)(smem + SEQ_LDS_S);
  float* fl = (float*)(smem + SEQ8_LDS_F);
  float* dts = fl; float* acs = fl + 128; float* wend = fl + 256; float* tmp = fl + 384;
  u16* halo = (u16*)(smem + SEQ8_LDS_HALO); float* cwl = (float*)(smem + SEQ8_LDS_CW); u16* zero3 = (u16*)(smem + SEQ8_LDS_ZERO);
  u16* raw = (u16*)(smem + SEQ8_LDS_RAW);
  int tid = otid512(), lane = tid & 63, w = tid >> 6, l15 = lane & 15, g = lane >> 4;
  const int gi = h >> 1;
  const u16* projb = (const u16*)(p.ws + OFF_PROJ) + (size_t)b * SEQ * NP;
  const float* smb = (const float*)(p.ws + OFF_SMALL) + (size_t)b * SEQ * NSMALL;
  const float* cw = p.ssm_conv_w + layer * 4 * 512; const float* cb = p.ssm_conv_b + layer * 512;
  u16* Y = (u16*)(p.ws + OFF_H);
  const float a_h = sgprf(-__expf(p.ssm_a_log[layer * 4 + h])), d_h = sgprf(p.ssm_d[layer * 4 + h]), dtb = sgprf(p.ssm_dt_bias[layer * 4 + h]);
  const int colB = PC_XBC + 256 + gi * 64, colC = PC_XBC + 384 + gi * 64, colX = PC_XBC + h * 64;
  f32x4 st[2] = {(f32x4){0.f, 0.f, 0.f, 0.f}, (f32x4){0.f, 0.f, 0.f, 0.f}};
  lds_barrier();
  stage_conv_w8(cwl, cw, cb, 256 + gi * 64, 512, tid);
  stage_conv_w8(cwl + 320, cw, cb, 384 + gi * 64, 512, tid);
  stage_conv_w8(cwl + 640, cw, cb, h * 64, 512, tid);
  if (tid < 96) ((unsigned*)zero3)[tid] = 0u;
  raw_dma8(projb, colB, 0, raw, tid); raw_dma8(projb, colC, 0, raw + 8192, tid); raw_dma8(projb, colX, 0, raw + 16384, tid);
  float dtraw = 0.f;
  if (tid < 128) dtraw = smb[(size_t)tid * NSMALL + SM_DT + h];
#pragma unroll 1
  for (int c = 0; c < 32; ++c) {
    const int t0 = c * 128;
    asm volatile("" : "+v"(tid)); lane = tid & 63; w = tid >> 6; l15 = lane & 15; g = lane >> 4;
    float dtv = 0.f;
    if (tid < 128) { const float xr = dtraw + dtb; dtv = xr > 15.f ? xr : __logf(1.f + __expf(xr)); }
    float cs = wave_scan_add(dtv * a_h, lane);
    if (tid == 63) tmp[0] = cs;
    asm volatile("s_waitcnt vmcnt(0)" ::: "memory");
    lds_barrier();
    if (w == 1) cs += tmp[0];
    if (tid < 128) { dts[tid] = dtv; acs[tid] = cs; }
    if (c + 1 < 32 && tid < 128) dtraw = smb[(size_t)(t0 + 128 + tid) * NSMALL + SM_DT + h];
    lds_barrier();
    {
      const u16* hc = halo + (c & 1) * 576;
      const u16* hB = c == 0 ? zero3 : hc; const u16* hC = c == 0 ? zero3 : hc + 192; const u16* hX = c == 0 ? zero3 : hc + 384;
      conv_raw8(raw, hB, cwl, nullptr, 1.f, Bs, tid);
      conv_raw8(raw + 8192, hC, cwl + 320, nullptr, 1.f, Cs, tid);
      conv_raw8(raw + 16384, hX, cwl + 640, dts, 1.f, Xs, tid);
      save_halo8(raw, halo + ((c + 1) & 1) * 576, tid);
    }
    if (tid < 128) wend[tid] = __expf(acs[127] - acs[tid]);
    state_to_lds8(Ss, st, w, l15, g);
    lds_barrier();
    if (c + 1 < 32) { raw_dma8(projb, colB, t0 + 128, raw, tid); raw_dma8(projb, colC, t0 + 128, raw + 8192, tid); raw_dma8(projb, colX, t0 + 128, raw + 16384, tid); }
    {
      const int tl = 16 * w + l15;
      bf16x8 cf[2];
#pragma unroll
      for (int ks = 0; ks < 2; ++ks) cf[ks] = ldfrag(Cs + tl * KLD + ks * 32 + 8 * g);
      f32x4 y[4];
#pragma unroll
      for (int d = 0; d < 4; ++d) y[d] = (f32x4){0.f, 0.f, 0.f, 0.f};
      const float at = acs[tl];
#pragma unroll 1
      for (int stl = 0; stl < 2; ++stl) {
        if (stl * 64 <= 16 * w + 15) {
          f32x4 sc[4];
          qk_tile1<2>(Bs + stl * 64 * KLD, cf, sc, l15, g);
#pragma unroll
          for (int kt = 0; kt < 4; ++kt) {
            const f32x4 as = *(const f32x4*)(acs + stl * 64 + kt * 16 + 4 * g);
#pragma unroll
            for (int r = 0; r < 4; ++r) {
              const bool ok = stl * 64 + kt * 16 + 4 * g + r <= tl;
              sc[kt][r] = ok ? sc[kt][r] * __expf(at - as[r]) : 0.f;
            }
          }
          pv_accum1(sc, Xs + stl * 64 * KLD, y, l15, g);
        }
      }
      const float ea = __expf(at), dsk = d_h / dts[tl];
      const size_t row = (size_t)b * SEQ + t0 + tl;
#pragma unroll
      for (int d = 0; d < 4; ++d) {
        f32x4 yo = (f32x4){0.f, 0.f, 0.f, 0.f};
#pragma unroll
        for (int ks = 0; ks < 2; ++ks) yo = mfma16(ldfrag(Ss + (d * 16 + l15) * KLD + ks * 32 + 8 * g), cf[ks], yo);
        const u32x2 xv = *(const u32x2*)(Xs + tl * KLD + d * 16 + 4 * g);
        const f32x4 v = y[d] + yo * ea;
        u32x2 o; o.x = pack2(v[0] + dsk * bflo(xv.x), v[1] + dsk * bfhi(xv.x)); o.y = pack2(v[2] + dsk * bflo(xv.y), v[3] + dsk * bfhi(xv.y));
        *(u32x2*)(Y + row * 1024 + Y_C + h * 64 + d * 16 + 4 * g) = o;
      }
    }
    lds_barrier();
    scale_rows8(Xs, wend, tid);
    lds_barrier();
    const float cd = __expf(acs[127]);
    st[0] *= cd; st[1] *= cd;
    state_update8(Xs, Bs, st, w, l15, g);
  }
  asm volatile("s_waitcnt vmcnt(0)" ::: "memory");
}

DI void mlstm_task8(const Params& p, int layer, int b, int h, unsigned char* smem) {
  u16* Qs = (u16*)(smem + SEQ_LDS_A); u16* Ks2 = (u16*)(smem + SEQ_LDS_B); u16* Vs2 = (u16*)(smem + SEQ_LDS_C); u16* Cst = (u16*)(smem + SEQ_LDS_S);
  float* fl = (float*)(smem + SEQ8_LDS_F);
  float* bcs = fl; float* us = fl + 128; float* pms = fl + 256; float* wend = fl + 384; float* nst = fl + 512; float* tmp = fl + 576; float* npart = fl + 640;
  u16* halo = (u16*)(smem + SEQ8_LDS_HALO); float* cwl = (float*)(smem + SEQ8_LDS_CW); u16* zero3 = (u16*)(smem + SEQ8_LDS_ZERO);
  u16* raw = (u16*)(smem + SEQ8_LDS_RAW);
  int tid = otid512(), lane = tid & 63, w = tid >> 6, l15 = lane & 15, g = lane >> 4;
  const u16* projb = (const u16*)(p.ws + OFF_PROJ) + (size_t)b * SEQ * NP;
  const float* smb = (const float*)(p.ws + OFF_SMALL) + (size_t)b * SEQ * NSMALL;
  const float* cw = p.ml_conv_w + layer * 4 * 512; const float* cb = p.ml_conv_b + layer * 512;
  const float ib = sgprf(p.ml_if_b[layer * 8 + h]), fb = sgprf(p.ml_if_b[layer * 8 + 4 + h]);
  u16* Y = (u16*)(p.ws + OFF_H);
  const int colQ = PD_QK + h * 64, colK = PD_QK + 256 + h * 64, colV = PD_V + h * 64;
  f32x4 st[2] = {(f32x4){0.f, 0.f, 0.f, 0.f}, (f32x4){0.f, 0.f, 0.f, 0.f}};
  float m_prev = 0.f;
  lds_barrier();
  if (tid < 64) nst[tid] = 0.f;
  stage_conv_w8(cwl, cw, cb, h * 64, 512, tid);
  stage_conv_w8(cwl + 320, cw, cb, 256 + h * 64, 512, tid);
  if (tid < 96) ((unsigned*)zero3)[tid] = 0u;
  raw_dma8(projb, colQ, 0, raw, tid); raw_dma8(projb, colK, 0, raw + 8192, tid); raw_dma8(projb, colV, 0, raw + 16384, tid);
  float iraw = 0.f, fraw = 0.f;
  if (tid < 128) { iraw = smb[(size_t)tid * NSMALL + SM_IF + h]; fraw = smb[(size_t)tid * NSMALL + SM_IF + 4 + h]; }
#pragma unroll 1
  for (int c = 0; c < 32; ++c) {
    const int t0 = c * 128;
    asm volatile("" : "+v"(tid)); lane = tid & 63; w = tid >> 6; l15 = lane & 15; g = lane >> 4;
    float ip = 0.f, lf = 0.f;
    if (tid < 128) { ip = iraw + ib; const float fp = fraw + fb; lf = fminf(fp, 0.f) - __logf(1.f + __expf(-fabsf(fp))); }
    float bc = wave_scan_add(lf, lane);
    if (tid == 63) tmp[0] = bc;
    asm volatile("s_waitcnt vmcnt(0)" ::: "memory");
    lds_barrier();
    if (w == 1) bc += tmp[0];
    const float u = tid < 128 ? ip - bc : -1e30f;
    float pm = wave_scan_max(u, lane);
    if (tid == 63) tmp[1] = pm;
    if (c + 1 < 32 && tid < 128) { iraw = smb[(size_t)(t0 + 128 + tid) * NSMALL + SM_IF + h]; fraw = smb[(size_t)(t0 + 128 + tid) * NSMALL + SM_IF + 4 + h]; }
    {
      const u16* hc = halo + (c & 1) * 576;
      const u16* hQ = c == 0 ? zero3 : hc; const u16* hK = c == 0 ? zero3 : hc + 192;
      conv_raw8(raw, hQ, cwl, nullptr, 1.f, Qs, tid);
      conv_raw8(raw + 8192, hK, cwl + 320, nullptr, 0.125f, Ks2, tid);
      save_halo8(raw, halo + ((c + 1) & 1) * 576, tid);
#pragma unroll
      for (int i = 0; i < 2; ++i) { const int chunk = tid + 512 * i; *(u32x4*)(Vs2 + (chunk >> 3) * KLD + (chunk & 7) * 8) = *(const u32x4*)(raw + 16384 + chunk * 8); }
    }
    state_to_lds8(Cst, st, w, l15, g);
    lds_barrier();
    if (w == 1) pm = fmaxf(pm, tmp[1]);
    if (tid < 128) { bcs[tid] = bc; us[tid] = u; pms[tid] = pm; }
    if (c + 1 < 32) { raw_dma8(projb, colQ, t0 + 128, raw, tid); raw_dma8(projb, colK, t0 + 128, raw + 8192, tid); raw_dma8(projb, colV, t0 + 128, raw + 16384, tid); }
    lds_barrier();
    const float blast = bcs[127];
    const float m_new = blast + fmaxf(m_prev, pms[127]);
    if (tid < 128) wend[tid] = __expf(blast - m_new + us[tid]);
    {
      const int tl = 16 * w + l15;
      bf16x8 qf[2];
#pragma unroll
      for (int ks = 0; ks < 2; ++ks) qf[ks] = ldfrag(Qs + tl * KLD + ks * 32 + 8 * g);
      f32x4 num[4];
#pragma unroll
      for (int d = 0; d < 4; ++d) num[d] = (f32x4){0.f, 0.f, 0.f, 0.f};
      const float bt = bcs[tl], mt = bt + fmaxf(m_prev, pms[tl]);
      float den = 0.f;
#pragma unroll 1
      for (int stl = 0; stl < 2; ++stl) {
        if (stl * 64 <= 16 * w + 15) {
          f32x4 sc[4];
          qk_tile1<2>(Ks2 + stl * 64 * KLD, qf, sc, l15, g);
#pragma unroll
          for (int kt = 0; kt < 4; ++kt) {
            const f32x4 uu = *(const f32x4*)(us + stl * 64 + kt * 16 + 4 * g);
#pragma unroll
            for (int r = 0; r < 4; ++r) {
              const bool ok = stl * 64 + kt * 16 + 4 * g + r <= tl;
              const float v = ok ? sc[kt][r] * __expf(bt - mt + uu[r]) : 0.f;
              sc[kt][r] = v; den += v;
            }
          }
          pv_accum1(sc, Vs2 + stl * 64 * KLD, num, l15, g);
        }
      }
      const float wi = __expf(bt + m_prev - mt);
      float qn = 0.f;
#pragma unroll
      for (int ks = 0; ks < 2; ++ks)
#pragma unroll
        for (int j = 0; j < 8; ++j) qn += bf2f((u16)qf[ks][j]) * nst[ks * 32 + 8 * g + j];
      qn = group_sum4(qn);
      const float dn = group_sum4(den) + wi * qn;
      const float inv = __builtin_amdgcn_rcpf(fmaxf(fabsf(dn), __expf(-mt)));
      const size_t row = (size_t)b * SEQ + t0 + tl;
#pragma unroll
      for (int d = 0; d < 4; ++d) {
        f32x4 ni = (f32x4){0.f, 0.f, 0.f, 0.f};
#pragma unroll
        for (int ks = 0; ks < 2; ++ks) ni = mfma16(ldfrag(Cst + (d * 16 + l15) * KLD + ks * 32 + 8 * g), qf[ks], ni);
        const f32x4 v = (num[d] + ni * wi) * inv;
        u32x2 o; o.x = pack2(v[0], v[1]); o.y = pack2(v[2], v[3]);
        *(u32x2*)(Y + row * 1024 + Y_D + h * 64 + d * 16 + 4 * g) = o;
      }
    }
    lds_barrier();
    scale_rows8(Ks2, wend, tid);
    lds_barrier();
    const float fprev = __expf(blast + m_prev - m_new);
    st[0] *= fprev; st[1] *= fprev;
    state_update8(Vs2, Ks2, st, w, l15, g);
    {
      const int e = tid & 63, part = tid >> 6;
      float a = 0.f;
#pragma unroll
      for (int s2 = 0; s2 < 16; ++s2) a += bf2f(Ks2[(part * 16 + s2) * KLD + e]);
      npart[part * 64 + e] = a;
    }
    lds_barrier();
    if (tid < 64) {
      float a = nst[tid] * fprev;
#pragma unroll
      for (int pp = 0; pp < 8; ++pp) a += npart[pp * 64 + tid];
      nst[tid] = a;
    }
    m_prev = m_new;
  }
  asm volatile("s_waitcnt vmcnt(0)" ::: "memory");
}

DI void compress_task(const Params& p, int layer, int b, int kv, int rb, unsigned char* smem) {
  constexpr int HLD = 136;
  u16* Hs = (u16*)smem;
  const int tid = otid(), lane = tid & 63, w = tid >> 6, l15 = lane & 15, g = lane >> 4;
  const u16* projb = (const u16*)(p.ws + OFF_PROJ) + (size_t)b * SEQ * NP + (kv ? PA_VC : PA_KC);
  const int mi = layer * 2 + kv;
  const u16* W1T = (const u16*)(p.ws + OFF_W1T) + (size_t)mi * 128 * 2048;
  const u16* W2T = (const u16*)(p.ws + OFF_W2T) + (size_t)mi * 64 * 128;
  const float* bias1 = (const float*)(p.ws + OFF_BIAS1) + mi * 16 * 128;
  f32x4 acc[2][2];
#pragma unroll
  for (int nt = 0; nt < 2; ++nt) { acc[nt][0] = (f32x4){0.f, 0.f, 0.f, 0.f}; acc[nt][1] = (f32x4){0.f, 0.f, 0.f, 0.f}; }
  int tok[2];
#pragma unroll
  for (int mt = 0; mt < 2; ++mt) { int i = rb * 32 + mt * 16 + l15; if (i > 254) i = 254; tok[mt] = 16 * i; }
#pragma unroll 4
  for (int ks = 0; ks < 64; ++ks) {
    const int j = ks >> 1, d0 = (ks & 1) * 32;
    bf16x8 af[2], wf[2];
#pragma unroll
    for (int mt = 0; mt < 2; ++mt) af[mt] = ldfrag(projb + (size_t)(tok[mt] + j) * NP + d0 + 8 * g);
#pragma unroll
    for (int nt = 0; nt < 2; ++nt) wf[nt] = ldfrag(W1T + (size_t)(w * 32 + nt * 16 + l15) * 2048 + ks * 32 + 8 * g);
#pragma unroll
    for (int nt = 0; nt < 2; ++nt)
#pragma unroll
      for (int mt = 0; mt < 2; ++mt) acc[nt][mt] = mfma16(wf[nt], af[mt], acc[nt][mt]);
  }
  lds_barrier();
#pragma unroll
  for (int nt = 0; nt < 2; ++nt) {
    const int n = w * 32 + nt * 16 + 4 * g;
    f32x4 bb = *(const f32x4*)(bias1 + n);
#pragma unroll
    for (int pc = 1; pc < 16; ++pc) bb += *(const f32x4*)(bias1 + pc * 128 + n);
#pragma unroll
    for (int mt = 0; mt < 2; ++mt) {
      const f32x4 v = acc[nt][mt] + bb;
      u32x2 o; o.x = pack2(siluf(v[0]), siluf(v[1])); o.y = pack2(siluf(v[2]), siluf(v[3]));
      *(u32x2*)(Hs + (mt * 16 + l15) * HLD + n) = o;
    }
  }
  lds_barrier();
  f32x4 acc2[2] = {(f32x4){0.f, 0.f, 0.f, 0.f}, (f32x4){0.f, 0.f, 0.f, 0.f}};
#pragma unroll
  for (int ks = 0; ks < 4; ++ks) {
    const bf16x8 wf = ldfrag(W2T + (size_t)(w * 16 + l15) * 128 + ks * 32 + 8 * g);
#pragma unroll
    for (int mt = 0; mt < 2; ++mt) acc2[mt] = mfma16(wf, ldfrag(Hs + (mt * 16 + l15) * HLD + ks * 32 + 8 * g), acc2[mt]);
  }
  u16* dst = (u16*)(p.ws + (kv ? OFF_VCMP : OFF_KCMP) + (size_t)layer * 512 * 1024) + (size_t)b * 256 * 64;
#pragma unroll
  for (int mt = 0; mt < 2; ++mt) {
    const int i = rb * 32 + mt * 16 + l15;
    u32x2 o; o.x = pack2(acc2[mt][0], acc2[mt][1]); o.y = pack2(acc2[mt][2], acc2[mt][3]);
    if (i > 254) { o.x = 0u; o.y = 0u; }
    *(u32x2*)(dst + (size_t)i * 64 + w * 16 + 4 * g) = o;
  }
}

DI void nsa_task(const Params& p, int layer, int b, int qi, unsigned char* smem) {
  u16* Ks = (u16*)smem; u16* Vs = Ks + 64 * KLD;
  float* T = (float*)(smem + 2 * KVBUF * 2);
  unsigned long long* selm = (unsigned long long*)(smem + 2 * KVBUF * 2 + 4 * 32 * 65 * 4);
  const int tid = otid(), lane = tid & 63, h = tid >> 6, l15 = lane & 15, g = lane >> 4;
  const int q0 = qi * 32;
  const u16* projb = (const u16*)(p.ws + OFF_PROJ) + (size_t)b * SEQ * NP;
  const float* smb = (const float*)(p.ws + OFF_SMALL) + (size_t)b * SEQ * NSMALL;
  const u16* kcmp = (const u16*)(p.ws + OFF_KCMP + (size_t)layer * 512 * 1024) + (size_t)b * 256 * 64;
  const u16* vcmp = (const u16*)(p.ws + OFF_VCMP + (size_t)layer * 512 * 1024) + (size_t)b * 256 * 64;
  bf16x8 qf[2][2];
#pragma unroll
  for (int qt = 0; qt < 2; ++qt)
#pragma unroll
    for (int ks = 0; ks < 2; ++ks) qf[qt][ks] = ldfrag(projb + (size_t)(q0 + qt * 16 + l15) * NP + PA_Q + h * 64 + ks * 32 + 8 * g);
  const float sc = 0.125f * 1.4426950408889634f;
  f32x4 outacc[4][2];
  AttnAcc a;
  const int ntc = (q0 >> 10) + 1;
  attn_init(a);
  lds_barrier();
  for (int i = tid; i < 4 * 32 * 65; i += 256) T[i] = 0.f;
  kv_pipeline(0, ntc, Ks,
    [&](int) { return true; },
    [&](int j, KVRegs& kr) { kv_load(kcmp, vcmp, 64, 64, j * 64, kr); },
    [&](int j, const u16* Kt, const u16* Vt) {
      f32x4 s[4][2];
      auto valid = [&](int kt, int r, int qt) { return 16 * (j * 64 + kt * 16 + 4 * g + r) + 31 <= q0 + qt * 16 + l15; };
      qk_tile<2>(Kt, 0, qf, s, l15, g);
      softmax_pv(s, a, Vt, sc, l15, g, valid);
    });
  float cinv[2];
#pragma unroll
  for (int qt = 0; qt < 2; ++qt) {
    const float lt = group_sum4(a.l[qt]);
    cinv[qt] = lt > 0.f ? 1.f / lt : 0.f;
    const float gt = sigmoidf_(smb[(size_t)(q0 + qt * 16 + l15) * NSMALL + SM_G + h * 3 + 0]) * cinv[qt];
#pragma unroll
    for (int d = 0; d < 4; ++d) outacc[d][qt] = a.o[d][qt] * gt;
  }
  float carry[2] = {0.f, 0.f};
  kv_pipeline(0, ntc, Ks,
    [&](int) { return true; },
    [&](int j, KVRegs& kr) { kv_load(kcmp, vcmp, 64, 64, j * 64, kr); },
    [&](int j, const u16* Kt, const u16*) {
      f32x4 s[4][2];
      qk_tile<2>(Kt, 0, qf, s, l15, g);
#pragma unroll
      for (int qt = 0; qt < 2; ++qt) {
        float prev3 = carry[qt];
#pragma unroll
        for (int kt = 0; kt < 4; ++kt) {
          float pr[4];
#pragma unroll
          for (int r = 0; r < 4; ++r) {
            const bool ok = 16 * (j * 64 + kt * 16 + 4 * g + r) + 31 <= q0 + qt * 16 + l15;
            pr[r] = ok ? exp2_(s[kt][qt][r] * sc - a.m[qt]) * cinv[qt] : 0.f;
          }
          const float below = __shfl_up(pr[3], 16);
          const float wrap = __shfl(prev3, l15 + 48);
          const float nb = g > 0 ? below : wrap;
          T[(h * 32 + qt * 16 + l15) * 65 + j * 16 + kt * 4 + g] = (pr[0] + pr[1]) + (pr[2] + 0.5f * pr[3]) + 0.5f * nb;
          prev3 = pr[3];
        }
        carry[qt] = prev3;
      }
    });
  lds_barrier();
#pragma unroll 1
  for (int qq = 0; qq < 8; ++qq) {
    const int q = h * 8 + qq, t = q0 + q, cur = t >> 6;
    const float imp = ((T[(0 * 32 + q) * 65 + lane] + T[(1 * 32 + q) * 65 + lane]) + T[(2 * 32 + q) * 65 + lane]) + T[(3 * 32 + q) * 65 + lane];
    const bool forced = lane == cur || lane == 0, allowed = lane <= cur, cand = allowed && !forced;
    const int K = cur == 0 ? 15 : 14;
    unsigned long long m;
    if (__popcll(__ballot(cand)) <= K) m = __ballot(allowed);
    else {
      const unsigned key = __float_as_uint(imp);
      unsigned prefix = 0u;
#pragma unroll 1
      for (int bit = 30; bit >= 0; --bit) {
        const unsigned cnd = prefix | (1u << bit);
        if (__popcll(__ballot(cand && key >= cnd)) >= K) prefix = cnd;
      }
      const unsigned long long gt = __ballot(cand && key > prefix), eq = __ballot(cand && key == prefix);
      const int need = K - __popcll(gt);
      const int myrank = __popcll(eq & ((1ull << lane) - 1ull));
      m = gt | __ballot(cand && key == prefix && myrank < need) | __ballot(forced);
    }
    if (lane == 0) selm[q] = m;
  }
  lds_barrier();
  f32x4* park = (f32x4*)T + (h * 8) * 64 + lane;
#pragma unroll
  for (int d = 0; d < 4; ++d) { park[(d * 2 + 0) * 64] = outacc[d][0]; park[(d * 2 + 1) * 64] = outacc[d][1]; }
  unsigned long long mq[2], anym = 0ull;
#pragma unroll
  for (int qt = 0; qt < 2; ++qt) mq[qt] = selm[qt * 16 + l15];
  for (int i = 0; i < 32; ++i) anym |= selm[i];
  const int jhi = (q0 + 31) >> 6;
#pragma unroll
  for (int qt = 0; qt < 2; ++qt)
#pragma unroll
    for (int ks = 0; ks < 2; ++ks) qf[qt][ks] = scale_frag(qf[qt][ks], sc);
  attn_init_rel(a);
  kv_pipeline(0, jhi + 1, Ks,
    [&](int j) { return (bool)((anym >> j) & 1ull); },
    [&](int j, KVRegs& kr) { kv_load(projb + PA_KS, projb + PA_VS, NP, NP, j * 64, kr); },
    [&](int j, const u16* Kt, const u16* Vt) {
      f32x4 s[4][2];
      auto valid = [&](int kt, int r, int qt) { return ((mq[qt] >> j) & 1ull) && (j * 64 + kt * 16 + 4 * g + r <= q0 + qt * 16 + l15); };
      bf16x8 pf[2][2];
      qk_tile_rel<2>(Kt, 0, qf, a, s, l15, g);
      if (j * 64 + 63 <= q0) softmax_rel<2>(s, a, pf, l15, valid, (bool)((mq[0] >> j) & 1ull), (bool)((mq[1] >> j) & 1ull));
      else softmax_rel<1>(s, a, pf, l15, valid);
      pv_accum(pf, Vt, a.o, l15, g);
      rowsum_accum(pf, a, l15);
    });
#pragma unroll
  for (int qt = 0; qt < 2; ++qt) {
    const float lt = rel_rowsum(a, qt, l15);
    const float gt = sigmoidf_(smb[(size_t)(q0 + qt * 16 + l15) * NSMALL + SM_G + h * 3 + 1]) * (lt > 0.f ? 1.f / lt : 0.f);
#pragma unroll
    for (int d = 0; d < 4; ++d) park[(d * 2 + qt) * 64] += a.o[d][qt] * gt;
  }
  attn_init_rel(a);
  const int jlo = q0 >= 511 ? (q0 - 511) >> 6 : 0;
  kv_pipeline(jlo, jhi + 1, Ks,
    [&](int) { return true; },
    [&](int j, KVRegs& kr) { kv_load(projb + PA_KW, projb + PA_VW, NP, NP, j * 64, kr); },
    [&](int j, const u16* Kt, const u16* Vt) {
      f32x4 s[4][2];
      auto valid = [&](int kt, int r, int qt) { const int key = j * 64 + kt * 16 + 4 * g + r, t = q0 + qt * 16 + l15; return key <= t && key + 512 > t; };
      bf16x8 pf[2][2];
      qk_tile_rel<2>(Kt, 0, qf, a, s, l15, g);
      if (j * 64 + 63 <= q0 && j * 64 + 512 > q0 + 31) softmax_rel<0>(s, a, pf, l15, valid);
      else softmax_rel<1>(s, a, pf, l15, valid);
      pv_accum(pf, Vt, a.o, l15, g);
      rowsum_accum(pf, a, l15);
    });
  u16* Y = (u16*)(p.ws + OFF_H);
  const float* ng = p.nsa_norm_g + layer * 64;
#pragma unroll
  for (int qt = 0; qt < 2; ++qt) {
    const int t = q0 + qt * 16 + l15;
    const float lt = rel_rowsum(a, qt, l15);
    const float gt = sigmoidf_(smb[(size_t)t * NSMALL + SM_G + h * 3 + 2]) * (lt > 0.f ? 1.f / lt : 0.f);
    f32x4 v[4]; float ss = 0.f;
#pragma unroll
    for (int d = 0; d < 4; ++d) { v[d] = park[(d * 2 + qt) * 64] + a.o[d][qt] * gt; ss += v[d][0] * v[d][0] + v[d][1] * v[d][1] + v[d][2] * v[d][2] + v[d][3] * v[d][3]; }
    ss = group_sum4(ss);
    const float rn = rsqrtf(ss * (1.f / 64.f) + 1e-6f);
    const size_t row = (size_t)b * SEQ + t;
#pragma unroll
    for (int d = 0; d < 4; ++d) {
      const int dd = d * 16 + 4 * g;
      const u32x2 zz = *(const u32x2*)(projb + (size_t)t * NP + PA_Z + h * 64 + dd);
      const f32x4 gg = *(const f32x4*)(ng + dd);
      u32x2 o;
      o.x = pack2(v[d][0] * rn * gg[0] * siluf(bflo(zz.x)), v[d][1] * rn * gg[1] * siluf(bfhi(zz.x)));
      o.y = pack2(v[d][2] * rn * gg[2] * siluf(bflo(zz.y)), v[d][3] * rn * gg[3] * siluf(bfhi(zz.y)));
      *(u32x2*)(Y + row * 1024 + Y_A + h * 64 + dd) = o;
    }
  }
}

DI void zero_y_cols(const Params& p, int c0, int ncols, int gtid, int gthreads) {
  u16* Y = (u16*)(p.ws + OFF_H);
  const int per_row = ncols / 8;
  for (size_t i = gtid; i < (size_t)NTOK * per_row; i += gthreads) {
    const size_t row = i / per_row; const int ch = (int)(i % per_row);
    *(u32x4*)(Y + row * 1024 + c0 + ch * 8) = (u32x4){0u, 0u, 0u, 0u};
  }
}

DI void final_norm_rows(const Params& p, int gw, int nw, int lane) {
  const float4* gp = (const float4*)p.final_g;
  float4 gg[4];
#pragma unroll
  for (int i = 0; i < 4; ++i) gg[i] = gp[lane + 64 * i];
  for (int row0 = gw * 4; row0 < NTOK; row0 += nw * 4) {
    float4 v[4][4]; float ss[4];
#pragma unroll
    for (int j = 0; j < 4; ++j) {
      const float4* xr = (const float4*)(p.out + (size_t)(row0 + j) * D_MODEL);
#pragma unroll
      for (int i = 0; i < 4; ++i) v[j][i] = xr[lane + 64 * i];
    }
#pragma unroll
    for (int j = 0; j < 4; ++j) {
      float a = 0.f;
#pragma unroll
      for (int i = 0; i < 4; ++i) a += v[j][i].x * v[j][i].x + v[j][i].y * v[j][i].y + v[j][i].z * v[j][i].z + v[j][i].w * v[j][i].w;
      ss[j] = wave_sum(a);
    }
#pragma unroll
    for (int j = 0; j < 4; ++j) {
      float4* xr = (float4*)(p.out + (size_t)(row0 + j) * D_MODEL);
      const float r = rsqrtf(ss[j] * (1.f / D_MODEL) + 1e-6f);
#pragma unroll
      for (int i = 0; i < 4; ++i) { float4 w; w.x = v[j][i].x * r * gg[i].x; w.y = v[j][i].y * r * gg[i].y; w.z = v[j][i].z * r * gg[i].z; w.w = v[j][i].w * r * gg[i].w; xr[lane + 64 * i] = w; }
    }
  }
}

#ifndef DEBUG_CHECK
#define DEBUG_CHECK 0
#endif
#if DEBUG_CHECK
constexpr int NCHK = 12;
DI float block_sum(float v, float* red) {
  v = wave_sum(v);
  lds_barrier();
  if ((threadIdx.x & 63) == 0) red[threadIdx.x >> 6] = v;
  lds_barrier();
  return red[0] + red[1] + red[2] + red[3];
}
DI float block_max(float v, float* red) {
#pragma unroll
  for (int o = 32; o > 0; o >>= 1) v = fmaxf(v, __shfl_xor(v, o));
  lds_barrier();
  if ((threadIdx.x & 63) == 0) red[threadIdx.x >> 6] = v;
  lds_barrier();
  return fmaxf(fmaxf(red[0], red[1]), fmaxf(red[2], red[3]));
}
DI float bfr(float v) { return bf2f(f2bf(v)); }
struct Chk { float num[NCHK], den[NCHK]; };
DI void chk_add(Chk& c, int id, float got, float ref) { const float d = got - ref; c.num[id] += d * d; c.den[id] += ref * ref; }

DI void dbg_diff_attn(const Params& p, int layer, int b, int t, int h, Chk& c, int id, unsigned char* smem) {
  float* p1 = (float*)smem; float* p2 = p1 + 4096; float* red = p2 + 4096;
  const int tid = otid();
  const u16* proj = (const u16*)(p.ws + OFF_PROJ) + (size_t)b * SEQ * NP;
  const u16* q = proj + (size_t)t * NP + PB_Q + h * 64;
  const float scale = 0.17677669529663687f;
  float m1 = -1e30f, m2 = -1e30f;
  for (int s = tid; s <= t; s += 256) {
    const u16* k = proj + (size_t)s * NP + PB_K + h * 64;
    float a1 = 0.f, a2 = 0.f;
    for (int d = 0; d < 32; ++d) { a1 += bf2f(q[d]) * bf2f(k[d]); a2 += bf2f(q[32 + d]) * bf2f(k[32 + d]); }
    a1 *= scale; a2 *= scale; p1[s] = a1; p2[s] = a2; m1 = fmaxf(m1, a1); m2 = fmaxf(m2, a2);
  }
  m1 = block_max(m1, red); m2 = block_max(m2, red);
  float l1 = 0.f, l2 = 0.f;
  for (int s = tid; s <= t; s += 256) { const float e1 = __expf(p1[s] - m1), e2 = __expf(p2[s] - m2); p1[s] = e1; p2[s] = e2; l1 += e1; l2 += e2; }
  l1 = block_sum(l1, red); l2 = block_sum(l2, red);
  const float* lam = p.diff_lam + layer * 128;
  float s01 = 0.f, s23 = 0.f;
  for (int i = 0; i < 32; ++i) { s01 += lam[i] * lam[32 + i]; s23 += lam[64 + i] * lam[96 + i]; }
  const float lam_init = 0.8f - 0.6f * expf(-0.3f * (float)layer);
  const float lam_full = expf(s01) - expf(s23) + lam_init;
  lds_barrier();
  float o = 0.f;
  if (tid < 64) for (int s = 0; s <= t; ++s) o += (p1[s] / l1 - lam_full * p2[s] / l2) * bf2f(proj[(size_t)s * NP + PB_V + h * 64 + tid]);
  float ss = block_sum(tid < 64 ? o * o : 0.f, red);
  if (tid < 64) {
    const float z = bf2f(proj[(size_t)t * NP + PB_Z + h * 64 + tid]);
    const float ref = o * rsqrtf(ss / 64.f + 1e-6f) * p.diff_norm_g[layer * 64 + tid] * (1.f - lam_init) * (z / (1.f + expf(-z)));
    const float got = bf2f(((const u16*)(p.ws + OFF_H))[((size_t)b * SEQ + t) * 1024 + Y_B + h * 64 + tid]);
    const float d = got - ref;
    o = d * d; ss = ref * ref;
  } else { o = 0.f; ss = 0.f; }
  c.num[id] += block_sum(o, red); c.den[id] += block_sum(ss, red);
}

DI float dbg_conv(const u16* projb, int t, int pcol, const float* cw, const float* cb, int ch, int nch) {
  float a = cb[ch];
  for (int j = 0; j < 4; ++j) { const int tt = t - 3 + j; if (tt >= 0) a += cw[j * nch + ch] * bf2f(projb[(size_t)tt * NP + pcol]); }
  return a / (1.f + expf(-a));
}
constexpr int DBG_NS = 11, DBG_T = 300;
DI int dbg_sample_idx(int t) {
  const int TS[DBG_NS] = {0, 1, 2, 3, 64, 127, 128, 129, 255, 256, 299};
  for (int i = 0; i < DBG_NS; ++i) if (TS[i] == t) return i;
  return -1;
}
DI int dbg_sample_t(int i) { const int TS[DBG_NS] = {0, 1, 2, 3, 64, 127, 128, 129, 255, 256, 299}; return TS[i]; }
DI void dbg_ssd(const Params& p, int layer, int b, int gi, Chk& c, int id, unsigned char* smem) {
  float* ybuf = (float*)smem;
  float* red = ybuf + DBG_NS * 128;
  const int tid = threadIdx.x, pp = tid >> 2, nq = tid & 3;
  const u16* projb = (const u16*)(p.ws + OFF_PROJ) + (size_t)b * SEQ * NP;
  const float* smb = (const float*)(p.ws + OFF_SMALL) + (size_t)b * SEQ * NSMALL;
  const float* cw = p.ssm_conv_w + layer * 4 * 512; const float* cb = p.ssm_conv_b + layer * 512;
  lds_barrier();
  for (int hh = 0; hh < 2; ++hh) {
    const int h = gi * 2 + hh;
    const float a_h = -expf(p.ssm_a_log[layer * 4 + h]), d_h = p.ssm_d[layer * 4 + h], dtb = p.ssm_dt_bias[layer * 4 + h];
    float hst[16];
    for (int i = 0; i < 16; ++i) hst[i] = 0.f;
    for (int t = 0; t < DBG_T; ++t) {
      const float xr = smb[(size_t)t * NSMALL + SM_DT + h] + dtb;
      const float dt = xr > 20.f ? xr : log1pf(expf(xr));
      const float dA = expf(dt * a_h);
      const float xp = dbg_conv(projb, t, PC_XBC + h * 64 + pp, cw, cb, h * 64 + pp, 512);
      float y = 0.f;
      for (int i = 0; i < 16; ++i) {
        const int n = nq * 16 + i;
        const float Bn = dbg_conv(projb, t, PC_XBC + 256 + gi * 64 + n, cw, cb, 256 + gi * 64 + n, 512);
        const float Cn = dbg_conv(projb, t, PC_XBC + 384 + gi * 64 + n, cw, cb, 384 + gi * 64 + n, 512);
        hst[i] = dA * hst[i] + dt * xp * Bn;
        y += Cn * hst[i];
      }
      y += __shfl_xor(y, 1); y += __shfl_xor(y, 2);
      y += d_h * xp;
      const int si = dbg_sample_idx(t);
      if (si >= 0 && nq == 0) { const float z = bf2f(projb[(size_t)t * NP + PC_Z + h * 64 + pp]); ybuf[si * 128 + hh * 64 + pp] = y * (z / (1.f + expf(-z))); }
    }
  }
  lds_barrier();
  for (int si = 0; si < DBG_NS; ++si) {
    const float v = tid < 128 ? ybuf[si * 128 + tid] : 0.f;
    const float ss = block_sum(v * v, red);
    float e2 = 0.f, r2 = 0.f;
    if (tid < 128) {
      const float ref = v * rsqrtf(ss / 128.f + 1e-6f) * p.ssm_norm_g[layer * 256 + gi * 128 + tid];
      const float got = bf2f(((const u16*)(p.ws + OFF_H))[((size_t)b * SEQ + dbg_sample_t(si)) * 1024 + Y_C + gi * 128 + tid]);
      e2 = (got - ref) * (got - ref); r2 = ref * ref;
    }
    c.num[id] += block_sum(e2, red); c.den[id] += block_sum(r2, red);
  }
}
DI void dbg_mlstm(const Params& p, int layer, int b, int h, Chk& c, int id, unsigned char* smem) {
  float* ybuf = (float*)smem;
  float* red = ybuf + DBG_NS * 128;
  const int tid = threadIdx.x, dd = tid >> 2, eq = tid & 3;
  const u16* projb = (const u16*)(p.ws + OFF_PROJ) + (size_t)b * SEQ * NP;
  const float* smb = (const float*)(p.ws + OFF_SMALL) + (size_t)b * SEQ * NSMALL;
  const float* cw = p.ml_conv_w + layer * 4 * 512; const float* cb = p.ml_conv_b + layer * 512;
  const float ib = p.ml_if_b[layer * 8 + h], fb = p.ml_if_b[layer * 8 + 4 + h];
  lds_barrier();
  float Cst[16], nst[16];
  for (int i = 0; i < 16; ++i) { Cst[i] = 0.f; nst[i] = 0.f; }
  float m = 0.f;
  for (int t = 0; t < DBG_T; ++t) {
    const float ip = smb[(size_t)t * NSMALL + SM_IF + h] + ib, fp = smb[(size_t)t * NSMALL + SM_IF + 4 + h] + fb;
    const float lf = fminf(fp, 0.f) - log1pf(expf(-fabsf(fp)));
    const float mn = fmaxf(lf + m, ip), fs = expf(lf + m - mn), is = expf(ip - mn);
    const float vd = bf2f(projb[(size_t)t * NP + PD_V + h * 64 + dd]);
    float num = 0.f, den = 0.f;
    for (int i = 0; i < 16; ++i) {
      const int e = eq * 16 + i;
      const float qe = dbg_conv(projb, t, PD_QK + h * 64 + e, cw, cb, h * 64 + e, 512);
      const float ke = 0.125f * dbg_conv(projb, t, PD_QK + 256 + h * 64 + e, cw, cb, 256 + h * 64 + e, 512);
      Cst[i] = fs * Cst[i] + is * vd * ke; nst[i] = fs * nst[i] + is * ke;
      num += Cst[i] * qe; den += nst[i] * qe;
    }
    num += __shfl_xor(num, 1); num += __shfl_xor(num, 2); den += __shfl_xor(den, 1); den += __shfl_xor(den, 2);
    const float hv = num / fmaxf(fabsf(den), expf(-mn));
    m = mn;
    const int si = dbg_sample_idx(t);
    if (si >= 0 && eq == 0) { const float o = bf2f(projb[(size_t)t * NP + PD_O + h * 64 + dd]); ybuf[si * 64 + dd] = hv / (1.f + expf(-o)); }
  }
  lds_barrier();
  for (int si = 0; si < DBG_NS; ++si) {
    const float v = tid < 64 ? ybuf[si * 64 + tid] : 0.f;
    const float ss = block_sum(v * v, red);
    float e2 = 0.f, r2 = 0.f;
    if (tid < 64) {
      const int t = dbg_sample_t(si);
      const float z = bf2f(projb[(size_t)t * NP + PD_Z + h * 64 + tid]);
      const float ref = v * rsqrtf(ss / 64.f + 1e-6f) * p.ml_norm_g[layer * 64 + tid] * (z / (1.f + expf(-z)));
      const float got = bf2f(((const u16*)(p.ws + OFF_H))[((size_t)b * SEQ + t) * 1024 + Y_D + h * 64 + tid]);
      e2 = (got - ref) * (got - ref); r2 = ref * ref;
    }
    c.num[id] += block_sum(e2, red); c.den[id] += block_sum(r2, red);
  }
}

DI void debug_checks(const Params& p, unsigned char* smem) {
  const int tid = otid();
  float* red = (float*)(smem + 36 * 1024);
  Chk c;
  for (int i = 0; i < NCHK; ++i) { c.num[i] = 0.f; c.den[i] = 0.f; }
  const float* adap = (const float*)(p.ws + OFF_ADAP);
  const u16* H = (const u16*)(p.ws + OFF_H);
  const u16* proj = (const u16*)(p.ws + OFF_PROJ);
  const float* sm = (const float*)(p.ws + OFF_SMALL);
#if DEBUG_CHECK == 1
  {
    const int bs[2] = {0, 5}; const int ns[4] = {3, 1024 + 77, 2048 + 500, 3071};
    for (int bi = 0; bi < 2; ++bi) for (int ni = 0; ni < 4; ++ni) {
      const int b = bs[bi], n = ns[ni];
      float a = 0.f;
      for (int k = tid; k < 1024; k += 256) { const float v = p.c[b * 1024 + k]; a += (v / (1.f + expf(-v))) * p.ada_w[(size_t)k * 3072 + n]; }
      const float ref = block_sum(a, red) + p.ada_b[n];
      float got = 0.f; for (int kc = 0; kc < 8; ++kc) got += adap[(((size_t)kc * 2 + 0) * 8 + b) * 3072 + n];
      chk_add(c, 1, got, ref);
    }
  }
  {
    const int ms[3] = {1, 9000, 32767};
    const int ns[14] = {0, 300, 700, 900, 1500, 2000, 2300, 2693, 3300, 3500, 3967, 3970, 3981, 3990};
    for (int mi = 0; mi < 3; ++mi) {
      const int m = ms[mi], b = m >> 12;
      float ss = 0.f;
      for (int k = tid; k < 1024; k += 256) { const float v = p.x[(size_t)m * 1024 + k]; ss += v * v; }
      ss = block_sum(ss, red);
      const float rstd = rsqrtf(ss / 1024.f + 1e-6f);
      for (int ni = 0; ni < 14; ++ni) {
        const int n = ns[ni], col = colmap(n);
        float a = 0.f, herr = 0.f, href = 0.f;
        for (int k = tid; k < 1024; k += 256) {
          float shf = 0.f, scl = 0.f;
          for (int kc = 0; kc < 8; ++kc) { const float* ap = adap + (((size_t)kc * 2 + 0) * 8 + b) * 3072; shf += ap[k]; scl += ap[1024 + k]; }
          const float hv = p.x[(size_t)m * 1024 + k] * rstd * p.norm_g[k] * (1.f + scl) + shf;
          const float hg = bf2f(H[(size_t)m * 1024 + k]);
          herr += (hg - hv) * (hg - hv); href += hv * hv;
          a += hv * p.w_in[(size_t)k * D_IN + col];
        }
        const float ref = block_sum(a, red);
        herr = block_sum(herr, red); href = block_sum(href, red);
        if (ni == 0 && DEBUG_STAGE == 1) { c.num[3] += herr; c.den[3] += href; }
        const float got = n < NP ? bf2f(proj[(size_t)m * NP + n]) : sm[(size_t)m * NSMALL + (n - NP)];
        chk_add(c, 2, got, ref);
      }
    }
  }
#endif
#if DEBUG_CHECK == 2
  dbg_diff_attn(p, 0, 0, 5, 0, c, 4, smem);
  dbg_diff_attn(p, 0, 1, 200, 3, c, 4, smem);
  dbg_diff_attn(p, 0, 3, 1500, 2, c, 4, smem);
  dbg_diff_attn(p, 0, 7, 4095, 1, c, 4, smem);
  {
    const int ms[3] = {2, 12345, 32766}; const int ns[3] = {0, 513, 1023};
    const u16* Y = (const u16*)(p.ws + OFF_H);
    for (int mi = 0; mi < 3; ++mi) for (int ni = 0; ni < 3; ++ni) {
      const int m = ms[mi], n = ns[ni], b = m >> 12;
      float a = 0.f;
      for (int k = tid; k < 1024; k += 256) a += bf2f(Y[(size_t)m * 1024 + k]) * p.w_out[(size_t)k * 1024 + n];
      a = block_sum(a, red);
      float gate = 0.f; for (int kc = 0; kc < 8; ++kc) gate += adap[(((size_t)kc * 2 + 0) * 8 + b) * 3072 + 2048 + n];
      chk_add(c, 5, p.out[(size_t)m * 1024 + n] - p.x[(size_t)m * 1024 + n], gate * a);
    }
  }
#endif
#if DEBUG_CHECK == 3
  dbg_ssd(p, 0, 0, 0, c, 6, smem);
  dbg_ssd(p, 0, 5, 1, c, 6, smem);
  dbg_mlstm(p, 0, 0, 0, c, 7, smem);
  dbg_mlstm(p, 0, 6, 3, c, 7, smem);
#endif
  lds_barrier();
  if (tid == 0) {
    int wid_ = 0, wcls = 99;
    for (int i = 1; i < NCHK; ++i) if (c.den[i] > 0.f) {
      const float rel = sqrtf(c.num[i] / c.den[i]);
      int cls = rel >= 1.f ? 0 : (int)floorf(-log10f(fmaxf(rel, 1e-9f)));
      if (cls > 9) cls = 9;
      if (!(rel == rel)) cls = 0;
      if (cls < wcls) { wcls = cls; wid_ = i; }
    }
    p.out[0] = 1e5f * ((float)wid_ + 0.1f * (float)wcls);
  }
}
#endif

constexpr int HALF_LDS = 76 * 1024;
constexpr int SMEM_BYTES = 2 * HALF_LDS;
__global__ void __launch_bounds__(512, 2) fwd_megakernel(Params p) {
  cg::grid_group grid = cg::this_grid();
  __shared__ __attribute__((aligned(16))) unsigned char smem[SMEM_BYTES];
  const int half = __builtin_amdgcn_readfirstlane(threadIdx.x >> 8);
  unsigned char* hsm = smem + half * HALF_LDS;
  const int G = gridDim.x, bid = blockIdx.x;
  const int slot = bid * 2 + half, NS = 2 * G;
  for (int t = slot; t < ((T0_TOTAL + NS - 1) / NS) * NS; t += NS) phase0_task(p, t < T0_TOTAL ? t : T0_TOTAL - 1, hsm);
  grid.sync();
  for (int layer = 0; layer < 2; ++layer) {
    Params q = p;
    { size_t zoff = 0; asm volatile("" : "+s"(zoff)); q.ws = p.ws + zoff; }
    const float* xin = layer == 0 ? q.x : q.out;
    for (int t = slot; t < ((NTOK / 64 + NS - 1) / NS) * NS; t += NS) phase1_task(q, layer, xin, t < NTOK / 64 ? t : NTOK / 64 - 1, hsm);
    grid.sync();
    for (int t = bid; t < (NTOK / 256) * (NPAD / 256); t += G) gemm_inproj_tile(q, layer, t, smem);
    grid.sync();
#if DEBUG_CHECK == 1
    if (bid == 0 && half == 0) debug_checks(q, smem);
    return;
#endif
    {
      unsigned* cnt = (unsigned*)(q.ws + OFF_CNT);
      int* s_pair = (int*)(smem + SMEM_BYTES - 16);
      if (bid < 32) ssd_task8(q, layer, bid >> 2, bid & 3, smem);
      else if (bid < 64) mlstm_task8(q, layer, (bid - 32) >> 2, (bid - 32) & 3, smem);
      if (bid < 64) {
        asm volatile("s_waitcnt vmcnt(0)" ::: "memory");
        lds_barrier();
        if (otid512() == 0) {
          __builtin_amdgcn_fence(__ATOMIC_RELEASE, "agent");
          asm volatile("s_waitcnt vmcnt(0)" ::: "memory");
          __hip_atomic_fetch_add(cnt + 4 + layer, 1u, __ATOMIC_RELAXED, __HIP_MEMORY_SCOPE_AGENT);
        }
      }
      constexpr int NPAIR_C = 64, NPAIR_D = 512, NPAIR_N = 512, NPAIR_F = NTOK / 128, NPAIR = NPAIR_C + NPAIR_D + NPAIR_N + NPAIR_F;
      for (;;) {
        const int t512 = otid512();
        lds_barrier();
        if (t512 == 0) *s_pair = (int)atomicAdd(cnt + layer, 1u);
        lds_barrier();
        const int pair = *s_pair;
        if (pair >= NPAIR) break;
        if (pair < NPAIR_C) {
          const int v = pair * 2 + half;
          compress_task(q, layer, v >> 4, (v >> 3) & 1, v & 7, hsm);
          asm volatile("s_waitcnt vmcnt(0)" ::: "memory");
          lds_barrier();
          if (t512 == 0) {
            __builtin_amdgcn_fence(__ATOMIC_RELEASE, "agent");
            asm volatile("s_waitcnt vmcnt(0)" ::: "memory");
            __hip_atomic_fetch_add(cnt + 2 + layer, 1u, __ATOMIC_RELAXED, __HIP_MEMORY_SCOPE_AGENT);
          }
        } else if (pair < NPAIR_C + NPAIR_D) {
          const int u = (pair - NPAIR_C) * 2 + half, qb = 31 - (u >> 5), bh = u & 31;
          diff_attn_task(q, layer, bh >> 2, bh & 3, qb, hsm, half != 0);
        } else if (pair >= NPAIR_C + NPAIR_D + NPAIR_N) {
          if (t512 == 0) {
            while (__hip_atomic_load(cnt + 4 + layer, __ATOMIC_RELAXED, __HIP_MEMORY_SCOPE_AGENT) < 64u) __builtin_amdgcn_s_sleep(16);
            __builtin_amdgcn_fence(__ATOMIC_ACQUIRE, "agent");
            asm volatile("s_waitcnt vmcnt(0)" ::: "memory");
          }
          lds_barrier();
          seq_fix_rows(q, layer, ((pair - NPAIR_C - NPAIR_D - NPAIR_N) * 2 + half) * 64, 64);
        } else {
          if (t512 == 0) {
            while (__hip_atomic_load(cnt + 2 + layer, __ATOMIC_RELAXED, __HIP_MEMORY_SCOPE_AGENT) < (unsigned)NPAIR_C) __builtin_amdgcn_s_sleep(16);
            __builtin_amdgcn_fence(__ATOMIC_ACQUIRE, "agent");
            asm volatile("s_waitcnt vmcnt(0)" ::: "memory");
          }
          lds_barrier();
          const int u = (pair - NPAIR_C - NPAIR_D) * 2 + half;
          nsa_task(q, layer, u & 7, 127 - (u >> 3), hsm);
        }
      }
    }
    grid.sync();
    for (int t = bid; t < (NTOK / 256) * 4; t += G) gemm_outproj_tile(q, layer, xin, q.out, t, smem);
    grid.sync();
#if DEBUG_CHECK >= 2
    if (bid == 0 && half == 0) debug_checks(q, smem);
    return;
#endif
  }
  { const int t5 = otid512(); final_norm_rows(p, bid * 8 + (t5 >> 6), G * 8, t5 & 63); }
}

extern "C" void kernel_launch(void* const* d_in, const int* in_sizes, int n_in, void* d_out, int out_size, void* d_ws, size_t ws_size,
                              hipStream_t stream) {
  static int grid_blocks = 0;
  if (!grid_blocks) {
    int dev = 0, cus = 0, per_cu = 0;
    (void)hipGetDevice(&dev);
    (void)hipDeviceGetAttribute(&cus, hipDeviceAttributeMultiprocessorCount, dev);
    (void)hipOccupancyMaxActiveBlocksPerMultiprocessor(&per_cu, fwd_megakernel, 512, 0);
    if (per_cu > 1) per_cu = 1;
    if (per_cu < 1) per_cu = 1;
    grid_blocks = cus * per_cu;
  }
  if (grid_blocks < 64 || (grid_blocks & 3)) { fprintf(stderr, "grid too small: %d\n", grid_blocks); return; }
  if (ws_size < WS_NEEDED) { fprintf(stderr, "workspace too small: %zu < %zu\n", ws_size, WS_NEEDED); return; }
  Params p{};
  const float** pp = (const float**)&p;
  for (int i = 0; i < 26; ++i) pp[i] = (const float*)d_in[i];
  p.out = (float*)d_out; p.ws = (unsigned char*)d_ws;
  (void)hipMemsetAsync((unsigned char*)d_ws + OFF_CNT, 0, 64, stream);
  void* args[] = {&p};
  hipError_t e = hipLaunchCooperativeKernel((void*)fwd_megakernel, dim3(grid_blocks), dim3(512), args, 0, stream);
  if (e != hipSuccess) fprintf(stderr, "cooperative launch failed: %s (grid %d)\n", hipGetErrorString(e), grid_blocks);
}
```

```cpp
#include <hip/hip_runtime.h>
#include <hip/hip_cooperative_groups.h>
#include <cstdio>
#include <cstdint>
#define DEBUG_CHECK 0
#define DEBUG_STAGE 1
#define REP_P1 1
#define REP_P2 1
#define REP_SEQ 1
#define REP_DIFF 1
#define REP_NSA 1
#define REP_P4 1
#define REP_P0 1
namespace cg = cooperative_groups;

typedef unsigned short u16;
typedef short bf16x8 __attribute__((ext_vector_type(8)));
typedef short s16x4 __attribute__((ext_vector_type(4)));
typedef float f32x4 __attribute__((ext_vector_type(4)));
typedef float f32x2 __attribute__((ext_vector_type(2)));
typedef unsigned u32x4 __attribute__((ext_vector_type(4)));
typedef unsigned u32x2 __attribute__((ext_vector_type(2)));
typedef __bf16 bf16x2_t __attribute__((ext_vector_type(2)));
#define DI __device__ __forceinline__
#define LDSP __attribute__((address_space(3)))

constexpr int D_MODEL = 1024, BATCH = 8, SEQ = 4096, NTOK = BATCH * SEQ;
constexpr int D_IN = 3992;
constexpr int NP = 3968, NPAD = 4096, NSMALL = 32;
constexpr int PA_Q = 0, PA_KC = 256, PA_VC = 320, PA_KS = 384, PA_VS = 448, PA_KW = 512, PA_VW = 576, PA_Z = 640;
constexpr int PB_Q = 896, PB_K = 1152, PB_V = 1408, PB_Z = 1664;
constexpr int PC_Z = 1920, PC_XBC = 2176;
constexpr int PD_QK = 2688, PD_V = 3200, PD_O = 3456, PD_Z = 3712;
constexpr int SM_G = 0, SM_DT = 12, SM_IF = 16;
constexpr int Y_A = 0, Y_B = 256, Y_C = 512, Y_D = 768;

constexpr size_t MiB = 1024 * 1024;
constexpr size_t OFF_WINT = 0;
constexpr size_t OFF_WOUTT = 16 * MiB;
constexpr size_t OFF_W1T = 20 * MiB;
constexpr size_t OFF_W2T = 22 * MiB;
constexpr size_t OFF_BIAS1 = 22 * MiB + 64 * 1024;
constexpr size_t OFF_ADAP = 22 * MiB + 128 * 1024;
constexpr size_t OFF_KCMP = 24 * MiB;
constexpr size_t OFF_VCMP = 24 * MiB + 256 * 1024;
constexpr size_t OFF_BAR = 29 * MiB + 64 * 1024;
constexpr size_t OFF_CNT = 29 * MiB;
constexpr size_t OFF_SMALL = 25 * MiB;
constexpr size_t OFF_SSQ = 29 * MiB;
constexpr size_t OFF_H = 32 * MiB;
constexpr size_t OFF_PROJ = 96 * MiB;
constexpr size_t WS_NEEDED = 96 * MiB + (size_t)NTOK * NP * 2;

struct Params {
  const float* x; const float* c; const float* norm_g; const float* ada_w; const float* ada_b;
  const float* w_in; const float* w_out;
  const float* nsa_cmp_pos; const float* nsa_ck_w1; const float* nsa_ck_w2; const float* nsa_cv_w1; const float* nsa_cv_w2; const float* nsa_norm_g;
  const float* diff_lam; const float* diff_norm_g;
  const float* ssm_conv_w; const float* ssm_conv_b; const float* ssm_dt_bias; const float* ssm_a_log; const float* ssm_d; const float* ssm_norm_g;
  const float* ml_conv_w; const float* ml_conv_b; const float* ml_if_b; const float* ml_norm_g; const float* final_g;
  float* out; unsigned char* ws;
};

DI void lds_barrier() { asm volatile("s_waitcnt lgkmcnt(0)" ::: "memory"); __builtin_amdgcn_s_barrier(); asm volatile("" ::: "memory"); }
DI int otid() { int t = threadIdx.x & 255; asm volatile("" : "+v"(t)); return t; }
DI int otid512() { int t = threadIdx.x; asm volatile("" : "+v"(t)); return t; }
DI unsigned pack2(float a, float b) { f32x2 v = {a, b}; bf16x2_t r = __builtin_convertvector(v, bf16x2_t); return __builtin_bit_cast(unsigned, r); }
DI u16 f2bf(float a) { return (u16)(pack2(a, 0.f) & 0xffffu); }
DI float bf2f(u16 h) { return __uint_as_float(((unsigned)h) << 16); }
DI float bflo(unsigned u) { return __uint_as_float(u << 16); }
DI float bfhi(unsigned u) { return __uint_as_float(u & 0xffff0000u); }
DI f32x4 mfma16(bf16x8 a, bf16x8 b, f32x4 c) { return __builtin_amdgcn_mfma_f32_16x16x32_bf16(a, b, c, 0, 0, 0); }
DI float wave_sum(float v) {
#pragma unroll
  for (int o = 32; o > 0; o >>= 1) v += __shfl_xor(v, o);
  return v;
}
DI float siluf(float v) { return v * __builtin_amdgcn_rcpf(1.f + __expf(-v)); }
DI float sigmoidf_(float v) { return __builtin_amdgcn_rcpf(1.f + __expf(-v)); }
DI float exp2_(float v) { return __builtin_amdgcn_exp2f(v); }
DI float sgprf(float v) { return __int_as_float(__builtin_amdgcn_readfirstlane(__float_as_int(v))); }
DI s16x4 tr_read(const u16* p) { return __builtin_amdgcn_ds_read_tr16_b64_v4i16((LDSP s16x4*)p); }
DI bf16x8 cat4(s16x4 a, s16x4 b) { bf16x8 r; r[0] = a[0]; r[1] = a[1]; r[2] = a[2]; r[3] = a[3]; r[4] = b[0]; r[5] = b[1]; r[6] = b[2]; r[7] = b[3]; return r; }
DI bf16x8 ldfrag(const u16* p) { return *(const bf16x8*)p; }

DI int colmap(int n) {
  if (n < 640) return n;
  if (n < 896) return 652 + (n - 640);
  if (n < 1920) return 908 + (n - 896);
  if (n < 2688) return 1932 + (n - 1920);
  if (n < 3456) return 2704 + (n - 2688);
  if (n < 3968) return 3480 + (n - 3456);
  if (n < 3980) return 640 + (n - 3968);
  if (n < 3984) return 2700 + (n - 3980);
  if (n < 3992) return 3472 + (n - 3984);
  return -1;
}

DI void tconv_tile(const float* __restrict__ src, int ldsrc, int k0, int n0, u16* __restrict__ dst, int ldd, bool use_map, unsigned char* smem) {
  float* tile = (float*)smem;
  const int tid = otid();
  lds_barrier();
  {
    const int nn = tid & 63; int col = n0 + nn; if (use_map) col = colmap(col);
#pragma unroll
    for (int i = 0; i < 16; ++i) { const int kk = i * 4 + (tid >> 6); tile[kk * 65 + nn] = col >= 0 ? src[(size_t)(k0 + kk) * ldsrc + col] : 0.f; }
  }
  lds_barrier();
#pragma unroll
  for (int i = 0; i < 2; ++i) {
    const int item = tid + 256 * i, nn = item >> 3, kc = item & 7;
    u32x4 w;
    w.x = pack2(tile[(kc * 8 + 0) * 65 + nn], tile[(kc * 8 + 1) * 65 + nn]);
    w.y = pack2(tile[(kc * 8 + 2) * 65 + nn], tile[(kc * 8 + 3) * 65 + nn]);
    w.z = pack2(tile[(kc * 8 + 4) * 65 + nn], tile[(kc * 8 + 5) * 65 + nn]);
    w.w = pack2(tile[(kc * 8 + 6) * 65 + nn], tile[(kc * 8 + 7) * 65 + nn]);
    *(u32x4*)(dst + (size_t)(n0 + nn) * ldd + k0 + kc * 8) = w;
  }
}

constexpr int T0_WIN = 2 * 16 * 64, T0_WOUT = 2 * 16 * 16, T0_W1 = 4 * 32 * 2, T0_W2 = 4 * 2, T0_ADA = 2 * 12 * 8, T0_B1 = 64;
constexpr int T0_TOTAL = T0_WIN + T0_WOUT + T0_W1 + T0_W2 + T0_ADA + T0_B1;

DI void phase0_task(const Params& p, int t, unsigned char* smem) {
  const int tid = otid();
  if (t < T0_WIN) {
    const int l = t / 1024, r = t % 1024, kt = r / 64, nt = r % 64;
    tconv_tile(p.w_in + (size_t)l * D_MODEL * D_IN, D_IN, kt * 64, nt * 64, (u16*)(p.ws + OFF_WINT) + (size_t)l * NPAD * 1024, 1024, true, smem);
    return;
  }
  t -= T0_WIN;
  if (t < T0_WOUT) {
    const int l = t / 256, r = t % 256, kt = r / 16, nt = r % 16;
    tconv_tile(p.w_out + (size_t)l * 1024 * 1024, 1024, kt * 64, nt * 64, (u16*)(p.ws + OFF_WOUTT) + (size_t)l * 1024 * 1024, 1024, false, smem);
    return;
  }
  t -= T0_WOUT;
  if (t < T0_W1) {
    const int m = t / 64, r = t % 64, kt = r / 2, nt = r % 2, l = m >> 1, kv = m & 1;
    const float* src = (kv ? p.nsa_cv_w1 : p.nsa_ck_w1) + (size_t)l * 2048 * 128;
    tconv_tile(src, 128, kt * 64, nt * 64, (u16*)(p.ws + OFF_W1T) + (size_t)m * 128 * 2048, 2048, false, smem);
    return;
  }
  t -= T0_W1;
  if (t < T0_W2) {
    const int m = t / 2, kt = t % 2, l = m >> 1, kv = m & 1;
    const float* src = (kv ? p.nsa_cv_w2 : p.nsa_ck_w2) + (size_t)l * 128 * 64;
    tconv_tile(src, 64, kt * 64, 0, (u16*)(p.ws + OFF_W2T) + (size_t)m * 64 * 128, 128, false, smem);
    return;
  }
  t -= T0_W2;
  if (t < T0_ADA) {
    const int l = t / 96, r = t % 96, nc = r / 8, kc = r % 8;
    float* cact = (float*)smem;
    lds_barrier();
    for (int i = tid; i < 1024; i += 256) { const int b = i >> 7, kk = i & 127; const float v = p.c[b * 1024 + kc * 128 + kk]; cact[i] = siluf(v); }
    lds_barrier();
    const int n = nc * 256 + tid;
    float acc[8];
#pragma unroll
    for (int b = 0; b < 8; ++b) acc[b] = 0.f;
    const float* w = p.ada_w + ((size_t)l * 1024 + kc * 128) * 3072 + n;
#pragma unroll 16
    for (int kk = 0; kk < 128; ++kk) {
      const float wv = w[(size_t)kk * 3072];
#pragma unroll
      for (int b = 0; b < 8; ++b) acc[b] += cact[b * 128 + kk] * wv;
    }
    float* adap = (float*)(p.ws + OFF_ADAP);
    const float bias = kc == 0 ? p.ada_b[l * 3072 + n] : 0.f;
#pragma unroll
    for (int b = 0; b < 8; ++b) adap[(((size_t)kc * 2 + l) * 8 + b) * 3072 + n] = acc[b] + bias;
    return;
  }
  t -= T0_ADA;
  {
    const int m = t >> 4, kc = t & 15, l = m >> 1, kv = m & 1;
    const float* w1 = (kv ? p.nsa_cv_w1 : p.nsa_ck_w1) + (size_t)l * 2048 * 128;
    const float* pos = p.nsa_cmp_pos + (size_t)l * 2048;
    const int n = tid & 127, half = tid >> 7;
    float acc = 0.f;
    const int k0 = kc * 128 + half * 64;
#pragma unroll 16
    for (int k = 0; k < 64; ++k) acc += pos[k0 + k] * w1[(size_t)(k0 + k) * 128 + n];
    float* red = (float*)smem;
    lds_barrier();
    red[tid] = acc;
    lds_barrier();
    if (tid < 128) ((float*)(p.ws + OFF_BIAS1))[(m * 16 + kc) * 128 + tid] = red[tid] + red[tid + 128];
  }
}

DI void phase1_task(const Params& p, int layer, const float* xin, int grp, unsigned char* smem) {
  const int tid = otid(), lane = tid & 63, wid = tid >> 6;
  const int b = grp >> 6;
  float* mul = (float*)smem;
  float* sh = mul + 1024;
  const float* adap = (const float*)(p.ws + OFF_ADAP);
  lds_barrier();
  for (int c = tid; c < 1024; c += 256) {
    float s0 = 0.f, s1 = 0.f;
#pragma unroll
    for (int kc = 0; kc < 8; ++kc) { const float* a = adap + (((size_t)kc * 2 + layer) * 8 + b) * 3072; s0 += a[c]; s1 += a[1024 + c]; }
    mul[c] = p.norm_g[layer * 1024 + c] * (1.f + s1); sh[c] = s0;
  }
  lds_barrier();
  u16* H = (u16*)(p.ws + OFF_H);
#pragma unroll 1
  for (int it = 0; it < 4; ++it) {
    float4 v[4][4]; float ss[4];
#pragma unroll
    for (int j = 0; j < 4; ++j) {
      const int row = grp * 64 + wid * 16 + it * 4 + j;
      const float4* xr = (const float4*)(xin + (size_t)row * D_MODEL);
#pragma unroll
      for (int i = 0; i < 4; ++i) v[j][i] = xr[lane + 64 * i];
    }
#pragma unroll
    for (int j = 0; j < 4; ++j) {
      float a = 0.f;
#pragma unroll
      for (int i = 0; i < 4; ++i) a += v[j][i].x * v[j][i].x + v[j][i].y * v[j][i].y + v[j][i].z * v[j][i].z + v[j][i].w * v[j][i].w;
      ss[j] = wave_sum(a);
    }
#pragma unroll
    for (int j = 0; j < 4; ++j) {
      const int row = grp * 64 + wid * 16 + it * 4 + j;
      const float r = rsqrtf(ss[j] * (1.f / D_MODEL) + 1e-6f);
#pragma unroll
      for (int i = 0; i < 4; ++i) {
        const int c = (lane + 64 * i) * 4;
        u32x2 w;
        w.x = pack2(v[j][i].x * r * mul[c] + sh[c], v[j][i].y * r * mul[c + 1] + sh[c + 1]);
        w.y = pack2(v[j][i].z * r * mul[c + 2] + sh[c + 2], v[j][i].w * r * mul[c + 3] + sh[c + 3]);
        *(u32x2*)(H + (size_t)row * 1024 + c) = w;
      }
    }
  }
}

namespace g8 {
constexpr int BM = 256, BK = 64, HALF = 128, HT = HALF * BK;
constexpr int LDS_BYTES = 8 * HT * 2;
DI int lds_byte(int r, int c) { const int st = (r >> 4) * 2 + (c >> 5), rr = r & 15, cc = c & 31, ob = rr * 64 + cc * 2; return st * 1024 + (ob ^ (((ob >> 9) & 1) << 5)); }
DI void stage_rc(int b, int& R, int& C) { const int st = b / 1024, sb = b % 1024, swz = sb ^ (((sb >> 9) & 1) << 5); R = (st >> 1) * 16 + swz / 64; C = (st & 1) * 32 + (swz % 64) / 2; }

DI void kloop(const u16* __restrict__ A, const u16* __restrict__ Bt, int K, int brow, int bcol, unsigned char* smem, f32x4 (&acc)[2][2][4][2]) {
  u16* shm = (u16*)smem;
  const int tid = otid512();
#define SA(b, h) (shm + ((b) * 2 + (h)) * HT)
#define SB(b, h) (shm + (4 + (b) * 2 + (h)) * HT)
#define STAGE(P, BASE, br, kt) do { const u16* _gb = BASE + ((long)(br) * K + (long)(kt) * BK); \
      __builtin_amdgcn_global_load_lds((const unsigned*)(_gb + soff0), (LDSP unsigned*)((LDSP char*)(P) + tid * 16), 16, 0, 0); \
      __builtin_amdgcn_global_load_lds((const unsigned*)(_gb + soff1), (LDSP unsigned*)((LDSP char*)(P) + tid * 16 + 8192), 16, 0, 0); } while (0)
#define LDA(dst, b, h) _Pragma("unroll") for (int m = 0; m < 4; ++m) _Pragma("unroll") for (int k = 0; k < 2; ++k) \
    dst[m][k] = *reinterpret_cast<const bf16x8*>((const char*)SA(b, h) + lds_byte(wr * 64 + m * 16 + fr, k * 32 + fq * 8))
#define LDB(dst, b, h) _Pragma("unroll") for (int n = 0; n < 2; ++n) _Pragma("unroll") for (int k = 0; k < 2; ++k) \
    dst[n][k] = *reinterpret_cast<const bf16x8*>((const char*)SB(b, h) + lds_byte(wc * 32 + n * 16 + fr, k * 32 + fq * 8))
#define MMA(ai, bj, At_, Bt_) do { __builtin_amdgcn_s_setprio(1); \
    _Pragma("unroll") for (int m = 0; m < 4; ++m) _Pragma("unroll") for (int n = 0; n < 2; ++n) _Pragma("unroll") for (int k = 0; k < 2; ++k) \
      acc[ai][bj][m][n] = __builtin_amdgcn_mfma_f32_16x16x32_bf16(Bt_[n][k], At_[m][k], acc[ai][bj][m][n], 0, 0, 0); \
    __builtin_amdgcn_s_setprio(0); } while (0)
#define WAIT_V(n) asm volatile("s_waitcnt vmcnt(" #n ")" ::: "memory")
#define WAIT_L(n) asm volatile("s_waitcnt lgkmcnt(" #n ")" ::: "memory")
#define BAR __builtin_amdgcn_s_barrier()
#define SCHED __builtin_amdgcn_sched_barrier(0)
  const int wid = __builtin_amdgcn_readfirstlane(tid >> 6), lane = tid & 63, wr = wid >> 2, wc = wid & 3, fr = lane & 15, fq = lane >> 4;
#pragma unroll
  for (int a = 0; a < 2; ++a)
#pragma unroll
    for (int b = 0; b < 2; ++b)
#pragma unroll
      for (int m = 0; m < 4; ++m) { acc[a][b][m][0] = (f32x4){0.f, 0.f, 0.f, 0.f}; acc[a][b][m][1] = (f32x4){0.f, 0.f, 0.f, 0.f}; }
  bf16x8 At[4][2], B0[2][2], B1[2][2];
  const int nt = K / BK;
  int soff0, soff1;
  { int r_, c_; stage_rc(tid * 16, r_, c_); soff0 = r_ * K + c_; stage_rc(tid * 16 + 8192, r_, c_); soff1 = r_ * K + c_; }
  STAGE(SB(0, 0), Bt, bcol, 0); STAGE(SA(0, 0), A, brow, 0);
  STAGE(SB(0, 1), Bt, bcol + HALF, 0); STAGE(SA(0, 1), A, brow + HALF, 0);
  if (wr == 1) BAR;
  WAIT_V(4); BAR;
  STAGE(SB(1, 0), Bt, bcol, 1); STAGE(SA(1, 0), A, brow, 1); STAGE(SB(1, 1), Bt, bcol + HALF, 1);
  WAIT_V(6); BAR;
#pragma unroll 1
  for (int t = 0; t < nt - 2; t += 2) {
    asm volatile("" : "+v"(soff0), "+v"(soff1));
    LDB(B0, 0, 0); SCHED; LDA(At, 0, 0); STAGE(SA(1, 1), A, brow + HALF, t + 1);
    WAIT_L(8); BAR; WAIT_L(0); MMA(0, 0, At, B0); BAR; SCHED;
    LDB(B1, 0, 1); STAGE(SB(0, 0), Bt, bcol, t + 2);
    BAR; WAIT_L(0); MMA(0, 1, At, B1); BAR;
    LDA(At, 0, 1); STAGE(SA(0, 0), A, brow, t + 2);
    BAR; WAIT_L(0); MMA(1, 0, At, B0); BAR; SCHED;
    STAGE(SB(0, 1), Bt, bcol + HALF, t + 2);
    WAIT_V(6); BAR; MMA(1, 1, At, B1); BAR;
    LDB(B0, 1, 0); SCHED; LDA(At, 1, 0); STAGE(SA(0, 1), A, brow + HALF, t + 2);
    WAIT_L(8); BAR; WAIT_L(0); MMA(0, 0, At, B0); BAR; SCHED;
    LDB(B1, 1, 1); STAGE(SB(1, 0), Bt, bcol, t + 3);
    BAR; WAIT_L(0); MMA(0, 1, At, B1); BAR;
    LDA(At, 1, 1); STAGE(SA(1, 0), A, brow, t + 3);
    BAR; WAIT_L(0); MMA(1, 0, At, B0); BAR; SCHED;
    STAGE(SB(1, 1), Bt, bcol + HALF, t + 3);
    WAIT_V(6); BAR; MMA(1, 1, At, B1); BAR;
  }
  { LDB(B0, 0, 0); LDA(At, 0, 0); STAGE(SA(1, 1), A, brow + HALF, nt - 1);
    BAR; WAIT_L(0); MMA(0, 0, At, B0); BAR;
    LDB(B1, 0, 1); BAR; WAIT_L(0); MMA(0, 1, At, B1); BAR;
    LDA(At, 0, 1); WAIT_V(4); BAR; WAIT_L(0); MMA(1, 0, At, B0); MMA(1, 1, At, B1); BAR; }
  { LDB(B0, 1, 0); LDA(At, 1, 0); WAIT_V(2); BAR; WAIT_L(0); MMA(0, 0, At, B0); BAR;
    LDB(B1, 1, 1); WAIT_V(0); BAR; WAIT_L(0); MMA(0, 1, At, B1); BAR;
    LDA(At, 1, 1); BAR; WAIT_L(0); MMA(1, 0, At, B0); MMA(1, 1, At, B1); BAR; }
  if (wr == 0) BAR;
#undef SA
#undef SB
#undef STAGE
#undef LDA
#undef LDB
#undef MMA
#undef WAIT_V
#undef WAIT_L
#undef BAR
#undef SCHED
}
DI void tile_map(int wgid, int nM, int nN, int& pm, int& pn) {
  const int nwg = nM * nN, NXCD = 8, WGM = 8;
  { const int q = nwg / NXCD, r = nwg % NXCD, xcd = wgid % NXCD, off = wgid / NXCD; wgid = (xcd < r ? xcd * (q + 1) : r * (q + 1) + (xcd - r) * q) + off; }
  const int nig = WGM * nN, gid = wgid / nig, fm = gid * WGM, gsz = (nM - fm) < WGM ? (nM - fm) : WGM;
  pm = fm + ((wgid % nig) % gsz); pn = (wgid % nig) / gsz;
}
}

DI void gemm_inproj_tile(const Params& p, int layer, int tile, unsigned char* smem) {
  int pm, pn; g8::tile_map(tile, NTOK / 256, NPAD / 256, pm, pn);
  const int brow = pm * 256, bcol = pn * 256;
  f32x4 acc[2][2][4][2];
  g8::kloop((const u16*)(p.ws + OFF_H), (const u16*)(p.ws + OFF_WINT) + (size_t)layer * NPAD * 1024, 1024, brow, bcol, smem, acc);
  const int tid = otid512(), wid = __builtin_amdgcn_readfirstlane(tid >> 6), lane = tid & 63, wr = wid >> 2, wc = wid & 3, fr = lane & 15, fq = lane >> 4;
  u16* proj = (u16*)(p.ws + OFF_PROJ);
  if (pn == 15 && wc == 0) {
    float* sm = (float*)(p.ws + OFF_SMALL);
#pragma unroll
    for (int ai = 0; ai < 2; ++ai)
#pragma unroll
      for (int m = 0; m < 4; ++m)
#pragma unroll
        for (int n = 0; n < 2; ++n) {
          const int mr = brow + ai * 128 + wr * 64 + m * 16 + fr;
          *(f32x4*)(sm + (size_t)mr * NSMALL + n * 16 + 4 * fq) = acc[ai][1][m][n];
        }
  }
  constexpr int CLD = 264;
  u16* Cs = (u16*)smem;
#pragma unroll
  for (int ai = 0; ai < 2; ++ai) {
    lds_barrier();
#pragma unroll
    for (int bj = 0; bj < 2; ++bj)
#pragma unroll
      for (int m = 0; m < 4; ++m)
#pragma unroll
        for (int n = 0; n < 2; ++n) {
          const f32x4 v = acc[ai][bj][m][n];
          u32x2 w; w.x = pack2(v[0], v[1]); w.y = pack2(v[2], v[3]);
          *(u32x2*)(Cs + (wr * 64 + m * 16 + fr) * CLD + bj * 128 + wc * 32 + n * 16 + 4 * fq) = w;
        }
    lds_barrier();
#pragma unroll
    for (int i = 0; i < 8; ++i) {
      const int id = tid + 512 * i, row = id >> 5, ch = id & 31;
      if (bcol + ch * 8 < NP) *(u32x4*)(proj + (size_t)(brow + ai * 128 + row) * NP + bcol + ch * 8) = *(const u32x4*)(Cs + row * CLD + ch * 8);
    }
  }
  asm volatile("s_waitcnt vmcnt(0)" ::: "memory");
  lds_barrier();
}

DI void gemm_outproj_tile(const Params& p, int layer, const float* xin, float* xout, int tile, unsigned char* smem) {
  int pm, pn; g8::tile_map(tile, NTOK / 256, 4, pm, pn);
  const int brow = pm * 256, bcol = pn * 256;
  f32x4 acc[2][2][4][2];
  g8::kloop((const u16*)(p.ws + OFF_H), (const u16*)(p.ws + OFF_WOUTT) + (size_t)layer * 1024 * 1024, 1024, brow, bcol, smem, acc);
  const int tid = otid512(), wid = __builtin_amdgcn_readfirstlane(tid >> 6), lane = tid & 63, wr = wid >> 2, wc = wid & 3, fr = lane & 15, fq = lane >> 4;
  const int b = brow >> 12;
  const float* adap = (const float*)(p.ws + OFF_ADAP);
  constexpr int CLD = 132;
  float* Cs = (float*)smem;
#pragma unroll
  for (int ai = 0; ai < 2; ++ai)
#pragma unroll
    for (int bj = 0; bj < 2; ++bj) {
      lds_barrier();
#pragma unroll
      for (int m = 0; m < 4; ++m)
#pragma unroll
        for (int n = 0; n < 2; ++n) *(f32x4*)(Cs + (wr * 64 + m * 16 + fr) * CLD + wc * 32 + n * 16 + 4 * fq) = acc[ai][bj][m][n];
      lds_barrier();
      const int ch = tid & 31, nc = bcol + bj * 128 + ch * 4;
      f32x4 gt = {0.f, 0.f, 0.f, 0.f};
#pragma unroll
      for (int kc = 0; kc < 8; ++kc) gt += *(const f32x4*)(adap + (((size_t)kc * 2 + layer) * 8 + b) * 3072 + 2048 + nc);
      f32x4 xv[8];
#pragma unroll
      for (int i = 0; i < 8; ++i) xv[i] = *(const f32x4*)(xin + (size_t)(brow + ai * 128 + (tid >> 5) + 16 * i) * 1024 + nc);
#pragma unroll
      for (int i = 0; i < 8; ++i) {
        const int row = (tid >> 5) + 16 * i;
        *(f32x4*)(xout + (size_t)(brow + ai * 128 + row) * 1024 + nc) = xv[i] + gt * *(const f32x4*)(Cs + row * CLD + ch * 4);
      }
    }
  asm volatile("s_waitcnt vmcnt(0)" ::: "memory");
  lds_barrier();
}

constexpr int KLD = 72;
struct KVRegs { u32x4 k[2], v[2]; };
DI void kv_load(const u16* kbase, const u16* vbase, int ldk, int ldv, int key0, KVRegs& r) {
  const int tid = otid();
#pragma unroll
  for (int i = 0; i < 2; ++i) {
    const int id = tid + 256 * i, row = id >> 3, ch = id & 7;
    r.k[i] = *(const u32x4*)(kbase + (size_t)(key0 + row) * ldk + ch * 8);
    r.v[i] = *(const u32x4*)(vbase + (size_t)(key0 + row) * ldv + ch * 8);
  }
}
DI void kv_store(u16* Ks, u16* Vs, const KVRegs& r) {
  const int tid = otid();
#pragma unroll
  for (int i = 0; i < 2; ++i) {
    const int id = tid + 256 * i, row = id >> 3, ch = id & 7;
    *(u32x4*)(Ks + row * KLD + ch * 8) = r.k[i];
    *(u32x4*)(Vs + row * KLD + ch * 8) = r.v[i];
  }
}
constexpr int KVBUF = 2 * 64 * KLD;
template <class UseF, class LoadF, class CompF>
DI void kv_pipeline(int j0, int j1, u16* buf, UseF use, LoadF load, CompF comp) {
  KVRegs kr;
  if (use(j0)) load(j0, kr);
  lds_barrier();
  if (use(j0)) kv_store(buf, buf + 64 * KLD, kr);
  if (j0 + 1 < j1 && use(j0 + 1)) load(j0 + 1, kr);
  lds_barrier();
  for (int j = j0; j < j1; ++j) {
    u16* cur = buf + ((j - j0) & 1) * KVBUF; u16* nxt = buf + (((j - j0) & 1) ^ 1) * KVBUF;
    if (j + 1 < j1 && use(j + 1)) kv_store(nxt, nxt + 64 * KLD, kr);
    if (j + 2 < j1 && use(j + 2)) load(j + 2, kr);
    if (use(j)) comp(j, cur, cur + 64 * KLD);
    lds_barrier();
  }
}
struct AttnAcc { f32x4 o[4][2]; float m[2], l[2]; f32x4 os[2]; int fresh; };
DI void attn_init(AttnAcc& a) {
#pragma unroll
  for (int d = 0; d < 4; ++d) { a.o[d][0] = (f32x4){0.f, 0.f, 0.f, 0.f}; a.o[d][1] = (f32x4){0.f, 0.f, 0.f, 0.f}; }
  a.m[0] = a.m[1] = -1e30f; a.l[0] = a.l[1] = 0.f;
}
template <int NKS>
DI void qk_tile(const u16* Ks, int dofs, const bf16x8 (&qf)[2][NKS], f32x4 (&s)[4][2], int l15, int g) {
#pragma unroll
  for (int kt = 0; kt < 4; ++kt) {
    s[kt][0] = (f32x4){0.f, 0.f, 0.f, 0.f}; s[kt][1] = (f32x4){0.f, 0.f, 0.f, 0.f};
#pragma unroll
    for (int ks = 0; ks < NKS; ++ks) {
      const bf16x8 a = ldfrag(Ks + (kt * 16 + l15) * KLD + dofs + ks * 32 + 8 * g);
      s[kt][0] = mfma16(a, qf[0][ks], s[kt][0]);
      s[kt][1] = mfma16(a, qf[1][ks], s[kt][1]);
    }
  }
}
DI void pv_accum(const bf16x8 (&pf)[2][2], const u16* Vs, f32x4 (&o)[4][2], int l15, int g) {
  const int tq = l15 >> 2, tp = l15 & 3;
#pragma unroll
  for (int kk = 0; kk < 2; ++kk)
#pragma unroll
    for (int d = 0; d < 4; ++d) {
      const bf16x8 vf = cat4(tr_read(Vs + (kk * 32 + 4 * g + tq) * KLD + d * 16 + 4 * tp), tr_read(Vs + (kk * 32 + 16 + 4 * g + tq) * KLD + d * 16 + 4 * tp));
      o[d][0] = mfma16(vf, pf[0][kk], o[d][0]);
      o[d][1] = mfma16(vf, pf[1][kk], o[d][1]);
    }
}
DI void pack_p(const f32x4 (&s)[4][2], bf16x8 (&pf)[2][2]) {
#pragma unroll
  for (int qt = 0; qt < 2; ++qt)
#pragma unroll
    for (int kk = 0; kk < 2; ++kk) {
      u32x4 w;
      w.x = pack2(s[2 * kk][qt][0], s[2 * kk][qt][1]); w.y = pack2(s[2 * kk][qt][2], s[2 * kk][qt][3]);
      w.z = pack2(s[2 * kk + 1][qt][0], s[2 * kk + 1][qt][1]); w.w = pack2(s[2 * kk + 1][qt][2], s[2 * kk + 1][qt][3]);
      pf[qt][kk] = __builtin_bit_cast(bf16x8, w);
    }
}
constexpr float DEFER_THR = 5.f;
template <class VF>
DI void softmax_pv(f32x4 (&s)[4][2], AttnAcc& a, const u16* Vs, float sc, int l15, int g, VF valid) {
  bf16x8 pf[2][2];
  float mxl[2];
#pragma unroll
  for (int qt = 0; qt < 2; ++qt) {
    float mx = -1e30f;
#pragma unroll
    for (int kt = 0; kt < 4; ++kt)
#pragma unroll
      for (int r = 0; r < 4; ++r) { const float v = valid(kt, r, qt) ? s[kt][qt][r] * sc : -1e30f; s[kt][qt][r] = v; mx = fmaxf(mx, v); }
    mxl[qt] = mx;
  }
  if (__any((mxl[0] > a.m[0] + DEFER_THR) || (mxl[1] > a.m[1] + DEFER_THR))) {
#pragma unroll
    for (int qt = 0; qt < 2; ++qt) {
      float mx = mxl[qt];
      mx = fmaxf(mx, __shfl_xor(mx, 16)); mx = fmaxf(mx, __shfl_xor(mx, 32));
      const float mn = fmaxf(a.m[qt], mx), alpha = exp2_(a.m[qt] - mn);
      a.m[qt] = mn; a.l[qt] *= alpha;
#pragma unroll
      for (int d = 0; d < 4; ++d) a.o[d][qt] *= alpha;
    }
  }
#pragma unroll
  for (int qt = 0; qt < 2; ++qt) {
    const float mn = a.m[qt];
    float ls = 0.f;
#pragma unroll
    for (int kt = 0; kt < 4; ++kt)
#pragma unroll
      for (int r = 0; r < 4; ++r) { const float v = s[kt][qt][r]; const float pv = v > -1e29f ? exp2_(v - mn) : 0.f; s[kt][qt][r] = pv; ls += pv; }
    a.l[qt] += ls;
  }
  pack_p(s, pf);
  pv_accum(pf, Vs, a.o, l15, g);
}
DI void softmax_pv_nomask(f32x4 (&s)[4][2], AttnAcc& a, const u16* Vs, float sc, int l15, int g) {
  bf16x8 pf[2][2];
  float mxl[2];
#pragma unroll
  for (int qt = 0; qt < 2; ++qt) {
    float mx = s[0][qt][0];
#pragma unroll
    for (int kt = 0; kt < 4; ++kt)
#pragma unroll
      for (int r = 0; r < 4; ++r) mx = fmaxf(mx, s[kt][qt][r]);
    mxl[qt] = mx * sc;
  }
  if (__any((mxl[0] > a.m[0] + DEFER_THR) || (mxl[1] > a.m[1] + DEFER_THR))) {
#pragma unroll
    for (int qt = 0; qt < 2; ++qt) {
      float mx = mxl[qt];
      mx = fmaxf(mx, __shfl_xor(mx, 16)); mx = fmaxf(mx, __shfl_xor(mx, 32));
      const float mn = fmaxf(a.m[qt], mx), alpha = exp2_(a.m[qt] - mn);
      a.m[qt] = mn; a.l[qt] *= alpha;
#pragma unroll
      for (int d = 0; d < 4; ++d) a.o[d][qt] *= alpha;
    }
  }
#pragma unroll
  for (int qt = 0; qt < 2; ++qt) {
    const float mn = a.m[qt];
    float ls = 0.f;
#pragma unroll
    for (int kt = 0; kt < 4; ++kt)
#pragma unroll
      for (int r = 0; r < 4; ++r) { const float pv = exp2_(__builtin_fmaf(s[kt][qt][r], sc, -mn)); s[kt][qt][r] = pv; ls += pv; }
    a.l[qt] += ls;
  }
  pack_p(s, pf);
  pv_accum(pf, Vs, a.o, l15, g);
}
template <class VF>
DI void softmax_p(f32x4 (&s)[4][2], AttnAcc& a, float sc, bf16x8 (&pf)[2][2], bool nomask, VF valid) {
  float mxl[2];
#pragma unroll
  for (int qt = 0; qt < 2; ++qt) {
    float mx = -1e30f;
#pragma unroll
    for (int kt = 0; kt < 4; ++kt)
#pragma unroll
      for (int r = 0; r < 4; ++r) { const float v = (nomask || valid(kt, r, qt)) ? s[kt][qt][r] * sc : -1e30f; s[kt][qt][r] = v; mx = fmaxf(mx, v); }
    mxl[qt] = mx;
  }
  if (__any((mxl[0] > a.m[0] + DEFER_THR) || (mxl[1] > a.m[1] + DEFER_THR))) {
#pragma unroll
    for (int qt = 0; qt < 2; ++qt) {
      float mx = mxl[qt];
      mx = fmaxf(mx, __shfl_xor(mx, 16)); mx = fmaxf(mx, __shfl_xor(mx, 32));
      const float mn = fmaxf(a.m[qt], mx), alpha = exp2_(a.m[qt] - mn);
      a.m[qt] = mn; a.l[qt] *= alpha;
#pragma unroll
      for (int d = 0; d < 4; ++d) a.o[d][qt] *= alpha;
    }
  }
#pragma unroll
  for (int qt = 0; qt < 2; ++qt) {
    const float mn = a.m[qt];
    float ls = 0.f;
#pragma unroll
    for (int kt = 0; kt < 4; ++kt)
#pragma unroll
      for (int r = 0; r < 4; ++r) { const float v = s[kt][qt][r]; const float pv = v > -1e29f ? exp2_(v - mn) : 0.f; s[kt][qt][r] = pv; ls += pv; }
    a.l[qt] += ls;
  }
  pack_p(s, pf);
}
DI void softmax_p_nomask(f32x4 (&s)[4][2], AttnAcc& a, float sc, bf16x8 (&pf)[2][2]) {
  float mxl[2];
#pragma unroll
  for (int qt = 0; qt < 2; ++qt) {
    float mx = s[0][qt][0];
#pragma unroll
    for (int kt = 0; kt < 4; ++kt)
#pragma unroll
      for (int r = 0; r < 4; ++r) mx = fmaxf(mx, s[kt][qt][r]);
    mxl[qt] = mx * sc;
  }
  if (__any((mxl[0] > a.m[0] + DEFER_THR) || (mxl[1] > a.m[1] + DEFER_THR))) {
#pragma unroll
    for (int qt = 0; qt < 2; ++qt) {
      float mx = mxl[qt];
      mx = fmaxf(mx, __shfl_xor(mx, 16)); mx = fmaxf(mx, __shfl_xor(mx, 32));
      const float mn = fmaxf(a.m[qt], mx), alpha = exp2_(a.m[qt] - mn);
      a.m[qt] = mn; a.l[qt] *= alpha;
#pragma unroll
      for (int d = 0; d < 4; ++d) a.o[d][qt] *= alpha;
    }
  }
#pragma unroll
  for (int qt = 0; qt < 2; ++qt) {
    const float mn = a.m[qt];
    float ls = 0.f;
#pragma unroll
    for (int kt = 0; kt < 4; ++kt)
#pragma unroll
      for (int r = 0; r < 4; ++r) { const float pv = exp2_(__builtin_fmaf(s[kt][qt][r], sc, -mn)); s[kt][qt][r] = pv; ls += pv; }
    a.l[qt] += ls;
  }
  pack_p(s, pf);
}
DI float group_sum4_(float v) { v += __shfl_xor(v, 16); v += __shfl_xor(v, 32); return v; }
DI bf16x8 scale_frag(bf16x8 f, float sc) {
  u32x4 w = __builtin_bit_cast(u32x4, f);
  w.x = pack2(bflo(w.x) * sc, bfhi(w.x) * sc); w.y = pack2(bflo(w.y) * sc, bfhi(w.y) * sc);
  w.z = pack2(bflo(w.z) * sc, bfhi(w.z) * sc); w.w = pack2(bflo(w.w) * sc, bfhi(w.w) * sc);
  return __builtin_bit_cast(bf16x8, w);
}
DI void attn_init_rel(AttnAcc& a) { attn_init(a); a.m[0] = a.m[1] = 0.f; a.os[0] = (f32x4){0.f, 0.f, 0.f, 0.f}; a.os[1] = (f32x4){0.f, 0.f, 0.f, 0.f}; a.fresh = 1; }
DI void rowsum_accum(const bf16x8 (&pf)[2][2], AttnAcc& a, int l15) {
  const short one = l15 == 0 ? (short)0x3F80 : (short)0;
  const bf16x8 ones = {one, one, one, one, one, one, one, one};
#pragma unroll
  for (int kk = 0; kk < 2; ++kk) { a.os[0] = mfma16(ones, pf[0][kk], a.os[0]); a.os[1] = mfma16(ones, pf[1][kk], a.os[1]); }
}
DI float rel_rowsum(const AttnAcc& a, int qt, int l15) { return __shfl(a.os[qt][0], l15); }
template <int NKS>
DI void qk_tile_rel(const u16* Ks, int dofs, const bf16x8 (&qf)[2][NKS], const AttnAcc& a, f32x4 (&s)[4][2], int l15, int g) {
  const float n0 = -a.m[0], n1 = -a.m[1];
#pragma unroll
  for (int kt = 0; kt < 4; ++kt) {
    s[kt][0] = (f32x4){n0, n0, n0, n0}; s[kt][1] = (f32x4){n1, n1, n1, n1};
#pragma unroll
    for (int ks = 0; ks < NKS; ++ks) {
      const bf16x8 k = ldfrag(Ks + (kt * 16 + l15) * KLD + dofs + ks * 32 + 8 * g);
      s[kt][0] = mfma16(k, qf[0][ks], s[kt][0]);
      s[kt][1] = mfma16(k, qf[1][ks], s[kt][1]);
    }
  }
}
template <int MODE, class VF>
DI void softmax_rel(f32x4 (&s)[4][2], AttnAcc& a, bf16x8 (&pf)[2][2], int l15_, VF valid, bool ok0 = true, bool ok1 = true) {
  float mxl[2];
#pragma unroll
  for (int qt = 0; qt < 2; ++qt) {
    float mx = -1e30f;
    const bool okq = qt == 0 ? ok0 : ok1;
#pragma unroll
    for (int kt = 0; kt < 4; ++kt)
#pragma unroll
      for (int r = 0; r < 4; ++r) {
        if (MODE == 1) s[kt][qt][r] = valid(kt, r, qt) ? s[kt][qt][r] : -1e30f;
        if (MODE == 2) s[kt][qt][r] = okq ? s[kt][qt][r] : -1e30f;
        mx = fmaxf(mx, s[kt][qt][r]);
      }
    mxl[qt] = mx;
  }
  if (a.fresh || __any(mxl[0] > DEFER_THR || mxl[1] > DEFER_THR)) {
    bool still = false;
#pragma unroll
    for (int qt = 0; qt < 2; ++qt) {
      float mx = mxl[qt];
      mx = fmaxf(mx, __shfl_xor(mx, 16)); mx = fmaxf(mx, __shfl_xor(mx, 32));
      const bool fresh = rel_rowsum(a, qt, l15_) == 0.f;
      const float dl = mx < -1e29f ? 0.f : (fresh ? mx : fmaxf(mx, 0.f)), alpha = exp2_(-dl);
      still = still || (fresh && mx < -1e29f);
      a.m[qt] += dl; a.os[qt] *= alpha;
#pragma unroll
      for (int d = 0; d < 4; ++d) a.o[d][qt] *= alpha;
#pragma unroll
      for (int kt = 0; kt < 4; ++kt)
#pragma unroll
        for (int r = 0; r < 4; ++r) s[kt][qt][r] -= dl;
    }
    a.fresh = __any(still) ? 1 : 0;
  }
#pragma unroll
  for (int qt = 0; qt < 2; ++qt)
#pragma unroll
    for (int kt = 0; kt < 4; ++kt)
#pragma unroll
      for (int r = 0; r < 4; ++r) s[kt][qt][r] = exp2_(s[kt][qt][r]);
  pack_p(s, pf);
}
template <class LoadF, class CompF>
DI void kv_pipeline3(int j0, int j1, u16* buf, LoadF load, CompF comp) {
  KVRegs kr;
  load(j0, kr);
  lds_barrier();
  kv_store(buf, buf + 64 * KLD, kr);
  if (j0 + 1 < j1) load(j0 + 1, kr);
  lds_barrier();
  int cb = 0;
  for (int j = j0; j < j1; ++j) {
    const int nb = cb == 2 ? 0 : cb + 1, pb = cb == 0 ? 2 : cb - 1;
    if (j + 1 < j1) kv_store(buf + nb * KVBUF, buf + nb * KVBUF + 64 * KLD, kr);
    if (j + 2 < j1) load(j + 2, kr);
    comp(j, buf + cb * KVBUF, buf + pb * KVBUF);
    lds_barrier();
    cb = nb;
  }
}
DI float group_sum4(float v) { v += __shfl_xor(v, 16); v += __shfl_xor(v, 32); return v; }

constexpr int DSTAGE = 2 * 128 * 64;
DI int fKs(int row) { return (row >> 1) & 7; }
DI int fVs(int row) { return ((row >> 1) & 3) << 1; }
DI void kv_dma128(const u16* kbase, const u16* vbase, int ld, int key0, u16* stage, int tid) {
#pragma unroll
  for (int i = 0; i < 4; ++i) {
    const int id = tid + 256 * i, row = id >> 3, c8 = id & 7;
    __builtin_amdgcn_global_load_lds((const unsigned*)(kbase + (size_t)(key0 + row) * ld + ((c8 ^ fKs(row)) * 8)), (LDSP unsigned*)((LDSP char*)stage + id * 16), 16, 0, 0);
  }
#pragma unroll
  for (int i = 0; i < 4; ++i) {
    const int id = tid + 256 * i, row = id >> 3, c8 = id & 7;
    __builtin_amdgcn_global_load_lds((const unsigned*)(vbase + (size_t)(key0 + row) * ld + ((c8 ^ fVs(row)) * 8)), (LDSP unsigned*)((LDSP char*)(stage + 128 * 64) + id * 16), 16, 0, 0);
  }
}
template <int NKS>
DI void qk_tile_rel_sw(const u16* Kh, int dofs, const bf16x8 (&qf)[2][NKS], const AttnAcc& a, f32x4 (&s)[4][2], int l15, int g) {
  const float n0 = -a.m[0], n1 = -a.m[1];
  const int sw = (l15 >> 1) & 7;
#pragma unroll
  for (int kt = 0; kt < 4; ++kt) {
    s[kt][0] = (f32x4){n0, n0, n0, n0}; s[kt][1] = (f32x4){n1, n1, n1, n1};
#pragma unroll
    for (int ks = 0; ks < NKS; ++ks) {
      const bf16x8 k = ldfrag(Kh + (kt * 16 + l15) * 64 + ((((dofs >> 3) + ks * 4 + g) ^ sw) * 8));
      s[kt][0] = mfma16(k, qf[0][ks], s[kt][0]);
      s[kt][1] = mfma16(k, qf[1][ks], s[kt][1]);
    }
  }
}
DI void pv_accum_sw(const bf16x8 (&pf)[2][2], const u16* Vh, f32x4 (&o)[4][2], int l15, int g) {
  const int tq = l15 >> 2, tp = l15 & 3;
#pragma unroll
  for (int kk = 0; kk < 2; ++kk) {
    const int r0 = kk * 32 + 4 * g + tq, r1 = r0 + 16;
    const int f0 = fVs(r0), f1 = fVs(r1);
#pragma unroll
    for (int d = 0; d < 4; ++d) {
      const int lc = d * 2 + (tp >> 1);
      const bf16x8 vf = cat4(tr_read(Vh + r0 * 64 + ((lc ^ f0) * 8) + (tp & 1) * 4), tr_read(Vh + r1 * 64 + ((lc ^ f1) * 8) + (tp & 1) * 4));
      o[d][0] = mfma16(vf, pf[0][kk], o[d][0]);
      o[d][1] = mfma16(vf, pf[1][kk], o[d][1]);
    }
  }
}
DI void diff_attn_task(const Params& p, int layer, int b, int h, int qb, unsigned char* smem, bool skew) {
  u16* Ks = (u16*)smem; u16* Vs = Ks + 64 * KLD;
  const int tid = otid(), lane = tid & 63, wid = tid >> 6, l15 = lane & 15, g = lane >> 4;
  const u16* proj = (const u16*)(p.ws + OFF_PROJ) + (size_t)b * SEQ * NP;
  const int q0w = qb * 128 + wid * 32;
  const float* lam = p.diff_lam + layer * 128;
  float s01 = 0.f, s23 = 0.f;
  for (int i = 0; i < 32; ++i) { s01 += lam[i] * lam[32 + i]; s23 += lam[64 + i] * lam[96 + i]; }
  const float lam_init = layer == 0 ? 0.2f : 0.35550906759096324f;
  const float lam_full = sgprf(__expf(s01) - __expf(s23) + lam_init);
  const float sc = 0.17677669529663687f * 1.4426950408889634f;
  const int ntile = 2 * qb + 2;
  const u16* vbase = proj + PB_V + h * 64;
  f32x4 res[4][2];
#pragma unroll 1
  for (int c = 0; c < 2; ++c) {
    const u16* kbase = proj + PB_K + h * 64;
    bf16x8 qf[2][1];
#pragma unroll
    for (int qt = 0; qt < 2; ++qt) qf[qt][0] = scale_frag(ldfrag(proj + (size_t)(q0w + qt * 16 + l15) * NP + PB_Q + h * 64 + c * 32 + 8 * g), sc);
    AttnAcc a; attn_init_rel(a);
    const int nst = qb + 1;
    asm volatile("s_waitcnt vmcnt(0)" ::: "memory");
    lds_barrier();
    kv_dma128(kbase, vbase, NP, 0, Ks, tid);
    asm volatile("s_waitcnt vmcnt(0)" ::: "memory");
    lds_barrier();
    for (int js = 0; js < nst; ++js) {
      const u16* st = Ks + (js & 1) * DSTAGE;
      if (js + 1 < nst) kv_dma128(kbase, vbase, NP, (js + 1) * 128, Ks + ((js + 1) & 1) * DSTAGE, tid);
#pragma unroll 1
      for (int hf = 0; hf < 2; ++hf) {
        const int key0 = js * 128 + hf * 64;
        if (key0 <= q0w + 31) {
          f32x4 s[4][2]; bf16x8 pf[2][2];
          auto valid = [&](int kt, int r, int qt) { return key0 + kt * 16 + 4 * g + r <= q0w + qt * 16 + l15; };
          qk_tile_rel_sw<1>(st + hf * 64 * 64, c * 32, qf, a, s, l15, g);
          if (key0 + 63 <= q0w) softmax_rel<0>(s, a, pf, l15, valid); else softmax_rel<1>(s, a, pf, l15, valid);
          pv_accum_sw(pf, st + 128 * 64 + hf * 64 * 64, a.o, l15, g);
          rowsum_accum(pf, a, l15);
        }
      }
      asm volatile("s_waitcnt vmcnt(0)" ::: "memory");
      lds_barrier();
    }
#pragma unroll
    for (int qt = 0; qt < 2; ++qt) {
      const float lt = rel_rowsum(a, qt, l15);
      const float inv = c == 0 ? 1.f / lt : -lam_full / lt;
#pragma unroll
      for (int d = 0; d < 4; ++d) res[d][qt] = c == 0 ? a.o[d][qt] * inv : res[d][qt] + a.o[d][qt] * inv;
    }
  }
  u16* Y = (u16*)(p.ws + OFF_H);
  const float* ng = p.diff_norm_g + layer * 64;
#pragma unroll
  for (int qt = 0; qt < 2; ++qt) {
    float ss = 0.f;
#pragma unroll
    for (int d = 0; d < 4; ++d) { const f32x4 v = res[d][qt]; ss += v[0] * v[0] + v[1] * v[1] + v[2] * v[2] + v[3] * v[3]; }
    ss = group_sum4(ss);
    const float rn = rsqrtf(ss * (1.f / 64.f) + 1e-6f) * (1.f - lam_init);
    const int t = q0w + qt * 16 + l15;
    const size_t row = (size_t)b * SEQ + t;
#pragma unroll
    for (int d = 0; d < 4; ++d) {
      const int dd = d * 16 + 4 * g;
      const f32x4 v = res[d][qt];
      const u32x2 zz = *(const u32x2*)(proj + (size_t)t * NP + PB_Z + h * 64 + dd);
      const f32x4 gg = *(const f32x4*)(ng + dd);
      u32x2 w;
      w.x = pack2(v[0] * rn * gg[0] * siluf(bflo(zz.x)), v[1] * rn * gg[1] * siluf(bfhi(zz.x)));
      w.y = pack2(v[2] * rn * gg[2] * siluf(bflo(zz.y)), v[3] * rn * gg[3] * siluf(bfhi(zz.y)));
      *(u32x2*)(Y + row * 1024 + Y_B + h * 64 + dd) = w;
    }
  }
}

template <int NKS>
DI void qk_tile1(const u16* Ks, const bf16x8 (&qf)[NKS], f32x4 (&s)[4], int l15, int g) {
#pragma unroll
  for (int kt = 0; kt < 4; ++kt) {
    s[kt] = (f32x4){0.f, 0.f, 0.f, 0.f};
#pragma unroll
    for (int ks = 0; ks < NKS; ++ks) s[kt] = mfma16(ldfrag(Ks + (kt * 16 + l15) * KLD + ks * 32 + 8 * g), qf[ks], s[kt]);
  }
}
DI void pv_accum1(const f32x4 (&s)[4], const u16* Vs, f32x4 (&o)[4], int l15, int g) {
  const int tq = l15 >> 2, tp = l15 & 3;
#pragma unroll
  for (int kk = 0; kk < 2; ++kk) {
    u32x4 w;
    w.x = pack2(s[2 * kk][0], s[2 * kk][1]); w.y = pack2(s[2 * kk][2], s[2 * kk][3]);
    w.z = pack2(s[2 * kk + 1][0], s[2 * kk + 1][1]); w.w = pack2(s[2 * kk + 1][2], s[2 * kk + 1][3]);
    const bf16x8 pf = __builtin_bit_cast(bf16x8, w);
#pragma unroll
    for (int d = 0; d < 4; ++d) {
      const bf16x8 vf = cat4(tr_read(Vs + (kk * 32 + 4 * g + tq) * KLD + d * 16 + 4 * tp), tr_read(Vs + (kk * 32 + 16 + 4 * g + tq) * KLD + d * 16 + 4 * tp));
      o[d] = mfma16(vf, pf, o[d]);
    }
  }
}
DI void conv_silu_stage(const u16* projb, int col0, const float* cw, const float* cb, int chan0, int nchan, int t0, u16* dst, const float* rowscale, float cscale) {
  const int tid = otid(), ch = (tid & 7) * 8;
  float w[4][8], bias[8];
#pragma unroll
  for (int j = 0; j < 4; ++j)
#pragma unroll
    for (int i = 0; i < 8; ++i) w[j][i] = cw[j * nchan + chan0 + ch + i];
#pragma unroll
  for (int i = 0; i < 8; ++i) bias[i] = cb[chan0 + ch + i];
#pragma unroll 1
  for (int ps = 0; ps < 4; ++ps) {
    const int row = ps * 32 + (tid >> 3), t = t0 + row;
    float acc[8];
#pragma unroll
    for (int i = 0; i < 8; ++i) acc[i] = bias[i];
#pragma unroll
    for (int j = 0; j < 4; ++j) {
      const int tt = t - 3 + j;
      if (tt >= 0) {
        const u32x4 v = *(const u32x4*)(projb + (size_t)tt * NP + col0 + ch);
        acc[0] += w[j][0] * bflo(v.x); acc[1] += w[j][1] * bfhi(v.x); acc[2] += w[j][2] * bflo(v.y); acc[3] += w[j][3] * bfhi(v.y);
        acc[4] += w[j][4] * bflo(v.z); acc[5] += w[j][5] * bfhi(v.z); acc[6] += w[j][6] * bflo(v.w); acc[7] += w[j][7] * bfhi(v.w);
      }
    }
    const float rs = (rowscale ? rowscale[row] : 1.f) * cscale;
#pragma unroll
    for (int i = 0; i < 8; ++i) acc[i] = siluf(acc[i]) * rs;
    u32x4 o; o.x = pack2(acc[0], acc[1]); o.y = pack2(acc[2], acc[3]); o.z = pack2(acc[4], acc[5]); o.w = pack2(acc[6], acc[7]);
    *(u32x4*)(dst + row * KLD + ch) = o;
  }
}
DI float block_scan128_add(float v, float* tmp) {
  const int tid = otid(), lane = tid & 63;
  float x = v;
#pragma unroll
  for (int o = 1; o < 64; o <<= 1) { const float y = __shfl_up(x, o); if (lane >= o) x += y; }
  lds_barrier();
  if (tid == 63) tmp[0] = x;
  lds_barrier();
  if ((tid >> 6) == 1) x += tmp[0];
  return x;
}
DI float block_scan128_max(float v, float* tmp) {
  const int tid = otid(), lane = tid & 63;
  float x = v;
#pragma unroll
  for (int o = 1; o < 64; o <<= 1) { const float y = __shfl_up(x, o); if (lane >= o) x = fmaxf(x, y); }
  lds_barrier();
  if (tid == 63) tmp[0] = x;
  lds_barrier();
  if ((tid >> 6) == 1) x = fmaxf(x, tmp[0]);
  return x;
}
DI void scale_rows(u16* A, const float* rs) {
  const int tid = otid(), ch = (tid & 7) * 8;
#pragma unroll
  for (int ps = 0; ps < 4; ++ps) {
    const int row = ps * 32 + (tid >> 3);
    const float f = rs[row];
    u32x4 v = *(u32x4*)(A + row * KLD + ch);
    v.x = pack2(bflo(v.x) * f, bfhi(v.x) * f); v.y = pack2(bflo(v.y) * f, bfhi(v.y) * f);
    v.z = pack2(bflo(v.z) * f, bfhi(v.z) * f); v.w = pack2(bflo(v.w) * f, bfhi(v.w) * f);
    *(u32x4*)(A + row * KLD + ch) = v;
  }
}
DI void state_update(const u16* Xs, const u16* Bs, f32x4 (&acc)[4], int w, int l15, int g) {
  const int tq = l15 >> 2, tp = l15 & 3;
#pragma unroll
  for (int kk = 0; kk < 4; ++kk) {
    const bf16x8 af = cat4(tr_read(Xs + (kk * 32 + 4 * g + tq) * KLD + w * 16 + 4 * tp), tr_read(Xs + (kk * 32 + 16 + 4 * g + tq) * KLD + w * 16 + 4 * tp));
#pragma unroll
    for (int nt = 0; nt < 4; ++nt) {
      const bf16x8 bfr = cat4(tr_read(Bs + (kk * 32 + 4 * g + tq) * KLD + nt * 16 + 4 * tp), tr_read(Bs + (kk * 32 + 16 + 4 * g + tq) * KLD + nt * 16 + 4 * tp));
      acc[nt] = mfma16(af, bfr, acc[nt]);
    }
  }
}
DI void state_to_lds(u16* Ss, const f32x4 (&acc)[4], int w, int l15, int g) {
#pragma unroll
  for (int nt = 0; nt < 4; ++nt)
#pragma unroll
    for (int r = 0; r < 4; ++r) Ss[(w * 16 + 4 * g + r) * KLD + nt * 16 + l15] = f2bf(acc[nt][r]);
}

constexpr int SEQ_LDS_A = 0, SEQ_LDS_B = 128 * KLD * 2, SEQ_LDS_C = 2 * 128 * KLD * 2, SEQ_LDS_S = 3 * 128 * KLD * 2, SEQ_LDS_F = SEQ_LDS_S + 64 * KLD * 2;
constexpr int SEQ_LDS_HALO = SEQ_LDS_F + 4096;
constexpr int SEQ_LDS_CW = SEQ_LDS_HALO + 2 * 3 * 3 * 64 * 2;
struct RawRegs { u32x4 r[4]; };
DI void raw_load(const u16* projb, int col0, int t0, RawRegs& rr, int tid) {
#pragma unroll
  for (int i = 0; i < 4; ++i) rr.r[i] = *(const u32x4*)(projb + (size_t)(t0 + (tid >> 3) + 32 * i) * NP + col0 + (tid & 7) * 8);
}
DI void raw_store(u16* dst, u16* halo_next, const RawRegs& rr, int tid) {
#pragma unroll
  for (int i = 0; i < 4; ++i) *(u32x4*)(dst + ((tid >> 3) + 32 * i) * KLD + (tid & 7) * 8) = rr.r[i];
  if (halo_next && tid >= 232) *(u32x4*)(halo_next + ((tid >> 3) - 29) * 64 + (tid & 7) * 8) = rr.r[3];
}
DI void conv_from_lds(const u16* raw, const u16* halo, const float* wl, const float* rowscale, float cscale, u32x4 (&out)[4], int tid) {
  const int q = tid >> 3, ch = (tid & 7) * 8;
  u32x4 v[7];
#pragma unroll
  for (int k = 0; k < 7; ++k) { const int r = 4 * q - 3 + k; v[k] = r >= 0 ? *(const u32x4*)(raw + r * KLD + ch) : *(const u32x4*)(halo + (r + 3) * 64 + ch); }
  float w[5][8];
#pragma unroll
  for (int j = 0; j < 5; ++j) { const f32x4 w0 = *(const f32x4*)(wl + j * 64 + ch), w1 = *(const f32x4*)(wl + j * 64 + ch + 4);
    w[j][0] = w0[0]; w[j][1] = w0[1]; w[j][2] = w0[2]; w[j][3] = w0[3]; w[j][4] = w1[0]; w[j][5] = w1[1]; w[j][6] = w1[2]; w[j][7] = w1[3]; }
#pragma unroll
  for (int o = 0; o < 4; ++o) {
    float acc[8];
#pragma unroll
    for (int i = 0; i < 8; ++i) acc[i] = w[4][i];
#pragma unroll
    for (int j = 0; j < 4; ++j) {
      const u32x4 x = v[o + j];
      acc[0] += w[j][0] * bflo(x.x); acc[1] += w[j][1] * bfhi(x.x); acc[2] += w[j][2] * bflo(x.y); acc[3] += w[j][3] * bfhi(x.y);
      acc[4] += w[j][4] * bflo(x.z); acc[5] += w[j][5] * bfhi(x.z); acc[6] += w[j][6] * bflo(x.w); acc[7] += w[j][7] * bfhi(x.w);
    }
    const float rs = (rowscale ? rowscale[4 * q + o] : 1.f) * cscale;
#pragma unroll
    for (int i = 0; i < 8; ++i) acc[i] = siluf(acc[i]) * rs;
    out[o].x = pack2(acc[0], acc[1]); out[o].y = pack2(acc[2], acc[3]); out[o].z = pack2(acc[4], acc[5]); out[o].w = pack2(acc[6], acc[7]);
  }
}
DI void conv_write(u16* dst, const u32x4 (&out)[4], int tid) {
  const int q = tid >> 3, ch = (tid & 7) * 8;
#pragma unroll
  for (int o = 0; o < 4; ++o) *(u32x4*)(dst + (4 * q + o) * KLD + ch) = out[o];
}
DI void stage_conv_w(float* wl, const float* cw, const float* cb, int chan0, int nchan, int tid) {
  for (int i = tid; i < 320; i += 256) { const int j = i >> 6, cc = i & 63; wl[i] = j < 4 ? cw[j * nchan + chan0 + cc] : cb[chan0 + cc]; }
}
DI float wave_scan_add(float x, int lane) {
#pragma unroll
  for (int o = 1; o < 64; o <<= 1) { const float y = __shfl_up(x, o); if (lane >= o) x += y; }
  return x;
}
DI float wave_scan_max(float x, int lane) {
#pragma unroll
  for (int o = 1; o < 64; o <<= 1) { const float y = __shfl_up(x, o); if (lane >= o) x = fmaxf(x, y); }
  return x;
}

DI void ssd_task(const Params& p, int layer, int b, int h, unsigned char* smem) {
  u16* Cs = (u16*)(smem + SEQ_LDS_A); u16* Bs = (u16*)(smem + SEQ_LDS_B); u16* Xs = (u16*)(smem + SEQ_LDS_C); u16* Ss = (u16*)(smem + SEQ_LDS_S);
  float* fl = (float*)(smem + SEQ_LDS_F);
  float* dts = fl; float* acs = fl + 128; float* wend = fl + 256; float* tmp = fl + 384;
  u16* halo = (u16*)(smem + SEQ_LDS_HALO); float* cwl = (float*)(smem + SEQ_LDS_CW);
  int tid = otid(), lane = tid & 63, w = tid >> 6, l15 = lane & 15, g = lane >> 4;
  const int gi = h >> 1;
  const u16* projb = (const u16*)(p.ws + OFF_PROJ) + (size_t)b * SEQ * NP;
  const float* smb = (const float*)(p.ws + OFF_SMALL) + (size_t)b * SEQ * NSMALL;
  const float* cw = p.ssm_conv_w + layer * 4 * 512; const float* cb = p.ssm_conv_b + layer * 512;
  u16* Y = (u16*)(p.ws + OFF_H);
  const float a_h = -__expf(p.ssm_a_log[layer * 4 + h]), d_h = p.ssm_d[layer * 4 + h], dtb = p.ssm_dt_bias[layer * 4 + h];
  const int colB = PC_XBC + 256 + gi * 64, colC = PC_XBC + 384 + gi * 64, colX = PC_XBC + h * 64;
  f32x4 st[4];
#pragma unroll
  for (int nt = 0; nt < 4; ++nt) st[nt] = (f32x4){0.f, 0.f, 0.f, 0.f};
  lds_barrier();
  stage_conv_w(cwl, cw, cb, 256 + gi * 64, 512, tid);
  stage_conv_w(cwl + 320, cw, cb, 384 + gi * 64, 512, tid);
  stage_conv_w(cwl + 640, cw, cb, h * 64, 512, tid);
  for (int i = tid; i < 3 * 3 * 64; i += 256) halo[i] = 0;
  RawRegs rB, rC, rX; float dtraw = 0.f;
  raw_load(projb, colB, 0, rB, tid); raw_load(projb, colC, 0, rC, tid); raw_load(projb, colX, 0, rX, tid);
  if (tid < 128) dtraw = smb[(size_t)tid * NSMALL + SM_DT + h];
#pragma unroll 1
  for (int c = 0; c < 32; ++c) {
    const int t0 = c * 128;
    asm volatile("" : "+v"(tid)); lane = tid & 63; w = tid >> 6; l15 = lane & 15; g = lane >> 4;
    u16* hcur = halo + (c & 1) * 576; u16* hnext = halo + ((c + 1) & 1) * 576;
    float dtv = 0.f;
    if (tid < 128) { const float xr = dtraw + dtb; dtv = xr > 15.f ? xr : __logf(1.f + __expf(xr)); }
    float cs = wave_scan_add(dtv * a_h, lane);
    if (tid == 63) tmp[0] = cs;
    lds_barrier();
    if (w == 1) cs += tmp[0];
    if (tid < 128) { dts[tid] = dtv; acs[tid] = cs; }
    raw_store(Bs, hnext, rB, tid); raw_store(Cs, hnext + 192, rC, tid); raw_store(Xs, hnext + 384, rX, tid);
    lds_barrier();
    if (c + 1 < 32) {
      raw_load(projb, colB, t0 + 128, rB, tid); raw_load(projb, colC, t0 + 128, rC, tid);
      if (tid < 128) dtraw = smb[(size_t)(t0 + 128 + tid) * NSMALL + SM_DT + h];
    }
    {
      u32x4 o1[4], o2[4];
      conv_from_lds(Bs, hcur, cwl, nullptr, 1.f, o1, tid);
      lds_barrier();
      conv_write(Bs, o1, tid);
      conv_from_lds(Cs, hcur + 192, cwl + 320, nullptr, 1.f, o2, tid);
      lds_barrier();
      conv_write(Cs, o2, tid);
      conv_from_lds(Xs, hcur + 384, cwl + 640, dts, 1.f, o1, tid);
      lds_barrier();
      conv_write(Xs, o1, tid);
    }
    if (tid < 128) wend[tid] = __expf(acs[127] - acs[tid]);
    state_to_lds(Ss, st, w, l15, g);
    lds_barrier();
#pragma unroll 1
    for (int qt = 0; qt < 2; ++qt) {
      const int tl = 32 * w + qt * 16 + l15;
      bf16x8 cf[2];
#pragma unroll
      for (int ks = 0; ks < 2; ++ks) cf[ks] = ldfrag(Cs + tl * KLD + ks * 32 + 8 * g);
      f32x4 y[4];
#pragma unroll
      for (int d = 0; d < 4; ++d) y[d] = (f32x4){0.f, 0.f, 0.f, 0.f};
      const float at = acs[tl];
#pragma unroll 1
      for (int stl = 0; stl < 2; ++stl) {
        if (stl * 64 <= 32 * w + qt * 16 + 15) {
          f32x4 sc[4];
          qk_tile1<2>(Bs + stl * 64 * KLD, cf, sc, l15, g);
#pragma unroll
          for (int kt = 0; kt < 4; ++kt) {
            const f32x4 as = *(const f32x4*)(acs + stl * 64 + kt * 16 + 4 * g);
#pragma unroll
            for (int r = 0; r < 4; ++r) {
              const bool ok = stl * 64 + kt * 16 + 4 * g + r <= tl;
              sc[kt][r] = ok ? sc[kt][r] * __expf(at - as[r]) : 0.f;
            }
          }
          pv_accum1(sc, Xs + stl * 64 * KLD, y, l15, g);
        }
      }
      const float ea = __expf(at), dsk = d_h / dts[tl];
      const size_t row = (size_t)b * SEQ + t0 + tl;
#pragma unroll
      for (int d = 0; d < 4; ++d) {
        f32x4 yo = (f32x4){0.f, 0.f, 0.f, 0.f};
#pragma unroll
        for (int ks = 0; ks < 2; ++ks) yo = mfma16(ldfrag(Ss + (d * 16 + l15) * KLD + ks * 32 + 8 * g), cf[ks], yo);
        const u32x2 xv = *(const u32x2*)(Xs + tl * KLD + d * 16 + 4 * g);
        const f32x4 v = y[d] + yo * ea;
        u32x2 o; o.x = pack2(v[0] + dsk * bflo(xv.x), v[1] + dsk * bfhi(xv.x)); o.y = pack2(v[2] + dsk * bflo(xv.y), v[3] + dsk * bfhi(xv.y));
        *(u32x2*)(Y + row * 1024 + Y_C + h * 64 + d * 16 + 4 * g) = o;
      }
    }
    if (c + 1 < 32) raw_load(projb, colX, t0 + 128, rX, tid);
    lds_barrier();
    scale_rows(Xs, wend);
    lds_barrier();
    const float cd = __expf(acs[127]);
#pragma unroll
    for (int nt = 0; nt < 4; ++nt) st[nt] *= cd;
    state_update(Xs, Bs, st, w, l15, g);
  }
}
DI void seq_fix_rows(const Params& p, int layer, int r0, int nrows) {
  u16* Y = (u16*)(p.ws + OFF_H);
  const u16* proj = (const u16*)(p.ws + OFF_PROJ);
  const int tid = otid(), lane = tid & 63, wv = tid >> 6;
  const bool ml = lane >= 32;
  const int ch = (lane & 31) * 8;
  const float* ng = ml ? p.ml_norm_g + layer * 64 + (ch & 63) : p.ssm_norm_g + layer * 256 + ch;
  const f32x4 g0 = *(const f32x4*)ng, g1 = *(const f32x4*)(ng + 4);
  for (int rb = wv * 4; rb < nrows; rb += 16) {
    u32x4 yv4[4], zv4[4], ov4[4];
#pragma unroll
    for (int j = 0; j < 4; ++j) {
      const size_t row = (size_t)(r0 + rb + j);
      yv4[j] = *(const u32x4*)(Y + row * 1024 + (ml ? Y_D : Y_C) + ch);
      zv4[j] = *(const u32x4*)(proj + row * NP + (ml ? PD_Z : PC_Z) + ch);
      ov4[j] = ml ? *(const u32x4*)(proj + row * NP + PD_O + ch) : (u32x4){0u, 0u, 0u, 0u};
    }
#pragma unroll
    for (int j = 0; j < 4; ++j) {
      const size_t row = (size_t)(r0 + rb + j);
      u16* yp = Y + row * 1024 + (ml ? Y_D : Y_C) + ch;
      const u32x4 yv = yv4[j], zv = zv4[j], ov = ov4[j];
      float v[8] = {bflo(yv.x), bfhi(yv.x), bflo(yv.y), bfhi(yv.y), bflo(yv.z), bfhi(yv.z), bflo(yv.w), bfhi(yv.w)};
      float z[8] = {bflo(zv.x), bfhi(zv.x), bflo(zv.y), bfhi(zv.y), bflo(zv.z), bfhi(zv.z), bflo(zv.w), bfhi(zv.w)};
      float ss = 0.f;
      if (ml) {
        const float o[8] = {bflo(ov.x), bfhi(ov.x), bflo(ov.y), bfhi(ov.y), bflo(ov.z), bfhi(ov.z), bflo(ov.w), bfhi(ov.w)};
#pragma unroll
        for (int i = 0; i < 8; ++i) { v[i] *= sigmoidf_(o[i]); ss += v[i] * v[i]; }
      } else {
#pragma unroll
        for (int i = 0; i < 8; ++i) { v[i] *= siluf(z[i]); ss += v[i] * v[i]; }
      }
      ss += __shfl_xor(ss, 1); ss += __shfl_xor(ss, 2); ss += __shfl_xor(ss, 4);
      const float ss16 = ss + __shfl_xor(ss, 8);
      const float rn = ml ? rsqrtf(ss * (1.f / 64.f) + 1e-6f) : rsqrtf(ss16 * (1.f / 128.f) + 1e-6f);
      float o8[8];
#pragma unroll
      for (int i = 0; i < 8; ++i) { const float gg = i < 4 ? g0[i & 3] : g1[i & 3]; o8[i] = v[i] * rn * gg * (ml ? siluf(z[i]) : 1.f); }
      u32x4 w; w.x = pack2(o8[0], o8[1]); w.y = pack2(o8[2], o8[3]); w.z = pack2(o8[4], o8[5]); w.w = pack2(o8[6], o8[7]);
      *(u32x4*)yp = w;
    }
  }
}

DI void mlstm_task(const Params& p, int layer, int b, int h, unsigned char* smem) {
  u16* Qs = (u16*)(smem + SEQ_LDS_A); u16* Ks2 = (u16*)(smem + SEQ_LDS_B); u16* Vs2 = (u16*)(smem + SEQ_LDS_C); u16* Cst = (u16*)(smem + SEQ_LDS_S);
  float* fl = (float*)(smem + SEQ_LDS_F);
  float* bcs = fl; float* us = fl + 128; float* pms = fl + 256; float* wend = fl + 384; float* nst = fl + 512; float* npart = fl + 576; float* tmp = fl + 832;
  u16* halo = (u16*)(smem + SEQ_LDS_HALO); float* cwl = (float*)(smem + SEQ_LDS_CW);
  int tid = otid(), lane = tid & 63, w = tid >> 6, l15 = lane & 15, g = lane >> 4;
  const u16* projb = (const u16*)(p.ws + OFF_PROJ) + (size_t)b * SEQ * NP;
  const float* smb = (const float*)(p.ws + OFF_SMALL) + (size_t)b * SEQ * NSMALL;
  const float* cw = p.ml_conv_w + layer * 4 * 512; const float* cb = p.ml_conv_b + layer * 512;
  const float ib = p.ml_if_b[layer * 8 + h], fb = p.ml_if_b[layer * 8 + 4 + h];
  u16* Y = (u16*)(p.ws + OFF_H);
  const int colQ = PD_QK + h * 64, colK = PD_QK + 256 + h * 64, colV = PD_V + h * 64;
  f32x4 st[4];
#pragma unroll
  for (int nt = 0; nt < 4; ++nt) st[nt] = (f32x4){0.f, 0.f, 0.f, 0.f};
  float m_prev = 0.f;
  lds_barrier();
  if (tid < 64) nst[tid] = 0.f;
  stage_conv_w(cwl, cw, cb, h * 64, 512, tid);
  stage_conv_w(cwl + 320, cw, cb, 256 + h * 64, 512, tid);
  for (int i = tid; i < 3 * 3 * 64; i += 256) halo[i] = 0;
  RawRegs rQ, rK, rV; float iraw = 0.f, fraw = 0.f;
  raw_load(projb, colQ, 0, rQ, tid); raw_load(projb, colK, 0, rK, tid); raw_load(projb, colV, 0, rV, tid);
  if (tid < 128) { iraw = smb[(size_t)tid * NSMALL + SM_IF + h]; fraw = smb[(size_t)tid * NSMALL + SM_IF + 4 + h]; }
#pragma unroll 1
  for (int c = 0; c < 32; ++c) {
    const int t0 = c * 128;
    asm volatile("" : "+v"(tid)); lane = tid & 63; w = tid >> 6; l15 = lane & 15; g = lane >> 4;
    u16* hcur = halo + (c & 1) * 576; u16* hnext = halo + ((c + 1) & 1) * 576;
    float ip = 0.f, lf = 0.f;
    if (tid < 128) { ip = iraw + ib; const float fp = fraw + fb; lf = fminf(fp, 0.f) - __logf(1.f + __expf(-fabsf(fp))); }
    float bc = wave_scan_add(lf, lane);
    if (tid == 63) tmp[0] = bc;
    lds_barrier();
    if (w == 1) bc += tmp[0];
    const float u = tid < 128 ? ip - bc : -1e30f;
    float pm = wave_scan_max(u, lane);
    if (tid == 63) tmp[1] = pm;
    raw_store(Qs, hnext, rQ, tid); raw_store(Ks2, hnext + 192, rK, tid); raw_store(Vs2, nullptr, rV, tid);
    lds_barrier();
    if (w == 1) pm = fmaxf(pm, tmp[1]);
    if (tid < 128) { bcs[tid] = bc; us[tid] = u; pms[tid] = pm; }
    if (c + 1 < 32) {
      raw_load(projb, colQ, t0 + 128, rQ, tid);
      if (tid < 128) { iraw = smb[(size_t)(t0 + 128 + tid) * NSMALL + SM_IF + h]; fraw = smb[(size_t)(t0 + 128 + tid) * NSMALL + SM_IF + 4 + h]; }
    }
    u32x4 oQ[4], oK[4];
    conv_from_lds(Qs, hcur, cwl, nullptr, 1.f, oQ, tid);
    __builtin_amdgcn_sched_barrier(0);
    conv_from_lds(Ks2, hcur + 192, cwl + 320, nullptr, 0.125f, oK, tid);
    __builtin_amdgcn_sched_barrier(0);
    lds_barrier();
    conv_write(Qs, oQ, tid); conv_write(Ks2, oK, tid);
    state_to_lds(Cst, st, w, l15, g);
    const float blast = bcs[127];
    const float m_new = blast + fmaxf(m_prev, pms[127]);
    if (tid < 128) wend[tid] = __expf(blast - m_new + us[tid]);
    lds_barrier();
#pragma unroll 1
    for (int qt = 0; qt < 2; ++qt) {
      const int tl = 32 * w + qt * 16 + l15;
      bf16x8 qf[2];
#pragma unroll
      for (int ks = 0; ks < 2; ++ks) qf[ks] = ldfrag(Qs + tl * KLD + ks * 32 + 8 * g);
      f32x4 num[4];
#pragma unroll
      for (int d = 0; d < 4; ++d) num[d] = (f32x4){0.f, 0.f, 0.f, 0.f};
      const float bt = bcs[tl], mt = bt + fmaxf(m_prev, pms[tl]);
      float den = 0.f;
#pragma unroll 1
      for (int stl = 0; stl < 2; ++stl) {
        if (stl * 64 <= 32 * w + qt * 16 + 15) {
          f32x4 sc[4];
          qk_tile1<2>(Ks2 + stl * 64 * KLD, qf, sc, l15, g);
#pragma unroll
          for (int kt = 0; kt < 4; ++kt) {
            const f32x4 uu = *(const f32x4*)(us + stl * 64 + kt * 16 + 4 * g);
#pragma unroll
            for (int r = 0; r < 4; ++r) {
              const bool ok = stl * 64 + kt * 16 + 4 * g + r <= tl;
              const float v = ok ? sc[kt][r] * __expf(bt - mt + uu[r]) : 0.f;
              sc[kt][r] = v; den += v;
            }
          }
          pv_accum1(sc, Vs2 + stl * 64 * KLD, num, l15, g);
        }
      }
      const float wi = __expf(bt + m_prev - mt);
      float qn = 0.f;
#pragma unroll
      for (int ks = 0; ks < 2; ++ks)
#pragma unroll
        for (int j = 0; j < 8; ++j) qn += bf2f((u16)qf[ks][j]) * nst[ks * 32 + 8 * g + j];
      qn = group_sum4(qn);
      const float dn = group_sum4(den) + wi * qn;
      const float inv = __builtin_amdgcn_rcpf(fmaxf(fabsf(dn), __expf(-mt)));
      const size_t row = (size_t)b * SEQ + t0 + tl;
#pragma unroll
      for (int d = 0; d < 4; ++d) {
        f32x4 ni = (f32x4){0.f, 0.f, 0.f, 0.f};
#pragma unroll
        for (int ks = 0; ks < 2; ++ks) ni = mfma16(ldfrag(Cst + (d * 16 + l15) * KLD + ks * 32 + 8 * g), qf[ks], ni);
        const f32x4 v = (num[d] + ni * wi) * inv;
        u32x2 o; o.x = pack2(v[0], v[1]); o.y = pack2(v[2], v[3]);
        *(u32x2*)(Y + row * 1024 + Y_D + h * 64 + d * 16 + 4 * g) = o;
      }
    }
    if (c + 1 < 32) { raw_load(projb, colK, t0 + 128, rK, tid); raw_load(projb, colV, t0 + 128, rV, tid); }
    lds_barrier();
    scale_rows(Ks2, wend);
    lds_barrier();
    const float fprev = __expf(blast + m_prev - m_new);
#pragma unroll
    for (int nt = 0; nt < 4; ++nt) st[nt] *= fprev;
    state_update(Vs2, Ks2, st, w, l15, g);
    {
      const int e = tid & 63, part = tid >> 6;
      float a = 0.f;
      for (int s2 = part * 32; s2 < part * 32 + 32; ++s2) a += bf2f(Ks2[s2 * KLD + e]);
      npart[part * 64 + e] = a;
    }
    lds_barrier();
    if (tid < 64) nst[tid] = nst[tid] * fprev + npart[tid] + npart[64 + tid] + npart[128 + tid] + npart[192 + tid];
    m_prev = m_new;
  }
}

constexpr int SEQ8_LDS_F = SEQ_LDS_S + 64 * KLD * 2;
constexpr int SEQ8_LDS_HALO = SEQ8_LDS_F + 8192;
constexpr int SEQ8_LDS_CW = SEQ8_LDS_HALO + 2 * 3 * 3 * 64 * 2;
struct RawRegs2 { u32x4 r[2]; };
DI void raw_load8(const u16* projb, int col0, int t0, RawRegs2& rr, int tid) {
#pragma unroll
  for (int i = 0; i < 2; ++i) rr.r[i] = *(const u32x4*)(projb + (size_t)(t0 + (tid >> 3) + 64 * i) * NP + col0 + (tid & 7) * 8);
}
DI void raw_store8(u16* dst, u16* halo_next, const RawRegs2& rr, int tid) {
#pragma unroll
  for (int i = 0; i < 2; ++i) *(u32x4*)(dst + ((tid >> 3) + 64 * i) * KLD + (tid & 7) * 8) = rr.r[i];
  if (halo_next && tid >= 488) *(u32x4*)(halo_next + ((tid >> 3) - 61) * 64 + (tid & 7) * 8) = rr.r[1];
}
DI void conv_from_lds8(const u16* raw, const u16* halo, const float* wl, const float* rowscale, float cscale, u32x4 (&out)[2], int tid) {
  const int q = tid >> 3, ch = (tid & 7) * 8;
  u32x4 v[5];
#pragma unroll
  for (int k = 0; k < 5; ++k) { const int r = 2 * q - 3 + k; v[k] = r >= 0 ? *(const u32x4*)(raw + r * KLD + ch) : *(const u32x4*)(halo + (r + 3) * 64 + ch); }
  float w[5][8];
#pragma unroll
  for (int j = 0; j < 5; ++j) { const f32x4 w0 = *(const f32x4*)(wl + j * 64 + ch), w1 = *(const f32x4*)(wl + j * 64 + ch + 4);
    w[j][0] = w0[0]; w[j][1] = w0[1]; w[j][2] = w0[2]; w[j][3] = w0[3]; w[j][4] = w1[0]; w[j][5] = w1[1]; w[j][6] = w1[2]; w[j][7] = w1[3]; }
#pragma unroll
  for (int o = 0; o < 2; ++o) {
    float acc[8];
#pragma unroll
    for (int i = 0; i < 8; ++i) acc[i] = w[4][i];
#pragma unroll
    for (int j = 0; j < 4; ++j) {
      const u32x4 x = v[o + j];
      acc[0] += w[j][0] * bflo(x.x); acc[1] += w[j][1] * bfhi(x.x); acc[2] += w[j][2] * bflo(x.y); acc[3] += w[j][3] * bfhi(x.y);
      acc[4] += w[j][4] * bflo(x.z); acc[5] += w[j][5] * bfhi(x.z); acc[6] += w[j][6] * bflo(x.w); acc[7] += w[j][7] * bfhi(x.w);
    }
    const float rs = (rowscale ? rowscale[2 * q + o] : 1.f) * cscale;
#pragma unroll
    for (int i = 0; i < 8; ++i) acc[i] = siluf(acc[i]) * rs;
    out[o].x = pack2(acc[0], acc[1]); out[o].y = pack2(acc[2], acc[3]); out[o].z = pack2(acc[4], acc[5]); out[o].w = pack2(acc[6], acc[7]);
  }
}
DI void conv_write8(u16* dst, const u32x4 (&out)[2], int tid) {
  const int q = tid >> 3, ch = (tid & 7) * 8;
#pragma unroll
  for (int o = 0; o < 2; ++o) *(u32x4*)(dst + (2 * q + o) * KLD + ch) = out[o];
}
DI void stage_conv_w8(float* wl, const float* cw, const float* cb, int chan0, int nchan, int tid) {
  if (tid < 320) { const int j = tid >> 6, cc = tid & 63; wl[tid] = j < 4 ? cw[j * nchan + chan0 + cc] : cb[chan0 + cc]; }
}
DI void scale_rows8(u16* A, const float* rs, int tid) {
  const int ch = (tid & 7) * 8;
#pragma unroll
  for (int i = 0; i < 2; ++i) {
    const int row = (tid >> 3) + 64 * i;
    const float f = rs[row];
    u32x4 v = *(u32x4*)(A + row * KLD + ch);
    v.x = pack2(bflo(v.x) * f, bfhi(v.x) * f); v.y = pack2(bflo(v.y) * f, bfhi(v.y) * f);
    v.z = pack2(bflo(v.z) * f, bfhi(v.z) * f); v.w = pack2(bflo(v.w) * f, bfhi(v.w) * f);
    *(u32x4*)(A + row * KLD + ch) = v;
  }
}
DI void state_update8(const u16* Xs, const u16* Bs, f32x4 (&acc)[2], int w8, int l15, int g) {
  const int tq = l15 >> 2, tp = l15 & 3, pt = w8 >> 1, nt0 = (w8 & 1) * 2;
#pragma unroll
  for (int kk = 0; kk < 4; ++kk) {
    const bf16x8 af = cat4(tr_read(Xs + (kk * 32 + 4 * g + tq) * KLD + pt * 16 + 4 * tp), tr_read(Xs + (kk * 32 + 16 + 4 * g + tq) * KLD + pt * 16 + 4 * tp));
#pragma unroll
    for (int n = 0; n < 2; ++n) {
      const bf16x8 bfr = cat4(tr_read(Bs + (kk * 32 + 4 * g + tq) * KLD + (nt0 + n) * 16 + 4 * tp), tr_read(Bs + (kk * 32 + 16 + 4 * g + tq) * KLD + (nt0 + n) * 16 + 4 * tp));
      acc[n] = mfma16(af, bfr, acc[n]);
    }
  }
}
DI void state_to_lds8(u16* Ss, const f32x4 (&acc)[2], int w8, int l15, int g) {
  const int pt = w8 >> 1, nt0 = (w8 & 1) * 2;
#pragma unroll
  for (int n = 0; n < 2; ++n)
#pragma unroll
    for (int r = 0; r < 4; ++r) Ss[(pt * 16 + 4 * g + r) * KLD + (nt0 + n) * 16 + l15] = f2bf(acc[n][r]);
}

constexpr int SEQ8_LDS_ZERO = SEQ8_LDS_CW + 3 * 320 * 4;
constexpr int SEQ8_LDS_RAW = ((SEQ8_LDS_ZERO + 3 * 128 + 255) / 256) * 256;
DI void raw_dma8(const u16* projb, int col0, int t0, u16* raw, int tid) {
#pragma unroll
  for (int i = 0; i < 2; ++i) {
    const int chunk = tid + 512 * i;
    __builtin_amdgcn_global_load_lds((const unsigned*)(projb + (size_t)(t0 + (chunk >> 3)) * NP + col0 + (chunk & 7) * 8), (LDSP unsigned*)((LDSP char*)raw + chunk * 16), 16, 0, 0);
  }
}
DI void conv_raw8(const u16* raw, const u16* halo, const float* wl, const float* rowscale, float cscale, u16* dst, int tid) {
  const int q = tid >> 3, ch = (tid & 7) * 8;
  u32x4 v[5];
#pragma unroll
  for (int k = 0; k < 5; ++k) { const int r = 2 * q - 3 + k; v[k] = r >= 0 ? *(const u32x4*)(raw + r * 64 + ch) : *(const u32x4*)(halo + (r + 3) * 64 + ch); }
  float w[5][8];
#pragma unroll
  for (int j = 0; j < 5; ++j) { const f32x4 w0 = *(const f32x4*)(wl + j * 64 + ch), w1 = *(const f32x4*)(wl + j * 64 + ch + 4);
    w[j][0] = w0[0]; w[j][1] = w0[1]; w[j][2] = w0[2]; w[j][3] = w0[3]; w[j][4] = w1[0]; w[j][5] = w1[1]; w[j][6] = w1[2]; w[j][7] = w1[3]; }
#pragma unroll
  for (int o = 0; o < 2; ++o) {
    float acc[8];
#pragma unroll
    for (int i = 0; i < 8; ++i) acc[i] = w[4][i];
#pragma unroll
    for (int j = 0; j < 4; ++j) {
      const u32x4 x = v[o + j];
      acc[0] += w[j][0] * bflo(x.x); acc[1] += w[j][1] * bfhi(x.x); acc[2] += w[j][2] * bflo(x.y); acc[3] += w[j][3] * bfhi(x.y);
      acc[4] += w[j][4] * bflo(x.z); acc[5] += w[j][5] * bfhi(x.z); acc[6] += w[j][6] * bflo(x.w); acc[7] += w[j][7] * bfhi(x.w);
    }
    const float rs = (rowscale ? rowscale[2 * q + o] : 1.f) * cscale;
#pragma unroll
    for (int i = 0; i < 8; ++i) acc[i] = siluf(acc[i]) * rs;
    u32x4 ov; ov.x = pack2(acc[0], acc[1]); ov.y = pack2(acc[2], acc[3]); ov.z = pack2(acc[4], acc[5]); ov.w = pack2(acc[6], acc[7]);
    *(u32x4*)(dst + (2 * q + o) * KLD + ch) = ov;
  }
}
DI void save_halo8(const u16* raw, u16* halo, int tid) {
  if (tid < 72) { const int arr = tid / 24, rem = tid % 24; *(u32x4*)(halo + arr * 192 + rem * 8) = *(const u32x4*)(raw + arr * 8192 + 125 * 64 + rem * 8); }
}

DI void ssd_task8(const Params& p, int layer, int b, int h, unsigned char* smem) {
  u16* Cs = (u16*)(smem + SEQ_LDS_A); u16* Bs = (u16*)(smem + SEQ_LDS_B); u16* Xs = (u16*)(smem + SEQ_LDS_C); u16* Ss = (u16*)(smem + SEQ_LDS_S);
  float* fl = (float*)(smem + SEQ8_LDS_F);
  float* dts = fl; float* acs = fl + 128; float* wend = fl + 256; float* tmp = fl + 384;
  u16* halo = (u16*)(smem + SEQ8_LDS_HALO); float* cwl = (float*)(smem + SEQ8_LDS_CW); u16* zero3 = (u16*)(smem + SEQ8_LDS_ZERO);
  u16* raw = (u16*)(smem + SEQ8_LDS_RAW);
  int tid = otid512(), lane = tid & 63, w = tid >> 6, l15 = lane & 15, g = lane >> 4;
  const int gi = h >> 1;
  const u16* projb = (const u16*)(p.ws + OFF_PROJ) + (size_t)b * SEQ * NP;
  const float* smb = (const float*)(p.ws + OFF_SMALL) + (size_t)b * SEQ * NSMALL;
  const float* cw = p.ssm_conv_w + layer * 4 * 512; const float* cb = p.ssm_conv_b + layer * 512;
  u16* Y = (u16*)(p.ws + OFF_H);
  const float a_h = sgprf(-__expf(p.ssm_a_log[layer * 4 + h])), d_h = sgprf(p.ssm_d[layer * 4 + h]), dtb = sgprf(p.ssm_dt_bias[layer * 4 + h]);
  const int colB = PC_XBC + 256 + gi * 64, colC = PC_XBC + 384 + gi * 64, colX = PC_XBC + h * 64;
  f32x4 st[2] = {(f32x4){0.f, 0.f, 0.f, 0.f}, (f32x4){0.f, 0.f, 0.f, 0.f}};
  lds_barrier();
  stage_conv_w8(cwl, cw, cb, 256 + gi * 64, 512, tid);
  stage_conv_w8(cwl + 320, cw, cb, 384 + gi * 64, 512, tid);
  stage_conv_w8(cwl + 640, cw, cb, h * 64, 512, tid);
  if (tid < 96) ((unsigned*)zero3)[tid] = 0u;
  raw_dma8(projb, colB, 0, raw, tid); raw_dma8(projb, colC, 0, raw + 8192, tid); raw_dma8(projb, colX, 0, raw + 16384, tid);
  float dtraw = 0.f;
  if (tid < 128) dtraw = smb[(size_t)tid * NSMALL + SM_DT + h];
#pragma unroll 1
  for (int c = 0; c < 32; ++c) {
    const int t0 = c * 128;
    asm volatile("" : "+v"(tid)); lane = tid & 63; w = tid >> 6; l15 = lane & 15; g = lane >> 4;
    float dtv = 0.f;
    if (tid < 128) { const float xr = dtraw + dtb; dtv = xr > 15.f ? xr : __logf(1.f + __expf(xr)); }
    float cs = wave_scan_add(dtv * a_h, lane);
    if (tid == 63) tmp[0] = cs;
    asm volatile("s_waitcnt vmcnt(0)" ::: "memory");
    lds_barrier();
    if (w == 1) cs += tmp[0];
    if (tid < 128) { dts[tid] = dtv; acs[tid] = cs; }
    if (c + 1 < 32 && tid < 128) dtraw = smb[(size_t)(t0 + 128 + tid) * NSMALL + SM_DT + h];
    lds_barrier();
    {
      const u16* hc = halo + (c & 1) * 576;
      const u16* hB = c == 0 ? zero3 : hc; const u16* hC = c == 0 ? zero3 : hc + 192; const u16* hX = c == 0 ? zero3 : hc + 384;
      conv_raw8(raw, hB, cwl, nullptr, 1.f, Bs, tid);
      conv_raw8(raw + 8192, hC, cwl + 320, nullptr, 1.f, Cs, tid);
      conv_raw8(raw + 16384, hX, cwl + 640, dts, 1.f, Xs, tid);
      save_halo8(raw, halo + ((c + 1) & 1) * 576, tid);
    }
    if (tid < 128) wend[tid] = __expf(acs[127] - acs[tid]);
    state_to_lds8(Ss, st, w, l15, g);
    lds_barrier();
    if (c + 1 < 32) { raw_dma8(projb, colB, t0 + 128, raw, tid); raw_dma8(projb, colC, t0 + 128, raw + 8192, tid); raw_dma8(projb, colX, t0 + 128, raw + 16384, tid); }
    {
      const int tl = 16 * w + l15;
      bf16x8 cf[2];
#pragma unroll
      for (int ks = 0; ks < 2; ++ks) cf[ks] = ldfrag(Cs + tl * KLD + ks * 32 + 8 * g);
      f32x4 y[4];
#pragma unroll
      for (int d = 0; d < 4; ++d) y[d] = (f32x4){0.f, 0.f, 0.f, 0.f};
      const float at = acs[tl];
#pragma unroll 1
      for (int stl = 0; stl < 2; ++stl) {
        if (stl * 64 <= 16 * w + 15) {
          f32x4 sc[4];
          qk_tile1<2>(Bs + stl * 64 * KLD, cf, sc, l15, g);
#pragma unroll
          for (int kt = 0; kt < 4; ++kt) {
            const f32x4 as = *(const f32x4*)(acs + stl * 64 + kt * 16 + 4 * g);
#pragma unroll
            for (int r = 0; r < 4; ++r) {
              const bool ok = stl * 64 + kt * 16 + 4 * g + r <= tl;
              sc[kt][r] = ok ? sc[kt][r] * __expf(at - as[r]) : 0.f;
            }
          }
          pv_accum1(sc, Xs + stl * 64 * KLD, y, l15, g);
        }
      }
      const float ea = __expf(at), dsk = d_h / dts[tl];
      const size_t row = (size_t)b * SEQ + t0 + tl;
#pragma unroll
      for (int d = 0; d < 4; ++d) {
        f32x4 yo = (f32x4){0.f, 0.f, 0.f, 0.f};
#pragma unroll
        for (int ks = 0; ks < 2; ++ks) yo = mfma16(ldfrag(Ss + (d * 16 + l15) * KLD + ks * 32 + 8 * g), cf[ks], yo);
        const u32x2 xv = *(const u32x2*)(Xs + tl * KLD + d * 16 + 4 * g);
        const f32x4 v = y[d] + yo * ea;
        u32x2 o; o.x = pack2(v[0] + dsk * bflo(xv.x), v[1] + dsk * bfhi(xv.x)); o.y = pack2(v[2] + dsk * bflo(xv.y), v[3] + dsk * bfhi(xv.y));
        *(u32x2*)(Y + row * 1024 + Y_C + h * 64 + d * 16 + 4 * g) = o;
      }
    }
    lds_barrier();
    scale_rows8(Xs, wend, tid);
    lds_barrier();
    const float cd = __expf(acs[127]);
    st[0] *= cd; st[1] *= cd;
    state_update8(Xs, Bs, st, w, l15, g);
  }
  asm volatile("s_waitcnt vmcnt(0)" ::: "memory");
}

DI void mlstm_task8(const Params& p, int layer, int b, int h, unsigned char* smem) {
  u16* Qs = (u16*)(smem + SEQ_LDS_A); u16* Ks2 = (u16*)(smem + SEQ_LDS_B); u16* Vs2 = (u16*)(smem + SEQ_LDS_C); u16* Cst = (u16*)(smem + SEQ_LDS_S);
  float* fl = (float*)(smem + SEQ8_LDS_F);
  float* bcs = fl; float* us = fl + 128; float* pms = fl + 256; float* wend = fl + 384; float* nst = fl + 512; float* tmp = fl + 576; float* npart = fl + 640;
  u16* halo = (u16*)(smem + SEQ8_LDS_HALO); float* cwl = (float*)(smem + SEQ8_LDS_CW); u16* zero3 = (u16*)(smem + SEQ8_LDS_ZERO);
  u16* raw = (u16*)(smem + SEQ8_LDS_RAW);
  int tid = otid512(), lane = tid & 63, w = tid >> 6, l15 = lane & 15, g = lane >> 4;
  const u16* projb = (const u16*)(p.ws + OFF_PROJ) + (size_t)b * SEQ * NP;
  const float* smb = (const float*)(p.ws + OFF_SMALL) + (size_t)b * SEQ * NSMALL;
  const float* cw = p.ml_conv_w + layer * 4 * 512; const float* cb = p.ml_conv_b + layer * 512;
  const float ib = sgprf(p.ml_if_b[layer * 8 + h]), fb = sgprf(p.ml_if_b[layer * 8 + 4 + h]);
  u16* Y = (u16*)(p.ws + OFF_H);
  const int colQ = PD_QK + h * 64, colK = PD_QK + 256 + h * 64, colV = PD_V + h * 64;
  f32x4 st[2] = {(f32x4){0.f, 0.f, 0.f, 0.f}, (f32x4){0.f, 0.f, 0.f, 0.f}};
  float m_prev = 0.f;
  lds_barrier();
  if (tid < 64) nst[tid] = 0.f;
  stage_conv_w8(cwl, cw, cb, h * 64, 512, tid);
  stage_conv_w8(cwl + 320, cw, cb, 256 + h * 64, 512, tid);
  if (tid < 96) ((unsigned*)zero3)[tid] = 0u;
  raw_dma8(projb, colQ, 0, raw, tid); raw_dma8(projb, colK, 0, raw + 8192, tid); raw_dma8(projb, colV, 0, raw + 16384, tid);
  float iraw = 0.f, fraw = 0.f;
  if (tid < 128) { iraw = smb[(size_t)tid * NSMALL + SM_IF + h]; fraw = smb[(size_t)tid * NSMALL + SM_IF + 4 + h]; }
#pragma unroll 1
  for (int c = 0; c < 32; ++c) {
    const int t0 = c * 128;
    asm volatile("" : "+v"(tid)); lane = tid & 63; w = tid >> 6; l15 = lane & 15; g = lane >> 4;
    float ip = 0.f, lf = 0.f;
    if (tid < 128) { ip = iraw + ib; const float fp = fraw + fb; lf = fminf(fp, 0.f) - __logf(1.f + __expf(-fabsf(fp))); }
    float bc = wave_scan_add(lf, lane);
    if (tid == 63) tmp[0] = bc;
    asm volatile("s_waitcnt vmcnt(0)" ::: "memory");
    lds_barrier();
    if (w == 1) bc += tmp[0];
    const float u = tid < 128 ? ip - bc : -1e30f;
    float pm = wave_scan_max(u, lane);
    if (tid == 63) tmp[1] = pm;
    if (c + 1 < 32 && tid < 128) { iraw = smb[(size_t)(t0 + 128 + tid) * NSMALL + SM_IF + h]; fraw = smb[(size_t)(t0 + 128 + tid) * NSMALL + SM_IF + 4 + h]; }
    {
      const u16* hc = halo + (c & 1) * 576;
      const u16* hQ = c == 0 ? zero3 : hc; const u16* hK = c == 0 ? zero3 : hc + 192;
      conv_raw8(raw, hQ, cwl, nullptr, 1.f, Qs, tid);
      conv_raw8(raw + 8192, hK, cwl + 320, nullptr, 0.125f, Ks2, tid);
      save_halo8(raw, halo + ((c + 1) & 1) * 576, tid);
#pragma unroll
      for (int i = 0; i < 2; ++i) { const int chunk = tid + 512 * i; *(u32x4*)(Vs2 + (chunk >> 3) * KLD + (chunk & 7) * 8) = *(const u32x4*)(raw + 16384 + chunk * 8); }
    }
    state_to_lds8(Cst, st, w, l15, g);
    lds_barrier();
    if (w == 1) pm = fmaxf(pm, tmp[1]);
    if (tid < 128) { bcs[tid] = bc; us[tid] = u; pms[tid] = pm; }
    if (c + 1 < 32) { raw_dma8(projb, colQ, t0 + 128, raw, tid); raw_dma8(projb, colK, t0 + 128, raw + 8192, tid); raw_dma8(projb, colV, t0 + 128, raw + 16384, tid); }
    lds_barrier();
    const float blast = bcs[127];
    const float m_new = blast + fmaxf(m_prev, pms[127]);
    if (tid < 128) wend[tid] = __expf(blast - m_new + us[tid]);
    {
      const int tl = 16 * w + l15;
      bf16x8 qf[2];
#pragma unroll
      for (int ks = 0; ks < 2; ++ks) qf[ks] = ldfrag(Qs + tl * KLD + ks * 32 + 8 * g);
      f32x4 num[4];
#pragma unroll
      for (int d = 0; d < 4; ++d) num[d] = (f32x4){0.f, 0.f, 0.f, 0.f};
      const float bt = bcs[tl], mt = bt + fmaxf(m_prev, pms[tl]);
      float den = 0.f;
#pragma unroll 1
      for (int stl = 0; stl < 2; ++stl) {
        if (stl * 64 <= 16 * w + 15) {
          f32x4 sc[4];
          qk_tile1<2>(Ks2 + stl * 64 * KLD, qf, sc, l15, g);
#pragma unroll
          for (int kt = 0; kt < 4; ++kt) {
            const f32x4 uu = *(const f32x4*)(us + stl * 64 + kt * 16 + 4 * g);
#pragma unroll
            for (int r = 0; r < 4; ++r) {
              const bool ok = stl * 64 + kt * 16 + 4 * g + r <= tl;
              const float v = ok ? sc[kt][r] * __expf(bt - mt + uu[r]) : 0.f;
              sc[kt][r] = v; den += v;
            }
          }
          pv_accum1(sc, Vs2 + stl * 64 * KLD, num, l15, g);
        }
      }
      const float wi = __expf(bt + m_prev - mt);
      float qn = 0.f;
#pragma unroll
      for (int ks = 0; ks < 2; ++ks)
#pragma unroll
        for (int j = 0; j < 8; ++j) qn += bf2f((u16)qf[ks][j]) * nst[ks * 32 + 8 * g + j];
      qn = group_sum4(qn);
      const float dn = group_sum4(den) + wi * qn;
      const float inv = __builtin_amdgcn_rcpf(fmaxf(fabsf(dn), __expf(-mt)));
      const size_t row = (size_t)b * SEQ + t0 + tl;
#pragma unroll
      for (int d = 0; d < 4; ++d) {
        f32x4 ni = (f32x4){0.f, 0.f, 0.f, 0.f};
#pragma unroll
        for (int ks = 0; ks < 2; ++ks) ni = mfma16(ldfrag(Cst + (d * 16 + l15) * KLD + ks * 32 + 8 * g), qf[ks], ni);
        const f32x4 v = (num[d] + ni * wi) * inv;
        u32x2 o; o.x = pack2(v[0], v[1]); o.y = pack2(v[2], v[3]);
        *(u32x2*)(Y + row * 1024 + Y_D + h * 64 + d * 16 + 4 * g) = o;
      }
    }
    lds_barrier();
    scale_rows8(Ks2, wend, tid);
    lds_barrier();
    const float fprev = __expf(blast + m_prev - m_new);
    st[0] *= fprev; st[1] *= fprev;
    state_update8(Vs2, Ks2, st, w, l15, g);
    {
      const int e = tid & 63, part = tid >> 6;
      float a = 0.f;
#pragma unroll
      for (int s2 = 0; s2 < 16; ++s2) a += bf2f(Ks2[(part * 16 + s2) * KLD + e]);
      npart[part * 64 + e] = a;
    }
    lds_barrier();
    if (tid < 64) {
      float a = nst[tid] * fprev;
#pragma unroll
      for (int pp = 0; pp < 8; ++pp) a += npart[pp * 64 + tid];
      nst[tid] = a;
    }
    m_prev = m_new;
  }
  asm volatile("s_waitcnt vmcnt(0)" ::: "memory");
}

DI void compress_task(const Params& p, int layer, int b, int kv, int rb, unsigned char* smem) {
  constexpr int HLD = 136;
  u16* Hs = (u16*)smem;
  const int tid = otid(), lane = tid & 63, w = tid >> 6, l15 = lane & 15, g = lane >> 4;
  const u16* projb = (const u16*)(p.ws + OFF_PROJ) + (size_t)b * SEQ * NP + (kv ? PA_VC : PA_KC);
  const int mi = layer * 2 + kv;
  const u16* W1T = (const u16*)(p.ws + OFF_W1T) + (size_t)mi * 128 * 2048;
  const u16* W2T = (const u16*)(p.ws + OFF_W2T) + (size_t)mi * 64 * 128;
  const float* bias1 = (const float*)(p.ws + OFF_BIAS1) + mi * 16 * 128;
  f32x4 acc[2][2];
#pragma unroll
  for (int nt = 0; nt < 2; ++nt) { acc[nt][0] = (f32x4){0.f, 0.f, 0.f, 0.f}; acc[nt][1] = (f32x4){0.f, 0.f, 0.f, 0.f}; }
  int tok[2];
#pragma unroll
  for (int mt = 0; mt < 2; ++mt) { int i = rb * 32 + mt * 16 + l15; if (i > 254) i = 254; tok[mt] = 16 * i; }
#pragma unroll 4
  for (int ks = 0; ks < 64; ++ks) {
    const int j = ks >> 1, d0 = (ks & 1) * 32;
    bf16x8 af[2], wf[2];
#pragma unroll
    for (int mt = 0; mt < 2; ++mt) af[mt] = ldfrag(projb + (size_t)(tok[mt] + j) * NP + d0 + 8 * g);
#pragma unroll
    for (int nt = 0; nt < 2; ++nt) wf[nt] = ldfrag(W1T + (size_t)(w * 32 + nt * 16 + l15) * 2048 + ks * 32 + 8 * g);
#pragma unroll
    for (int nt = 0; nt < 2; ++nt)
#pragma unroll
      for (int mt = 0; mt < 2; ++mt) acc[nt][mt] = mfma16(wf[nt], af[mt], acc[nt][mt]);
  }
  lds_barrier();
#pragma unroll
  for (int nt = 0; nt < 2; ++nt) {
    const int n = w * 32 + nt * 16 + 4 * g;
    f32x4 bb = *(const f32x4*)(bias1 + n);
#pragma unroll
    for (int pc = 1; pc < 16; ++pc) bb += *(const f32x4*)(bias1 + pc * 128 + n);
#pragma unroll
    for (int mt = 0; mt < 2; ++mt) {
      const f32x4 v = acc[nt][mt] + bb;
      u32x2 o; o.x = pack2(siluf(v[0]), siluf(v[1])); o.y = pack2(siluf(v[2]), siluf(v[3]));
      *(u32x2*)(Hs + (mt * 16 + l15) * HLD + n) = o;
    }
  }
  lds_barrier();
  f32x4 acc2[2] = {(f32x4){0.f, 0.f, 0.f, 0.f}, (f32x4){0.f, 0.f, 0.f, 0.f}};
#pragma unroll
  for (int ks = 0; ks < 4; ++ks) {
    const bf16x8 wf = ldfrag(W2T + (size_t)(w * 16 + l15) * 128 + ks * 32 + 8 * g);
#pragma unroll
    for (int mt = 0; mt < 2; ++mt) acc2[mt] = mfma16(wf, ldfrag(Hs + (mt * 16 + l15) * HLD + ks * 32 + 8 * g), acc2[mt]);
  }
  u16* dst = (u16*)(p.ws + (kv ? OFF_VCMP : OFF_KCMP) + (size_t)layer * 512 * 1024) + (size_t)b * 256 * 64;
#pragma unroll
  for (int mt = 0; mt < 2; ++mt) {
    const int i = rb * 32 + mt * 16 + l15;
    u32x2 o; o.x = pack2(acc2[mt][0], acc2[mt][1]); o.y = pack2(acc2[mt][2], acc2[mt][3]);
    if (i > 254) { o.x = 0u; o.y = 0u; }
    *(u32x2*)(dst + (size_t)i * 64 + w * 16 + 4 * g) = o;
  }
}

DI void nsa_task(const Params& p, int layer, int b, int qi, unsigned char* smem) {
  u16* Ks = (u16*)smem; u16* Vs = Ks + 64 * KLD;
  float* T = (float*)(smem + 2 * KVBUF * 2);
  unsigned long long* selm = (unsigned long long*)(smem + 2 * KVBUF * 2 + 4 * 32 * 65 * 4);
  const int tid = otid(), lane = tid & 63, h = tid >> 6, l15 = lane & 15, g = lane >> 4;
  const int q0 = qi * 32;
  const u16* projb = (const u16*)(p.ws + OFF_PROJ) + (size_t)b * SEQ * NP;
  const float* smb = (const float*)(p.ws + OFF_SMALL) + (size_t)b * SEQ * NSMALL;
  const u16* kcmp = (const u16*)(p.ws + OFF_KCMP + (size_t)layer * 512 * 1024) + (size_t)b * 256 * 64;
  const u16* vcmp = (const u16*)(p.ws + OFF_VCMP + (size_t)layer * 512 * 1024) + (size_t)b * 256 * 64;
  bf16x8 qf[2][2];
#pragma unroll
  for (int qt = 0; qt < 2; ++qt)
#pragma unroll
    for (int ks = 0; ks < 2; ++ks) qf[qt][ks] = ldfrag(projb + (size_t)(q0 + qt * 16 + l15) * NP + PA_Q + h * 64 + ks * 32 + 8 * g);
  const float sc = 0.125f * 1.4426950408889634f;
  f32x4 outacc[4][2];
  AttnAcc a;
  const int ntc = (q0 >> 10) + 1;
  attn_init(a);
  lds_barrier();
  for (int i = tid; i < 4 * 32 * 65; i += 256) T[i] = 0.f;
  kv_pipeline(0, ntc, Ks,
    [&](int) { return true; },
    [&](int j, KVRegs& kr) { kv_load(kcmp, vcmp, 64, 64, j * 64, kr); },
    [&](int j, const u16* Kt, const u16* Vt) {
      f32x4 s[4][2];
      auto valid = [&](int kt, int r, int qt) { return 16 * (j * 64 + kt * 16 + 4 * g + r) + 31 <= q0 + qt * 16 + l15; };
      qk_tile<2>(Kt, 0, qf, s, l15, g);
      softmax_pv(s, a, Vt, sc, l15, g, valid);
    });
  float cinv[2];
#pragma unroll
  for (int qt = 0; qt < 2; ++qt) {
    const float lt = group_sum4(a.l[qt]);
    cinv[qt] = lt > 0.f ? 1.f / lt : 0.f;
    const float gt = sigmoidf_(smb[(size_t)(q0 + qt * 16 + l15) * NSMALL + SM_G + h * 3 + 0]) * cinv[qt];
#pragma unroll
    for (int d = 0; d < 4; ++d) outacc[d][qt] = a.o[d][qt] * gt;
  }
  float carry[2] = {0.f, 0.f};
  kv_pipeline(0, ntc, Ks,
    [&](int) { return true; },
    [&](int j, KVRegs& kr) { kv_load(kcmp, vcmp, 64, 64, j * 64, kr); },
    [&](int j, const u16* Kt, const u16*) {
      f32x4 s[4][2];
      qk_tile<2>(Kt, 0, qf, s, l15, g);
#pragma unroll
      for (int qt = 0; qt < 2; ++qt) {
        float prev3 = carry[qt];
#pragma unroll
        for (int kt = 0; kt < 4; ++kt) {
          float pr[4];
#pragma unroll
          for (int r = 0; r < 4; ++r) {
            const bool ok = 16 * (j * 64 + kt * 16 + 4 * g + r) + 31 <= q0 + qt * 16 + l15;
            pr[r] = ok ? exp2_(s[kt][qt][r] * sc - a.m[qt]) * cinv[qt] : 0.f;
          }
          const float below = __shfl_up(pr[3], 16);
          const float wrap = __shfl(prev3, l15 + 48);
          const float nb = g > 0 ? below : wrap;
          T[(h * 32 + qt * 16 + l15) * 65 + j * 16 + kt * 4 + g] = (pr[0] + pr[1]) + (pr[2] + 0.5f * pr[3]) + 0.5f * nb;
          prev3 = pr[3];
        }
        carry[qt] = prev3;
      }
    });
  lds_barrier();
#pragma unroll 1
  for (int qq = 0; qq < 8; ++qq) {
    const int q = h * 8 + qq, t = q0 + q, cur = t >> 6;
    const float imp = ((T[(0 * 32 + q) * 65 + lane] + T[(1 * 32 + q) * 65 + lane]) + T[(2 * 32 + q) * 65 + lane]) + T[(3 * 32 + q) * 65 + lane];
    const bool forced = lane == cur || lane == 0, allowed = lane <= cur, cand = allowed && !forced;
    const int K = cur == 0 ? 15 : 14;
    unsigned long long m;
    if (__popcll(__ballot(cand)) <= K) m = __ballot(allowed);
    else {
      const unsigned key = __float_as_uint(imp);
      unsigned prefix = 0u;
#pragma unroll 1
      for (int bit = 30; bit >= 0; --bit) {
        const unsigned cnd = prefix | (1u << bit);
        if (__popcll(__ballot(cand && key >= cnd)) >= K) prefix = cnd;
      }
      const unsigned long long gt = __ballot(cand && key > prefix), eq = __ballot(cand && key == prefix);
      const int need = K - __popcll(gt);
      const int myrank = __popcll(eq & ((1ull << lane) - 1ull));
      m = gt | __ballot(cand && key == prefix && myrank < need) | __ballot(forced);
    }
    if (lane == 0) selm[q] = m;
  }
  lds_barrier();
  f32x4* park = (f32x4*)T + (h * 8) * 64 + lane;
#pragma unroll
  for (int d = 0; d < 4; ++d) { park[(d * 2 + 0) * 64] = outacc[d][0]; park[(d * 2 + 1) * 64] = outacc[d][1]; }
  unsigned long long mq[2], anym = 0ull;
#pragma unroll
  for (int qt = 0; qt < 2; ++qt) mq[qt] = selm[qt * 16 + l15];
  for (int i = 0; i < 32; ++i) anym |= selm[i];
  const int jhi = (q0 + 31) >> 6;
#pragma unroll
  for (int qt = 0; qt < 2; ++qt)
#pragma unroll
    for (int ks = 0; ks < 2; ++ks) qf[qt][ks] = scale_frag(qf[qt][ks], sc);
  attn_init_rel(a);
  kv_pipeline(0, jhi + 1, Ks,
    [&](int j) { return (bool)((anym >> j) & 1ull); },
    [&](int j, KVRegs& kr) { kv_load(projb + PA_KS, projb + PA_VS, NP, NP, j * 64, kr); },
    [&](int j, const u16* Kt, const u16* Vt) {
      f32x4 s[4][2];
      auto valid = [&](int kt, int r, int qt) { return ((mq[qt] >> j) & 1ull) && (j * 64 + kt * 16 + 4 * g + r <= q0 + qt * 16 + l15); };
      bf16x8 pf[2][2];
      qk_tile_rel<2>(Kt, 0, qf, a, s, l15, g);
      if (j * 64 + 63 <= q0) softmax_rel<2>(s, a, pf, l15, valid, (bool)((mq[0] >> j) & 1ull), (bool)((mq[1] >> j) & 1ull));
      else softmax_rel<1>(s, a, pf, l15, valid);
      pv_accum(pf, Vt, a.o, l15, g);
      rowsum_accum(pf, a, l15);
    });
#pragma unroll
  for (int qt = 0; qt < 2; ++qt) {
    const float lt = rel_rowsum(a, qt, l15);
    const float gt = sigmoidf_(smb[(size_t)(q0 + qt * 16 + l15) * NSMALL + SM_G + h * 3 + 1]) * (lt > 0.f ? 1.f / lt : 0.f);
#pragma unroll
    for (int d = 0; d < 4; ++d) park[(d * 2 + qt) * 64] += a.o[d][qt] * gt;
  }
  attn_init_rel(a);
  const int jlo = q0 >= 511 ? (q0 - 511) >> 6 : 0;
  kv_pipeline(jlo, jhi + 1, Ks,
    [&](int) { return true; },
    [&](int j, KVRegs& kr) { kv_load(projb + PA_KW, projb + PA_VW, NP, NP, j * 64, kr); },
    [&](int j, const u16* Kt, const u16* Vt) {
      f32x4 s[4][2];
      auto valid = [&](int kt, int r, int qt) { const int key = j * 64 + kt * 16 + 4 * g + r, t = q0 + qt * 16 + l15; return key <= t && key + 512 > t; };
      bf16x8 pf[2][2];
      qk_tile_rel<2>(Kt, 0, qf, a, s, l15, g);
      if (j * 64 + 63 <= q0 && j * 64 + 512 > q0 + 31) softmax_rel<0>(s, a, pf, l15, valid);
      else softmax_rel<1>(s, a, pf, l15, valid);
      pv_accum(pf, Vt, a.o, l15, g);
      rowsum_accum(pf, a, l15);
    });
  u16* Y = (u16*)(p.ws + OFF_H);
  const float* ng = p.nsa_norm_g + layer * 64;
#pragma unroll
  for (int qt = 0; qt < 2; ++qt) {
    const int t = q0 + qt * 16 + l15;
    const float lt = rel_rowsum(a, qt, l15);
    const float gt = sigmoidf_(smb[(size_t)t * NSMALL + SM_G + h * 3 + 2]) * (lt > 0.f ? 1.f / lt : 0.f);
    f32x4 v[4]; float ss = 0.f;
#pragma unroll
    for (int d = 0; d < 4; ++d) { v[d] = park[(d * 2 + qt) * 64] + a.o[d][qt] * gt; ss += v[d][0] * v[d][0] + v[d][1] * v[d][1] + v[d][2] * v[d][2] + v[d][3] * v[d][3]; }
    ss = group_sum4(ss);
    const float rn = rsqrtf(ss * (1.f / 64.f) + 1e-6f);
    const size_t row = (size_t)b * SEQ + t;
#pragma unroll
    for (int d = 0; d < 4; ++d) {
      const int dd = d * 16 + 4 * g;
      const u32x2 zz = *(const u32x2*)(projb + (size_t)t * NP + PA_Z + h * 64 + dd);
      const f32x4 gg = *(const f32x4*)(ng + dd);
      u32x2 o;
      o.x = pack2(v[d][0] * rn * gg[0] * siluf(bflo(zz.x)), v[d][1] * rn * gg[1] * siluf(bfhi(zz.x)));
      o.y = pack2(v[d][2] * rn * gg[2] * siluf(bflo(zz.y)), v[d][3] * rn * gg[3] * siluf(bfhi(zz.y)));
      *(u32x2*)(Y + row * 1024 + Y_A + h * 64 + dd) = o;
    }
  }
}

DI void zero_y_cols(const Params& p, int c0, int ncols, int gtid, int gthreads) {
  u16* Y = (u16*)(p.ws + OFF_H);
  const int per_row = ncols / 8;
  for (size_t i = gtid; i < (size_t)NTOK * per_row; i += gthreads) {
    const size_t row = i / per_row; const int ch = (int)(i % per_row);
    *(u32x4*)(Y + row * 1024 + c0 + ch * 8) = (u32x4){0u, 0u, 0u, 0u};
  }
}

DI void final_norm_rows(const Params& p, int gw, int nw, int lane) {
  const float4* gp = (const float4*)p.final_g;
  float4 gg[4];
#pragma unroll
  for (int i = 0; i < 4; ++i) gg[i] = gp[lane + 64 * i];
  for (int row0 = gw * 4; row0 < NTOK; row0 += nw * 4) {
    float4 v[4][4]; float ss[4];
#pragma unroll
    for (int j = 0; j < 4; ++j) {
      const float4* xr = (const float4*)(p.out + (size_t)(row0 + j) * D_MODEL);
#pragma unroll
      for (int i = 0; i < 4; ++i) v[j][i] = xr[lane + 64 * i];
    }
#pragma unroll
    for (int j = 0; j < 4; ++j) {
      float a = 0.f;
#pragma unroll
      for (int i = 0; i < 4; ++i) a += v[j][i].x * v[j][i].x + v[j][i].y * v[j][i].y + v[j][i].z * v[j][i].z + v[j][i].w * v[j][i].w;
      ss[j] = wave_sum(a);
    }
#pragma unroll
    for (int j = 0; j < 4; ++j) {
      float4* xr = (float4*)(p.out + (size_t)(row0 + j) * D_MODEL);
      const float r = rsqrtf(ss[j] * (1.f / D_MODEL) + 1e-6f);
#pragma unroll
      for (int i = 0; i < 4; ++i) { float4 w; w.x = v[j][i].x * r * gg[i].x; w.y = v[j][i].y * r * gg[i].y; w.z = v[j][i].z * r * gg[i].z; w.w = v[j][i].w * r * gg[i].w; xr[lane + 64 * i] = w; }
    }
  }
}

#ifndef DEBUG_CHECK
#define DEBUG_CHECK 0
#endif
#if DEBUG_CHECK
constexpr int NCHK = 12;
DI float block_sum(float v, float* red) {
  v = wave_sum(v);
  lds_barrier();
  if ((threadIdx.x & 63) == 0) red[threadIdx.x >> 6] = v;
  lds_barrier();
  return red[0] + red[1] + red[2] + red[3];
}
DI float block_max(float v, float* red) {
#pragma unroll
  for (int o = 32; o > 0; o >>= 1) v = fmaxf(v, __shfl_xor(v, o));
  lds_barrier();
  if ((threadIdx.x & 63) == 0) red[threadIdx.x >> 6] = v;
  lds_barrier();
  return fmaxf(fmaxf(red[0], red[1]), fmaxf(red[2], red[3]));
}
DI float bfr(float v) { return bf2f(f2bf(v)); }
struct Chk { float num[NCHK], den[NCHK]; };
DI void chk_add(Chk& c, int id, float got, float ref) { const float d = got - ref; c.num[id] += d * d; c.den[id] += ref * ref; }

DI void dbg_diff_attn(const Params& p, int layer, int b, int t, int h, Chk& c, int id, unsigned char* smem) {
  float* p1 = (float*)smem; float* p2 = p1 + 4096; float* red = p2 + 4096;
  const int tid = otid();
  const u16* proj = (const u16*)(p.ws + OFF_PROJ) + (size_t)b * SEQ * NP;
  const u16* q = proj + (size_t)t * NP + PB_Q + h * 64;
  const float scale = 0.17677669529663687f;
  float m1 = -1e30f, m2 = -1e30f;
  for (int s = tid; s <= t; s += 256) {
    const u16* k = proj + (size_t)s * NP + PB_K + h * 64;
    float a1 = 0.f, a2 = 0.f;
    for (int d = 0; d < 32; ++d) { a1 += bf2f(q[d]) * bf2f(k[d]); a2 += bf2f(q[32 + d]) * bf2f(k[32 + d]); }
    a1 *= scale; a2 *= scale; p1[s] = a1; p2[s] = a2; m1 = fmaxf(m1, a1); m2 = fmaxf(m2, a2);
  }
  m1 = block_max(m1, red); m2 = block_max(m2, red);
  float l1 = 0.f, l2 = 0.f;
  for (int s = tid; s <= t; s += 256) { const float e1 = __expf(p1[s] - m1), e2 = __expf(p2[s] - m2); p1[s] = e1; p2[s] = e2; l1 += e1; l2 += e2; }
  l1 = block_sum(l1, red); l2 = block_sum(l2, red);
  const float* lam = p.diff_lam + layer * 128;
  float s01 = 0.f, s23 = 0.f;
  for (int i = 0; i < 32; ++i) { s01 += lam[i] * lam[32 + i]; s23 += lam[64 + i] * lam[96 + i]; }
  const float lam_init = 0.8f - 0.6f * expf(-0.3f * (float)layer);
  const float lam_full = expf(s01) - expf(s23) + lam_init;
  lds_barrier();
  float o = 0.f;
  if (tid < 64) for (int s = 0; s <= t; ++s) o += (p1[s] / l1 - lam_full * p2[s] / l2) * bf2f(proj[(size_t)s * NP + PB_V + h * 64 + tid]);
  float ss = block_sum(tid < 64 ? o * o : 0.f, red);
  if (tid < 64) {
    const float z = bf2f(proj[(size_t)t * NP + PB_Z + h * 64 + tid]);
    const float ref = o * rsqrtf(ss / 64.f + 1e-6f) * p.diff_norm_g[layer * 64 + tid] * (1.f - lam_init) * (z / (1.f + expf(-z)));
    const float got = bf2f(((const u16*)(p.ws + OFF_H))[((size_t)b * SEQ + t) * 1024 + Y_B + h * 64 + tid]);
    const float d = got - ref;
    o = d * d; ss = ref * ref;
  } else { o = 0.f; ss = 0.f; }
  c.num[id] += block_sum(o, red); c.den[id] += block_sum(ss, red);
}

DI float dbg_conv(const u16* projb, int t, int pcol, const float* cw, const float* cb, int ch, int nch) {
  float a = cb[ch];
  for (int j = 0; j < 4; ++j) { const int tt = t - 3 + j; if (tt >= 0) a += cw[j * nch + ch] * bf2f(projb[(size_t)tt * NP + pcol]); }
  return a / (1.f + expf(-a));
}
constexpr int DBG_NS = 11, DBG_T = 300;
DI int dbg_sample_idx(int t) {
  const int TS[DBG_NS] = {0, 1, 2, 3, 64, 127, 128, 129, 255, 256, 299};
  for (int i = 0; i < DBG_NS; ++i) if (TS[i] == t) return i;
  return -1;
}
DI int dbg_sample_t(int i) { const int TS[DBG_NS] = {0, 1, 2, 3, 64, 127, 128, 129, 255, 256, 299}; return TS[i]; }
DI void dbg_ssd(const Params& p, int layer, int b, int gi, Chk& c, int id, unsigned char* smem) {
  float* ybuf = (float*)smem;
  float* red = ybuf + DBG_NS * 128;
  const int tid = threadIdx.x, pp = tid >> 2, nq = tid & 3;
  const u16* projb = (const u16*)(p.ws + OFF_PROJ) + (size_t)b * SEQ * NP;
  const float* smb = (const float*)(p.ws + OFF_SMALL) + (size_t)b * SEQ * NSMALL;
  const float* cw = p.ssm_conv_w + layer * 4 * 512; const float* cb = p.ssm_conv_b + layer * 512;
  lds_barrier();
  for (int hh = 0; hh < 2; ++hh) {
    const int h = gi * 2 + hh;
    const float a_h = -expf(p.ssm_a_log[layer * 4 + h]), d_h = p.ssm_d[layer * 4 + h], dtb = p.ssm_dt_bias[layer * 4 + h];
    float hst[16];
    for (int i = 0; i < 16; ++i) hst[i] = 0.f;
    for (int t = 0; t < DBG_T; ++t) {
      const float xr = smb[(size_t)t * NSMALL + SM_DT + h] + dtb;
      const float dt = xr > 20.f ? xr : log1pf(expf(xr));
      const float dA = expf(dt * a_h);
      const float xp = dbg_conv(projb, t, PC_XBC + h * 64 + pp, cw, cb, h * 64 + pp, 512);
      float y = 0.f;
      for (int i = 0; i < 16; ++i) {
        const int n = nq * 16 + i;
        const float Bn = dbg_conv(projb, t, PC_XBC + 256 + gi * 64 + n, cw, cb, 256 + gi * 64 + n, 512);
        const float Cn = dbg_conv(projb, t, PC_XBC + 384 + gi * 64 + n, cw, cb, 384 + gi * 64 + n, 512);
        hst[i] = dA * hst[i] + dt * xp * Bn;
        y += Cn * hst[i];
      }
      y += __shfl_xor(y, 1); y += __shfl_xor(y, 2);
      y += d_h * xp;
      const int si = dbg_sample_idx(t);
      if (si >= 0 && nq == 0) { const float z = bf2f(projb[(size_t)t * NP + PC_Z + h * 64 + pp]); ybuf[si * 128 + hh * 64 + pp] = y * (z / (1.f + expf(-z))); }
    }
  }
  lds_barrier();
  for (int si = 0; si < DBG_NS; ++si) {
    const float v = tid < 128 ? ybuf[si * 128 + tid] : 0.f;
    const float ss = block_sum(v * v, red);
    float e2 = 0.f, r2 = 0.f;
    if (tid < 128) {
      const float ref = v * rsqrtf(ss / 128.f + 1e-6f) * p.ssm_norm_g[layer * 256 + gi * 128 + tid];
      const float got = bf2f(((const u16*)(p.ws + OFF_H))[((size_t)b * SEQ + dbg_sample_t(si)) * 1024 + Y_C + gi * 128 + tid]);
      e2 = (got - ref) * (got - ref); r2 = ref * ref;
    }
    c.num[id] += block_sum(e2, red); c.den[id] += block_sum(r2, red);
  }
}
DI void dbg_mlstm(const Params& p, int layer, int b, int h, Chk& c, int id, unsigned char* smem) {
  float* ybuf = (float*)smem;
  float* red = ybuf + DBG_NS * 128;
  const int tid = threadIdx.x, dd = tid >> 2, eq = tid & 3;
  const u16* projb = (const u16*)(p.ws + OFF_PROJ) + (size_t)b * SEQ * NP;
  const float* smb = (const float*)(p.ws + OFF_SMALL) + (size_t)b * SEQ * NSMALL;
  const float* cw = p.ml_conv_w + layer * 4 * 512; const float* cb = p.ml_conv_b + layer * 512;
  const float ib = p.ml_if_b[layer * 8 + h], fb = p.ml_if_b[layer * 8 + 4 + h];
  lds_barrier();
  float Cst[16], nst[16];
  for (int i = 0; i < 16; ++i) { Cst[i] = 0.f; nst[i] = 0.f; }
  float m = 0.f;
  for (int t = 0; t < DBG_T; ++t) {
    const float ip = smb[(size_t)t * NSMALL + SM_IF + h] + ib, fp = smb[(size_t)t * NSMALL + SM_IF + 4 + h] + fb;
    const float lf = fminf(fp, 0.f) - log1pf(expf(-fabsf(fp)));
    const float mn = fmaxf(lf + m, ip), fs = expf(lf + m - mn), is = expf(ip - mn);
    const float vd = bf2f(projb[(size_t)t * NP + PD_V + h * 64 + dd]);
    float num = 0.f, den = 0.f;
    for (int i = 0; i < 16; ++i) {
      const int e = eq * 16 + i;
      const float qe = dbg_conv(projb, t, PD_QK + h * 64 + e, cw, cb, h * 64 + e, 512);
      const float ke = 0.125f * dbg_conv(projb, t, PD_QK + 256 + h * 64 + e, cw, cb, 256 + h * 64 + e, 512);
      Cst[i] = fs * Cst[i] + is * vd * ke; nst[i] = fs * nst[i] + is * ke;
      num += Cst[i] * qe; den += nst[i] * qe;
    }
    num += __shfl_xor(num, 1); num += __shfl_xor(num, 2); den += __shfl_xor(den, 1); den += __shfl_xor(den, 2);
    const float hv = num / fmaxf(fabsf(den), expf(-mn));
    m = mn;
    const int si = dbg_sample_idx(t);
    if (si >= 0 && eq == 0) { const float o = bf2f(projb[(size_t)t * NP + PD_O + h * 64 + dd]); ybuf[si * 64 + dd] = hv / (1.f + expf(-o)); }
  }
  lds_barrier();
  for (int si = 0; si < DBG_NS; ++si) {
    const float v = tid < 64 ? ybuf[si * 64 + tid] : 0.f;
    const float ss = block_sum(v * v, red);
    float e2 = 0.f, r2 = 0.f;
    if (tid < 64) {
      const int t = dbg_sample_t(si);
      const float z = bf2f(projb[(size_t)t * NP + PD_Z + h * 64 + tid]);
      const float ref = v * rsqrtf(ss / 64.f + 1e-6f) * p.ml_norm_g[layer * 64 + tid] * (z / (1.f + expf(-z)));
      const float got = bf2f(((const u16*)(p.ws + OFF_H))[((size_t)b * SEQ + t) * 1024 + Y_D + h * 64 + tid]);
      e2 = (got - ref) * (got - ref); r2 = ref * ref;
    }
    c.num[id] += block_sum(e2, red); c.den[id] += block_sum(r2, red);
  }
}

DI void debug_checks(const Params& p, unsigned char* smem) {
  const int tid = otid();
  float* red = (float*)(smem + 36 * 1024);
  Chk c;
  for (int i = 0; i < NCHK; ++i) { c.num[i] = 0.f; c.den[i] = 0.f; }
  const float* adap = (const float*)(p.ws + OFF_ADAP);
  const u16* H = (const u16*)(p.ws + OFF_H);
  const u16* proj = (const u16*)(p.ws + OFF_PROJ);
  const float* sm = (const float*)(p.ws + OFF_SMALL);
#if DEBUG_CHECK == 1
  {
    const int bs[2] = {0, 5}; const int ns[4] = {3, 1024 + 77, 2048 + 500, 3071};
    for (int bi = 0; bi < 2; ++bi) for (int ni = 0; ni < 4; ++ni) {
      const int b = bs[bi], n = ns[ni];
      float a = 0.f;
      for (int k = tid; k < 1024; k += 256) { const float v = p.c[b * 1024 + k]; a += (v / (1.f + expf(-v))) * p.ada_w[(size_t)k * 3072 + n]; }
      const float ref = block_sum(a, red) + p.ada_b[n];
      float got = 0.f; for (int kc = 0; kc < 8; ++kc) got += adap[(((size_t)kc * 2 + 0) * 8 + b) * 3072 + n];
      chk_add(c, 1, got, ref);
    }
  }
  {
    const int ms[3] = {1, 9000, 32767};
    const int ns[14] = {0, 300, 700, 900, 1500, 2000, 2300, 2693, 3300, 3500, 3967, 3970, 3981, 3990};
    for (int mi = 0; mi < 3; ++mi) {
      const int m = ms[mi], b = m >> 12;
      float ss = 0.f;
      for (int k = tid; k < 1024; k += 256) { const float v = p.x[(size_t)m * 1024 + k]; ss += v * v; }
      ss = block_sum(ss, red);
      const float rstd = rsqrtf(ss / 1024.f + 1e-6f);
      for (int ni = 0; ni < 14; ++ni) {
        const int n = ns[ni], col = colmap(n);
        float a = 0.f, herr = 0.f, href = 0.f;
        for (int k = tid; k < 1024; k += 256) {
          float shf = 0.f, scl = 0.f;
          for (int kc = 0; kc < 8; ++kc) { const float* ap = adap + (((size_t)kc * 2 + 0) * 8 + b) * 3072; shf += ap[k]; scl += ap[1024 + k]; }
          const float hv = p.x[(size_t)m * 1024 + k] * rstd * p.norm_g[k] * (1.f + scl) + shf;
          const float hg = bf2f(H[(size_t)m * 1024 + k]);
          herr += (hg - hv) * (hg - hv); href += hv * hv;
          a += hv * p.w_in[(size_t)k * D_IN + col];
        }
        const float ref = block_sum(a, red);
        herr = block_sum(herr, red); href = block_sum(href, red);
        if (ni == 0 && DEBUG_STAGE == 1) { c.num[3] += herr; c.den[3] += href; }
        const float got = n < NP ? bf2f(proj[(size_t)m * NP + n]) : sm[(size_t)m * NSMALL + (n - NP)];
        chk_add(c, 2, got, ref);
      }
    }
  }
#endif
#if DEBUG_CHECK == 2
  dbg_diff_attn(p, 0, 0, 5, 0, c, 4, smem);
  dbg_diff_attn(p, 0, 1, 200, 3, c, 4, smem);
  dbg_diff_attn(p, 0, 3, 1500, 2, c, 4, smem);
  dbg_diff_attn(p, 0, 7, 4095, 1, c, 4, smem);
  {
    const int ms[3] = {2, 12345, 32766}; const int ns[3] = {0, 513, 1023};
    const u16* Y = (const u16*)(p.ws + OFF_H);
    for (int mi = 0; mi < 3; ++mi) for (int ni = 0; ni < 3; ++ni) {
      const int m = ms[mi], n = ns[ni], b = m >> 12;
      float a = 0.f;
      for (int k = tid; k < 1024; k += 256) a += bf2f(Y[(size_t)m * 1024 + k]) * p.w_out[(size_t)k * 1024 + n];
      a = block_sum(a, red);
      float gate = 0.f; for (int kc = 0; kc < 8; ++kc) gate += adap[(((size_t)kc * 2 + 0) * 8 + b) * 3072 + 2048 + n];
      chk_add(c, 5, p.out[(size_t)m * 1024 + n] - p.x[(size_t)m * 1024 + n], gate * a);
    }
  }
#endif
#if DEBUG_CHECK == 3
  dbg_ssd(p, 0, 0, 0, c, 6, smem);
  dbg_ssd(p, 0, 5, 1, c, 6, smem);
  dbg_mlstm(p, 0, 0, 0, c, 7, smem);
  dbg_mlstm(p, 0, 6, 3, c, 7, smem);
#endif
  lds_barrier();
  if (tid == 0) {
    int wid_ = 0, wcls = 99;
    for (int i = 1; i < NCHK; ++i) if (c.den[i] > 0.f) {
      const float rel = sqrtf(c.num[i] / c.den[i]);
      int cls = rel >= 1.f ? 0 : (int)floorf(-log10f(fmaxf(rel, 1e-9f)));
      if (cls > 9) cls = 9;
      if (!(rel == rel)) cls = 0;
      if (cls < wcls) { wcls = cls; wid_ = i; }
    }
    p.out[0] = 1e5f * ((float)wid_ + 0.1f * (float)wcls);
  }
}
#endif

#define XB_TMO      128
#define XB_XCNT(j)  (256  + 64 * (j))
#define XB_XSUB(j)  (1280 + 64 * (j))
#define XB_XGEN(j)  (2304 + 64 * (j))
#define XB_TOP      3328
#define XB_TOPGEN   3392
#define XCD_BAR_WORDS 3456
#define XB_SPIN_CAP (1u << 23)
DI unsigned xb_ld(unsigned* p)              { return __hip_atomic_load(p, __ATOMIC_RELAXED, __HIP_MEMORY_SCOPE_AGENT); }
DI unsigned xb_add(unsigned* p, unsigned v) { return __hip_atomic_fetch_add(p, v, __ATOMIC_RELAXED, __HIP_MEMORY_SCOPE_AGENT); }
DI unsigned xb_xcc_id() { return (unsigned)__builtin_amdgcn_s_getreg((3 << 11) | 20) & 0xFu; }
#define XB_SPIN(cond, bar) do { unsigned _sp = 0; while (cond) { __builtin_amdgcn_s_sleep(1); \
    if ((++_sp & 255u) == 0u) { if (xb_ld(&(bar)[XB_TMO])) break; if (_sp > XB_SPIN_CAP) { atomicAdd(&(bar)[XB_TMO], 1u); break; } } } } while (0)
struct XcdBarrier { unsigned* bar; unsigned x; volatile LDSP unsigned* st; };
DI XcdBarrier xcd_barrier_post(unsigned* bar, volatile LDSP unsigned* st) {
  XcdBarrier b; b.bar = bar; b.x = xb_xcc_id(); b.st = st;
  if (threadIdx.x == 0) (void)xb_add(&bar[XB_XCNT(b.x)], 1u);
  return b;
}
DI void xcd_barrier_complete(unsigned* bar, unsigned x, unsigned& nloc, unsigned& nx) {
  const unsigned G = gridDim.x * gridDim.y * gridDim.z;
  unsigned sum, cnt, mine, sp = 0u;
  for (;;) {
    sum = 0u; cnt = 0u; mine = 0u;
#pragma unroll
    for (unsigned j = 0; j < 16; ++j) { const unsigned c = xb_ld(&bar[XB_XCNT(j)]); sum += c; cnt += (c > 0u) ? 1u : 0u; mine = (j == x) ? c : mine; }
    if (sum == G) break;
    __builtin_amdgcn_s_sleep(1);
    if ((++sp & 255u) == 0u) { if (xb_ld(&bar[XB_TMO])) break; if (sp > XB_SPIN_CAP) { atomicAdd(&bar[XB_TMO], 1u); break; } }
  }
  nloc = mine > 0u ? mine : 1u; nx = cnt > 0u ? cnt : 1u;
}
DI void xcd_barrier(const XcdBarrier& b) {
  asm volatile("s_waitcnt vmcnt(0)" ::: "memory");
  __syncthreads();
  if (threadIdx.x == 0) {
    unsigned* bar = b.bar;
    __builtin_amdgcn_s_waitcnt(0);
    unsigned nloc = b.st[0], nx = b.st[1];
    if (nloc == 0u) { xcd_barrier_complete(bar, b.x, nloc, nx); b.st[0] = nloc; b.st[1] = nx; }
    const unsigned old = xb_add(&bar[XB_XSUB(b.x)], 1u);
    const unsigned gen = old / nloc;
    if (old + 1u == (gen + 1u) * nloc) {
      __builtin_amdgcn_fence(__ATOMIC_RELEASE, "agent");
      asm volatile("s_waitcnt vmcnt(0)" ::: "memory");
      const unsigned og = xb_add(&bar[XB_TOP], 1u);
      const unsigned tg = og / nx;
      if (og + 1u == (tg + 1u) * nx) xb_add(&bar[XB_TOPGEN], 1u);
      else XB_SPIN(xb_ld(&bar[XB_TOPGEN]) == tg, bar);
      __builtin_amdgcn_fence(__ATOMIC_ACQUIRE, "agent");
      xb_add(&bar[XB_XGEN(b.x)], 1u);
      asm volatile("s_waitcnt vmcnt(0)" ::: "memory");
    } else {
      XB_SPIN(xb_ld(&bar[XB_XGEN(b.x)]) == gen, bar);
      __builtin_amdgcn_fence(__ATOMIC_ACQUIRE, "agent");
      asm volatile("s_waitcnt vmcnt(0)" ::: "memory");
    }
  }
  __syncthreads();
}

constexpr int HALF_LDS = 76 * 1024;
constexpr int SMEM_BYTES = 2 * HALF_LDS;
__global__ void __launch_bounds__(512, 2) fwd_megakernel(Params p) {
  cg::grid_group grid = cg::this_grid();
  __shared__ __attribute__((aligned(16))) unsigned char smem[SMEM_BYTES];
  const int half = __builtin_amdgcn_readfirstlane(threadIdx.x >> 8);
  unsigned char* hsm = smem + half * HALF_LDS;
  const int G = gridDim.x, bid = blockIdx.x;
  const int slot = bid * 2 + half, NS = 2 * G;
  volatile LDSP unsigned* xst = (volatile LDSP unsigned*)(LDSP unsigned char*)(smem + SMEM_BYTES - 32);
  if (threadIdx.x == 0) { xst[0] = 0u; xst[1] = 0u; }
  __syncthreads();
  const XcdBarrier xb = xcd_barrier_post((unsigned*)(p.ws + OFF_BAR), xst);
  for (int t = slot; t < ((T0_TOTAL + NS - 1) / NS) * NS; t += NS) phase0_task(p, t < T0_TOTAL ? t : T0_TOTAL - 1, hsm);
  grid.sync();
  for (int layer = 0; layer < 2; ++layer) {
    Params q = p;
    { size_t zoff = 0; asm volatile("" : "+s"(zoff)); q.ws = p.ws + zoff; }
    const float* xin = layer == 0 ? q.x : q.out;
    for (int t = slot; t < ((NTOK / 64 + NS - 1) / NS) * NS; t += NS) phase1_task(q, layer, xin, t < NTOK / 64 ? t : NTOK / 64 - 1, hsm);
    xcd_barrier(xb);
    for (int t = bid; t < (NTOK / 256) * (NPAD / 256); t += G) gemm_inproj_tile(q, layer, t, smem);
    xcd_barrier(xb);
#if DEBUG_CHECK == 1
    if (bid == 0 && half == 0) debug_checks(q, smem);
    return;
#endif
    {
      unsigned* cnt = (unsigned*)(q.ws + OFF_CNT);
      int* s_pair = (int*)(smem + SMEM_BYTES - 16);
      if (bid < 32) ssd_task8(q, layer, bid >> 2, bid & 3, smem);
      else if (bid < 64) mlstm_task8(q, layer, (bid - 32) >> 2, (bid - 32) & 3, smem);
      if (bid < 64) {
        asm volatile("s_waitcnt vmcnt(0)" ::: "memory");
        lds_barrier();
        if (otid512() == 0) {
          __builtin_amdgcn_fence(__ATOMIC_RELEASE, "agent");
          asm volatile("s_waitcnt vmcnt(0)" ::: "memory");
          __hip_atomic_fetch_add(cnt + 4 + layer, 1u, __ATOMIC_RELAXED, __HIP_MEMORY_SCOPE_AGENT);
        }
      }
      constexpr int NPAIR_C = 64, NPAIR_D = 512, NPAIR_N = 512, NPAIR_F = NTOK / 128, NPAIR = NPAIR_C + NPAIR_D + NPAIR_N + NPAIR_F;
      for (;;) {
        const int t512 = otid512();
        lds_barrier();
        if (t512 == 0) *s_pair = (int)atomicAdd(cnt + layer, 1u);
        lds_barrier();
        const int pair = *s_pair;
        if (pair >= NPAIR) break;
        if (pair < NPAIR_C) {
          const int v = pair * 2 + half;
          compress_task(q, layer, v >> 4, (v >> 3) & 1, v & 7, hsm);
          asm volatile("s_waitcnt vmcnt(0)" ::: "memory");
          lds_barrier();
          if (t512 == 0) {
            __builtin_amdgcn_fence(__ATOMIC_RELEASE, "agent");
            asm volatile("s_waitcnt vmcnt(0)" ::: "memory");
            __hip_atomic_fetch_add(cnt + 2 + layer, 1u, __ATOMIC_RELAXED, __HIP_MEMORY_SCOPE_AGENT);
          }
        } else if (pair < NPAIR_C + NPAIR_D) {
          const int u = (pair - NPAIR_C) * 2 + half, qb = 31 - (u >> 5), bh = u & 31;
          diff_attn_task(q, layer, bh >> 2, bh & 3, qb, hsm, half != 0);
        } else if (pair >= NPAIR_C + NPAIR_D + NPAIR_N) {
          if (t512 == 0) {
            while (__hip_atomic_load(cnt + 4 + layer, __ATOMIC_RELAXED, __HIP_MEMORY_SCOPE_AGENT) < 64u) __builtin_amdgcn_s_sleep(16);
            __builtin_amdgcn_fence(__ATOMIC_ACQUIRE, "agent");
            asm volatile("s_waitcnt vmcnt(0)" ::: "memory");
          }
          lds_barrier();
          seq_fix_rows(q, layer, ((pair - NPAIR_C - NPAIR_D - NPAIR_N) * 2 + half) * 64, 64);
        } else {
          if (t512 == 0) {
            while (__hip_atomic_load(cnt + 2 + layer, __ATOMIC_RELAXED, __HIP_MEMORY_SCOPE_AGENT) < (unsigned)NPAIR_C) __builtin_amdgcn_s_sleep(16);
            __builtin_amdgcn_fence(__ATOMIC_ACQUIRE, "agent");
            asm volatile("s_waitcnt vmcnt(0)" ::: "memory");
          }
          lds_barrier();
          const int u = (pair - NPAIR_C - NPAIR_D) * 2 + half;
          nsa_task(q, layer, u & 7, 127 - (u >> 3), hsm);
        }
      }
    }
    xcd_barrier(xb);
    for (int t = bid; t < (NTOK / 256) * 4; t += G) gemm_outproj_tile(q, layer, xin, q.out, t, smem);
    xcd_barrier(xb);
#if DEBUG_CHECK >= 2
    if (bid == 0 && half == 0) debug_checks(q, smem);
    return;
#endif
  }
  { const int t5 = otid512(); final_norm_rows(p, bid * 8 + (t5 >> 6), G * 8, t5 & 63); }
}

extern "C" void kernel_launch(void* const* d_in, const int* in_sizes, int n_in, void* d_out, int out_size, void* d_ws, size_t ws_size,
                              hipStream_t stream) {
  static int grid_blocks = 0;
  if (!grid_blocks) {
    int dev = 0, cus = 0, per_cu = 0;
    (void)hipGetDevice(&dev);
    (void)hipDeviceGetAttribute(&cus, hipDeviceAttributeMultiprocessorCount, dev);
    (void)hipOccupancyMaxActiveBlocksPerMultiprocessor(&per_cu, fwd_megakernel, 512, 0);
    if (per_cu > 1) per_cu = 1;
    if (per_cu < 1) per_cu = 1;
    grid_blocks = cus * per_cu;
  }
  if (grid_blocks < 64 || (grid_blocks & 3)) { fprintf(stderr, "grid too small: %d\n", grid_blocks); return; }
  if (ws_size < WS_NEEDED) { fprintf(stderr, "workspace too small: %zu < %zu\n", ws_size, WS_NEEDED); return; }
  Params p{};
  const float** pp = (const float**)&p;
  for (int i = 0; i < 26; ++i) pp[i] = (const float*)d_in[i];
  p.out = (float*)d_out; p.ws = (unsigned char*)d_ws;
  (void)hipMemsetAsync((unsigned char*)d_ws + OFF_CNT, 0, 64 * 1024 + XCD_BAR_WORDS * 4, stream);
  void* args[] = {&p};
  hipError_t e = hipLaunchCooperativeKernel((void*)fwd_megakernel, dim3(grid_blocks), dim3(512), args, 0, stream);
  if (e != hipSuccess) fprintf(stderr, "cooperative launch failed: %s (grid %d)\n", hipGetErrorString(e), grid_blocks);
}
```

```cpp
#include <hip/hip_runtime.h>
#include <hip/hip_cooperative_groups.h>
#include <cstdio>
#include <cstdint>
#define DEBUG_CHECK 0
#define DEBUG_STAGE 1
#define REP_P1 1
#define REP_P2 1
#define REP_SEQ 1
#define REP_DIFF 1
#define REP_NSA 1
#define REP_P4 1
#define REP_P0 1
namespace cg = cooperative_groups;

typedef unsigned short u16;
typedef short bf16x8 __attribute__((ext_vector_type(8)));
typedef short s16x4 __attribute__((ext_vector_type(4)));
typedef float f32x4 __attribute__((ext_vector_type(4)));
typedef float f32x2 __attribute__((ext_vector_type(2)));
typedef unsigned u32x4 __attribute__((ext_vector_type(4)));
typedef unsigned u32x2 __attribute__((ext_vector_type(2)));
typedef __bf16 bf16x2_t __attribute__((ext_vector_type(2)));
#define DI __device__ __forceinline__
#define LDSP __attribute__((address_space(3)))

constexpr int D_MODEL = 1024, BATCH = 8, SEQ = 4096, NTOK = BATCH * SEQ;
constexpr int D_IN = 3992;
constexpr int NP = 3968, NPAD = 4096, NSMALL = 32;
constexpr int PA_Q = 0, PA_KC = 256, PA_VC = 320, PA_KS = 384, PA_VS = 448, PA_KW = 512, PA_VW = 576, PA_Z = 640;
constexpr int PB_Q = 896, PB_K = 1152, PB_V = 1408, PB_Z = 1664;
constexpr int PC_Z = 1920, PC_XBC = 2176;
constexpr int PD_QK = 2688, PD_V = 3200, PD_O = 3456, PD_Z = 3712;
constexpr int SM_G = 0, SM_DT = 12, SM_IF = 16;
constexpr int Y_A = 0, Y_B = 256, Y_C = 512, Y_D = 768;

constexpr size_t MiB = 1024 * 1024;
constexpr size_t OFF_WINT = 0;
constexpr size_t OFF_WOUTT = 16 * MiB;
constexpr size_t OFF_W1T = 20 * MiB;
constexpr size_t OFF_W2T = 22 * MiB;
constexpr size_t OFF_BIAS1 = 22 * MiB + 64 * 1024;
constexpr size_t OFF_ADAP = 22 * MiB + 128 * 1024;
constexpr size_t OFF_KCMP = 24 * MiB;
constexpr size_t OFF_VCMP = 24 * MiB + 256 * 1024;
constexpr size_t OFF_BAR = 29 * MiB + 64 * 1024;
constexpr size_t OFF_CNT = 29 * MiB;
constexpr size_t OFF_SMALL = 25 * MiB;
constexpr size_t OFF_SSQ = 29 * MiB;
constexpr size_t OFF_H = 32 * MiB;
constexpr size_t OFF_PROJ = 96 * MiB;
constexpr size_t OFF_X1B = 352 * MiB;
constexpr size_t WS_NEEDED = OFF_X1B + (size_t)NTOK * 1024 * 2;

struct Params {
  const float* x; const float* c; const float* norm_g; const float* ada_w; const float* ada_b;
  const float* w_in; const float* w_out;
  const float* nsa_cmp_pos; const float* nsa_ck_w1; const float* nsa_ck_w2; const float* nsa_cv_w1; const float* nsa_cv_w2; const float* nsa_norm_g;
  const float* diff_lam; const float* diff_norm_g;
  const float* ssm_conv_w; const float* ssm_conv_b; const float* ssm_dt_bias; const float* ssm_a_log; const float* ssm_d; const float* ssm_norm_g;
  const float* ml_conv_w; const float* ml_conv_b; const float* ml_if_b; const float* ml_norm_g; const float* final_g;
  float* out; unsigned char* ws;
};

DI void lds_barrier() { asm volatile("s_waitcnt lgkmcnt(0)" ::: "memory"); __builtin_amdgcn_s_barrier(); asm volatile("" ::: "memory"); }
DI int otid() { int t = threadIdx.x & 255; asm volatile("" : "+v"(t)); return t; }
DI int otid512() { int t = threadIdx.x; asm volatile("" : "+v"(t)); return t; }
DI unsigned pack2(float a, float b) { f32x2 v = {a, b}; bf16x2_t r = __builtin_convertvector(v, bf16x2_t); return __builtin_bit_cast(unsigned, r); }
DI u16 f2bf(float a) { return (u16)(pack2(a, 0.f) & 0xffffu); }
DI float bf2f(u16 h) { return __uint_as_float(((unsigned)h) << 16); }
DI float bflo(unsigned u) { return __uint_as_float(u << 16); }
DI float bfhi(unsigned u) { return __uint_as_float(u & 0xffff0000u); }
DI f32x4 mfma16(bf16x8 a, bf16x8 b, f32x4 c) { return __builtin_amdgcn_mfma_f32_16x16x32_bf16(a, b, c, 0, 0, 0); }
DI float wave_sum(float v) {
#pragma unroll
  for (int o = 32; o > 0; o >>= 1) v += __shfl_xor(v, o);
  return v;
}
DI float siluf(float v) { return v * __builtin_amdgcn_rcpf(1.f + __expf(-v)); }
DI float sigmoidf_(float v) { return __builtin_amdgcn_rcpf(1.f + __expf(-v)); }
DI float exp2_(float v) { return __builtin_amdgcn_exp2f(v); }
DI float sgprf(float v) { return __int_as_float(__builtin_amdgcn_readfirstlane(__float_as_int(v))); }
DI s16x4 tr_read(const u16* p) { return __builtin_amdgcn_ds_read_tr16_b64_v4i16((LDSP s16x4*)p); }
DI bf16x8 cat4(s16x4 a, s16x4 b) { bf16x8 r; r[0] = a[0]; r[1] = a[1]; r[2] = a[2]; r[3] = a[3]; r[4] = b[0]; r[5] = b[1]; r[6] = b[2]; r[7] = b[3]; return r; }
DI bf16x8 ldfrag(const u16* p) { return *(const bf16x8*)p; }

DI int colmap(int n) {
  if (n < 640) return n;
  if (n < 896) return 652 + (n - 640);
  if (n < 1920) return 908 + (n - 896);
  if (n < 2688) return 1932 + (n - 1920);
  if (n < 3456) return 2704 + (n - 2688);
  if (n < 3968) return 3480 + (n - 3456);
  if (n < 3980) return 640 + (n - 3968);
  if (n < 3984) return 2700 + (n - 3980);
  if (n < 3992) return 3472 + (n - 3984);
  return -1;
}

DI void tconv_tile(const float* __restrict__ src, int ldsrc, int k0, int n0, u16* __restrict__ dst, int ldd, bool use_map, unsigned char* smem) {
  float* tile = (float*)smem;
  const int tid = otid();
  lds_barrier();
  {
    const int nn = tid & 63; int col = n0 + nn; if (use_map) col = colmap(col);
#pragma unroll
    for (int i = 0; i < 16; ++i) { const int kk = i * 4 + (tid >> 6); tile[kk * 65 + nn] = col >= 0 ? src[(size_t)(k0 + kk) * ldsrc + col] : 0.f; }
  }
  lds_barrier();
#pragma unroll
  for (int i = 0; i < 2; ++i) {
    const int item = tid + 256 * i, nn = item >> 3, kc = item & 7;
    u32x4 w;
    w.x = pack2(tile[(kc * 8 + 0) * 65 + nn], tile[(kc * 8 + 1) * 65 + nn]);
    w.y = pack2(tile[(kc * 8 + 2) * 65 + nn], tile[(kc * 8 + 3) * 65 + nn]);
    w.z = pack2(tile[(kc * 8 + 4) * 65 + nn], tile[(kc * 8 + 5) * 65 + nn]);
    w.w = pack2(tile[(kc * 8 + 6) * 65 + nn], tile[(kc * 8 + 7) * 65 + nn]);
    *(u32x4*)(dst + (size_t)(n0 + nn) * ldd + k0 + kc * 8) = w;
  }
}

constexpr int T0_WIN = 2 * 16 * 64, T0_WOUT = 2 * 16 * 16, T0_W1 = 4 * 32 * 2, T0_W2 = 4 * 2, T0_ADA = 2 * 12 * 8, T0_B1 = 64;
constexpr int T0_TOTAL = T0_WIN + T0_WOUT + T0_W1 + T0_W2 + T0_ADA + T0_B1;

DI void phase0_task(const Params& p, int t, unsigned char* smem) {
  const int tid = otid();
  if (t < T0_WIN) {
    const int l = t / 1024, r = t % 1024, kt = r / 64, nt = r % 64;
    tconv_tile(p.w_in + (size_t)l * D_MODEL * D_IN, D_IN, kt * 64, nt * 64, (u16*)(p.ws + OFF_WINT) + (size_t)l * NPAD * 1024, 1024, true, smem);
    return;
  }
  t -= T0_WIN;
  if (t < T0_WOUT) {
    const int l = t / 256, r = t % 256, kt = r / 16, nt = r % 16;
    tconv_tile(p.w_out + (size_t)l * 1024 * 1024, 1024, kt * 64, nt * 64, (u16*)(p.ws + OFF_WOUTT) + (size_t)l * 1024 * 1024, 1024, false, smem);
    return;
  }
  t -= T0_WOUT;
  if (t < T0_W1) {
    const int m = t / 64, r = t % 64, kt = r / 2, nt = r % 2, l = m >> 1, kv = m & 1;
    const float* src = (kv ? p.nsa_cv_w1 : p.nsa_ck_w1) + (size_t)l * 2048 * 128;
    tconv_tile(src, 128, kt * 64, nt * 64, (u16*)(p.ws + OFF_W1T) + (size_t)m * 128 * 2048, 2048, false, smem);
    return;
  }
  t -= T0_W1;
  if (t < T0_W2) {
    const int m = t / 2, kt = t % 2, l = m >> 1, kv = m & 1;
    const float* src = (kv ? p.nsa_cv_w2 : p.nsa_ck_w2) + (size_t)l * 128 * 64;
    tconv_tile(src, 64, kt * 64, 0, (u16*)(p.ws + OFF_W2T) + (size_t)m * 64 * 128, 128, false, smem);
    return;
  }
  t -= T0_W2;
  if (t < T0_ADA) {
    const int l = t / 96, r = t % 96, nc = r / 8, kc = r % 8;
    float* cact = (float*)smem;
    lds_barrier();
    for (int i = tid; i < 1024; i += 256) { const int b = i >> 7, kk = i & 127; const float v = p.c[b * 1024 + kc * 128 + kk]; cact[i] = siluf(v); }
    lds_barrier();
    const int n = nc * 256 + tid;
    float acc[8];
#pragma unroll
    for (int b = 0; b < 8; ++b) acc[b] = 0.f;
    const float* w = p.ada_w + ((size_t)l * 1024 + kc * 128) * 3072 + n;
#pragma unroll 16
    for (int kk = 0; kk < 128; ++kk) {
      const float wv = w[(size_t)kk * 3072];
#pragma unroll
      for (int b = 0; b < 8; ++b) acc[b] += cact[b * 128 + kk] * wv;
    }
    float* adap = (float*)(p.ws + OFF_ADAP);
    const float bias = kc == 0 ? p.ada_b[l * 3072 + n] : 0.f;
#pragma unroll
    for (int b = 0; b < 8; ++b) adap[(((size_t)kc * 2 + l) * 8 + b) * 3072 + n] = acc[b] + bias;
    return;
  }
  t -= T0_ADA;
  {
    const int m = t >> 4, kc = t & 15, l = m >> 1, kv = m & 1;
    const float* w1 = (kv ? p.nsa_cv_w1 : p.nsa_ck_w1) + (size_t)l * 2048 * 128;
    const float* pos = p.nsa_cmp_pos + (size_t)l * 2048;
    const int n = tid & 127, half = tid >> 7;
    float acc = 0.f;
    const int k0 = kc * 128 + half * 64;
#pragma unroll 16
    for (int k = 0; k < 64; ++k) acc += pos[k0 + k] * w1[(size_t)(k0 + k) * 128 + n];
    float* red = (float*)smem;
    lds_barrier();
    red[tid] = acc;
    lds_barrier();
    if (tid < 128) ((float*)(p.ws + OFF_BIAS1))[(m * 16 + kc) * 128 + tid] = red[tid] + red[tid + 128];
  }
}

DI void phase1_task(const Params& p, int layer, const float* xin, int grp, unsigned char* smem) {
  const int tid = otid(), lane = tid & 63, wid = tid >> 6;
  const int b = grp >> 6;
  float* mul = (float*)smem;
  float* sh = mul + 1024;
  const float* adap = (const float*)(p.ws + OFF_ADAP);
  lds_barrier();
  for (int c = tid; c < 1024; c += 256) {
    float s0 = 0.f, s1 = 0.f;
#pragma unroll
    for (int kc = 0; kc < 8; ++kc) { const float* a = adap + (((size_t)kc * 2 + layer) * 8 + b) * 3072; s0 += a[c]; s1 += a[1024 + c]; }
    mul[c] = p.norm_g[layer * 1024 + c] * (1.f + s1); sh[c] = s0;
  }
  lds_barrier();
  u16* H = (u16*)(p.ws + OFF_H);
#pragma unroll 1
  for (int it = 0; it < 4; ++it) {
    float4 v[4][4]; float ss[4];
#pragma unroll
    for (int j = 0; j < 4; ++j) {
      const int row = grp * 64 + wid * 16 + it * 4 + j;
      if (layer == 0) {
        const float4* xr = (const float4*)(xin + (size_t)row * D_MODEL);
#pragma unroll
        for (int i = 0; i < 4; ++i) v[j][i] = xr[lane + 64 * i];
      } else {
        const u32x2* xr = (const u32x2*)((const u16*)(p.ws + OFF_X1B) + (size_t)row * D_MODEL);
#pragma unroll
        for (int i = 0; i < 4; ++i) { const u32x2 w = xr[lane + 64 * i]; v[j][i] = make_float4(bflo(w.x), bfhi(w.x), bflo(w.y), bfhi(w.y)); }
      }
    }
#pragma unroll
    for (int j = 0; j < 4; ++j) {
      float a = 0.f;
#pragma unroll
      for (int i = 0; i < 4; ++i) a += v[j][i].x * v[j][i].x + v[j][i].y * v[j][i].y + v[j][i].z * v[j][i].z + v[j][i].w * v[j][i].w;
      ss[j] = wave_sum(a);
    }
#pragma unroll
    for (int j = 0; j < 4; ++j) {
      const int row = grp * 64 + wid * 16 + it * 4 + j;
      const float r = rsqrtf(ss[j] * (1.f / D_MODEL) + 1e-6f);
#pragma unroll
      for (int i = 0; i < 4; ++i) {
        const int c = (lane + 64 * i) * 4;
        u32x2 w;
        w.x = pack2(v[j][i].x * r * mul[c] + sh[c], v[j][i].y * r * mul[c + 1] + sh[c + 1]);
        w.y = pack2(v[j][i].z * r * mul[c + 2] + sh[c + 2], v[j][i].w * r * mul[c + 3] + sh[c + 3]);
        *(u32x2*)(H + (size_t)row * 1024 + c) = w;
      }
    }
  }
}

namespace g8 {
constexpr int BM = 256, BK = 64, HALF = 128, HT = HALF * BK;
constexpr int LDS_BYTES = 8 * HT * 2;
DI int lds_byte(int r, int c) { const int st = (r >> 4) * 2 + (c >> 5), rr = r & 15, cc = c & 31, ob = rr * 64 + cc * 2; return st * 1024 + (ob ^ (((ob >> 9) & 1) << 5)); }
DI void stage_rc(int b, int& R, int& C) { const int st = b / 1024, sb = b % 1024, swz = sb ^ (((sb >> 9) & 1) << 5); R = (st >> 1) * 16 + swz / 64; C = (st & 1) * 32 + (swz % 64) / 2; }

DI void kloop(const u16* __restrict__ A, const u16* __restrict__ Bt, int K, int brow, int bcol, unsigned char* smem, f32x4 (&acc)[2][2][4][2]) {
  u16* shm = (u16*)smem;
  const int tid = otid512();
#define SA(b, h) (shm + ((b) * 2 + (h)) * HT)
#define SB(b, h) (shm + (4 + (b) * 2 + (h)) * HT)
#define STAGE(P, BASE, br, kt) do { const u16* _gb = BASE + ((long)(br) * K + (long)(kt) * BK); \
      __builtin_amdgcn_global_load_lds((const unsigned*)(_gb + soff0), (LDSP unsigned*)((LDSP char*)(P) + tid * 16), 16, 0, 0); \
      __builtin_amdgcn_global_load_lds((const unsigned*)(_gb + soff1), (LDSP unsigned*)((LDSP char*)(P) + tid * 16 + 8192), 16, 0, 0); } while (0)
#define LDA(dst, b, h) _Pragma("unroll") for (int m = 0; m < 4; ++m) _Pragma("unroll") for (int k = 0; k < 2; ++k) \
    dst[m][k] = *reinterpret_cast<const bf16x8*>((const char*)SA(b, h) + lds_byte(wr * 64 + m * 16 + fr, k * 32 + fq * 8))
#define LDB(dst, b, h) _Pragma("unroll") for (int n = 0; n < 2; ++n) _Pragma("unroll") for (int k = 0; k < 2; ++k) \
    dst[n][k] = *reinterpret_cast<const bf16x8*>((const char*)SB(b, h) + lds_byte(wc * 32 + n * 16 + fr, k * 32 + fq * 8))
#define MMA(ai, bj, At_, Bt_) do { __builtin_amdgcn_s_setprio(1); \
    _Pragma("unroll") for (int m = 0; m < 4; ++m) _Pragma("unroll") for (int n = 0; n < 2; ++n) _Pragma("unroll") for (int k = 0; k < 2; ++k) \
      acc[ai][bj][m][n] = __builtin_amdgcn_mfma_f32_16x16x32_bf16(Bt_[n][k], At_[m][k], acc[ai][bj][m][n], 0, 0, 0); \
    __builtin_amdgcn_s_setprio(0); } while (0)
#define WAIT_V(n) asm volatile("s_waitcnt vmcnt(" #n ")" ::: "memory")
#define WAIT_L(n) asm volatile("s_waitcnt lgkmcnt(" #n ")" ::: "memory")
#define BAR __builtin_amdgcn_s_barrier()
#define SCHED __builtin_amdgcn_sched_barrier(0)
  const int wid = __builtin_amdgcn_readfirstlane(tid >> 6), lane = tid & 63, wr = wid >> 2, wc = wid & 3, fr = lane & 15, fq = lane >> 4;
#pragma unroll
  for (int a = 0; a < 2; ++a)
#pragma unroll
    for (int b = 0; b < 2; ++b)
#pragma unroll
      for (int m = 0; m < 4; ++m) { acc[a][b][m][0] = (f32x4){0.f, 0.f, 0.f, 0.f}; acc[a][b][m][1] = (f32x4){0.f, 0.f, 0.f, 0.f}; }
  bf16x8 At[4][2], B0[2][2], B1[2][2];
  const int nt = K / BK;
  int soff0, soff1;
  { int r_, c_; stage_rc(tid * 16, r_, c_); soff0 = r_ * K + c_; stage_rc(tid * 16 + 8192, r_, c_); soff1 = r_ * K + c_; }
  STAGE(SB(0, 0), Bt, bcol, 0); STAGE(SA(0, 0), A, brow, 0);
  STAGE(SB(0, 1), Bt, bcol + HALF, 0); STAGE(SA(0, 1), A, brow + HALF, 0);
  if (wr == 1) BAR;
  WAIT_V(4); BAR;
  STAGE(SB(1, 0), Bt, bcol, 1); STAGE(SA(1, 0), A, brow, 1); STAGE(SB(1, 1), Bt, bcol + HALF, 1);
  WAIT_V(6); BAR;
#pragma unroll 1
  for (int t = 0; t < nt - 2; t += 2) {
    asm volatile("" : "+v"(soff0), "+v"(soff1));
    LDB(B0, 0, 0); SCHED; LDA(At, 0, 0); STAGE(SA(1, 1), A, brow + HALF, t + 1);
    WAIT_L(8); BAR; WAIT_L(0); MMA(0, 0, At, B0); BAR; SCHED;
    LDB(B1, 0, 1); STAGE(SB(0, 0), Bt, bcol, t + 2);
    BAR; WAIT_L(0); MMA(0, 1, At, B1); BAR;
    LDA(At, 0, 1); STAGE(SA(0, 0), A, brow, t + 2);
    BAR; WAIT_L(0); MMA(1, 0, At, B0); BAR; SCHED;
    STAGE(SB(0, 1), Bt, bcol + HALF, t + 2);
    WAIT_V(6); BAR; MMA(1, 1, At, B1); BAR;
    LDB(B0, 1, 0); SCHED; LDA(At, 1, 0); STAGE(SA(0, 1), A, brow + HALF, t + 2);
    WAIT_L(8); BAR; WAIT_L(0); MMA(0, 0, At, B0); BAR; SCHED;
    LDB(B1, 1, 1); STAGE(SB(1, 0), Bt, bcol, t + 3);
    BAR; WAIT_L(0); MMA(0, 1, At, B1); BAR;
    LDA(At, 1, 1); STAGE(SA(1, 0), A, brow, t + 3);
    BAR; WAIT_L(0); MMA(1, 0, At, B0); BAR; SCHED;
    STAGE(SB(1, 1), Bt, bcol + HALF, t + 3);
    WAIT_V(6); BAR; MMA(1, 1, At, B1); BAR;
  }
  { LDB(B0, 0, 0); LDA(At, 0, 0); STAGE(SA(1, 1), A, brow + HALF, nt - 1);
    BAR; WAIT_L(0); MMA(0, 0, At, B0); BAR;
    LDB(B1, 0, 1); BAR; WAIT_L(0); MMA(0, 1, At, B1); BAR;
    LDA(At, 0, 1); WAIT_V(4); BAR; WAIT_L(0); MMA(1, 0, At, B0); MMA(1, 1, At, B1); BAR; }
  { LDB(B0, 1, 0); LDA(At, 1, 0); WAIT_V(2); BAR; WAIT_L(0); MMA(0, 0, At, B0); BAR;
    LDB(B1, 1, 1); WAIT_V(0); BAR; WAIT_L(0); MMA(0, 1, At, B1); BAR;
    LDA(At, 1, 1); BAR; WAIT_L(0); MMA(1, 0, At, B0); MMA(1, 1, At, B1); BAR; }
  if (wr == 0) BAR;
#undef SA
#undef SB
#undef STAGE
#undef LDA
#undef LDB
#undef MMA
#undef WAIT_V
#undef WAIT_L
#undef BAR
#undef SCHED
}
DI void tile_map(int wgid, int nM, int nN, int& pm, int& pn) {
  const int nwg = nM * nN, NXCD = 8, WGM = 8;
  { const int q = nwg / NXCD, r = nwg % NXCD, xcd = wgid % NXCD, off = wgid / NXCD; wgid = (xcd < r ? xcd * (q + 1) : r * (q + 1) + (xcd - r) * q) + off; }
  const int nig = WGM * nN, gid = wgid / nig, fm = gid * WGM, gsz = (nM - fm) < WGM ? (nM - fm) : WGM;
  pm = fm + ((wgid % nig) % gsz); pn = (wgid % nig) / gsz;
}
}

DI void gemm_inproj_tile(const Params& p, int layer, int tile, unsigned char* smem) {
  int pm, pn; g8::tile_map(tile, NTOK / 256, NPAD / 256, pm, pn);
  const int brow = pm * 256, bcol = pn * 256;
  f32x4 acc[2][2][4][2];
  g8::kloop((const u16*)(p.ws + OFF_H), (const u16*)(p.ws + OFF_WINT) + (size_t)layer * NPAD * 1024, 1024, brow, bcol, smem, acc);
  const int tid = otid512(), wid = __builtin_amdgcn_readfirstlane(tid >> 6), lane = tid & 63, wr = wid >> 2, wc = wid & 3, fr = lane & 15, fq = lane >> 4;
  u16* proj = (u16*)(p.ws + OFF_PROJ);
  if (pn == 15 && wc == 0) {
    float* sm = (float*)(p.ws + OFF_SMALL);
#pragma unroll
    for (int ai = 0; ai < 2; ++ai)
#pragma unroll
      for (int m = 0; m < 4; ++m)
#pragma unroll
        for (int n = 0; n < 2; ++n) {
          const int mr = brow + ai * 128 + wr * 64 + m * 16 + fr;
          *(f32x4*)(sm + (size_t)mr * NSMALL + n * 16 + 4 * fq) = acc[ai][1][m][n];
        }
  }
  constexpr int CLD = 264;
  u16* Cs = (u16*)smem;
#pragma unroll
  for (int ai = 0; ai < 2; ++ai) {
    lds_barrier();
#pragma unroll
    for (int bj = 0; bj < 2; ++bj)
#pragma unroll
      for (int m = 0; m < 4; ++m)
#pragma unroll
        for (int n = 0; n < 2; ++n) {
          const f32x4 v = acc[ai][bj][m][n];
          u32x2 w; w.x = pack2(v[0], v[1]); w.y = pack2(v[2], v[3]);
          *(u32x2*)(Cs + (wr * 64 + m * 16 + fr) * CLD + bj * 128 + wc * 32 + n * 16 + 4 * fq) = w;
        }
    lds_barrier();
#pragma unroll
    for (int i = 0; i < 8; ++i) {
      const int id = tid + 512 * i, row = id >> 5, ch = id & 31;
      if (bcol + ch * 8 < NP) *(u32x4*)(proj + (size_t)(brow + ai * 128 + row) * NP + bcol + ch * 8) = *(const u32x4*)(Cs + row * CLD + ch * 8);
    }
  }
  lds_barrier();
}

template <int layer>
DI void gemm_outproj_tile(const Params& p, const float* xin, float* xout, int tile, unsigned char* smem) {
  int pm, pn; g8::tile_map(tile, NTOK / 256, 4, pm, pn);
  const int brow = pm * 256, bcol = pn * 256;
  f32x4 acc[2][2][4][2];
  g8::kloop((const u16*)(p.ws + OFF_H), (const u16*)(p.ws + OFF_WOUTT) + (size_t)layer * 1024 * 1024, 1024, brow, bcol, smem, acc);
  const int tid = otid512(), wid = __builtin_amdgcn_readfirstlane(tid >> 6), lane = tid & 63, wr = wid >> 2, wc = wid & 3, fr = lane & 15, fq = lane >> 4;
  const int b = brow >> 12;
  const float* adap = (const float*)(p.ws + OFF_ADAP);
  constexpr int CLD = 132;
  float* Cs = (float*)smem;
#pragma unroll
  for (int ai = 0; ai < 2; ++ai)
#pragma unroll
    for (int bj = 0; bj < 2; ++bj) {
      lds_barrier();
#pragma unroll
      for (int m = 0; m < 4; ++m)
#pragma unroll
        for (int n = 0; n < 2; ++n) *(f32x4*)(Cs + (wr * 64 + m * 16 + fr) * CLD + wc * 32 + n * 16 + 4 * fq) = acc[ai][bj][m][n];
      lds_barrier();
      const int ch = tid & 31, nc = bcol + bj * 128 + ch * 4;
      f32x4 gt = {0.f, 0.f, 0.f, 0.f};
#pragma unroll
      for (int kc = 0; kc < 8; ++kc) gt += *(const f32x4*)(adap + (((size_t)kc * 2 + layer) * 8 + b) * 3072 + 2048 + nc);
      u16* x1b = (u16*)(p.ws + OFF_X1B);
      f32x4 xv[8];
#pragma unroll
      for (int i = 0; i < 8; ++i) {
        const size_t off = (size_t)(brow + ai * 128 + (tid >> 5) + 16 * i) * 1024 + nc;
        if (layer == 0) xv[i] = *(const f32x4*)(xin + off);
        else { const u32x2 w = *(const u32x2*)(x1b + off); xv[i] = (f32x4){bflo(w.x), bfhi(w.x), bflo(w.y), bfhi(w.y)}; }
      }
#pragma unroll
      for (int i = 0; i < 8; ++i) {
        const int row = (tid >> 5) + 16 * i;
        const size_t off = (size_t)(brow + ai * 128 + row) * 1024 + nc;
        const f32x4 v = xv[i] + gt * *(const f32x4*)(Cs + row * CLD + ch * 4);
        if (layer == 0) { u32x2 w; w.x = pack2(v[0], v[1]); w.y = pack2(v[2], v[3]); *(u32x2*)(x1b + off) = w; }
        else *(f32x4*)(xout + off) = v;
      }
    }
  lds_barrier();
}

constexpr int KLD = 72;
struct KVRegs { u32x4 k[2], v[2]; };
DI void kv_load(const u16* kbase, const u16* vbase, int ldk, int ldv, int key0, KVRegs& r) {
  const int tid = otid();
#pragma unroll
  for (int i = 0; i < 2; ++i) {
    const int id = tid + 256 * i, row = id >> 3, ch = id & 7;
    r.k[i] = *(const u32x4*)(kbase + (size_t)(key0 + row) * ldk + ch * 8);
    r.v[i] = *(const u32x4*)(vbase + (size_t)(key0 + row) * ldv + ch * 8);
  }
}
DI void kv_store(u16* Ks, u16* Vs, const KVRegs& r) {
  const int tid = otid();
#pragma unroll
  for (int i = 0; i < 2; ++i) {
    const int id = tid + 256 * i, row = id >> 3, ch = id & 7;
    *(u32x4*)(Ks + row * KLD + ch * 8) = r.k[i];
    *(u32x4*)(Vs + row * KLD + ch * 8) = r.v[i];
  }
}
constexpr int KVBUF = 2 * 64 * KLD;
template <class UseF, class LoadF, class CompF>
DI void kv_pipeline(int j0, int j1, u16* buf, UseF use, LoadF load, CompF comp) {
  KVRegs kr;
  if (use(j0)) load(j0, kr);
  lds_barrier();
  if (use(j0)) kv_store(buf, buf + 64 * KLD, kr);
  if (j0 + 1 < j1 && use(j0 + 1)) load(j0 + 1, kr);
  lds_barrier();
  for (int j = j0; j < j1; ++j) {
    u16* cur = buf + ((j - j0) & 1) * KVBUF; u16* nxt = buf + (((j - j0) & 1) ^ 1) * KVBUF;
    if (j + 1 < j1 && use(j + 1)) kv_store(nxt, nxt + 64 * KLD, kr);
    if (j + 2 < j1 && use(j + 2)) load(j + 2, kr);
    if (use(j)) comp(j, cur, cur + 64 * KLD);
    lds_barrier();
  }
}
struct AttnAcc { f32x4 o[4][2]; float m[2], l[2]; f32x4 os[2]; int fresh; };
DI void attn_init(AttnAcc& a) {
#pragma unroll
  for (int d = 0; d < 4; ++d) { a.o[d][0] = (f32x4){0.f, 0.f, 0.f, 0.f}; a.o[d][1] = (f32x4){0.f, 0.f, 0.f, 0.f}; }
  a.m[0] = a.m[1] = -1e30f; a.l[0] = a.l[1] = 0.f;
}
template <int NKS>
DI void qk_tile(const u16* Ks, int dofs, const bf16x8 (&qf)[2][NKS], f32x4 (&s)[4][2], int l15, int g) {
#pragma unroll
  for (int kt = 0; kt < 4; ++kt) {
    s[kt][0] = (f32x4){0.f, 0.f, 0.f, 0.f}; s[kt][1] = (f32x4){0.f, 0.f, 0.f, 0.f};
#pragma unroll
    for (int ks = 0; ks < NKS; ++ks) {
      const bf16x8 a = ldfrag(Ks + (kt * 16 + l15) * KLD + dofs + ks * 32 + 8 * g);
      s[kt][0] = mfma16(a, qf[0][ks], s[kt][0]);
      s[kt][1] = mfma16(a, qf[1][ks], s[kt][1]);
    }
  }
}
DI void pv_accum(const bf16x8 (&pf)[2][2], const u16* Vs, f32x4 (&o)[4][2], int l15, int g) {
  const int tq = l15 >> 2, tp = l15 & 3;
#pragma unroll
  for (int kk = 0; kk < 2; ++kk)
#pragma unroll
    for (int d = 0; d < 4; ++d) {
      const bf16x8 vf = cat4(tr_read(Vs + (kk * 32 + 4 * g + tq) * KLD + d * 16 + 4 * tp), tr_read(Vs + (kk * 32 + 16 + 4 * g + tq) * KLD + d * 16 + 4 * tp));
      o[d][0] = mfma16(vf, pf[0][kk], o[d][0]);
      o[d][1] = mfma16(vf, pf[1][kk], o[d][1]);
    }
}
DI void pack_p(const f32x4 (&s)[4][2], bf16x8 (&pf)[2][2]) {
#pragma unroll
  for (int qt = 0; qt < 2; ++qt)
#pragma unroll
    for (int kk = 0; kk < 2; ++kk) {
      u32x4 w;
      w.x = pack2(s[2 * kk][qt][0], s[2 * kk][qt][1]); w.y = pack2(s[2 * kk][qt][2], s[2 * kk][qt][3]);
      w.z = pack2(s[2 * kk + 1][qt][0], s[2 * kk + 1][qt][1]); w.w = pack2(s[2 * kk + 1][qt][2], s[2 * kk + 1][qt][3]);
      pf[qt][kk] = __builtin_bit_cast(bf16x8, w);
    }
}
constexpr float DEFER_THR = 5.f;
template <class VF>
DI void softmax_pv(f32x4 (&s)[4][2], AttnAcc& a, const u16* Vs, float sc, int l15, int g, VF valid) {
  bf16x8 pf[2][2];
  float mxl[2];
#pragma unroll
  for (int qt = 0; qt < 2; ++qt) {
    float mx = -1e30f;
#pragma unroll
    for (int kt = 0; kt < 4; ++kt)
#pragma unroll
      for (int r = 0; r < 4; ++r) { const float v = valid(kt, r, qt) ? s[kt][qt][r] * sc : -1e30f; s[kt][qt][r] = v; mx = fmaxf(mx, v); }
    mxl[qt] = mx;
  }
  if (__any((mxl[0] > a.m[0] + DEFER_THR) || (mxl[1] > a.m[1] + DEFER_THR))) {
#pragma unroll
    for (int qt = 0; qt < 2; ++qt) {
      float mx = mxl[qt];
      mx = fmaxf(mx, __shfl_xor(mx, 16)); mx = fmaxf(mx, __shfl_xor(mx, 32));
      const float mn = fmaxf(a.m[qt], mx), alpha = exp2_(a.m[qt] - mn);
      a.m[qt] = mn; a.l[qt] *= alpha;
#pragma unroll
      for (int d = 0; d < 4; ++d) a.o[d][qt] *= alpha;
    }
  }
#pragma unroll
  for (int qt = 0; qt < 2; ++qt) {
    const float mn = a.m[qt];
    float ls = 0.f;
#pragma unroll
    for (int kt = 0; kt < 4; ++kt)
#pragma unroll
      for (int r = 0; r < 4; ++r) { const float v = s[kt][qt][r]; const float pv = v > -1e29f ? exp2_(v - mn) : 0.f; s[kt][qt][r] = pv; ls += pv; }
    a.l[qt] += ls;
  }
  pack_p(s, pf);
  pv_accum(pf, Vs, a.o, l15, g);
}
DI void softmax_pv_nomask(f32x4 (&s)[4][2], AttnAcc& a, const u16* Vs, float sc, int l15, int g) {
  bf16x8 pf[2][2];
  float mxl[2];
#pragma unroll
  for (int qt = 0; qt < 2; ++qt) {
    float mx = s[0][qt][0];
#pragma unroll
    for (int kt = 0; kt < 4; ++kt)
#pragma unroll
      for (int r = 0; r < 4; ++r) mx = fmaxf(mx, s[kt][qt][r]);
    mxl[qt] = mx * sc;
  }
  if (__any((mxl[0] > a.m[0] + DEFER_THR) || (mxl[1] > a.m[1] + DEFER_THR))) {
#pragma unroll
    for (int qt = 0; qt < 2; ++qt) {
      float mx = mxl[qt];
      mx = fmaxf(mx, __shfl_xor(mx, 16)); mx = fmaxf(mx, __shfl_xor(mx, 32));
      const float mn = fmaxf(a.m[qt], mx), alpha = exp2_(a.m[qt] - mn);
      a.m[qt] = mn; a.l[qt] *= alpha;
#pragma unroll
      for (int d = 0; d < 4; ++d) a.o[d][qt] *= alpha;
    }
  }
#pragma unroll
  for (int qt = 0; qt < 2; ++qt) {
    const float mn = a.m[qt];
    float ls = 0.f;
#pragma unroll
    for (int kt = 0; kt < 4; ++kt)
#pragma unroll
      for (int r = 0; r < 4; ++r) { const float pv = exp2_(__builtin_fmaf(s[kt][qt][r], sc, -mn)); s[kt][qt][r] = pv; ls += pv; }
    a.l[qt] += ls;
  }
  pack_p(s, pf);
  pv_accum(pf, Vs, a.o, l15, g);
}
template <class VF>
DI void softmax_p(f32x4 (&s)[4][2], AttnAcc& a, float sc, bf16x8 (&pf)[2][2], bool nomask, VF valid) {
  float mxl[2];
#pragma unroll
  for (int qt = 0; qt < 2; ++qt) {
    float mx = -1e30f;
#pragma unroll
    for (int kt = 0; kt < 4; ++kt)
#pragma unroll
      for (int r = 0; r < 4; ++r) { const float v = (nomask || valid(kt, r, qt)) ? s[kt][qt][r] * sc : -1e30f; s[kt][qt][r] = v; mx = fmaxf(mx, v); }
    mxl[qt] = mx;
  }
  if (__any((mxl[0] > a.m[0] + DEFER_THR) || (mxl[1] > a.m[1] + DEFER_THR))) {
#pragma unroll
    for (int qt = 0; qt < 2; ++qt) {
      float mx = mxl[qt];
      mx = fmaxf(mx, __shfl_xor(mx, 16)); mx = fmaxf(mx, __shfl_xor(mx, 32));
      const float mn = fmaxf(a.m[qt], mx), alpha = exp2_(a.m[qt] - mn);
      a.m[qt] = mn; a.l[qt] *= alpha;
#pragma unroll
      for (int d = 0; d < 4; ++d) a.o[d][qt] *= alpha;
    }
  }
#pragma unroll
  for (int qt = 0; qt < 2; ++qt) {
    const float mn = a.m[qt];
    float ls = 0.f;
#pragma unroll
    for (int kt = 0; kt < 4; ++kt)
#pragma unroll
      for (int r = 0; r < 4; ++r) { const float v = s[kt][qt][r]; const float pv = v > -1e29f ? exp2_(v - mn) : 0.f; s[kt][qt][r] = pv; ls += pv; }
    a.l[qt] += ls;
  }
  pack_p(s, pf);
}
DI void softmax_p_nomask(f32x4 (&s)[4][2], AttnAcc& a, float sc, bf16x8 (&pf)[2][2]) {
  float mxl[2];
#pragma unroll
  for (int qt = 0; qt < 2; ++qt) {
    float mx = s[0][qt][0];
#pragma unroll
    for (int kt = 0; kt < 4; ++kt)
#pragma unroll
      for (int r = 0; r < 4; ++r) mx = fmaxf(mx, s[kt][qt][r]);
    mxl[qt] = mx * sc;
  }
  if (__any((mxl[0] > a.m[0] + DEFER_THR) || (mxl[1] > a.m[1] + DEFER_THR))) {
#pragma unroll
    for (int qt = 0; qt < 2; ++qt) {
      float mx = mxl[qt];
      mx = fmaxf(mx, __shfl_xor(mx, 16)); mx = fmaxf(mx, __shfl_xor(mx, 32));
      const float mn = fmaxf(a.m[qt], mx), alpha = exp2_(a.m[qt] - mn);
      a.m[qt] = mn; a.l[qt] *= alpha;
#pragma unroll
      for (int d = 0; d < 4; ++d) a.o[d][qt] *= alpha;
    }
  }
#pragma unroll
  for (int qt = 0; qt < 2; ++qt) {
    const float mn = a.m[qt];
    float ls = 0.f;
#pragma unroll
    for (int kt = 0; kt < 4; ++kt)
#pragma unroll
      for (int r = 0; r < 4; ++r) { const float pv = exp2_(__builtin_fmaf(s[kt][qt][r], sc, -mn)); s[kt][qt][r] = pv; ls += pv; }
    a.l[qt] += ls;
  }
  pack_p(s, pf);
}
DI float group_sum4_(float v) { v += __shfl_xor(v, 16); v += __shfl_xor(v, 32); return v; }
DI bf16x8 scale_frag(bf16x8 f, float sc) {
  u32x4 w = __builtin_bit_cast(u32x4, f);
  w.x = pack2(bflo(w.x) * sc, bfhi(w.x) * sc); w.y = pack2(bflo(w.y) * sc, bfhi(w.y) * sc);
  w.z = pack2(bflo(w.z) * sc, bfhi(w.z) * sc); w.w = pack2(bflo(w.w) * sc, bfhi(w.w) * sc);
  return __builtin_bit_cast(bf16x8, w);
}
DI void attn_init_rel(AttnAcc& a) { attn_init(a); a.m[0] = a.m[1] = 0.f; a.os[0] = (f32x4){0.f, 0.f, 0.f, 0.f}; a.os[1] = (f32x4){0.f, 0.f, 0.f, 0.f}; a.fresh = 1; }
DI void rowsum_accum(const bf16x8 (&pf)[2][2], AttnAcc& a, int l15) {
  const short one = l15 == 0 ? (short)0x3F80 : (short)0;
  const bf16x8 ones = {one, one, one, one, one, one, one, one};
#pragma unroll
  for (int kk = 0; kk < 2; ++kk) { a.os[0] = mfma16(ones, pf[0][kk], a.os[0]); a.os[1] = mfma16(ones, pf[1][kk], a.os[1]); }
}
DI float rel_rowsum(const AttnAcc& a, int qt, int l15) { return __shfl(a.os[qt][0], l15); }
template <int NKS>
DI void qk_tile_rel(const u16* Ks, int dofs, const bf16x8 (&qf)[2][NKS], const AttnAcc& a, f32x4 (&s)[4][2], int l15, int g) {
  const float n0 = -a.m[0], n1 = -a.m[1];
#pragma unroll
  for (int kt = 0; kt < 4; ++kt) {
    s[kt][0] = (f32x4){n0, n0, n0, n0}; s[kt][1] = (f32x4){n1, n1, n1, n1};
#pragma unroll
    for (int ks = 0; ks < NKS; ++ks) {
      const bf16x8 k = ldfrag(Ks + (kt * 16 + l15) * KLD + dofs + ks * 32 + 8 * g);
      s[kt][0] = mfma16(k, qf[0][ks], s[kt][0]);
      s[kt][1] = mfma16(k, qf[1][ks], s[kt][1]);
    }
  }
}
template <int MODE, class VF>
DI void softmax_rel(f32x4 (&s)[4][2], AttnAcc& a, bf16x8 (&pf)[2][2], int l15_, VF valid, bool ok0 = true, bool ok1 = true) {
  float mxl[2];
#pragma unroll
  for (int qt = 0; qt < 2; ++qt) {
    float mx = -1e30f;
    const bool okq = qt == 0 ? ok0 : ok1;
#pragma unroll
    for (int kt = 0; kt < 4; ++kt)
#pragma unroll
      for (int r = 0; r < 4; ++r) {
        if (MODE == 1) s[kt][qt][r] = valid(kt, r, qt) ? s[kt][qt][r] : -1e30f;
        if (MODE == 2) s[kt][qt][r] = okq ? s[kt][qt][r] : -1e30f;
        mx = fmaxf(mx, s[kt][qt][r]);
      }
    mxl[qt] = mx;
  }
  if (a.fresh || __any(mxl[0] > DEFER_THR || mxl[1] > DEFER_THR)) {
    bool still = false;
#pragma unroll
    for (int qt = 0; qt < 2; ++qt) {
      float mx = mxl[qt];
      mx = fmaxf(mx, __shfl_xor(mx, 16)); mx = fmaxf(mx, __shfl_xor(mx, 32));
      const bool fresh = rel_rowsum(a, qt, l15_) == 0.f;
      const float dl = mx < -1e29f ? 0.f : (fresh ? mx : fmaxf(mx, 0.f)), alpha = exp2_(-dl);
      still = still || (fresh && mx < -1e29f);
      a.m[qt] += dl; a.os[qt] *= alpha;
#pragma unroll
      for (int d = 0; d < 4; ++d) a.o[d][qt] *= alpha;
#pragma unroll
      for (int kt = 0; kt < 4; ++kt)
#pragma unroll
        for (int r = 0; r < 4; ++r) s[kt][qt][r] -= dl;
    }
    a.fresh = __any(still) ? 1 : 0;
  }
#pragma unroll
  for (int qt = 0; qt < 2; ++qt)
#pragma unroll
    for (int kt = 0; kt < 4; ++kt)
#pragma unroll
      for (int r = 0; r < 4; ++r) s[kt][qt][r] = exp2_(s[kt][qt][r]);
  pack_p(s, pf);
}
template <class LoadF, class CompF>
DI void kv_pipeline3(int j0, int j1, u16* buf, LoadF load, CompF comp) {
  KVRegs kr;
  load(j0, kr);
  lds_barrier();
  kv_store(buf, buf + 64 * KLD, kr);
  if (j0 + 1 < j1) load(j0 + 1, kr);
  lds_barrier();
  int cb = 0;
  for (int j = j0; j < j1; ++j) {
    const int nb = cb == 2 ? 0 : cb + 1, pb = cb == 0 ? 2 : cb - 1;
    if (j + 1 < j1) kv_store(buf + nb * KVBUF, buf + nb * KVBUF + 64 * KLD, kr);
    if (j + 2 < j1) load(j + 2, kr);
    comp(j, buf + cb * KVBUF, buf + pb * KVBUF);
    lds_barrier();
    cb = nb;
  }
}
DI float group_sum4(float v) { v += __shfl_xor(v, 16); v += __shfl_xor(v, 32); return v; }

constexpr int DSTAGE = 2 * 128 * 64;
DI int fKs(int row) { return (row >> 1) & 7; }
DI int fVs(int row) { return ((row >> 1) & 3) << 1; }
DI void kv_dma128(const u16* kbase, const u16* vbase, int ld, int key0, u16* stage, int tid) {
#pragma unroll
  for (int i = 0; i < 4; ++i) {
    const int id = tid + 256 * i, row = id >> 3, c8 = id & 7;
    __builtin_amdgcn_global_load_lds((const unsigned*)(kbase + (size_t)(key0 + row) * ld + ((c8 ^ fKs(row)) * 8)), (LDSP unsigned*)((LDSP char*)stage + id * 16), 16, 0, 0);
  }
#pragma unroll
  for (int i = 0; i < 4; ++i) {
    const int id = tid + 256 * i, row = id >> 3, c8 = id & 7;
    __builtin_amdgcn_global_load_lds((const unsigned*)(vbase + (size_t)(key0 + row) * ld + ((c8 ^ fVs(row)) * 8)), (LDSP unsigned*)((LDSP char*)(stage + 128 * 64) + id * 16), 16, 0, 0);
  }
}
template <int NKS>
DI void qk_tile_rel_sw(const u16* Kh, int dofs, const bf16x8 (&qf)[2][NKS], const AttnAcc& a, f32x4 (&s)[4][2], int l15, int g) {
  const float n0 = -a.m[0], n1 = -a.m[1];
  const int sw = (l15 >> 1) & 7;
#pragma unroll
  for (int kt = 0; kt < 4; ++kt) {
    s[kt][0] = (f32x4){n0, n0, n0, n0}; s[kt][1] = (f32x4){n1, n1, n1, n1};
#pragma unroll
    for (int ks = 0; ks < NKS; ++ks) {
      const bf16x8 k = ldfrag(Kh + (kt * 16 + l15) * 64 + ((((dofs >> 3) + ks * 4 + g) ^ sw) * 8));
      s[kt][0] = mfma16(k, qf[0][ks], s[kt][0]);
      s[kt][1] = mfma16(k, qf[1][ks], s[kt][1]);
    }
  }
}
DI void pv_accum_sw(const bf16x8 (&pf)[2][2], const u16* Vh, f32x4 (&o)[4][2], int l15, int g) {
  const int tq = l15 >> 2, tp = l15 & 3;
#pragma unroll
  for (int kk = 0; kk < 2; ++kk) {
    const int r0 = kk * 32 + 4 * g + tq, r1 = r0 + 16;
    const int f0 = fVs(r0), f1 = fVs(r1);
#pragma unroll
    for (int d = 0; d < 4; ++d) {
      const int lc = d * 2 + (tp >> 1);
      const bf16x8 vf = cat4(tr_read(Vh + r0 * 64 + ((lc ^ f0) * 8) + (tp & 1) * 4), tr_read(Vh + r1 * 64 + ((lc ^ f1) * 8) + (tp & 1) * 4));
      o[d][0] = mfma16(vf, pf[0][kk], o[d][0]);
      o[d][1] = mfma16(vf, pf[1][kk], o[d][1]);
    }
  }
}
DI void diff_attn_task(const Params& p, int layer, int b, int h, int qb, unsigned char* smem, bool skew) {
  u16* Ks = (u16*)smem; u16* Vs = Ks + 64 * KLD;
  const int tid = otid(), lane = tid & 63, wid = tid >> 6, l15 = lane & 15, g = lane >> 4;
  const u16* proj = (const u16*)(p.ws + OFF_PROJ) + (size_t)b * SEQ * NP;
  const int q0w = qb * 128 + wid * 32;
  const float* lam = p.diff_lam + layer * 128;
  float s01 = 0.f, s23 = 0.f;
  for (int i = 0; i < 32; ++i) { s01 += lam[i] * lam[32 + i]; s23 += lam[64 + i] * lam[96 + i]; }
  const float lam_init = layer == 0 ? 0.2f : 0.35550906759096324f;
  const float lam_full = sgprf(__expf(s01) - __expf(s23) + lam_init);
  const float sc = 0.17677669529663687f * 1.4426950408889634f;
  const int ntile = 2 * qb + 2;
  const u16* vbase = proj + PB_V + h * 64;
  f32x4 res[4][2];
#pragma unroll 1
  for (int c = 0; c < 2; ++c) {
    const u16* kbase = proj + PB_K + h * 64;
    bf16x8 qf[2][1];
#pragma unroll
    for (int qt = 0; qt < 2; ++qt) qf[qt][0] = scale_frag(ldfrag(proj + (size_t)(q0w + qt * 16 + l15) * NP + PB_Q + h * 64 + c * 32 + 8 * g), sc);
    AttnAcc a; attn_init_rel(a);
    const int nst = qb + 1;
    asm volatile("s_waitcnt vmcnt(0)" ::: "memory");
    lds_barrier();
    kv_dma128(kbase, vbase, NP, 0, Ks, tid);
    asm volatile("s_waitcnt vmcnt(0)" ::: "memory");
    lds_barrier();
    for (int js = 0; js < nst; ++js) {
      const u16* st = Ks + (js & 1) * DSTAGE;
      if (js + 1 < nst) kv_dma128(kbase, vbase, NP, (js + 1) * 128, Ks + ((js + 1) & 1) * DSTAGE, tid);
#pragma unroll 1
      for (int hf = 0; hf < 2; ++hf) {
        const int key0 = js * 128 + hf * 64;
        if (key0 <= q0w + 31) {
          f32x4 s[4][2]; bf16x8 pf[2][2];
          auto valid = [&](int kt, int r, int qt) { return key0 + kt * 16 + 4 * g + r <= q0w + qt * 16 + l15; };
          qk_tile_rel_sw<1>(st + hf * 64 * 64, c * 32, qf, a, s, l15, g);
          if (key0 + 63 <= q0w) softmax_rel<0>(s, a, pf, l15, valid); else softmax_rel<1>(s, a, pf, l15, valid);
          pv_accum_sw(pf, st + 128 * 64 + hf * 64 * 64, a.o, l15, g);
          rowsum_accum(pf, a, l15);
        }
      }
      asm volatile("s_waitcnt vmcnt(0)" ::: "memory");
      lds_barrier();
    }
#pragma unroll
    for (int qt = 0; qt < 2; ++qt) {
      const float lt = rel_rowsum(a, qt, l15);
      const float inv = c == 0 ? 1.f / lt : -lam_full / lt;
#pragma unroll
      for (int d = 0; d < 4; ++d) res[d][qt] = c == 0 ? a.o[d][qt] * inv : res[d][qt] + a.o[d][qt] * inv;
    }
  }
  u16* Y = (u16*)(p.ws + OFF_H);
  const float* ng = p.diff_norm_g + layer * 64;
#pragma unroll
  for (int qt = 0; qt < 2; ++qt) {
    float ss = 0.f;
#pragma unroll
    for (int d = 0; d < 4; ++d) { const f32x4 v = res[d][qt]; ss += v[0] * v[0] + v[1] * v[1] + v[2] * v[2] + v[3] * v[3]; }
    ss = group_sum4(ss);
    const float rn = rsqrtf(ss * (1.f / 64.f) + 1e-6f) * (1.f - lam_init);
    const int t = q0w + qt * 16 + l15;
    const size_t row = (size_t)b * SEQ + t;
#pragma unroll
    for (int d = 0; d < 4; ++d) {
      const int dd = d * 16 + 4 * g;
      const f32x4 v = res[d][qt];
      const u32x2 zz = *(const u32x2*)(proj + (size_t)t * NP + PB_Z + h * 64 + dd);
      const f32x4 gg = *(const f32x4*)(ng + dd);
      u32x2 w;
      w.x = pack2(v[0] * rn * gg[0] * siluf(bflo(zz.x)), v[1] * rn * gg[1] * siluf(bfhi(zz.x)));
      w.y = pack2(v[2] * rn * gg[2] * siluf(bflo(zz.y)), v[3] * rn * gg[3] * siluf(bfhi(zz.y)));
      *(u32x2*)(Y + row * 1024 + Y_B + h * 64 + dd) = w;
    }
  }
}

template <int NKS>
DI void qk_tile1(const u16* Ks, const bf16x8 (&qf)[NKS], f32x4 (&s)[4], int l15, int g) {
#pragma unroll
  for (int kt = 0; kt < 4; ++kt) {
    s[kt] = (f32x4){0.f, 0.f, 0.f, 0.f};
#pragma unroll
    for (int ks = 0; ks < NKS; ++ks) s[kt] = mfma16(ldfrag(Ks + (kt * 16 + l15) * KLD + ks * 32 + 8 * g), qf[ks], s[kt]);
  }
}
DI void pv_accum1(const f32x4 (&s)[4], const u16* Vs, f32x4 (&o)[4], int l15, int g) {
  const int tq = l15 >> 2, tp = l15 & 3;
#pragma unroll
  for (int kk = 0; kk < 2; ++kk) {
    u32x4 w;
    w.x = pack2(s[2 * kk][0], s[2 * kk][1]); w.y = pack2(s[2 * kk][2], s[2 * kk][3]);
    w.z = pack2(s[2 * kk + 1][0], s[2 * kk + 1][1]); w.w = pack2(s[2 * kk + 1][2], s[2 * kk + 1][3]);
    const bf16x8 pf = __builtin_bit_cast(bf16x8, w);
#pragma unroll
    for (int d = 0; d < 4; ++d) {
      const bf16x8 vf = cat4(tr_read(Vs + (kk * 32 + 4 * g + tq) * KLD + d * 16 + 4 * tp), tr_read(Vs + (kk * 32 + 16 + 4 * g + tq) * KLD + d * 16 + 4 * tp));
      o[d] = mfma16(vf, pf, o[d]);
    }
  }
}
DI void conv_silu_stage(const u16* projb, int col0, const float* cw, const float* cb, int chan0, int nchan, int t0, u16* dst, const float* rowscale, float cscale) {
  const int tid = otid(), ch = (tid & 7) * 8;
  float w[4][8], bias[8];
#pragma unroll
  for (int j = 0; j < 4; ++j)
#pragma unroll
    for (int i = 0; i < 8; ++i) w[j][i] = cw[j * nchan + chan0 + ch + i];
#pragma unroll
  for (int i = 0; i < 8; ++i) bias[i] = cb[chan0 + ch + i];
#pragma unroll 1
  for (int ps = 0; ps < 4; ++ps) {
    const int row = ps * 32 + (tid >> 3), t = t0 + row;
    float acc[8];
#pragma unroll
    for (int i = 0; i < 8; ++i) acc[i] = bias[i];
#pragma unroll
    for (int j = 0; j < 4; ++j) {
      const int tt = t - 3 + j;
      if (tt >= 0) {
        const u32x4 v = *(const u32x4*)(projb + (size_t)tt * NP + col0 + ch);
        acc[0] += w[j][0] * bflo(v.x); acc[1] += w[j][1] * bfhi(v.x); acc[2] += w[j][2] * bflo(v.y); acc[3] += w[j][3] * bfhi(v.y);
        acc[4] += w[j][4] * bflo(v.z); acc[5] += w[j][5] * bfhi(v.z); acc[6] += w[j][6] * bflo(v.w); acc[7] += w[j][7] * bfhi(v.w);
      }
    }
    const float rs = (rowscale ? rowscale[row] : 1.f) * cscale;
#pragma unroll
    for (int i = 0; i < 8; ++i) acc[i] = siluf(acc[i]) * rs;
    u32x4 o; o.x = pack2(acc[0], acc[1]); o.y = pack2(acc[2], acc[3]); o.z = pack2(acc[4], acc[5]); o.w = pack2(acc[6], acc[7]);
    *(u32x4*)(dst + row * KLD + ch) = o;
  }
}
DI float block_scan128_add(float v, float* tmp) {
  const int tid = otid(), lane = tid & 63;
  float x = v;
#pragma unroll
  for (int o = 1; o < 64; o <<= 1) { const float y = __shfl_up(x, o); if (lane >= o) x += y; }
  lds_barrier();
  if (tid == 63) tmp[0] = x;
  lds_barrier();
  if ((tid >> 6) == 1) x += tmp[0];
  return x;
}
DI float block_scan128_max(float v, float* tmp) {
  const int tid = otid(), lane = tid & 63;
  float x = v;
#pragma unroll
  for (int o = 1; o < 64; o <<= 1) { const float y = __shfl_up(x, o); if (lane >= o) x = fmaxf(x, y); }
  lds_barrier();
  if (tid == 63) tmp[0] = x;
  lds_barrier();
  if ((tid >> 6) == 1) x = fmaxf(x, tmp[0]);
  return x;
}
DI void scale_rows(u16* A, const float* rs) {
  const int tid = otid(), ch = (tid & 7) * 8;
#pragma unroll
  for (int ps = 0; ps < 4; ++ps) {
    const int row = ps * 32 + (tid >> 3);
    const float f = rs[row];
    u32x4 v = *(u32x4*)(A + row * KLD + ch);
    v.x = pack2(bflo(v.x) * f, bfhi(v.x) * f); v.y = pack2(bflo(v.y) * f, bfhi(v.y) * f);
    v.z = pack2(bflo(v.z) * f, bfhi(v.z) * f); v.w = pack2(bflo(v.w) * f, bfhi(v.w) * f);
    *(u32x4*)(A + row * KLD + ch) = v;
  }
}
DI void state_update(const u16* Xs, const u16* Bs, f32x4 (&acc)[4], int w, int l15, int g) {
  const int tq = l15 >> 2, tp = l15 & 3;
#pragma unroll
  for (int kk = 0; kk < 4; ++kk) {
    const bf16x8 af = cat4(tr_read(Xs + (kk * 32 + 4 * g + tq) * KLD + w * 16 + 4 * tp), tr_read(Xs + (kk * 32 + 16 + 4 * g + tq) * KLD + w * 16 + 4 * tp));
#pragma unroll
    for (int nt = 0; nt < 4; ++nt) {
      const bf16x8 bfr = cat4(tr_read(Bs + (kk * 32 + 4 * g + tq) * KLD + nt * 16 + 4 * tp), tr_read(Bs + (kk * 32 + 16 + 4 * g + tq) * KLD + nt * 16 + 4 * tp));
      acc[nt] = mfma16(af, bfr, acc[nt]);
    }
  }
}
DI void state_to_lds(u16* Ss, const f32x4 (&acc)[4], int w, int l15, int g) {
#pragma unroll
  for (int nt = 0; nt < 4; ++nt)
#pragma unroll
    for (int r = 0; r < 4; ++r) Ss[(w * 16 + 4 * g + r) * KLD + nt * 16 + l15] = f2bf(acc[nt][r]);
}

constexpr int SEQ_LDS_A = 0, SEQ_LDS_B = 128 * KLD * 2, SEQ_LDS_C = 2 * 128 * KLD * 2, SEQ_LDS_S = 3 * 128 * KLD * 2, SEQ_LDS_F = SEQ_LDS_S + 64 * KLD * 2;
constexpr int SEQ_LDS_HALO = SEQ_LDS_F + 4096;
constexpr int SEQ_LDS_CW = SEQ_LDS_HALO + 2 * 3 * 3 * 64 * 2;
struct RawRegs { u32x4 r[4]; };
DI void raw_load(const u16* projb, int col0, int t0, RawRegs& rr, int tid) {
#pragma unroll
  for (int i = 0; i < 4; ++i) rr.r[i] = *(const u32x4*)(projb + (size_t)(t0 + (tid >> 3) + 32 * i) * NP + col0 + (tid & 7) * 8);
}
DI void raw_store(u16* dst, u16* halo_next, const RawRegs& rr, int tid) {
#pragma unroll
  for (int i = 0; i < 4; ++i) *(u32x4*)(dst + ((tid >> 3) + 32 * i) * KLD + (tid & 7) * 8) = rr.r[i];
  if (halo_next && tid >= 232) *(u32x4*)(halo_next + ((tid >> 3) - 29) * 64 + (tid & 7) * 8) = rr.r[3];
}
DI void conv_from_lds(const u16* raw, const u16* halo, const float* wl, const float* rowscale, float cscale, u32x4 (&out)[4], int tid) {
  const int q = tid >> 3, ch = (tid & 7) * 8;
  u32x4 v[7];
#pragma unroll
  for (int k = 0; k < 7; ++k) { const int r = 4 * q - 3 + k; v[k] = r >= 0 ? *(const u32x4*)(raw + r * KLD + ch) : *(const u32x4*)(halo + (r + 3) * 64 + ch); }
  float w[5][8];
#pragma unroll
  for (int j = 0; j < 5; ++j) { const f32x4 w0 = *(const f32x4*)(wl + j * 64 + ch), w1 = *(const f32x4*)(wl + j * 64 + ch + 4);
    w[j][0] = w0[0]; w[j][1] = w0[1]; w[j][2] = w0[2]; w[j][3] = w0[3]; w[j][4] = w1[0]; w[j][5] = w1[1]; w[j][6] = w1[2]; w[j][7] = w1[3]; }
#pragma unroll
  for (int o = 0; o < 4; ++o) {
    float acc[8];
#pragma unroll
    for (int i = 0; i < 8; ++i) acc[i] = w[4][i];
#pragma unroll
    for (int j = 0; j < 4; ++j) {
      const u32x4 x = v[o + j];
      acc[0] += w[j][0] * bflo(x.x); acc[1] += w[j][1] * bfhi(x.x); acc[2] += w[j][2] * bflo(x.y); acc[3] += w[j][3] * bfhi(x.y);
      acc[4] += w[j][4] * bflo(x.z); acc[5] += w[j][5] * bfhi(x.z); acc[6] += w[j][6] * bflo(x.w); acc[7] += w[j][7] * bfhi(x.w);
    }
    const float rs = (rowscale ? rowscale[4 * q + o] : 1.f) * cscale;
#pragma unroll
    for (int i = 0; i < 8; ++i) acc[i] = siluf(acc[i]) * rs;
    out[o].x = pack2(acc[0], acc[1]); out[o].y = pack2(acc[2], acc[3]); out[o].z = pack2(acc[4], acc[5]); out[o].w = pack2(acc[6], acc[7]);
  }
}
DI void conv_write(u16* dst, const u32x4 (&out)[4], int tid) {
  const int q = tid >> 3, ch = (tid & 7) * 8;
#pragma unroll
  for (int o = 0; o < 4; ++o) *(u32x4*)(dst + (4 * q + o) * KLD + ch) = out[o];
}
DI void stage_conv_w(float* wl, const float* cw, const float* cb, int chan0, int nchan, int tid) {
  for (int i = tid; i < 320; i += 256) { const int j = i >> 6, cc = i & 63; wl[i] = j < 4 ? cw[j * nchan + chan0 + cc] : cb[chan0 + cc]; }
}
DI float wave_scan_add(float x, int lane) {
#pragma unroll
  for (int o = 1; o < 64; o <<= 1) { const float y = __shfl_up(x, o); if (lane >= o) x += y; }
  return x;
}
DI float wave_scan_max(float x, int lane) {
#pragma unroll
  for (int o = 1; o < 64; o <<= 1) { const float y = __shfl_up(x, o); if (lane >= o) x = fmaxf(x, y); }
  return x;
}

DI void ssd_task(const Params& p, int layer, int b, int h, unsigned char* smem) {
  u16* Cs = (u16*)(smem + SEQ_LDS_A); u16* Bs = (u16*)(smem + SEQ_LDS_B); u16* Xs = (u16*)(smem + SEQ_LDS_C); u16* Ss = (u16*)(smem + SEQ_LDS_S);
  float* fl = (float*)(smem + SEQ_LDS_F);
  float* dts = fl; float* acs = fl + 128; float* wend = fl + 256; float* tmp = fl + 384;
  u16* halo = (u16*)(smem + SEQ_LDS_HALO); float* cwl = (float*)(smem + SEQ_LDS_CW);
  int tid = otid(), lane = tid & 63, w = tid >> 6, l15 = lane & 15, g = lane >> 4;
  const int gi = h >> 1;
  const u16* projb = (const u16*)(p.ws + OFF_PROJ) + (size_t)b * SEQ * NP;
  const float* smb = (const float*)(p.ws + OFF_SMALL) + (size_t)b * SEQ * NSMALL;
  const float* cw = p.ssm_conv_w + layer * 4 * 512; const float* cb = p.ssm_conv_b + layer * 512;
  u16* Y = (u16*)(p.ws + OFF_H);
  const float a_h = -__expf(p.ssm_a_log[layer * 4 + h]), d_h = p.ssm_d[layer * 4 + h], dtb = p.ssm_dt_bias[layer * 4 + h];
  const int colB = PC_XBC + 256 + gi * 64, colC = PC_XBC + 384 + gi * 64, colX = PC_XBC + h * 64;
  f32x4 st[4];
#pragma unroll
  for (int nt = 0; nt < 4; ++nt) st[nt] = (f32x4){0.f, 0.f, 0.f, 0.f};
  lds_barrier();
  stage_conv_w(cwl, cw, cb, 256 + gi * 64, 512, tid);
  stage_conv_w(cwl + 320, cw, cb, 384 + gi * 64, 512, tid);
  stage_conv_w(cwl + 640, cw, cb, h * 64, 512, tid);
  for (int i = tid; i < 3 * 3 * 64; i += 256) halo[i] = 0;
  RawRegs rB, rC, rX; float dtraw = 0.f;
  raw_load(projb, colB, 0, rB, tid); raw_load(projb, colC, 0, rC, tid); raw_load(projb, colX, 0, rX, tid);
  if (tid < 128) dtraw = smb[(size_t)tid * NSMALL + SM_DT + h];
#pragma unroll 1
  for (int c = 0; c < 32; ++c) {
    const int t0 = c * 128;
    asm volatile("" : "+v"(tid)); lane = tid & 63; w = tid >> 6; l15 = lane & 15; g = lane >> 4;
    u16* hcur = halo + (c & 1) * 576; u16* hnext = halo + ((c + 1) & 1) * 576;
    float dtv = 0.f;
    if (tid < 128) { const float xr = dtraw + dtb; dtv = xr > 15.f ? xr : __logf(1.f + __expf(xr)); }
    float cs = wave_scan_add(dtv * a_h, lane);
    if (tid == 63) tmp[0] = cs;
    lds_barrier();
    if (w == 1) cs += tmp[0];
    if (tid < 128) { dts[tid] = dtv; acs[tid] = cs; }
    raw_store(Bs, hnext, rB, tid); raw_store(Cs, hnext + 192, rC, tid); raw_store(Xs, hnext + 384, rX, tid);
    lds_barrier();
    if (c + 1 < 32) {
      raw_load(projb, colB, t0 + 128, rB, tid); raw_load(projb, colC, t0 + 128, rC, tid);
      if (tid < 128) dtraw = smb[(size_t)(t0 + 128 + tid) * NSMALL + SM_DT + h];
    }
    {
      u32x4 o1[4], o2[4];
      conv_from_lds(Bs, hcur, cwl, nullptr, 1.f, o1, tid);
      lds_barrier();
      conv_write(Bs, o1, tid);
      conv_from_lds(Cs, hcur + 192, cwl + 320, nullptr, 1.f, o2, tid);
      lds_barrier();
      conv_write(Cs, o2, tid);
      conv_from_lds(Xs, hcur + 384, cwl + 640, dts, 1.f, o1, tid);
      lds_barrier();
      conv_write(Xs, o1, tid);
    }
    if (tid < 128) wend[tid] = __expf(acs[127] - acs[tid]);
    state_to_lds(Ss, st, w, l15, g);
    lds_barrier();
#pragma unroll 1
    for (int qt = 0; qt < 2; ++qt) {
      const int tl = 32 * w + qt * 16 + l15;
      bf16x8 cf[2];
#pragma unroll
      for (int ks = 0; ks < 2; ++ks) cf[ks] = ldfrag(Cs + tl * KLD + ks * 32 + 8 * g);
      f32x4 y[4];
#pragma unroll
      for (int d = 0; d < 4; ++d) y[d] = (f32x4){0.f, 0.f, 0.f, 0.f};
      const float at = acs[tl];
#pragma unroll 1
      for (int stl = 0; stl < 2; ++stl) {
        if (stl * 64 <= 32 * w + qt * 16 + 15) {
          f32x4 sc[4];
          qk_tile1<2>(Bs + stl * 64 * KLD, cf, sc, l15, g);
#pragma unroll
          for (int kt = 0; kt < 4; ++kt) {
            const f32x4 as = *(const f32x4*)(acs + stl * 64 + kt * 16 + 4 * g);
#pragma unroll
            for (int r = 0; r < 4; ++r) {
              const bool ok = stl * 64 + kt * 16 + 4 * g + r <= tl;
              sc[kt][r] = ok ? sc[kt][r] * __expf(at - as[r]) : 0.f;
            }
          }
          pv_accum1(sc, Xs + stl * 64 * KLD, y, l15, g);
        }
      }
      const float ea = __expf(at), dsk = d_h / dts[tl];
      const size_t row = (size_t)b * SEQ + t0 + tl;
#pragma unroll
      for (int d = 0; d < 4; ++d) {
        f32x4 yo = (f32x4){0.f, 0.f, 0.f, 0.f};
#pragma unroll
        for (int ks = 0; ks < 2; ++ks) yo = mfma16(ldfrag(Ss + (d * 16 + l15) * KLD + ks * 32 + 8 * g), cf[ks], yo);
        const u32x2 xv = *(const u32x2*)(Xs + tl * KLD + d * 16 + 4 * g);
        const f32x4 v = y[d] + yo * ea;
        u32x2 o; o.x = pack2(v[0] + dsk * bflo(xv.x), v[1] + dsk * bfhi(xv.x)); o.y = pack2(v[2] + dsk * bflo(xv.y), v[3] + dsk * bfhi(xv.y));
        *(u32x2*)(Y + row * 1024 + Y_C + h * 64 + d * 16 + 4 * g) = o;
      }
    }
    if (c + 1 < 32) raw_load(projb, colX, t0 + 128, rX, tid);
    lds_barrier();
    scale_rows(Xs, wend);
    lds_barrier();
    const float cd = __expf(acs[127]);
#pragma unroll
    for (int nt = 0; nt < 4; ++nt) st[nt] *= cd;
    state_update(Xs, Bs, st, w, l15, g);
  }
}
DI void seq_fix_rows(const Params& p, int layer, int r0, int nrows) {
  u16* Y = (u16*)(p.ws + OFF_H);
  const u16* proj = (const u16*)(p.ws + OFF_PROJ);
  const int tid = otid(), lane = tid & 63, wv = tid >> 6;
  const bool ml = lane >= 32;
  const int ch = (lane & 31) * 8;
  const float* ng = ml ? p.ml_norm_g + layer * 64 + (ch & 63) : p.ssm_norm_g + layer * 256 + ch;
  const f32x4 g0 = *(const f32x4*)ng, g1 = *(const f32x4*)(ng + 4);
  for (int rb = wv * 4; rb < nrows; rb += 16) {
    u32x4 yv4[4], zv4[4], ov4[4];
#pragma unroll
    for (int j = 0; j < 4; ++j) {
      const size_t row = (size_t)(r0 + rb + j);
      yv4[j] = *(const u32x4*)(Y + row * 1024 + (ml ? Y_D : Y_C) + ch);
      zv4[j] = *(const u32x4*)(proj + row * NP + (ml ? PD_Z : PC_Z) + ch);
      ov4[j] = ml ? *(const u32x4*)(proj + row * NP + PD_O + ch) : (u32x4){0u, 0u, 0u, 0u};
    }
#pragma unroll
    for (int j = 0; j < 4; ++j) {
      const size_t row = (size_t)(r0 + rb + j);
      u16* yp = Y + row * 1024 + (ml ? Y_D : Y_C) + ch;
      const u32x4 yv = yv4[j], zv = zv4[j], ov = ov4[j];
      float v[8] = {bflo(yv.x), bfhi(yv.x), bflo(yv.y), bfhi(yv.y), bflo(yv.z), bfhi(yv.z), bflo(yv.w), bfhi(yv.w)};
      float z[8] = {bflo(zv.x), bfhi(zv.x), bflo(zv.y), bfhi(zv.y), bflo(zv.z), bfhi(zv.z), bflo(zv.w), bfhi(zv.w)};
      float ss = 0.f;
      if (ml) {
        const float o[8] = {bflo(ov.x), bfhi(ov.x), bflo(ov.y), bfhi(ov.y), bflo(ov.z), bfhi(ov.z), bflo(ov.w), bfhi(ov.w)};
#pragma unroll
        for (int i = 0; i < 8; ++i) { v[i] *= sigmoidf_(o[i]); ss += v[i] * v[i]; }
      } else {
#pragma unroll
        for (int i = 0; i < 8; ++i) { v[i] *= siluf(z[i]); ss += v[i] * v[i]; }
      }
      ss += __shfl_xor(ss, 1); ss += __shfl_xor(ss, 2); ss += __shfl_xor(ss, 4);
      const float ss16 = ss + __shfl_xor(ss, 8);
      const float rn = ml ? rsqrtf(ss * (1.f / 64.f) + 1e-6f) : rsqrtf(ss16 * (1.f / 128.f) + 1e-6f);
      float o8[8];
#pragma unroll
      for (int i = 0; i < 8; ++i) { const float gg = i < 4 ? g0[i & 3] : g1[i & 3]; o8[i] = v[i] * rn * gg * (ml ? siluf(z[i]) : 1.f); }
      u32x4 w; w.x = pack2(o8[0], o8[1]); w.y = pack2(o8[2], o8[3]); w.z = pack2(o8[4], o8[5]); w.w = pack2(o8[6], o8[7]);
      *(u32x4*)yp = w;
    }
  }
}

DI void mlstm_task(const Params& p, int layer, int b, int h, unsigned char* smem) {
  u16* Qs = (u16*)(smem + SEQ_LDS_A); u16* Ks2 = (u16*)(smem + SEQ_LDS_B); u16* Vs2 = (u16*)(smem + SEQ_LDS_C); u16* Cst = (u16*)(smem + SEQ_LDS_S);
  float* fl = (float*)(smem + SEQ_LDS_F);
  float* bcs = fl; float* us = fl + 128; float* pms = fl + 256; float* wend = fl + 384; float* nst = fl + 512; float* npart = fl + 576; float* tmp = fl + 832;
  u16* halo = (u16*)(smem + SEQ_LDS_HALO); float* cwl = (float*)(smem + SEQ_LDS_CW);
  int tid = otid(), lane = tid & 63, w = tid >> 6, l15 = lane & 15, g = lane >> 4;
  const u16* projb = (const u16*)(p.ws + OFF_PROJ) + (size_t)b * SEQ * NP;
  const float* smb = (const float*)(p.ws + OFF_SMALL) + (size_t)b * SEQ * NSMALL;
  const float* cw = p.ml_conv_w + layer * 4 * 512; const float* cb = p.ml_conv_b + layer * 512;
  const float ib = p.ml_if_b[layer * 8 + h], fb = p.ml_if_b[layer * 8 + 4 + h];
  u16* Y = (u16*)(p.ws + OFF_H);
  const int colQ = PD_QK + h * 64, colK = PD_QK + 256 + h * 64, colV = PD_V + h * 64;
  f32x4 st[4];
#pragma unroll
  for (int nt = 0; nt < 4; ++nt) st[nt] = (f32x4){0.f, 0.f, 0.f, 0.f};
  float m_prev = 0.f;
  lds_barrier();
  if (tid < 64) nst[tid] = 0.f;
  stage_conv_w(cwl, cw, cb, h * 64, 512, tid);
  stage_conv_w(cwl + 320, cw, cb, 256 + h * 64, 512, tid);
  for (int i = tid; i < 3 * 3 * 64; i += 256) halo[i] = 0;
  RawRegs rQ, rK, rV; float iraw = 0.f, fraw = 0.f;
  raw_load(projb, colQ, 0, rQ, tid); raw_load(projb, colK, 0, rK, tid); raw_load(projb, colV, 0, rV, tid);
  if (tid < 128) { iraw = smb[(size_t)tid * NSMALL + SM_IF + h]; fraw = smb[(size_t)tid * NSMALL + SM_IF + 4 + h]; }
#pragma unroll 1
  for (int c = 0; c < 32; ++c) {
    const int t0 = c * 128;
    asm volatile("" : "+v"(tid)); lane = tid & 63; w = tid >> 6; l15 = lane & 15; g = lane >> 4;
    u16* hcur = halo + (c & 1) * 576; u16* hnext = halo + ((c + 1) & 1) * 576;
    float ip = 0.f, lf = 0.f;
    if (tid < 128) { ip = iraw + ib; const float fp = fraw + fb; lf = fminf(fp, 0.f) - __logf(1.f + __expf(-fabsf(fp))); }
    float bc = wave_scan_add(lf, lane);
    if (tid == 63) tmp[0] = bc;
    lds_barrier();
    if (w == 1) bc += tmp[0];
    const float u = tid < 128 ? ip - bc : -1e30f;
    float pm = wave_scan_max(u, lane);
    if (tid == 63) tmp[1] = pm;
    raw_store(Qs, hnext, rQ, tid); raw_store(Ks2, hnext + 192, rK, tid); raw_store(Vs2, nullptr, rV, tid);
    lds_barrier();
    if (w == 1) pm = fmaxf(pm, tmp[1]);
    if (tid < 128) { bcs[tid] = bc; us[tid] = u; pms[tid] = pm; }
    if (c + 1 < 32) {
      raw_load(projb, colQ, t0 + 128, rQ, tid);
      if (tid < 128) { iraw = smb[(size_t)(t0 + 128 + tid) * NSMALL + SM_IF + h]; fraw = smb[(size_t)(t0 + 128 + tid) * NSMALL + SM_IF + 4 + h]; }
    }
    u32x4 oQ[4], oK[4];
    conv_from_lds(Qs, hcur, cwl, nullptr, 1.f, oQ, tid);
    __builtin_amdgcn_sched_barrier(0);
    conv_from_lds(Ks2, hcur + 192, cwl + 320, nullptr, 0.125f, oK, tid);
    __builtin_amdgcn_sched_barrier(0);
    lds_barrier();
    conv_write(Qs, oQ, tid); conv_write(Ks2, oK, tid);
    state_to_lds(Cst, st, w, l15, g);
    const float blast = bcs[127];
    const float m_new = blast + fmaxf(m_prev, pms[127]);
    if (tid < 128) wend[tid] = __expf(blast - m_new + us[tid]);
    lds_barrier();
#pragma unroll 1
    for (int qt = 0; qt < 2; ++qt) {
      const int tl = 32 * w + qt * 16 + l15;
      bf16x8 qf[2];
#pragma unroll
      for (int ks = 0; ks < 2; ++ks) qf[ks] = ldfrag(Qs + tl * KLD + ks * 32 + 8 * g);
      f32x4 num[4];
#pragma unroll
      for (int d = 0; d < 4; ++d) num[d] = (f32x4){0.f, 0.f, 0.f, 0.f};
      const float bt = bcs[tl], mt = bt + fmaxf(m_prev, pms[tl]);
      float den = 0.f;
#pragma unroll 1
      for (int stl = 0; stl < 2; ++stl) {
        if (stl * 64 <= 32 * w + qt * 16 + 15) {
          f32x4 sc[4];
          qk_tile1<2>(Ks2 + stl * 64 * KLD, qf, sc, l15, g);
#pragma unroll
          for (int kt = 0; kt < 4; ++kt) {
            const f32x4 uu = *(const f32x4*)(us + stl * 64 + kt * 16 + 4 * g);
#pragma unroll
            for (int r = 0; r < 4; ++r) {
              const bool ok = stl * 64 + kt * 16 + 4 * g + r <= tl;
              const float v = ok ? sc[kt][r] * __expf(bt - mt + uu[r]) : 0.f;
              sc[kt][r] = v; den += v;
            }
          }
          pv_accum1(sc, Vs2 + stl * 64 * KLD, num, l15, g);
        }
      }
      const float wi = __expf(bt + m_prev - mt);
      float qn = 0.f;
#pragma unroll
      for (int ks = 0; ks < 2; ++ks)
#pragma unroll
        for (int j = 0; j < 8; ++j) qn += bf2f((u16)qf[ks][j]) * nst[ks * 32 + 8 * g + j];
      qn = group_sum4(qn);
      const float dn = group_sum4(den) + wi * qn;
      const float inv = __builtin_amdgcn_rcpf(fmaxf(fabsf(dn), __expf(-mt)));
      const size_t row = (size_t)b * SEQ + t0 + tl;
#pragma unroll
      for (int d = 0; d < 4; ++d) {
        f32x4 ni = (f32x4){0.f, 0.f, 0.f, 0.f};
#pragma unroll
        for (int ks = 0; ks < 2; ++ks) ni = mfma16(ldfrag(Cst + (d * 16 + l15) * KLD + ks * 32 + 8 * g), qf[ks], ni);
        const f32x4 v = (num[d] + ni * wi) * inv;
        u32x2 o; o.x = pack2(v[0], v[1]); o.y = pack2(v[2], v[3]);
        *(u32x2*)(Y + row * 1024 + Y_D + h * 64 + d * 16 + 4 * g) = o;
      }
    }
    if (c + 1 < 32) { raw_load(projb, colK, t0 + 128, rK, tid); raw_load(projb, colV, t0 + 128, rV, tid); }
    lds_barrier();
    scale_rows(Ks2, wend);
    lds_barrier();
    const float fprev = __expf(blast + m_prev - m_new);
#pragma unroll
    for (int nt = 0; nt < 4; ++nt) st[nt] *= fprev;
    state_update(Vs2, Ks2, st, w, l15, g);
    {
      const int e = tid & 63, part = tid >> 6;
      float a = 0.f;
      for (int s2 = part * 32; s2 < part * 32 + 32; ++s2) a += bf2f(Ks2[s2 * KLD + e]);
      npart[part * 64 + e] = a;
    }
    lds_barrier();
    if (tid < 64) nst[tid] = nst[tid] * fprev + npart[tid] + npart[64 + tid] + npart[128 + tid] + npart[192 + tid];
    m_prev = m_new;
  }
}

constexpr int SEQ8_LDS_F = SEQ_LDS_S + 64 * KLD * 2;
constexpr int SEQ8_LDS_HALO = SEQ8_LDS_F + 8192;
constexpr int SEQ8_LDS_CW = SEQ8_LDS_HALO + 2 * 3 * 3 * 64 * 2;
struct RawRegs2 { u32x4 r[2]; };
DI void raw_load8(const u16* projb, int col0, int t0, RawRegs2& rr, int tid) {
#pragma unroll
  for (int i = 0; i < 2; ++i) rr.r[i] = *(const u32x4*)(projb + (size_t)(t0 + (tid >> 3) + 64 * i) * NP + col0 + (tid & 7) * 8);
}
DI void raw_store8(u16* dst, u16* halo_next, const RawRegs2& rr, int tid) {
#pragma unroll
  for (int i = 0; i < 2; ++i) *(u32x4*)(dst + ((tid >> 3) + 64 * i) * KLD + (tid & 7) * 8) = rr.r[i];
  if (halo_next && tid >= 488) *(u32x4*)(halo_next + ((tid >> 3) - 61) * 64 + (tid & 7) * 8) = rr.r[1];
}
DI void conv_from_lds8(const u16* raw, const u16* halo, const float* wl, const float* rowscale, float cscale, u32x4 (&out)[2], int tid) {
  const int q = tid >> 3, ch = (tid & 7) * 8;
  u32x4 v[5];
#pragma unroll
  for (int k = 0; k < 5; ++k) { const int r = 2 * q - 3 + k; v[k] = r >= 0 ? *(const u32x4*)(raw + r * KLD + ch) : *(const u32x4*)(halo + (r + 3) * 64 + ch); }
  float w[5][8];
#pragma unroll
  for (int j = 0; j < 5; ++j) { const f32x4 w0 = *(const f32x4*)(wl + j * 64 + ch), w1 = *(const f32x4*)(wl + j * 64 + ch + 4);
    w[j][0] = w0[0]; w[j][1] = w0[1]; w[j][2] = w0[2]; w[j][3] = w0[3]; w[j][4] = w1[0]; w[j][5] = w1[1]; w[j][6] = w1[2]; w[j][7] = w1[3]; }
#pragma unroll
  for (int o = 0; o < 2; ++o) {
    float acc[8];
#pragma unroll
    for (int i = 0; i < 8; ++i) acc[i] = w[4][i];
#pragma unroll
    for (int j = 0; j < 4; ++j) {
      const u32x4 x = v[o + j];
      acc[0] += w[j][0] * bflo(x.x); acc[1] += w[j][1] * bfhi(x.x); acc[2] += w[j][2] * bflo(x.y); acc[3] += w[j][3] * bfhi(x.y);
      acc[4] += w[j][4] * bflo(x.z); acc[5] += w[j][5] * bfhi(x.z); acc[6] += w[j][6] * bflo(x.w); acc[7] += w[j][7] * bfhi(x.w);
    }
    const float rs = (rowscale ? rowscale[2 * q + o] : 1.f) * cscale;
#pragma unroll
    for (int i = 0; i < 8; ++i) acc[i] = siluf(acc[i]) * rs;
    out[o].x = pack2(acc[0], acc[1]); out[o].y = pack2(acc[2], acc[3]); out[o].z = pack2(acc[4], acc[5]); out[o].w = pack2(acc[6], acc[7]);
  }
}
DI void conv_write8(u16* dst, const u32x4 (&out)[2], int tid) {
  const int q = tid >> 3, ch = (tid & 7) * 8;
#pragma unroll
  for (int o = 0; o < 2; ++o) *(u32x4*)(dst + (2 * q + o) * KLD + ch) = out[o];
}
DI void stage_conv_w8(float* wl, const float* cw, const float* cb, int chan0, int nchan, int tid) {
  if (tid < 320) { const int j = tid >> 6, cc = tid & 63; wl[tid] = j < 4 ? cw[j * nchan + chan0 + cc] : cb[chan0 + cc]; }
}
DI void scale_rows8(u16* A, const float* rs, int tid) {
  const int ch = (tid & 7) * 8;
#pragma unroll
  for (int i = 0; i < 2; ++i) {
    const int row = (tid >> 3) + 64 * i;
    const float f = rs[row];
    u32x4 v = *(u32x4*)(A + row * KLD + ch);
    v.x = pack2(bflo(v.x) * f, bfhi(v.x) * f); v.y = pack2(bflo(v.y) * f, bfhi(v.y) * f);
    v.z = pack2(bflo(v.z) * f, bfhi(v.z) * f); v.w = pack2(bflo(v.w) * f, bfhi(v.w) * f);
    *(u32x4*)(A + row * KLD + ch) = v;
  }
}
DI void state_update8(const u16* Xs, const u16* Bs, f32x4 (&acc)[2], int w8, int l15, int g) {
  const int tq = l15 >> 2, tp = l15 & 3, pt = w8 >> 1, nt0 = (w8 & 1) * 2;
#pragma unroll
  for (int kk = 0; kk < 4; ++kk) {
    const bf16x8 af = cat4(tr_read(Xs + (kk * 32 + 4 * g + tq) * KLD + pt * 16 + 4 * tp), tr_read(Xs + (kk * 32 + 16 + 4 * g + tq) * KLD + pt * 16 + 4 * tp));
#pragma unroll
    for (int n = 0; n < 2; ++n) {
      const bf16x8 bfr = cat4(tr_read(Bs + (kk * 32 + 4 * g + tq) * KLD + (nt0 + n) * 16 + 4 * tp), tr_read(Bs + (kk * 32 + 16 + 4 * g + tq) * KLD + (nt0 + n) * 16 + 4 * tp));
      acc[n] = mfma16(af, bfr, acc[n]);
    }
  }
}
DI void state_to_lds8(u16* Ss, const f32x4 (&acc)[2], int w8, int l15, int g) {
  const int pt = w8 >> 1, nt0 = (w8 & 1) * 2;
#pragma unroll
  for (int n = 0; n < 2; ++n)
#pragma unroll
    for (int r = 0; r < 4; ++r) Ss[(pt * 16 + 4 * g + r) * KLD + (nt0 + n) * 16 + l15] = f2bf(acc[n][r]);
}

constexpr int SEQ8_LDS_ZERO = SEQ8_LDS_CW + 3 * 320 * 4;
constexpr int SEQ8_LDS_RAW = ((SEQ8_LDS_ZERO + 3 * 128 + 255) / 256) * 256;
DI void raw_dma8(const u16* projb, int col0, int t0, u16* raw, int tid) {
#pragma unroll
  for (int i = 0; i < 2; ++i) {
    const int chunk = tid + 512 * i;
    __builtin_amdgcn_global_load_lds((const unsigned*)(projb + (size_t)(t0 + (chunk >> 3)) * NP + col0 + (chunk & 7) * 8), (LDSP unsigned*)((LDSP char*)raw + chunk * 16), 16, 0, 0);
  }
}
DI void conv_raw8(const u16* raw, const u16* halo, const float* wl, const float* rowscale, float cscale, u16* dst, int tid) {
  const int q = tid >> 3, ch = (tid & 7) * 8;
  u32x4 v[5];
#pragma unroll
  for (int k = 0; k < 5; ++k) { const int r = 2 * q - 3 + k; v[k] = r >= 0 ? *(const u32x4*)(raw + r * 64 + ch) : *(const u32x4*)(halo + (r + 3) * 64 + ch); }
  float w[5][8];
#pragma unroll
  for (int j = 0; j < 5; ++j) { const f32x4 w0 = *(const f32x4*)(wl + j * 64 + ch), w1 = *(const f32x4*)(wl + j * 64 + ch + 4);
    w[j][0] = w0[0]; w[j][1] = w0[1]; w[j][2] = w0[2]; w[j][3] = w0[3]; w[j][4] = w1[0]; w[j][5] = w1[1]; w[j][6] = w1[2]; w[j][7] = w1[3]; }
#pragma unroll
  for (int o = 0; o < 2; ++o) {
    float acc[8];
#pragma unroll
    for (int i = 0; i < 8; ++i) acc[i] = w[4][i];
#pragma unroll
    for (int j = 0; j < 4; ++j) {
      const u32x4 x = v[o + j];
      acc[0] += w[j][0] * bflo(x.x); acc[1] += w[j][1] * bfhi(x.x); acc[2] += w[j][2] * bflo(x.y); acc[3] += w[j][3] * bfhi(x.y);
      acc[4] += w[j][4] * bflo(x.z); acc[5] += w[j][5] * bfhi(x.z); acc[6] += w[j][6] * bflo(x.w); acc[7] += w[j][7] * bfhi(x.w);
    }
    const float rs = (rowscale ? rowscale[2 * q + o] : 1.f) * cscale;
#pragma unroll
    for (int i = 0; i < 8; ++i) acc[i] = siluf(acc[i]) * rs;
    u32x4 ov; ov.x = pack2(acc[0], acc[1]); ov.y = pack2(acc[2], acc[3]); ov.z = pack2(acc[4], acc[5]); ov.w = pack2(acc[6], acc[7]);
    *(u32x4*)(dst + (2 * q + o) * KLD + ch) = ov;
  }
}
DI void save_halo8(const u16* raw, u16* halo, int tid) {
  if (tid < 72) { const int arr = tid / 24, rem = tid % 24; *(u32x4*)(halo + arr * 192 + rem * 8) = *(const u32x4*)(raw + arr * 8192 + 125 * 64 + rem * 8); }
}

DI void ssd_task8(const Params& p, int layer, int b, int h, unsigned char* smem) {
  u16* Cs = (u16*)(smem + SEQ_LDS_A); u16* Bs = (u16*)(smem + SEQ_LDS_B); u16* Xs = (u16*)(smem + SEQ_LDS_C); u16* Ss = (u16*)(smem + SEQ_LDS_S);
  float* fl = (float*)(smem + SEQ8_LDS_F);
  float* dts = fl; float* acs = fl + 128; float* wend = fl + 256; float* tmp = fl + 384;
  u16* halo = (u16*)(smem + SEQ8_LDS_HALO); float* cwl = (float*)(smem + SEQ8_LDS_CW); u16* zero3 = (u16*)(smem + SEQ8_LDS_ZERO);
  u16* raw = (u16*)(smem + SEQ8_LDS_RAW);
  int tid = otid512(), lane = tid & 63, w = tid >> 6, l15 = lane & 15, g = lane >> 4;
  const int gi = h >> 1;
  const u16* projb = (const u16*)(p.ws + OFF_PROJ) + (size_t)b * SEQ * NP;
  const float* smb = (const float*)(p.ws + OFF_SMALL) + (size_t)b * SEQ * NSMALL;
  const float* cw = p.ssm_conv_w + layer * 4 * 512; const float* cb = p.ssm_conv_b + layer * 512;
  u16* Y = (u16*)(p.ws + OFF_H);
  const float a_h = sgprf(-__expf(p.ssm_a_log[layer * 4 + h])), d_h = sgprf(p.ssm_d[layer * 4 + h]), dtb = sgprf(p.ssm_dt_bias[layer * 4 + h]);
  const int colB = PC_XBC + 256 + gi * 64, colC = PC_XBC + 384 + gi * 64, colX = PC_XBC + h * 64;
  f32x4 st[2] = {(f32x4){0.f, 0.f, 0.f, 0.f}, (f32x4){0.f, 0.f, 0.f, 0.f}};
  lds_barrier();
  stage_conv_w8(cwl, cw, cb, 256 + gi * 64, 512, tid);
  stage_conv_w8(cwl + 320, cw, cb, 384 + gi * 64, 512, tid);
  stage_conv_w8(cwl + 640, cw, cb, h * 64, 512, tid);
  if (tid < 96) ((unsigned*)zero3)[tid] = 0u;
  raw_dma8(projb, colB, 0, raw, tid); raw_dma8(projb, colC, 0, raw + 8192, tid); raw_dma8(projb, colX, 0, raw + 16384, tid);
  float dtraw = 0.f;
  if (tid < 128) dtraw = smb[(size_t)tid * NSMALL + SM_DT + h];
#pragma unroll 1
  for (int c = 0; c < 32; ++c) {
    const int t0 = c * 128;
    asm volatile("" : "+v"(tid)); lane = tid & 63; w = tid >> 6; l15 = lane & 15; g = lane >> 4;
    float dtv = 0.f;
    if (tid < 128) { const float xr = dtraw + dtb; dtv = xr > 15.f ? xr : __logf(1.f + __expf(xr)); }
    float cs = wave_scan_add(dtv * a_h, lane);
    if (tid == 63) tmp[0] = cs;
    asm volatile("s_waitcnt vmcnt(0)" ::: "memory");
    lds_barrier();
    if (w == 1) cs += tmp[0];
    if (tid < 128) { dts[tid] = dtv; acs[tid] = cs; }
    if (c + 1 < 32 && tid < 128) dtraw = smb[(size_t)(t0 + 128 + tid) * NSMALL + SM_DT + h];
    lds_barrier();
    {
      const u16* hc = halo + (c & 1) * 576;
      const u16* hB = c == 0 ? zero3 : hc; const u16* hC = c == 0 ? zero3 : hc + 192; const u16* hX = c == 0 ? zero3 : hc + 384;
      conv_raw8(raw, hB, cwl, nullptr, 1.f, Bs, tid);
      conv_raw8(raw + 8192, hC, cwl + 320, nullptr, 1.f, Cs, tid);
      conv_raw8(raw + 16384, hX, cwl + 640, dts, 1.f, Xs, tid);
      save_halo8(raw, halo + ((c + 1) & 1) * 576, tid);
    }
    if (tid < 128) wend[tid] = __expf(acs[127] - acs[tid]);
    state_to_lds8(Ss, st, w, l15, g);
    lds_barrier();
    if (c + 1 < 32) { raw_dma8(projb, colB, t0 + 128, raw, tid); raw_dma8(projb, colC, t0 + 128, raw + 8192, tid); raw_dma8(projb, colX, t0 + 128, raw + 16384, tid); }
    {
      const int tl = 16 * w + l15;
      bf16x8 cf[2];
#pragma unroll
      for (int ks = 0; ks < 2; ++ks) cf[ks] = ldfrag(Cs + tl * KLD + ks * 32 + 8 * g);
      f32x4 y[4];
#pragma unroll
      for (int d = 0; d < 4; ++d) y[d] = (f32x4){0.f, 0.f, 0.f, 0.f};
      const float at = acs[tl];
#pragma unroll 1
      for (int stl = 0; stl < 2; ++stl) {
        if (stl * 64 <= 16 * w + 15) {
          f32x4 sc[4];
          qk_tile1<2>(Bs + stl * 64 * KLD, cf, sc, l15, g);
#pragma unroll
          for (int kt = 0; kt < 4; ++kt) {
            const f32x4 as = *(const f32x4*)(acs + stl * 64 + kt * 16 + 4 * g);
#pragma unroll
            for (int r = 0; r < 4; ++r) {
              const bool ok = stl * 64 + kt * 16 + 4 * g + r <= tl;
              sc[kt][r] = ok ? sc[kt][r] * __expf(at - as[r]) : 0.f;
            }
          }
          pv_accum1(sc, Xs + stl * 64 * KLD, y, l15, g);
        }
      }
      const float ea = __expf(at), dsk = d_h / dts[tl];
      const size_t row = (size_t)b * SEQ + t0 + tl;
#pragma unroll
      for (int d = 0; d < 4; ++d) {
        f32x4 yo = (f32x4){0.f, 0.f, 0.f, 0.f};
#pragma unroll
        for (int ks = 0; ks < 2; ++ks) yo = mfma16(ldfrag(Ss + (d * 16 + l15) * KLD + ks * 32 + 8 * g), cf[ks], yo);
        const u32x2 xv = *(const u32x2*)(Xs + tl * KLD + d * 16 + 4 * g);
        const f32x4 v = y[d] + yo * ea;
        u32x2 o; o.x = pack2(v[0] + dsk * bflo(xv.x), v[1] + dsk * bfhi(xv.x)); o.y = pack2(v[2] + dsk * bflo(xv.y), v[3] + dsk * bfhi(xv.y));
        *(u32x2*)(Y + row * 1024 + Y_C + h * 64 + d * 16 + 4 * g) = o;
      }
    }
    lds_barrier();
    scale_rows8(Xs, wend, tid);
    lds_barrier();
    const float cd = __expf(acs[127]);
    st[0] *= cd; st[1] *= cd;
    state_update8(Xs, Bs, st, w, l15, g);
  }
  asm volatile("s_waitcnt vmcnt(0)" ::: "memory");
}

DI void mlstm_task8(const Params& p, int layer, int b, int h, unsigned char* smem) {
  u16* Qs = (u16*)(smem + SEQ_LDS_A); u16* Ks2 = (u16*)(smem + SEQ_LDS_B); u16* Vs2 = (u16*)(smem + SEQ_LDS_C); u16* Cst = (u16*)(smem + SEQ_LDS_S);
  float* fl = (float*)(smem + SEQ8_LDS_F);
  float* bcs = fl; float* us = fl + 128; float* pms = fl + 256; float* wend = fl + 384; float* nst = fl + 512; float* tmp = fl + 576; float* npart = fl + 640;
  u16* halo = (u16*)(smem + SEQ8_LDS_HALO); float* cwl = (float*)(smem + SEQ8_LDS_CW); u16* zero3 = (u16*)(smem + SEQ8_LDS_ZERO);
  u16* raw = (u16*)(smem + SEQ8_LDS_RAW);
  int tid = otid512(), lane = tid & 63, w = tid >> 6, l15 = lane & 15, g = lane >> 4;
  const u16* projb = (const u16*)(p.ws + OFF_PROJ) + (size_t)b * SEQ * NP;
  const float* smb = (const float*)(p.ws + OFF_SMALL) + (size_t)b * SEQ * NSMALL;
  const float* cw = p.ml_conv_w + layer * 4 * 512; const float* cb = p.ml_conv_b + layer * 512;
  const float ib = sgprf(p.ml_if_b[layer * 8 + h]), fb = sgprf(p.ml_if_b[layer * 8 + 4 + h]);
  u16* Y = (u16*)(p.ws + OFF_H);
  const int colQ = PD_QK + h * 64, colK = PD_QK + 256 + h * 64, colV = PD_V + h * 64;
  f32x4 st[2] = {(f32x4){0.f, 0.f, 0.f, 0.f}, (f32x4){0.f, 0.f, 0.f, 0.f}};
  float m_prev = 0.f;
  lds_barrier();
  if (tid < 64) nst[tid] = 0.f;
  stage_conv_w8(cwl, cw, cb, h * 64, 512, tid);
  stage_conv_w8(cwl + 320, cw, cb, 256 + h * 64, 512, tid);
  if (tid < 96) ((unsigned*)zero3)[tid] = 0u;
  raw_dma8(projb, colQ, 0, raw, tid); raw_dma8(projb, colK, 0, raw + 8192, tid); raw_dma8(projb, colV, 0, raw + 16384, tid);
  float iraw = 0.f, fraw = 0.f;
  if (tid < 128) { iraw = smb[(size_t)tid * NSMALL + SM_IF + h]; fraw = smb[(size_t)tid * NSMALL + SM_IF + 4 + h]; }
#pragma unroll 1
  for (int c = 0; c < 32; ++c) {
    const int t0 = c * 128;
    asm volatile("" : "+v"(tid)); lane = tid & 63; w = tid >> 6; l15 = lane & 15; g = lane >> 4;
    float ip = 0.f, lf = 0.f;
    if (tid < 128) { ip = iraw + ib; const float fp = fraw + fb; lf = fminf(fp, 0.f) - __logf(1.f + __expf(-fabsf(fp))); }
    float bc = wave_scan_add(lf, lane);
    if (tid == 63) tmp[0] = bc;
    asm volatile("s_waitcnt vmcnt(0)" ::: "memory");
    lds_barrier();
    if (w == 1) bc += tmp[0];
    const float u = tid < 128 ? ip - bc : -1e30f;
    float pm = wave_scan_max(u, lane);
    if (tid == 63) tmp[1] = pm;
    if (c + 1 < 32 && tid < 128) { iraw = smb[(size_t)(t0 + 128 + tid) * NSMALL + SM_IF + h]; fraw = smb[(size_t)(t0 + 128 + tid) * NSMALL + SM_IF + 4 + h]; }
    {
      const u16* hc = halo + (c & 1) * 576;
      const u16* hQ = c == 0 ? zero3 : hc; const u16* hK = c == 0 ? zero3 : hc + 192;
      conv_raw8(raw, hQ, cwl, nullptr, 1.f, Qs, tid);
      conv_raw8(raw + 8192, hK, cwl + 320, nullptr, 0.125f, Ks2, tid);
      save_halo8(raw, halo + ((c + 1) & 1) * 576, tid);
#pragma unroll
      for (int i = 0; i < 2; ++i) { const int chunk = tid + 512 * i; *(u32x4*)(Vs2 + (chunk >> 3) * KLD + (chunk & 7) * 8) = *(const u32x4*)(raw + 16384 + chunk * 8); }
    }
    state_to_lds8(Cst, st, w, l15, g);
    lds_barrier();
    if (w == 1) pm = fmaxf(pm, tmp[1]);
    if (tid < 128) { bcs[tid] = bc; us[tid] = u; pms[tid] = pm; }
    if (c + 1 < 32) { raw_dma8(projb, colQ, t0 + 128, raw, tid); raw_dma8(projb, colK, t0 + 128, raw + 8192, tid); raw_dma8(projb, colV, t0 + 128, raw + 16384, tid); }
    lds_barrier();
    const float blast = bcs[127];
    const float m_new = blast + fmaxf(m_prev, pms[127]);
    if (tid < 128) wend[tid] = __expf(blast - m_new + us[tid]);
    {
      const int tl = 16 * w + l15;
      bf16x8 qf[2];
#pragma unroll
      for (int ks = 0; ks < 2; ++ks) qf[ks] = ldfrag(Qs + tl * KLD + ks * 32 + 8 * g);
      f32x4 num[4];
#pragma unroll
      for (int d = 0; d < 4; ++d) num[d] = (f32x4){0.f, 0.f, 0.f, 0.f};
      const float bt = bcs[tl], mt = bt + fmaxf(m_prev, pms[tl]);
      float den = 0.f;
#pragma unroll 1
      for (int stl = 0; stl < 2; ++stl) {
        if (stl * 64 <= 16 * w + 15) {
          f32x4 sc[4];
          qk_tile1<2>(Ks2 + stl * 64 * KLD, qf, sc, l15, g);
#pragma unroll
          for (int kt = 0; kt < 4; ++kt) {
            const f32x4 uu = *(const f32x4*)(us + stl * 64 + kt * 16 + 4 * g);
#pragma unroll
            for (int r = 0; r < 4; ++r) {
              const bool ok = stl * 64 + kt * 16 + 4 * g + r <= tl;
              const float v = ok ? sc[kt][r] * __expf(bt - mt + uu[r]) : 0.f;
              sc[kt][r] = v; den += v;
            }
          }
          pv_accum1(sc, Vs2 + stl * 64 * KLD, num, l15, g);
        }
      }
      const float wi = __expf(bt + m_prev - mt);
      float qn = 0.f;
#pragma unroll
      for (int ks = 0; ks < 2; ++ks)
#pragma unroll
        for (int j = 0; j < 8; ++j) qn += bf2f((u16)qf[ks][j]) * nst[ks * 32 + 8 * g + j];
      qn = group_sum4(qn);
      const float dn = group_sum4(den) + wi * qn;
      const float inv = __builtin_amdgcn_rcpf(fmaxf(fabsf(dn), __expf(-mt)));
      const size_t row = (size_t)b * SEQ + t0 + tl;
#pragma unroll
      for (int d = 0; d < 4; ++d) {
        f32x4 ni = (f32x4){0.f, 0.f, 0.f, 0.f};
#pragma unroll
        for (int ks = 0; ks < 2; ++ks) ni = mfma16(ldfrag(Cst + (d * 16 + l15) * KLD + ks * 32 + 8 * g), qf[ks], ni);
        const f32x4 v = (num[d] + ni * wi) * inv;
        u32x2 o; o.x = pack2(v[0], v[1]); o.y = pack2(v[2], v[3]);
        *(u32x2*)(Y + row * 1024 + Y_D + h * 64 + d * 16 + 4 * g) = o;
      }
    }
    lds_barrier();
    scale_rows8(Ks2, wend, tid);
    lds_barrier();
    const float fprev = __expf(blast + m_prev - m_new);
    st[0] *= fprev; st[1] *= fprev;
    state_update8(Vs2, Ks2, st, w, l15, g);
    {
      const int e = tid & 63, part = tid >> 6;
      float a = 0.f;
#pragma unroll
      for (int s2 = 0; s2 < 16; ++s2) a += bf2f(Ks2[(part * 16 + s2) * KLD + e]);
      npart[part * 64 + e] = a;
    }
    lds_barrier();
    if (tid < 64) {
      float a = nst[tid] * fprev;
#pragma unroll
      for (int pp = 0; pp < 8; ++pp) a += npart[pp * 64 + tid];
      nst[tid] = a;
    }
    m_prev = m_new;
  }
  asm volatile("s_waitcnt vmcnt(0)" ::: "memory");
}

DI void compress_task(const Params& p, int layer, int b, int kv, int rb, unsigned char* smem) {
  constexpr int HLD = 136;
  u16* Hs = (u16*)smem;
  const int tid = otid(), lane = tid & 63, w = tid >> 6, l15 = lane & 15, g = lane >> 4;
  const u16* projb = (const u16*)(p.ws + OFF_PROJ) + (size_t)b * SEQ * NP + (kv ? PA_VC : PA_KC);
  const int mi = layer * 2 + kv;
  const u16* W1T = (const u16*)(p.ws + OFF_W1T) + (size_t)mi * 128 * 2048;
  const u16* W2T = (const u16*)(p.ws + OFF_W2T) + (size_t)mi * 64 * 128;
  const float* bias1 = (const float*)(p.ws + OFF_BIAS1) + mi * 16 * 128;
  f32x4 acc[2][2];
#pragma unroll
  for (int nt = 0; nt < 2; ++nt) { acc[nt][0] = (f32x4){0.f, 0.f, 0.f, 0.f}; acc[nt][1] = (f32x4){0.f, 0.f, 0.f, 0.f}; }
  int tok[2];
#pragma unroll
  for (int mt = 0; mt < 2; ++mt) { int i = rb * 32 + mt * 16 + l15; if (i > 254) i = 254; tok[mt] = 16 * i; }
#pragma unroll 4
  for (int ks = 0; ks < 64; ++ks) {
    const int j = ks >> 1, d0 = (ks & 1) * 32;
    bf16x8 af[2], wf[2];
#pragma unroll
    for (int mt = 0; mt < 2; ++mt) af[mt] = ldfrag(projb + (size_t)(tok[mt] + j) * NP + d0 + 8 * g);
#pragma unroll
    for (int nt = 0; nt < 2; ++nt) wf[nt] = ldfrag(W1T + (size_t)(w * 32 + nt * 16 + l15) * 2048 + ks * 32 + 8 * g);
#pragma unroll
    for (int nt = 0; nt < 2; ++nt)
#pragma unroll
      for (int mt = 0; mt < 2; ++mt) acc[nt][mt] = mfma16(wf[nt], af[mt], acc[nt][mt]);
  }
  lds_barrier();
#pragma unroll
  for (int nt = 0; nt < 2; ++nt) {
    const int n = w * 32 + nt * 16 + 4 * g;
    f32x4 bb = *(const f32x4*)(bias1 + n);
#pragma unroll
    for (int pc = 1; pc < 16; ++pc) bb += *(const f32x4*)(bias1 + pc * 128 + n);
#pragma unroll
    for (int mt = 0; mt < 2; ++mt) {
      const f32x4 v = acc[nt][mt] + bb;
      u32x2 o; o.x = pack2(siluf(v[0]), siluf(v[1])); o.y = pack2(siluf(v[2]), siluf(v[3]));
      *(u32x2*)(Hs + (mt * 16 + l15) * HLD + n) = o;
    }
  }
  lds_barrier();
  f32x4 acc2[2] = {(f32x4){0.f, 0.f, 0.f, 0.f}, (f32x4){0.f, 0.f, 0.f, 0.f}};
#pragma unroll
  for (int ks = 0; ks < 4; ++ks) {
    const bf16x8 wf = ldfrag(W2T + (size_t)(w * 16 + l15) * 128 + ks * 32 + 8 * g);
#pragma unroll
    for (int mt = 0; mt < 2; ++mt) acc2[mt] = mfma16(wf, ldfrag(Hs + (mt * 16 + l15) * HLD + ks * 32 + 8 * g), acc2[mt]);
  }
  u16* dst = (u16*)(p.ws + (kv ? OFF_VCMP : OFF_KCMP) + (size_t)layer * 512 * 1024) + (size_t)b * 256 * 64;
#pragma unroll
  for (int mt = 0; mt < 2; ++mt) {
    const int i = rb * 32 + mt * 16 + l15;
    u32x2 o; o.x = pack2(acc2[mt][0], acc2[mt][1]); o.y = pack2(acc2[mt][2], acc2[mt][3]);
    if (i > 254) { o.x = 0u; o.y = 0u; }
    *(u32x2*)(dst + (size_t)i * 64 + w * 16 + 4 * g) = o;
  }
}

DI void nsa_task(const Params& p, int layer, int b, int qi, unsigned char* smem) {
  u16* Ks = (u16*)smem; u16* Vs = Ks + 64 * KLD;
  float* T = (float*)(smem + 2 * KVBUF * 2);
  unsigned long long* selm = (unsigned long long*)(smem + 2 * KVBUF * 2 + 4 * 32 * 65 * 4);
  const int tid = otid(), lane = tid & 63, h = tid >> 6, l15 = lane & 15, g = lane >> 4;
  const int q0 = qi * 32;
  const u16* projb = (const u16*)(p.ws + OFF_PROJ) + (size_t)b * SEQ * NP;
  const float* smb = (const float*)(p.ws + OFF_SMALL) + (size_t)b * SEQ * NSMALL;
  const u16* kcmp = (const u16*)(p.ws + OFF_KCMP + (size_t)layer * 512 * 1024) + (size_t)b * 256 * 64;
  const u16* vcmp = (const u16*)(p.ws + OFF_VCMP + (size_t)layer * 512 * 1024) + (size_t)b * 256 * 64;
  bf16x8 qf[2][2];
#pragma unroll
  for (int qt = 0; qt < 2; ++qt)
#pragma unroll
    for (int ks = 0; ks < 2; ++ks) qf[qt][ks] = ldfrag(projb + (size_t)(q0 + qt * 16 + l15) * NP + PA_Q + h * 64 + ks * 32 + 8 * g);
  const float sc = 0.125f * 1.4426950408889634f;
  f32x4 outacc[4][2];
  AttnAcc a;
  const int ntc = (q0 >> 10) + 1;
  attn_init(a);
  lds_barrier();
  for (int i = tid; i < 4 * 32 * 65; i += 256) T[i] = 0.f;
  kv_pipeline(0, ntc, Ks,
    [&](int) { return true; },
    [&](int j, KVRegs& kr) { kv_load(kcmp, vcmp, 64, 64, j * 64, kr); },
    [&](int j, const u16* Kt, const u16* Vt) {
      f32x4 s[4][2];
      auto valid = [&](int kt, int r, int qt) { return 16 * (j * 64 + kt * 16 + 4 * g + r) + 31 <= q0 + qt * 16 + l15; };
      qk_tile<2>(Kt, 0, qf, s, l15, g);
      softmax_pv(s, a, Vt, sc, l15, g, valid);
    });
  float cinv[2];
#pragma unroll
  for (int qt = 0; qt < 2; ++qt) {
    const float lt = group_sum4(a.l[qt]);
    cinv[qt] = lt > 0.f ? 1.f / lt : 0.f;
    const float gt = sigmoidf_(smb[(size_t)(q0 + qt * 16 + l15) * NSMALL + SM_G + h * 3 + 0]) * cinv[qt];
#pragma unroll
    for (int d = 0; d < 4; ++d) outacc[d][qt] = a.o[d][qt] * gt;
  }
  float carry[2] = {0.f, 0.f};
  kv_pipeline(0, ntc, Ks,
    [&](int) { return true; },
    [&](int j, KVRegs& kr) { kv_load(kcmp, vcmp, 64, 64, j * 64, kr); },
    [&](int j, const u16* Kt, const u16*) {
      f32x4 s[4][2];
      qk_tile<2>(Kt, 0, qf, s, l15, g);
#pragma unroll
      for (int qt = 0; qt < 2; ++qt) {
        float prev3 = carry[qt];
#pragma unroll
        for (int kt = 0; kt < 4; ++kt) {
          float pr[4];
#pragma unroll
          for (int r = 0; r < 4; ++r) {
            const bool ok = 16 * (j * 64 + kt * 16 + 4 * g + r) + 31 <= q0 + qt * 16 + l15;
            pr[r] = ok ? exp2_(s[kt][qt][r] * sc - a.m[qt]) * cinv[qt] : 0.f;
          }
          const float below = __shfl_up(pr[3], 16);
          const float wrap = __shfl(prev3, l15 + 48);
          const float nb = g > 0 ? below : wrap;
          T[(h * 32 + qt * 16 + l15) * 65 + j * 16 + kt * 4 + g] = (pr[0] + pr[1]) + (pr[2] + 0.5f * pr[3]) + 0.5f * nb;
          prev3 = pr[3];
        }
        carry[qt] = prev3;
      }
    });
  lds_barrier();
#pragma unroll 1
  for (int qq = 0; qq < 8; ++qq) {
    const int q = h * 8 + qq, t = q0 + q, cur = t >> 6;
    const float imp = ((T[(0 * 32 + q) * 65 + lane] + T[(1 * 32 + q) * 65 + lane]) + T[(2 * 32 + q) * 65 + lane]) + T[(3 * 32 + q) * 65 + lane];
    const bool forced = lane == cur || lane == 0, allowed = lane <= cur, cand = allowed && !forced;
    const int K = cur == 0 ? 15 : 14;
    unsigned long long m;
    if (__popcll(__ballot(cand)) <= K) m = __ballot(allowed);
    else {
      const unsigned key = __float_as_uint(imp);
      unsigned prefix = 0u;
#pragma unroll 1
      for (int bit = 30; bit >= 0; --bit) {
        const unsigned cnd = prefix | (1u << bit);
        if (__popcll(__ballot(cand && key >= cnd)) >= K) prefix = cnd;
      }
      const unsigned long long gt = __ballot(cand && key > prefix), eq = __ballot(cand && key == prefix);
      const int need = K - __popcll(gt);
      const int myrank = __popcll(eq & ((1ull << lane) - 1ull));
      m = gt | __ballot(cand && key == prefix && myrank < need) | __ballot(forced);
    }
    if (lane == 0) selm[q] = m;
  }
  lds_barrier();
  f32x4* park = (f32x4*)T + (h * 8) * 64 + lane;
#pragma unroll
  for (int d = 0; d < 4; ++d) { park[(d * 2 + 0) * 64] = outacc[d][0]; park[(d * 2 + 1) * 64] = outacc[d][1]; }
  unsigned long long mq[2], anym = 0ull;
#pragma unroll
  for (int qt = 0; qt < 2; ++qt) mq[qt] = selm[qt * 16 + l15];
  for (int i = 0; i < 32; ++i) anym |= selm[i];
  const int jhi = (q0 + 31) >> 6;
#pragma unroll
  for (int qt = 0; qt < 2; ++qt)
#pragma unroll
    for (int ks = 0; ks < 2; ++ks) qf[qt][ks] = scale_frag(qf[qt][ks], sc);
  attn_init_rel(a);
  kv_pipeline(0, jhi + 1, Ks,
    [&](int j) { return (bool)((anym >> j) & 1ull); },
    [&](int j, KVRegs& kr) { kv_load(projb + PA_KS, projb + PA_VS, NP, NP, j * 64, kr); },
    [&](int j, const u16* Kt, const u16* Vt) {
      f32x4 s[4][2];
      auto valid = [&](int kt, int r, int qt) { return ((mq[qt] >> j) & 1ull) && (j * 64 + kt * 16 + 4 * g + r <= q0 + qt * 16 + l15); };
      bf16x8 pf[2][2];
      qk_tile_rel<2>(Kt, 0, qf, a, s, l15, g);
      if (j * 64 + 63 <= q0) softmax_rel<2>(s, a, pf, l15, valid, (bool)((mq[0] >> j) & 1ull), (bool)((mq[1] >> j) & 1ull));
      else softmax_rel<1>(s, a, pf, l15, valid);
      pv_accum(pf, Vt, a.o, l15, g);
      rowsum_accum(pf, a, l15);
    });
#pragma unroll
  for (int qt = 0; qt < 2; ++qt) {
    const float lt = rel_rowsum(a, qt, l15);
    const float gt = sigmoidf_(smb[(size_t)(q0 + qt * 16 + l15) * NSMALL + SM_G + h * 3 + 1]) * (lt > 0.f ? 1.f / lt : 0.f);
#pragma unroll
    for (int d = 0; d < 4; ++d) park[(d * 2 + qt) * 64] += a.o[d][qt] * gt;
  }
  attn_init_rel(a);
  const int jlo = q0 >= 511 ? (q0 - 511) >> 6 : 0;
  kv_pipeline(jlo, jhi + 1, Ks,
    [&](int) { return true; },
    [&](int j, KVRegs& kr) { kv_load(projb + PA_KW, projb + PA_VW, NP, NP, j * 64, kr); },
    [&](int j, const u16* Kt, const u16* Vt) {
      f32x4 s[4][2];
      auto valid = [&](int kt, int r, int qt) { const int key = j * 64 + kt * 16 + 4 * g + r, t = q0 + qt * 16 + l15; return key <= t && key + 512 > t; };
      bf16x8 pf[2][2];
      qk_tile_rel<2>(Kt, 0, qf, a, s, l15, g);
      if (j * 64 + 63 <= q0 && j * 64 + 512 > q0 + 31) softmax_rel<0>(s, a, pf, l15, valid);
      else softmax_rel<1>(s, a, pf, l15, valid);
      pv_accum(pf, Vt, a.o, l15, g);
      rowsum_accum(pf, a, l15);
    });
  u16* Y = (u16*)(p.ws + OFF_H);
  const float* ng = p.nsa_norm_g + layer * 64;
#pragma unroll
  for (int qt = 0; qt < 2; ++qt) {
    const int t = q0 + qt * 16 + l15;
    const float lt = rel_rowsum(a, qt, l15);
    const float gt = sigmoidf_(smb[(size_t)t * NSMALL + SM_G + h * 3 + 2]) * (lt > 0.f ? 1.f / lt : 0.f);
    f32x4 v[4]; float ss = 0.f;
#pragma unroll
    for (int d = 0; d < 4; ++d) { v[d] = park[(d * 2 + qt) * 64] + a.o[d][qt] * gt; ss += v[d][0] * v[d][0] + v[d][1] * v[d][1] + v[d][2] * v[d][2] + v[d][3] * v[d][3]; }
    ss = group_sum4(ss);
    const float rn = rsqrtf(ss * (1.f / 64.f) + 1e-6f);
    const size_t row = (size_t)b * SEQ + t;
#pragma unroll
    for (int d = 0; d < 4; ++d) {
      const int dd = d * 16 + 4 * g;
      const u32x2 zz = *(const u32x2*)(projb + (size_t)t * NP + PA_Z + h * 64 + dd);
      const f32x4 gg = *(const f32x4*)(ng + dd);
      u32x2 o;
      o.x = pack2(v[d][0] * rn * gg[0] * siluf(bflo(zz.x)), v[d][1] * rn * gg[1] * siluf(bfhi(zz.x)));
      o.y = pack2(v[d][2] * rn * gg[2] * siluf(bflo(zz.y)), v[d][3] * rn * gg[3] * siluf(bfhi(zz.y)));
      *(u32x2*)(Y + row * 1024 + Y_A + h * 64 + dd) = o;
    }
  }
}

DI void zero_y_cols(const Params& p, int c0, int ncols, int gtid, int gthreads) {
  u16* Y = (u16*)(p.ws + OFF_H);
  const int per_row = ncols / 8;
  for (size_t i = gtid; i < (size_t)NTOK * per_row; i += gthreads) {
    const size_t row = i / per_row; const int ch = (int)(i % per_row);
    *(u32x4*)(Y + row * 1024 + c0 + ch * 8) = (u32x4){0u, 0u, 0u, 0u};
  }
}

DI void final_norm_rows(const Params& p, int gw, int nw, int lane) {
  const float4* gp = (const float4*)p.final_g;
  float4 gg[4];
#pragma unroll
  for (int i = 0; i < 4; ++i) gg[i] = gp[lane + 64 * i];
  for (int row0 = gw * 4; row0 < NTOK; row0 += nw * 4) {
    float4 v[4][4]; float ss[4];
#pragma unroll
    for (int j = 0; j < 4; ++j) {
      const float4* xr = (const float4*)(p.out + (size_t)(row0 + j) * D_MODEL);
#pragma unroll
      for (int i = 0; i < 4; ++i) v[j][i] = xr[lane + 64 * i];
    }
#pragma unroll
    for (int j = 0; j < 4; ++j) {
      float a = 0.f;
#pragma unroll
      for (int i = 0; i < 4; ++i) a += v[j][i].x * v[j][i].x + v[j][i].y * v[j][i].y + v[j][i].z * v[j][i].z + v[j][i].w * v[j][i].w;
      ss[j] = wave_sum(a);
    }
#pragma unroll
    for (int j = 0; j < 4; ++j) {
      float4* xr = (float4*)(p.out + (size_t)(row0 + j) * D_MODEL);
      const float r = rsqrtf(ss[j] * (1.f / D_MODEL) + 1e-6f);
#pragma unroll
      for (int i = 0; i < 4; ++i) { float4 w; w.x = v[j][i].x * r * gg[i].x; w.y = v[j][i].y * r * gg[i].y; w.z = v[j][i].z * r * gg[i].z; w.w = v[j][i].w * r * gg[i].w; xr[lane + 64 * i] = w; }
    }
  }
}

#ifndef DEBUG_CHECK
#define DEBUG_CHECK 0
#endif
#if DEBUG_CHECK
constexpr int NCHK = 12;
DI float block_sum(float v, float* red) {
  v = wave_sum(v);
  lds_barrier();
  if ((threadIdx.x & 63) == 0) red[threadIdx.x >> 6] = v;
  lds_barrier();
  return red[0] + red[1] + red[2] + red[3];
}
DI float block_max(float v, float* red) {
#pragma unroll
  for (int o = 32; o > 0; o >>= 1) v = fmaxf(v, __shfl_xor(v, o));
  lds_barrier();
  if ((threadIdx.x & 63) == 0) red[threadIdx.x >> 6] = v;
  lds_barrier();
  return fmaxf(fmaxf(red[0], red[1]), fmaxf(red[2], red[3]));
}
DI float bfr(float v) { return bf2f(f2bf(v)); }
struct Chk { float num[NCHK], den[NCHK]; };
DI void chk_add(Chk& c, int id, float got, float ref) { const float d = got - ref; c.num[id] += d * d; c.den[id] += ref * ref; }

DI void dbg_diff_attn(const Params& p, int layer, int b, int t, int h, Chk& c, int id, unsigned char* smem) {
  float* p1 = (float*)smem; float* p2 = p1 + 4096; float* red = p2 + 4096;
  const int tid = otid();
  const u16* proj = (const u16*)(p.ws + OFF_PROJ) + (size_t)b * SEQ * NP;
  const u16* q = proj + (size_t)t * NP + PB_Q + h * 64;
  const float scale = 0.17677669529663687f;
  float m1 = -1e30f, m2 = -1e30f;
  for (int s = tid; s <= t; s += 256) {
    const u16* k = proj + (size_t)s * NP + PB_K + h * 64;
    float a1 = 0.f, a2 = 0.f;
    for (int d = 0; d < 32; ++d) { a1 += bf2f(q[d]) * bf2f(k[d]); a2 += bf2f(q[32 + d]) * bf2f(k[32 + d]); }
    a1 *= scale; a2 *= scale; p1[s] = a1; p2[s] = a2; m1 = fmaxf(m1, a1); m2 = fmaxf(m2, a2);
  }
  m1 = block_max(m1, red); m2 = block_max(m2, red);
  float l1 = 0.f, l2 = 0.f;
  for (int s = tid; s <= t; s += 256) { const float e1 = __expf(p1[s] - m1), e2 = __expf(p2[s] - m2); p1[s] = e1; p2[s] = e2; l1 += e1; l2 += e2; }
  l1 = block_sum(l1, red); l2 = block_sum(l2, red);
  const float* lam = p.diff_lam + layer * 128;
  float s01 = 0.f, s23 = 0.f;
  for (int i = 0; i < 32; ++i) { s01 += lam[i] * lam[32 + i]; s23 += lam[64 + i] * lam[96 + i]; }
  const float lam_init = 0.8f - 0.6f * expf(-0.3f * (float)layer);
  const float lam_full = expf(s01) - expf(s23) + lam_init;
  lds_barrier();
  float o = 0.f;
  if (tid < 64) for (int s = 0; s <= t; ++s) o += (p1[s] / l1 - lam_full * p2[s] / l2) * bf2f(proj[(size_t)s * NP + PB_V + h * 64 + tid]);
  float ss = block_sum(tid < 64 ? o * o : 0.f, red);
  if (tid < 64) {
    const float z = bf2f(proj[(size_t)t * NP + PB_Z + h * 64 + tid]);
    const float ref = o * rsqrtf(ss / 64.f + 1e-6f) * p.diff_norm_g[layer * 64 + tid] * (1.f - lam_init) * (z / (1.f + expf(-z)));
    const float got = bf2f(((const u16*)(p.ws + OFF_H))[((size_t)b * SEQ + t) * 1024 + Y_B + h * 64 + tid]);
    const float d = got - ref;
    o = d * d; ss = ref * ref;
  } else { o = 0.f; ss = 0.f; }
  c.num[id] += block_sum(o, red); c.den[id] += block_sum(ss, red);
}

DI float dbg_conv(const u16* projb, int t, int pcol, const float* cw, const float* cb, int ch, int nch) {
  float a = cb[ch];
  for (int j = 0; j < 4; ++j) { const int tt = t - 3 + j; if (tt >= 0) a += cw[j * nch + ch] * bf2f(projb[(size_t)tt * NP + pcol]); }
  return a / (1.f + expf(-a));
}
constexpr int DBG_NS = 11, DBG_T = 300;
DI int dbg_sample_idx(int t) {
  const int TS[DBG_NS] = {0, 1, 2, 3, 64, 127, 128, 129, 255, 256, 299};
  for (int i = 0; i < DBG_NS; ++i) if (TS[i] == t) return i;
  return -1;
}
DI int dbg_sample_t(int i) { const int TS[DBG_NS] = {0, 1, 2, 3, 64, 127, 128, 129, 255, 256, 299}; return TS[i]; }
DI void dbg_ssd(const Params& p, int layer, int b, int gi, Chk& c, int id, unsigned char* smem) {
  float* ybuf = (float*)smem;
  float* red = ybuf + DBG_NS * 128;
  const int tid = threadIdx.x, pp = tid >> 2, nq = tid & 3;
  const u16* projb = (const u16*)(p.ws + OFF_PROJ) + (size_t)b * SEQ * NP;
  const float* smb = (const float*)(p.ws + OFF_SMALL) + (size_t)b * SEQ * NSMALL;
  const float* cw = p.ssm_conv_w + layer * 4 * 512; const float* cb = p.ssm_conv_b + layer * 512;
  lds_barrier();
  for (int hh = 0; hh < 2; ++hh) {
    const int h = gi * 2 + hh;
    const float a_h = -expf(p.ssm_a_log[layer * 4 + h]), d_h = p.ssm_d[layer * 4 + h], dtb = p.ssm_dt_bias[layer * 4 + h];
    float hst[16];
    for (int i = 0; i < 16; ++i) hst[i] = 0.f;
    for (int t = 0; t < DBG_T; ++t) {
      const float xr = smb[(size_t)t * NSMALL + SM_DT + h] + dtb;
      const float dt = xr > 20.f ? xr : log1pf(expf(xr));
      const float dA = expf(dt * a_h);
      const float xp = dbg_conv(projb, t, PC_XBC + h * 64 + pp, cw, cb, h * 64 + pp, 512);
      float y = 0.f;
      for (int i = 0; i < 16; ++i) {
        const int n = nq * 16 + i;
        const float Bn = dbg_conv(projb, t, PC_XBC + 256 + gi * 64 + n, cw, cb, 256 + gi * 64 + n, 512);
        const float Cn = dbg_conv(projb, t, PC_XBC + 384 + gi * 64 + n, cw, cb, 384 + gi * 64 + n, 512);
        hst[i] = dA * hst[i] + dt * xp * Bn;
        y += Cn * hst[i];
      }
      y += __shfl_xor(y, 1); y += __shfl_xor(y, 2);
      y += d_h * xp;
      const int si = dbg_sample_idx(t);
      if (si >= 0 && nq == 0) { const float z = bf2f(projb[(size_t)t * NP + PC_Z + h * 64 + pp]); ybuf[si * 128 + hh * 64 + pp] = y * (z / (1.f + expf(-z))); }
    }
  }
  lds_barrier();
  for (int si = 0; si < DBG_NS; ++si) {
    const float v = tid < 128 ? ybuf[si * 128 + tid] : 0.f;
    const float ss = block_sum(v * v, red);
    float e2 = 0.f, r2 = 0.f;
    if (tid < 128) {
      const float ref = v * rsqrtf(ss / 128.f + 1e-6f) * p.ssm_norm_g[layer * 256 + gi * 128 + tid];
      const float got = bf2f(((const u16*)(p.ws + OFF_H))[((size_t)b * SEQ + dbg_sample_t(si)) * 1024 + Y_C + gi * 128 + tid]);
      e2 = (got - ref) * (got - ref); r2 = ref * ref;
    }
    c.num[id] += block_sum(e2, red); c.den[id] += block_sum(r2, red);
  }
}
DI void dbg_mlstm(const Params& p, int layer, int b, int h, Chk& c, int id, unsigned char* smem) {
  float* ybuf = (float*)smem;
  float* red = ybuf + DBG_NS * 128;
  const int tid = threadIdx.x, dd = tid >> 2, eq = tid & 3;
  const u16* projb = (const u16*)(p.ws + OFF_PROJ) + (size_t)b * SEQ * NP;
  const float* smb = (const float*)(p.ws + OFF_SMALL) + (size_t)b * SEQ * NSMALL;
  const float* cw = p.ml_conv_w + layer * 4 * 512; const float* cb = p.ml_conv_b + layer * 512;
  const float ib = p.ml_if_b[layer * 8 + h], fb = p.ml_if_b[layer * 8 + 4 + h];
  lds_barrier();
  float Cst[16], nst[16];
  for (int i = 0; i < 16; ++i) { Cst[i] = 0.f; nst[i] = 0.f; }
  float m = 0.f;
  for (int t = 0; t < DBG_T; ++t) {
    const float ip = smb[(size_t)t * NSMALL + SM_IF + h] + ib, fp = smb[(size_t)t * NSMALL + SM_IF + 4 + h] + fb;
    const float lf = fminf(fp, 0.f) - log1pf(expf(-fabsf(fp)));
    const float mn = fmaxf(lf + m, ip), fs = expf(lf + m - mn), is = expf(ip - mn);
    const float vd = bf2f(projb[(size_t)t * NP + PD_V + h * 64 + dd]);
    float num = 0.f, den = 0.f;
    for (int i = 0; i < 16; ++i) {
      const int e = eq * 16 + i;
      const float qe = dbg_conv(projb, t, PD_QK + h * 64 + e, cw, cb, h * 64 + e, 512);
      const float ke = 0.125f * dbg_conv(projb, t, PD_QK + 256 + h * 64 + e, cw, cb, 256 + h * 64 + e, 512);
      Cst[i] = fs * Cst[i] + is * vd * ke; nst[i] = fs * nst[i] + is * ke;
      num += Cst[i] * qe; den += nst[i] * qe;
    }
    num += __shfl_xor(num, 1); num += __shfl_xor(num, 2); den += __shfl_xor(den, 1); den += __shfl_xor(den, 2);
    const float hv = num / fmaxf(fabsf(den), expf(-mn));
    m = mn;
    const int si = dbg_sample_idx(t);
    if (si >= 0 && eq == 0) { const float o = bf2f(projb[(size_t)t * NP + PD_O + h * 64 + dd]); ybuf[si * 64 + dd] = hv / (1.f + expf(-o)); }
  }
  lds_barrier();
  for (int si = 0; si < DBG_NS; ++si) {
    const float v = tid < 64 ? ybuf[si * 64 + tid] : 0.f;
    const float ss = block_sum(v * v, red);
    float e2 = 0.f, r2 = 0.f;
    if (tid < 64) {
      const int t = dbg_sample_t(si);
      const float z = bf2f(projb[(size_t)t * NP + PD_Z + h * 64 + tid]);
      const float ref = v * rsqrtf(ss / 64.f + 1e-6f) * p.ml_norm_g[layer * 64 + tid] * (z / (1.f + expf(-z)));
      const float got = bf2f(((const u16*)(p.ws + OFF_H))[((size_t)b * SEQ + t) * 1024 + Y_D + h * 64 + tid]);
      e2 = (got - ref) * (got - ref); r2 = ref * ref;
    }
    c.num[id] += block_sum(e2, red); c.den[id] += block_sum(r2, red);
  }
}

DI void debug_checks(const Params& p, unsigned char* smem) {
  const int tid = otid();
  float* red = (float*)(smem + 36 * 1024);
  Chk c;
  for (int i = 0; i < NCHK; ++i) { c.num[i] = 0.f; c.den[i] = 0.f; }
  const float* adap = (const float*)(p.ws + OFF_ADAP);
  const u16* H = (const u16*)(p.ws + OFF_H);
  const u16* proj = (const u16*)(p.ws + OFF_PROJ);
  const float* sm = (const float*)(p.ws + OFF_SMALL);
#if DEBUG_CHECK == 1
  {
    const int bs[2] = {0, 5}; const int ns[4] = {3, 1024 + 77, 2048 + 500, 3071};
    for (int bi = 0; bi < 2; ++bi) for (int ni = 0; ni < 4; ++ni) {
      const int b = bs[bi], n = ns[ni];
      float a = 0.f;
      for (int k = tid; k < 1024; k += 256) { const float v = p.c[b * 1024 + k]; a += (v / (1.f + expf(-v))) * p.ada_w[(size_t)k * 3072 + n]; }
      const float ref = block_sum(a, red) + p.ada_b[n];
      float got = 0.f; for (int kc = 0; kc < 8; ++kc) got += adap[(((size_t)kc * 2 + 0) * 8 + b) * 3072 + n];
      chk_add(c, 1, got, ref);
    }
  }
  {
    const int ms[3] = {1, 9000, 32767};
    const int ns[14] = {0, 300, 700, 900, 1500, 2000, 2300, 2693, 3300, 3500, 3967, 3970, 3981, 3990};
    for (int mi = 0; mi < 3; ++mi) {
      const int m = ms[mi], b = m >> 12;
      float ss = 0.f;
      for (int k = tid; k < 1024; k += 256) { const float v = p.x[(size_t)m * 1024 + k]; ss += v * v; }
      ss = block_sum(ss, red);
      const float rstd = rsqrtf(ss / 1024.f + 1e-6f);
      for (int ni = 0; ni < 14; ++ni) {
        const int n = ns[ni], col = colmap(n);
        float a = 0.f, herr = 0.f, href = 0.f;
        for (int k = tid; k < 1024; k += 256) {
          float shf = 0.f, scl = 0.f;
          for (int kc = 0; kc < 8; ++kc) { const float* ap = adap + (((size_t)kc * 2 + 0) * 8 + b) * 3072; shf += ap[k]; scl += ap[1024 + k]; }
          const float hv = p.x[(size_t)m * 1024 + k] * rstd * p.norm_g[k] * (1.f + scl) + shf;
          const float hg = bf2f(H[(size_t)m * 1024 + k]);
          herr += (hg - hv) * (hg - hv); href += hv * hv;
          a += hv * p.w_in[(size_t)k * D_IN + col];
        }
        const float ref = block_sum(a, red);
        herr = block_sum(herr, red); href = block_sum(href, red);
        if (ni == 0 && DEBUG_STAGE == 1) { c.num[3] += herr; c.den[3] += href; }
        const float got = n < NP ? bf2f(proj[(size_t)m * NP + n]) : sm[(size_t)m * NSMALL + (n - NP)];
        chk_add(c, 2, got, ref);
      }
    }
  }
#endif
#if DEBUG_CHECK == 2
  dbg_diff_attn(p, 0, 0, 5, 0, c, 4, smem);
  dbg_diff_attn(p, 0, 1, 200, 3, c, 4, smem);
  dbg_diff_attn(p, 0, 3, 1500, 2, c, 4, smem);
  dbg_diff_attn(p, 0, 7, 4095, 1, c, 4, smem);
  {
    const int ms[3] = {2, 12345, 32766}; const int ns[3] = {0, 513, 1023};
    const u16* Y = (const u16*)(p.ws + OFF_H);
    for (int mi = 0; mi < 3; ++mi) for (int ni = 0; ni < 3; ++ni) {
      const int m = ms[mi], n = ns[ni], b = m >> 12;
      float a = 0.f;
      for (int k = tid; k < 1024; k += 256) a += bf2f(Y[(size_t)m * 1024 + k]) * p.w_out[(size_t)k * 1024 + n];
      a = block_sum(a, red);
      float gate = 0.f; for (int kc = 0; kc < 8; ++kc) gate += adap[(((size_t)kc * 2 + 0) * 8 + b) * 3072 + 2048 + n];
      chk_add(c, 5, p.out[(size_t)m * 1024 + n] - p.x[(size_t)m * 1024 + n], gate * a);
    }
  }
#endif
#if DEBUG_CHECK == 3
  dbg_ssd(p, 0, 0, 0, c, 6, smem);
  dbg_ssd(p, 0, 5, 1, c, 6, smem);
  dbg_mlstm(p, 0, 0, 0, c, 7, smem);
  dbg_mlstm(p, 0, 6, 3, c, 7, smem);
#endif
  lds_barrier();
  if (tid == 0) {
    int wid_ = 0, wcls = 99;
    for (int i = 1; i < NCHK; ++i) if (c.den[i] > 0.f) {
      const float rel = sqrtf(c.num[i] / c.den[i]);
      int cls = rel >= 1.f ? 0 : (int)floorf(-log10f(fmaxf(rel, 1e-9f)));
      if (cls > 9) cls = 9;
      if (!(rel == rel)) cls = 0;
      if (cls < wcls) { wcls = cls; wid_ = i; }
    }
    p.out[0] = 1e5f * ((float)wid_ + 0.1f * (float)wcls);
  }
}
#endif

#define XB_TMO      128
#define XB_XCNT(j)  (256  + 64 * (j))
#define XB_XSUB(j)  (1280 + 64 * (j))
#define XB_XGEN(j)  (2304 + 64 * (j))
#define XB_TOP      3328
#define XB_TOPGEN   3392
#define XCD_BAR_WORDS 3456
#define XB_SPIN_CAP (1u << 23)
DI unsigned xb_ld(unsigned* p)              { return __hip_atomic_load(p, __ATOMIC_RELAXED, __HIP_MEMORY_SCOPE_AGENT); }
DI unsigned xb_add(unsigned* p, unsigned v) { return __hip_atomic_fetch_add(p, v, __ATOMIC_RELAXED, __HIP_MEMORY_SCOPE_AGENT); }
DI unsigned xb_xcc_id() { return (unsigned)__builtin_amdgcn_s_getreg((3 << 11) | 20) & 0xFu; }
#define XB_SPIN(cond, bar) do { unsigned _sp = 0; while (cond) { __builtin_amdgcn_s_sleep(1); \
    if ((++_sp & 255u) == 0u) { if (xb_ld(&(bar)[XB_TMO])) break; if (_sp > XB_SPIN_CAP) { atomicAdd(&(bar)[XB_TMO], 1u); break; } } } } while (0)
struct XcdBarrier { unsigned* bar; unsigned x; volatile LDSP unsigned* st; };
DI XcdBarrier xcd_barrier_post(unsigned* bar, volatile LDSP unsigned* st) {
  XcdBarrier b; b.bar = bar; b.x = xb_xcc_id(); b.st = st;
  if (threadIdx.x == 0) (void)xb_add(&bar[XB_XCNT(b.x)], 1u);
  return b;
}
DI void xcd_barrier_complete(unsigned* bar, unsigned x, unsigned& nloc, unsigned& nx) {
  const unsigned G = gridDim.x * gridDim.y * gridDim.z;
  unsigned sum, cnt, mine, sp = 0u;
  for (;;) {
    sum = 0u; cnt = 0u; mine = 0u;
#pragma unroll
    for (unsigned j = 0; j < 16; ++j) { const unsigned c = xb_ld(&bar[XB_XCNT(j)]); sum += c; cnt += (c > 0u) ? 1u : 0u; mine = (j == x) ? c : mine; }
    if (sum == G) break;
    __builtin_amdgcn_s_sleep(1);
    if ((++sp & 255u) == 0u) { if (xb_ld(&bar[XB_TMO])) break; if (sp > XB_SPIN_CAP) { atomicAdd(&bar[XB_TMO], 1u); break; } }
  }
  nloc = mine > 0u ? mine : 1u; nx = cnt > 0u ? cnt : 1u;
}
DI void xcd_barrier(const XcdBarrier& b) {
  asm volatile("s_waitcnt vmcnt(0)" ::: "memory");
  __syncthreads();
  if (threadIdx.x == 0) {
    unsigned* bar = b.bar;
    __builtin_amdgcn_s_waitcnt(0);
    unsigned nloc = b.st[0], nx = b.st[1];
    if (nloc == 0u) { xcd_barrier_complete(bar, b.x, nloc, nx); b.st[0] = nloc; b.st[1] = nx; }
    const unsigned old = xb_add(&bar[XB_XSUB(b.x)], 1u);
    const unsigned gen = old / nloc;
    if (old + 1u == (gen + 1u) * nloc) {
      __builtin_amdgcn_fence(__ATOMIC_RELEASE, "agent");
      asm volatile("s_waitcnt vmcnt(0)" ::: "memory");
      const unsigned og = xb_add(&bar[XB_TOP], 1u);
      const unsigned tg = og / nx;
      if (og + 1u == (tg + 1u) * nx) xb_add(&bar[XB_TOPGEN], 1u);
      else XB_SPIN(xb_ld(&bar[XB_TOPGEN]) == tg, bar);
      __builtin_amdgcn_fence(__ATOMIC_ACQUIRE, "agent");
      xb_add(&bar[XB_XGEN(b.x)], 1u);
      asm volatile("s_waitcnt vmcnt(0)" ::: "memory");
    } else {
      XB_SPIN(xb_ld(&bar[XB_XGEN(b.x)]) == gen, bar);
      __builtin_amdgcn_fence(__ATOMIC_ACQUIRE, "agent");
      asm volatile("s_waitcnt vmcnt(0)" ::: "memory");
    }
  }
  __syncthreads();
}

constexpr int HALF_LDS = 76 * 1024;
constexpr int SMEM_BYTES = 2 * HALF_LDS;
__global__ void __launch_bounds__(512, 2) fwd_megakernel(Params p) {
  cg::grid_group grid = cg::this_grid();
  __shared__ __attribute__((aligned(16))) unsigned char smem[SMEM_BYTES];
  const int half = __builtin_amdgcn_readfirstlane(threadIdx.x >> 8);
  unsigned char* hsm = smem + half * HALF_LDS;
  const int G = gridDim.x, bid = blockIdx.x;
  const int slot = bid * 2 + half, NS = 2 * G;
  volatile LDSP unsigned* xst = (volatile LDSP unsigned*)(LDSP unsigned char*)(smem + SMEM_BYTES - 32);
  if (threadIdx.x == 0) { xst[0] = 0u; xst[1] = 0u; }
  __syncthreads();
  const XcdBarrier xb = xcd_barrier_post((unsigned*)(p.ws + OFF_BAR), xst);
  for (int t = slot; t < ((T0_TOTAL + NS - 1) / NS) * NS; t += NS) phase0_task(p, t < T0_TOTAL ? t : T0_TOTAL - 1, hsm);
  grid.sync();
  for (int layer = 0; layer < 2; ++layer) {
    Params q = p;
    { size_t zoff = 0; asm volatile("" : "+s"(zoff)); q.ws = p.ws + zoff; }
    const float* xin = layer == 0 ? q.x : q.out;
    for (int t = slot; t < ((NTOK / 64 + NS - 1) / NS) * NS; t += NS) phase1_task(q, layer, xin, t < NTOK / 64 ? t : NTOK / 64 - 1, hsm);
    xcd_barrier(xb);
    for (int t = bid; t < (NTOK / 256) * (NPAD / 256); t += G) gemm_inproj_tile(q, layer, t, smem);
    xcd_barrier(xb);
#if DEBUG_CHECK == 1
    if (bid == 0 && half == 0) debug_checks(q, smem);
    return;
#endif
    {
      unsigned* cnt = (unsigned*)(q.ws + OFF_CNT);
      int* s_pair = (int*)(smem + SMEM_BYTES - 16);
      if (bid < 32) ssd_task8(q, layer, bid >> 2, bid & 3, smem);
      else if (bid < 64) mlstm_task8(q, layer, (bid - 32) >> 2, (bid - 32) & 3, smem);
      if (bid < 64) {
        asm volatile("s_waitcnt vmcnt(0)" ::: "memory");
        lds_barrier();
        if (otid512() == 0) {
          __builtin_amdgcn_fence(__ATOMIC_RELEASE, "agent");
          asm volatile("s_waitcnt vmcnt(0)" ::: "memory");
          __hip_atomic_fetch_add(cnt + 4 + layer, 1u, __ATOMIC_RELAXED, __HIP_MEMORY_SCOPE_AGENT);
        }
      }
      constexpr int NPAIR_C = 64, NPAIR_D = 512, NPAIR_N = 512, NPAIR_F = NTOK / 128, NPAIR = NPAIR_C + NPAIR_D + NPAIR_N + NPAIR_F;
      for (;;) {
        const int t512 = otid512();
        lds_barrier();
        if (t512 == 0) *s_pair = (int)atomicAdd(cnt + layer, 1u);
        lds_barrier();
        const int pair = *s_pair;
        if (pair >= NPAIR) break;
        if (pair < NPAIR_C) {
          const int v = pair * 2 + half;
          compress_task(q, layer, v >> 4, (v >> 3) & 1, v & 7, hsm);
          asm volatile("s_waitcnt vmcnt(0)" ::: "memory");
          lds_barrier();
          if (t512 == 0) {
            __builtin_amdgcn_fence(__ATOMIC_RELEASE, "agent");
            asm volatile("s_waitcnt vmcnt(0)" ::: "memory");
            __hip_atomic_fetch_add(cnt + 2 + layer, 1u, __ATOMIC_RELAXED, __HIP_MEMORY_SCOPE_AGENT);
          }
        } else if (pair < NPAIR_C + NPAIR_D) {
          const int u = (pair - NPAIR_C) * 2 + half, qb = 31 - (u >> 5), bh = u & 31;
          diff_attn_task(q, layer, bh >> 2, bh & 3, qb, hsm, half != 0);
        } else if (pair >= NPAIR_C + NPAIR_D + NPAIR_N) {
          if (t512 == 0) {
            while (__hip_atomic_load(cnt + 4 + layer, __ATOMIC_RELAXED, __HIP_MEMORY_SCOPE_AGENT) < 64u) __builtin_amdgcn_s_sleep(16);
            __builtin_amdgcn_fence(__ATOMIC_ACQUIRE, "agent");
            asm volatile("s_waitcnt vmcnt(0)" ::: "memory");
          }
          lds_barrier();
          seq_fix_rows(q, layer, ((pair - NPAIR_C - NPAIR_D - NPAIR_N) * 2 + half) * 64, 64);
        } else {
          if (t512 == 0) {
            while (__hip_atomic_load(cnt + 2 + layer, __ATOMIC_RELAXED, __HIP_MEMORY_SCOPE_AGENT) < (unsigned)NPAIR_C) __builtin_amdgcn_s_sleep(16);
            __builtin_amdgcn_fence(__ATOMIC_ACQUIRE, "agent");
            asm volatile("s_waitcnt vmcnt(0)" ::: "memory");
          }
          lds_barrier();
          const int u = (pair - NPAIR_C - NPAIR_D) * 2 + half;
          nsa_task(q, layer, u & 7, 127 - (u >> 3), hsm);
        }
      }
    }
    xcd_barrier(xb);
    if (layer == 0) { for (int t = bid; t < (NTOK / 256) * 4; t += G) gemm_outproj_tile<0>(q, xin, q.out, t, smem); }
    else { for (int t = bid; t < (NTOK / 256) * 4; t += G) gemm_outproj_tile<1>(q, xin, q.out, t, smem); }
    xcd_barrier(xb);
#if DEBUG_CHECK >= 2
    if (bid == 0 && half == 0) debug_checks(q, smem);
    return;
#endif
  }
  { const int t5 = otid512(); final_norm_rows(p, bid * 8 + (t5 >> 6), G * 8, t5 & 63); }
}

extern "C" void kernel_launch(void* const* d_in, const int* in_sizes, int n_in, void* d_out, int out_size, void* d_ws, size_t ws_size,
                              hipStream_t stream) {
  static int grid_blocks = 0;
  if (!grid_blocks) {
    int dev = 0, cus = 0, per_cu = 0;
    (void)hipGetDevice(&dev);
    (void)hipDeviceGetAttribute(&cus, hipDeviceAttributeMultiprocessorCount, dev);
    (void)hipOccupancyMaxActiveBlocksPerMultiprocessor(&per_cu, fwd_megakernel, 512, 0);
    if (per_cu > 1) per_cu = 1;
    if (per_cu < 1) per_cu = 1;
    grid_blocks = cus * per_cu;
  }
  if (grid_blocks < 64 || (grid_blocks & 3)) { fprintf(stderr, "grid too small: %d\n", grid_blocks); return; }
  if (ws_size < WS_NEEDED) { fprintf(stderr, "workspace too small: %zu < %zu\n", ws_size, WS_NEEDED); return; }
  Params p{};
  const float** pp = (const float**)&p;
  for (int i = 0; i < 26; ++i) pp[i] = (const float*)d_in[i];
  p.out = (float*)d_out; p.ws = (unsigned char*)d_ws;
  (void)hipMemsetAsync((unsigned char*)d_ws + OFF_CNT, 0, 64 * 1024 + XCD_BAR_WORDS * 4, stream);
  void* args[] = {&p};
  hipError_t e = hipLaunchCooperativeKernel((void*)fwd_megakernel, dim3(grid_blocks), dim3(512), args, 0, stream);
  if (e != hipSuccess) fprintf(stderr, "cooperative launch failed: %s (grid %d)\n", hipGetErrorString(e), grid_blocks);
}
```

```cpp
#include <hip/hip_runtime.h>
#include <hip/hip_cooperative_groups.h>
#include <cstdio>
#include <cstdint>
#define DEBUG_CHECK 0
#define DEBUG_STAGE 1
#define REP_P1 1
#define REP_P2 1
#define REP_SEQ 1
#define REP_DIFF 1
#define REP_NSA 1
#define REP_P4 1
#define REP_P0 1
namespace cg = cooperative_groups;

typedef unsigned short u16;
typedef short bf16x8 __attribute__((ext_vector_type(8)));
typedef short s16x4 __attribute__((ext_vector_type(4)));
typedef float f32x4 __attribute__((ext_vector_type(4)));
typedef float f32x2 __attribute__((ext_vector_type(2)));
typedef unsigned u32x4 __attribute__((ext_vector_type(4)));
typedef unsigned u32x2 __attribute__((ext_vector_type(2)));
typedef __bf16 bf16x2_t __attribute__((ext_vector_type(2)));
#define DI __device__ __forceinline__
#define LDSP __attribute__((address_space(3)))

constexpr int D_MODEL = 1024, BATCH = 8, SEQ = 4096, NTOK = BATCH * SEQ;
constexpr int D_IN = 3992;
constexpr int NP = 3968, NPAD = 4096, NSMALL = 32;
constexpr int PA_Q = 0, PA_KC = 256, PA_VC = 320, PA_KS = 384, PA_VS = 448, PA_KW = 512, PA_VW = 576, PA_Z = 640;
constexpr int PB_Q = 896, PB_K = 1152, PB_V = 1408, PB_Z = 1664;
constexpr int PC_Z = 1920, PC_XBC = 2176;
constexpr int PD_QK = 2688, PD_V = 3200, PD_O = 3456, PD_Z = 3712;
constexpr int SM_G = 0, SM_DT = 12, SM_IF = 16;
constexpr int Y_A = 0, Y_B = 256, Y_C = 512, Y_D = 768;

constexpr size_t MiB = 1024 * 1024;
constexpr size_t OFF_WINT = 0;
constexpr size_t OFF_WOUTT = 16 * MiB;
constexpr size_t OFF_W1T = 20 * MiB;
constexpr size_t OFF_W2T = 22 * MiB;
constexpr size_t OFF_BIAS1 = 22 * MiB + 64 * 1024;
constexpr size_t OFF_ADAP = 22 * MiB + 128 * 1024;
constexpr size_t OFF_KCMP = 24 * MiB;
constexpr size_t OFF_VCMP = 24 * MiB + 256 * 1024;
constexpr size_t OFF_BAR = 29 * MiB + 64 * 1024;
constexpr size_t OFF_CNT = 29 * MiB;
constexpr size_t OFF_SMALL = 25 * MiB;
constexpr size_t OFF_SSQ = 29 * MiB;
constexpr size_t OFF_H = 32 * MiB;
constexpr size_t OFF_PROJ = 96 * MiB;
constexpr size_t OFF_X1B = 352 * MiB;
constexpr size_t WS_NEEDED = OFF_X1B + (size_t)NTOK * 1024 * 2;

struct Params {
  const float* x; const float* c; const float* norm_g; const float* ada_w; const float* ada_b;
  const float* w_in; const float* w_out;
  const float* nsa_cmp_pos; const float* nsa_ck_w1; const float* nsa_ck_w2; const float* nsa_cv_w1; const float* nsa_cv_w2; const float* nsa_norm_g;
  const float* diff_lam; const float* diff_norm_g;
  const float* ssm_conv_w; const float* ssm_conv_b; const float* ssm_dt_bias; const float* ssm_a_log; const float* ssm_d; const float* ssm_norm_g;
  const float* ml_conv_w; const float* ml_conv_b; const float* ml_if_b; const float* ml_norm_g; const float* final_g;
  float* out; unsigned char* ws;
};

DI void lds_barrier() { asm volatile("s_waitcnt lgkmcnt(0)" ::: "memory"); __builtin_amdgcn_s_barrier(); asm volatile("" ::: "memory"); }
DI int otid() { int t = threadIdx.x & 255; asm volatile("" : "+v"(t)); return t; }
DI int otid512() { int t = threadIdx.x; asm volatile("" : "+v"(t)); return t; }
DI unsigned pack2(float a, float b) { f32x2 v = {a, b}; bf16x2_t r = __builtin_convertvector(v, bf16x2_t); return __builtin_bit_cast(unsigned, r); }
DI u16 f2bf(float a) { return (u16)(pack2(a, 0.f) & 0xffffu); }
DI float bf2f(u16 h) { return __uint_as_float(((unsigned)h) << 16); }
DI float bflo(unsigned u) { return __uint_as_float(u << 16); }
DI float bfhi(unsigned u) { return __uint_as_float(u & 0xffff0000u); }
DI f32x4 mfma16(bf16x8 a, bf16x8 b, f32x4 c) { return __builtin_amdgcn_mfma_f32_16x16x32_bf16(a, b, c, 0, 0, 0); }
DI float wave_sum(float v) {
#pragma unroll
  for (int o = 32; o > 0; o >>= 1) v += __shfl_xor(v, o);
  return v;
}
DI float siluf(float v) { return v * __builtin_amdgcn_rcpf(1.f + __expf(-v)); }
DI float sigmoidf_(float v) { return __builtin_amdgcn_rcpf(1.f + __expf(-v)); }
DI float exp2_(float v) { return __builtin_amdgcn_exp2f(v); }
DI float sgprf(float v) { return __int_as_float(__builtin_amdgcn_readfirstlane(__float_as_int(v))); }
DI s16x4 tr_read(const u16* p) { return __builtin_amdgcn_ds_read_tr16_b64_v4i16((LDSP s16x4*)p); }
DI bf16x8 cat4(s16x4 a, s16x4 b) { bf16x8 r; r[0] = a[0]; r[1] = a[1]; r[2] = a[2]; r[3] = a[3]; r[4] = b[0]; r[5] = b[1]; r[6] = b[2]; r[7] = b[3]; return r; }
DI bf16x8 ldfrag(const u16* p) { return *(const bf16x8*)p; }

DI int colmap(int n) {
  if (n < 640) return n;
  if (n < 896) return 652 + (n - 640);
  if (n < 1920) return 908 + (n - 896);
  if (n < 2688) return 1932 + (n - 1920);
  if (n < 3456) return 2704 + (n - 2688);
  if (n < 3968) return 3480 + (n - 3456);
  if (n < 3980) return 640 + (n - 3968);
  if (n < 3984) return 2700 + (n - 3980);
  if (n < 3992) return 3472 + (n - 3984);
  return -1;
}

DI void tconv_tile(const float* __restrict__ src, int ldsrc, int k0, int n0, u16* __restrict__ dst, int ldd, bool use_map, unsigned char* smem) {
  float* tile = (float*)smem;
  const int tid = otid();
  lds_barrier();
  {
    const int nn = tid & 63; int col = n0 + nn; if (use_map) col = colmap(col);
#pragma unroll
    for (int i = 0; i < 16; ++i) { const int kk = i * 4 + (tid >> 6); tile[kk * 65 + nn] = col >= 0 ? src[(size_t)(k0 + kk) * ldsrc + col] : 0.f; }
  }
  lds_barrier();
#pragma unroll
  for (int i = 0; i < 2; ++i) {
    const int item = tid + 256 * i, nn = item >> 3, kc = item & 7;
    u32x4 w;
    w.x = pack2(tile[(kc * 8 + 0) * 65 + nn], tile[(kc * 8 + 1) * 65 + nn]);
    w.y = pack2(tile[(kc * 8 + 2) * 65 + nn], tile[(kc * 8 + 3) * 65 + nn]);
    w.z = pack2(tile[(kc * 8 + 4) * 65 + nn], tile[(kc * 8 + 5) * 65 + nn]);
    w.w = pack2(tile[(kc * 8 + 6) * 65 + nn], tile[(kc * 8 + 7) * 65 + nn]);
    *(u32x4*)(dst + (size_t)(n0 + nn) * ldd + k0 + kc * 8) = w;
  }
}

constexpr int T0_WIN = 2 * 16 * 64, T0_WOUT = 2 * 16 * 16, T0_W1 = 4 * 32 * 2, T0_W2 = 4 * 2, T0_ADA = 2 * 12 * 8, T0_B1 = 64;
constexpr int T0_TOTAL = T0_WIN + T0_WOUT + T0_W1 + T0_W2 + T0_ADA + T0_B1;

DI void phase0_task(const Params& p, int t, unsigned char* smem) {
  const int tid = otid();
  if (t < T0_WIN) {
    const int l = t / 1024, r = t % 1024, kt = r / 64, nt = r % 64;
    tconv_tile(p.w_in + (size_t)l * D_MODEL * D_IN, D_IN, kt * 64, nt * 64, (u16*)(p.ws + OFF_WINT) + (size_t)l * NPAD * 1024, 1024, true, smem);
    return;
  }
  t -= T0_WIN;
  if (t < T0_WOUT) {
    const int l = t / 256, r = t % 256, kt = r / 16, nt = r % 16;
    tconv_tile(p.w_out + (size_t)l * 1024 * 1024, 1024, kt * 64, nt * 64, (u16*)(p.ws + OFF_WOUTT) + (size_t)l * 1024 * 1024, 1024, false, smem);
    return;
  }
  t -= T0_WOUT;
  if (t < T0_W1) {
    const int m = t / 64, r = t % 64, kt = r / 2, nt = r % 2, l = m >> 1, kv = m & 1;
    const float* src = (kv ? p.nsa_cv_w1 : p.nsa_ck_w1) + (size_t)l * 2048 * 128;
    tconv_tile(src, 128, kt * 64, nt * 64, (u16*)(p.ws + OFF_W1T) + (size_t)m * 128 * 2048, 2048, false, smem);
    return;
  }
  t -= T0_W1;
  if (t < T0_W2) {
    const int m = t / 2, kt = t % 2, l = m >> 1, kv = m & 1;
    const float* src = (kv ? p.nsa_cv_w2 : p.nsa_ck_w2) + (size_t)l * 128 * 64;
    tconv_tile(src, 64, kt * 64, 0, (u16*)(p.ws + OFF_W2T) + (size_t)m * 64 * 128, 128, false, smem);
    return;
  }
  t -= T0_W2;
  if (t < T0_ADA) {
    const int l = t / 96, r = t % 96, nc = r / 8, kc = r % 8;
    float* cact = (float*)smem;
    lds_barrier();
    for (int i = tid; i < 1024; i += 256) { const int b = i >> 7, kk = i & 127; const float v = p.c[b * 1024 + kc * 128 + kk]; cact[i] = siluf(v); }
    lds_barrier();
    const int n = nc * 256 + tid;
    float acc[8];
#pragma unroll
    for (int b = 0; b < 8; ++b) acc[b] = 0.f;
    const float* w = p.ada_w + ((size_t)l * 1024 + kc * 128) * 3072 + n;
#pragma unroll 16
    for (int kk = 0; kk < 128; ++kk) {
      const float wv = w[(size_t)kk * 3072];
#pragma unroll
      for (int b = 0; b < 8; ++b) acc[b] += cact[b * 128 + kk] * wv;
    }
    float* adap = (float*)(p.ws + OFF_ADAP);
    const float bias = kc == 0 ? p.ada_b[l * 3072 + n] : 0.f;
#pragma unroll
    for (int b = 0; b < 8; ++b) adap[(((size_t)kc * 2 + l) * 8 + b) * 3072 + n] = acc[b] + bias;
    return;
  }
  t -= T0_ADA;
  {
    const int m = t >> 4, kc = t & 15, l = m >> 1, kv = m & 1;
    const float* w1 = (kv ? p.nsa_cv_w1 : p.nsa_ck_w1) + (size_t)l * 2048 * 128;
    const float* pos = p.nsa_cmp_pos + (size_t)l * 2048;
    const int n = tid & 127, half = tid >> 7;
    float acc = 0.f;
    const int k0 = kc * 128 + half * 64;
#pragma unroll 16
    for (int k = 0; k < 64; ++k) acc += pos[k0 + k] * w1[(size_t)(k0 + k) * 128 + n];
    float* red = (float*)smem;
    lds_barrier();
    red[tid] = acc;
    lds_barrier();
    if (tid < 128) ((float*)(p.ws + OFF_BIAS1))[(m * 16 + kc) * 128 + tid] = red[tid] + red[tid + 128];
  }
}

DI void phase1_task(const Params& p, int layer, const float* xin, int grp, unsigned char* smem) {
  const int tid = otid(), lane = tid & 63, wid = tid >> 6;
  const int b = grp >> 6;
  float* mul = (float*)smem;
  float* sh = mul + 1024;
  const float* adap = (const float*)(p.ws + OFF_ADAP);
  lds_barrier();
  for (int c = tid; c < 1024; c += 256) {
    float s0 = 0.f, s1 = 0.f;
#pragma unroll
    for (int kc = 0; kc < 8; ++kc) { const float* a = adap + (((size_t)kc * 2 + layer) * 8 + b) * 3072; s0 += a[c]; s1 += a[1024 + c]; }
    mul[c] = p.norm_g[layer * 1024 + c] * (1.f + s1); sh[c] = s0;
  }
  lds_barrier();
  u16* H = (u16*)(p.ws + OFF_H);
#pragma unroll 1
  for (int it = 0; it < 4; ++it) {
    float4 v[4][4]; float ss[4];
#pragma unroll
    for (int j = 0; j < 4; ++j) {
      const int row = grp * 64 + wid * 16 + it * 4 + j;
      if (layer == 0) {
        const float4* xr = (const float4*)(xin + (size_t)row * D_MODEL);
#pragma unroll
        for (int i = 0; i < 4; ++i) v[j][i] = xr[lane + 64 * i];
      } else {
        const u32x2* xr = (const u32x2*)((const u16*)(p.ws + OFF_X1B) + (size_t)row * D_MODEL);
#pragma unroll
        for (int i = 0; i < 4; ++i) { const u32x2 w = xr[lane + 64 * i]; v[j][i] = make_float4(bflo(w.x), bfhi(w.x), bflo(w.y), bfhi(w.y)); }
      }
    }
#pragma unroll
    for (int j = 0; j < 4; ++j) {
      float a = 0.f;
#pragma unroll
      for (int i = 0; i < 4; ++i) a += v[j][i].x * v[j][i].x + v[j][i].y * v[j][i].y + v[j][i].z * v[j][i].z + v[j][i].w * v[j][i].w;
      ss[j] = wave_sum(a);
    }
#pragma unroll
    for (int j = 0; j < 4; ++j) {
      const int row = grp * 64 + wid * 16 + it * 4 + j;
      const float r = rsqrtf(ss[j] * (1.f / D_MODEL) + 1e-6f);
#pragma unroll
      for (int i = 0; i < 4; ++i) {
        const int c = (lane + 64 * i) * 4;
        u32x2 w;
        w.x = pack2(v[j][i].x * r * mul[c] + sh[c], v[j][i].y * r * mul[c + 1] + sh[c + 1]);
        w.y = pack2(v[j][i].z * r * mul[c + 2] + sh[c + 2], v[j][i].w * r * mul[c + 3] + sh[c + 3]);
        *(u32x2*)(H + (size_t)row * 1024 + c) = w;
      }
    }
  }
}

namespace g8 {
constexpr int BM = 256, BK = 64, HALF = 128, HT = HALF * BK;
constexpr int LDS_BYTES = 8 * HT * 2;
DI int lds_byte(int r, int c) { const int st = (r >> 4) * 2 + (c >> 5), rr = r & 15, cc = c & 31, ob = rr * 64 + cc * 2; return st * 1024 + (ob ^ (((ob >> 9) & 1) << 5)); }
DI void stage_rc(int b, int& R, int& C) { const int st = b / 1024, sb = b % 1024, swz = sb ^ (((sb >> 9) & 1) << 5); R = (st >> 1) * 16 + swz / 64; C = (st & 1) * 32 + (swz % 64) / 2; }

DI void kloop(const u16* __restrict__ A, const u16* __restrict__ Bt, int K, int brow, int bcol, unsigned char* smem, f32x4 (&acc)[2][2][4][2]) {
  u16* shm = (u16*)smem;
  const int tid = otid512();
#define SA(b, h) (shm + ((b) * 2 + (h)) * HT)
#define SB(b, h) (shm + (4 + (b) * 2 + (h)) * HT)
#define STAGE(P, BASE, br, kt) do { const u16* _gb = BASE + ((long)(br) * K + (long)(kt) * BK); \
      __builtin_amdgcn_global_load_lds((const unsigned*)(_gb + soff0), (LDSP unsigned*)((LDSP char*)(P) + tid * 16), 16, 0, 0); \
      __builtin_amdgcn_global_load_lds((const unsigned*)(_gb + soff1), (LDSP unsigned*)((LDSP char*)(P) + tid * 16 + 8192), 16, 0, 0); } while (0)
#define LDA(dst, b, h) _Pragma("unroll") for (int m = 0; m < 4; ++m) _Pragma("unroll") for (int k = 0; k < 2; ++k) \
    dst[m][k] = *reinterpret_cast<const bf16x8*>((const char*)SA(b, h) + lds_byte(wr * 64 + m * 16 + fr, k * 32 + fq * 8))
#define LDB(dst, b, h) _Pragma("unroll") for (int n = 0; n < 2; ++n) _Pragma("unroll") for (int k = 0; k < 2; ++k) \
    dst[n][k] = *reinterpret_cast<const bf16x8*>((const char*)SB(b, h) + lds_byte(wc * 32 + n * 16 + fr, k * 32 + fq * 8))
#define MMA(ai, bj, At_, Bt_) do { __builtin_amdgcn_s_setprio(1); \
    _Pragma("unroll") for (int m = 0; m < 4; ++m) _Pragma("unroll") for (int n = 0; n < 2; ++n) _Pragma("unroll") for (int k = 0; k < 2; ++k) \
      acc[ai][bj][m][n] = __builtin_amdgcn_mfma_f32_16x16x32_bf16(Bt_[n][k], At_[m][k], acc[ai][bj][m][n], 0, 0, 0); \
    __builtin_amdgcn_s_setprio(0); } while (0)
#define WAIT_V(n) asm volatile("s_waitcnt vmcnt(" #n ")" ::: "memory")
#define WAIT_L(n) asm volatile("s_waitcnt lgkmcnt(" #n ")" ::: "memory")
#define BAR __builtin_amdgcn_s_barrier()
#define SCHED __builtin_amdgcn_sched_barrier(0)
  const int wid = __builtin_amdgcn_readfirstlane(tid >> 6), lane = tid & 63, wr = wid >> 2, wc = wid & 3, fr = lane & 15, fq = lane >> 4;
#pragma unroll
  for (int a = 0; a < 2; ++a)
#pragma unroll
    for (int b = 0; b < 2; ++b)
#pragma unroll
      for (int m = 0; m < 4; ++m) { acc[a][b][m][0] = (f32x4){0.f, 0.f, 0.f, 0.f}; acc[a][b][m][1] = (f32x4){0.f, 0.f, 0.f, 0.f}; }
  bf16x8 At[4][2], B0[2][2], B1[2][2];
  const int nt = K / BK;
  int soff0, soff1;
  { int r_, c_; stage_rc(tid * 16, r_, c_); soff0 = r_ * K + c_; stage_rc(tid * 16 + 8192, r_, c_); soff1 = r_ * K + c_; }
  STAGE(SB(0, 0), Bt, bcol, 0); STAGE(SA(0, 0), A, brow, 0);
  STAGE(SB(0, 1), Bt, bcol + HALF, 0); STAGE(SA(0, 1), A, brow + HALF, 0);
  if (wr == 1) BAR;
  WAIT_V(4); BAR;
  STAGE(SB(1, 0), Bt, bcol, 1); STAGE(SA(1, 0), A, brow, 1); STAGE(SB(1, 1), Bt, bcol + HALF, 1);
  WAIT_V(6); BAR;
#pragma unroll 1
  for (int t = 0; t < nt - 2; t += 2) {
    asm volatile("" : "+v"(soff0), "+v"(soff1));
    LDB(B0, 0, 0); SCHED; LDA(At, 0, 0); STAGE(SA(1, 1), A, brow + HALF, t + 1);
    WAIT_L(8); BAR; WAIT_L(0); MMA(0, 0, At, B0); BAR; SCHED;
    LDB(B1, 0, 1); STAGE(SB(0, 0), Bt, bcol, t + 2);
    BAR; WAIT_L(0); MMA(0, 1, At, B1); BAR;
    LDA(At, 0, 1); STAGE(SA(0, 0), A, brow, t + 2);
    BAR; WAIT_L(0); MMA(1, 0, At, B0); BAR; SCHED;
    STAGE(SB(0, 1), Bt, bcol + HALF, t + 2);
    WAIT_V(6); BAR; MMA(1, 1, At, B1); BAR;
    LDB(B0, 1, 0); SCHED; LDA(At, 1, 0); STAGE(SA(0, 1), A, brow + HALF, t + 2);
    WAIT_L(8); BAR; WAIT_L(0); MMA(0, 0, At, B0); BAR; SCHED;
    LDB(B1, 1, 1); STAGE(SB(1, 0), Bt, bcol, t + 3);
    BAR; WAIT_L(0); MMA(0, 1, At, B1); BAR;
    LDA(At, 1, 1); STAGE(SA(1, 0), A, brow, t + 3);
    BAR; WAIT_L(0); MMA(1, 0, At, B0); BAR; SCHED;
    STAGE(SB(1, 1), Bt, bcol + HALF, t + 3);
    WAIT_V(6); BAR; MMA(1, 1, At, B1); BAR;
  }
  { LDB(B0, 0, 0); LDA(At, 0, 0); STAGE(SA(1, 1), A, brow + HALF, nt - 1);
    BAR; WAIT_L(0); MMA(0, 0, At, B0); BAR;
    LDB(B1, 0, 1); BAR; WAIT_L(0); MMA(0, 1, At, B1); BAR;
    LDA(At, 0, 1); WAIT_V(4); BAR; WAIT_L(0); MMA(1, 0, At, B0); MMA(1, 1, At, B1); BAR; }
  { LDB(B0, 1, 0); LDA(At, 1, 0); WAIT_V(2); BAR; WAIT_L(0); MMA(0, 0, At, B0); BAR;
    LDB(B1, 1, 1); WAIT_V(0); BAR; WAIT_L(0); MMA(0, 1, At, B1); BAR;
    LDA(At, 1, 1); BAR; WAIT_L(0); MMA(1, 0, At, B0); MMA(1, 1, At, B1); BAR; }
  if (wr == 0) BAR;
#undef SA
#undef SB
#undef STAGE
#undef LDA
#undef LDB
#undef MMA
#undef WAIT_V
#undef WAIT_L
#undef BAR
#undef SCHED
}
DI void tile_map(int wgid, int nM, int nN, int& pm, int& pn) {
  const int nwg = nM * nN, NXCD = 8, WGM = 8;
  { const int q = nwg / NXCD, r = nwg % NXCD, xcd = wgid % NXCD, off = wgid / NXCD; wgid = (xcd < r ? xcd * (q + 1) : r * (q + 1) + (xcd - r) * q) + off; }
  const int nig = WGM * nN, gid = wgid / nig, fm = gid * WGM, gsz = (nM - fm) < WGM ? (nM - fm) : WGM;
  pm = fm + ((wgid % nig) % gsz); pn = (wgid % nig) / gsz;
}
}

DI void gemm_inproj_tile(const Params& p, int layer, int tile, unsigned char* smem) {
  int pm, pn; g8::tile_map(tile, NTOK / 256, NPAD / 256, pm, pn);
  const int brow = pm * 256, bcol = pn * 256;
  f32x4 acc[2][2][4][2];
  g8::kloop((const u16*)(p.ws + OFF_H), (const u16*)(p.ws + OFF_WINT) + (size_t)layer * NPAD * 1024, 1024, brow, bcol, smem, acc);
  const int tid = otid512(), wid = __builtin_amdgcn_readfirstlane(tid >> 6), lane = tid & 63, wr = wid >> 2, wc = wid & 3, fr = lane & 15, fq = lane >> 4;
  u16* proj = (u16*)(p.ws + OFF_PROJ);
  if (pn == 15 && wc == 0) {
    float* sm = (float*)(p.ws + OFF_SMALL);
#pragma unroll
    for (int ai = 0; ai < 2; ++ai)
#pragma unroll
      for (int m = 0; m < 4; ++m)
#pragma unroll
        for (int n = 0; n < 2; ++n) {
          const int mr = brow + ai * 128 + wr * 64 + m * 16 + fr;
          *(f32x4*)(sm + (size_t)mr * NSMALL + n * 16 + 4 * fq) = acc[ai][1][m][n];
        }
  }
  constexpr int CLD = 264;
  u16* Cs = (u16*)smem;
#pragma unroll
  for (int ai = 0; ai < 2; ++ai) {
    lds_barrier();
#pragma unroll
    for (int bj = 0; bj < 2; ++bj)
#pragma unroll
      for (int m = 0; m < 4; ++m)
#pragma unroll
        for (int n = 0; n < 2; ++n) {
          const f32x4 v = acc[ai][bj][m][n];
          u32x2 w; w.x = pack2(v[0], v[1]); w.y = pack2(v[2], v[3]);
          *(u32x2*)(Cs + (wr * 64 + m * 16 + fr) * CLD + bj * 128 + wc * 32 + n * 16 + 4 * fq) = w;
        }
    lds_barrier();
#pragma unroll
    for (int i = 0; i < 8; ++i) {
      const int id = tid + 512 * i, row = id >> 5, ch = id & 31;
      if (bcol + ch * 8 < NP) *(u32x4*)(proj + (size_t)(brow + ai * 128 + row) * NP + bcol + ch * 8) = *(const u32x4*)(Cs + row * CLD + ch * 8);
    }
  }
  lds_barrier();
}

template <int layer>
DI void gemm_outproj_tile(const Params& p, const float* xin, float* xout, int tile, unsigned char* smem) {
  int pm, pn; g8::tile_map(tile, NTOK / 256, 4, pm, pn);
  const int brow = pm * 256, bcol = pn * 256;
  f32x4 acc[2][2][4][2];
  g8::kloop((const u16*)(p.ws + OFF_H), (const u16*)(p.ws + OFF_WOUTT) + (size_t)layer * 1024 * 1024, 1024, brow, bcol, smem, acc);
  const int tid = otid512(), wid = __builtin_amdgcn_readfirstlane(tid >> 6), lane = tid & 63, wr = wid >> 2, wc = wid & 3, fr = lane & 15, fq = lane >> 4;
  const int b = brow >> 12;
  const float* adap = (const float*)(p.ws + OFF_ADAP);
  constexpr int CLD = 132;
  float* Cs = (float*)smem;
#pragma unroll
  for (int ai = 0; ai < 2; ++ai)
#pragma unroll
    for (int bj = 0; bj < 2; ++bj) {
      lds_barrier();
#pragma unroll
      for (int m = 0; m < 4; ++m)
#pragma unroll
        for (int n = 0; n < 2; ++n) *(f32x4*)(Cs + (wr * 64 + m * 16 + fr) * CLD + wc * 32 + n * 16 + 4 * fq) = acc[ai][bj][m][n];
      lds_barrier();
      const int ch = tid & 31, nc = bcol + bj * 128 + ch * 4;
      f32x4 gt = {0.f, 0.f, 0.f, 0.f};
#pragma unroll
      for (int kc = 0; kc < 8; ++kc) gt += *(const f32x4*)(adap + (((size_t)kc * 2 + layer) * 8 + b) * 3072 + 2048 + nc);
      u16* x1b = (u16*)(p.ws + OFF_X1B);
      f32x4 xv[8];
#pragma unroll
      for (int i = 0; i < 8; ++i) {
        const size_t off = (size_t)(brow + ai * 128 + (tid >> 5) + 16 * i) * 1024 + nc;
        if (layer == 0) xv[i] = *(const f32x4*)(xin + off);
        else { const u32x2 w = *(const u32x2*)(x1b + off); xv[i] = (f32x4){bflo(w.x), bfhi(w.x), bflo(w.y), bfhi(w.y)}; }
      }
#pragma unroll
      for (int i = 0; i < 8; ++i) {
        const int row = (tid >> 5) + 16 * i;
        const size_t off = (size_t)(brow + ai * 128 + row) * 1024 + nc;
        const f32x4 v = xv[i] + gt * *(const f32x4*)(Cs + row * CLD + ch * 4);
        if (layer == 0) { u32x2 w; w.x = pack2(v[0], v[1]); w.y = pack2(v[2], v[3]); *(u32x2*)(x1b + off) = w; }
        else *(f32x4*)(xout + off) = v;
      }
    }
  lds_barrier();
}

constexpr int KLD = 72;
struct KVRegs { u32x4 k[2], v[2]; };
DI void kv_load(const u16* kbase, const u16* vbase, int ldk, int ldv, int key0, KVRegs& r) {
  const int tid = otid();
#pragma unroll
  for (int i = 0; i < 2; ++i) {
    const int id = tid + 256 * i, row = id >> 3, ch = id & 7;
    r.k[i] = *(const u32x4*)(kbase + (size_t)(key0 + row) * ldk + ch * 8);
    r.v[i] = *(const u32x4*)(vbase + (size_t)(key0 + row) * ldv + ch * 8);
  }
}
DI void kv_store(u16* Ks, u16* Vs, const KVRegs& r) {
  const int tid = otid();
#pragma unroll
  for (int i = 0; i < 2; ++i) {
    const int id = tid + 256 * i, row = id >> 3, ch = id & 7;
    *(u32x4*)(Ks + row * KLD + ch * 8) = r.k[i];
    *(u32x4*)(Vs + row * KLD + ch * 8) = r.v[i];
  }
}
constexpr int KVBUF = 2 * 64 * KLD;
template <class UseF, class LoadF, class CompF>
DI void kv_pipeline(int j0, int j1, u16* buf, UseF use, LoadF load, CompF comp) {
  KVRegs kr;
  if (use(j0)) load(j0, kr);
  lds_barrier();
  if (use(j0)) kv_store(buf, buf + 64 * KLD, kr);
  if (j0 + 1 < j1 && use(j0 + 1)) load(j0 + 1, kr);
  lds_barrier();
  for (int j = j0; j < j1; ++j) {
    u16* cur = buf + ((j - j0) & 1) * KVBUF; u16* nxt = buf + (((j - j0) & 1) ^ 1) * KVBUF;
    if (j + 1 < j1 && use(j + 1)) kv_store(nxt, nxt + 64 * KLD, kr);
    if (j + 2 < j1 && use(j + 2)) load(j + 2, kr);
    if (use(j)) comp(j, cur, cur + 64 * KLD);
    lds_barrier();
  }
}
struct AttnAcc { f32x4 o[4][2]; float m[2], l[2]; f32x4 os[2]; int fresh; };
DI void attn_init(AttnAcc& a) {
#pragma unroll
  for (int d = 0; d < 4; ++d) { a.o[d][0] = (f32x4){0.f, 0.f, 0.f, 0.f}; a.o[d][1] = (f32x4){0.f, 0.f, 0.f, 0.f}; }
  a.m[0] = a.m[1] = -1e30f; a.l[0] = a.l[1] = 0.f;
}
template <int NKS>
DI void qk_tile(const u16* Ks, int dofs, const bf16x8 (&qf)[2][NKS], f32x4 (&s)[4][2], int l15, int g) {
#pragma unroll
  for (int kt = 0; kt < 4; ++kt) {
    s[kt][0] = (f32x4){0.f, 0.f, 0.f, 0.f}; s[kt][1] = (f32x4){0.f, 0.f, 0.f, 0.f};
#pragma unroll
    for (int ks = 0; ks < NKS; ++ks) {
      const bf16x8 a = ldfrag(Ks + (kt * 16 + l15) * KLD + dofs + ks * 32 + 8 * g);
      s[kt][0] = mfma16(a, qf[0][ks], s[kt][0]);
      s[kt][1] = mfma16(a, qf[1][ks], s[kt][1]);
    }
  }
}
DI void pv_accum(const bf16x8 (&pf)[2][2], const u16* Vs, f32x4 (&o)[4][2], int l15, int g) {
  const int tq = l15 >> 2, tp = l15 & 3;
#pragma unroll
  for (int kk = 0; kk < 2; ++kk)
#pragma unroll
    for (int d = 0; d < 4; ++d) {
      const bf16x8 vf = cat4(tr_read(Vs + (kk * 32 + 4 * g + tq) * KLD + d * 16 + 4 * tp), tr_read(Vs + (kk * 32 + 16 + 4 * g + tq) * KLD + d * 16 + 4 * tp));
      o[d][0] = mfma16(vf, pf[0][kk], o[d][0]);
      o[d][1] = mfma16(vf, pf[1][kk], o[d][1]);
    }
}
DI void pack_p(const f32x4 (&s)[4][2], bf16x8 (&pf)[2][2]) {
#pragma unroll
  for (int qt = 0; qt < 2; ++qt)
#pragma unroll
    for (int kk = 0; kk < 2; ++kk) {
      u32x4 w;
      w.x = pack2(s[2 * kk][qt][0], s[2 * kk][qt][1]); w.y = pack2(s[2 * kk][qt][2], s[2 * kk][qt][3]);
      w.z = pack2(s[2 * kk + 1][qt][0], s[2 * kk + 1][qt][1]); w.w = pack2(s[2 * kk + 1][qt][2], s[2 * kk + 1][qt][3]);
      pf[qt][kk] = __builtin_bit_cast(bf16x8, w);
    }
}
constexpr float DEFER_THR = 5.f;
template <class VF>
DI void softmax_pv(f32x4 (&s)[4][2], AttnAcc& a, const u16* Vs, float sc, int l15, int g, VF valid) {
  bf16x8 pf[2][2];
  float mxl[2];
#pragma unroll
  for (int qt = 0; qt < 2; ++qt) {
    float mx = -1e30f;
#pragma unroll
    for (int kt = 0; kt < 4; ++kt)
#pragma unroll
      for (int r = 0; r < 4; ++r) { const float v = valid(kt, r, qt) ? s[kt][qt][r] * sc : -1e30f; s[kt][qt][r] = v; mx = fmaxf(mx, v); }
    mxl[qt] = mx;
  }
  if (__any((mxl[0] > a.m[0] + DEFER_THR) || (mxl[1] > a.m[1] + DEFER_THR))) {
#pragma unroll
    for (int qt = 0; qt < 2; ++qt) {
      float mx = mxl[qt];
      mx = fmaxf(mx, __shfl_xor(mx, 16)); mx = fmaxf(mx, __shfl_xor(mx, 32));
      const float mn = fmaxf(a.m[qt], mx), alpha = exp2_(a.m[qt] - mn);
      a.m[qt] = mn; a.l[qt] *= alpha;
#pragma unroll
      for (int d = 0; d < 4; ++d) a.o[d][qt] *= alpha;
    }
  }
#pragma unroll
  for (int qt = 0; qt < 2; ++qt) {
    const float mn = a.m[qt];
    float ls = 0.f;
#pragma unroll
    for (int kt = 0; kt < 4; ++kt)
#pragma unroll
      for (int r = 0; r < 4; ++r) { const float v = s[kt][qt][r]; const float pv = v > -1e29f ? exp2_(v - mn) : 0.f; s[kt][qt][r] = pv; ls += pv; }
    a.l[qt] += ls;
  }
  pack_p(s, pf);
  pv_accum(pf, Vs, a.o, l15, g);
}
DI void softmax_pv_nomask(f32x4 (&s)[4][2], AttnAcc& a, const u16* Vs, float sc, int l15, int g) {
  bf16x8 pf[2][2];
  float mxl[2];
#pragma unroll
  for (int qt = 0; qt < 2; ++qt) {
    float mx = s[0][qt][0];
#pragma unroll
    for (int kt = 0; kt < 4; ++kt)
#pragma unroll
      for (int r = 0; r < 4; ++r) mx = fmaxf(mx, s[kt][qt][r]);
    mxl[qt] = mx * sc;
  }
  if (__any((mxl[0] > a.m[0] + DEFER_THR) || (mxl[1] > a.m[1] + DEFER_THR))) {
#pragma unroll
    for (int qt = 0; qt < 2; ++qt) {
      float mx = mxl[qt];
      mx = fmaxf(mx, __shfl_xor(mx, 16)); mx = fmaxf(mx, __shfl_xor(mx, 32));
      const float mn = fmaxf(a.m[qt], mx), alpha = exp2_(a.m[qt] - mn);
      a.m[qt] = mn; a.l[qt] *= alpha;
#pragma unroll
      for (int d = 0; d < 4; ++d) a.o[d][qt] *= alpha;
    }
  }
#pragma unroll
  for (int qt = 0; qt < 2; ++qt) {
    const float mn = a.m[qt];
    float ls = 0.f;
#pragma unroll
    for (int kt = 0; kt < 4; ++kt)
#pragma unroll
      for (int r = 0; r < 4; ++r) { const float pv = exp2_(__builtin_fmaf(s[kt][qt][r], sc, -mn)); s[kt][qt][r] = pv; ls += pv; }
    a.l[qt] += ls;
  }
  pack_p(s, pf);
  pv_accum(pf, Vs, a.o, l15, g);
}
template <class VF>
DI void softmax_p(f32x4 (&s)[4][2], AttnAcc& a, float sc, bf16x8 (&pf)[2][2], bool nomask, VF valid) {
  float mxl[2];
#pragma unroll
  for (int qt = 0; qt < 2; ++qt) {
    float mx = -1e30f;
#pragma unroll
    for (int kt = 0; kt < 4; ++kt)
#pragma unroll
      for (int r = 0; r < 4; ++r) { const float v = (nomask || valid(kt, r, qt)) ? s[kt][qt][r] * sc : -1e30f; s[kt][qt][r] = v; mx = fmaxf(mx, v); }
    mxl[qt] = mx;
  }
  if (__any((mxl[0] > a.m[0] + DEFER_THR) || (mxl[1] > a.m[1] + DEFER_THR))) {
#pragma unroll
    for (int qt = 0; qt < 2; ++qt) {
      float mx = mxl[qt];
      mx = fmaxf(mx, __shfl_xor(mx, 16)); mx = fmaxf(mx, __shfl_xor(mx, 32));
      const float mn = fmaxf(a.m[qt], mx), alpha = exp2_(a.m[qt] - mn);
      a.m[qt] = mn; a.l[qt] *= alpha;
#pragma unroll
      for (int d = 0; d < 4; ++d) a.o[d][qt] *= alpha;
    }
  }
#pragma unroll
  for (int qt = 0; qt < 2; ++qt) {
    const float mn = a.m[qt];
    float ls = 0.f;
#pragma unroll
    for (int kt = 0; kt < 4; ++kt)
#pragma unroll
      for (int r = 0; r < 4; ++r) { const float v = s[kt][qt][r]; const float pv = v > -1e29f ? exp2_(v - mn) : 0.f; s[kt][qt][r] = pv; ls += pv; }
    a.l[qt] += ls;
  }
  pack_p(s, pf);
}
DI void softmax_p_nomask(f32x4 (&s)[4][2], AttnAcc& a, float sc, bf16x8 (&pf)[2][2]) {
  float mxl[2];
#pragma unroll
  for (int qt = 0; qt < 2; ++qt) {
    float mx = s[0][qt][0];
#pragma unroll
    for (int kt = 0; kt < 4; ++kt)
#pragma unroll
      for (int r = 0; r < 4; ++r) mx = fmaxf(mx, s[kt][qt][r]);
    mxl[qt] = mx * sc;
  }
  if (__any((mxl[0] > a.m[0] + DEFER_THR) || (mxl[1] > a.m[1] + DEFER_THR))) {
#pragma unroll
    for (int qt = 0; qt < 2; ++qt) {
      float mx = mxl[qt];
      mx = fmaxf(mx, __shfl_xor(mx, 16)); mx = fmaxf(mx, __shfl_xor(mx, 32));
      const float mn = fmaxf(a.m[qt], mx), alpha = exp2_(a.m[qt] - mn);
      a.m[qt] = mn; a.l[qt] *= alpha;
#pragma unroll
      for (int d = 0; d < 4; ++d) a.o[d][qt] *= alpha;
    }
  }
#pragma unroll
  for (int qt = 0; qt < 2; ++qt) {
    const float mn = a.m[qt];
    float ls = 0.f;
#pragma unroll
    for (int kt = 0; kt < 4; ++kt)
#pragma unroll
      for (int r = 0; r < 4; ++r) { const float pv = exp2_(__builtin_fmaf(s[kt][qt][r], sc, -mn)); s[kt][qt][r] = pv; ls += pv; }
    a.l[qt] += ls;
  }
  pack_p(s, pf);
}
DI float group_sum4_(float v) { v += __shfl_xor(v, 16); v += __shfl_xor(v, 32); return v; }
DI bf16x8 scale_frag(bf16x8 f, float sc) {
  u32x4 w = __builtin_bit_cast(u32x4, f);
  w.x = pack2(bflo(w.x) * sc, bfhi(w.x) * sc); w.y = pack2(bflo(w.y) * sc, bfhi(w.y) * sc);
  w.z = pack2(bflo(w.z) * sc, bfhi(w.z) * sc); w.w = pack2(bflo(w.w) * sc, bfhi(w.w) * sc);
  return __builtin_bit_cast(bf16x8, w);
}
DI void attn_init_rel(AttnAcc& a) { attn_init(a); a.m[0] = a.m[1] = 0.f; a.os[0] = (f32x4){0.f, 0.f, 0.f, 0.f}; a.os[1] = (f32x4){0.f, 0.f, 0.f, 0.f}; a.fresh = 1; }
DI void rowsum_accum(const bf16x8 (&pf)[2][2], AttnAcc& a, int l15) {
  const short one = l15 == 0 ? (short)0x3F80 : (short)0;
  const bf16x8 ones = {one, one, one, one, one, one, one, one};
#pragma unroll
  for (int kk = 0; kk < 2; ++kk) { a.os[0] = mfma16(ones, pf[0][kk], a.os[0]); a.os[1] = mfma16(ones, pf[1][kk], a.os[1]); }
}
DI float rel_rowsum(const AttnAcc& a, int qt, int l15) { return __shfl(a.os[qt][0], l15); }
template <int NKS>
DI void qk_tile_rel(const u16* Ks, int dofs, const bf16x8 (&qf)[2][NKS], const AttnAcc& a, f32x4 (&s)[4][2], int l15, int g, bool ok0 = true, bool ok1 = true) {
  const float n0 = ok0 ? -a.m[0] : -1e30f, n1 = ok1 ? -a.m[1] : -1e30f;
#pragma unroll
  for (int kt = 0; kt < 4; ++kt) {
    s[kt][0] = (f32x4){n0, n0, n0, n0}; s[kt][1] = (f32x4){n1, n1, n1, n1};
#pragma unroll
    for (int ks = 0; ks < NKS; ++ks) {
      const bf16x8 k = ldfrag(Ks + (kt * 16 + l15) * KLD + dofs + ks * 32 + 8 * g);
      s[kt][0] = mfma16(k, qf[0][ks], s[kt][0]);
      s[kt][1] = mfma16(k, qf[1][ks], s[kt][1]);
    }
  }
}
template <int MODE, class VF>
DI void softmax_rel(f32x4 (&s)[4][2], AttnAcc& a, bf16x8 (&pf)[2][2], int l15_, VF valid, bool ok0 = true, bool ok1 = true) {
  float mxl[2];
#pragma unroll
  for (int qt = 0; qt < 2; ++qt) {
    float mx = -1e30f;
    const bool okq = qt == 0 ? ok0 : ok1;
#pragma unroll
    for (int kt = 0; kt < 4; ++kt)
#pragma unroll
      for (int r = 0; r < 4; ++r) {
        if (MODE == 1) s[kt][qt][r] = valid(kt, r, qt) ? s[kt][qt][r] : -1e30f;
        if (MODE == 2) s[kt][qt][r] = okq ? s[kt][qt][r] : -1e30f;
        mx = fmaxf(mx, s[kt][qt][r]);
      }
    mxl[qt] = mx;
  }
  if (a.fresh || __any(mxl[0] > DEFER_THR || mxl[1] > DEFER_THR)) {
    bool still = false;
#pragma unroll
    for (int qt = 0; qt < 2; ++qt) {
      float mx = mxl[qt];
      mx = fmaxf(mx, __shfl_xor(mx, 16)); mx = fmaxf(mx, __shfl_xor(mx, 32));
      const bool fresh = rel_rowsum(a, qt, l15_) == 0.f;
      const float dl = mx < -1e29f ? 0.f : (fresh ? mx : fmaxf(mx, 0.f)), alpha = exp2_(-dl);
      still = still || (fresh && mx < -1e29f);
      a.m[qt] += dl; a.os[qt] *= alpha;
#pragma unroll
      for (int d = 0; d < 4; ++d) a.o[d][qt] *= alpha;
#pragma unroll
      for (int kt = 0; kt < 4; ++kt)
#pragma unroll
        for (int r = 0; r < 4; ++r) s[kt][qt][r] -= dl;
    }
    a.fresh = __any(still) ? 1 : 0;
  }
#pragma unroll
  for (int qt = 0; qt < 2; ++qt)
#pragma unroll
    for (int kt = 0; kt < 4; ++kt)
#pragma unroll
      for (int r = 0; r < 4; ++r) s[kt][qt][r] = exp2_(s[kt][qt][r]);
  pack_p(s, pf);
}
template <class LoadF, class CompF>
DI void kv_pipeline3(int j0, int j1, u16* buf, LoadF load, CompF comp) {
  KVRegs kr;
  load(j0, kr);
  lds_barrier();
  kv_store(buf, buf + 64 * KLD, kr);
  if (j0 + 1 < j1) load(j0 + 1, kr);
  lds_barrier();
  int cb = 0;
  for (int j = j0; j < j1; ++j) {
    const int nb = cb == 2 ? 0 : cb + 1, pb = cb == 0 ? 2 : cb - 1;
    if (j + 1 < j1) kv_store(buf + nb * KVBUF, buf + nb * KVBUF + 64 * KLD, kr);
    if (j + 2 < j1) load(j + 2, kr);
    comp(j, buf + cb * KVBUF, buf + pb * KVBUF);
    lds_barrier();
    cb = nb;
  }
}
DI float group_sum4(float v) { v += __shfl_xor(v, 16); v += __shfl_xor(v, 32); return v; }

constexpr int DSTAGE = 2 * 128 * 64;
DI int fKs(int row) { return (row >> 1) & 7; }
DI int fVs(int row) { return ((row >> 1) & 3) << 1; }
DI void kv_dma128(const u16* kbase, const u16* vbase, int ld, int key0, u16* stage, int tid) {
#pragma unroll
  for (int i = 0; i < 4; ++i) {
    const int id = tid + 256 * i, row = id >> 3, c8 = id & 7;
    __builtin_amdgcn_global_load_lds((const unsigned*)(kbase + (size_t)(key0 + row) * ld + ((c8 ^ fKs(row)) * 8)), (LDSP unsigned*)((LDSP char*)stage + id * 16), 16, 0, 0);
  }
#pragma unroll
  for (int i = 0; i < 4; ++i) {
    const int id = tid + 256 * i, row = id >> 3, c8 = id & 7;
    __builtin_amdgcn_global_load_lds((const unsigned*)(vbase + (size_t)(key0 + row) * ld + ((c8 ^ fVs(row)) * 8)), (LDSP unsigned*)((LDSP char*)(stage + 128 * 64) + id * 16), 16, 0, 0);
  }
}
template <int NKS>
DI void qk_tile_rel_sw(const u16* Kh, int dofs, const bf16x8 (&qf)[2][NKS], const AttnAcc& a, f32x4 (&s)[4][2], int l15, int g) {
  const float n0 = -a.m[0], n1 = -a.m[1];
  const int sw = (l15 >> 1) & 7;
#pragma unroll
  for (int kt = 0; kt < 4; ++kt) {
    s[kt][0] = (f32x4){n0, n0, n0, n0}; s[kt][1] = (f32x4){n1, n1, n1, n1};
#pragma unroll
    for (int ks = 0; ks < NKS; ++ks) {
      const bf16x8 k = ldfrag(Kh + (kt * 16 + l15) * 64 + ((((dofs >> 3) + ks * 4 + g) ^ sw) * 8));
      s[kt][0] = mfma16(k, qf[0][ks], s[kt][0]);
      s[kt][1] = mfma16(k, qf[1][ks], s[kt][1]);
    }
  }
}
DI void pv_accum_sw(const bf16x8 (&pf)[2][2], const u16* Vh, f32x4 (&o)[4][2], int l15, int g) {
  const int tq = l15 >> 2, tp = l15 & 3;
#pragma unroll
  for (int kk = 0; kk < 2; ++kk) {
    const int r0 = kk * 32 + 4 * g + tq, r1 = r0 + 16;
    const int f0 = fVs(r0), f1 = fVs(r1);
#pragma unroll
    for (int d = 0; d < 4; ++d) {
      const int lc = d * 2 + (tp >> 1);
      const bf16x8 vf = cat4(tr_read(Vh + r0 * 64 + ((lc ^ f0) * 8) + (tp & 1) * 4), tr_read(Vh + r1 * 64 + ((lc ^ f1) * 8) + (tp & 1) * 4));
      o[d][0] = mfma16(vf, pf[0][kk], o[d][0]);
      o[d][1] = mfma16(vf, pf[1][kk], o[d][1]);
    }
  }
}
DI void diff_attn_task(const Params& p, int layer, int b, int h, int qb, unsigned char* smem, bool skew) {
  u16* Ks = (u16*)smem; u16* Vs = Ks + 64 * KLD;
  const int tid = otid(), lane = tid & 63, wid = tid >> 6, l15 = lane & 15, g = lane >> 4;
  const u16* proj = (const u16*)(p.ws + OFF_PROJ) + (size_t)b * SEQ * NP;
  const int q0w = qb * 128 + wid * 32;
  const float* lam = p.diff_lam + layer * 128;
  float s01 = 0.f, s23 = 0.f;
  for (int i = 0; i < 32; ++i) { s01 += lam[i] * lam[32 + i]; s23 += lam[64 + i] * lam[96 + i]; }
  const float lam_init = layer == 0 ? 0.2f : 0.35550906759096324f;
  const float lam_full = sgprf(__expf(s01) - __expf(s23) + lam_init);
  const float sc = 0.17677669529663687f * 1.4426950408889634f;
  const int ntile = 2 * qb + 2;
  const u16* vbase = proj + PB_V + h * 64;
  f32x4 res[4][2];
#pragma unroll 1
  for (int c = 0; c < 2; ++c) {
    const u16* kbase = proj + PB_K + h * 64;
    bf16x8 qf[2][1];
#pragma unroll
    for (int qt = 0; qt < 2; ++qt) qf[qt][0] = scale_frag(ldfrag(proj + (size_t)(q0w + qt * 16 + l15) * NP + PB_Q + h * 64 + c * 32 + 8 * g), sc);
    AttnAcc a; attn_init_rel(a);
    const int nst = qb + 1;
    asm volatile("s_waitcnt vmcnt(0)" ::: "memory");
    lds_barrier();
    kv_dma128(kbase, vbase, NP, 0, Ks, tid);
    asm volatile("s_waitcnt vmcnt(0)" ::: "memory");
    lds_barrier();
    for (int js = 0; js < nst; ++js) {
      const u16* st = Ks + (js & 1) * DSTAGE;
      if (js + 1 < nst) kv_dma128(kbase, vbase, NP, (js + 1) * 128, Ks + ((js + 1) & 1) * DSTAGE, tid);
#pragma unroll 1
      for (int hf = 0; hf < 2; ++hf) {
        const int key0 = js * 128 + hf * 64;
        if (key0 <= q0w + 31) {
          f32x4 s[4][2]; bf16x8 pf[2][2];
          auto valid = [&](int kt, int r, int qt) { return key0 + kt * 16 + 4 * g + r <= q0w + qt * 16 + l15; };
          qk_tile_rel_sw<1>(st + hf * 64 * 64, c * 32, qf, a, s, l15, g);
          if (key0 + 63 <= q0w) softmax_rel<0>(s, a, pf, l15, valid); else softmax_rel<1>(s, a, pf, l15, valid);
          pv_accum_sw(pf, st + 128 * 64 + hf * 64 * 64, a.o, l15, g);
          rowsum_accum(pf, a, l15);
        }
      }
      asm volatile("s_waitcnt vmcnt(0)" ::: "memory");
      lds_barrier();
    }
#pragma unroll
    for (int qt = 0; qt < 2; ++qt) {
      const float lt = rel_rowsum(a, qt, l15);
      const float inv = c == 0 ? 1.f / lt : -lam_full / lt;
#pragma unroll
      for (int d = 0; d < 4; ++d) res[d][qt] = c == 0 ? a.o[d][qt] * inv : res[d][qt] + a.o[d][qt] * inv;
    }
  }
  u16* Y = (u16*)(p.ws + OFF_H);
  const float* ng = p.diff_norm_g + layer * 64;
#pragma unroll
  for (int qt = 0; qt < 2; ++qt) {
    float ss = 0.f;
#pragma unroll
    for (int d = 0; d < 4; ++d) { const f32x4 v = res[d][qt]; ss += v[0] * v[0] + v[1] * v[1] + v[2] * v[2] + v[3] * v[3]; }
    ss = group_sum4(ss);
    const float rn = rsqrtf(ss * (1.f / 64.f) + 1e-6f) * (1.f - lam_init);
    const int t = q0w + qt * 16 + l15;
    const size_t row = (size_t)b * SEQ + t;
#pragma unroll
    for (int d = 0; d < 4; ++d) {
      const int dd = d * 16 + 4 * g;
      const f32x4 v = res[d][qt];
      const u32x2 zz = *(const u32x2*)(proj + (size_t)t * NP + PB_Z + h * 64 + dd);
      const f32x4 gg = *(const f32x4*)(ng + dd);
      u32x2 w;
      w.x = pack2(v[0] * rn * gg[0] * siluf(bflo(zz.x)), v[1] * rn * gg[1] * siluf(bfhi(zz.x)));
      w.y = pack2(v[2] * rn * gg[2] * siluf(bflo(zz.y)), v[3] * rn * gg[3] * siluf(bfhi(zz.y)));
      *(u32x2*)(Y + row * 1024 + Y_B + h * 64 + dd) = w;
    }
  }
}

template <int NKS>
DI void qk_tile1(const u16* Ks, const bf16x8 (&qf)[NKS], f32x4 (&s)[4], int l15, int g) {
#pragma unroll
  for (int kt = 0; kt < 4; ++kt) {
    s[kt] = (f32x4){0.f, 0.f, 0.f, 0.f};
#pragma unroll
    for (int ks = 0; ks < NKS; ++ks) s[kt] = mfma16(ldfrag(Ks + (kt * 16 + l15) * KLD + ks * 32 + 8 * g), qf[ks], s[kt]);
  }
}
DI void pv_accum1(const f32x4 (&s)[4], const u16* Vs, f32x4 (&o)[4], int l15, int g) {
  const int tq = l15 >> 2, tp = l15 & 3;
#pragma unroll
  for (int kk = 0; kk < 2; ++kk) {
    u32x4 w;
    w.x = pack2(s[2 * kk][0], s[2 * kk][1]); w.y = pack2(s[2 * kk][2], s[2 * kk][3]);
    w.z = pack2(s[2 * kk + 1][0], s[2 * kk + 1][1]); w.w = pack2(s[2 * kk + 1][2], s[2 * kk + 1][3]);
    const bf16x8 pf = __builtin_bit_cast(bf16x8, w);
#pragma unroll
    for (int d = 0; d < 4; ++d) {
      const bf16x8 vf = cat4(tr_read(Vs + (kk * 32 + 4 * g + tq) * KLD + d * 16 + 4 * tp), tr_read(Vs + (kk * 32 + 16 + 4 * g + tq) * KLD + d * 16 + 4 * tp));
      o[d] = mfma16(vf, pf, o[d]);
    }
  }
}
DI void conv_silu_stage(const u16* projb, int col0, const float* cw, const float* cb, int chan0, int nchan, int t0, u16* dst, const float* rowscale, float cscale) {
  const int tid = otid(), ch = (tid & 7) * 8;
  float w[4][8], bias[8];
#pragma unroll
  for (int j = 0; j < 4; ++j)
#pragma unroll
    for (int i = 0; i < 8; ++i) w[j][i] = cw[j * nchan + chan0 + ch + i];
#pragma unroll
  for (int i = 0; i < 8; ++i) bias[i] = cb[chan0 + ch + i];
#pragma unroll 1
  for (int ps = 0; ps < 4; ++ps) {
    const int row = ps * 32 + (tid >> 3), t = t0 + row;
    float acc[8];
#pragma unroll
    for (int i = 0; i < 8; ++i) acc[i] = bias[i];
#pragma unroll
    for (int j = 0; j < 4; ++j) {
      const int tt = t - 3 + j;
      if (tt >= 0) {
        const u32x4 v = *(const u32x4*)(projb + (size_t)tt * NP + col0 + ch);
        acc[0] += w[j][0] * bflo(v.x); acc[1] += w[j][1] * bfhi(v.x); acc[2] += w[j][2] * bflo(v.y); acc[3] += w[j][3] * bfhi(v.y);
        acc[4] += w[j][4] * bflo(v.z); acc[5] += w[j][5] * bfhi(v.z); acc[6] += w[j][6] * bflo(v.w); acc[7] += w[j][7] * bfhi(v.w);
      }
    }
    const float rs = (rowscale ? rowscale[row] : 1.f) * cscale;
#pragma unroll
    for (int i = 0; i < 8; ++i) acc[i] = siluf(acc[i]) * rs;
    u32x4 o; o.x = pack2(acc[0], acc[1]); o.y = pack2(acc[2], acc[3]); o.z = pack2(acc[4], acc[5]); o.w = pack2(acc[6], acc[7]);
    *(u32x4*)(dst + row * KLD + ch) = o;
  }
}
DI float block_scan128_add(float v, float* tmp) {
  const int tid = otid(), lane = tid & 63;
  float x = v;
#pragma unroll
  for (int o = 1; o < 64; o <<= 1) { const float y = __shfl_up(x, o); if (lane >= o) x += y; }
  lds_barrier();
  if (tid == 63) tmp[0] = x;
  lds_barrier();
  if ((tid >> 6) == 1) x += tmp[0];
  return x;
}
DI float block_scan128_max(float v, float* tmp) {
  const int tid = otid(), lane = tid & 63;
  float x = v;
#pragma unroll
  for (int o = 1; o < 64; o <<= 1) { const float y = __shfl_up(x, o); if (lane >= o) x = fmaxf(x, y); }
  lds_barrier();
  if (tid == 63) tmp[0] = x;
  lds_barrier();
  if ((tid >> 6) == 1) x = fmaxf(x, tmp[0]);
  return x;
}
DI void scale_rows(u16* A, const float* rs) {
  const int tid = otid(), ch = (tid & 7) * 8;
#pragma unroll
  for (int ps = 0; ps < 4; ++ps) {
    const int row = ps * 32 + (tid >> 3);
    const float f = rs[row];
    u32x4 v = *(u32x4*)(A + row * KLD + ch);
    v.x = pack2(bflo(v.x) * f, bfhi(v.x) * f); v.y = pack2(bflo(v.y) * f, bfhi(v.y) * f);
    v.z = pack2(bflo(v.z) * f, bfhi(v.z) * f); v.w = pack2(bflo(v.w) * f, bfhi(v.w) * f);
    *(u32x4*)(A + row * KLD + ch) = v;
  }
}
DI void state_update(const u16* Xs, const u16* Bs, f32x4 (&acc)[4], int w, int l15, int g) {
  const int tq = l15 >> 2, tp = l15 & 3;
#pragma unroll
  for (int kk = 0; kk < 4; ++kk) {
    const bf16x8 af = cat4(tr_read(Xs + (kk * 32 + 4 * g + tq) * KLD + w * 16 + 4 * tp), tr_read(Xs + (kk * 32 + 16 + 4 * g + tq) * KLD + w * 16 + 4 * tp));
#pragma unroll
    for (int nt = 0; nt < 4; ++nt) {
      const bf16x8 bfr = cat4(tr_read(Bs + (kk * 32 + 4 * g + tq) * KLD + nt * 16 + 4 * tp), tr_read(Bs + (kk * 32 + 16 + 4 * g + tq) * KLD + nt * 16 + 4 * tp));
      acc[nt] = mfma16(af, bfr, acc[nt]);
    }
  }
}
DI void state_to_lds(u16* Ss, const f32x4 (&acc)[4], int w, int l15, int g) {
#pragma unroll
  for (int nt = 0; nt < 4; ++nt)
#pragma unroll
    for (int r = 0; r < 4; ++r) Ss[(w * 16 + 4 * g + r) * KLD + nt * 16 + l15] = f2bf(acc[nt][r]);
}

constexpr int SEQ_LDS_A = 0, SEQ_LDS_B = 128 * KLD * 2, SEQ_LDS_C = 2 * 128 * KLD * 2, SEQ_LDS_S = 3 * 128 * KLD * 2, SEQ_LDS_F = SEQ_LDS_S + 64 * KLD * 2;
constexpr int SEQ_LDS_HALO = SEQ_LDS_F + 4096;
constexpr int SEQ_LDS_CW = SEQ_LDS_HALO + 2 * 3 * 3 * 64 * 2;
struct RawRegs { u32x4 r[4]; };
DI void raw_load(const u16* projb, int col0, int t0, RawRegs& rr, int tid) {
#pragma unroll
  for (int i = 0; i < 4; ++i) rr.r[i] = *(const u32x4*)(projb + (size_t)(t0 + (tid >> 3) + 32 * i) * NP + col0 + (tid & 7) * 8);
}
DI void raw_store(u16* dst, u16* halo_next, const RawRegs& rr, int tid) {
#pragma unroll
  for (int i = 0; i < 4; ++i) *(u32x4*)(dst + ((tid >> 3) + 32 * i) * KLD + (tid & 7) * 8) = rr.r[i];
  if (halo_next && tid >= 232) *(u32x4*)(halo_next + ((tid >> 3) - 29) * 64 + (tid & 7) * 8) = rr.r[3];
}
DI void conv_from_lds(const u16* raw, const u16* halo, const float* wl, const float* rowscale, float cscale, u32x4 (&out)[4], int tid) {
  const int q = tid >> 3, ch = (tid & 7) * 8;
  u32x4 v[7];
#pragma unroll
  for (int k = 0; k < 7; ++k) { const int r = 4 * q - 3 + k; v[k] = r >= 0 ? *(const u32x4*)(raw + r * KLD + ch) : *(const u32x4*)(halo + (r + 3) * 64 + ch); }
  float w[5][8];
#pragma unroll
  for (int j = 0; j < 5; ++j) { const f32x4 w0 = *(const f32x4*)(wl + j * 64 + ch), w1 = *(const f32x4*)(wl + j * 64 + ch + 4);
    w[j][0] = w0[0]; w[j][1] = w0[1]; w[j][2] = w0[2]; w[j][3] = w0[3]; w[j][4] = w1[0]; w[j][5] = w1[1]; w[j][6] = w1[2]; w[j][7] = w1[3]; }
#pragma unroll
  for (int o = 0; o < 4; ++o) {
    float acc[8];
#pragma unroll
    for (int i = 0; i < 8; ++i) acc[i] = w[4][i];
#pragma unroll
    for (int j = 0; j < 4; ++j) {
      const u32x4 x = v[o + j];
      acc[0] += w[j][0] * bflo(x.x); acc[1] += w[j][1] * bfhi(x.x); acc[2] += w[j][2] * bflo(x.y); acc[3] += w[j][3] * bfhi(x.y);
      acc[4] += w[j][4] * bflo(x.z); acc[5] += w[j][5] * bfhi(x.z); acc[6] += w[j][6] * bflo(x.w); acc[7] += w[j][7] * bfhi(x.w);
    }
    const float rs = (rowscale ? rowscale[4 * q + o] : 1.f) * cscale;
#pragma unroll
    for (int i = 0; i < 8; ++i) acc[i] = siluf(acc[i]) * rs;
    out[o].x = pack2(acc[0], acc[1]); out[o].y = pack2(acc[2], acc[3]); out[o].z = pack2(acc[4], acc[5]); out[o].w = pack2(acc[6], acc[7]);
  }
}
DI void conv_write(u16* dst, const u32x4 (&out)[4], int tid) {
  const int q = tid >> 3, ch = (tid & 7) * 8;
#pragma unroll
  for (int o = 0; o < 4; ++o) *(u32x4*)(dst + (4 * q + o) * KLD + ch) = out[o];
}
DI void stage_conv_w(float* wl, const float* cw, const float* cb, int chan0, int nchan, int tid) {
  for (int i = tid; i < 320; i += 256) { const int j = i >> 6, cc = i & 63; wl[i] = j < 4 ? cw[j * nchan + chan0 + cc] : cb[chan0 + cc]; }
}
DI float wave_scan_add(float x, int lane) {
#pragma unroll
  for (int o = 1; o < 64; o <<= 1) { const float y = __shfl_up(x, o); if (lane >= o) x += y; }
  return x;
}
DI float wave_scan_max(float x, int lane) {
#pragma unroll
  for (int o = 1; o < 64; o <<= 1) { const float y = __shfl_up(x, o); if (lane >= o) x = fmaxf(x, y); }
  return x;
}

DI void ssd_task(const Params& p, int layer, int b, int h, unsigned char* smem) {
  u16* Cs = (u16*)(smem + SEQ_LDS_A); u16* Bs = (u16*)(smem + SEQ_LDS_B); u16* Xs = (u16*)(smem + SEQ_LDS_C); u16* Ss = (u16*)(smem + SEQ_LDS_S);
  float* fl = (float*)(smem + SEQ_LDS_F);
  float* dts = fl; float* acs = fl + 128; float* wend = fl + 256; float* tmp = fl + 384;
  u16* halo = (u16*)(smem + SEQ_LDS_HALO); float* cwl = (float*)(smem + SEQ_LDS_CW);
  int tid = otid(), lane = tid & 63, w = tid >> 6, l15 = lane & 15, g = lane >> 4;
  const int gi = h >> 1;
  const u16* projb = (const u16*)(p.ws + OFF_PROJ) + (size_t)b * SEQ * NP;
  const float* smb = (const float*)(p.ws + OFF_SMALL) + (size_t)b * SEQ * NSMALL;
  const float* cw = p.ssm_conv_w + layer * 4 * 512; const float* cb = p.ssm_conv_b + layer * 512;
  u16* Y = (u16*)(p.ws + OFF_H);
  const float a_h = -__expf(p.ssm_a_log[layer * 4 + h]), d_h = p.ssm_d[layer * 4 + h], dtb = p.ssm_dt_bias[layer * 4 + h];
  const int colB = PC_XBC + 256 + gi * 64, colC = PC_XBC + 384 + gi * 64, colX = PC_XBC + h * 64;
  f32x4 st[4];
#pragma unroll
  for (int nt = 0; nt < 4; ++nt) st[nt] = (f32x4){0.f, 0.f, 0.f, 0.f};
  lds_barrier();
  stage_conv_w(cwl, cw, cb, 256 + gi * 64, 512, tid);
  stage_conv_w(cwl + 320, cw, cb, 384 + gi * 64, 512, tid);
  stage_conv_w(cwl + 640, cw, cb, h * 64, 512, tid);
  for (int i = tid; i < 3 * 3 * 64; i += 256) halo[i] = 0;
  RawRegs rB, rC, rX; float dtraw = 0.f;
  raw_load(projb, colB, 0, rB, tid); raw_load(projb, colC, 0, rC, tid); raw_load(projb, colX, 0, rX, tid);
  if (tid < 128) dtraw = smb[(size_t)tid * NSMALL + SM_DT + h];
#pragma unroll 1
  for (int c = 0; c < 32; ++c) {
    const int t0 = c * 128;
    asm volatile("" : "+v"(tid)); lane = tid & 63; w = tid >> 6; l15 = lane & 15; g = lane >> 4;
    u16* hcur = halo + (c & 1) * 576; u16* hnext = halo + ((c + 1) & 1) * 576;
    float dtv = 0.f;
    if (tid < 128) { const float xr = dtraw + dtb; dtv = xr > 15.f ? xr : __logf(1.f + __expf(xr)); }
    float cs = wave_scan_add(dtv * a_h, lane);
    if (tid == 63) tmp[0] = cs;
    lds_barrier();
    if (w == 1) cs += tmp[0];
    if (tid < 128) { dts[tid] = dtv; acs[tid] = cs; }
    raw_store(Bs, hnext, rB, tid); raw_store(Cs, hnext + 192, rC, tid); raw_store(Xs, hnext + 384, rX, tid);
    lds_barrier();
    if (c + 1 < 32) {
      raw_load(projb, colB, t0 + 128, rB, tid); raw_load(projb, colC, t0 + 128, rC, tid);
      if (tid < 128) dtraw = smb[(size_t)(t0 + 128 + tid) * NSMALL + SM_DT + h];
    }
    {
      u32x4 o1[4], o2[4];
      conv_from_lds(Bs, hcur, cwl, nullptr, 1.f, o1, tid);
      lds_barrier();
      conv_write(Bs, o1, tid);
      conv_from_lds(Cs, hcur + 192, cwl + 320, nullptr, 1.f, o2, tid);
      lds_barrier();
      conv_write(Cs, o2, tid);
      conv_from_lds(Xs, hcur + 384, cwl + 640, dts, 1.f, o1, tid);
      lds_barrier();
      conv_write(Xs, o1, tid);
    }
    if (tid < 128) wend[tid] = __expf(acs[127] - acs[tid]);
    state_to_lds(Ss, st, w, l15, g);
    lds_barrier();
#pragma unroll 1
    for (int qt = 0; qt < 2; ++qt) {
      const int tl = 32 * w + qt * 16 + l15;
      bf16x8 cf[2];
#pragma unroll
      for (int ks = 0; ks < 2; ++ks) cf[ks] = ldfrag(Cs + tl * KLD + ks * 32 + 8 * g);
      f32x4 y[4];
#pragma unroll
      for (int d = 0; d < 4; ++d) y[d] = (f32x4){0.f, 0.f, 0.f, 0.f};
      const float at = acs[tl];
#pragma unroll 1
      for (int stl = 0; stl < 2; ++stl) {
        if (stl * 64 <= 32 * w + qt * 16 + 15) {
          f32x4 sc[4];
          qk_tile1<2>(Bs + stl * 64 * KLD, cf, sc, l15, g);
#pragma unroll
          for (int kt = 0; kt < 4; ++kt) {
            const f32x4 as = *(const f32x4*)(acs + stl * 64 + kt * 16 + 4 * g);
#pragma unroll
            for (int r = 0; r < 4; ++r) {
              const bool ok = stl * 64 + kt * 16 + 4 * g + r <= tl;
              sc[kt][r] = ok ? sc[kt][r] * __expf(at - as[r]) : 0.f;
            }
          }
          pv_accum1(sc, Xs + stl * 64 * KLD, y, l15, g);
        }
      }
      const float ea = __expf(at), dsk = d_h / dts[tl];
      const size_t row = (size_t)b * SEQ + t0 + tl;
#pragma unroll
      for (int d = 0; d < 4; ++d) {
        f32x4 yo = (f32x4){0.f, 0.f, 0.f, 0.f};
#pragma unroll
        for (int ks = 0; ks < 2; ++ks) yo = mfma16(ldfrag(Ss + (d * 16 + l15) * KLD + ks * 32 + 8 * g), cf[ks], yo);
        const u32x2 xv = *(const u32x2*)(Xs + tl * KLD + d * 16 + 4 * g);
        const f32x4 v = y[d] + yo * ea;
        u32x2 o; o.x = pack2(v[0] + dsk * bflo(xv.x), v[1] + dsk * bfhi(xv.x)); o.y = pack2(v[2] + dsk * bflo(xv.y), v[3] + dsk * bfhi(xv.y));
        *(u32x2*)(Y + row * 1024 + Y_C + h * 64 + d * 16 + 4 * g) = o;
      }
    }
    if (c + 1 < 32) raw_load(projb, colX, t0 + 128, rX, tid);
    lds_barrier();
    scale_rows(Xs, wend);
    lds_barrier();
    const float cd = __expf(acs[127]);
#pragma unroll
    for (int nt = 0; nt < 4; ++nt) st[nt] *= cd;
    state_update(Xs, Bs, st, w, l15, g);
  }
}
DI void seq_fix_rows(const Params& p, int layer, int r0, int nrows) {
  u16* Y = (u16*)(p.ws + OFF_H);
  const u16* proj = (const u16*)(p.ws + OFF_PROJ);
  const int tid = otid(), lane = tid & 63, wv = tid >> 6;
  const bool ml = lane >= 32;
  const int ch = (lane & 31) * 8;
  const float* ng = ml ? p.ml_norm_g + layer * 64 + (ch & 63) : p.ssm_norm_g + layer * 256 + ch;
  const f32x4 g0 = *(const f32x4*)ng, g1 = *(const f32x4*)(ng + 4);
  for (int rb = wv * 4; rb < nrows; rb += 16) {
    u32x4 yv4[4], zv4[4], ov4[4];
#pragma unroll
    for (int j = 0; j < 4; ++j) {
      const size_t row = (size_t)(r0 + rb + j);
      yv4[j] = *(const u32x4*)(Y + row * 1024 + (ml ? Y_D : Y_C) + ch);
      zv4[j] = *(const u32x4*)(proj + row * NP + (ml ? PD_Z : PC_Z) + ch);
      ov4[j] = ml ? *(const u32x4*)(proj + row * NP + PD_O + ch) : (u32x4){0u, 0u, 0u, 0u};
    }
#pragma unroll
    for (int j = 0; j < 4; ++j) {
      const size_t row = (size_t)(r0 + rb + j);
      u16* yp = Y + row * 1024 + (ml ? Y_D : Y_C) + ch;
      const u32x4 yv = yv4[j], zv = zv4[j], ov = ov4[j];
      float v[8] = {bflo(yv.x), bfhi(yv.x), bflo(yv.y), bfhi(yv.y), bflo(yv.z), bfhi(yv.z), bflo(yv.w), bfhi(yv.w)};
      float z[8] = {bflo(zv.x), bfhi(zv.x), bflo(zv.y), bfhi(zv.y), bflo(zv.z), bfhi(zv.z), bflo(zv.w), bfhi(zv.w)};
      float ss = 0.f;
      if (ml) {
        const float o[8] = {bflo(ov.x), bfhi(ov.x), bflo(ov.y), bfhi(ov.y), bflo(ov.z), bfhi(ov.z), bflo(ov.w), bfhi(ov.w)};
#pragma unroll
        for (int i = 0; i < 8; ++i) { v[i] *= sigmoidf_(o[i]); ss += v[i] * v[i]; }
      } else {
#pragma unroll
        for (int i = 0; i < 8; ++i) { v[i] *= siluf(z[i]); ss += v[i] * v[i]; }
      }
      ss += __shfl_xor(ss, 1); ss += __shfl_xor(ss, 2); ss += __shfl_xor(ss, 4);
      const float ss16 = ss + __shfl_xor(ss, 8);
      const float rn = ml ? rsqrtf(ss * (1.f / 64.f) + 1e-6f) : rsqrtf(ss16 * (1.f / 128.f) + 1e-6f);
      float o8[8];
#pragma unroll
      for (int i = 0; i < 8; ++i) { const float gg = i < 4 ? g0[i & 3] : g1[i & 3]; o8[i] = v[i] * rn * gg * (ml ? siluf(z[i]) : 1.f); }
      u32x4 w; w.x = pack2(o8[0], o8[1]); w.y = pack2(o8[2], o8[3]); w.z = pack2(o8[4], o8[5]); w.w = pack2(o8[6], o8[7]);
      *(u32x4*)yp = w;
    }
  }
}

DI void mlstm_task(const Params& p, int layer, int b, int h, unsigned char* smem) {
  u16* Qs = (u16*)(smem + SEQ_LDS_A); u16* Ks2 = (u16*)(smem + SEQ_LDS_B); u16* Vs2 = (u16*)(smem + SEQ_LDS_C); u16* Cst = (u16*)(smem + SEQ_LDS_S);
  float* fl = (float*)(smem + SEQ_LDS_F);
  float* bcs = fl; float* us = fl + 128; float* pms = fl + 256; float* wend = fl + 384; float* nst = fl + 512; float* npart = fl + 576; float* tmp = fl + 832;
  u16* halo = (u16*)(smem + SEQ_LDS_HALO); float* cwl = (float*)(smem + SEQ_LDS_CW);
  int tid = otid(), lane = tid & 63, w = tid >> 6, l15 = lane & 15, g = lane >> 4;
  const u16* projb = (const u16*)(p.ws + OFF_PROJ) + (size_t)b * SEQ * NP;
  const float* smb = (const float*)(p.ws + OFF_SMALL) + (size_t)b * SEQ * NSMALL;
  const float* cw = p.ml_conv_w + layer * 4 * 512; const float* cb = p.ml_conv_b + layer * 512;
  const float ib = p.ml_if_b[layer * 8 + h], fb = p.ml_if_b[layer * 8 + 4 + h];
  u16* Y = (u16*)(p.ws + OFF_H);
  const int colQ = PD_QK + h * 64, colK = PD_QK + 256 + h * 64, colV = PD_V + h * 64;
  f32x4 st[4];
#pragma unroll
  for (int nt = 0; nt < 4; ++nt) st[nt] = (f32x4){0.f, 0.f, 0.f, 0.f};
  float m_prev = 0.f;
  lds_barrier();
  if (tid < 64) nst[tid] = 0.f;
  stage_conv_w(cwl, cw, cb, h * 64, 512, tid);
  stage_conv_w(cwl + 320, cw, cb, 256 + h * 64, 512, tid);
  for (int i = tid; i < 3 * 3 * 64; i += 256) halo[i] = 0;
  RawRegs rQ, rK, rV; float iraw = 0.f, fraw = 0.f;
  raw_load(projb, colQ, 0, rQ, tid); raw_load(projb, colK, 0, rK, tid); raw_load(projb, colV, 0, rV, tid);
  if (tid < 128) { iraw = smb[(size_t)tid * NSMALL + SM_IF + h]; fraw = smb[(size_t)tid * NSMALL + SM_IF + 4 + h]; }
#pragma unroll 1
  for (int c = 0; c < 32; ++c) {
    const int t0 = c * 128;
    asm volatile("" : "+v"(tid)); lane = tid & 63; w = tid >> 6; l15 = lane & 15; g = lane >> 4;
    u16* hcur = halo + (c & 1) * 576; u16* hnext = halo + ((c + 1) & 1) * 576;
    float ip = 0.f, lf = 0.f;
    if (tid < 128) { ip = iraw + ib; const float fp = fraw + fb; lf = fminf(fp, 0.f) - __logf(1.f + __expf(-fabsf(fp))); }
    float bc = wave_scan_add(lf, lane);
    if (tid == 63) tmp[0] = bc;
    lds_barrier();
    if (w == 1) bc += tmp[0];
    const float u = tid < 128 ? ip - bc : -1e30f;
    float pm = wave_scan_max(u, lane);
    if (tid == 63) tmp[1] = pm;
    raw_store(Qs, hnext, rQ, tid); raw_store(Ks2, hnext + 192, rK, tid); raw_store(Vs2, nullptr, rV, tid);
    lds_barrier();
    if (w == 1) pm = fmaxf(pm, tmp[1]);
    if (tid < 128) { bcs[tid] = bc; us[tid] = u; pms[tid] = pm; }
    if (c + 1 < 32) {
      raw_load(projb, colQ, t0 + 128, rQ, tid);
      if (tid < 128) { iraw = smb[(size_t)(t0 + 128 + tid) * NSMALL + SM_IF + h]; fraw = smb[(size_t)(t0 + 128 + tid) * NSMALL + SM_IF + 4 + h]; }
    }
    u32x4 oQ[4], oK[4];
    conv_from_lds(Qs, hcur, cwl, nullptr, 1.f, oQ, tid);
    __builtin_amdgcn_sched_barrier(0);
    conv_from_lds(Ks2, hcur + 192, cwl + 320, nullptr, 0.125f, oK, tid);
    __builtin_amdgcn_sched_barrier(0);
    lds_barrier();
    conv_write(Qs, oQ, tid); conv_write(Ks2, oK, tid);
    state_to_lds(Cst, st, w, l15, g);
    const float blast = bcs[127];
    const float m_new = blast + fmaxf(m_prev, pms[127]);
    if (tid < 128) wend[tid] = __expf(blast - m_new + us[tid]);
    lds_barrier();
#pragma unroll 1
    for (int qt = 0; qt < 2; ++qt) {
      const int tl = 32 * w + qt * 16 + l15;
      bf16x8 qf[2];
#pragma unroll
      for (int ks = 0; ks < 2; ++ks) qf[ks] = ldfrag(Qs + tl * KLD + ks * 32 + 8 * g);
      f32x4 num[4];
#pragma unroll
      for (int d = 0; d < 4; ++d) num[d] = (f32x4){0.f, 0.f, 0.f, 0.f};
      const float bt = bcs[tl], mt = bt + fmaxf(m_prev, pms[tl]);
      float den = 0.f;
#pragma unroll 1
      for (int stl = 0; stl < 2; ++stl) {
        if (stl * 64 <= 32 * w + qt * 16 + 15) {
          f32x4 sc[4];
          qk_tile1<2>(Ks2 + stl * 64 * KLD, qf, sc, l15, g);
#pragma unroll
          for (int kt = 0; kt < 4; ++kt) {
            const f32x4 uu = *(const f32x4*)(us + stl * 64 + kt * 16 + 4 * g);
#pragma unroll
            for (int r = 0; r < 4; ++r) {
              const bool ok = stl * 64 + kt * 16 + 4 * g + r <= tl;
              const float v = ok ? sc[kt][r] * __expf(bt - mt + uu[r]) : 0.f;
              sc[kt][r] = v; den += v;
            }
          }
          pv_accum1(sc, Vs2 + stl * 64 * KLD, num, l15, g);
        }
      }
      const float wi = __expf(bt + m_prev - mt);
      float qn = 0.f;
#pragma unroll
      for (int ks = 0; ks < 2; ++ks)
#pragma unroll
        for (int j = 0; j < 8; ++j) qn += bf2f((u16)qf[ks][j]) * nst[ks * 32 + 8 * g + j];
      qn = group_sum4(qn);
      const float dn = group_sum4(den) + wi * qn;
      const float inv = __builtin_amdgcn_rcpf(fmaxf(fabsf(dn), __expf(-mt)));
      const size_t row = (size_t)b * SEQ + t0 + tl;
#pragma unroll
      for (int d = 0; d < 4; ++d) {
        f32x4 ni = (f32x4){0.f, 0.f, 0.f, 0.f};
#pragma unroll
        for (int ks = 0; ks < 2; ++ks) ni = mfma16(ldfrag(Cst + (d * 16 + l15) * KLD + ks * 32 + 8 * g), qf[ks], ni);
        const f32x4 v = (num[d] + ni * wi) * inv;
        u32x2 o; o.x = pack2(v[0], v[1]); o.y = pack2(v[2], v[3]);
        *(u32x2*)(Y + row * 1024 + Y_D + h * 64 + d * 16 + 4 * g) = o;
      }
    }
    if (c + 1 < 32) { raw_load(projb, colK, t0 + 128, rK, tid); raw_load(projb, colV, t0 + 128, rV, tid); }
    lds_barrier();
    scale_rows(Ks2, wend);
    lds_barrier();
    const float fprev = __expf(blast + m_prev - m_new);
#pragma unroll
    for (int nt = 0; nt < 4; ++nt) st[nt] *= fprev;
    state_update(Vs2, Ks2, st, w, l15, g);
    {
      const int e = tid & 63, part = tid >> 6;
      float a = 0.f;
      for (int s2 = part * 32; s2 < part * 32 + 32; ++s2) a += bf2f(Ks2[s2 * KLD + e]);
      npart[part * 64 + e] = a;
    }
    lds_barrier();
    if (tid < 64) nst[tid] = nst[tid] * fprev + npart[tid] + npart[64 + tid] + npart[128 + tid] + npart[192 + tid];
    m_prev = m_new;
  }
}

constexpr int SEQ8_LDS_F = SEQ_LDS_S + 64 * KLD * 2;
constexpr int SEQ8_LDS_HALO = SEQ8_LDS_F + 8192;
constexpr int SEQ8_LDS_CW = SEQ8_LDS_HALO + 2 * 3 * 3 * 64 * 2;
struct RawRegs2 { u32x4 r[2]; };
DI void raw_load8(const u16* projb, int col0, int t0, RawRegs2& rr, int tid) {
#pragma unroll
  for (int i = 0; i < 2; ++i) rr.r[i] = *(const u32x4*)(projb + (size_t)(t0 + (tid >> 3) + 64 * i) * NP + col0 + (tid & 7) * 8);
}
DI void raw_store8(u16* dst, u16* halo_next, const RawRegs2& rr, int tid) {
#pragma unroll
  for (int i = 0; i < 2; ++i) *(u32x4*)(dst + ((tid >> 3) + 64 * i) * KLD + (tid & 7) * 8) = rr.r[i];
  if (halo_next && tid >= 488) *(u32x4*)(halo_next + ((tid >> 3) - 61) * 64 + (tid & 7) * 8) = rr.r[1];
}
DI void conv_from_lds8(const u16* raw, const u16* halo, const float* wl, const float* rowscale, float cscale, u32x4 (&out)[2], int tid) {
  const int q = tid >> 3, ch = (tid & 7) * 8;
  u32x4 v[5];
#pragma unroll
  for (int k = 0; k < 5; ++k) { const int r = 2 * q - 3 + k; v[k] = r >= 0 ? *(const u32x4*)(raw + r * KLD + ch) : *(const u32x4*)(halo + (r + 3) * 64 + ch); }
  float w[5][8];
#pragma unroll
  for (int j = 0; j < 5; ++j) { const f32x4 w0 = *(const f32x4*)(wl + j * 64 + ch), w1 = *(const f32x4*)(wl + j * 64 + ch + 4);
    w[j][0] = w0[0]; w[j][1] = w0[1]; w[j][2] = w0[2]; w[j][3] = w0[3]; w[j][4] = w1[0]; w[j][5] = w1[1]; w[j][6] = w1[2]; w[j][7] = w1[3]; }
#pragma unroll
  for (int o = 0; o < 2; ++o) {
    float acc[8];
#pragma unroll
    for (int i = 0; i < 8; ++i) acc[i] = w[4][i];
#pragma unroll
    for (int j = 0; j < 4; ++j) {
      const u32x4 x = v[o + j];
      acc[0] += w[j][0] * bflo(x.x); acc[1] += w[j][1] * bfhi(x.x); acc[2] += w[j][2] * bflo(x.y); acc[3] += w[j][3] * bfhi(x.y);
      acc[4] += w[j][4] * bflo(x.z); acc[5] += w[j][5] * bfhi(x.z); acc[6] += w[j][6] * bflo(x.w); acc[7] += w[j][7] * bfhi(x.w);
    }
    const float rs = (rowscale ? rowscale[2 * q + o] : 1.f) * cscale;
#pragma unroll
    for (int i = 0; i < 8; ++i) acc[i] = siluf(acc[i]) * rs;
    out[o].x = pack2(acc[0], acc[1]); out[o].y = pack2(acc[2], acc[3]); out[o].z = pack2(acc[4], acc[5]); out[o].w = pack2(acc[6], acc[7]);
  }
}
DI void conv_write8(u16* dst, const u32x4 (&out)[2], int tid) {
  const int q = tid >> 3, ch = (tid & 7) * 8;
#pragma unroll
  for (int o = 0; o < 2; ++o) *(u32x4*)(dst + (2 * q + o) * KLD + ch) = out[o];
}
DI void stage_conv_w8(float* wl, const float* cw, const float* cb, int chan0, int nchan, int tid) {
  if (tid < 320) { const int j = tid >> 6, cc = tid & 63; wl[tid] = j < 4 ? cw[j * nchan + chan0 + cc] : cb[chan0 + cc]; }
}
DI void scale_rows8(u16* A, const float* rs, int tid) {
  const int ch = (tid & 7) * 8;
#pragma unroll
  for (int i = 0; i < 2; ++i) {
    const int row = (tid >> 3) + 64 * i;
    const float f = rs[row];
    u32x4 v = *(u32x4*)(A + row * KLD + ch);
    v.x = pack2(bflo(v.x) * f, bfhi(v.x) * f); v.y = pack2(bflo(v.y) * f, bfhi(v.y) * f);
    v.z = pack2(bflo(v.z) * f, bfhi(v.z) * f); v.w = pack2(bflo(v.w) * f, bfhi(v.w) * f);
    *(u32x4*)(A + row * KLD + ch) = v;
  }
}
DI void state_update8(const u16* Xs, const u16* Bs, f32x4 (&acc)[2], int w8, int l15, int g) {
  const int tq = l15 >> 2, tp = l15 & 3, pt = w8 >> 1, nt0 = (w8 & 1) * 2;
#pragma unroll
  for (int kk = 0; kk < 4; ++kk) {
    const bf16x8 af = cat4(tr_read(Xs + (kk * 32 + 4 * g + tq) * KLD + pt * 16 + 4 * tp), tr_read(Xs + (kk * 32 + 16 + 4 * g + tq) * KLD + pt * 16 + 4 * tp));
#pragma unroll
    for (int n = 0; n < 2; ++n) {
      const bf16x8 bfr = cat4(tr_read(Bs + (kk * 32 + 4 * g + tq) * KLD + (nt0 + n) * 16 + 4 * tp), tr_read(Bs + (kk * 32 + 16 + 4 * g + tq) * KLD + (nt0 + n) * 16 + 4 * tp));
      acc[n] = mfma16(af, bfr, acc[n]);
    }
  }
}
DI void state_to_lds8(u16* Ss, const f32x4 (&acc)[2], int w8, int l15, int g) {
  const int pt = w8 >> 1, nt0 = (w8 & 1) * 2;
#pragma unroll
  for (int n = 0; n < 2; ++n)
#pragma unroll
    for (int r = 0; r < 4; ++r) Ss[(pt * 16 + 4 * g + r) * KLD + (nt0 + n) * 16 + l15] = f2bf(acc[n][r]);
}

constexpr int SEQ8_LDS_ZERO = SEQ8_LDS_CW + 3 * 320 * 4;
constexpr int SEQ8_LDS_RAW = ((SEQ8_LDS_ZERO + 3 * 128 + 255) / 256) * 256;
DI void raw_dma8(const u16* projb, int col0, int t0, u16* raw, int tid) {
#pragma unroll
  for (int i = 0; i < 2; ++i) {
    const int chunk = tid + 512 * i;
    __builtin_amdgcn_global_load_lds((const unsigned*)(projb + (size_t)(t0 + (chunk >> 3)) * NP + col0 + (chunk & 7) * 8), (LDSP unsigned*)((LDSP char*)raw + chunk * 16), 16, 0, 0);
  }
}
DI void conv_raw8(const u16* raw, const u16* halo, const float* wl, const float* rowscale, float cscale, u16* dst, int tid) {
  const int q = tid >> 3, ch = (tid & 7) * 8;
  u32x4 v[5];
#pragma unroll
  for (int k = 0; k < 5; ++k) { const int r = 2 * q - 3 + k; v[k] = r >= 0 ? *(const u32x4*)(raw + r * 64 + ch) : *(const u32x4*)(halo + (r + 3) * 64 + ch); }
  float w[5][8];
#pragma unroll
  for (int j = 0; j < 5; ++j) { const f32x4 w0 = *(const f32x4*)(wl + j * 64 + ch), w1 = *(const f32x4*)(wl + j * 64 + ch + 4);
    w[j][0] = w0[0]; w[j][1] = w0[1]; w[j][2] = w0[2]; w[j][3] = w0[3]; w[j][4] = w1[0]; w[j][5] = w1[1]; w[j][6] = w1[2]; w[j][7] = w1[3]; }
#pragma unroll
  for (int o = 0; o < 2; ++o) {
    float acc[8];
#pragma unroll
    for (int i = 0; i < 8; ++i) acc[i] = w[4][i];
#pragma unroll
    for (int j = 0; j < 4; ++j) {
      const u32x4 x = v[o + j];
      acc[0] += w[j][0] * bflo(x.x); acc[1] += w[j][1] * bfhi(x.x); acc[2] += w[j][2] * bflo(x.y); acc[3] += w[j][3] * bfhi(x.y);
      acc[4] += w[j][4] * bflo(x.z); acc[5] += w[j][5] * bfhi(x.z); acc[6] += w[j][6] * bflo(x.w); acc[7] += w[j][7] * bfhi(x.w);
    }
    const float rs = (rowscale ? rowscale[2 * q + o] : 1.f) * cscale;
#pragma unroll
    for (int i = 0; i < 8; ++i) acc[i] = siluf(acc[i]) * rs;
    u32x4 ov; ov.x = pack2(acc[0], acc[1]); ov.y = pack2(acc[2], acc[3]); ov.z = pack2(acc[4], acc[5]); ov.w = pack2(acc[6], acc[7]);
    *(u32x4*)(dst + (2 * q + o) * KLD + ch) = ov;
  }
}
DI void save_halo8(const u16* raw, u16* halo, int tid) {
  if (tid < 72) { const int arr = tid / 24, rem = tid % 24; *(u32x4*)(halo + arr * 192 + rem * 8) = *(const u32x4*)(raw + arr * 8192 + 125 * 64 + rem * 8); }
}

DI void ssd_task8(const Params& p, int layer, int b, int h, unsigned char* smem) {
  u16* Cs = (u16*)(smem + SEQ_LDS_A); u16* Bs = (u16*)(smem + SEQ_LDS_B); u16* Xs = (u16*)(smem + SEQ_LDS_C); u16* Ss = (u16*)(smem + SEQ_LDS_S);
  float* fl = (float*)(smem + SEQ8_LDS_F);
  float* dts = fl; float* acs = fl + 128; float* wend = fl + 256; float* tmp = fl + 384;
  u16* halo = (u16*)(smem + SEQ8_LDS_HALO); float* cwl = (float*)(smem + SEQ8_LDS_CW); u16* zero3 = (u16*)(smem + SEQ8_LDS_ZERO);
  u16* raw = (u16*)(smem + SEQ8_LDS_RAW);
  int tid = otid512(), lane = tid & 63, w = tid >> 6, l15 = lane & 15, g = lane >> 4;
  const int gi = h >> 1;
  const u16* projb = (const u16*)(p.ws + OFF_PROJ) + (size_t)b * SEQ * NP;
  const float* smb = (const float*)(p.ws + OFF_SMALL) + (size_t)b * SEQ * NSMALL;
  const float* cw = p.ssm_conv_w + layer * 4 * 512; const float* cb = p.ssm_conv_b + layer * 512;
  u16* Y = (u16*)(p.ws + OFF_H);
  const float a_h = sgprf(-__expf(p.ssm_a_log[layer * 4 + h])), d_h = sgprf(p.ssm_d[layer * 4 + h]), dtb = sgprf(p.ssm_dt_bias[layer * 4 + h]);
  const int colB = PC_XBC + 256 + gi * 64, colC = PC_XBC + 384 + gi * 64, colX = PC_XBC + h * 64;
  f32x4 st[2] = {(f32x4){0.f, 0.f, 0.f, 0.f}, (f32x4){0.f, 0.f, 0.f, 0.f}};
  lds_barrier();
  stage_conv_w8(cwl, cw, cb, 256 + gi * 64, 512, tid);
  stage_conv_w8(cwl + 320, cw, cb, 384 + gi * 64, 512, tid);
  stage_conv_w8(cwl + 640, cw, cb, h * 64, 512, tid);
  if (tid < 96) ((unsigned*)zero3)[tid] = 0u;
  raw_dma8(projb, colB, 0, raw, tid); raw_dma8(projb, colC, 0, raw + 8192, tid); raw_dma8(projb, colX, 0, raw + 16384, tid);
  float dtraw = 0.f;
  if (tid < 128) dtraw = smb[(size_t)tid * NSMALL + SM_DT + h];
#pragma unroll 1
  for (int c = 0; c < 32; ++c) {
    const int t0 = c * 128;
    asm volatile("" : "+v"(tid)); lane = tid & 63; w = tid >> 6; l15 = lane & 15; g = lane >> 4;
    float dtv = 0.f;
    if (tid < 128) { const float xr = dtraw + dtb; dtv = xr > 15.f ? xr : __logf(1.f + __expf(xr)); }
    float cs = wave_scan_add(dtv * a_h, lane);
    if (tid == 63) tmp[0] = cs;
    asm volatile("s_waitcnt vmcnt(0)" ::: "memory");
    lds_barrier();
    if (w == 1) cs += tmp[0];
    if (tid < 128) { dts[tid] = dtv; acs[tid] = cs; }
    if (c + 1 < 32 && tid < 128) dtraw = smb[(size_t)(t0 + 128 + tid) * NSMALL + SM_DT + h];
    lds_barrier();
    {
      const u16* hc = halo + (c & 1) * 576;
      const u16* hB = c == 0 ? zero3 : hc; const u16* hC = c == 0 ? zero3 : hc + 192; const u16* hX = c == 0 ? zero3 : hc + 384;
      conv_raw8(raw, hB, cwl, nullptr, 1.f, Bs, tid);
      conv_raw8(raw + 8192, hC, cwl + 320, nullptr, 1.f, Cs, tid);
      conv_raw8(raw + 16384, hX, cwl + 640, dts, 1.f, Xs, tid);
      save_halo8(raw, halo + ((c + 1) & 1) * 576, tid);
    }
    if (tid < 128) wend[tid] = __expf(acs[127] - acs[tid]);
    state_to_lds8(Ss, st, w, l15, g);
    lds_barrier();
    if (c + 1 < 32) { raw_dma8(projb, colB, t0 + 128, raw, tid); raw_dma8(projb, colC, t0 + 128, raw + 8192, tid); raw_dma8(projb, colX, t0 + 128, raw + 16384, tid); }
    {
      const int tl = 16 * w + l15;
      bf16x8 cf[2];
#pragma unroll
      for (int ks = 0; ks < 2; ++ks) cf[ks] = ldfrag(Cs + tl * KLD + ks * 32 + 8 * g);
      f32x4 y[4];
#pragma unroll
      for (int d = 0; d < 4; ++d) y[d] = (f32x4){0.f, 0.f, 0.f, 0.f};
      const float at = acs[tl];
#pragma unroll 1
      for (int stl = 0; stl < 2; ++stl) {
        if (stl * 64 <= 16 * w + 15) {
          f32x4 sc[4];
          qk_tile1<2>(Bs + stl * 64 * KLD, cf, sc, l15, g);
#pragma unroll
          for (int kt = 0; kt < 4; ++kt) {
            const f32x4 as = *(const f32x4*)(acs + stl * 64 + kt * 16 + 4 * g);
#pragma unroll
            for (int r = 0; r < 4; ++r) {
              const bool ok = stl * 64 + kt * 16 + 4 * g + r <= tl;
              sc[kt][r] = ok ? sc[kt][r] * __expf(at - as[r]) : 0.f;
            }
          }
          pv_accum1(sc, Xs + stl * 64 * KLD, y, l15, g);
        }
      }
      const float ea = __expf(at), dsk = d_h / dts[tl];
      const size_t row = (size_t)b * SEQ + t0 + tl;
#pragma unroll
      for (int d = 0; d < 4; ++d) {
        f32x4 yo = (f32x4){0.f, 0.f, 0.f, 0.f};
#pragma unroll
        for (int ks = 0; ks < 2; ++ks) yo = mfma16(ldfrag(Ss + (d * 16 + l15) * KLD + ks * 32 + 8 * g), cf[ks], yo);
        const u32x2 xv = *(const u32x2*)(Xs + tl * KLD + d * 16 + 4 * g);
        const f32x4 v = y[d] + yo * ea;
        u32x2 o; o.x = pack2(v[0] + dsk * bflo(xv.x), v[1] + dsk * bfhi(xv.x)); o.y = pack2(v[2] + dsk * bflo(xv.y), v[3] + dsk * bfhi(xv.y));
        *(u32x2*)(Y + row * 1024 + Y_C + h * 64 + d * 16 + 4 * g) = o;
      }
    }
    lds_barrier();
    scale_rows8(Xs, wend, tid);
    lds_barrier();
    const float cd = __expf(acs[127]);
    st[0] *= cd; st[1] *= cd;
    state_update8(Xs, Bs, st, w, l15, g);
  }
  asm volatile("s_waitcnt vmcnt(0)" ::: "memory");
}

DI void mlstm_task8(const Params& p, int layer, int b, int h, unsigned char* smem) {
  u16* Qs = (u16*)(smem + SEQ_LDS_A); u16* Ks2 = (u16*)(smem + SEQ_LDS_B); u16* Vs2 = (u16*)(smem + SEQ_LDS_C); u16* Cst = (u16*)(smem + SEQ_LDS_S);
  float* fl = (float*)(smem + SEQ8_LDS_F);
  float* bcs = fl; float* us = fl + 128; float* pms = fl + 256; float* wend = fl + 384; float* nst = fl + 512; float* tmp = fl + 576; float* npart = fl + 640;
  u16* halo = (u16*)(smem + SEQ8_LDS_HALO); float* cwl = (float*)(smem + SEQ8_LDS_CW); u16* zero3 = (u16*)(smem + SEQ8_LDS_ZERO);
  u16* raw = (u16*)(smem + SEQ8_LDS_RAW);
  int tid = otid512(), lane = tid & 63, w = tid >> 6, l15 = lane & 15, g = lane >> 4;
  const u16* projb = (const u16*)(p.ws + OFF_PROJ) + (size_t)b * SEQ * NP;
  const float* smb = (const float*)(p.ws + OFF_SMALL) + (size_t)b * SEQ * NSMALL;
  const float* cw = p.ml_conv_w + layer * 4 * 512; const float* cb = p.ml_conv_b + layer * 512;
  const float ib = sgprf(p.ml_if_b[layer * 8 + h]), fb = sgprf(p.ml_if_b[layer * 8 + 4 + h]);
  u16* Y = (u16*)(p.ws + OFF_H);
  const int colQ = PD_QK + h * 64, colK = PD_QK + 256 + h * 64, colV = PD_V + h * 64;
  f32x4 st[2] = {(f32x4){0.f, 0.f, 0.f, 0.f}, (f32x4){0.f, 0.f, 0.f, 0.f}};
  float m_prev = 0.f;
  lds_barrier();
  if (tid < 64) nst[tid] = 0.f;
  stage_conv_w8(cwl, cw, cb, h * 64, 512, tid);
  stage_conv_w8(cwl + 320, cw, cb, 256 + h * 64, 512, tid);
  if (tid < 96) ((unsigned*)zero3)[tid] = 0u;
  raw_dma8(projb, colQ, 0, raw, tid); raw_dma8(projb, colK, 0, raw + 8192, tid); raw_dma8(projb, colV, 0, raw + 16384, tid);
  float iraw = 0.f, fraw = 0.f;
  if (tid < 128) { iraw = smb[(size_t)tid * NSMALL + SM_IF + h]; fraw = smb[(size_t)tid * NSMALL + SM_IF + 4 + h]; }
#pragma unroll 1
  for (int c = 0; c < 32; ++c) {
    const int t0 = c * 128;
    asm volatile("" : "+v"(tid)); lane = tid & 63; w = tid >> 6; l15 = lane & 15; g = lane >> 4;
    float ip = 0.f, lf = 0.f;
    if (tid < 128) { ip = iraw + ib; const float fp = fraw + fb; lf = fminf(fp, 0.f) - __logf(1.f + __expf(-fabsf(fp))); }
    float bc = wave_scan_add(lf, lane);
    if (tid == 63) tmp[0] = bc;
    asm volatile("s_waitcnt vmcnt(0)" ::: "memory");
    lds_barrier();
    if (w == 1) bc += tmp[0];
    const float u = tid < 128 ? ip - bc : -1e30f;
    float pm = wave_scan_max(u, lane);
    if (tid == 63) tmp[1] = pm;
    if (c + 1 < 32 && tid < 128) { iraw = smb[(size_t)(t0 + 128 + tid) * NSMALL + SM_IF + h]; fraw = smb[(size_t)(t0 + 128 + tid) * NSMALL + SM_IF + 4 + h]; }
    {
      const u16* hc = halo + (c & 1) * 576;
      const u16* hQ = c == 0 ? zero3 : hc; const u16* hK = c == 0 ? zero3 : hc + 192;
      conv_raw8(raw, hQ, cwl, nullptr, 1.f, Qs, tid);
      conv_raw8(raw + 8192, hK, cwl + 320, nullptr, 0.125f, Ks2, tid);
      save_halo8(raw, halo + ((c + 1) & 1) * 576, tid);
#pragma unroll
      for (int i = 0; i < 2; ++i) { const int chunk = tid + 512 * i; *(u32x4*)(Vs2 + (chunk >> 3) * KLD + (chunk & 7) * 8) = *(const u32x4*)(raw + 16384 + chunk * 8); }
    }
    state_to_lds8(Cst, st, w, l15, g);
    lds_barrier();
    if (w == 1) pm = fmaxf(pm, tmp[1]);
    if (tid < 128) { bcs[tid] = bc; us[tid] = u; pms[tid] = pm; }
    if (c + 1 < 32) { raw_dma8(projb, colQ, t0 + 128, raw, tid); raw_dma8(projb, colK, t0 + 128, raw + 8192, tid); raw_dma8(projb, colV, t0 + 128, raw + 16384, tid); }
    lds_barrier();
    const float blast = bcs[127];
    const float m_new = blast + fmaxf(m_prev, pms[127]);
    if (tid < 128) wend[tid] = __expf(blast - m_new + us[tid]);
    {
      const int tl = 16 * w + l15;
      bf16x8 qf[2];
#pragma unroll
      for (int ks = 0; ks < 2; ++ks) qf[ks] = ldfrag(Qs + tl * KLD + ks * 32 + 8 * g);
      f32x4 num[4];
#pragma unroll
      for (int d = 0; d < 4; ++d) num[d] = (f32x4){0.f, 0.f, 0.f, 0.f};
      const float bt = bcs[tl], mt = bt + fmaxf(m_prev, pms[tl]);
      float den = 0.f;
#pragma unroll 1
      for (int stl = 0; stl < 2; ++stl) {
        if (stl * 64 <= 16 * w + 15) {
          f32x4 sc[4];
          qk_tile1<2>(Ks2 + stl * 64 * KLD, qf, sc, l15, g);
#pragma unroll
          for (int kt = 0; kt < 4; ++kt) {
            const f32x4 uu = *(const f32x4*)(us + stl * 64 + kt * 16 + 4 * g);
#pragma unroll
            for (int r = 0; r < 4; ++r) {
              const bool ok = stl * 64 + kt * 16 + 4 * g + r <= tl;
              const float v = ok ? sc[kt][r] * __expf(bt - mt + uu[r]) : 0.f;
              sc[kt][r] = v; den += v;
            }
          }
          pv_accum1(sc, Vs2 + stl * 64 * KLD, num, l15, g);
        }
      }
      const float wi = __expf(bt + m_prev - mt);
      float qn = 0.f;
#pragma unroll
      for (int ks = 0; ks < 2; ++ks)
#pragma unroll
        for (int j = 0; j < 8; ++j) qn += bf2f((u16)qf[ks][j]) * nst[ks * 32 + 8 * g + j];
      qn = group_sum4(qn);
      const float dn = group_sum4(den) + wi * qn;
      const float inv = __builtin_amdgcn_rcpf(fmaxf(fabsf(dn), __expf(-mt)));
      const size_t row = (size_t)b * SEQ + t0 + tl;
#pragma unroll
      for (int d = 0; d < 4; ++d) {
        f32x4 ni = (f32x4){0.f, 0.f, 0.f, 0.f};
#pragma unroll
        for (int ks = 0; ks < 2; ++ks) ni = mfma16(ldfrag(Cst + (d * 16 + l15) * KLD + ks * 32 + 8 * g), qf[ks], ni);
        const f32x4 v = (num[d] + ni * wi) * inv;
        u32x2 o; o.x = pack2(v[0], v[1]); o.y = pack2(v[2], v[3]);
        *(u32x2*)(Y + row * 1024 + Y_D + h * 64 + d * 16 + 4 * g) = o;
      }
    }
    lds_barrier();
    scale_rows8(Ks2, wend, tid);
    lds_barrier();
    const float fprev = __expf(blast + m_prev - m_new);
    st[0] *= fprev; st[1] *= fprev;
    state_update8(Vs2, Ks2, st, w, l15, g);
    {
      const int e = tid & 63, part = tid >> 6;
      float a = 0.f;
#pragma unroll
      for (int s2 = 0; s2 < 16; ++s2) a += bf2f(Ks2[(part * 16 + s2) * KLD + e]);
      npart[part * 64 + e] = a;
    }
    lds_barrier();
    if (tid < 64) {
      float a = nst[tid] * fprev;
#pragma unroll
      for (int pp = 0; pp < 8; ++pp) a += npart[pp * 64 + tid];
      nst[tid] = a;
    }
    m_prev = m_new;
  }
  asm volatile("s_waitcnt vmcnt(0)" ::: "memory");
}

DI void compress_task(const Params& p, int layer, int b, int kv, int rb, unsigned char* smem) {
  constexpr int HLD = 136;
  u16* Hs = (u16*)smem;
  const int tid = otid(), lane = tid & 63, w = tid >> 6, l15 = lane & 15, g = lane >> 4;
  const u16* projb = (const u16*)(p.ws + OFF_PROJ) + (size_t)b * SEQ * NP + (kv ? PA_VC : PA_KC);
  const int mi = layer * 2 + kv;
  const u16* W1T = (const u16*)(p.ws + OFF_W1T) + (size_t)mi * 128 * 2048;
  const u16* W2T = (const u16*)(p.ws + OFF_W2T) + (size_t)mi * 64 * 128;
  const float* bias1 = (const float*)(p.ws + OFF_BIAS1) + mi * 16 * 128;
  f32x4 acc[2][2];
#pragma unroll
  for (int nt = 0; nt < 2; ++nt) { acc[nt][0] = (f32x4){0.f, 0.f, 0.f, 0.f}; acc[nt][1] = (f32x4){0.f, 0.f, 0.f, 0.f}; }
  int tok[2];
#pragma unroll
  for (int mt = 0; mt < 2; ++mt) { int i = rb * 32 + mt * 16 + l15; if (i > 254) i = 254; tok[mt] = 16 * i; }
#pragma unroll 4
  for (int ks = 0; ks < 64; ++ks) {
    const int j = ks >> 1, d0 = (ks & 1) * 32;
    bf16x8 af[2], wf[2];
#pragma unroll
    for (int mt = 0; mt < 2; ++mt) af[mt] = ldfrag(projb + (size_t)(tok[mt] + j) * NP + d0 + 8 * g);
#pragma unroll
    for (int nt = 0; nt < 2; ++nt) wf[nt] = ldfrag(W1T + (size_t)(w * 32 + nt * 16 + l15) * 2048 + ks * 32 + 8 * g);
#pragma unroll
    for (int nt = 0; nt < 2; ++nt)
#pragma unroll
      for (int mt = 0; mt < 2; ++mt) acc[nt][mt] = mfma16(wf[nt], af[mt], acc[nt][mt]);
  }
  lds_barrier();
#pragma unroll
  for (int nt = 0; nt < 2; ++nt) {
    const int n = w * 32 + nt * 16 + 4 * g;
    f32x4 bb = *(const f32x4*)(bias1 + n);
#pragma unroll
    for (int pc = 1; pc < 16; ++pc) bb += *(const f32x4*)(bias1 + pc * 128 + n);
#pragma unroll
    for (int mt = 0; mt < 2; ++mt) {
      const f32x4 v = acc[nt][mt] + bb;
      u32x2 o; o.x = pack2(siluf(v[0]), siluf(v[1])); o.y = pack2(siluf(v[2]), siluf(v[3]));
      *(u32x2*)(Hs + (mt * 16 + l15) * HLD + n) = o;
    }
  }
  lds_barrier();
  f32x4 acc2[2] = {(f32x4){0.f, 0.f, 0.f, 0.f}, (f32x4){0.f, 0.f, 0.f, 0.f}};
#pragma unroll
  for (int ks = 0; ks < 4; ++ks) {
    const bf16x8 wf = ldfrag(W2T + (size_t)(w * 16 + l15) * 128 + ks * 32 + 8 * g);
#pragma unroll
    for (int mt = 0; mt < 2; ++mt) acc2[mt] = mfma16(wf, ldfrag(Hs + (mt * 16 + l15) * HLD + ks * 32 + 8 * g), acc2[mt]);
  }
  u16* dst = (u16*)(p.ws + (kv ? OFF_VCMP : OFF_KCMP) + (size_t)layer * 512 * 1024) + (size_t)b * 256 * 64;
#pragma unroll
  for (int mt = 0; mt < 2; ++mt) {
    const int i = rb * 32 + mt * 16 + l15;
    u32x2 o; o.x = pack2(acc2[mt][0], acc2[mt][1]); o.y = pack2(acc2[mt][2], acc2[mt][3]);
    if (i > 254) { o.x = 0u; o.y = 0u; }
    *(u32x2*)(dst + (size_t)i * 64 + w * 16 + 4 * g) = o;
  }
}

DI void nsa_task(const Params& p, int layer, int b, int qi, unsigned char* smem) {
  u16* Ks = (u16*)smem; u16* Vs = Ks + 64 * KLD;
  float* T = (float*)(smem + 2 * KVBUF * 2);
  unsigned long long* selm = (unsigned long long*)(smem + 2 * KVBUF * 2 + 4 * 32 * 65 * 4);
  const int tid = otid(), lane = tid & 63, h = tid >> 6, l15 = lane & 15, g = lane >> 4;
  const int q0 = qi * 32;
  const u16* projb = (const u16*)(p.ws + OFF_PROJ) + (size_t)b * SEQ * NP;
  const float* smb = (const float*)(p.ws + OFF_SMALL) + (size_t)b * SEQ * NSMALL;
  const u16* kcmp = (const u16*)(p.ws + OFF_KCMP + (size_t)layer * 512 * 1024) + (size_t)b * 256 * 64;
  const u16* vcmp = (const u16*)(p.ws + OFF_VCMP + (size_t)layer * 512 * 1024) + (size_t)b * 256 * 64;
  bf16x8 qf[2][2];
#pragma unroll
  for (int qt = 0; qt < 2; ++qt)
#pragma unroll
    for (int ks = 0; ks < 2; ++ks) qf[qt][ks] = ldfrag(projb + (size_t)(q0 + qt * 16 + l15) * NP + PA_Q + h * 64 + ks * 32 + 8 * g);
  const float sc = 0.125f * 1.4426950408889634f;
  f32x4 outacc[4][2];
  AttnAcc a;
  const int ntc = (q0 >> 10) + 1;
  attn_init(a);
  lds_barrier();
  for (int i = tid; i < 4 * 32 * 65; i += 256) T[i] = 0.f;
  kv_pipeline(0, ntc, Ks,
    [&](int) { return true; },
    [&](int j, KVRegs& kr) { kv_load(kcmp, vcmp, 64, 64, j * 64, kr); },
    [&](int j, const u16* Kt, const u16* Vt) {
      f32x4 s[4][2];
      auto valid = [&](int kt, int r, int qt) { return 16 * (j * 64 + kt * 16 + 4 * g + r) + 31 <= q0 + qt * 16 + l15; };
      qk_tile<2>(Kt, 0, qf, s, l15, g);
      softmax_pv(s, a, Vt, sc, l15, g, valid);
    });
  float cinv[2];
#pragma unroll
  for (int qt = 0; qt < 2; ++qt) {
    const float lt = group_sum4(a.l[qt]);
    cinv[qt] = lt > 0.f ? 1.f / lt : 0.f;
    const float gt = sigmoidf_(smb[(size_t)(q0 + qt * 16 + l15) * NSMALL + SM_G + h * 3 + 0]) * cinv[qt];
#pragma unroll
    for (int d = 0; d < 4; ++d) outacc[d][qt] = a.o[d][qt] * gt;
  }
  float carry[2] = {0.f, 0.f};
  kv_pipeline(0, ntc, Ks,
    [&](int) { return true; },
    [&](int j, KVRegs& kr) { kv_load(kcmp, vcmp, 64, 64, j * 64, kr); },
    [&](int j, const u16* Kt, const u16*) {
      f32x4 s[4][2];
      qk_tile<2>(Kt, 0, qf, s, l15, g);
#pragma unroll
      for (int qt = 0; qt < 2; ++qt) {
        float prev3 = carry[qt];
#pragma unroll
        for (int kt = 0; kt < 4; ++kt) {
          float pr[4];
#pragma unroll
          for (int r = 0; r < 4; ++r) {
            const bool ok = 16 * (j * 64 + kt * 16 + 4 * g + r) + 31 <= q0 + qt * 16 + l15;
            pr[r] = ok ? exp2_(s[kt][qt][r] * sc - a.m[qt]) * cinv[qt] : 0.f;
          }
          const float below = __shfl_up(pr[3], 16);
          const float wrap = __shfl(prev3, l15 + 48);
          const float nb = g > 0 ? below : wrap;
          T[(h * 32 + qt * 16 + l15) * 65 + j * 16 + kt * 4 + g] = (pr[0] + pr[1]) + (pr[2] + 0.5f * pr[3]) + 0.5f * nb;
          prev3 = pr[3];
        }
        carry[qt] = prev3;
      }
    });
  lds_barrier();
#pragma unroll 1
  for (int qq = 0; qq < 8; ++qq) {
    const int q = h * 8 + qq, t = q0 + q, cur = t >> 6;
    const float imp = ((T[(0 * 32 + q) * 65 + lane] + T[(1 * 32 + q) * 65 + lane]) + T[(2 * 32 + q) * 65 + lane]) + T[(3 * 32 + q) * 65 + lane];
    const bool forced = lane == cur || lane == 0, allowed = lane <= cur, cand = allowed && !forced;
    const int K = cur == 0 ? 15 : 14;
    unsigned long long m;
    if (__popcll(__ballot(cand)) <= K) m = __ballot(allowed);
    else {
      const unsigned key = __float_as_uint(imp);
      unsigned prefix = 0u;
#pragma unroll 1
      for (int bit = 30; bit >= 0; --bit) {
        const unsigned cnd = prefix | (1u << bit);
        if (__popcll(__ballot(cand && key >= cnd)) >= K) prefix = cnd;
      }
      const unsigned long long gt = __ballot(cand && key > prefix), eq = __ballot(cand && key == prefix);
      const int need = K - __popcll(gt);
      const int myrank = __popcll(eq & ((1ull << lane) - 1ull));
      m = gt | __ballot(cand && key == prefix && myrank < need) | __ballot(forced);
    }
    if (lane == 0) selm[q] = m;
  }
  lds_barrier();
  f32x4* park = (f32x4*)T + (h * 8) * 64 + lane;
#pragma unroll
  for (int d = 0; d < 4; ++d) { park[(d * 2 + 0) * 64] = outacc[d][0]; park[(d * 2 + 1) * 64] = outacc[d][1]; }
  unsigned long long mq[2], anym = 0ull;
#pragma unroll
  for (int qt = 0; qt < 2; ++qt) mq[qt] = selm[qt * 16 + l15];
  for (int i = 0; i < 32; ++i) anym |= selm[i];
  const int jhi = (q0 + 31) >> 6;
#pragma unroll
  for (int qt = 0; qt < 2; ++qt)
#pragma unroll
    for (int ks = 0; ks < 2; ++ks) qf[qt][ks] = scale_frag(qf[qt][ks], sc);
  attn_init_rel(a);
  kv_pipeline(0, jhi + 1, Ks,
    [&](int j) { return (bool)((anym >> j) & 1ull); },
    [&](int j, KVRegs& kr) { kv_load(projb + PA_KS, projb + PA_VS, NP, NP, j * 64, kr); },
    [&](int j, const u16* Kt, const u16* Vt) {
      f32x4 s[4][2];
      auto valid = [&](int kt, int r, int qt) { return ((mq[qt] >> j) & 1ull) && (j * 64 + kt * 16 + 4 * g + r <= q0 + qt * 16 + l15); };
      bf16x8 pf[2][2];
      if (j * 64 + 63 <= q0) {
        qk_tile_rel<2>(Kt, 0, qf, a, s, l15, g, (bool)((mq[0] >> j) & 1ull), (bool)((mq[1] >> j) & 1ull));
        softmax_rel<0>(s, a, pf, l15, valid);
      } else {
        qk_tile_rel<2>(Kt, 0, qf, a, s, l15, g);
        softmax_rel<1>(s, a, pf, l15, valid);
      }
      pv_accum(pf, Vt, a.o, l15, g);
      rowsum_accum(pf, a, l15);
    });
#pragma unroll
  for (int qt = 0; qt < 2; ++qt) {
    const float lt = rel_rowsum(a, qt, l15);
    const float gt = sigmoidf_(smb[(size_t)(q0 + qt * 16 + l15) * NSMALL + SM_G + h * 3 + 1]) * (lt > 0.f ? 1.f / lt : 0.f);
#pragma unroll
    for (int d = 0; d < 4; ++d) park[(d * 2 + qt) * 64] += a.o[d][qt] * gt;
  }
  attn_init_rel(a);
  const int jlo = q0 >= 511 ? (q0 - 511) >> 6 : 0;
  kv_pipeline(jlo, jhi + 1, Ks,
    [&](int) { return true; },
    [&](int j, KVRegs& kr) { kv_load(projb + PA_KW, projb + PA_VW, NP, NP, j * 64, kr); },
    [&](int j, const u16* Kt, const u16* Vt) {
      f32x4 s[4][2];
      auto valid = [&](int kt, int r, int qt) { const int key = j * 64 + kt * 16 + 4 * g + r, t = q0 + qt * 16 + l15; return key <= t && key + 512 > t; };
      bf16x8 pf[2][2];
      qk_tile_rel<2>(Kt, 0, qf, a, s, l15, g);
      if (j * 64 + 63 <= q0 && j * 64 + 512 > q0 + 31) softmax_rel<0>(s, a, pf, l15, valid);
      else softmax_rel<1>(s, a, pf, l15, valid);
      pv_accum(pf, Vt, a.o, l15, g);
      rowsum_accum(pf, a, l15);
    });
  u16* Y = (u16*)(p.ws + OFF_H);
  const float* ng = p.nsa_norm_g + layer * 64;
#pragma unroll
  for (int qt = 0; qt < 2; ++qt) {
    const int t = q0 + qt * 16 + l15;
    const float lt = rel_rowsum(a, qt, l15);
    const float gt = sigmoidf_(smb[(size_t)t * NSMALL + SM_G + h * 3 + 2]) * (lt > 0.f ? 1.f / lt : 0.f);
    f32x4 v[4]; float ss = 0.f;
#pragma unroll
    for (int d = 0; d < 4; ++d) { v[d] = park[(d * 2 + qt) * 64] + a.o[d][qt] * gt; ss += v[d][0] * v[d][0] + v[d][1] * v[d][1] + v[d][2] * v[d][2] + v[d][3] * v[d][3]; }
    ss = group_sum4(ss);
    const float rn = rsqrtf(ss * (1.f / 64.f) + 1e-6f);
    const size_t row = (size_t)b * SEQ + t;
#pragma unroll
    for (int d = 0; d < 4; ++d) {
      const int dd = d * 16 + 4 * g;
      const u32x2 zz = *(const u32x2*)(projb + (size_t)t * NP + PA_Z + h * 64 + dd);
      const f32x4 gg = *(const f32x4*)(ng + dd);
      u32x2 o;
      o.x = pack2(v[d][0] * rn * gg[0] * siluf(bflo(zz.x)), v[d][1] * rn * gg[1] * siluf(bfhi(zz.x)));
      o.y = pack2(v[d][2] * rn * gg[2] * siluf(bflo(zz.y)), v[d][3] * rn * gg[3] * siluf(bfhi(zz.y)));
      *(u32x2*)(Y + row * 1024 + Y_A + h * 64 + dd) = o;
    }
  }
}

DI void zero_y_cols(const Params& p, int c0, int ncols, int gtid, int gthreads) {
  u16* Y = (u16*)(p.ws + OFF_H);
  const int per_row = ncols / 8;
  for (size_t i = gtid; i < (size_t)NTOK * per_row; i += gthreads) {
    const size_t row = i / per_row; const int ch = (int)(i % per_row);
    *(u32x4*)(Y + row * 1024 + c0 + ch * 8) = (u32x4){0u, 0u, 0u, 0u};
  }
}

DI void final_norm_rows(const Params& p, int gw, int nw, int lane) {
  const float4* gp = (const float4*)p.final_g;
  float4 gg[4];
#pragma unroll
  for (int i = 0; i < 4; ++i) gg[i] = gp[lane + 64 * i];
  for (int row0 = gw * 4; row0 < NTOK; row0 += nw * 4) {
    float4 v[4][4]; float ss[4];
#pragma unroll
    for (int j = 0; j < 4; ++j) {
      const float4* xr = (const float4*)(p.out + (size_t)(row0 + j) * D_MODEL);
#pragma unroll
      for (int i = 0; i < 4; ++i) v[j][i] = xr[lane + 64 * i];
    }
#pragma unroll
    for (int j = 0; j < 4; ++j) {
      float a = 0.f;
#pragma unroll
      for (int i = 0; i < 4; ++i) a += v[j][i].x * v[j][i].x + v[j][i].y * v[j][i].y + v[j][i].z * v[j][i].z + v[j][i].w * v[j][i].w;
      ss[j] = wave_sum(a);
    }
#pragma unroll
    for (int j = 0; j < 4; ++j) {
      float4* xr = (float4*)(p.out + (size_t)(row0 + j) * D_MODEL);
      const float r = rsqrtf(ss[j] * (1.f / D_MODEL) + 1e-6f);
#pragma unroll
      for (int i = 0; i < 4; ++i) { float4 w; w.x = v[j][i].x * r * gg[i].x; w.y = v[j][i].y * r * gg[i].y; w.z = v[j][i].z * r * gg[i].z; w.w = v[j][i].w * r * gg[i].w; xr[lane + 64 * i] = w; }
    }
  }
}

#ifndef DEBUG_CHECK
#define DEBUG_CHECK 0
#endif
#if DEBUG_CHECK
constexpr int NCHK = 12;
DI float block_sum(float v, float* red) {
  v = wave_sum(v);
  lds_barrier();
  if ((threadIdx.x & 63) == 0) red[threadIdx.x >> 6] = v;
  lds_barrier();
  return red[0] + red[1] + red[2] + red[3];
}
DI float block_max(float v, float* red) {
#pragma unroll
  for (int o = 32; o > 0; o >>= 1) v = fmaxf(v, __shfl_xor(v, o));
  lds_barrier();
  if ((threadIdx.x & 63) == 0) red[threadIdx.x >> 6] = v;
  lds_barrier();
  return fmaxf(fmaxf(red[0], red[1]), fmaxf(red[2], red[3]));
}
DI float bfr(float v) { return bf2f(f2bf(v)); }
struct Chk { float num[NCHK], den[NCHK]; };
DI void chk_add(Chk& c, int id, float got, float ref) { const float d = got - ref; c.num[id] += d * d; c.den[id] += ref * ref; }

DI void dbg_diff_attn(const Params& p, int layer, int b, int t, int h, Chk& c, int id, unsigned char* smem) {
  float* p1 = (float*)smem; float* p2 = p1 + 4096; float* red = p2 + 4096;
  const int tid = otid();
  const u16* proj = (const u16*)(p.ws + OFF_PROJ) + (size_t)b * SEQ * NP;
  const u16* q = proj + (size_t)t * NP + PB_Q + h * 64;
  const float scale = 0.17677669529663687f;
  float m1 = -1e30f, m2 = -1e30f;
  for (int s = tid; s <= t; s += 256) {
    const u16* k = proj + (size_t)s * NP + PB_K + h * 64;
    float a1 = 0.f, a2 = 0.f;
    for (int d = 0; d < 32; ++d) { a1 += bf2f(q[d]) * bf2f(k[d]); a2 += bf2f(q[32 + d]) * bf2f(k[32 + d]); }
    a1 *= scale; a2 *= scale; p1[s] = a1; p2[s] = a2; m1 = fmaxf(m1, a1); m2 = fmaxf(m2, a2);
  }
  m1 = block_max(m1, red); m2 = block_max(m2, red);
  float l1 = 0.f, l2 = 0.f;
  for (int s = tid; s <= t; s += 256) { const float e1 = __expf(p1[s] - m1), e2 = __expf(p2[s] - m2); p1[s] = e1; p2[s] = e2; l1 += e1; l2 += e2; }
  l1 = block_sum(l1, red); l2 = block_sum(l2, red);
  const float* lam = p.diff_lam + layer * 128;
  float s01 = 0.f, s23 = 0.f;
  for (int i = 0; i < 32; ++i) { s01 += lam[i] * lam[32 + i]; s23 += lam[64 + i] * lam[96 + i]; }
  const float lam_init = 0.8f - 0.6f * expf(-0.3f * (float)layer);
  const float lam_full = expf(s01) - expf(s23) + lam_init;
  lds_barrier();
  float o = 0.f;
  if (tid < 64) for (int s = 0; s <= t; ++s) o += (p1[s] / l1 - lam_full * p2[s] / l2) * bf2f(proj[(size_t)s * NP + PB_V + h * 64 + tid]);
  float ss = block_sum(tid < 64 ? o * o : 0.f, red);
  if (tid < 64) {
    const float z = bf2f(proj[(size_t)t * NP + PB_Z + h * 64 + tid]);
    const float ref = o * rsqrtf(ss / 64.f + 1e-6f) * p.diff_norm_g[layer * 64 + tid] * (1.f - lam_init) * (z / (1.f + expf(-z)));
    const float got = bf2f(((const u16*)(p.ws + OFF_H))[((size_t)b * SEQ + t) * 1024 + Y_B + h * 64 + tid]);
    const float d = got - ref;
    o = d * d; ss = ref * ref;
  } else { o = 0.f; ss = 0.f; }
  c.num[id] += block_sum(o, red); c.den[id] += block_sum(ss, red);
}

DI float dbg_conv(const u16* projb, int t, int pcol, const float* cw, const float* cb, int ch, int nch) {
  float a = cb[ch];
  for (int j = 0; j < 4; ++j) { const int tt = t - 3 + j; if (tt >= 0) a += cw[j * nch + ch] * bf2f(projb[(size_t)tt * NP + pcol]); }
  return a / (1.f + expf(-a));
}
constexpr int DBG_NS = 11, DBG_T = 300;
DI int dbg_sample_idx(int t) {
  const int TS[DBG_NS] = {0, 1, 2, 3, 64, 127, 128, 129, 255, 256, 299};
  for (int i = 0; i < DBG_NS; ++i) if (TS[i] == t) return i;
  return -1;
}
DI int dbg_sample_t(int i) { const int TS[DBG_NS] = {0, 1, 2, 3, 64, 127, 128, 129, 255, 256, 299}; return TS[i]; }
DI void dbg_ssd(const Params& p, int layer, int b, int gi, Chk& c, int id, unsigned char* smem) {
  float* ybuf = (float*)smem;
  float* red = ybuf + DBG_NS * 128;
  const int tid = threadIdx.x, pp = tid >> 2, nq = tid & 3;
  const u16* projb = (const u16*)(p.ws + OFF_PROJ) + (size_t)b * SEQ * NP;
  const float* smb = (const float*)(p.ws + OFF_SMALL) + (size_t)b * SEQ * NSMALL;
  const float* cw = p.ssm_conv_w + layer * 4 * 512; const float* cb = p.ssm_conv_b + layer * 512;
  lds_barrier();
  for (int hh = 0; hh < 2; ++hh) {
    const int h = gi * 2 + hh;
    const float a_h = -expf(p.ssm_a_log[layer * 4 + h]), d_h = p.ssm_d[layer * 4 + h], dtb = p.ssm_dt_bias[layer * 4 + h];
    float hst[16];
    for (int i = 0; i < 16; ++i) hst[i] = 0.f;
    for (int t = 0; t < DBG_T; ++t) {
      const float xr = smb[(size_t)t * NSMALL + SM_DT + h] + dtb;
      const float dt = xr > 20.f ? xr : log1pf(expf(xr));
      const float dA = expf(dt * a_h);
      const float xp = dbg_conv(projb, t, PC_XBC + h * 64 + pp, cw, cb, h * 64 + pp, 512);
      float y = 0.f;
      for (int i = 0; i < 16; ++i) {
        const int n = nq * 16 + i;
        const float Bn = dbg_conv(projb, t, PC_XBC + 256 + gi * 64 + n, cw, cb, 256 + gi * 64 + n, 512);
        const float Cn = dbg_conv(projb, t, PC_XBC + 384 + gi * 64 + n, cw, cb, 384 + gi * 64 + n, 512);
        hst[i] = dA * hst[i] + dt * xp * Bn;
        y += Cn * hst[i];
      }
      y += __shfl_xor(y, 1); y += __shfl_xor(y, 2);
      y += d_h * xp;
      const int si = dbg_sample_idx(t);
      if (si >= 0 && nq == 0) { const float z = bf2f(projb[(size_t)t * NP + PC_Z + h * 64 + pp]); ybuf[si * 128 + hh * 64 + pp] = y * (z / (1.f + expf(-z))); }
    }
  }
  lds_barrier();
  for (int si = 0; si < DBG_NS; ++si) {
    const float v = tid < 128 ? ybuf[si * 128 + tid] : 0.f;
    const float ss = block_sum(v * v, red);
    float e2 = 0.f, r2 = 0.f;
    if (tid < 128) {
      const float ref = v * rsqrtf(ss / 128.f + 1e-6f) * p.ssm_norm_g[layer * 256 + gi * 128 + tid];
      const float got = bf2f(((const u16*)(p.ws + OFF_H))[((size_t)b * SEQ + dbg_sample_t(si)) * 1024 + Y_C + gi * 128 + tid]);
      e2 = (got - ref) * (got - ref); r2 = ref * ref;
    }
    c.num[id] += block_sum(e2, red); c.den[id] += block_sum(r2, red);
  }
}
DI void dbg_mlstm(const Params& p, int layer, int b, int h, Chk& c, int id, unsigned char* smem) {
  float* ybuf = (float*)smem;
  float* red = ybuf + DBG_NS * 128;
  const int tid = threadIdx.x, dd = tid >> 2, eq = tid & 3;
  const u16* projb = (const u16*)(p.ws + OFF_PROJ) + (size_t)b * SEQ * NP;
  const float* smb = (const float*)(p.ws + OFF_SMALL) + (size_t)b * SEQ * NSMALL;
  const float* cw = p.ml_conv_w + layer * 4 * 512; const float* cb = p.ml_conv_b + layer * 512;
  const float ib = p.ml_if_b[layer * 8 + h], fb = p.ml_if_b[layer * 8 + 4 + h];
  lds_barrier();
  float Cst[16], nst[16];
  for (int i = 0; i < 16; ++i) { Cst[i] = 0.f; nst[i] = 0.f; }
  float m = 0.f;
  for (int t = 0; t < DBG_T; ++t) {
    const float ip = smb[(size_t)t * NSMALL + SM_IF + h] + ib, fp = smb[(size_t)t * NSMALL + SM_IF + 4 + h] + fb;
    const float lf = fminf(fp, 0.f) - log1pf(expf(-fabsf(fp)));
    const float mn = fmaxf(lf + m, ip), fs = expf(lf + m - mn), is = expf(ip - mn);
    const float vd = bf2f(projb[(size_t)t * NP + PD_V + h * 64 + dd]);
    float num = 0.f, den = 0.f;
    for (int i = 0; i < 16; ++i) {
      const int e = eq * 16 + i;
      const float qe = dbg_conv(projb, t, PD_QK + h * 64 + e, cw, cb, h * 64 + e, 512);
      const float ke = 0.125f * dbg_conv(projb, t, PD_QK + 256 + h * 64 + e, cw, cb, 256 + h * 64 + e, 512);
      Cst[i] = fs * Cst[i] + is * vd * ke; nst[i] = fs * nst[i] + is * ke;
      num += Cst[i] * qe; den += nst[i] * qe;
    }
    num += __shfl_xor(num, 1); num += __shfl_xor(num, 2); den += __shfl_xor(den, 1); den += __shfl_xor(den, 2);
    const float hv = num / fmaxf(fabsf(den), expf(-mn));
    m = mn;
    const int si = dbg_sample_idx(t);
    if (si >= 0 && eq == 0) { const float o = bf2f(projb[(size_t)t * NP + PD_O + h * 64 + dd]); ybuf[si * 64 + dd] = hv / (1.f + expf(-o)); }
  }
  lds_barrier();
  for (int si = 0; si < DBG_NS; ++si) {
    const float v = tid < 64 ? ybuf[si * 64 + tid] : 0.f;
    const float ss = block_sum(v * v, red);
    float e2 = 0.f, r2 = 0.f;
    if (tid < 64) {
      const int t = dbg_sample_t(si);
      const float z = bf2f(projb[(size_t)t * NP + PD_Z + h * 64 + tid]);
      const float ref = v * rsqrtf(ss / 64.f + 1e-6f) * p.ml_norm_g[layer * 64 + tid] * (z / (1.f + expf(-z)));
      const float got = bf2f(((const u16*)(p.ws + OFF_H))[((size_t)b * SEQ + t) * 1024 + Y_D + h * 64 + tid]);
      e2 = (got - ref) * (got - ref); r2 = ref * ref;
    }
    c.num[id] += block_sum(e2, red); c.den[id] += block_sum(r2, red);
  }
}

DI void debug_checks(const Params& p, unsigned char* smem) {
  const int tid = otid();
  float* red = (float*)(smem + 36 * 1024);
  Chk c;
  for (int i = 0; i < NCHK; ++i) { c.num[i] = 0.f; c.den[i] = 0.f; }
  const float* adap = (const float*)(p.ws + OFF_ADAP);
  const u16* H = (const u16*)(p.ws + OFF_H);
  const u16* proj = (const u16*)(p.ws + OFF_PROJ);
  const float* sm = (const float*)(p.ws + OFF_SMALL);
#if DEBUG_CHECK == 1
  {
    const int bs[2] = {0, 5}; const int ns[4] = {3, 1024 + 77, 2048 + 500, 3071};
    for (int bi = 0; bi < 2; ++bi) for (int ni = 0; ni < 4; ++ni) {
      const int b = bs[bi], n = ns[ni];
      float a = 0.f;
      for (int k = tid; k < 1024; k += 256) { const float v = p.c[b * 1024 + k]; a += (v / (1.f + expf(-v))) * p.ada_w[(size_t)k * 3072 + n]; }
      const float ref = block_sum(a, red) + p.ada_b[n];
      float got = 0.f; for (int kc = 0; kc < 8; ++kc) got += adap[(((size_t)kc * 2 + 0) * 8 + b) * 3072 + n];
      chk_add(c, 1, got, ref);
    }
  }
  {
    const int ms[3] = {1, 9000, 32767};
    const int ns[14] = {0, 300, 700, 900, 1500, 2000, 2300, 2693, 3300, 3500, 3967, 3970, 3981, 3990};
    for (int mi = 0; mi < 3; ++mi) {
      const int m = ms[mi], b = m >> 12;
      float ss = 0.f;
      for (int k = tid; k < 1024; k += 256) { const float v = p.x[(size_t)m * 1024 + k]; ss += v * v; }
      ss = block_sum(ss, red);
      const float rstd = rsqrtf(ss / 1024.f + 1e-6f);
      for (int ni = 0; ni < 14; ++ni) {
        const int n = ns[ni], col = colmap(n);
        float a = 0.f, herr = 0.f, href = 0.f;
        for (int k = tid; k < 1024; k += 256) {
          float shf = 0.f, scl = 0.f;
          for (int kc = 0; kc < 8; ++kc) { const float* ap = adap + (((size_t)kc * 2 + 0) * 8 + b) * 3072; shf += ap[k]; scl += ap[1024 + k]; }
          const float hv = p.x[(size_t)m * 1024 + k] * rstd * p.norm_g[k] * (1.f + scl) + shf;
          const float hg = bf2f(H[(size_t)m * 1024 + k]);
          herr += (hg - hv) * (hg - hv); href += hv * hv;
          a += hv * p.w_in[(size_t)k * D_IN + col];
        }
        const float ref = block_sum(a, red);
        herr = block_sum(herr, red); href = block_sum(href, red);
        if (ni == 0 && DEBUG_STAGE == 1) { c.num[3] += herr; c.den[3] += href; }
        const float got = n < NP ? bf2f(proj[(size_t)m * NP + n]) : sm[(size_t)m * NSMALL + (n - NP)];
        chk_add(c, 2, got, ref);
      }
    }
  }
#endif
#if DEBUG_CHECK == 2
  dbg_diff_attn(p, 0, 0, 5, 0, c, 4, smem);
  dbg_diff_attn(p, 0, 1, 200, 3, c, 4, smem);
  dbg_diff_attn(p, 0, 3, 1500, 2, c, 4, smem);
  dbg_diff_attn(p, 0, 7, 4095, 1, c, 4, smem);
  {
    const int ms[3] = {2, 12345, 32766}; const int ns[3] = {0, 513, 1023};
    const u16* Y = (const u16*)(p.ws + OFF_H);
    for (int mi = 0; mi < 3; ++mi) for (int ni = 0; ni < 3; ++ni) {
      const int m = ms[mi], n = ns[ni], b = m >> 12;
      float a = 0.f;
      for (int k = tid; k < 1024; k += 256) a += bf2f(Y[(size_t)m * 1024 + k]) * p.w_out[(size_t)k * 1024 + n];
      a = block_sum(a, red);
      float gate = 0.f; for (int kc = 0; kc < 8; ++kc) gate += adap[(((size_t)kc * 2 + 0) * 8 + b) * 3072 + 2048 + n];
      chk_add(c, 5, p.out[(size_t)m * 1024 + n] - p.x[(size_t)m * 1024 + n], gate * a);
    }
  }
#endif
#if DEBUG_CHECK == 3
  dbg_ssd(p, 0, 0, 0, c, 6, smem);
  dbg_ssd(p, 0, 5, 1, c, 6, smem);
  dbg_mlstm(p, 0, 0, 0, c, 7, smem);
  dbg_mlstm(p, 0, 6, 3, c, 7, smem);
#endif
  lds_barrier();
  if (tid == 0) {
    int wid_ = 0, wcls = 99;
    for (int i = 1; i < NCHK; ++i) if (c.den[i] > 0.f) {
      const float rel = sqrtf(c.num[i] / c.den[i]);
      int cls = rel >= 1.f ? 0 : (int)floorf(-log10f(fmaxf(rel, 1e-9f)));
      if (cls > 9) cls = 9;
      if (!(rel == rel)) cls = 0;
      if (cls < wcls) { wcls = cls; wid_ = i; }
    }
    p.out[0] = 1e5f * ((float)wid_ + 0.1f * (float)wcls);
  }
}
#endif

#define XB_TMO      128
#define XB_XCNT(j)  (256  + 64 * (j))
#define XB_XSUB(j)  (1280 + 64 * (j))
#define XB_XGEN(j)  (2304 + 64 * (j))
#define XB_TOP      3328
#define XB_TOPGEN   3392
#define XCD_BAR_WORDS 3456
#define XB_SPIN_CAP (1u << 23)
DI unsigned xb_ld(unsigned* p)              { return __hip_atomic_load(p, __ATOMIC_RELAXED, __HIP_MEMORY_SCOPE_AGENT); }
DI unsigned xb_add(unsigned* p, unsigned v) { return __hip_atomic_fetch_add(p, v, __ATOMIC_RELAXED, __HIP_MEMORY_SCOPE_AGENT); }
DI unsigned xb_xcc_id() { return (unsigned)__builtin_amdgcn_s_getreg((3 << 11) | 20) & 0xFu; }
#define XB_SPIN(cond, bar) do { unsigned _sp = 0; while (cond) { __builtin_amdgcn_s_sleep(1); \
    if ((++_sp & 255u) == 0u) { if (xb_ld(&(bar)[XB_TMO])) break; if (_sp > XB_SPIN_CAP) { atomicAdd(&(bar)[XB_TMO], 1u); break; } } } } while (0)
struct XcdBarrier { unsigned* bar; unsigned x; volatile LDSP unsigned* st; };
DI XcdBarrier xcd_barrier_post(unsigned* bar, volatile LDSP unsigned* st) {
  XcdBarrier b; b.bar = bar; b.x = xb_xcc_id(); b.st = st;
  if (threadIdx.x == 0) (void)xb_add(&bar[XB_XCNT(b.x)], 1u);
  return b;
}
DI void xcd_barrier_complete(unsigned* bar, unsigned x, unsigned& nloc, unsigned& nx) {
  const unsigned G = gridDim.x * gridDim.y * gridDim.z;
  unsigned sum, cnt, mine, sp = 0u;
  for (;;) {
    sum = 0u; cnt = 0u; mine = 0u;
#pragma unroll
    for (unsigned j = 0; j < 16; ++j) { const unsigned c = xb_ld(&bar[XB_XCNT(j)]); sum += c; cnt += (c > 0u) ? 1u : 0u; mine = (j == x) ? c : mine; }
    if (sum == G) break;
    __builtin_amdgcn_s_sleep(1);
    if ((++sp & 255u) == 0u) { if (xb_ld(&bar[XB_TMO])) break; if (sp > XB_SPIN_CAP) { atomicAdd(&bar[XB_TMO], 1u); break; } }
  }
  nloc = mine > 0u ? mine : 1u; nx = cnt > 0u ? cnt : 1u;
}
DI void xcd_barrier(const XcdBarrier& b) {
  asm volatile("s_waitcnt vmcnt(0)" ::: "memory");
  __syncthreads();
  if (threadIdx.x == 0) {
    unsigned* bar = b.bar;
    __builtin_amdgcn_s_waitcnt(0);
    unsigned nloc = b.st[0], nx = b.st[1];
    if (nloc == 0u) { xcd_barrier_complete(bar, b.x, nloc, nx); b.st[0] = nloc; b.st[1] = nx; }
    const unsigned old = xb_add(&bar[XB_XSUB(b.x)], 1u);
    const unsigned gen = old / nloc;
    if (old + 1u == (gen + 1u) * nloc) {
      __builtin_amdgcn_fence(__ATOMIC_RELEASE, "agent");
      asm volatile("s_waitcnt vmcnt(0)" ::: "memory");
      const unsigned og = xb_add(&bar[XB_TOP], 1u);
      const unsigned tg = og / nx;
      if (og + 1u == (tg + 1u) * nx) xb_add(&bar[XB_TOPGEN], 1u);
      else XB_SPIN(xb_ld(&bar[XB_TOPGEN]) == tg, bar);
      __builtin_amdgcn_fence(__ATOMIC_ACQUIRE, "agent");
      xb_add(&bar[XB_XGEN(b.x)], 1u);
      asm volatile("s_waitcnt vmcnt(0)" ::: "memory");
    } else {
      XB_SPIN(xb_ld(&bar[XB_XGEN(b.x)]) == gen, bar);
      __builtin_amdgcn_fence(__ATOMIC_ACQUIRE, "agent");
      asm volatile("s_waitcnt vmcnt(0)" ::: "memory");
    }
  }
  __syncthreads();
}

constexpr int HALF_LDS = 76 * 1024;
constexpr int SMEM_BYTES = 2 * HALF_LDS;
__global__ void __launch_bounds__(512, 2) fwd_megakernel(Params p) {
  cg::grid_group grid = cg::this_grid();
  __shared__ __attribute__((aligned(16))) unsigned char smem[SMEM_BYTES];
  const int half = __builtin_amdgcn_readfirstlane(threadIdx.x >> 8);
  unsigned char* hsm = smem + half * HALF_LDS;
  const int G = gridDim.x, bid = blockIdx.x;
  const int slot = bid * 2 + half, NS = 2 * G;
  volatile LDSP unsigned* xst = (volatile LDSP unsigned*)(LDSP unsigned char*)(smem + SMEM_BYTES - 32);
  if (threadIdx.x == 0) { xst[0] = 0u; xst[1] = 0u; }
  __syncthreads();
  const XcdBarrier xb = xcd_barrier_post((unsigned*)(p.ws + OFF_BAR), xst);
  {
    constexpr int ADA0 = T0_WIN + T0_WOUT + T0_W1 + T0_W2;
    unsigned* cnt = (unsigned*)(p.ws + OFF_CNT);
    for (int i = slot; i < ((T0_TOTAL + NS - 1) / NS) * NS; i += NS) {
      const int ii = i < T0_TOTAL ? i : T0_TOTAL - 1;
      const int t = ii < 96 ? ADA0 + ii : (ii - 96 < ADA0 ? ii - 96 : ii);
      phase0_task(p, t, hsm);
      if (i < 96) {
        asm volatile("s_waitcnt vmcnt(0)" ::: "memory");
        lds_barrier();
        if (otid512() == 0) {
          __builtin_amdgcn_fence(__ATOMIC_RELEASE, "agent");
          asm volatile("s_waitcnt vmcnt(0)" ::: "memory");
          __hip_atomic_fetch_add(cnt + 8, 2u, __ATOMIC_RELAXED, __HIP_MEMORY_SCOPE_AGENT);
        }
      }
    }
    if (otid512() == 0) {
      unsigned sp = 0;
      while (__hip_atomic_load(cnt + 8, __ATOMIC_RELAXED, __HIP_MEMORY_SCOPE_AGENT) < 96u) { __builtin_amdgcn_s_sleep(8); if (++sp > (1u << 22)) break; }
      __builtin_amdgcn_fence(__ATOMIC_ACQUIRE, "agent");
      asm volatile("s_waitcnt vmcnt(0)" ::: "memory");
    }
    lds_barrier();
    for (int t = slot; t < ((NTOK / 64 + NS - 1) / NS) * NS; t += NS) phase1_task(p, 0, p.x, t < NTOK / 64 ? t : NTOK / 64 - 1, hsm);
  }
  grid.sync();
  for (int layer = 0; layer < 2; ++layer) {
    Params q = p;
    { size_t zoff = 0; asm volatile("" : "+s"(zoff)); q.ws = p.ws + zoff; }
    const float* xin = layer == 0 ? q.x : q.out;
    if (layer != 0) {
      for (int t = slot; t < ((NTOK / 64 + NS - 1) / NS) * NS; t += NS) phase1_task(q, layer, xin, t < NTOK / 64 ? t : NTOK / 64 - 1, hsm);
      xcd_barrier(xb);
    }
    for (int t = bid; t < (NTOK / 256) * (NPAD / 256); t += G) gemm_inproj_tile(q, layer, t, smem);
    xcd_barrier(xb);
#if DEBUG_CHECK == 1
    if (bid == 0 && half == 0) debug_checks(q, smem);
    return;
#endif
    {
      unsigned* cnt = (unsigned*)(q.ws + OFF_CNT);
      int* s_pair = (int*)(smem + SMEM_BYTES - 16);
      if (bid < 32) ssd_task8(q, layer, bid >> 2, bid & 3, smem);
      else if (bid < 64) mlstm_task8(q, layer, (bid - 32) >> 2, (bid - 32) & 3, smem);
      if (bid < 64) {
        asm volatile("s_waitcnt vmcnt(0)" ::: "memory");
        lds_barrier();
        if (otid512() == 0) {
          __builtin_amdgcn_fence(__ATOMIC_RELEASE, "agent");
          asm volatile("s_waitcnt vmcnt(0)" ::: "memory");
          __hip_atomic_fetch_add(cnt + 4 + layer, 1u, __ATOMIC_RELAXED, __HIP_MEMORY_SCOPE_AGENT);
        }
      }
      constexpr int NPAIR_C = 64, NPAIR_D = 512, NPAIR_N = 512, NPAIR_F = NTOK / 128, NPAIR = NPAIR_C + NPAIR_D + NPAIR_N + NPAIR_F;
      for (;;) {
        const int t512 = otid512();
        lds_barrier();
        if (t512 == 0) *s_pair = (int)atomicAdd(cnt + layer, 1u);
        lds_barrier();
        const int pair = *s_pair;
        if (pair >= NPAIR) break;
        if (pair < NPAIR_C) {
          const int v = pair * 2 + half;
          compress_task(q, layer, v >> 4, (v >> 3) & 1, v & 7, hsm);
          asm volatile("s_waitcnt vmcnt(0)" ::: "memory");
          lds_barrier();
          if (t512 == 0) {
            __builtin_amdgcn_fence(__ATOMIC_RELEASE, "agent");
            asm volatile("s_waitcnt vmcnt(0)" ::: "memory");
            __hip_atomic_fetch_add(cnt + 2 + layer, 1u, __ATOMIC_RELAXED, __HIP_MEMORY_SCOPE_AGENT);
          }
        } else if (pair < NPAIR_C + NPAIR_D) {
          const int u = (pair - NPAIR_C) * 2 + half, qb = 31 - (u >> 5), bh = u & 31;
          diff_attn_task(q, layer, bh >> 2, bh & 3, qb, hsm, half != 0);
        } else if (pair >= NPAIR_C + NPAIR_D + NPAIR_N) {
          if (t512 == 0) {
            while (__hip_atomic_load(cnt + 4 + layer, __ATOMIC_RELAXED, __HIP_MEMORY_SCOPE_AGENT) < 64u) __builtin_amdgcn_s_sleep(16);
            __builtin_amdgcn_fence(__ATOMIC_ACQUIRE, "agent");
            asm volatile("s_waitcnt vmcnt(0)" ::: "memory");
          }
          lds_barrier();
          seq_fix_rows(q, layer, ((pair - NPAIR_C - NPAIR_D - NPAIR_N) * 2 + half) * 64, 64);
        } else {
          if (t512 == 0) {
            while (__hip_atomic_load(cnt + 2 + layer, __ATOMIC_RELAXED, __HIP_MEMORY_SCOPE_AGENT) < (unsigned)NPAIR_C) __builtin_amdgcn_s_sleep(16);
            __builtin_amdgcn_fence(__ATOMIC_ACQUIRE, "agent");
            asm volatile("s_waitcnt vmcnt(0)" ::: "memory");
          }
          lds_barrier();
          const int u = (pair - NPAIR_C - NPAIR_D) * 2 + half;
          nsa_task(q, layer, u & 7, 127 - (u >> 3), hsm);
        }
      }
    }
    xcd_barrier(xb);
    if (layer == 0) { for (int t = bid; t < (NTOK / 256) * 4; t += G) gemm_outproj_tile<0>(q, xin, q.out, t, smem); }
    else { for (int t = bid; t < (NTOK / 256) * 4; t += G) gemm_outproj_tile<1>(q, xin, q.out, t, smem); }
    xcd_barrier(xb);
#if DEBUG_CHECK >= 2
    if (bid == 0 && half == 0) debug_checks(q, smem);
    return;
#endif
  }
  { const int t5 = otid512(); final_norm_rows(p, bid * 8 + (t5 >> 6), G * 8, t5 & 63); }
}

extern "C" void kernel_launch(void* const* d_in, const int* in_sizes, int n_in, void* d_out, int out_size, void* d_ws, size_t ws_size,
                              hipStream_t stream) {
  static int grid_blocks = 0;
  if (!grid_blocks) {
    int dev = 0, cus = 0, per_cu = 0;
    (void)hipGetDevice(&dev);
    (void)hipDeviceGetAttribute(&cus, hipDeviceAttributeMultiprocessorCount, dev);
    (void)hipOccupancyMaxActiveBlocksPerMultiprocessor(&per_cu, fwd_megakernel, 512, 0);
    if (per_cu > 1) per_cu = 1;
    if (per_cu < 1) per_cu = 1;
    grid_blocks = cus * per_cu;
  }
  if (grid_blocks < 64 || (grid_blocks & 3)) { fprintf(stderr, "grid too small: %d\n", grid_blocks); return; }
  if (ws_size < WS_NEEDED) { fprintf(stderr, "workspace too small: %zu < %zu\n", ws_size, WS_NEEDED); return; }
  Params p{};
  const float** pp = (const float**)&p;
  for (int i = 0; i < 26; ++i) pp[i] = (const float*)d_in[i];
  p.out = (float*)d_out; p.ws = (unsigned char*)d_ws;
  (void)hipMemsetAsync((unsigned char*)d_ws + OFF_CNT, 0, 64 * 1024 + XCD_BAR_WORDS * 4, stream);
  void* args[] = {&p};
  hipError_t e = hipLaunchCooperativeKernel((void*)fwd_megakernel, dim3(grid_blocks), dim3(512), args, 0, stream);
  if (e != hipSuccess) fprintf(stderr, "cooperative launch failed: %s (grid %d)\n", hipGetErrorString(e), grid_blocks);
}
```

```cpp
#include <hip/hip_runtime.h>
#include <hip/hip_cooperative_groups.h>
#include <cstdio>
#include <cstdint>
#define DEBUG_CHECK 0
#define DEBUG_STAGE 1
#define REP_P1 1
#define REP_P2 1
#define REP_SEQ 1
#define REP_DIFF 1
#define REP_NSA 1
#define REP_P4 1
#define REP_P0 1
namespace cg = cooperative_groups;

typedef unsigned short u16;
typedef short bf16x8 __attribute__((ext_vector_type(8)));
typedef short s16x4 __attribute__((ext_vector_type(4)));
typedef float f32x4 __attribute__((ext_vector_type(4)));
typedef float f32x2 __attribute__((ext_vector_type(2)));
typedef unsigned u32x4 __attribute__((ext_vector_type(4)));
typedef unsigned u32x2 __attribute__((ext_vector_type(2)));
typedef __bf16 bf16x2_t __attribute__((ext_vector_type(2)));
#define DI __device__ __forceinline__
#define LDSP __attribute__((address_space(3)))

constexpr int D_MODEL = 1024, BATCH = 8, SEQ = 4096, NTOK = BATCH * SEQ;
constexpr int D_IN = 3992;
constexpr int NP = 3968, NPAD = 4096, NSMALL = 32;
constexpr int PA_Q = 0, PA_KC = 256, PA_VC = 320, PA_KS = 384, PA_VS = 448, PA_KW = 512, PA_VW = 576, PA_Z = 640;
constexpr int PB_Q = 896, PB_K = 1152, PB_V = 1408, PB_Z = 1664;
constexpr int PC_Z = 1920, PC_XBC = 2176;
constexpr int PD_QK = 2688, PD_V = 3200, PD_O = 3456, PD_Z = 3712;
constexpr int SM_G = 0, SM_DT = 12, SM_IF = 16;
constexpr int Y_A = 0, Y_B = 256, Y_C = 512, Y_D = 768;

constexpr size_t MiB = 1024 * 1024;
constexpr size_t OFF_WINT = 0;
constexpr size_t OFF_WOUTT = 16 * MiB;
constexpr size_t OFF_W1T = 20 * MiB;
constexpr size_t OFF_W2T = 22 * MiB;
constexpr size_t OFF_BIAS1 = 22 * MiB + 64 * 1024;
constexpr size_t OFF_ADAP = 22 * MiB + 128 * 1024;
constexpr size_t OFF_KCMP = 24 * MiB;
constexpr size_t OFF_VCMP = 24 * MiB + 256 * 1024;
constexpr size_t OFF_BAR = 29 * MiB + 64 * 1024;
constexpr size_t OFF_CNT = 29 * MiB;
constexpr size_t OFF_SMALL = 25 * MiB;
constexpr size_t OFF_SSQ = 29 * MiB;
constexpr size_t OFF_H = 32 * MiB;
constexpr size_t OFF_PROJ = 96 * MiB;
constexpr size_t OFF_X1B = 352 * MiB;
constexpr size_t WS_NEEDED = OFF_X1B + (size_t)NTOK * 1024 * 2;

struct Params {
  const float* x; const float* c; const float* norm_g; const float* ada_w; const float* ada_b;
  const float* w_in; const float* w_out;
  const float* nsa_cmp_pos; const float* nsa_ck_w1; const float* nsa_ck_w2; const float* nsa_cv_w1; const float* nsa_cv_w2; const float* nsa_norm_g;
  const float* diff_lam; const float* diff_norm_g;
  const float* ssm_conv_w; const float* ssm_conv_b; const float* ssm_dt_bias; const float* ssm_a_log; const float* ssm_d; const float* ssm_norm_g;
  const float* ml_conv_w; const float* ml_conv_b; const float* ml_if_b; const float* ml_norm_g; const float* final_g;
  float* out; unsigned char* ws;
};

DI void lds_barrier() { asm volatile("s_waitcnt lgkmcnt(0)" ::: "memory"); __builtin_amdgcn_s_barrier(); asm volatile("" ::: "memory"); }
DI int otid() { int t = threadIdx.x & 255; asm volatile("" : "+v"(t)); return t; }
DI int otid512() { int t = threadIdx.x; asm volatile("" : "+v"(t)); return t; }
DI unsigned pack2(float a, float b) { f32x2 v = {a, b}; bf16x2_t r = __builtin_convertvector(v, bf16x2_t); return __builtin_bit_cast(unsigned, r); }
DI u16 f2bf(float a) { return (u16)(pack2(a, 0.f) & 0xffffu); }
DI float bf2f(u16 h) { return __uint_as_float(((unsigned)h) << 16); }
DI float bflo(unsigned u) { return __uint_as_float(u << 16); }
DI float bfhi(unsigned u) { return __uint_as_float(u & 0xffff0000u); }
DI f32x4 mfma16(bf16x8 a, bf16x8 b, f32x4 c) { return __builtin_amdgcn_mfma_f32_16x16x32_bf16(a, b, c, 0, 0, 0); }
DI float wave_sum(float v) {
#pragma unroll
  for (int o = 32; o > 0; o >>= 1) v += __shfl_xor(v, o);
  return v;
}
DI float siluf(float v) { return v * __builtin_amdgcn_rcpf(1.f + __expf(-v)); }
DI float sigmoidf_(float v) { return __builtin_amdgcn_rcpf(1.f + __expf(-v)); }
DI float exp2_(float v) { return __builtin_amdgcn_exp2f(v); }
DI float sgprf(float v) { return __int_as_float(__builtin_amdgcn_readfirstlane(__float_as_int(v))); }
DI s16x4 tr_read(const u16* p) { return __builtin_amdgcn_ds_read_tr16_b64_v4i16((LDSP s16x4*)p); }
DI bf16x8 cat4(s16x4 a, s16x4 b) { bf16x8 r; r[0] = a[0]; r[1] = a[1]; r[2] = a[2]; r[3] = a[3]; r[4] = b[0]; r[5] = b[1]; r[6] = b[2]; r[7] = b[3]; return r; }
DI bf16x8 ldfrag(const u16* p) { return *(const bf16x8*)p; }

DI int colmap(int n) {
  if (n < 640) return n;
  if (n < 896) return 652 + (n - 640);
  if (n < 1920) return 908 + (n - 896);
  if (n < 2688) return 1932 + (n - 1920);
  if (n < 3456) return 2704 + (n - 2688);
  if (n < 3968) return 3480 + (n - 3456);
  if (n < 3980) return 640 + (n - 3968);
  if (n < 3984) return 2700 + (n - 3980);
  if (n < 3992) return 3472 + (n - 3984);
  return -1;
}

DI void tconv_tile(const float* __restrict__ src, int ldsrc, int k0, int n0, u16* __restrict__ dst, int ldd, bool use_map, unsigned char* smem) {
  float* tile = (float*)smem;
  const int tid = otid();
  lds_barrier();
  {
    const int nn = tid & 63; int col = n0 + nn; if (use_map) col = colmap(col);
#pragma unroll
    for (int i = 0; i < 16; ++i) { const int kk = i * 4 + (tid >> 6); tile[kk * 65 + nn] = col >= 0 ? src[(size_t)(k0 + kk) * ldsrc + col] : 0.f; }
  }
  lds_barrier();
#pragma unroll
  for (int i = 0; i < 2; ++i) {
    const int item = tid + 256 * i, nn = item >> 3, kc = item & 7;
    u32x4 w;
    w.x = pack2(tile[(kc * 8 + 0) * 65 + nn], tile[(kc * 8 + 1) * 65 + nn]);
    w.y = pack2(tile[(kc * 8 + 2) * 65 + nn], tile[(kc * 8 + 3) * 65 + nn]);
    w.z = pack2(tile[(kc * 8 + 4) * 65 + nn], tile[(kc * 8 + 5) * 65 + nn]);
    w.w = pack2(tile[(kc * 8 + 6) * 65 + nn], tile[(kc * 8 + 7) * 65 + nn]);
    *(u32x4*)(dst + (size_t)(n0 + nn) * ldd + k0 + kc * 8) = w;
  }
}

constexpr int T0_WIN = 2 * 16 * 64, T0_WOUT = 2 * 16 * 16, T0_W1 = 4 * 32 * 2, T0_W2 = 4 * 2, T0_ADA = 2 * 12 * 8, T0_B1 = 64;
constexpr int T0_TOTAL = T0_WIN + T0_WOUT + T0_W1 + T0_W2 + T0_ADA + T0_B1;

DI void phase0_task(const Params& p, int t, unsigned char* smem) {
  const int tid = otid();
  if (t < T0_WIN) {
    const int l = t / 1024, r = t % 1024, kt = r / 64, nt = r % 64;
    tconv_tile(p.w_in + (size_t)l * D_MODEL * D_IN, D_IN, kt * 64, nt * 64, (u16*)(p.ws + OFF_WINT) + (size_t)l * NPAD * 1024, 1024, true, smem);
    return;
  }
  t -= T0_WIN;
  if (t < T0_WOUT) {
    const int l = t / 256, r = t % 256, kt = r / 16, nt = r % 16;
    tconv_tile(p.w_out + (size_t)l * 1024 * 1024, 1024, kt * 64, nt * 64, (u16*)(p.ws + OFF_WOUTT) + (size_t)l * 1024 * 1024, 1024, false, smem);
    return;
  }
  t -= T0_WOUT;
  if (t < T0_W1) {
    const int m = t / 64, r = t % 64, kt = r / 2, nt = r % 2, l = m >> 1, kv = m & 1;
    const float* src = (kv ? p.nsa_cv_w1 : p.nsa_ck_w1) + (size_t)l * 2048 * 128;
    tconv_tile(src, 128, kt * 64, nt * 64, (u16*)(p.ws + OFF_W1T) + (size_t)m * 128 * 2048, 2048, false, smem);
    return;
  }
  t -= T0_W1;
  if (t < T0_W2) {
    const int m = t / 2, kt = t % 2, l = m >> 1, kv = m & 1;
    const float* src = (kv ? p.nsa_cv_w2 : p.nsa_ck_w2) + (size_t)l * 128 * 64;
    tconv_tile(src, 64, kt * 64, 0, (u16*)(p.ws + OFF_W2T) + (size_t)m * 64 * 128, 128, false, smem);
    return;
  }
  t -= T0_W2;
  if (t < T0_ADA) {
    const int l = t / 96, r = t % 96, nc = r / 8, kc = r % 8;
    float* cact = (float*)smem;
    lds_barrier();
    for (int i = tid; i < 1024; i += 256) { const int b = i >> 7, kk = i & 127; const float v = p.c[b * 1024 + kc * 128 + kk]; cact[i] = siluf(v); }
    lds_barrier();
    const int n = nc * 256 + tid;
    float acc[8];
#pragma unroll
    for (int b = 0; b < 8; ++b) acc[b] = 0.f;
    const float* w = p.ada_w + ((size_t)l * 1024 + kc * 128) * 3072 + n;
#pragma unroll 16
    for (int kk = 0; kk < 128; ++kk) {
      const float wv = w[(size_t)kk * 3072];
#pragma unroll
      for (int b = 0; b < 8; ++b) acc[b] += cact[b * 128 + kk] * wv;
    }
    float* adap = (float*)(p.ws + OFF_ADAP);
    const float bias = kc == 0 ? p.ada_b[l * 3072 + n] : 0.f;
#pragma unroll
    for (int b = 0; b < 8; ++b) adap[(((size_t)kc * 2 + l) * 8 + b) * 3072 + n] = acc[b] + bias;
    return;
  }
  t -= T0_ADA;
  {
    const int m = t >> 4, kc = t & 15, l = m >> 1, kv = m & 1;
    const float* w1 = (kv ? p.nsa_cv_w1 : p.nsa_ck_w1) + (size_t)l * 2048 * 128;
    const float* pos = p.nsa_cmp_pos + (size_t)l * 2048;
    const int n = tid & 127, half = tid >> 7;
    float acc = 0.f;
    const int k0 = kc * 128 + half * 64;
#pragma unroll 16
    for (int k = 0; k < 64; ++k) acc += pos[k0 + k] * w1[(size_t)(k0 + k) * 128 + n];
    float* red = (float*)smem;
    lds_barrier();
    red[tid] = acc;
    lds_barrier();
    if (tid < 128) ((float*)(p.ws + OFF_BIAS1))[(m * 16 + kc) * 128 + tid] = red[tid] + red[tid + 128];
  }
}

DI void phase1_task(const Params& p, int layer, const float* xin, int grp, unsigned char* smem) {
  const int tid = otid(), lane = tid & 63, wid = tid >> 6;
  const int b = grp >> 6;
  float* mul = (float*)smem;
  float* sh = mul + 1024;
  const float* adap = (const float*)(p.ws + OFF_ADAP);
  lds_barrier();
  for (int c = tid; c < 1024; c += 256) {
    float s0 = 0.f, s1 = 0.f;
#pragma unroll
    for (int kc = 0; kc < 8; ++kc) { const float* a = adap + (((size_t)kc * 2 + layer) * 8 + b) * 3072; s0 += a[c]; s1 += a[1024 + c]; }
    mul[c] = p.norm_g[layer * 1024 + c] * (1.f + s1); sh[c] = s0;
  }
  lds_barrier();
  u16* H = (u16*)(p.ws + OFF_H);
#pragma unroll 1
  for (int it = 0; it < 4; ++it) {
    float4 v[4][4]; float ss[4];
#pragma unroll
    for (int j = 0; j < 4; ++j) {
      const int row = grp * 64 + wid * 16 + it * 4 + j;
      if (layer == 0) {
        const float4* xr = (const float4*)(xin + (size_t)row * D_MODEL);
#pragma unroll
        for (int i = 0; i < 4; ++i) v[j][i] = xr[lane + 64 * i];
      } else {
        const u32x2* xr = (const u32x2*)((const u16*)(p.ws + OFF_X1B) + (size_t)row * D_MODEL);
#pragma unroll
        for (int i = 0; i < 4; ++i) { const u32x2 w = xr[lane + 64 * i]; v[j][i] = make_float4(bflo(w.x), bfhi(w.x), bflo(w.y), bfhi(w.y)); }
      }
    }
#pragma unroll
    for (int j = 0; j < 4; ++j) {
      float a = 0.f;
#pragma unroll
      for (int i = 0; i < 4; ++i) a += v[j][i].x * v[j][i].x + v[j][i].y * v[j][i].y + v[j][i].z * v[j][i].z + v[j][i].w * v[j][i].w;
      ss[j] = wave_sum(a);
    }
#pragma unroll
    for (int j = 0; j < 4; ++j) {
      const int row = grp * 64 + wid * 16 + it * 4 + j;
      const float r = rsqrtf(ss[j] * (1.f / D_MODEL) + 1e-6f);
#pragma unroll
      for (int i = 0; i < 4; ++i) {
        const int c = (lane + 64 * i) * 4;
        u32x2 w;
        w.x = pack2(v[j][i].x * r * mul[c] + sh[c], v[j][i].y * r * mul[c + 1] + sh[c + 1]);
        w.y = pack2(v[j][i].z * r * mul[c + 2] + sh[c + 2], v[j][i].w * r * mul[c + 3] + sh[c + 3]);
        *(u32x2*)(H + (size_t)row * 1024 + c) = w;
      }
    }
  }
}

namespace g8 {
constexpr int BM = 256, BK = 64, HALF = 128, HT = HALF * BK;
constexpr int LDS_BYTES = 8 * HT * 2;
DI int lds_byte(int r, int c) { const int st = (r >> 4) * 2 + (c >> 5), rr = r & 15, cc = c & 31, ob = rr * 64 + cc * 2; return st * 1024 + (ob ^ (((ob >> 9) & 1) << 5)); }
DI void stage_rc(int b, int& R, int& C) { const int st = b / 1024, sb = b % 1024, swz = sb ^ (((sb >> 9) & 1) << 5); R = (st >> 1) * 16 + swz / 64; C = (st & 1) * 32 + (swz % 64) / 2; }

DI void kloop(const u16* __restrict__ A, const u16* __restrict__ Bt, int K, int brow, int bcol, unsigned char* smem, f32x4 (&acc)[2][2][4][2]) {
  u16* shm = (u16*)smem;
  const int tid = otid512();
#define SA(b, h) (shm + ((b) * 2 + (h)) * HT)
#define SB(b, h) (shm + (4 + (b) * 2 + (h)) * HT)
#define STAGE(P, BASE, br, kt) do { const u16* _gb = BASE + ((long)(br) * K + (long)(kt) * BK); \
      __builtin_amdgcn_global_load_lds((const unsigned*)(_gb + soff0), (LDSP unsigned*)((LDSP char*)(P) + tid * 16), 16, 0, 0); \
      __builtin_amdgcn_global_load_lds((const unsigned*)(_gb + soff1), (LDSP unsigned*)((LDSP char*)(P) + tid * 16 + 8192), 16, 0, 0); } while (0)
#define LDA(dst, b, h) _Pragma("unroll") for (int m = 0; m < 4; ++m) _Pragma("unroll") for (int k = 0; k < 2; ++k) \
    dst[m][k] = *reinterpret_cast<const bf16x8*>((const char*)SA(b, h) + lds_byte(wr * 64 + m * 16 + fr, k * 32 + fq * 8))
#define LDB(dst, b, h) _Pragma("unroll") for (int n = 0; n < 2; ++n) _Pragma("unroll") for (int k = 0; k < 2; ++k) \
    dst[n][k] = *reinterpret_cast<const bf16x8*>((const char*)SB(b, h) + lds_byte(wc * 32 + n * 16 + fr, k * 32 + fq * 8))
#define MMA(ai, bj, At_, Bt_) do { __builtin_amdgcn_s_setprio(1); \
    _Pragma("unroll") for (int m = 0; m < 4; ++m) _Pragma("unroll") for (int n = 0; n < 2; ++n) _Pragma("unroll") for (int k = 0; k < 2; ++k) \
      acc[ai][bj][m][n] = __builtin_amdgcn_mfma_f32_16x16x32_bf16(Bt_[n][k], At_[m][k], acc[ai][bj][m][n], 0, 0, 0); \
    __builtin_amdgcn_s_setprio(0); } while (0)
#define WAIT_V(n) asm volatile("s_waitcnt vmcnt(" #n ")" ::: "memory")
#define WAIT_L(n) asm volatile("s_waitcnt lgkmcnt(" #n ")" ::: "memory")
#define BAR __builtin_amdgcn_s_barrier()
#define SCHED __builtin_amdgcn_sched_barrier(0)
  const int wid = __builtin_amdgcn_readfirstlane(tid >> 6), lane = tid & 63, wr = wid >> 2, wc = wid & 3, fr = lane & 15, fq = lane >> 4;
#pragma unroll
  for (int a = 0; a < 2; ++a)
#pragma unroll
    for (int b = 0; b < 2; ++b)
#pragma unroll
      for (int m = 0; m < 4; ++m) { acc[a][b][m][0] = (f32x4){0.f, 0.f, 0.f, 0.f}; acc[a][b][m][1] = (f32x4){0.f, 0.f, 0.f, 0.f}; }
  bf16x8 At[4][2], B0[2][2], B1[2][2];
  const int nt = K / BK;
  int soff0, soff1;
  { int r_, c_; stage_rc(tid * 16, r_, c_); soff0 = r_ * K + c_; stage_rc(tid * 16 + 8192, r_, c_); soff1 = r_ * K + c_; }
  STAGE(SB(0, 0), Bt, bcol, 0); STAGE(SA(0, 0), A, brow, 0);
  STAGE(SB(0, 1), Bt, bcol + HALF, 0); STAGE(SA(0, 1), A, brow + HALF, 0);
  if (wr == 1) BAR;
  WAIT_V(4); BAR;
  STAGE(SB(1, 0), Bt, bcol, 1); STAGE(SA(1, 0), A, brow, 1); STAGE(SB(1, 1), Bt, bcol + HALF, 1);
  WAIT_V(6); BAR;
#pragma unroll 1
  for (int t = 0; t < nt - 2; t += 2) {
    asm volatile("" : "+v"(soff0), "+v"(soff1));
    LDB(B0, 0, 0); SCHED; LDA(At, 0, 0); STAGE(SA(1, 1), A, brow + HALF, t + 1);
    WAIT_L(8); BAR; WAIT_L(0); MMA(0, 0, At, B0); BAR; SCHED;
    LDB(B1, 0, 1); STAGE(SB(0, 0), Bt, bcol, t + 2);
    BAR; WAIT_L(0); MMA(0, 1, At, B1); BAR;
    LDA(At, 0, 1); STAGE(SA(0, 0), A, brow, t + 2);
    BAR; WAIT_L(0); MMA(1, 0, At, B0); BAR; SCHED;
    STAGE(SB(0, 1), Bt, bcol + HALF, t + 2);
    WAIT_V(6); BAR; MMA(1, 1, At, B1); BAR;
    LDB(B0, 1, 0); SCHED; LDA(At, 1, 0); STAGE(SA(0, 1), A, brow + HALF, t + 2);
    WAIT_L(8); BAR; WAIT_L(0); MMA(0, 0, At, B0); BAR; SCHED;
    LDB(B1, 1, 1); STAGE(SB(1, 0), Bt, bcol, t + 3);
    BAR; WAIT_L(0); MMA(0, 1, At, B1); BAR;
    LDA(At, 1, 1); STAGE(SA(1, 0), A, brow, t + 3);
    BAR; WAIT_L(0); MMA(1, 0, At, B0); BAR; SCHED;
    STAGE(SB(1, 1), Bt, bcol + HALF, t + 3);
    WAIT_V(6); BAR; MMA(1, 1, At, B1); BAR;
  }
  { LDB(B0, 0, 0); LDA(At, 0, 0); STAGE(SA(1, 1), A, brow + HALF, nt - 1);
    BAR; WAIT_L(0); MMA(0, 0, At, B0); BAR;
    LDB(B1, 0, 1); BAR; WAIT_L(0); MMA(0, 1, At, B1); BAR;
    LDA(At, 0, 1); WAIT_V(4); BAR; WAIT_L(0); MMA(1, 0, At, B0); MMA(1, 1, At, B1); BAR; }
  { LDB(B0, 1, 0); LDA(At, 1, 0); WAIT_V(2); BAR; WAIT_L(0); MMA(0, 0, At, B0); BAR;
    LDB(B1, 1, 1); WAIT_V(0); BAR; WAIT_L(0); MMA(0, 1, At, B1); BAR;
    LDA(At, 1, 1); BAR; WAIT_L(0); MMA(1, 0, At, B0); MMA(1, 1, At, B1); BAR; }
  if (wr == 0) BAR;
#undef SA
#undef SB
#undef STAGE
#undef LDA
#undef LDB
#undef MMA
#undef WAIT_V
#undef WAIT_L
#undef BAR
#undef SCHED
}
DI void tile_map(int wgid, int nM, int nN, int& pm, int& pn) {
  const int nwg = nM * nN, NXCD = 8, WGM = 8;
  { const int q = nwg / NXCD, r = nwg % NXCD, xcd = wgid % NXCD, off = wgid / NXCD; wgid = (xcd < r ? xcd * (q + 1) : r * (q + 1) + (xcd - r) * q) + off; }
  const int nig = WGM * nN, gid = wgid / nig, fm = gid * WGM, gsz = (nM - fm) < WGM ? (nM - fm) : WGM;
  pm = fm + ((wgid % nig) % gsz); pn = (wgid % nig) / gsz;
}
}

DI void gemm_inproj_tile(const Params& p, int layer, int tile, unsigned char* smem) {
  int pm, pn; g8::tile_map(tile, NTOK / 256, NPAD / 256, pm, pn);
  const int brow = pm * 256, bcol = pn * 256;
  f32x4 acc[2][2][4][2];
  g8::kloop((const u16*)(p.ws + OFF_H), (const u16*)(p.ws + OFF_WINT) + (size_t)layer * NPAD * 1024, 1024, brow, bcol, smem, acc);
  const int tid = otid512(), wid = __builtin_amdgcn_readfirstlane(tid >> 6), lane = tid & 63, wr = wid >> 2, wc = wid & 3, fr = lane & 15, fq = lane >> 4;
  u16* proj = (u16*)(p.ws + OFF_PROJ);
  if (pn == 15 && wc == 0) {
    float* sm = (float*)(p.ws + OFF_SMALL);
#pragma unroll
    for (int ai = 0; ai < 2; ++ai)
#pragma unroll
      for (int m = 0; m < 4; ++m)
#pragma unroll
        for (int n = 0; n < 2; ++n) {
          const int mr = brow + ai * 128 + wr * 64 + m * 16 + fr;
          *(f32x4*)(sm + (size_t)mr * NSMALL + n * 16 + 4 * fq) = acc[ai][1][m][n];
        }
  }
  constexpr int CLD = 264;
  u16* Cs = (u16*)smem;
#pragma unroll
  for (int ai = 0; ai < 2; ++ai) {
    lds_barrier();
#pragma unroll
    for (int bj = 0; bj < 2; ++bj)
#pragma unroll
      for (int m = 0; m < 4; ++m)
#pragma unroll
        for (int n = 0; n < 2; ++n) {
          const f32x4 v = acc[ai][bj][m][n];
          u32x2 w; w.x = pack2(v[0], v[1]); w.y = pack2(v[2], v[3]);
          *(u32x2*)(Cs + (wr * 64 + m * 16 + fr) * CLD + bj * 128 + wc * 32 + n * 16 + 4 * fq) = w;
        }
    lds_barrier();
#pragma unroll
    for (int i = 0; i < 8; ++i) {
      const int id = tid + 512 * i, row = id >> 5, ch = id & 31;
      if (bcol + ch * 8 < NP) *(u32x4*)(proj + (size_t)(brow + ai * 128 + row) * NP + bcol + ch * 8) = *(const u32x4*)(Cs + row * CLD + ch * 8);
    }
  }
  lds_barrier();
}

template <int layer>
DI void gemm_outproj_tile(const Params& p, const float* xin, float* xout, int tile, unsigned char* smem) {
  int pm, pn; g8::tile_map(tile, NTOK / 256, 4, pm, pn);
  const int brow = pm * 256, bcol = pn * 256;
  f32x4 acc[2][2][4][2];
  g8::kloop((const u16*)(p.ws + OFF_H), (const u16*)(p.ws + OFF_WOUTT) + (size_t)layer * 1024 * 1024, 1024, brow, bcol, smem, acc);
  const int tid = otid512(), wid = __builtin_amdgcn_readfirstlane(tid >> 6), lane = tid & 63, wr = wid >> 2, wc = wid & 3, fr = lane & 15, fq = lane >> 4;
  const int b = brow >> 12;
  const float* adap = (const float*)(p.ws + OFF_ADAP);
  constexpr int CLD = 132;
  float* Cs = (float*)smem;
#pragma unroll
  for (int ai = 0; ai < 2; ++ai)
#pragma unroll
    for (int bj = 0; bj < 2; ++bj) {
      lds_barrier();
#pragma unroll
      for (int m = 0; m < 4; ++m)
#pragma unroll
        for (int n = 0; n < 2; ++n) *(f32x4*)(Cs + (wr * 64 + m * 16 + fr) * CLD + wc * 32 + n * 16 + 4 * fq) = acc[ai][bj][m][n];
      lds_barrier();
      const int ch = tid & 31, nc = bcol + bj * 128 + ch * 4;
      f32x4 gt = {0.f, 0.f, 0.f, 0.f};
#pragma unroll
      for (int kc = 0; kc < 8; ++kc) gt += *(const f32x4*)(adap + (((size_t)kc * 2 + layer) * 8 + b) * 3072 + 2048 + nc);
      u16* x1b = (u16*)(p.ws + OFF_X1B);
      f32x4 xv[8];
#pragma unroll
      for (int i = 0; i < 8; ++i) {
        const size_t off = (size_t)(brow + ai * 128 + (tid >> 5) + 16 * i) * 1024 + nc;
        if (layer == 0) xv[i] = *(const f32x4*)(xin + off);
        else { const u32x2 w = *(const u32x2*)(x1b + off); xv[i] = (f32x4){bflo(w.x), bfhi(w.x), bflo(w.y), bfhi(w.y)}; }
      }
#pragma unroll
      for (int i = 0; i < 8; ++i) {
        const int row = (tid >> 5) + 16 * i;
        const size_t off = (size_t)(brow + ai * 128 + row) * 1024 + nc;
        const f32x4 v = xv[i] + gt * *(const f32x4*)(Cs + row * CLD + ch * 4);
        if (layer == 0) { u32x2 w; w.x = pack2(v[0], v[1]); w.y = pack2(v[2], v[3]); *(u32x2*)(x1b + off) = w; }
        else *(f32x4*)(xout + off) = v;
      }
    }
  lds_barrier();
}

constexpr int KLD = 72;
struct KVRegs { u32x4 k[2], v[2]; };
DI void kv_load(const u16* kbase, const u16* vbase, int ldk, int ldv, int key0, KVRegs& r) {
  const int tid = otid();
#pragma unroll
  for (int i = 0; i < 2; ++i) {
    const int id = tid + 256 * i, row = id >> 3, ch = id & 7;
    r.k[i] = *(const u32x4*)(kbase + (size_t)(key0 + row) * ldk + ch * 8);
    r.v[i] = *(const u32x4*)(vbase + (size_t)(key0 + row) * ldv + ch * 8);
  }
}
DI void kv_store(u16* Ks, u16* Vs, const KVRegs& r) {
  const int tid = otid();
#pragma unroll
  for (int i = 0; i < 2; ++i) {
    const int id = tid + 256 * i, row = id >> 3, ch = id & 7;
    *(u32x4*)(Ks + row * KLD + ch * 8) = r.k[i];
    *(u32x4*)(Vs + row * KLD + ch * 8) = r.v[i];
  }
}
constexpr int KVBUF = 2 * 64 * KLD;
template <class UseF, class LoadF, class CompF>
DI void kv_pipeline(int j0, int j1, u16* buf, UseF use, LoadF load, CompF comp) {
  KVRegs kr;
  if (use(j0)) load(j0, kr);
  lds_barrier();
  if (use(j0)) kv_store(buf, buf + 64 * KLD, kr);
  if (j0 + 1 < j1 && use(j0 + 1)) load(j0 + 1, kr);
  lds_barrier();
  for (int j = j0; j < j1; ++j) {
    u16* cur = buf + ((j - j0) & 1) * KVBUF; u16* nxt = buf + (((j - j0) & 1) ^ 1) * KVBUF;
    if (j + 1 < j1 && use(j + 1)) kv_store(nxt, nxt + 64 * KLD, kr);
    if (j + 2 < j1 && use(j + 2)) load(j + 2, kr);
    if (use(j)) comp(j, cur, cur + 64 * KLD);
    lds_barrier();
  }
}
struct AttnAcc { f32x4 o[4][2]; float m[2], l[2]; f32x4 os[2]; int fresh; };
DI void attn_init(AttnAcc& a) {
#pragma unroll
  for (int d = 0; d < 4; ++d) { a.o[d][0] = (f32x4){0.f, 0.f, 0.f, 0.f}; a.o[d][1] = (f32x4){0.f, 0.f, 0.f, 0.f}; }
  a.m[0] = a.m[1] = -1e30f; a.l[0] = a.l[1] = 0.f;
}
template <int NKS>
DI void qk_tile(const u16* Ks, int dofs, const bf16x8 (&qf)[2][NKS], f32x4 (&s)[4][2], int l15, int g) {
#pragma unroll
  for (int kt = 0; kt < 4; ++kt) {
    s[kt][0] = (f32x4){0.f, 0.f, 0.f, 0.f}; s[kt][1] = (f32x4){0.f, 0.f, 0.f, 0.f};
#pragma unroll
    for (int ks = 0; ks < NKS; ++ks) {
      const bf16x8 a = ldfrag(Ks + (kt * 16 + l15) * KLD + dofs + ks * 32 + 8 * g);
      s[kt][0] = mfma16(a, qf[0][ks], s[kt][0]);
      s[kt][1] = mfma16(a, qf[1][ks], s[kt][1]);
    }
  }
}
DI void pv_accum(const bf16x8 (&pf)[2][2], const u16* Vs, f32x4 (&o)[4][2], int l15, int g) {
  const int tq = l15 >> 2, tp = l15 & 3;
#pragma unroll
  for (int kk = 0; kk < 2; ++kk)
#pragma unroll
    for (int d = 0; d < 4; ++d) {
      const bf16x8 vf = cat4(tr_read(Vs + (kk * 32 + 4 * g + tq) * KLD + d * 16 + 4 * tp), tr_read(Vs + (kk * 32 + 16 + 4 * g + tq) * KLD + d * 16 + 4 * tp));
      o[d][0] = mfma16(vf, pf[0][kk], o[d][0]);
      o[d][1] = mfma16(vf, pf[1][kk], o[d][1]);
    }
}
DI void pack_p(const f32x4 (&s)[4][2], bf16x8 (&pf)[2][2]) {
#pragma unroll
  for (int qt = 0; qt < 2; ++qt)
#pragma unroll
    for (int kk = 0; kk < 2; ++kk) {
      u32x4 w;
      w.x = pack2(s[2 * kk][qt][0], s[2 * kk][qt][1]); w.y = pack2(s[2 * kk][qt][2], s[2 * kk][qt][3]);
      w.z = pack2(s[2 * kk + 1][qt][0], s[2 * kk + 1][qt][1]); w.w = pack2(s[2 * kk + 1][qt][2], s[2 * kk + 1][qt][3]);
      pf[qt][kk] = __builtin_bit_cast(bf16x8, w);
    }
}
constexpr float DEFER_THR = 5.f;
template <class VF>
DI void softmax_pv(f32x4 (&s)[4][2], AttnAcc& a, const u16* Vs, float sc, int l15, int g, VF valid) {
  bf16x8 pf[2][2];
  float mxl[2];
#pragma unroll
  for (int qt = 0; qt < 2; ++qt) {
    float mx = -1e30f;
#pragma unroll
    for (int kt = 0; kt < 4; ++kt)
#pragma unroll
      for (int r = 0; r < 4; ++r) { const float v = valid(kt, r, qt) ? s[kt][qt][r] * sc : -1e30f; s[kt][qt][r] = v; mx = fmaxf(mx, v); }
    mxl[qt] = mx;
  }
  if (__any((mxl[0] > a.m[0] + DEFER_THR) || (mxl[1] > a.m[1] + DEFER_THR))) {
#pragma unroll
    for (int qt = 0; qt < 2; ++qt) {
      float mx = mxl[qt];
      mx = fmaxf(mx, __shfl_xor(mx, 16)); mx = fmaxf(mx, __shfl_xor(mx, 32));
      const float mn = fmaxf(a.m[qt], mx), alpha = exp2_(a.m[qt] - mn);
      a.m[qt] = mn; a.l[qt] *= alpha;
#pragma unroll
      for (int d = 0; d < 4; ++d) a.o[d][qt] *= alpha;
    }
  }
#pragma unroll
  for (int qt = 0; qt < 2; ++qt) {
    const float mn = a.m[qt];
    float ls = 0.f;
#pragma unroll
    for (int kt = 0; kt < 4; ++kt)
#pragma unroll
      for (int r = 0; r < 4; ++r) { const float v = s[kt][qt][r]; const float pv = v > -1e29f ? exp2_(v - mn) : 0.f; s[kt][qt][r] = pv; ls += pv; }
    a.l[qt] += ls;
  }
  pack_p(s, pf);
  pv_accum(pf, Vs, a.o, l15, g);
}
DI void softmax_pv_nomask(f32x4 (&s)[4][2], AttnAcc& a, const u16* Vs, float sc, int l15, int g) {
  bf16x8 pf[2][2];
  float mxl[2];
#pragma unroll
  for (int qt = 0; qt < 2; ++qt) {
    float mx = s[0][qt][0];
#pragma unroll
    for (int kt = 0; kt < 4; ++kt)
#pragma unroll
      for (int r = 0; r < 4; ++r) mx = fmaxf(mx, s[kt][qt][r]);
    mxl[qt] = mx * sc;
  }
  if (__any((mxl[0] > a.m[0] + DEFER_THR) || (mxl[1] > a.m[1] + DEFER_THR))) {
#pragma unroll
    for (int qt = 0; qt < 2; ++qt) {
      float mx = mxl[qt];
      mx = fmaxf(mx, __shfl_xor(mx, 16)); mx = fmaxf(mx, __shfl_xor(mx, 32));
      const float mn = fmaxf(a.m[qt], mx), alpha = exp2_(a.m[qt] - mn);
      a.m[qt] = mn; a.l[qt] *= alpha;
#pragma unroll
      for (int d = 0; d < 4; ++d) a.o[d][qt] *= alpha;
    }
  }
#pragma unroll
  for (int qt = 0; qt < 2; ++qt) {
    const float mn = a.m[qt];
    float ls = 0.f;
#pragma unroll
    for (int kt = 0; kt < 4; ++kt)
#pragma unroll
      for (int r = 0; r < 4; ++r) { const float pv = exp2_(__builtin_fmaf(s[kt][qt][r], sc, -mn)); s[kt][qt][r] = pv; ls += pv; }
    a.l[qt] += ls;
  }
  pack_p(s, pf);
  pv_accum(pf, Vs, a.o, l15, g);
}
template <class VF>
DI void softmax_p(f32x4 (&s)[4][2], AttnAcc& a, float sc, bf16x8 (&pf)[2][2], bool nomask, VF valid) {
  float mxl[2];
#pragma unroll
  for (int qt = 0; qt < 2; ++qt) {
    float mx = -1e30f;
#pragma unroll
    for (int kt = 0; kt < 4; ++kt)
#pragma unroll
      for (int r = 0; r < 4; ++r) { const float v = (nomask || valid(kt, r, qt)) ? s[kt][qt][r] * sc : -1e30f; s[kt][qt][r] = v; mx = fmaxf(mx, v); }
    mxl[qt] = mx;
  }
  if (__any((mxl[0] > a.m[0] + DEFER_THR) || (mxl[1] > a.m[1] + DEFER_THR))) {
#pragma unroll
    for (int qt = 0; qt < 2; ++qt) {
      float mx = mxl[qt];
      mx = fmaxf(mx, __shfl_xor(mx, 16)); mx = fmaxf(mx, __shfl_xor(mx, 32));
      const float mn = fmaxf(a.m[qt], mx), alpha = exp2_(a.m[qt] - mn);
      a.m[qt] = mn; a.l[qt] *= alpha;
#pragma unroll
      for (int d = 0; d < 4; ++d) a.o[d][qt] *= alpha;
    }
  }
#pragma unroll
  for (int qt = 0; qt < 2; ++qt) {
    const float mn = a.m[qt];
    float ls = 0.f;
#pragma unroll
    for (int kt = 0; kt < 4; ++kt)
#pragma unroll
      for (int r = 0; r < 4; ++r) { const float v = s[kt][qt][r]; const float pv = v > -1e29f ? exp2_(v - mn) : 0.f; s[kt][qt][r] = pv; ls += pv; }
    a.l[qt] += ls;
  }
  pack_p(s, pf);
}
DI void softmax_p_nomask(f32x4 (&s)[4][2], AttnAcc& a, float sc, bf16x8 (&pf)[2][2]) {
  float mxl[2];
#pragma unroll
  for (int qt = 0; qt < 2; ++qt) {
    float mx = s[0][qt][0];
#pragma unroll
    for (int kt = 0; kt < 4; ++kt)
#pragma unroll
      for (int r = 0; r < 4; ++r) mx = fmaxf(mx, s[kt][qt][r]);
    mxl[qt] = mx * sc;
  }
  if (__any((mxl[0] > a.m[0] + DEFER_THR) || (mxl[1] > a.m[1] + DEFER_THR))) {
#pragma unroll
    for (int qt = 0; qt < 2; ++qt) {
      float mx = mxl[qt];
      mx = fmaxf(mx, __shfl_xor(mx, 16)); mx = fmaxf(mx, __shfl_xor(mx, 32));
      const float mn = fmaxf(a.m[qt], mx), alpha = exp2_(a.m[qt] - mn);
      a.m[qt] = mn; a.l[qt] *= alpha;
#pragma unroll
      for (int d = 0; d < 4; ++d) a.o[d][qt] *= alpha;
    }
  }
#pragma unroll
  for (int qt = 0; qt < 2; ++qt) {
    const float mn = a.m[qt];
    float ls = 0.f;
#pragma unroll
    for (int kt = 0; kt < 4; ++kt)
#pragma unroll
      for (int r = 0; r < 4; ++r) { const float pv = exp2_(__builtin_fmaf(s[kt][qt][r], sc, -mn)); s[kt][qt][r] = pv; ls += pv; }
    a.l[qt] += ls;
  }
  pack_p(s, pf);
}
DI float group_sum4_(float v) { v += __shfl_xor(v, 16); v += __shfl_xor(v, 32); return v; }
DI bf16x8 scale_frag(bf16x8 f, float sc) {
  u32x4 w = __builtin_bit_cast(u32x4, f);
  w.x = pack2(bflo(w.x) * sc, bfhi(w.x) * sc); w.y = pack2(bflo(w.y) * sc, bfhi(w.y) * sc);
  w.z = pack2(bflo(w.z) * sc, bfhi(w.z) * sc); w.w = pack2(bflo(w.w) * sc, bfhi(w.w) * sc);
  return __builtin_bit_cast(bf16x8, w);
}
DI void attn_init_rel(AttnAcc& a) { attn_init(a); a.m[0] = a.m[1] = 0.f; a.os[0] = (f32x4){0.f, 0.f, 0.f, 0.f}; a.os[1] = (f32x4){0.f, 0.f, 0.f, 0.f}; a.fresh = 1; }
DI void rowsum_accum(const bf16x8 (&pf)[2][2], AttnAcc& a, int l15) {
  const short one = l15 == 0 ? (short)0x3F80 : (short)0;
  const bf16x8 ones = {one, one, one, one, one, one, one, one};
#pragma unroll
  for (int kk = 0; kk < 2; ++kk) { a.os[0] = mfma16(ones, pf[0][kk], a.os[0]); a.os[1] = mfma16(ones, pf[1][kk], a.os[1]); }
}
DI float rel_rowsum(const AttnAcc& a, int qt, int l15) { return __shfl(a.os[qt][0], l15); }
template <int NKS>
DI void qk_tile_rel(const u16* Ks, int dofs, const bf16x8 (&qf)[2][NKS], const AttnAcc& a, f32x4 (&s)[4][2], int l15, int g, bool ok0 = true, bool ok1 = true) {
  const float n0 = ok0 ? -a.m[0] : -1e30f, n1 = ok1 ? -a.m[1] : -1e30f;
#pragma unroll
  for (int kt = 0; kt < 4; ++kt) {
    s[kt][0] = (f32x4){n0, n0, n0, n0}; s[kt][1] = (f32x4){n1, n1, n1, n1};
#pragma unroll
    for (int ks = 0; ks < NKS; ++ks) {
      const bf16x8 k = ldfrag(Ks + (kt * 16 + l15) * KLD + dofs + ks * 32 + 8 * g);
      s[kt][0] = mfma16(k, qf[0][ks], s[kt][0]);
      s[kt][1] = mfma16(k, qf[1][ks], s[kt][1]);
    }
  }
}
template <int MODE, class VF>
DI void softmax_rel(f32x4 (&s)[4][2], AttnAcc& a, bf16x8 (&pf)[2][2], int l15_, VF valid, bool ok0 = true, bool ok1 = true) {
  float mxl[2];
#pragma unroll
  for (int qt = 0; qt < 2; ++qt) {
    float mx = -1e30f;
    const bool okq = qt == 0 ? ok0 : ok1;
#pragma unroll
    for (int kt = 0; kt < 4; ++kt)
#pragma unroll
      for (int r = 0; r < 4; ++r) {
        if (MODE == 1) s[kt][qt][r] = valid(kt, r, qt) ? s[kt][qt][r] : -1e30f;
        if (MODE == 2) s[kt][qt][r] = okq ? s[kt][qt][r] : -1e30f;
        mx = fmaxf(mx, s[kt][qt][r]);
      }
    mxl[qt] = mx;
  }
  if (a.fresh || __any(mxl[0] > DEFER_THR || mxl[1] > DEFER_THR)) {
    bool still = false;
#pragma unroll
    for (int qt = 0; qt < 2; ++qt) {
      float mx = mxl[qt];
      mx = fmaxf(mx, __shfl_xor(mx, 16)); mx = fmaxf(mx, __shfl_xor(mx, 32));
      const bool fresh = rel_rowsum(a, qt, l15_) == 0.f;
      const float dl = mx < -1e29f ? 0.f : (fresh ? mx : fmaxf(mx, 0.f)), alpha = exp2_(-dl);
      still = still || (fresh && mx < -1e29f);
      a.m[qt] += dl; a.os[qt] *= alpha;
#pragma unroll
      for (int d = 0; d < 4; ++d) a.o[d][qt] *= alpha;
#pragma unroll
      for (int kt = 0; kt < 4; ++kt)
#pragma unroll
        for (int r = 0; r < 4; ++r) s[kt][qt][r] -= dl;
    }
    a.fresh = __any(still) ? 1 : 0;
  }
#pragma unroll
  for (int qt = 0; qt < 2; ++qt)
#pragma unroll
    for (int kt = 0; kt < 4; ++kt)
#pragma unroll
      for (int r = 0; r < 4; ++r) s[kt][qt][r] = exp2_(s[kt][qt][r]);
  pack_p(s, pf);
}
template <class LoadF, class CompF>
DI void kv_pipeline3(int j0, int j1, u16* buf, LoadF load, CompF comp) {
  KVRegs kr;
  load(j0, kr);
  lds_barrier();
  kv_store(buf, buf + 64 * KLD, kr);
  if (j0 + 1 < j1) load(j0 + 1, kr);
  lds_barrier();
  int cb = 0;
  for (int j = j0; j < j1; ++j) {
    const int nb = cb == 2 ? 0 : cb + 1, pb = cb == 0 ? 2 : cb - 1;
    if (j + 1 < j1) kv_store(buf + nb * KVBUF, buf + nb * KVBUF + 64 * KLD, kr);
    if (j + 2 < j1) load(j + 2, kr);
    comp(j, buf + cb * KVBUF, buf + pb * KVBUF);
    lds_barrier();
    cb = nb;
  }
}
DI float group_sum4(float v) { v += __shfl_xor(v, 16); v += __shfl_xor(v, 32); return v; }

constexpr int DSTAGE = 2 * 128 * 64;
DI int fKs(int row) { return (row >> 1) & 7; }
DI int fVs(int row) { return ((row >> 1) & 3) << 1; }
DI void kv_dma128(const u16* kbase, const u16* vbase, int ld, int key0, u16* stage, int tid) {
#pragma unroll
  for (int i = 0; i < 4; ++i) {
    const int id = tid + 256 * i, row = id >> 3, c8 = id & 7;
    __builtin_amdgcn_global_load_lds((const unsigned*)(kbase + (size_t)(key0 + row) * ld + ((c8 ^ fKs(row)) * 8)), (LDSP unsigned*)((LDSP char*)stage + id * 16), 16, 0, 0);
  }
#pragma unroll
  for (int i = 0; i < 4; ++i) {
    const int id = tid + 256 * i, row = id >> 3, c8 = id & 7;
    __builtin_amdgcn_global_load_lds((const unsigned*)(vbase + (size_t)(key0 + row) * ld + ((c8 ^ fVs(row)) * 8)), (LDSP unsigned*)((LDSP char*)(stage + 128 * 64) + id * 16), 16, 0, 0);
  }
}
template <int NKS>
DI void qk_tile_rel_sw(const u16* Kh, int dofs, const bf16x8 (&qf)[2][NKS], const AttnAcc& a, f32x4 (&s)[4][2], int l15, int g) {
  const float n0 = -a.m[0], n1 = -a.m[1];
  const int sw = (l15 >> 1) & 7;
#pragma unroll
  for (int kt = 0; kt < 4; ++kt) {
    s[kt][0] = (f32x4){n0, n0, n0, n0}; s[kt][1] = (f32x4){n1, n1, n1, n1};
#pragma unroll
    for (int ks = 0; ks < NKS; ++ks) {
      const bf16x8 k = ldfrag(Kh + (kt * 16 + l15) * 64 + ((((dofs >> 3) + ks * 4 + g) ^ sw) * 8));
      s[kt][0] = mfma16(k, qf[0][ks], s[kt][0]);
      s[kt][1] = mfma16(k, qf[1][ks], s[kt][1]);
    }
  }
}
DI void pv_accum_sw(const bf16x8 (&pf)[2][2], const u16* Vh, f32x4 (&o)[4][2], int l15, int g) {
  const int tq = l15 >> 2, tp = l15 & 3;
#pragma unroll
  for (int kk = 0; kk < 2; ++kk) {
    const int r0 = kk * 32 + 4 * g + tq, r1 = r0 + 16;
    const int f0 = fVs(r0), f1 = fVs(r1);
#pragma unroll
    for (int d = 0; d < 4; ++d) {
      const int lc = d * 2 + (tp >> 1);
      const bf16x8 vf = cat4(tr_read(Vh + r0 * 64 + ((lc ^ f0) * 8) + (tp & 1) * 4), tr_read(Vh + r1 * 64 + ((lc ^ f1) * 8) + (tp & 1) * 4));
      o[d][0] = mfma16(vf, pf[0][kk], o[d][0]);
      o[d][1] = mfma16(vf, pf[1][kk], o[d][1]);
    }
  }
}
DI void diff_attn_task(const Params& p, int layer, int b, int h, int qb, unsigned char* smem, bool skew) {
  u16* Ks = (u16*)smem; u16* Vs = Ks + 64 * KLD;
  const int tid = otid(), lane = tid & 63, wid = tid >> 6, l15 = lane & 15, g = lane >> 4;
  const u16* proj = (const u16*)(p.ws + OFF_PROJ) + (size_t)b * SEQ * NP;
  const int q0w = qb * 128 + wid * 32;
  const float* lam = p.diff_lam + layer * 128;
  float s01 = 0.f, s23 = 0.f;
  for (int i = 0; i < 32; ++i) { s01 += lam[i] * lam[32 + i]; s23 += lam[64 + i] * lam[96 + i]; }
  const float lam_init = layer == 0 ? 0.2f : 0.35550906759096324f;
  const float lam_full = sgprf(__expf(s01) - __expf(s23) + lam_init);
  const float sc = 0.17677669529663687f * 1.4426950408889634f;
  const int ntile = 2 * qb + 2;
  const u16* vbase = proj + PB_V + h * 64;
  f32x4 res[4][2];
#pragma unroll 1
  for (int c = 0; c < 2; ++c) {
    const u16* kbase = proj + PB_K + h * 64;
    bf16x8 qf[2][1];
#pragma unroll
    for (int qt = 0; qt < 2; ++qt) qf[qt][0] = scale_frag(ldfrag(proj + (size_t)(q0w + qt * 16 + l15) * NP + PB_Q + h * 64 + c * 32 + 8 * g), sc);
    AttnAcc a; attn_init_rel(a);
    const int nst = qb + 1;
    asm volatile("s_waitcnt vmcnt(0)" ::: "memory");
    lds_barrier();
    kv_dma128(kbase, vbase, NP, 0, Ks, tid);
    asm volatile("s_waitcnt vmcnt(0)" ::: "memory");
    lds_barrier();
    for (int js = 0; js < nst; ++js) {
      const u16* st = Ks + (js & 1) * DSTAGE;
      if (js + 1 < nst) kv_dma128(kbase, vbase, NP, (js + 1) * 128, Ks + ((js + 1) & 1) * DSTAGE, tid);
#pragma unroll 1
      for (int hf = 0; hf < 2; ++hf) {
        const int key0 = js * 128 + hf * 64;
        if (key0 <= q0w + 31) {
          f32x4 s[4][2]; bf16x8 pf[2][2];
          auto valid = [&](int kt, int r, int qt) { return key0 + kt * 16 + 4 * g + r <= q0w + qt * 16 + l15; };
          qk_tile_rel_sw<1>(st + hf * 64 * 64, c * 32, qf, a, s, l15, g);
          if (key0 + 63 <= q0w) softmax_rel<0>(s, a, pf, l15, valid); else softmax_rel<1>(s, a, pf, l15, valid);
          pv_accum_sw(pf, st + 128 * 64 + hf * 64 * 64, a.o, l15, g);
          rowsum_accum(pf, a, l15);
        }
      }
      asm volatile("s_waitcnt vmcnt(0)" ::: "memory");
      lds_barrier();
    }
#pragma unroll
    for (int qt = 0; qt < 2; ++qt) {
      const float lt = rel_rowsum(a, qt, l15);
      const float inv = c == 0 ? 1.f / lt : -lam_full / lt;
#pragma unroll
      for (int d = 0; d < 4; ++d) res[d][qt] = c == 0 ? a.o[d][qt] * inv : res[d][qt] + a.o[d][qt] * inv;
    }
  }
  u16* Y = (u16*)(p.ws + OFF_H);
  const float* ng = p.diff_norm_g + layer * 64;
#pragma unroll
  for (int qt = 0; qt < 2; ++qt) {
    float ss = 0.f;
#pragma unroll
    for (int d = 0; d < 4; ++d) { const f32x4 v = res[d][qt]; ss += v[0] * v[0] + v[1] * v[1] + v[2] * v[2] + v[3] * v[3]; }
    ss = group_sum4(ss);
    const float rn = rsqrtf(ss * (1.f / 64.f) + 1e-6f) * (1.f - lam_init);
    const int t = q0w + qt * 16 + l15;
    const size_t row = (size_t)b * SEQ + t;
#pragma unroll
    for (int d = 0; d < 4; ++d) {
      const int dd = d * 16 + 4 * g;
      const f32x4 v = res[d][qt];
      const u32x2 zz = *(const u32x2*)(proj + (size_t)t * NP + PB_Z + h * 64 + dd);
      const f32x4 gg = *(const f32x4*)(ng + dd);
      u32x2 w;
      w.x = pack2(v[0] * rn * gg[0] * siluf(bflo(zz.x)), v[1] * rn * gg[1] * siluf(bfhi(zz.x)));
      w.y = pack2(v[2] * rn * gg[2] * siluf(bflo(zz.y)), v[3] * rn * gg[3] * siluf(bfhi(zz.y)));
      *(u32x2*)(Y + row * 1024 + Y_B + h * 64 + dd) = w;
    }
  }
}

template <int NKS>
DI void qk_tile1(const u16* Ks, const bf16x8 (&qf)[NKS], f32x4 (&s)[4], int l15, int g) {
#pragma unroll
  for (int kt = 0; kt < 4; ++kt) {
    s[kt] = (f32x4){0.f, 0.f, 0.f, 0.f};
#pragma unroll
    for (int ks = 0; ks < NKS; ++ks) s[kt] = mfma16(ldfrag(Ks + (kt * 16 + l15) * KLD + ks * 32 + 8 * g), qf[ks], s[kt]);
  }
}
DI void pv_accum1(const f32x4 (&s)[4], const u16* Vs, f32x4 (&o)[4], int l15, int g) {
  const int tq = l15 >> 2, tp = l15 & 3;
#pragma unroll
  for (int kk = 0; kk < 2; ++kk) {
    u32x4 w;
    w.x = pack2(s[2 * kk][0], s[2 * kk][1]); w.y = pack2(s[2 * kk][2], s[2 * kk][3]);
    w.z = pack2(s[2 * kk + 1][0], s[2 * kk + 1][1]); w.w = pack2(s[2 * kk + 1][2], s[2 * kk + 1][3]);
    const bf16x8 pf = __builtin_bit_cast(bf16x8, w);
#pragma unroll
    for (int d = 0; d < 4; ++d) {
      const bf16x8 vf = cat4(tr_read(Vs + (kk * 32 + 4 * g + tq) * KLD + d * 16 + 4 * tp), tr_read(Vs + (kk * 32 + 16 + 4 * g + tq) * KLD + d * 16 + 4 * tp));
      o[d] = mfma16(vf, pf, o[d]);
    }
  }
}
DI void conv_silu_stage(const u16* projb, int col0, const float* cw, const float* cb, int chan0, int nchan, int t0, u16* dst, const float* rowscale, float cscale) {
  const int tid = otid(), ch = (tid & 7) * 8;
  float w[4][8], bias[8];
#pragma unroll
  for (int j = 0; j < 4; ++j)
#pragma unroll
    for (int i = 0; i < 8; ++i) w[j][i] = cw[j * nchan + chan0 + ch + i];
#pragma unroll
  for (int i = 0; i < 8; ++i) bias[i] = cb[chan0 + ch + i];
#pragma unroll 1
  for (int ps = 0; ps < 4; ++ps) {
    const int row = ps * 32 + (tid >> 3), t = t0 + row;
    float acc[8];
#pragma unroll
    for (int i = 0; i < 8; ++i) acc[i] = bias[i];
#pragma unroll
    for (int j = 0; j < 4; ++j) {
      const int tt = t - 3 + j;
      if (tt >= 0) {
        const u32x4 v = *(const u32x4*)(projb + (size_t)tt * NP + col0 + ch);
        acc[0] += w[j][0] * bflo(v.x); acc[1] += w[j][1] * bfhi(v.x); acc[2] += w[j][2] * bflo(v.y); acc[3] += w[j][3] * bfhi(v.y);
        acc[4] += w[j][4] * bflo(v.z); acc[5] += w[j][5] * bfhi(v.z); acc[6] += w[j][6] * bflo(v.w); acc[7] += w[j][7] * bfhi(v.w);
      }
    }
    const float rs = (rowscale ? rowscale[row] : 1.f) * cscale;
#pragma unroll
    for (int i = 0; i < 8; ++i) acc[i] = siluf(acc[i]) * rs;
    u32x4 o; o.x = pack2(acc[0], acc[1]); o.y = pack2(acc[2], acc[3]); o.z = pack2(acc[4], acc[5]); o.w = pack2(acc[6], acc[7]);
    *(u32x4*)(dst + row * KLD + ch) = o;
  }
}
DI float block_scan128_add(float v, float* tmp) {
  const int tid = otid(), lane = tid & 63;
  float x = v;
#pragma unroll
  for (int o = 1; o < 64; o <<= 1) { const float y = __shfl_up(x, o); if (lane >= o) x += y; }
  lds_barrier();
  if (tid == 63) tmp[0] = x;
  lds_barrier();
  if ((tid >> 6) == 1) x += tmp[0];
  return x;
}
DI float block_scan128_max(float v, float* tmp) {
  const int tid = otid(), lane = tid & 63;
  float x = v;
#pragma unroll
  for (int o = 1; o < 64; o <<= 1) { const float y = __shfl_up(x, o); if (lane >= o) x = fmaxf(x, y); }
  lds_barrier();
  if (tid == 63) tmp[0] = x;
  lds_barrier();
  if ((tid >> 6) == 1) x = fmaxf(x, tmp[0]);
  return x;
}
DI void scale_rows(u16* A, const float* rs) {
  const int tid = otid(), ch = (tid & 7) * 8;
#pragma unroll
  for (int ps = 0; ps < 4; ++ps) {
    const int row = ps * 32 + (tid >> 3);
    const float f = rs[row];
    u32x4 v = *(u32x4*)(A + row * KLD + ch);
    v.x = pack2(bflo(v.x) * f, bfhi(v.x) * f); v.y = pack2(bflo(v.y) * f, bfhi(v.y) * f);
    v.z = pack2(bflo(v.z) * f, bfhi(v.z) * f); v.w = pack2(bflo(v.w) * f, bfhi(v.w) * f);
    *(u32x4*)(A + row * KLD + ch) = v;
  }
}
DI void state_update(const u16* Xs, const u16* Bs, f32x4 (&acc)[4], int w, int l15, int g) {
  const int tq = l15 >> 2, tp = l15 & 3;
#pragma unroll
  for (int kk = 0; kk < 4; ++kk) {
    const bf16x8 af = cat4(tr_read(Xs + (kk * 32 + 4 * g + tq) * KLD + w * 16 + 4 * tp), tr_read(Xs + (kk * 32 + 16 + 4 * g + tq) * KLD + w * 16 + 4 * tp));
#pragma unroll
    for (int nt = 0; nt < 4; ++nt) {
      const bf16x8 bfr = cat4(tr_read(Bs + (kk * 32 + 4 * g + tq) * KLD + nt * 16 + 4 * tp), tr_read(Bs + (kk * 32 + 16 + 4 * g + tq) * KLD + nt * 16 + 4 * tp));
      acc[nt] = mfma16(af, bfr, acc[nt]);
    }
  }
}
DI void state_to_lds(u16* Ss, const f32x4 (&acc)[4], int w, int l15, int g) {
#pragma unroll
  for (int nt = 0; nt < 4; ++nt)
#pragma unroll
    for (int r = 0; r < 4; ++r) Ss[(w * 16 + 4 * g + r) * KLD + nt * 16 + l15] = f2bf(acc[nt][r]);
}

constexpr int SEQ_LDS_A = 0, SEQ_LDS_B = 128 * KLD * 2, SEQ_LDS_C = 2 * 128 * KLD * 2, SEQ_LDS_S = 3 * 128 * KLD * 2, SEQ_LDS_F = SEQ_LDS_S + 64 * KLD * 2;
constexpr int SEQ_LDS_HALO = SEQ_LDS_F + 4096;
constexpr int SEQ_LDS_CW = SEQ_LDS_HALO + 2 * 3 * 3 * 64 * 2;
struct RawRegs { u32x4 r[4]; };
DI void raw_load(const u16* projb, int col0, int t0, RawRegs& rr, int tid) {
#pragma unroll
  for (int i = 0; i < 4; ++i) rr.r[i] = *(const u32x4*)(projb + (size_t)(t0 + (tid >> 3) + 32 * i) * NP + col0 + (tid & 7) * 8);
}
DI void raw_store(u16* dst, u16* halo_next, const RawRegs& rr, int tid) {
#pragma unroll
  for (int i = 0; i < 4; ++i) *(u32x4*)(dst + ((tid >> 3) + 32 * i) * KLD + (tid & 7) * 8) = rr.r[i];
  if (halo_next && tid >= 232) *(u32x4*)(halo_next + ((tid >> 3) - 29) * 64 + (tid & 7) * 8) = rr.r[3];
}
DI void conv_from_lds(const u16* raw, const u16* halo, const float* wl, const float* rowscale, float cscale, u32x4 (&out)[4], int tid) {
  const int q = tid >> 3, ch = (tid & 7) * 8;
  u32x4 v[7];
#pragma unroll
  for (int k = 0; k < 7; ++k) { const int r = 4 * q - 3 + k; v[k] = r >= 0 ? *(const u32x4*)(raw + r * KLD + ch) : *(const u32x4*)(halo + (r + 3) * 64 + ch); }
  float w[5][8];
#pragma unroll
  for (int j = 0; j < 5; ++j) { const f32x4 w0 = *(const f32x4*)(wl + j * 64 + ch), w1 = *(const f32x4*)(wl + j * 64 + ch + 4);
    w[j][0] = w0[0]; w[j][1] = w0[1]; w[j][2] = w0[2]; w[j][3] = w0[3]; w[j][4] = w1[0]; w[j][5] = w1[1]; w[j][6] = w1[2]; w[j][7] = w1[3]; }
#pragma unroll
  for (int o = 0; o < 4; ++o) {
    float acc[8];
#pragma unroll
    for (int i = 0; i < 8; ++i) acc[i] = w[4][i];
#pragma unroll
    for (int j = 0; j < 4; ++j) {
      const u32x4 x = v[o + j];
      acc[0] += w[j][0] * bflo(x.x); acc[1] += w[j][1] * bfhi(x.x); acc[2] += w[j][2] * bflo(x.y); acc[3] += w[j][3] * bfhi(x.y);
      acc[4] += w[j][4] * bflo(x.z); acc[5] += w[j][5] * bfhi(x.z); acc[6] += w[j][6] * bflo(x.w); acc[7] += w[j][7] * bfhi(x.w);
    }
    const float rs = (rowscale ? rowscale[4 * q + o] : 1.f) * cscale;
#pragma unroll
    for (int i = 0; i < 8; ++i) acc[i] = siluf(acc[i]) * rs;
    out[o].x = pack2(acc[0], acc[1]); out[o].y = pack2(acc[2], acc[3]); out[o].z = pack2(acc[4], acc[5]); out[o].w = pack2(acc[6], acc[7]);
  }
}
DI void conv_write(u16* dst, const u32x4 (&out)[4], int tid) {
  const int q = tid >> 3, ch = (tid & 7) * 8;
#pragma unroll
  for (int o = 0; o < 4; ++o) *(u32x4*)(dst + (4 * q + o) * KLD + ch) = out[o];
}
DI void stage_conv_w(float* wl, const float* cw, const float* cb, int chan0, int nchan, int tid) {
  for (int i = tid; i < 320; i += 256) { const int j = i >> 6, cc = i & 63; wl[i] = j < 4 ? cw[j * nchan + chan0 + cc] : cb[chan0 + cc]; }
}
DI float wave_scan_add(float x, int lane) {
#pragma unroll
  for (int o = 1; o < 64; o <<= 1) { const float y = __shfl_up(x, o); if (lane >= o) x += y; }
  return x;
}
DI float wave_scan_max(float x, int lane) {
#pragma unroll
  for (int o = 1; o < 64; o <<= 1) { const float y = __shfl_up(x, o); if (lane >= o) x = fmaxf(x, y); }
  return x;
}

DI void ssd_task(const Params& p, int layer, int b, int h, unsigned char* smem) {
  u16* Cs = (u16*)(smem + SEQ_LDS_A); u16* Bs = (u16*)(smem + SEQ_LDS_B); u16* Xs = (u16*)(smem + SEQ_LDS_C); u16* Ss = (u16*)(smem + SEQ_LDS_S);
  float* fl = (float*)(smem + SEQ_LDS_F);
  float* dts = fl; float* acs = fl + 128; float* wend = fl + 256; float* tmp = fl + 384;
  u16* halo = (u16*)(smem + SEQ_LDS_HALO); float* cwl = (float*)(smem + SEQ_LDS_CW);
  int tid = otid(), lane = tid & 63, w = tid >> 6, l15 = lane & 15, g = lane >> 4;
  const int gi = h >> 1;
  const u16* projb = (const u16*)(p.ws + OFF_PROJ) + (size_t)b * SEQ * NP;
  const float* smb = (const float*)(p.ws + OFF_SMALL) + (size_t)b * SEQ * NSMALL;
  const float* cw = p.ssm_conv_w + layer * 4 * 512; const float* cb = p.ssm_conv_b + layer * 512;
  u16* Y = (u16*)(p.ws + OFF_H);
  const float a_h = -__expf(p.ssm_a_log[layer * 4 + h]), d_h = p.ssm_d[layer * 4 + h], dtb = p.ssm_dt_bias[layer * 4 + h];
  const int colB = PC_XBC + 256 + gi * 64, colC = PC_XBC + 384 + gi * 64, colX = PC_XBC + h * 64;
  f32x4 st[4];
#pragma unroll
  for (int nt = 0; nt < 4; ++nt) st[nt] = (f32x4){0.f, 0.f, 0.f, 0.f};
  lds_barrier();
  stage_conv_w(cwl, cw, cb, 256 + gi * 64, 512, tid);
  stage_conv_w(cwl + 320, cw, cb, 384 + gi * 64, 512, tid);
  stage_conv_w(cwl + 640, cw, cb, h * 64, 512, tid);
  for (int i = tid; i < 3 * 3 * 64; i += 256) halo[i] = 0;
  RawRegs rB, rC, rX; float dtraw = 0.f;
  raw_load(projb, colB, 0, rB, tid); raw_load(projb, colC, 0, rC, tid); raw_load(projb, colX, 0, rX, tid);
  if (tid < 128) dtraw = smb[(size_t)tid * NSMALL + SM_DT + h];
#pragma unroll 1
  for (int c = 0; c < 32; ++c) {
    const int t0 = c * 128;
    asm volatile("" : "+v"(tid)); lane = tid & 63; w = tid >> 6; l15 = lane & 15; g = lane >> 4;
    u16* hcur = halo + (c & 1) * 576; u16* hnext = halo + ((c + 1) & 1) * 576;
    float dtv = 0.f;
    if (tid < 128) { const float xr = dtraw + dtb; dtv = xr > 15.f ? xr : __logf(1.f + __expf(xr)); }
    float cs = wave_scan_add(dtv * a_h, lane);
    if (tid == 63) tmp[0] = cs;
    lds_barrier();
    if (w == 1) cs += tmp[0];
    if (tid < 128) { dts[tid] = dtv; acs[tid] = cs; }
    raw_store(Bs, hnext, rB, tid); raw_store(Cs, hnext + 192, rC, tid); raw_store(Xs, hnext + 384, rX, tid);
    lds_barrier();
    if (c + 1 < 32) {
      raw_load(projb, colB, t0 + 128, rB, tid); raw_load(projb, colC, t0 + 128, rC, tid);
      if (tid < 128) dtraw = smb[(size_t)(t0 + 128 + tid) * NSMALL + SM_DT + h];
    }
    {
      u32x4 o1[4], o2[4];
      conv_from_lds(Bs, hcur, cwl, nullptr, 1.f, o1, tid);
      lds_barrier();
      conv_write(Bs, o1, tid);
      conv_from_lds(Cs, hcur + 192, cwl + 320, nullptr, 1.f, o2, tid);
      lds_barrier();
      conv_write(Cs, o2, tid);
      conv_from_lds(Xs, hcur + 384, cwl + 640, dts, 1.f, o1, tid);
      lds_barrier();
      conv_write(Xs, o1, tid);
    }
    if (tid < 128) wend[tid] = __expf(acs[127] - acs[tid]);
    state_to_lds(Ss, st, w, l15, g);
    lds_barrier();
#pragma unroll 1
    for (int qt = 0; qt < 2; ++qt) {
      const int tl = 32 * w + qt * 16 + l15;
      bf16x8 cf[2];
#pragma unroll
      for (int ks = 0; ks < 2; ++ks) cf[ks] = ldfrag(Cs + tl * KLD + ks * 32 + 8 * g);
      f32x4 y[4];
#pragma unroll
      for (int d = 0; d < 4; ++d) y[d] = (f32x4){0.f, 0.f, 0.f, 0.f};
      const float at = acs[tl];
#pragma unroll 1
      for (int stl = 0; stl < 2; ++stl) {
        if (stl * 64 <= 32 * w + qt * 16 + 15) {
          f32x4 sc[4];
          qk_tile1<2>(Bs + stl * 64 * KLD, cf, sc, l15, g);
#pragma unroll
          for (int kt = 0; kt < 4; ++kt) {
            const f32x4 as = *(const f32x4*)(acs + stl * 64 + kt * 16 + 4 * g);
#pragma unroll
            for (int r = 0; r < 4; ++r) {
              const bool ok = stl * 64 + kt * 16 + 4 * g + r <= tl;
              sc[kt][r] = ok ? sc[kt][r] * __expf(at - as[r]) : 0.f;
            }
          }
          pv_accum1(sc, Xs + stl * 64 * KLD, y, l15, g);
        }
      }
      const float ea = __expf(at), dsk = d_h / dts[tl];
      const size_t row = (size_t)b * SEQ + t0 + tl;
#pragma unroll
      for (int d = 0; d < 4; ++d) {
        f32x4 yo = (f32x4){0.f, 0.f, 0.f, 0.f};
#pragma unroll
        for (int ks = 0; ks < 2; ++ks) yo = mfma16(ldfrag(Ss + (d * 16 + l15) * KLD + ks * 32 + 8 * g), cf[ks], yo);
        const u32x2 xv = *(const u32x2*)(Xs + tl * KLD + d * 16 + 4 * g);
        const f32x4 v = y[d] + yo * ea;
        u32x2 o; o.x = pack2(v[0] + dsk * bflo(xv.x), v[1] + dsk * bfhi(xv.x)); o.y = pack2(v[2] + dsk * bflo(xv.y), v[3] + dsk * bfhi(xv.y));
        *(u32x2*)(Y + row * 1024 + Y_C + h * 64 + d * 16 + 4 * g) = o;
      }
    }
    if (c + 1 < 32) raw_load(projb, colX, t0 + 128, rX, tid);
    lds_barrier();
    scale_rows(Xs, wend);
    lds_barrier();
    const float cd = __expf(acs[127]);
#pragma unroll
    for (int nt = 0; nt < 4; ++nt) st[nt] *= cd;
    state_update(Xs, Bs, st, w, l15, g);
  }
}
DI void seq_fix_rows(const Params& p, int layer, int r0, int nrows) {
  u16* Y = (u16*)(p.ws + OFF_H);
  const u16* proj = (const u16*)(p.ws + OFF_PROJ);
  const int tid = otid(), lane = tid & 63, wv = tid >> 6;
  const bool ml = lane >= 32;
  const int ch = (lane & 31) * 8;
  const float* ng = ml ? p.ml_norm_g + layer * 64 + (ch & 63) : p.ssm_norm_g + layer * 256 + ch;
  const f32x4 g0 = *(const f32x4*)ng, g1 = *(const f32x4*)(ng + 4);
  for (int rb = wv * 4; rb < nrows; rb += 16) {
    u32x4 yv4[4], zv4[4], ov4[4];
#pragma unroll
    for (int j = 0; j < 4; ++j) {
      const size_t row = (size_t)(r0 + rb + j);
      yv4[j] = *(const u32x4*)(Y + row * 1024 + (ml ? Y_D : Y_C) + ch);
      zv4[j] = *(const u32x4*)(proj + row * NP + (ml ? PD_Z : PC_Z) + ch);
      ov4[j] = ml ? *(const u32x4*)(proj + row * NP + PD_O + ch) : (u32x4){0u, 0u, 0u, 0u};
    }
#pragma unroll
    for (int j = 0; j < 4; ++j) {
      const size_t row = (size_t)(r0 + rb + j);
      u16* yp = Y + row * 1024 + (ml ? Y_D : Y_C) + ch;
      const u32x4 yv = yv4[j], zv = zv4[j], ov = ov4[j];
      float v[8] = {bflo(yv.x), bfhi(yv.x), bflo(yv.y), bfhi(yv.y), bflo(yv.z), bfhi(yv.z), bflo(yv.w), bfhi(yv.w)};
      float z[8] = {bflo(zv.x), bfhi(zv.x), bflo(zv.y), bfhi(zv.y), bflo(zv.z), bfhi(zv.z), bflo(zv.w), bfhi(zv.w)};
      float ss = 0.f;
      if (ml) {
        const float o[8] = {bflo(ov.x), bfhi(ov.x), bflo(ov.y), bfhi(ov.y), bflo(ov.z), bfhi(ov.z), bflo(ov.w), bfhi(ov.w)};
#pragma unroll
        for (int i = 0; i < 8; ++i) { v[i] *= sigmoidf_(o[i]); ss += v[i] * v[i]; }
      } else {
#pragma unroll
        for (int i = 0; i < 8; ++i) { v[i] *= siluf(z[i]); ss += v[i] * v[i]; }
      }
      ss += __shfl_xor(ss, 1); ss += __shfl_xor(ss, 2); ss += __shfl_xor(ss, 4);
      const float ss16 = ss + __shfl_xor(ss, 8);
      const float rn = ml ? rsqrtf(ss * (1.f / 64.f) + 1e-6f) : rsqrtf(ss16 * (1.f / 128.f) + 1e-6f);
      float o8[8];
#pragma unroll
      for (int i = 0; i < 8; ++i) { const float gg = i < 4 ? g0[i & 3] : g1[i & 3]; o8[i] = v[i] * rn * gg * (ml ? siluf(z[i]) : 1.f); }
      u32x4 w; w.x = pack2(o8[0], o8[1]); w.y = pack2(o8[2], o8[3]); w.z = pack2(o8[4], o8[5]); w.w = pack2(o8[6], o8[7]);
      *(u32x4*)yp = w;
    }
  }
}

DI void mlstm_task(const Params& p, int layer, int b, int h, unsigned char* smem) {
  u16* Qs = (u16*)(smem + SEQ_LDS_A); u16* Ks2 = (u16*)(smem + SEQ_LDS_B); u16* Vs2 = (u16*)(smem + SEQ_LDS_C); u16* Cst = (u16*)(smem + SEQ_LDS_S);
  float* fl = (float*)(smem + SEQ_LDS_F);
  float* bcs = fl; float* us = fl + 128; float* pms = fl + 256; float* wend = fl + 384; float* nst = fl + 512; float* npart = fl + 576; float* tmp = fl + 832;
  u16* halo = (u16*)(smem + SEQ_LDS_HALO); float* cwl = (float*)(smem + SEQ_LDS_CW);
  int tid = otid(), lane = tid & 63, w = tid >> 6, l15 = lane & 15, g = lane >> 4;
  const u16* projb = (const u16*)(p.ws + OFF_PROJ) + (size_t)b * SEQ * NP;
  const float* smb = (const float*)(p.ws + OFF_SMALL) + (size_t)b * SEQ * NSMALL;
  const float* cw = p.ml_conv_w + layer * 4 * 512; const float* cb = p.ml_conv_b + layer * 512;
  const float ib = p.ml_if_b[layer * 8 + h], fb = p.ml_if_b[layer * 8 + 4 + h];
  u16* Y = (u16*)(p.ws + OFF_H);
  const int colQ = PD_QK + h * 64, colK = PD_QK + 256 + h * 64, colV = PD_V + h * 64;
  f32x4 st[4];
#pragma unroll
  for (int nt = 0; nt < 4; ++nt) st[nt] = (f32x4){0.f, 0.f, 0.f, 0.f};
  float m_prev = 0.f;
  lds_barrier();
  if (tid < 64) nst[tid] = 0.f;
  stage_conv_w(cwl, cw, cb, h * 64, 512, tid);
  stage_conv_w(cwl + 320, cw, cb, 256 + h * 64, 512, tid);
  for (int i = tid; i < 3 * 3 * 64; i += 256) halo[i] = 0;
  RawRegs rQ, rK, rV; float iraw = 0.f, fraw = 0.f;
  raw_load(projb, colQ, 0, rQ, tid); raw_load(projb, colK, 0, rK, tid); raw_load(projb, colV, 0, rV, tid);
  if (tid < 128) { iraw = smb[(size_t)tid * NSMALL + SM_IF + h]; fraw = smb[(size_t)tid * NSMALL + SM_IF + 4 + h]; }
#pragma unroll 1
  for (int c = 0; c < 32; ++c) {
    const int t0 = c * 128;
    asm volatile("" : "+v"(tid)); lane = tid & 63; w = tid >> 6; l15 = lane & 15; g = lane >> 4;
    u16* hcur = halo + (c & 1) * 576; u16* hnext = halo + ((c + 1) & 1) * 576;
    float ip = 0.f, lf = 0.f;
    if (tid < 128) { ip = iraw + ib; const float fp = fraw + fb; lf = fminf(fp, 0.f) - __logf(1.f + __expf(-fabsf(fp))); }
    float bc = wave_scan_add(lf, lane);
    if (tid == 63) tmp[0] = bc;
    lds_barrier();
    if (w == 1) bc += tmp[0];
    const float u = tid < 128 ? ip - bc : -1e30f;
    float pm = wave_scan_max(u, lane);
    if (tid == 63) tmp[1] = pm;
    raw_store(Qs, hnext, rQ, tid); raw_store(Ks2, hnext + 192, rK, tid); raw_store(Vs2, nullptr, rV, tid);
    lds_barrier();
    if (w == 1) pm = fmaxf(pm, tmp[1]);
    if (tid < 128) { bcs[tid] = bc; us[tid] = u; pms[tid] = pm; }
    if (c + 1 < 32) {
      raw_load(projb, colQ, t0 + 128, rQ, tid);
      if (tid < 128) { iraw = smb[(size_t)(t0 + 128 + tid) * NSMALL + SM_IF + h]; fraw = smb[(size_t)(t0 + 128 + tid) * NSMALL + SM_IF + 4 + h]; }
    }
    u32x4 oQ[4], oK[4];
    conv_from_lds(Qs, hcur, cwl, nullptr, 1.f, oQ, tid);
    __builtin_amdgcn_sched_barrier(0);
    conv_from_lds(Ks2, hcur + 192, cwl + 320, nullptr, 0.125f, oK, tid);
    __builtin_amdgcn_sched_barrier(0);
    lds_barrier();
    conv_write(Qs, oQ, tid); conv_write(Ks2, oK, tid);
    state_to_lds(Cst, st, w, l15, g);
    const float blast = bcs[127];
    const float m_new = blast + fmaxf(m_prev, pms[127]);
    if (tid < 128) wend[tid] = __expf(blast - m_new + us[tid]);
    lds_barrier();
#pragma unroll 1
    for (int qt = 0; qt < 2; ++qt) {
      const int tl = 32 * w + qt * 16 + l15;
      bf16x8 qf[2];
#pragma unroll
      for (int ks = 0; ks < 2; ++ks) qf[ks] = ldfrag(Qs + tl * KLD + ks * 32 + 8 * g);
      f32x4 num[4];
#pragma unroll
      for (int d = 0; d < 4; ++d) num[d] = (f32x4){0.f, 0.f, 0.f, 0.f};
      const float bt = bcs[tl], mt = bt + fmaxf(m_prev, pms[tl]);
      float den = 0.f;
#pragma unroll 1
      for (int stl = 0; stl < 2; ++stl) {
        if (stl * 64 <= 32 * w + qt * 16 + 15) {
          f32x4 sc[4];
          qk_tile1<2>(Ks2 + stl * 64 * KLD, qf, sc, l15, g);
#pragma unroll
          for (int kt = 0; kt < 4; ++kt) {
            const f32x4 uu = *(const f32x4*)(us + stl * 64 + kt * 16 + 4 * g);
#pragma unroll
            for (int r = 0; r < 4; ++r) {
              const bool ok = stl * 64 + kt * 16 + 4 * g + r <= tl;
              const float v = ok ? sc[kt][r] * __expf(bt - mt + uu[r]) : 0.f;
              sc[kt][r] = v; den += v;
            }
          }
          pv_accum1(sc, Vs2 + stl * 64 * KLD, num, l15, g);
        }
      }
      const float wi = __expf(bt + m_prev - mt);
      float qn = 0.f;
#pragma unroll
      for (int ks = 0; ks < 2; ++ks)
#pragma unroll
        for (int j = 0; j < 8; ++j) qn += bf2f((u16)qf[ks][j]) * nst[ks * 32 + 8 * g + j];
      qn = group_sum4(qn);
      const float dn = group_sum4(den) + wi * qn;
      const float inv = __builtin_amdgcn_rcpf(fmaxf(fabsf(dn), __expf(-mt)));
      const size_t row = (size_t)b * SEQ + t0 + tl;
#pragma unroll
      for (int d = 0; d < 4; ++d) {
        f32x4 ni = (f32x4){0.f, 0.f, 0.f, 0.f};
#pragma unroll
        for (int ks = 0; ks < 2; ++ks) ni = mfma16(ldfrag(Cst + (d * 16 + l15) * KLD + ks * 32 + 8 * g), qf[ks], ni);
        const f32x4 v = (num[d] + ni * wi) * inv;
        u32x2 o; o.x = pack2(v[0], v[1]); o.y = pack2(v[2], v[3]);
        *(u32x2*)(Y + row * 1024 + Y_D + h * 64 + d * 16 + 4 * g) = o;
      }
    }
    if (c + 1 < 32) { raw_load(projb, colK, t0 + 128, rK, tid); raw_load(projb, colV, t0 + 128, rV, tid); }
    lds_barrier();
    scale_rows(Ks2, wend);
    lds_barrier();
    const float fprev = __expf(blast + m_prev - m_new);
#pragma unroll
    for (int nt = 0; nt < 4; ++nt) st[nt] *= fprev;
    state_update(Vs2, Ks2, st, w, l15, g);
    {
      const int e = tid & 63, part = tid >> 6;
      float a = 0.f;
      for (int s2 = part * 32; s2 < part * 32 + 32; ++s2) a += bf2f(Ks2[s2 * KLD + e]);
      npart[part * 64 + e] = a;
    }
    lds_barrier();
    if (tid < 64) nst[tid] = nst[tid] * fprev + npart[tid] + npart[64 + tid] + npart[128 + tid] + npart[192 + tid];
    m_prev = m_new;
  }
}

constexpr int SEQ8_LDS_F = SEQ_LDS_S + 64 * KLD * 2;
constexpr int SEQ8_LDS_HALO = SEQ8_LDS_F + 8192;
constexpr int SEQ8_LDS_CW = SEQ8_LDS_HALO + 2 * 3 * 3 * 64 * 2;
struct RawRegs2 { u32x4 r[2]; };
DI void raw_load8(const u16* projb, int col0, int t0, RawRegs2& rr, int tid) {
#pragma unroll
  for (int i = 0; i < 2; ++i) rr.r[i] = *(const u32x4*)(projb + (size_t)(t0 + (tid >> 3) + 64 * i) * NP + col0 + (tid & 7) * 8);
}
DI void raw_store8(u16* dst, u16* halo_next, const RawRegs2& rr, int tid) {
#pragma unroll
  for (int i = 0; i < 2; ++i) *(u32x4*)(dst + ((tid >> 3) + 64 * i) * KLD + (tid & 7) * 8) = rr.r[i];
  if (halo_next && tid >= 488) *(u32x4*)(halo_next + ((tid >> 3) - 61) * 64 + (tid & 7) * 8) = rr.r[1];
}
DI void conv_from_lds8(const u16* raw, const u16* halo, const float* wl, const float* rowscale, float cscale, u32x4 (&out)[2], int tid) {
  const int q = tid >> 3, ch = (tid & 7) * 8;
  u32x4 v[5];
#pragma unroll
  for (int k = 0; k < 5; ++k) { const int r = 2 * q - 3 + k; v[k] = r >= 0 ? *(const u32x4*)(raw + r * KLD + ch) : *(const u32x4*)(halo + (r + 3) * 64 + ch); }
  float w[5][8];
#pragma unroll
  for (int j = 0; j < 5; ++j) { const f32x4 w0 = *(const f32x4*)(wl + j * 64 + ch), w1 = *(const f32x4*)(wl + j * 64 + ch + 4);
    w[j][0] = w0[0]; w[j][1] = w0[1]; w[j][2] = w0[2]; w[j][3] = w0[3]; w[j][4] = w1[0]; w[j][5] = w1[1]; w[j][6] = w1[2]; w[j][7] = w1[3]; }
#pragma unroll
  for (int o = 0; o < 2; ++o) {
    float acc[8];
#pragma unroll
    for (int i = 0; i < 8; ++i) acc[i] = w[4][i];
#pragma unroll
    for (int j = 0; j < 4; ++j) {
      const u32x4 x = v[o + j];
      acc[0] += w[j][0] * bflo(x.x); acc[1] += w[j][1] * bfhi(x.x); acc[2] += w[j][2] * bflo(x.y); acc[3] += w[j][3] * bfhi(x.y);
      acc[4] += w[j][4] * bflo(x.z); acc[5] += w[j][5] * bfhi(x.z); acc[6] += w[j][6] * bflo(x.w); acc[7] += w[j][7] * bfhi(x.w);
    }
    const float rs = (rowscale ? rowscale[2 * q + o] : 1.f) * cscale;
#pragma unroll
    for (int i = 0; i < 8; ++i) acc[i] = siluf(acc[i]) * rs;
    out[o].x = pack2(acc[0], acc[1]); out[o].y = pack2(acc[2], acc[3]); out[o].z = pack2(acc[4], acc[5]); out[o].w = pack2(acc[6], acc[7]);
  }
}
DI void conv_write8(u16* dst, const u32x4 (&out)[2], int tid) {
  const int q = tid >> 3, ch = (tid & 7) * 8;
#pragma unroll
  for (int o = 0; o < 2; ++o) *(u32x4*)(dst + (2 * q + o) * KLD + ch) = out[o];
}
DI void stage_conv_w8(float* wl, const float* cw, const float* cb, int chan0, int nchan, int tid) {
  if (tid < 320) { const int j = tid >> 6, cc = tid & 63; wl[tid] = j < 4 ? cw[j * nchan + chan0 + cc] : cb[chan0 + cc]; }
}
DI void scale_rows8(u16* A, const float* rs, int tid) {
  const int ch = (tid & 7) * 8;
#pragma unroll
  for (int i = 0; i < 2; ++i) {
    const int row = (tid >> 3) + 64 * i;
    const float f = rs[row];
    u32x4 v = *(u32x4*)(A + row * KLD + ch);
    v.x = pack2(bflo(v.x) * f, bfhi(v.x) * f); v.y = pack2(bflo(v.y) * f, bfhi(v.y) * f);
    v.z = pack2(bflo(v.z) * f, bfhi(v.z) * f); v.w = pack2(bflo(v.w) * f, bfhi(v.w) * f);
    *(u32x4*)(A + row * KLD + ch) = v;
  }
}
DI void state_update8(const u16* Xs, const u16* Bs, f32x4 (&acc)[2], int w8, int l15, int g) {
  const int tq = l15 >> 2, tp = l15 & 3, pt = w8 >> 1, nt0 = (w8 & 1) * 2;
#pragma unroll
  for (int kk = 0; kk < 4; ++kk) {
    const bf16x8 af = cat4(tr_read(Xs + (kk * 32 + 4 * g + tq) * KLD + pt * 16 + 4 * tp), tr_read(Xs + (kk * 32 + 16 + 4 * g + tq) * KLD + pt * 16 + 4 * tp));
#pragma unroll
    for (int n = 0; n < 2; ++n) {
      const bf16x8 bfr = cat4(tr_read(Bs + (kk * 32 + 4 * g + tq) * KLD + (nt0 + n) * 16 + 4 * tp), tr_read(Bs + (kk * 32 + 16 + 4 * g + tq) * KLD + (nt0 + n) * 16 + 4 * tp));
      acc[n] = mfma16(af, bfr, acc[n]);
    }
  }
}
DI void state_to_lds8(u16* Ss, const f32x4 (&acc)[2], int w8, int l15, int g) {
  const int pt = w8 >> 1, nt0 = (w8 & 1) * 2;
#pragma unroll
  for (int n = 0; n < 2; ++n)
#pragma unroll
    for (int r = 0; r < 4; ++r) Ss[(pt * 16 + 4 * g + r) * KLD + (nt0 + n) * 16 + l15] = f2bf(acc[n][r]);
}

constexpr int SEQ8_LDS_ZERO = SEQ8_LDS_CW + 3 * 320 * 4;
constexpr int SEQ8_LDS_RAW = ((SEQ8_LDS_ZERO + 3 * 128 + 255) / 256) * 256;
DI void raw_dma8(const u16* projb, int col0, int t0, u16* raw, int tid) {
#pragma unroll
  for (int i = 0; i < 2; ++i) {
    const int chunk = tid + 512 * i;
    __builtin_amdgcn_global_load_lds((const unsigned*)(projb + (size_t)(t0 + (chunk >> 3)) * NP + col0 + (chunk & 7) * 8), (LDSP unsigned*)((LDSP char*)raw + chunk * 16), 16, 0, 0);
  }
}
DI void conv_raw8(const u16* raw, const u16* halo, const float* wl, const float* rowscale, float cscale, u16* dst, int tid) {
  const int q = tid >> 3, ch = (tid & 7) * 8;
  u32x4 v[5];
#pragma unroll
  for (int k = 0; k < 5; ++k) { const int r = 2 * q - 3 + k; v[k] = r >= 0 ? *(const u32x4*)(raw + r * 64 + ch) : *(const u32x4*)(halo + (r + 3) * 64 + ch); }
  float w[5][8];
#pragma unroll
  for (int j = 0; j < 5; ++j) { const f32x4 w0 = *(const f32x4*)(wl + j * 64 + ch), w1 = *(const f32x4*)(wl + j * 64 + ch + 4);
    w[j][0] = w0[0]; w[j][1] = w0[1]; w[j][2] = w0[2]; w[j][3] = w0[3]; w[j][4] = w1[0]; w[j][5] = w1[1]; w[j][6] = w1[2]; w[j][7] = w1[3]; }
#pragma unroll
  for (int o = 0; o < 2; ++o) {
    float acc[8];
#pragma unroll
    for (int i = 0; i < 8; ++i) acc[i] = w[4][i];
#pragma unroll
    for (int j = 0; j < 4; ++j) {
      const u32x4 x = v[o + j];
      acc[0] += w[j][0] * bflo(x.x); acc[1] += w[j][1] * bfhi(x.x); acc[2] += w[j][2] * bflo(x.y); acc[3] += w[j][3] * bfhi(x.y);
      acc[4] += w[j][4] * bflo(x.z); acc[5] += w[j][5] * bfhi(x.z); acc[6] += w[j][6] * bflo(x.w); acc[7] += w[j][7] * bfhi(x.w);
    }
    const float rs = (rowscale ? rowscale[2 * q + o] : 1.f) * cscale;
#pragma unroll
    for (int i = 0; i < 8; ++i) acc[i] = siluf(acc[i]) * rs;
    u32x4 ov; ov.x = pack2(acc[0], acc[1]); ov.y = pack2(acc[2], acc[3]); ov.z = pack2(acc[4], acc[5]); ov.w = pack2(acc[6], acc[7]);
    *(u32x4*)(dst + (2 * q + o) * KLD + ch) = ov;
  }
}
DI void save_halo8(const u16* raw, u16* halo, int tid) {
  if (tid < 72) { const int arr = tid / 24, rem = tid % 24; *(u32x4*)(halo + arr * 192 + rem * 8) = *(const u32x4*)(raw + arr * 8192 + 125 * 64 + rem * 8); }
}

DI void ssd_task8(const Params& p, int layer, int b, int h, unsigned char* smem) {
  u16* Cs = (u16*)(smem + SEQ_LDS_A); u16* Bs = (u16*)(smem + SEQ_LDS_B); u16* Xs = (u16*)(smem + SEQ_LDS_C); u16* Ss = (u16*)(smem + SEQ_LDS_S);
  float* fl = (float*)(smem + SEQ8_LDS_F);
  float* dts = fl; float* acs = fl + 128; float* wend = fl + 256; float* tmp = fl + 384;
  u16* halo = (u16*)(smem + SEQ8_LDS_HALO); float* cwl = (float*)(smem + SEQ8_LDS_CW); u16* zero3 = (u16*)(smem + SEQ8_LDS_ZERO);
  u16* raw = (u16*)(smem + SEQ8_LDS_RAW);
  int tid = otid512(), lane = tid & 63, w = tid >> 6, l15 = lane & 15, g = lane >> 4;
  const int gi = h >> 1;
  const u16* projb = (const u16*)(p.ws + OFF_PROJ) + (size_t)b * SEQ * NP;
  const float* smb = (const float*)(p.ws + OFF_SMALL) + (size_t)b * SEQ * NSMALL;
  const float* cw = p.ssm_conv_w + layer * 4 * 512; const float* cb = p.ssm_conv_b + layer * 512;
  u16* Y = (u16*)(p.ws + OFF_H);
  const float a_h = sgprf(-__expf(p.ssm_a_log[layer * 4 + h])), d_h = sgprf(p.ssm_d[layer * 4 + h]), dtb = sgprf(p.ssm_dt_bias[layer * 4 + h]);
  const int colB = PC_XBC + 256 + gi * 64, colC = PC_XBC + 384 + gi * 64, colX = PC_XBC + h * 64;
  f32x4 st[2] = {(f32x4){0.f, 0.f, 0.f, 0.f}, (f32x4){0.f, 0.f, 0.f, 0.f}};
  lds_barrier();
  stage_conv_w8(cwl, cw, cb, 256 + gi * 64, 512, tid);
  stage_conv_w8(cwl + 320, cw, cb, 384 + gi * 64, 512, tid);
  stage_conv_w8(cwl + 640, cw, cb, h * 64, 512, tid);
  if (tid < 96) ((unsigned*)zero3)[tid] = 0u;
  raw_dma8(projb, colB, 0, raw, tid); raw_dma8(projb, colC, 0, raw + 8192, tid); raw_dma8(projb, colX, 0, raw + 16384, tid);
  float dtraw = 0.f;
  if (tid < 128) dtraw = smb[(size_t)tid * NSMALL + SM_DT + h];
#pragma unroll 1
  for (int c = 0; c < 32; ++c) {
    const int t0 = c * 128;
    asm volatile("" : "+v"(tid)); lane = tid & 63; w = tid >> 6; l15 = lane & 15; g = lane >> 4;
    float dtv = 0.f;
    if (tid < 128) { const float xr = dtraw + dtb; dtv = xr > 15.f ? xr : __logf(1.f + __expf(xr)); }
    float cs = wave_scan_add(dtv * a_h, lane);
    if (tid == 63) tmp[0] = cs;
    asm volatile("s_waitcnt vmcnt(0)" ::: "memory");
    lds_barrier();
    if (w == 1) cs += tmp[0];
    if (tid < 128) { dts[tid] = dtv; acs[tid] = cs; }
    if (c + 1 < 32 && tid < 128) dtraw = smb[(size_t)(t0 + 128 + tid) * NSMALL + SM_DT + h];
    lds_barrier();
    {
      const u16* hc = halo + (c & 1) * 576;
      const u16* hB = c == 0 ? zero3 : hc; const u16* hC = c == 0 ? zero3 : hc + 192; const u16* hX = c == 0 ? zero3 : hc + 384;
      conv_raw8(raw, hB, cwl, nullptr, 1.f, Bs, tid);
      conv_raw8(raw + 8192, hC, cwl + 320, nullptr, 1.f, Cs, tid);
      conv_raw8(raw + 16384, hX, cwl + 640, dts, 1.f, Xs, tid);
      save_halo8(raw, halo + ((c + 1) & 1) * 576, tid);
    }
    if (tid < 128) wend[tid] = __expf(acs[127] - acs[tid]);
    state_to_lds8(Ss, st, w, l15, g);
    lds_barrier();
    if (c + 1 < 32) { raw_dma8(projb, colB, t0 + 128, raw, tid); raw_dma8(projb, colC, t0 + 128, raw + 8192, tid); raw_dma8(projb, colX, t0 + 128, raw + 16384, tid); }
    {
      const int tl = 16 * w + l15;
      bf16x8 cf[2];
#pragma unroll
      for (int ks = 0; ks < 2; ++ks) cf[ks] = ldfrag(Cs + tl * KLD + ks * 32 + 8 * g);
      f32x4 y[4];
#pragma unroll
      for (int d = 0; d < 4; ++d) y[d] = (f32x4){0.f, 0.f, 0.f, 0.f};
      const float at = acs[tl];
#pragma unroll 1
      for (int stl = 0; stl < 2; ++stl) {
        if (stl * 64 <= 16 * w + 15) {
          f32x4 sc[4];
          qk_tile1<2>(Bs + stl * 64 * KLD, cf, sc, l15, g);
#pragma unroll
          for (int kt = 0; kt < 4; ++kt) {
            const f32x4 as = *(const f32x4*)(acs + stl * 64 + kt * 16 + 4 * g);
#pragma unroll
            for (int r = 0; r < 4; ++r) {
              const bool ok = stl * 64 + kt * 16 + 4 * g + r <= tl;
              sc[kt][r] = ok ? sc[kt][r] * __expf(at - as[r]) : 0.f;
            }
          }
          pv_accum1(sc, Xs + stl * 64 * KLD, y, l15, g);
        }
      }
      const float ea = __expf(at), dsk = d_h / dts[tl];
      const size_t row = (size_t)b * SEQ + t0 + tl;
#pragma unroll
      for (int d = 0; d < 4; ++d) {
        f32x4 yo = (f32x4){0.f, 0.f, 0.f, 0.f};
#pragma unroll
        for (int ks = 0; ks < 2; ++ks) yo = mfma16(ldfrag(Ss + (d * 16 + l15) * KLD + ks * 32 + 8 * g), cf[ks], yo);
        const u32x2 xv = *(const u32x2*)(Xs + tl * KLD + d * 16 + 4 * g);
        const f32x4 v = y[d] + yo * ea;
        u32x2 o; o.x = pack2(v[0] + dsk * bflo(xv.x), v[1] + dsk * bfhi(xv.x)); o.y = pack2(v[2] + dsk * bflo(xv.y), v[3] + dsk * bfhi(xv.y));
        *(u32x2*)(Y + row * 1024 + Y_C + h * 64 + d * 16 + 4 * g) = o;
      }
    }
    lds_barrier();
    scale_rows8(Xs, wend, tid);
    lds_barrier();
    const float cd = __expf(acs[127]);
    st[0] *= cd; st[1] *= cd;
    state_update8(Xs, Bs, st, w, l15, g);
  }
  asm volatile("s_waitcnt vmcnt(0)" ::: "memory");
}

DI void mlstm_task8(const Params& p, int layer, int b, int h, unsigned char* smem) {
  u16* Qs = (u16*)(smem + SEQ_LDS_A); u16* Ks2 = (u16*)(smem + SEQ_LDS_B); u16* Vs2 = (u16*)(smem + SEQ_LDS_C); u16* Cst = (u16*)(smem + SEQ_LDS_S);
  float* fl = (float*)(smem + SEQ8_LDS_F);
  float* bcs = fl; float* us = fl + 128; float* pms = fl + 256; float* wend = fl + 384; float* nst = fl + 512; float* tmp = fl + 576; float* npart = fl + 640;
  u16* halo = (u16*)(smem + SEQ8_LDS_HALO); float* cwl = (float*)(smem + SEQ8_LDS_CW); u16* zero3 = (u16*)(smem + SEQ8_LDS_ZERO);
  u16* raw = (u16*)(smem + SEQ8_LDS_RAW);
  int tid = otid512(), lane = tid & 63, w = tid >> 6, l15 = lane & 15, g = lane >> 4;
  const u16* projb = (const u16*)(p.ws + OFF_PROJ) + (size_t)b * SEQ * NP;
  const float* smb = (const float*)(p.ws + OFF_SMALL) + (size_t)b * SEQ * NSMALL;
  const float* cw = p.ml_conv_w + layer * 4 * 512; const float* cb = p.ml_conv_b + layer * 512;
  const float ib = sgprf(p.ml_if_b[layer * 8 + h]), fb = sgprf(p.ml_if_b[layer * 8 + 4 + h]);
  u16* Y = (u16*)(p.ws + OFF_H);
  const int colQ = PD_QK + h * 64, colK = PD_QK + 256 + h * 64, colV = PD_V + h * 64;
  f32x4 st[2] = {(f32x4){0.f, 0.f, 0.f, 0.f}, (f32x4){0.f, 0.f, 0.f, 0.f}};
  float m_prev = 0.f;
  lds_barrier();
  if (tid < 64) nst[tid] = 0.f;
  stage_conv_w8(cwl, cw, cb, h * 64, 512, tid);
  stage_conv_w8(cwl + 320, cw, cb, 256 + h * 64, 512, tid);
  if (tid < 96) ((unsigned*)zero3)[tid] = 0u;
  raw_dma8(projb, colQ, 0, raw, tid); raw_dma8(projb, colK, 0, raw + 8192, tid); raw_dma8(projb, colV, 0, raw + 16384, tid);
  float iraw = 0.f, fraw = 0.f;
  if (tid < 128) { iraw = smb[(size_t)tid * NSMALL + SM_IF + h]; fraw = smb[(size_t)tid * NSMALL + SM_IF + 4 + h]; }
#pragma unroll 1
  for (int c = 0; c < 32; ++c) {
    const int t0 = c * 128;
    asm volatile("" : "+v"(tid)); lane = tid & 63; w = tid >> 6; l15 = lane & 15; g = lane >> 4;
    float ip = 0.f, lf = 0.f;
    if (tid < 128) { ip = iraw + ib; const float fp = fraw + fb; lf = fminf(fp, 0.f) - __logf(1.f + __expf(-fabsf(fp))); }
    float bc = wave_scan_add(lf, lane);
    if (tid == 63) tmp[0] = bc;
    asm volatile("s_waitcnt vmcnt(0)" ::: "memory");
    lds_barrier();
    if (w == 1) bc += tmp[0];
    const float u = tid < 128 ? ip - bc : -1e30f;
    float pm = wave_scan_max(u, lane);
    if (tid == 63) tmp[1] = pm;
    if (c + 1 < 32 && tid < 128) { iraw = smb[(size_t)(t0 + 128 + tid) * NSMALL + SM_IF + h]; fraw = smb[(size_t)(t0 + 128 + tid) * NSMALL + SM_IF + 4 + h]; }
    {
      const u16* hc = halo + (c & 1) * 576;
      const u16* hQ = c == 0 ? zero3 : hc; const u16* hK = c == 0 ? zero3 : hc + 192;
      conv_raw8(raw, hQ, cwl, nullptr, 1.f, Qs, tid);
      conv_raw8(raw + 8192, hK, cwl + 320, nullptr, 0.125f, Ks2, tid);
      save_halo8(raw, halo + ((c + 1) & 1) * 576, tid);
#pragma unroll
      for (int i = 0; i < 2; ++i) { const int chunk = tid + 512 * i; *(u32x4*)(Vs2 + (chunk >> 3) * KLD + (chunk & 7) * 8) = *(const u32x4*)(raw + 16384 + chunk * 8); }
    }
    state_to_lds8(Cst, st, w, l15, g);
    lds_barrier();
    if (w == 1) pm = fmaxf(pm, tmp[1]);
    if (tid < 128) { bcs[tid] = bc; us[tid] = u; pms[tid] = pm; }
    if (c + 1 < 32) { raw_dma8(projb, colQ, t0 + 128, raw, tid); raw_dma8(projb, colK, t0 + 128, raw + 8192, tid); raw_dma8(projb, colV, t0 + 128, raw + 16384, tid); }
    lds_barrier();
    const float blast = bcs[127];
    const float m_new = blast + fmaxf(m_prev, pms[127]);
    if (tid < 128) wend[tid] = __expf(blast - m_new + us[tid]);
    {
      const int tl = 16 * w + l15;
      bf16x8 qf[2];
#pragma unroll
      for (int ks = 0; ks < 2; ++ks) qf[ks] = ldfrag(Qs + tl * KLD + ks * 32 + 8 * g);
      f32x4 num[4];
#pragma unroll
      for (int d = 0; d < 4; ++d) num[d] = (f32x4){0.f, 0.f, 0.f, 0.f};
      const float bt = bcs[tl], mt = bt + fmaxf(m_prev, pms[tl]);
      float den = 0.f;
#pragma unroll 1
      for (int stl = 0; stl < 2; ++stl) {
        if (stl * 64 <= 16 * w + 15) {
          f32x4 sc[4];
          qk_tile1<2>(Ks2 + stl * 64 * KLD, qf, sc, l15, g);
#pragma unroll
          for (int kt = 0; kt < 4; ++kt) {
            const f32x4 uu = *(const f32x4*)(us + stl * 64 + kt * 16 + 4 * g);
#pragma unroll
            for (int r = 0; r < 4; ++r) {
              const bool ok = stl * 64 + kt * 16 + 4 * g + r <= tl;
              const float v = ok ? sc[kt][r] * __expf(bt - mt + uu[r]) : 0.f;
              sc[kt][r] = v; den += v;
            }
          }
          pv_accum1(sc, Vs2 + stl * 64 * KLD, num, l15, g);
        }
      }
      const float wi = __expf(bt + m_prev - mt);
      float qn = 0.f;
#pragma unroll
      for (int ks = 0; ks < 2; ++ks)
#pragma unroll
        for (int j = 0; j < 8; ++j) qn += bf2f((u16)qf[ks][j]) * nst[ks * 32 + 8 * g + j];
      qn = group_sum4(qn);
      const float dn = group_sum4(den) + wi * qn;
      const float inv = __builtin_amdgcn_rcpf(fmaxf(fabsf(dn), __expf(-mt)));
      const size_t row = (size_t)b * SEQ + t0 + tl;
#pragma unroll
      for (int d = 0; d < 4; ++d) {
        f32x4 ni = (f32x4){0.f, 0.f, 0.f, 0.f};
#pragma unroll
        for (int ks = 0; ks < 2; ++ks) ni = mfma16(ldfrag(Cst + (d * 16 + l15) * KLD + ks * 32 + 8 * g), qf[ks], ni);
        const f32x4 v = (num[d] + ni * wi) * inv;
        u32x2 o; o.x = pack2(v[0], v[1]); o.y = pack2(v[2], v[3]);
        *(u32x2*)(Y + row * 1024 + Y_D + h * 64 + d * 16 + 4 * g) = o;
      }
    }
    lds_barrier();
    scale_rows8(Ks2, wend, tid);
    lds_barrier();
    const float fprev = __expf(blast + m_prev - m_new);
    st[0] *= fprev; st[1] *= fprev;
    state_update8(Vs2, Ks2, st, w, l15, g);
    {
      const int e = tid & 63, part = tid >> 6;
      float a = 0.f;
#pragma unroll
      for (int s2 = 0; s2 < 16; ++s2) a += bf2f(Ks2[(part * 16 + s2) * KLD + e]);
      npart[part * 64 + e] = a;
    }
    lds_barrier();
    if (tid < 64) {
      float a = nst[tid] * fprev;
#pragma unroll
      for (int pp = 0; pp < 8; ++pp) a += npart[pp * 64 + tid];
      nst[tid] = a;
    }
    m_prev = m_new;
  }
  asm volatile("s_waitcnt vmcnt(0)" ::: "memory");
}

DI void compress_task(const Params& p, int layer, int b, int kv, int rb, unsigned char* smem) {
  constexpr int HLD = 136;
  u16* Hs = (u16*)smem;
  const int tid = otid(), lane = tid & 63, w = tid >> 6, l15 = lane & 15, g = lane >> 4;
  const u16* projb = (const u16*)(p.ws + OFF_PROJ) + (size_t)b * SEQ * NP + (kv ? PA_VC : PA_KC);
  const int mi = layer * 2 + kv;
  const u16* W1T = (const u16*)(p.ws + OFF_W1T) + (size_t)mi * 128 * 2048;
  const u16* W2T = (const u16*)(p.ws + OFF_W2T) + (size_t)mi * 64 * 128;
  const float* bias1 = (const float*)(p.ws + OFF_BIAS1) + mi * 16 * 128;
  f32x4 acc[2][2];
#pragma unroll
  for (int nt = 0; nt < 2; ++nt) { acc[nt][0] = (f32x4){0.f, 0.f, 0.f, 0.f}; acc[nt][1] = (f32x4){0.f, 0.f, 0.f, 0.f}; }
  int tok[2];
#pragma unroll
  for (int mt = 0; mt < 2; ++mt) { int i = rb * 32 + mt * 16 + l15; if (i > 254) i = 254; tok[mt] = 16 * i; }
#pragma unroll 4
  for (int ks = 0; ks < 64; ++ks) {
    const int j = ks >> 1, d0 = (ks & 1) * 32;
    bf16x8 af[2], wf[2];
#pragma unroll
    for (int mt = 0; mt < 2; ++mt) af[mt] = ldfrag(projb + (size_t)(tok[mt] + j) * NP + d0 + 8 * g);
#pragma unroll
    for (int nt = 0; nt < 2; ++nt) wf[nt] = ldfrag(W1T + (size_t)(w * 32 + nt * 16 + l15) * 2048 + ks * 32 + 8 * g);
#pragma unroll
    for (int nt = 0; nt < 2; ++nt)
#pragma unroll
      for (int mt = 0; mt < 2; ++mt) acc[nt][mt] = mfma16(wf[nt], af[mt], acc[nt][mt]);
  }
  lds_barrier();
#pragma unroll
  for (int nt = 0; nt < 2; ++nt) {
    const int n = w * 32 + nt * 16 + 4 * g;
    f32x4 bb = *(const f32x4*)(bias1 + n);
#pragma unroll
    for (int pc = 1; pc < 16; ++pc) bb += *(const f32x4*)(bias1 + pc * 128 + n);
#pragma unroll
    for (int mt = 0; mt < 2; ++mt) {
      const f32x4 v = acc[nt][mt] + bb;
      u32x2 o; o.x = pack2(siluf(v[0]), siluf(v[1])); o.y = pack2(siluf(v[2]), siluf(v[3]));
      *(u32x2*)(Hs + (mt * 16 + l15) * HLD + n) = o;
    }
  }
  lds_barrier();
  f32x4 acc2[2] = {(f32x4){0.f, 0.f, 0.f, 0.f}, (f32x4){0.f, 0.f, 0.f, 0.f}};
#pragma unroll
  for (int ks = 0; ks < 4; ++ks) {
    const bf16x8 wf = ldfrag(W2T + (size_t)(w * 16 + l15) * 128 + ks * 32 + 8 * g);
#pragma unroll
    for (int mt = 0; mt < 2; ++mt) acc2[mt] = mfma16(wf, ldfrag(Hs + (mt * 16 + l15) * HLD + ks * 32 + 8 * g), acc2[mt]);
  }
  u16* dst = (u16*)(p.ws + (kv ? OFF_VCMP : OFF_KCMP) + (size_t)layer * 512 * 1024) + (size_t)b * 256 * 64;
#pragma unroll
  for (int mt = 0; mt < 2; ++mt) {
    const int i = rb * 32 + mt * 16 + l15;
    u32x2 o; o.x = pack2(acc2[mt][0], acc2[mt][1]); o.y = pack2(acc2[mt][2], acc2[mt][3]);
    if (i > 254) { o.x = 0u; o.y = 0u; }
    *(u32x2*)(dst + (size_t)i * 64 + w * 16 + 4 * g) = o;
  }
}

DI void nsa_task(const Params& p, int layer, int b, int qi, unsigned char* smem) {
  u16* Ks = (u16*)smem; u16* Vs = Ks + 64 * KLD;
  float* T = (float*)(smem + 2 * KVBUF * 2);
  unsigned long long* selm = (unsigned long long*)(smem + 2 * KVBUF * 2 + 4 * 32 * 65 * 4);
  const int tid = otid(), lane = tid & 63, h = tid >> 6, l15 = lane & 15, g = lane >> 4;
  const int q0 = qi * 32;
  const u16* projb = (const u16*)(p.ws + OFF_PROJ) + (size_t)b * SEQ * NP;
  const float* smb = (const float*)(p.ws + OFF_SMALL) + (size_t)b * SEQ * NSMALL;
  const u16* kcmp = (const u16*)(p.ws + OFF_KCMP + (size_t)layer * 512 * 1024) + (size_t)b * 256 * 64;
  const u16* vcmp = (const u16*)(p.ws + OFF_VCMP + (size_t)layer * 512 * 1024) + (size_t)b * 256 * 64;
  bf16x8 qf[2][2];
#pragma unroll
  for (int qt = 0; qt < 2; ++qt)
#pragma unroll
    for (int ks = 0; ks < 2; ++ks) qf[qt][ks] = ldfrag(projb + (size_t)(q0 + qt * 16 + l15) * NP + PA_Q + h * 64 + ks * 32 + 8 * g);
  const float sc = 0.125f * 1.4426950408889634f;
  f32x4 outacc[4][2];
  AttnAcc a;
  const int ntc = (q0 >> 10) + 1;
  attn_init(a);
  lds_barrier();
  for (int i = tid; i < 4 * 32 * 65; i += 256) T[i] = 0.f;
  kv_pipeline(0, ntc, Ks,
    [&](int) { return true; },
    [&](int j, KVRegs& kr) { kv_load(kcmp, vcmp, 64, 64, j * 64, kr); },
    [&](int j, const u16* Kt, const u16* Vt) {
      f32x4 s[4][2];
      auto valid = [&](int kt, int r, int qt) { return 16 * (j * 64 + kt * 16 + 4 * g + r) + 31 <= q0 + qt * 16 + l15; };
      qk_tile<2>(Kt, 0, qf, s, l15, g);
      softmax_pv(s, a, Vt, sc, l15, g, valid);
    });
  float cinv[2];
#pragma unroll
  for (int qt = 0; qt < 2; ++qt) {
    const float lt = group_sum4(a.l[qt]);
    cinv[qt] = lt > 0.f ? 1.f / lt : 0.f;
    const float gt = sigmoidf_(smb[(size_t)(q0 + qt * 16 + l15) * NSMALL + SM_G + h * 3 + 0]) * cinv[qt];
#pragma unroll
    for (int d = 0; d < 4; ++d) outacc[d][qt] = a.o[d][qt] * gt;
  }
  float carry[2] = {0.f, 0.f};
  kv_pipeline(0, ntc, Ks,
    [&](int) { return true; },
    [&](int j, KVRegs& kr) { kv_load(kcmp, vcmp, 64, 64, j * 64, kr); },
    [&](int j, const u16* Kt, const u16*) {
      f32x4 s[4][2];
      qk_tile<2>(Kt, 0, qf, s, l15, g);
#pragma unroll
      for (int qt = 0; qt < 2; ++qt) {
        float prev3 = carry[qt];
#pragma unroll
        for (int kt = 0; kt < 4; ++kt) {
          float pr[4];
#pragma unroll
          for (int r = 0; r < 4; ++r) {
            const bool ok = 16 * (j * 64 + kt * 16 + 4 * g + r) + 31 <= q0 + qt * 16 + l15;
            pr[r] = ok ? exp2_(s[kt][qt][r] * sc - a.m[qt]) * cinv[qt] : 0.f;
          }
          const float below = __shfl_up(pr[3], 16);
          const float wrap = __shfl(prev3, l15 + 48);
          const float nb = g > 0 ? below : wrap;
          T[(h * 32 + qt * 16 + l15) * 65 + j * 16 + kt * 4 + g] = (pr[0] + pr[1]) + (pr[2] + 0.5f * pr[3]) + 0.5f * nb;
          prev3 = pr[3];
        }
        carry[qt] = prev3;
      }
    });
  lds_barrier();
#pragma unroll 1
  for (int qq = 0; qq < 8; ++qq) {
    const int q = h * 8 + qq, t = q0 + q, cur = t >> 6;
    const float imp = ((T[(0 * 32 + q) * 65 + lane] + T[(1 * 32 + q) * 65 + lane]) + T[(2 * 32 + q) * 65 + lane]) + T[(3 * 32 + q) * 65 + lane];
    const bool forced = lane == cur || lane == 0, allowed = lane <= cur, cand = allowed && !forced;
    const int K = cur == 0 ? 15 : 14;
    unsigned long long m;
    if (__popcll(__ballot(cand)) <= K) m = __ballot(allowed);
    else {
      const unsigned key = __float_as_uint(imp);
      unsigned prefix = 0u;
#pragma unroll 1
      for (int bit = 30; bit >= 0; --bit) {
        const unsigned cnd = prefix | (1u << bit);
        if (__popcll(__ballot(cand && key >= cnd)) >= K) prefix = cnd;
      }
      const unsigned long long gt = __ballot(cand && key > prefix), eq = __ballot(cand && key == prefix);
      const int need = K - __popcll(gt);
      const int myrank = __popcll(eq & ((1ull << lane) - 1ull));
      m = gt | __ballot(cand && key == prefix && myrank < need) | __ballot(forced);
    }
    if (lane == 0) selm[q] = m;
  }
  lds_barrier();
  f32x4* park = (f32x4*)T + (h * 8) * 64 + lane;
#pragma unroll
  for (int d = 0; d < 4; ++d) { park[(d * 2 + 0) * 64] = outacc[d][0]; park[(d * 2 + 1) * 64] = outacc[d][1]; }
  unsigned long long mq[2], anym = 0ull;
#pragma unroll
  for (int qt = 0; qt < 2; ++qt) mq[qt] = selm[qt * 16 + l15];
  for (int i = 0; i < 32; ++i) anym |= selm[i];
  const int jhi = (q0 + 31) >> 6;
#pragma unroll
  for (int qt = 0; qt < 2; ++qt)
#pragma unroll
    for (int ks = 0; ks < 2; ++ks) qf[qt][ks] = scale_frag(qf[qt][ks], sc);
  attn_init_rel(a);
  kv_pipeline(0, jhi + 1, Ks,
    [&](int j) { return (bool)((anym >> j) & 1ull); },
    [&](int j, KVRegs& kr) { kv_load(projb + PA_KS, projb + PA_VS, NP, NP, j * 64, kr); },
    [&](int j, const u16* Kt, const u16* Vt) {
      f32x4 s[4][2];
      auto valid = [&](int kt, int r, int qt) { return ((mq[qt] >> j) & 1ull) && (j * 64 + kt * 16 + 4 * g + r <= q0 + qt * 16 + l15); };
      bf16x8 pf[2][2];
      if (j * 64 + 63 <= q0) {
        qk_tile_rel<2>(Kt, 0, qf, a, s, l15, g, (bool)((mq[0] >> j) & 1ull), (bool)((mq[1] >> j) & 1ull));
        softmax_rel<0>(s, a, pf, l15, valid);
      } else {
        qk_tile_rel<2>(Kt, 0, qf, a, s, l15, g);
        softmax_rel<1>(s, a, pf, l15, valid);
      }
      pv_accum(pf, Vt, a.o, l15, g);
      rowsum_accum(pf, a, l15);
    });
#pragma unroll
  for (int qt = 0; qt < 2; ++qt) {
    const float lt = rel_rowsum(a, qt, l15);
    const float gt = sigmoidf_(smb[(size_t)(q0 + qt * 16 + l15) * NSMALL + SM_G + h * 3 + 1]) * (lt > 0.f ? 1.f / lt : 0.f);
#pragma unroll
    for (int d = 0; d < 4; ++d) park[(d * 2 + qt) * 64] += a.o[d][qt] * gt;
  }
  attn_init_rel(a);
  const int jlo = q0 >= 511 ? (q0 - 511) >> 6 : 0;
  kv_pipeline(jlo, jhi + 1, Ks,
    [&](int) { return true; },
    [&](int j, KVRegs& kr) { kv_load(projb + PA_KW, projb + PA_VW, NP, NP, j * 64, kr); },
    [&](int j, const u16* Kt, const u16* Vt) {
      f32x4 s[4][2];
      auto valid = [&](int kt, int r, int qt) { const int key = j * 64 + kt * 16 + 4 * g + r, t = q0 + qt * 16 + l15; return key <= t && key + 512 > t; };
      bf16x8 pf[2][2];
      qk_tile_rel<2>(Kt, 0, qf, a, s, l15, g);
      if (j * 64 + 63 <= q0 && j * 64 + 512 > q0 + 31) softmax_rel<0>(s, a, pf, l15, valid);
      else softmax_rel<1>(s, a, pf, l15, valid);
      pv_accum(pf, Vt, a.o, l15, g);
      rowsum_accum(pf, a, l15);
    });
  u16* Y = (u16*)(p.ws + OFF_H);
  const float* ng = p.nsa_norm_g + layer * 64;
#pragma unroll
  for (int qt = 0; qt < 2; ++qt) {
    const int t = q0 + qt * 16 + l15;
    const float lt = rel_rowsum(a, qt, l15);
    const float gt = sigmoidf_(smb[(size_t)t * NSMALL + SM_G + h * 3 + 2]) * (lt > 0.f ? 1.f / lt : 0.f);
    f32x4 v[4]; float ss = 0.f;
#pragma unroll
    for (int d = 0; d < 4; ++d) { v[d] = park[(d * 2 + qt) * 64] + a.o[d][qt] * gt; ss += v[d][0] * v[d][0] + v[d][1] * v[d][1] + v[d][2] * v[d][2] + v[d][3] * v[d][3]; }
    ss = group_sum4(ss);
    const float rn = rsqrtf(ss * (1.f / 64.f) + 1e-6f);
    const size_t row = (size_t)b * SEQ + t;
#pragma unroll
    for (int d = 0; d < 4; ++d) {
      const int dd = d * 16 + 4 * g;
      const u32x2 zz = *(const u32x2*)(projb + (size_t)t * NP + PA_Z + h * 64 + dd);
      const f32x4 gg = *(const f32x4*)(ng + dd);
      u32x2 o;
      o.x = pack2(v[d][0] * rn * gg[0] * siluf(bflo(zz.x)), v[d][1] * rn * gg[1] * siluf(bfhi(zz.x)));
      o.y = pack2(v[d][2] * rn * gg[2] * siluf(bflo(zz.y)), v[d][3] * rn * gg[3] * siluf(bfhi(zz.y)));
      *(u32x2*)(Y + row * 1024 + Y_A + h * 64 + dd) = o;
    }
  }
}

DI void zero_y_cols(const Params& p, int c0, int ncols, int gtid, int gthreads) {
  u16* Y = (u16*)(p.ws + OFF_H);
  const int per_row = ncols / 8;
  for (size_t i = gtid; i < (size_t)NTOK * per_row; i += gthreads) {
    const size_t row = i / per_row; const int ch = (int)(i % per_row);
    *(u32x4*)(Y + row * 1024 + c0 + ch * 8) = (u32x4){0u, 0u, 0u, 0u};
  }
}

DI void final_norm_rows(const Params& p, int gw, int nw, int lane) {
  const float4* gp = (const float4*)p.final_g;
  float4 gg[4];
#pragma unroll
  for (int i = 0; i < 4; ++i) gg[i] = gp[lane + 64 * i];
  for (int row0 = gw * 4; row0 < NTOK; row0 += nw * 4) {
    float4 v[4][4]; float ss[4];
#pragma unroll
    for (int j = 0; j < 4; ++j) {
      const float4* xr = (const float4*)(p.out + (size_t)(row0 + j) * D_MODEL);
#pragma unroll
      for (int i = 0; i < 4; ++i) v[j][i] = xr[lane + 64 * i];
    }
#pragma unroll
    for (int j = 0; j < 4; ++j) {
      float a = 0.f;
#pragma unroll
      for (int i = 0; i < 4; ++i) a += v[j][i].x * v[j][i].x + v[j][i].y * v[j][i].y + v[j][i].z * v[j][i].z + v[j][i].w * v[j][i].w;
      ss[j] = wave_sum(a);
    }
#pragma unroll
    for (int j = 0; j < 4; ++j) {
      float4* xr = (float4*)(p.out + (size_t)(row0 + j) * D_MODEL);
      const float r = rsqrtf(ss[j] * (1.f / D_MODEL) + 1e-6f);
#pragma unroll
      for (int i = 0; i < 4; ++i) { float4 w; w.x = v[j][i].x * r * gg[i].x; w.y = v[j][i].y * r * gg[i].y; w.z = v[j][i].z * r * gg[i].z; w.w = v[j][i].w * r * gg[i].w; xr[lane + 64 * i] = w; }
    }
  }
}

#ifndef DEBUG_CHECK
#define DEBUG_CHECK 0
#endif
#if DEBUG_CHECK
constexpr int NCHK = 12;
DI float block_sum(float v, float* red) {
  v = wave_sum(v);
  lds_barrier();
  if ((threadIdx.x & 63) == 0) red[threadIdx.x >> 6] = v;
  lds_barrier();
  return red[0] + red[1] + red[2] + red[3];
}
DI float block_max(float v, float* red) {
#pragma unroll
  for (int o = 32; o > 0; o >>= 1) v = fmaxf(v, __shfl_xor(v, o));
  lds_barrier();
  if ((threadIdx.x & 63) == 0) red[threadIdx.x >> 6] = v;
  lds_barrier();
  return fmaxf(fmaxf(red[0], red[1]), fmaxf(red[2], red[3]));
}
DI float bfr(float v) { return bf2f(f2bf(v)); }
struct Chk { float num[NCHK], den[NCHK]; };
DI void chk_add(Chk& c, int id, float got, float ref) { const float d = got - ref; c.num[id] += d * d; c.den[id] += ref * ref; }

DI void dbg_diff_attn(const Params& p, int layer, int b, int t, int h, Chk& c, int id, unsigned char* smem) {
  float* p1 = (float*)smem; float* p2 = p1 + 4096; float* red = p2 + 4096;
  const int tid = otid();
  const u16* proj = (const u16*)(p.ws + OFF_PROJ) + (size_t)b * SEQ * NP;
  const u16* q = proj + (size_t)t * NP + PB_Q + h * 64;
  const float scale = 0.17677669529663687f;
  float m1 = -1e30f, m2 = -1e30f;
  for (int s = tid; s <= t; s += 256) {
    const u16* k = proj + (size_t)s * NP + PB_K + h * 64;
    float a1 = 0.f, a2 = 0.f;
    for (int d = 0; d < 32; ++d) { a1 += bf2f(q[d]) * bf2f(k[d]); a2 += bf2f(q[32 + d]) * bf2f(k[32 + d]); }
    a1 *= scale; a2 *= scale; p1[s] = a1; p2[s] = a2; m1 = fmaxf(m1, a1); m2 = fmaxf(m2, a2);
  }
  m1 = block_max(m1, red); m2 = block_max(m2, red);
  float l1 = 0.f, l2 = 0.f;
  for (int s = tid; s <= t; s += 256) { const float e1 = __expf(p1[s] - m1), e2 = __expf(p2[s] - m2); p1[s] = e1; p2[s] = e2; l1 += e1; l2 += e2; }
  l1 = block_sum(l1, red); l2 = block_sum(l2, red);
  const float* lam = p.diff_lam + layer * 128;
  float s01 = 0.f, s23 = 0.f;
  for (int i = 0; i < 32; ++i) { s01 += lam[i] * lam[32 + i]; s23 += lam[64 + i] * lam[96 + i]; }
  const float lam_init = 0.8f - 0.6f * expf(-0.3f * (float)layer);
  const float lam_full = expf(s01) - expf(s23) + lam_init;
  lds_barrier();
  float o = 0.f;
  if (tid < 64) for (int s = 0; s <= t; ++s) o += (p1[s] / l1 - lam_full * p2[s] / l2) * bf2f(proj[(size_t)s * NP + PB_V + h * 64 + tid]);
  float ss = block_sum(tid < 64 ? o * o : 0.f, red);
  if (tid < 64) {
    const float z = bf2f(proj[(size_t)t * NP + PB_Z + h * 64 + tid]);
    const float ref = o * rsqrtf(ss / 64.f + 1e-6f) * p.diff_norm_g[layer * 64 + tid] * (1.f - lam_init) * (z / (1.f + expf(-z)));
    const float got = bf2f(((const u16*)(p.ws + OFF_H))[((size_t)b * SEQ + t) * 1024 + Y_B + h * 64 + tid]);
    const float d = got - ref;
    o = d * d; ss = ref * ref;
  } else { o = 0.f; ss = 0.f; }
  c.num[id] += block_sum(o, red); c.den[id] += block_sum(ss, red);
}

DI float dbg_conv(const u16* projb, int t, int pcol, const float* cw, const float* cb, int ch, int nch) {
  float a = cb[ch];
  for (int j = 0; j < 4; ++j) { const int tt = t - 3 + j; if (tt >= 0) a += cw[j * nch + ch] * bf2f(projb[(size_t)tt * NP + pcol]); }
  return a / (1.f + expf(-a));
}
constexpr int DBG_NS = 11, DBG_T = 300;
DI int dbg_sample_idx(int t) {
  const int TS[DBG_NS] = {0, 1, 2, 3, 64, 127, 128, 129, 255, 256, 299};
  for (int i = 0; i < DBG_NS; ++i) if (TS[i] == t) return i;
  return -1;
}
DI int dbg_sample_t(int i) { const int TS[DBG_NS] = {0, 1, 2, 3, 64, 127, 128, 129, 255, 256, 299}; return TS[i]; }
DI void dbg_ssd(const Params& p, int layer, int b, int gi, Chk& c, int id, unsigned char* smem) {
  float* ybuf = (float*)smem;
  float* red = ybuf + DBG_NS * 128;
  const int tid = threadIdx.x, pp = tid >> 2, nq = tid & 3;
  const u16* projb = (const u16*)(p.ws + OFF_PROJ) + (size_t)b * SEQ * NP;
  const float* smb = (const float*)(p.ws + OFF_SMALL) + (size_t)b * SEQ * NSMALL;
  const float* cw = p.ssm_conv_w + layer * 4 * 512; const float* cb = p.ssm_conv_b + layer * 512;
  lds_barrier();
  for (int hh = 0; hh < 2; ++hh) {
    const int h = gi * 2 + hh;
    const float a_h = -expf(p.ssm_a_log[layer * 4 + h]), d_h = p.ssm_d[layer * 4 + h], dtb = p.ssm_dt_bias[layer * 4 + h];
    float hst[16];
    for (int i = 0; i < 16; ++i) hst[i] = 0.f;
    for (int t = 0; t < DBG_T; ++t) {
      const float xr = smb[(size_t)t * NSMALL + SM_DT + h] + dtb;
      const float dt = xr > 20.f ? xr : log1pf(expf(xr));
      const float dA = expf(dt * a_h);
      const float xp = dbg_conv(projb, t, PC_XBC + h * 64 + pp, cw, cb, h * 64 + pp, 512);
      float y = 0.f;
      for (int i = 0; i < 16; ++i) {
        const int n = nq * 16 + i;
        const float Bn = dbg_conv(projb, t, PC_XBC + 256 + gi * 64 + n, cw, cb, 256 + gi * 64 + n, 512);
        const float Cn = dbg_conv(projb, t, PC_XBC + 384 + gi * 64 + n, cw, cb, 384 + gi * 64 + n, 512);
        hst[i] = dA * hst[i] + dt * xp * Bn;
        y += Cn * hst[i];
      }
      y += __shfl_xor(y, 1); y += __shfl_xor(y, 2);
      y += d_h * xp;
      const int si = dbg_sample_idx(t);
      if (si >= 0 && nq == 0) { const float z = bf2f(projb[(size_t)t * NP + PC_Z + h * 64 + pp]); ybuf[si * 128 + hh * 64 + pp] = y * (z / (1.f + expf(-z))); }
    }
  }
  lds_barrier();
  for (int si = 0; si < DBG_NS; ++si) {
    const float v = tid < 128 ? ybuf[si * 128 + tid] : 0.f;
    const float ss = block_sum(v * v, red);
    float e2 = 0.f, r2 = 0.f;
    if (tid < 128) {
      const float ref = v * rsqrtf(ss / 128.f + 1e-6f) * p.ssm_norm_g[layer * 256 + gi * 128 + tid];
      const float got = bf2f(((const u16*)(p.ws + OFF_H))[((size_t)b * SEQ + dbg_sample_t(si)) * 1024 + Y_C + gi * 128 + tid]);
      e2 = (got - ref) * (got - ref); r2 = ref * ref;
    }
    c.num[id] += block_sum(e2, red); c.den[id] += block_sum(r2, red);
  }
}
DI void dbg_mlstm(const Params& p, int layer, int b, int h, Chk& c, int id, unsigned char* smem) {
  float* ybuf = (float*)smem;
  float* red = ybuf + DBG_NS * 128;
  const int tid = threadIdx.x, dd = tid >> 2, eq = tid & 3;
  const u16* projb = (const u16*)(p.ws + OFF_PROJ) + (size_t)b * SEQ * NP;
  const float* smb = (const float*)(p.ws + OFF_SMALL) + (size_t)b * SEQ * NSMALL;
  const float* cw = p.ml_conv_w + layer * 4 * 512; const float* cb = p.ml_conv_b + layer * 512;
  const float ib = p.ml_if_b[layer * 8 + h], fb = p.ml_if_b[layer * 8 + 4 + h];
  lds_barrier();
  float Cst[16], nst[16];
  for (int i = 0; i < 16; ++i) { Cst[i] = 0.f; nst[i] = 0.f; }
  float m = 0.f;
  for (int t = 0; t < DBG_T; ++t) {
    const float ip = smb[(size_t)t * NSMALL + SM_IF + h] + ib, fp = smb[(size_t)t * NSMALL + SM_IF + 4 + h] + fb;
    const float lf = fminf(fp, 0.f) - log1pf(expf(-fabsf(fp)));
    const float mn = fmaxf(lf + m, ip), fs = expf(lf + m - mn), is = expf(ip - mn);
    const float vd = bf2f(projb[(size_t)t * NP + PD_V + h * 64 + dd]);
    float num = 0.f, den = 0.f;
    for (int i = 0; i < 16; ++i) {
      const int e = eq * 16 + i;
      const float qe = dbg_conv(projb, t, PD_QK + h * 64 + e, cw, cb, h * 64 + e, 512);
      const float ke = 0.125f * dbg_conv(projb, t, PD_QK + 256 + h * 64 + e, cw, cb, 256 + h * 64 + e, 512);
      Cst[i] = fs * Cst[i] + is * vd * ke; nst[i] = fs * nst[i] + is * ke;
      num += Cst[i] * qe; den += nst[i] * qe;
    }
    num += __shfl_xor(num, 1); num += __shfl_xor(num, 2); den += __shfl_xor(den, 1); den += __shfl_xor(den, 2);
    const float hv = num / fmaxf(fabsf(den), expf(-mn));
    m = mn;
    const int si = dbg_sample_idx(t);
    if (si >= 0 && eq == 0) { const float o = bf2f(projb[(size_t)t * NP + PD_O + h * 64 + dd]); ybuf[si * 64 + dd] = hv / (1.f + expf(-o)); }
  }
  lds_barrier();
  for (int si = 0; si < DBG_NS; ++si) {
    const float v = tid < 64 ? ybuf[si * 64 + tid] : 0.f;
    const float ss = block_sum(v * v, red);
    float e2 = 0.f, r2 = 0.f;
    if (tid < 64) {
      const int t = dbg_sample_t(si);
      const float z = bf2f(projb[(size_t)t * NP + PD_Z + h * 64 + tid]);
      const float ref = v * rsqrtf(ss / 64.f + 1e-6f) * p.ml_norm_g[layer * 64 + tid] * (z / (1.f + expf(-z)));
      const float got = bf2f(((const u16*)(p.ws + OFF_H))[((size_t)b * SEQ + t) * 1024 + Y_D + h * 64 + tid]);
      e2 = (got - ref) * (got - ref); r2 = ref * ref;
    }
    c.num[id] += block_sum(e2, red); c.den[id] += block_sum(r2, red);
  }
}

DI void debug_checks(const Params& p, unsigned char* smem) {
  const int tid = otid();
  float* red = (float*)(smem + 36 * 1024);
  Chk c;
  for (int i = 0; i < NCHK; ++i) { c.num[i] = 0.f; c.den[i] = 0.f; }
  const float* adap = (const float*)(p.ws + OFF_ADAP);
  const u16* H = (const u16*)(p.ws + OFF_H);
  const u16* proj = (const u16*)(p.ws + OFF_PROJ);
  const float* sm = (const float*)(p.ws + OFF_SMALL);
#if DEBUG_CHECK == 1
  {
    const int bs[2] = {0, 5}; const int ns[4] = {3, 1024 + 77, 2048 + 500, 3071};
    for (int bi = 0; bi < 2; ++bi) for (int ni = 0; ni < 4; ++ni) {
      const int b = bs[bi], n = ns[ni];
      float a = 0.f;
      for (int k = tid; k < 1024; k += 256) { const float v = p.c[b * 1024 + k]; a += (v / (1.f + expf(-v))) * p.ada_w[(size_t)k * 3072 + n]; }
      const float ref = block_sum(a, red) + p.ada_b[n];
      float got = 0.f; for (int kc = 0; kc < 8; ++kc) got += adap[(((size_t)kc * 2 + 0) * 8 + b) * 3072 + n];
      chk_add(c, 1, got, ref);
    }
  }
  {
    const int ms[3] = {1, 9000, 32767};
    const int ns[14] = {0, 300, 700, 900, 1500, 2000, 2300, 2693, 3300, 3500, 3967, 3970, 3981, 3990};
    for (int mi = 0; mi < 3; ++mi) {
      const int m = ms[mi], b = m >> 12;
      float ss = 0.f;
      for (int k = tid; k < 1024; k += 256) { const float v = p.x[(size_t)m * 1024 + k]; ss += v * v; }
      ss = block_sum(ss, red);
      const float rstd = rsqrtf(ss / 1024.f + 1e-6f);
      for (int ni = 0; ni < 14; ++ni) {
        const int n = ns[ni], col = colmap(n);
        float a = 0.f, herr = 0.f, href = 0.f;
        for (int k = tid; k < 1024; k += 256) {
          float shf = 0.f, scl = 0.f;
          for (int kc = 0; kc < 8; ++kc) { const float* ap = adap + (((size_t)kc * 2 + 0) * 8 + b) * 3072; shf += ap[k]; scl += ap[1024 + k]; }
          const float hv = p.x[(size_t)m * 1024 + k] * rstd * p.norm_g[k] * (1.f + scl) + shf;
          const float hg = bf2f(H[(size_t)m * 1024 + k]);
          herr += (hg - hv) * (hg - hv); href += hv * hv;
          a += hv * p.w_in[(size_t)k * D_IN + col];
        }
        const float ref = block_sum(a, red);
        herr = block_sum(herr, red); href = block_sum(href, red);
        if (ni == 0 && DEBUG_STAGE == 1) { c.num[3] += herr; c.den[3] += href; }
        const float got = n < NP ? bf2f(proj[(size_t)m * NP + n]) : sm[(size_t)m * NSMALL + (n - NP)];
        chk_add(c, 2, got, ref);
      }
    }
  }
#endif
#if DEBUG_CHECK == 2
  dbg_diff_attn(p, 0, 0, 5, 0, c, 4, smem);
  dbg_diff_attn(p, 0, 1, 200, 3, c, 4, smem);
  dbg_diff_attn(p, 0, 3, 1500, 2, c, 4, smem);
  dbg_diff_attn(p, 0, 7, 4095, 1, c, 4, smem);
  {
    const int ms[3] = {2, 12345, 32766}; const int ns[3] = {0, 513, 1023};
    const u16* Y = (const u16*)(p.ws + OFF_H);
    for (int mi = 0; mi < 3; ++mi) for (int ni = 0; ni < 3; ++ni) {
      const int m = ms[mi], n = ns[ni], b = m >> 12;
      float a = 0.f;
      for (int k = tid; k < 1024; k += 256) a += bf2f(Y[(size_t)m * 1024 + k]) * p.w_out[(size_t)k * 1024 + n];
      a = block_sum(a, red);
      float gate = 0.f; for (int kc = 0; kc < 8; ++kc) gate += adap[(((size_t)kc * 2 + 0) * 8 + b) * 3072 + 2048 + n];
      chk_add(c, 5, p.out[(size_t)m * 1024 + n] - p.x[(size_t)m * 1024 + n], gate * a);
    }
  }
#endif
#if DEBUG_CHECK == 3
  dbg_ssd(p, 0, 0, 0, c, 6, smem);
  dbg_ssd(p, 0, 5, 1, c, 6, smem);
  dbg_mlstm(p, 0, 0, 0, c, 7, smem);
  dbg_mlstm(p, 0, 6, 3, c, 7, smem);
#endif
  lds_barrier();
  if (tid == 0) {
    int wid_ = 0, wcls = 99;
    for (int i = 1; i < NCHK; ++i) if (c.den[i] > 0.f) {
      const float rel = sqrtf(c.num[i] / c.den[i]);
      int cls = rel >= 1.f ? 0 : (int)floorf(-log10f(fmaxf(rel, 1e-9f)));
      if (cls > 9) cls = 9;
      if (!(rel == rel)) cls = 0;
      if (cls < wcls) { wcls = cls; wid_ = i; }
    }
    p.out[0] = 1e5f * ((float)wid_ + 0.1f * (float)wcls);
  }
}
#endif

#define XB_TMO      128
#define XB_XCNT(j)  (256  + 64 * (j))
#define XB_XSUB(j)  (1280 + 64 * (j))
#define XB_XGEN(j)  (2304 + 64 * (j))
#define XB_TOP      3328
#define XB_TOPGEN   3392
#define XCD_BAR_WORDS 3456
#define XB_SPIN_CAP (1u << 23)
DI unsigned xb_ld(unsigned* p)              { return __hip_atomic_load(p, __ATOMIC_RELAXED, __HIP_MEMORY_SCOPE_AGENT); }
DI unsigned xb_add(unsigned* p, unsigned v) { return __hip_atomic_fetch_add(p, v, __ATOMIC_RELAXED, __HIP_MEMORY_SCOPE_AGENT); }
DI unsigned xb_xcc_id() { return (unsigned)__builtin_amdgcn_s_getreg((3 << 11) | 20) & 0xFu; }
#define XB_SPIN(cond, bar) do { unsigned _sp = 0; while (cond) { __builtin_amdgcn_s_sleep(1); \
    if ((++_sp & 255u) == 0u) { if (xb_ld(&(bar)[XB_TMO])) break; if (_sp > XB_SPIN_CAP) { atomicAdd(&(bar)[XB_TMO], 1u); break; } } } } while (0)
struct XcdBarrier { unsigned* bar; unsigned x; volatile LDSP unsigned* st; };
DI XcdBarrier xcd_barrier_post(unsigned* bar, volatile LDSP unsigned* st) {
  XcdBarrier b; b.bar = bar; b.x = xb_xcc_id(); b.st = st;
  if (threadIdx.x == 0) (void)xb_add(&bar[XB_XCNT(b.x)], 1u);
  return b;
}
DI void xcd_barrier_complete(unsigned* bar, unsigned x, unsigned& nloc, unsigned& nx) {
  const unsigned G = gridDim.x * gridDim.y * gridDim.z;
  unsigned sum, cnt, mine, sp = 0u;
  for (;;) {
    sum = 0u; cnt = 0u; mine = 0u;
#pragma unroll
    for (unsigned j = 0; j < 16; ++j) { const unsigned c = xb_ld(&bar[XB_XCNT(j)]); sum += c; cnt += (c > 0u) ? 1u : 0u; mine = (j == x) ? c : mine; }
    if (sum == G) break;
    __builtin_amdgcn_s_sleep(1);
    if ((++sp & 255u) == 0u) { if (xb_ld(&bar[XB_TMO])) break; if (sp > XB_SPIN_CAP) { atomicAdd(&bar[XB_TMO], 1u); break; } }
  }
  nloc = mine > 0u ? mine : 1u; nx = cnt > 0u ? cnt : 1u;
}
DI void xcd_barrier(const XcdBarrier& b) {
  asm volatile("s_waitcnt vmcnt(0)" ::: "memory");
  __syncthreads();
  if (threadIdx.x == 0) {
    unsigned* bar = b.bar;
    __builtin_amdgcn_s_waitcnt(0);
    unsigned nloc = b.st[0], nx = b.st[1];
    if (nloc == 0u) { xcd_barrier_complete(bar, b.x, nloc, nx); b.st[0] = nloc; b.st[1] = nx; }
    const unsigned old = xb_add(&bar[XB_XSUB(b.x)], 1u);
    const unsigned gen = old / nloc;
    if (old + 1u == (gen + 1u) * nloc) {
      __builtin_amdgcn_fence(__ATOMIC_RELEASE, "agent");
      asm volatile("s_waitcnt vmcnt(0)" ::: "memory");
      const unsigned og = xb_add(&bar[XB_TOP], 1u);
      const unsigned tg = og / nx;
      if (og + 1u == (tg + 1u) * nx) xb_add(&bar[XB_TOPGEN], 1u);
      else XB_SPIN(xb_ld(&bar[XB_TOPGEN]) == tg, bar);
      __builtin_amdgcn_fence(__ATOMIC_ACQUIRE, "agent");
      xb_add(&bar[XB_XGEN(b.x)], 1u);
      asm volatile("s_waitcnt vmcnt(0)" ::: "memory");
    } else {
      XB_SPIN(xb_ld(&bar[XB_XGEN(b.x)]) == gen, bar);
      __builtin_amdgcn_fence(__ATOMIC_ACQUIRE, "agent");
      asm volatile("s_waitcnt vmcnt(0)" ::: "memory");
    }
  }
  __syncthreads();
}

constexpr int HALF_LDS = 76 * 1024;
constexpr int SMEM_BYTES = 2 * HALF_LDS;
__global__ void __launch_bounds__(512, 2) fwd_megakernel(Params p) {
  cg::grid_group grid = cg::this_grid();
  __shared__ __attribute__((aligned(16))) unsigned char smem[SMEM_BYTES];
  const int half = __builtin_amdgcn_readfirstlane(threadIdx.x >> 8);
  unsigned char* hsm = smem + half * HALF_LDS;
  const int G = gridDim.x, bid = blockIdx.x;
  const int slot = bid * 2 + half, NS = 2 * G;
  volatile LDSP unsigned* xst = (volatile LDSP unsigned*)(LDSP unsigned char*)(smem + SMEM_BYTES - 32);
  if (threadIdx.x == 0) { xst[0] = 0u; xst[1] = 0u; }
  __syncthreads();
  const XcdBarrier xb = xcd_barrier_post((unsigned*)(p.ws + OFF_BAR), xst);
  {
    constexpr int ADA0 = T0_WIN + T0_WOUT + T0_W1 + T0_W2;
    unsigned* cnt = (unsigned*)(p.ws + OFF_CNT);
    for (int i = slot; i < ((T0_TOTAL + NS - 1) / NS) * NS; i += NS) {
      const int ii = i < T0_TOTAL ? i : T0_TOTAL - 1;
      const int t = ii < 96 ? ADA0 + ii : (ii - 96 < ADA0 ? ii - 96 : ii);
      phase0_task(p, t, hsm);
      if (i < 96) {
        asm volatile("s_waitcnt vmcnt(0)" ::: "memory");
        lds_barrier();
        if (otid512() == 0) {
          __builtin_amdgcn_fence(__ATOMIC_RELEASE, "agent");
          asm volatile("s_waitcnt vmcnt(0)" ::: "memory");
          __hip_atomic_fetch_add(cnt + 8, 2u, __ATOMIC_RELAXED, __HIP_MEMORY_SCOPE_AGENT);
        }
      }
    }
    if (otid512() == 0) {
      unsigned sp = 0;
      while (__hip_atomic_load(cnt + 8, __ATOMIC_RELAXED, __HIP_MEMORY_SCOPE_AGENT) < 96u) { __builtin_amdgcn_s_sleep(8); if (++sp > (1u << 22)) break; }
      __builtin_amdgcn_fence(__ATOMIC_ACQUIRE, "agent");
      asm volatile("s_waitcnt vmcnt(0)" ::: "memory");
    }
    lds_barrier();
    for (int t = slot; t < ((NTOK / 64 + NS - 1) / NS) * NS; t += NS) phase1_task(p, 0, p.x, t < NTOK / 64 ? t : NTOK / 64 - 1, hsm);
  }
  grid.sync();
  for (int layer = 0; layer < 2; ++layer) {
    Params q = p;
    { size_t zoff = 0; asm volatile("" : "+s"(zoff)); q.ws = p.ws + zoff; }
    const float* xin = layer == 0 ? q.x : q.out;
    if (layer != 0) {
      for (int t = slot; t < ((NTOK / 64 + NS - 1) / NS) * NS; t += NS) phase1_task(q, layer, xin, t < NTOK / 64 ? t : NTOK / 64 - 1, hsm);
      xcd_barrier(xb);
    }
    for (int t = bid; t < (NTOK / 256) * (NPAD / 256); t += G) gemm_inproj_tile(q, layer, t, smem);
    xcd_barrier(xb);
#if DEBUG_CHECK == 1
    if (bid == 0 && half == 0) debug_checks(q, smem);
    return;
#endif
    {
      unsigned* cnt = (unsigned*)(q.ws + OFF_CNT);
      unsigned* qcnt = cnt + 32 + layer * 8; unsigned* cdone = cnt + 64 + layer * 8; unsigned* sdone = cnt + 96 + layer * 8;
      int* s_pair = (int*)(smem + SMEM_BYTES - 16);
      if (bid < 32) ssd_task8(q, layer, bid >> 2, bid & 3, smem);
      else if (bid < 64) mlstm_task8(q, layer, (bid - 32) >> 2, (bid - 32) & 3, smem);
      if (bid < 64) {
        asm volatile("s_waitcnt vmcnt(0)" ::: "memory");
        lds_barrier();
        if (otid512() == 0) {
          __builtin_amdgcn_fence(__ATOMIC_RELEASE, "agent");
          asm volatile("s_waitcnt vmcnt(0)" ::: "memory");
          __hip_atomic_fetch_add(sdone + ((bid & 31) >> 2), 1u, __ATOMIC_RELAXED, __HIP_MEMORY_SCOPE_AGENT);
        }
      }
      constexpr int NP_C = 8, NP_D = 64, NP_N = 64, NP_F = 32, NP_ALL = NP_C + NP_D + NP_N + NP_F;
      for (int kq = 0; kq < 8; ++kq) {
        const int bq = (int)((xb.x + (unsigned)kq) & 7u);
        for (;;) {
          const int t512 = otid512();
          lds_barrier();
          if (t512 == 0) *s_pair = (int)atomicAdd(qcnt + bq, 1u);
          lds_barrier();
          const int pair = *s_pair;
          if (pair >= NP_ALL) break;
          if (pair < NP_C) {
            const int v = pair * 2 + half;
            compress_task(q, layer, bq, v >> 3, v & 7, hsm);
            asm volatile("s_waitcnt vmcnt(0)" ::: "memory");
            lds_barrier();
            if (t512 == 0) {
              __builtin_amdgcn_fence(__ATOMIC_RELEASE, "agent");
              asm volatile("s_waitcnt vmcnt(0)" ::: "memory");
              __hip_atomic_fetch_add(cdone + bq, 1u, __ATOMIC_RELAXED, __HIP_MEMORY_SCOPE_AGENT);
            }
          } else if (pair < NP_C + NP_D) {
            const int d = pair - NP_C;
            diff_attn_task(q, layer, bq, 2 * (d & 1) + half, 31 - (d >> 1), hsm, half != 0);
          } else if (pair < NP_C + NP_D + NP_N) {
            if (t512 == 0) {
              while (__hip_atomic_load(cdone + bq, __ATOMIC_RELAXED, __HIP_MEMORY_SCOPE_AGENT) < (unsigned)NP_C) __builtin_amdgcn_s_sleep(16);
              __builtin_amdgcn_fence(__ATOMIC_ACQUIRE, "agent");
              asm volatile("s_waitcnt vmcnt(0)" ::: "memory");
            }
            lds_barrier();
            nsa_task(q, layer, bq, 2 * (63 - (pair - NP_C - NP_D)) + half, hsm);
          } else {
            if (t512 == 0) {
              while (__hip_atomic_load(sdone + bq, __ATOMIC_RELAXED, __HIP_MEMORY_SCOPE_AGENT) < 8u) __builtin_amdgcn_s_sleep(16);
              __builtin_amdgcn_fence(__ATOMIC_ACQUIRE, "agent");
              asm volatile("s_waitcnt vmcnt(0)" ::: "memory");
            }
            lds_barrier();
            seq_fix_rows(q, layer, bq * SEQ + ((pair - NP_C - NP_D - NP_N) * 2 + half) * 64, 64);
          }
        }
      }
    }
    xcd_barrier(xb);
    if (layer == 0) { for (int t = bid; t < (NTOK / 256) * 4; t += G) gemm_outproj_tile<0>(q, xin, q.out, t, smem); }
    else { for (int t = bid; t < (NTOK / 256) * 4; t += G) gemm_outproj_tile<1>(q, xin, q.out, t, smem); }
    xcd_barrier(xb);
#if DEBUG_CHECK >= 2
    if (bid == 0 && half == 0) debug_checks(q, smem);
    return;
#endif
  }
  { const int t5 = otid512(); final_norm_rows(p, bid * 8 + (t5 >> 6), G * 8, t5 & 63); }
}

extern "C" void kernel_launch(void* const* d_in, const int* in_sizes, int n_in, void* d_out, int out_size, void* d_ws, size_t ws_size,
                              hipStream_t stream) {
  static int grid_blocks = 0;
  if (!grid_blocks) {
    int dev = 0, cus = 0, per_cu = 0;
    (void)hipGetDevice(&dev);
    (void)hipDeviceGetAttribute(&cus, hipDeviceAttributeMultiprocessorCount, dev);
    (void)hipOccupancyMaxActiveBlocksPerMultiprocessor(&per_cu, fwd_megakernel, 512, 0);
    if (per_cu > 1) per_cu = 1;
    if (per_cu < 1) per_cu = 1;
    grid_blocks = cus * per_cu;
  }
  if (grid_blocks < 64 || (grid_blocks & 3)) { fprintf(stderr, "grid too small: %d\n", grid_blocks); return; }
  if (ws_size < WS_NEEDED) { fprintf(stderr, "workspace too small: %zu < %zu\n", ws_size, WS_NEEDED); return; }
  Params p{};
  const float** pp = (const float**)&p;
  for (int i = 0; i < 26; ++i) pp[i] = (const float*)d_in[i];
  p.out = (float*)d_out; p.ws = (unsigned char*)d_ws;
  (void)hipMemsetAsync((unsigned char*)d_ws + OFF_CNT, 0, 64 * 1024 + XCD_BAR_WORDS * 4, stream);
  void* args[] = {&p};
  hipError_t e = hipLaunchCooperativeKernel((void*)fwd_megakernel, dim3(grid_blocks), dim3(512), args, 0, stream);
  if (e != hipSuccess) fprintf(stderr, "cooperative launch failed: %s (grid %d)\n", hipGetErrorString(e), grid_blocks);
}
```

```cpp
#include <hip/hip_runtime.h>
#include <hip/hip_cooperative_groups.h>
#include <cstdio>
#include <cstdint>
namespace cg = cooperative_groups;

typedef unsigned short u16;
typedef short bf16x8 __attribute__((ext_vector_type(8)));
typedef short s16x4 __attribute__((ext_vector_type(4)));
typedef float f32x4 __attribute__((ext_vector_type(4)));
typedef float f32x2 __attribute__((ext_vector_type(2)));
typedef unsigned u32x4 __attribute__((ext_vector_type(4)));
typedef unsigned u32x2 __attribute__((ext_vector_type(2)));
typedef __bf16 bf16x2_t __attribute__((ext_vector_type(2)));
#define DI __device__ __forceinline__
#define LDSP __attribute__((address_space(3)))

constexpr int D_MODEL = 1024, BATCH = 8, SEQ = 4096, NTOK = BATCH * SEQ;
constexpr int D_IN = 3992;
constexpr int NP = 3968, NPAD = 4096, NSMALL = 32;
constexpr int PA_Q = 0, PA_KC = 256, PA_VC = 320, PA_KS = 384, PA_VS = 448, PA_KW = 512, PA_VW = 576, PA_Z = 640;
constexpr int PB_Q = 896, PB_K = 1152, PB_V = 1408, PB_Z = 1664;
constexpr int PC_Z = 1920, PC_XBC = 2176;
constexpr int PD_QK = 2688, PD_V = 3200, PD_O = 3456, PD_Z = 3712;
constexpr int SM_G = 0, SM_DT = 12, SM_IF = 16;
constexpr int Y_A = 0, Y_B = 256, Y_C = 512, Y_D = 768;

constexpr size_t MiB = 1024 * 1024;
constexpr size_t OFF_WINT = 0;
constexpr size_t OFF_WOUTT = 16 * MiB;
constexpr size_t OFF_W1T = 20 * MiB;
constexpr size_t OFF_W2T = 22 * MiB;
constexpr size_t OFF_BIAS1 = 22 * MiB + 64 * 1024;
constexpr size_t OFF_ADAP = 22 * MiB + 128 * 1024;
constexpr size_t OFF_KCMP = 24 * MiB;
constexpr size_t OFF_VCMP = 24 * MiB + 256 * 1024;
constexpr size_t OFF_BAR = 29 * MiB + 64 * 1024;
constexpr size_t OFF_CNT = 29 * MiB;
constexpr size_t OFF_SMALL = 25 * MiB;
constexpr size_t OFF_SSQ = 29 * MiB;
constexpr size_t OFF_H = 32 * MiB;
constexpr size_t OFF_PROJ = 96 * MiB;
constexpr size_t OFF_X1B = 352 * MiB;
constexpr size_t WS_NEEDED = OFF_X1B + (size_t)NTOK * 1024 * 2;

struct Params {
  const float* x; const float* c; const float* norm_g; const float* ada_w; const float* ada_b;
  const float* w_in; const float* w_out;
  const float* nsa_cmp_pos; const float* nsa_ck_w1; const float* nsa_ck_w2; const float* nsa_cv_w1; const float* nsa_cv_w2; const float* nsa_norm_g;
  const float* diff_lam; const float* diff_norm_g;
  const float* ssm_conv_w; const float* ssm_conv_b; const float* ssm_dt_bias; const float* ssm_a_log; const float* ssm_d; const float* ssm_norm_g;
  const float* ml_conv_w; const float* ml_conv_b; const float* ml_if_b; const float* ml_norm_g; const float* final_g;
  float* out; unsigned char* ws;
};

DI void lds_barrier() { asm volatile("s_waitcnt lgkmcnt(0)" ::: "memory"); __builtin_amdgcn_s_barrier(); asm volatile("" ::: "memory"); }
DI int otid() { int t = threadIdx.x & 255; asm volatile("" : "+v"(t)); return t; }
DI int otid512() { int t = threadIdx.x; asm volatile("" : "+v"(t)); return t; }
DI unsigned pack2(float a, float b) { f32x2 v = {a, b}; bf16x2_t r = __builtin_convertvector(v, bf16x2_t); return __builtin_bit_cast(unsigned, r); }
DI u16 f2bf(float a) { return (u16)(pack2(a, 0.f) & 0xffffu); }
DI float bf2f(u16 h) { return __uint_as_float(((unsigned)h) << 16); }
DI float bflo(unsigned u) { return __uint_as_float(u << 16); }
DI float bfhi(unsigned u) { return __uint_as_float(u & 0xffff0000u); }
DI f32x4 mfma16(bf16x8 a, bf16x8 b, f32x4 c) { return __builtin_amdgcn_mfma_f32_16x16x32_bf16(a, b, c, 0, 0, 0); }
DI float wave_sum(float v) {
#pragma unroll
  for (int o = 32; o > 0; o >>= 1) v += __shfl_xor(v, o);
  return v;
}
DI float siluf(float v) { return v * __builtin_amdgcn_rcpf(1.f + __expf(-v)); }
DI float sigmoidf_(float v) { return __builtin_amdgcn_rcpf(1.f + __expf(-v)); }
DI float exp2_(float v) { return __builtin_amdgcn_exp2f(v); }
DI float sgprf(float v) { return __int_as_float(__builtin_amdgcn_readfirstlane(__float_as_int(v))); }
DI s16x4 tr_read(const u16* p) { return __builtin_amdgcn_ds_read_tr16_b64_v4i16((LDSP s16x4*)p); }
DI bf16x8 cat4(s16x4 a, s16x4 b) { bf16x8 r; r[0] = a[0]; r[1] = a[1]; r[2] = a[2]; r[3] = a[3]; r[4] = b[0]; r[5] = b[1]; r[6] = b[2]; r[7] = b[3]; return r; }
DI bf16x8 ldfrag(const u16* p) { return *(const bf16x8*)p; }

DI int colmap(int n) {
  if (n < 640) return n;
  if (n < 896) return 652 + (n - 640);
  if (n < 1920) return 908 + (n - 896);
  if (n < 2688) return 1932 + (n - 1920);
  if (n < 3456) return 2704 + (n - 2688);
  if (n < 3968) return 3480 + (n - 3456);
  if (n < 3980) return 640 + (n - 3968);
  if (n < 3984) return 2700 + (n - 3980);
  if (n < 3992) return 3472 + (n - 3984);
  return -1;
}

DI void tconv_tile(const float* __restrict__ src, int ldsrc, int k0, int n0, u16* __restrict__ dst, int ldd, bool use_map, unsigned char* smem) {
  float* tile = (float*)smem;
  const int tid = otid();
  lds_barrier();
  {
    const int nn = tid & 63; int col = n0 + nn; if (use_map) col = colmap(col);
#pragma unroll
    for (int i = 0; i < 16; ++i) { const int kk = i * 4 + (tid >> 6); tile[kk * 65 + nn] = col >= 0 ? src[(size_t)(k0 + kk) * ldsrc + col] : 0.f; }
  }
  lds_barrier();
#pragma unroll
  for (int i = 0; i < 2; ++i) {
    const int item = tid + 256 * i, nn = item >> 3, kc = item & 7;
    u32x4 w;
    w.x = pack2(tile[(kc * 8 + 0) * 65 + nn], tile[(kc * 8 + 1) * 65 + nn]);
    w.y = pack2(tile[(kc * 8 + 2) * 65 + nn], tile[(kc * 8 + 3) * 65 + nn]);
    w.z = pack2(tile[(kc * 8 + 4) * 65 + nn], tile[(kc * 8 + 5) * 65 + nn]);
    w.w = pack2(tile[(kc * 8 + 6) * 65 + nn], tile[(kc * 8 + 7) * 65 + nn]);
    *(u32x4*)(dst + (size_t)(n0 + nn) * ldd + k0 + kc * 8) = w;
  }
}

constexpr int T0_WIN = 2 * 16 * 64, T0_WOUT = 2 * 16 * 16, T0_W1 = 4 * 32 * 2, T0_W2 = 4 * 2, T0_ADA = 2 * 12 * 8, T0_B1 = 64;
constexpr int T0_TOTAL = T0_WIN + T0_WOUT + T0_W1 + T0_W2 + T0_ADA + T0_B1;

DI void phase0_task(const Params& p, int t, unsigned char* smem) {
  const int tid = otid();
  if (t < T0_WIN) {
    const int l = t / 1024, r = t % 1024, kt = r / 64, nt = r % 64;
    tconv_tile(p.w_in + (size_t)l * D_MODEL * D_IN, D_IN, kt * 64, nt * 64, (u16*)(p.ws + OFF_WINT) + (size_t)l * NPAD * 1024, 1024, true, smem);
    return;
  }
  t -= T0_WIN;
  if (t < T0_WOUT) {
    const int l = t / 256, r = t % 256, kt = r / 16, nt = r % 16;
    tconv_tile(p.w_out + (size_t)l * 1024 * 1024, 1024, kt * 64, nt * 64, (u16*)(p.ws + OFF_WOUTT) + (size_t)l * 1024 * 1024, 1024, false, smem);
    return;
  }
  t -= T0_WOUT;
  if (t < T0_W1) {
    const int m = t / 64, r = t % 64, kt = r / 2, nt = r % 2, l = m >> 1, kv = m & 1;
    const float* src = (kv ? p.nsa_cv_w1 : p.nsa_ck_w1) + (size_t)l * 2048 * 128;
    tconv_tile(src, 128, kt * 64, nt * 64, (u16*)(p.ws + OFF_W1T) + (size_t)m * 128 * 2048, 2048, false, smem);
    return;
  }
  t -= T0_W1;
  if (t < T0_W2) {
    const int m = t / 2, kt = t % 2, l = m >> 1, kv = m & 1;
    const float* src = (kv ? p.nsa_cv_w2 : p.nsa_ck_w2) + (size_t)l * 128 * 64;
    tconv_tile(src, 64, kt * 64, 0, (u16*)(p.ws + OFF_W2T) + (size_t)m * 64 * 128, 128, false, smem);
    return;
  }
  t -= T0_W2;
  if (t < T0_ADA) {
    const int l = t / 96, r = t % 96, nc = r / 8, kc = r % 8;
    float* cact = (float*)smem;
    lds_barrier();
    for (int i = tid; i < 1024; i += 256) { const int b = i >> 7, kk = i & 127; const float v = p.c[b * 1024 + kc * 128 + kk]; cact[i] = siluf(v); }
    lds_barrier();
    const int n = nc * 256 + tid;
    float acc[8];
#pragma unroll
    for (int b = 0; b < 8; ++b) acc[b] = 0.f;
    const float* w = p.ada_w + ((size_t)l * 1024 + kc * 128) * 3072 + n;
#pragma unroll 16
    for (int kk = 0; kk < 128; ++kk) {
      const float wv = w[(size_t)kk * 3072];
#pragma unroll
      for (int b = 0; b < 8; ++b) acc[b] += cact[b * 128 + kk] * wv;
    }
    float* adap = (float*)(p.ws + OFF_ADAP);
    const float bias = kc == 0 ? p.ada_b[l * 3072 + n] : 0.f;
#pragma unroll
    for (int b = 0; b < 8; ++b) adap[(((size_t)kc * 2 + l) * 8 + b) * 3072 + n] = acc[b] + bias;
    return;
  }
  t -= T0_ADA;
  {
    const int m = t >> 4, kc = t & 15, l = m >> 1, kv = m & 1;
    const float* w1 = (kv ? p.nsa_cv_w1 : p.nsa_ck_w1) + (size_t)l * 2048 * 128;
    const float* pos = p.nsa_cmp_pos + (size_t)l * 2048;
    const int n = tid & 127, half = tid >> 7;
    float acc = 0.f;
    const int k0 = kc * 128 + half * 64;
#pragma unroll 16
    for (int k = 0; k < 64; ++k) acc += pos[k0 + k] * w1[(size_t)(k0 + k) * 128 + n];
    float* red = (float*)smem;
    lds_barrier();
    red[tid] = acc;
    lds_barrier();
    if (tid < 128) ((float*)(p.ws + OFF_BIAS1))[(m * 16 + kc) * 128 + tid] = red[tid] + red[tid + 128];
  }
}

DI void phase1_task(const Params& p, int layer, const float* xin, int grp, unsigned char* smem) {
  const int tid = otid(), lane = tid & 63, wid = tid >> 6;
  const int b = grp >> 6;
  float* mul = (float*)smem;
  float* sh = mul + 1024;
  const float* adap = (const float*)(p.ws + OFF_ADAP);
  lds_barrier();
  for (int c = tid; c < 1024; c += 256) {
    float s0 = 0.f, s1 = 0.f;
#pragma unroll
    for (int kc = 0; kc < 8; ++kc) { const float* a = adap + (((size_t)kc * 2 + layer) * 8 + b) * 3072; s0 += a[c]; s1 += a[1024 + c]; }
    mul[c] = p.norm_g[layer * 1024 + c] * (1.f + s1); sh[c] = s0;
  }
  lds_barrier();
  u16* H = (u16*)(p.ws + OFF_H);
#pragma unroll 1
  for (int it = 0; it < 4; ++it) {
    float4 v[4][4]; float ss[4];
#pragma unroll
    for (int j = 0; j < 4; ++j) {
      const int row = grp * 64 + wid * 16 + it * 4 + j;
      if (layer == 0) {
        const float4* xr = (const float4*)(xin + (size_t)row * D_MODEL);
#pragma unroll
        for (int i = 0; i < 4; ++i) v[j][i] = xr[lane + 64 * i];
      } else {
        const u32x2* xr = (const u32x2*)((const u16*)(p.ws + OFF_X1B) + (size_t)row * D_MODEL);
#pragma unroll
        for (int i = 0; i < 4; ++i) { const u32x2 w = xr[lane + 64 * i]; v[j][i] = make_float4(bflo(w.x), bfhi(w.x), bflo(w.y), bfhi(w.y)); }
      }
    }
#pragma unroll
    for (int j = 0; j < 4; ++j) {
      float a = 0.f;
#pragma unroll
      for (int i = 0; i < 4; ++i) a += v[j][i].x * v[j][i].x + v[j][i].y * v[j][i].y + v[j][i].z * v[j][i].z + v[j][i].w * v[j][i].w;
      ss[j] = wave_sum(a);
    }
#pragma unroll
    for (int j = 0; j < 4; ++j) {
      const int row = grp * 64 + wid * 16 + it * 4 + j;
      const float r = rsqrtf(ss[j] * (1.f / D_MODEL) + 1e-6f);
#pragma unroll
      for (int i = 0; i < 4; ++i) {
        const int c = (lane + 64 * i) * 4;
        u32x2 w;
        w.x = pack2(v[j][i].x * r * mul[c] + sh[c], v[j][i].y * r * mul[c + 1] + sh[c + 1]);
        w.y = pack2(v[j][i].z * r * mul[c + 2] + sh[c + 2], v[j][i].w * r * mul[c + 3] + sh[c + 3]);
        *(u32x2*)(H + (size_t)row * 1024 + c) = w;
      }
    }
  }
}

namespace g8 {
constexpr int BM = 256, BK = 64, HALF = 128, HT = HALF * BK;
constexpr int LDS_BYTES = 8 * HT * 2;
DI int lds_byte(int r, int c) { const int st = (r >> 4) * 2 + (c >> 5), rr = r & 15, cc = c & 31, ob = rr * 64 + cc * 2; return st * 1024 + (ob ^ (((ob >> 9) & 1) << 5)); }
DI void stage_rc(int b, int& R, int& C) { const int st = b / 1024, sb = b % 1024, swz = sb ^ (((sb >> 9) & 1) << 5); R = (st >> 1) * 16 + swz / 64; C = (st & 1) * 32 + (swz % 64) / 2; }

DI void kloop(const u16* __restrict__ A, const u16* __restrict__ Bt, int K, int brow, int bcol, unsigned char* smem, f32x4 (&acc)[2][2][4][2]) {
  u16* shm = (u16*)smem;
  const int tid = otid512();
#define SA(b, h) (shm + ((b) * 2 + (h)) * HT)
#define SB(b, h) (shm + (4 + (b) * 2 + (h)) * HT)
#define STAGE(P, BASE, br, kt) do { const u16* _gb = BASE + ((long)(br) * K + (long)(kt) * BK); \
      __builtin_amdgcn_global_load_lds((const unsigned*)(_gb + soff0), (LDSP unsigned*)((LDSP char*)(P) + tid * 16), 16, 0, 0); \
      __builtin_amdgcn_global_load_lds((const unsigned*)(_gb + soff1), (LDSP unsigned*)((LDSP char*)(P) + tid * 16 + 8192), 16, 0, 0); } while (0)
#define LDA(dst, b, h) _Pragma("unroll") for (int m = 0; m < 4; ++m) _Pragma("unroll") for (int k = 0; k < 2; ++k) \
    dst[m][k] = *reinterpret_cast<const bf16x8*>((const char*)SA(b, h) + lds_byte(wr * 64 + m * 16 + fr, k * 32 + fq * 8))
#define LDB(dst, b, h) _Pragma("unroll") for (int n = 0; n < 2; ++n) _Pragma("unroll") for (int k = 0; k < 2; ++k) \
    dst[n][k] = *reinterpret_cast<const bf16x8*>((const char*)SB(b, h) + lds_byte(wc * 32 + n * 16 + fr, k * 32 + fq * 8))
#define MMA(ai, bj, At_, Bt_) do { __builtin_amdgcn_s_setprio(1); \
    _Pragma("unroll") for (int m = 0; m < 4; ++m) _Pragma("unroll") for (int n = 0; n < 2; ++n) _Pragma("unroll") for (int k = 0; k < 2; ++k) \
      acc[ai][bj][m][n] = __builtin_amdgcn_mfma_f32_16x16x32_bf16(Bt_[n][k], At_[m][k], acc[ai][bj][m][n], 0, 0, 0); \
    __builtin_amdgcn_s_setprio(0); } while (0)
#define WAIT_V(n) asm volatile("s_waitcnt vmcnt(" #n ")" ::: "memory")
#define WAIT_L(n) asm volatile("s_waitcnt lgkmcnt(" #n ")" ::: "memory")
#define BAR __builtin_amdgcn_s_barrier()
#define SCHED __builtin_amdgcn_sched_barrier(0)
  const int wid = __builtin_amdgcn_readfirstlane(tid >> 6), lane = tid & 63, wr = wid >> 2, wc = wid & 3, fr = lane & 15, fq = lane >> 4;
#pragma unroll
  for (int a = 0; a < 2; ++a)
#pragma unroll
    for (int b = 0; b < 2; ++b)
#pragma unroll
      for (int m = 0; m < 4; ++m) { acc[a][b][m][0] = (f32x4){0.f, 0.f, 0.f, 0.f}; acc[a][b][m][1] = (f32x4){0.f, 0.f, 0.f, 0.f}; }
  bf16x8 At[4][2], B0[2][2], B1[2][2];
  const int nt = K / BK;
  int soff0, soff1;
  { int r_, c_; stage_rc(tid * 16, r_, c_); soff0 = r_ * K + c_; stage_rc(tid * 16 + 8192, r_, c_); soff1 = r_ * K + c_; }
  STAGE(SB(0, 0), Bt, bcol, 0); STAGE(SA(0, 0), A, brow, 0);
  STAGE(SB(0, 1), Bt, bcol + HALF, 0); STAGE(SA(0, 1), A, brow + HALF, 0);
  if (wr == 1) BAR;
  WAIT_V(4); BAR;
  STAGE(SB(1, 0), Bt, bcol, 1); STAGE(SA(1, 0), A, brow, 1); STAGE(SB(1, 1), Bt, bcol + HALF, 1);
  WAIT_V(6); BAR;
#pragma unroll 1
  for (int t = 0; t < nt - 2; t += 2) {
    asm volatile("" : "+v"(soff0), "+v"(soff1));
    LDB(B0, 0, 0); SCHED; LDA(At, 0, 0); STAGE(SA(1, 1), A, brow + HALF, t + 1);
    WAIT_L(8); BAR; WAIT_L(0); MMA(0, 0, At, B0); BAR; SCHED;
    LDB(B1, 0, 1); STAGE(SB(0, 0), Bt, bcol, t + 2);
    BAR; WAIT_L(0); MMA(0, 1, At, B1); BAR;
    LDA(At, 0, 1); STAGE(SA(0, 0), A, brow, t + 2);
    BAR; WAIT_L(0); MMA(1, 0, At, B0); BAR; SCHED;
    STAGE(SB(0, 1), Bt, bcol + HALF, t + 2);
    WAIT_V(6); BAR; MMA(1, 1, At, B1); BAR;
    LDB(B0, 1, 0); SCHED; LDA(At, 1, 0); STAGE(SA(0, 1), A, brow + HALF, t + 2);
    WAIT_L(8); BAR; WAIT_L(0); MMA(0, 0, At, B0); BAR; SCHED;
    LDB(B1, 1, 1); STAGE(SB(1, 0), Bt, bcol, t + 3);
    BAR; WAIT_L(0); MMA(0, 1, At, B1); BAR;
    LDA(At, 1, 1); STAGE(SA(1, 0), A, brow, t + 3);
    BAR; WAIT_L(0); MMA(1, 0, At, B0); BAR; SCHED;
    STAGE(SB(1, 1), Bt, bcol + HALF, t + 3);
    WAIT_V(6); BAR; MMA(1, 1, At, B1); BAR;
  }
  { LDB(B0, 0, 0); LDA(At, 0, 0); STAGE(SA(1, 1), A, brow + HALF, nt - 1);
    BAR; WAIT_L(0); MMA(0, 0, At, B0); BAR;
    LDB(B1, 0, 1); BAR; WAIT_L(0); MMA(0, 1, At, B1); BAR;
    LDA(At, 0, 1); WAIT_V(4); BAR; WAIT_L(0); MMA(1, 0, At, B0); MMA(1, 1, At, B1); BAR; }
  { LDB(B0, 1, 0); LDA(At, 1, 0); WAIT_V(2); BAR; WAIT_L(0); MMA(0, 0, At, B0); BAR;
    LDB(B1, 1, 1); WAIT_V(0); BAR; WAIT_L(0); MMA(0, 1, At, B1); BAR;
    LDA(At, 1, 1); BAR; WAIT_L(0); MMA(1, 0, At, B0); MMA(1, 1, At, B1); BAR; }
  if (wr == 0) BAR;
#undef SA
#undef SB
#undef STAGE
#undef LDA
#undef LDB
#undef MMA
#undef WAIT_V
#undef WAIT_L
#undef BAR
#undef SCHED
}
DI void tile_map(int wgid, int nM, int nN, int& pm, int& pn) {
  const int nwg = nM * nN, NXCD = 8, WGM = 8;
  { const int q = nwg / NXCD, r = nwg % NXCD, xcd = wgid % NXCD, off = wgid / NXCD; wgid = (xcd < r ? xcd * (q + 1) : r * (q + 1) + (xcd - r) * q) + off; }
  const int nig = WGM * nN, gid = wgid / nig, fm = gid * WGM, gsz = (nM - fm) < WGM ? (nM - fm) : WGM;
  pm = fm + ((wgid % nig) % gsz); pn = (wgid % nig) / gsz;
}
}

DI void gemm_inproj_tile(const Params& p, int layer, int tile, unsigned char* smem) {
  int pm, pn; g8::tile_map(tile, NTOK / 256, NPAD / 256, pm, pn);
  const int brow = pm * 256, bcol = pn * 256;
  f32x4 acc[2][2][4][2];
  g8::kloop((const u16*)(p.ws + OFF_H), (const u16*)(p.ws + OFF_WINT) + (size_t)layer * NPAD * 1024, 1024, brow, bcol, smem, acc);
  const int tid = otid512(), wid = __builtin_amdgcn_readfirstlane(tid >> 6), lane = tid & 63, wr = wid >> 2, wc = wid & 3, fr = lane & 15, fq = lane >> 4;
  u16* proj = (u16*)(p.ws + OFF_PROJ);
  if (pn == 15 && wc == 0) {
    float* sm = (float*)(p.ws + OFF_SMALL);
#pragma unroll
    for (int ai = 0; ai < 2; ++ai)
#pragma unroll
      for (int m = 0; m < 4; ++m)
#pragma unroll
        for (int n = 0; n < 2; ++n) {
          const int mr = brow + ai * 128 + wr * 64 + m * 16 + fr;
          *(f32x4*)(sm + (size_t)mr * NSMALL + n * 16 + 4 * fq) = acc[ai][1][m][n];
        }
  }
  constexpr int CLD = 264;
  u16* Cs = (u16*)smem;
#pragma unroll
  for (int ai = 0; ai < 2; ++ai) {
    lds_barrier();
#pragma unroll
    for (int bj = 0; bj < 2; ++bj)
#pragma unroll
      for (int m = 0; m < 4; ++m)
#pragma unroll
        for (int n = 0; n < 2; ++n) {
          const f32x4 v = acc[ai][bj][m][n];
          u32x2 w; w.x = pack2(v[0], v[1]); w.y = pack2(v[2], v[3]);
          *(u32x2*)(Cs + (wr * 64 + m * 16 + fr) * CLD + bj * 128 + wc * 32 + n * 16 + 4 * fq) = w;
        }
    lds_barrier();
#pragma unroll
    for (int i = 0; i < 8; ++i) {
      const int id = tid + 512 * i, row = id >> 5, ch = id & 31;
      if (bcol + ch * 8 < NP) *(u32x4*)(proj + (size_t)(brow + ai * 128 + row) * NP + bcol + ch * 8) = *(const u32x4*)(Cs + row * CLD + ch * 8);
    }
  }
  lds_barrier();
}

template <int layer>
DI void gemm_outproj_tile(const Params& p, const float* xin, float* xout, int tile, unsigned char* smem) {
  int pm, pn; g8::tile_map(tile, NTOK / 256, 4, pm, pn);
  const int brow = pm * 256, bcol = pn * 256;
  f32x4 acc[2][2][4][2];
  g8::kloop((const u16*)(p.ws + OFF_H), (const u16*)(p.ws + OFF_WOUTT) + (size_t)layer * 1024 * 1024, 1024, brow, bcol, smem, acc);
  const int tid = otid512(), wid = __builtin_amdgcn_readfirstlane(tid >> 6), lane = tid & 63, wr = wid >> 2, wc = wid & 3, fr = lane & 15, fq = lane >> 4;
  const int b = brow >> 12;
  const float* adap = (const float*)(p.ws + OFF_ADAP);
  constexpr int CLD = 132;
  float* Cs = (float*)smem;
#pragma unroll
  for (int ai = 0; ai < 2; ++ai)
#pragma unroll
    for (int bj = 0; bj < 2; ++bj) {
      lds_barrier();
#pragma unroll
      for (int m = 0; m < 4; ++m)
#pragma unroll
        for (int n = 0; n < 2; ++n) *(f32x4*)(Cs + (wr * 64 + m * 16 + fr) * CLD + wc * 32 + n * 16 + 4 * fq) = acc[ai][bj][m][n];
      lds_barrier();
      const int ch = tid & 31, nc = bcol + bj * 128 + ch * 4;
      f32x4 gt = {0.f, 0.f, 0.f, 0.f};
#pragma unroll
      for (int kc = 0; kc < 8; ++kc) gt += *(const f32x4*)(adap + (((size_t)kc * 2 + layer) * 8 + b) * 3072 + 2048 + nc);
      u16* x1b = (u16*)(p.ws + OFF_X1B);
      f32x4 xv[8];
#pragma unroll
      for (int i = 0; i < 8; ++i) {
        const size_t off = (size_t)(brow + ai * 128 + (tid >> 5) + 16 * i) * 1024 + nc;
        if (layer == 0) xv[i] = *(const f32x4*)(xin + off);
        else { const u32x2 w = *(const u32x2*)(x1b + off); xv[i] = (f32x4){bflo(w.x), bfhi(w.x), bflo(w.y), bfhi(w.y)}; }
      }
#pragma unroll
      for (int i = 0; i < 8; ++i) {
        const int row = (tid >> 5) + 16 * i;
        const size_t off = (size_t)(brow + ai * 128 + row) * 1024 + nc;
        const f32x4 v = xv[i] + gt * *(const f32x4*)(Cs + row * CLD + ch * 4);
        if (layer == 0) { u32x2 w; w.x = pack2(v[0], v[1]); w.y = pack2(v[2], v[3]); *(u32x2*)(x1b + off) = w; }
        else *(f32x4*)(xout + off) = v;
      }
    }
  lds_barrier();
}

constexpr int KLD = 72;
struct KVRegs { u32x4 k[2], v[2]; };
DI void kv_load(const u16* kbase, const u16* vbase, int ldk, int ldv, int key0, KVRegs& r) {
  const int tid = otid();
#pragma unroll
  for (int i = 0; i < 2; ++i) {
    const int id = tid + 256 * i, row = id >> 3, ch = id & 7;
    r.k[i] = *(const u32x4*)(kbase + (size_t)(key0 + row) * ldk + ch * 8);
    r.v[i] = *(const u32x4*)(vbase + (size_t)(key0 + row) * ldv + ch * 8);
  }
}
DI void kv_store(u16* Ks, u16* Vs, const KVRegs& r) {
  const int tid = otid();
#pragma unroll
  for (int i = 0; i < 2; ++i) {
    const int id = tid + 256 * i, row = id >> 3, ch = id & 7;
    *(u32x4*)(Ks + row * KLD + ch * 8) = r.k[i];
    *(u32x4*)(Vs + row * KLD + ch * 8) = r.v[i];
  }
}
constexpr int KVBUF = 2 * 64 * KLD;
template <class UseF, class LoadF, class CompF>
DI void kv_pipeline(int j0, int j1, u16* buf, UseF use, LoadF load, CompF comp) {
  KVRegs kr;
  if (use(j0)) load(j0, kr);
  lds_barrier();
  if (use(j0)) kv_store(buf, buf + 64 * KLD, kr);
  if (j0 + 1 < j1 && use(j0 + 1)) load(j0 + 1, kr);
  lds_barrier();
  for (int j = j0; j < j1; ++j) {
    u16* cur = buf + ((j - j0) & 1) * KVBUF; u16* nxt = buf + (((j - j0) & 1) ^ 1) * KVBUF;
    if (j + 1 < j1 && use(j + 1)) kv_store(nxt, nxt + 64 * KLD, kr);
    if (j + 2 < j1 && use(j + 2)) load(j + 2, kr);
    if (use(j)) comp(j, cur, cur + 64 * KLD);
    lds_barrier();
  }
}
struct AttnAcc { f32x4 o[4][2]; float m[2], l[2]; f32x4 os[2]; int fresh; };
DI void attn_init(AttnAcc& a) {
#pragma unroll
  for (int d = 0; d < 4; ++d) { a.o[d][0] = (f32x4){0.f, 0.f, 0.f, 0.f}; a.o[d][1] = (f32x4){0.f, 0.f, 0.f, 0.f}; }
  a.m[0] = a.m[1] = -1e30f; a.l[0] = a.l[1] = 0.f;
}
template <int NKS>
DI void qk_tile(const u16* Ks, int dofs, const bf16x8 (&qf)[2][NKS], f32x4 (&s)[4][2], int l15, int g) {
#pragma unroll
  for (int kt = 0; kt < 4; ++kt) {
    s[kt][0] = (f32x4){0.f, 0.f, 0.f, 0.f}; s[kt][1] = (f32x4){0.f, 0.f, 0.f, 0.f};
#pragma unroll
    for (int ks = 0; ks < NKS; ++ks) {
      const bf16x8 a = ldfrag(Ks + (kt * 16 + l15) * KLD + dofs + ks * 32 + 8 * g);
      s[kt][0] = mfma16(a, qf[0][ks], s[kt][0]);
      s[kt][1] = mfma16(a, qf[1][ks], s[kt][1]);
    }
  }
}
DI void pv_accum(const bf16x8 (&pf)[2][2], const u16* Vs, f32x4 (&o)[4][2], int l15, int g) {
  const int tq = l15 >> 2, tp = l15 & 3;
#pragma unroll
  for (int kk = 0; kk < 2; ++kk)
#pragma unroll
    for (int d = 0; d < 4; ++d) {
      const bf16x8 vf = cat4(tr_read(Vs + (kk * 32 + 4 * g + tq) * KLD + d * 16 + 4 * tp), tr_read(Vs + (kk * 32 + 16 + 4 * g + tq) * KLD + d * 16 + 4 * tp));
      o[d][0] = mfma16(vf, pf[0][kk], o[d][0]);
      o[d][1] = mfma16(vf, pf[1][kk], o[d][1]);
    }
}
DI void pack_p(const f32x4 (&s)[4][2], bf16x8 (&pf)[2][2]) {
#pragma unroll
  for (int qt = 0; qt < 2; ++qt)
#pragma unroll
    for (int kk = 0; kk < 2; ++kk) {
      u32x4 w;
      w.x = pack2(s[2 * kk][qt][0], s[2 * kk][qt][1]); w.y = pack2(s[2 * kk][qt][2], s[2 * kk][qt][3]);
      w.z = pack2(s[2 * kk + 1][qt][0], s[2 * kk + 1][qt][1]); w.w = pack2(s[2 * kk + 1][qt][2], s[2 * kk + 1][qt][3]);
      pf[qt][kk] = __builtin_bit_cast(bf16x8, w);
    }
}
constexpr float DEFER_THR = 5.f;
template <class VF>
DI void softmax_pv(f32x4 (&s)[4][2], AttnAcc& a, const u16* Vs, float sc, int l15, int g, VF valid) {
  bf16x8 pf[2][2];
  float mxl[2];
#pragma unroll
  for (int qt = 0; qt < 2; ++qt) {
    float mx = -1e30f;
#pragma unroll
    for (int kt = 0; kt < 4; ++kt)
#pragma unroll
      for (int r = 0; r < 4; ++r) { const float v = valid(kt, r, qt) ? s[kt][qt][r] * sc : -1e30f; s[kt][qt][r] = v; mx = fmaxf(mx, v); }
    mxl[qt] = mx;
  }
  if (__any((mxl[0] > a.m[0] + DEFER_THR) || (mxl[1] > a.m[1] + DEFER_THR))) {
#pragma unroll
    for (int qt = 0; qt < 2; ++qt) {
      float mx = mxl[qt];
      mx = fmaxf(mx, __shfl_xor(mx, 16)); mx = fmaxf(mx, __shfl_xor(mx, 32));
      const float mn = fmaxf(a.m[qt], mx), alpha = exp2_(a.m[qt] - mn);
      a.m[qt] = mn; a.l[qt] *= alpha;
#pragma unroll
      for (int d = 0; d < 4; ++d) a.o[d][qt] *= alpha;
    }
  }
#pragma unroll
  for (int qt = 0; qt < 2; ++qt) {
    const float mn = a.m[qt];
    float ls = 0.f;
#pragma unroll
    for (int kt = 0; kt < 4; ++kt)
#pragma unroll
      for (int r = 0; r < 4; ++r) { const float v = s[kt][qt][r]; const float pv = v > -1e29f ? exp2_(v - mn) : 0.f; s[kt][qt][r] = pv; ls += pv; }
    a.l[qt] += ls;
  }
  pack_p(s, pf);
  pv_accum(pf, Vs, a.o, l15, g);
}
DI float group_sum4_(float v) { v += __shfl_xor(v, 16); v += __shfl_xor(v, 32); return v; }
DI bf16x8 scale_frag(bf16x8 f, float sc) {
  u32x4 w = __builtin_bit_cast(u32x4, f);
  w.x = pack2(bflo(w.x) * sc, bfhi(w.x) * sc); w.y = pack2(bflo(w.y) * sc, bfhi(w.y) * sc);
  w.z = pack2(bflo(w.z) * sc, bfhi(w.z) * sc); w.w = pack2(bflo(w.w) * sc, bfhi(w.w) * sc);
  return __builtin_bit_cast(bf16x8, w);
}
DI void attn_init_rel(AttnAcc& a) { attn_init(a); a.m[0] = a.m[1] = 0.f; a.os[0] = (f32x4){0.f, 0.f, 0.f, 0.f}; a.os[1] = (f32x4){0.f, 0.f, 0.f, 0.f}; a.fresh = 1; }
DI void rowsum_accum(const bf16x8 (&pf)[2][2], AttnAcc& a, int l15) {
  const short one = l15 == 0 ? (short)0x3F80 : (short)0;
  const bf16x8 ones = {one, one, one, one, one, one, one, one};
#pragma unroll
  for (int kk = 0; kk < 2; ++kk) { a.os[0] = mfma16(ones, pf[0][kk], a.os[0]); a.os[1] = mfma16(ones, pf[1][kk], a.os[1]); }
}
DI float rel_rowsum(const AttnAcc& a, int qt, int l15) { return __shfl(a.os[qt][0], l15); }
template <int NKS>
DI void qk_tile_rel(const u16* Ks, int dofs, const bf16x8 (&qf)[2][NKS], const AttnAcc& a, f32x4 (&s)[4][2], int l15, int g, bool ok0 = true, bool ok1 = true) {
  const float n0 = ok0 ? -a.m[0] : -1e30f, n1 = ok1 ? -a.m[1] : -1e30f;
#pragma unroll
  for (int kt = 0; kt < 4; ++kt) {
    s[kt][0] = (f32x4){n0, n0, n0, n0}; s[kt][1] = (f32x4){n1, n1, n1, n1};
#pragma unroll
    for (int ks = 0; ks < NKS; ++ks) {
      const bf16x8 k = ldfrag(Ks + (kt * 16 + l15) * KLD + dofs + ks * 32 + 8 * g);
      s[kt][0] = mfma16(k, qf[0][ks], s[kt][0]);
      s[kt][1] = mfma16(k, qf[1][ks], s[kt][1]);
    }
  }
}
template <int MODE, class VF>
DI void softmax_rel(f32x4 (&s)[4][2], AttnAcc& a, bf16x8 (&pf)[2][2], int l15_, VF valid, bool ok0 = true, bool ok1 = true) {
  float mxl[2];
#pragma unroll
  for (int qt = 0; qt < 2; ++qt) {
    float mx = -1e30f;
    const bool okq = qt == 0 ? ok0 : ok1;
#pragma unroll
    for (int kt = 0; kt < 4; ++kt)
#pragma unroll
      for (int r = 0; r < 4; ++r) {
        if (MODE == 1) s[kt][qt][r] = valid(kt, r, qt) ? s[kt][qt][r] : -1e30f;
        if (MODE == 2) s[kt][qt][r] = okq ? s[kt][qt][r] : -1e30f;
        mx = fmaxf(mx, s[kt][qt][r]);
      }
    mxl[qt] = mx;
  }
  if (a.fresh || __any(mxl[0] > DEFER_THR || mxl[1] > DEFER_THR)) {
    bool still = false;
#pragma unroll
    for (int qt = 0; qt < 2; ++qt) {
      float mx = mxl[qt];
      mx = fmaxf(mx, __shfl_xor(mx, 16)); mx = fmaxf(mx, __shfl_xor(mx, 32));
      const bool fresh = rel_rowsum(a, qt, l15_) == 0.f;
      const float dl = mx < -1e29f ? 0.f : (fresh ? mx : fmaxf(mx, 0.f)), alpha = exp2_(-dl);
      still = still || (fresh && mx < -1e29f);
      a.m[qt] += dl; a.os[qt] *= alpha;
#pragma unroll
      for (int d = 0; d < 4; ++d) a.o[d][qt] *= alpha;
#pragma unroll
      for (int kt = 0; kt < 4; ++kt)
#pragma unroll
        for (int r = 0; r < 4; ++r) s[kt][qt][r] -= dl;
    }
    a.fresh = __any(still) ? 1 : 0;
  }
#pragma unroll
  for (int qt = 0; qt < 2; ++qt)
#pragma unroll
    for (int kt = 0; kt < 4; ++kt)
#pragma unroll
      for (int r = 0; r < 4; ++r) s[kt][qt][r] = exp2_(s[kt][qt][r]);
  pack_p(s, pf);
}
DI float group_sum4(float v) { v += __shfl_xor(v, 16); v += __shfl_xor(v, 32); return v; }

constexpr int DSTAGE = 2 * 128 * 64;
DI int fKs(int row) { return (row >> 1) & 7; }
DI int fVs(int row) { return ((row >> 1) & 3) << 1; }
DI void kv_dma128(const u16* kbase, const u16* vbase, int ld, int key0, u16* stage, int tid) {
#pragma unroll
  for (int i = 0; i < 4; ++i) {
    const int id = tid + 256 * i, row = id >> 3, c8 = id & 7;
    __builtin_amdgcn_global_load_lds((const unsigned*)(kbase + (size_t)(key0 + row) * ld + ((c8 ^ fKs(row)) * 8)), (LDSP unsigned*)((LDSP char*)stage + id * 16), 16, 0, 0);
  }
#pragma unroll
  for (int i = 0; i < 4; ++i) {
    const int id = tid + 256 * i, row = id >> 3, c8 = id & 7;
    __builtin_amdgcn_global_load_lds((const unsigned*)(vbase + (size_t)(key0 + row) * ld + ((c8 ^ fVs(row)) * 8)), (LDSP unsigned*)((LDSP char*)(stage + 128 * 64) + id * 16), 16, 0, 0);
  }
}
template <int NKS>
DI void qk_tile_rel_sw(const u16* Kh, int dofs, const bf16x8 (&qf)[2][NKS], const AttnAcc& a, f32x4 (&s)[4][2], int l15, int g) {
  const float n0 = -a.m[0], n1 = -a.m[1];
  const int sw = (l15 >> 1) & 7;
#pragma unroll
  for (int kt = 0; kt < 4; ++kt) {
    s[kt][0] = (f32x4){n0, n0, n0, n0}; s[kt][1] = (f32x4){n1, n1, n1, n1};
#pragma unroll
    for (int ks = 0; ks < NKS; ++ks) {
      const bf16x8 k = ldfrag(Kh + (kt * 16 + l15) * 64 + ((((dofs >> 3) + ks * 4 + g) ^ sw) * 8));
      s[kt][0] = mfma16(k, qf[0][ks], s[kt][0]);
      s[kt][1] = mfma16(k, qf[1][ks], s[kt][1]);
    }
  }
}
DI void pv_accum_sw(const bf16x8 (&pf)[2][2], const u16* Vh, f32x4 (&o)[4][2], int l15, int g) {
  const int tq = l15 >> 2, tp = l15 & 3;
#pragma unroll
  for (int kk = 0; kk < 2; ++kk) {
    const int r0 = kk * 32 + 4 * g + tq, r1 = r0 + 16;
    const int f0 = fVs(r0), f1 = fVs(r1);
#pragma unroll
    for (int d = 0; d < 4; ++d) {
      const int lc = d * 2 + (tp >> 1);
      const bf16x8 vf = cat4(tr_read(Vh + r0 * 64 + ((lc ^ f0) * 8) + (tp & 1) * 4), tr_read(Vh + r1 * 64 + ((lc ^ f1) * 8) + (tp & 1) * 4));
      o[d][0] = mfma16(vf, pf[0][kk], o[d][0]);
      o[d][1] = mfma16(vf, pf[1][kk], o[d][1]);
    }
  }
}
DI void diff_attn_task(const Params& p, int layer, int b, int h, int qb, unsigned char* smem) {
  u16* Ks = (u16*)smem; u16* Vs = Ks + 64 * KLD;
  const int tid = otid(), lane = tid & 63, wid = tid >> 6, l15 = lane & 15, g = lane >> 4;
  const u16* proj = (const u16*)(p.ws + OFF_PROJ) + (size_t)b * SEQ * NP;
  const int q0w = qb * 128 + wid * 32;
  const float* lam = p.diff_lam + layer * 128;
  float s01 = 0.f, s23 = 0.f;
  for (int i = 0; i < 32; ++i) { s01 += lam[i] * lam[32 + i]; s23 += lam[64 + i] * lam[96 + i]; }
  const float lam_init = layer == 0 ? 0.2f : 0.35550906759096324f;
  const float lam_full = sgprf(__expf(s01) - __expf(s23) + lam_init);
  const float sc = 0.17677669529663687f * 1.4426950408889634f;
  const int ntile = 2 * qb + 2;
  const u16* vbase = proj + PB_V + h * 64;
  f32x4 res[4][2];
#pragma unroll 1
  for (int c = 0; c < 2; ++c) {
    const u16* kbase = proj + PB_K + h * 64;
    bf16x8 qf[2][1];
#pragma unroll
    for (int qt = 0; qt < 2; ++qt) qf[qt][0] = scale_frag(ldfrag(proj + (size_t)(q0w + qt * 16 + l15) * NP + PB_Q + h * 64 + c * 32 + 8 * g), sc);
    AttnAcc a; attn_init_rel(a);
    const int nst = qb + 1;
    asm volatile("s_waitcnt vmcnt(0)" ::: "memory");
    lds_barrier();
    kv_dma128(kbase, vbase, NP, 0, Ks, tid);
    asm volatile("s_waitcnt vmcnt(0)" ::: "memory");
    lds_barrier();
    for (int js = 0; js < nst; ++js) {
      const u16* st = Ks + (js & 1) * DSTAGE;
      if (js + 1 < nst) kv_dma128(kbase, vbase, NP, (js + 1) * 128, Ks + ((js + 1) & 1) * DSTAGE, tid);
#pragma unroll 1
      for (int hf = 0; hf < 2; ++hf) {
        const int key0 = js * 128 + hf * 64;
        if (key0 <= q0w + 31) {
          f32x4 s[4][2]; bf16x8 pf[2][2];
          auto valid = [&](int kt, int r, int qt) { return key0 + kt * 16 + 4 * g + r <= q0w + qt * 16 + l15; };
          qk_tile_rel_sw<1>(st + hf * 64 * 64, c * 32, qf, a, s, l15, g);
          if (key0 + 63 <= q0w) softmax_rel<0>(s, a, pf, l15, valid); else softmax_rel<1>(s, a, pf, l15, valid);
          pv_accum_sw(pf, st + 128 * 64 + hf * 64 * 64, a.o, l15, g);
          rowsum_accum(pf, a, l15);
        }
      }
      asm volatile("s_waitcnt vmcnt(0)" ::: "memory");
      lds_barrier();
    }
#pragma unroll
    for (int qt = 0; qt < 2; ++qt) {
      const float lt = rel_rowsum(a, qt, l15);
      const float inv = c == 0 ? 1.f / lt : -lam_full / lt;
#pragma unroll
      for (int d = 0; d < 4; ++d) res[d][qt] = c == 0 ? a.o[d][qt] * inv : res[d][qt] + a.o[d][qt] * inv;
    }
  }
  u16* Y = (u16*)(p.ws + OFF_H);
  const float* ng = p.diff_norm_g + layer * 64;
#pragma unroll
  for (int qt = 0; qt < 2; ++qt) {
    float ss = 0.f;
#pragma unroll
    for (int d = 0; d < 4; ++d) { const f32x4 v = res[d][qt]; ss += v[0] * v[0] + v[1] * v[1] + v[2] * v[2] + v[3] * v[3]; }
    ss = group_sum4(ss);
    const float rn = rsqrtf(ss * (1.f / 64.f) + 1e-6f) * (1.f - lam_init);
    const int t = q0w + qt * 16 + l15;
    const size_t row = (size_t)b * SEQ + t;
#pragma unroll
    for (int d = 0; d < 4; ++d) {
      const int dd = d * 16 + 4 * g;
      const f32x4 v = res[d][qt];
      const u32x2 zz = *(const u32x2*)(proj + (size_t)t * NP + PB_Z + h * 64 + dd);
      const f32x4 gg = *(const f32x4*)(ng + dd);
      u32x2 w;
      w.x = pack2(v[0] * rn * gg[0] * siluf(bflo(zz.x)), v[1] * rn * gg[1] * siluf(bfhi(zz.x)));
      w.y = pack2(v[2] * rn * gg[2] * siluf(bflo(zz.y)), v[3] * rn * gg[3] * siluf(bfhi(zz.y)));
      *(u32x2*)(Y + row * 1024 + Y_B + h * 64 + dd) = w;
    }
  }
}

template <int NKS>
DI void qk_tile1(const u16* Ks, const bf16x8 (&qf)[NKS], f32x4 (&s)[4], int l15, int g) {
#pragma unroll
  for (int kt = 0; kt < 4; ++kt) {
    s[kt] = (f32x4){0.f, 0.f, 0.f, 0.f};
#pragma unroll
    for (int ks = 0; ks < NKS; ++ks) s[kt] = mfma16(ldfrag(Ks + (kt * 16 + l15) * KLD + ks * 32 + 8 * g), qf[ks], s[kt]);
  }
}
DI void pv_accum1(const f32x4 (&s)[4], const u16* Vs, f32x4 (&o)[4], int l15, int g) {
  const int tq = l15 >> 2, tp = l15 & 3;
#pragma unroll
  for (int kk = 0; kk < 2; ++kk) {
    u32x4 w;
    w.x = pack2(s[2 * kk][0], s[2 * kk][1]); w.y = pack2(s[2 * kk][2], s[2 * kk][3]);
    w.z = pack2(s[2 * kk + 1][0], s[2 * kk + 1][1]); w.w = pack2(s[2 * kk + 1][2], s[2 * kk + 1][3]);
    const bf16x8 pf = __builtin_bit_cast(bf16x8, w);
#pragma unroll
    for (int d = 0; d < 4; ++d) {
      const bf16x8 vf = cat4(tr_read(Vs + (kk * 32 + 4 * g + tq) * KLD + d * 16 + 4 * tp), tr_read(Vs + (kk * 32 + 16 + 4 * g + tq) * KLD + d * 16 + 4 * tp));
      o[d] = mfma16(vf, pf, o[d]);
    }
  }
}

constexpr int SEQ_LDS_A = 0, SEQ_LDS_B = 128 * KLD * 2, SEQ_LDS_C = 2 * 128 * KLD * 2, SEQ_LDS_S = 3 * 128 * KLD * 2, SEQ_LDS_F = SEQ_LDS_S + 64 * KLD * 2;
constexpr int SEQ_LDS_HALO = SEQ_LDS_F + 4096;
constexpr int SEQ_LDS_CW = SEQ_LDS_HALO + 2 * 3 * 3 * 64 * 2;
DI float wave_scan_add(float x, int lane) {
#pragma unroll
  for (int o = 1; o < 64; o <<= 1) { const float y = __shfl_up(x, o); if (lane >= o) x += y; }
  return x;
}
DI float wave_scan_max(float x, int lane) {
#pragma unroll
  for (int o = 1; o < 64; o <<= 1) { const float y = __shfl_up(x, o); if (lane >= o) x = fmaxf(x, y); }
  return x;
}

DI void seq_fix_rows(const Params& p, int layer, int r0, int nrows) {
  u16* Y = (u16*)(p.ws + OFF_H);
  const u16* proj = (const u16*)(p.ws + OFF_PROJ);
  const int tid = otid(), lane = tid & 63, wv = tid >> 6;
  const bool ml = lane >= 32;
  const int ch = (lane & 31) * 8;
  const float* ng = ml ? p.ml_norm_g + layer * 64 + (ch & 63) : p.ssm_norm_g + layer * 256 + ch;
  const f32x4 g0 = *(const f32x4*)ng, g1 = *(const f32x4*)(ng + 4);
  for (int rb = wv * 4; rb < nrows; rb += 16) {
    u32x4 yv4[4], zv4[4], ov4[4];
#pragma unroll
    for (int j = 0; j < 4; ++j) {
      const size_t row = (size_t)(r0 + rb + j);
      yv4[j] = *(const u32x4*)(Y + row * 1024 + (ml ? Y_D : Y_C) + ch);
      zv4[j] = *(const u32x4*)(proj + row * NP + (ml ? PD_Z : PC_Z) + ch);
      ov4[j] = ml ? *(const u32x4*)(proj + row * NP + PD_O + ch) : (u32x4){0u, 0u, 0u, 0u};
    }
#pragma unroll
    for (int j = 0; j < 4; ++j) {
      const size_t row = (size_t)(r0 + rb + j);
      u16* yp = Y + row * 1024 + (ml ? Y_D : Y_C) + ch;
      const u32x4 yv = yv4[j], zv = zv4[j], ov = ov4[j];
      float v[8] = {bflo(yv.x), bfhi(yv.x), bflo(yv.y), bfhi(yv.y), bflo(yv.z), bfhi(yv.z), bflo(yv.w), bfhi(yv.w)};
      float z[8] = {bflo(zv.x), bfhi(zv.x), bflo(zv.y), bfhi(zv.y), bflo(zv.z), bfhi(zv.z), bflo(zv.w), bfhi(zv.w)};
      float ss = 0.f;
      if (ml) {
        const float o[8] = {bflo(ov.x), bfhi(ov.x), bflo(ov.y), bfhi(ov.y), bflo(ov.z), bfhi(ov.z), bflo(ov.w), bfhi(ov.w)};
#pragma unroll
        for (int i = 0; i < 8; ++i) { v[i] *= sigmoidf_(o[i]); ss += v[i] * v[i]; }
      } else {
#pragma unroll
        for (int i = 0; i < 8; ++i) { v[i] *= siluf(z[i]); ss += v[i] * v[i]; }
      }
      ss += __shfl_xor(ss, 1); ss += __shfl_xor(ss, 2); ss += __shfl_xor(ss, 4);
      const float ss16 = ss + __shfl_xor(ss, 8);
      const float rn = ml ? rsqrtf(ss * (1.f / 64.f) + 1e-6f) : rsqrtf(ss16 * (1.f / 128.f) + 1e-6f);
      float o8[8];
#pragma unroll
      for (int i = 0; i < 8; ++i) { const float gg = i < 4 ? g0[i & 3] : g1[i & 3]; o8[i] = v[i] * rn * gg * (ml ? siluf(z[i]) : 1.f); }
      u32x4 w; w.x = pack2(o8[0], o8[1]); w.y = pack2(o8[2], o8[3]); w.z = pack2(o8[4], o8[5]); w.w = pack2(o8[6], o8[7]);
      *(u32x4*)yp = w;
    }
  }
}


constexpr int SEQ8_LDS_F = SEQ_LDS_S + 64 * KLD * 2;
constexpr int SEQ8_LDS_HALO = SEQ8_LDS_F + 8192;
constexpr int SEQ8_LDS_CW = SEQ8_LDS_HALO + 2 * 3 * 3 * 64 * 2;
DI void stage_conv_w8(float* wl, const float* cw, const float* cb, int chan0, int nchan, int tid) {
  if (tid < 320) { const int j = tid >> 6, cc = tid & 63; wl[tid] = j < 4 ? cw[j * nchan + chan0 + cc] : cb[chan0 + cc]; }
}
DI void scale_rows8(u16* A, const float* rs, int tid) {
  const int ch = (tid & 7) * 8;
#pragma unroll
  for (int i = 0; i < 2; ++i) {
    const int row = (tid >> 3) + 64 * i;
    const float f = rs[row];
    u32x4 v = *(u32x4*)(A + row * KLD + ch);
    v.x = pack2(bflo(v.x) * f, bfhi(v.x) * f); v.y = pack2(bflo(v.y) * f, bfhi(v.y) * f);
    v.z = pack2(bflo(v.z) * f, bfhi(v.z) * f); v.w = pack2(bflo(v.w) * f, bfhi(v.w) * f);
    *(u32x4*)(A + row * KLD + ch) = v;
  }
}
DI void state_update8(const u16* Xs, const u16* Bs, f32x4 (&acc)[2], int w8, int l15, int g) {
  const int tq = l15 >> 2, tp = l15 & 3, pt = w8 >> 1, nt0 = (w8 & 1) * 2;
#pragma unroll
  for (int kk = 0; kk < 4; ++kk) {
    const bf16x8 af = cat4(tr_read(Xs + (kk * 32 + 4 * g + tq) * KLD + pt * 16 + 4 * tp), tr_read(Xs + (kk * 32 + 16 + 4 * g + tq) * KLD + pt * 16 + 4 * tp));
#pragma unroll
    for (int n = 0; n < 2; ++n) {
      const bf16x8 bfr = cat4(tr_read(Bs + (kk * 32 + 4 * g + tq) * KLD + (nt0 + n) * 16 + 4 * tp), tr_read(Bs + (kk * 32 + 16 + 4 * g + tq) * KLD + (nt0 + n) * 16 + 4 * tp));
      acc[n] = mfma16(af, bfr, acc[n]);
    }
  }
}
DI void state_to_lds8(u16* Ss, const f32x4 (&acc)[2], int w8, int l15, int g) {
  const int pt = w8 >> 1, nt0 = (w8 & 1) * 2;
#pragma unroll
  for (int n = 0; n < 2; ++n)
#pragma unroll
    for (int r = 0; r < 4; ++r) Ss[(pt * 16 + 4 * g + r) * KLD + (nt0 + n) * 16 + l15] = f2bf(acc[n][r]);
}

constexpr int SEQ8_LDS_ZERO = SEQ8_LDS_CW + 3 * 320 * 4;
constexpr int SEQ8_LDS_RAW = ((SEQ8_LDS_ZERO + 3 * 128 + 255) / 256) * 256;
DI void raw_dma8(const u16* projb, int col0, int t0, u16* raw, int tid) {
#pragma unroll
  for (int i = 0; i < 2; ++i) {
    const int chunk = tid + 512 * i;
    __builtin_amdgcn_global_load_lds((const unsigned*)(projb + (size_t)(t0 + (chunk >> 3)) * NP + col0 + (chunk & 7) * 8), (LDSP unsigned*)((LDSP char*)raw + chunk * 16), 16, 0, 0);
  }
}
DI void conv_raw8(const u16* raw, const u16* halo, const float* wl, const float* rowscale, float cscale, u16* dst, int tid) {
  const int q = tid >> 3, ch = (tid & 7) * 8;
  u32x4 v[5];
#pragma unroll
  for (int k = 0; k < 5; ++k) { const int r = 2 * q - 3 + k; v[k] = r >= 0 ? *(const u32x4*)(raw + r * 64 + ch) : *(const u32x4*)(halo + (r + 3) * 64 + ch); }
  float w[5][8];
#pragma unroll
  for (int j = 0; j < 5; ++j) { const f32x4 w0 = *(const f32x4*)(wl + j * 64 + ch), w1 = *(const f32x4*)(wl + j * 64 + ch + 4);
    w[j][0] = w0[0]; w[j][1] = w0[1]; w[j][2] = w0[2]; w[j][3] = w0[3]; w[j][4] = w1[0]; w[j][5] = w1[1]; w[j][6] = w1[2]; w[j][7] = w1[3]; }
#pragma unroll
  for (int o = 0; o < 2; ++o) {
    float acc[8];
#pragma unroll
    for (int i = 0; i < 8; ++i) acc[i] = w[4][i];
#pragma unroll
    for (int j = 0; j < 4; ++j) {
      const u32x4 x = v[o + j];
      acc[0] += w[j][0] * bflo(x.x); acc[1] += w[j][1] * bfhi(x.x); acc[2] += w[j][2] * bflo(x.y); acc[3] += w[j][3] * bfhi(x.y);
      acc[4] += w[j][4] * bflo(x.z); acc[5] += w[j][5] * bfhi(x.z); acc[6] += w[j][6] * bflo(x.w); acc[7] += w[j][7] * bfhi(x.w);
    }
    const float rs = (rowscale ? rowscale[2 * q + o] : 1.f) * cscale;
#pragma unroll
    for (int i = 0; i < 8; ++i) acc[i] = siluf(acc[i]) * rs;
    u32x4 ov; ov.x = pack2(acc[0], acc[1]); ov.y = pack2(acc[2], acc[3]); ov.z = pack2(acc[4], acc[5]); ov.w = pack2(acc[6], acc[7]);
    *(u32x4*)(dst + (2 * q + o) * KLD + ch) = ov;
  }
}
DI void save_halo8(const u16* raw, u16* halo, int tid) {
  if (tid < 72) { const int arr = tid / 24, rem = tid % 24; *(u32x4*)(halo + arr * 192 + rem * 8) = *(const u32x4*)(raw + arr * 8192 + 125 * 64 + rem * 8); }
}

DI void ssd_task8(const Params& p, int layer, int b, int h, unsigned char* smem) {
  u16* Cs = (u16*)(smem + SEQ_LDS_A); u16* Bs = (u16*)(smem + SEQ_LDS_B); u16* Xs = (u16*)(smem + SEQ_LDS_C); u16* Ss = (u16*)(smem + SEQ_LDS_S);
  float* fl = (float*)(smem + SEQ8_LDS_F);
  float* dts = fl; float* acs = fl + 128; float* wend = fl + 256; float* tmp = fl + 384;
  u16* halo = (u16*)(smem + SEQ8_LDS_HALO); float* cwl = (float*)(smem + SEQ8_LDS_CW); u16* zero3 = (u16*)(smem + SEQ8_LDS_ZERO);
  u16* raw = (u16*)(smem + SEQ8_LDS_RAW);
  int tid = otid512(), lane = tid & 63, w = tid >> 6, l15 = lane & 15, g = lane >> 4;
  const int gi = h >> 1;
  const u16* projb = (const u16*)(p.ws + OFF_PROJ) + (size_t)b * SEQ * NP;
  const float* smb = (const float*)(p.ws + OFF_SMALL) + (size_t)b * SEQ * NSMALL;
  const float* cw = p.ssm_conv_w + layer * 4 * 512; const float* cb = p.ssm_conv_b + layer * 512;
  u16* Y = (u16*)(p.ws + OFF_H);
  const float a_h = sgprf(-__expf(p.ssm_a_log[layer * 4 + h])), d_h = sgprf(p.ssm_d[layer * 4 + h]), dtb = sgprf(p.ssm_dt_bias[layer * 4 + h]);
  const int colB = PC_XBC + 256 + gi * 64, colC = PC_XBC + 384 + gi * 64, colX = PC_XBC + h * 64;
  f32x4 st[2] = {(f32x4){0.f, 0.f, 0.f, 0.f}, (f32x4){0.f, 0.f, 0.f, 0.f}};
  lds_barrier();
  stage_conv_w8(cwl, cw, cb, 256 + gi * 64, 512, tid);
  stage_conv_w8(cwl + 320, cw, cb, 384 + gi * 64, 512, tid);
  stage_conv_w8(cwl + 640, cw, cb, h * 64, 512, tid);
  if (tid < 96) ((unsigned*)zero3)[tid] = 0u;
  raw_dma8(projb, colB, 0, raw, tid); raw_dma8(projb, colC, 0, raw + 8192, tid); raw_dma8(projb, colX, 0, raw + 16384, tid);
  float dtraw = 0.f;
  if (tid < 128) dtraw = smb[(size_t)tid * NSMALL + SM_DT + h];
#pragma unroll 1
  for (int c = 0; c < 32; ++c) {
    const int t0 = c * 128;
    asm volatile("" : "+v"(tid)); lane = tid & 63; w = tid >> 6; l15 = lane & 15; g = lane >> 4;
    float dtv = 0.f;
    if (tid < 128) { const float xr = dtraw + dtb; dtv = xr > 15.f ? xr : __logf(1.f + __expf(xr)); }
    float cs = wave_scan_add(dtv * a_h, lane);
    if (tid == 63) tmp[0] = cs;
    asm volatile("s_waitcnt vmcnt(0)" ::: "memory");
    lds_barrier();
    if (w == 1) cs += tmp[0];
    if (tid < 128) { dts[tid] = dtv; acs[tid] = cs; }
    if (c + 1 < 32 && tid < 128) dtraw = smb[(size_t)(t0 + 128 + tid) * NSMALL + SM_DT + h];
    lds_barrier();
    {
      const u16* hc = halo + (c & 1) * 576;
      const u16* hB = c == 0 ? zero3 : hc; const u16* hC = c == 0 ? zero3 : hc + 192; const u16* hX = c == 0 ? zero3 : hc + 384;
      conv_raw8(raw, hB, cwl, nullptr, 1.f, Bs, tid);
      conv_raw8(raw + 8192, hC, cwl + 320, nullptr, 1.f, Cs, tid);
      conv_raw8(raw + 16384, hX, cwl + 640, dts, 1.f, Xs, tid);
      save_halo8(raw, halo + ((c + 1) & 1) * 576, tid);
    }
    if (tid < 128) wend[tid] = __expf(acs[127] - acs[tid]);
    state_to_lds8(Ss, st, w, l15, g);
    lds_barrier();
    if (c + 1 < 32) { raw_dma8(projb, colB, t0 + 128, raw, tid); raw_dma8(projb, colC, t0 + 128, raw + 8192, tid); raw_dma8(projb, colX, t0 + 128, raw + 16384, tid); }
    {
      const int tl = 16 * w + l15;
      bf16x8 cf[2];
#pragma unroll
      for (int ks = 0; ks < 2; ++ks) cf[ks] = ldfrag(Cs + tl * KLD + ks * 32 + 8 * g);
      f32x4 y[4];
#pragma unroll
      for (int d = 0; d < 4; ++d) y[d] = (f32x4){0.f, 0.f, 0.f, 0.f};
      const float at = acs[tl];
#pragma unroll 1
      for (int stl = 0; stl < 2; ++stl) {
        if (stl * 64 <= 16 * w + 15) {
          f32x4 sc[4];
          qk_tile1<2>(Bs + stl * 64 * KLD, cf, sc, l15, g);
#pragma unroll
          for (int kt = 0; kt < 4; ++kt) {
            const f32x4 as = *(const f32x4*)(acs + stl * 64 + kt * 16 + 4 * g);
#pragma unroll
            for (int r = 0; r < 4; ++r) {
              const bool ok = stl * 64 + kt * 16 + 4 * g + r <= tl;
              sc[kt][r] = ok ? sc[kt][r] * __expf(at - as[r]) : 0.f;
            }
          }
          pv_accum1(sc, Xs + stl * 64 * KLD, y, l15, g);
        }
      }
      const float ea = __expf(at), dsk = d_h / dts[tl];
      const size_t row = (size_t)b * SEQ + t0 + tl;
#pragma unroll
      for (int d = 0; d < 4; ++d) {
        f32x4 yo = (f32x4){0.f, 0.f, 0.f, 0.f};
#pragma unroll
        for (int ks = 0; ks < 2; ++ks) yo = mfma16(ldfrag(Ss + (d * 16 + l15) * KLD + ks * 32 + 8 * g), cf[ks], yo);
        const u32x2 xv = *(const u32x2*)(Xs + tl * KLD + d * 16 + 4 * g);
        const f32x4 v = y[d] + yo * ea;
        u32x2 o; o.x = pack2(v[0] + dsk * bflo(xv.x), v[1] + dsk * bfhi(xv.x)); o.y = pack2(v[2] + dsk * bflo(xv.y), v[3] + dsk * bfhi(xv.y));
        *(u32x2*)(Y + row * 1024 + Y_C + h * 64 + d * 16 + 4 * g) = o;
      }
    }
    lds_barrier();
    scale_rows8(Xs, wend, tid);
    lds_barrier();
    const float cd = __expf(acs[127]);
    st[0] *= cd; st[1] *= cd;
    state_update8(Xs, Bs, st, w, l15, g);
  }
  asm volatile("s_waitcnt vmcnt(0)" ::: "memory");
}

DI void mlstm_task8(const Params& p, int layer, int b, int h, unsigned char* smem) {
  u16* Qs = (u16*)(smem + SEQ_LDS_A); u16* Ks2 = (u16*)(smem + SEQ_LDS_B); u16* Vs2 = (u16*)(smem + SEQ_LDS_C); u16* Cst = (u16*)(smem + SEQ_LDS_S);
  float* fl = (float*)(smem + SEQ8_LDS_F);
  float* bcs = fl; float* us = fl + 128; float* pms = fl + 256; float* wend = fl + 384; float* nst = fl + 512; float* tmp = fl + 576; float* npart = fl + 640;
  u16* halo = (u16*)(smem + SEQ8_LDS_HALO); float* cwl = (float*)(smem + SEQ8_LDS_CW); u16* zero3 = (u16*)(smem + SEQ8_LDS_ZERO);
  u16* raw = (u16*)(smem + SEQ8_LDS_RAW);
  int tid = otid512(), lane = tid & 63, w = tid >> 6, l15 = lane & 15, g = lane >> 4;
  const u16* projb = (const u16*)(p.ws + OFF_PROJ) + (size_t)b * SEQ * NP;
  const float* smb = (const float*)(p.ws + OFF_SMALL) + (size_t)b * SEQ * NSMALL;
  const float* cw = p.ml_conv_w + layer * 4 * 512; const float* cb = p.ml_conv_b + layer * 512;
  const float ib = sgprf(p.ml_if_b[layer * 8 + h]), fb = sgprf(p.ml_if_b[layer * 8 + 4 + h]);
  u16* Y = (u16*)(p.ws + OFF_H);
  const int colQ = PD_QK + h * 64, colK = PD_QK + 256 + h * 64, colV = PD_V + h * 64;
  f32x4 st[2] = {(f32x4){0.f, 0.f, 0.f, 0.f}, (f32x4){0.f, 0.f, 0.f, 0.f}};
  float m_prev = 0.f;
  lds_barrier();
  if (tid < 64) nst[tid] = 0.f;
  stage_conv_w8(cwl, cw, cb, h * 64, 512, tid);
  stage_conv_w8(cwl + 320, cw, cb, 256 + h * 64, 512, tid);
  if (tid < 96) ((unsigned*)zero3)[tid] = 0u;
  raw_dma8(projb, colQ, 0, raw, tid); raw_dma8(projb, colK, 0, raw + 8192, tid); raw_dma8(projb, colV, 0, raw + 16384, tid);
  float iraw = 0.f, fraw = 0.f;
  if (tid < 128) { iraw = smb[(size_t)tid * NSMALL + SM_IF + h]; fraw = smb[(size_t)tid * NSMALL + SM_IF + 4 + h]; }
#pragma unroll 1
  for (int c = 0; c < 32; ++c) {
    const int t0 = c * 128;
    asm volatile("" : "+v"(tid)); lane = tid & 63; w = tid >> 6; l15 = lane & 15; g = lane >> 4;
    float ip = 0.f, lf = 0.f;
    if (tid < 128) { ip = iraw + ib; const float fp = fraw + fb; lf = fminf(fp, 0.f) - __logf(1.f + __expf(-fabsf(fp))); }
    float bc = wave_scan_add(lf, lane);
    if (tid == 63) tmp[0] = bc;
    asm volatile("s_waitcnt vmcnt(0)" ::: "memory");
    lds_barrier();
    if (w == 1) bc += tmp[0];
    const float u = tid < 128 ? ip - bc : -1e30f;
    float pm = wave_scan_max(u, lane);
    if (tid == 63) tmp[1] = pm;
    if (c + 1 < 32 && tid < 128) { iraw = smb[(size_t)(t0 + 128 + tid) * NSMALL + SM_IF + h]; fraw = smb[(size_t)(t0 + 128 + tid) * NSMALL + SM_IF + 4 + h]; }
    {
      const u16* hc = halo + (c & 1) * 576;
      const u16* hQ = c == 0 ? zero3 : hc; const u16* hK = c == 0 ? zero3 : hc + 192;
      conv_raw8(raw, hQ, cwl, nullptr, 1.f, Qs, tid);
      conv_raw8(raw + 8192, hK, cwl + 320, nullptr, 0.125f, Ks2, tid);
      save_halo8(raw, halo + ((c + 1) & 1) * 576, tid);
#pragma unroll
      for (int i = 0; i < 2; ++i) { const int chunk = tid + 512 * i; *(u32x4*)(Vs2 + (chunk >> 3) * KLD + (chunk & 7) * 8) = *(const u32x4*)(raw + 16384 + chunk * 8); }
    }
    state_to_lds8(Cst, st, w, l15, g);
    lds_barrier();
    if (w == 1) pm = fmaxf(pm, tmp[1]);
    if (tid < 128) { bcs[tid] = bc; us[tid] = u; pms[tid] = pm; }
    if (c + 1 < 32) { raw_dma8(projb, colQ, t0 + 128, raw, tid); raw_dma8(projb, colK, t0 + 128, raw + 8192, tid); raw_dma8(projb, colV, t0 + 128, raw + 16384, tid); }
    lds_barrier();
    const float blast = bcs[127];
    const float m_new = blast + fmaxf(m_prev, pms[127]);
    if (tid < 128) wend[tid] = __expf(blast - m_new + us[tid]);
    {
      const int tl = 16 * w + l15;
      bf16x8 qf[2];
#pragma unroll
      for (int ks = 0; ks < 2; ++ks) qf[ks] = ldfrag(Qs + tl * KLD + ks * 32 + 8 * g);
      f32x4 num[4];
#pragma unroll
      for (int d = 0; d < 4; ++d) num[d] = (f32x4){0.f, 0.f, 0.f, 0.f};
      const float bt = bcs[tl], mt = bt + fmaxf(m_prev, pms[tl]);
      float den = 0.f;
#pragma unroll 1
      for (int stl = 0; stl < 2; ++stl) {
        if (stl * 64 <= 16 * w + 15) {
          f32x4 sc[4];
          qk_tile1<2>(Ks2 + stl * 64 * KLD, qf, sc, l15, g);
#pragma unroll
          for (int kt = 0; kt < 4; ++kt) {
            const f32x4 uu = *(const f32x4*)(us + stl * 64 + kt * 16 + 4 * g);
#pragma unroll
            for (int r = 0; r < 4; ++r) {
              const bool ok = stl * 64 + kt * 16 + 4 * g + r <= tl;
              const float v = ok ? sc[kt][r] * __expf(bt - mt + uu[r]) : 0.f;
              sc[kt][r] = v; den += v;
            }
          }
          pv_accum1(sc, Vs2 + stl * 64 * KLD, num, l15, g);
        }
      }
      const float wi = __expf(bt + m_prev - mt);
      float qn = 0.f;
#pragma unroll
      for (int ks = 0; ks < 2; ++ks)
#pragma unroll
        for (int j = 0; j < 8; ++j) qn += bf2f((u16)qf[ks][j]) * nst[ks * 32 + 8 * g + j];
      qn = group_sum4(qn);
      const float dn = group_sum4(den) + wi * qn;
      const float inv = __builtin_amdgcn_rcpf(fmaxf(fabsf(dn), __expf(-mt)));
      const size_t row = (size_t)b * SEQ + t0 + tl;
#pragma unroll
      for (int d = 0; d < 4; ++d) {
        f32x4 ni = (f32x4){0.f, 0.f, 0.f, 0.f};
#pragma unroll
        for (int ks = 0; ks < 2; ++ks) ni = mfma16(ldfrag(Cst + (d * 16 + l15) * KLD + ks * 32 + 8 * g), qf[ks], ni);
        const f32x4 v = (num[d] + ni * wi) * inv;
        u32x2 o; o.x = pack2(v[0], v[1]); o.y = pack2(v[2], v[3]);
        *(u32x2*)(Y + row * 1024 + Y_D + h * 64 + d * 16 + 4 * g) = o;
      }
    }
    lds_barrier();
    scale_rows8(Ks2, wend, tid);
    lds_barrier();
    const float fprev = __expf(blast + m_prev - m_new);
    st[0] *= fprev; st[1] *= fprev;
    state_update8(Vs2, Ks2, st, w, l15, g);
    {
      const int e = tid & 63, part = tid >> 6;
      float a = 0.f;
#pragma unroll
      for (int s2 = 0; s2 < 16; ++s2) a += bf2f(Ks2[(part * 16 + s2) * KLD + e]);
      npart[part * 64 + e] = a;
    }
    lds_barrier();
    if (tid < 64) {
      float a = nst[tid] * fprev;
#pragma unroll
      for (int pp = 0; pp < 8; ++pp) a += npart[pp * 64 + tid];
      nst[tid] = a;
    }
    m_prev = m_new;
  }
  asm volatile("s_waitcnt vmcnt(0)" ::: "memory");
}

DI void compress_task(const Params& p, int layer, int b, int kv, int rb, unsigned char* smem) {
  constexpr int HLD = 136;
  u16* Hs = (u16*)smem;
  const int tid = otid(), lane = tid & 63, w = tid >> 6, l15 = lane & 15, g = lane >> 4;
  const u16* projb = (const u16*)(p.ws + OFF_PROJ) + (size_t)b * SEQ * NP + (kv ? PA_VC : PA_KC);
  const int mi = layer * 2 + kv;
  const u16* W1T = (const u16*)(p.ws + OFF_W1T) + (size_t)mi * 128 * 2048;
  const u16* W2T = (const u16*)(p.ws + OFF_W2T) + (size_t)mi * 64 * 128;
  const float* bias1 = (const float*)(p.ws + OFF_BIAS1) + mi * 16 * 128;
  f32x4 acc[2][2];
#pragma unroll
  for (int nt = 0; nt < 2; ++nt) { acc[nt][0] = (f32x4){0.f, 0.f, 0.f, 0.f}; acc[nt][1] = (f32x4){0.f, 0.f, 0.f, 0.f}; }
  int tok[2];
#pragma unroll
  for (int mt = 0; mt < 2; ++mt) { int i = rb * 32 + mt * 16 + l15; if (i > 254) i = 254; tok[mt] = 16 * i; }
#pragma unroll 4
  for (int ks = 0; ks < 64; ++ks) {
    const int j = ks >> 1, d0 = (ks & 1) * 32;
    bf16x8 af[2], wf[2];
#pragma unroll
    for (int mt = 0; mt < 2; ++mt) af[mt] = ldfrag(projb + (size_t)(tok[mt] + j) * NP + d0 + 8 * g);
#pragma unroll
    for (int nt = 0; nt < 2; ++nt) wf[nt] = ldfrag(W1T + (size_t)(w * 32 + nt * 16 + l15) * 2048 + ks * 32 + 8 * g);
#pragma unroll
    for (int nt = 0; nt < 2; ++nt)
#pragma unroll
      for (int mt = 0; mt < 2; ++mt) acc[nt][mt] = mfma16(wf[nt], af[mt], acc[nt][mt]);
  }
  lds_barrier();
#pragma unroll
  for (int nt = 0; nt < 2; ++nt) {
    const int n = w * 32 + nt * 16 + 4 * g;
    f32x4 bb = *(const f32x4*)(bias1 + n);
#pragma unroll
    for (int pc = 1; pc < 16; ++pc) bb += *(const f32x4*)(bias1 + pc * 128 + n);
#pragma unroll
    for (int mt = 0; mt < 2; ++mt) {
      const f32x4 v = acc[nt][mt] + bb;
      u32x2 o; o.x = pack2(siluf(v[0]), siluf(v[1])); o.y = pack2(siluf(v[2]), siluf(v[3]));
      *(u32x2*)(Hs + (mt * 16 + l15) * HLD + n) = o;
    }
  }
  lds_barrier();
  f32x4 acc2[2] = {(f32x4){0.f, 0.f, 0.f, 0.f}, (f32x4){0.f, 0.f, 0.f, 0.f}};
#pragma unroll
  for (int ks = 0; ks < 4; ++ks) {
    const bf16x8 wf = ldfrag(W2T + (size_t)(w * 16 + l15) * 128 + ks * 32 + 8 * g);
#pragma unroll
    for (int mt = 0; mt < 2; ++mt) acc2[mt] = mfma16(wf, ldfrag(Hs + (mt * 16 + l15) * HLD + ks * 32 + 8 * g), acc2[mt]);
  }
  u16* dst = (u16*)(p.ws + (kv ? OFF_VCMP : OFF_KCMP) + (size_t)layer * 512 * 1024) + (size_t)b * 256 * 64;
#pragma unroll
  for (int mt = 0; mt < 2; ++mt) {
    const int i = rb * 32 + mt * 16 + l15;
    u32x2 o; o.x = pack2(acc2[mt][0], acc2[mt][1]); o.y = pack2(acc2[mt][2], acc2[mt][3]);
    if (i > 254) { o.x = 0u; o.y = 0u; }
    *(u32x2*)(dst + (size_t)i * 64 + w * 16 + 4 * g) = o;
  }
}

DI void nsa_task(const Params& p, int layer, int b, int qi, unsigned char* smem) {
  u16* Ks = (u16*)smem; u16* Vs = Ks + 64 * KLD;
  float* T = (float*)(smem + 2 * KVBUF * 2);
  unsigned long long* selm = (unsigned long long*)(smem + 2 * KVBUF * 2 + 4 * 32 * 65 * 4);
  const int tid = otid(), lane = tid & 63, h = tid >> 6, l15 = lane & 15, g = lane >> 4;
  const int q0 = qi * 32;
  const u16* projb = (const u16*)(p.ws + OFF_PROJ) + (size_t)b * SEQ * NP;
  const float* smb = (const float*)(p.ws + OFF_SMALL) + (size_t)b * SEQ * NSMALL;
  const u16* kcmp = (const u16*)(p.ws + OFF_KCMP + (size_t)layer * 512 * 1024) + (size_t)b * 256 * 64;
  const u16* vcmp = (const u16*)(p.ws + OFF_VCMP + (size_t)layer * 512 * 1024) + (size_t)b * 256 * 64;
  bf16x8 qf[2][2];
#pragma unroll
  for (int qt = 0; qt < 2; ++qt)
#pragma unroll
    for (int ks = 0; ks < 2; ++ks) qf[qt][ks] = ldfrag(projb + (size_t)(q0 + qt * 16 + l15) * NP + PA_Q + h * 64 + ks * 32 + 8 * g);
  const float sc = 0.125f * 1.4426950408889634f;
  f32x4 outacc[4][2];
  AttnAcc a;
  const int ntc = (q0 >> 10) + 1;
  attn_init(a);
  lds_barrier();
  for (int i = tid; i < 4 * 32 * 65; i += 256) T[i] = 0.f;
  kv_pipeline(0, ntc, Ks,
    [&](int) { return true; },
    [&](int j, KVRegs& kr) { kv_load(kcmp, vcmp, 64, 64, j * 64, kr); },
    [&](int j, const u16* Kt, const u16* Vt) {
      f32x4 s[4][2];
      auto valid = [&](int kt, int r, int qt) { return 16 * (j * 64 + kt * 16 + 4 * g + r) + 31 <= q0 + qt * 16 + l15; };
      qk_tile<2>(Kt, 0, qf, s, l15, g);
      softmax_pv(s, a, Vt, sc, l15, g, valid);
    });
  float cinv[2];
#pragma unroll
  for (int qt = 0; qt < 2; ++qt) {
    const float lt = group_sum4(a.l[qt]);
    cinv[qt] = lt > 0.f ? 1.f / lt : 0.f;
    const float gt = sigmoidf_(smb[(size_t)(q0 + qt * 16 + l15) * NSMALL + SM_G + h * 3 + 0]) * cinv[qt];
#pragma unroll
    for (int d = 0; d < 4; ++d) outacc[d][qt] = a.o[d][qt] * gt;
  }
  float carry[2] = {0.f, 0.f};
  kv_pipeline(0, ntc, Ks,
    [&](int) { return true; },
    [&](int j, KVRegs& kr) { kv_load(kcmp, vcmp, 64, 64, j * 64, kr); },
    [&](int j, const u16* Kt, const u16*) {
      f32x4 s[4][2];
      qk_tile<2>(Kt, 0, qf, s, l15, g);
#pragma unroll
      for (int qt = 0; qt < 2; ++qt) {
        float prev3 = carry[qt];
#pragma unroll
        for (int kt = 0; kt < 4; ++kt) {
          float pr[4];
#pragma unroll
          for (int r = 0; r < 4; ++r) {
            const bool ok = 16 * (j * 64 + kt * 16 + 4 * g + r) + 31 <= q0 + qt * 16 + l15;
            pr[r] = ok ? exp2_(s[kt][qt][r] * sc - a.m[qt]) * cinv[qt] : 0.f;
          }
          const float below = __shfl_up(pr[3], 16);
          const float wrap = __shfl(prev3, l15 + 48);
          const float nb = g > 0 ? below : wrap;
          T[(h * 32 + qt * 16 + l15) * 65 + j * 16 + kt * 4 + g] = (pr[0] + pr[1]) + (pr[2] + 0.5f * pr[3]) + 0.5f * nb;
          prev3 = pr[3];
        }
        carry[qt] = prev3;
      }
    });
  lds_barrier();
#pragma unroll 1
  for (int qq = 0; qq < 8; ++qq) {
    const int q = h * 8 + qq, t = q0 + q, cur = t >> 6;
    const float imp = ((T[(0 * 32 + q) * 65 + lane] + T[(1 * 32 + q) * 65 + lane]) + T[(2 * 32 + q) * 65 + lane]) + T[(3 * 32 + q) * 65 + lane];
    const bool forced = lane == cur || lane == 0, allowed = lane <= cur, cand = allowed && !forced;
    const int K = cur == 0 ? 15 : 14;
    unsigned long long m;
    if (__popcll(__ballot(cand)) <= K) m = __ballot(allowed);
    else {
      const unsigned key = __float_as_uint(imp);
      unsigned prefix = 0u;
#pragma unroll 1
      for (int bit = 30; bit >= 0; --bit) {
        const unsigned cnd = prefix | (1u << bit);
        if (__popcll(__ballot(cand && key >= cnd)) >= K) prefix = cnd;
      }
      const unsigned long long gt = __ballot(cand && key > prefix), eq = __ballot(cand && key == prefix);
      const int need = K - __popcll(gt);
      const int myrank = __popcll(eq & ((1ull << lane) - 1ull));
      m = gt | __ballot(cand && key == prefix && myrank < need) | __ballot(forced);
    }
    if (lane == 0) selm[q] = m;
  }
  lds_barrier();
  f32x4* park = (f32x4*)T + (h * 8) * 64 + lane;
#pragma unroll
  for (int d = 0; d < 4; ++d) { park[(d * 2 + 0) * 64] = outacc[d][0]; park[(d * 2 + 1) * 64] = outacc[d][1]; }
  unsigned long long mq[2], anym = 0ull;
#pragma unroll
  for (int qt = 0; qt < 2; ++qt) mq[qt] = selm[qt * 16 + l15];
  for (int i = 0; i < 32; ++i) anym |= selm[i];
  const int jhi = (q0 + 31) >> 6;
#pragma unroll
  for (int qt = 0; qt < 2; ++qt)
#pragma unroll
    for (int ks = 0; ks < 2; ++ks) qf[qt][ks] = scale_frag(qf[qt][ks], sc);
  attn_init_rel(a);
  kv_pipeline(0, jhi + 1, Ks,
    [&](int j) { return (bool)((anym >> j) & 1ull); },
    [&](int j, KVRegs& kr) { kv_load(projb + PA_KS, projb + PA_VS, NP, NP, j * 64, kr); },
    [&](int j, const u16* Kt, const u16* Vt) {
      f32x4 s[4][2];
      auto valid = [&](int kt, int r, int qt) { return ((mq[qt] >> j) & 1ull) && (j * 64 + kt * 16 + 4 * g + r <= q0 + qt * 16 + l15); };
      bf16x8 pf[2][2];
      if (j * 64 + 63 <= q0) {
        qk_tile_rel<2>(Kt, 0, qf, a, s, l15, g, (bool)((mq[0] >> j) & 1ull), (bool)((mq[1] >> j) & 1ull));
        softmax_rel<0>(s, a, pf, l15, valid);
      } else {
        qk_tile_rel<2>(Kt, 0, qf, a, s, l15, g);
        softmax_rel<1>(s, a, pf, l15, valid);
      }
      pv_accum(pf, Vt, a.o, l15, g);
      rowsum_accum(pf, a, l15);
    });
#pragma unroll
  for (int qt = 0; qt < 2; ++qt) {
    const float lt = rel_rowsum(a, qt, l15);
    const float gt = sigmoidf_(smb[(size_t)(q0 + qt * 16 + l15) * NSMALL + SM_G + h * 3 + 1]) * (lt > 0.f ? 1.f / lt : 0.f);
#pragma unroll
    for (int d = 0; d < 4; ++d) park[(d * 2 + qt) * 64] += a.o[d][qt] * gt;
  }
  attn_init_rel(a);
  const int jlo = q0 >= 511 ? (q0 - 511) >> 6 : 0;
  kv_pipeline(jlo, jhi + 1, Ks,
    [&](int) { return true; },
    [&](int j, KVRegs& kr) { kv_load(projb + PA_KW, projb + PA_VW, NP, NP, j * 64, kr); },
    [&](int j, const u16* Kt, const u16* Vt) {
      f32x4 s[4][2];
      auto valid = [&](int kt, int r, int qt) { const int key = j * 64 + kt * 16 + 4 * g + r, t = q0 + qt * 16 + l15; return key <= t && key + 512 > t; };
      bf16x8 pf[2][2];
      qk_tile_rel<2>(Kt, 0, qf, a, s, l15, g);
      if (j * 64 + 63 <= q0 && j * 64 + 512 > q0 + 31) softmax_rel<0>(s, a, pf, l15, valid);
      else softmax_rel<1>(s, a, pf, l15, valid);
      pv_accum(pf, Vt, a.o, l15, g);
      rowsum_accum(pf, a, l15);
    });
  u16* Y = (u16*)(p.ws + OFF_H);
  const float* ng = p.nsa_norm_g + layer * 64;
#pragma unroll
  for (int qt = 0; qt < 2; ++qt) {
    const int t = q0 + qt * 16 + l15;
    const float lt = rel_rowsum(a, qt, l15);
    const float gt = sigmoidf_(smb[(size_t)t * NSMALL + SM_G + h * 3 + 2]) * (lt > 0.f ? 1.f / lt : 0.f);
    f32x4 v[4]; float ss = 0.f;
#pragma unroll
    for (int d = 0; d < 4; ++d) { v[d] = park[(d * 2 + qt) * 64] + a.o[d][qt] * gt; ss += v[d][0] * v[d][0] + v[d][1] * v[d][1] + v[d][2] * v[d][2] + v[d][3] * v[d][3]; }
    ss = group_sum4(ss);
    const float rn = rsqrtf(ss * (1.f / 64.f) + 1e-6f);
    const size_t row = (size_t)b * SEQ + t;
#pragma unroll
    for (int d = 0; d < 4; ++d) {
      const int dd = d * 16 + 4 * g;
      const u32x2 zz = *(const u32x2*)(projb + (size_t)t * NP + PA_Z + h * 64 + dd);
      const f32x4 gg = *(const f32x4*)(ng + dd);
      u32x2 o;
      o.x = pack2(v[d][0] * rn * gg[0] * siluf(bflo(zz.x)), v[d][1] * rn * gg[1] * siluf(bfhi(zz.x)));
      o.y = pack2(v[d][2] * rn * gg[2] * siluf(bflo(zz.y)), v[d][3] * rn * gg[3] * siluf(bfhi(zz.y)));
      *(u32x2*)(Y + row * 1024 + Y_A + h * 64 + dd) = o;
    }
  }
}


DI void final_norm_rows(const Params& p, int gw, int nw, int lane) {
  const float4* gp = (const float4*)p.final_g;
  float4 gg[4];
#pragma unroll
  for (int i = 0; i < 4; ++i) gg[i] = gp[lane + 64 * i];
  for (int row0 = gw * 4; row0 < NTOK; row0 += nw * 4) {
    float4 v[4][4]; float ss[4];
#pragma unroll
    for (int j = 0; j < 4; ++j) {
      const float4* xr = (const float4*)(p.out + (size_t)(row0 + j) * D_MODEL);
#pragma unroll
      for (int i = 0; i < 4; ++i) v[j][i] = xr[lane + 64 * i];
    }
#pragma unroll
    for (int j = 0; j < 4; ++j) {
      float a = 0.f;
#pragma unroll
      for (int i = 0; i < 4; ++i) a += v[j][i].x * v[j][i].x + v[j][i].y * v[j][i].y + v[j][i].z * v[j][i].z + v[j][i].w * v[j][i].w;
      ss[j] = wave_sum(a);
    }
#pragma unroll
    for (int j = 0; j < 4; ++j) {
      float4* xr = (float4*)(p.out + (size_t)(row0 + j) * D_MODEL);
      const float r = rsqrtf(ss[j] * (1.f / D_MODEL) + 1e-6f);
#pragma unroll
      for (int i = 0; i < 4; ++i) { float4 w; w.x = v[j][i].x * r * gg[i].x; w.y = v[j][i].y * r * gg[i].y; w.z = v[j][i].z * r * gg[i].z; w.w = v[j][i].w * r * gg[i].w; xr[lane + 64 * i] = w; }
    }
  }
}

#define XB_TMO      128
#define XB_XCNT(j)  (256  + 64 * (j))
#define XB_XSUB(j)  (1280 + 64 * (j))
#define XB_XGEN(j)  (2304 + 64 * (j))
#define XB_TOP      3328
#define XB_TOPGEN   3392
#define XCD_BAR_WORDS 3456
#define XB_SPIN_CAP (1u << 23)
DI unsigned xb_ld(unsigned* p)              { return __hip_atomic_load(p, __ATOMIC_RELAXED, __HIP_MEMORY_SCOPE_AGENT); }
DI unsigned xb_add(unsigned* p, unsigned v) { return __hip_atomic_fetch_add(p, v, __ATOMIC_RELAXED, __HIP_MEMORY_SCOPE_AGENT); }
DI unsigned xb_xcc_id() { return (unsigned)__builtin_amdgcn_s_getreg((3 << 11) | 20) & 0xFu; }
#define XB_SPIN(cond, bar) do { unsigned _sp = 0; while (cond) { __builtin_amdgcn_s_sleep(1); \
    if ((++_sp & 255u) == 0u) { if (xb_ld(&(bar)[XB_TMO])) break; if (_sp > XB_SPIN_CAP) { atomicAdd(&(bar)[XB_TMO], 1u); break; } } } } while (0)
struct XcdBarrier { unsigned* bar; unsigned x; volatile LDSP unsigned* st; };
DI XcdBarrier xcd_barrier_post(unsigned* bar, volatile LDSP unsigned* st) {
  XcdBarrier b; b.bar = bar; b.x = xb_xcc_id(); b.st = st;
  if (threadIdx.x == 0) (void)xb_add(&bar[XB_XCNT(b.x)], 1u);
  return b;
}
DI void xcd_barrier_complete(unsigned* bar, unsigned x, unsigned& nloc, unsigned& nx) {
  const unsigned G = gridDim.x * gridDim.y * gridDim.z;
  unsigned sum, cnt, mine, sp = 0u;
  for (;;) {
    sum = 0u; cnt = 0u; mine = 0u;
#pragma unroll
    for (unsigned j = 0; j < 16; ++j) { const unsigned c = xb_ld(&bar[XB_XCNT(j)]); sum += c; cnt += (c > 0u) ? 1u : 0u; mine = (j == x) ? c : mine; }
    if (sum == G) break;
    __builtin_amdgcn_s_sleep(1);
    if ((++sp & 255u) == 0u) { if (xb_ld(&bar[XB_TMO])) break; if (sp > XB_SPIN_CAP) { atomicAdd(&bar[XB_TMO], 1u); break; } }
  }
  nloc = mine > 0u ? mine : 1u; nx = cnt > 0u ? cnt : 1u;
}
DI void xcd_barrier(const XcdBarrier& b) {
  asm volatile("s_waitcnt vmcnt(0)" ::: "memory");
  __syncthreads();
  if (threadIdx.x == 0) {
    unsigned* bar = b.bar;
    __builtin_amdgcn_s_waitcnt(0);
    unsigned nloc = b.st[0], nx = b.st[1];
    if (nloc == 0u) { xcd_barrier_complete(bar, b.x, nloc, nx); b.st[0] = nloc; b.st[1] = nx; }
    const unsigned old = xb_add(&bar[XB_XSUB(b.x)], 1u);
    const unsigned gen = old / nloc;
    if (old + 1u == (gen + 1u) * nloc) {
      __builtin_amdgcn_fence(__ATOMIC_RELEASE, "agent");
      asm volatile("s_waitcnt vmcnt(0)" ::: "memory");
      const unsigned og = xb_add(&bar[XB_TOP], 1u);
      const unsigned tg = og / nx;
      if (og + 1u == (tg + 1u) * nx) xb_add(&bar[XB_TOPGEN], 1u);
      else XB_SPIN(xb_ld(&bar[XB_TOPGEN]) == tg, bar);
      __builtin_amdgcn_fence(__ATOMIC_ACQUIRE, "agent");
      xb_add(&bar[XB_XGEN(b.x)], 1u);
      asm volatile("s_waitcnt vmcnt(0)" ::: "memory");
    } else {
      XB_SPIN(xb_ld(&bar[XB_XGEN(b.x)]) == gen, bar);
      __builtin_amdgcn_fence(__ATOMIC_ACQUIRE, "agent");
      asm volatile("s_waitcnt vmcnt(0)" ::: "memory");
    }
  }
  __syncthreads();
}

constexpr int HALF_LDS = 76 * 1024;
constexpr int SMEM_BYTES = 2 * HALF_LDS;
__global__ void __launch_bounds__(512, 2) fwd_megakernel(Params p) {
  cg::grid_group grid = cg::this_grid();
  __shared__ __attribute__((aligned(16))) unsigned char smem[SMEM_BYTES];
  const int half = __builtin_amdgcn_readfirstlane(threadIdx.x >> 8);
  unsigned char* hsm = smem + half * HALF_LDS;
  const int G = gridDim.x, bid = blockIdx.x;
  const int slot = bid * 2 + half, NS = 2 * G;
  volatile LDSP unsigned* xst = (volatile LDSP unsigned*)(LDSP unsigned char*)(smem + SMEM_BYTES - 32);
  if (threadIdx.x == 0) { xst[0] = 0u; xst[1] = 0u; }
  __syncthreads();
  const XcdBarrier xb = xcd_barrier_post((unsigned*)(p.ws + OFF_BAR), xst);
  {
    constexpr int ADA0 = T0_WIN + T0_WOUT + T0_W1 + T0_W2;
    unsigned* cnt = (unsigned*)(p.ws + OFF_CNT);
    for (int i = slot; i < ((T0_TOTAL + NS - 1) / NS) * NS; i += NS) {
      const int ii = i < T0_TOTAL ? i : T0_TOTAL - 1;
      const int t = ii < 96 ? ADA0 + ii : (ii - 96 < ADA0 ? ii - 96 : ii);
      phase0_task(p, t, hsm);
      if (i < 96) {
        asm volatile("s_waitcnt vmcnt(0)" ::: "memory");
        lds_barrier();
        if (otid512() == 0) {
          __builtin_amdgcn_fence(__ATOMIC_RELEASE, "agent");
          asm volatile("s_waitcnt vmcnt(0)" ::: "memory");
          __hip_atomic_fetch_add(cnt + 8, 2u, __ATOMIC_RELAXED, __HIP_MEMORY_SCOPE_AGENT);
        }
      }
    }
    if (otid512() == 0) {
      unsigned sp = 0;
      while (__hip_atomic_load(cnt + 8, __ATOMIC_RELAXED, __HIP_MEMORY_SCOPE_AGENT) < 96u) { __builtin_amdgcn_s_sleep(8); if (++sp > (1u << 22)) break; }
      __builtin_amdgcn_fence(__ATOMIC_ACQUIRE, "agent");
      asm volatile("s_waitcnt vmcnt(0)" ::: "memory");
    }
    lds_barrier();
    for (int t = slot; t < ((NTOK / 64 + NS - 1) / NS) * NS; t += NS) phase1_task(p, 0, p.x, t < NTOK / 64 ? t : NTOK / 64 - 1, hsm);
  }
  grid.sync();
  for (int layer = 0; layer < 2; ++layer) {
    Params q = p;
    { size_t zoff = 0; asm volatile("" : "+s"(zoff)); q.ws = p.ws + zoff; }
    const float* xin = layer == 0 ? q.x : q.out;
    if (layer != 0) {
      for (int t = slot; t < ((NTOK / 64 + NS - 1) / NS) * NS; t += NS) phase1_task(q, layer, xin, t < NTOK / 64 ? t : NTOK / 64 - 1, hsm);
      xcd_barrier(xb);
    }
    for (int t = bid; t < (NTOK / 256) * (NPAD / 256); t += G) gemm_inproj_tile(q, layer, t, smem);
    xcd_barrier(xb);
    {
      unsigned* cnt = (unsigned*)(q.ws + OFF_CNT);
      unsigned* qcnt = cnt + 32 + layer * 8; unsigned* cdone = cnt + 64 + layer * 8; unsigned* sdone = cnt + 96 + layer * 8;
      int* s_pair = (int*)(smem + SMEM_BYTES - 16);
      if (bid < 32) ssd_task8(q, layer, bid >> 2, bid & 3, smem);
      else if (bid < 64) mlstm_task8(q, layer, (bid - 32) >> 2, (bid - 32) & 3, smem);
      if (bid < 64) {
        asm volatile("s_waitcnt vmcnt(0)" ::: "memory");
        lds_barrier();
        if (otid512() == 0) {
          __builtin_amdgcn_fence(__ATOMIC_RELEASE, "agent");
          asm volatile("s_waitcnt vmcnt(0)" ::: "memory");
          __hip_atomic_fetch_add(sdone + ((bid & 31) >> 2), 1u, __ATOMIC_RELAXED, __HIP_MEMORY_SCOPE_AGENT);
        }
      }
      constexpr int NP_C = 8, NP_D = 64, NP_N = 64, NP_F = 32, NP_ALL = NP_C + NP_D + NP_N + NP_F;
      for (int kq = 0; kq < 8; ++kq) {
        const int bq = (int)((xb.x + (unsigned)kq) & 7u);
        for (;;) {
          const int t512 = otid512();
          lds_barrier();
          if (t512 == 0) *s_pair = (int)atomicAdd(qcnt + bq, 1u);
          lds_barrier();
          const int pair = *s_pair;
          if (pair >= NP_ALL) break;
          if (pair < NP_C) {
            const int v = pair * 2 + half;
            compress_task(q, layer, bq, v >> 3, v & 7, hsm);
            asm volatile("s_waitcnt vmcnt(0)" ::: "memory");
            lds_barrier();
            if (t512 == 0) {
              __builtin_amdgcn_fence(__ATOMIC_RELEASE, "agent");
              asm volatile("s_waitcnt vmcnt(0)" ::: "memory");
              __hip_atomic_fetch_add(cdone + bq, 1u, __ATOMIC_RELAXED, __HIP_MEMORY_SCOPE_AGENT);
            }
          } else if (pair < NP_C + NP_D) {
            const int d = pair - NP_C;
            diff_attn_task(q, layer, bq, 2 * (d & 1) + half, 31 - (d >> 1), hsm);
          } else if (pair < NP_C + NP_D + NP_N) {
            if (t512 == 0) {
              while (__hip_atomic_load(cdone + bq, __ATOMIC_RELAXED, __HIP_MEMORY_SCOPE_AGENT) < (unsigned)NP_C) __builtin_amdgcn_s_sleep(16);
              __builtin_amdgcn_fence(__ATOMIC_ACQUIRE, "agent");
              asm volatile("s_waitcnt vmcnt(0)" ::: "memory");
            }
            lds_barrier();
            nsa_task(q, layer, bq, 2 * (63 - (pair - NP_C - NP_D)) + half, hsm);
          } else {
            if (t512 == 0) {
              while (__hip_atomic_load(sdone + bq, __ATOMIC_RELAXED, __HIP_MEMORY_SCOPE_AGENT) < 8u) __builtin_amdgcn_s_sleep(16);
              __builtin_amdgcn_fence(__ATOMIC_ACQUIRE, "agent");
              asm volatile("s_waitcnt vmcnt(0)" ::: "memory");
            }
            lds_barrier();
            seq_fix_rows(q, layer, bq * SEQ + ((pair - NP_C - NP_D - NP_N) * 2 + half) * 64, 64);
          }
        }
      }
    }
    xcd_barrier(xb);
    if (layer == 0) { for (int t = bid; t < (NTOK / 256) * 4; t += G) gemm_outproj_tile<0>(q, xin, q.out, t, smem); }
    else { for (int t = bid; t < (NTOK / 256) * 4; t += G) gemm_outproj_tile<1>(q, xin, q.out, t, smem); }
    xcd_barrier(xb);
  }
  { const int t5 = otid512(); final_norm_rows(p, bid * 8 + (t5 >> 6), G * 8, t5 & 63); }
}

extern "C" void kernel_launch(void* const* d_in, const int* in_sizes, int n_in, void* d_out, int out_size, void* d_ws, size_t ws_size,
                              hipStream_t stream) {
  static int grid_blocks = 0;
  if (!grid_blocks) {
    int dev = 0, cus = 0, per_cu = 0;
    (void)hipGetDevice(&dev);
    (void)hipDeviceGetAttribute(&cus, hipDeviceAttributeMultiprocessorCount, dev);
    (void)hipOccupancyMaxActiveBlocksPerMultiprocessor(&per_cu, fwd_megakernel, 512, 0);
    if (per_cu > 1) per_cu = 1;
    if (per_cu < 1) per_cu = 1;
    grid_blocks = cus * per_cu;
  }
  if (grid_blocks < 64 || (grid_blocks & 3)) { fprintf(stderr, "grid too small: %d\n", grid_blocks); return; }
  if (ws_size < WS_NEEDED) { fprintf(stderr, "workspace too small: %zu < %zu\n", ws_size, WS_NEEDED); return; }
  Params p{};
  const float** pp = (const float**)&p;
  for (int i = 0; i < 26; ++i) pp[i] = (const float*)d_in[i];
  p.out = (float*)d_out; p.ws = (unsigned char*)d_ws;
  (void)hipMemsetAsync((unsigned char*)d_ws + OFF_CNT, 0, 64 * 1024 + XCD_BAR_WORDS * 4, stream);
  void* args[] = {&p};
  hipError_t e = hipLaunchCooperativeKernel((void*)fwd_megakernel, dim3(grid_blocks), dim3(512), args, 0, stream);
  if (e != hipSuccess) fprintf(stderr, "cooperative launch failed: %s (grid %d)\n", hipGetErrorString(e), grid_blocks);
}
```

```cpp
#include <hip/hip_runtime.h>
#include <hip/hip_cooperative_groups.h>
#include <cstdio>
#include <cstdint>
namespace cg = cooperative_groups;

typedef unsigned short u16;
typedef short bf16x8 __attribute__((ext_vector_type(8)));
typedef short s16x4 __attribute__((ext_vector_type(4)));
typedef float f32x4 __attribute__((ext_vector_type(4)));
typedef float f32x2 __attribute__((ext_vector_type(2)));
typedef unsigned u32x4 __attribute__((ext_vector_type(4)));
typedef unsigned u32x2 __attribute__((ext_vector_type(2)));
typedef __bf16 bf16x2_t __attribute__((ext_vector_type(2)));
#define DI __device__ __forceinline__
#define LDSP __attribute__((address_space(3)))

constexpr int D_MODEL = 1024, BATCH = 8, SEQ = 4096, NTOK = BATCH * SEQ;
constexpr int D_IN = 3992;
constexpr int NP = 3968, NPAD = 4096, NSMALL = 32;
constexpr int PA_Q = 0, PA_KC = 256, PA_VC = 320, PA_KS = 384, PA_VS = 448, PA_KW = 512, PA_VW = 576, PA_Z = 640;
constexpr int PB_Q = 896, PB_K = 1152, PB_V = 1408, PB_Z = 1664;
constexpr int PC_Z = 1920, PC_XBC = 2176;
constexpr int PD_QK = 2688, PD_V = 3200, PD_O = 3456, PD_Z = 3712;
constexpr int SM_G = 0, SM_DT = 12, SM_IF = 16;
constexpr int Y_A = 0, Y_B = 256, Y_C = 512, Y_D = 768;

constexpr size_t MiB = 1024 * 1024;
constexpr size_t OFF_WINT = 0;
constexpr size_t OFF_WOUTT = 16 * MiB;
constexpr size_t OFF_W1T = 20 * MiB;
constexpr size_t OFF_W2T = 22 * MiB;
constexpr size_t OFF_BIAS1 = 22 * MiB + 64 * 1024;
constexpr size_t OFF_ADAP = 22 * MiB + 128 * 1024;
constexpr size_t OFF_KCMP = 24 * MiB;
constexpr size_t OFF_VCMP = 24 * MiB + 256 * 1024;
constexpr size_t OFF_BAR = 29 * MiB + 64 * 1024;
constexpr size_t OFF_CNT = 29 * MiB;
constexpr size_t OFF_SMALL = 25 * MiB;
constexpr size_t OFF_SSQ = 29 * MiB;
constexpr size_t OFF_H = 32 * MiB;
constexpr size_t OFF_PROJ = 96 * MiB;
constexpr size_t OFF_X1B = 352 * MiB;
constexpr size_t WS_NEEDED = OFF_X1B + (size_t)NTOK * 1024 * 2;

struct Params {
  const float* x; const float* c; const float* norm_g; const float* ada_w; const float* ada_b;
  const float* w_in; const float* w_out;
  const float* nsa_cmp_pos; const float* nsa_ck_w1; const float* nsa_ck_w2; const float* nsa_cv_w1; const float* nsa_cv_w2; const float* nsa_norm_g;
  const float* diff_lam; const float* diff_norm_g;
  const float* ssm_conv_w; const float* ssm_conv_b; const float* ssm_dt_bias; const float* ssm_a_log; const float* ssm_d; const float* ssm_norm_g;
  const float* ml_conv_w; const float* ml_conv_b; const float* ml_if_b; const float* ml_norm_g; const float* final_g;
  float* out; unsigned char* ws;
};

DI void lds_barrier() { asm volatile("s_waitcnt lgkmcnt(0)" ::: "memory"); __builtin_amdgcn_s_barrier(); asm volatile("" ::: "memory"); }
DI int otid() { int t = threadIdx.x & 255; asm volatile("" : "+v"(t)); return t; }
DI int otid512() { int t = threadIdx.x; asm volatile("" : "+v"(t)); return t; }
DI unsigned pack2(float a, float b) { f32x2 v = {a, b}; bf16x2_t r = __builtin_convertvector(v, bf16x2_t); return __builtin_bit_cast(unsigned, r); }
DI u16 f2bf(float a) { return (u16)(pack2(a, 0.f) & 0xffffu); }
DI float bf2f(u16 h) { return __uint_as_float(((unsigned)h) << 16); }
DI float bflo(unsigned u) { return __uint_as_float(u << 16); }
DI float bfhi(unsigned u) { return __uint_as_float(u & 0xffff0000u); }
DI f32x4 mfma16(bf16x8 a, bf16x8 b, f32x4 c) { return __builtin_amdgcn_mfma_f32_16x16x32_bf16(a, b, c, 0, 0, 0); }
DI float wave_sum(float v) {
#pragma unroll
  for (int o = 32; o > 0; o >>= 1) v += __shfl_xor(v, o);
  return v;
}
DI float siluf(float v) { return v * __builtin_amdgcn_rcpf(1.f + __expf(-v)); }
DI float sigmoidf_(float v) { return __builtin_amdgcn_rcpf(1.f + __expf(-v)); }
DI float exp2_(float v) { return __builtin_amdgcn_exp2f(v); }
DI float sgprf(float v) { return __int_as_float(__builtin_amdgcn_readfirstlane(__float_as_int(v))); }
DI s16x4 tr_read(const u16* p) { return __builtin_amdgcn_ds_read_tr16_b64_v4i16((LDSP s16x4*)p); }
DI bf16x8 cat4(s16x4 a, s16x4 b) { bf16x8 r; r[0] = a[0]; r[1] = a[1]; r[2] = a[2]; r[3] = a[3]; r[4] = b[0]; r[5] = b[1]; r[6] = b[2]; r[7] = b[3]; return r; }
DI bf16x8 ldfrag(const u16* p) { return *(const bf16x8*)p; }

DI int colmap(int n) {
  if (n < 640) return n;
  if (n < 896) return 652 + (n - 640);
  if (n < 1920) return 908 + (n - 896);
  if (n < 2688) return 1932 + (n - 1920);
  if (n < 3456) return 2704 + (n - 2688);
  if (n < 3968) return 3480 + (n - 3456);
  if (n < 3980) return 640 + (n - 3968);
  if (n < 3984) return 2700 + (n - 3980);
  if (n < 3992) return 3472 + (n - 3984);
  return -1;
}

DI void tconv_tile(const float* __restrict__ src, int ldsrc, int k0, int n0, u16* __restrict__ dst, int ldd, bool use_map, unsigned char* smem) {
  float* tile = (float*)smem;
  const int tid = otid();
  lds_barrier();
  {
    const int nn = tid & 63; int col = n0 + nn; if (use_map) col = colmap(col);
#pragma unroll
    for (int i = 0; i < 16; ++i) { const int kk = i * 4 + (tid >> 6); tile[kk * 65 + nn] = col >= 0 ? src[(size_t)(k0 + kk) * ldsrc + col] : 0.f; }
  }
  lds_barrier();
#pragma unroll
  for (int i = 0; i < 2; ++i) {
    const int item = tid + 256 * i, nn = item >> 3, kc = item & 7;
    u32x4 w;
    w.x = pack2(tile[(kc * 8 + 0) * 65 + nn], tile[(kc * 8 + 1) * 65 + nn]);
    w.y = pack2(tile[(kc * 8 + 2) * 65 + nn], tile[(kc * 8 + 3) * 65 + nn]);
    w.z = pack2(tile[(kc * 8 + 4) * 65 + nn], tile[(kc * 8 + 5) * 65 + nn]);
    w.w = pack2(tile[(kc * 8 + 6) * 65 + nn], tile[(kc * 8 + 7) * 65 + nn]);
    *(u32x4*)(dst + (size_t)(n0 + nn) * ldd + k0 + kc * 8) = w;
  }
}

constexpr int T0_WIN = 2 * 16 * 64, T0_WOUT = 2 * 16 * 16, T0_W1 = 4 * 32 * 2, T0_W2 = 4 * 2, T0_ADA = 2 * 12 * 8, T0_B1 = 64;
constexpr int T0_TOTAL = T0_WIN + T0_WOUT + T0_W1 + T0_W2 + T0_ADA + T0_B1;

DI void phase0_task(const Params& p, int t, unsigned char* smem) {
  const int tid = otid();
  if (t < T0_WIN) {
    const int l = t / 1024, r = t % 1024, kt = r / 64, nt = r % 64;
    tconv_tile(p.w_in + (size_t)l * D_MODEL * D_IN, D_IN, kt * 64, nt * 64, (u16*)(p.ws + OFF_WINT) + (size_t)l * NPAD * 1024, 1024, true, smem);
    return;
  }
  t -= T0_WIN;
  if (t < T0_WOUT) {
    const int l = t / 256, r = t % 256, kt = r / 16, nt = r % 16;
    tconv_tile(p.w_out + (size_t)l * 1024 * 1024, 1024, kt * 64, nt * 64, (u16*)(p.ws + OFF_WOUTT) + (size_t)l * 1024 * 1024, 1024, false, smem);
    return;
  }
  t -= T0_WOUT;
  if (t < T0_W1) {
    const int m = t / 64, r = t % 64, kt = r / 2, nt = r % 2, l = m >> 1, kv = m & 1;
    const float* src = (kv ? p.nsa_cv_w1 : p.nsa_ck_w1) + (size_t)l * 2048 * 128;
    tconv_tile(src, 128, kt * 64, nt * 64, (u16*)(p.ws + OFF_W1T) + (size_t)m * 128 * 2048, 2048, false, smem);
    return;
  }
  t -= T0_W1;
  if (t < T0_W2) {
    const int m = t / 2, kt = t % 2, l = m >> 1, kv = m & 1;
    const float* src = (kv ? p.nsa_cv_w2 : p.nsa_ck_w2) + (size_t)l * 128 * 64;
    tconv_tile(src, 64, kt * 64, 0, (u16*)(p.ws + OFF_W2T) + (size_t)m * 64 * 128, 128, false, smem);
    return;
  }
  t -= T0_W2;
  if (t < T0_ADA) {
    const int l = t / 96, r = t % 96, nc = r / 8, kc = r % 8;
    float* cact = (float*)smem;
    lds_barrier();
    for (int i = tid; i < 1024; i += 256) { const int b = i >> 7, kk = i & 127; const float v = p.c[b * 1024 + kc * 128 + kk]; cact[i] = siluf(v); }
    lds_barrier();
    const int n = nc * 256 + tid;
    float acc[8];
#pragma unroll
    for (int b = 0; b < 8; ++b) acc[b] = 0.f;
    const float* w = p.ada_w + ((size_t)l * 1024 + kc * 128) * 3072 + n;
#pragma unroll 16
    for (int kk = 0; kk < 128; ++kk) {
      const float wv = w[(size_t)kk * 3072];
#pragma unroll
      for (int b = 0; b < 8; ++b) acc[b] += cact[b * 128 + kk] * wv;
    }
    float* adap = (float*)(p.ws + OFF_ADAP);
    const float bias = kc == 0 ? p.ada_b[l * 3072 + n] : 0.f;
#pragma unroll
    for (int b = 0; b < 8; ++b) adap[(((size_t)kc * 2 + l) * 8 + b) * 3072 + n] = acc[b] + bias;
    return;
  }
  t -= T0_ADA;
  {
    const int m = t >> 4, kc = t & 15, l = m >> 1, kv = m & 1;
    const float* w1 = (kv ? p.nsa_cv_w1 : p.nsa_ck_w1) + (size_t)l * 2048 * 128;
    const float* pos = p.nsa_cmp_pos + (size_t)l * 2048;
    const int n = tid & 127, half = tid >> 7;
    float acc = 0.f;
    const int k0 = kc * 128 + half * 64;
#pragma unroll 16
    for (int k = 0; k < 64; ++k) acc += pos[k0 + k] * w1[(size_t)(k0 + k) * 128 + n];
    float* red = (float*)smem;
    lds_barrier();
    red[tid] = acc;
    lds_barrier();
    if (tid < 128) ((float*)(p.ws + OFF_BIAS1))[(m * 16 + kc) * 128 + tid] = red[tid] + red[tid + 128];
  }
}

DI void phase1_task(const Params& p, int layer, const float* xin, int grp, unsigned char* smem) {
  const int tid = otid(), lane = tid & 63, wid = tid >> 6;
  const int b = grp >> 6;
  float* mul = (float*)smem;
  float* sh = mul + 1024;
  const float* adap = (const float*)(p.ws + OFF_ADAP);
  lds_barrier();
  for (int c = tid; c < 1024; c += 256) {
    float s0 = 0.f, s1 = 0.f;
#pragma unroll
    for (int kc = 0; kc < 8; ++kc) { const float* a = adap + (((size_t)kc * 2 + layer) * 8 + b) * 3072; s0 += a[c]; s1 += a[1024 + c]; }
    mul[c] = p.norm_g[layer * 1024 + c] * (1.f + s1); sh[c] = s0;
  }
  lds_barrier();
  u16* H = (u16*)(p.ws + OFF_H);
#pragma unroll 1
  for (int it = 0; it < 4; ++it) {
    float4 v[4][4]; float ss[4];
#pragma unroll
    for (int j = 0; j < 4; ++j) {
      const int row = grp * 64 + wid * 16 + it * 4 + j;
      if (layer == 0) {
        const float4* xr = (const float4*)(xin + (size_t)row * D_MODEL);
#pragma unroll
        for (int i = 0; i < 4; ++i) v[j][i] = xr[lane + 64 * i];
      } else {
        const u32x2* xr = (const u32x2*)((const u16*)(p.ws + OFF_X1B) + (size_t)row * D_MODEL);
#pragma unroll
        for (int i = 0; i < 4; ++i) { const u32x2 w = xr[lane + 64 * i]; v[j][i] = make_float4(bflo(w.x), bfhi(w.x), bflo(w.y), bfhi(w.y)); }
      }
    }
#pragma unroll
    for (int j = 0; j < 4; ++j) {
      float a = 0.f;
#pragma unroll
      for (int i = 0; i < 4; ++i) a += v[j][i].x * v[j][i].x + v[j][i].y * v[j][i].y + v[j][i].z * v[j][i].z + v[j][i].w * v[j][i].w;
      ss[j] = wave_sum(a);
    }
#pragma unroll
    for (int j = 0; j < 4; ++j) {
      const int row = grp * 64 + wid * 16 + it * 4 + j;
      const float r = rsqrtf(ss[j] * (1.f / D_MODEL) + 1e-6f);
#pragma unroll
      for (int i = 0; i < 4; ++i) {
        const int c = (lane + 64 * i) * 4;
        u32x2 w;
        w.x = pack2(v[j][i].x * r * mul[c] + sh[c], v[j][i].y * r * mul[c + 1] + sh[c + 1]);
        w.y = pack2(v[j][i].z * r * mul[c + 2] + sh[c + 2], v[j][i].w * r * mul[c + 3] + sh[c + 3]);
        *(u32x2*)(H + (size_t)row * 1024 + c) = w;
      }
    }
  }
}

namespace g8 {
constexpr int BM = 256, BK = 64, HALF = 128, HT = HALF * BK;
constexpr int LDS_BYTES = 8 * HT * 2;
DI int lds_byte(int r, int c) { const int st = (r >> 4) * 2 + (c >> 5), rr = r & 15, cc = c & 31, ob = rr * 64 + cc * 2; return st * 1024 + (ob ^ (((ob >> 9) & 1) << 5)); }
DI void stage_rc(int b, int& R, int& C) { const int st = b / 1024, sb = b % 1024, swz = sb ^ (((sb >> 9) & 1) << 5); R = (st >> 1) * 16 + swz / 64; C = (st & 1) * 32 + (swz % 64) / 2; }

DI void kloop(const u16* __restrict__ A, const u16* __restrict__ Bt, int K, int brow, int bcol, unsigned char* smem, f32x4 (&acc)[2][2][4][2]) {
  u16* shm = (u16*)smem;
  const int tid = otid512();
#define SA(b, h) (shm + ((b) * 2 + (h)) * HT)
#define SB(b, h) (shm + (4 + (b) * 2 + (h)) * HT)
#define STAGE(P, BASE, br, kt) do { const u16* _gb = BASE + ((long)(br) * K + (long)(kt) * BK); \
      __builtin_amdgcn_global_load_lds((const unsigned*)(_gb + soff0), (LDSP unsigned*)((LDSP char*)(P) + tid * 16), 16, 0, 0); \
      __builtin_amdgcn_global_load_lds((const unsigned*)(_gb + soff1), (LDSP unsigned*)((LDSP char*)(P) + tid * 16 + 8192), 16, 0, 0); } while (0)
#define LDA(dst, b, h) _Pragma("unroll") for (int m = 0; m < 4; ++m) _Pragma("unroll") for (int k = 0; k < 2; ++k) \
    dst[m][k] = *reinterpret_cast<const bf16x8*>((const char*)SA(b, h) + lds_byte(wr * 64 + m * 16 + fr, k * 32 + fq * 8))
#define LDB(dst, b, h) _Pragma("unroll") for (int n = 0; n < 2; ++n) _Pragma("unroll") for (int k = 0; k < 2; ++k) \
    dst[n][k] = *reinterpret_cast<const bf16x8*>((const char*)SB(b, h) + lds_byte(wc * 32 + n * 16 + fr, k * 32 + fq * 8))
#define MMA(ai, bj, At_, Bt_) do { __builtin_amdgcn_s_setprio(1); \
    _Pragma("unroll") for (int m = 0; m < 4; ++m) _Pragma("unroll") for (int n = 0; n < 2; ++n) _Pragma("unroll") for (int k = 0; k < 2; ++k) \
      acc[ai][bj][m][n] = __builtin_amdgcn_mfma_f32_16x16x32_bf16(Bt_[n][k], At_[m][k], acc[ai][bj][m][n], 0, 0, 0); \
    __builtin_amdgcn_s_setprio(0); } while (0)
#define WAIT_V(n) asm volatile("s_waitcnt vmcnt(" #n ")" ::: "memory")
#define WAIT_L(n) asm volatile("s_waitcnt lgkmcnt(" #n ")" ::: "memory")
#define BAR __builtin_amdgcn_s_barrier()
#define SCHED __builtin_amdgcn_sched_barrier(0)
  const int wid = __builtin_amdgcn_readfirstlane(tid >> 6), lane = tid & 63, wr = wid >> 2, wc = wid & 3, fr = lane & 15, fq = lane >> 4;
#pragma unroll
  for (int a = 0; a < 2; ++a)
#pragma unroll
    for (int b = 0; b < 2; ++b)
#pragma unroll
      for (int m = 0; m < 4; ++m) { acc[a][b][m][0] = (f32x4){0.f, 0.f, 0.f, 0.f}; acc[a][b][m][1] = (f32x4){0.f, 0.f, 0.f, 0.f}; }
  bf16x8 At[4][2], B0[2][2], B1[2][2];
  const int nt = K / BK;
  int soff0, soff1;
  { int r_, c_; stage_rc(tid * 16, r_, c_); soff0 = r_ * K + c_; stage_rc(tid * 16 + 8192, r_, c_); soff1 = r_ * K + c_; }
  STAGE(SB(0, 0), Bt, bcol, 0); STAGE(SA(0, 0), A, brow, 0);
  STAGE(SB(0, 1), Bt, bcol + HALF, 0); STAGE(SA(0, 1), A, brow + HALF, 0);
  if (wr == 1) BAR;
  WAIT_V(4); BAR;
  STAGE(SB(1, 0), Bt, bcol, 1); STAGE(SA(1, 0), A, brow, 1); STAGE(SB(1, 1), Bt, bcol + HALF, 1);
  WAIT_V(6); BAR;
#pragma unroll 1
  for (int t = 0; t < nt - 2; t += 2) {
    asm volatile("" : "+v"(soff0), "+v"(soff1));
    LDB(B0, 0, 0); SCHED; LDA(At, 0, 0); STAGE(SA(1, 1), A, brow + HALF, t + 1);
    WAIT_L(8); BAR; WAIT_L(0); MMA(0, 0, At, B0); BAR; SCHED;
    LDB(B1, 0, 1); STAGE(SB(0, 0), Bt, bcol, t + 2);
    BAR; WAIT_L(0); MMA(0, 1, At, B1); BAR;
    LDA(At, 0, 1); STAGE(SA(0, 0), A, brow, t + 2);
    BAR; WAIT_L(0); MMA(1, 0, At, B0); BAR; SCHED;
    STAGE(SB(0, 1), Bt, bcol + HALF, t + 2);
    WAIT_V(6); BAR; MMA(1, 1, At, B1); BAR;
    LDB(B0, 1, 0); SCHED; LDA(At, 1, 0); STAGE(SA(0, 1), A, brow + HALF, t + 2);
    WAIT_L(8); BAR; WAIT_L(0); MMA(0, 0, At, B0); BAR; SCHED;
    LDB(B1, 1, 1); STAGE(SB(1, 0), Bt, bcol, t + 3);
    BAR; WAIT_L(0); MMA(0, 1, At, B1); BAR;
    LDA(At, 1, 1); STAGE(SA(1, 0), A, brow, t + 3);
    BAR; WAIT_L(0); MMA(1, 0, At, B0); BAR; SCHED;
    STAGE(SB(1, 1), Bt, bcol + HALF, t + 3);
    WAIT_V(6); BAR; MMA(1, 1, At, B1); BAR;
  }
  { LDB(B0, 0, 0); LDA(At, 0, 0); STAGE(SA(1, 1), A, brow + HALF, nt - 1);
    BAR; WAIT_L(0); MMA(0, 0, At, B0); BAR;
    LDB(B1, 0, 1); BAR; WAIT_L(0); MMA(0, 1, At, B1); BAR;
    LDA(At, 0, 1); WAIT_V(4); BAR; WAIT_L(0); MMA(1, 0, At, B0); MMA(1, 1, At, B1); BAR; }
  { LDB(B0, 1, 0); LDA(At, 1, 0); WAIT_V(2); BAR; WAIT_L(0); MMA(0, 0, At, B0); BAR;
    LDB(B1, 1, 1); WAIT_V(0); BAR; WAIT_L(0); MMA(0, 1, At, B1); BAR;
    LDA(At, 1, 1); BAR; WAIT_L(0); MMA(1, 0, At, B0); MMA(1, 1, At, B1); BAR; }
  if (wr == 0) BAR;
#undef SA
#undef SB
#undef STAGE
#undef LDA
#undef LDB
#undef MMA
#undef WAIT_V
#undef WAIT_L
#undef BAR
#undef SCHED
}
DI void tile_map(int wgid, int nM, int nN, int& pm, int& pn) {
  const int nwg = nM * nN, NXCD = 8, WGM = 8;
  { const int q = nwg / NXCD, r = nwg % NXCD, xcd = wgid % NXCD, off = wgid / NXCD; wgid = (xcd < r ? xcd * (q + 1) : r * (q + 1) + (xcd - r) * q) + off; }
  const int nig = WGM * nN, gid = wgid / nig, fm = gid * WGM, gsz = (nM - fm) < WGM ? (nM - fm) : WGM;
  pm = fm + ((wgid % nig) % gsz); pn = (wgid % nig) / gsz;
}
}

DI void gemm_inproj_tile(const Params& p, int layer, int tile, unsigned char* smem) {
  int pm, pn; g8::tile_map(tile, NTOK / 256, NPAD / 256, pm, pn);
  const int brow = pm * 256, bcol = pn * 256;
  f32x4 acc[2][2][4][2];
  g8::kloop((const u16*)(p.ws + OFF_H), (const u16*)(p.ws + OFF_WINT) + (size_t)layer * NPAD * 1024, 1024, brow, bcol, smem, acc);
  const int tid = otid512(), wid = __builtin_amdgcn_readfirstlane(tid >> 6), lane = tid & 63, wr = wid >> 2, wc = wid & 3, fr = lane & 15, fq = lane >> 4;
  u16* proj = (u16*)(p.ws + OFF_PROJ);
  if (pn == 15 && wc == 0) {
    float* sm = (float*)(p.ws + OFF_SMALL);
#pragma unroll
    for (int ai = 0; ai < 2; ++ai)
#pragma unroll
      for (int m = 0; m < 4; ++m)
#pragma unroll
        for (int n = 0; n < 2; ++n) {
          const int mr = brow + ai * 128 + wr * 64 + m * 16 + fr;
          *(f32x4*)(sm + (size_t)mr * NSMALL + n * 16 + 4 * fq) = acc[ai][1][m][n];
        }
  }
  constexpr int CLD = 264;
  u16* Cs = (u16*)smem;
#pragma unroll
  for (int ai = 0; ai < 2; ++ai) {
    lds_barrier();
#pragma unroll
    for (int bj = 0; bj < 2; ++bj)
#pragma unroll
      for (int m = 0; m < 4; ++m)
#pragma unroll
        for (int n = 0; n < 2; ++n) {
          const f32x4 v = acc[ai][bj][m][n];
          u32x2 w; w.x = pack2(v[0], v[1]); w.y = pack2(v[2], v[3]);
          *(u32x2*)(Cs + (wr * 64 + m * 16 + fr) * CLD + bj * 128 + wc * 32 + n * 16 + 4 * fq) = w;
        }
    lds_barrier();
#pragma unroll
    for (int i = 0; i < 8; ++i) {
      const int id = tid + 512 * i, row = id >> 5, ch = id & 31;
      if (bcol + ch * 8 < NP) *(u32x4*)(proj + (size_t)(brow + ai * 128 + row) * NP + bcol + ch * 8) = *(const u32x4*)(Cs + row * CLD + ch * 8);
    }
  }
  lds_barrier();
}

template <int layer>
DI void gemm_outproj_tile(const Params& p, const float* xin, float* xout, int tile, unsigned char* smem) {
  int pm, pn; g8::tile_map(tile, NTOK / 256, 4, pm, pn);
  const int brow = pm * 256, bcol = pn * 256;
  f32x4 acc[2][2][4][2];
  g8::kloop((const u16*)(p.ws + OFF_H), (const u16*)(p.ws + OFF_WOUTT) + (size_t)layer * 1024 * 1024, 1024, brow, bcol, smem, acc);
  const int tid = otid512(), wid = __builtin_amdgcn_readfirstlane(tid >> 6), lane = tid & 63, wr = wid >> 2, wc = wid & 3, fr = lane & 15, fq = lane >> 4;
  const int b = brow >> 12;
  const float* adap = (const float*)(p.ws + OFF_ADAP);
  constexpr int CLD = 132;
  float* Cs = (float*)smem;
#pragma unroll
  for (int ai = 0; ai < 2; ++ai)
#pragma unroll
    for (int bj = 0; bj < 2; ++bj) {
      lds_barrier();
#pragma unroll
      for (int m = 0; m < 4; ++m)
#pragma unroll
        for (int n = 0; n < 2; ++n) *(f32x4*)(Cs + (wr * 64 + m * 16 + fr) * CLD + wc * 32 + n * 16 + 4 * fq) = acc[ai][bj][m][n];
      lds_barrier();
      const int ch = tid & 31, nc = bcol + bj * 128 + ch * 4;
      f32x4 gt = {0.f, 0.f, 0.f, 0.f};
#pragma unroll
      for (int kc = 0; kc < 8; ++kc) gt += *(const f32x4*)(adap + (((size_t)kc * 2 + layer) * 8 + b) * 3072 + 2048 + nc);
      u16* x1b = (u16*)(p.ws + OFF_X1B);
      f32x4 xv[8];
#pragma unroll
      for (int i = 0; i < 8; ++i) {
        const size_t off = (size_t)(brow + ai * 128 + (tid >> 5) + 16 * i) * 1024 + nc;
        if (layer == 0) xv[i] = *(const f32x4*)(xin + off);
        else { const u32x2 w = *(const u32x2*)(x1b + off); xv[i] = (f32x4){bflo(w.x), bfhi(w.x), bflo(w.y), bfhi(w.y)}; }
      }
#pragma unroll
      for (int i = 0; i < 8; ++i) {
        const int row = (tid >> 5) + 16 * i;
        const size_t off = (size_t)(brow + ai * 128 + row) * 1024 + nc;
        const f32x4 v = xv[i] + gt * *(const f32x4*)(Cs + row * CLD + ch * 4);
        if (layer == 0) { u32x2 w; w.x = pack2(v[0], v[1]); w.y = pack2(v[2], v[3]); *(u32x2*)(x1b + off) = w; }
        else *(f32x4*)(xout + off) = v;
      }
    }
  lds_barrier();
}

constexpr int KLD = 72;
struct KVRegs { u32x4 k[2], v[2]; };
DI void kv_load(const u16* kbase, const u16* vbase, int ldk, int ldv, int key0, KVRegs& r) {
  const int tid = otid();
#pragma unroll
  for (int i = 0; i < 2; ++i) {
    const int id = tid + 256 * i, row = id >> 3, ch = id & 7;
    r.k[i] = *(const u32x4*)(kbase + (size_t)(key0 + row) * ldk + ch * 8);
    r.v[i] = *(const u32x4*)(vbase + (size_t)(key0 + row) * ldv + ch * 8);
  }
}
DI void kv_store(u16* Ks, u16* Vs, const KVRegs& r) {
  const int tid = otid();
#pragma unroll
  for (int i = 0; i < 2; ++i) {
    const int id = tid + 256 * i, row = id >> 3, ch = id & 7;
    *(u32x4*)(Ks + row * KLD + ch * 8) = r.k[i];
    *(u32x4*)(Vs + row * KLD + ch * 8) = r.v[i];
  }
}
constexpr int KVBUF = 2 * 64 * KLD;
template <class UseF, class LoadF, class CompF>
DI void kv_pipeline(int j0, int j1, u16* buf, UseF use, LoadF load, CompF comp) {
  KVRegs kr;
  if (use(j0)) load(j0, kr);
  lds_barrier();
  if (use(j0)) kv_store(buf, buf + 64 * KLD, kr);
  if (j0 + 1 < j1 && use(j0 + 1)) load(j0 + 1, kr);
  lds_barrier();
  for (int j = j0; j < j1; ++j) {
    u16* cur = buf + ((j - j0) & 1) * KVBUF; u16* nxt = buf + (((j - j0) & 1) ^ 1) * KVBUF;
    if (j + 1 < j1 && use(j + 1)) kv_store(nxt, nxt + 64 * KLD, kr);
    if (j + 2 < j1 && use(j + 2)) load(j + 2, kr);
    if (use(j)) comp(j, cur, cur + 64 * KLD);
    lds_barrier();
  }
}
struct AttnAcc { f32x4 o[4][2]; float m[2], l[2]; f32x4 os[2]; int fresh; };
DI void attn_init(AttnAcc& a) {
#pragma unroll
  for (int d = 0; d < 4; ++d) { a.o[d][0] = (f32x4){0.f, 0.f, 0.f, 0.f}; a.o[d][1] = (f32x4){0.f, 0.f, 0.f, 0.f}; }
  a.m[0] = a.m[1] = -1e30f; a.l[0] = a.l[1] = 0.f;
}
template <int NKS>
DI void qk_tile(const u16* Ks, int dofs, const bf16x8 (&qf)[2][NKS], f32x4 (&s)[4][2], int l15, int g) {
#pragma unroll
  for (int kt = 0; kt < 4; ++kt) {
    s[kt][0] = (f32x4){0.f, 0.f, 0.f, 0.f}; s[kt][1] = (f32x4){0.f, 0.f, 0.f, 0.f};
#pragma unroll
    for (int ks = 0; ks < NKS; ++ks) {
      const bf16x8 a = ldfrag(Ks + (kt * 16 + l15) * KLD + dofs + ks * 32 + 8 * g);
      s[kt][0] = mfma16(a, qf[0][ks], s[kt][0]);
      s[kt][1] = mfma16(a, qf[1][ks], s[kt][1]);
    }
  }
}
DI void pv_accum(const bf16x8 (&pf)[2][2], const u16* Vs, f32x4 (&o)[4][2], int l15, int g) {
  const int tq = l15 >> 2, tp = l15 & 3;
#pragma unroll
  for (int kk = 0; kk < 2; ++kk)
#pragma unroll
    for (int d = 0; d < 4; ++d) {
      const bf16x8 vf = cat4(tr_read(Vs + (kk * 32 + 4 * g + tq) * KLD + d * 16 + 4 * tp), tr_read(Vs + (kk * 32 + 16 + 4 * g + tq) * KLD + d * 16 + 4 * tp));
      o[d][0] = mfma16(vf, pf[0][kk], o[d][0]);
      o[d][1] = mfma16(vf, pf[1][kk], o[d][1]);
    }
}
DI void pack_p(const f32x4 (&s)[4][2], bf16x8 (&pf)[2][2]) {
#pragma unroll
  for (int qt = 0; qt < 2; ++qt)
#pragma unroll
    for (int kk = 0; kk < 2; ++kk) {
      u32x4 w;
      w.x = pack2(s[2 * kk][qt][0], s[2 * kk][qt][1]); w.y = pack2(s[2 * kk][qt][2], s[2 * kk][qt][3]);
      w.z = pack2(s[2 * kk + 1][qt][0], s[2 * kk + 1][qt][1]); w.w = pack2(s[2 * kk + 1][qt][2], s[2 * kk + 1][qt][3]);
      pf[qt][kk] = __builtin_bit_cast(bf16x8, w);
    }
}
constexpr float DEFER_THR = 5.f;
template <class VF>
DI void softmax_pv(f32x4 (&s)[4][2], AttnAcc& a, const u16* Vs, float sc, int l15, int g, VF valid) {
  bf16x8 pf[2][2];
  float mxl[2];
#pragma unroll
  for (int qt = 0; qt < 2; ++qt) {
    float mx = -1e30f;
#pragma unroll
    for (int kt = 0; kt < 4; ++kt)
#pragma unroll
      for (int r = 0; r < 4; ++r) { const float v = valid(kt, r, qt) ? s[kt][qt][r] * sc : -1e30f; s[kt][qt][r] = v; mx = fmaxf(mx, v); }
    mxl[qt] = mx;
  }
  if (__any((mxl[0] > a.m[0] + DEFER_THR) || (mxl[1] > a.m[1] + DEFER_THR))) {
#pragma unroll
    for (int qt = 0; qt < 2; ++qt) {
      float mx = mxl[qt];
      mx = fmaxf(mx, __shfl_xor(mx, 16)); mx = fmaxf(mx, __shfl_xor(mx, 32));
      const float mn = fmaxf(a.m[qt], mx), alpha = exp2_(a.m[qt] - mn);
      a.m[qt] = mn; a.l[qt] *= alpha;
#pragma unroll
      for (int d = 0; d < 4; ++d) a.o[d][qt] *= alpha;
    }
  }
#pragma unroll
  for (int qt = 0; qt < 2; ++qt) {
    const float mn = a.m[qt];
    float ls = 0.f;
#pragma unroll
    for (int kt = 0; kt < 4; ++kt)
#pragma unroll
      for (int r = 0; r < 4; ++r) { const float v = s[kt][qt][r]; const float pv = v > -1e29f ? exp2_(v - mn) : 0.f; s[kt][qt][r] = pv; ls += pv; }
    a.l[qt] += ls;
  }
  pack_p(s, pf);
  pv_accum(pf, Vs, a.o, l15, g);
}
DI float group_sum4_(float v) { v += __shfl_xor(v, 16); v += __shfl_xor(v, 32); return v; }
DI bf16x8 scale_frag(bf16x8 f, float sc) {
  u32x4 w = __builtin_bit_cast(u32x4, f);
  w.x = pack2(bflo(w.x) * sc, bfhi(w.x) * sc); w.y = pack2(bflo(w.y) * sc, bfhi(w.y) * sc);
  w.z = pack2(bflo(w.z) * sc, bfhi(w.z) * sc); w.w = pack2(bflo(w.w) * sc, bfhi(w.w) * sc);
  return __builtin_bit_cast(bf16x8, w);
}
DI void attn_init_rel(AttnAcc& a) { attn_init(a); a.m[0] = a.m[1] = 0.f; a.os[0] = (f32x4){0.f, 0.f, 0.f, 0.f}; a.os[1] = (f32x4){0.f, 0.f, 0.f, 0.f}; a.fresh = 1; }
DI void rowsum_accum(const bf16x8 (&pf)[2][2], AttnAcc& a, int l15) {
  const short one = l15 == 0 ? (short)0x3F80 : (short)0;
  const bf16x8 ones = {one, one, one, one, one, one, one, one};
#pragma unroll
  for (int kk = 0; kk < 2; ++kk) { a.os[0] = mfma16(ones, pf[0][kk], a.os[0]); a.os[1] = mfma16(ones, pf[1][kk], a.os[1]); }
}
DI float rel_rowsum(const AttnAcc& a, int qt, int l15) { return __shfl(a.os[qt][0], l15); }
template <int NKS>
DI void qk_tile_rel(const u16* Ks, int dofs, const bf16x8 (&qf)[2][NKS], const AttnAcc& a, f32x4 (&s)[4][2], int l15, int g, bool ok0 = true, bool ok1 = true) {
  const float n0 = ok0 ? -a.m[0] : -1e30f, n1 = ok1 ? -a.m[1] : -1e30f;
#pragma unroll
  for (int kt = 0; kt < 4; ++kt) {
    s[kt][0] = (f32x4){n0, n0, n0, n0}; s[kt][1] = (f32x4){n1, n1, n1, n1};
#pragma unroll
    for (int ks = 0; ks < NKS; ++ks) {
      const bf16x8 k = ldfrag(Ks + (kt * 16 + l15) * KLD + dofs + ks * 32 + 8 * g);
      s[kt][0] = mfma16(k, qf[0][ks], s[kt][0]);
      s[kt][1] = mfma16(k, qf[1][ks], s[kt][1]);
    }
  }
}
template <int MODE, class VF>
DI void softmax_rel(f32x4 (&s)[4][2], AttnAcc& a, bf16x8 (&pf)[2][2], int l15_, VF valid, bool ok0 = true, bool ok1 = true) {
  float mxl[2];
#pragma unroll
  for (int qt = 0; qt < 2; ++qt) {
    float mx = -1e30f;
    const bool okq = qt == 0 ? ok0 : ok1;
#pragma unroll
    for (int kt = 0; kt < 4; ++kt)
#pragma unroll
      for (int r = 0; r < 4; ++r) {
        if (MODE == 1) s[kt][qt][r] = valid(kt, r, qt) ? s[kt][qt][r] : -1e30f;
        if (MODE == 2) s[kt][qt][r] = okq ? s[kt][qt][r] : -1e30f;
        mx = fmaxf(mx, s[kt][qt][r]);
      }
    mxl[qt] = mx;
  }
  if (a.fresh || __any(mxl[0] > DEFER_THR || mxl[1] > DEFER_THR)) {
    bool still = false;
#pragma unroll
    for (int qt = 0; qt < 2; ++qt) {
      float mx = mxl[qt];
      mx = fmaxf(mx, __shfl_xor(mx, 16)); mx = fmaxf(mx, __shfl_xor(mx, 32));
      const bool fresh = rel_rowsum(a, qt, l15_) == 0.f;
      const float dl = mx < -1e29f ? 0.f : (fresh ? mx : fmaxf(mx, 0.f)), alpha = exp2_(-dl);
      still = still || (fresh && mx < -1e29f);
      a.m[qt] += dl; a.os[qt] *= alpha;
#pragma unroll
      for (int d = 0; d < 4; ++d) a.o[d][qt] *= alpha;
#pragma unroll
      for (int kt = 0; kt < 4; ++kt)
#pragma unroll
        for (int r = 0; r < 4; ++r) s[kt][qt][r] -= dl;
    }
    a.fresh = __any(still) ? 1 : 0;
  }
#pragma unroll
  for (int qt = 0; qt < 2; ++qt)
#pragma unroll
    for (int kt = 0; kt < 4; ++kt)
#pragma unroll
      for (int r = 0; r < 4; ++r) s[kt][qt][r] = exp2_(s[kt][qt][r]);
  pack_p(s, pf);
}
DI float group_sum4(float v) { v += __shfl_xor(v, 16); v += __shfl_xor(v, 32); return v; }

constexpr int DSTAGE = 2 * 128 * 64;
DI int fKs(int row) { return (row >> 1) & 7; }
DI int fVs(int row) { return ((row >> 1) & 3) << 1; }
DI void kv_dma128(const u16* kbase, const u16* vbase, int ld, int key0, u16* stage, int tid) {
#pragma unroll
  for (int i = 0; i < 4; ++i) {
    const int id = tid + 256 * i, row = id >> 3, c8 = id & 7;
    __builtin_amdgcn_global_load_lds((const unsigned*)(kbase + (size_t)(key0 + row) * ld + ((c8 ^ fKs(row)) * 8)), (LDSP unsigned*)((LDSP char*)stage + id * 16), 16, 0, 0);
  }
#pragma unroll
  for (int i = 0; i < 4; ++i) {
    const int id = tid + 256 * i, row = id >> 3, c8 = id & 7;
    __builtin_amdgcn_global_load_lds((const unsigned*)(vbase + (size_t)(key0 + row) * ld + ((c8 ^ fVs(row)) * 8)), (LDSP unsigned*)((LDSP char*)(stage + 128 * 64) + id * 16), 16, 0, 0);
  }
}
template <int NKS>
DI void qk_tile_rel_sw(const u16* Kh, int dofs, const bf16x8 (&qf)[2][NKS], const AttnAcc& a, f32x4 (&s)[4][2], int l15, int g) {
  const float n0 = -a.m[0], n1 = -a.m[1];
  const int sw = (l15 >> 1) & 7;
#pragma unroll
  for (int kt = 0; kt < 4; ++kt) {
    s[kt][0] = (f32x4){n0, n0, n0, n0}; s[kt][1] = (f32x4){n1, n1, n1, n1};
#pragma unroll
    for (int ks = 0; ks < NKS; ++ks) {
      const bf16x8 k = ldfrag(Kh + (kt * 16 + l15) * 64 + ((((dofs >> 3) + ks * 4 + g) ^ sw) * 8));
      s[kt][0] = mfma16(k, qf[0][ks], s[kt][0]);
      s[kt][1] = mfma16(k, qf[1][ks], s[kt][1]);
    }
  }
}
DI void pv_accum_sw(const bf16x8 (&pf)[2][2], const u16* Vh, f32x4 (&o)[4][2], int l15, int g) {
  const int tq = l15 >> 2, tp = l15 & 3;
#pragma unroll
  for (int kk = 0; kk < 2; ++kk) {
    const int r0 = kk * 32 + 4 * g + tq, r1 = r0 + 16;
    const int f0 = fVs(r0), f1 = fVs(r1);
#pragma unroll
    for (int d = 0; d < 4; ++d) {
      const int lc = d * 2 + (tp >> 1);
      const bf16x8 vf = cat4(tr_read(Vh + r0 * 64 + ((lc ^ f0) * 8) + (tp & 1) * 4), tr_read(Vh + r1 * 64 + ((lc ^ f1) * 8) + (tp & 1) * 4));
      o[d][0] = mfma16(vf, pf[0][kk], o[d][0]);
      o[d][1] = mfma16(vf, pf[1][kk], o[d][1]);
    }
  }
}
DI void diff_attn_task(const Params& p, int layer, int b, int h, int qb, unsigned char* smem) {
  u16* Ks = (u16*)smem; u16* Vs = Ks + 64 * KLD;
  const int tid = otid(), lane = tid & 63, wid = tid >> 6, l15 = lane & 15, g = lane >> 4;
  const u16* proj = (const u16*)(p.ws + OFF_PROJ) + (size_t)b * SEQ * NP;
  const int q0w = qb * 128 + wid * 32;
  const float* lam = p.diff_lam + layer * 128;
  float s01 = 0.f, s23 = 0.f;
  for (int i = 0; i < 32; ++i) { s01 += lam[i] * lam[32 + i]; s23 += lam[64 + i] * lam[96 + i]; }
  const float lam_init = layer == 0 ? 0.2f : 0.35550906759096324f;
  const float lam_full = sgprf(__expf(s01) - __expf(s23) + lam_init);
  const float sc = 0.17677669529663687f * 1.4426950408889634f;
  const int ntile = 2 * qb + 2;
  const u16* vbase = proj + PB_V + h * 64;
  f32x4 res[4][2];
#pragma unroll 1
  for (int c = 0; c < 2; ++c) {
    const u16* kbase = proj + PB_K + h * 64;
    bf16x8 qf[2][1];
#pragma unroll
    for (int qt = 0; qt < 2; ++qt) qf[qt][0] = scale_frag(ldfrag(proj + (size_t)(q0w + qt * 16 + l15) * NP + PB_Q + h * 64 + c * 32 + 8 * g), sc);
    AttnAcc a; attn_init_rel(a);
    const int nst = qb + 1;
    asm volatile("s_waitcnt vmcnt(0)" ::: "memory");
    lds_barrier();
    kv_dma128(kbase, vbase, NP, 0, Ks, tid);
    asm volatile("s_waitcnt vmcnt(0)" ::: "memory");
    lds_barrier();
    for (int js = 0; js < nst; ++js) {
      const u16* st = Ks + (js & 1) * DSTAGE;
      if (js + 1 < nst) kv_dma128(kbase, vbase, NP, (js + 1) * 128, Ks + ((js + 1) & 1) * DSTAGE, tid);
#pragma unroll 1
      for (int hf = 0; hf < 2; ++hf) {
        const int key0 = js * 128 + hf * 64;
        if (key0 <= q0w + 31) {
          f32x4 s[4][2]; bf16x8 pf[2][2];
          auto valid = [&](int kt, int r, int qt) { return key0 + kt * 16 + 4 * g + r <= q0w + qt * 16 + l15; };
          qk_tile_rel_sw<1>(st + hf * 64 * 64, c * 32, qf, a, s, l15, g);
          if (key0 + 63 <= q0w) softmax_rel<0>(s, a, pf, l15, valid); else softmax_rel<1>(s, a, pf, l15, valid);
          pv_accum_sw(pf, st + 128 * 64 + hf * 64 * 64, a.o, l15, g);
          rowsum_accum(pf, a, l15);
        }
      }
      asm volatile("s_waitcnt vmcnt(0)" ::: "memory");
      lds_barrier();
    }
#pragma unroll
    for (int qt = 0; qt < 2; ++qt) {
      const float lt = rel_rowsum(a, qt, l15);
      const float inv = c == 0 ? 1.f / lt : -lam_full / lt;
#pragma unroll
      for (int d = 0; d < 4; ++d) res[d][qt] = c == 0 ? a.o[d][qt] * inv : res[d][qt] + a.o[d][qt] * inv;
    }
  }
  u16* Y = (u16*)(p.ws + OFF_H);
  const float* ng = p.diff_norm_g + layer * 64;
#pragma unroll
  for (int qt = 0; qt < 2; ++qt) {
    float ss = 0.f;
#pragma unroll
    for (int d = 0; d < 4; ++d) { const f32x4 v = res[d][qt]; ss += v[0] * v[0] + v[1] * v[1] + v[2] * v[2] + v[3] * v[3]; }
    ss = group_sum4(ss);
    const float rn = rsqrtf(ss * (1.f / 64.f) + 1e-6f) * (1.f - lam_init);
    const int t = q0w + qt * 16 + l15;
    const size_t row = (size_t)b * SEQ + t;
#pragma unroll
    for (int d = 0; d < 4; ++d) {
      const int dd = d * 16 + 4 * g;
      const f32x4 v = res[d][qt];
      const u32x2 zz = *(const u32x2*)(proj + (size_t)t * NP + PB_Z + h * 64 + dd);
      const f32x4 gg = *(const f32x4*)(ng + dd);
      u32x2 w;
      w.x = pack2(v[0] * rn * gg[0] * siluf(bflo(zz.x)), v[1] * rn * gg[1] * siluf(bfhi(zz.x)));
      w.y = pack2(v[2] * rn * gg[2] * siluf(bflo(zz.y)), v[3] * rn * gg[3] * siluf(bfhi(zz.y)));
      *(u32x2*)(Y + row * 1024 + Y_B + h * 64 + dd) = w;
    }
  }
}

template <int NKS>
DI void qk_tile1(const u16* Ks, const bf16x8 (&qf)[NKS], f32x4 (&s)[4], int l15, int g) {
#pragma unroll
  for (int kt = 0; kt < 4; ++kt) {
    s[kt] = (f32x4){0.f, 0.f, 0.f, 0.f};
#pragma unroll
    for (int ks = 0; ks < NKS; ++ks) s[kt] = mfma16(ldfrag(Ks + (kt * 16 + l15) * KLD + ks * 32 + 8 * g), qf[ks], s[kt]);
  }
}
DI void pv_accum1(const f32x4 (&s)[4], const u16* Vs, f32x4 (&o)[4], int l15, int g) {
  const int tq = l15 >> 2, tp = l15 & 3;
#pragma unroll
  for (int kk = 0; kk < 2; ++kk) {
    u32x4 w;
    w.x = pack2(s[2 * kk][0], s[2 * kk][1]); w.y = pack2(s[2 * kk][2], s[2 * kk][3]);
    w.z = pack2(s[2 * kk + 1][0], s[2 * kk + 1][1]); w.w = pack2(s[2 * kk + 1][2], s[2 * kk + 1][3]);
    const bf16x8 pf = __builtin_bit_cast(bf16x8, w);
#pragma unroll
    for (int d = 0; d < 4; ++d) {
      const bf16x8 vf = cat4(tr_read(Vs + (kk * 32 + 4 * g + tq) * KLD + d * 16 + 4 * tp), tr_read(Vs + (kk * 32 + 16 + 4 * g + tq) * KLD + d * 16 + 4 * tp));
      o[d] = mfma16(vf, pf, o[d]);
    }
  }
}

constexpr int SEQ_LDS_A = 0, SEQ_LDS_B = 128 * KLD * 2, SEQ_LDS_C = 2 * 128 * KLD * 2, SEQ_LDS_S = 3 * 128 * KLD * 2, SEQ_LDS_F = SEQ_LDS_S + 64 * KLD * 2;
constexpr int SEQ_LDS_HALO = SEQ_LDS_F + 4096;
constexpr int SEQ_LDS_CW = SEQ_LDS_HALO + 2 * 3 * 3 * 64 * 2;
DI float wave_scan_add(float x, int lane) {
#pragma unroll
  for (int o = 1; o < 64; o <<= 1) { const float y = __shfl_up(x, o); if (lane >= o) x += y; }
  return x;
}
DI float wave_scan_max(float x, int lane) {
#pragma unroll
  for (int o = 1; o < 64; o <<= 1) { const float y = __shfl_up(x, o); if (lane >= o) x = fmaxf(x, y); }
  return x;
}

DI void seq_fix_rows(const Params& p, int layer, int r0, int nrows) {
  u16* Y = (u16*)(p.ws + OFF_H);
  const u16* proj = (const u16*)(p.ws + OFF_PROJ);
  const int tid = otid(), lane = tid & 63, wv = tid >> 6;
  const bool ml = lane >= 32;
  const int ch = (lane & 31) * 8;
  const float* ng = ml ? p.ml_norm_g + layer * 64 + (ch & 63) : p.ssm_norm_g + layer * 256 + ch;
  const f32x4 g0 = *(const f32x4*)ng, g1 = *(const f32x4*)(ng + 4);
  for (int rb = wv * 4; rb < nrows; rb += 16) {
    u32x4 yv4[4], zv4[4], ov4[4];
#pragma unroll
    for (int j = 0; j < 4; ++j) {
      const size_t row = (size_t)(r0 + rb + j);
      yv4[j] = *(const u32x4*)(Y + row * 1024 + (ml ? Y_D : Y_C) + ch);
      zv4[j] = *(const u32x4*)(proj + row * NP + (ml ? PD_Z : PC_Z) + ch);
      ov4[j] = ml ? *(const u32x4*)(proj + row * NP + PD_O + ch) : (u32x4){0u, 0u, 0u, 0u};
    }
#pragma unroll
    for (int j = 0; j < 4; ++j) {
      const size_t row = (size_t)(r0 + rb + j);
      u16* yp = Y + row * 1024 + (ml ? Y_D : Y_C) + ch;
      const u32x4 yv = yv4[j], zv = zv4[j], ov = ov4[j];
      float v[8] = {bflo(yv.x), bfhi(yv.x), bflo(yv.y), bfhi(yv.y), bflo(yv.z), bfhi(yv.z), bflo(yv.w), bfhi(yv.w)};
      float z[8] = {bflo(zv.x), bfhi(zv.x), bflo(zv.y), bfhi(zv.y), bflo(zv.z), bfhi(zv.z), bflo(zv.w), bfhi(zv.w)};
      float ss = 0.f;
      if (ml) {
        const float o[8] = {bflo(ov.x), bfhi(ov.x), bflo(ov.y), bfhi(ov.y), bflo(ov.z), bfhi(ov.z), bflo(ov.w), bfhi(ov.w)};
#pragma unroll
        for (int i = 0; i < 8; ++i) { v[i] *= sigmoidf_(o[i]); ss += v[i] * v[i]; }
      } else {
#pragma unroll
        for (int i = 0; i < 8; ++i) { v[i] *= siluf(z[i]); ss += v[i] * v[i]; }
      }
      ss += __shfl_xor(ss, 1); ss += __shfl_xor(ss, 2); ss += __shfl_xor(ss, 4);
      const float ss16 = ss + __shfl_xor(ss, 8);
      const float rn = ml ? rsqrtf(ss * (1.f / 64.f) + 1e-6f) : rsqrtf(ss16 * (1.f / 128.f) + 1e-6f);
      float o8[8];
#pragma unroll
      for (int i = 0; i < 8; ++i) { const float gg = i < 4 ? g0[i & 3] : g1[i & 3]; o8[i] = v[i] * rn * gg * (ml ? siluf(z[i]) : 1.f); }
      u32x4 w; w.x = pack2(o8[0], o8[1]); w.y = pack2(o8[2], o8[3]); w.z = pack2(o8[4], o8[5]); w.w = pack2(o8[6], o8[7]);
      *(u32x4*)yp = w;
    }
  }
}


constexpr int SEQ8_LDS_F = SEQ_LDS_S + 64 * KLD * 2;
constexpr int SEQ8_LDS_HALO = SEQ8_LDS_F + 8192;
constexpr int SEQ8_LDS_CW = SEQ8_LDS_HALO + 2 * 3 * 3 * 64 * 2;
DI void stage_conv_w8(float* wl, const float* cw, const float* cb, int chan0, int nchan, int tid) {
  if (tid < 320) { const int j = tid >> 6, cc = tid & 63; wl[tid] = j < 4 ? cw[j * nchan + chan0 + cc] : cb[chan0 + cc]; }
}
DI void scale_rows8(u16* A, const float* rs, int tid) {
  const int ch = (tid & 7) * 8;
#pragma unroll
  for (int i = 0; i < 2; ++i) {
    const int row = (tid >> 3) + 64 * i;
    const float f = rs[row];
    u32x4 v = *(u32x4*)(A + row * KLD + ch);
    v.x = pack2(bflo(v.x) * f, bfhi(v.x) * f); v.y = pack2(bflo(v.y) * f, bfhi(v.y) * f);
    v.z = pack2(bflo(v.z) * f, bfhi(v.z) * f); v.w = pack2(bflo(v.w) * f, bfhi(v.w) * f);
    *(u32x4*)(A + row * KLD + ch) = v;
  }
}
DI void state_update8(const u16* Xs, const u16* Bs, f32x4 (&acc)[2], int w8, int l15, int g) {
  const int tq = l15 >> 2, tp = l15 & 3, pt = w8 >> 1, nt0 = (w8 & 1) * 2;
#pragma unroll
  for (int kk = 0; kk < 4; ++kk) {
    const bf16x8 af = cat4(tr_read(Xs + (kk * 32 + 4 * g + tq) * KLD + pt * 16 + 4 * tp), tr_read(Xs + (kk * 32 + 16 + 4 * g + tq) * KLD + pt * 16 + 4 * tp));
#pragma unroll
    for (int n = 0; n < 2; ++n) {
      const bf16x8 bfr = cat4(tr_read(Bs + (kk * 32 + 4 * g + tq) * KLD + (nt0 + n) * 16 + 4 * tp), tr_read(Bs + (kk * 32 + 16 + 4 * g + tq) * KLD + (nt0 + n) * 16 + 4 * tp));
      acc[n] = mfma16(af, bfr, acc[n]);
    }
  }
}
DI void state_to_lds8(u16* Ss, const f32x4 (&acc)[2], int w8, int l15, int g) {
  const int pt = w8 >> 1, nt0 = (w8 & 1) * 2;
#pragma unroll
  for (int n = 0; n < 2; ++n)
#pragma unroll
    for (int r = 0; r < 4; ++r) Ss[(pt * 16 + 4 * g + r) * KLD + (nt0 + n) * 16 + l15] = f2bf(acc[n][r]);
}

constexpr int SEQ8_LDS_ZERO = SEQ8_LDS_CW + 3 * 320 * 4;
constexpr int SEQ8_LDS_RAW = ((SEQ8_LDS_ZERO + 3 * 128 + 255) / 256) * 256;
DI void raw_dma8(const u16* projb, int col0, int t0, u16* raw, int tid) {
#pragma unroll
  for (int i = 0; i < 2; ++i) {
    const int chunk = tid + 512 * i;
    __builtin_amdgcn_global_load_lds((const unsigned*)(projb + (size_t)(t0 + (chunk >> 3)) * NP + col0 + (chunk & 7) * 8), (LDSP unsigned*)((LDSP char*)raw + chunk * 16), 16, 0, 0);
  }
}
DI void conv_raw8(const u16* raw, const u16* halo, const float* wl, const float* rowscale, float cscale, u16* dst, int tid) {
  const int q = tid >> 3, ch = (tid & 7) * 8;
  u32x4 v[5];
#pragma unroll
  for (int k = 0; k < 5; ++k) { const int r = 2 * q - 3 + k; v[k] = r >= 0 ? *(const u32x4*)(raw + r * 64 + ch) : *(const u32x4*)(halo + (r + 3) * 64 + ch); }
  float w[5][8];
#pragma unroll
  for (int j = 0; j < 5; ++j) { const f32x4 w0 = *(const f32x4*)(wl + j * 64 + ch), w1 = *(const f32x4*)(wl + j * 64 + ch + 4);
    w[j][0] = w0[0]; w[j][1] = w0[1]; w[j][2] = w0[2]; w[j][3] = w0[3]; w[j][4] = w1[0]; w[j][5] = w1[1]; w[j][6] = w1[2]; w[j][7] = w1[3]; }
#pragma unroll
  for (int o = 0; o < 2; ++o) {
    float acc[8];
#pragma unroll
    for (int i = 0; i < 8; ++i) acc[i] = w[4][i];
#pragma unroll
    for (int j = 0; j < 4; ++j) {
      const u32x4 x = v[o + j];
      acc[0] += w[j][0] * bflo(x.x); acc[1] += w[j][1] * bfhi(x.x); acc[2] += w[j][2] * bflo(x.y); acc[3] += w[j][3] * bfhi(x.y);
      acc[4] += w[j][4] * bflo(x.z); acc[5] += w[j][5] * bfhi(x.z); acc[6] += w[j][6] * bflo(x.w); acc[7] += w[j][7] * bfhi(x.w);
    }
    const float rs = (rowscale ? rowscale[2 * q + o] : 1.f) * cscale;
#pragma unroll
    for (int i = 0; i < 8; ++i) acc[i] = siluf(acc[i]) * rs;
    u32x4 ov; ov.x = pack2(acc[0], acc[1]); ov.y = pack2(acc[2], acc[3]); ov.z = pack2(acc[4], acc[5]); ov.w = pack2(acc[6], acc[7]);
    *(u32x4*)(dst + (2 * q + o) * KLD + ch) = ov;
  }
}
DI void save_halo8(const u16* raw, u16* halo, int tid) {
  if (tid < 72) { const int arr = tid / 24, rem = tid % 24; *(u32x4*)(halo + arr * 192 + rem * 8) = *(const u32x4*)(raw + arr * 8192 + 125 * 64 + rem * 8); }
}

DI void ssd_task8(const Params& p, int layer, int b, int h, unsigned char* smem) {
  u16* Cs = (u16*)(smem + SEQ_LDS_A); u16* Bs = (u16*)(smem + SEQ_LDS_B); u16* Xs = (u16*)(smem + SEQ_LDS_C); u16* Ss = (u16*)(smem + SEQ_LDS_S);
  float* fl = (float*)(smem + SEQ8_LDS_F);
  float* dts = fl; float* acs = fl + 128; float* wend = fl + 256; float* tmp = fl + 384;
  u16* halo = (u16*)(smem + SEQ8_LDS_HALO); float* cwl = (float*)(smem + SEQ8_LDS_CW); u16* zero3 = (u16*)(smem + SEQ8_LDS_ZERO);
  u16* raw = (u16*)(smem + SEQ8_LDS_RAW);
  int tid = otid512(), lane = tid & 63, w = tid >> 6, l15 = lane & 15, g = lane >> 4;
  const int gi = h >> 1;
  const u16* projb = (const u16*)(p.ws + OFF_PROJ) + (size_t)b * SEQ * NP;
  const float* smb = (const float*)(p.ws + OFF_SMALL) + (size_t)b * SEQ * NSMALL;
  const float* cw = p.ssm_conv_w + layer * 4 * 512; const float* cb = p.ssm_conv_b + layer * 512;
  u16* Y = (u16*)(p.ws + OFF_H);
  const float a_h = sgprf(-__expf(p.ssm_a_log[layer * 4 + h])), d_h = sgprf(p.ssm_d[layer * 4 + h]), dtb = sgprf(p.ssm_dt_bias[layer * 4 + h]);
  const int colB = PC_XBC + 256 + gi * 64, colC = PC_XBC + 384 + gi * 64, colX = PC_XBC + h * 64;
  f32x4 st[2] = {(f32x4){0.f, 0.f, 0.f, 0.f}, (f32x4){0.f, 0.f, 0.f, 0.f}};
  lds_barrier();
  stage_conv_w8(cwl, cw, cb, 256 + gi * 64, 512, tid);
  stage_conv_w8(cwl + 320, cw, cb, 384 + gi * 64, 512, tid);
  stage_conv_w8(cwl + 640, cw, cb, h * 64, 512, tid);
  if (tid < 96) ((unsigned*)zero3)[tid] = 0u;
  raw_dma8(projb, colB, 0, raw, tid); raw_dma8(projb, colC, 0, raw + 8192, tid); raw_dma8(projb, colX, 0, raw + 16384, tid);
  float dtraw = 0.f;
  if (tid < 128) dtraw = smb[(size_t)tid * NSMALL + SM_DT + h];
#pragma unroll 1
  for (int c = 0; c < 32; ++c) {
    const int t0 = c * 128;
    asm volatile("" : "+v"(tid)); lane = tid & 63; w = tid >> 6; l15 = lane & 15; g = lane >> 4;
    float dtv = 0.f;
    if (tid < 128) { const float xr = dtraw + dtb; dtv = xr > 15.f ? xr : (xr < -15.f ? __expf(xr) : __logf(1.f + __expf(xr))); }
    float cs = wave_scan_add(dtv * a_h, lane);
    if (tid == 63) tmp[0] = cs;
    asm volatile("s_waitcnt vmcnt(0)" ::: "memory");
    lds_barrier();
    if (w == 1) cs += tmp[0];
    if (tid < 128) { dts[tid] = dtv; acs[tid] = cs; }
    if (c + 1 < 32 && tid < 128) dtraw = smb[(size_t)(t0 + 128 + tid) * NSMALL + SM_DT + h];
    lds_barrier();
    {
      const u16* hc = halo + (c & 1) * 576;
      const u16* hB = c == 0 ? zero3 : hc; const u16* hC = c == 0 ? zero3 : hc + 192; const u16* hX = c == 0 ? zero3 : hc + 384;
      conv_raw8(raw, hB, cwl, nullptr, 1.f, Bs, tid);
      conv_raw8(raw + 8192, hC, cwl + 320, nullptr, 1.f, Cs, tid);
      conv_raw8(raw + 16384, hX, cwl + 640, dts, 1.f, Xs, tid);
      save_halo8(raw, halo + ((c + 1) & 1) * 576, tid);
    }
    if (tid < 128) wend[tid] = __expf(acs[127] - acs[tid]);
    state_to_lds8(Ss, st, w, l15, g);
    lds_barrier();
    if (c + 1 < 32) { raw_dma8(projb, colB, t0 + 128, raw, tid); raw_dma8(projb, colC, t0 + 128, raw + 8192, tid); raw_dma8(projb, colX, t0 + 128, raw + 16384, tid); }
    {
      const int tl = 16 * w + l15;
      bf16x8 cf[2];
#pragma unroll
      for (int ks = 0; ks < 2; ++ks) cf[ks] = ldfrag(Cs + tl * KLD + ks * 32 + 8 * g);
      f32x4 y[4];
#pragma unroll
      for (int d = 0; d < 4; ++d) y[d] = (f32x4){0.f, 0.f, 0.f, 0.f};
      const float at = acs[tl];
#pragma unroll 1
      for (int stl = 0; stl < 2; ++stl) {
        if (stl * 64 <= 16 * w + 15) {
          f32x4 sc[4];
          qk_tile1<2>(Bs + stl * 64 * KLD, cf, sc, l15, g);
#pragma unroll
          for (int kt = 0; kt < 4; ++kt) {
            const f32x4 as = *(const f32x4*)(acs + stl * 64 + kt * 16 + 4 * g);
#pragma unroll
            for (int r = 0; r < 4; ++r) {
              const bool ok = stl * 64 + kt * 16 + 4 * g + r <= tl;
              sc[kt][r] = ok ? sc[kt][r] * __expf(at - as[r]) : 0.f;
            }
          }
          pv_accum1(sc, Xs + stl * 64 * KLD, y, l15, g);
        }
      }
      const float ea = __expf(at), dsk = d_h / dts[tl];
      const size_t row = (size_t)b * SEQ + t0 + tl;
#pragma unroll
      for (int d = 0; d < 4; ++d) {
        f32x4 yo = (f32x4){0.f, 0.f, 0.f, 0.f};
#pragma unroll
        for (int ks = 0; ks < 2; ++ks) yo = mfma16(ldfrag(Ss + (d * 16 + l15) * KLD + ks * 32 + 8 * g), cf[ks], yo);
        const u32x2 xv = *(const u32x2*)(Xs + tl * KLD + d * 16 + 4 * g);
        const f32x4 v = y[d] + yo * ea;
        u32x2 o; o.x = pack2(v[0] + dsk * bflo(xv.x), v[1] + dsk * bfhi(xv.x)); o.y = pack2(v[2] + dsk * bflo(xv.y), v[3] + dsk * bfhi(xv.y));
        *(u32x2*)(Y + row * 1024 + Y_C + h * 64 + d * 16 + 4 * g) = o;
      }
    }
    lds_barrier();
    scale_rows8(Xs, wend, tid);
    lds_barrier();
    const float cd = __expf(acs[127]);
    st[0] *= cd; st[1] *= cd;
    state_update8(Xs, Bs, st, w, l15, g);
  }
  asm volatile("s_waitcnt vmcnt(0)" ::: "memory");
}

DI void mlstm_task8(const Params& p, int layer, int b, int h, unsigned char* smem) {
  u16* Qs = (u16*)(smem + SEQ_LDS_A); u16* Ks2 = (u16*)(smem + SEQ_LDS_B); u16* Vs2 = (u16*)(smem + SEQ_LDS_C); u16* Cst = (u16*)(smem + SEQ_LDS_S);
  float* fl = (float*)(smem + SEQ8_LDS_F);
  float* bcs = fl; float* us = fl + 128; float* pms = fl + 256; float* wend = fl + 384; float* nst = fl + 512; float* tmp = fl + 576; float* npart = fl + 640;
  u16* halo = (u16*)(smem + SEQ8_LDS_HALO); float* cwl = (float*)(smem + SEQ8_LDS_CW); u16* zero3 = (u16*)(smem + SEQ8_LDS_ZERO);
  u16* raw = (u16*)(smem + SEQ8_LDS_RAW);
  int tid = otid512(), lane = tid & 63, w = tid >> 6, l15 = lane & 15, g = lane >> 4;
  const u16* projb = (const u16*)(p.ws + OFF_PROJ) + (size_t)b * SEQ * NP;
  const float* smb = (const float*)(p.ws + OFF_SMALL) + (size_t)b * SEQ * NSMALL;
  const float* cw = p.ml_conv_w + layer * 4 * 512; const float* cb = p.ml_conv_b + layer * 512;
  const float ib = sgprf(p.ml_if_b[layer * 8 + h]), fb = sgprf(p.ml_if_b[layer * 8 + 4 + h]);
  u16* Y = (u16*)(p.ws + OFF_H);
  const int colQ = PD_QK + h * 64, colK = PD_QK + 256 + h * 64, colV = PD_V + h * 64;
  f32x4 st[2] = {(f32x4){0.f, 0.f, 0.f, 0.f}, (f32x4){0.f, 0.f, 0.f, 0.f}};
  float m_prev = 0.f;
  lds_barrier();
  if (tid < 64) nst[tid] = 0.f;
  stage_conv_w8(cwl, cw, cb, h * 64, 512, tid);
  stage_conv_w8(cwl + 320, cw, cb, 256 + h * 64, 512, tid);
  if (tid < 96) ((unsigned*)zero3)[tid] = 0u;
  raw_dma8(projb, colQ, 0, raw, tid); raw_dma8(projb, colK, 0, raw + 8192, tid); raw_dma8(projb, colV, 0, raw + 16384, tid);
  float iraw = 0.f, fraw = 0.f;
  if (tid < 128) { iraw = smb[(size_t)tid * NSMALL + SM_IF + h]; fraw = smb[(size_t)tid * NSMALL + SM_IF + 4 + h]; }
#pragma unroll 1
  for (int c = 0; c < 32; ++c) {
    const int t0 = c * 128;
    asm volatile("" : "+v"(tid)); lane = tid & 63; w = tid >> 6; l15 = lane & 15; g = lane >> 4;
    float ip = 0.f, lf = 0.f;
    if (tid < 128) { ip = iraw + ib; const float fp = fraw + fb; lf = fminf(fp, 0.f) - __logf(1.f + __expf(-fabsf(fp))); }
    float bc = wave_scan_add(lf, lane);
    if (tid == 63) tmp[0] = bc;
    asm volatile("s_waitcnt vmcnt(0)" ::: "memory");
    lds_barrier();
    if (w == 1) bc += tmp[0];
    const float u = tid < 128 ? ip - bc : -1e30f;
    float pm = wave_scan_max(u, lane);
    if (tid == 63) tmp[1] = pm;
    if (c + 1 < 32 && tid < 128) { iraw = smb[(size_t)(t0 + 128 + tid) * NSMALL + SM_IF + h]; fraw = smb[(size_t)(t0 + 128 + tid) * NSMALL + SM_IF + 4 + h]; }
    {
      const u16* hc = halo + (c & 1) * 576;
      const u16* hQ = c == 0 ? zero3 : hc; const u16* hK = c == 0 ? zero3 : hc + 192;
      conv_raw8(raw, hQ, cwl, nullptr, 1.f, Qs, tid);
      conv_raw8(raw + 8192, hK, cwl + 320, nullptr, 0.125f, Ks2, tid);
      save_halo8(raw, halo + ((c + 1) & 1) * 576, tid);
#pragma unroll
      for (int i = 0; i < 2; ++i) { const int chunk = tid + 512 * i; *(u32x4*)(Vs2 + (chunk >> 3) * KLD + (chunk & 7) * 8) = *(const u32x4*)(raw + 16384 + chunk * 8); }
    }
    state_to_lds8(Cst, st, w, l15, g);
    lds_barrier();
    if (w == 1) pm = fmaxf(pm, tmp[1]);
    if (tid < 128) { bcs[tid] = bc; us[tid] = u; pms[tid] = pm; }
    if (c + 1 < 32) { raw_dma8(projb, colQ, t0 + 128, raw, tid); raw_dma8(projb, colK, t0 + 128, raw + 8192, tid); raw_dma8(projb, colV, t0 + 128, raw + 16384, tid); }
    lds_barrier();
    const float blast = bcs[127];
    const float m_new = blast + fmaxf(m_prev, pms[127]);
    if (tid < 128) wend[tid] = __expf(blast - m_new + us[tid]);
    {
      const int tl = 16 * w + l15;
      bf16x8 qf[2];
#pragma unroll
      for (int ks = 0; ks < 2; ++ks) qf[ks] = ldfrag(Qs + tl * KLD + ks * 32 + 8 * g);
      f32x4 num[4];
#pragma unroll
      for (int d = 0; d < 4; ++d) num[d] = (f32x4){0.f, 0.f, 0.f, 0.f};
      const float bt = bcs[tl], mt = bt + fmaxf(m_prev, pms[tl]);
      float den = 0.f;
#pragma unroll 1
      for (int stl = 0; stl < 2; ++stl) {
        if (stl * 64 <= 16 * w + 15) {
          f32x4 sc[4];
          qk_tile1<2>(Ks2 + stl * 64 * KLD, qf, sc, l15, g);
#pragma unroll
          for (int kt = 0; kt < 4; ++kt) {
            const f32x4 uu = *(const f32x4*)(us + stl * 64 + kt * 16 + 4 * g);
#pragma unroll
            for (int r = 0; r < 4; ++r) {
              const bool ok = stl * 64 + kt * 16 + 4 * g + r <= tl;
              const float v = ok ? sc[kt][r] * __expf(bt - mt + uu[r]) : 0.f;
              sc[kt][r] = v; den += v;
            }
          }
          pv_accum1(sc, Vs2 + stl * 64 * KLD, num, l15, g);
        }
      }
      const float wi = __expf(bt + m_prev - mt);
      float qn = 0.f;
#pragma unroll
      for (int ks = 0; ks < 2; ++ks)
#pragma unroll
        for (int j = 0; j < 8; ++j) qn += bf2f((u16)qf[ks][j]) * nst[ks * 32 + 8 * g + j];
      qn = group_sum4(qn);
      const float dn = group_sum4(den) + wi * qn;
      const float inv = __builtin_amdgcn_rcpf(fmaxf(fabsf(dn), __expf(-mt)));
      const size_t row = (size_t)b * SEQ + t0 + tl;
#pragma unroll
      for (int d = 0; d < 4; ++d) {
        f32x4 ni = (f32x4){0.f, 0.f, 0.f, 0.f};
#pragma unroll
        for (int ks = 0; ks < 2; ++ks) ni = mfma16(ldfrag(Cst + (d * 16 + l15) * KLD + ks * 32 + 8 * g), qf[ks], ni);
        const f32x4 v = (num[d] + ni * wi) * inv;
        u32x2 o; o.x = pack2(v[0], v[1]); o.y = pack2(v[2], v[3]);
        *(u32x2*)(Y + row * 1024 + Y_D + h * 64 + d * 16 + 4 * g) = o;
      }
    }
    lds_barrier();
    scale_rows8(Ks2, wend, tid);
    lds_barrier();
    const float fprev = __expf(blast + m_prev - m_new);
    st[0] *= fprev; st[1] *= fprev;
    state_update8(Vs2, Ks2, st, w, l15, g);
    {
      const int e = tid & 63, part = tid >> 6;
      float a = 0.f;
#pragma unroll
      for (int s2 = 0; s2 < 16; ++s2) a += bf2f(Ks2[(part * 16 + s2) * KLD + e]);
      npart[part * 64 + e] = a;
    }
    lds_barrier();
    if (tid < 64) {
      float a = nst[tid] * fprev;
#pragma unroll
      for (int pp = 0; pp < 8; ++pp) a += npart[pp * 64 + tid];
      nst[tid] = a;
    }
    m_prev = m_new;
  }
  asm volatile("s_waitcnt vmcnt(0)" ::: "memory");
}

DI void compress_task(const Params& p, int layer, int b, int kv, int rb, unsigned char* smem) {
  constexpr int HLD = 136;
  u16* Hs = (u16*)smem;
  const int tid = otid(), lane = tid & 63, w = tid >> 6, l15 = lane & 15, g = lane >> 4;
  const u16* projb = (const u16*)(p.ws + OFF_PROJ) + (size_t)b * SEQ * NP + (kv ? PA_VC : PA_KC);
  const int mi = layer * 2 + kv;
  const u16* W1T = (const u16*)(p.ws + OFF_W1T) + (size_t)mi * 128 * 2048;
  const u16* W2T = (const u16*)(p.ws + OFF_W2T) + (size_t)mi * 64 * 128;
  const float* bias1 = (const float*)(p.ws + OFF_BIAS1) + mi * 16 * 128;
  f32x4 acc[2][2];
#pragma unroll
  for (int nt = 0; nt < 2; ++nt) { acc[nt][0] = (f32x4){0.f, 0.f, 0.f, 0.f}; acc[nt][1] = (f32x4){0.f, 0.f, 0.f, 0.f}; }
  int tok[2];
#pragma unroll
  for (int mt = 0; mt < 2; ++mt) { int i = rb * 32 + mt * 16 + l15; if (i > 254) i = 254; tok[mt] = 16 * i; }
#pragma unroll 4
  for (int ks = 0; ks < 64; ++ks) {
    const int j = ks >> 1, d0 = (ks & 1) * 32;
    bf16x8 af[2], wf[2];
#pragma unroll
    for (int mt = 0; mt < 2; ++mt) af[mt] = ldfrag(projb + (size_t)(tok[mt] + j) * NP + d0 + 8 * g);
#pragma unroll
    for (int nt = 0; nt < 2; ++nt) wf[nt] = ldfrag(W1T + (size_t)(w * 32 + nt * 16 + l15) * 2048 + ks * 32 + 8 * g);
#pragma unroll
    for (int nt = 0; nt < 2; ++nt)
#pragma unroll
      for (int mt = 0; mt < 2; ++mt) acc[nt][mt] = mfma16(wf[nt], af[mt], acc[nt][mt]);
  }
  lds_barrier();
#pragma unroll
  for (int nt = 0; nt < 2; ++nt) {
    const int n = w * 32 + nt * 16 + 4 * g;
    f32x4 bb = *(const f32x4*)(bias1 + n);
#pragma unroll
    for (int pc = 1; pc < 16; ++pc) bb += *(const f32x4*)(bias1 + pc * 128 + n);
#pragma unroll
    for (int mt = 0; mt < 2; ++mt) {
      const f32x4 v = acc[nt][mt] + bb;
      u32x2 o; o.x = pack2(siluf(v[0]), siluf(v[1])); o.y = pack2(siluf(v[2]), siluf(v[3]));
      *(u32x2*)(Hs + (mt * 16 + l15) * HLD + n) = o;
    }
  }
  lds_barrier();
  f32x4 acc2[2] = {(f32x4){0.f, 0.f, 0.f, 0.f}, (f32x4){0.f, 0.f, 0.f, 0.f}};
#pragma unroll
  for (int ks = 0; ks < 4; ++ks) {
    const bf16x8 wf = ldfrag(W2T + (size_t)(w * 16 + l15) * 128 + ks * 32 + 8 * g);
#pragma unroll
    for (int mt = 0; mt < 2; ++mt) acc2[mt] = mfma16(wf, ldfrag(Hs + (mt * 16 + l15) * HLD + ks * 32 + 8 * g), acc2[mt]);
  }
  u16* dst = (u16*)(p.ws + (kv ? OFF_VCMP : OFF_KCMP) + (size_t)layer * 512 * 1024) + (size_t)b * 256 * 64;
#pragma unroll
  for (int mt = 0; mt < 2; ++mt) {
    const int i = rb * 32 + mt * 16 + l15;
    u32x2 o; o.x = pack2(acc2[mt][0], acc2[mt][1]); o.y = pack2(acc2[mt][2], acc2[mt][3]);
    if (i > 254) { o.x = 0u; o.y = 0u; }
    *(u32x2*)(dst + (size_t)i * 64 + w * 16 + 4 * g) = o;
  }
}

DI void nsa_task(const Params& p, int layer, int b, int qi, unsigned char* smem) {
  u16* Ks = (u16*)smem; u16* Vs = Ks + 64 * KLD;
  float* T = (float*)(smem + 2 * KVBUF * 2);
  unsigned long long* selm = (unsigned long long*)(smem + 2 * KVBUF * 2 + 4 * 32 * 65 * 4);
  const int tid = otid(), lane = tid & 63, h = tid >> 6, l15 = lane & 15, g = lane >> 4;
  const int q0 = qi * 32;
  const u16* projb = (const u16*)(p.ws + OFF_PROJ) + (size_t)b * SEQ * NP;
  const float* smb = (const float*)(p.ws + OFF_SMALL) + (size_t)b * SEQ * NSMALL;
  const u16* kcmp = (const u16*)(p.ws + OFF_KCMP + (size_t)layer * 512 * 1024) + (size_t)b * 256 * 64;
  const u16* vcmp = (const u16*)(p.ws + OFF_VCMP + (size_t)layer * 512 * 1024) + (size_t)b * 256 * 64;
  bf16x8 qf[2][2];
#pragma unroll
  for (int qt = 0; qt < 2; ++qt)
#pragma unroll
    for (int ks = 0; ks < 2; ++ks) qf[qt][ks] = ldfrag(projb + (size_t)(q0 + qt * 16 + l15) * NP + PA_Q + h * 64 + ks * 32 + 8 * g);
  const float sc = 0.125f * 1.4426950408889634f;
  f32x4 outacc[4][2];
  AttnAcc a;
  const int ntc = (q0 >> 10) + 1;
  attn_init(a);
  lds_barrier();
  for (int i = tid; i < 4 * 32 * 65; i += 256) T[i] = 0.f;
  kv_pipeline(0, ntc, Ks,
    [&](int) { return true; },
    [&](int j, KVRegs& kr) { kv_load(kcmp, vcmp, 64, 64, j * 64, kr); },
    [&](int j, const u16* Kt, const u16* Vt) {
      f32x4 s[4][2];
      auto valid = [&](int kt, int r, int qt) { return 16 * (j * 64 + kt * 16 + 4 * g + r) + 31 <= q0 + qt * 16 + l15; };
      qk_tile<2>(Kt, 0, qf, s, l15, g);
      softmax_pv(s, a, Vt, sc, l15, g, valid);
    });
  float cinv[2];
#pragma unroll
  for (int qt = 0; qt < 2; ++qt) {
    const float lt = group_sum4(a.l[qt]);
    cinv[qt] = lt > 0.f ? 1.f / lt : 0.f;
    const float gt = sigmoidf_(smb[(size_t)(q0 + qt * 16 + l15) * NSMALL + SM_G + h * 3 + 0]) * cinv[qt];
#pragma unroll
    for (int d = 0; d < 4; ++d) outacc[d][qt] = a.o[d][qt] * gt;
  }
  float carry[2] = {0.f, 0.f};
  kv_pipeline(0, ntc, Ks,
    [&](int) { return true; },
    [&](int j, KVRegs& kr) { kv_load(kcmp, vcmp, 64, 64, j * 64, kr); },
    [&](int j, const u16* Kt, const u16*) {
      f32x4 s[4][2];
      qk_tile<2>(Kt, 0, qf, s, l15, g);
#pragma unroll
      for (int qt = 0; qt < 2; ++qt) {
        float prev3 = carry[qt];
#pragma unroll
        for (int kt = 0; kt < 4; ++kt) {
          float pr[4];
#pragma unroll
          for (int r = 0; r < 4; ++r) {
            const bool ok = 16 * (j * 64 + kt * 16 + 4 * g + r) + 31 <= q0 + qt * 16 + l15;
            pr[r] = ok ? exp2_(s[kt][qt][r] * sc - a.m[qt]) * cinv[qt] : 0.f;
          }
          const float below = __shfl_up(pr[3], 16);
          const float wrap = __shfl(prev3, l15 + 48);
          const float nb = g > 0 ? below : wrap;
          T[(h * 32 + qt * 16 + l15) * 65 + j * 16 + kt * 4 + g] = (pr[0] + pr[1]) + (pr[2] + 0.5f * pr[3]) + 0.5f * nb;
          prev3 = pr[3];
        }
        carry[qt] = prev3;
      }
    });
  lds_barrier();
#pragma unroll 1
  for (int qq = 0; qq < 8; ++qq) {
    const int q = h * 8 + qq, t = q0 + q, cur = t >> 6;
    const float imp = ((T[(0 * 32 + q) * 65 + lane] + T[(1 * 32 + q) * 65 + lane]) + T[(2 * 32 + q) * 65 + lane]) + T[(3 * 32 + q) * 65 + lane];
    const bool forced = lane == cur || lane == 0, allowed = lane <= cur, cand = allowed && !forced;
    const int K = cur == 0 ? 15 : 14;
    unsigned long long m;
    if (__popcll(__ballot(cand)) <= K) m = __ballot(allowed);
    else {
      const unsigned key = __float_as_uint(imp);
      unsigned prefix = 0u;
#pragma unroll 1
      for (int bit = 30; bit >= 0; --bit) {
        const unsigned cnd = prefix | (1u << bit);
        if (__popcll(__ballot(cand && key >= cnd)) >= K) prefix = cnd;
      }
      const unsigned long long gt = __ballot(cand && key > prefix), eq = __ballot(cand && key == prefix);
      const int need = K - __popcll(gt);
      const int myrank = __popcll(eq & ((1ull << lane) - 1ull));
      m = gt | __ballot(cand && key == prefix && myrank < need) | __ballot(forced);
    }
    if (lane == 0) selm[q] = m;
  }
  lds_barrier();
  f32x4* park = (f32x4*)T + (h * 8) * 64 + lane;
#pragma unroll
  for (int d = 0; d < 4; ++d) { park[(d * 2 + 0) * 64] = outacc[d][0]; park[(d * 2 + 1) * 64] = outacc[d][1]; }
  unsigned long long mq[2], anym = 0ull;
#pragma unroll
  for (int qt = 0; qt < 2; ++qt) mq[qt] = selm[qt * 16 + l15];
  for (int i = 0; i < 32; ++i) anym |= selm[i];
  const int jhi = (q0 + 31) >> 6;
#pragma unroll
  for (int qt = 0; qt < 2; ++qt)
#pragma unroll
    for (int ks = 0; ks < 2; ++ks) qf[qt][ks] = scale_frag(qf[qt][ks], sc);
  attn_init_rel(a);
  kv_pipeline(0, jhi + 1, Ks,
    [&](int j) { return (bool)((anym >> j) & 1ull); },
    [&](int j, KVRegs& kr) { kv_load(projb + PA_KS, projb + PA_VS, NP, NP, j * 64, kr); },
    [&](int j, const u16* Kt, const u16* Vt) {
      f32x4 s[4][2];
      auto valid = [&](int kt, int r, int qt) { return ((mq[qt] >> j) & 1ull) && (j * 64 + kt * 16 + 4 * g + r <= q0 + qt * 16 + l15); };
      bf16x8 pf[2][2];
      if (j * 64 + 63 <= q0) {
        qk_tile_rel<2>(Kt, 0, qf, a, s, l15, g, (bool)((mq[0] >> j) & 1ull), (bool)((mq[1] >> j) & 1ull));
        softmax_rel<0>(s, a, pf, l15, valid);
      } else {
        qk_tile_rel<2>(Kt, 0, qf, a, s, l15, g);
        softmax_rel<1>(s, a, pf, l15, valid);
      }
      pv_accum(pf, Vt, a.o, l15, g);
      rowsum_accum(pf, a, l15);
    });
#pragma unroll
  for (int qt = 0; qt < 2; ++qt) {
    const float lt = rel_rowsum(a, qt, l15);
    const float gt = sigmoidf_(smb[(size_t)(q0 + qt * 16 + l15) * NSMALL + SM_G + h * 3 + 1]) * (lt > 0.f ? 1.f / lt : 0.f);
#pragma unroll
    for (int d = 0; d < 4; ++d) park[(d * 2 + qt) * 64] += a.o[d][qt] * gt;
  }
  attn_init_rel(a);
  const int jlo = q0 >= 511 ? (q0 - 511) >> 6 : 0;
  kv_pipeline(jlo, jhi + 1, Ks,
    [&](int) { return true; },
    [&](int j, KVRegs& kr) { kv_load(projb + PA_KW, projb + PA_VW, NP, NP, j * 64, kr); },
    [&](int j, const u16* Kt, const u16* Vt) {
      f32x4 s[4][2];
      auto valid = [&](int kt, int r, int qt) { const int key = j * 64 + kt * 16 + 4 * g + r, t = q0 + qt * 16 + l15; return key <= t && key + 512 > t; };
      bf16x8 pf[2][2];
      qk_tile_rel<2>(Kt, 0, qf, a, s, l15, g);
      if (j * 64 + 63 <= q0 && j * 64 + 512 > q0 + 31) softmax_rel<0>(s, a, pf, l15, valid);
      else softmax_rel<1>(s, a, pf, l15, valid);
      pv_accum(pf, Vt, a.o, l15, g);
      rowsum_accum(pf, a, l15);
    });
  u16* Y = (u16*)(p.ws + OFF_H);
  const float* ng = p.nsa_norm_g + layer * 64;
#pragma unroll
  for (int qt = 0; qt < 2; ++qt) {
    const int t = q0 + qt * 16 + l15;
    const float lt = rel_rowsum(a, qt, l15);
    const float gt = sigmoidf_(smb[(size_t)t * NSMALL + SM_G + h * 3 + 2]) * (lt > 0.f ? 1.f / lt : 0.f);
    f32x4 v[4]; float ss = 0.f;
#pragma unroll
    for (int d = 0; d < 4; ++d) { v[d] = park[(d * 2 + qt) * 64] + a.o[d][qt] * gt; ss += v[d][0] * v[d][0] + v[d][1] * v[d][1] + v[d][2] * v[d][2] + v[d][3] * v[d][3]; }
    ss = group_sum4(ss);
    const float rn = rsqrtf(ss * (1.f / 64.f) + 1e-6f);
    const size_t row = (size_t)b * SEQ + t;
#pragma unroll
    for (int d = 0; d < 4; ++d) {
      const int dd = d * 16 + 4 * g;
      const u32x2 zz = *(const u32x2*)(projb + (size_t)t * NP + PA_Z + h * 64 + dd);
      const f32x4 gg = *(const f32x4*)(ng + dd);
      u32x2 o;
      o.x = pack2(v[d][0] * rn * gg[0] * siluf(bflo(zz.x)), v[d][1] * rn * gg[1] * siluf(bfhi(zz.x)));
      o.y = pack2(v[d][2] * rn * gg[2] * siluf(bflo(zz.y)), v[d][3] * rn * gg[3] * siluf(bfhi(zz.y)));
      *(u32x2*)(Y + row * 1024 + Y_A + h * 64 + dd) = o;
    }
  }
}


DI void final_norm_rows(const Params& p, int gw, int nw, int lane) {
  const float4* gp = (const float4*)p.final_g;
  float4 gg[4];
#pragma unroll
  for (int i = 0; i < 4; ++i) gg[i] = gp[lane + 64 * i];
  for (int row0 = gw * 4; row0 < NTOK; row0 += nw * 4) {
    float4 v[4][4]; float ss[4];
#pragma unroll
    for (int j = 0; j < 4; ++j) {
      const float4* xr = (const float4*)(p.out + (size_t)(row0 + j) * D_MODEL);
#pragma unroll
      for (int i = 0; i < 4; ++i) v[j][i] = xr[lane + 64 * i];
    }
#pragma unroll
    for (int j = 0; j < 4; ++j) {
      float a = 0.f;
#pragma unroll
      for (int i = 0; i < 4; ++i) a += v[j][i].x * v[j][i].x + v[j][i].y * v[j][i].y + v[j][i].z * v[j][i].z + v[j][i].w * v[j][i].w;
      ss[j] = wave_sum(a);
    }
#pragma unroll
    for (int j = 0; j < 4; ++j) {
      float4* xr = (float4*)(p.out + (size_t)(row0 + j) * D_MODEL);
      const float r = rsqrtf(ss[j] * (1.f / D_MODEL) + 1e-6f);
#pragma unroll
      for (int i = 0; i < 4; ++i) { float4 w; w.x = v[j][i].x * r * gg[i].x; w.y = v[j][i].y * r * gg[i].y; w.z = v[j][i].z * r * gg[i].z; w.w = v[j][i].w * r * gg[i].w; xr[lane + 64 * i] = w; }
    }
  }
}

#define XB_TMO      128
#define XB_XCNT(j)  (256  + 64 * (j))
#define XB_XSUB(j)  (1280 + 64 * (j))
#define XB_XGEN(j)  (2304 + 64 * (j))
#define XB_TOP      3328
#define XB_TOPGEN   3392
#define XCD_BAR_WORDS 3456
#define XB_SPIN_CAP (1u << 23)
DI unsigned xb_ld(unsigned* p)              { return __hip_atomic_load(p, __ATOMIC_RELAXED, __HIP_MEMORY_SCOPE_AGENT); }
DI unsigned xb_add(unsigned* p, unsigned v) { return __hip_atomic_fetch_add(p, v, __ATOMIC_RELAXED, __HIP_MEMORY_SCOPE_AGENT); }
DI unsigned xb_xcc_id() { return (unsigned)__builtin_amdgcn_s_getreg((3 << 11) | 20) & 0xFu; }
#define XB_SPIN(cond, bar) do { unsigned _sp = 0; while (cond) { __builtin_amdgcn_s_sleep(1); \
    if ((++_sp & 255u) == 0u) { if (xb_ld(&(bar)[XB_TMO])) break; if (_sp > XB_SPIN_CAP) { atomicAdd(&(bar)[XB_TMO], 1u); break; } } } } while (0)
struct XcdBarrier { unsigned* bar; unsigned x; volatile LDSP unsigned* st; };
DI XcdBarrier xcd_barrier_post(unsigned* bar, volatile LDSP unsigned* st) {
  XcdBarrier b; b.bar = bar; b.x = xb_xcc_id(); b.st = st;
  if (threadIdx.x == 0) (void)xb_add(&bar[XB_XCNT(b.x)], 1u);
  return b;
}
DI void xcd_barrier_complete(unsigned* bar, unsigned x, unsigned& nloc, unsigned& nx) {
  const unsigned G = gridDim.x * gridDim.y * gridDim.z;
  unsigned sum, cnt, mine, sp = 0u;
  for (;;) {
    sum = 0u; cnt = 0u; mine = 0u;
#pragma unroll
    for (unsigned j = 0; j < 16; ++j) { const unsigned c = xb_ld(&bar[XB_XCNT(j)]); sum += c; cnt += (c > 0u) ? 1u : 0u; mine = (j == x) ? c : mine; }
    if (sum == G) break;
    __builtin_amdgcn_s_sleep(1);
    if ((++sp & 255u) == 0u) { if (xb_ld(&bar[XB_TMO])) break; if (sp > XB_SPIN_CAP) { atomicAdd(&bar[XB_TMO], 1u); break; } }
  }
  nloc = mine > 0u ? mine : 1u; nx = cnt > 0u ? cnt : 1u;
}
DI void xcd_barrier(const XcdBarrier& b) {
  asm volatile("s_waitcnt vmcnt(0)" ::: "memory");
  __syncthreads();
  if (threadIdx.x == 0) {
    unsigned* bar = b.bar;
    __builtin_amdgcn_s_waitcnt(0);
    unsigned nloc = b.st[0], nx = b.st[1];
    if (nloc == 0u) { xcd_barrier_complete(bar, b.x, nloc, nx); b.st[0] = nloc; b.st[1] = nx; }
    const unsigned old = xb_add(&bar[XB_XSUB(b.x)], 1u);
    const unsigned gen = old / nloc;
    if (old + 1u == (gen + 1u) * nloc) {
      __builtin_amdgcn_fence(__ATOMIC_RELEASE, "agent");
      asm volatile("s_waitcnt vmcnt(0)" ::: "memory");
      const unsigned og = xb_add(&bar[XB_TOP], 1u);
      const unsigned tg = og / nx;
      if (og + 1u == (tg + 1u) * nx) xb_add(&bar[XB_TOPGEN], 1u);
      else XB_SPIN(xb_ld(&bar[XB_TOPGEN]) == tg, bar);
      __builtin_amdgcn_fence(__ATOMIC_ACQUIRE, "agent");
      xb_add(&bar[XB_XGEN(b.x)], 1u);
      asm volatile("s_waitcnt vmcnt(0)" ::: "memory");
    } else {
      XB_SPIN(xb_ld(&bar[XB_XGEN(b.x)]) == gen, bar);
      __builtin_amdgcn_fence(__ATOMIC_ACQUIRE, "agent");
      asm volatile("s_waitcnt vmcnt(0)" ::: "memory");
    }
  }
  __syncthreads();
}

constexpr int HALF_LDS = 76 * 1024;
constexpr int SMEM_BYTES = 2 * HALF_LDS;
__global__ void __launch_bounds__(512, 2) fwd_megakernel(Params p) {
  cg::grid_group grid = cg::this_grid();
  __shared__ __attribute__((aligned(16))) unsigned char smem[SMEM_BYTES];
  const int half = __builtin_amdgcn_readfirstlane(threadIdx.x >> 8);
  unsigned char* hsm = smem + half * HALF_LDS;
  const int G = gridDim.x, bid = blockIdx.x;
  const int slot = bid * 2 + half, NS = 2 * G;
  volatile LDSP unsigned* xst = (volatile LDSP unsigned*)(LDSP unsigned char*)(smem + SMEM_BYTES - 32);
  if (threadIdx.x == 0) { xst[0] = 0u; xst[1] = 0u; }
  __syncthreads();
  const XcdBarrier xb = xcd_barrier_post((unsigned*)(p.ws + OFF_BAR), xst);
  {
    constexpr int ADA0 = T0_WIN + T0_WOUT + T0_W1 + T0_W2;
    unsigned* cnt = (unsigned*)(p.ws + OFF_CNT);
    for (int i = slot; i < ((T0_TOTAL + NS - 1) / NS) * NS; i += NS) {
      const int ii = i < T0_TOTAL ? i : T0_TOTAL - 1;
      const int t = ii < 96 ? ADA0 + ii : (ii - 96 < ADA0 ? ii - 96 : ii);
      phase0_task(p, t, hsm);
      if (i < 96) {
        asm volatile("s_waitcnt vmcnt(0)" ::: "memory");
        lds_barrier();
        if (otid512() == 0) {
          __builtin_amdgcn_fence(__ATOMIC_RELEASE, "agent");
          asm volatile("s_waitcnt vmcnt(0)" ::: "memory");
          __hip_atomic_fetch_add(cnt + 8, 2u, __ATOMIC_RELAXED, __HIP_MEMORY_SCOPE_AGENT);
        }
      }
    }
    if (otid512() == 0) {
      unsigned sp = 0;
      while (__hip_atomic_load(cnt + 8, __ATOMIC_RELAXED, __HIP_MEMORY_SCOPE_AGENT) < 96u) { __builtin_amdgcn_s_sleep(8); if (++sp > (1u << 22)) break; }
      __builtin_amdgcn_fence(__ATOMIC_ACQUIRE, "agent");
      asm volatile("s_waitcnt vmcnt(0)" ::: "memory");
    }
    lds_barrier();
    for (int t = slot; t < ((NTOK / 64 + NS - 1) / NS) * NS; t += NS) phase1_task(p, 0, p.x, t < NTOK / 64 ? t : NTOK / 64 - 1, hsm);
  }
  grid.sync();
  for (int layer = 0; layer < 2; ++layer) {
    Params q = p;
    { size_t zoff = 0; asm volatile("" : "+s"(zoff)); q.ws = p.ws + zoff; }
    const float* xin = layer == 0 ? q.x : q.out;
    if (layer != 0) {
      for (int t = slot; t < ((NTOK / 64 + NS - 1) / NS) * NS; t += NS) phase1_task(q, layer, xin, t < NTOK / 64 ? t : NTOK / 64 - 1, hsm);
      xcd_barrier(xb);
    }
    for (int t = bid; t < (NTOK / 256) * (NPAD / 256); t += G) gemm_inproj_tile(q, layer, t, smem);
    xcd_barrier(xb);
    {
      unsigned* cnt = (unsigned*)(q.ws + OFF_CNT);
      unsigned* qcnt = cnt + 32 + layer * 8; unsigned* cdone = cnt + 64 + layer * 8; unsigned* sdone = cnt + 96 + layer * 8;
      int* s_pair = (int*)(smem + SMEM_BYTES - 16);
      if (bid < 32) ssd_task8(q, layer, bid >> 2, bid & 3, smem);
      else if (bid < 64) mlstm_task8(q, layer, (bid - 32) >> 2, (bid - 32) & 3, smem);
      if (bid < 64) {
        asm volatile("s_waitcnt vmcnt(0)" ::: "memory");
        lds_barrier();
        if (otid512() == 0) {
          __builtin_amdgcn_fence(__ATOMIC_RELEASE, "agent");
          asm volatile("s_waitcnt vmcnt(0)" ::: "memory");
          __hip_atomic_fetch_add(sdone + ((bid & 31) >> 2), 1u, __ATOMIC_RELAXED, __HIP_MEMORY_SCOPE_AGENT);
        }
      }
      constexpr int NP_C = 8, NP_D = 64, NP_N = 64, NP_F = 32, NP_ALL = NP_C + NP_D + NP_N + NP_F;
      for (int kq = 0; kq < 8; ++kq) {
        const int bq = (int)((xb.x + (unsigned)kq) & 7u);
        for (;;) {
          const int t512 = otid512();
          lds_barrier();
          if (t512 == 0) *s_pair = (int)atomicAdd(qcnt + bq, 1u);
          lds_barrier();
          const int pair = *s_pair;
          if (pair >= NP_ALL) break;
          if (pair < NP_C) {
            const int v = pair * 2 + half;
            compress_task(q, layer, bq, v >> 3, v & 7, hsm);
            asm volatile("s_waitcnt vmcnt(0)" ::: "memory");
            lds_barrier();
            if (t512 == 0) {
              __builtin_amdgcn_fence(__ATOMIC_RELEASE, "agent");
              asm volatile("s_waitcnt vmcnt(0)" ::: "memory");
              __hip_atomic_fetch_add(cdone + bq, 1u, __ATOMIC_RELAXED, __HIP_MEMORY_SCOPE_AGENT);
            }
          } else if (pair < NP_C + NP_D) {
            const int d = pair - NP_C;
            diff_attn_task(q, layer, bq, 2 * (d & 1) + half, 31 - (d >> 1), hsm);
          } else if (pair < NP_C + NP_D + NP_N) {
            if (t512 == 0) {
              while (__hip_atomic_load(cdone + bq, __ATOMIC_RELAXED, __HIP_MEMORY_SCOPE_AGENT) < (unsigned)NP_C) __builtin_amdgcn_s_sleep(16);
              __builtin_amdgcn_fence(__ATOMIC_ACQUIRE, "agent");
              asm volatile("s_waitcnt vmcnt(0)" ::: "memory");
            }
            lds_barrier();
            nsa_task(q, layer, bq, 2 * (63 - (pair - NP_C - NP_D)) + half, hsm);
          } else {
            if (t512 == 0) {
              while (__hip_atomic_load(sdone + bq, __ATOMIC_RELAXED, __HIP_MEMORY_SCOPE_AGENT) < 8u) __builtin_amdgcn_s_sleep(16);
              __builtin_amdgcn_fence(__ATOMIC_ACQUIRE, "agent");
              asm volatile("s_waitcnt vmcnt(0)" ::: "memory");
            }
            lds_barrier();
            seq_fix_rows(q, layer, bq * SEQ + ((pair - NP_C - NP_D - NP_N) * 2 + half) * 64, 64);
          }
        }
      }
    }
    xcd_barrier(xb);
    if (layer == 0) { for (int t = bid; t < (NTOK / 256) * 4; t += G) gemm_outproj_tile<0>(q, xin, q.out, t, smem); }
    else { for (int t = bid; t < (NTOK / 256) * 4; t += G) gemm_outproj_tile<1>(q, xin, q.out, t, smem); }
    xcd_barrier(xb);
  }
  { const int t5 = otid512(); final_norm_rows(p, bid * 8 + (t5 >> 6), G * 8, t5 & 63); }
}

extern "C" void kernel_launch(void* const* d_in, const int* in_sizes, int n_in, void* d_out, int out_size, void* d_ws, size_t ws_size,
                              hipStream_t stream) {
  static int grid_blocks = 0;
  if (!grid_blocks) {
    int dev = 0, cus = 0, per_cu = 0;
    (void)hipGetDevice(&dev);
    (void)hipDeviceGetAttribute(&cus, hipDeviceAttributeMultiprocessorCount, dev);
    (void)hipOccupancyMaxActiveBlocksPerMultiprocessor(&per_cu, fwd_megakernel, 512, 0);
    if (per_cu > 1) per_cu = 1;
    if (per_cu < 1) per_cu = 1;
    grid_blocks = cus * per_cu;
  }
  if (grid_blocks < 64 || (grid_blocks & 3)) { fprintf(stderr, "grid too small: %d\n", grid_blocks); return; }
  if (ws_size < WS_NEEDED) { fprintf(stderr, "workspace too small: %zu < %zu\n", ws_size, WS_NEEDED); return; }
  Params p{};
  const float** pp = (const float**)&p;
  for (int i = 0; i < 26; ++i) pp[i] = (const float*)d_in[i];
  p.out = (float*)d_out; p.ws = (unsigned char*)d_ws;
  (void)hipMemsetAsync((unsigned char*)d_ws + OFF_CNT, 0, 64 * 1024 + XCD_BAR_WORDS * 4, stream);
  void* args[] = {&p};
  hipError_t e = hipLaunchCooperativeKernel((void*)fwd_megakernel, dim3(grid_blocks), dim3(512), args, 0, stream);
  if (e != hipSuccess) fprintf(stderr, "cooperative launch failed: %s (grid %d)\n", hipGetErrorString(e), grid_blocks);
}
```

```cpp
#include <hip/hip_runtime.h>
#include <hip/hip_cooperative_groups.h>
#include <cstdio>
#include <cstdint>
namespace cg = cooperative_groups;

typedef unsigned short u16;
typedef short bf16x8 __attribute__((ext_vector_type(8)));
typedef short s16x4 __attribute__((ext_vector_type(4)));
typedef float f32x4 __attribute__((ext_vector_type(4)));
typedef float f32x2 __attribute__((ext_vector_type(2)));
typedef unsigned u32x4 __attribute__((ext_vector_type(4)));
typedef unsigned u32x2 __attribute__((ext_vector_type(2)));
typedef __bf16 bf16x2_t __attribute__((ext_vector_type(2)));
#define DI __device__ __forceinline__
#define LDSP __attribute__((address_space(3)))

constexpr int D_MODEL = 1024, BATCH = 8, SEQ = 4096, NTOK = BATCH * SEQ;
constexpr int D_IN = 3992;
constexpr int NP = 3968, NPAD = 4096, NSMALL = 32;
constexpr int PA_Q = 0, PA_KC = 256, PA_VC = 320, PA_KS = 384, PA_VS = 448, PA_KW = 512, PA_VW = 576, PA_Z = 640;
constexpr int PB_Q = 896, PB_K = 1152, PB_V = 1408, PB_Z = 1664;
constexpr int PC_Z = 1920, PC_XBC = 2176;
constexpr int PD_QK = 2688, PD_V = 3200, PD_O = 3456, PD_Z = 3712;
constexpr int SM_G = 0, SM_DT = 12, SM_IF = 16;
constexpr int Y_A = 0, Y_B = 256, Y_C = 512, Y_D = 768;

constexpr size_t MiB = 1024 * 1024;
constexpr size_t OFF_WINT = 0;
constexpr size_t OFF_WOUTT = 16 * MiB;
constexpr size_t OFF_W1T = 20 * MiB;
constexpr size_t OFF_W2T = 22 * MiB;
constexpr size_t OFF_BIAS1 = 22 * MiB + 64 * 1024;
constexpr size_t OFF_ADAP = 22 * MiB + 128 * 1024;
constexpr size_t OFF_KCMP = 24 * MiB;
constexpr size_t OFF_VCMP = 24 * MiB + 256 * 1024;
constexpr size_t OFF_BAR = 29 * MiB + 64 * 1024;
constexpr size_t OFF_CNT = 29 * MiB;
constexpr size_t OFF_SMALL = 25 * MiB;
constexpr size_t OFF_SSQ = 29 * MiB;
constexpr size_t OFF_H = 32 * MiB;
constexpr size_t OFF_PROJ = 96 * MiB;
constexpr size_t OFF_X1B = 352 * MiB;
constexpr size_t WS_NEEDED = OFF_X1B + (size_t)NTOK * 1024 * 2;

struct Params {
  const float* x; const float* c; const float* norm_g; const float* ada_w; const float* ada_b;
  const float* w_in; const float* w_out;
  const float* nsa_cmp_pos; const float* nsa_ck_w1; const float* nsa_ck_w2; const float* nsa_cv_w1; const float* nsa_cv_w2; const float* nsa_norm_g;
  const float* diff_lam; const float* diff_norm_g;
  const float* ssm_conv_w; const float* ssm_conv_b; const float* ssm_dt_bias; const float* ssm_a_log; const float* ssm_d; const float* ssm_norm_g;
  const float* ml_conv_w; const float* ml_conv_b; const float* ml_if_b; const float* ml_norm_g; const float* final_g;
  float* out; unsigned char* ws;
};

DI void lds_barrier() { asm volatile("s_waitcnt lgkmcnt(0)" ::: "memory"); __builtin_amdgcn_s_barrier(); asm volatile("" ::: "memory"); }
DI int otid() { int t = threadIdx.x & 255; asm volatile("" : "+v"(t)); return t; }
DI int otid512() { int t = threadIdx.x; asm volatile("" : "+v"(t)); return t; }
DI unsigned pack2(float a, float b) { f32x2 v = {a, b}; bf16x2_t r = __builtin_convertvector(v, bf16x2_t); return __builtin_bit_cast(unsigned, r); }
DI u16 f2bf(float a) { return (u16)(pack2(a, 0.f) & 0xffffu); }
DI float bf2f(u16 h) { return __uint_as_float(((unsigned)h) << 16); }
DI float bflo(unsigned u) { return __uint_as_float(u << 16); }
DI float bfhi(unsigned u) { return __uint_as_float(u & 0xffff0000u); }
DI f32x4 mfma16(bf16x8 a, bf16x8 b, f32x4 c) { return __builtin_amdgcn_mfma_f32_16x16x32_bf16(a, b, c, 0, 0, 0); }
DI float wave_sum(float v) {
#pragma unroll
  for (int o = 32; o > 0; o >>= 1) v += __shfl_xor(v, o);
  return v;
}
DI float siluf(float v) { return v * __builtin_amdgcn_rcpf(1.f + __expf(-v)); }
DI float sigmoidf_(float v) { return __builtin_amdgcn_rcpf(1.f + __expf(-v)); }
DI float exp2_(float v) { return __builtin_amdgcn_exp2f(v); }
DI float sgprf(float v) { return __int_as_float(__builtin_amdgcn_readfirstlane(__float_as_int(v))); }
DI s16x4 tr_read(const u16* p) { return __builtin_amdgcn_ds_read_tr16_b64_v4i16((LDSP s16x4*)p); }
DI bf16x8 cat4(s16x4 a, s16x4 b) { bf16x8 r; r[0] = a[0]; r[1] = a[1]; r[2] = a[2]; r[3] = a[3]; r[4] = b[0]; r[5] = b[1]; r[6] = b[2]; r[7] = b[3]; return r; }
DI bf16x8 ldfrag(const u16* p) { return *(const bf16x8*)p; }

DI int colmap(int n) {
  if (n < 640) return n;
  if (n < 896) return 652 + (n - 640);
  if (n < 1920) return 908 + (n - 896);
  if (n < 2688) return 1932 + (n - 1920);
  if (n < 3456) return 2704 + (n - 2688);
  if (n < 3968) return 3480 + (n - 3456);
  if (n < 3980) return 640 + (n - 3968);
  if (n < 3984) return 2700 + (n - 3980);
  if (n < 3992) return 3472 + (n - 3984);
  return -1;
}

DI void tconv_tile(const float* __restrict__ src, int ldsrc, int k0, int n0, u16* __restrict__ dst, int ldd, bool use_map, unsigned char* smem) {
  float* tile = (float*)smem;
  const int tid = otid();
  lds_barrier();
  {
    const int nn = tid & 63; int col = n0 + nn; if (use_map) col = colmap(col);
#pragma unroll
    for (int i = 0; i < 16; ++i) { const int kk = i * 4 + (tid >> 6); tile[kk * 65 + nn] = col >= 0 ? src[(size_t)(k0 + kk) * ldsrc + col] : 0.f; }
  }
  lds_barrier();
#pragma unroll
  for (int i = 0; i < 2; ++i) {
    const int item = tid + 256 * i, nn = item >> 3, kc = item & 7;
    u32x4 w;
    w.x = pack2(tile[(kc * 8 + 0) * 65 + nn], tile[(kc * 8 + 1) * 65 + nn]);
    w.y = pack2(tile[(kc * 8 + 2) * 65 + nn], tile[(kc * 8 + 3) * 65 + nn]);
    w.z = pack2(tile[(kc * 8 + 4) * 65 + nn], tile[(kc * 8 + 5) * 65 + nn]);
    w.w = pack2(tile[(kc * 8 + 6) * 65 + nn], tile[(kc * 8 + 7) * 65 + nn]);
    *(u32x4*)(dst + (size_t)(n0 + nn) * ldd + k0 + kc * 8) = w;
  }
}

constexpr int T0_WIN = 2 * 16 * 64, T0_WOUT = 2 * 16 * 16, T0_W1 = 4 * 32 * 2, T0_W2 = 4 * 2, T0_ADA = 2 * 12 * 8, T0_B1 = 64;
constexpr int T0_TOTAL = T0_WIN + T0_WOUT + T0_W1 + T0_W2 + T0_ADA + T0_B1;

DI void phase0_task(const Params& p, int t, unsigned char* smem) {
  const int tid = otid();
  if (t < T0_WIN) {
    const int l = t / 1024, r = t % 1024, kt = r / 64, nt = r % 64;
    tconv_tile(p.w_in + (size_t)l * D_MODEL * D_IN, D_IN, kt * 64, nt * 64, (u16*)(p.ws + OFF_WINT) + (size_t)l * NPAD * 1024, 1024, true, smem);
    return;
  }
  t -= T0_WIN;
  if (t < T0_WOUT) {
    const int l = t / 256, r = t % 256, kt = r / 16, nt = r % 16;
    tconv_tile(p.w_out + (size_t)l * 1024 * 1024, 1024, kt * 64, nt * 64, (u16*)(p.ws + OFF_WOUTT) + (size_t)l * 1024 * 1024, 1024, false, smem);
    return;
  }
  t -= T0_WOUT;
  if (t < T0_W1) {
    const int m = t / 64, r = t % 64, kt = r / 2, nt = r % 2, l = m >> 1, kv = m & 1;
    const float* src = (kv ? p.nsa_cv_w1 : p.nsa_ck_w1) + (size_t)l * 2048 * 128;
    tconv_tile(src, 128, kt * 64, nt * 64, (u16*)(p.ws + OFF_W1T) + (size_t)m * 128 * 2048, 2048, false, smem);
    return;
  }
  t -= T0_W1;
  if (t < T0_W2) {
    const int m = t / 2, kt = t % 2, l = m >> 1, kv = m & 1;
    const float* src = (kv ? p.nsa_cv_w2 : p.nsa_ck_w2) + (size_t)l * 128 * 64;
    tconv_tile(src, 64, kt * 64, 0, (u16*)(p.ws + OFF_W2T) + (size_t)m * 64 * 128, 128, false, smem);
    return;
  }
  t -= T0_W2;
  if (t < T0_ADA) {
    const int l = t / 96, r = t % 96, nc = r / 8, kc = r % 8;
    float* cact = (float*)smem;
    lds_barrier();
    for (int i = tid; i < 1024; i += 256) { const int b = i >> 7, kk = i & 127; const float v = p.c[b * 1024 + kc * 128 + kk]; cact[i] = siluf(v); }
    lds_barrier();
    const int n = nc * 256 + tid;
    float acc[8];
#pragma unroll
    for (int b = 0; b < 8; ++b) acc[b] = 0.f;
    const float* w = p.ada_w + ((size_t)l * 1024 + kc * 128) * 3072 + n;
#pragma unroll 16
    for (int kk = 0; kk < 128; ++kk) {
      const float wv = w[(size_t)kk * 3072];
#pragma unroll
      for (int b = 0; b < 8; ++b) acc[b] += cact[b * 128 + kk] * wv;
    }
    float* adap = (float*)(p.ws + OFF_ADAP);
    const float bias = kc == 0 ? p.ada_b[l * 3072 + n] : 0.f;
#pragma unroll
    for (int b = 0; b < 8; ++b) adap[(((size_t)kc * 2 + l) * 8 + b) * 3072 + n] = acc[b] + bias;
    return;
  }
  t -= T0_ADA;
  {
    const int m = t >> 4, kc = t & 15, l = m >> 1, kv = m & 1;
    const float* w1 = (kv ? p.nsa_cv_w1 : p.nsa_ck_w1) + (size_t)l * 2048 * 128;
    const float* pos = p.nsa_cmp_pos + (size_t)l * 2048;
    const int n = tid & 127, half = tid >> 7;
    float acc = 0.f;
    const int k0 = kc * 128 + half * 64;
#pragma unroll 16
    for (int k = 0; k < 64; ++k) acc += pos[k0 + k] * w1[(size_t)(k0 + k) * 128 + n];
    float* red = (float*)smem;
    lds_barrier();
    red[tid] = acc;
    lds_barrier();
    if (tid < 128) ((float*)(p.ws + OFF_BIAS1))[(m * 16 + kc) * 128 + tid] = red[tid] + red[tid + 128];
  }
}

DI void phase1_task(const Params& p, int layer, const float* xin, int grp, unsigned char* smem) {
  const int tid = otid(), lane = tid & 63, wid = tid >> 6;
  const int b = grp >> 6;
  float* mul = (float*)smem;
  float* sh = mul + 1024;
  const float* adap = (const float*)(p.ws + OFF_ADAP);
  lds_barrier();
  for (int c = tid; c < 1024; c += 256) {
    float s0 = 0.f, s1 = 0.f;
#pragma unroll
    for (int kc = 0; kc < 8; ++kc) { const float* a = adap + (((size_t)kc * 2 + layer) * 8 + b) * 3072; s0 += a[c]; s1 += a[1024 + c]; }
    mul[c] = p.norm_g[layer * 1024 + c] * (1.f + s1); sh[c] = s0;
  }
  lds_barrier();
  u16* H = (u16*)(p.ws + OFF_H);
#pragma unroll 1
  for (int it = 0; it < 4; ++it) {
    float4 v[4][4]; float ss[4];
#pragma unroll
    for (int j = 0; j < 4; ++j) {
      const int row = grp * 64 + wid * 16 + it * 4 + j;
      if (layer == 0) {
        const float4* xr = (const float4*)(xin + (size_t)row * D_MODEL);
#pragma unroll
        for (int i = 0; i < 4; ++i) v[j][i] = xr[lane + 64 * i];
      } else {
        const u32x2* xr = (const u32x2*)((const u16*)(p.ws + OFF_X1B) + (size_t)row * D_MODEL);
#pragma unroll
        for (int i = 0; i < 4; ++i) { const u32x2 w = xr[lane + 64 * i]; v[j][i] = make_float4(bflo(w.x), bfhi(w.x), bflo(w.y), bfhi(w.y)); }
      }
    }
#pragma unroll
    for (int j = 0; j < 4; ++j) {
      float a = 0.f;
#pragma unroll
      for (int i = 0; i < 4; ++i) a += v[j][i].x * v[j][i].x + v[j][i].y * v[j][i].y + v[j][i].z * v[j][i].z + v[j][i].w * v[j][i].w;
      ss[j] = wave_sum(a);
    }
#pragma unroll
    for (int j = 0; j < 4; ++j) {
      const int row = grp * 64 + wid * 16 + it * 4 + j;
      const float r = rsqrtf(ss[j] * (1.f / D_MODEL) + 1e-6f);
#pragma unroll
      for (int i = 0; i < 4; ++i) {
        const int c = (lane + 64 * i) * 4;
        u32x2 w;
        w.x = pack2(v[j][i].x * r * mul[c] + sh[c], v[j][i].y * r * mul[c + 1] + sh[c + 1]);
        w.y = pack2(v[j][i].z * r * mul[c + 2] + sh[c + 2], v[j][i].w * r * mul[c + 3] + sh[c + 3]);
        *(u32x2*)(H + (size_t)row * 1024 + c) = w;
      }
    }
  }
}

namespace g8 {
constexpr int BM = 256, BK = 64, HALF = 128, HT = HALF * BK;
constexpr int LDS_BYTES = 8 * HT * 2;
DI int lds_byte(int r, int c) { const int st = (r >> 4) * 2 + (c >> 5), rr = r & 15, cc = c & 31, ob = rr * 64 + cc * 2; return st * 1024 + (ob ^ (((ob >> 9) & 1) << 5)); }
DI void stage_rc(int b, int& R, int& C) { const int st = b / 1024, sb = b % 1024, swz = sb ^ (((sb >> 9) & 1) << 5); R = (st >> 1) * 16 + swz / 64; C = (st & 1) * 32 + (swz % 64) / 2; }

DI void kloop(const u16* __restrict__ A, const u16* __restrict__ Bt, int K, int brow, int bcol, unsigned char* smem, f32x4 (&acc)[2][2][4][2]) {
  u16* shm = (u16*)smem;
  const int tid = otid512();
#define SA(b, h) (shm + ((b) * 2 + (h)) * HT)
#define SB(b, h) (shm + (4 + (b) * 2 + (h)) * HT)
#define STAGE(P, BASE, br, kt) do { const u16* _gb = BASE + ((long)(br) * K + (long)(kt) * BK); \
      __builtin_amdgcn_global_load_lds((const unsigned*)(_gb + soff0), (LDSP unsigned*)((LDSP char*)(P) + tid * 16), 16, 0, 0); \
      __builtin_amdgcn_global_load_lds((const unsigned*)(_gb + soff1), (LDSP unsigned*)((LDSP char*)(P) + tid * 16 + 8192), 16, 0, 0); } while (0)
#define LDA(dst, b, h) _Pragma("unroll") for (int m = 0; m < 4; ++m) _Pragma("unroll") for (int k = 0; k < 2; ++k) \
    dst[m][k] = *reinterpret_cast<const bf16x8*>((const char*)SA(b, h) + lds_byte(wr * 64 + m * 16 + fr, k * 32 + fq * 8))
#define LDB(dst, b, h) _Pragma("unroll") for (int n = 0; n < 2; ++n) _Pragma("unroll") for (int k = 0; k < 2; ++k) \
    dst[n][k] = *reinterpret_cast<const bf16x8*>((const char*)SB(b, h) + lds_byte(wc * 32 + n * 16 + fr, k * 32 + fq * 8))
#define MMA(ai, bj, At_, Bt_) do { __builtin_amdgcn_s_setprio(1); \
    _Pragma("unroll") for (int m = 0; m < 4; ++m) _Pragma("unroll") for (int n = 0; n < 2; ++n) _Pragma("unroll") for (int k = 0; k < 2; ++k) \
      acc[ai][bj][m][n] = __builtin_amdgcn_mfma_f32_16x16x32_bf16(Bt_[n][k], At_[m][k], acc[ai][bj][m][n], 0, 0, 0); \
    __builtin_amdgcn_s_setprio(0); } while (0)
#define WAIT_V(n) asm volatile("s_waitcnt vmcnt(" #n ")" ::: "memory")
#define WAIT_L(n) asm volatile("s_waitcnt lgkmcnt(" #n ")" ::: "memory")
#define BAR __builtin_amdgcn_s_barrier()
#define SCHED __builtin_amdgcn_sched_barrier(0)
  const int wid = __builtin_amdgcn_readfirstlane(tid >> 6), lane = tid & 63, wr = wid >> 2, wc = wid & 3, fr = lane & 15, fq = lane >> 4;
#pragma unroll
  for (int a = 0; a < 2; ++a)
#pragma unroll
    for (int b = 0; b < 2; ++b)
#pragma unroll
      for (int m = 0; m < 4; ++m) { acc[a][b][m][0] = (f32x4){0.f, 0.f, 0.f, 0.f}; acc[a][b][m][1] = (f32x4){0.f, 0.f, 0.f, 0.f}; }
  bf16x8 At[4][2], B0[2][2], B1[2][2];
  const int nt = K / BK;
  int soff0, soff1;
  { int r_, c_; stage_rc(tid * 16, r_, c_); soff0 = r_ * K + c_; stage_rc(tid * 16 + 8192, r_, c_); soff1 = r_ * K + c_; }
  STAGE(SB(0, 0), Bt, bcol, 0); STAGE(SA(0, 0), A, brow, 0);
  STAGE(SB(0, 1), Bt, bcol + HALF, 0); STAGE(SA(0, 1), A, brow + HALF, 0);
  if (wr == 1) BAR;
  WAIT_V(4); BAR;
  STAGE(SB(1, 0), Bt, bcol, 1); STAGE(SA(1, 0), A, brow, 1); STAGE(SB(1, 1), Bt, bcol + HALF, 1);
  WAIT_V(6); BAR;
#pragma unroll 1
  for (int t = 0; t < nt - 2; t += 2) {
    asm volatile("" : "+v"(soff0), "+v"(soff1));
    LDB(B0, 0, 0); SCHED; LDA(At, 0, 0); STAGE(SA(1, 1), A, brow + HALF, t + 1);
    WAIT_L(8); BAR; WAIT_L(0); MMA(0, 0, At, B0); BAR; SCHED;
    LDB(B1, 0, 1); STAGE(SB(0, 0), Bt, bcol, t + 2);
    BAR; WAIT_L(0); MMA(0, 1, At, B1); BAR;
    LDA(At, 0, 1); STAGE(SA(0, 0), A, brow, t + 2);
    BAR; WAIT_L(0); MMA(1, 0, At, B0); BAR; SCHED;
    STAGE(SB(0, 1), Bt, bcol + HALF, t + 2);
    WAIT_V(6); BAR; MMA(1, 1, At, B1); BAR;
    LDB(B0, 1, 0); SCHED; LDA(At, 1, 0); STAGE(SA(0, 1), A, brow + HALF, t + 2);
    WAIT_L(8); BAR; WAIT_L(0); MMA(0, 0, At, B0); BAR; SCHED;
    LDB(B1, 1, 1); STAGE(SB(1, 0), Bt, bcol, t + 3);
    BAR; WAIT_L(0); MMA(0, 1, At, B1); BAR;
    LDA(At, 1, 1); STAGE(SA(1, 0), A, brow, t + 3);
    BAR; WAIT_L(0); MMA(1, 0, At, B0); BAR; SCHED;
    STAGE(SB(1, 1), Bt, bcol + HALF, t + 3);
    WAIT_V(6); BAR; MMA(1, 1, At, B1); BAR;
  }
  { LDB(B0, 0, 0); LDA(At, 0, 0); STAGE(SA(1, 1), A, brow + HALF, nt - 1);
    BAR; WAIT_L(0); MMA(0, 0, At, B0); BAR;
    LDB(B1, 0, 1); BAR; WAIT_L(0); MMA(0, 1, At, B1); BAR;
    LDA(At, 0, 1); WAIT_V(4); BAR; WAIT_L(0); MMA(1, 0, At, B0); MMA(1, 1, At, B1); BAR; }
  { LDB(B0, 1, 0); LDA(At, 1, 0); WAIT_V(2); BAR; WAIT_L(0); MMA(0, 0, At, B0); BAR;
    LDB(B1, 1, 1); WAIT_V(0); BAR; WAIT_L(0); MMA(0, 1, At, B1); BAR;
    LDA(At, 1, 1); BAR; WAIT_L(0); MMA(1, 0, At, B0); MMA(1, 1, At, B1); BAR; }
  if (wr == 0) BAR;
#undef SA
#undef SB
#undef STAGE
#undef LDA
#undef LDB
#undef MMA
#undef WAIT_V
#undef WAIT_L
#undef BAR
#undef SCHED
}
DI void tile_map(int wgid, int nM, int nN, int& pm, int& pn) {
  const int nwg = nM * nN, NXCD = 8, WGM = 8;
  { const int q = nwg / NXCD, r = nwg % NXCD, xcd = wgid % NXCD, off = wgid / NXCD; wgid = (xcd < r ? xcd * (q + 1) : r * (q + 1) + (xcd - r) * q) + off; }
  const int nig = WGM * nN, gid = wgid / nig, fm = gid * WGM, gsz = (nM - fm) < WGM ? (nM - fm) : WGM;
  pm = fm + ((wgid % nig) % gsz); pn = (wgid % nig) / gsz;
}
}

DI void gemm_inproj_tile(const Params& p, int layer, int pm, int pn, unsigned char* smem) {
  const int brow = pm * 256, bcol = pn * 256;
  f32x4 acc[2][2][4][2];
  g8::kloop((const u16*)(p.ws + OFF_H), (const u16*)(p.ws + OFF_WINT) + (size_t)layer * NPAD * 1024, 1024, brow, bcol, smem, acc);
  const int tid = otid512(), wid = __builtin_amdgcn_readfirstlane(tid >> 6), lane = tid & 63, wr = wid >> 2, wc = wid & 3, fr = lane & 15, fq = lane >> 4;
  u16* proj = (u16*)(p.ws + OFF_PROJ);
  if (pn == 15 && wc == 0) {
    float* sm = (float*)(p.ws + OFF_SMALL);
#pragma unroll
    for (int ai = 0; ai < 2; ++ai)
#pragma unroll
      for (int m = 0; m < 4; ++m)
#pragma unroll
        for (int n = 0; n < 2; ++n) {
          const int mr = brow + ai * 128 + wr * 64 + m * 16 + fr;
          *(f32x4*)(sm + (size_t)mr * NSMALL + n * 16 + 4 * fq) = acc[ai][1][m][n];
        }
  }
  constexpr int CLD = 264;
  u16* Cs = (u16*)smem;
#pragma unroll
  for (int ai = 0; ai < 2; ++ai) {
    lds_barrier();
#pragma unroll
    for (int bj = 0; bj < 2; ++bj)
#pragma unroll
      for (int m = 0; m < 4; ++m)
#pragma unroll
        for (int n = 0; n < 2; ++n) {
          const f32x4 v = acc[ai][bj][m][n];
          u32x2 w; w.x = pack2(v[0], v[1]); w.y = pack2(v[2], v[3]);
          *(u32x2*)(Cs + (wr * 64 + m * 16 + fr) * CLD + bj * 128 + wc * 32 + n * 16 + 4 * fq) = w;
        }
    lds_barrier();
#pragma unroll
    for (int i = 0; i < 8; ++i) {
      const int id = tid + 512 * i, row = id >> 5, ch = id & 31;
      if (bcol + ch * 8 < NP) *(u32x4*)(proj + (size_t)(brow + ai * 128 + row) * NP + bcol + ch * 8) = *(const u32x4*)(Cs + row * CLD + ch * 8);
    }
  }
  lds_barrier();
}

template <int layer>
DI void gemm_outproj_tile(const Params& p, const float* xin, float* xout, int pm, int pn, unsigned char* smem) {
  const int brow = pm * 256, bcol = pn * 256;
  f32x4 acc[2][2][4][2];
  g8::kloop((const u16*)(p.ws + OFF_H), (const u16*)(p.ws + OFF_WOUTT) + (size_t)layer * 1024 * 1024, 1024, brow, bcol, smem, acc);
  const int tid = otid512(), wid = __builtin_amdgcn_readfirstlane(tid >> 6), lane = tid & 63, wr = wid >> 2, wc = wid & 3, fr = lane & 15, fq = lane >> 4;
  const int b = brow >> 12;
  const float* adap = (const float*)(p.ws + OFF_ADAP);
  constexpr int CLD = 132;
  float* Cs = (float*)smem;
#pragma unroll
  for (int ai = 0; ai < 2; ++ai)
#pragma unroll
    for (int bj = 0; bj < 2; ++bj) {
      lds_barrier();
#pragma unroll
      for (int m = 0; m < 4; ++m)
#pragma unroll
        for (int n = 0; n < 2; ++n) *(f32x4*)(Cs + (wr * 64 + m * 16 + fr) * CLD + wc * 32 + n * 16 + 4 * fq) = acc[ai][bj][m][n];
      lds_barrier();
      const int ch = tid & 31, nc = bcol + bj * 128 + ch * 4;
      f32x4 gt = {0.f, 0.f, 0.f, 0.f};
#pragma unroll
      for (int kc = 0; kc < 8; ++kc) gt += *(const f32x4*)(adap + (((size_t)kc * 2 + layer) * 8 + b) * 3072 + 2048 + nc);
      u16* x1b = (u16*)(p.ws + OFF_X1B);
      f32x4 xv[8];
#pragma unroll
      for (int i = 0; i < 8; ++i) {
        const size_t off = (size_t)(brow + ai * 128 + (tid >> 5) + 16 * i) * 1024 + nc;
        if (layer == 0) xv[i] = *(const f32x4*)(xin + off);
        else { const u32x2 w = *(const u32x2*)(x1b + off); xv[i] = (f32x4){bflo(w.x), bfhi(w.x), bflo(w.y), bfhi(w.y)}; }
      }
#pragma unroll
      for (int i = 0; i < 8; ++i) {
        const int row = (tid >> 5) + 16 * i;
        const size_t off = (size_t)(brow + ai * 128 + row) * 1024 + nc;
        const f32x4 v = xv[i] + gt * *(const f32x4*)(Cs + row * CLD + ch * 4);
        if (layer == 0) { u32x2 w; w.x = pack2(v[0], v[1]); w.y = pack2(v[2], v[3]); *(u32x2*)(x1b + off) = w; }
        else *(f32x4*)(xout + off) = v;
      }
    }
  lds_barrier();
}

constexpr int KLD = 72;
struct KVRegs { u32x4 k[2], v[2]; };
DI void kv_load(const u16* kbase, const u16* vbase, int ldk, int ldv, int key0, KVRegs& r) {
  const int tid = otid();
#pragma unroll
  for (int i = 0; i < 2; ++i) {
    const int id = tid + 256 * i, row = id >> 3, ch = id & 7;
    r.k[i] = *(const u32x4*)(kbase + (size_t)(key0 + row) * ldk + ch * 8);
    r.v[i] = *(const u32x4*)(vbase + (size_t)(key0 + row) * ldv + ch * 8);
  }
}
DI void kv_store(u16* Ks, u16* Vs, const KVRegs& r) {
  const int tid = otid();
#pragma unroll
  for (int i = 0; i < 2; ++i) {
    const int id = tid + 256 * i, row = id >> 3, ch = id & 7;
    *(u32x4*)(Ks + row * KLD + ch * 8) = r.k[i];
    *(u32x4*)(Vs + row * KLD + ch * 8) = r.v[i];
  }
}
constexpr int KVBUF = 2 * 64 * KLD;
template <class UseF, class LoadF, class CompF>
DI void kv_pipeline(int j0, int j1, u16* buf, UseF use, LoadF load, CompF comp) {
  KVRegs kr;
  if (use(j0)) load(j0, kr);
  lds_barrier();
  if (use(j0)) kv_store(buf, buf + 64 * KLD, kr);
  if (j0 + 1 < j1 && use(j0 + 1)) load(j0 + 1, kr);
  lds_barrier();
  for (int j = j0; j < j1; ++j) {
    u16* cur = buf + ((j - j0) & 1) * KVBUF; u16* nxt = buf + (((j - j0) & 1) ^ 1) * KVBUF;
    if (j + 1 < j1 && use(j + 1)) kv_store(nxt, nxt + 64 * KLD, kr);
    if (j + 2 < j1 && use(j + 2)) load(j + 2, kr);
    if (use(j)) comp(j, cur, cur + 64 * KLD);
    lds_barrier();
  }
}
struct AttnAcc { f32x4 o[4][2]; float m[2], l[2]; f32x4 os[2]; int fresh; };
DI void attn_init(AttnAcc& a) {
#pragma unroll
  for (int d = 0; d < 4; ++d) { a.o[d][0] = (f32x4){0.f, 0.f, 0.f, 0.f}; a.o[d][1] = (f32x4){0.f, 0.f, 0.f, 0.f}; }
  a.m[0] = a.m[1] = -1e30f; a.l[0] = a.l[1] = 0.f;
}
template <int NKS>
DI void qk_tile(const u16* Ks, int dofs, const bf16x8 (&qf)[2][NKS], f32x4 (&s)[4][2], int l15, int g) {
#pragma unroll
  for (int kt = 0; kt < 4; ++kt) {
    s[kt][0] = (f32x4){0.f, 0.f, 0.f, 0.f}; s[kt][1] = (f32x4){0.f, 0.f, 0.f, 0.f};
#pragma unroll
    for (int ks = 0; ks < NKS; ++ks) {
      const bf16x8 a = ldfrag(Ks + (kt * 16 + l15) * KLD + dofs + ks * 32 + 8 * g);
      s[kt][0] = mfma16(a, qf[0][ks], s[kt][0]);
      s[kt][1] = mfma16(a, qf[1][ks], s[kt][1]);
    }
  }
}
DI void pv_accum(const bf16x8 (&pf)[2][2], const u16* Vs, f32x4 (&o)[4][2], int l15, int g) {
  const int tq = l15 >> 2, tp = l15 & 3;
#pragma unroll
  for (int kk = 0; kk < 2; ++kk)
#pragma unroll
    for (int d = 0; d < 4; ++d) {
      const bf16x8 vf = cat4(tr_read(Vs + (kk * 32 + 4 * g + tq) * KLD + d * 16 + 4 * tp), tr_read(Vs + (kk * 32 + 16 + 4 * g + tq) * KLD + d * 16 + 4 * tp));
      o[d][0] = mfma16(vf, pf[0][kk], o[d][0]);
      o[d][1] = mfma16(vf, pf[1][kk], o[d][1]);
    }
}
DI void pack_p(const f32x4 (&s)[4][2], bf16x8 (&pf)[2][2]) {
#pragma unroll
  for (int qt = 0; qt < 2; ++qt)
#pragma unroll
    for (int kk = 0; kk < 2; ++kk) {
      u32x4 w;
      w.x = pack2(s[2 * kk][qt][0], s[2 * kk][qt][1]); w.y = pack2(s[2 * kk][qt][2], s[2 * kk][qt][3]);
      w.z = pack2(s[2 * kk + 1][qt][0], s[2 * kk + 1][qt][1]); w.w = pack2(s[2 * kk + 1][qt][2], s[2 * kk + 1][qt][3]);
      pf[qt][kk] = __builtin_bit_cast(bf16x8, w);
    }
}
constexpr float DEFER_THR = 5.f;
template <class VF>
DI void softmax_pv(f32x4 (&s)[4][2], AttnAcc& a, const u16* Vs, float sc, int l15, int g, VF valid) {
  bf16x8 pf[2][2];
  float mxl[2];
#pragma unroll
  for (int qt = 0; qt < 2; ++qt) {
    float mx = -1e30f;
#pragma unroll
    for (int kt = 0; kt < 4; ++kt)
#pragma unroll
      for (int r = 0; r < 4; ++r) { const float v = valid(kt, r, qt) ? s[kt][qt][r] * sc : -1e30f; s[kt][qt][r] = v; mx = fmaxf(mx, v); }
    mxl[qt] = mx;
  }
  if (__any((mxl[0] > a.m[0] + DEFER_THR) || (mxl[1] > a.m[1] + DEFER_THR))) {
#pragma unroll
    for (int qt = 0; qt < 2; ++qt) {
      float mx = mxl[qt];
      mx = fmaxf(mx, __shfl_xor(mx, 16)); mx = fmaxf(mx, __shfl_xor(mx, 32));
      const float mn = fmaxf(a.m[qt], mx), alpha = exp2_(a.m[qt] - mn);
      a.m[qt] = mn; a.l[qt] *= alpha;
#pragma unroll
      for (int d = 0; d < 4; ++d) a.o[d][qt] *= alpha;
    }
  }
#pragma unroll
  for (int qt = 0; qt < 2; ++qt) {
    const float mn = a.m[qt];
    float ls = 0.f;
#pragma unroll
    for (int kt = 0; kt < 4; ++kt)
#pragma unroll
      for (int r = 0; r < 4; ++r) { const float v = s[kt][qt][r]; const float pv = v > -1e29f ? exp2_(v - mn) : 0.f; s[kt][qt][r] = pv; ls += pv; }
    a.l[qt] += ls;
  }
  pack_p(s, pf);
  pv_accum(pf, Vs, a.o, l15, g);
}
DI float group_sum4_(float v) { v += __shfl_xor(v, 16); v += __shfl_xor(v, 32); return v; }
DI bf16x8 scale_frag(bf16x8 f, float sc) {
  u32x4 w = __builtin_bit_cast(u32x4, f);
  w.x = pack2(bflo(w.x) * sc, bfhi(w.x) * sc); w.y = pack2(bflo(w.y) * sc, bfhi(w.y) * sc);
  w.z = pack2(bflo(w.z) * sc, bfhi(w.z) * sc); w.w = pack2(bflo(w.w) * sc, bfhi(w.w) * sc);
  return __builtin_bit_cast(bf16x8, w);
}
DI void attn_init_rel(AttnAcc& a) { attn_init(a); a.m[0] = a.m[1] = 0.f; a.os[0] = (f32x4){0.f, 0.f, 0.f, 0.f}; a.os[1] = (f32x4){0.f, 0.f, 0.f, 0.f}; a.fresh = 1; }
DI void rowsum_accum(const bf16x8 (&pf)[2][2], AttnAcc& a, int l15) {
  const short one = l15 == 0 ? (short)0x3F80 : (short)0;
  const bf16x8 ones = {one, one, one, one, one, one, one, one};
#pragma unroll
  for (int kk = 0; kk < 2; ++kk) { a.os[0] = mfma16(ones, pf[0][kk], a.os[0]); a.os[1] = mfma16(ones, pf[1][kk], a.os[1]); }
}
DI float rel_rowsum(const AttnAcc& a, int qt, int l15) { return __shfl(a.os[qt][0], l15); }
template <int NKS>
DI void qk_tile_rel(const u16* Ks, int dofs, const bf16x8 (&qf)[2][NKS], const AttnAcc& a, f32x4 (&s)[4][2], int l15, int g, bool ok0 = true, bool ok1 = true) {
  const float n0 = ok0 ? -a.m[0] : -1e30f, n1 = ok1 ? -a.m[1] : -1e30f;
#pragma unroll
  for (int kt = 0; kt < 4; ++kt) {
    s[kt][0] = (f32x4){n0, n0, n0, n0}; s[kt][1] = (f32x4){n1, n1, n1, n1};
#pragma unroll
    for (int ks = 0; ks < NKS; ++ks) {
      const bf16x8 k = ldfrag(Ks + (kt * 16 + l15) * KLD + dofs + ks * 32 + 8 * g);
      s[kt][0] = mfma16(k, qf[0][ks], s[kt][0]);
      s[kt][1] = mfma16(k, qf[1][ks], s[kt][1]);
    }
  }
}
template <int MODE, class VF>
DI void softmax_rel(f32x4 (&s)[4][2], AttnAcc& a, bf16x8 (&pf)[2][2], int l15_, VF valid, bool ok0 = true, bool ok1 = true) {
  float mxl[2];
#pragma unroll
  for (int qt = 0; qt < 2; ++qt) {
    float mx = -1e30f;
    const bool okq = qt == 0 ? ok0 : ok1;
#pragma unroll
    for (int kt = 0; kt < 4; ++kt)
#pragma unroll
      for (int r = 0; r < 4; ++r) {
        if (MODE == 1) s[kt][qt][r] = valid(kt, r, qt) ? s[kt][qt][r] : -1e30f;
        if (MODE == 2) s[kt][qt][r] = okq ? s[kt][qt][r] : -1e30f;
        mx = fmaxf(mx, s[kt][qt][r]);
      }
    mxl[qt] = mx;
  }
  if (a.fresh || __any(mxl[0] > DEFER_THR || mxl[1] > DEFER_THR)) {
    bool still = false;
#pragma unroll
    for (int qt = 0; qt < 2; ++qt) {
      float mx = mxl[qt];
      mx = fmaxf(mx, __shfl_xor(mx, 16)); mx = fmaxf(mx, __shfl_xor(mx, 32));
      const bool fresh = rel_rowsum(a, qt, l15_) == 0.f;
      const float dl = mx < -1e29f ? 0.f : (fresh ? mx : fmaxf(mx, 0.f)), alpha = exp2_(-dl);
      still = still || (fresh && mx < -1e29f);
      a.m[qt] += dl; a.os[qt] *= alpha;
#pragma unroll
      for (int d = 0; d < 4; ++d) a.o[d][qt] *= alpha;
#pragma unroll
      for (int kt = 0; kt < 4; ++kt)
#pragma unroll
        for (int r = 0; r < 4; ++r) s[kt][qt][r] -= dl;
    }
    a.fresh = __any(still) ? 1 : 0;
  }
#pragma unroll
  for (int qt = 0; qt < 2; ++qt)
#pragma unroll
    for (int kt = 0; kt < 4; ++kt)
#pragma unroll
      for (int r = 0; r < 4; ++r) s[kt][qt][r] = exp2_(s[kt][qt][r]);
  pack_p(s, pf);
}
DI float group_sum4(float v) { v += __shfl_xor(v, 16); v += __shfl_xor(v, 32); return v; }

constexpr int DSTAGE = 2 * 128 * 64;
DI int fKs(int row) { return (row >> 1) & 7; }
DI int fVs(int row) { return ((row >> 1) & 3) << 1; }
DI void kv_dma128(const u16* kbase, const u16* vbase, int ld, int key0, u16* stage, int tid) {
#pragma unroll
  for (int i = 0; i < 4; ++i) {
    const int id = tid + 256 * i, row = id >> 3, c8 = id & 7;
    __builtin_amdgcn_global_load_lds((const unsigned*)(kbase + (size_t)(key0 + row) * ld + ((c8 ^ fKs(row)) * 8)), (LDSP unsigned*)((LDSP char*)stage + id * 16), 16, 0, 0);
  }
#pragma unroll
  for (int i = 0; i < 4; ++i) {
    const int id = tid + 256 * i, row = id >> 3, c8 = id & 7;
    __builtin_amdgcn_global_load_lds((const unsigned*)(vbase + (size_t)(key0 + row) * ld + ((c8 ^ fVs(row)) * 8)), (LDSP unsigned*)((LDSP char*)(stage + 128 * 64) + id * 16), 16, 0, 0);
  }
}
template <int NKS>
DI void qk_tile_rel_sw(const u16* Kh, int dofs, const bf16x8 (&qf)[2][NKS], const AttnAcc& a, f32x4 (&s)[4][2], int l15, int g) {
  const float n0 = -a.m[0], n1 = -a.m[1];
  const int sw = (l15 >> 1) & 7;
#pragma unroll
  for (int kt = 0; kt < 4; ++kt) {
    s[kt][0] = (f32x4){n0, n0, n0, n0}; s[kt][1] = (f32x4){n1, n1, n1, n1};
#pragma unroll
    for (int ks = 0; ks < NKS; ++ks) {
      const bf16x8 k = ldfrag(Kh + (kt * 16 + l15) * 64 + ((((dofs >> 3) + ks * 4 + g) ^ sw) * 8));
      s[kt][0] = mfma16(k, qf[0][ks], s[kt][0]);
      s[kt][1] = mfma16(k, qf[1][ks], s[kt][1]);
    }
  }
}
DI void pv_accum_sw(const bf16x8 (&pf)[2][2], const u16* Vh, f32x4 (&o)[4][2], int l15, int g) {
  const int tq = l15 >> 2, tp = l15 & 3;
#pragma unroll
  for (int kk = 0; kk < 2; ++kk) {
    const int r0 = kk * 32 + 4 * g + tq, r1 = r0 + 16;
    const int f0 = fVs(r0), f1 = fVs(r1);
#pragma unroll
    for (int d = 0; d < 4; ++d) {
      const int lc = d * 2 + (tp >> 1);
      const bf16x8 vf = cat4(tr_read(Vh + r0 * 64 + ((lc ^ f0) * 8) + (tp & 1) * 4), tr_read(Vh + r1 * 64 + ((lc ^ f1) * 8) + (tp & 1) * 4));
      o[d][0] = mfma16(vf, pf[0][kk], o[d][0]);
      o[d][1] = mfma16(vf, pf[1][kk], o[d][1]);
    }
  }
}
DI void diff_attn_task(const Params& p, int layer, int b, int h, int qb, unsigned char* smem) {
  u16* Ks = (u16*)smem; u16* Vs = Ks + 64 * KLD;
  const int tid = otid(), lane = tid & 63, wid = tid >> 6, l15 = lane & 15, g = lane >> 4;
  const u16* proj = (const u16*)(p.ws + OFF_PROJ) + (size_t)b * SEQ * NP;
  const int q0w = qb * 128 + wid * 32;
  const float* lam = p.diff_lam + layer * 128;
  float s01 = 0.f, s23 = 0.f;
  for (int i = 0; i < 32; ++i) { s01 += lam[i] * lam[32 + i]; s23 += lam[64 + i] * lam[96 + i]; }
  const float lam_init = layer == 0 ? 0.2f : 0.35550906759096324f;
  const float lam_full = sgprf(__expf(s01) - __expf(s23) + lam_init);
  const float sc = 0.17677669529663687f * 1.4426950408889634f;
  const int ntile = 2 * qb + 2;
  const u16* vbase = proj + PB_V + h * 64;
  f32x4 res[4][2];
#pragma unroll 1
  for (int c = 0; c < 2; ++c) {
    const u16* kbase = proj + PB_K + h * 64;
    bf16x8 qf[2][1];
#pragma unroll
    for (int qt = 0; qt < 2; ++qt) qf[qt][0] = scale_frag(ldfrag(proj + (size_t)(q0w + qt * 16 + l15) * NP + PB_Q + h * 64 + c * 32 + 8 * g), sc);
    AttnAcc a; attn_init_rel(a);
    const int nst = qb + 1;
    asm volatile("s_waitcnt vmcnt(0)" ::: "memory");
    lds_barrier();
    kv_dma128(kbase, vbase, NP, 0, Ks, tid);
    asm volatile("s_waitcnt vmcnt(0)" ::: "memory");
    lds_barrier();
    for (int js = 0; js < nst; ++js) {
      const u16* st = Ks + (js & 1) * DSTAGE;
      if (js + 1 < nst) kv_dma128(kbase, vbase, NP, (js + 1) * 128, Ks + ((js + 1) & 1) * DSTAGE, tid);
#pragma unroll 1
      for (int hf = 0; hf < 2; ++hf) {
        const int key0 = js * 128 + hf * 64;
        if (key0 <= q0w + 31) {
          f32x4 s[4][2]; bf16x8 pf[2][2];
          auto valid = [&](int kt, int r, int qt) { return key0 + kt * 16 + 4 * g + r <= q0w + qt * 16 + l15; };
          qk_tile_rel_sw<1>(st + hf * 64 * 64, c * 32, qf, a, s, l15, g);
          if (key0 + 63 <= q0w) softmax_rel<0>(s, a, pf, l15, valid); else softmax_rel<1>(s, a, pf, l15, valid);
          pv_accum_sw(pf, st + 128 * 64 + hf * 64 * 64, a.o, l15, g);
          rowsum_accum(pf, a, l15);
        }
      }
      asm volatile("s_waitcnt vmcnt(0)" ::: "memory");
      lds_barrier();
    }
#pragma unroll
    for (int qt = 0; qt < 2; ++qt) {
      const float lt = rel_rowsum(a, qt, l15);
      const float inv = c == 0 ? 1.f / lt : -lam_full / lt;
#pragma unroll
      for (int d = 0; d < 4; ++d) res[d][qt] = c == 0 ? a.o[d][qt] * inv : res[d][qt] + a.o[d][qt] * inv;
    }
  }
  u16* Y = (u16*)(p.ws + OFF_H);
  const float* ng = p.diff_norm_g + layer * 64;
#pragma unroll
  for (int qt = 0; qt < 2; ++qt) {
    float ss = 0.f;
#pragma unroll
    for (int d = 0; d < 4; ++d) { const f32x4 v = res[d][qt]; ss += v[0] * v[0] + v[1] * v[1] + v[2] * v[2] + v[3] * v[3]; }
    ss = group_sum4(ss);
    const float rn = rsqrtf(ss * (1.f / 64.f) + 1e-6f) * (1.f - lam_init);
    const int t = q0w + qt * 16 + l15;
    const size_t row = (size_t)b * SEQ + t;
#pragma unroll
    for (int d = 0; d < 4; ++d) {
      const int dd = d * 16 + 4 * g;
      const f32x4 v = res[d][qt];
      const u32x2 zz = *(const u32x2*)(proj + (size_t)t * NP + PB_Z + h * 64 + dd);
      const f32x4 gg = *(const f32x4*)(ng + dd);
      u32x2 w;
      w.x = pack2(v[0] * rn * gg[0] * siluf(bflo(zz.x)), v[1] * rn * gg[1] * siluf(bfhi(zz.x)));
      w.y = pack2(v[2] * rn * gg[2] * siluf(bflo(zz.y)), v[3] * rn * gg[3] * siluf(bfhi(zz.y)));
      *(u32x2*)(Y + row * 1024 + Y_B + h * 64 + dd) = w;
    }
  }
}

template <int NKS>
DI void qk_tile1(const u16* Ks, const bf16x8 (&qf)[NKS], f32x4 (&s)[4], int l15, int g) {
#pragma unroll
  for (int kt = 0; kt < 4; ++kt) {
    s[kt] = (f32x4){0.f, 0.f, 0.f, 0.f};
#pragma unroll
    for (int ks = 0; ks < NKS; ++ks) s[kt] = mfma16(ldfrag(Ks + (kt * 16 + l15) * KLD + ks * 32 + 8 * g), qf[ks], s[kt]);
  }
}
DI void pv_accum1(const f32x4 (&s)[4], const u16* Vs, f32x4 (&o)[4], int l15, int g) {
  const int tq = l15 >> 2, tp = l15 & 3;
#pragma unroll
  for (int kk = 0; kk < 2; ++kk) {
    u32x4 w;
    w.x = pack2(s[2 * kk][0], s[2 * kk][1]); w.y = pack2(s[2 * kk][2], s[2 * kk][3]);
    w.z = pack2(s[2 * kk + 1][0], s[2 * kk + 1][1]); w.w = pack2(s[2 * kk + 1][2], s[2 * kk + 1][3]);
    const bf16x8 pf = __builtin_bit_cast(bf16x8, w);
#pragma unroll
    for (int d = 0; d < 4; ++d) {
      const bf16x8 vf = cat4(tr_read(Vs + (kk * 32 + 4 * g + tq) * KLD + d * 16 + 4 * tp), tr_read(Vs + (kk * 32 + 16 + 4 * g + tq) * KLD + d * 16 + 4 * tp));
      o[d] = mfma16(vf, pf, o[d]);
    }
  }
}

constexpr int SEQ_LDS_A = 0, SEQ_LDS_B = 128 * KLD * 2, SEQ_LDS_C = 2 * 128 * KLD * 2, SEQ_LDS_S = 3 * 128 * KLD * 2, SEQ_LDS_F = SEQ_LDS_S + 64 * KLD * 2;
constexpr int SEQ_LDS_HALO = SEQ_LDS_F + 4096;
constexpr int SEQ_LDS_CW = SEQ_LDS_HALO + 2 * 3 * 3 * 64 * 2;
DI float wave_scan_add(float x, int lane) {
#pragma unroll
  for (int o = 1; o < 64; o <<= 1) { const float y = __shfl_up(x, o); if (lane >= o) x += y; }
  return x;
}
DI float wave_scan_max(float x, int lane) {
#pragma unroll
  for (int o = 1; o < 64; o <<= 1) { const float y = __shfl_up(x, o); if (lane >= o) x = fmaxf(x, y); }
  return x;
}

DI void seq_fix_rows(const Params& p, int layer, int r0, int nrows) {
  u16* Y = (u16*)(p.ws + OFF_H);
  const u16* proj = (const u16*)(p.ws + OFF_PROJ);
  const int tid = otid(), lane = tid & 63, wv = tid >> 6;
  const bool ml = lane >= 32;
  const int ch = (lane & 31) * 8;
  const float* ng = ml ? p.ml_norm_g + layer * 64 + (ch & 63) : p.ssm_norm_g + layer * 256 + ch;
  const f32x4 g0 = *(const f32x4*)ng, g1 = *(const f32x4*)(ng + 4);
  for (int rb = wv * 4; rb < nrows; rb += 16) {
    u32x4 yv4[4], zv4[4], ov4[4];
#pragma unroll
    for (int j = 0; j < 4; ++j) {
      const size_t row = (size_t)(r0 + rb + j);
      yv4[j] = *(const u32x4*)(Y + row * 1024 + (ml ? Y_D : Y_C) + ch);
      zv4[j] = *(const u32x4*)(proj + row * NP + (ml ? PD_Z : PC_Z) + ch);
      ov4[j] = ml ? *(const u32x4*)(proj + row * NP + PD_O + ch) : (u32x4){0u, 0u, 0u, 0u};
    }
#pragma unroll
    for (int j = 0; j < 4; ++j) {
      const size_t row = (size_t)(r0 + rb + j);
      u16* yp = Y + row * 1024 + (ml ? Y_D : Y_C) + ch;
      const u32x4 yv = yv4[j], zv = zv4[j], ov = ov4[j];
      float v[8] = {bflo(yv.x), bfhi(yv.x), bflo(yv.y), bfhi(yv.y), bflo(yv.z), bfhi(yv.z), bflo(yv.w), bfhi(yv.w)};
      float z[8] = {bflo(zv.x), bfhi(zv.x), bflo(zv.y), bfhi(zv.y), bflo(zv.z), bfhi(zv.z), bflo(zv.w), bfhi(zv.w)};
      float ss = 0.f;
      if (ml) {
        const float o[8] = {bflo(ov.x), bfhi(ov.x), bflo(ov.y), bfhi(ov.y), bflo(ov.z), bfhi(ov.z), bflo(ov.w), bfhi(ov.w)};
#pragma unroll
        for (int i = 0; i < 8; ++i) { v[i] *= sigmoidf_(o[i]); ss += v[i] * v[i]; }
      } else {
#pragma unroll
        for (int i = 0; i < 8; ++i) { v[i] *= siluf(z[i]); ss += v[i] * v[i]; }
      }
      ss += __shfl_xor(ss, 1); ss += __shfl_xor(ss, 2); ss += __shfl_xor(ss, 4);
      const float ss16 = ss + __shfl_xor(ss, 8);
      const float rn = ml ? rsqrtf(ss * (1.f / 64.f) + 1e-6f) : rsqrtf(ss16 * (1.f / 128.f) + 1e-6f);
      float o8[8];
#pragma unroll
      for (int i = 0; i < 8; ++i) { const float gg = i < 4 ? g0[i & 3] : g1[i & 3]; o8[i] = v[i] * rn * gg * (ml ? siluf(z[i]) : 1.f); }
      u32x4 w; w.x = pack2(o8[0], o8[1]); w.y = pack2(o8[2], o8[3]); w.z = pack2(o8[4], o8[5]); w.w = pack2(o8[6], o8[7]);
      *(u32x4*)yp = w;
    }
  }
}


constexpr int SEQ8_LDS_F = SEQ_LDS_S + 64 * KLD * 2;
constexpr int SEQ8_LDS_HALO = SEQ8_LDS_F + 8192;
constexpr int SEQ8_LDS_CW = SEQ8_LDS_HALO + 2 * 3 * 3 * 64 * 2;
DI void stage_conv_w8(float* wl, const float* cw, const float* cb, int chan0, int nchan, int tid) {
  if (tid < 320) { const int j = tid >> 6, cc = tid & 63; wl[tid] = j < 4 ? cw[j * nchan + chan0 + cc] : cb[chan0 + cc]; }
}
DI void scale_rows8(u16* A, const float* rs, int tid) {
  const int ch = (tid & 7) * 8;
#pragma unroll
  for (int i = 0; i < 2; ++i) {
    const int row = (tid >> 3) + 64 * i;
    const float f = rs[row];
    u32x4 v = *(u32x4*)(A + row * KLD + ch);
    v.x = pack2(bflo(v.x) * f, bfhi(v.x) * f); v.y = pack2(bflo(v.y) * f, bfhi(v.y) * f);
    v.z = pack2(bflo(v.z) * f, bfhi(v.z) * f); v.w = pack2(bflo(v.w) * f, bfhi(v.w) * f);
    *(u32x4*)(A + row * KLD + ch) = v;
  }
}
DI void state_update8(const u16* Xs, const u16* Bs, f32x4 (&acc)[2], int w8, int l15, int g) {
  const int tq = l15 >> 2, tp = l15 & 3, pt = w8 >> 1, nt0 = (w8 & 1) * 2;
#pragma unroll
  for (int kk = 0; kk < 4; ++kk) {
    const bf16x8 af = cat4(tr_read(Xs + (kk * 32 + 4 * g + tq) * KLD + pt * 16 + 4 * tp), tr_read(Xs + (kk * 32 + 16 + 4 * g + tq) * KLD + pt * 16 + 4 * tp));
#pragma unroll
    for (int n = 0; n < 2; ++n) {
      const bf16x8 bfr = cat4(tr_read(Bs + (kk * 32 + 4 * g + tq) * KLD + (nt0 + n) * 16 + 4 * tp), tr_read(Bs + (kk * 32 + 16 + 4 * g + tq) * KLD + (nt0 + n) * 16 + 4 * tp));
      acc[n] = mfma16(af, bfr, acc[n]);
    }
  }
}
DI void state_to_lds8(u16* Ss, const f32x4 (&acc)[2], int w8, int l15, int g) {
  const int pt = w8 >> 1, nt0 = (w8 & 1) * 2;
#pragma unroll
  for (int n = 0; n < 2; ++n)
#pragma unroll
    for (int r = 0; r < 4; ++r) Ss[(pt * 16 + 4 * g + r) * KLD + (nt0 + n) * 16 + l15] = f2bf(acc[n][r]);
}

constexpr int SEQ8_LDS_ZERO = SEQ8_LDS_CW + 3 * 320 * 4;
constexpr int SEQ8_LDS_RAW = ((SEQ8_LDS_ZERO + 3 * 128 + 255) / 256) * 256;
DI void raw_dma8(const u16* projb, int col0, int t0, u16* raw, int tid) {
#pragma unroll
  for (int i = 0; i < 2; ++i) {
    const int chunk = tid + 512 * i;
    __builtin_amdgcn_global_load_lds((const unsigned*)(projb + (size_t)(t0 + (chunk >> 3)) * NP + col0 + (chunk & 7) * 8), (LDSP unsigned*)((LDSP char*)raw + chunk * 16), 16, 0, 0);
  }
}
DI void conv_raw8(const u16* raw, const u16* halo, const float* wl, const float* rowscale, float cscale, u16* dst, int tid) {
  const int q = tid >> 3, ch = (tid & 7) * 8;
  u32x4 v[5];
#pragma unroll
  for (int k = 0; k < 5; ++k) { const int r = 2 * q - 3 + k; v[k] = r >= 0 ? *(const u32x4*)(raw + r * 64 + ch) : *(const u32x4*)(halo + (r + 3) * 64 + ch); }
  float w[5][8];
#pragma unroll
  for (int j = 0; j < 5; ++j) { const f32x4 w0 = *(const f32x4*)(wl + j * 64 + ch), w1 = *(const f32x4*)(wl + j * 64 + ch + 4);
    w[j][0] = w0[0]; w[j][1] = w0[1]; w[j][2] = w0[2]; w[j][3] = w0[3]; w[j][4] = w1[0]; w[j][5] = w1[1]; w[j][6] = w1[2]; w[j][7] = w1[3]; }
#pragma unroll
  for (int o = 0; o < 2; ++o) {
    float acc[8];
#pragma unroll
    for (int i = 0; i < 8; ++i) acc[i] = w[4][i];
#pragma unroll
    for (int j = 0; j < 4; ++j) {
      const u32x4 x = v[o + j];
      acc[0] += w[j][0] * bflo(x.x); acc[1] += w[j][1] * bfhi(x.x); acc[2] += w[j][2] * bflo(x.y); acc[3] += w[j][3] * bfhi(x.y);
      acc[4] += w[j][4] * bflo(x.z); acc[5] += w[j][5] * bfhi(x.z); acc[6] += w[j][6] * bflo(x.w); acc[7] += w[j][7] * bfhi(x.w);
    }
    const float rs = (rowscale ? rowscale[2 * q + o] : 1.f) * cscale;
#pragma unroll
    for (int i = 0; i < 8; ++i) acc[i] = siluf(acc[i]) * rs;
    u32x4 ov; ov.x = pack2(acc[0], acc[1]); ov.y = pack2(acc[2], acc[3]); ov.z = pack2(acc[4], acc[5]); ov.w = pack2(acc[6], acc[7]);
    *(u32x4*)(dst + (2 * q + o) * KLD + ch) = ov;
  }
}
DI void save_halo8(const u16* raw, u16* halo, int tid) {
  if (tid < 72) { const int arr = tid / 24, rem = tid % 24; *(u32x4*)(halo + arr * 192 + rem * 8) = *(const u32x4*)(raw + arr * 8192 + 125 * 64 + rem * 8); }
}

DI void ssd_task8(const Params& p, int layer, int b, int h, unsigned char* smem) {
  u16* Cs = (u16*)(smem + SEQ_LDS_A); u16* Bs = (u16*)(smem + SEQ_LDS_B); u16* Xs = (u16*)(smem + SEQ_LDS_C); u16* Ss = (u16*)(smem + SEQ_LDS_S);
  float* fl = (float*)(smem + SEQ8_LDS_F);
  float* dts = fl; float* acs = fl + 128; float* wend = fl + 256; float* tmp = fl + 384;
  u16* halo = (u16*)(smem + SEQ8_LDS_HALO); float* cwl = (float*)(smem + SEQ8_LDS_CW); u16* zero3 = (u16*)(smem + SEQ8_LDS_ZERO);
  u16* raw = (u16*)(smem + SEQ8_LDS_RAW);
  int tid = otid512(), lane = tid & 63, w = tid >> 6, l15 = lane & 15, g = lane >> 4;
  const int gi = h >> 1;
  const u16* projb = (const u16*)(p.ws + OFF_PROJ) + (size_t)b * SEQ * NP;
  const float* smb = (const float*)(p.ws + OFF_SMALL) + (size_t)b * SEQ * NSMALL;
  const float* cw = p.ssm_conv_w + layer * 4 * 512; const float* cb = p.ssm_conv_b + layer * 512;
  u16* Y = (u16*)(p.ws + OFF_H);
  const float a_h = sgprf(-__expf(p.ssm_a_log[layer * 4 + h])), d_h = sgprf(p.ssm_d[layer * 4 + h]), dtb = sgprf(p.ssm_dt_bias[layer * 4 + h]);
  const int colB = PC_XBC + 256 + gi * 64, colC = PC_XBC + 384 + gi * 64, colX = PC_XBC + h * 64;
  f32x4 st[2] = {(f32x4){0.f, 0.f, 0.f, 0.f}, (f32x4){0.f, 0.f, 0.f, 0.f}};
  lds_barrier();
  stage_conv_w8(cwl, cw, cb, 256 + gi * 64, 512, tid);
  stage_conv_w8(cwl + 320, cw, cb, 384 + gi * 64, 512, tid);
  stage_conv_w8(cwl + 640, cw, cb, h * 64, 512, tid);
  if (tid < 96) ((unsigned*)zero3)[tid] = 0u;
  raw_dma8(projb, colB, 0, raw, tid); raw_dma8(projb, colC, 0, raw + 8192, tid); raw_dma8(projb, colX, 0, raw + 16384, tid);
  float dtraw = 0.f;
  if (tid < 128) dtraw = smb[(size_t)tid * NSMALL + SM_DT + h];
#pragma unroll 1
  for (int c = 0; c < 32; ++c) {
    const int t0 = c * 128;
    asm volatile("" : "+v"(tid)); lane = tid & 63; w = tid >> 6; l15 = lane & 15; g = lane >> 4;
    float dtv = 0.f;
    if (tid < 128) { const float xr = dtraw + dtb; dtv = xr > 15.f ? xr : (xr < -15.f ? __expf(xr) : __logf(1.f + __expf(xr))); }
    float cs = wave_scan_add(dtv * a_h, lane);
    if (tid == 63) tmp[0] = cs;
    asm volatile("s_waitcnt vmcnt(0)" ::: "memory");
    lds_barrier();
    if (w == 1) cs += tmp[0];
    if (tid < 128) { dts[tid] = dtv; acs[tid] = cs; }
    if (c + 1 < 32 && tid < 128) dtraw = smb[(size_t)(t0 + 128 + tid) * NSMALL + SM_DT + h];
    lds_barrier();
    {
      const u16* hc = halo + (c & 1) * 576;
      const u16* hB = c == 0 ? zero3 : hc; const u16* hC = c == 0 ? zero3 : hc + 192; const u16* hX = c == 0 ? zero3 : hc + 384;
      conv_raw8(raw, hB, cwl, nullptr, 1.f, Bs, tid);
      conv_raw8(raw + 8192, hC, cwl + 320, nullptr, 1.f, Cs, tid);
      conv_raw8(raw + 16384, hX, cwl + 640, dts, 1.f, Xs, tid);
      save_halo8(raw, halo + ((c + 1) & 1) * 576, tid);
    }
    if (tid < 128) wend[tid] = __expf(acs[127] - acs[tid]);
    state_to_lds8(Ss, st, w, l15, g);
    lds_barrier();
    if (c + 1 < 32) { raw_dma8(projb, colB, t0 + 128, raw, tid); raw_dma8(projb, colC, t0 + 128, raw + 8192, tid); raw_dma8(projb, colX, t0 + 128, raw + 16384, tid); }
    {
      const int tl = 16 * w + l15;
      bf16x8 cf[2];
#pragma unroll
      for (int ks = 0; ks < 2; ++ks) cf[ks] = ldfrag(Cs + tl * KLD + ks * 32 + 8 * g);
      f32x4 y[4];
#pragma unroll
      for (int d = 0; d < 4; ++d) y[d] = (f32x4){0.f, 0.f, 0.f, 0.f};
      const float at = acs[tl];
#pragma unroll 1
      for (int stl = 0; stl < 2; ++stl) {
        if (stl * 64 <= 16 * w + 15) {
          f32x4 sc[4];
          qk_tile1<2>(Bs + stl * 64 * KLD, cf, sc, l15, g);
#pragma unroll
          for (int kt = 0; kt < 4; ++kt) {
            const f32x4 as = *(const f32x4*)(acs + stl * 64 + kt * 16 + 4 * g);
#pragma unroll
            for (int r = 0; r < 4; ++r) {
              const bool ok = stl * 64 + kt * 16 + 4 * g + r <= tl;
              sc[kt][r] = ok ? sc[kt][r] * __expf(at - as[r]) : 0.f;
            }
          }
          pv_accum1(sc, Xs + stl * 64 * KLD, y, l15, g);
        }
      }
      const float ea = __expf(at), dsk = d_h / dts[tl];
      const size_t row = (size_t)b * SEQ + t0 + tl;
#pragma unroll
      for (int d = 0; d < 4; ++d) {
        f32x4 yo = (f32x4){0.f, 0.f, 0.f, 0.f};
#pragma unroll
        for (int ks = 0; ks < 2; ++ks) yo = mfma16(ldfrag(Ss + (d * 16 + l15) * KLD + ks * 32 + 8 * g), cf[ks], yo);
        const u32x2 xv = *(const u32x2*)(Xs + tl * KLD + d * 16 + 4 * g);
        const f32x4 v = y[d] + yo * ea;
        u32x2 o; o.x = pack2(v[0] + dsk * bflo(xv.x), v[1] + dsk * bfhi(xv.x)); o.y = pack2(v[2] + dsk * bflo(xv.y), v[3] + dsk * bfhi(xv.y));
        *(u32x2*)(Y + row * 1024 + Y_C + h * 64 + d * 16 + 4 * g) = o;
      }
    }
    lds_barrier();
    scale_rows8(Xs, wend, tid);
    lds_barrier();
    const float cd = __expf(acs[127]);
    st[0] *= cd; st[1] *= cd;
    state_update8(Xs, Bs, st, w, l15, g);
  }
  asm volatile("s_waitcnt vmcnt(0)" ::: "memory");
}

DI void mlstm_task8(const Params& p, int layer, int b, int h, unsigned char* smem) {
  u16* Qs = (u16*)(smem + SEQ_LDS_A); u16* Ks2 = (u16*)(smem + SEQ_LDS_B); u16* Vs2 = (u16*)(smem + SEQ_LDS_C); u16* Cst = (u16*)(smem + SEQ_LDS_S);
  float* fl = (float*)(smem + SEQ8_LDS_F);
  float* bcs = fl; float* us = fl + 128; float* pms = fl + 256; float* wend = fl + 384; float* nst = fl + 512; float* tmp = fl + 576; float* npart = fl + 640;
  u16* halo = (u16*)(smem + SEQ8_LDS_HALO); float* cwl = (float*)(smem + SEQ8_LDS_CW); u16* zero3 = (u16*)(smem + SEQ8_LDS_ZERO);
  u16* raw = (u16*)(smem + SEQ8_LDS_RAW);
  int tid = otid512(), lane = tid & 63, w = tid >> 6, l15 = lane & 15, g = lane >> 4;
  const u16* projb = (const u16*)(p.ws + OFF_PROJ) + (size_t)b * SEQ * NP;
  const float* smb = (const float*)(p.ws + OFF_SMALL) + (size_t)b * SEQ * NSMALL;
  const float* cw = p.ml_conv_w + layer * 4 * 512; const float* cb = p.ml_conv_b + layer * 512;
  const float ib = sgprf(p.ml_if_b[layer * 8 + h]), fb = sgprf(p.ml_if_b[layer * 8 + 4 + h]);
  u16* Y = (u16*)(p.ws + OFF_H);
  const int colQ = PD_QK + h * 64, colK = PD_QK + 256 + h * 64, colV = PD_V + h * 64;
  f32x4 st[2] = {(f32x4){0.f, 0.f, 0.f, 0.f}, (f32x4){0.f, 0.f, 0.f, 0.f}};
  float m_prev = 0.f;
  lds_barrier();
  if (tid < 64) nst[tid] = 0.f;
  stage_conv_w8(cwl, cw, cb, h * 64, 512, tid);
  stage_conv_w8(cwl + 320, cw, cb, 256 + h * 64, 512, tid);
  if (tid < 96) ((unsigned*)zero3)[tid] = 0u;
  raw_dma8(projb, colQ, 0, raw, tid); raw_dma8(projb, colK, 0, raw + 8192, tid); raw_dma8(projb, colV, 0, raw + 16384, tid);
  float iraw = 0.f, fraw = 0.f;
  if (tid < 128) { iraw = smb[(size_t)tid * NSMALL + SM_IF + h]; fraw = smb[(size_t)tid * NSMALL + SM_IF + 4 + h]; }
#pragma unroll 1
  for (int c = 0; c < 32; ++c) {
    const int t0 = c * 128;
    asm volatile("" : "+v"(tid)); lane = tid & 63; w = tid >> 6; l15 = lane & 15; g = lane >> 4;
    float ip = 0.f, lf = 0.f;
    if (tid < 128) { ip = iraw + ib; const float fp = fraw + fb; lf = fminf(fp, 0.f) - __logf(1.f + __expf(-fabsf(fp))); }
    float bc = wave_scan_add(lf, lane);
    if (tid == 63) tmp[0] = bc;
    asm volatile("s_waitcnt vmcnt(0)" ::: "memory");
    lds_barrier();
    if (w == 1) bc += tmp[0];
    const float u = tid < 128 ? ip - bc : -1e30f;
    float pm = wave_scan_max(u, lane);
    if (tid == 63) tmp[1] = pm;
    if (c + 1 < 32 && tid < 128) { iraw = smb[(size_t)(t0 + 128 + tid) * NSMALL + SM_IF + h]; fraw = smb[(size_t)(t0 + 128 + tid) * NSMALL + SM_IF + 4 + h]; }
    {
      const u16* hc = halo + (c & 1) * 576;
      const u16* hQ = c == 0 ? zero3 : hc; const u16* hK = c == 0 ? zero3 : hc + 192;
      conv_raw8(raw, hQ, cwl, nullptr, 1.f, Qs, tid);
      conv_raw8(raw + 8192, hK, cwl + 320, nullptr, 0.125f, Ks2, tid);
      save_halo8(raw, halo + ((c + 1) & 1) * 576, tid);
#pragma unroll
      for (int i = 0; i < 2; ++i) { const int chunk = tid + 512 * i; *(u32x4*)(Vs2 + (chunk >> 3) * KLD + (chunk & 7) * 8) = *(const u32x4*)(raw + 16384 + chunk * 8); }
    }
    state_to_lds8(Cst, st, w, l15, g);
    lds_barrier();
    if (w == 1) pm = fmaxf(pm, tmp[1]);
    if (tid < 128) { bcs[tid] = bc; us[tid] = u; pms[tid] = pm; }
    if (c + 1 < 32) { raw_dma8(projb, colQ, t0 + 128, raw, tid); raw_dma8(projb, colK, t0 + 128, raw + 8192, tid); raw_dma8(projb, colV, t0 + 128, raw + 16384, tid); }
    lds_barrier();
    const float blast = bcs[127];
    const float m_new = blast + fmaxf(m_prev, pms[127]);
    if (tid < 128) wend[tid] = __expf(blast - m_new + us[tid]);
    {
      const int tl = 16 * w + l15;
      bf16x8 qf[2];
#pragma unroll
      for (int ks = 0; ks < 2; ++ks) qf[ks] = ldfrag(Qs + tl * KLD + ks * 32 + 8 * g);
      f32x4 num[4];
#pragma unroll
      for (int d = 0; d < 4; ++d) num[d] = (f32x4){0.f, 0.f, 0.f, 0.f};
      const float bt = bcs[tl], mt = bt + fmaxf(m_prev, pms[tl]);
      float den = 0.f;
#pragma unroll 1
      for (int stl = 0; stl < 2; ++stl) {
        if (stl * 64 <= 16 * w + 15) {
          f32x4 sc[4];
          qk_tile1<2>(Ks2 + stl * 64 * KLD, qf, sc, l15, g);
#pragma unroll
          for (int kt = 0; kt < 4; ++kt) {
            const f32x4 uu = *(const f32x4*)(us + stl * 64 + kt * 16 + 4 * g);
#pragma unroll
            for (int r = 0; r < 4; ++r) {
              const bool ok = stl * 64 + kt * 16 + 4 * g + r <= tl;
              const float v = ok ? sc[kt][r] * __expf(bt - mt + uu[r]) : 0.f;
              sc[kt][r] = v; den += v;
            }
          }
          pv_accum1(sc, Vs2 + stl * 64 * KLD, num, l15, g);
        }
      }
      const float wi = __expf(bt + m_prev - mt);
      float qn = 0.f;
#pragma unroll
      for (int ks = 0; ks < 2; ++ks)
#pragma unroll
        for (int j = 0; j < 8; ++j) qn += bf2f((u16)qf[ks][j]) * nst[ks * 32 + 8 * g + j];
      qn = group_sum4(qn);
      const float dn = group_sum4(den) + wi * qn;
      const float inv = __builtin_amdgcn_rcpf(fmaxf(fabsf(dn), __expf(-mt)));
      const size_t row = (size_t)b * SEQ + t0 + tl;
#pragma unroll
      for (int d = 0; d < 4; ++d) {
        f32x4 ni = (f32x4){0.f, 0.f, 0.f, 0.f};
#pragma unroll
        for (int ks = 0; ks < 2; ++ks) ni = mfma16(ldfrag(Cst + (d * 16 + l15) * KLD + ks * 32 + 8 * g), qf[ks], ni);
        const f32x4 v = (num[d] + ni * wi) * inv;
        u32x2 o; o.x = pack2(v[0], v[1]); o.y = pack2(v[2], v[3]);
        *(u32x2*)(Y + row * 1024 + Y_D + h * 64 + d * 16 + 4 * g) = o;
      }
    }
    lds_barrier();
    scale_rows8(Ks2, wend, tid);
    lds_barrier();
    const float fprev = __expf(blast + m_prev - m_new);
    st[0] *= fprev; st[1] *= fprev;
    state_update8(Vs2, Ks2, st, w, l15, g);
    {
      const int e = tid & 63, part = tid >> 6;
      float a = 0.f;
#pragma unroll
      for (int s2 = 0; s2 < 16; ++s2) a += bf2f(Ks2[(part * 16 + s2) * KLD + e]);
      npart[part * 64 + e] = a;
    }
    lds_barrier();
    if (tid < 64) {
      float a = nst[tid] * fprev;
#pragma unroll
      for (int pp = 0; pp < 8; ++pp) a += npart[pp * 64 + tid];
      nst[tid] = a;
    }
    m_prev = m_new;
  }
  asm volatile("s_waitcnt vmcnt(0)" ::: "memory");
}

DI void compress_task(const Params& p, int layer, int b, int kv, int rb, unsigned char* smem) {
  constexpr int HLD = 136;
  u16* Hs = (u16*)smem;
  const int tid = otid(), lane = tid & 63, w = tid >> 6, l15 = lane & 15, g = lane >> 4;
  const u16* projb = (const u16*)(p.ws + OFF_PROJ) + (size_t)b * SEQ * NP + (kv ? PA_VC : PA_KC);
  const int mi = layer * 2 + kv;
  const u16* W1T = (const u16*)(p.ws + OFF_W1T) + (size_t)mi * 128 * 2048;
  const u16* W2T = (const u16*)(p.ws + OFF_W2T) + (size_t)mi * 64 * 128;
  const float* bias1 = (const float*)(p.ws + OFF_BIAS1) + mi * 16 * 128;
  f32x4 acc[2][2];
#pragma unroll
  for (int nt = 0; nt < 2; ++nt) { acc[nt][0] = (f32x4){0.f, 0.f, 0.f, 0.f}; acc[nt][1] = (f32x4){0.f, 0.f, 0.f, 0.f}; }
  int tok[2];
#pragma unroll
  for (int mt = 0; mt < 2; ++mt) { int i = rb * 32 + mt * 16 + l15; if (i > 254) i = 254; tok[mt] = 16 * i; }
#pragma unroll 4
  for (int ks = 0; ks < 64; ++ks) {
    const int j = ks >> 1, d0 = (ks & 1) * 32;
    bf16x8 af[2], wf[2];
#pragma unroll
    for (int mt = 0; mt < 2; ++mt) af[mt] = ldfrag(projb + (size_t)(tok[mt] + j) * NP + d0 + 8 * g);
#pragma unroll
    for (int nt = 0; nt < 2; ++nt) wf[nt] = ldfrag(W1T + (size_t)(w * 32 + nt * 16 + l15) * 2048 + ks * 32 + 8 * g);
#pragma unroll
    for (int nt = 0; nt < 2; ++nt)
#pragma unroll
      for (int mt = 0; mt < 2; ++mt) acc[nt][mt] = mfma16(wf[nt], af[mt], acc[nt][mt]);
  }
  lds_barrier();
#pragma unroll
  for (int nt = 0; nt < 2; ++nt) {
    const int n = w * 32 + nt * 16 + 4 * g;
    f32x4 bb = *(const f32x4*)(bias1 + n);
#pragma unroll
    for (int pc = 1; pc < 16; ++pc) bb += *(const f32x4*)(bias1 + pc * 128 + n);
#pragma unroll
    for (int mt = 0; mt < 2; ++mt) {
      const f32x4 v = acc[nt][mt] + bb;
      u32x2 o; o.x = pack2(siluf(v[0]), siluf(v[1])); o.y = pack2(siluf(v[2]), siluf(v[3]));
      *(u32x2*)(Hs + (mt * 16 + l15) * HLD + n) = o;
    }
  }
  lds_barrier();
  f32x4 acc2[2] = {(f32x4){0.f, 0.f, 0.f, 0.f}, (f32x4){0.f, 0.f, 0.f, 0.f}};
#pragma unroll
  for (int ks = 0; ks < 4; ++ks) {
    const bf16x8 wf = ldfrag(W2T + (size_t)(w * 16 + l15) * 128 + ks * 32 + 8 * g);
#pragma unroll
    for (int mt = 0; mt < 2; ++mt) acc2[mt] = mfma16(wf, ldfrag(Hs + (mt * 16 + l15) * HLD + ks * 32 + 8 * g), acc2[mt]);
  }
  u16* dst = (u16*)(p.ws + (kv ? OFF_VCMP : OFF_KCMP) + (size_t)layer * 512 * 1024) + (size_t)b * 256 * 64;
#pragma unroll
  for (int mt = 0; mt < 2; ++mt) {
    const int i = rb * 32 + mt * 16 + l15;
    u32x2 o; o.x = pack2(acc2[mt][0], acc2[mt][1]); o.y = pack2(acc2[mt][2], acc2[mt][3]);
    if (i > 254) { o.x = 0u; o.y = 0u; }
    *(u32x2*)(dst + (size_t)i * 64 + w * 16 + 4 * g) = o;
  }
}

DI void nsa_task(const Params& p, int layer, int b, int qi, unsigned char* smem) {
  u16* Ks = (u16*)smem; u16* Vs = Ks + 64 * KLD;
  float* T = (float*)(smem + 2 * KVBUF * 2);
  unsigned long long* selm = (unsigned long long*)(smem + 2 * KVBUF * 2 + 4 * 32 * 65 * 4);
  const int tid = otid(), lane = tid & 63, h = tid >> 6, l15 = lane & 15, g = lane >> 4;
  const int q0 = qi * 32;
  const u16* projb = (const u16*)(p.ws + OFF_PROJ) + (size_t)b * SEQ * NP;
  const float* smb = (const float*)(p.ws + OFF_SMALL) + (size_t)b * SEQ * NSMALL;
  const u16* kcmp = (const u16*)(p.ws + OFF_KCMP + (size_t)layer * 512 * 1024) + (size_t)b * 256 * 64;
  const u16* vcmp = (const u16*)(p.ws + OFF_VCMP + (size_t)layer * 512 * 1024) + (size_t)b * 256 * 64;
  bf16x8 qf[2][2];
#pragma unroll
  for (int qt = 0; qt < 2; ++qt)
#pragma unroll
    for (int ks = 0; ks < 2; ++ks) qf[qt][ks] = ldfrag(projb + (size_t)(q0 + qt * 16 + l15) * NP + PA_Q + h * 64 + ks * 32 + 8 * g);
  const float sc = 0.125f * 1.4426950408889634f;
  f32x4 outacc[4][2];
  AttnAcc a;
  const int ntc = (q0 >> 10) + 1;
  attn_init(a);
  lds_barrier();
  for (int i = tid; i < 4 * 32 * 65; i += 256) T[i] = 0.f;
  kv_pipeline(0, ntc, Ks,
    [&](int) { return true; },
    [&](int j, KVRegs& kr) { kv_load(kcmp, vcmp, 64, 64, j * 64, kr); },
    [&](int j, const u16* Kt, const u16* Vt) {
      f32x4 s[4][2];
      auto valid = [&](int kt, int r, int qt) { return 16 * (j * 64 + kt * 16 + 4 * g + r) + 31 <= q0 + qt * 16 + l15; };
      qk_tile<2>(Kt, 0, qf, s, l15, g);
      softmax_pv(s, a, Vt, sc, l15, g, valid);
    });
  float cinv[2];
#pragma unroll
  for (int qt = 0; qt < 2; ++qt) {
    const float lt = group_sum4(a.l[qt]);
    cinv[qt] = lt > 0.f ? 1.f / lt : 0.f;
    const float gt = sigmoidf_(smb[(size_t)(q0 + qt * 16 + l15) * NSMALL + SM_G + h * 3 + 0]) * cinv[qt];
#pragma unroll
    for (int d = 0; d < 4; ++d) outacc[d][qt] = a.o[d][qt] * gt;
  }
  float carry[2] = {0.f, 0.f};
  kv_pipeline(0, ntc, Ks,
    [&](int) { return true; },
    [&](int j, KVRegs& kr) { kv_load(kcmp, vcmp, 64, 64, j * 64, kr); },
    [&](int j, const u16* Kt, const u16*) {
      f32x4 s[4][2];
      qk_tile<2>(Kt, 0, qf, s, l15, g);
#pragma unroll
      for (int qt = 0; qt < 2; ++qt) {
        float prev3 = carry[qt];
#pragma unroll
        for (int kt = 0; kt < 4; ++kt) {
          float pr[4];
#pragma unroll
          for (int r = 0; r < 4; ++r) {
            const bool ok = 16 * (j * 64 + kt * 16 + 4 * g + r) + 31 <= q0 + qt * 16 + l15;
            pr[r] = ok ? exp2_(s[kt][qt][r] * sc - a.m[qt]) * cinv[qt] : 0.f;
          }
          const float below = __shfl_up(pr[3], 16);
          const float wrap = __shfl(prev3, l15 + 48);
          const float nb = g > 0 ? below : wrap;
          T[(h * 32 + qt * 16 + l15) * 65 + j * 16 + kt * 4 + g] = (pr[0] + pr[1]) + (pr[2] + 0.5f * pr[3]) + 0.5f * nb;
          prev3 = pr[3];
        }
        carry[qt] = prev3;
      }
    });
  lds_barrier();
#pragma unroll 1
  for (int qq = 0; qq < 8; ++qq) {
    const int q = h * 8 + qq, t = q0 + q, cur = t >> 6;
    const float imp = ((T[(0 * 32 + q) * 65 + lane] + T[(1 * 32 + q) * 65 + lane]) + T[(2 * 32 + q) * 65 + lane]) + T[(3 * 32 + q) * 65 + lane];
    const bool forced = lane == cur || lane == 0, allowed = lane <= cur, cand = allowed && !forced;
    const int K = cur == 0 ? 15 : 14;
    unsigned long long m;
    if (__popcll(__ballot(cand)) <= K) m = __ballot(allowed);
    else {
      const unsigned key = __float_as_uint(imp);
      unsigned prefix = 0u;
#pragma unroll 1
      for (int bit = 30; bit >= 0; --bit) {
        const unsigned cnd = prefix | (1u << bit);
        if (__popcll(__ballot(cand && key >= cnd)) >= K) prefix = cnd;
      }
      const unsigned long long gt = __ballot(cand && key > prefix), eq = __ballot(cand && key == prefix);
      const int need = K - __popcll(gt);
      const int myrank = __popcll(eq & ((1ull << lane) - 1ull));
      m = gt | __ballot(cand && key == prefix && myrank < need) | __ballot(forced);
    }
    if (lane == 0) selm[q] = m;
  }
  lds_barrier();
  f32x4* park = (f32x4*)T + (h * 8) * 64 + lane;
#pragma unroll
  for (int d = 0; d < 4; ++d) { park[(d * 2 + 0) * 64] = outacc[d][0]; park[(d * 2 + 1) * 64] = outacc[d][1]; }
  unsigned long long mq[2], anym = 0ull;
#pragma unroll
  for (int qt = 0; qt < 2; ++qt) mq[qt] = selm[qt * 16 + l15];
  for (int i = 0; i < 32; ++i) anym |= selm[i];
  const int jhi = (q0 + 31) >> 6;
#pragma unroll
  for (int qt = 0; qt < 2; ++qt)
#pragma unroll
    for (int ks = 0; ks < 2; ++ks) qf[qt][ks] = scale_frag(qf[qt][ks], sc);
  attn_init_rel(a);
  kv_pipeline(0, jhi + 1, Ks,
    [&](int j) { return (bool)((anym >> j) & 1ull); },
    [&](int j, KVRegs& kr) { kv_load(projb + PA_KS, projb + PA_VS, NP, NP, j * 64, kr); },
    [&](int j, const u16* Kt, const u16* Vt) {
      f32x4 s[4][2];
      auto valid = [&](int kt, int r, int qt) { return ((mq[qt] >> j) & 1ull) && (j * 64 + kt * 16 + 4 * g + r <= q0 + qt * 16 + l15); };
      bf16x8 pf[2][2];
      if (j * 64 + 63 <= q0) {
        qk_tile_rel<2>(Kt, 0, qf, a, s, l15, g, (bool)((mq[0] >> j) & 1ull), (bool)((mq[1] >> j) & 1ull));
        softmax_rel<0>(s, a, pf, l15, valid);
      } else {
        qk_tile_rel<2>(Kt, 0, qf, a, s, l15, g);
        softmax_rel<1>(s, a, pf, l15, valid);
      }
      pv_accum(pf, Vt, a.o, l15, g);
      rowsum_accum(pf, a, l15);
    });
#pragma unroll
  for (int qt = 0; qt < 2; ++qt) {
    const float lt = rel_rowsum(a, qt, l15);
    const float gt = sigmoidf_(smb[(size_t)(q0 + qt * 16 + l15) * NSMALL + SM_G + h * 3 + 1]) * (lt > 0.f ? 1.f / lt : 0.f);
#pragma unroll
    for (int d = 0; d < 4; ++d) park[(d * 2 + qt) * 64] += a.o[d][qt] * gt;
  }
  attn_init_rel(a);
  const int jlo = q0 >= 511 ? (q0 - 511) >> 6 : 0;
  kv_pipeline(jlo, jhi + 1, Ks,
    [&](int) { return true; },
    [&](int j, KVRegs& kr) { kv_load(projb + PA_KW, projb + PA_VW, NP, NP, j * 64, kr); },
    [&](int j, const u16* Kt, const u16* Vt) {
      f32x4 s[4][2];
      auto valid = [&](int kt, int r, int qt) { const int key = j * 64 + kt * 16 + 4 * g + r, t = q0 + qt * 16 + l15; return key <= t && key + 512 > t; };
      bf16x8 pf[2][2];
      qk_tile_rel<2>(Kt, 0, qf, a, s, l15, g);
      if (j * 64 + 63 <= q0 && j * 64 + 512 > q0 + 31) softmax_rel<0>(s, a, pf, l15, valid);
      else softmax_rel<1>(s, a, pf, l15, valid);
      pv_accum(pf, Vt, a.o, l15, g);
      rowsum_accum(pf, a, l15);
    });
  u16* Y = (u16*)(p.ws + OFF_H);
  const float* ng = p.nsa_norm_g + layer * 64;
#pragma unroll
  for (int qt = 0; qt < 2; ++qt) {
    const int t = q0 + qt * 16 + l15;
    const float lt = rel_rowsum(a, qt, l15);
    const float gt = sigmoidf_(smb[(size_t)t * NSMALL + SM_G + h * 3 + 2]) * (lt > 0.f ? 1.f / lt : 0.f);
    f32x4 v[4]; float ss = 0.f;
#pragma unroll
    for (int d = 0; d < 4; ++d) { v[d] = park[(d * 2 + qt) * 64] + a.o[d][qt] * gt; ss += v[d][0] * v[d][0] + v[d][1] * v[d][1] + v[d][2] * v[d][2] + v[d][3] * v[d][3]; }
    ss = group_sum4(ss);
    const float rn = rsqrtf(ss * (1.f / 64.f) + 1e-6f);
    const size_t row = (size_t)b * SEQ + t;
#pragma unroll
    for (int d = 0; d < 4; ++d) {
      const int dd = d * 16 + 4 * g;
      const u32x2 zz = *(const u32x2*)(projb + (size_t)t * NP + PA_Z + h * 64 + dd);
      const f32x4 gg = *(const f32x4*)(ng + dd);
      u32x2 o;
      o.x = pack2(v[d][0] * rn * gg[0] * siluf(bflo(zz.x)), v[d][1] * rn * gg[1] * siluf(bfhi(zz.x)));
      o.y = pack2(v[d][2] * rn * gg[2] * siluf(bflo(zz.y)), v[d][3] * rn * gg[3] * siluf(bfhi(zz.y)));
      *(u32x2*)(Y + row * 1024 + Y_A + h * 64 + dd) = o;
    }
  }
}


DI void final_norm_rows(const Params& p, int rbase, int nrows, int gw, int nw, int lane) {
  const float4* gp = (const float4*)p.final_g;
  float4 gg[4];
#pragma unroll
  for (int i = 0; i < 4; ++i) gg[i] = gp[lane + 64 * i];
  for (int row0 = rbase + gw * 4; row0 < rbase + nrows; row0 += nw * 4) {
    float4 v[4][4]; float ss[4];
#pragma unroll
    for (int j = 0; j < 4; ++j) {
      const float4* xr = (const float4*)(p.out + (size_t)(row0 + j) * D_MODEL);
#pragma unroll
      for (int i = 0; i < 4; ++i) v[j][i] = xr[lane + 64 * i];
    }
#pragma unroll
    for (int j = 0; j < 4; ++j) {
      float a = 0.f;
#pragma unroll
      for (int i = 0; i < 4; ++i) a += v[j][i].x * v[j][i].x + v[j][i].y * v[j][i].y + v[j][i].z * v[j][i].z + v[j][i].w * v[j][i].w;
      ss[j] = wave_sum(a);
    }
#pragma unroll
    for (int j = 0; j < 4; ++j) {
      float4* xr = (float4*)(p.out + (size_t)(row0 + j) * D_MODEL);
      const float r = rsqrtf(ss[j] * (1.f / D_MODEL) + 1e-6f);
#pragma unroll
      for (int i = 0; i < 4; ++i) { float4 w; w.x = v[j][i].x * r * gg[i].x; w.y = v[j][i].y * r * gg[i].y; w.z = v[j][i].z * r * gg[i].z; w.w = v[j][i].w * r * gg[i].w; xr[lane + 64 * i] = w; }
    }
  }
}

#define XB_TMO      128
#define XB_XCNT(j)  (256  + 64 * (j))
#define XB_XSUB(j)  (1280 + 64 * (j))
#define XB_XGEN(j)  (2304 + 64 * (j))
#define XB_TOP      3328
#define XB_TOPGEN   3392
#define XCD_BAR_WORDS 3456
#define XB_SPIN_CAP (1u << 23)
DI unsigned xb_ld(unsigned* p)              { return __hip_atomic_load(p, __ATOMIC_RELAXED, __HIP_MEMORY_SCOPE_AGENT); }
DI unsigned xb_add(unsigned* p, unsigned v) { return __hip_atomic_fetch_add(p, v, __ATOMIC_RELAXED, __HIP_MEMORY_SCOPE_AGENT); }
DI unsigned xb_xcc_id() { return (unsigned)__builtin_amdgcn_s_getreg((3 << 11) | 20) & 0xFu; }
#define XB_SPIN(cond, bar) do { unsigned _sp = 0; while (cond) { __builtin_amdgcn_s_sleep(1); \
    if ((++_sp & 255u) == 0u) { if (xb_ld(&(bar)[XB_TMO])) break; if (_sp > XB_SPIN_CAP) { atomicAdd(&(bar)[XB_TMO], 1u); break; } } } } while (0)
struct XcdBarrier { unsigned* bar; unsigned x; volatile LDSP unsigned* st; };
DI XcdBarrier xcd_barrier_post(unsigned* bar, volatile LDSP unsigned* st) {
  XcdBarrier b; b.bar = bar; b.x = xb_xcc_id(); b.st = st;
  if (threadIdx.x == 0) (void)xb_add(&bar[XB_XCNT(b.x)], 1u);
  return b;
}
DI void xcd_barrier_complete(unsigned* bar, unsigned x, unsigned& nloc, unsigned& nx) {
  const unsigned G = gridDim.x * gridDim.y * gridDim.z;
  unsigned sum, cnt, mine, sp = 0u;
  for (;;) {
    sum = 0u; cnt = 0u; mine = 0u;
#pragma unroll
    for (unsigned j = 0; j < 16; ++j) { const unsigned c = xb_ld(&bar[XB_XCNT(j)]); sum += c; cnt += (c > 0u) ? 1u : 0u; mine = (j == x) ? c : mine; }
    if (sum == G) break;
    __builtin_amdgcn_s_sleep(1);
    if ((++sp & 255u) == 0u) { if (xb_ld(&bar[XB_TMO])) break; if (sp > XB_SPIN_CAP) { atomicAdd(&bar[XB_TMO], 1u); break; } }
  }
  nloc = mine > 0u ? mine : 1u; nx = cnt > 0u ? cnt : 1u;
}
DI void xcd_barrier(const XcdBarrier& b) {
  asm volatile("s_waitcnt vmcnt(0)" ::: "memory");
  __syncthreads();
  if (threadIdx.x == 0) {
    unsigned* bar = b.bar;
    __builtin_amdgcn_s_waitcnt(0);
    unsigned nloc = b.st[0], nx = b.st[1];
    if (nloc == 0u) { xcd_barrier_complete(bar, b.x, nloc, nx); b.st[0] = nloc; b.st[1] = nx; }
    const unsigned old = xb_add(&bar[XB_XSUB(b.x)], 1u);
    const unsigned gen = old / nloc;
    if (old + 1u == (gen + 1u) * nloc) {
      __builtin_amdgcn_fence(__ATOMIC_RELEASE, "agent");
      asm volatile("s_waitcnt vmcnt(0)" ::: "memory");
      const unsigned og = xb_add(&bar[XB_TOP], 1u);
      const unsigned tg = og / nx;
      if (og + 1u == (tg + 1u) * nx) xb_add(&bar[XB_TOPGEN], 1u);
      else XB_SPIN(xb_ld(&bar[XB_TOPGEN]) == tg, bar);
      __builtin_amdgcn_fence(__ATOMIC_ACQUIRE, "agent");
      xb_add(&bar[XB_XGEN(b.x)], 1u);
      asm volatile("s_waitcnt vmcnt(0)" ::: "memory");
    } else {
      XB_SPIN(xb_ld(&bar[XB_XGEN(b.x)]) == gen, bar);
      __builtin_amdgcn_fence(__ATOMIC_ACQUIRE, "agent");
      asm volatile("s_waitcnt vmcnt(0)" ::: "memory");
    }
  }
  __syncthreads();
}

constexpr int HALF_LDS = 76 * 1024;
constexpr int SMEM_BYTES = 2 * HALF_LDS;
DI void group_barrier(unsigned* gc, unsigned target) {
  asm volatile("s_waitcnt vmcnt(0)" ::: "memory");
  __syncthreads();
  if (threadIdx.x == 0) {
    __hip_atomic_fetch_add(gc, 1u, __ATOMIC_RELAXED, __HIP_MEMORY_SCOPE_AGENT);
    unsigned sp = 0;
    while (__hip_atomic_load(gc, __ATOMIC_RELAXED, __HIP_MEMORY_SCOPE_AGENT) < target) { __builtin_amdgcn_s_sleep(1); if (++sp > (1u << 24)) break; }
    __builtin_amdgcn_fence(__ATOMIC_ACQUIRE, "agent");
    asm volatile("s_waitcnt vmcnt(0)" ::: "memory");
  }
  __syncthreads();
}
#ifndef STAGGER_US
#define STAGGER_US 0
#endif
__global__ void __launch_bounds__(512, 2) fwd_megakernel(Params p) {
  cg::grid_group grid = cg::this_grid();
  __shared__ __attribute__((aligned(16))) unsigned char smem[SMEM_BYTES];
  const int half = __builtin_amdgcn_readfirstlane(threadIdx.x >> 8);
  unsigned char* hsm = smem + half * HALF_LDS;
  const int G = gridDim.x, bid = blockIdx.x;
  const int slot = bid * 2 + half, NS = 2 * G;
  volatile LDSP unsigned* xst = (volatile LDSP unsigned*)(LDSP unsigned char*)(smem + SMEM_BYTES - 64);
  unsigned* cntp = (unsigned*)(p.ws + OFF_CNT);
  const XcdBarrier xb = xcd_barrier_post((unsigned*)(p.ws + OFF_BAR), xst);
  if (threadIdx.x == 0) xst[4] = __hip_atomic_fetch_add(cntp + 128 + xb.x, 1u, __ATOMIC_RELAXED, __HIP_MEMORY_SCOPE_AGENT);
  {
    constexpr int ADA0 = T0_WIN + T0_WOUT + T0_W1 + T0_W2;
    unsigned* cnt = cntp;
    for (int i = slot; i < ((T0_TOTAL + NS - 1) / NS) * NS; i += NS) {
      const int ii = i < T0_TOTAL ? i : T0_TOTAL - 1;
      const int t = ii < 96 ? ADA0 + ii : (ii - 96 < ADA0 ? ii - 96 : ii);
      phase0_task(p, t, hsm);
      if (i < 96) {
        asm volatile("s_waitcnt vmcnt(0)" ::: "memory");
        lds_barrier();
        if (otid512() == 0) {
          __builtin_amdgcn_fence(__ATOMIC_RELEASE, "agent");
          asm volatile("s_waitcnt vmcnt(0)" ::: "memory");
          __hip_atomic_fetch_add(cnt + 8, 2u, __ATOMIC_RELAXED, __HIP_MEMORY_SCOPE_AGENT);
        }
      }
    }
    if (otid512() == 0) {
      unsigned sp = 0;
      while (__hip_atomic_load(cnt + 8, __ATOMIC_RELAXED, __HIP_MEMORY_SCOPE_AGENT) < 96u) { __builtin_amdgcn_s_sleep(8); if (++sp > (1u << 22)) break; }
      __builtin_amdgcn_fence(__ATOMIC_ACQUIRE, "agent");
      asm volatile("s_waitcnt vmcnt(0)" ::: "memory");
    }
    lds_barrier();
    for (int t = slot; t < ((NTOK / 64 + NS - 1) / NS) * NS; t += NS) phase1_task(p, 0, p.x, t < NTOK / 64 ? t : NTOK / 64 - 1, hsm);
  }
  grid.sync();
  if (threadIdx.x == 0) {
    unsigned nloc = 0, ng = 0, gi = 0;
    for (unsigned j = 0; j < 16; ++j) { const unsigned c = xb_ld(xb.bar + XB_XCNT(j)); if (c) { if (j < xb.x) ++gi; ++ng; } if (j == xb.x) nloc = c; }
    xst[5] = nloc ? nloc : 1u; xst[6] = ng ? ng : 1u; xst[7] = gi;
  }
  __syncthreads();
  const int rank = __builtin_amdgcn_readfirstlane((int)xst[4]), nloc = __builtin_amdgcn_readfirstlane((int)xst[5]), ng = __builtin_amdgcn_readfirstlane((int)xst[6]), gi = __builtin_amdgcn_readfirstlane((int)xst[7]);
  unsigned* gcnt = cntp + 256 + 64 * xb.x;
  unsigned epoch = 0;
#if STAGGER_US
  { const unsigned long long t0 = wall_clock64(); while (wall_clock64() - t0 < (unsigned long long)(STAGGER_US * 100) * (unsigned long long)gi) __builtin_amdgcn_s_sleep(8); }
#endif
  const int lslot = rank * 2 + half, LNS = 2 * nloc;
  for (int bb = gi; bb < BATCH; bb += ng)
  for (int layer = 0; layer < 2; ++layer) {
    Params q = p;
    { size_t zoff = 0; asm volatile("" : "+s"(zoff)); q.ws = p.ws + zoff; }
    const float* xin = layer == 0 ? q.x : q.out;
    if (layer != 0) {
      for (int t = lslot; t < ((64 + LNS - 1) / LNS) * LNS; t += LNS) phase1_task(q, layer, xin, bb * 64 + (t < 64 ? t : 63), hsm);
      group_barrier(gcnt, ++epoch * (unsigned)nloc);
    }
    for (int t = rank; t < 256; t += nloc) { const int r = t >> 5, i = t & 31; gemm_inproj_tile(q, layer, bb * 16 + (i & 7) + 8 * (r & 1), (i >> 3) + 4 * (r >> 1), smem); }
    group_barrier(gcnt, ++epoch * (unsigned)nloc);
    {
      unsigned* cnt = (unsigned*)(q.ws + OFF_CNT);
      unsigned* qcnt = cnt + 32 + layer * 8; unsigned* cdone = cnt + 64 + layer * 8; unsigned* sdone = cnt + 96 + layer * 8;
      int* s_pair = (int*)(smem + SMEM_BYTES - 16);
      for (int sq = rank; sq < 8; sq += nloc) {
        if (sq < 4) ssd_task8(q, layer, bb, sq, smem); else mlstm_task8(q, layer, bb, sq - 4, smem);
        asm volatile("s_waitcnt vmcnt(0)" ::: "memory");
        lds_barrier();
        if (otid512() == 0) {
          __builtin_amdgcn_fence(__ATOMIC_RELEASE, "agent");
          asm volatile("s_waitcnt vmcnt(0)" ::: "memory");
          __hip_atomic_fetch_add(sdone + bb, 1u, __ATOMIC_RELAXED, __HIP_MEMORY_SCOPE_AGENT);
        }
      }
      constexpr int NP_C = 8, NP_D = 64, NP_N = 64, NP_F = 32, NP_ALL = NP_C + NP_D + NP_N + NP_F;
      const int bq = bb;
      for (;;) {
        const int t512 = otid512();
        lds_barrier();
        if (t512 == 0) *s_pair = (int)atomicAdd(qcnt + bq, 1u);
        lds_barrier();
        const int pair = *s_pair;
        if (pair >= NP_ALL) break;
        if (pair < NP_C) {
          const int v = pair * 2 + half;
          compress_task(q, layer, bq, v >> 3, v & 7, hsm);
          asm volatile("s_waitcnt vmcnt(0)" ::: "memory");
          lds_barrier();
          if (t512 == 0) {
            __builtin_amdgcn_fence(__ATOMIC_RELEASE, "agent");
            asm volatile("s_waitcnt vmcnt(0)" ::: "memory");
            __hip_atomic_fetch_add(cdone + bq, 1u, __ATOMIC_RELAXED, __HIP_MEMORY_SCOPE_AGENT);
          }
        } else if (pair < NP_C + NP_D) {
          const int d = pair - NP_C;
          diff_attn_task(q, layer, bq, 2 * (d & 1) + half, 31 - (d >> 1), hsm);
        } else if (pair < NP_C + NP_D + NP_N) {
          if (t512 == 0) {
            while (__hip_atomic_load(cdone + bq, __ATOMIC_RELAXED, __HIP_MEMORY_SCOPE_AGENT) < (unsigned)NP_C) __builtin_amdgcn_s_sleep(16);
            __builtin_amdgcn_fence(__ATOMIC_ACQUIRE, "agent");
            asm volatile("s_waitcnt vmcnt(0)" ::: "memory");
          }
          lds_barrier();
          nsa_task(q, layer, bq, 2 * (63 - (pair - NP_C - NP_D)) + half, hsm);
        } else {
          if (t512 == 0) {
            while (__hip_atomic_load(sdone + bq, __ATOMIC_RELAXED, __HIP_MEMORY_SCOPE_AGENT) < 8u) __builtin_amdgcn_s_sleep(16);
            __builtin_amdgcn_fence(__ATOMIC_ACQUIRE, "agent");
            asm volatile("s_waitcnt vmcnt(0)" ::: "memory");
          }
          lds_barrier();
          seq_fix_rows(q, layer, bq * SEQ + ((pair - NP_C - NP_D - NP_N) * 2 + half) * 64, 64);
        }
      }
    }
    group_barrier(gcnt, ++epoch * (unsigned)nloc);
    if (layer == 0) { for (int t = rank; t < 64; t += nloc) gemm_outproj_tile<0>(q, xin, q.out, bb * 16 + (t & 15), t >> 4, smem); }
    else { for (int t = rank; t < 64; t += nloc) gemm_outproj_tile<1>(q, xin, q.out, bb * 16 + (t & 15), t >> 4, smem); }
    group_barrier(gcnt, ++epoch * (unsigned)nloc);
    if (layer == 1) {
      const int t5 = otid512();
      final_norm_rows(q, bb * SEQ, SEQ, rank * 8 + (t5 >> 6), nloc * 8, t5 & 63);
    }
  }
}

extern "C" void kernel_launch(void* const* d_in, const int* in_sizes, int n_in, void* d_out, int out_size, void* d_ws, size_t ws_size,
                              hipStream_t stream) {
  static int grid_blocks = 0;
  if (!grid_blocks) {
    int dev = 0, cus = 0, per_cu = 0;
    (void)hipGetDevice(&dev);
    (void)hipDeviceGetAttribute(&cus, hipDeviceAttributeMultiprocessorCount, dev);
    (void)hipOccupancyMaxActiveBlocksPerMultiprocessor(&per_cu, fwd_megakernel, 512, 0);
    if (per_cu > 1) per_cu = 1;
    if (per_cu < 1) per_cu = 1;
    grid_blocks = cus * per_cu;
  }
  if (grid_blocks < 64 || (grid_blocks & 3)) { fprintf(stderr, "grid too small: %d\n", grid_blocks); return; }
  if (ws_size < WS_NEEDED) { fprintf(stderr, "workspace too small: %zu < %zu\n", ws_size, WS_NEEDED); return; }
  Params p{};
  const float** pp = (const float**)&p;
  for (int i = 0; i < 26; ++i) pp[i] = (const float*)d_in[i];
  p.out = (float*)d_out; p.ws = (unsigned char*)d_ws;
  (void)hipMemsetAsync((unsigned char*)d_ws + OFF_CNT, 0, 64 * 1024 + XCD_BAR_WORDS * 4, stream);
  void* args[] = {&p};
  hipError_t e = hipLaunchCooperativeKernel((void*)fwd_megakernel, dim3(grid_blocks), dim3(512), args, 0, stream);
  if (e != hipSuccess) fprintf(stderr, "cooperative launch failed: %s (grid %d)\n", hipGetErrorString(e), grid_blocks);
}
```

```cpp
#include <hip/hip_runtime.h>
#include <hip/hip_cooperative_groups.h>
#include <cstdio>
#include <cstdint>
namespace cg = cooperative_groups;

typedef unsigned short u16;
typedef short bf16x8 __attribute__((ext_vector_type(8)));
typedef short s16x4 __attribute__((ext_vector_type(4)));
typedef float f32x4 __attribute__((ext_vector_type(4)));
typedef float f32x2 __attribute__((ext_vector_type(2)));
typedef unsigned u32x4 __attribute__((ext_vector_type(4)));
typedef unsigned u32x2 __attribute__((ext_vector_type(2)));
typedef __bf16 bf16x2_t __attribute__((ext_vector_type(2)));
#define DI __device__ __forceinline__
#define LDSP __attribute__((address_space(3)))

constexpr int D_MODEL = 1024, BATCH = 8, SEQ = 4096, NTOK = BATCH * SEQ;
constexpr int D_IN = 3992;
constexpr int NP = 3968, NPAD = 4096, NSMALL = 32;
constexpr int PA_Q = 0, PA_KC = 256, PA_VC = 320, PA_KS = 384, PA_VS = 448, PA_KW = 512, PA_VW = 576, PA_Z = 640;
constexpr int PB_Q = 896, PB_K = 1152, PB_V = 1408, PB_Z = 1664;
constexpr int PC_Z = 1920, PC_XBC = 2176;
constexpr int PD_QK = 2688, PD_V = 3200, PD_O = 3456, PD_Z = 3712;
constexpr int SM_G = 0, SM_DT = 12, SM_IF = 16;
constexpr int Y_A = 0, Y_B = 256, Y_C = 512, Y_D = 768;

constexpr size_t MiB = 1024 * 1024;
constexpr size_t OFF_WINT = 0;
constexpr size_t OFF_WOUTT = 16 * MiB;
constexpr size_t OFF_W1T = 20 * MiB;
constexpr size_t OFF_W2T = 22 * MiB;
constexpr size_t OFF_BIAS1 = 22 * MiB + 64 * 1024;
constexpr size_t OFF_ADAP = 22 * MiB + 128 * 1024;
constexpr size_t OFF_KCMP = 24 * MiB;
constexpr size_t OFF_VCMP = 24 * MiB + 256 * 1024;
constexpr size_t OFF_BAR = 29 * MiB + 64 * 1024;
constexpr size_t OFF_CNT = 29 * MiB;
constexpr size_t OFF_SMALL = 25 * MiB;
constexpr size_t OFF_SSQ = 29 * MiB;
constexpr size_t OFF_H = 32 * MiB;
constexpr size_t OFF_PROJ = 96 * MiB;
constexpr size_t OFF_X1B = 352 * MiB;
constexpr size_t WS_NEEDED = OFF_X1B + (size_t)NTOK * 1024 * 2;

struct Params {
  const float* x; const float* c; const float* norm_g; const float* ada_w; const float* ada_b;
  const float* w_in; const float* w_out;
  const float* nsa_cmp_pos; const float* nsa_ck_w1; const float* nsa_ck_w2; const float* nsa_cv_w1; const float* nsa_cv_w2; const float* nsa_norm_g;
  const float* diff_lam; const float* diff_norm_g;
  const float* ssm_conv_w; const float* ssm_conv_b; const float* ssm_dt_bias; const float* ssm_a_log; const float* ssm_d; const float* ssm_norm_g;
  const float* ml_conv_w; const float* ml_conv_b; const float* ml_if_b; const float* ml_norm_g; const float* final_g;
  float* out; unsigned char* ws;
};

DI void lds_barrier() { asm volatile("s_waitcnt lgkmcnt(0)" ::: "memory"); __builtin_amdgcn_s_barrier(); asm volatile("" ::: "memory"); }
DI int otid() { int t = threadIdx.x & 255; asm volatile("" : "+v"(t)); return t; }
DI int otid512() { int t = threadIdx.x; asm volatile("" : "+v"(t)); return t; }
DI unsigned pack2(float a, float b) { f32x2 v = {a, b}; bf16x2_t r = __builtin_convertvector(v, bf16x2_t); return __builtin_bit_cast(unsigned, r); }
DI u16 f2bf(float a) { return (u16)(pack2(a, 0.f) & 0xffffu); }
DI float bf2f(u16 h) { return __uint_as_float(((unsigned)h) << 16); }
DI float bflo(unsigned u) { return __uint_as_float(u << 16); }
DI float bfhi(unsigned u) { return __uint_as_float(u & 0xffff0000u); }
DI f32x4 mfma16(bf16x8 a, bf16x8 b, f32x4 c) { return __builtin_amdgcn_mfma_f32_16x16x32_bf16(a, b, c, 0, 0, 0); }
DI float wave_sum(float v) {
#pragma unroll
  for (int o = 32; o > 0; o >>= 1) v += __shfl_xor(v, o);
  return v;
}
DI float siluf(float v) { return v * __builtin_amdgcn_rcpf(1.f + __expf(-v)); }
DI float sigmoidf_(float v) { return __builtin_amdgcn_rcpf(1.f + __expf(-v)); }
DI float exp2_(float v) { return __builtin_amdgcn_exp2f(v); }
DI float sgprf(float v) { return __int_as_float(__builtin_amdgcn_readfirstlane(__float_as_int(v))); }
DI s16x4 tr_read(const u16* p) { return __builtin_amdgcn_ds_read_tr16_b64_v4i16((LDSP s16x4*)p); }
DI bf16x8 cat4(s16x4 a, s16x4 b) { bf16x8 r; r[0] = a[0]; r[1] = a[1]; r[2] = a[2]; r[3] = a[3]; r[4] = b[0]; r[5] = b[1]; r[6] = b[2]; r[7] = b[3]; return r; }
DI bf16x8 ldfrag(const u16* p) { return *(const bf16x8*)p; }

DI int colmap(int n) {
  if (n < 640) return n;
  if (n < 896) return 652 + (n - 640);
  if (n < 1920) return 908 + (n - 896);
  if (n < 2688) return 1932 + (n - 1920);
  if (n < 3456) return 2704 + (n - 2688);
  if (n < 3968) return 3480 + (n - 3456);
  if (n < 3980) return 640 + (n - 3968);
  if (n < 3984) return 2700 + (n - 3980);
  if (n < 3992) return 3472 + (n - 3984);
  return -1;
}

#define PIN4(a) asm volatile("" : "+v"(a[0]), "+v"(a[1]), "+v"(a[2]), "+v"(a[3]))
DI void tconv_tile(const float* __restrict__ src, int ldsrc, int k0, int n0, u16* __restrict__ dst, int ldd, bool use_map, unsigned char* smem) {
  float* tile = (float*)smem;
  const int tid = otid();
  {
    const int c4 = tid & 15, kk0 = tid >> 4; int col = n0 + c4 * 4; if (use_map) col = colmap(col);
    const float* sp = src + (size_t)(k0 + kk0) * ldsrc + (col >= 0 ? col : 0);
    f32x4 v[4];
#pragma unroll
    for (int i = 0; i < 4; ++i) v[i] = *(const f32x4*)(sp + (size_t)(16 * i) * ldsrc);
    PIN4(v);
    lds_barrier();
#pragma unroll
    for (int i = 0; i < 4; ++i) {
      const f32x4 w = col >= 0 ? v[i] : (f32x4){0.f, 0.f, 0.f, 0.f};
      float* tp = tile + (kk0 + 16 * i) * 65 + c4 * 4;
      tp[0] = w[0]; tp[1] = w[1]; tp[2] = w[2]; tp[3] = w[3];
    }
  }
  lds_barrier();
#pragma unroll
  for (int i = 0; i < 2; ++i) {
    const int item = tid + 256 * i, nn = item >> 3, kc = item & 7;
    u32x4 w;
    w.x = pack2(tile[(kc * 8 + 0) * 65 + nn], tile[(kc * 8 + 1) * 65 + nn]);
    w.y = pack2(tile[(kc * 8 + 2) * 65 + nn], tile[(kc * 8 + 3) * 65 + nn]);
    w.z = pack2(tile[(kc * 8 + 4) * 65 + nn], tile[(kc * 8 + 5) * 65 + nn]);
    w.w = pack2(tile[(kc * 8 + 6) * 65 + nn], tile[(kc * 8 + 7) * 65 + nn]);
    *(u32x4*)(dst + (size_t)(n0 + nn) * ldd + k0 + kc * 8) = w;
  }
}

constexpr int T0_WIN = 2 * 16 * 64, T0_WOUT = 2 * 16 * 16, T0_W1 = 4 * 32 * 2, T0_W2 = 4 * 2, T0_ADA = 2 * 12 * 8, T0_B1 = 64;
constexpr int T0_TOTAL = T0_WIN + T0_WOUT + T0_W1 + T0_W2 + T0_ADA + T0_B1;

DI void phase0_task(const Params& p, int t, unsigned char* smem) {
  const int tid = otid();
  if (t >= T0_TOTAL) { lds_barrier(); lds_barrier(); return; }
  if (t < T0_WIN) {
    const int l = t / 1024, r = t % 1024, kt = r / 64, nt = r % 64;
    tconv_tile(p.w_in + (size_t)l * D_MODEL * D_IN, D_IN, kt * 64, nt * 64, (u16*)(p.ws + OFF_WINT) + (size_t)l * NPAD * 1024, 1024, true, smem);
    return;
  }
  t -= T0_WIN;
  if (t < T0_WOUT) {
    const int l = t / 256, r = t % 256, kt = r / 16, nt = r % 16;
    tconv_tile(p.w_out + (size_t)l * 1024 * 1024, 1024, kt * 64, nt * 64, (u16*)(p.ws + OFF_WOUTT) + (size_t)l * 1024 * 1024, 1024, false, smem);
    return;
  }
  t -= T0_WOUT;
  if (t < T0_W1) {
    const int m = t / 64, r = t % 64, kt = r / 2, nt = r % 2, l = m >> 1, kv = m & 1;
    const float* src = (kv ? p.nsa_cv_w1 : p.nsa_ck_w1) + (size_t)l * 2048 * 128;
    tconv_tile(src, 128, kt * 64, nt * 64, (u16*)(p.ws + OFF_W1T) + (size_t)m * 128 * 2048, 2048, false, smem);
    return;
  }
  t -= T0_W1;
  if (t < T0_W2) {
    const int m = t / 2, kt = t % 2, l = m >> 1, kv = m & 1;
    const float* src = (kv ? p.nsa_cv_w2 : p.nsa_ck_w2) + (size_t)l * 128 * 64;
    tconv_tile(src, 64, kt * 64, 0, (u16*)(p.ws + OFF_W2T) + (size_t)m * 64 * 128, 128, false, smem);
    return;
  }
  t -= T0_W2;
  if (t < T0_ADA) {
    const int l = t / 96, r = t % 96, nc = r / 8, kc = r % 8;
    float* cact = (float*)(smem + 20480);
    float* red = (float*)(smem + 24576);
    const int kq = __builtin_amdgcn_readfirstlane(tid >> 6), c4 = tid & 63;
    const float* w = p.ada_w + ((size_t)l * 1024 + kc * 128 + kq) * 3072 + nc * 256 + c4 * 4;
    float cv[4];
#pragma unroll
    for (int i = 0; i < 4; ++i) { const int e = tid + 256 * i; cv[i] = p.c[(e >> 7) * 1024 + kc * 128 + (e & 127)]; }
    f32x4 wv[32];
#pragma unroll
    for (int j = 0; j < 32; ++j) wv[j] = *(const f32x4*)(w + (size_t)(4 * j) * 3072);
    PIN4(cv);
#pragma unroll
    for (int i = 0; i < 4; ++i) cact[tid + 256 * i] = siluf(cv[i]);
#pragma unroll
    for (int j = 0; j < 32; j += 4) asm volatile("" : "+v"(wv[j]), "+v"(wv[j + 1]), "+v"(wv[j + 2]), "+v"(wv[j + 3]));
    lds_barrier();
    f32x4 acc[8];
#pragma unroll
    for (int b = 0; b < 8; ++b) acc[b] = (f32x4){0.f, 0.f, 0.f, 0.f};
#pragma unroll
    for (int j = 0; j < 32; ++j) {
#pragma unroll
      for (int b = 0; b < 8; ++b) acc[b] += cact[b * 128 + kq + 4 * j] * wv[j];
    }
#pragma unroll
    for (int b = 0; b < 8; ++b) *(f32x4*)(red + (kq * 8 + b) * 256 + c4 * 4) = acc[b];
    lds_barrier();
    float* adap = (float*)(p.ws + OFF_ADAP);
    const int n = nc * 256 + tid;
    float bias = p.ada_b[l * 3072 + n];
    asm volatile("" : "+v"(bias));
    bias = kc == 0 ? bias : 0.f;
#pragma unroll
    for (int i = 0; i < 8; ++i) {
      adap[(((size_t)kc * 2 + l) * 8 + i) * 3072 + n] = ((red[(0 * 8 + i) * 256 + tid] + red[(1 * 8 + i) * 256 + tid]) + (red[(2 * 8 + i) * 256 + tid] + red[(3 * 8 + i) * 256 + tid])) + bias;
    }
    return;
  }
  t -= T0_ADA;
  {
    const int m = t >> 4, kc = t & 15, l = m >> 1, kv = m & 1;
    const float* w1 = (kv ? p.nsa_cv_w1 : p.nsa_ck_w1) + (size_t)l * 2048 * 128;
    const float* pos = p.nsa_cmp_pos + (size_t)l * 2048;
    const int n = tid & 127, half = tid >> 7;
    float acc = 0.f;
    const int k0 = kc * 128 + half * 64;
#pragma unroll 1
    for (int kb = 0; kb < 64; kb += 16) {
      float wv[16];
#pragma unroll
      for (int k = 0; k < 16; ++k) wv[k] = w1[(size_t)(k0 + kb + k) * 128 + n];
#pragma unroll
      for (int k = 0; k < 16; k += 4) asm volatile("" : "+v"(wv[k]), "+v"(wv[k + 1]), "+v"(wv[k + 2]), "+v"(wv[k + 3]));
#pragma unroll
      for (int k = 0; k < 16; ++k) acc += pos[k0 + kb + k] * wv[k];
    }
    float* red = (float*)smem;
    lds_barrier();
    red[tid] = acc;
    lds_barrier();
    if (tid < 128) ((float*)(p.ws + OFF_BIAS1))[(m * 16 + kc) * 128 + tid] = red[tid] + red[tid + 128];
  }
}

DI void phase1_task(const Params& p, int layer, const float* xin, int grp, unsigned char* smem) {
  const int tid = otid(), lane = tid & 63, wid = tid >> 6;
  const int b = grp >> 6;
  float* mul = (float*)smem;
  float* sh = mul + 1024;
  const float* adap = (const float*)(p.ws + OFF_ADAP);
  lds_barrier();
  for (int c = tid; c < 1024; c += 256) {
    float s0 = 0.f, s1 = 0.f;
#pragma unroll
    for (int kc = 0; kc < 8; ++kc) { const float* a = adap + (((size_t)kc * 2 + layer) * 8 + b) * 3072; s0 += a[c]; s1 += a[1024 + c]; }
    mul[c] = p.norm_g[layer * 1024 + c] * (1.f + s1); sh[c] = s0;
  }
  lds_barrier();
  u16* H = (u16*)(p.ws + OFF_H);
#pragma unroll 1
  for (int it = 0; it < 4; ++it) {
    float4 v[4][4]; float ss[4];
#pragma unroll
    for (int j = 0; j < 4; ++j) {
      const int row = grp * 64 + wid * 16 + it * 4 + j;
      if (layer == 0) {
        const float4* xr = (const float4*)(xin + (size_t)row * D_MODEL);
#pragma unroll
        for (int i = 0; i < 4; ++i) v[j][i] = xr[lane + 64 * i];
      } else {
        const u32x2* xr = (const u32x2*)((const u16*)(p.ws + OFF_X1B) + (size_t)row * D_MODEL);
#pragma unroll
        for (int i = 0; i < 4; ++i) { const u32x2 w = xr[lane + 64 * i]; v[j][i] = make_float4(bflo(w.x), bfhi(w.x), bflo(w.y), bfhi(w.y)); }
      }
    }
#pragma unroll
    for (int j = 0; j < 4; ++j) {
      float a = 0.f;
#pragma unroll
      for (int i = 0; i < 4; ++i) a += v[j][i].x * v[j][i].x + v[j][i].y * v[j][i].y + v[j][i].z * v[j][i].z + v[j][i].w * v[j][i].w;
      ss[j] = wave_sum(a);
    }
#pragma unroll
    for (int j = 0; j < 4; ++j) {
      const int row = grp * 64 + wid * 16 + it * 4 + j;
      const float r = rsqrtf(ss[j] * (1.f / D_MODEL) + 1e-6f);
#pragma unroll
      for (int i = 0; i < 4; ++i) {
        const int c = (lane + 64 * i) * 4;
        u32x2 w;
        w.x = pack2(v[j][i].x * r * mul[c] + sh[c], v[j][i].y * r * mul[c + 1] + sh[c + 1]);
        w.y = pack2(v[j][i].z * r * mul[c + 2] + sh[c + 2], v[j][i].w * r * mul[c + 3] + sh[c + 3]);
        *(u32x2*)(H + (size_t)row * 1024 + c) = w;
      }
    }
  }
}

namespace g8 {
constexpr int BM = 256, BK = 64, HALF = 128, HT = HALF * BK;
constexpr int LDS_BYTES = 8 * HT * 2;
DI int lds_byte(int r, int c) { const int st = (r >> 4) * 2 + (c >> 5), rr = r & 15, cc = c & 31, ob = rr * 64 + cc * 2; return st * 1024 + (ob ^ (((ob >> 9) & 1) << 5)); }
DI void stage_rc(int b, int& R, int& C) { const int st = b / 1024, sb = b % 1024, swz = sb ^ (((sb >> 9) & 1) << 5); R = (st >> 1) * 16 + swz / 64; C = (st & 1) * 32 + (swz % 64) / 2; }

DI void kloop(const u16* __restrict__ A, const u16* __restrict__ Bt, int K, int brow, int bcol, unsigned char* smem, f32x4 (&acc)[2][2][4][2]) {
  u16* shm = (u16*)smem;
  const int tid = otid512();
#define SA(b, h) (shm + ((b) * 2 + (h)) * HT)
#define SB(b, h) (shm + (4 + (b) * 2 + (h)) * HT)
#define STAGE(P, BASE, br, kt) do { const u16* _gb = BASE + ((long)(br) * K + (long)(kt) * BK); \
      __builtin_amdgcn_global_load_lds((const unsigned*)(_gb + soff0), (LDSP unsigned*)((LDSP char*)(P) + tid * 16), 16, 0, 0); \
      __builtin_amdgcn_global_load_lds((const unsigned*)(_gb + soff1), (LDSP unsigned*)((LDSP char*)(P) + tid * 16 + 8192), 16, 0, 0); } while (0)
#define LDA(dst, b, h) _Pragma("unroll") for (int m = 0; m < 4; ++m) _Pragma("unroll") for (int k = 0; k < 2; ++k) \
    dst[m][k] = *reinterpret_cast<const bf16x8*>((const char*)SA(b, h) + lds_byte(wr * 64 + m * 16 + fr, k * 32 + fq * 8))
#define LDB(dst, b, h) _Pragma("unroll") for (int n = 0; n < 2; ++n) _Pragma("unroll") for (int k = 0; k < 2; ++k) \
    dst[n][k] = *reinterpret_cast<const bf16x8*>((const char*)SB(b, h) + lds_byte(wc * 32 + n * 16 + fr, k * 32 + fq * 8))
#define MMA(ai, bj, At_, Bt_) do { __builtin_amdgcn_s_setprio(1); \
    _Pragma("unroll") for (int m = 0; m < 4; ++m) _Pragma("unroll") for (int n = 0; n < 2; ++n) _Pragma("unroll") for (int k = 0; k < 2; ++k) \
      acc[ai][bj][m][n] = __builtin_amdgcn_mfma_f32_16x16x32_bf16(Bt_[n][k], At_[m][k], acc[ai][bj][m][n], 0, 0, 0); \
    __builtin_amdgcn_s_setprio(0); } while (0)
#define WAIT_V(n) asm volatile("s_waitcnt vmcnt(" #n ")" ::: "memory")
#define WAIT_L(n) asm volatile("s_waitcnt lgkmcnt(" #n ")" ::: "memory")
#define BAR __builtin_amdgcn_s_barrier()
#define SCHED __builtin_amdgcn_sched_barrier(0)
  const int wid = __builtin_amdgcn_readfirstlane(tid >> 6), lane = tid & 63, wr = wid >> 2, wc = wid & 3, fr = lane & 15, fq = lane >> 4;
#pragma unroll
  for (int a = 0; a < 2; ++a)
#pragma unroll
    for (int b = 0; b < 2; ++b)
#pragma unroll
      for (int m = 0; m < 4; ++m) { acc[a][b][m][0] = (f32x4){0.f, 0.f, 0.f, 0.f}; acc[a][b][m][1] = (f32x4){0.f, 0.f, 0.f, 0.f}; }
  bf16x8 At[4][2], B0[2][2], B1[2][2];
  const int nt = K / BK;
  int soff0, soff1;
  { int r_, c_; stage_rc(tid * 16, r_, c_); soff0 = r_ * K + c_; stage_rc(tid * 16 + 8192, r_, c_); soff1 = r_ * K + c_; }
  STAGE(SB(0, 0), Bt, bcol, 0); STAGE(SA(0, 0), A, brow, 0);
  STAGE(SB(0, 1), Bt, bcol + HALF, 0); STAGE(SA(0, 1), A, brow + HALF, 0);
  if (wr == 1) BAR;
  WAIT_V(4); BAR;
  STAGE(SB(1, 0), Bt, bcol, 1); STAGE(SA(1, 0), A, brow, 1); STAGE(SB(1, 1), Bt, bcol + HALF, 1);
  WAIT_V(6); BAR;
#pragma unroll 1
  for (int t = 0; t < nt - 2; t += 2) {
    asm volatile("" : "+v"(soff0), "+v"(soff1));
    LDB(B0, 0, 0); SCHED; LDA(At, 0, 0); STAGE(SA(1, 1), A, brow + HALF, t + 1);
    WAIT_L(8); BAR; WAIT_L(0); MMA(0, 0, At, B0); BAR; SCHED;
    LDB(B1, 0, 1); STAGE(SB(0, 0), Bt, bcol, t + 2);
    BAR; WAIT_L(0); MMA(0, 1, At, B1); BAR;
    LDA(At, 0, 1); STAGE(SA(0, 0), A, brow, t + 2);
    BAR; WAIT_L(0); MMA(1, 0, At, B0); BAR; SCHED;
    STAGE(SB(0, 1), Bt, bcol + HALF, t + 2);
    WAIT_V(6); BAR; MMA(1, 1, At, B1); BAR;
    LDB(B0, 1, 0); SCHED; LDA(At, 1, 0); STAGE(SA(0, 1), A, brow + HALF, t + 2);
    WAIT_L(8); BAR; WAIT_L(0); MMA(0, 0, At, B0); BAR; SCHED;
    LDB(B1, 1, 1); STAGE(SB(1, 0), Bt, bcol, t + 3);
    BAR; WAIT_L(0); MMA(0, 1, At, B1); BAR;
    LDA(At, 1, 1); STAGE(SA(1, 0), A, brow, t + 3);
    BAR; WAIT_L(0); MMA(1, 0, At, B0); BAR; SCHED;
    STAGE(SB(1, 1), Bt, bcol + HALF, t + 3);
    WAIT_V(6); BAR; MMA(1, 1, At, B1); BAR;
  }
  { LDB(B0, 0, 0); LDA(At, 0, 0); STAGE(SA(1, 1), A, brow + HALF, nt - 1);
    BAR; WAIT_L(0); MMA(0, 0, At, B0); BAR;
    LDB(B1, 0, 1); BAR; WAIT_L(0); MMA(0, 1, At, B1); BAR;
    LDA(At, 0, 1); WAIT_V(4); BAR; WAIT_L(0); MMA(1, 0, At, B0); MMA(1, 1, At, B1); BAR; }
  { LDB(B0, 1, 0); LDA(At, 1, 0); WAIT_V(2); BAR; WAIT_L(0); MMA(0, 0, At, B0); BAR;
    LDB(B1, 1, 1); WAIT_V(0); BAR; WAIT_L(0); MMA(0, 1, At, B1); BAR;
    LDA(At, 1, 1); BAR; WAIT_L(0); MMA(1, 0, At, B0); MMA(1, 1, At, B1); BAR; }
  if (wr == 0) BAR;
#undef SA
#undef SB
#undef STAGE
#undef LDA
#undef LDB
#undef MMA
#undef WAIT_V
#undef WAIT_L
#undef BAR
#undef SCHED
}
DI void tile_map(int wgid, int nM, int nN, int& pm, int& pn) {
  const int nwg = nM * nN, NXCD = 8, WGM = 8;
  { const int q = nwg / NXCD, r = nwg % NXCD, xcd = wgid % NXCD, off = wgid / NXCD; wgid = (xcd < r ? xcd * (q + 1) : r * (q + 1) + (xcd - r) * q) + off; }
  const int nig = WGM * nN, gid = wgid / nig, fm = gid * WGM, gsz = (nM - fm) < WGM ? (nM - fm) : WGM;
  pm = fm + ((wgid % nig) % gsz); pn = (wgid % nig) / gsz;
}
}

DI void gemm_inproj_tile(const Params& p, int layer, int pm, int pn, unsigned char* smem) {
  const int brow = pm * 256, bcol = pn * 256;
  f32x4 acc[2][2][4][2];
  g8::kloop((const u16*)(p.ws + OFF_H), (const u16*)(p.ws + OFF_WINT) + (size_t)layer * NPAD * 1024, 1024, brow, bcol, smem, acc);
  const int tid = otid512(), wid = __builtin_amdgcn_readfirstlane(tid >> 6), lane = tid & 63, wr = wid >> 2, wc = wid & 3, fr = lane & 15, fq = lane >> 4;
  u16* proj = (u16*)(p.ws + OFF_PROJ);
  if (pn == 15 && wc == 0) {
    float* sm = (float*)(p.ws + OFF_SMALL);
#pragma unroll
    for (int ai = 0; ai < 2; ++ai)
#pragma unroll
      for (int m = 0; m < 4; ++m)
#pragma unroll
        for (int n = 0; n < 2; ++n) {
          const int mr = brow + ai * 128 + wr * 64 + m * 16 + fr;
          *(f32x4*)(sm + (size_t)mr * NSMALL + n * 16 + 4 * fq) = acc[ai][1][m][n];
        }
  }
  constexpr int CLD = 264;
  u16* Cs = (u16*)smem;
#pragma unroll
  for (int ai = 0; ai < 2; ++ai) {
    lds_barrier();
#pragma unroll
    for (int bj = 0; bj < 2; ++bj)
#pragma unroll
      for (int m = 0; m < 4; ++m)
#pragma unroll
        for (int n = 0; n < 2; ++n) {
          const f32x4 v = acc[ai][bj][m][n];
          u32x2 w; w.x = pack2(v[0], v[1]); w.y = pack2(v[2], v[3]);
          *(u32x2*)(Cs + (wr * 64 + m * 16 + fr) * CLD + bj * 128 + wc * 32 + n * 16 + 4 * fq) = w;
        }
    lds_barrier();
#pragma unroll
    for (int i = 0; i < 8; ++i) {
      const int id = tid + 512 * i, row = id >> 5, ch = id & 31;
      if (bcol + ch * 8 < NP) *(u32x4*)(proj + (size_t)(brow + ai * 128 + row) * NP + bcol + ch * 8) = *(const u32x4*)(Cs + row * CLD + ch * 8);
    }
  }
  lds_barrier();
}

template <int layer>
DI void gemm_outproj_tile(const Params& p, const float* xin, float* xout, int pm, int pn, unsigned char* smem) {
  const int brow = pm * 256, bcol = pn * 256;
  f32x4 acc[2][2][4][2];
  g8::kloop((const u16*)(p.ws + OFF_H), (const u16*)(p.ws + OFF_WOUTT) + (size_t)layer * 1024 * 1024, 1024, brow, bcol, smem, acc);
  const int tid = otid512(), wid = __builtin_amdgcn_readfirstlane(tid >> 6), lane = tid & 63, wr = wid >> 2, wc = wid & 3, fr = lane & 15, fq = lane >> 4;
  const int b = brow >> 12;
  const float* adap = (const float*)(p.ws + OFF_ADAP);
  constexpr int CLD = 132;
  float* Cs = (float*)smem;
#pragma unroll
  for (int ai = 0; ai < 2; ++ai)
#pragma unroll
    for (int bj = 0; bj < 2; ++bj) {
      lds_barrier();
#pragma unroll
      for (int m = 0; m < 4; ++m)
#pragma unroll
        for (int n = 0; n < 2; ++n) *(f32x4*)(Cs + (wr * 64 + m * 16 + fr) * CLD + wc * 32 + n * 16 + 4 * fq) = acc[ai][bj][m][n];
      lds_barrier();
      const int ch = tid & 31, nc = bcol + bj * 128 + ch * 4;
      f32x4 gt = {0.f, 0.f, 0.f, 0.f};
#pragma unroll
      for (int kc = 0; kc < 8; ++kc) gt += *(const f32x4*)(adap + (((size_t)kc * 2 + layer) * 8 + b) * 3072 + 2048 + nc);
      u16* x1b = (u16*)(p.ws + OFF_X1B);
      f32x4 xv[8];
#pragma unroll
      for (int i = 0; i < 8; ++i) {
        const size_t off = (size_t)(brow + ai * 128 + (tid >> 5) + 16 * i) * 1024 + nc;
        if (layer == 0) xv[i] = *(const f32x4*)(xin + off);
        else { const u32x2 w = *(const u32x2*)(x1b + off); xv[i] = (f32x4){bflo(w.x), bfhi(w.x), bflo(w.y), bfhi(w.y)}; }
      }
#pragma unroll
      for (int i = 0; i < 8; ++i) {
        const int row = (tid >> 5) + 16 * i;
        const size_t off = (size_t)(brow + ai * 128 + row) * 1024 + nc;
        const f32x4 v = xv[i] + gt * *(const f32x4*)(Cs + row * CLD + ch * 4);
        if (layer == 0) { u32x2 w; w.x = pack2(v[0], v[1]); w.y = pack2(v[2], v[3]); *(u32x2*)(x1b + off) = w; }
        else *(f32x4*)(xout + off) = v;
      }
    }
  lds_barrier();
}

constexpr int KLD = 72;
struct KVRegs { u32x4 k[2], v[2]; };
DI void kv_load(const u16* kbase, const u16* vbase, int ldk, int ldv, int key0, KVRegs& r) {
  const int tid = otid();
#pragma unroll
  for (int i = 0; i < 2; ++i) {
    const int id = tid + 256 * i, row = id >> 3, ch = id & 7;
    r.k[i] = *(const u32x4*)(kbase + (size_t)(key0 + row) * ldk + ch * 8);
    r.v[i] = *(const u32x4*)(vbase + (size_t)(key0 + row) * ldv + ch * 8);
  }
}
DI void kv_store(u16* Ks, u16* Vs, const KVRegs& r) {
  const int tid = otid();
#pragma unroll
  for (int i = 0; i < 2; ++i) {
    const int id = tid + 256 * i, row = id >> 3, ch = id & 7;
    *(u32x4*)(Ks + row * KLD + ch * 8) = r.k[i];
    *(u32x4*)(Vs + row * KLD + ch * 8) = r.v[i];
  }
}
constexpr int KVBUF = 2 * 64 * KLD;
template <class UseF, class LoadF, class CompF>
DI void kv_pipeline(int j0, int j1, u16* buf, UseF use, LoadF load, CompF comp) {
  KVRegs kr;
  if (use(j0)) load(j0, kr);
  lds_barrier();
  if (use(j0)) kv_store(buf, buf + 64 * KLD, kr);
  if (j0 + 1 < j1 && use(j0 + 1)) load(j0 + 1, kr);
  lds_barrier();
  for (int j = j0; j < j1; ++j) {
    u16* cur = buf + ((j - j0) & 1) * KVBUF; u16* nxt = buf + (((j - j0) & 1) ^ 1) * KVBUF;
    if (j + 1 < j1 && use(j + 1)) kv_store(nxt, nxt + 64 * KLD, kr);
    if (j + 2 < j1 && use(j + 2)) load(j + 2, kr);
    if (use(j)) comp(j, cur, cur + 64 * KLD);
    lds_barrier();
  }
}
struct AttnAcc { f32x4 o[4][2]; float m[2], l[2]; f32x4 os[2]; int fresh; };
DI void attn_init(AttnAcc& a) {
#pragma unroll
  for (int d = 0; d < 4; ++d) { a.o[d][0] = (f32x4){0.f, 0.f, 0.f, 0.f}; a.o[d][1] = (f32x4){0.f, 0.f, 0.f, 0.f}; }
  a.m[0] = a.m[1] = -1e30f; a.l[0] = a.l[1] = 0.f;
}
template <int NKS>
DI void qk_tile(const u16* Ks, int dofs, const bf16x8 (&qf)[2][NKS], f32x4 (&s)[4][2], int l15, int g) {
#pragma unroll
  for (int kt = 0; kt < 4; ++kt) {
    s[kt][0] = (f32x4){0.f, 0.f, 0.f, 0.f}; s[kt][1] = (f32x4){0.f, 0.f, 0.f, 0.f};
#pragma unroll
    for (int ks = 0; ks < NKS; ++ks) {
      const bf16x8 a = ldfrag(Ks + (kt * 16 + l15) * KLD + dofs + ks * 32 + 8 * g);
      s[kt][0] = mfma16(a, qf[0][ks], s[kt][0]);
      s[kt][1] = mfma16(a, qf[1][ks], s[kt][1]);
    }
  }
}
DI void pv_accum(const bf16x8 (&pf)[2][2], const u16* Vs, f32x4 (&o)[4][2], int l15, int g) {
  const int tq = l15 >> 2, tp = l15 & 3;
#pragma unroll
  for (int kk = 0; kk < 2; ++kk)
#pragma unroll
    for (int d = 0; d < 4; ++d) {
      const bf16x8 vf = cat4(tr_read(Vs + (kk * 32 + 4 * g + tq) * KLD + d * 16 + 4 * tp), tr_read(Vs + (kk * 32 + 16 + 4 * g + tq) * KLD + d * 16 + 4 * tp));
      o[d][0] = mfma16(vf, pf[0][kk], o[d][0]);
      o[d][1] = mfma16(vf, pf[1][kk], o[d][1]);
    }
}
DI void pack_p(const f32x4 (&s)[4][2], bf16x8 (&pf)[2][2]) {
#pragma unroll
  for (int qt = 0; qt < 2; ++qt)
#pragma unroll
    for (int kk = 0; kk < 2; ++kk) {
      u32x4 w;
      w.x = pack2(s[2 * kk][qt][0], s[2 * kk][qt][1]); w.y = pack2(s[2 * kk][qt][2], s[2 * kk][qt][3]);
      w.z = pack2(s[2 * kk + 1][qt][0], s[2 * kk + 1][qt][1]); w.w = pack2(s[2 * kk + 1][qt][2], s[2 * kk + 1][qt][3]);
      pf[qt][kk] = __builtin_bit_cast(bf16x8, w);
    }
}
constexpr float DEFER_THR = 5.f;
template <class VF>
DI void softmax_pv(f32x4 (&s)[4][2], AttnAcc& a, const u16* Vs, float sc, int l15, int g, VF valid) {
  bf16x8 pf[2][2];
  float mxl[2];
#pragma unroll
  for (int qt = 0; qt < 2; ++qt) {
    float mx = -1e30f;
#pragma unroll
    for (int kt = 0; kt < 4; ++kt)
#pragma unroll
      for (int r = 0; r < 4; ++r) { const float v = valid(kt, r, qt) ? s[kt][qt][r] * sc : -1e30f; s[kt][qt][r] = v; mx = fmaxf(mx, v); }
    mxl[qt] = mx;
  }
  if (__any((mxl[0] > a.m[0] + DEFER_THR) || (mxl[1] > a.m[1] + DEFER_THR))) {
#pragma unroll
    for (int qt = 0; qt < 2; ++qt) {
      float mx = mxl[qt];
      mx = fmaxf(mx, __shfl_xor(mx, 16)); mx = fmaxf(mx, __shfl_xor(mx, 32));
      const float mn = fmaxf(a.m[qt], mx), alpha = exp2_(a.m[qt] - mn);
      a.m[qt] = mn; a.l[qt] *= alpha;
#pragma unroll
      for (int d = 0; d < 4; ++d) a.o[d][qt] *= alpha;
    }
  }
#pragma unroll
  for (int qt = 0; qt < 2; ++qt) {
    const float mn = a.m[qt];
    float ls = 0.f;
#pragma unroll
    for (int kt = 0; kt < 4; ++kt)
#pragma unroll
      for (int r = 0; r < 4; ++r) { const float v = s[kt][qt][r]; const float pv = v > -1e29f ? exp2_(v - mn) : 0.f; s[kt][qt][r] = pv; ls += pv; }
    a.l[qt] += ls;
  }
  pack_p(s, pf);
  pv_accum(pf, Vs, a.o, l15, g);
}
DI float group_sum4_(float v) { v += __shfl_xor(v, 16); v += __shfl_xor(v, 32); return v; }
DI bf16x8 scale_frag(bf16x8 f, float sc) {
  u32x4 w = __builtin_bit_cast(u32x4, f);
  w.x = pack2(bflo(w.x) * sc, bfhi(w.x) * sc); w.y = pack2(bflo(w.y) * sc, bfhi(w.y) * sc);
  w.z = pack2(bflo(w.z) * sc, bfhi(w.z) * sc); w.w = pack2(bflo(w.w) * sc, bfhi(w.w) * sc);
  return __builtin_bit_cast(bf16x8, w);
}
DI void attn_init_rel(AttnAcc& a) { attn_init(a); a.m[0] = a.m[1] = 0.f; a.os[0] = (f32x4){0.f, 0.f, 0.f, 0.f}; a.os[1] = (f32x4){0.f, 0.f, 0.f, 0.f}; a.fresh = 1; }
DI void rowsum_accum(const bf16x8 (&pf)[2][2], AttnAcc& a, int l15) {
  const short one = l15 == 0 ? (short)0x3F80 : (short)0;
  const bf16x8 ones = {one, one, one, one, one, one, one, one};
#pragma unroll
  for (int kk = 0; kk < 2; ++kk) { a.os[0] = mfma16(ones, pf[0][kk], a.os[0]); a.os[1] = mfma16(ones, pf[1][kk], a.os[1]); }
}
DI float rel_rowsum(const AttnAcc& a, int qt, int l15) { return __shfl(a.os[qt][0], l15); }
template <int NKS>
DI void qk_tile_rel(const u16* Ks, int dofs, const bf16x8 (&qf)[2][NKS], const AttnAcc& a, f32x4 (&s)[4][2], int l15, int g, bool ok0 = true, bool ok1 = true) {
  const float n0 = ok0 ? -a.m[0] : -1e30f, n1 = ok1 ? -a.m[1] : -1e30f;
#pragma unroll
  for (int kt = 0; kt < 4; ++kt) {
    s[kt][0] = (f32x4){n0, n0, n0, n0}; s[kt][1] = (f32x4){n1, n1, n1, n1};
#pragma unroll
    for (int ks = 0; ks < NKS; ++ks) {
      const bf16x8 k = ldfrag(Ks + (kt * 16 + l15) * KLD + dofs + ks * 32 + 8 * g);
      s[kt][0] = mfma16(k, qf[0][ks], s[kt][0]);
      s[kt][1] = mfma16(k, qf[1][ks], s[kt][1]);
    }
  }
}
template <int MODE, class VF>
DI void softmax_rel(f32x4 (&s)[4][2], AttnAcc& a, bf16x8 (&pf)[2][2], int l15_, VF valid, bool ok0 = true, bool ok1 = true) {
  float mxl[2];
#pragma unroll
  for (int qt = 0; qt < 2; ++qt) {
    float mx = -1e30f;
    const bool okq = qt == 0 ? ok0 : ok1;
#pragma unroll
    for (int kt = 0; kt < 4; ++kt)
#pragma unroll
      for (int r = 0; r < 4; ++r) {
        if (MODE == 1) s[kt][qt][r] = valid(kt, r, qt) ? s[kt][qt][r] : -1e30f;
        if (MODE == 2) s[kt][qt][r] = okq ? s[kt][qt][r] : -1e30f;
        mx = fmaxf(mx, s[kt][qt][r]);
      }
    mxl[qt] = mx;
  }
  if (a.fresh || __any(mxl[0] > DEFER_THR || mxl[1] > DEFER_THR)) {
    bool still = false;
#pragma unroll
    for (int qt = 0; qt < 2; ++qt) {
      float mx = mxl[qt];
      mx = fmaxf(mx, __shfl_xor(mx, 16)); mx = fmaxf(mx, __shfl_xor(mx, 32));
      const bool fresh = rel_rowsum(a, qt, l15_) == 0.f;
      const float dl = mx < -1e29f ? 0.f : (fresh ? mx : fmaxf(mx, 0.f)), alpha = exp2_(-dl);
      still = still || (fresh && mx < -1e29f);
      a.m[qt] += dl; a.os[qt] *= alpha;
#pragma unroll
      for (int d = 0; d < 4; ++d) a.o[d][qt] *= alpha;
#pragma unroll
      for (int kt = 0; kt < 4; ++kt)
#pragma unroll
        for (int r = 0; r < 4; ++r) s[kt][qt][r] -= dl;
    }
    a.fresh = __any(still) ? 1 : 0;
  }
#pragma unroll
  for (int qt = 0; qt < 2; ++qt)
#pragma unroll
    for (int kt = 0; kt < 4; ++kt)
#pragma unroll
      for (int r = 0; r < 4; ++r) s[kt][qt][r] = exp2_(s[kt][qt][r]);
  pack_p(s, pf);
}
DI float group_sum4(float v) { v += __shfl_xor(v, 16); v += __shfl_xor(v, 32); return v; }

constexpr int DSTAGE = 2 * 128 * 64;
DI int fKs(int row) { return (row >> 1) & 7; }
DI int fVs(int row) { return ((row >> 1) & 3) << 1; }
DI void kv_dma128(const u16* kbase, const u16* vbase, int ld, int key0, u16* stage, int tid) {
#pragma unroll
  for (int i = 0; i < 4; ++i) {
    const int id = tid + 256 * i, row = id >> 3, c8 = id & 7;
    __builtin_amdgcn_global_load_lds((const unsigned*)(kbase + (size_t)(key0 + row) * ld + ((c8 ^ fKs(row)) * 8)), (LDSP unsigned*)((LDSP char*)stage + id * 16), 16, 0, 0);
  }
#pragma unroll
  for (int i = 0; i < 4; ++i) {
    const int id = tid + 256 * i, row = id >> 3, c8 = id & 7;
    __builtin_amdgcn_global_load_lds((const unsigned*)(vbase + (size_t)(key0 + row) * ld + ((c8 ^ fVs(row)) * 8)), (LDSP unsigned*)((LDSP char*)(stage + 128 * 64) + id * 16), 16, 0, 0);
  }
}
template <int NKS>
DI void qk_tile_rel_sw(const u16* Kh, int dofs, const bf16x8 (&qf)[2][NKS], const AttnAcc& a, f32x4 (&s)[4][2], int l15, int g) {
  const float n0 = -a.m[0], n1 = -a.m[1];
  const int sw = (l15 >> 1) & 7;
#pragma unroll
  for (int kt = 0; kt < 4; ++kt) {
    s[kt][0] = (f32x4){n0, n0, n0, n0}; s[kt][1] = (f32x4){n1, n1, n1, n1};
#pragma unroll
    for (int ks = 0; ks < NKS; ++ks) {
      const bf16x8 k = ldfrag(Kh + (kt * 16 + l15) * 64 + ((((dofs >> 3) + ks * 4 + g) ^ sw) * 8));
      s[kt][0] = mfma16(k, qf[0][ks], s[kt][0]);
      s[kt][1] = mfma16(k, qf[1][ks], s[kt][1]);
    }
  }
}
DI void pv_accum_sw(const bf16x8 (&pf)[2][2], const u16* Vh, f32x4 (&o)[4][2], int l15, int g) {
  const int tq = l15 >> 2, tp = l15 & 3;
#pragma unroll
  for (int kk = 0; kk < 2; ++kk) {
    const int r0 = kk * 32 + 4 * g + tq, r1 = r0 + 16;
    const int f0 = fVs(r0), f1 = fVs(r1);
#pragma unroll
    for (int d = 0; d < 4; ++d) {
      const int lc = d * 2 + (tp >> 1);
      const bf16x8 vf = cat4(tr_read(Vh + r0 * 64 + ((lc ^ f0) * 8) + (tp & 1) * 4), tr_read(Vh + r1 * 64 + ((lc ^ f1) * 8) + (tp & 1) * 4));
      o[d][0] = mfma16(vf, pf[0][kk], o[d][0]);
      o[d][1] = mfma16(vf, pf[1][kk], o[d][1]);
    }
  }
}
DI void diff_attn_task(const Params& p, int layer, int b, int h, int qb, unsigned char* smem) {
  u16* Ks = (u16*)smem; u16* Vs = Ks + 64 * KLD;
  const int tid = otid(), lane = tid & 63, wid = tid >> 6, l15 = lane & 15, g = lane >> 4;
  const u16* proj = (const u16*)(p.ws + OFF_PROJ) + (size_t)b * SEQ * NP;
  const int q0w = qb * 128 + wid * 32;
  const float* lam = p.diff_lam + layer * 128;
  float s01 = 0.f, s23 = 0.f;
  for (int i = 0; i < 32; ++i) { s01 += lam[i] * lam[32 + i]; s23 += lam[64 + i] * lam[96 + i]; }
  const float lam_init = layer == 0 ? 0.2f : 0.35550906759096324f;
  const float lam_full = sgprf(__expf(s01) - __expf(s23) + lam_init);
  const float sc = 0.17677669529663687f * 1.4426950408889634f;
  const int ntile = 2 * qb + 2;
  const u16* vbase = proj + PB_V + h * 64;
  f32x4 res[4][2];
#pragma unroll 1
  for (int c = 0; c < 2; ++c) {
    const u16* kbase = proj + PB_K + h * 64;
    bf16x8 qf[2][1];
#pragma unroll
    for (int qt = 0; qt < 2; ++qt) qf[qt][0] = scale_frag(ldfrag(proj + (size_t)(q0w + qt * 16 + l15) * NP + PB_Q + h * 64 + c * 32 + 8 * g), sc);
    AttnAcc a; attn_init_rel(a);
    const int nst = qb + 1;
    asm volatile("s_waitcnt vmcnt(0)" ::: "memory");
    lds_barrier();
    kv_dma128(kbase, vbase, NP, 0, Ks, tid);
    asm volatile("s_waitcnt vmcnt(0)" ::: "memory");
    lds_barrier();
    for (int js = 0; js < nst; ++js) {
      const u16* st = Ks + (js & 1) * DSTAGE;
      if (js + 1 < nst) kv_dma128(kbase, vbase, NP, (js + 1) * 128, Ks + ((js + 1) & 1) * DSTAGE, tid);
#pragma unroll 1
      for (int hf = 0; hf < 2; ++hf) {
        const int key0 = js * 128 + hf * 64;
        if (key0 <= q0w + 31) {
          f32x4 s[4][2]; bf16x8 pf[2][2];
          auto valid = [&](int kt, int r, int qt) { return key0 + kt * 16 + 4 * g + r <= q0w + qt * 16 + l15; };
          qk_tile_rel_sw<1>(st + hf * 64 * 64, c * 32, qf, a, s, l15, g);
          if (key0 + 63 <= q0w) softmax_rel<0>(s, a, pf, l15, valid); else softmax_rel<1>(s, a, pf, l15, valid);
          pv_accum_sw(pf, st + 128 * 64 + hf * 64 * 64, a.o, l15, g);
          rowsum_accum(pf, a, l15);
        }
      }
      asm volatile("s_waitcnt vmcnt(0)" ::: "memory");
      lds_barrier();
    }
#pragma unroll
    for (int qt = 0; qt < 2; ++qt) {
      const float lt = rel_rowsum(a, qt, l15);
      const float inv = c == 0 ? 1.f / lt : -lam_full / lt;
#pragma unroll
      for (int d = 0; d < 4; ++d) res[d][qt] = c == 0 ? a.o[d][qt] * inv : res[d][qt] + a.o[d][qt] * inv;
    }
  }
  u16* Y = (u16*)(p.ws + OFF_H);
  const float* ng = p.diff_norm_g + layer * 64;
#pragma unroll
  for (int qt = 0; qt < 2; ++qt) {
    float ss = 0.f;
#pragma unroll
    for (int d = 0; d < 4; ++d) { const f32x4 v = res[d][qt]; ss += v[0] * v[0] + v[1] * v[1] + v[2] * v[2] + v[3] * v[3]; }
    ss = group_sum4(ss);
    const float rn = rsqrtf(ss * (1.f / 64.f) + 1e-6f) * (1.f - lam_init);
    const int t = q0w + qt * 16 + l15;
    const size_t row = (size_t)b * SEQ + t;
#pragma unroll
    for (int d = 0; d < 4; ++d) {
      const int dd = d * 16 + 4 * g;
      const f32x4 v = res[d][qt];
      const u32x2 zz = *(const u32x2*)(proj + (size_t)t * NP + PB_Z + h * 64 + dd);
      const f32x4 gg = *(const f32x4*)(ng + dd);
      u32x2 w;
      w.x = pack2(v[0] * rn * gg[0] * siluf(bflo(zz.x)), v[1] * rn * gg[1] * siluf(bfhi(zz.x)));
      w.y = pack2(v[2] * rn * gg[2] * siluf(bflo(zz.y)), v[3] * rn * gg[3] * siluf(bfhi(zz.y)));
      *(u32x2*)(Y + row * 1024 + Y_B + h * 64 + dd) = w;
    }
  }
}

template <int NKS>
DI void qk_tile1(const u16* Ks, const bf16x8 (&qf)[NKS], f32x4 (&s)[4], int l15, int g) {
#pragma unroll
  for (int kt = 0; kt < 4; ++kt) {
    s[kt] = (f32x4){0.f, 0.f, 0.f, 0.f};
#pragma unroll
    for (int ks = 0; ks < NKS; ++ks) s[kt] = mfma16(ldfrag(Ks + (kt * 16 + l15) * KLD + ks * 32 + 8 * g), qf[ks], s[kt]);
  }
}
DI void pv_accum1(const f32x4 (&s)[4], const u16* Vs, f32x4 (&o)[4], int l15, int g) {
  const int tq = l15 >> 2, tp = l15 & 3;
#pragma unroll
  for (int kk = 0; kk < 2; ++kk) {
    u32x4 w;
    w.x = pack2(s[2 * kk][0], s[2 * kk][1]); w.y = pack2(s[2 * kk][2], s[2 * kk][3]);
    w.z = pack2(s[2 * kk + 1][0], s[2 * kk + 1][1]); w.w = pack2(s[2 * kk + 1][2], s[2 * kk + 1][3]);
    const bf16x8 pf = __builtin_bit_cast(bf16x8, w);
#pragma unroll
    for (int d = 0; d < 4; ++d) {
      const bf16x8 vf = cat4(tr_read(Vs + (kk * 32 + 4 * g + tq) * KLD + d * 16 + 4 * tp), tr_read(Vs + (kk * 32 + 16 + 4 * g + tq) * KLD + d * 16 + 4 * tp));
      o[d] = mfma16(vf, pf, o[d]);
    }
  }
}

constexpr int SEQ_LDS_A = 0, SEQ_LDS_B = 128 * KLD * 2, SEQ_LDS_C = 2 * 128 * KLD * 2, SEQ_LDS_S = 3 * 128 * KLD * 2, SEQ_LDS_F = SEQ_LDS_S + 64 * KLD * 2;
constexpr int SEQ_LDS_HALO = SEQ_LDS_F + 4096;
constexpr int SEQ_LDS_CW = SEQ_LDS_HALO + 2 * 3 * 3 * 64 * 2;
DI float wave_scan_add(float x, int lane) {
#pragma unroll
  for (int o = 1; o < 64; o <<= 1) { const float y = __shfl_up(x, o); if (lane >= o) x += y; }
  return x;
}
DI float wave_scan_max(float x, int lane) {
#pragma unroll
  for (int o = 1; o < 64; o <<= 1) { const float y = __shfl_up(x, o); if (lane >= o) x = fmaxf(x, y); }
  return x;
}

DI void seq_fix_rows(const Params& p, int layer, int r0, int nrows) {
  u16* Y = (u16*)(p.ws + OFF_H);
  const u16* proj = (const u16*)(p.ws + OFF_PROJ);
  const int tid = otid(), lane = tid & 63, wv = tid >> 6;
  const bool ml = lane >= 32;
  const int ch = (lane & 31) * 8;
  const float* ng = ml ? p.ml_norm_g + layer * 64 + (ch & 63) : p.ssm_norm_g + layer * 256 + ch;
  const f32x4 g0 = *(const f32x4*)ng, g1 = *(const f32x4*)(ng + 4);
  for (int rb = wv * 4; rb < nrows; rb += 16) {
    u32x4 yv4[4], zv4[4], ov4[4];
#pragma unroll
    for (int j = 0; j < 4; ++j) {
      const size_t row = (size_t)(r0 + rb + j);
      yv4[j] = *(const u32x4*)(Y + row * 1024 + (ml ? Y_D : Y_C) + ch);
      zv4[j] = *(const u32x4*)(proj + row * NP + (ml ? PD_Z : PC_Z) + ch);
      ov4[j] = ml ? *(const u32x4*)(proj + row * NP + PD_O + ch) : (u32x4){0u, 0u, 0u, 0u};
    }
#pragma unroll
    for (int j = 0; j < 4; ++j) {
      const size_t row = (size_t)(r0 + rb + j);
      u16* yp = Y + row * 1024 + (ml ? Y_D : Y_C) + ch;
      const u32x4 yv = yv4[j], zv = zv4[j], ov = ov4[j];
      float v[8] = {bflo(yv.x), bfhi(yv.x), bflo(yv.y), bfhi(yv.y), bflo(yv.z), bfhi(yv.z), bflo(yv.w), bfhi(yv.w)};
      float z[8] = {bflo(zv.x), bfhi(zv.x), bflo(zv.y), bfhi(zv.y), bflo(zv.z), bfhi(zv.z), bflo(zv.w), bfhi(zv.w)};
      float ss = 0.f;
      if (ml) {
        const float o[8] = {bflo(ov.x), bfhi(ov.x), bflo(ov.y), bfhi(ov.y), bflo(ov.z), bfhi(ov.z), bflo(ov.w), bfhi(ov.w)};
#pragma unroll
        for (int i = 0; i < 8; ++i) { v[i] *= sigmoidf_(o[i]); ss += v[i] * v[i]; }
      } else {
#pragma unroll
        for (int i = 0; i < 8; ++i) { v[i] *= siluf(z[i]); ss += v[i] * v[i]; }
      }
      ss += __shfl_xor(ss, 1); ss += __shfl_xor(ss, 2); ss += __shfl_xor(ss, 4);
      const float ss16 = ss + __shfl_xor(ss, 8);
      const float rn = ml ? rsqrtf(ss * (1.f / 64.f) + 1e-6f) : rsqrtf(ss16 * (1.f / 128.f) + 1e-6f);
      float o8[8];
#pragma unroll
      for (int i = 0; i < 8; ++i) { const float gg = i < 4 ? g0[i & 3] : g1[i & 3]; o8[i] = v[i] * rn * gg * (ml ? siluf(z[i]) : 1.f); }
      u32x4 w; w.x = pack2(o8[0], o8[1]); w.y = pack2(o8[2], o8[3]); w.z = pack2(o8[4], o8[5]); w.w = pack2(o8[6], o8[7]);
      *(u32x4*)yp = w;
    }
  }
}


constexpr int SEQ8_LDS_F = SEQ_LDS_S + 64 * KLD * 2;
constexpr int SEQ8_LDS_HALO = SEQ8_LDS_F + 8192;
constexpr int SEQ8_LDS_CW = SEQ8_LDS_HALO + 2 * 3 * 3 * 64 * 2;
DI void stage_conv_w8(float* wl, const float* cw, const float* cb, int chan0, int nchan, int tid) {
  if (tid < 320) { const int j = tid >> 6, cc = tid & 63; wl[tid] = j < 4 ? cw[j * nchan + chan0 + cc] : cb[chan0 + cc]; }
}
DI void scale_rows8(u16* A, const float* rs, int tid) {
  const int ch = (tid & 7) * 8;
#pragma unroll
  for (int i = 0; i < 2; ++i) {
    const int row = (tid >> 3) + 64 * i;
    const float f = rs[row];
    u32x4 v = *(u32x4*)(A + row * KLD + ch);
    v.x = pack2(bflo(v.x) * f, bfhi(v.x) * f); v.y = pack2(bflo(v.y) * f, bfhi(v.y) * f);
    v.z = pack2(bflo(v.z) * f, bfhi(v.z) * f); v.w = pack2(bflo(v.w) * f, bfhi(v.w) * f);
    *(u32x4*)(A + row * KLD + ch) = v;
  }
}
DI void state_update8(const u16* Xs, const u16* Bs, f32x4 (&acc)[2], int w8, int l15, int g) {
  const int tq = l15 >> 2, tp = l15 & 3, pt = w8 >> 1, nt0 = (w8 & 1) * 2;
#pragma unroll
  for (int kk = 0; kk < 4; ++kk) {
    const bf16x8 af = cat4(tr_read(Xs + (kk * 32 + 4 * g + tq) * KLD + pt * 16 + 4 * tp), tr_read(Xs + (kk * 32 + 16 + 4 * g + tq) * KLD + pt * 16 + 4 * tp));
#pragma unroll
    for (int n = 0; n < 2; ++n) {
      const bf16x8 bfr = cat4(tr_read(Bs + (kk * 32 + 4 * g + tq) * KLD + (nt0 + n) * 16 + 4 * tp), tr_read(Bs + (kk * 32 + 16 + 4 * g + tq) * KLD + (nt0 + n) * 16 + 4 * tp));
      acc[n] = mfma16(af, bfr, acc[n]);
    }
  }
}
DI void state_to_lds8(u16* Ss, const f32x4 (&acc)[2], int w8, int l15, int g) {
  const int pt = w8 >> 1, nt0 = (w8 & 1) * 2;
#pragma unroll
  for (int n = 0; n < 2; ++n)
#pragma unroll
    for (int r = 0; r < 4; ++r) Ss[(pt * 16 + 4 * g + r) * KLD + (nt0 + n) * 16 + l15] = f2bf(acc[n][r]);
}

constexpr int SEQ8_LDS_ZERO = SEQ8_LDS_CW + 3 * 320 * 4;
constexpr int SEQ8_LDS_RAW = ((SEQ8_LDS_ZERO + 3 * 128 + 255) / 256) * 256;
DI void raw_dma8(const u16* projb, int col0, int t0, u16* raw, int tid) {
#pragma unroll
  for (int i = 0; i < 2; ++i) {
    const int chunk = tid + 512 * i;
    __builtin_amdgcn_global_load_lds((const unsigned*)(projb + (size_t)(t0 + (chunk >> 3)) * NP + col0 + (chunk & 7) * 8), (LDSP unsigned*)((LDSP char*)raw + chunk * 16), 16, 0, 0);
  }
}
DI void conv_raw8(const u16* raw, const u16* halo, const float* wl, const float* rowscale, float cscale, u16* dst, int tid) {
  const int q = tid >> 3, ch = (tid & 7) * 8;
  u32x4 v[5];
#pragma unroll
  for (int k = 0; k < 5; ++k) { const int r = 2 * q - 3 + k; v[k] = r >= 0 ? *(const u32x4*)(raw + r * 64 + ch) : *(const u32x4*)(halo + (r + 3) * 64 + ch); }
  float w[5][8];
#pragma unroll
  for (int j = 0; j < 5; ++j) { const f32x4 w0 = *(const f32x4*)(wl + j * 64 + ch), w1 = *(const f32x4*)(wl + j * 64 + ch + 4);
    w[j][0] = w0[0]; w[j][1] = w0[1]; w[j][2] = w0[2]; w[j][3] = w0[3]; w[j][4] = w1[0]; w[j][5] = w1[1]; w[j][6] = w1[2]; w[j][7] = w1[3]; }
#pragma unroll
  for (int o = 0; o < 2; ++o) {
    float acc[8];
#pragma unroll
    for (int i = 0; i < 8; ++i) acc[i] = w[4][i];
#pragma unroll
    for (int j = 0; j < 4; ++j) {
      const u32x4 x = v[o + j];
      acc[0] += w[j][0] * bflo(x.x); acc[1] += w[j][1] * bfhi(x.x); acc[2] += w[j][2] * bflo(x.y); acc[3] += w[j][3] * bfhi(x.y);
      acc[4] += w[j][4] * bflo(x.z); acc[5] += w[j][5] * bfhi(x.z); acc[6] += w[j][6] * bflo(x.w); acc[7] += w[j][7] * bfhi(x.w);
    }
    const float rs = (rowscale ? rowscale[2 * q + o] : 1.f) * cscale;
#pragma unroll
    for (int i = 0; i < 8; ++i) acc[i] = siluf(acc[i]) * rs;
    u32x4 ov; ov.x = pack2(acc[0], acc[1]); ov.y = pack2(acc[2], acc[3]); ov.z = pack2(acc[4], acc[5]); ov.w = pack2(acc[6], acc[7]);
    *(u32x4*)(dst + (2 * q + o) * KLD + ch) = ov;
  }
}
DI void save_halo8(const u16* raw, u16* halo, int tid) {
  if (tid < 72) { const int arr = tid / 24, rem = tid % 24; *(u32x4*)(halo + arr * 192 + rem * 8) = *(const u32x4*)(raw + arr * 8192 + 125 * 64 + rem * 8); }
}

DI void ssd_task8(const Params& p, int layer, int b, int h, unsigned char* smem) {
  u16* Cs = (u16*)(smem + SEQ_LDS_A); u16* Bs = (u16*)(smem + SEQ_LDS_B); u16* Xs = (u16*)(smem + SEQ_LDS_C); u16* Ss = (u16*)(smem + SEQ_LDS_S);
  float* fl = (float*)(smem + SEQ8_LDS_F);
  float* dts = fl; float* acs = fl + 128; float* wend = fl + 256; float* tmp = fl + 384;
  u16* halo = (u16*)(smem + SEQ8_LDS_HALO); float* cwl = (float*)(smem + SEQ8_LDS_CW); u16* zero3 = (u16*)(smem + SEQ8_LDS_ZERO);
  u16* raw = (u16*)(smem + SEQ8_LDS_RAW);
  int tid = otid512(), lane = tid & 63, w = tid >> 6, l15 = lane & 15, g = lane >> 4;
  const int gi = h >> 1;
  const u16* projb = (const u16*)(p.ws + OFF_PROJ) + (size_t)b * SEQ * NP;
  const float* smb = (const float*)(p.ws + OFF_SMALL) + (size_t)b * SEQ * NSMALL;
  const float* cw = p.ssm_conv_w + layer * 4 * 512; const float* cb = p.ssm_conv_b + layer * 512;
  u16* Y = (u16*)(p.ws + OFF_H);
  const float a_h = sgprf(-__expf(p.ssm_a_log[layer * 4 + h])), d_h = sgprf(p.ssm_d[layer * 4 + h]), dtb = sgprf(p.ssm_dt_bias[layer * 4 + h]);
  const int colB = PC_XBC + 256 + gi * 64, colC = PC_XBC + 384 + gi * 64, colX = PC_XBC + h * 64;
  f32x4 st[2] = {(f32x4){0.f, 0.f, 0.f, 0.f}, (f32x4){0.f, 0.f, 0.f, 0.f}};
  lds_barrier();
  stage_conv_w8(cwl, cw, cb, 256 + gi * 64, 512, tid);
  stage_conv_w8(cwl + 320, cw, cb, 384 + gi * 64, 512, tid);
  stage_conv_w8(cwl + 640, cw, cb, h * 64, 512, tid);
  if (tid < 96) ((unsigned*)zero3)[tid] = 0u;
  raw_dma8(projb, colB, 0, raw, tid); raw_dma8(projb, colC, 0, raw + 8192, tid); raw_dma8(projb, colX, 0, raw + 16384, tid);
  float dtraw = 0.f;
  if (tid < 128) dtraw = smb[(size_t)tid * NSMALL + SM_DT + h];
#pragma unroll 1
  for (int c = 0; c < 32; ++c) {
    const int t0 = c * 128;
    asm volatile("" : "+v"(tid)); lane = tid & 63; w = tid >> 6; l15 = lane & 15; g = lane >> 4;
    float dtv = 0.f;
    if (tid < 128) { const float xr = dtraw + dtb; dtv = xr > 15.f ? xr : (xr < -15.f ? __expf(xr) : __logf(1.f + __expf(xr))); }
    float cs = wave_scan_add(dtv * a_h, lane);
    if (tid == 63) tmp[0] = cs;
    asm volatile("s_waitcnt vmcnt(0)" ::: "memory");
    lds_barrier();
    if (w == 1) cs += tmp[0];
    if (tid < 128) { dts[tid] = dtv; acs[tid] = cs; }
    if (c + 1 < 32 && tid < 128) dtraw = smb[(size_t)(t0 + 128 + tid) * NSMALL + SM_DT + h];
    lds_barrier();
    {
      const u16* hc = halo + (c & 1) * 576;
      const u16* hB = c == 0 ? zero3 : hc; const u16* hC = c == 0 ? zero3 : hc + 192; const u16* hX = c == 0 ? zero3 : hc + 384;
      conv_raw8(raw, hB, cwl, nullptr, 1.f, Bs, tid);
      conv_raw8(raw + 8192, hC, cwl + 320, nullptr, 1.f, Cs, tid);
      conv_raw8(raw + 16384, hX, cwl + 640, dts, 1.f, Xs, tid);
      save_halo8(raw, halo + ((c + 1) & 1) * 576, tid);
    }
    if (tid < 128) wend[tid] = __expf(acs[127] - acs[tid]);
    state_to_lds8(Ss, st, w, l15, g);
    lds_barrier();
    if (c + 1 < 32) { raw_dma8(projb, colB, t0 + 128, raw, tid); raw_dma8(projb, colC, t0 + 128, raw + 8192, tid); raw_dma8(projb, colX, t0 + 128, raw + 16384, tid); }
    {
      const int tl = 16 * w + l15;
      bf16x8 cf[2];
#pragma unroll
      for (int ks = 0; ks < 2; ++ks) cf[ks] = ldfrag(Cs + tl * KLD + ks * 32 + 8 * g);
      f32x4 y[4];
#pragma unroll
      for (int d = 0; d < 4; ++d) y[d] = (f32x4){0.f, 0.f, 0.f, 0.f};
      const float at = acs[tl];
#pragma unroll 1
      for (int stl = 0; stl < 2; ++stl) {
        if (stl * 64 <= 16 * w + 15) {
          f32x4 sc[4];
          qk_tile1<2>(Bs + stl * 64 * KLD, cf, sc, l15, g);
#pragma unroll
          for (int kt = 0; kt < 4; ++kt) {
            const f32x4 as = *(const f32x4*)(acs + stl * 64 + kt * 16 + 4 * g);
#pragma unroll
            for (int r = 0; r < 4; ++r) {
              const bool ok = stl * 64 + kt * 16 + 4 * g + r <= tl;
              sc[kt][r] = ok ? sc[kt][r] * __expf(at - as[r]) : 0.f;
            }
          }
          pv_accum1(sc, Xs + stl * 64 * KLD, y, l15, g);
        }
      }
      const float ea = __expf(at), dsk = d_h / dts[tl];
      const size_t row = (size_t)b * SEQ + t0 + tl;
#pragma unroll
      for (int d = 0; d < 4; ++d) {
        f32x4 yo = (f32x4){0.f, 0.f, 0.f, 0.f};
#pragma unroll
        for (int ks = 0; ks < 2; ++ks) yo = mfma16(ldfrag(Ss + (d * 16 + l15) * KLD + ks * 32 + 8 * g), cf[ks], yo);
        const u32x2 xv = *(const u32x2*)(Xs + tl * KLD + d * 16 + 4 * g);
        const f32x4 v = y[d] + yo * ea;
        u32x2 o; o.x = pack2(v[0] + dsk * bflo(xv.x), v[1] + dsk * bfhi(xv.x)); o.y = pack2(v[2] + dsk * bflo(xv.y), v[3] + dsk * bfhi(xv.y));
        *(u32x2*)(Y + row * 1024 + Y_C + h * 64 + d * 16 + 4 * g) = o;
      }
    }
    lds_barrier();
    scale_rows8(Xs, wend, tid);
    lds_barrier();
    const float cd = __expf(acs[127]);
    st[0] *= cd; st[1] *= cd;
    state_update8(Xs, Bs, st, w, l15, g);
  }
  asm volatile("s_waitcnt vmcnt(0)" ::: "memory");
}

DI void mlstm_task8(const Params& p, int layer, int b, int h, unsigned char* smem) {
  u16* Qs = (u16*)(smem + SEQ_LDS_A); u16* Ks2 = (u16*)(smem + SEQ_LDS_B); u16* Vs2 = (u16*)(smem + SEQ_LDS_C); u16* Cst = (u16*)(smem + SEQ_LDS_S);
  float* fl = (float*)(smem + SEQ8_LDS_F);
  float* bcs = fl; float* us = fl + 128; float* pms = fl + 256; float* wend = fl + 384; float* nst = fl + 512; float* tmp = fl + 576; float* npart = fl + 640;
  u16* halo = (u16*)(smem + SEQ8_LDS_HALO); float* cwl = (float*)(smem + SEQ8_LDS_CW); u16* zero3 = (u16*)(smem + SEQ8_LDS_ZERO);
  u16* raw = (u16*)(smem + SEQ8_LDS_RAW);
  int tid = otid512(), lane = tid & 63, w = tid >> 6, l15 = lane & 15, g = lane >> 4;
  const u16* projb = (const u16*)(p.ws + OFF_PROJ) + (size_t)b * SEQ * NP;
  const float* smb = (const float*)(p.ws + OFF_SMALL) + (size_t)b * SEQ * NSMALL;
  const float* cw = p.ml_conv_w + layer * 4 * 512; const float* cb = p.ml_conv_b + layer * 512;
  const float ib = sgprf(p.ml_if_b[layer * 8 + h]), fb = sgprf(p.ml_if_b[layer * 8 + 4 + h]);
  u16* Y = (u16*)(p.ws + OFF_H);
  const int colQ = PD_QK + h * 64, colK = PD_QK + 256 + h * 64, colV = PD_V + h * 64;
  f32x4 st[2] = {(f32x4){0.f, 0.f, 0.f, 0.f}, (f32x4){0.f, 0.f, 0.f, 0.f}};
  float m_prev = 0.f;
  lds_barrier();
  if (tid < 64) nst[tid] = 0.f;
  stage_conv_w8(cwl, cw, cb, h * 64, 512, tid);
  stage_conv_w8(cwl + 320, cw, cb, 256 + h * 64, 512, tid);
  if (tid < 96) ((unsigned*)zero3)[tid] = 0u;
  raw_dma8(projb, colQ, 0, raw, tid); raw_dma8(projb, colK, 0, raw + 8192, tid); raw_dma8(projb, colV, 0, raw + 16384, tid);
  float iraw = 0.f, fraw = 0.f;
  if (tid < 128) { iraw = smb[(size_t)tid * NSMALL + SM_IF + h]; fraw = smb[(size_t)tid * NSMALL + SM_IF + 4 + h]; }
#pragma unroll 1
  for (int c = 0; c < 32; ++c) {
    const int t0 = c * 128;
    asm volatile("" : "+v"(tid)); lane = tid & 63; w = tid >> 6; l15 = lane & 15; g = lane >> 4;
    float ip = 0.f, lf = 0.f;
    if (tid < 128) { ip = iraw + ib; const float fp = fraw + fb; lf = fminf(fp, 0.f) - __logf(1.f + __expf(-fabsf(fp))); }
    float bc = wave_scan_add(lf, lane);
    if (tid == 63) tmp[0] = bc;
    asm volatile("s_waitcnt vmcnt(0)" ::: "memory");
    lds_barrier();
    if (w == 1) bc += tmp[0];
    const float u = tid < 128 ? ip - bc : -1e30f;
    float pm = wave_scan_max(u, lane);
    if (tid == 63) tmp[1] = pm;
    if (c + 1 < 32 && tid < 128) { iraw = smb[(size_t)(t0 + 128 + tid) * NSMALL + SM_IF + h]; fraw = smb[(size_t)(t0 + 128 + tid) * NSMALL + SM_IF + 4 + h]; }
    {
      const u16* hc = halo + (c & 1) * 576;
      const u16* hQ = c == 0 ? zero3 : hc; const u16* hK = c == 0 ? zero3 : hc + 192;
      conv_raw8(raw, hQ, cwl, nullptr, 1.f, Qs, tid);
      conv_raw8(raw + 8192, hK, cwl + 320, nullptr, 0.125f, Ks2, tid);
      save_halo8(raw, halo + ((c + 1) & 1) * 576, tid);
#pragma unroll
      for (int i = 0; i < 2; ++i) { const int chunk = tid + 512 * i; *(u32x4*)(Vs2 + (chunk >> 3) * KLD + (chunk & 7) * 8) = *(const u32x4*)(raw + 16384 + chunk * 8); }
    }
    state_to_lds8(Cst, st, w, l15, g);
    lds_barrier();
    if (w == 1) pm = fmaxf(pm, tmp[1]);
    if (tid < 128) { bcs[tid] = bc; us[tid] = u; pms[tid] = pm; }
    if (c + 1 < 32) { raw_dma8(projb, colQ, t0 + 128, raw, tid); raw_dma8(projb, colK, t0 + 128, raw + 8192, tid); raw_dma8(projb, colV, t0 + 128, raw + 16384, tid); }
    lds_barrier();
    const float blast = bcs[127];
    const float m_new = blast + fmaxf(m_prev, pms[127]);
    if (tid < 128) wend[tid] = __expf(blast - m_new + us[tid]);
    {
      const int tl = 16 * w + l15;
      bf16x8 qf[2];
#pragma unroll
      for (int ks = 0; ks < 2; ++ks) qf[ks] = ldfrag(Qs + tl * KLD + ks * 32 + 8 * g);
      f32x4 num[4];
#pragma unroll
      for (int d = 0; d < 4; ++d) num[d] = (f32x4){0.f, 0.f, 0.f, 0.f};
      const float bt = bcs[tl], mt = bt + fmaxf(m_prev, pms[tl]);
      float den = 0.f;
#pragma unroll 1
      for (int stl = 0; stl < 2; ++stl) {
        if (stl * 64 <= 16 * w + 15) {
          f32x4 sc[4];
          qk_tile1<2>(Ks2 + stl * 64 * KLD, qf, sc, l15, g);
#pragma unroll
          for (int kt = 0; kt < 4; ++kt) {
            const f32x4 uu = *(const f32x4*)(us + stl * 64 + kt * 16 + 4 * g);
#pragma unroll
            for (int r = 0; r < 4; ++r) {
              const bool ok = stl * 64 + kt * 16 + 4 * g + r <= tl;
              const float v = ok ? sc[kt][r] * __expf(bt - mt + uu[r]) : 0.f;
              sc[kt][r] = v; den += v;
            }
          }
          pv_accum1(sc, Vs2 + stl * 64 * KLD, num, l15, g);
        }
      }
      const float wi = __expf(bt + m_prev - mt);
      float qn = 0.f;
#pragma unroll
      for (int ks = 0; ks < 2; ++ks)
#pragma unroll
        for (int j = 0; j < 8; ++j) qn += bf2f((u16)qf[ks][j]) * nst[ks * 32 + 8 * g + j];
      qn = group_sum4(qn);
      const float dn = group_sum4(den) + wi * qn;
      const float inv = __builtin_amdgcn_rcpf(fmaxf(fabsf(dn), __expf(-mt)));
      const size_t row = (size_t)b * SEQ + t0 + tl;
#pragma unroll
      for (int d = 0; d < 4; ++d) {
        f32x4 ni = (f32x4){0.f, 0.f, 0.f, 0.f};
#pragma unroll
        for (int ks = 0; ks < 2; ++ks) ni = mfma16(ldfrag(Cst + (d * 16 + l15) * KLD + ks * 32 + 8 * g), qf[ks], ni);
        const f32x4 v = (num[d] + ni * wi) * inv;
        u32x2 o; o.x = pack2(v[0], v[1]); o.y = pack2(v[2], v[3]);
        *(u32x2*)(Y + row * 1024 + Y_D + h * 64 + d * 16 + 4 * g) = o;
      }
    }
    lds_barrier();
    scale_rows8(Ks2, wend, tid);
    lds_barrier();
    const float fprev = __expf(blast + m_prev - m_new);
    st[0] *= fprev; st[1] *= fprev;
    state_update8(Vs2, Ks2, st, w, l15, g);
    {
      const int e = tid & 63, part = tid >> 6;
      float a = 0.f;
#pragma unroll
      for (int s2 = 0; s2 < 16; ++s2) a += bf2f(Ks2[(part * 16 + s2) * KLD + e]);
      npart[part * 64 + e] = a;
    }
    lds_barrier();
    if (tid < 64) {
      float a = nst[tid] * fprev;
#pragma unroll
      for (int pp = 0; pp < 8; ++pp) a += npart[pp * 64 + tid];
      nst[tid] = a;
    }
    m_prev = m_new;
  }
  asm volatile("s_waitcnt vmcnt(0)" ::: "memory");
}

DI void compress_task(const Params& p, int layer, int b, int kv, int rb, unsigned char* smem) {
  constexpr int HLD = 136;
  u16* Hs = (u16*)smem;
  const int tid = otid(), lane = tid & 63, w = tid >> 6, l15 = lane & 15, g = lane >> 4;
  const u16* projb = (const u16*)(p.ws + OFF_PROJ) + (size_t)b * SEQ * NP + (kv ? PA_VC : PA_KC);
  const int mi = layer * 2 + kv;
  const u16* W1T = (const u16*)(p.ws + OFF_W1T) + (size_t)mi * 128 * 2048;
  const u16* W2T = (const u16*)(p.ws + OFF_W2T) + (size_t)mi * 64 * 128;
  const float* bias1 = (const float*)(p.ws + OFF_BIAS1) + mi * 16 * 128;
  f32x4 acc[2][2];
#pragma unroll
  for (int nt = 0; nt < 2; ++nt) { acc[nt][0] = (f32x4){0.f, 0.f, 0.f, 0.f}; acc[nt][1] = (f32x4){0.f, 0.f, 0.f, 0.f}; }
  int tok[2];
#pragma unroll
  for (int mt = 0; mt < 2; ++mt) { int i = rb * 32 + mt * 16 + l15; if (i > 254) i = 254; tok[mt] = 16 * i; }
#pragma unroll 4
  for (int ks = 0; ks < 64; ++ks) {
    const int j = ks >> 1, d0 = (ks & 1) * 32;
    bf16x8 af[2], wf[2];
#pragma unroll
    for (int mt = 0; mt < 2; ++mt) af[mt] = ldfrag(projb + (size_t)(tok[mt] + j) * NP + d0 + 8 * g);
#pragma unroll
    for (int nt = 0; nt < 2; ++nt) wf[nt] = ldfrag(W1T + (size_t)(w * 32 + nt * 16 + l15) * 2048 + ks * 32 + 8 * g);
#pragma unroll
    for (int nt = 0; nt < 2; ++nt)
#pragma unroll
      for (int mt = 0; mt < 2; ++mt) acc[nt][mt] = mfma16(wf[nt], af[mt], acc[nt][mt]);
  }
  lds_barrier();
#pragma unroll
  for (int nt = 0; nt < 2; ++nt) {
    const int n = w * 32 + nt * 16 + 4 * g;
    f32x4 bb = *(const f32x4*)(bias1 + n);
#pragma unroll
    for (int pc = 1; pc < 16; ++pc) bb += *(const f32x4*)(bias1 + pc * 128 + n);
#pragma unroll
    for (int mt = 0; mt < 2; ++mt) {
      const f32x4 v = acc[nt][mt] + bb;
      u32x2 o; o.x = pack2(siluf(v[0]), siluf(v[1])); o.y = pack2(siluf(v[2]), siluf(v[3]));
      *(u32x2*)(Hs + (mt * 16 + l15) * HLD + n) = o;
    }
  }
  lds_barrier();
  f32x4 acc2[2] = {(f32x4){0.f, 0.f, 0.f, 0.f}, (f32x4){0.f, 0.f, 0.f, 0.f}};
#pragma unroll
  for (int ks = 0; ks < 4; ++ks) {
    const bf16x8 wf = ldfrag(W2T + (size_t)(w * 16 + l15) * 128 + ks * 32 + 8 * g);
#pragma unroll
    for (int mt = 0; mt < 2; ++mt) acc2[mt] = mfma16(wf, ldfrag(Hs + (mt * 16 + l15) * HLD + ks * 32 + 8 * g), acc2[mt]);
  }
  u16* dst = (u16*)(p.ws + (kv ? OFF_VCMP : OFF_KCMP) + (size_t)layer * 512 * 1024) + (size_t)b * 256 * 64;
#pragma unroll
  for (int mt = 0; mt < 2; ++mt) {
    const int i = rb * 32 + mt * 16 + l15;
    u32x2 o; o.x = pack2(acc2[mt][0], acc2[mt][1]); o.y = pack2(acc2[mt][2], acc2[mt][3]);
    if (i > 254) { o.x = 0u; o.y = 0u; }
    *(u32x2*)(dst + (size_t)i * 64 + w * 16 + 4 * g) = o;
  }
}

DI void nsa_task(const Params& p, int layer, int b, int qi, unsigned char* smem) {
  u16* Ks = (u16*)smem; u16* Vs = Ks + 64 * KLD;
  float* T = (float*)(smem + 2 * KVBUF * 2);
  unsigned long long* selm = (unsigned long long*)(smem + 2 * KVBUF * 2 + 4 * 32 * 65 * 4);
  const int tid = otid(), lane = tid & 63, h = tid >> 6, l15 = lane & 15, g = lane >> 4;
  const int q0 = qi * 32;
  const u16* projb = (const u16*)(p.ws + OFF_PROJ) + (size_t)b * SEQ * NP;
  const float* smb = (const float*)(p.ws + OFF_SMALL) + (size_t)b * SEQ * NSMALL;
  const u16* kcmp = (const u16*)(p.ws + OFF_KCMP + (size_t)layer * 512 * 1024) + (size_t)b * 256 * 64;
  const u16* vcmp = (const u16*)(p.ws + OFF_VCMP + (size_t)layer * 512 * 1024) + (size_t)b * 256 * 64;
  bf16x8 qf[2][2];
#pragma unroll
  for (int qt = 0; qt < 2; ++qt)
#pragma unroll
    for (int ks = 0; ks < 2; ++ks) qf[qt][ks] = ldfrag(projb + (size_t)(q0 + qt * 16 + l15) * NP + PA_Q + h * 64 + ks * 32 + 8 * g);
  const float sc = 0.125f * 1.4426950408889634f;
  f32x4 outacc[4][2];
  AttnAcc a;
  const int ntc = (q0 >> 10) + 1;
  attn_init(a);
  lds_barrier();
  for (int i = tid; i < 4 * 32 * 65; i += 256) T[i] = 0.f;
  kv_pipeline(0, ntc, Ks,
    [&](int) { return true; },
    [&](int j, KVRegs& kr) { kv_load(kcmp, vcmp, 64, 64, j * 64, kr); },
    [&](int j, const u16* Kt, const u16* Vt) {
      f32x4 s[4][2];
      auto valid = [&](int kt, int r, int qt) { return 16 * (j * 64 + kt * 16 + 4 * g + r) + 31 <= q0 + qt * 16 + l15; };
      qk_tile<2>(Kt, 0, qf, s, l15, g);
      softmax_pv(s, a, Vt, sc, l15, g, valid);
    });
  float cinv[2];
#pragma unroll
  for (int qt = 0; qt < 2; ++qt) {
    const float lt = group_sum4(a.l[qt]);
    cinv[qt] = lt > 0.f ? 1.f / lt : 0.f;
    const float gt = sigmoidf_(smb[(size_t)(q0 + qt * 16 + l15) * NSMALL + SM_G + h * 3 + 0]) * cinv[qt];
#pragma unroll
    for (int d = 0; d < 4; ++d) outacc[d][qt] = a.o[d][qt] * gt;
  }
  float carry[2] = {0.f, 0.f};
  kv_pipeline(0, ntc, Ks,
    [&](int) { return true; },
    [&](int j, KVRegs& kr) { kv_load(kcmp, vcmp, 64, 64, j * 64, kr); },
    [&](int j, const u16* Kt, const u16*) {
      f32x4 s[4][2];
      qk_tile<2>(Kt, 0, qf, s, l15, g);
#pragma unroll
      for (int qt = 0; qt < 2; ++qt) {
        float prev3 = carry[qt];
#pragma unroll
        for (int kt = 0; kt < 4; ++kt) {
          float pr[4];
#pragma unroll
          for (int r = 0; r < 4; ++r) {
            const bool ok = 16 * (j * 64 + kt * 16 + 4 * g + r) + 31 <= q0 + qt * 16 + l15;
            pr[r] = ok ? exp2_(s[kt][qt][r] * sc - a.m[qt]) * cinv[qt] : 0.f;
          }
          const float below = __shfl_up(pr[3], 16);
          const float wrap = __shfl(prev3, l15 + 48);
          const float nb = g > 0 ? below : wrap;
          T[(h * 32 + qt * 16 + l15) * 65 + j * 16 + kt * 4 + g] = (pr[0] + pr[1]) + (pr[2] + 0.5f * pr[3]) + 0.5f * nb;
          prev3 = pr[3];
        }
        carry[qt] = prev3;
      }
    });
  lds_barrier();
#pragma unroll 1
  for (int qq = 0; qq < 8; ++qq) {
    const int q = h * 8 + qq, t = q0 + q, cur = t >> 6;
    const float imp = ((T[(0 * 32 + q) * 65 + lane] + T[(1 * 32 + q) * 65 + lane]) + T[(2 * 32 + q) * 65 + lane]) + T[(3 * 32 + q) * 65 + lane];
    const bool forced = lane == cur || lane == 0, allowed = lane <= cur, cand = allowed && !forced;
    const int K = cur == 0 ? 15 : 14;
    unsigned long long m;
    if (__popcll(__ballot(cand)) <= K) m = __ballot(allowed);
    else {
      const unsigned key = __float_as_uint(imp);
      unsigned prefix = 0u;
#pragma unroll 1
      for (int bit = 30; bit >= 0; --bit) {
        const unsigned cnd = prefix | (1u << bit);
        if (__popcll(__ballot(cand && key >= cnd)) >= K) prefix = cnd;
      }
      const unsigned long long gt = __ballot(cand && key > prefix), eq = __ballot(cand && key == prefix);
      const int need = K - __popcll(gt);
      const int myrank = __popcll(eq & ((1ull << lane) - 1ull));
      m = gt | __ballot(cand && key == prefix && myrank < need) | __ballot(forced);
    }
    if (lane == 0) selm[q] = m;
  }
  lds_barrier();
  f32x4* park = (f32x4*)T + (h * 8) * 64 + lane;
#pragma unroll
  for (int d = 0; d < 4; ++d) { park[(d * 2 + 0) * 64] = outacc[d][0]; park[(d * 2 + 1) * 64] = outacc[d][1]; }
  unsigned long long mq[2], anym = 0ull;
#pragma unroll
  for (int qt = 0; qt < 2; ++qt) mq[qt] = selm[qt * 16 + l15];
  for (int i = 0; i < 32; ++i) anym |= selm[i];
  const int jhi = (q0 + 31) >> 6;
#pragma unroll
  for (int qt = 0; qt < 2; ++qt)
#pragma unroll
    for (int ks = 0; ks < 2; ++ks) qf[qt][ks] = scale_frag(qf[qt][ks], sc);
  attn_init_rel(a);
  kv_pipeline(0, jhi + 1, Ks,
    [&](int j) { return (bool)((anym >> j) & 1ull); },
    [&](int j, KVRegs& kr) { kv_load(projb + PA_KS, projb + PA_VS, NP, NP, j * 64, kr); },
    [&](int j, const u16* Kt, const u16* Vt) {
      f32x4 s[4][2];
      auto valid = [&](int kt, int r, int qt) { return ((mq[qt] >> j) & 1ull) && (j * 64 + kt * 16 + 4 * g + r <= q0 + qt * 16 + l15); };
      bf16x8 pf[2][2];
      if (j * 64 + 63 <= q0) {
        qk_tile_rel<2>(Kt, 0, qf, a, s, l15, g, (bool)((mq[0] >> j) & 1ull), (bool)((mq[1] >> j) & 1ull));
        softmax_rel<0>(s, a, pf, l15, valid);
      } else {
        qk_tile_rel<2>(Kt, 0, qf, a, s, l15, g);
        softmax_rel<1>(s, a, pf, l15, valid);
      }
      pv_accum(pf, Vt, a.o, l15, g);
      rowsum_accum(pf, a, l15);
    });
#pragma unroll
  for (int qt = 0; qt < 2; ++qt) {
    const float lt = rel_rowsum(a, qt, l15);
    const float gt = sigmoidf_(smb[(size_t)(q0 + qt * 16 + l15) * NSMALL + SM_G + h * 3 + 1]) * (lt > 0.f ? 1.f / lt : 0.f);
#pragma unroll
    for (int d = 0; d < 4; ++d) park[(d * 2 + qt) * 64] += a.o[d][qt] * gt;
  }
  attn_init_rel(a);
  const int jlo = q0 >= 511 ? (q0 - 511) >> 6 : 0;
  kv_pipeline(jlo, jhi + 1, Ks,
    [&](int) { return true; },
    [&](int j, KVRegs& kr) { kv_load(projb + PA_KW, projb + PA_VW, NP, NP, j * 64, kr); },
    [&](int j, const u16* Kt, const u16* Vt) {
      f32x4 s[4][2];
      auto valid = [&](int kt, int r, int qt) { const int key = j * 64 + kt * 16 + 4 * g + r, t = q0 + qt * 16 + l15; return key <= t && key + 512 > t; };
      bf16x8 pf[2][2];
      qk_tile_rel<2>(Kt, 0, qf, a, s, l15, g);
      if (j * 64 + 63 <= q0 && j * 64 + 512 > q0 + 31) softmax_rel<0>(s, a, pf, l15, valid);
      else softmax_rel<1>(s, a, pf, l15, valid);
      pv_accum(pf, Vt, a.o, l15, g);
      rowsum_accum(pf, a, l15);
    });
  u16* Y = (u16*)(p.ws + OFF_H);
  const float* ng = p.nsa_norm_g + layer * 64;
#pragma unroll
  for (int qt = 0; qt < 2; ++qt) {
    const int t = q0 + qt * 16 + l15;
    const float lt = rel_rowsum(a, qt, l15);
    const float gt = sigmoidf_(smb[(size_t)t * NSMALL + SM_G + h * 3 + 2]) * (lt > 0.f ? 1.f / lt : 0.f);
    f32x4 v[4]; float ss = 0.f;
#pragma unroll
    for (int d = 0; d < 4; ++d) { v[d] = park[(d * 2 + qt) * 64] + a.o[d][qt] * gt; ss += v[d][0] * v[d][0] + v[d][1] * v[d][1] + v[d][2] * v[d][2] + v[d][3] * v[d][3]; }
    ss = group_sum4(ss);
    const float rn = rsqrtf(ss * (1.f / 64.f) + 1e-6f);
    const size_t row = (size_t)b * SEQ + t;
#pragma unroll
    for (int d = 0; d < 4; ++d) {
      const int dd = d * 16 + 4 * g;
      const u32x2 zz = *(const u32x2*)(projb + (size_t)t * NP + PA_Z + h * 64 + dd);
      const f32x4 gg = *(const f32x4*)(ng + dd);
      u32x2 o;
      o.x = pack2(v[d][0] * rn * gg[0] * siluf(bflo(zz.x)), v[d][1] * rn * gg[1] * siluf(bfhi(zz.x)));
      o.y = pack2(v[d][2] * rn * gg[2] * siluf(bflo(zz.y)), v[d][3] * rn * gg[3] * siluf(bfhi(zz.y)));
      *(u32x2*)(Y + row * 1024 + Y_A + h * 64 + dd) = o;
    }
  }
}


DI void final_norm_rows(const Params& p, int rbase, int nrows, int gw, int nw, int lane) {
  const float4* gp = (const float4*)p.final_g;
  float4 gg[4];
#pragma unroll
  for (int i = 0; i < 4; ++i) gg[i] = gp[lane + 64 * i];
  for (int row0 = rbase + gw * 4; row0 < rbase + nrows; row0 += nw * 4) {
    float4 v[4][4]; float ss[4];
#pragma unroll
    for (int j = 0; j < 4; ++j) {
      const float4* xr = (const float4*)(p.out + (size_t)(row0 + j) * D_MODEL);
#pragma unroll
      for (int i = 0; i < 4; ++i) v[j][i] = xr[lane + 64 * i];
    }
#pragma unroll
    for (int j = 0; j < 4; ++j) {
      float a = 0.f;
#pragma unroll
      for (int i = 0; i < 4; ++i) a += v[j][i].x * v[j][i].x + v[j][i].y * v[j][i].y + v[j][i].z * v[j][i].z + v[j][i].w * v[j][i].w;
      ss[j] = wave_sum(a);
    }
#pragma unroll
    for (int j = 0; j < 4; ++j) {
      float4* xr = (float4*)(p.out + (size_t)(row0 + j) * D_MODEL);
      const float r = rsqrtf(ss[j] * (1.f / D_MODEL) + 1e-6f);
#pragma unroll
      for (int i = 0; i < 4; ++i) { float4 w; w.x = v[j][i].x * r * gg[i].x; w.y = v[j][i].y * r * gg[i].y; w.z = v[j][i].z * r * gg[i].z; w.w = v[j][i].w * r * gg[i].w; xr[lane + 64 * i] = w; }
    }
  }
}

#define XB_TMO      128
#define XB_XCNT(j)  (256  + 64 * (j))
#define XB_XSUB(j)  (1280 + 64 * (j))
#define XB_XGEN(j)  (2304 + 64 * (j))
#define XB_TOP      3328
#define XB_TOPGEN   3392
#define XCD_BAR_WORDS 3456
#define XB_SPIN_CAP (1u << 23)
DI unsigned xb_ld(unsigned* p)              { return __hip_atomic_load(p, __ATOMIC_RELAXED, __HIP_MEMORY_SCOPE_AGENT); }
DI unsigned xb_add(unsigned* p, unsigned v) { return __hip_atomic_fetch_add(p, v, __ATOMIC_RELAXED, __HIP_MEMORY_SCOPE_AGENT); }
DI unsigned xb_xcc_id() { return (unsigned)__builtin_amdgcn_s_getreg((3 << 11) | 20) & 0xFu; }
#define XB_SPIN(cond, bar) do { unsigned _sp = 0; while (cond) { __builtin_amdgcn_s_sleep(1); \
    if ((++_sp & 255u) == 0u) { if (xb_ld(&(bar)[XB_TMO])) break; if (_sp > XB_SPIN_CAP) { atomicAdd(&(bar)[XB_TMO], 1u); break; } } } } while (0)
struct XcdBarrier { unsigned* bar; unsigned x; volatile LDSP unsigned* st; };
DI XcdBarrier xcd_barrier_post(unsigned* bar, volatile LDSP unsigned* st) {
  XcdBarrier b; b.bar = bar; b.x = xb_xcc_id(); b.st = st;
  if (threadIdx.x == 0) (void)xb_add(&bar[XB_XCNT(b.x)], 1u);
  return b;
}
DI void xcd_barrier_complete(unsigned* bar, unsigned x, unsigned& nloc, unsigned& nx) {
  const unsigned G = gridDim.x * gridDim.y * gridDim.z;
  unsigned sum, cnt, mine, sp = 0u;
  for (;;) {
    sum = 0u; cnt = 0u; mine = 0u;
#pragma unroll
    for (unsigned j = 0; j < 16; ++j) { const unsigned c = xb_ld(&bar[XB_XCNT(j)]); sum += c; cnt += (c > 0u) ? 1u : 0u; mine = (j == x) ? c : mine; }
    if (sum == G) break;
    __builtin_amdgcn_s_sleep(1);
    if ((++sp & 255u) == 0u) { if (xb_ld(&bar[XB_TMO])) break; if (sp > XB_SPIN_CAP) { atomicAdd(&bar[XB_TMO], 1u); break; } }
  }
  nloc = mine > 0u ? mine : 1u; nx = cnt > 0u ? cnt : 1u;
}
DI void xcd_barrier(const XcdBarrier& b) {
  asm volatile("s_waitcnt vmcnt(0)" ::: "memory");
  __syncthreads();
  if (threadIdx.x == 0) {
    unsigned* bar = b.bar;
    __builtin_amdgcn_s_waitcnt(0);
    unsigned nloc = b.st[0], nx = b.st[1];
    if (nloc == 0u) { xcd_barrier_complete(bar, b.x, nloc, nx); b.st[0] = nloc; b.st[1] = nx; }
    const unsigned old = xb_add(&bar[XB_XSUB(b.x)], 1u);
    const unsigned gen = old / nloc;
    if (old + 1u == (gen + 1u) * nloc) {
      __builtin_amdgcn_fence(__ATOMIC_RELEASE, "agent");
      asm volatile("s_waitcnt vmcnt(0)" ::: "memory");
      const unsigned og = xb_add(&bar[XB_TOP], 1u);
      const unsigned tg = og / nx;
      if (og + 1u == (tg + 1u) * nx) xb_add(&bar[XB_TOPGEN], 1u);
      else XB_SPIN(xb_ld(&bar[XB_TOPGEN]) == tg, bar);
      __builtin_amdgcn_fence(__ATOMIC_ACQUIRE, "agent");
      xb_add(&bar[XB_XGEN(b.x)], 1u);
      asm volatile("s_waitcnt vmcnt(0)" ::: "memory");
    } else {
      XB_SPIN(xb_ld(&bar[XB_XGEN(b.x)]) == gen, bar);
      __builtin_amdgcn_fence(__ATOMIC_ACQUIRE, "agent");
      asm volatile("s_waitcnt vmcnt(0)" ::: "memory");
    }
  }
  __syncthreads();
}

constexpr int HALF_LDS = 76 * 1024;
constexpr int SMEM_BYTES = 2 * HALF_LDS;
DI void group_barrier(unsigned* gc, unsigned target) {
  asm volatile("s_waitcnt vmcnt(0)" ::: "memory");
  __syncthreads();
  if (threadIdx.x == 0) {
    __hip_atomic_fetch_add(gc, 1u, __ATOMIC_RELAXED, __HIP_MEMORY_SCOPE_AGENT);
    unsigned sp = 0;
    while (__hip_atomic_load(gc, __ATOMIC_RELAXED, __HIP_MEMORY_SCOPE_AGENT) < target) { __builtin_amdgcn_s_sleep(1); if (++sp > (1u << 24)) break; }
    __builtin_amdgcn_fence(__ATOMIC_ACQUIRE, "agent");
    asm volatile("s_waitcnt vmcnt(0)" ::: "memory");
  }
  __syncthreads();
}
#ifndef STAGGER_US
#define STAGGER_US 0
#endif
__global__ void __launch_bounds__(512, 2) fwd_megakernel(Params p) {
  cg::grid_group grid = cg::this_grid();
  __shared__ __attribute__((aligned(16))) unsigned char smem[SMEM_BYTES];
  const int half = __builtin_amdgcn_readfirstlane(threadIdx.x >> 8);
  unsigned char* hsm = smem + half * HALF_LDS;
  const int G = gridDim.x, bid = blockIdx.x;
  const int slot = bid * 2 + half, NS = 2 * G;
  volatile LDSP unsigned* xst = (volatile LDSP unsigned*)(LDSP unsigned char*)(smem + SMEM_BYTES - 64);
  unsigned* cntp = (unsigned*)(p.ws + OFF_CNT);
  const XcdBarrier xb = xcd_barrier_post((unsigned*)(p.ws + OFF_BAR), xst);
  if (threadIdx.x == 0) xst[4] = __hip_atomic_fetch_add(cntp + 128 + xb.x, 1u, __ATOMIC_RELAXED, __HIP_MEMORY_SCOPE_AGENT);
  {
    constexpr int ADA0 = T0_WIN + T0_WOUT + T0_W1 + T0_W2;
    unsigned* cnt = cntp;
    for (int i = slot; i < ((T0_TOTAL + NS - 1) / NS) * NS; i += NS) {
      const int t = i < 96 ? ADA0 + i : (i - 96 < ADA0 ? i - 96 : i);
      phase0_task(p, t, hsm);
      if (i < 96) {
        asm volatile("s_waitcnt vmcnt(0)" ::: "memory");
        lds_barrier();
        if (otid512() == 0) {
          __builtin_amdgcn_fence(__ATOMIC_RELEASE, "agent");
          asm volatile("s_waitcnt vmcnt(0)" ::: "memory");
          __hip_atomic_fetch_add(cnt + 8, 2u, __ATOMIC_RELAXED, __HIP_MEMORY_SCOPE_AGENT);
        }
      }
    }
    if (otid512() == 0) {
      unsigned sp = 0;
      while (__hip_atomic_load(cnt + 8, __ATOMIC_RELAXED, __HIP_MEMORY_SCOPE_AGENT) < 96u) { __builtin_amdgcn_s_sleep(8); if (++sp > (1u << 22)) break; }
      __builtin_amdgcn_fence(__ATOMIC_ACQUIRE, "agent");
      asm volatile("s_waitcnt vmcnt(0)" ::: "memory");
    }
    lds_barrier();
    for (int t = slot; t < ((NTOK / 64 + NS - 1) / NS) * NS; t += NS) phase1_task(p, 0, p.x, t < NTOK / 64 ? t : NTOK / 64 - 1, hsm);
  }
  grid.sync();
  if (threadIdx.x == 0) {
    unsigned nloc = 0, ng = 0, gi = 0;
    for (unsigned j = 0; j < 16; ++j) { const unsigned c = xb_ld(xb.bar + XB_XCNT(j)); if (c) { if (j < xb.x) ++gi; ++ng; } if (j == xb.x) nloc = c; }
    xst[5] = nloc ? nloc : 1u; xst[6] = ng ? ng : 1u; xst[7] = gi;
  }
  __syncthreads();
  const int rank = __builtin_amdgcn_readfirstlane((int)xst[4]), nloc = __builtin_amdgcn_readfirstlane((int)xst[5]), ng = __builtin_amdgcn_readfirstlane((int)xst[6]), gi = __builtin_amdgcn_readfirstlane((int)xst[7]);
  unsigned* gcnt = cntp + 256 + 64 * xb.x;
  unsigned epoch = 0;
#if STAGGER_US
  { const unsigned long long t0 = wall_clock64(); while (wall_clock64() - t0 < (unsigned long long)(STAGGER_US * 100) * (unsigned long long)gi) __builtin_amdgcn_s_sleep(8); }
#endif
  const int lslot = rank * 2 + half, LNS = 2 * nloc;
  for (int bb = gi; bb < BATCH; bb += ng)
  for (int layer = 0; layer < 2; ++layer) {
    Params q = p;
    { size_t zoff = 0; asm volatile("" : "+s"(zoff)); q.ws = p.ws + zoff; }
    const float* xin = layer == 0 ? q.x : q.out;
    if (layer != 0) {
      for (int t = lslot; t < ((64 + LNS - 1) / LNS) * LNS; t += LNS) phase1_task(q, layer, xin, bb * 64 + (t < 64 ? t : 63), hsm);
      group_barrier(gcnt, ++epoch * (unsigned)nloc);
    }
    for (int t = rank; t < 256; t += nloc) { const int r = t >> 5, i = t & 31; gemm_inproj_tile(q, layer, bb * 16 + (i & 7) + 8 * (r & 1), (i >> 3) + 4 * (r >> 1), smem); }
    group_barrier(gcnt, ++epoch * (unsigned)nloc);
    {
      unsigned* cnt = (unsigned*)(q.ws + OFF_CNT);
      unsigned* qcnt = cnt + 32 + layer * 8; unsigned* cdone = cnt + 64 + layer * 8; unsigned* sdone = cnt + 96 + layer * 8;
      int* s_pair = (int*)(smem + SMEM_BYTES - 16);
      for (int sq = rank; sq < 8; sq += nloc) {
        if (sq < 4) ssd_task8(q, layer, bb, sq, smem); else mlstm_task8(q, layer, bb, sq - 4, smem);
        asm volatile("s_waitcnt vmcnt(0)" ::: "memory");
        lds_barrier();
        if (otid512() == 0) {
          __builtin_amdgcn_fence(__ATOMIC_RELEASE, "agent");
          asm volatile("s_waitcnt vmcnt(0)" ::: "memory");
          __hip_atomic_fetch_add(sdone + bb, 1u, __ATOMIC_RELAXED, __HIP_MEMORY_SCOPE_AGENT);
        }
      }
      constexpr int NP_C = 8, NP_D = 64, NP_N = 64, NP_F = 32, NP_ALL = NP_C + NP_D + NP_N + NP_F;
      const int bq = bb;
      for (;;) {
        const int t512 = otid512();
        lds_barrier();
        if (t512 == 0) *s_pair = (int)atomicAdd(qcnt + bq, 1u);
        lds_barrier();
        const int pair = *s_pair;
        if (pair >= NP_ALL) break;
        if (pair < NP_C) {
          const int v = pair * 2 + half;
          compress_task(q, layer, bq, v >> 3, v & 7, hsm);
          asm volatile("s_waitcnt vmcnt(0)" ::: "memory");
          lds_barrier();
          if (t512 == 0) {
            __builtin_amdgcn_fence(__ATOMIC_RELEASE, "agent");
            asm volatile("s_waitcnt vmcnt(0)" ::: "memory");
            __hip_atomic_fetch_add(cdone + bq, 1u, __ATOMIC_RELAXED, __HIP_MEMORY_SCOPE_AGENT);
          }
        } else if (pair < NP_C + NP_D) {
          const int d = pair - NP_C;
          diff_attn_task(q, layer, bq, 2 * (d & 1) + half, 31 - (d >> 1), hsm);
        } else if (pair < NP_C + NP_D + NP_N) {
          if (t512 == 0) {
            while (__hip_atomic_load(cdone + bq, __ATOMIC_RELAXED, __HIP_MEMORY_SCOPE_AGENT) < (unsigned)NP_C) __builtin_amdgcn_s_sleep(16);
            __builtin_amdgcn_fence(__ATOMIC_ACQUIRE, "agent");
            asm volatile("s_waitcnt vmcnt(0)" ::: "memory");
          }
          lds_barrier();
          nsa_task(q, layer, bq, 2 * (63 - (pair - NP_C - NP_D)) + half, hsm);
        } else {
          if (t512 == 0) {
            while (__hip_atomic_load(sdone + bq, __ATOMIC_RELAXED, __HIP_MEMORY_SCOPE_AGENT) < 8u) __builtin_amdgcn_s_sleep(16);
            __builtin_amdgcn_fence(__ATOMIC_ACQUIRE, "agent");
            asm volatile("s_waitcnt vmcnt(0)" ::: "memory");
          }
          lds_barrier();
          seq_fix_rows(q, layer, bq * SEQ + ((pair - NP_C - NP_D - NP_N) * 2 + half) * 64, 64);
        }
      }
    }
    group_barrier(gcnt, ++epoch * (unsigned)nloc);
    if (layer == 0) { for (int t = rank; t < 64; t += nloc) gemm_outproj_tile<0>(q, xin, q.out, bb * 16 + (t & 15), t >> 4, smem); }
    else { for (int t = rank; t < 64; t += nloc) gemm_outproj_tile<1>(q, xin, q.out, bb * 16 + (t & 15), t >> 4, smem); }
    group_barrier(gcnt, ++epoch * (unsigned)nloc);
    if (layer == 1) {
      const int t5 = otid512();
      final_norm_rows(q, bb * SEQ, SEQ, rank * 8 + (t5 >> 6), nloc * 8, t5 & 63);
    }
  }
}

extern "C" void kernel_launch(void* const* d_in, const int* in_sizes, int n_in, void* d_out, int out_size, void* d_ws, size_t ws_size,
                              hipStream_t stream) {
  static int grid_blocks = 0;
  if (!grid_blocks) {
    int dev = 0, cus = 0, per_cu = 0;
    (void)hipGetDevice(&dev);
    (void)hipDeviceGetAttribute(&cus, hipDeviceAttributeMultiprocessorCount, dev);
    (void)hipOccupancyMaxActiveBlocksPerMultiprocessor(&per_cu, fwd_megakernel, 512, 0);
    if (per_cu > 1) per_cu = 1;
    if (per_cu < 1) per_cu = 1;
    grid_blocks = cus * per_cu;
  }
  if (grid_blocks < 64 || (grid_blocks & 3)) { fprintf(stderr, "grid too small: %d\n", grid_blocks); return; }
  if (ws_size < WS_NEEDED) { fprintf(stderr, "workspace too small: %zu < %zu\n", ws_size, WS_NEEDED); return; }
  Params p{};
  const float** pp = (const float**)&p;
  for (int i = 0; i < 26; ++i) pp[i] = (const float*)d_in[i];
  p.out = (float*)d_out; p.ws = (unsigned char*)d_ws;
  (void)hipMemsetAsync((unsigned char*)d_ws + OFF_CNT, 0, 64 * 1024 + XCD_BAR_WORDS * 4, stream);
  void* args[] = {&p};
  hipError_t e = hipLaunchCooperativeKernel((void*)fwd_megakernel, dim3(grid_blocks), dim3(512), args, 0, stream);
  if (e != hipSuccess) fprintf(stderr, "cooperative launch failed: %s (grid %d)\n", hipGetErrorString(e), grid_blocks);
}
```

```cpp
#include <hip/hip_runtime.h>
#include <hip/hip_cooperative_groups.h>
#include <cstdio>
#include <cstdint>
namespace cg = cooperative_groups;

typedef unsigned short u16;
typedef short bf16x8 __attribute__((ext_vector_type(8)));
typedef short s16x4 __attribute__((ext_vector_type(4)));
typedef float f32x4 __attribute__((ext_vector_type(4)));
typedef float f32x2 __attribute__((ext_vector_type(2)));
typedef unsigned u32x4 __attribute__((ext_vector_type(4)));
typedef unsigned u32x2 __attribute__((ext_vector_type(2)));
typedef __bf16 bf16x2_t __attribute__((ext_vector_type(2)));
#define DI __device__ __forceinline__
#define LDSP __attribute__((address_space(3)))

constexpr int D_MODEL = 1024, BATCH = 8, SEQ = 4096, NTOK = BATCH * SEQ;
constexpr int D_IN = 3992;
constexpr int NP = 3968, NPAD = 4096, NSMALL = 32;
constexpr int PA_Q = 0, PA_KC = 256, PA_VC = 320, PA_KS = 384, PA_VS = 448, PA_KW = 512, PA_VW = 576, PA_Z = 640;
constexpr int PB_Q = 896, PB_K = 1152, PB_V = 1408, PB_Z = 1664;
constexpr int PC_Z = 1920, PC_XBC = 2176;
constexpr int PD_QK = 2688, PD_V = 3200, PD_O = 3456, PD_Z = 3712;
constexpr int SM_G = 0, SM_DT = 12, SM_IF = 16;
constexpr int Y_A = 0, Y_B = 256, Y_C = 512, Y_D = 768;

constexpr size_t MiB = 1024 * 1024;
constexpr size_t OFF_WINT = 0;
constexpr size_t OFF_WOUTT = 16 * MiB;
constexpr size_t OFF_W1T = 20 * MiB;
constexpr size_t OFF_W2T = 22 * MiB;
constexpr size_t OFF_BIAS1 = 22 * MiB + 64 * 1024;
constexpr size_t OFF_ADAP = 22 * MiB + 128 * 1024;
constexpr size_t OFF_KCMP = 24 * MiB;
constexpr size_t OFF_VCMP = 24 * MiB + 256 * 1024;
constexpr size_t OFF_BAR = 29 * MiB + 64 * 1024;
constexpr size_t OFF_CNT = 29 * MiB;
constexpr size_t OFF_SMALL = 25 * MiB;
constexpr size_t OFF_SSQ = 29 * MiB;
constexpr size_t OFF_H = 32 * MiB;
constexpr size_t OFF_PROJ = 96 * MiB;
constexpr size_t OFF_X1B = 352 * MiB;
constexpr size_t WS_NEEDED = OFF_X1B + (size_t)NTOK * 1024 * 2;

struct Params {
  const float* x; const float* c; const float* norm_g; const float* ada_w; const float* ada_b;
  const float* w_in; const float* w_out;
  const float* nsa_cmp_pos; const float* nsa_ck_w1; const float* nsa_ck_w2; const float* nsa_cv_w1; const float* nsa_cv_w2; const float* nsa_norm_g;
  const float* diff_lam; const float* diff_norm_g;
  const float* ssm_conv_w; const float* ssm_conv_b; const float* ssm_dt_bias; const float* ssm_a_log; const float* ssm_d; const float* ssm_norm_g;
  const float* ml_conv_w; const float* ml_conv_b; const float* ml_if_b; const float* ml_norm_g; const float* final_g;
  float* out; unsigned char* ws;
};

DI void lds_barrier() { asm volatile("s_waitcnt lgkmcnt(0)" ::: "memory"); __builtin_amdgcn_s_barrier(); asm volatile("" ::: "memory"); }
DI int otid() { int t = threadIdx.x & 255; asm volatile("" : "+v"(t)); return t; }
DI int otid512() { int t = threadIdx.x; asm volatile("" : "+v"(t)); return t; }
DI unsigned pack2(float a, float b) { f32x2 v = {a, b}; bf16x2_t r = __builtin_convertvector(v, bf16x2_t); return __builtin_bit_cast(unsigned, r); }
DI u16 f2bf(float a) { return (u16)(pack2(a, 0.f) & 0xffffu); }
DI float bf2f(u16 h) { return __uint_as_float(((unsigned)h) << 16); }
DI float bflo(unsigned u) { return __uint_as_float(u << 16); }
DI float bfhi(unsigned u) { return __uint_as_float(u & 0xffff0000u); }
DI f32x4 mfma16(bf16x8 a, bf16x8 b, f32x4 c) { return __builtin_amdgcn_mfma_f32_16x16x32_bf16(a, b, c, 0, 0, 0); }
DI float wave_sum(float v) {
#pragma unroll
  for (int o = 32; o > 0; o >>= 1) v += __shfl_xor(v, o);
  return v;
}
DI float siluf(float v) { return v * __builtin_amdgcn_rcpf(1.f + __expf(-v)); }
DI float sigmoidf_(float v) { return __builtin_amdgcn_rcpf(1.f + __expf(-v)); }
DI float exp2_(float v) { return __builtin_amdgcn_exp2f(v); }
DI float sgprf(float v) { return __int_as_float(__builtin_amdgcn_readfirstlane(__float_as_int(v))); }
DI s16x4 tr_read(const u16* p) { return __builtin_amdgcn_ds_read_tr16_b64_v4i16((LDSP s16x4*)p); }
DI bf16x8 cat4(s16x4 a, s16x4 b) { bf16x8 r; r[0] = a[0]; r[1] = a[1]; r[2] = a[2]; r[3] = a[3]; r[4] = b[0]; r[5] = b[1]; r[6] = b[2]; r[7] = b[3]; return r; }
DI bf16x8 ldfrag(const u16* p) { return *(const bf16x8*)p; }

DI int colmap(int n) {
  if (n < 640) return n;
  if (n < 896) return 652 + (n - 640);
  if (n < 1920) return 908 + (n - 896);
  if (n < 2688) return 1932 + (n - 1920);
  if (n < 3456) return 2704 + (n - 2688);
  if (n < 3968) return 3480 + (n - 3456);
  if (n < 3980) return 640 + (n - 3968);
  if (n < 3984) return 2700 + (n - 3980);
  if (n < 3992) return 3472 + (n - 3984);
  return -1;
}

#define PIN4(a) asm volatile("" : "+v"(a[0]), "+v"(a[1]), "+v"(a[2]), "+v"(a[3]))
DI void tconv_tile(const float* __restrict__ src, int ldsrc, int k0, int n0, u16* __restrict__ dst, int ldd, bool use_map, unsigned char* smem) {
  float* tile = (float*)smem;
  const int tid = otid();
  {
    const int c4 = tid & 15, kk0 = tid >> 4; int col = n0 + c4 * 4; if (use_map) col = colmap(col);
    const float* sp = src + (size_t)(k0 + kk0) * ldsrc + (col >= 0 ? col : 0);
    f32x4 v[4];
#pragma unroll
    for (int i = 0; i < 4; ++i) v[i] = *(const f32x4*)(sp + (size_t)(16 * i) * ldsrc);
    PIN4(v);
    lds_barrier();
#pragma unroll
    for (int i = 0; i < 4; ++i) {
      const f32x4 w = col >= 0 ? v[i] : (f32x4){0.f, 0.f, 0.f, 0.f};
      float* tp = tile + (kk0 + 16 * i) * 65 + c4 * 4;
      tp[0] = w[0]; tp[1] = w[1]; tp[2] = w[2]; tp[3] = w[3];
    }
  }
  lds_barrier();
#pragma unroll
  for (int i = 0; i < 2; ++i) {
    const int item = tid + 256 * i, nn = item >> 3, kc = item & 7;
    u32x4 w;
    w.x = pack2(tile[(kc * 8 + 0) * 65 + nn], tile[(kc * 8 + 1) * 65 + nn]);
    w.y = pack2(tile[(kc * 8 + 2) * 65 + nn], tile[(kc * 8 + 3) * 65 + nn]);
    w.z = pack2(tile[(kc * 8 + 4) * 65 + nn], tile[(kc * 8 + 5) * 65 + nn]);
    w.w = pack2(tile[(kc * 8 + 6) * 65 + nn], tile[(kc * 8 + 7) * 65 + nn]);
    *(u32x4*)(dst + (size_t)(n0 + nn) * ldd + k0 + kc * 8) = w;
  }
}

constexpr int T0_WIN = 2 * 16 * 64, T0_WOUT = 2 * 16 * 16, T0_W1 = 4 * 32 * 2, T0_W2 = 4 * 2, T0_ADA = 2 * 12 * 8, T0_B1 = 64;
constexpr int T0_TOTAL = T0_WIN + T0_WOUT + T0_W1 + T0_W2 + T0_ADA + T0_B1;

DI void phase0_task(const Params& p, int t, unsigned char* smem) {
  const int tid = otid();
  if (t >= T0_TOTAL) { lds_barrier(); lds_barrier(); return; }
  if (t < T0_WIN) {
    const int l = t / 1024, r = t % 1024, kt = r / 64, nt = r % 64;
    tconv_tile(p.w_in + (size_t)l * D_MODEL * D_IN, D_IN, kt * 64, nt * 64, (u16*)(p.ws + OFF_WINT) + (size_t)l * NPAD * 1024, 1024, true, smem);
    return;
  }
  t -= T0_WIN;
  if (t < T0_WOUT) {
    const int l = t / 256, r = t % 256, kt = r / 16, nt = r % 16;
    tconv_tile(p.w_out + (size_t)l * 1024 * 1024, 1024, kt * 64, nt * 64, (u16*)(p.ws + OFF_WOUTT) + (size_t)l * 1024 * 1024, 1024, false, smem);
    return;
  }
  t -= T0_WOUT;
  if (t < T0_W1) {
    const int m = t / 64, r = t % 64, kt = r / 2, nt = r % 2, l = m >> 1, kv = m & 1;
    const float* src = (kv ? p.nsa_cv_w1 : p.nsa_ck_w1) + (size_t)l * 2048 * 128;
    tconv_tile(src, 128, kt * 64, nt * 64, (u16*)(p.ws + OFF_W1T) + (size_t)m * 128 * 2048, 2048, false, smem);
    return;
  }
  t -= T0_W1;
  if (t < T0_W2) {
    const int m = t / 2, kt = t % 2, l = m >> 1, kv = m & 1;
    const float* src = (kv ? p.nsa_cv_w2 : p.nsa_ck_w2) + (size_t)l * 128 * 64;
    tconv_tile(src, 64, kt * 64, 0, (u16*)(p.ws + OFF_W2T) + (size_t)m * 64 * 128, 128, false, smem);
    return;
  }
  t -= T0_W2;
  if (t < T0_ADA) {
    const int l = t / 96, r = t % 96, nc = r / 8, kc = r % 8;
    float* cact = (float*)(smem + 20480);
    float* red = (float*)(smem + 24576);
    const int kq = __builtin_amdgcn_readfirstlane(tid >> 6), c4 = tid & 63;
    const float* w = p.ada_w + ((size_t)l * 1024 + kc * 128 + kq) * 3072 + nc * 256 + c4 * 4;
    float cv[4];
#pragma unroll
    for (int i = 0; i < 4; ++i) { const int e = tid + 256 * i; cv[i] = p.c[(e >> 7) * 1024 + kc * 128 + (e & 127)]; }
    f32x4 wv[32];
#pragma unroll
    for (int j = 0; j < 32; ++j) wv[j] = *(const f32x4*)(w + (size_t)(4 * j) * 3072);
    PIN4(cv);
#pragma unroll
    for (int i = 0; i < 4; ++i) cact[tid + 256 * i] = siluf(cv[i]);
#pragma unroll
    for (int j = 0; j < 32; j += 4) asm volatile("" : "+v"(wv[j]), "+v"(wv[j + 1]), "+v"(wv[j + 2]), "+v"(wv[j + 3]));
    lds_barrier();
    f32x4 acc[8];
#pragma unroll
    for (int b = 0; b < 8; ++b) acc[b] = (f32x4){0.f, 0.f, 0.f, 0.f};
#pragma unroll
    for (int j = 0; j < 32; ++j) {
#pragma unroll
      for (int b = 0; b < 8; ++b) acc[b] += cact[b * 128 + kq + 4 * j] * wv[j];
    }
#pragma unroll
    for (int b = 0; b < 8; ++b) *(f32x4*)(red + (kq * 8 + b) * 256 + c4 * 4) = acc[b];
    lds_barrier();
    float* adap = (float*)(p.ws + OFF_ADAP);
    const int n = nc * 256 + tid;
    float bias = p.ada_b[l * 3072 + n];
    asm volatile("" : "+v"(bias));
    bias = kc == 0 ? bias : 0.f;
#pragma unroll
    for (int i = 0; i < 8; ++i) {
      adap[(((size_t)kc * 2 + l) * 8 + i) * 3072 + n] = ((red[(0 * 8 + i) * 256 + tid] + red[(1 * 8 + i) * 256 + tid]) + (red[(2 * 8 + i) * 256 + tid] + red[(3 * 8 + i) * 256 + tid])) + bias;
    }
    return;
  }
  t -= T0_ADA;
  {
    const int m = t >> 4, kc = t & 15, l = m >> 1, kv = m & 1;
    const float* w1 = (kv ? p.nsa_cv_w1 : p.nsa_ck_w1) + (size_t)l * 2048 * 128;
    const float* pos = p.nsa_cmp_pos + (size_t)l * 2048;
    const int n = tid & 127, half = tid >> 7;
    float acc = 0.f;
    const int k0 = kc * 128 + half * 64;
#pragma unroll 1
    for (int kb = 0; kb < 64; kb += 16) {
      float wv[16];
#pragma unroll
      for (int k = 0; k < 16; ++k) wv[k] = w1[(size_t)(k0 + kb + k) * 128 + n];
#pragma unroll
      for (int k = 0; k < 16; k += 4) asm volatile("" : "+v"(wv[k]), "+v"(wv[k + 1]), "+v"(wv[k + 2]), "+v"(wv[k + 3]));
#pragma unroll
      for (int k = 0; k < 16; ++k) acc += pos[k0 + kb + k] * wv[k];
    }
    float* red = (float*)smem;
    lds_barrier();
    red[tid] = acc;
    lds_barrier();
    if (tid < 128) ((float*)(p.ws + OFF_BIAS1))[(m * 16 + kc) * 128 + tid] = red[tid] + red[tid + 128];
  }
}

DI void phase1_task(const Params& p, int layer, const float* xin, int grp, unsigned char* smem) {
  const int tid = otid(), lane = tid & 63, wid = tid >> 6;
  const int b = grp >> 6;
  float* mul = (float*)smem;
  float* sh = mul + 1024;
  const float* adap = (const float*)(p.ws + OFF_ADAP);
  lds_barrier();
  {
    f32x4 a0[8], a1[8];
#pragma unroll
    for (int kc = 0; kc < 8; ++kc) { const float* a = adap + (((size_t)kc * 2 + layer) * 8 + b) * 3072 + 4 * tid; a0[kc] = *(const f32x4*)a; a1[kc] = *(const f32x4*)(a + 1024); }
    f32x4 gv = *(const f32x4*)(p.norm_g + layer * 1024 + 4 * tid);
    asm volatile("" : "+v"(a0[0]), "+v"(a0[1]), "+v"(a0[2]), "+v"(a0[3]), "+v"(a0[4]), "+v"(a0[5]), "+v"(a0[6]), "+v"(a0[7]));
    asm volatile("" : "+v"(a1[0]), "+v"(a1[1]), "+v"(a1[2]), "+v"(a1[3]), "+v"(a1[4]), "+v"(a1[5]), "+v"(a1[6]), "+v"(a1[7]), "+v"(gv));
    f32x4 s0 = a0[0], s1 = a1[0];
#pragma unroll
    for (int kc = 1; kc < 8; ++kc) { s0 += a0[kc]; s1 += a1[kc]; }
    *(f32x4*)(mul + 4 * tid) = gv * (1.f + s1); *(f32x4*)(sh + 4 * tid) = s0;
  }
  lds_barrier();
  u16* H = (u16*)(p.ws + OFF_H);
#pragma unroll 1
  for (int it = 0; it < 4; ++it) {
    f32x4 v[4][4]; float ss[4];
#pragma unroll
    for (int j = 0; j < 4; ++j) {
      const int row = grp * 64 + wid * 16 + it * 4 + j;
      if (layer == 0) {
        const f32x4* xr = (const f32x4*)(xin + (size_t)row * D_MODEL);
#pragma unroll
        for (int i = 0; i < 4; ++i) v[j][i] = xr[lane + 64 * i];
      } else {
        const u32x2* xr = (const u32x2*)((const u16*)(p.ws + OFF_X1B) + (size_t)row * D_MODEL);
#pragma unroll
        for (int i = 0; i < 4; ++i) { const u32x2 w = xr[lane + 64 * i]; v[j][i] = (f32x4){bflo(w.x), bfhi(w.x), bflo(w.y), bfhi(w.y)}; }
      }
    }
    if (layer == 0) asm volatile("" : "+v"(v[0][0]), "+v"(v[0][1]), "+v"(v[0][2]), "+v"(v[0][3]), "+v"(v[1][0]), "+v"(v[1][1]), "+v"(v[1][2]), "+v"(v[1][3]), "+v"(v[2][0]), "+v"(v[2][1]), "+v"(v[2][2]), "+v"(v[2][3]), "+v"(v[3][0]), "+v"(v[3][1]), "+v"(v[3][2]), "+v"(v[3][3]));
#pragma unroll
    for (int j = 0; j < 4; ++j) {
      float a = 0.f;
#pragma unroll
      for (int i = 0; i < 4; ++i) a += v[j][i][0] * v[j][i][0] + v[j][i][1] * v[j][i][1] + v[j][i][2] * v[j][i][2] + v[j][i][3] * v[j][i][3];
      ss[j] = wave_sum(a);
    }
#pragma unroll
    for (int j = 0; j < 4; ++j) {
      const int row = grp * 64 + wid * 16 + it * 4 + j;
      const float r = rsqrtf(ss[j] * (1.f / D_MODEL) + 1e-6f);
#pragma unroll
      for (int i = 0; i < 4; ++i) {
        const int c = (lane + 64 * i) * 4;
        u32x2 w;
        w.x = pack2(v[j][i][0] * r * mul[c] + sh[c], v[j][i][1] * r * mul[c + 1] + sh[c + 1]);
        w.y = pack2(v[j][i][2] * r * mul[c + 2] + sh[c + 2], v[j][i][3] * r * mul[c + 3] + sh[c + 3]);
        *(u32x2*)(H + (size_t)row * 1024 + c) = w;
      }
    }
  }
}

namespace g8 {
constexpr int BM = 256, BK = 64, HALF = 128, HT = HALF * BK;
constexpr int LDS_BYTES = 8 * HT * 2;
DI int lds_byte(int r, int c) { const int st = (r >> 4) * 2 + (c >> 5), rr = r & 15, cc = c & 31, ob = rr * 64 + cc * 2; return st * 1024 + (ob ^ (((ob >> 9) & 1) << 5)); }
DI void stage_rc(int b, int& R, int& C) { const int st = b / 1024, sb = b % 1024, swz = sb ^ (((sb >> 9) & 1) << 5); R = (st >> 1) * 16 + swz / 64; C = (st & 1) * 32 + (swz % 64) / 2; }

DI void kloop(const u16* __restrict__ A, const u16* __restrict__ Bt, int K, int brow, int bcol, unsigned char* smem, f32x4 (&acc)[2][2][4][2]) {
  u16* shm = (u16*)smem;
  const int tid = otid512();
#define SA(b, h) (shm + ((b) * 2 + (h)) * HT)
#define SB(b, h) (shm + (4 + (b) * 2 + (h)) * HT)
#define STAGE(P, BASE, br, kt) do { const u16* _gb = BASE + ((long)(br) * K + (long)(kt) * BK); \
      __builtin_amdgcn_global_load_lds((const unsigned*)(_gb + soff0), (LDSP unsigned*)((LDSP char*)(P) + tid * 16), 16, 0, 0); \
      __builtin_amdgcn_global_load_lds((const unsigned*)(_gb + soff1), (LDSP unsigned*)((LDSP char*)(P) + tid * 16 + 8192), 16, 0, 0); } while (0)
#define LDA(dst, b, h) _Pragma("unroll") for (int m = 0; m < 4; ++m) _Pragma("unroll") for (int k = 0; k < 2; ++k) \
    dst[m][k] = *reinterpret_cast<const bf16x8*>((const char*)SA(b, h) + lds_byte(wr * 64 + m * 16 + fr, k * 32 + fq * 8))
#define LDB(dst, b, h) _Pragma("unroll") for (int n = 0; n < 2; ++n) _Pragma("unroll") for (int k = 0; k < 2; ++k) \
    dst[n][k] = *reinterpret_cast<const bf16x8*>((const char*)SB(b, h) + lds_byte(wc * 32 + n * 16 + fr, k * 32 + fq * 8))
#define MMA(ai, bj, At_, Bt_) do { __builtin_amdgcn_s_setprio(1); \
    _Pragma("unroll") for (int m = 0; m < 4; ++m) _Pragma("unroll") for (int n = 0; n < 2; ++n) _Pragma("unroll") for (int k = 0; k < 2; ++k) \
      acc[ai][bj][m][n] = __builtin_amdgcn_mfma_f32_16x16x32_bf16(Bt_[n][k], At_[m][k], acc[ai][bj][m][n], 0, 0, 0); \
    __builtin_amdgcn_s_setprio(0); } while (0)
#define WAIT_V(n) asm volatile("s_waitcnt vmcnt(" #n ")" ::: "memory")
#define WAIT_L(n) asm volatile("s_waitcnt lgkmcnt(" #n ")" ::: "memory")
#define BAR __builtin_amdgcn_s_barrier()
#define SCHED __builtin_amdgcn_sched_barrier(0)
  const int wid = __builtin_amdgcn_readfirstlane(tid >> 6), lane = tid & 63, wr = wid >> 2, wc = wid & 3, fr = lane & 15, fq = lane >> 4;
#pragma unroll
  for (int a = 0; a < 2; ++a)
#pragma unroll
    for (int b = 0; b < 2; ++b)
#pragma unroll
      for (int m = 0; m < 4; ++m) { acc[a][b][m][0] = (f32x4){0.f, 0.f, 0.f, 0.f}; acc[a][b][m][1] = (f32x4){0.f, 0.f, 0.f, 0.f}; }
  bf16x8 At[4][2], B0[2][2], B1[2][2];
  const int nt = K / BK;
  int soff0, soff1;
  { int r_, c_; stage_rc(tid * 16, r_, c_); soff0 = r_ * K + c_; stage_rc(tid * 16 + 8192, r_, c_); soff1 = r_ * K + c_; }
  STAGE(SB(0, 0), Bt, bcol, 0); STAGE(SA(0, 0), A, brow, 0);
  STAGE(SB(0, 1), Bt, bcol + HALF, 0); STAGE(SA(0, 1), A, brow + HALF, 0);
  if (wr == 1) BAR;
  WAIT_V(4); BAR;
  STAGE(SB(1, 0), Bt, bcol, 1); STAGE(SA(1, 0), A, brow, 1); STAGE(SB(1, 1), Bt, bcol + HALF, 1);
  WAIT_V(6); BAR;
#pragma unroll 1
  for (int t = 0; t < nt - 2; t += 2) {
    asm volatile("" : "+v"(soff0), "+v"(soff1));
    LDB(B0, 0, 0); SCHED; LDA(At, 0, 0); STAGE(SA(1, 1), A, brow + HALF, t + 1);
    WAIT_L(8); BAR; WAIT_L(0); MMA(0, 0, At, B0); BAR; SCHED;
    LDB(B1, 0, 1); STAGE(SB(0, 0), Bt, bcol, t + 2);
    BAR; WAIT_L(0); MMA(0, 1, At, B1); BAR;
    LDA(At, 0, 1); STAGE(SA(0, 0), A, brow, t + 2);
    BAR; WAIT_L(0); MMA(1, 0, At, B0); BAR; SCHED;
    STAGE(SB(0, 1), Bt, bcol + HALF, t + 2);
    WAIT_V(6); BAR; MMA(1, 1, At, B1); BAR;
    LDB(B0, 1, 0); SCHED; LDA(At, 1, 0); STAGE(SA(0, 1), A, brow + HALF, t + 2);
    WAIT_L(8); BAR; WAIT_L(0); MMA(0, 0, At, B0); BAR; SCHED;
    LDB(B1, 1, 1); STAGE(SB(1, 0), Bt, bcol, t + 3);
    BAR; WAIT_L(0); MMA(0, 1, At, B1); BAR;
    LDA(At, 1, 1); STAGE(SA(1, 0), A, brow, t + 3);
    BAR; WAIT_L(0); MMA(1, 0, At, B0); BAR; SCHED;
    STAGE(SB(1, 1), Bt, bcol + HALF, t + 3);
    WAIT_V(6); BAR; MMA(1, 1, At, B1); BAR;
  }
  { LDB(B0, 0, 0); LDA(At, 0, 0); STAGE(SA(1, 1), A, brow + HALF, nt - 1);
    BAR; WAIT_L(0); MMA(0, 0, At, B0); BAR;
    LDB(B1, 0, 1); BAR; WAIT_L(0); MMA(0, 1, At, B1); BAR;
    LDA(At, 0, 1); WAIT_V(4); BAR; WAIT_L(0); MMA(1, 0, At, B0); MMA(1, 1, At, B1); BAR; }
  { LDB(B0, 1, 0); LDA(At, 1, 0); WAIT_V(2); BAR; WAIT_L(0); MMA(0, 0, At, B0); BAR;
    LDB(B1, 1, 1); WAIT_V(0); BAR; WAIT_L(0); MMA(0, 1, At, B1); BAR;
    LDA(At, 1, 1); BAR; WAIT_L(0); MMA(1, 0, At, B0); MMA(1, 1, At, B1); BAR; }
  if (wr == 0) BAR;
#undef SA
#undef SB
#undef STAGE
#undef LDA
#undef LDB
#undef MMA
#undef WAIT_V
#undef WAIT_L
#undef BAR
#undef SCHED
}
DI void tile_map(int wgid, int nM, int nN, int& pm, int& pn) {
  const int nwg = nM * nN, NXCD = 8, WGM = 8;
  { const int q = nwg / NXCD, r = nwg % NXCD, xcd = wgid % NXCD, off = wgid / NXCD; wgid = (xcd < r ? xcd * (q + 1) : r * (q + 1) + (xcd - r) * q) + off; }
  const int nig = WGM * nN, gid = wgid / nig, fm = gid * WGM, gsz = (nM - fm) < WGM ? (nM - fm) : WGM;
  pm = fm + ((wgid % nig) % gsz); pn = (wgid % nig) / gsz;
}
}

DI void gemm_inproj_tile(const Params& p, int layer, int pm, int pn, unsigned char* smem) {
  const int brow = pm * 256, bcol = pn * 256;
  f32x4 acc[2][2][4][2];
  g8::kloop((const u16*)(p.ws + OFF_H), (const u16*)(p.ws + OFF_WINT) + (size_t)layer * NPAD * 1024, 1024, brow, bcol, smem, acc);
  const int tid = otid512(), wid = __builtin_amdgcn_readfirstlane(tid >> 6), lane = tid & 63, wr = wid >> 2, wc = wid & 3, fr = lane & 15, fq = lane >> 4;
  u16* proj = (u16*)(p.ws + OFF_PROJ);
  if (pn == 15 && wc == 0) {
    float* sm = (float*)(p.ws + OFF_SMALL);
#pragma unroll
    for (int ai = 0; ai < 2; ++ai)
#pragma unroll
      for (int m = 0; m < 4; ++m)
#pragma unroll
        for (int n = 0; n < 2; ++n) {
          const int mr = brow + ai * 128 + wr * 64 + m * 16 + fr;
          *(f32x4*)(sm + (size_t)mr * NSMALL + n * 16 + 4 * fq) = acc[ai][1][m][n];
        }
  }
  constexpr int CLD = 264;
  u16* Cs = (u16*)smem;
#pragma unroll
  for (int ai = 0; ai < 2; ++ai) {
    lds_barrier();
#pragma unroll
    for (int bj = 0; bj < 2; ++bj)
#pragma unroll
      for (int m = 0; m < 4; ++m)
#pragma unroll
        for (int n = 0; n < 2; ++n) {
          const f32x4 v = acc[ai][bj][m][n];
          u32x2 w; w.x = pack2(v[0], v[1]); w.y = pack2(v[2], v[3]);
          *(u32x2*)(Cs + (wr * 64 + m * 16 + fr) * CLD + bj * 128 + wc * 32 + n * 16 + 4 * fq) = w;
        }
    lds_barrier();
#pragma unroll
    for (int i = 0; i < 8; ++i) {
      const int id = tid + 512 * i, row = id >> 5, ch = id & 31;
      if (bcol + ch * 8 < NP) *(u32x4*)(proj + (size_t)(brow + ai * 128 + row) * NP + bcol + ch * 8) = *(const u32x4*)(Cs + row * CLD + ch * 8);
    }
  }
  lds_barrier();
}

template <int layer>
DI void gemm_outproj_tile(const Params& p, const float* xin, float* xout, int pm, int pn, unsigned char* smem) {
  const int brow = pm * 256, bcol = pn * 256;
  f32x4 acc[2][2][4][2];
  g8::kloop((const u16*)(p.ws + OFF_H), (const u16*)(p.ws + OFF_WOUTT) + (size_t)layer * 1024 * 1024, 1024, brow, bcol, smem, acc);
  const int tid = otid512(), wid = __builtin_amdgcn_readfirstlane(tid >> 6), lane = tid & 63, wr = wid >> 2, wc = wid & 3, fr = lane & 15, fq = lane >> 4;
  const int b = brow >> 12;
  const float* adap = (const float*)(p.ws + OFF_ADAP);
  constexpr int CLD = 132;
  float* Cs = (float*)smem;
#pragma unroll
  for (int ai = 0; ai < 2; ++ai)
#pragma unroll
    for (int bj = 0; bj < 2; ++bj) {
      lds_barrier();
#pragma unroll
      for (int m = 0; m < 4; ++m)
#pragma unroll
        for (int n = 0; n < 2; ++n) *(f32x4*)(Cs + (wr * 64 + m * 16 + fr) * CLD + wc * 32 + n * 16 + 4 * fq) = acc[ai][bj][m][n];
      lds_barrier();
      const int ch = tid & 31, nc = bcol + bj * 128 + ch * 4;
      f32x4 gt = {0.f, 0.f, 0.f, 0.f};
#pragma unroll
      for (int kc = 0; kc < 8; ++kc) gt += *(const f32x4*)(adap + (((size_t)kc * 2 + layer) * 8 + b) * 3072 + 2048 + nc);
      u16* x1b = (u16*)(p.ws + OFF_X1B);
      f32x4 xv[8];
#pragma unroll
      for (int i = 0; i < 8; ++i) {
        const size_t off = (size_t)(brow + ai * 128 + (tid >> 5) + 16 * i) * 1024 + nc;
        if (layer == 0) xv[i] = *(const f32x4*)(xin + off);
        else { const u32x2 w = *(const u32x2*)(x1b + off); xv[i] = (f32x4){bflo(w.x), bfhi(w.x), bflo(w.y), bfhi(w.y)}; }
      }
#pragma unroll
      for (int i = 0; i < 8; ++i) {
        const int row = (tid >> 5) + 16 * i;
        const size_t off = (size_t)(brow + ai * 128 + row) * 1024 + nc;
        const f32x4 v = xv[i] + gt * *(const f32x4*)(Cs + row * CLD + ch * 4);
        if (layer == 0) { u32x2 w; w.x = pack2(v[0], v[1]); w.y = pack2(v[2], v[3]); *(u32x2*)(x1b + off) = w; }
        else *(f32x4*)(xout + off) = v;
      }
    }
  lds_barrier();
}

constexpr int KLD = 72;
struct KVRegs { u32x4 k[2], v[2]; };
DI void kv_load(const u16* kbase, const u16* vbase, int ldk, int ldv, int key0, KVRegs& r) {
  const int tid = otid();
#pragma unroll
  for (int i = 0; i < 2; ++i) {
    const int id = tid + 256 * i, row = id >> 3, ch = id & 7;
    r.k[i] = *(const u32x4*)(kbase + (size_t)(key0 + row) * ldk + ch * 8);
    r.v[i] = *(const u32x4*)(vbase + (size_t)(key0 + row) * ldv + ch * 8);
  }
}
DI void kv_store(u16* Ks, u16* Vs, const KVRegs& r) {
  const int tid = otid();
#pragma unroll
  for (int i = 0; i < 2; ++i) {
    const int id = tid + 256 * i, row = id >> 3, ch = id & 7;
    *(u32x4*)(Ks + row * KLD + ch * 8) = r.k[i];
    *(u32x4*)(Vs + row * KLD + ch * 8) = r.v[i];
  }
}
constexpr int KVBUF = 2 * 64 * KLD;
template <class UseF, class LoadF, class CompF>
DI void kv_pipeline(int j0, int j1, u16* buf, UseF use, LoadF load, CompF comp) {
  KVRegs kr;
  if (use(j0)) load(j0, kr);
  lds_barrier();
  if (use(j0)) kv_store(buf, buf + 64 * KLD, kr);
  if (j0 + 1 < j1 && use(j0 + 1)) load(j0 + 1, kr);
  lds_barrier();
  for (int j = j0; j < j1; ++j) {
    u16* cur = buf + ((j - j0) & 1) * KVBUF; u16* nxt = buf + (((j - j0) & 1) ^ 1) * KVBUF;
    if (j + 1 < j1 && use(j + 1)) kv_store(nxt, nxt + 64 * KLD, kr);
    if (j + 2 < j1 && use(j + 2)) load(j + 2, kr);
    if (use(j)) comp(j, cur, cur + 64 * KLD);
    lds_barrier();
  }
}
struct AttnAcc { f32x4 o[4][2]; float m[2], l[2]; f32x4 os[2]; int fresh; };
DI void attn_init(AttnAcc& a) {
#pragma unroll
  for (int d = 0; d < 4; ++d) { a.o[d][0] = (f32x4){0.f, 0.f, 0.f, 0.f}; a.o[d][1] = (f32x4){0.f, 0.f, 0.f, 0.f}; }
  a.m[0] = a.m[1] = -1e30f; a.l[0] = a.l[1] = 0.f;
}
template <int NKS>
DI void qk_tile(const u16* Ks, int dofs, const bf16x8 (&qf)[2][NKS], f32x4 (&s)[4][2], int l15, int g) {
#pragma unroll
  for (int kt = 0; kt < 4; ++kt) {
    s[kt][0] = (f32x4){0.f, 0.f, 0.f, 0.f}; s[kt][1] = (f32x4){0.f, 0.f, 0.f, 0.f};
#pragma unroll
    for (int ks = 0; ks < NKS; ++ks) {
      const bf16x8 a = ldfrag(Ks + (kt * 16 + l15) * KLD + dofs + ks * 32 + 8 * g);
      s[kt][0] = mfma16(a, qf[0][ks], s[kt][0]);
      s[kt][1] = mfma16(a, qf[1][ks], s[kt][1]);
    }
  }
}
DI void pv_accum(const bf16x8 (&pf)[2][2], const u16* Vs, f32x4 (&o)[4][2], int l15, int g) {
  const int tq = l15 >> 2, tp = l15 & 3;
#pragma unroll
  for (int kk = 0; kk < 2; ++kk)
#pragma unroll
    for (int d = 0; d < 4; ++d) {
      const bf16x8 vf = cat4(tr_read(Vs + (kk * 32 + 4 * g + tq) * KLD + d * 16 + 4 * tp), tr_read(Vs + (kk * 32 + 16 + 4 * g + tq) * KLD + d * 16 + 4 * tp));
      o[d][0] = mfma16(vf, pf[0][kk], o[d][0]);
      o[d][1] = mfma16(vf, pf[1][kk], o[d][1]);
    }
}
DI void pack_p(const f32x4 (&s)[4][2], bf16x8 (&pf)[2][2]) {
#pragma unroll
  for (int qt = 0; qt < 2; ++qt)
#pragma unroll
    for (int kk = 0; kk < 2; ++kk) {
      u32x4 w;
      w.x = pack2(s[2 * kk][qt][0], s[2 * kk][qt][1]); w.y = pack2(s[2 * kk][qt][2], s[2 * kk][qt][3]);
      w.z = pack2(s[2 * kk + 1][qt][0], s[2 * kk + 1][qt][1]); w.w = pack2(s[2 * kk + 1][qt][2], s[2 * kk + 1][qt][3]);
      pf[qt][kk] = __builtin_bit_cast(bf16x8, w);
    }
}
constexpr float DEFER_THR = 5.f;
template <class VF>
DI void softmax_pv(f32x4 (&s)[4][2], AttnAcc& a, const u16* Vs, float sc, int l15, int g, VF valid) {
  bf16x8 pf[2][2];
  float mxl[2];
#pragma unroll
  for (int qt = 0; qt < 2; ++qt) {
    float mx = -1e30f;
#pragma unroll
    for (int kt = 0; kt < 4; ++kt)
#pragma unroll
      for (int r = 0; r < 4; ++r) { const float v = valid(kt, r, qt) ? s[kt][qt][r] * sc : -1e30f; s[kt][qt][r] = v; mx = fmaxf(mx, v); }
    mxl[qt] = mx;
  }
  if (__any((mxl[0] > a.m[0] + DEFER_THR) || (mxl[1] > a.m[1] + DEFER_THR))) {
#pragma unroll
    for (int qt = 0; qt < 2; ++qt) {
      float mx = mxl[qt];
      mx = fmaxf(mx, __shfl_xor(mx, 16)); mx = fmaxf(mx, __shfl_xor(mx, 32));
      const float mn = fmaxf(a.m[qt], mx), alpha = exp2_(a.m[qt] - mn);
      a.m[qt] = mn; a.l[qt] *= alpha;
#pragma unroll
      for (int d = 0; d < 4; ++d) a.o[d][qt] *= alpha;
    }
  }
#pragma unroll
  for (int qt = 0; qt < 2; ++qt) {
    const float mn = a.m[qt];
    float ls = 0.f;
#pragma unroll
    for (int kt = 0; kt < 4; ++kt)
#pragma unroll
      for (int r = 0; r < 4; ++r) { const float v = s[kt][qt][r]; const float pv = v > -1e29f ? exp2_(v - mn) : 0.f; s[kt][qt][r] = pv; ls += pv; }
    a.l[qt] += ls;
  }
  pack_p(s, pf);
  pv_accum(pf, Vs, a.o, l15, g);
}
DI float group_sum4_(float v) { v += __shfl_xor(v, 16); v += __shfl_xor(v, 32); return v; }
DI bf16x8 scale_frag(bf16x8 f, float sc) {
  u32x4 w = __builtin_bit_cast(u32x4, f);
  w.x = pack2(bflo(w.x) * sc, bfhi(w.x) * sc); w.y = pack2(bflo(w.y) * sc, bfhi(w.y) * sc);
  w.z = pack2(bflo(w.z) * sc, bfhi(w.z) * sc); w.w = pack2(bflo(w.w) * sc, bfhi(w.w) * sc);
  return __builtin_bit_cast(bf16x8, w);
}
DI void attn_init_rel(AttnAcc& a) { attn_init(a); a.m[0] = a.m[1] = 0.f; a.os[0] = (f32x4){0.f, 0.f, 0.f, 0.f}; a.os[1] = (f32x4){0.f, 0.f, 0.f, 0.f}; a.fresh = 1; }
DI void rowsum_accum(const bf16x8 (&pf)[2][2], AttnAcc& a, int l15) {
  const short one = l15 == 0 ? (short)0x3F80 : (short)0;
  const bf16x8 ones = {one, one, one, one, one, one, one, one};
#pragma unroll
  for (int kk = 0; kk < 2; ++kk) { a.os[0] = mfma16(ones, pf[0][kk], a.os[0]); a.os[1] = mfma16(ones, pf[1][kk], a.os[1]); }
}
DI float rel_rowsum(const AttnAcc& a, int qt, int l15) { return __shfl(a.os[qt][0], l15); }
template <int NKS>
DI void qk_tile_rel(const u16* Ks, int dofs, const bf16x8 (&qf)[2][NKS], const AttnAcc& a, f32x4 (&s)[4][2], int l15, int g, bool ok0 = true, bool ok1 = true) {
  const float n0 = ok0 ? -a.m[0] : -1e30f, n1 = ok1 ? -a.m[1] : -1e30f;
#pragma unroll
  for (int kt = 0; kt < 4; ++kt) {
    s[kt][0] = (f32x4){n0, n0, n0, n0}; s[kt][1] = (f32x4){n1, n1, n1, n1};
#pragma unroll
    for (int ks = 0; ks < NKS; ++ks) {
      const bf16x8 k = ldfrag(Ks + (kt * 16 + l15) * KLD + dofs + ks * 32 + 8 * g);
      s[kt][0] = mfma16(k, qf[0][ks], s[kt][0]);
      s[kt][1] = mfma16(k, qf[1][ks], s[kt][1]);
    }
  }
}
template <int MODE, class VF>
DI void softmax_rel(f32x4 (&s)[4][2], AttnAcc& a, bf16x8 (&pf)[2][2], int l15_, VF valid, bool ok0 = true, bool ok1 = true) {
  float mxl[2];
#pragma unroll
  for (int qt = 0; qt < 2; ++qt) {
    float mx = -1e30f;
    const bool okq = qt == 0 ? ok0 : ok1;
#pragma unroll
    for (int kt = 0; kt < 4; ++kt)
#pragma unroll
      for (int r = 0; r < 4; ++r) {
        if (MODE == 1) s[kt][qt][r] = valid(kt, r, qt) ? s[kt][qt][r] : -1e30f;
        if (MODE == 2) s[kt][qt][r] = okq ? s[kt][qt][r] : -1e30f;
        mx = fmaxf(mx, s[kt][qt][r]);
      }
    mxl[qt] = mx;
  }
  if (a.fresh || __any(mxl[0] > DEFER_THR || mxl[1] > DEFER_THR)) {
    bool still = false;
#pragma unroll
    for (int qt = 0; qt < 2; ++qt) {
      float mx = mxl[qt];
      mx = fmaxf(mx, __shfl_xor(mx, 16)); mx = fmaxf(mx, __shfl_xor(mx, 32));
      const bool fresh = rel_rowsum(a, qt, l15_) == 0.f;
      const float dl = mx < -1e29f ? 0.f : (fresh ? mx : fmaxf(mx, 0.f)), alpha = exp2_(-dl);
      still = still || (fresh && mx < -1e29f);
      a.m[qt] += dl; a.os[qt] *= alpha;
#pragma unroll
      for (int d = 0; d < 4; ++d) a.o[d][qt] *= alpha;
#pragma unroll
      for (int kt = 0; kt < 4; ++kt)
#pragma unroll
        for (int r = 0; r < 4; ++r) s[kt][qt][r] -= dl;
    }
    a.fresh = __any(still) ? 1 : 0;
  }
#pragma unroll
  for (int qt = 0; qt < 2; ++qt)
#pragma unroll
    for (int kt = 0; kt < 4; ++kt)
#pragma unroll
      for (int r = 0; r < 4; ++r) s[kt][qt][r] = exp2_(s[kt][qt][r]);
  pack_p(s, pf);
}
DI float group_sum4(float v) { v += __shfl_xor(v, 16); v += __shfl_xor(v, 32); return v; }

constexpr int DSTAGE = 2 * 128 * 64;
DI int fKs(int row) { return (row >> 1) & 7; }
DI int fVs(int row) { return ((row >> 1) & 3) << 1; }
DI void kv_dma128(const u16* kbase, const u16* vbase, int ld, int key0, u16* stage, int tid) {
#pragma unroll
  for (int i = 0; i < 4; ++i) {
    const int id = tid + 256 * i, row = id >> 3, c8 = id & 7;
    __builtin_amdgcn_global_load_lds((const unsigned*)(kbase + (size_t)(key0 + row) * ld + ((c8 ^ fKs(row)) * 8)), (LDSP unsigned*)((LDSP char*)stage + id * 16), 16, 0, 0);
  }
#pragma unroll
  for (int i = 0; i < 4; ++i) {
    const int id = tid + 256 * i, row = id >> 3, c8 = id & 7;
    __builtin_amdgcn_global_load_lds((const unsigned*)(vbase + (size_t)(key0 + row) * ld + ((c8 ^ fVs(row)) * 8)), (LDSP unsigned*)((LDSP char*)(stage + 128 * 64) + id * 16), 16, 0, 0);
  }
}
template <int NKS>
DI void qk_tile_rel_sw(const u16* Kh, int dofs, const bf16x8 (&qf)[2][NKS], const AttnAcc& a, f32x4 (&s)[4][2], int l15, int g) {
  const float n0 = -a.m[0], n1 = -a.m[1];
  const int sw = (l15 >> 1) & 7;
#pragma unroll
  for (int kt = 0; kt < 4; ++kt) {
    s[kt][0] = (f32x4){n0, n0, n0, n0}; s[kt][1] = (f32x4){n1, n1, n1, n1};
#pragma unroll
    for (int ks = 0; ks < NKS; ++ks) {
      const bf16x8 k = ldfrag(Kh + (kt * 16 + l15) * 64 + ((((dofs >> 3) + ks * 4 + g) ^ sw) * 8));
      s[kt][0] = mfma16(k, qf[0][ks], s[kt][0]);
      s[kt][1] = mfma16(k, qf[1][ks], s[kt][1]);
    }
  }
}
DI void pv_accum_sw(const bf16x8 (&pf)[2][2], const u16* Vh, f32x4 (&o)[4][2], int l15, int g) {
  const int tq = l15 >> 2, tp = l15 & 3;
#pragma unroll
  for (int kk = 0; kk < 2; ++kk) {
    const int r0 = kk * 32 + 4 * g + tq, r1 = r0 + 16;
    const int f0 = fVs(r0), f1 = fVs(r1);
#pragma unroll
    for (int d = 0; d < 4; ++d) {
      const int lc = d * 2 + (tp >> 1);
      const bf16x8 vf = cat4(tr_read(Vh + r0 * 64 + ((lc ^ f0) * 8) + (tp & 1) * 4), tr_read(Vh + r1 * 64 + ((lc ^ f1) * 8) + (tp & 1) * 4));
      o[d][0] = mfma16(vf, pf[0][kk], o[d][0]);
      o[d][1] = mfma16(vf, pf[1][kk], o[d][1]);
    }
  }
}
DI void diff_attn_task(const Params& p, int layer, int b, int h, int qb, unsigned char* smem) {
  u16* Ks = (u16*)smem; u16* Vs = Ks + 64 * KLD;
  const int tid = otid(), lane = tid & 63, wid = tid >> 6, l15 = lane & 15, g = lane >> 4;
  const u16* proj = (const u16*)(p.ws + OFF_PROJ) + (size_t)b * SEQ * NP;
  const int q0w = qb * 128 + wid * 32;
  const float* lam = p.diff_lam + layer * 128;
  float s01 = 0.f, s23 = 0.f;
  for (int i = 0; i < 32; ++i) { s01 += lam[i] * lam[32 + i]; s23 += lam[64 + i] * lam[96 + i]; }
  const float lam_init = layer == 0 ? 0.2f : 0.35550906759096324f;
  const float lam_full = sgprf(__expf(s01) - __expf(s23) + lam_init);
  const float sc = 0.17677669529663687f * 1.4426950408889634f;
  const int ntile = 2 * qb + 2;
  const u16* vbase = proj + PB_V + h * 64;
  f32x4 res[4][2];
#pragma unroll 1
  for (int c = 0; c < 2; ++c) {
    const u16* kbase = proj + PB_K + h * 64;
    bf16x8 qf[2][1];
#pragma unroll
    for (int qt = 0; qt < 2; ++qt) qf[qt][0] = scale_frag(ldfrag(proj + (size_t)(q0w + qt * 16 + l15) * NP + PB_Q + h * 64 + c * 32 + 8 * g), sc);
    AttnAcc a; attn_init_rel(a);
    const int nst = qb + 1;
    asm volatile("s_waitcnt vmcnt(0)" ::: "memory");
    lds_barrier();
    kv_dma128(kbase, vbase, NP, 0, Ks, tid);
    asm volatile("s_waitcnt vmcnt(0)" ::: "memory");
    lds_barrier();
    for (int js = 0; js < nst; ++js) {
      const u16* st = Ks + (js & 1) * DSTAGE;
      if (js + 1 < nst) kv_dma128(kbase, vbase, NP, (js + 1) * 128, Ks + ((js + 1) & 1) * DSTAGE, tid);
#pragma unroll 1
      for (int hf = 0; hf < 2; ++hf) {
        const int key0 = js * 128 + hf * 64;
        if (key0 <= q0w + 31) {
          f32x4 s[4][2]; bf16x8 pf[2][2];
          auto valid = [&](int kt, int r, int qt) { return key0 + kt * 16 + 4 * g + r <= q0w + qt * 16 + l15; };
          qk_tile_rel_sw<1>(st + hf * 64 * 64, c * 32, qf, a, s, l15, g);
          if (key0 + 63 <= q0w) softmax_rel<0>(s, a, pf, l15, valid); else softmax_rel<1>(s, a, pf, l15, valid);
          pv_accum_sw(pf, st + 128 * 64 + hf * 64 * 64, a.o, l15, g);
          rowsum_accum(pf, a, l15);
        }
      }
      asm volatile("s_waitcnt vmcnt(0)" ::: "memory");
      lds_barrier();
    }
#pragma unroll
    for (int qt = 0; qt < 2; ++qt) {
      const float lt = rel_rowsum(a, qt, l15);
      const float inv = c == 0 ? 1.f / lt : -lam_full / lt;
#pragma unroll
      for (int d = 0; d < 4; ++d) res[d][qt] = c == 0 ? a.o[d][qt] * inv : res[d][qt] + a.o[d][qt] * inv;
    }
  }
  u16* Y = (u16*)(p.ws + OFF_H);
  const float* ng = p.diff_norm_g + layer * 64;
#pragma unroll
  for (int qt = 0; qt < 2; ++qt) {
    float ss = 0.f;
#pragma unroll
    for (int d = 0; d < 4; ++d) { const f32x4 v = res[d][qt]; ss += v[0] * v[0] + v[1] * v[1] + v[2] * v[2] + v[3] * v[3]; }
    ss = group_sum4(ss);
    const float rn = rsqrtf(ss * (1.f / 64.f) + 1e-6f) * (1.f - lam_init);
    const int t = q0w + qt * 16 + l15;
    const size_t row = (size_t)b * SEQ + t;
#pragma unroll
    for (int d = 0; d < 4; ++d) {
      const int dd = d * 16 + 4 * g;
      const f32x4 v = res[d][qt];
      const u32x2 zz = *(const u32x2*)(proj + (size_t)t * NP + PB_Z + h * 64 + dd);
      const f32x4 gg = *(const f32x4*)(ng + dd);
      u32x2 w;
      w.x = pack2(v[0] * rn * gg[0] * siluf(bflo(zz.x)), v[1] * rn * gg[1] * siluf(bfhi(zz.x)));
      w.y = pack2(v[2] * rn * gg[2] * siluf(bflo(zz.y)), v[3] * rn * gg[3] * siluf(bfhi(zz.y)));
      *(u32x2*)(Y + row * 1024 + Y_B + h * 64 + dd) = w;
    }
  }
}

template <int NKS>
DI void qk_tile1(const u16* Ks, const bf16x8 (&qf)[NKS], f32x4 (&s)[4], int l15, int g) {
#pragma unroll
  for (int kt = 0; kt < 4; ++kt) {
    s[kt] = (f32x4){0.f, 0.f, 0.f, 0.f};
#pragma unroll
    for (int ks = 0; ks < NKS; ++ks) s[kt] = mfma16(ldfrag(Ks + (kt * 16 + l15) * KLD + ks * 32 + 8 * g), qf[ks], s[kt]);
  }
}
DI void pv_accum1(const f32x4 (&s)[4], const u16* Vs, f32x4 (&o)[4], int l15, int g) {
  const int tq = l15 >> 2, tp = l15 & 3;
#pragma unroll
  for (int kk = 0; kk < 2; ++kk) {
    u32x4 w;
    w.x = pack2(s[2 * kk][0], s[2 * kk][1]); w.y = pack2(s[2 * kk][2], s[2 * kk][3]);
    w.z = pack2(s[2 * kk + 1][0], s[2 * kk + 1][1]); w.w = pack2(s[2 * kk + 1][2], s[2 * kk + 1][3]);
    const bf16x8 pf = __builtin_bit_cast(bf16x8, w);
#pragma unroll
    for (int d = 0; d < 4; ++d) {
      const bf16x8 vf = cat4(tr_read(Vs + (kk * 32 + 4 * g + tq) * KLD + d * 16 + 4 * tp), tr_read(Vs + (kk * 32 + 16 + 4 * g + tq) * KLD + d * 16 + 4 * tp));
      o[d] = mfma16(vf, pf, o[d]);
    }
  }
}

constexpr int SEQ_LDS_A = 0, SEQ_LDS_B = 128 * KLD * 2, SEQ_LDS_C = 2 * 128 * KLD * 2, SEQ_LDS_S = 3 * 128 * KLD * 2, SEQ_LDS_F = SEQ_LDS_S + 64 * KLD * 2;
constexpr int SEQ_LDS_HALO = SEQ_LDS_F + 4096;
constexpr int SEQ_LDS_CW = SEQ_LDS_HALO + 2 * 3 * 3 * 64 * 2;
DI float wave_scan_add(float x, int lane) {
#pragma unroll
  for (int o = 1; o < 64; o <<= 1) { const float y = __shfl_up(x, o); if (lane >= o) x += y; }
  return x;
}
DI float wave_scan_max(float x, int lane) {
#pragma unroll
  for (int o = 1; o < 64; o <<= 1) { const float y = __shfl_up(x, o); if (lane >= o) x = fmaxf(x, y); }
  return x;
}

DI void seq_fix_rows(const Params& p, int layer, int r0, int nrows) {
  u16* Y = (u16*)(p.ws + OFF_H);
  const u16* proj = (const u16*)(p.ws + OFF_PROJ);
  const int tid = otid(), lane = tid & 63, wv = tid >> 6;
  const bool ml = lane >= 32;
  const int ch = (lane & 31) * 8;
  const float* ng = ml ? p.ml_norm_g + layer * 64 + (ch & 63) : p.ssm_norm_g + layer * 256 + ch;
  const f32x4 g0 = *(const f32x4*)ng, g1 = *(const f32x4*)(ng + 4);
  for (int rb = wv * 4; rb < nrows; rb += 16) {
    u32x4 yv4[4], zv4[4], ov4[4];
#pragma unroll
    for (int j = 0; j < 4; ++j) {
      const size_t row = (size_t)(r0 + rb + j);
      yv4[j] = *(const u32x4*)(Y + row * 1024 + (ml ? Y_D : Y_C) + ch);
      zv4[j] = *(const u32x4*)(proj + row * NP + (ml ? PD_Z : PC_Z) + ch);
      ov4[j] = *(const u32x4*)(proj + row * NP + PD_O + ch);
    }
    asm volatile("" : "+v"(yv4[0]), "+v"(yv4[1]), "+v"(yv4[2]), "+v"(yv4[3]), "+v"(zv4[0]), "+v"(zv4[1]), "+v"(zv4[2]), "+v"(zv4[3]), "+v"(ov4[0]), "+v"(ov4[1]), "+v"(ov4[2]), "+v"(ov4[3]));
#pragma unroll
    for (int j = 0; j < 4; ++j) {
      const size_t row = (size_t)(r0 + rb + j);
      u16* yp = Y + row * 1024 + (ml ? Y_D : Y_C) + ch;
      const u32x4 yv = yv4[j], zv = zv4[j], ov = ov4[j];
      float v[8] = {bflo(yv.x), bfhi(yv.x), bflo(yv.y), bfhi(yv.y), bflo(yv.z), bfhi(yv.z), bflo(yv.w), bfhi(yv.w)};
      float z[8] = {bflo(zv.x), bfhi(zv.x), bflo(zv.y), bfhi(zv.y), bflo(zv.z), bfhi(zv.z), bflo(zv.w), bfhi(zv.w)};
      float ss = 0.f;
      if (ml) {
        const float o[8] = {bflo(ov.x), bfhi(ov.x), bflo(ov.y), bfhi(ov.y), bflo(ov.z), bfhi(ov.z), bflo(ov.w), bfhi(ov.w)};
#pragma unroll
        for (int i = 0; i < 8; ++i) { v[i] *= sigmoidf_(o[i]); ss += v[i] * v[i]; }
      } else {
#pragma unroll
        for (int i = 0; i < 8; ++i) { v[i] *= siluf(z[i]); ss += v[i] * v[i]; }
      }
      ss += __shfl_xor(ss, 1); ss += __shfl_xor(ss, 2); ss += __shfl_xor(ss, 4);
      const float ss16 = ss + __shfl_xor(ss, 8);
      const float rn = ml ? rsqrtf(ss * (1.f / 64.f) + 1e-6f) : rsqrtf(ss16 * (1.f / 128.f) + 1e-6f);
      float o8[8];
#pragma unroll
      for (int i = 0; i < 8; ++i) { const float gg = i < 4 ? g0[i & 3] : g1[i & 3]; o8[i] = v[i] * rn * gg * (ml ? siluf(z[i]) : 1.f); }
      u32x4 w; w.x = pack2(o8[0], o8[1]); w.y = pack2(o8[2], o8[3]); w.z = pack2(o8[4], o8[5]); w.w = pack2(o8[6], o8[7]);
      *(u32x4*)yp = w;
    }
  }
}


constexpr int SEQ8_LDS_F = SEQ_LDS_S + 64 * KLD * 2;
constexpr int SEQ8_LDS_HALO = SEQ8_LDS_F + 8192;
constexpr int SEQ8_LDS_CW = SEQ8_LDS_HALO + 2 * 3 * 3 * 64 * 2;
DI void stage_conv_w8(float* wl, const float* cw, const float* cb, int chan0, int nchan, int tid) {
  if (tid < 320) { const int j = tid >> 6, cc = tid & 63; wl[tid] = j < 4 ? cw[j * nchan + chan0 + cc] : cb[chan0 + cc]; }
}
DI void scale_rows8(u16* A, const float* rs, int tid) {
  const int ch = (tid & 7) * 8;
#pragma unroll
  for (int i = 0; i < 2; ++i) {
    const int row = (tid >> 3) + 64 * i;
    const float f = rs[row];
    u32x4 v = *(u32x4*)(A + row * KLD + ch);
    v.x = pack2(bflo(v.x) * f, bfhi(v.x) * f); v.y = pack2(bflo(v.y) * f, bfhi(v.y) * f);
    v.z = pack2(bflo(v.z) * f, bfhi(v.z) * f); v.w = pack2(bflo(v.w) * f, bfhi(v.w) * f);
    *(u32x4*)(A + row * KLD + ch) = v;
  }
}
DI void state_update8(const u16* Xs, const u16* Bs, f32x4 (&acc)[2], int w8, int l15, int g) {
  const int tq = l15 >> 2, tp = l15 & 3, pt = w8 >> 1, nt0 = (w8 & 1) * 2;
#pragma unroll
  for (int kk = 0; kk < 4; ++kk) {
    const bf16x8 af = cat4(tr_read(Xs + (kk * 32 + 4 * g + tq) * KLD + pt * 16 + 4 * tp), tr_read(Xs + (kk * 32 + 16 + 4 * g + tq) * KLD + pt * 16 + 4 * tp));
#pragma unroll
    for (int n = 0; n < 2; ++n) {
      const bf16x8 bfr = cat4(tr_read(Bs + (kk * 32 + 4 * g + tq) * KLD + (nt0 + n) * 16 + 4 * tp), tr_read(Bs + (kk * 32 + 16 + 4 * g + tq) * KLD + (nt0 + n) * 16 + 4 * tp));
      acc[n] = mfma16(af, bfr, acc[n]);
    }
  }
}
DI void state_to_lds8(u16* Ss, const f32x4 (&acc)[2], int w8, int l15, int g) {
  const int pt = w8 >> 1, nt0 = (w8 & 1) * 2;
#pragma unroll
  for (int n = 0; n < 2; ++n)
#pragma unroll
    for (int r = 0; r < 4; ++r) Ss[(pt * 16 + 4 * g + r) * KLD + (nt0 + n) * 16 + l15] = f2bf(acc[n][r]);
}

constexpr int SEQ8_LDS_ZERO = SEQ8_LDS_CW + 3 * 320 * 4;
constexpr int SEQ8_LDS_RAW = ((SEQ8_LDS_ZERO + 3 * 128 + 255) / 256) * 256;
DI void raw_dma8(const u16* projb, int col0, int t0, u16* raw, int tid) {
#pragma unroll
  for (int i = 0; i < 2; ++i) {
    const int chunk = tid + 512 * i;
    __builtin_amdgcn_global_load_lds((const unsigned*)(projb + (size_t)(t0 + (chunk >> 3)) * NP + col0 + (chunk & 7) * 8), (LDSP unsigned*)((LDSP char*)raw + chunk * 16), 16, 0, 0);
  }
}
DI void conv_raw8(const u16* raw, const u16* halo, const float* wl, const float* rowscale, float cscale, u16* dst, int tid) {
  const int q = tid >> 3, ch = (tid & 7) * 8;
  u32x4 v[5];
#pragma unroll
  for (int k = 0; k < 5; ++k) { const int r = 2 * q - 3 + k; v[k] = r >= 0 ? *(const u32x4*)(raw + r * 64 + ch) : *(const u32x4*)(halo + (r + 3) * 64 + ch); }
  float w[5][8];
#pragma unroll
  for (int j = 0; j < 5; ++j) { const f32x4 w0 = *(const f32x4*)(wl + j * 64 + ch), w1 = *(const f32x4*)(wl + j * 64 + ch + 4);
    w[j][0] = w0[0]; w[j][1] = w0[1]; w[j][2] = w0[2]; w[j][3] = w0[3]; w[j][4] = w1[0]; w[j][5] = w1[1]; w[j][6] = w1[2]; w[j][7] = w1[3]; }
#pragma unroll
  for (int o = 0; o < 2; ++o) {
    float acc[8];
#pragma unroll
    for (int i = 0; i < 8; ++i) acc[i] = w[4][i];
#pragma unroll
    for (int j = 0; j < 4; ++j) {
      const u32x4 x = v[o + j];
      acc[0] += w[j][0] * bflo(x.x); acc[1] += w[j][1] * bfhi(x.x); acc[2] += w[j][2] * bflo(x.y); acc[3] += w[j][3] * bfhi(x.y);
      acc[4] += w[j][4] * bflo(x.z); acc[5] += w[j][5] * bfhi(x.z); acc[6] += w[j][6] * bflo(x.w); acc[7] += w[j][7] * bfhi(x.w);
    }
    const float rs = (rowscale ? rowscale[2 * q + o] : 1.f) * cscale;
#pragma unroll
    for (int i = 0; i < 8; ++i) acc[i] = siluf(acc[i]) * rs;
    u32x4 ov; ov.x = pack2(acc[0], acc[1]); ov.y = pack2(acc[2], acc[3]); ov.z = pack2(acc[4], acc[5]); ov.w = pack2(acc[6], acc[7]);
    *(u32x4*)(dst + (2 * q + o) * KLD + ch) = ov;
  }
}
DI void save_halo8(const u16* raw, u16* halo, int tid) {
  if (tid < 72) { const int arr = tid / 24, rem = tid % 24; *(u32x4*)(halo + arr * 192 + rem * 8) = *(const u32x4*)(raw + arr * 8192 + 125 * 64 + rem * 8); }
}

DI void ssd_task8(const Params& p, int layer, int b, int h, unsigned char* smem) {
  u16* Cs = (u16*)(smem + SEQ_LDS_A); u16* Bs = (u16*)(smem + SEQ_LDS_B); u16* Xs = (u16*)(smem + SEQ_LDS_C); u16* Ss = (u16*)(smem + SEQ_LDS_S);
  float* fl = (float*)(smem + SEQ8_LDS_F);
  float* dts = fl; float* acs = fl + 128; float* wend = fl + 256; float* tmp = fl + 384;
  u16* halo = (u16*)(smem + SEQ8_LDS_HALO); float* cwl = (float*)(smem + SEQ8_LDS_CW); u16* zero3 = (u16*)(smem + SEQ8_LDS_ZERO);
  u16* raw = (u16*)(smem + SEQ8_LDS_RAW);
  int tid = otid512(), lane = tid & 63, w = tid >> 6, l15 = lane & 15, g = lane >> 4;
  const int gi = h >> 1;
  const u16* projb = (const u16*)(p.ws + OFF_PROJ) + (size_t)b * SEQ * NP;
  const float* smb = (const float*)(p.ws + OFF_SMALL) + (size_t)b * SEQ * NSMALL;
  const float* cw = p.ssm_conv_w + layer * 4 * 512; const float* cb = p.ssm_conv_b + layer * 512;
  u16* Y = (u16*)(p.ws + OFF_H);
  const float a_h = sgprf(-__expf(p.ssm_a_log[layer * 4 + h])), d_h = sgprf(p.ssm_d[layer * 4 + h]), dtb = sgprf(p.ssm_dt_bias[layer * 4 + h]);
  const int colB = PC_XBC + 256 + gi * 64, colC = PC_XBC + 384 + gi * 64, colX = PC_XBC + h * 64;
  f32x4 st[2] = {(f32x4){0.f, 0.f, 0.f, 0.f}, (f32x4){0.f, 0.f, 0.f, 0.f}};
  lds_barrier();
  stage_conv_w8(cwl, cw, cb, 256 + gi * 64, 512, tid);
  stage_conv_w8(cwl + 320, cw, cb, 384 + gi * 64, 512, tid);
  stage_conv_w8(cwl + 640, cw, cb, h * 64, 512, tid);
  if (tid < 96) ((unsigned*)zero3)[tid] = 0u;
  raw_dma8(projb, colB, 0, raw, tid); raw_dma8(projb, colC, 0, raw + 8192, tid); raw_dma8(projb, colX, 0, raw + 16384, tid);
  float dtraw = 0.f;
  if (tid < 128) dtraw = smb[(size_t)tid * NSMALL + SM_DT + h];
#pragma unroll 1
  for (int c = 0; c < 32; ++c) {
    const int t0 = c * 128;
    asm volatile("" : "+v"(tid)); lane = tid & 63; w = tid >> 6; l15 = lane & 15; g = lane >> 4;
    float dtv = 0.f;
    if (tid < 128) { const float xr = dtraw + dtb; dtv = xr > 15.f ? xr : (xr < -15.f ? __expf(xr) : __logf(1.f + __expf(xr))); }
    float cs = wave_scan_add(dtv * a_h, lane);
    if (tid == 63) tmp[0] = cs;
    asm volatile("s_waitcnt vmcnt(0)" ::: "memory");
    lds_barrier();
    if (w == 1) cs += tmp[0];
    if (tid < 128) { dts[tid] = dtv; acs[tid] = cs; }
    if (c + 1 < 32 && tid < 128) dtraw = smb[(size_t)(t0 + 128 + tid) * NSMALL + SM_DT + h];
    lds_barrier();
    {
      const u16* hc = halo + (c & 1) * 576;
      const u16* hB = c == 0 ? zero3 : hc; const u16* hC = c == 0 ? zero3 : hc + 192; const u16* hX = c == 0 ? zero3 : hc + 384;
      conv_raw8(raw, hB, cwl, nullptr, 1.f, Bs, tid);
      conv_raw8(raw + 8192, hC, cwl + 320, nullptr, 1.f, Cs, tid);
      conv_raw8(raw + 16384, hX, cwl + 640, dts, 1.f, Xs, tid);
      save_halo8(raw, halo + ((c + 1) & 1) * 576, tid);
    }
    if (tid < 128) wend[tid] = __expf(acs[127] - acs[tid]);
    state_to_lds8(Ss, st, w, l15, g);
    lds_barrier();
    if (c + 1 < 32) { raw_dma8(projb, colB, t0 + 128, raw, tid); raw_dma8(projb, colC, t0 + 128, raw + 8192, tid); raw_dma8(projb, colX, t0 + 128, raw + 16384, tid); }
    {
      const int tl = 16 * w + l15;
      bf16x8 cf[2];
#pragma unroll
      for (int ks = 0; ks < 2; ++ks) cf[ks] = ldfrag(Cs + tl * KLD + ks * 32 + 8 * g);
      f32x4 y[4];
#pragma unroll
      for (int d = 0; d < 4; ++d) y[d] = (f32x4){0.f, 0.f, 0.f, 0.f};
      const float at = acs[tl];
#pragma unroll 1
      for (int stl = 0; stl < 2; ++stl) {
        if (stl * 64 <= 16 * w + 15) {
          f32x4 sc[4];
          qk_tile1<2>(Bs + stl * 64 * KLD, cf, sc, l15, g);
#pragma unroll
          for (int kt = 0; kt < 4; ++kt) {
            const f32x4 as = *(const f32x4*)(acs + stl * 64 + kt * 16 + 4 * g);
#pragma unroll
            for (int r = 0; r < 4; ++r) {
              const bool ok = stl * 64 + kt * 16 + 4 * g + r <= tl;
              sc[kt][r] = ok ? sc[kt][r] * __expf(at - as[r]) : 0.f;
            }
          }
          pv_accum1(sc, Xs + stl * 64 * KLD, y, l15, g);
        }
      }
      const float ea = __expf(at), dsk = d_h / dts[tl];
      const size_t row = (size_t)b * SEQ + t0 + tl;
#pragma unroll
      for (int d = 0; d < 4; ++d) {
        f32x4 yo = (f32x4){0.f, 0.f, 0.f, 0.f};
#pragma unroll
        for (int ks = 0; ks < 2; ++ks) yo = mfma16(ldfrag(Ss + (d * 16 + l15) * KLD + ks * 32 + 8 * g), cf[ks], yo);
        const u32x2 xv = *(const u32x2*)(Xs + tl * KLD + d * 16 + 4 * g);
        const f32x4 v = y[d] + yo * ea;
        u32x2 o; o.x = pack2(v[0] + dsk * bflo(xv.x), v[1] + dsk * bfhi(xv.x)); o.y = pack2(v[2] + dsk * bflo(xv.y), v[3] + dsk * bfhi(xv.y));
        *(u32x2*)(Y + row * 1024 + Y_C + h * 64 + d * 16 + 4 * g) = o;
      }
    }
    lds_barrier();
    scale_rows8(Xs, wend, tid);
    lds_barrier();
    const float cd = __expf(acs[127]);
    st[0] *= cd; st[1] *= cd;
    state_update8(Xs, Bs, st, w, l15, g);
  }
  asm volatile("s_waitcnt vmcnt(0)" ::: "memory");
}

DI void mlstm_task8(const Params& p, int layer, int b, int h, unsigned char* smem) {
  u16* Qs = (u16*)(smem + SEQ_LDS_A); u16* Ks2 = (u16*)(smem + SEQ_LDS_B); u16* Vs2 = (u16*)(smem + SEQ_LDS_C); u16* Cst = (u16*)(smem + SEQ_LDS_S);
  float* fl = (float*)(smem + SEQ8_LDS_F);
  float* bcs = fl; float* us = fl + 128; float* pms = fl + 256; float* wend = fl + 384; float* nst = fl + 512; float* tmp = fl + 576; float* npart = fl + 640;
  u16* halo = (u16*)(smem + SEQ8_LDS_HALO); float* cwl = (float*)(smem + SEQ8_LDS_CW); u16* zero3 = (u16*)(smem + SEQ8_LDS_ZERO);
  u16* raw = (u16*)(smem + SEQ8_LDS_RAW);
  int tid = otid512(), lane = tid & 63, w = tid >> 6, l15 = lane & 15, g = lane >> 4;
  const u16* projb = (const u16*)(p.ws + OFF_PROJ) + (size_t)b * SEQ * NP;
  const float* smb = (const float*)(p.ws + OFF_SMALL) + (size_t)b * SEQ * NSMALL;
  const float* cw = p.ml_conv_w + layer * 4 * 512; const float* cb = p.ml_conv_b + layer * 512;
  const float ib = sgprf(p.ml_if_b[layer * 8 + h]), fb = sgprf(p.ml_if_b[layer * 8 + 4 + h]);
  u16* Y = (u16*)(p.ws + OFF_H);
  const int colQ = PD_QK + h * 64, colK = PD_QK + 256 + h * 64, colV = PD_V + h * 64;
  f32x4 st[2] = {(f32x4){0.f, 0.f, 0.f, 0.f}, (f32x4){0.f, 0.f, 0.f, 0.f}};
  float m_prev = 0.f;
  lds_barrier();
  if (tid < 64) nst[tid] = 0.f;
  stage_conv_w8(cwl, cw, cb, h * 64, 512, tid);
  stage_conv_w8(cwl + 320, cw, cb, 256 + h * 64, 512, tid);
  if (tid < 96) ((unsigned*)zero3)[tid] = 0u;
  raw_dma8(projb, colQ, 0, raw, tid); raw_dma8(projb, colK, 0, raw + 8192, tid); raw_dma8(projb, colV, 0, raw + 16384, tid);
  float iraw = 0.f, fraw = 0.f;
  if (tid < 128) { iraw = smb[(size_t)tid * NSMALL + SM_IF + h]; fraw = smb[(size_t)tid * NSMALL + SM_IF + 4 + h]; }
#pragma unroll 1
  for (int c = 0; c < 32; ++c) {
    const int t0 = c * 128;
    asm volatile("" : "+v"(tid)); lane = tid & 63; w = tid >> 6; l15 = lane & 15; g = lane >> 4;
    float ip = 0.f, lf = 0.f;
    if (tid < 128) { ip = iraw + ib; const float fp = fraw + fb; lf = fminf(fp, 0.f) - __logf(1.f + __expf(-fabsf(fp))); }
    float bc = wave_scan_add(lf, lane);
    if (tid == 63) tmp[0] = bc;
    asm volatile("s_waitcnt vmcnt(0)" ::: "memory");
    lds_barrier();
    if (w == 1) bc += tmp[0];
    const float u = tid < 128 ? ip - bc : -1e30f;
    float pm = wave_scan_max(u, lane);
    if (tid == 63) tmp[1] = pm;
    if (c + 1 < 32 && tid < 128) { iraw = smb[(size_t)(t0 + 128 + tid) * NSMALL + SM_IF + h]; fraw = smb[(size_t)(t0 + 128 + tid) * NSMALL + SM_IF + 4 + h]; }
    {
      const u16* hc = halo + (c & 1) * 576;
      const u16* hQ = c == 0 ? zero3 : hc; const u16* hK = c == 0 ? zero3 : hc + 192;
      conv_raw8(raw, hQ, cwl, nullptr, 1.f, Qs, tid);
      conv_raw8(raw + 8192, hK, cwl + 320, nullptr, 0.125f, Ks2, tid);
      save_halo8(raw, halo + ((c + 1) & 1) * 576, tid);
#pragma unroll
      for (int i = 0; i < 2; ++i) { const int chunk = tid + 512 * i; *(u32x4*)(Vs2 + (chunk >> 3) * KLD + (chunk & 7) * 8) = *(const u32x4*)(raw + 16384 + chunk * 8); }
    }
    state_to_lds8(Cst, st, w, l15, g);
    lds_barrier();
    if (w == 1) pm = fmaxf(pm, tmp[1]);
    if (tid < 128) { bcs[tid] = bc; us[tid] = u; pms[tid] = pm; }
    if (c + 1 < 32) { raw_dma8(projb, colQ, t0 + 128, raw, tid); raw_dma8(projb, colK, t0 + 128, raw + 8192, tid); raw_dma8(projb, colV, t0 + 128, raw + 16384, tid); }
    lds_barrier();
    const float blast = bcs[127];
    const float m_new = blast + fmaxf(m_prev, pms[127]);
    if (tid < 128) wend[tid] = __expf(blast - m_new + us[tid]);
    {
      const int tl = 16 * w + l15;
      bf16x8 qf[2];
#pragma unroll
      for (int ks = 0; ks < 2; ++ks) qf[ks] = ldfrag(Qs + tl * KLD + ks * 32 + 8 * g);
      f32x4 num[4];
#pragma unroll
      for (int d = 0; d < 4; ++d) num[d] = (f32x4){0.f, 0.f, 0.f, 0.f};
      const float bt = bcs[tl], mt = bt + fmaxf(m_prev, pms[tl]);
      float den = 0.f;
#pragma unroll 1
      for (int stl = 0; stl < 2; ++stl) {
        if (stl * 64 <= 16 * w + 15) {
          f32x4 sc[4];
          qk_tile1<2>(Ks2 + stl * 64 * KLD, qf, sc, l15, g);
#pragma unroll
          for (int kt = 0; kt < 4; ++kt) {
            const f32x4 uu = *(const f32x4*)(us + stl * 64 + kt * 16 + 4 * g);
#pragma unroll
            for (int r = 0; r < 4; ++r) {
              const bool ok = stl * 64 + kt * 16 + 4 * g + r <= tl;
              const float v = ok ? sc[kt][r] * __expf(bt - mt + uu[r]) : 0.f;
              sc[kt][r] = v; den += v;
            }
          }
          pv_accum1(sc, Vs2 + stl * 64 * KLD, num, l15, g);
        }
      }
      const float wi = __expf(bt + m_prev - mt);
      float qn = 0.f;
#pragma unroll
      for (int ks = 0; ks < 2; ++ks)
#pragma unroll
        for (int j = 0; j < 8; ++j) qn += bf2f((u16)qf[ks][j]) * nst[ks * 32 + 8 * g + j];
      qn = group_sum4(qn);
      const float dn = group_sum4(den) + wi * qn;
      const float inv = __builtin_amdgcn_rcpf(fmaxf(fabsf(dn), __expf(-mt)));
      const size_t row = (size_t)b * SEQ + t0 + tl;
#pragma unroll
      for (int d = 0; d < 4; ++d) {
        f32x4 ni = (f32x4){0.f, 0.f, 0.f, 0.f};
#pragma unroll
        for (int ks = 0; ks < 2; ++ks) ni = mfma16(ldfrag(Cst + (d * 16 + l15) * KLD + ks * 32 + 8 * g), qf[ks], ni);
        const f32x4 v = (num[d] + ni * wi) * inv;
        u32x2 o; o.x = pack2(v[0], v[1]); o.y = pack2(v[2], v[3]);
        *(u32x2*)(Y + row * 1024 + Y_D + h * 64 + d * 16 + 4 * g) = o;
      }
    }
    lds_barrier();
    scale_rows8(Ks2, wend, tid);
    lds_barrier();
    const float fprev = __expf(blast + m_prev - m_new);
    st[0] *= fprev; st[1] *= fprev;
    state_update8(Vs2, Ks2, st, w, l15, g);
    {
      const int e = tid & 63, part = tid >> 6;
      float a = 0.f;
#pragma unroll
      for (int s2 = 0; s2 < 16; ++s2) a += bf2f(Ks2[(part * 16 + s2) * KLD + e]);
      npart[part * 64 + e] = a;
    }
    lds_barrier();
    if (tid < 64) {
      float a = nst[tid] * fprev;
#pragma unroll
      for (int pp = 0; pp < 8; ++pp) a += npart[pp * 64 + tid];
      nst[tid] = a;
    }
    m_prev = m_new;
  }
  asm volatile("s_waitcnt vmcnt(0)" ::: "memory");
}

DI void compress_task(const Params& p, int layer, int b, int kv, int rb, unsigned char* smem) {
  constexpr int HLD = 136;
  u16* Hs = (u16*)smem;
  const int tid = otid(), lane = tid & 63, w = tid >> 6, l15 = lane & 15, g = lane >> 4;
  const u16* projb = (const u16*)(p.ws + OFF_PROJ) + (size_t)b * SEQ * NP + (kv ? PA_VC : PA_KC);
  const int mi = layer * 2 + kv;
  const u16* W1T = (const u16*)(p.ws + OFF_W1T) + (size_t)mi * 128 * 2048;
  const u16* W2T = (const u16*)(p.ws + OFF_W2T) + (size_t)mi * 64 * 128;
  const float* bias1 = (const float*)(p.ws + OFF_BIAS1) + mi * 16 * 128;
  f32x4 acc[2][2];
#pragma unroll
  for (int nt = 0; nt < 2; ++nt) { acc[nt][0] = (f32x4){0.f, 0.f, 0.f, 0.f}; acc[nt][1] = (f32x4){0.f, 0.f, 0.f, 0.f}; }
  int tok[2];
#pragma unroll
  for (int mt = 0; mt < 2; ++mt) { int i = rb * 32 + mt * 16 + l15; if (i > 254) i = 254; tok[mt] = 16 * i; }
#pragma unroll 4
  for (int ks = 0; ks < 64; ++ks) {
    const int j = ks >> 1, d0 = (ks & 1) * 32;
    bf16x8 af[2], wf[2];
#pragma unroll
    for (int mt = 0; mt < 2; ++mt) af[mt] = ldfrag(projb + (size_t)(tok[mt] + j) * NP + d0 + 8 * g);
#pragma unroll
    for (int nt = 0; nt < 2; ++nt) wf[nt] = ldfrag(W1T + (size_t)(w * 32 + nt * 16 + l15) * 2048 + ks * 32 + 8 * g);
#pragma unroll
    for (int nt = 0; nt < 2; ++nt)
#pragma unroll
      for (int mt = 0; mt < 2; ++mt) acc[nt][mt] = mfma16(wf[nt], af[mt], acc[nt][mt]);
  }
  lds_barrier();
#pragma unroll
  for (int nt = 0; nt < 2; ++nt) {
    const int n = w * 32 + nt * 16 + 4 * g;
    f32x4 bp[16];
#pragma unroll
    for (int pc = 0; pc < 16; ++pc) bp[pc] = *(const f32x4*)(bias1 + pc * 128 + n);
#pragma unroll
    for (int pc = 0; pc < 16; pc += 4) asm volatile("" : "+v"(bp[pc]), "+v"(bp[pc + 1]), "+v"(bp[pc + 2]), "+v"(bp[pc + 3]));
    f32x4 bb = bp[0];
#pragma unroll
    for (int pc = 1; pc < 16; ++pc) bb += bp[pc];
#pragma unroll
    for (int mt = 0; mt < 2; ++mt) {
      const f32x4 v = acc[nt][mt] + bb;
      u32x2 o; o.x = pack2(siluf(v[0]), siluf(v[1])); o.y = pack2(siluf(v[2]), siluf(v[3]));
      *(u32x2*)(Hs + (mt * 16 + l15) * HLD + n) = o;
    }
  }
  lds_barrier();
  f32x4 acc2[2] = {(f32x4){0.f, 0.f, 0.f, 0.f}, (f32x4){0.f, 0.f, 0.f, 0.f}};
#pragma unroll
  for (int ks = 0; ks < 4; ++ks) {
    const bf16x8 wf = ldfrag(W2T + (size_t)(w * 16 + l15) * 128 + ks * 32 + 8 * g);
#pragma unroll
    for (int mt = 0; mt < 2; ++mt) acc2[mt] = mfma16(wf, ldfrag(Hs + (mt * 16 + l15) * HLD + ks * 32 + 8 * g), acc2[mt]);
  }
  u16* dst = (u16*)(p.ws + (kv ? OFF_VCMP : OFF_KCMP) + (size_t)layer * 512 * 1024) + (size_t)b * 256 * 64;
#pragma unroll
  for (int mt = 0; mt < 2; ++mt) {
    const int i = rb * 32 + mt * 16 + l15;
    u32x2 o; o.x = pack2(acc2[mt][0], acc2[mt][1]); o.y = pack2(acc2[mt][2], acc2[mt][3]);
    if (i > 254) { o.x = 0u; o.y = 0u; }
    *(u32x2*)(dst + (size_t)i * 64 + w * 16 + 4 * g) = o;
  }
}

DI void nsa_task(const Params& p, int layer, int b, int qi, unsigned char* smem) {
  u16* Ks = (u16*)smem; u16* Vs = Ks + 64 * KLD;
  float* T = (float*)(smem + 2 * KVBUF * 2);
  unsigned long long* selm = (unsigned long long*)(smem + 2 * KVBUF * 2 + 4 * 32 * 65 * 4);
  const int tid = otid(), lane = tid & 63, h = tid >> 6, l15 = lane & 15, g = lane >> 4;
  const int q0 = qi * 32;
  const u16* projb = (const u16*)(p.ws + OFF_PROJ) + (size_t)b * SEQ * NP;
  const float* smb = (const float*)(p.ws + OFF_SMALL) + (size_t)b * SEQ * NSMALL;
  const u16* kcmp = (const u16*)(p.ws + OFF_KCMP + (size_t)layer * 512 * 1024) + (size_t)b * 256 * 64;
  const u16* vcmp = (const u16*)(p.ws + OFF_VCMP + (size_t)layer * 512 * 1024) + (size_t)b * 256 * 64;
  bf16x8 qf[2][2];
#pragma unroll
  for (int qt = 0; qt < 2; ++qt)
#pragma unroll
    for (int ks = 0; ks < 2; ++ks) qf[qt][ks] = ldfrag(projb + (size_t)(q0 + qt * 16 + l15) * NP + PA_Q + h * 64 + ks * 32 + 8 * g);
  const float sc = 0.125f * 1.4426950408889634f;
  f32x4 outacc[4][2];
  AttnAcc a;
  const int ntc = (q0 >> 10) + 1;
  attn_init(a);
  lds_barrier();
  for (int i = tid; i < 4 * 32 * 65; i += 256) T[i] = 0.f;
  kv_pipeline(0, ntc, Ks,
    [&](int) { return true; },
    [&](int j, KVRegs& kr) { kv_load(kcmp, vcmp, 64, 64, j * 64, kr); },
    [&](int j, const u16* Kt, const u16* Vt) {
      f32x4 s[4][2];
      auto valid = [&](int kt, int r, int qt) { return 16 * (j * 64 + kt * 16 + 4 * g + r) + 31 <= q0 + qt * 16 + l15; };
      qk_tile<2>(Kt, 0, qf, s, l15, g);
      softmax_pv(s, a, Vt, sc, l15, g, valid);
    });
  float cinv[2];
#pragma unroll
  for (int qt = 0; qt < 2; ++qt) {
    const float lt = group_sum4(a.l[qt]);
    cinv[qt] = lt > 0.f ? 1.f / lt : 0.f;
    const float gt = sigmoidf_(smb[(size_t)(q0 + qt * 16 + l15) * NSMALL + SM_G + h * 3 + 0]) * cinv[qt];
#pragma unroll
    for (int d = 0; d < 4; ++d) outacc[d][qt] = a.o[d][qt] * gt;
  }
  float carry[2] = {0.f, 0.f};
  kv_pipeline(0, ntc, Ks,
    [&](int) { return true; },
    [&](int j, KVRegs& kr) { kv_load(kcmp, vcmp, 64, 64, j * 64, kr); },
    [&](int j, const u16* Kt, const u16*) {
      f32x4 s[4][2];
      qk_tile<2>(Kt, 0, qf, s, l15, g);
#pragma unroll
      for (int qt = 0; qt < 2; ++qt) {
        float prev3 = carry[qt];
#pragma unroll
        for (int kt = 0; kt < 4; ++kt) {
          float pr[4];
#pragma unroll
          for (int r = 0; r < 4; ++r) {
            const bool ok = 16 * (j * 64 + kt * 16 + 4 * g + r) + 31 <= q0 + qt * 16 + l15;
            pr[r] = ok ? exp2_(s[kt][qt][r] * sc - a.m[qt]) * cinv[qt] : 0.f;
          }
          const float below = __shfl_up(pr[3], 16);
          const float wrap = __shfl(prev3, l15 + 48);
          const float nb = g > 0 ? below : wrap;
          T[(h * 32 + qt * 16 + l15) * 65 + j * 16 + kt * 4 + g] = (pr[0] + pr[1]) + (pr[2] + 0.5f * pr[3]) + 0.5f * nb;
          prev3 = pr[3];
        }
        carry[qt] = prev3;
      }
    });
  lds_barrier();
#pragma unroll 1
  for (int qq = 0; qq < 8; ++qq) {
    const int q = h * 8 + qq, t = q0 + q, cur = t >> 6;
    const float imp = ((T[(0 * 32 + q) * 65 + lane] + T[(1 * 32 + q) * 65 + lane]) + T[(2 * 32 + q) * 65 + lane]) + T[(3 * 32 + q) * 65 + lane];
    const bool forced = lane == cur || lane == 0, allowed = lane <= cur, cand = allowed && !forced;
    const int K = cur == 0 ? 15 : 14;
    unsigned long long m;
    if (__popcll(__ballot(cand)) <= K) m = __ballot(allowed);
    else {
      const unsigned key = __float_as_uint(imp);
      unsigned prefix = 0u;
#pragma unroll 1
      for (int bit = 30; bit >= 0; --bit) {
        const unsigned cnd = prefix | (1u << bit);
        if (__popcll(__ballot(cand && key >= cnd)) >= K) prefix = cnd;
      }
      const unsigned long long gt = __ballot(cand && key > prefix), eq = __ballot(cand && key == prefix);
      const int need = K - __popcll(gt);
      const int myrank = __popcll(eq & ((1ull << lane) - 1ull));
      m = gt | __ballot(cand && key == prefix && myrank < need) | __ballot(forced);
    }
    if (lane == 0) selm[q] = m;
  }
  lds_barrier();
  f32x4* park = (f32x4*)T + (h * 8) * 64 + lane;
#pragma unroll
  for (int d = 0; d < 4; ++d) { park[(d * 2 + 0) * 64] = outacc[d][0]; park[(d * 2 + 1) * 64] = outacc[d][1]; }
  unsigned long long mq[2], anym = 0ull;
#pragma unroll
  for (int qt = 0; qt < 2; ++qt) mq[qt] = selm[qt * 16 + l15];
  for (int i = 0; i < 32; ++i) anym |= selm[i];
  const int jhi = (q0 + 31) >> 6;
#pragma unroll
  for (int qt = 0; qt < 2; ++qt)
#pragma unroll
    for (int ks = 0; ks < 2; ++ks) qf[qt][ks] = scale_frag(qf[qt][ks], sc);
  attn_init_rel(a);
  kv_pipeline(0, jhi + 1, Ks,
    [&](int j) { return (bool)((anym >> j) & 1ull); },
    [&](int j, KVRegs& kr) { kv_load(projb + PA_KS, projb + PA_VS, NP, NP, j * 64, kr); },
    [&](int j, const u16* Kt, const u16* Vt) {
      f32x4 s[4][2];
      auto valid = [&](int kt, int r, int qt) { return ((mq[qt] >> j) & 1ull) && (j * 64 + kt * 16 + 4 * g + r <= q0 + qt * 16 + l15); };
      bf16x8 pf[2][2];
      if (j * 64 + 63 <= q0) {
        qk_tile_rel<2>(Kt, 0, qf, a, s, l15, g, (bool)((mq[0] >> j) & 1ull), (bool)((mq[1] >> j) & 1ull));
        softmax_rel<0>(s, a, pf, l15, valid);
      } else {
        qk_tile_rel<2>(Kt, 0, qf, a, s, l15, g);
        softmax_rel<1>(s, a, pf, l15, valid);
      }
      pv_accum(pf, Vt, a.o, l15, g);
      rowsum_accum(pf, a, l15);
    });
#pragma unroll
  for (int qt = 0; qt < 2; ++qt) {
    const float lt = rel_rowsum(a, qt, l15);
    const float gt = sigmoidf_(smb[(size_t)(q0 + qt * 16 + l15) * NSMALL + SM_G + h * 3 + 1]) * (lt > 0.f ? 1.f / lt : 0.f);
#pragma unroll
    for (int d = 0; d < 4; ++d) park[(d * 2 + qt) * 64] += a.o[d][qt] * gt;
  }
  attn_init_rel(a);
  const int jlo = q0 >= 511 ? (q0 - 511) >> 6 : 0;
  kv_pipeline(jlo, jhi + 1, Ks,
    [&](int) { return true; },
    [&](int j, KVRegs& kr) { kv_load(projb + PA_KW, projb + PA_VW, NP, NP, j * 64, kr); },
    [&](int j, const u16* Kt, const u16* Vt) {
      f32x4 s[4][2];
      auto valid = [&](int kt, int r, int qt) { const int key = j * 64 + kt * 16 + 4 * g + r, t = q0 + qt * 16 + l15; return key <= t && key + 512 > t; };
      bf16x8 pf[2][2];
      qk_tile_rel<2>(Kt, 0, qf, a, s, l15, g);
      if (j * 64 + 63 <= q0 && j * 64 + 512 > q0 + 31) softmax_rel<0>(s, a, pf, l15, valid);
      else softmax_rel<1>(s, a, pf, l15, valid);
      pv_accum(pf, Vt, a.o, l15, g);
      rowsum_accum(pf, a, l15);
    });
  u16* Y = (u16*)(p.ws + OFF_H);
  const float* ng = p.nsa_norm_g + layer * 64;
#pragma unroll
  for (int qt = 0; qt < 2; ++qt) {
    const int t = q0 + qt * 16 + l15;
    const float lt = rel_rowsum(a, qt, l15);
    const float gt = sigmoidf_(smb[(size_t)t * NSMALL + SM_G + h * 3 + 2]) * (lt > 0.f ? 1.f / lt : 0.f);
    f32x4 v[4]; float ss = 0.f;
#pragma unroll
    for (int d = 0; d < 4; ++d) { v[d] = park[(d * 2 + qt) * 64] + a.o[d][qt] * gt; ss += v[d][0] * v[d][0] + v[d][1] * v[d][1] + v[d][2] * v[d][2] + v[d][3] * v[d][3]; }
    ss = group_sum4(ss);
    const float rn = rsqrtf(ss * (1.f / 64.f) + 1e-6f);
    const size_t row = (size_t)b * SEQ + t;
#pragma unroll
    for (int d = 0; d < 4; ++d) {
      const int dd = d * 16 + 4 * g;
      const u32x2 zz = *(const u32x2*)(projb + (size_t)t * NP + PA_Z + h * 64 + dd);
      const f32x4 gg = *(const f32x4*)(ng + dd);
      u32x2 o;
      o.x = pack2(v[d][0] * rn * gg[0] * siluf(bflo(zz.x)), v[d][1] * rn * gg[1] * siluf(bfhi(zz.x)));
      o.y = pack2(v[d][2] * rn * gg[2] * siluf(bflo(zz.y)), v[d][3] * rn * gg[3] * siluf(bfhi(zz.y)));
      *(u32x2*)(Y + row * 1024 + Y_A + h * 64 + dd) = o;
    }
  }
}


DI void final_norm_rows(const Params& p, int rbase, int nrows, int gw, int nw, int lane) {
  const float4* gp = (const float4*)p.final_g;
  float4 gg[4];
#pragma unroll
  for (int i = 0; i < 4; ++i) gg[i] = gp[lane + 64 * i];
  for (int row0 = rbase + gw * 4; row0 < rbase + nrows; row0 += nw * 4) {
    f32x4 v[4][4]; float ss[4];
#pragma unroll
    for (int j = 0; j < 4; ++j) {
      const f32x4* xr = (const f32x4*)(p.out + (size_t)(row0 + j) * D_MODEL);
#pragma unroll
      for (int i = 0; i < 4; ++i) v[j][i] = xr[lane + 64 * i];
    }
    asm volatile("" : "+v"(v[0][0]), "+v"(v[0][1]), "+v"(v[0][2]), "+v"(v[0][3]), "+v"(v[1][0]), "+v"(v[1][1]), "+v"(v[1][2]), "+v"(v[1][3]), "+v"(v[2][0]), "+v"(v[2][1]), "+v"(v[2][2]), "+v"(v[2][3]), "+v"(v[3][0]), "+v"(v[3][1]), "+v"(v[3][2]), "+v"(v[3][3]));
#pragma unroll
    for (int j = 0; j < 4; ++j) {
      float a = 0.f;
#pragma unroll
      for (int i = 0; i < 4; ++i) a += v[j][i][0] * v[j][i][0] + v[j][i][1] * v[j][i][1] + v[j][i][2] * v[j][i][2] + v[j][i][3] * v[j][i][3];
      ss[j] = wave_sum(a);
    }
#pragma unroll
    for (int j = 0; j < 4; ++j) {
      float4* xr = (float4*)(p.out + (size_t)(row0 + j) * D_MODEL);
      const float r = rsqrtf(ss[j] * (1.f / D_MODEL) + 1e-6f);
#pragma unroll
      for (int i = 0; i < 4; ++i) { float4 w; w.x = v[j][i][0] * r * gg[i].x; w.y = v[j][i][1] * r * gg[i].y; w.z = v[j][i][2] * r * gg[i].z; w.w = v[j][i][3] * r * gg[i].w; xr[lane + 64 * i] = w; }
    }
  }
}

#define XB_TMO      128
#define XB_XCNT(j)  (256  + 64 * (j))
#define XB_XSUB(j)  (1280 + 64 * (j))
#define XB_XGEN(j)  (2304 + 64 * (j))
#define XB_TOP      3328
#define XB_TOPGEN   3392
#define XCD_BAR_WORDS 3456
#define XB_SPIN_CAP (1u << 23)
DI unsigned xb_ld(unsigned* p)              { return __hip_atomic_load(p, __ATOMIC_RELAXED, __HIP_MEMORY_SCOPE_AGENT); }
DI unsigned xb_add(unsigned* p, unsigned v) { return __hip_atomic_fetch_add(p, v, __ATOMIC_RELAXED, __HIP_MEMORY_SCOPE_AGENT); }
DI unsigned xb_xcc_id() { return (unsigned)__builtin_amdgcn_s_getreg((3 << 11) | 20) & 0xFu; }
#define XB_SPIN(cond, bar) do { unsigned _sp = 0; while (cond) { __builtin_amdgcn_s_sleep(1); \
    if ((++_sp & 255u) == 0u) { if (xb_ld(&(bar)[XB_TMO])) break; if (_sp > XB_SPIN_CAP) { atomicAdd(&(bar)[XB_TMO], 1u); break; } } } } while (0)
struct XcdBarrier { unsigned* bar; unsigned x; volatile LDSP unsigned* st; };
DI XcdBarrier xcd_barrier_post(unsigned* bar, volatile LDSP unsigned* st) {
  XcdBarrier b; b.bar = bar; b.x = xb_xcc_id(); b.st = st;
  if (threadIdx.x == 0) (void)xb_add(&bar[XB_XCNT(b.x)], 1u);
  return b;
}
DI void xcd_barrier_complete(unsigned* bar, unsigned x, unsigned& nloc, unsigned& nx) {
  const unsigned G = gridDim.x * gridDim.y * gridDim.z;
  unsigned sum, cnt, mine, sp = 0u;
  for (;;) {
    sum = 0u; cnt = 0u; mine = 0u;
#pragma unroll
    for (unsigned j = 0; j < 16; ++j) { const unsigned c = xb_ld(&bar[XB_XCNT(j)]); sum += c; cnt += (c > 0u) ? 1u : 0u; mine = (j == x) ? c : mine; }
    if (sum == G) break;
    __builtin_amdgcn_s_sleep(1);
    if ((++sp & 255u) == 0u) { if (xb_ld(&bar[XB_TMO])) break; if (sp > XB_SPIN_CAP) { atomicAdd(&bar[XB_TMO], 1u); break; } }
  }
  nloc = mine > 0u ? mine : 1u; nx = cnt > 0u ? cnt : 1u;
}
DI void xcd_barrier(const XcdBarrier& b) {
  asm volatile("s_waitcnt vmcnt(0)" ::: "memory");
  __syncthreads();
  if (threadIdx.x == 0) {
    unsigned* bar = b.bar;
    __builtin_amdgcn_s_waitcnt(0);
    unsigned nloc = b.st[0], nx = b.st[1];
    if (nloc == 0u) { xcd_barrier_complete(bar, b.x, nloc, nx); b.st[0] = nloc; b.st[1] = nx; }
    const unsigned old = xb_add(&bar[XB_XSUB(b.x)], 1u);
    const unsigned gen = old / nloc;
    if (old + 1u == (gen + 1u) * nloc) {
      __builtin_amdgcn_fence(__ATOMIC_RELEASE, "agent");
      asm volatile("s_waitcnt vmcnt(0)" ::: "memory");
      const unsigned og = xb_add(&bar[XB_TOP], 1u);
      const unsigned tg = og / nx;
      if (og + 1u == (tg + 1u) * nx) xb_add(&bar[XB_TOPGEN], 1u);
      else XB_SPIN(xb_ld(&bar[XB_TOPGEN]) == tg, bar);
      __builtin_amdgcn_fence(__ATOMIC_ACQUIRE, "agent");
      xb_add(&bar[XB_XGEN(b.x)], 1u);
      asm volatile("s_waitcnt vmcnt(0)" ::: "memory");
    } else {
      XB_SPIN(xb_ld(&bar[XB_XGEN(b.x)]) == gen, bar);
      __builtin_amdgcn_fence(__ATOMIC_ACQUIRE, "agent");
      asm volatile("s_waitcnt vmcnt(0)" ::: "memory");
    }
  }
  __syncthreads();
}

constexpr int HALF_LDS = 76 * 1024;
constexpr int SMEM_BYTES = 2 * HALF_LDS;
DI void group_barrier(unsigned* gc, unsigned target) {
  asm volatile("s_waitcnt vmcnt(0)" ::: "memory");
  __syncthreads();
  if (threadIdx.x == 0) {
    __hip_atomic_fetch_add(gc, 1u, __ATOMIC_RELAXED, __HIP_MEMORY_SCOPE_AGENT);
    unsigned sp = 0;
    while (__hip_atomic_load(gc, __ATOMIC_RELAXED, __HIP_MEMORY_SCOPE_AGENT) < target) { __builtin_amdgcn_s_sleep(1); if (++sp > (1u << 24)) break; }
    __builtin_amdgcn_fence(__ATOMIC_ACQUIRE, "agent");
    asm volatile("s_waitcnt vmcnt(0)" ::: "memory");
  }
  __syncthreads();
}
#ifndef STAGGER_US
#define STAGGER_US 0
#endif
__global__ void __launch_bounds__(512, 2) fwd_megakernel(Params p) {
  cg::grid_group grid = cg::this_grid();
  __shared__ __attribute__((aligned(16))) unsigned char smem[SMEM_BYTES];
  const int half = __builtin_amdgcn_readfirstlane(threadIdx.x >> 8);
  unsigned char* hsm = smem + half * HALF_LDS;
  const int G = gridDim.x, bid = blockIdx.x;
  const int slot = bid * 2 + half, NS = 2 * G;
  volatile LDSP unsigned* xst = (volatile LDSP unsigned*)(LDSP unsigned char*)(smem + SMEM_BYTES - 64);
  unsigned* cntp = (unsigned*)(p.ws + OFF_CNT);
  const XcdBarrier xb = xcd_barrier_post((unsigned*)(p.ws + OFF_BAR), xst);
  if (threadIdx.x == 0) xst[4] = __hip_atomic_fetch_add(cntp + 128 + xb.x, 1u, __ATOMIC_RELAXED, __HIP_MEMORY_SCOPE_AGENT);
  {
    constexpr int ADA0 = T0_WIN + T0_WOUT + T0_W1 + T0_W2;
    unsigned* cnt = cntp;
    for (int i = slot; i < ((T0_TOTAL + NS - 1) / NS) * NS; i += NS) {
      const int t = i < 96 ? ADA0 + i : (i - 96 < ADA0 ? i - 96 : i);
      phase0_task(p, t, hsm);
      if (i < 96) {
        asm volatile("s_waitcnt vmcnt(0)" ::: "memory");
        lds_barrier();
        if (otid512() == 0) {
          __builtin_amdgcn_fence(__ATOMIC_RELEASE, "agent");
          asm volatile("s_waitcnt vmcnt(0)" ::: "memory");
          __hip_atomic_fetch_add(cnt + 8, 2u, __ATOMIC_RELAXED, __HIP_MEMORY_SCOPE_AGENT);
        }
      }
    }
    if (otid512() == 0) {
      unsigned sp = 0;
      while (__hip_atomic_load(cnt + 8, __ATOMIC_RELAXED, __HIP_MEMORY_SCOPE_AGENT) < 96u) { __builtin_amdgcn_s_sleep(8); if (++sp > (1u << 22)) break; }
      __builtin_amdgcn_fence(__ATOMIC_ACQUIRE, "agent");
      asm volatile("s_waitcnt vmcnt(0)" ::: "memory");
    }
    lds_barrier();
    for (int t = slot; t < ((NTOK / 64 + NS - 1) / NS) * NS; t += NS) phase1_task(p, 0, p.x, t < NTOK / 64 ? t : NTOK / 64 - 1, hsm);
  }
  grid.sync();
  if (threadIdx.x == 0) {
    unsigned nloc = 0, ng = 0, gi = 0;
    for (unsigned j = 0; j < 16; ++j) { const unsigned c = xb_ld(xb.bar + XB_XCNT(j)); if (c) { if (j < xb.x) ++gi; ++ng; } if (j == xb.x) nloc = c; }
    xst[5] = nloc ? nloc : 1u; xst[6] = ng ? ng : 1u; xst[7] = gi;
  }
  __syncthreads();
  const int rank = __builtin_amdgcn_readfirstlane((int)xst[4]), nloc = __builtin_amdgcn_readfirstlane((int)xst[5]), ng = __builtin_amdgcn_readfirstlane((int)xst[6]), gi = __builtin_amdgcn_readfirstlane((int)xst[7]);
  unsigned* gcnt = cntp + 256 + 64 * xb.x;
  unsigned epoch = 0;
#if STAGGER_US
  { const unsigned long long t0 = wall_clock64(); while (wall_clock64() - t0 < (unsigned long long)(STAGGER_US * 100) * (unsigned long long)gi) __builtin_amdgcn_s_sleep(8); }
#endif
  const int lslot = rank * 2 + half, LNS = 2 * nloc;
  for (int bb = gi; bb < BATCH; bb += ng)
  for (int layer = 0; layer < 2; ++layer) {
    Params q = p;
    { size_t zoff = 0; asm volatile("" : "+s"(zoff)); q.ws = p.ws + zoff; }
    const float* xin = layer == 0 ? q.x : q.out;
    if (layer != 0) {
      for (int t = lslot; t < ((64 + LNS - 1) / LNS) * LNS; t += LNS) phase1_task(q, layer, xin, bb * 64 + (t < 64 ? t : 63), hsm);
      group_barrier(gcnt, ++epoch * (unsigned)nloc);
    }
    for (int t = rank; t < 256; t += nloc) { const int r = t >> 5, i = t & 31; gemm_inproj_tile(q, layer, bb * 16 + (i & 7) + 8 * (r & 1), (i >> 3) + 4 * (r >> 1), smem); }
    group_barrier(gcnt, ++epoch * (unsigned)nloc);
    {
      unsigned* cnt = (unsigned*)(q.ws + OFF_CNT);
      unsigned* qcnt = cnt + 32 + layer * 8; unsigned* cdone = cnt + 64 + layer * 8; unsigned* sdone = cnt + 96 + layer * 8;
      int* s_pair = (int*)(smem + SMEM_BYTES - 16);
      for (int sq = rank; sq < 8; sq += nloc) {
        if (sq < 4) ssd_task8(q, layer, bb, sq, smem); else mlstm_task8(q, layer, bb, sq - 4, smem);
        asm volatile("s_waitcnt vmcnt(0)" ::: "memory");
        lds_barrier();
        if (otid512() == 0) {
          __builtin_amdgcn_fence(__ATOMIC_RELEASE, "agent");
          asm volatile("s_waitcnt vmcnt(0)" ::: "memory");
          __hip_atomic_fetch_add(sdone + bb, 1u, __ATOMIC_RELAXED, __HIP_MEMORY_SCOPE_AGENT);
        }
      }
      constexpr int NP_C = 8, NP_D = 64, NP_N = 64, NP_F = 32, NP_ALL = NP_C + NP_D + NP_N + NP_F;
      const int bq = bb;
      for (;;) {
        const int t512 = otid512();
        lds_barrier();
        if (t512 == 0) *s_pair = (int)atomicAdd(qcnt + bq, 1u);
        lds_barrier();
        const int pair = *s_pair;
        if (pair >= NP_ALL) break;
        if (pair < NP_C) {
          const int v = pair * 2 + half;
          compress_task(q, layer, bq, v >> 3, v & 7, hsm);
          asm volatile("s_waitcnt vmcnt(0)" ::: "memory");
          lds_barrier();
          if (t512 == 0) {
            __builtin_amdgcn_fence(__ATOMIC_RELEASE, "agent");
            asm volatile("s_waitcnt vmcnt(0)" ::: "memory");
            __hip_atomic_fetch_add(cdone + bq, 1u, __ATOMIC_RELAXED, __HIP_MEMORY_SCOPE_AGENT);
          }
        } else if (pair < NP_C + NP_D) {
          const int d = pair - NP_C;
          diff_attn_task(q, layer, bq, 2 * (d & 1) + half, 31 - (d >> 1), hsm);
        } else if (pair < NP_C + NP_D + NP_N) {
          if (t512 == 0) {
            while (__hip_atomic_load(cdone + bq, __ATOMIC_RELAXED, __HIP_MEMORY_SCOPE_AGENT) < (unsigned)NP_C) __builtin_amdgcn_s_sleep(16);
            __builtin_amdgcn_fence(__ATOMIC_ACQUIRE, "agent");
            asm volatile("s_waitcnt vmcnt(0)" ::: "memory");
          }
          lds_barrier();
          nsa_task(q, layer, bq, 2 * (63 - (pair - NP_C - NP_D)) + half, hsm);
        } else {
          if (t512 == 0) {
            while (__hip_atomic_load(sdone + bq, __ATOMIC_RELAXED, __HIP_MEMORY_SCOPE_AGENT) < 8u) __builtin_amdgcn_s_sleep(16);
            __builtin_amdgcn_fence(__ATOMIC_ACQUIRE, "agent");
            asm volatile("s_waitcnt vmcnt(0)" ::: "memory");
          }
          lds_barrier();
          seq_fix_rows(q, layer, bq * SEQ + ((pair - NP_C - NP_D - NP_N) * 2 + half) * 64, 64);
        }
      }
    }
    group_barrier(gcnt, ++epoch * (unsigned)nloc);
    if (layer == 0) { for (int t = rank; t < 64; t += nloc) gemm_outproj_tile<0>(q, xin, q.out, bb * 16 + (t & 15), t >> 4, smem); }
    else { for (int t = rank; t < 64; t += nloc) gemm_outproj_tile<1>(q, xin, q.out, bb * 16 + (t & 15), t >> 4, smem); }
    group_barrier(gcnt, ++epoch * (unsigned)nloc);
    if (layer == 1) {
      const int t5 = otid512();
      final_norm_rows(q, bb * SEQ, SEQ, rank * 8 + (t5 >> 6), nloc * 8, t5 & 63);
    }
  }
}

extern "C" void kernel_launch(void* const* d_in, const int* in_sizes, int n_in, void* d_out, int out_size, void* d_ws, size_t ws_size,
                              hipStream_t stream) {
  static int grid_blocks = 0;
  if (!grid_blocks) {
    int dev = 0, cus = 0, per_cu = 0;
    (void)hipGetDevice(&dev);
    (void)hipDeviceGetAttribute(&cus, hipDeviceAttributeMultiprocessorCount, dev);
    (void)hipOccupancyMaxActiveBlocksPerMultiprocessor(&per_cu, fwd_megakernel, 512, 0);
    if (per_cu > 1) per_cu = 1;
    if (per_cu < 1) per_cu = 1;
    grid_blocks = cus * per_cu;
  }
  if (grid_blocks < 64 || (grid_blocks & 3)) { fprintf(stderr, "grid too small: %d\n", grid_blocks); return; }
  if (ws_size < WS_NEEDED) { fprintf(stderr, "workspace too small: %zu < %zu\n", ws_size, WS_NEEDED); return; }
  Params p{};
  const float** pp = (const float**)&p;
  for (int i = 0; i < 26; ++i) pp[i] = (const float*)d_in[i];
  p.out = (float*)d_out; p.ws = (unsigned char*)d_ws;
  (void)hipMemsetAsync((unsigned char*)d_ws + OFF_CNT, 0, 64 * 1024 + XCD_BAR_WORDS * 4, stream);
  void* args[] = {&p};
  hipError_t e = hipLaunchCooperativeKernel((void*)fwd_megakernel, dim3(grid_blocks), dim3(512), args, 0, stream);
  if (e != hipSuccess) fprintf(stderr, "cooperative launch failed: %s (grid %d)\n", hipGetErrorString(e), grid_blocks);
}
```

```cpp
#include <hip/hip_runtime.h>
#include <hip/hip_cooperative_groups.h>
#include <cstdio>
#include <cstdint>
namespace cg = cooperative_groups;

typedef unsigned short u16;
typedef short bf16x8 __attribute__((ext_vector_type(8)));
typedef short s16x4 __attribute__((ext_vector_type(4)));
typedef float f32x4 __attribute__((ext_vector_type(4)));
typedef float f32x2 __attribute__((ext_vector_type(2)));
typedef unsigned u32x4 __attribute__((ext_vector_type(4)));
typedef unsigned u32x2 __attribute__((ext_vector_type(2)));
typedef __bf16 bf16x2_t __attribute__((ext_vector_type(2)));
#define DI __device__ __forceinline__
#define LDSP __attribute__((address_space(3)))

constexpr int D_MODEL = 1024, BATCH = 8, SEQ = 4096, NTOK = BATCH * SEQ;
constexpr int D_IN = 3992;
constexpr int NP = 3968, NPAD = 4096, NSMALL = 32;
constexpr int PA_Q = 0, PA_KC = 256, PA_VC = 320, PA_KS = 384, PA_VS = 448, PA_KW = 512, PA_VW = 576, PA_Z = 640;
constexpr int PB_Q = 896, PB_K = 1152, PB_V = 1408, PB_Z = 1664;
constexpr int PC_Z = 1920, PC_XBC = 2176;
constexpr int PD_QK = 2688, PD_V = 3200, PD_O = 3456, PD_Z = 3712;
constexpr int SM_G = 0, SM_DT = 12, SM_IF = 16;
constexpr int Y_A = 0, Y_B = 256, Y_C = 512, Y_D = 768;

constexpr size_t MiB = 1024 * 1024;
constexpr size_t OFF_WINT = 0;
constexpr size_t OFF_WOUTT = 16 * MiB;
constexpr size_t OFF_W1T = 20 * MiB;
constexpr size_t OFF_W2T = 22 * MiB;
constexpr size_t OFF_BIAS1 = 22 * MiB + 64 * 1024;
constexpr size_t OFF_ADAP = 22 * MiB + 128 * 1024;
constexpr size_t OFF_KCMP = 24 * MiB;
constexpr size_t OFF_VCMP = 24 * MiB + 256 * 1024;
constexpr size_t OFF_BAR = 29 * MiB + 64 * 1024;
constexpr size_t OFF_CNT = 29 * MiB;
constexpr size_t OFF_SMALL = 25 * MiB;
constexpr size_t OFF_SSQ = 29 * MiB;
constexpr size_t OFF_H = 32 * MiB;
constexpr size_t OFF_PROJ = 96 * MiB;
constexpr size_t OFF_X1B = 352 * MiB;
constexpr size_t WS_NEEDED = OFF_X1B + (size_t)NTOK * 1024 * 2;

struct Params {
  const float* x; const float* c; const float* norm_g; const float* ada_w; const float* ada_b;
  const float* w_in; const float* w_out;
  const float* nsa_cmp_pos; const float* nsa_ck_w1; const float* nsa_ck_w2; const float* nsa_cv_w1; const float* nsa_cv_w2; const float* nsa_norm_g;
  const float* diff_lam; const float* diff_norm_g;
  const float* ssm_conv_w; const float* ssm_conv_b; const float* ssm_dt_bias; const float* ssm_a_log; const float* ssm_d; const float* ssm_norm_g;
  const float* ml_conv_w; const float* ml_conv_b; const float* ml_if_b; const float* ml_norm_g; const float* final_g;
  float* out; unsigned char* ws;
};

DI void lds_barrier() { asm volatile("s_waitcnt lgkmcnt(0)" ::: "memory"); __builtin_amdgcn_s_barrier(); asm volatile("" ::: "memory"); }
DI int otid() { int t = threadIdx.x & 255; asm volatile("" : "+v"(t)); return t; }
DI int otid512() { int t = threadIdx.x; asm volatile("" : "+v"(t)); return t; }
DI unsigned pack2(float a, float b) { f32x2 v = {a, b}; bf16x2_t r = __builtin_convertvector(v, bf16x2_t); return __builtin_bit_cast(unsigned, r); }
DI u16 f2bf(float a) { return (u16)(pack2(a, 0.f) & 0xffffu); }
DI float bf2f(u16 h) { return __uint_as_float(((unsigned)h) << 16); }
DI float bflo(unsigned u) { return __uint_as_float(u << 16); }
DI float bfhi(unsigned u) { return __uint_as_float(u & 0xffff0000u); }
DI f32x4 mfma16(bf16x8 a, bf16x8 b, f32x4 c) { return __builtin_amdgcn_mfma_f32_16x16x32_bf16(a, b, c, 0, 0, 0); }
DI float wave_sum(float v) {
#pragma unroll
  for (int o = 32; o > 0; o >>= 1) v += __shfl_xor(v, o);
  return v;
}
DI float siluf(float v) { return v * __builtin_amdgcn_rcpf(1.f + __expf(-v)); }
DI float sigmoidf_(float v) { return __builtin_amdgcn_rcpf(1.f + __expf(-v)); }
DI float exp2_(float v) { return __builtin_amdgcn_exp2f(v); }
DI float sgprf(float v) { return __int_as_float(__builtin_amdgcn_readfirstlane(__float_as_int(v))); }
DI s16x4 tr_read(const u16* p) { return __builtin_amdgcn_ds_read_tr16_b64_v4i16((LDSP s16x4*)p); }
DI bf16x8 cat4(s16x4 a, s16x4 b) { bf16x8 r; r[0] = a[0]; r[1] = a[1]; r[2] = a[2]; r[3] = a[3]; r[4] = b[0]; r[5] = b[1]; r[6] = b[2]; r[7] = b[3]; return r; }
DI bf16x8 ldfrag(const u16* p) { return *(const bf16x8*)p; }

DI int colmap(int n) {
  if (n < 640) return n;
  if (n < 896) return 652 + (n - 640);
  if (n < 1920) return 908 + (n - 896);
  if (n < 2688) return 1932 + (n - 1920);
  if (n < 3456) return 2704 + (n - 2688);
  if (n < 3968) return 3480 + (n - 3456);
  if (n < 3980) return 640 + (n - 3968);
  if (n < 3984) return 2700 + (n - 3980);
  if (n < 3992) return 3472 + (n - 3984);
  return -1;
}

#define PIN4(a) asm volatile("" : "+v"(a[0]), "+v"(a[1]), "+v"(a[2]), "+v"(a[3]))
DI void tconv_tile(const float* __restrict__ src, int ldsrc, int k0, int n0, u16* __restrict__ dst, int ldd, bool use_map, unsigned char* smem) {
  float* tile = (float*)smem;
  const int tid = otid();
  {
    const int c4 = tid & 15, kk0 = tid >> 4; int col = n0 + c4 * 4; if (use_map) col = colmap(col);
    const float* sp = src + (size_t)(k0 + kk0) * ldsrc + (col >= 0 ? col : 0);
    f32x4 v[4];
#pragma unroll
    for (int i = 0; i < 4; ++i) v[i] = *(const f32x4*)(sp + (size_t)(16 * i) * ldsrc);
    PIN4(v);
    lds_barrier();
#pragma unroll
    for (int i = 0; i < 4; ++i) {
      const f32x4 w = col >= 0 ? v[i] : (f32x4){0.f, 0.f, 0.f, 0.f};
      float* tp = tile + (kk0 + 16 * i) * 65 + c4 * 4;
      tp[0] = w[0]; tp[1] = w[1]; tp[2] = w[2]; tp[3] = w[3];
    }
  }
  lds_barrier();
#pragma unroll
  for (int i = 0; i < 2; ++i) {
    const int item = tid + 256 * i, nn = item >> 3, kc = item & 7;
    u32x4 w;
    w.x = pack2(tile[(kc * 8 + 0) * 65 + nn], tile[(kc * 8 + 1) * 65 + nn]);
    w.y = pack2(tile[(kc * 8 + 2) * 65 + nn], tile[(kc * 8 + 3) * 65 + nn]);
    w.z = pack2(tile[(kc * 8 + 4) * 65 + nn], tile[(kc * 8 + 5) * 65 + nn]);
    w.w = pack2(tile[(kc * 8 + 6) * 65 + nn], tile[(kc * 8 + 7) * 65 + nn]);
    *(u32x4*)(dst + (size_t)(n0 + nn) * ldd + k0 + kc * 8) = w;
  }
}

constexpr int T0_WIN = 2 * 16 * 64, T0_WOUT = 2 * 16 * 16, T0_W1 = 4 * 32 * 2, T0_W2 = 4 * 2, T0_ADA = 2 * 12 * 8, T0_B1 = 64;
constexpr int T0_TOTAL = T0_WIN + T0_WOUT + T0_W1 + T0_W2 + T0_ADA + T0_B1;

DI void phase0_task(const Params& p, int t, unsigned char* smem) {
  const int tid = otid();
  if (t >= T0_TOTAL) { lds_barrier(); lds_barrier(); return; }
  if (t < T0_WIN) {
    const int l = t / 1024, r = t % 1024, kt = r / 64, nt = r % 64;
    tconv_tile(p.w_in + (size_t)l * D_MODEL * D_IN, D_IN, kt * 64, nt * 64, (u16*)(p.ws + OFF_WINT) + (size_t)l * NPAD * 1024, 1024, true, smem);
    return;
  }
  t -= T0_WIN;
  if (t < T0_WOUT) {
    const int l = t / 256, r = t % 256, kt = r / 16, nt = r % 16;
    tconv_tile(p.w_out + (size_t)l * 1024 * 1024, 1024, kt * 64, nt * 64, (u16*)(p.ws + OFF_WOUTT) + (size_t)l * 1024 * 1024, 1024, false, smem);
    return;
  }
  t -= T0_WOUT;
  if (t < T0_W1) {
    const int m = t / 64, r = t % 64, kt = r / 2, nt = r % 2, l = m >> 1, kv = m & 1;
    const float* src = (kv ? p.nsa_cv_w1 : p.nsa_ck_w1) + (size_t)l * 2048 * 128;
    tconv_tile(src, 128, kt * 64, nt * 64, (u16*)(p.ws + OFF_W1T) + (size_t)m * 128 * 2048, 2048, false, smem);
    return;
  }
  t -= T0_W1;
  if (t < T0_W2) {
    const int m = t / 2, kt = t % 2, l = m >> 1, kv = m & 1;
    const float* src = (kv ? p.nsa_cv_w2 : p.nsa_ck_w2) + (size_t)l * 128 * 64;
    tconv_tile(src, 64, kt * 64, 0, (u16*)(p.ws + OFF_W2T) + (size_t)m * 64 * 128, 128, false, smem);
    return;
  }
  t -= T0_W2;
  if (t < T0_ADA) {
    const int l = t / 96, r = t % 96, nc = r / 8, kc = r % 8;
    float* cact = (float*)(smem + 20480);
    float* red = (float*)(smem + 24576);
    const int kq = __builtin_amdgcn_readfirstlane(tid >> 6), c4 = tid & 63;
    const float* w = p.ada_w + ((size_t)l * 1024 + kc * 128 + kq) * 3072 + nc * 256 + c4 * 4;
    float cv[4];
#pragma unroll
    for (int i = 0; i < 4; ++i) { const int e = tid + 256 * i; cv[i] = p.c[(e >> 7) * 1024 + kc * 128 + (e & 127)]; }
    f32x4 wv[32];
#pragma unroll
    for (int j = 0; j < 32; ++j) wv[j] = *(const f32x4*)(w + (size_t)(4 * j) * 3072);
    PIN4(cv);
#pragma unroll
    for (int i = 0; i < 4; ++i) cact[tid + 256 * i] = siluf(cv[i]);
#pragma unroll
    for (int j = 0; j < 32; j += 4) asm volatile("" : "+v"(wv[j]), "+v"(wv[j + 1]), "+v"(wv[j + 2]), "+v"(wv[j + 3]));
    lds_barrier();
    f32x4 acc[8];
#pragma unroll
    for (int b = 0; b < 8; ++b) acc[b] = (f32x4){0.f, 0.f, 0.f, 0.f};
#pragma unroll
    for (int j = 0; j < 32; ++j) {
#pragma unroll
      for (int b = 0; b < 8; ++b) acc[b] += cact[b * 128 + kq + 4 * j] * wv[j];
    }
#pragma unroll
    for (int b = 0; b < 8; ++b) *(f32x4*)(red + (kq * 8 + b) * 256 + c4 * 4) = acc[b];
    lds_barrier();
    float* adap = (float*)(p.ws + OFF_ADAP);
    const int n = nc * 256 + tid;
    float bias = p.ada_b[l * 3072 + n];
    asm volatile("" : "+v"(bias));
    bias = kc == 0 ? bias : 0.f;
#pragma unroll
    for (int i = 0; i < 8; ++i) {
      adap[(((size_t)kc * 2 + l) * 8 + i) * 3072 + n] = ((red[(0 * 8 + i) * 256 + tid] + red[(1 * 8 + i) * 256 + tid]) + (red[(2 * 8 + i) * 256 + tid] + red[(3 * 8 + i) * 256 + tid])) + bias;
    }
    return;
  }
  t -= T0_ADA;
  {
    const int m = t >> 4, kc = t & 15, l = m >> 1, kv = m & 1;
    const float* w1 = (kv ? p.nsa_cv_w1 : p.nsa_ck_w1) + (size_t)l * 2048 * 128;
    const float* pos = p.nsa_cmp_pos + (size_t)l * 2048;
    const int n = tid & 127, half = tid >> 7;
    float acc = 0.f;
    const int k0 = kc * 128 + half * 64;
#pragma unroll 1
    for (int kb = 0; kb < 64; kb += 16) {
      float wv[16];
#pragma unroll
      for (int k = 0; k < 16; ++k) wv[k] = w1[(size_t)(k0 + kb + k) * 128 + n];
#pragma unroll
      for (int k = 0; k < 16; k += 4) asm volatile("" : "+v"(wv[k]), "+v"(wv[k + 1]), "+v"(wv[k + 2]), "+v"(wv[k + 3]));
#pragma unroll
      for (int k = 0; k < 16; ++k) acc += pos[k0 + kb + k] * wv[k];
    }
    float* red = (float*)smem;
    lds_barrier();
    red[tid] = acc;
    lds_barrier();
    if (tid < 128) ((float*)(p.ws + OFF_BIAS1))[(m * 16 + kc) * 128 + tid] = red[tid] + red[tid + 128];
  }
}

DI void phase1_task(const Params& p, int layer, const float* xin, int grp, unsigned char* smem) {
  const int tid = otid(), lane = tid & 63, wid = tid >> 6;
  const int b = grp >> 6;
  float* mul = (float*)smem;
  float* sh = mul + 1024;
  const float* adap = (const float*)(p.ws + OFF_ADAP);
  lds_barrier();
  {
    f32x4 a0[8], a1[8];
#pragma unroll
    for (int kc = 0; kc < 8; ++kc) { const float* a = adap + (((size_t)kc * 2 + layer) * 8 + b) * 3072 + 4 * tid; a0[kc] = *(const f32x4*)a; a1[kc] = *(const f32x4*)(a + 1024); }
    f32x4 gv = *(const f32x4*)(p.norm_g + layer * 1024 + 4 * tid);
    asm volatile("" : "+v"(a0[0]), "+v"(a0[1]), "+v"(a0[2]), "+v"(a0[3]), "+v"(a0[4]), "+v"(a0[5]), "+v"(a0[6]), "+v"(a0[7]));
    asm volatile("" : "+v"(a1[0]), "+v"(a1[1]), "+v"(a1[2]), "+v"(a1[3]), "+v"(a1[4]), "+v"(a1[5]), "+v"(a1[6]), "+v"(a1[7]), "+v"(gv));
    f32x4 s0 = a0[0], s1 = a1[0];
#pragma unroll
    for (int kc = 1; kc < 8; ++kc) { s0 += a0[kc]; s1 += a1[kc]; }
    *(f32x4*)(mul + 4 * tid) = gv * (1.f + s1); *(f32x4*)(sh + 4 * tid) = s0;
  }
  lds_barrier();
  u16* H = (u16*)(p.ws + OFF_H);
#pragma unroll 1
  for (int it = 0; it < 4; ++it) {
    f32x4 v[4][4]; float ss[4];
#pragma unroll
    for (int j = 0; j < 4; ++j) {
      const int row = grp * 64 + wid * 16 + it * 4 + j;
      if (layer == 0) {
        const f32x4* xr = (const f32x4*)(xin + (size_t)row * D_MODEL);
#pragma unroll
        for (int i = 0; i < 4; ++i) v[j][i] = xr[lane + 64 * i];
      } else {
        const u32x2* xr = (const u32x2*)((const u16*)(p.ws + OFF_X1B) + (size_t)row * D_MODEL);
#pragma unroll
        for (int i = 0; i < 4; ++i) { const u32x2 w = xr[lane + 64 * i]; v[j][i] = (f32x4){bflo(w.x), bfhi(w.x), bflo(w.y), bfhi(w.y)}; }
      }
    }
    if (layer == 0) asm volatile("" : "+v"(v[0][0]), "+v"(v[0][1]), "+v"(v[0][2]), "+v"(v[0][3]), "+v"(v[1][0]), "+v"(v[1][1]), "+v"(v[1][2]), "+v"(v[1][3]), "+v"(v[2][0]), "+v"(v[2][1]), "+v"(v[2][2]), "+v"(v[2][3]), "+v"(v[3][0]), "+v"(v[3][1]), "+v"(v[3][2]), "+v"(v[3][3]));
#pragma unroll
    for (int j = 0; j < 4; ++j) {
      float a = 0.f;
#pragma unroll
      for (int i = 0; i < 4; ++i) a += v[j][i][0] * v[j][i][0] + v[j][i][1] * v[j][i][1] + v[j][i][2] * v[j][i][2] + v[j][i][3] * v[j][i][3];
      ss[j] = wave_sum(a);
    }
#pragma unroll
    for (int j = 0; j < 4; ++j) {
      const int row = grp * 64 + wid * 16 + it * 4 + j;
      const float r = rsqrtf(ss[j] * (1.f / D_MODEL) + 1e-6f);
#pragma unroll
      for (int i = 0; i < 4; ++i) {
        const int c = (lane + 64 * i) * 4;
        u32x2 w;
        w.x = pack2(v[j][i][0] * r * mul[c] + sh[c], v[j][i][1] * r * mul[c + 1] + sh[c + 1]);
        w.y = pack2(v[j][i][2] * r * mul[c + 2] + sh[c + 2], v[j][i][3] * r * mul[c + 3] + sh[c + 3]);
        *(u32x2*)(H + (size_t)row * 1024 + c) = w;
      }
    }
  }
}

namespace g8 {
constexpr int BM = 256, BK = 64, HALF = 128, HT = HALF * BK;
constexpr int LDS_BYTES = 8 * HT * 2;
DI int lds_byte(int r, int c) { const int st = (r >> 4) * 2 + (c >> 5), rr = r & 15, cc = c & 31, ob = rr * 64 + cc * 2; return st * 1024 + (ob ^ (((ob >> 9) & 1) << 5)); }
DI void stage_rc(int b, int& R, int& C) { const int st = b / 1024, sb = b % 1024, swz = sb ^ (((sb >> 9) & 1) << 5); R = (st >> 1) * 16 + swz / 64; C = (st & 1) * 32 + (swz % 64) / 2; }

DI void kloop(const u16* __restrict__ A, const u16* __restrict__ Bt, int K, int brow, int bcol, unsigned char* smem, f32x4 (&acc)[2][2][4][2]) {
  u16* shm = (u16*)smem;
  const int tid = otid512();
#define SA(b, h) (shm + ((b) * 2 + (h)) * HT)
#define SB(b, h) (shm + (4 + (b) * 2 + (h)) * HT)
#define STAGE(P, BASE, br, kt) do { const u16* _gb = BASE + ((long)(br) * K + (long)(kt) * BK); \
      __builtin_amdgcn_global_load_lds((const unsigned*)(_gb + soff0), (LDSP unsigned*)((LDSP char*)(P) + tid * 16), 16, 0, 0); \
      __builtin_amdgcn_global_load_lds((const unsigned*)(_gb + soff1), (LDSP unsigned*)((LDSP char*)(P) + tid * 16 + 8192), 16, 0, 0); } while (0)
#define LDA(dst, b, h) _Pragma("unroll") for (int m = 0; m < 4; ++m) _Pragma("unroll") for (int k = 0; k < 2; ++k) \
    dst[m][k] = *reinterpret_cast<const bf16x8*>((const char*)SA(b, h) + lds_byte(wr * 64 + m * 16 + fr, k * 32 + fq * 8))
#define LDB(dst, b, h) _Pragma("unroll") for (int n = 0; n < 2; ++n) _Pragma("unroll") for (int k = 0; k < 2; ++k) \
    dst[n][k] = *reinterpret_cast<const bf16x8*>((const char*)SB(b, h) + lds_byte(wc * 32 + n * 16 + fr, k * 32 + fq * 8))
#define MMA(ai, bj, At_, Bt_) do { __builtin_amdgcn_s_setprio(1); \
    _Pragma("unroll") for (int m = 0; m < 4; ++m) _Pragma("unroll") for (int n = 0; n < 2; ++n) _Pragma("unroll") for (int k = 0; k < 2; ++k) \
      acc[ai][bj][m][n] = __builtin_amdgcn_mfma_f32_16x16x32_bf16(Bt_[n][k], At_[m][k], acc[ai][bj][m][n], 0, 0, 0); \
    __builtin_amdgcn_s_setprio(0); } while (0)
#define WAIT_V(n) asm volatile("s_waitcnt vmcnt(" #n ")" ::: "memory")
#define WAIT_L(n) asm volatile("s_waitcnt lgkmcnt(" #n ")" ::: "memory")
#define BAR __builtin_amdgcn_s_barrier()
#define SCHED __builtin_amdgcn_sched_barrier(0)
  const int wid = __builtin_amdgcn_readfirstlane(tid >> 6), lane = tid & 63, wr = wid >> 2, wc = wid & 3, fr = lane & 15, fq = lane >> 4;
#pragma unroll
  for (int a = 0; a < 2; ++a)
#pragma unroll
    for (int b = 0; b < 2; ++b)
#pragma unroll
      for (int m = 0; m < 4; ++m) { acc[a][b][m][0] = (f32x4){0.f, 0.f, 0.f, 0.f}; acc[a][b][m][1] = (f32x4){0.f, 0.f, 0.f, 0.f}; }
  bf16x8 At[4][2], B0[2][2], B1[2][2];
  const int nt = K / BK;
  int soff0, soff1;
  { int r_, c_; stage_rc(tid * 16, r_, c_); soff0 = r_ * K + c_; stage_rc(tid * 16 + 8192, r_, c_); soff1 = r_ * K + c_; }
  STAGE(SB(0, 0), Bt, bcol, 0); STAGE(SA(0, 0), A, brow, 0);
  STAGE(SB(0, 1), Bt, bcol + HALF, 0); STAGE(SA(0, 1), A, brow + HALF, 0);
  if (wr == 1) BAR;
  WAIT_V(4); BAR;
  STAGE(SB(1, 0), Bt, bcol, 1); STAGE(SA(1, 0), A, brow, 1); STAGE(SB(1, 1), Bt, bcol + HALF, 1);
  WAIT_V(6); BAR;
#pragma unroll 1
  for (int t = 0; t < nt - 2; t += 2) {
    asm volatile("" : "+v"(soff0), "+v"(soff1));
    LDB(B0, 0, 0); SCHED; LDA(At, 0, 0); STAGE(SA(1, 1), A, brow + HALF, t + 1);
    WAIT_L(8); BAR; WAIT_L(0); MMA(0, 0, At, B0); BAR; SCHED;
    LDB(B1, 0, 1); STAGE(SB(0, 0), Bt, bcol, t + 2);
    BAR; WAIT_L(0); MMA(0, 1, At, B1); BAR;
    LDA(At, 0, 1); STAGE(SA(0, 0), A, brow, t + 2);
    BAR; WAIT_L(0); MMA(1, 0, At, B0); BAR; SCHED;
    STAGE(SB(0, 1), Bt, bcol + HALF, t + 2);
    WAIT_V(6); BAR; MMA(1, 1, At, B1); BAR;
    LDB(B0, 1, 0); SCHED; LDA(At, 1, 0); STAGE(SA(0, 1), A, brow + HALF, t + 2);
    WAIT_L(8); BAR; WAIT_L(0); MMA(0, 0, At, B0); BAR; SCHED;
    LDB(B1, 1, 1); STAGE(SB(1, 0), Bt, bcol, t + 3);
    BAR; WAIT_L(0); MMA(0, 1, At, B1); BAR;
    LDA(At, 1, 1); STAGE(SA(1, 0), A, brow, t + 3);
    BAR; WAIT_L(0); MMA(1, 0, At, B0); BAR; SCHED;
    STAGE(SB(1, 1), Bt, bcol + HALF, t + 3);
    WAIT_V(6); BAR; MMA(1, 1, At, B1); BAR;
  }
  { LDB(B0, 0, 0); LDA(At, 0, 0); STAGE(SA(1, 1), A, brow + HALF, nt - 1);
    BAR; WAIT_L(0); MMA(0, 0, At, B0); BAR;
    LDB(B1, 0, 1); BAR; WAIT_L(0); MMA(0, 1, At, B1); BAR;
    LDA(At, 0, 1); WAIT_V(4); BAR; WAIT_L(0); MMA(1, 0, At, B0); MMA(1, 1, At, B1); BAR; }
  { LDB(B0, 1, 0); LDA(At, 1, 0); WAIT_V(2); BAR; WAIT_L(0); MMA(0, 0, At, B0); BAR;
    LDB(B1, 1, 1); WAIT_V(0); BAR; WAIT_L(0); MMA(0, 1, At, B1); BAR;
    LDA(At, 1, 1); BAR; WAIT_L(0); MMA(1, 0, At, B0); MMA(1, 1, At, B1); BAR; }
  if (wr == 0) BAR;
#undef SA
#undef SB
#undef STAGE
#undef LDA
#undef LDB
#undef MMA
#undef WAIT_V
#undef WAIT_L
#undef BAR
#undef SCHED
}
DI void tile_map(int wgid, int nM, int nN, int& pm, int& pn) {
  const int nwg = nM * nN, NXCD = 8, WGM = 8;
  { const int q = nwg / NXCD, r = nwg % NXCD, xcd = wgid % NXCD, off = wgid / NXCD; wgid = (xcd < r ? xcd * (q + 1) : r * (q + 1) + (xcd - r) * q) + off; }
  const int nig = WGM * nN, gid = wgid / nig, fm = gid * WGM, gsz = (nM - fm) < WGM ? (nM - fm) : WGM;
  pm = fm + ((wgid % nig) % gsz); pn = (wgid % nig) / gsz;
}
}

DI void gemm_inproj_tile(const Params& p, int layer, int pm, int pn, unsigned char* smem) {
  const int brow = pm * 256, bcol = pn * 256;
  f32x4 acc[2][2][4][2];
  g8::kloop((const u16*)(p.ws + OFF_H), (const u16*)(p.ws + OFF_WINT) + (size_t)layer * NPAD * 1024, 1024, brow, bcol, smem, acc);
  const int tid = otid512(), wid = __builtin_amdgcn_readfirstlane(tid >> 6), lane = tid & 63, wr = wid >> 2, wc = wid & 3, fr = lane & 15, fq = lane >> 4;
  u16* proj = (u16*)(p.ws + OFF_PROJ);
  if (pn == 15 && wc == 0) {
    float* sm = (float*)(p.ws + OFF_SMALL);
#pragma unroll
    for (int ai = 0; ai < 2; ++ai)
#pragma unroll
      for (int m = 0; m < 4; ++m)
#pragma unroll
        for (int n = 0; n < 2; ++n) {
          const int mr = brow + ai * 128 + wr * 64 + m * 16 + fr;
          *(f32x4*)(sm + (size_t)mr * NSMALL + n * 16 + 4 * fq) = acc[ai][1][m][n];
        }
  }
  constexpr int CLD = 264;
  u16* Cs = (u16*)smem;
#pragma unroll
  for (int ai = 0; ai < 2; ++ai) {
    lds_barrier();
#pragma unroll
    for (int bj = 0; bj < 2; ++bj)
#pragma unroll
      for (int m = 0; m < 4; ++m)
#pragma unroll
        for (int n = 0; n < 2; ++n) {
          const f32x4 v = acc[ai][bj][m][n];
          u32x2 w; w.x = pack2(v[0], v[1]); w.y = pack2(v[2], v[3]);
          *(u32x2*)(Cs + (wr * 64 + m * 16 + fr) * CLD + bj * 128 + wc * 32 + n * 16 + 4 * fq) = w;
        }
    lds_barrier();
#pragma unroll
    for (int i = 0; i < 8; ++i) {
      const int id = tid + 512 * i, row = id >> 5, ch = id & 31;
      if (bcol + ch * 8 < NP) *(u32x4*)(proj + (size_t)(brow + ai * 128 + row) * NP + bcol + ch * 8) = *(const u32x4*)(Cs + row * CLD + ch * 8);
    }
  }
  lds_barrier();
}

template <int layer>
DI void gemm_outproj_tile(const Params& p, const float* xin, float* xout, int pm, int pn, unsigned char* smem) {
  const int brow = pm * 256, bcol = pn * 256;
  f32x4 acc[2][2][4][2];
  g8::kloop((const u16*)(p.ws + OFF_H), (const u16*)(p.ws + OFF_WOUTT) + (size_t)layer * 1024 * 1024, 1024, brow, bcol, smem, acc);
  const int tid = otid512(), wid = __builtin_amdgcn_readfirstlane(tid >> 6), lane = tid & 63, wr = wid >> 2, wc = wid & 3, fr = lane & 15, fq = lane >> 4;
  const int b = brow >> 12;
  const float* adap = (const float*)(p.ws + OFF_ADAP);
  constexpr int CLD = 132;
  float* Cs = (float*)smem;
#pragma unroll
  for (int ai = 0; ai < 2; ++ai)
#pragma unroll
    for (int bj = 0; bj < 2; ++bj) {
      lds_barrier();
#pragma unroll
      for (int m = 0; m < 4; ++m)
#pragma unroll
        for (int n = 0; n < 2; ++n) *(f32x4*)(Cs + (wr * 64 + m * 16 + fr) * CLD + wc * 32 + n * 16 + 4 * fq) = acc[ai][bj][m][n];
      lds_barrier();
      const int ch = tid & 31, nc = bcol + bj * 128 + ch * 4;
      f32x4 gt = {0.f, 0.f, 0.f, 0.f};
#pragma unroll
      for (int kc = 0; kc < 8; ++kc) gt += *(const f32x4*)(adap + (((size_t)kc * 2 + layer) * 8 + b) * 3072 + 2048 + nc);
      u16* x1b = (u16*)(p.ws + OFF_X1B);
      f32x4 xv[8];
#pragma unroll
      for (int i = 0; i < 8; ++i) {
        const size_t off = (size_t)(brow + ai * 128 + (tid >> 5) + 16 * i) * 1024 + nc;
        if (layer == 0) xv[i] = *(const f32x4*)(xin + off);
        else { const u32x2 w = *(const u32x2*)(x1b + off); xv[i] = (f32x4){bflo(w.x), bfhi(w.x), bflo(w.y), bfhi(w.y)}; }
      }
#pragma unroll
      for (int i = 0; i < 8; ++i) {
        const int row = (tid >> 5) + 16 * i;
        const size_t off = (size_t)(brow + ai * 128 + row) * 1024 + nc;
        const f32x4 v = xv[i] + gt * *(const f32x4*)(Cs + row * CLD + ch * 4);
        if (layer == 0) { u32x2 w; w.x = pack2(v[0], v[1]); w.y = pack2(v[2], v[3]); *(u32x2*)(x1b + off) = w; }
        else *(f32x4*)(xout + off) = v;
      }
    }
  lds_barrier();
}

constexpr int KLD = 72;
struct KVRegs { u32x4 k[2], v[2]; };
DI void kv_load(const u16* kbase, const u16* vbase, int ldk, int ldv, int key0, KVRegs& r) {
  const int tid = otid();
#pragma unroll
  for (int i = 0; i < 2; ++i) {
    const int id = tid + 256 * i, row = id >> 3, ch = id & 7;
    r.k[i] = *(const u32x4*)(kbase + (size_t)(key0 + row) * ldk + ch * 8);
    r.v[i] = *(const u32x4*)(vbase + (size_t)(key0 + row) * ldv + ch * 8);
  }
}
DI void kv_store(u16* Ks, u16* Vs, const KVRegs& r) {
  const int tid = otid();
#pragma unroll
  for (int i = 0; i < 2; ++i) {
    const int id = tid + 256 * i, row = id >> 3, ch = id & 7;
    *(u32x4*)(Ks + row * KLD + ch * 8) = r.k[i];
    *(u32x4*)(Vs + row * KLD + ch * 8) = r.v[i];
  }
}
constexpr int KVBUF = 2 * 64 * KLD;
template <class UseF, class LoadF, class CompF>
DI void kv_pipeline(int j0, int j1, u16* buf, UseF use, LoadF load, CompF comp) {
  KVRegs kr;
  if (use(j0)) load(j0, kr);
  lds_barrier();
  if (use(j0)) kv_store(buf, buf + 64 * KLD, kr);
  if (j0 + 1 < j1 && use(j0 + 1)) load(j0 + 1, kr);
  lds_barrier();
  for (int j = j0; j < j1; ++j) {
    u16* cur = buf + ((j - j0) & 1) * KVBUF; u16* nxt = buf + (((j - j0) & 1) ^ 1) * KVBUF;
    if (j + 1 < j1 && use(j + 1)) kv_store(nxt, nxt + 64 * KLD, kr);
    if (j + 2 < j1 && use(j + 2)) load(j + 2, kr);
    if (use(j)) comp(j, cur, cur + 64 * KLD);
    lds_barrier();
  }
}
struct AttnAcc { f32x4 o[4][2]; float m[2], l[2]; f32x4 os[2]; int fresh; };
DI void attn_init(AttnAcc& a) {
#pragma unroll
  for (int d = 0; d < 4; ++d) { a.o[d][0] = (f32x4){0.f, 0.f, 0.f, 0.f}; a.o[d][1] = (f32x4){0.f, 0.f, 0.f, 0.f}; }
  a.m[0] = a.m[1] = -1e30f; a.l[0] = a.l[1] = 0.f;
}
template <int NKS>
DI void qk_tile(const u16* Ks, int dofs, const bf16x8 (&qf)[2][NKS], f32x4 (&s)[4][2], int l15, int g) {
#pragma unroll
  for (int kt = 0; kt < 4; ++kt) {
    s[kt][0] = (f32x4){0.f, 0.f, 0.f, 0.f}; s[kt][1] = (f32x4){0.f, 0.f, 0.f, 0.f};
#pragma unroll
    for (int ks = 0; ks < NKS; ++ks) {
      const bf16x8 a = ldfrag(Ks + (kt * 16 + l15) * KLD + dofs + ks * 32 + 8 * g);
      s[kt][0] = mfma16(a, qf[0][ks], s[kt][0]);
      s[kt][1] = mfma16(a, qf[1][ks], s[kt][1]);
    }
  }
}
DI void pv_accum(const bf16x8 (&pf)[2][2], const u16* Vs, f32x4 (&o)[4][2], int l15, int g) {
  const int tq = l15 >> 2, tp = l15 & 3;
#pragma unroll
  for (int kk = 0; kk < 2; ++kk)
#pragma unroll
    for (int d = 0; d < 4; ++d) {
      const bf16x8 vf = cat4(tr_read(Vs + (kk * 32 + 4 * g + tq) * KLD + d * 16 + 4 * tp), tr_read(Vs + (kk * 32 + 16 + 4 * g + tq) * KLD + d * 16 + 4 * tp));
      o[d][0] = mfma16(vf, pf[0][kk], o[d][0]);
      o[d][1] = mfma16(vf, pf[1][kk], o[d][1]);
    }
}
DI void pack_p(const f32x4 (&s)[4][2], bf16x8 (&pf)[2][2]) {
#pragma unroll
  for (int qt = 0; qt < 2; ++qt)
#pragma unroll
    for (int kk = 0; kk < 2; ++kk) {
      u32x4 w;
      w.x = pack2(s[2 * kk][qt][0], s[2 * kk][qt][1]); w.y = pack2(s[2 * kk][qt][2], s[2 * kk][qt][3]);
      w.z = pack2(s[2 * kk + 1][qt][0], s[2 * kk + 1][qt][1]); w.w = pack2(s[2 * kk + 1][qt][2], s[2 * kk + 1][qt][3]);
      pf[qt][kk] = __builtin_bit_cast(bf16x8, w);
    }
}
constexpr float DEFER_THR = 5.f;
template <class VF>
DI void softmax_pv(f32x4 (&s)[4][2], AttnAcc& a, const u16* Vs, float sc, int l15, int g, VF valid) {
  bf16x8 pf[2][2];
  float mxl[2];
#pragma unroll
  for (int qt = 0; qt < 2; ++qt) {
    float mx = -1e30f;
#pragma unroll
    for (int kt = 0; kt < 4; ++kt)
#pragma unroll
      for (int r = 0; r < 4; ++r) { const float v = valid(kt, r, qt) ? s[kt][qt][r] * sc : -1e30f; s[kt][qt][r] = v; mx = fmaxf(mx, v); }
    mxl[qt] = mx;
  }
  if (__any((mxl[0] > a.m[0] + DEFER_THR) || (mxl[1] > a.m[1] + DEFER_THR))) {
#pragma unroll
    for (int qt = 0; qt < 2; ++qt) {
      float mx = mxl[qt];
      mx = fmaxf(mx, __shfl_xor(mx, 16)); mx = fmaxf(mx, __shfl_xor(mx, 32));
      const float mn = fmaxf(a.m[qt], mx), alpha = exp2_(a.m[qt] - mn);
      a.m[qt] = mn; a.l[qt] *= alpha;
#pragma unroll
      for (int d = 0; d < 4; ++d) a.o[d][qt] *= alpha;
    }
  }
#pragma unroll
  for (int qt = 0; qt < 2; ++qt) {
    const float mn = a.m[qt];
    float ls = 0.f;
#pragma unroll
    for (int kt = 0; kt < 4; ++kt)
#pragma unroll
      for (int r = 0; r < 4; ++r) { const float v = s[kt][qt][r]; const float pv = v > -1e29f ? exp2_(v - mn) : 0.f; s[kt][qt][r] = pv; ls += pv; }
    a.l[qt] += ls;
  }
  pack_p(s, pf);
  pv_accum(pf, Vs, a.o, l15, g);
}
DI float group_sum4_(float v) { v += __shfl_xor(v, 16); v += __shfl_xor(v, 32); return v; }
DI bf16x8 scale_frag(bf16x8 f, float sc) {
  u32x4 w = __builtin_bit_cast(u32x4, f);
  w.x = pack2(bflo(w.x) * sc, bfhi(w.x) * sc); w.y = pack2(bflo(w.y) * sc, bfhi(w.y) * sc);
  w.z = pack2(bflo(w.z) * sc, bfhi(w.z) * sc); w.w = pack2(bflo(w.w) * sc, bfhi(w.w) * sc);
  return __builtin_bit_cast(bf16x8, w);
}
DI void attn_init_rel(AttnAcc& a) { attn_init(a); a.m[0] = a.m[1] = 0.f; a.os[0] = (f32x4){0.f, 0.f, 0.f, 0.f}; a.os[1] = (f32x4){0.f, 0.f, 0.f, 0.f}; a.fresh = 1; }
DI void rowsum_accum(const bf16x8 (&pf)[2][2], AttnAcc& a, int l15) {
  const short one = l15 == 0 ? (short)0x3F80 : (short)0;
  const bf16x8 ones = {one, one, one, one, one, one, one, one};
#pragma unroll
  for (int kk = 0; kk < 2; ++kk) { a.os[0] = mfma16(ones, pf[0][kk], a.os[0]); a.os[1] = mfma16(ones, pf[1][kk], a.os[1]); }
}
DI float rel_rowsum(const AttnAcc& a, int qt, int l15) { return __shfl(a.os[qt][0], l15); }
template <int NKS>
DI void qk_tile_rel(const u16* Ks, int dofs, const bf16x8 (&qf)[2][NKS], const AttnAcc& a, f32x4 (&s)[4][2], int l15, int g, bool ok0 = true, bool ok1 = true) {
  const float n0 = ok0 ? -a.m[0] : -1e30f, n1 = ok1 ? -a.m[1] : -1e30f;
#pragma unroll
  for (int kt = 0; kt < 4; ++kt) {
    s[kt][0] = (f32x4){n0, n0, n0, n0}; s[kt][1] = (f32x4){n1, n1, n1, n1};
#pragma unroll
    for (int ks = 0; ks < NKS; ++ks) {
      const bf16x8 k = ldfrag(Ks + (kt * 16 + l15) * KLD + dofs + ks * 32 + 8 * g);
      s[kt][0] = mfma16(k, qf[0][ks], s[kt][0]);
      s[kt][1] = mfma16(k, qf[1][ks], s[kt][1]);
    }
  }
}
template <int MODE, class VF>
DI void softmax_rel(f32x4 (&s)[4][2], AttnAcc& a, bf16x8 (&pf)[2][2], int l15_, VF valid, bool ok0 = true, bool ok1 = true) {
  float mxl[2];
#pragma unroll
  for (int qt = 0; qt < 2; ++qt) {
    float mx = -1e30f;
    const bool okq = qt == 0 ? ok0 : ok1;
#pragma unroll
    for (int kt = 0; kt < 4; ++kt)
#pragma unroll
      for (int r = 0; r < 4; ++r) {
        if (MODE == 1) s[kt][qt][r] = valid(kt, r, qt) ? s[kt][qt][r] : -1e30f;
        if (MODE == 2) s[kt][qt][r] = okq ? s[kt][qt][r] : -1e30f;
        mx = fmaxf(mx, s[kt][qt][r]);
      }
    mxl[qt] = mx;
  }
  if (a.fresh || __any(mxl[0] > DEFER_THR || mxl[1] > DEFER_THR)) {
    bool still = false;
#pragma unroll
    for (int qt = 0; qt < 2; ++qt) {
      float mx = mxl[qt];
      mx = fmaxf(mx, __shfl_xor(mx, 16)); mx = fmaxf(mx, __shfl_xor(mx, 32));
      const bool fresh = rel_rowsum(a, qt, l15_) == 0.f;
      const float dl = mx < -1e29f ? 0.f : (fresh ? mx : fmaxf(mx, 0.f)), alpha = exp2_(-dl);
      still = still || (fresh && mx < -1e29f);
      a.m[qt] += dl; a.os[qt] *= alpha;
#pragma unroll
      for (int d = 0; d < 4; ++d) a.o[d][qt] *= alpha;
#pragma unroll
      for (int kt = 0; kt < 4; ++kt)
#pragma unroll
        for (int r = 0; r < 4; ++r) s[kt][qt][r] -= dl;
    }
    a.fresh = __any(still) ? 1 : 0;
  }
#pragma unroll
  for (int qt = 0; qt < 2; ++qt)
#pragma unroll
    for (int kt = 0; kt < 4; ++kt)
#pragma unroll
      for (int r = 0; r < 4; ++r) s[kt][qt][r] = exp2_(s[kt][qt][r]);
  pack_p(s, pf);
}
DI float group_sum4(float v) { v += __shfl_xor(v, 16); v += __shfl_xor(v, 32); return v; }

constexpr int DSTAGE = 2 * 128 * 64;
DI int fKs(int row) { return (row >> 1) & 7; }
DI int fVs(int row) { return ((row >> 1) & 3) << 1; }
DI void kv_dma128(const u16* kbase, const u16* vbase, int ld, int key0, u16* stage, int tid) {
#pragma unroll
  for (int i = 0; i < 4; ++i) {
    const int id = tid + 256 * i, row = id >> 3, c8 = id & 7;
    __builtin_amdgcn_global_load_lds((const unsigned*)(kbase + (size_t)(key0 + row) * ld + ((c8 ^ fKs(row)) * 8)), (LDSP unsigned*)((LDSP char*)stage + id * 16), 16, 0, 0);
  }
#pragma unroll
  for (int i = 0; i < 4; ++i) {
    const int id = tid + 256 * i, row = id >> 3, c8 = id & 7;
    __builtin_amdgcn_global_load_lds((const unsigned*)(vbase + (size_t)(key0 + row) * ld + ((c8 ^ fVs(row)) * 8)), (LDSP unsigned*)((LDSP char*)(stage + 128 * 64) + id * 16), 16, 0, 0);
  }
}
template <int NKS>
DI void qk_tile_rel_sw(const u16* Kh, int dofs, const bf16x8 (&qf)[2][NKS], const AttnAcc& a, f32x4 (&s)[4][2], int l15, int g) {
  const float n0 = -a.m[0], n1 = -a.m[1];
  const int sw = (l15 >> 1) & 7;
  bf16x8 kf[4][NKS];
#pragma unroll
  for (int kt = 0; kt < 4; ++kt)
#pragma unroll
    for (int ks = 0; ks < NKS; ++ks) kf[kt][ks] = ldfrag(Kh + (kt * 16 + l15) * 64 + ((((dofs >> 3) + ks * 4 + g) ^ sw) * 8));
  if constexpr (NKS == 1) asm volatile("" : "+v"(kf[0][0]), "+v"(kf[1][0]), "+v"(kf[2][0]), "+v"(kf[3][0]));
#pragma unroll
  for (int kt = 0; kt < 4; ++kt) {
    s[kt][0] = (f32x4){n0, n0, n0, n0}; s[kt][1] = (f32x4){n1, n1, n1, n1};
#pragma unroll
    for (int ks = 0; ks < NKS; ++ks) {
      s[kt][0] = mfma16(kf[kt][ks], qf[0][ks], s[kt][0]);
      s[kt][1] = mfma16(kf[kt][ks], qf[1][ks], s[kt][1]);
    }
  }
}
DI void v_frags_sw(const u16* Vh, bf16x8 (&vf)[2][4], int l15, int g) {
  const int tq = l15 >> 2, tp = l15 & 3;
#pragma unroll
  for (int kk = 0; kk < 2; ++kk) {
    const int r0 = kk * 32 + 4 * g + tq, r1 = r0 + 16;
    const int f0 = fVs(r0), f1 = fVs(r1);
#pragma unroll
    for (int d = 0; d < 4; ++d) {
      const int lc = d * 2 + (tp >> 1);
      vf[kk][d] = cat4(tr_read(Vh + r0 * 64 + ((lc ^ f0) * 8) + (tp & 1) * 4), tr_read(Vh + r1 * 64 + ((lc ^ f1) * 8) + (tp & 1) * 4));
    }
  }
}
DI void pv_mma(const bf16x8 (&pf)[2][2], bf16x8 (&vf)[2][4], f32x4 (&o)[4][2]) {
  asm volatile("" : "+v"(vf[0][0]), "+v"(vf[0][1]), "+v"(vf[0][2]), "+v"(vf[0][3]), "+v"(vf[1][0]), "+v"(vf[1][1]), "+v"(vf[1][2]), "+v"(vf[1][3]));
#pragma unroll
  for (int kk = 0; kk < 2; ++kk)
#pragma unroll
    for (int d = 0; d < 4; ++d) {
      o[d][0] = mfma16(vf[kk][d], pf[0][kk], o[d][0]);
      o[d][1] = mfma16(vf[kk][d], pf[1][kk], o[d][1]);
    }
}
DI void diff_attn_task(const Params& p, int layer, int b, int h, int qb, unsigned char* smem) {
  u16* Ks = (u16*)smem; u16* Vs = Ks + 64 * KLD;
  const int tid = otid(), lane = tid & 63, wid = tid >> 6, l15 = lane & 15, g = lane >> 4;
  const u16* proj = (const u16*)(p.ws + OFF_PROJ) + (size_t)b * SEQ * NP;
  const int q0w = qb * 128 + wid * 32;
  const float* lam = p.diff_lam + layer * 128;
  float s01 = 0.f, s23 = 0.f;
  for (int i = 0; i < 32; ++i) { s01 += lam[i] * lam[32 + i]; s23 += lam[64 + i] * lam[96 + i]; }
  const float lam_init = layer == 0 ? 0.2f : 0.35550906759096324f;
  const float lam_full = sgprf(__expf(s01) - __expf(s23) + lam_init);
  const float sc = 0.17677669529663687f * 1.4426950408889634f;
  const int ntile = 2 * qb + 2;
  const u16* vbase = proj + PB_V + h * 64;
  f32x4 res[4][2];
#pragma unroll 1
  for (int c = 0; c < 2; ++c) {
    const u16* kbase = proj + PB_K + h * 64;
    bf16x8 qf[2][1];
#pragma unroll
    for (int qt = 0; qt < 2; ++qt) qf[qt][0] = scale_frag(ldfrag(proj + (size_t)(q0w + qt * 16 + l15) * NP + PB_Q + h * 64 + c * 32 + 8 * g), sc);
    AttnAcc a; attn_init_rel(a);
    const int nst = qb + 1;
    asm volatile("s_waitcnt vmcnt(0)" ::: "memory");
    lds_barrier();
    kv_dma128(kbase, vbase, NP, 0, Ks, tid);
    asm volatile("s_waitcnt vmcnt(0)" ::: "memory");
    lds_barrier();
    for (int js = 0; js < nst; ++js) {
      const u16* st = Ks + (js & 1) * DSTAGE;
      if (js + 1 < nst) kv_dma128(kbase, vbase, NP, (js + 1) * 128, Ks + ((js + 1) & 1) * DSTAGE, tid);
#pragma unroll 1
      for (int hf = 0; hf < 2; ++hf) {
        const int key0 = js * 128 + hf * 64;
        if (key0 <= q0w + 31) {
          f32x4 s[4][2]; bf16x8 pf[2][2];
          auto valid = [&](int kt, int r, int qt) { return key0 + kt * 16 + 4 * g + r <= q0w + qt * 16 + l15; };
          qk_tile_rel_sw<1>(st + hf * 64 * 64, c * 32, qf, a, s, l15, g);
          if (key0 + 63 <= q0w) softmax_rel<0>(s, a, pf, l15, valid); else softmax_rel<1>(s, a, pf, l15, valid);
          bf16x8 vf[2][4];
          v_frags_sw(st + 128 * 64 + hf * 64 * 64, vf, l15, g);
          pv_mma(pf, vf, a.o);
          rowsum_accum(pf, a, l15);
        }
      }
      asm volatile("s_waitcnt vmcnt(0)" ::: "memory");
      lds_barrier();
    }
#pragma unroll
    for (int qt = 0; qt < 2; ++qt) {
      const float lt = rel_rowsum(a, qt, l15);
      const float inv = c == 0 ? 1.f / lt : -lam_full / lt;
#pragma unroll
      for (int d = 0; d < 4; ++d) res[d][qt] = c == 0 ? a.o[d][qt] * inv : res[d][qt] + a.o[d][qt] * inv;
    }
  }
  u16* Y = (u16*)(p.ws + OFF_H);
  const float* ng = p.diff_norm_g + layer * 64;
#pragma unroll
  for (int qt = 0; qt < 2; ++qt) {
    float ss = 0.f;
#pragma unroll
    for (int d = 0; d < 4; ++d) { const f32x4 v = res[d][qt]; ss += v[0] * v[0] + v[1] * v[1] + v[2] * v[2] + v[3] * v[3]; }
    ss = group_sum4(ss);
    const float rn = rsqrtf(ss * (1.f / 64.f) + 1e-6f) * (1.f - lam_init);
    const int t = q0w + qt * 16 + l15;
    const size_t row = (size_t)b * SEQ + t;
#pragma unroll
    for (int d = 0; d < 4; ++d) {
      const int dd = d * 16 + 4 * g;
      const f32x4 v = res[d][qt];
      const u32x2 zz = *(const u32x2*)(proj + (size_t)t * NP + PB_Z + h * 64 + dd);
      const f32x4 gg = *(const f32x4*)(ng + dd);
      u32x2 w;
      w.x = pack2(v[0] * rn * gg[0] * siluf(bflo(zz.x)), v[1] * rn * gg[1] * siluf(bfhi(zz.x)));
      w.y = pack2(v[2] * rn * gg[2] * siluf(bflo(zz.y)), v[3] * rn * gg[3] * siluf(bfhi(zz.y)));
      *(u32x2*)(Y + row * 1024 + Y_B + h * 64 + dd) = w;
    }
  }
}

template <int NKS>
DI void qk_tile1(const u16* Ks, const bf16x8 (&qf)[NKS], f32x4 (&s)[4], int l15, int g) {
#pragma unroll
  for (int kt = 0; kt < 4; ++kt) {
    s[kt] = (f32x4){0.f, 0.f, 0.f, 0.f};
#pragma unroll
    for (int ks = 0; ks < NKS; ++ks) s[kt] = mfma16(ldfrag(Ks + (kt * 16 + l15) * KLD + ks * 32 + 8 * g), qf[ks], s[kt]);
  }
}
DI void pv_accum1(const f32x4 (&s)[4], const u16* Vs, f32x4 (&o)[4], int l15, int g) {
  const int tq = l15 >> 2, tp = l15 & 3;
#pragma unroll
  for (int kk = 0; kk < 2; ++kk) {
    u32x4 w;
    w.x = pack2(s[2 * kk][0], s[2 * kk][1]); w.y = pack2(s[2 * kk][2], s[2 * kk][3]);
    w.z = pack2(s[2 * kk + 1][0], s[2 * kk + 1][1]); w.w = pack2(s[2 * kk + 1][2], s[2 * kk + 1][3]);
    const bf16x8 pf = __builtin_bit_cast(bf16x8, w);
#pragma unroll
    for (int d = 0; d < 4; ++d) {
      const bf16x8 vf = cat4(tr_read(Vs + (kk * 32 + 4 * g + tq) * KLD + d * 16 + 4 * tp), tr_read(Vs + (kk * 32 + 16 + 4 * g + tq) * KLD + d * 16 + 4 * tp));
      o[d] = mfma16(vf, pf, o[d]);
    }
  }
}

constexpr int SEQ_LDS_A = 0, SEQ_LDS_B = 128 * KLD * 2, SEQ_LDS_C = 2 * 128 * KLD * 2, SEQ_LDS_S = 3 * 128 * KLD * 2, SEQ_LDS_F = SEQ_LDS_S + 64 * KLD * 2;
constexpr int SEQ_LDS_HALO = SEQ_LDS_F + 4096;
constexpr int SEQ_LDS_CW = SEQ_LDS_HALO + 2 * 3 * 3 * 64 * 2;
DI float wave_scan_add(float x, int lane) {
#pragma unroll
  for (int o = 1; o < 64; o <<= 1) { const float y = __shfl_up(x, o); if (lane >= o) x += y; }
  return x;
}
DI float wave_scan_max(float x, int lane) {
#pragma unroll
  for (int o = 1; o < 64; o <<= 1) { const float y = __shfl_up(x, o); if (lane >= o) x = fmaxf(x, y); }
  return x;
}

DI void seq_fix_rows(const Params& p, int layer, int r0, int nrows) {
  u16* Y = (u16*)(p.ws + OFF_H);
  const u16* proj = (const u16*)(p.ws + OFF_PROJ);
  const int tid = otid(), lane = tid & 63, wv = tid >> 6;
  const bool ml = lane >= 32;
  const int ch = (lane & 31) * 8;
  const float* ng = ml ? p.ml_norm_g + layer * 64 + (ch & 63) : p.ssm_norm_g + layer * 256 + ch;
  const f32x4 g0 = *(const f32x4*)ng, g1 = *(const f32x4*)(ng + 4);
  for (int rb = wv * 4; rb < nrows; rb += 16) {
    u32x4 yv4[4], zv4[4], ov4[4];
#pragma unroll
    for (int j = 0; j < 4; ++j) {
      const size_t row = (size_t)(r0 + rb + j);
      yv4[j] = *(const u32x4*)(Y + row * 1024 + (ml ? Y_D : Y_C) + ch);
      zv4[j] = *(const u32x4*)(proj + row * NP + (ml ? PD_Z : PC_Z) + ch);
      ov4[j] = *(const u32x4*)(proj + row * NP + PD_O + ch);
    }
    asm volatile("" : "+v"(yv4[0]), "+v"(yv4[1]), "+v"(yv4[2]), "+v"(yv4[3]), "+v"(zv4[0]), "+v"(zv4[1]), "+v"(zv4[2]), "+v"(zv4[3]), "+v"(ov4[0]), "+v"(ov4[1]), "+v"(ov4[2]), "+v"(ov4[3]));
#pragma unroll
    for (int j = 0; j < 4; ++j) {
      const size_t row = (size_t)(r0 + rb + j);
      u16* yp = Y + row * 1024 + (ml ? Y_D : Y_C) + ch;
      const u32x4 yv = yv4[j], zv = zv4[j], ov = ov4[j];
      float v[8] = {bflo(yv.x), bfhi(yv.x), bflo(yv.y), bfhi(yv.y), bflo(yv.z), bfhi(yv.z), bflo(yv.w), bfhi(yv.w)};
      float z[8] = {bflo(zv.x), bfhi(zv.x), bflo(zv.y), bfhi(zv.y), bflo(zv.z), bfhi(zv.z), bflo(zv.w), bfhi(zv.w)};
      float ss = 0.f;
      if (ml) {
        const float o[8] = {bflo(ov.x), bfhi(ov.x), bflo(ov.y), bfhi(ov.y), bflo(ov.z), bfhi(ov.z), bflo(ov.w), bfhi(ov.w)};
#pragma unroll
        for (int i = 0; i < 8; ++i) { v[i] *= sigmoidf_(o[i]); ss += v[i] * v[i]; }
      } else {
#pragma unroll
        for (int i = 0; i < 8; ++i) { v[i] *= siluf(z[i]); ss += v[i] * v[i]; }
      }
      ss += __shfl_xor(ss, 1); ss += __shfl_xor(ss, 2); ss += __shfl_xor(ss, 4);
      const float ss16 = ss + __shfl_xor(ss, 8);
      const float rn = ml ? rsqrtf(ss * (1.f / 64.f) + 1e-6f) : rsqrtf(ss16 * (1.f / 128.f) + 1e-6f);
      float o8[8];
#pragma unroll
      for (int i = 0; i < 8; ++i) { const float gg = i < 4 ? g0[i & 3] : g1[i & 3]; o8[i] = v[i] * rn * gg * (ml ? siluf(z[i]) : 1.f); }
      u32x4 w; w.x = pack2(o8[0], o8[1]); w.y = pack2(o8[2], o8[3]); w.z = pack2(o8[4], o8[5]); w.w = pack2(o8[6], o8[7]);
      *(u32x4*)yp = w;
    }
  }
}


constexpr int SEQ8_LDS_F = SEQ_LDS_S + 64 * KLD * 2;
constexpr int SEQ8_LDS_HALO = SEQ8_LDS_F + 8192;
constexpr int SEQ8_LDS_CW = SEQ8_LDS_HALO + 2 * 3 * 3 * 64 * 2;
DI void stage_conv_w8(float* wl, const float* cw, const float* cb, int chan0, int nchan, int tid) {
  if (tid < 320) { const int j = tid >> 6, cc = tid & 63; wl[tid] = j < 4 ? cw[j * nchan + chan0 + cc] : cb[chan0 + cc]; }
}
DI void scale_rows8(u16* A, const float* rs, int tid) {
  const int ch = (tid & 7) * 8;
#pragma unroll
  for (int i = 0; i < 2; ++i) {
    const int row = (tid >> 3) + 64 * i;
    const float f = rs[row];
    u32x4 v = *(u32x4*)(A + row * KLD + ch);
    v.x = pack2(bflo(v.x) * f, bfhi(v.x) * f); v.y = pack2(bflo(v.y) * f, bfhi(v.y) * f);
    v.z = pack2(bflo(v.z) * f, bfhi(v.z) * f); v.w = pack2(bflo(v.w) * f, bfhi(v.w) * f);
    *(u32x4*)(A + row * KLD + ch) = v;
  }
}
DI void state_update8(const u16* Xs, const u16* Bs, f32x4 (&acc)[2], int w8, int l15, int g) {
  const int tq = l15 >> 2, tp = l15 & 3, pt = w8 >> 1, nt0 = (w8 & 1) * 2;
#pragma unroll
  for (int kk = 0; kk < 4; ++kk) {
    const bf16x8 af = cat4(tr_read(Xs + (kk * 32 + 4 * g + tq) * KLD + pt * 16 + 4 * tp), tr_read(Xs + (kk * 32 + 16 + 4 * g + tq) * KLD + pt * 16 + 4 * tp));
#pragma unroll
    for (int n = 0; n < 2; ++n) {
      const bf16x8 bfr = cat4(tr_read(Bs + (kk * 32 + 4 * g + tq) * KLD + (nt0 + n) * 16 + 4 * tp), tr_read(Bs + (kk * 32 + 16 + 4 * g + tq) * KLD + (nt0 + n) * 16 + 4 * tp));
      acc[n] = mfma16(af, bfr, acc[n]);
    }
  }
}
DI void state_to_lds8(u16* Ss, const f32x4 (&acc)[2], int w8, int l15, int g) {
  const int pt = w8 >> 1, nt0 = (w8 & 1) * 2;
#pragma unroll
  for (int n = 0; n < 2; ++n)
#pragma unroll
    for (int r = 0; r < 4; ++r) Ss[(pt * 16 + 4 * g + r) * KLD + (nt0 + n) * 16 + l15] = f2bf(acc[n][r]);
}

constexpr int SEQ8_LDS_ZERO = SEQ8_LDS_CW + 3 * 320 * 4;
constexpr int SEQ8_LDS_RAW = ((SEQ8_LDS_ZERO + 3 * 128 + 255) / 256) * 256;
DI void raw_dma8(const u16* projb, int col0, int t0, u16* raw, int tid) {
#pragma unroll
  for (int i = 0; i < 2; ++i) {
    const int chunk = tid + 512 * i;
    __builtin_amdgcn_global_load_lds((const unsigned*)(projb + (size_t)(t0 + (chunk >> 3)) * NP + col0 + (chunk & 7) * 8), (LDSP unsigned*)((LDSP char*)raw + chunk * 16), 16, 0, 0);
  }
}
DI void conv_raw8(const u16* raw, const u16* halo, const float* wl, const float* rowscale, float cscale, u16* dst, int tid) {
  const int q = tid >> 3, ch = (tid & 7) * 8;
  u32x4 v[5];
#pragma unroll
  for (int k = 0; k < 5; ++k) { const int r = 2 * q - 3 + k; v[k] = r >= 0 ? *(const u32x4*)(raw + r * 64 + ch) : *(const u32x4*)(halo + (r + 3) * 64 + ch); }
  float w[5][8];
#pragma unroll
  for (int j = 0; j < 5; ++j) { const f32x4 w0 = *(const f32x4*)(wl + j * 64 + ch), w1 = *(const f32x4*)(wl + j * 64 + ch + 4);
    w[j][0] = w0[0]; w[j][1] = w0[1]; w[j][2] = w0[2]; w[j][3] = w0[3]; w[j][4] = w1[0]; w[j][5] = w1[1]; w[j][6] = w1[2]; w[j][7] = w1[3]; }
#pragma unroll
  for (int o = 0; o < 2; ++o) {
    float acc[8];
#pragma unroll
    for (int i = 0; i < 8; ++i) acc[i] = w[4][i];
#pragma unroll
    for (int j = 0; j < 4; ++j) {
      const u32x4 x = v[o + j];
      acc[0] += w[j][0] * bflo(x.x); acc[1] += w[j][1] * bfhi(x.x); acc[2] += w[j][2] * bflo(x.y); acc[3] += w[j][3] * bfhi(x.y);
      acc[4] += w[j][4] * bflo(x.z); acc[5] += w[j][5] * bfhi(x.z); acc[6] += w[j][6] * bflo(x.w); acc[7] += w[j][7] * bfhi(x.w);
    }
    const float rs = (rowscale ? rowscale[2 * q + o] : 1.f) * cscale;
#pragma unroll
    for (int i = 0; i < 8; ++i) acc[i] = siluf(acc[i]) * rs;
    u32x4 ov; ov.x = pack2(acc[0], acc[1]); ov.y = pack2(acc[2], acc[3]); ov.z = pack2(acc[4], acc[5]); ov.w = pack2(acc[6], acc[7]);
    *(u32x4*)(dst + (2 * q + o) * KLD + ch) = ov;
  }
}
DI void save_halo8(const u16* raw, u16* halo, int tid) {
  if (tid < 72) { const int arr = tid / 24, rem = tid % 24; *(u32x4*)(halo + arr * 192 + rem * 8) = *(const u32x4*)(raw + arr * 8192 + 125 * 64 + rem * 8); }
}

DI void ssd_task8(const Params& p, int layer, int b, int h, unsigned char* smem) {
  u16* Cs = (u16*)(smem + SEQ_LDS_A); u16* Bs = (u16*)(smem + SEQ_LDS_B); u16* Xs = (u16*)(smem + SEQ_LDS_C); u16* Ss = (u16*)(smem + SEQ_LDS_S);
  float* fl = (float*)(smem + SEQ8_LDS_F);
  float* dts = fl; float* acs = fl + 128; float* wend = fl + 256; float* tmp = fl + 384;
  u16* halo = (u16*)(smem + SEQ8_LDS_HALO); float* cwl = (float*)(smem + SEQ8_LDS_CW); u16* zero3 = (u16*)(smem + SEQ8_LDS_ZERO);
  u16* raw = (u16*)(smem + SEQ8_LDS_RAW);
  int tid = otid512(), lane = tid & 63, w = tid >> 6, l15 = lane & 15, g = lane >> 4;
  const int gi = h >> 1;
  const u16* projb = (const u16*)(p.ws + OFF_PROJ) + (size_t)b * SEQ * NP;
  const float* smb = (const float*)(p.ws + OFF_SMALL) + (size_t)b * SEQ * NSMALL;
  const float* cw = p.ssm_conv_w + layer * 4 * 512; const float* cb = p.ssm_conv_b + layer * 512;
  u16* Y = (u16*)(p.ws + OFF_H);
  const float a_h = sgprf(-__expf(p.ssm_a_log[layer * 4 + h])), d_h = sgprf(p.ssm_d[layer * 4 + h]), dtb = sgprf(p.ssm_dt_bias[layer * 4 + h]);
  const int colB = PC_XBC + 256 + gi * 64, colC = PC_XBC + 384 + gi * 64, colX = PC_XBC + h * 64;
  f32x4 st[2] = {(f32x4){0.f, 0.f, 0.f, 0.f}, (f32x4){0.f, 0.f, 0.f, 0.f}};
  lds_barrier();
  stage_conv_w8(cwl, cw, cb, 256 + gi * 64, 512, tid);
  stage_conv_w8(cwl + 320, cw, cb, 384 + gi * 64, 512, tid);
  stage_conv_w8(cwl + 640, cw, cb, h * 64, 512, tid);
  if (tid < 96) ((unsigned*)zero3)[tid] = 0u;
  raw_dma8(projb, colB, 0, raw, tid); raw_dma8(projb, colC, 0, raw + 8192, tid); raw_dma8(projb, colX, 0, raw + 16384, tid);
  float dtraw = 0.f;
  if (tid < 128) dtraw = smb[(size_t)tid * NSMALL + SM_DT + h];
#pragma unroll 1
  for (int c = 0; c < 32; ++c) {
    const int t0 = c * 128;
    asm volatile("" : "+v"(tid)); lane = tid & 63; w = tid >> 6; l15 = lane & 15; g = lane >> 4;
    float dtv = 0.f;
    if (tid < 128) { const float xr = dtraw + dtb; dtv = xr > 15.f ? xr : (xr < -15.f ? __expf(xr) : __logf(1.f + __expf(xr))); }
    float cs = wave_scan_add(dtv * a_h, lane);
    if (tid == 63) tmp[0] = cs;
    asm volatile("s_waitcnt vmcnt(0)" ::: "memory");
    lds_barrier();
    if (w == 1) cs += tmp[0];
    if (tid < 128) { dts[tid] = dtv; acs[tid] = cs; }
    if (c + 1 < 32 && tid < 128) dtraw = smb[(size_t)(t0 + 128 + tid) * NSMALL + SM_DT + h];
    lds_barrier();
    {
      const u16* hc = halo + (c & 1) * 576;
      const u16* hB = c == 0 ? zero3 : hc; const u16* hC = c == 0 ? zero3 : hc + 192; const u16* hX = c == 0 ? zero3 : hc + 384;
      conv_raw8(raw, hB, cwl, nullptr, 1.f, Bs, tid);
      conv_raw8(raw + 8192, hC, cwl + 320, nullptr, 1.f, Cs, tid);
      conv_raw8(raw + 16384, hX, cwl + 640, dts, 1.f, Xs, tid);
      save_halo8(raw, halo + ((c + 1) & 1) * 576, tid);
    }
    if (tid < 128) wend[tid] = __expf(acs[127] - acs[tid]);
    state_to_lds8(Ss, st, w, l15, g);
    lds_barrier();
    if (c + 1 < 32) { raw_dma8(projb, colB, t0 + 128, raw, tid); raw_dma8(projb, colC, t0 + 128, raw + 8192, tid); raw_dma8(projb, colX, t0 + 128, raw + 16384, tid); }
    {
      const int tl = 16 * w + l15;
      bf16x8 cf[2];
#pragma unroll
      for (int ks = 0; ks < 2; ++ks) cf[ks] = ldfrag(Cs + tl * KLD + ks * 32 + 8 * g);
      f32x4 y[4];
#pragma unroll
      for (int d = 0; d < 4; ++d) y[d] = (f32x4){0.f, 0.f, 0.f, 0.f};
      const float at = acs[tl];
#pragma unroll 1
      for (int stl = 0; stl < 2; ++stl) {
        if (stl * 64 <= 16 * w + 15) {
          f32x4 sc[4];
          qk_tile1<2>(Bs + stl * 64 * KLD, cf, sc, l15, g);
#pragma unroll
          for (int kt = 0; kt < 4; ++kt) {
            const f32x4 as = *(const f32x4*)(acs + stl * 64 + kt * 16 + 4 * g);
#pragma unroll
            for (int r = 0; r < 4; ++r) {
              const bool ok = stl * 64 + kt * 16 + 4 * g + r <= tl;
              sc[kt][r] = ok ? sc[kt][r] * __expf(at - as[r]) : 0.f;
            }
          }
          pv_accum1(sc, Xs + stl * 64 * KLD, y, l15, g);
        }
      }
      const float ea = __expf(at), dsk = d_h / dts[tl];
      const size_t row = (size_t)b * SEQ + t0 + tl;
#pragma unroll
      for (int d = 0; d < 4; ++d) {
        f32x4 yo = (f32x4){0.f, 0.f, 0.f, 0.f};
#pragma unroll
        for (int ks = 0; ks < 2; ++ks) yo = mfma16(ldfrag(Ss + (d * 16 + l15) * KLD + ks * 32 + 8 * g), cf[ks], yo);
        const u32x2 xv = *(const u32x2*)(Xs + tl * KLD + d * 16 + 4 * g);
        const f32x4 v = y[d] + yo * ea;
        u32x2 o; o.x = pack2(v[0] + dsk * bflo(xv.x), v[1] + dsk * bfhi(xv.x)); o.y = pack2(v[2] + dsk * bflo(xv.y), v[3] + dsk * bfhi(xv.y));
        *(u32x2*)(Y + row * 1024 + Y_C + h * 64 + d * 16 + 4 * g) = o;
      }
    }
    lds_barrier();
    scale_rows8(Xs, wend, tid);
    lds_barrier();
    const float cd = __expf(acs[127]);
    st[0] *= cd; st[1] *= cd;
    state_update8(Xs, Bs, st, w, l15, g);
  }
  asm volatile("s_waitcnt vmcnt(0)" ::: "memory");
}

DI void mlstm_task8(const Params& p, int layer, int b, int h, unsigned char* smem) {
  u16* Qs = (u16*)(smem + SEQ_LDS_A); u16* Ks2 = (u16*)(smem + SEQ_LDS_B); u16* Vs2 = (u16*)(smem + SEQ_LDS_C); u16* Cst = (u16*)(smem + SEQ_LDS_S);
  float* fl = (float*)(smem + SEQ8_LDS_F);
  float* bcs = fl; float* us = fl + 128; float* pms = fl + 256; float* wend = fl + 384; float* nst = fl + 512; float* tmp = fl + 576; float* npart = fl + 640;
  u16* halo = (u16*)(smem + SEQ8_LDS_HALO); float* cwl = (float*)(smem + SEQ8_LDS_CW); u16* zero3 = (u16*)(smem + SEQ8_LDS_ZERO);
  u16* raw = (u16*)(smem + SEQ8_LDS_RAW);
  int tid = otid512(), lane = tid & 63, w = tid >> 6, l15 = lane & 15, g = lane >> 4;
  const u16* projb = (const u16*)(p.ws + OFF_PROJ) + (size_t)b * SEQ * NP;
  const float* smb = (const float*)(p.ws + OFF_SMALL) + (size_t)b * SEQ * NSMALL;
  const float* cw = p.ml_conv_w + layer * 4 * 512; const float* cb = p.ml_conv_b + layer * 512;
  const float ib = sgprf(p.ml_if_b[layer * 8 + h]), fb = sgprf(p.ml_if_b[layer * 8 + 4 + h]);
  u16* Y = (u16*)(p.ws + OFF_H);
  const int colQ = PD_QK + h * 64, colK = PD_QK + 256 + h * 64, colV = PD_V + h * 64;
  f32x4 st[2] = {(f32x4){0.f, 0.f, 0.f, 0.f}, (f32x4){0.f, 0.f, 0.f, 0.f}};
  float m_prev = 0.f;
  lds_barrier();
  if (tid < 64) nst[tid] = 0.f;
  stage_conv_w8(cwl, cw, cb, h * 64, 512, tid);
  stage_conv_w8(cwl + 320, cw, cb, 256 + h * 64, 512, tid);
  if (tid < 96) ((unsigned*)zero3)[tid] = 0u;
  raw_dma8(projb, colQ, 0, raw, tid); raw_dma8(projb, colK, 0, raw + 8192, tid); raw_dma8(projb, colV, 0, raw + 16384, tid);
  float iraw = 0.f, fraw = 0.f;
  if (tid < 128) { iraw = smb[(size_t)tid * NSMALL + SM_IF + h]; fraw = smb[(size_t)tid * NSMALL + SM_IF + 4 + h]; }
#pragma unroll 1
  for (int c = 0; c < 32; ++c) {
    const int t0 = c * 128;
    asm volatile("" : "+v"(tid)); lane = tid & 63; w = tid >> 6; l15 = lane & 15; g = lane >> 4;
    float ip = 0.f, lf = 0.f;
    if (tid < 128) { ip = iraw + ib; const float fp = fraw + fb; lf = fminf(fp, 0.f) - __logf(1.f + __expf(-fabsf(fp))); }
    float bc = wave_scan_add(lf, lane);
    if (tid == 63) tmp[0] = bc;
    asm volatile("s_waitcnt vmcnt(0)" ::: "memory");
    lds_barrier();
    if (w == 1) bc += tmp[0];
    const float u = tid < 128 ? ip - bc : -1e30f;
    float pm = wave_scan_max(u, lane);
    if (tid == 63) tmp[1] = pm;
    if (c + 1 < 32 && tid < 128) { iraw = smb[(size_t)(t0 + 128 + tid) * NSMALL + SM_IF + h]; fraw = smb[(size_t)(t0 + 128 + tid) * NSMALL + SM_IF + 4 + h]; }
    {
      const u16* hc = halo + (c & 1) * 576;
      const u16* hQ = c == 0 ? zero3 : hc; const u16* hK = c == 0 ? zero3 : hc + 192;
      conv_raw8(raw, hQ, cwl, nullptr, 1.f, Qs, tid);
      conv_raw8(raw + 8192, hK, cwl + 320, nullptr, 0.125f, Ks2, tid);
      save_halo8(raw, halo + ((c + 1) & 1) * 576, tid);
#pragma unroll
      for (int i = 0; i < 2; ++i) { const int chunk = tid + 512 * i; *(u32x4*)(Vs2 + (chunk >> 3) * KLD + (chunk & 7) * 8) = *(const u32x4*)(raw + 16384 + chunk * 8); }
    }
    state_to_lds8(Cst, st, w, l15, g);
    lds_barrier();
    if (w == 1) pm = fmaxf(pm, tmp[1]);
    if (tid < 128) { bcs[tid] = bc; us[tid] = u; pms[tid] = pm; }
    if (c + 1 < 32) { raw_dma8(projb, colQ, t0 + 128, raw, tid); raw_dma8(projb, colK, t0 + 128, raw + 8192, tid); raw_dma8(projb, colV, t0 + 128, raw + 16384, tid); }
    lds_barrier();
    const float blast = bcs[127];
    const float m_new = blast + fmaxf(m_prev, pms[127]);
    if (tid < 128) wend[tid] = __expf(blast - m_new + us[tid]);
    {
      const int tl = 16 * w + l15;
      bf16x8 qf[2];
#pragma unroll
      for (int ks = 0; ks < 2; ++ks) qf[ks] = ldfrag(Qs + tl * KLD + ks * 32 + 8 * g);
      f32x4 num[4];
#pragma unroll
      for (int d = 0; d < 4; ++d) num[d] = (f32x4){0.f, 0.f, 0.f, 0.f};
      const float bt = bcs[tl], mt = bt + fmaxf(m_prev, pms[tl]);
      float den = 0.f;
#pragma unroll 1
      for (int stl = 0; stl < 2; ++stl) {
        if (stl * 64 <= 16 * w + 15) {
          f32x4 sc[4];
          qk_tile1<2>(Ks2 + stl * 64 * KLD, qf, sc, l15, g);
#pragma unroll
          for (int kt = 0; kt < 4; ++kt) {
            const f32x4 uu = *(const f32x4*)(us + stl * 64 + kt * 16 + 4 * g);
#pragma unroll
            for (int r = 0; r < 4; ++r) {
              const bool ok = stl * 64 + kt * 16 + 4 * g + r <= tl;
              const float v = ok ? sc[kt][r] * __expf(bt - mt + uu[r]) : 0.f;
              sc[kt][r] = v; den += v;
            }
          }
          pv_accum1(sc, Vs2 + stl * 64 * KLD, num, l15, g);
        }
      }
      const float wi = __expf(bt + m_prev - mt);
      float qn = 0.f;
#pragma unroll
      for (int ks = 0; ks < 2; ++ks)
#pragma unroll
        for (int j = 0; j < 8; ++j) qn += bf2f((u16)qf[ks][j]) * nst[ks * 32 + 8 * g + j];
      qn = group_sum4(qn);
      const float dn = group_sum4(den) + wi * qn;
      const float inv = __builtin_amdgcn_rcpf(fmaxf(fabsf(dn), __expf(-mt)));
      const size_t row = (size_t)b * SEQ + t0 + tl;
#pragma unroll
      for (int d = 0; d < 4; ++d) {
        f32x4 ni = (f32x4){0.f, 0.f, 0.f, 0.f};
#pragma unroll
        for (int ks = 0; ks < 2; ++ks) ni = mfma16(ldfrag(Cst + (d * 16 + l15) * KLD + ks * 32 + 8 * g), qf[ks], ni);
        const f32x4 v = (num[d] + ni * wi) * inv;
        u32x2 o; o.x = pack2(v[0], v[1]); o.y = pack2(v[2], v[3]);
        *(u32x2*)(Y + row * 1024 + Y_D + h * 64 + d * 16 + 4 * g) = o;
      }
    }
    lds_barrier();
    scale_rows8(Ks2, wend, tid);
    lds_barrier();
    const float fprev = __expf(blast + m_prev - m_new);
    st[0] *= fprev; st[1] *= fprev;
    state_update8(Vs2, Ks2, st, w, l15, g);
    {
      const int e = tid & 63, part = tid >> 6;
      float a = 0.f;
#pragma unroll
      for (int s2 = 0; s2 < 16; ++s2) a += bf2f(Ks2[(part * 16 + s2) * KLD + e]);
      npart[part * 64 + e] = a;
    }
    lds_barrier();
    if (tid < 64) {
      float a = nst[tid] * fprev;
#pragma unroll
      for (int pp = 0; pp < 8; ++pp) a += npart[pp * 64 + tid];
      nst[tid] = a;
    }
    m_prev = m_new;
  }
  asm volatile("s_waitcnt vmcnt(0)" ::: "memory");
}

DI void compress_task(const Params& p, int layer, int b, int kv, int rb, unsigned char* smem) {
  constexpr int HLD = 136;
  u16* Hs = (u16*)smem;
  const int tid = otid(), lane = tid & 63, w = tid >> 6, l15 = lane & 15, g = lane >> 4;
  const u16* projb = (const u16*)(p.ws + OFF_PROJ) + (size_t)b * SEQ * NP + (kv ? PA_VC : PA_KC);
  const int mi = layer * 2 + kv;
  const u16* W1T = (const u16*)(p.ws + OFF_W1T) + (size_t)mi * 128 * 2048;
  const u16* W2T = (const u16*)(p.ws + OFF_W2T) + (size_t)mi * 64 * 128;
  const float* bias1 = (const float*)(p.ws + OFF_BIAS1) + mi * 16 * 128;
  f32x4 acc[2][2];
#pragma unroll
  for (int nt = 0; nt < 2; ++nt) { acc[nt][0] = (f32x4){0.f, 0.f, 0.f, 0.f}; acc[nt][1] = (f32x4){0.f, 0.f, 0.f, 0.f}; }
  int tok[2];
#pragma unroll
  for (int mt = 0; mt < 2; ++mt) { int i = rb * 32 + mt * 16 + l15; if (i > 254) i = 254; tok[mt] = 16 * i; }
#pragma unroll 4
  for (int ks = 0; ks < 64; ++ks) {
    const int j = ks >> 1, d0 = (ks & 1) * 32;
    bf16x8 af[2], wf[2];
#pragma unroll
    for (int mt = 0; mt < 2; ++mt) af[mt] = ldfrag(projb + (size_t)(tok[mt] + j) * NP + d0 + 8 * g);
#pragma unroll
    for (int nt = 0; nt < 2; ++nt) wf[nt] = ldfrag(W1T + (size_t)(w * 32 + nt * 16 + l15) * 2048 + ks * 32 + 8 * g);
#pragma unroll
    for (int nt = 0; nt < 2; ++nt)
#pragma unroll
      for (int mt = 0; mt < 2; ++mt) acc[nt][mt] = mfma16(wf[nt], af[mt], acc[nt][mt]);
  }
  lds_barrier();
#pragma unroll
  for (int nt = 0; nt < 2; ++nt) {
    const int n = w * 32 + nt * 16 + 4 * g;
    f32x4 bp[16];
#pragma unroll
    for (int pc = 0; pc < 16; ++pc) bp[pc] = *(const f32x4*)(bias1 + pc * 128 + n);
#pragma unroll
    for (int pc = 0; pc < 16; pc += 4) asm volatile("" : "+v"(bp[pc]), "+v"(bp[pc + 1]), "+v"(bp[pc + 2]), "+v"(bp[pc + 3]));
    f32x4 bb = bp[0];
#pragma unroll
    for (int pc = 1; pc < 16; ++pc) bb += bp[pc];
#pragma unroll
    for (int mt = 0; mt < 2; ++mt) {
      const f32x4 v = acc[nt][mt] + bb;
      u32x2 o; o.x = pack2(siluf(v[0]), siluf(v[1])); o.y = pack2(siluf(v[2]), siluf(v[3]));
      *(u32x2*)(Hs + (mt * 16 + l15) * HLD + n) = o;
    }
  }
  lds_barrier();
  f32x4 acc2[2] = {(f32x4){0.f, 0.f, 0.f, 0.f}, (f32x4){0.f, 0.f, 0.f, 0.f}};
#pragma unroll
  for (int ks = 0; ks < 4; ++ks) {
    const bf16x8 wf = ldfrag(W2T + (size_t)(w * 16 + l15) * 128 + ks * 32 + 8 * g);
#pragma unroll
    for (int mt = 0; mt < 2; ++mt) acc2[mt] = mfma16(wf, ldfrag(Hs + (mt * 16 + l15) * HLD + ks * 32 + 8 * g), acc2[mt]);
  }
  u16* dst = (u16*)(p.ws + (kv ? OFF_VCMP : OFF_KCMP) + (size_t)layer * 512 * 1024) + (size_t)b * 256 * 64;
#pragma unroll
  for (int mt = 0; mt < 2; ++mt) {
    const int i = rb * 32 + mt * 16 + l15;
    u32x2 o; o.x = pack2(acc2[mt][0], acc2[mt][1]); o.y = pack2(acc2[mt][2], acc2[mt][3]);
    if (i > 254) { o.x = 0u; o.y = 0u; }
    *(u32x2*)(dst + (size_t)i * 64 + w * 16 + 4 * g) = o;
  }
}

DI void nsa_task(const Params& p, int layer, int b, int qi, unsigned char* smem) {
  u16* Ks = (u16*)smem; u16* Vs = Ks + 64 * KLD;
  float* T = (float*)(smem + 2 * KVBUF * 2);
  unsigned long long* selm = (unsigned long long*)(smem + 2 * KVBUF * 2 + 4 * 32 * 65 * 4);
  const int tid = otid(), lane = tid & 63, h = tid >> 6, l15 = lane & 15, g = lane >> 4;
  const int q0 = qi * 32;
  const u16* projb = (const u16*)(p.ws + OFF_PROJ) + (size_t)b * SEQ * NP;
  const float* smb = (const float*)(p.ws + OFF_SMALL) + (size_t)b * SEQ * NSMALL;
  const u16* kcmp = (const u16*)(p.ws + OFF_KCMP + (size_t)layer * 512 * 1024) + (size_t)b * 256 * 64;
  const u16* vcmp = (const u16*)(p.ws + OFF_VCMP + (size_t)layer * 512 * 1024) + (size_t)b * 256 * 64;
  bf16x8 qf[2][2];
#pragma unroll
  for (int qt = 0; qt < 2; ++qt)
#pragma unroll
    for (int ks = 0; ks < 2; ++ks) qf[qt][ks] = ldfrag(projb + (size_t)(q0 + qt * 16 + l15) * NP + PA_Q + h * 64 + ks * 32 + 8 * g);
  const float sc = 0.125f * 1.4426950408889634f;
  f32x4 outacc[4][2];
  AttnAcc a;
  const int ntc = (q0 >> 10) + 1;
  attn_init(a);
  lds_barrier();
  for (int i = tid; i < 4 * 32 * 65; i += 256) T[i] = 0.f;
  kv_pipeline(0, ntc, Ks,
    [&](int) { return true; },
    [&](int j, KVRegs& kr) { kv_load(kcmp, vcmp, 64, 64, j * 64, kr); },
    [&](int j, const u16* Kt, const u16* Vt) {
      f32x4 s[4][2];
      auto valid = [&](int kt, int r, int qt) { return 16 * (j * 64 + kt * 16 + 4 * g + r) + 31 <= q0 + qt * 16 + l15; };
      qk_tile<2>(Kt, 0, qf, s, l15, g);
      softmax_pv(s, a, Vt, sc, l15, g, valid);
    });
  float cinv[2];
#pragma unroll
  for (int qt = 0; qt < 2; ++qt) {
    const float lt = group_sum4(a.l[qt]);
    cinv[qt] = lt > 0.f ? 1.f / lt : 0.f;
    const float gt = sigmoidf_(smb[(size_t)(q0 + qt * 16 + l15) * NSMALL + SM_G + h * 3 + 0]) * cinv[qt];
#pragma unroll
    for (int d = 0; d < 4; ++d) outacc[d][qt] = a.o[d][qt] * gt;
  }
  float carry[2] = {0.f, 0.f};
  kv_pipeline(0, ntc, Ks,
    [&](int) { return true; },
    [&](int j, KVRegs& kr) { kv_load(kcmp, vcmp, 64, 64, j * 64, kr); },
    [&](int j, const u16* Kt, const u16*) {
      f32x4 s[4][2];
      qk_tile<2>(Kt, 0, qf, s, l15, g);
#pragma unroll
      for (int qt = 0; qt < 2; ++qt) {
        float prev3 = carry[qt];
#pragma unroll
        for (int kt = 0; kt < 4; ++kt) {
          float pr[4];
#pragma unroll
          for (int r = 0; r < 4; ++r) {
            const bool ok = 16 * (j * 64 + kt * 16 + 4 * g + r) + 31 <= q0 + qt * 16 + l15;
            pr[r] = ok ? exp2_(s[kt][qt][r] * sc - a.m[qt]) * cinv[qt] : 0.f;
          }
          const float below = __shfl_up(pr[3], 16);
          const float wrap = __shfl(prev3, l15 + 48);
          const float nb = g > 0 ? below : wrap;
          T[(h * 32 + qt * 16 + l15) * 65 + j * 16 + kt * 4 + g] = (pr[0] + pr[1]) + (pr[2] + 0.5f * pr[3]) + 0.5f * nb;
          prev3 = pr[3];
        }
        carry[qt] = prev3;
      }
    });
  lds_barrier();
#pragma unroll 1
  for (int qq = 0; qq < 8; ++qq) {
    const int q = h * 8 + qq, t = q0 + q, cur = t >> 6;
    const float imp = ((T[(0 * 32 + q) * 65 + lane] + T[(1 * 32 + q) * 65 + lane]) + T[(2 * 32 + q) * 65 + lane]) + T[(3 * 32 + q) * 65 + lane];
    const bool forced = lane == cur || lane == 0, allowed = lane <= cur, cand = allowed && !forced;
    const int K = cur == 0 ? 15 : 14;
    unsigned long long m;
    if (__popcll(__ballot(cand)) <= K) m = __ballot(allowed);
    else {
      const unsigned key = __float_as_uint(imp);
      unsigned prefix = 0u;
#pragma unroll 1
      for (int bit = 30; bit >= 0; --bit) {
        const unsigned cnd = prefix | (1u << bit);
        if (__popcll(__ballot(cand && key >= cnd)) >= K) prefix = cnd;
      }
      const unsigned long long gt = __ballot(cand && key > prefix), eq = __ballot(cand && key == prefix);
      const int need = K - __popcll(gt);
      const int myrank = __popcll(eq & ((1ull << lane) - 1ull));
      m = gt | __ballot(cand && key == prefix && myrank < need) | __ballot(forced);
    }
    if (lane == 0) selm[q] = m;
  }
  lds_barrier();
  f32x4* park = (f32x4*)T + (h * 8) * 64 + lane;
#pragma unroll
  for (int d = 0; d < 4; ++d) { park[(d * 2 + 0) * 64] = outacc[d][0]; park[(d * 2 + 1) * 64] = outacc[d][1]; }
  unsigned long long mq[2], anym = 0ull;
#pragma unroll
  for (int qt = 0; qt < 2; ++qt) mq[qt] = selm[qt * 16 + l15];
  for (int i = 0; i < 32; ++i) anym |= selm[i];
  const int jhi = (q0 + 31) >> 6;
#pragma unroll
  for (int qt = 0; qt < 2; ++qt)
#pragma unroll
    for (int ks = 0; ks < 2; ++ks) qf[qt][ks] = scale_frag(qf[qt][ks], sc);
  attn_init_rel(a);
  kv_pipeline(0, jhi + 1, Ks,
    [&](int j) { return (bool)((anym >> j) & 1ull); },
    [&](int j, KVRegs& kr) { kv_load(projb + PA_KS, projb + PA_VS, NP, NP, j * 64, kr); },
    [&](int j, const u16* Kt, const u16* Vt) {
      f32x4 s[4][2];
      auto valid = [&](int kt, int r, int qt) { return ((mq[qt] >> j) & 1ull) && (j * 64 + kt * 16 + 4 * g + r <= q0 + qt * 16 + l15); };
      bf16x8 pf[2][2];
      if (j * 64 + 63 <= q0) {
        qk_tile_rel<2>(Kt, 0, qf, a, s, l15, g, (bool)((mq[0] >> j) & 1ull), (bool)((mq[1] >> j) & 1ull));
        softmax_rel<0>(s, a, pf, l15, valid);
      } else {
        qk_tile_rel<2>(Kt, 0, qf, a, s, l15, g);
        softmax_rel<1>(s, a, pf, l15, valid);
      }
      pv_accum(pf, Vt, a.o, l15, g);
      rowsum_accum(pf, a, l15);
    });
#pragma unroll
  for (int qt = 0; qt < 2; ++qt) {
    const float lt = rel_rowsum(a, qt, l15);
    const float gt = sigmoidf_(smb[(size_t)(q0 + qt * 16 + l15) * NSMALL + SM_G + h * 3 + 1]) * (lt > 0.f ? 1.f / lt : 0.f);
#pragma unroll
    for (int d = 0; d < 4; ++d) park[(d * 2 + qt) * 64] += a.o[d][qt] * gt;
  }
  attn_init_rel(a);
  const int jlo = q0 >= 511 ? (q0 - 511) >> 6 : 0;
  kv_pipeline(jlo, jhi + 1, Ks,
    [&](int) { return true; },
    [&](int j, KVRegs& kr) { kv_load(projb + PA_KW, projb + PA_VW, NP, NP, j * 64, kr); },
    [&](int j, const u16* Kt, const u16* Vt) {
      f32x4 s[4][2];
      auto valid = [&](int kt, int r, int qt) { const int key = j * 64 + kt * 16 + 4 * g + r, t = q0 + qt * 16 + l15; return key <= t && key + 512 > t; };
      bf16x8 pf[2][2];
      qk_tile_rel<2>(Kt, 0, qf, a, s, l15, g);
      if (j * 64 + 63 <= q0 && j * 64 + 512 > q0 + 31) softmax_rel<0>(s, a, pf, l15, valid);
      else softmax_rel<1>(s, a, pf, l15, valid);
      pv_accum(pf, Vt, a.o, l15, g);
      rowsum_accum(pf, a, l15);
    });
  u16* Y = (u16*)(p.ws + OFF_H);
  const float* ng = p.nsa_norm_g + layer * 64;
#pragma unroll
  for (int qt = 0; qt < 2; ++qt) {
    const int t = q0 + qt * 16 + l15;
    const float lt = rel_rowsum(a, qt, l15);
    const float gt = sigmoidf_(smb[(size_t)t * NSMALL + SM_G + h * 3 + 2]) * (lt > 0.f ? 1.f / lt : 0.f);
    f32x4 v[4]; float ss = 0.f;
#pragma unroll
    for (int d = 0; d < 4; ++d) { v[d] = park[(d * 2 + qt) * 64] + a.o[d][qt] * gt; ss += v[d][0] * v[d][0] + v[d][1] * v[d][1] + v[d][2] * v[d][2] + v[d][3] * v[d][3]; }
    ss = group_sum4(ss);
    const float rn = rsqrtf(ss * (1.f / 64.f) + 1e-6f);
    const size_t row = (size_t)b * SEQ + t;
#pragma unroll
    for (int d = 0; d < 4; ++d) {
      const int dd = d * 16 + 4 * g;
      const u32x2 zz = *(const u32x2*)(projb + (size_t)t * NP + PA_Z + h * 64 + dd);
      const f32x4 gg = *(const f32x4*)(ng + dd);
      u32x2 o;
      o.x = pack2(v[d][0] * rn * gg[0] * siluf(bflo(zz.x)), v[d][1] * rn * gg[1] * siluf(bfhi(zz.x)));
      o.y = pack2(v[d][2] * rn * gg[2] * siluf(bflo(zz.y)), v[d][3] * rn * gg[3] * siluf(bfhi(zz.y)));
      *(u32x2*)(Y + row * 1024 + Y_A + h * 64 + dd) = o;
    }
  }
}


DI void final_norm_rows(const Params& p, int rbase, int nrows, int gw, int nw, int lane) {
  const float4* gp = (const float4*)p.final_g;
  float4 gg[4];
#pragma unroll
  for (int i = 0; i < 4; ++i) gg[i] = gp[lane + 64 * i];
  for (int row0 = rbase + gw * 4; row0 < rbase + nrows; row0 += nw * 4) {
    f32x4 v[4][4]; float ss[4];
#pragma unroll
    for (int j = 0; j < 4; ++j) {
      const f32x4* xr = (const f32x4*)(p.out + (size_t)(row0 + j) * D_MODEL);
#pragma unroll
      for (int i = 0; i < 4; ++i) v[j][i] = xr[lane + 64 * i];
    }
    asm volatile("" : "+v"(v[0][0]), "+v"(v[0][1]), "+v"(v[0][2]), "+v"(v[0][3]), "+v"(v[1][0]), "+v"(v[1][1]), "+v"(v[1][2]), "+v"(v[1][3]), "+v"(v[2][0]), "+v"(v[2][1]), "+v"(v[2][2]), "+v"(v[2][3]), "+v"(v[3][0]), "+v"(v[3][1]), "+v"(v[3][2]), "+v"(v[3][3]));
#pragma unroll
    for (int j = 0; j < 4; ++j) {
      float a = 0.f;
#pragma unroll
      for (int i = 0; i < 4; ++i) a += v[j][i][0] * v[j][i][0] + v[j][i][1] * v[j][i][1] + v[j][i][2] * v[j][i][2] + v[j][i][3] * v[j][i][3];
      ss[j] = wave_sum(a);
    }
#pragma unroll
    for (int j = 0; j < 4; ++j) {
      float4* xr = (float4*)(p.out + (size_t)(row0 + j) * D_MODEL);
      const float r = rsqrtf(ss[j] * (1.f / D_MODEL) + 1e-6f);
#pragma unroll
      for (int i = 0; i < 4; ++i) { float4 w; w.x = v[j][i][0] * r * gg[i].x; w.y = v[j][i][1] * r * gg[i].y; w.z = v[j][i][2] * r * gg[i].z; w.w = v[j][i][3] * r * gg[i].w; xr[lane + 64 * i] = w; }
    }
  }
}

#define XB_TMO      128
#define XB_XCNT(j)  (256  + 64 * (j))
#define XB_XSUB(j)  (1280 + 64 * (j))
#define XB_XGEN(j)  (2304 + 64 * (j))
#define XB_TOP      3328
#define XB_TOPGEN   3392
#define XCD_BAR_WORDS 3456
#define XB_SPIN_CAP (1u << 23)
DI unsigned xb_ld(unsigned* p)              { return __hip_atomic_load(p, __ATOMIC_RELAXED, __HIP_MEMORY_SCOPE_AGENT); }
DI unsigned xb_add(unsigned* p, unsigned v) { return __hip_atomic_fetch_add(p, v, __ATOMIC_RELAXED, __HIP_MEMORY_SCOPE_AGENT); }
DI unsigned xb_xcc_id() { return (unsigned)__builtin_amdgcn_s_getreg((3 << 11) | 20) & 0xFu; }
#define XB_SPIN(cond, bar) do { unsigned _sp = 0; while (cond) { __builtin_amdgcn_s_sleep(1); \
    if ((++_sp & 255u) == 0u) { if (xb_ld(&(bar)[XB_TMO])) break; if (_sp > XB_SPIN_CAP) { atomicAdd(&(bar)[XB_TMO], 1u); break; } } } } while (0)
struct XcdBarrier { unsigned* bar; unsigned x; volatile LDSP unsigned* st; };
DI XcdBarrier xcd_barrier_post(unsigned* bar, volatile LDSP unsigned* st) {
  XcdBarrier b; b.bar = bar; b.x = xb_xcc_id(); b.st = st;
  if (threadIdx.x == 0) (void)xb_add(&bar[XB_XCNT(b.x)], 1u);
  return b;
}
DI void xcd_barrier_complete(unsigned* bar, unsigned x, unsigned& nloc, unsigned& nx) {
  const unsigned G = gridDim.x * gridDim.y * gridDim.z;
  unsigned sum, cnt, mine, sp = 0u;
  for (;;) {
    sum = 0u; cnt = 0u; mine = 0u;
#pragma unroll
    for (unsigned j = 0; j < 16; ++j) { const unsigned c = xb_ld(&bar[XB_XCNT(j)]); sum += c; cnt += (c > 0u) ? 1u : 0u; mine = (j == x) ? c : mine; }
    if (sum == G) break;
    __builtin_amdgcn_s_sleep(1);
    if ((++sp & 255u) == 0u) { if (xb_ld(&bar[XB_TMO])) break; if (sp > XB_SPIN_CAP) { atomicAdd(&bar[XB_TMO], 1u); break; } }
  }
  nloc = mine > 0u ? mine : 1u; nx = cnt > 0u ? cnt : 1u;
}
DI void xcd_barrier(const XcdBarrier& b) {
  asm volatile("s_waitcnt vmcnt(0)" ::: "memory");
  __syncthreads();
  if (threadIdx.x == 0) {
    unsigned* bar = b.bar;
    __builtin_amdgcn_s_waitcnt(0);
    unsigned nloc = b.st[0], nx = b.st[1];
    if (nloc == 0u) { xcd_barrier_complete(bar, b.x, nloc, nx); b.st[0] = nloc; b.st[1] = nx; }
    const unsigned old = xb_add(&bar[XB_XSUB(b.x)], 1u);
    const unsigned gen = old / nloc;
    if (old + 1u == (gen + 1u) * nloc) {
      __builtin_amdgcn_fence(__ATOMIC_RELEASE, "agent");
      asm volatile("s_waitcnt vmcnt(0)" ::: "memory");
      const unsigned og = xb_add(&bar[XB_TOP], 1u);
      const unsigned tg = og / nx;
      if (og + 1u == (tg + 1u) * nx) xb_add(&bar[XB_TOPGEN], 1u);
      else XB_SPIN(xb_ld(&bar[XB_TOPGEN]) == tg, bar);
      __builtin_amdgcn_fence(__ATOMIC_ACQUIRE, "agent");
      xb_add(&bar[XB_XGEN(b.x)], 1u);
      asm volatile("s_waitcnt vmcnt(0)" ::: "memory");
    } else {
      XB_SPIN(xb_ld(&bar[XB_XGEN(b.x)]) == gen, bar);
      __builtin_amdgcn_fence(__ATOMIC_ACQUIRE, "agent");
      asm volatile("s_waitcnt vmcnt(0)" ::: "memory");
    }
  }
  __syncthreads();
}

constexpr int HALF_LDS = 76 * 1024;
constexpr int SMEM_BYTES = 2 * HALF_LDS;
DI void group_barrier(unsigned* gc, unsigned target) {
  asm volatile("s_waitcnt vmcnt(0)" ::: "memory");
  __syncthreads();
  if (threadIdx.x == 0) {
    __hip_atomic_fetch_add(gc, 1u, __ATOMIC_RELAXED, __HIP_MEMORY_SCOPE_AGENT);
    unsigned sp = 0;
    while (__hip_atomic_load(gc, __ATOMIC_RELAXED, __HIP_MEMORY_SCOPE_AGENT) < target) { __builtin_amdgcn_s_sleep(1); if (++sp > (1u << 24)) break; }
    __builtin_amdgcn_fence(__ATOMIC_ACQUIRE, "agent");
    asm volatile("s_waitcnt vmcnt(0)" ::: "memory");
  }
  __syncthreads();
}
#ifndef STAGGER_US
#define STAGGER_US 0
#endif
__global__ void __launch_bounds__(512, 2) fwd_megakernel(Params p) {
  cg::grid_group grid = cg::this_grid();
  __shared__ __attribute__((aligned(16))) unsigned char smem[SMEM_BYTES];
  const int half = __builtin_amdgcn_readfirstlane(threadIdx.x >> 8);
  unsigned char* hsm = smem + half * HALF_LDS;
  const int G = gridDim.x, bid = blockIdx.x;
  const int slot = bid * 2 + half, NS = 2 * G;
  volatile LDSP unsigned* xst = (volatile LDSP unsigned*)(LDSP unsigned char*)(smem + SMEM_BYTES - 64);
  unsigned* cntp = (unsigned*)(p.ws + OFF_CNT);
  const XcdBarrier xb = xcd_barrier_post((unsigned*)(p.ws + OFF_BAR), xst);
  if (threadIdx.x == 0) xst[4] = __hip_atomic_fetch_add(cntp + 128 + xb.x, 1u, __ATOMIC_RELAXED, __HIP_MEMORY_SCOPE_AGENT);
  {
    constexpr int ADA0 = T0_WIN + T0_WOUT + T0_W1 + T0_W2;
    unsigned* cnt = cntp;
    for (int i = slot; i < ((T0_TOTAL + NS - 1) / NS) * NS; i += NS) {
      const int t = i < 96 ? ADA0 + i : (i - 96 < ADA0 ? i - 96 : i);
      phase0_task(p, t, hsm);
      if (i < 96) {
        asm volatile("s_waitcnt vmcnt(0)" ::: "memory");
        lds_barrier();
        if (otid512() == 0) {
          __builtin_amdgcn_fence(__ATOMIC_RELEASE, "agent");
          asm volatile("s_waitcnt vmcnt(0)" ::: "memory");
          __hip_atomic_fetch_add(cnt + 8, 2u, __ATOMIC_RELAXED, __HIP_MEMORY_SCOPE_AGENT);
        }
      }
    }
    if (otid512() == 0) {
      unsigned sp = 0;
      while (__hip_atomic_load(cnt + 8, __ATOMIC_RELAXED, __HIP_MEMORY_SCOPE_AGENT) < 96u) { __builtin_amdgcn_s_sleep(8); if (++sp > (1u << 22)) break; }
      __builtin_amdgcn_fence(__ATOMIC_ACQUIRE, "agent");
      asm volatile("s_waitcnt vmcnt(0)" ::: "memory");
    }
    lds_barrier();
    for (int t = slot; t < ((NTOK / 64 + NS - 1) / NS) * NS; t += NS) phase1_task(p, 0, p.x, t < NTOK / 64 ? t : NTOK / 64 - 1, hsm);
  }
  grid.sync();
  if (threadIdx.x == 0) {
    unsigned nloc = 0, ng = 0, gi = 0;
    for (unsigned j = 0; j < 16; ++j) { const unsigned c = xb_ld(xb.bar + XB_XCNT(j)); if (c) { if (j < xb.x) ++gi; ++ng; } if (j == xb.x) nloc = c; }
    xst[5] = nloc ? nloc : 1u; xst[6] = ng ? ng : 1u; xst[7] = gi;
  }
  __syncthreads();
  const int rank = __builtin_amdgcn_readfirstlane((int)xst[4]), nloc = __builtin_amdgcn_readfirstlane((int)xst[5]), ng = __builtin_amdgcn_readfirstlane((int)xst[6]), gi = __builtin_amdgcn_readfirstlane((int)xst[7]);
  unsigned* gcnt = cntp + 256 + 64 * xb.x;
  unsigned epoch = 0;
#if STAGGER_US
  { const unsigned long long t0 = wall_clock64(); while (wall_clock64() - t0 < (unsigned long long)(STAGGER_US * 100) * (unsigned long long)gi) __builtin_amdgcn_s_sleep(8); }
#endif
  const int lslot = rank * 2 + half, LNS = 2 * nloc;
  for (int bb = gi; bb < BATCH; bb += ng)
  for (int layer = 0; layer < 2; ++layer) {
    Params q = p;
    { size_t zoff = 0; asm volatile("" : "+s"(zoff)); q.ws = p.ws + zoff; }
    const float* xin = layer == 0 ? q.x : q.out;
    if (layer != 0) {
      for (int t = lslot; t < ((64 + LNS - 1) / LNS) * LNS; t += LNS) phase1_task(q, layer, xin, bb * 64 + (t < 64 ? t : 63), hsm);
      group_barrier(gcnt, ++epoch * (unsigned)nloc);
    }
    for (int t = rank; t < 256; t += nloc) { const int r = t >> 5, i = t & 31; gemm_inproj_tile(q, layer, bb * 16 + (i & 7) + 8 * (r & 1), (i >> 3) + 4 * (r >> 1), smem); }
    group_barrier(gcnt, ++epoch * (unsigned)nloc);
    {
      unsigned* cnt = (unsigned*)(q.ws + OFF_CNT);
      unsigned* qcnt = cnt + 32 + layer * 8; unsigned* cdone = cnt + 64 + layer * 8; unsigned* sdone = cnt + 96 + layer * 8;
      int* s_pair = (int*)(smem + SMEM_BYTES - 16);
      for (int sq = rank; sq < 8; sq += nloc) {
        if (sq < 4) ssd_task8(q, layer, bb, sq, smem); else mlstm_task8(q, layer, bb, sq - 4, smem);
        asm volatile("s_waitcnt vmcnt(0)" ::: "memory");
        lds_barrier();
        if (otid512() == 0) {
          __builtin_amdgcn_fence(__ATOMIC_RELEASE, "agent");
          asm volatile("s_waitcnt vmcnt(0)" ::: "memory");
          __hip_atomic_fetch_add(sdone + bb, 1u, __ATOMIC_RELAXED, __HIP_MEMORY_SCOPE_AGENT);
        }
      }
      constexpr int NP_C = 8, NP_D = 64, NP_N = 64, NP_F = 32, NP_ALL = NP_C + NP_D + NP_N + NP_F;
      const int bq = bb;
      for (;;) {
        const int t512 = otid512();
        lds_barrier();
        if (t512 == 0) *s_pair = (int)atomicAdd(qcnt + bq, 1u);
        lds_barrier();
        const int pair = *s_pair;
        if (pair >= NP_ALL) break;
        if (pair < NP_C) {
          const int v = pair * 2 + half;
          compress_task(q, layer, bq, v >> 3, v & 7, hsm);
          asm volatile("s_waitcnt vmcnt(0)" ::: "memory");
          lds_barrier();
          if (t512 == 0) {
            __builtin_amdgcn_fence(__ATOMIC_RELEASE, "agent");
            asm volatile("s_waitcnt vmcnt(0)" ::: "memory");
            __hip_atomic_fetch_add(cdone + bq, 1u, __ATOMIC_RELAXED, __HIP_MEMORY_SCOPE_AGENT);
          }
        } else if (pair < NP_C + NP_D) {
          const int d = pair - NP_C;
          diff_attn_task(q, layer, bq, 2 * (d & 1) + half, 31 - (d >> 1), hsm);
        } else if (pair < NP_C + NP_D + NP_N) {
          if (t512 == 0) {
            while (__hip_atomic_load(cdone + bq, __ATOMIC_RELAXED, __HIP_MEMORY_SCOPE_AGENT) < (unsigned)NP_C) __builtin_amdgcn_s_sleep(16);
            __builtin_amdgcn_fence(__ATOMIC_ACQUIRE, "agent");
            asm volatile("s_waitcnt vmcnt(0)" ::: "memory");
          }
          lds_barrier();
          nsa_task(q, layer, bq, 2 * (63 - (pair - NP_C - NP_D)) + half, hsm);
        } else {
          if (t512 == 0) {
            while (__hip_atomic_load(sdone + bq, __ATOMIC_RELAXED, __HIP_MEMORY_SCOPE_AGENT) < 8u) __builtin_amdgcn_s_sleep(16);
            __builtin_amdgcn_fence(__ATOMIC_ACQUIRE, "agent");
            asm volatile("s_waitcnt vmcnt(0)" ::: "memory");
          }
          lds_barrier();
          seq_fix_rows(q, layer, bq * SEQ + ((pair - NP_C - NP_D - NP_N) * 2 + half) * 64, 64);
        }
      }
    }
    group_barrier(gcnt, ++epoch * (unsigned)nloc);
    if (layer == 0) { for (int t = rank; t < 64; t += nloc) gemm_outproj_tile<0>(q, xin, q.out, bb * 16 + (t & 15), t >> 4, smem); }
    else { for (int t = rank; t < 64; t += nloc) gemm_outproj_tile<1>(q, xin, q.out, bb * 16 + (t & 15), t >> 4, smem); }
    group_barrier(gcnt, ++epoch * (unsigned)nloc);
    if (layer == 1) {
      const int t5 = otid512();
      final_norm_rows(q, bb * SEQ, SEQ, rank * 8 + (t5 >> 6), nloc * 8, t5 & 63);
    }
  }
}

extern "C" void kernel_launch(void* const* d_in, const int* in_sizes, int n_in, void* d_out, int out_size, void* d_ws, size_t ws_size,
                              hipStream_t stream) {
  static int grid_blocks = 0;
  if (!grid_blocks) {
    int dev = 0, cus = 0, per_cu = 0;
    (void)hipGetDevice(&dev);
    (void)hipDeviceGetAttribute(&cus, hipDeviceAttributeMultiprocessorCount, dev);
    (void)hipOccupancyMaxActiveBlocksPerMultiprocessor(&per_cu, fwd_megakernel, 512, 0);
    if (per_cu > 1) per_cu = 1;
    if (per_cu < 1) per_cu = 1;
    grid_blocks = cus * per_cu;
  }
  if (grid_blocks < 64 || (grid_blocks & 3)) { fprintf(stderr, "grid too small: %d\n", grid_blocks); return; }
  if (ws_size < WS_NEEDED) { fprintf(stderr, "workspace too small: %zu < %zu\n", ws_size, WS_NEEDED); return; }
  Params p{};
  const float** pp = (const float**)&p;
  for (int i = 0; i < 26; ++i) pp[i] = (const float*)d_in[i];
  p.out = (float*)d_out; p.ws = (unsigned char*)d_ws;
  (void)hipMemsetAsync((unsigned char*)d_ws + OFF_CNT, 0, 64 * 1024 + XCD_BAR_WORDS * 4, stream);
  void* args[] = {&p};
  hipError_t e = hipLaunchCooperativeKernel((void*)fwd_megakernel, dim3(grid_blocks), dim3(512), args, 0, stream);
  if (e != hipSuccess) fprintf(stderr, "cooperative launch failed: %s (grid %d)\n", hipGetErrorString(e), grid_blocks);
}
```

```cpp
#include <hip/hip_runtime.h>
#include <hip/hip_cooperative_groups.h>
#include <cstdio>
#include <cstdint>
namespace cg = cooperative_groups;

typedef unsigned short u16;
typedef short bf16x8 __attribute__((ext_vector_type(8)));
typedef short s16x4 __attribute__((ext_vector_type(4)));
typedef float f32x4 __attribute__((ext_vector_type(4)));
typedef float f32x2 __attribute__((ext_vector_type(2)));
typedef unsigned u32x4 __attribute__((ext_vector_type(4)));
typedef unsigned u32x2 __attribute__((ext_vector_type(2)));
typedef __bf16 bf16x2_t __attribute__((ext_vector_type(2)));
#define DI __device__ __forceinline__
#define LDSP __attribute__((address_space(3)))

constexpr int D_MODEL = 1024, BATCH = 8, SEQ = 4096, NTOK = BATCH * SEQ;
constexpr int D_IN = 3992;
constexpr int NP = 3968, NPAD = 4096, NSMALL = 32;
constexpr int PA_Q = 0, PA_KC = 256, PA_VC = 320, PA_KS = 384, PA_VS = 448, PA_KW = 512, PA_VW = 576, PA_Z = 640;
constexpr int PB_Q = 896, PB_K = 1152, PB_V = 1408, PB_Z = 1664;
constexpr int PC_Z = 1920, PC_XBC = 2176;
constexpr int PD_QK = 2688, PD_V = 3200, PD_O = 3456, PD_Z = 3712;
constexpr int SM_G = 0, SM_DT = 12, SM_IF = 16;
constexpr int Y_A = 0, Y_B = 256, Y_C = 512, Y_D = 768;

constexpr size_t MiB = 1024 * 1024;
constexpr size_t OFF_WINT = 0;
constexpr size_t OFF_WOUTT = 16 * MiB;
constexpr size_t OFF_W1T = 20 * MiB;
constexpr size_t OFF_W2T = 22 * MiB;
constexpr size_t OFF_BIAS1 = 22 * MiB + 64 * 1024;
constexpr size_t OFF_ADAP = 22 * MiB + 128 * 1024;
constexpr size_t OFF_KCMP = 24 * MiB;
constexpr size_t OFF_VCMP = 24 * MiB + 256 * 1024;
constexpr size_t OFF_BAR = 29 * MiB + 64 * 1024;
constexpr size_t OFF_CNT = 29 * MiB;
constexpr size_t OFF_SMALL = 25 * MiB;
constexpr size_t OFF_SSQ = 29 * MiB;
constexpr size_t OFF_H = 32 * MiB;
constexpr size_t OFF_PROJ = 96 * MiB;
constexpr size_t OFF_X1B = 352 * MiB;
constexpr size_t WS_NEEDED = OFF_X1B + (size_t)NTOK * 1024 * 2;

struct Params {
  const float* x; const float* c; const float* norm_g; const float* ada_w; const float* ada_b;
  const float* w_in; const float* w_out;
  const float* nsa_cmp_pos; const float* nsa_ck_w1; const float* nsa_ck_w2; const float* nsa_cv_w1; const float* nsa_cv_w2; const float* nsa_norm_g;
  const float* diff_lam; const float* diff_norm_g;
  const float* ssm_conv_w; const float* ssm_conv_b; const float* ssm_dt_bias; const float* ssm_a_log; const float* ssm_d; const float* ssm_norm_g;
  const float* ml_conv_w; const float* ml_conv_b; const float* ml_if_b; const float* ml_norm_g; const float* final_g;
  float* out; unsigned char* ws;
};

DI void lds_barrier() { asm volatile("s_waitcnt lgkmcnt(0)" ::: "memory"); __builtin_amdgcn_s_barrier(); asm volatile("" ::: "memory"); }
DI int otid() { int t = threadIdx.x & 255; asm volatile("" : "+v"(t)); return t; }
DI int otid512() { int t = threadIdx.x; asm volatile("" : "+v"(t)); return t; }
DI unsigned pack2(float a, float b) { f32x2 v = {a, b}; bf16x2_t r = __builtin_convertvector(v, bf16x2_t); return __builtin_bit_cast(unsigned, r); }
DI u16 f2bf(float a) { return (u16)(pack2(a, 0.f) & 0xffffu); }
DI float bf2f(u16 h) { return __uint_as_float(((unsigned)h) << 16); }
DI float bflo(unsigned u) { return __uint_as_float(u << 16); }
DI float bfhi(unsigned u) { return __uint_as_float(u & 0xffff0000u); }
DI f32x4 mfma16(bf16x8 a, bf16x8 b, f32x4 c) { return __builtin_amdgcn_mfma_f32_16x16x32_bf16(a, b, c, 0, 0, 0); }
DI float wave_sum(float v) {
#pragma unroll
  for (int o = 32; o > 0; o >>= 1) v += __shfl_xor(v, o);
  return v;
}
DI float siluf(float v) { return v * __builtin_amdgcn_rcpf(1.f + __expf(-v)); }
DI float sigmoidf_(float v) { return __builtin_amdgcn_rcpf(1.f + __expf(-v)); }
DI float exp2_(float v) { return __builtin_amdgcn_exp2f(v); }
DI float sgprf(float v) { return __int_as_float(__builtin_amdgcn_readfirstlane(__float_as_int(v))); }
DI s16x4 tr_read(const u16* p) { return __builtin_amdgcn_ds_read_tr16_b64_v4i16((LDSP s16x4*)p); }
DI bf16x8 cat4(s16x4 a, s16x4 b) { bf16x8 r; r[0] = a[0]; r[1] = a[1]; r[2] = a[2]; r[3] = a[3]; r[4] = b[0]; r[5] = b[1]; r[6] = b[2]; r[7] = b[3]; return r; }
DI bf16x8 ldfrag(const u16* p) { return *(const bf16x8*)p; }

DI int colmap(int n) {
  if (n < 640) return n;
  if (n < 896) return 652 + (n - 640);
  if (n < 1920) return 908 + (n - 896);
  if (n < 2688) return 1932 + (n - 1920);
  if (n < 3456) return 2704 + (n - 2688);
  if (n < 3968) return 3480 + (n - 3456);
  if (n < 3980) return 640 + (n - 3968);
  if (n < 3984) return 2700 + (n - 3980);
  if (n < 3992) return 3472 + (n - 3984);
  return -1;
}

#define PIN4(a) asm volatile("" : "+v"(a[0]), "+v"(a[1]), "+v"(a[2]), "+v"(a[3]))
DI void tconv_tile(const float* __restrict__ src, int ldsrc, int k0, int n0, u16* __restrict__ dst, int ldd, bool use_map, unsigned char* smem) {
  float* tile = (float*)smem;
  const int tid = otid();
  {
    const int c4 = tid & 15, kk0 = tid >> 4; int col = n0 + c4 * 4; if (use_map) col = colmap(col);
    const float* sp = src + (size_t)(k0 + kk0) * ldsrc + (col >= 0 ? col : 0);
    f32x4 v[4];
#pragma unroll
    for (int i = 0; i < 4; ++i) v[i] = *(const f32x4*)(sp + (size_t)(16 * i) * ldsrc);
    PIN4(v);
    lds_barrier();
#pragma unroll
    for (int i = 0; i < 4; ++i) {
      const f32x4 w = col >= 0 ? v[i] : (f32x4){0.f, 0.f, 0.f, 0.f};
      float* tp = tile + (kk0 + 16 * i) * 65 + c4 * 4;
      tp[0] = w[0]; tp[1] = w[1]; tp[2] = w[2]; tp[3] = w[3];
    }
  }
  lds_barrier();
#pragma unroll
  for (int i = 0; i < 2; ++i) {
    const int item = tid + 256 * i, nn = item >> 3, kc = item & 7;
    u32x4 w;
    w.x = pack2(tile[(kc * 8 + 0) * 65 + nn], tile[(kc * 8 + 1) * 65 + nn]);
    w.y = pack2(tile[(kc * 8 + 2) * 65 + nn], tile[(kc * 8 + 3) * 65 + nn]);
    w.z = pack2(tile[(kc * 8 + 4) * 65 + nn], tile[(kc * 8 + 5) * 65 + nn]);
    w.w = pack2(tile[(kc * 8 + 6) * 65 + nn], tile[(kc * 8 + 7) * 65 + nn]);
    *(u32x4*)(dst + (size_t)(n0 + nn) * ldd + k0 + kc * 8) = w;
  }
}

constexpr int T0_WIN = 2 * 16 * 64, T0_WOUT = 2 * 16 * 16, T0_W1 = 4 * 32 * 2, T0_W2 = 4 * 2, T0_ADA = 2 * 12 * 8, T0_B1 = 64;
constexpr int T0_TOTAL = T0_WIN + T0_WOUT + T0_W1 + T0_W2 + T0_ADA + T0_B1;

DI void phase0_task(const Params& p, int t, unsigned char* smem) {
  const int tid = otid();
  if (t >= T0_TOTAL) { lds_barrier(); lds_barrier(); return; }
  if (t < T0_WIN) {
    const int l = t / 1024, r = t % 1024, kt = r / 64, nt = r % 64;
    tconv_tile(p.w_in + (size_t)l * D_MODEL * D_IN, D_IN, kt * 64, nt * 64, (u16*)(p.ws + OFF_WINT) + (size_t)l * NPAD * 1024, 1024, true, smem);
    return;
  }
  t -= T0_WIN;
  if (t < T0_WOUT) {
    const int l = t / 256, r = t % 256, kt = r / 16, nt = r % 16;
    tconv_tile(p.w_out + (size_t)l * 1024 * 1024, 1024, kt * 64, nt * 64, (u16*)(p.ws + OFF_WOUTT) + (size_t)l * 1024 * 1024, 1024, false, smem);
    return;
  }
  t -= T0_WOUT;
  if (t < T0_W1) {
    const int m = t / 64, r = t % 64, kt = r / 2, nt = r % 2, l = m >> 1, kv = m & 1;
    const float* src = (kv ? p.nsa_cv_w1 : p.nsa_ck_w1) + (size_t)l * 2048 * 128;
    tconv_tile(src, 128, kt * 64, nt * 64, (u16*)(p.ws + OFF_W1T) + (size_t)m * 128 * 2048, 2048, false, smem);
    return;
  }
  t -= T0_W1;
  if (t < T0_W2) {
    const int m = t / 2, kt = t % 2, l = m >> 1, kv = m & 1;
    const float* src = (kv ? p.nsa_cv_w2 : p.nsa_ck_w2) + (size_t)l * 128 * 64;
    tconv_tile(src, 64, kt * 64, 0, (u16*)(p.ws + OFF_W2T) + (size_t)m * 64 * 128, 128, false, smem);
    return;
  }
  t -= T0_W2;
  if (t < T0_ADA) {
    const int l = t / 96, r = t % 96, nc = r / 8, kc = r % 8;
    float* cact = (float*)(smem + 20480);
    float* red = (float*)(smem + 24576);
    const int kq = __builtin_amdgcn_readfirstlane(tid >> 6), c4 = tid & 63;
    const float* w = p.ada_w + ((size_t)l * 1024 + kc * 128 + kq) * 3072 + nc * 256 + c4 * 4;
    float cv[4];
#pragma unroll
    for (int i = 0; i < 4; ++i) { const int e = tid + 256 * i; cv[i] = p.c[(e >> 7) * 1024 + kc * 128 + (e & 127)]; }
    f32x4 wv[32];
#pragma unroll
    for (int j = 0; j < 32; ++j) wv[j] = *(const f32x4*)(w + (size_t)(4 * j) * 3072);
    PIN4(cv);
#pragma unroll
    for (int i = 0; i < 4; ++i) cact[tid + 256 * i] = siluf(cv[i]);
#pragma unroll
    for (int j = 0; j < 32; j += 4) asm volatile("" : "+v"(wv[j]), "+v"(wv[j + 1]), "+v"(wv[j + 2]), "+v"(wv[j + 3]));
    lds_barrier();
    f32x4 acc[8];
#pragma unroll
    for (int b = 0; b < 8; ++b) acc[b] = (f32x4){0.f, 0.f, 0.f, 0.f};
#pragma unroll
    for (int j = 0; j < 32; ++j) {
#pragma unroll
      for (int b = 0; b < 8; ++b) acc[b] += cact[b * 128 + kq + 4 * j] * wv[j];
    }
#pragma unroll
    for (int b = 0; b < 8; ++b) *(f32x4*)(red + (kq * 8 + b) * 256 + c4 * 4) = acc[b];
    lds_barrier();
    float* adap = (float*)(p.ws + OFF_ADAP);
    const int n = nc * 256 + tid;
    float bias = p.ada_b[l * 3072 + n];
    asm volatile("" : "+v"(bias));
    bias = kc == 0 ? bias : 0.f;
#pragma unroll
    for (int i = 0; i < 8; ++i) {
      adap[(((size_t)kc * 2 + l) * 8 + i) * 3072 + n] = ((red[(0 * 8 + i) * 256 + tid] + red[(1 * 8 + i) * 256 + tid]) + (red[(2 * 8 + i) * 256 + tid] + red[(3 * 8 + i) * 256 + tid])) + bias;
    }
    return;
  }
  t -= T0_ADA;
  {
    const int m = t >> 4, kc = t & 15, l = m >> 1, kv = m & 1;
    const float* w1 = (kv ? p.nsa_cv_w1 : p.nsa_ck_w1) + (size_t)l * 2048 * 128;
    const float* pos = p.nsa_cmp_pos + (size_t)l * 2048;
    const int n = tid & 127, half = tid >> 7;
    float acc = 0.f;
    const int k0 = kc * 128 + half * 64;
#pragma unroll 1
    for (int kb = 0; kb < 64; kb += 16) {
      float wv[16];
#pragma unroll
      for (int k = 0; k < 16; ++k) wv[k] = w1[(size_t)(k0 + kb + k) * 128 + n];
#pragma unroll
      for (int k = 0; k < 16; k += 4) asm volatile("" : "+v"(wv[k]), "+v"(wv[k + 1]), "+v"(wv[k + 2]), "+v"(wv[k + 3]));
#pragma unroll
      for (int k = 0; k < 16; ++k) acc += pos[k0 + kb + k] * wv[k];
    }
    float* red = (float*)smem;
    lds_barrier();
    red[tid] = acc;
    lds_barrier();
    if (tid < 128) ((float*)(p.ws + OFF_BIAS1))[(m * 16 + kc) * 128 + tid] = red[tid] + red[tid + 128];
  }
}

DI void phase1_task(const Params& p, int layer, const float* xin, int grp, unsigned char* smem) {
  const int tid = otid(), lane = tid & 63, wid = tid >> 6;
  const int b = grp >> 6;
  float* mul = (float*)smem;
  float* sh = mul + 1024;
  const float* adap = (const float*)(p.ws + OFF_ADAP);
  lds_barrier();
  {
    f32x4 a0[8], a1[8];
#pragma unroll
    for (int kc = 0; kc < 8; ++kc) { const float* a = adap + (((size_t)kc * 2 + layer) * 8 + b) * 3072 + 4 * tid; a0[kc] = *(const f32x4*)a; a1[kc] = *(const f32x4*)(a + 1024); }
    f32x4 gv = *(const f32x4*)(p.norm_g + layer * 1024 + 4 * tid);
    asm volatile("" : "+v"(a0[0]), "+v"(a0[1]), "+v"(a0[2]), "+v"(a0[3]), "+v"(a0[4]), "+v"(a0[5]), "+v"(a0[6]), "+v"(a0[7]));
    asm volatile("" : "+v"(a1[0]), "+v"(a1[1]), "+v"(a1[2]), "+v"(a1[3]), "+v"(a1[4]), "+v"(a1[5]), "+v"(a1[6]), "+v"(a1[7]), "+v"(gv));
    f32x4 s0 = a0[0], s1 = a1[0];
#pragma unroll
    for (int kc = 1; kc < 8; ++kc) { s0 += a0[kc]; s1 += a1[kc]; }
    *(f32x4*)(mul + 4 * tid) = gv * (1.f + s1); *(f32x4*)(sh + 4 * tid) = s0;
  }
  lds_barrier();
  u16* H = (u16*)(p.ws + OFF_H);
#pragma unroll 1
  for (int it = 0; it < 4; ++it) {
    f32x4 v[4][4]; float ss[4];
#pragma unroll
    for (int j = 0; j < 4; ++j) {
      const int row = grp * 64 + wid * 16 + it * 4 + j;
      if (layer == 0) {
        const f32x4* xr = (const f32x4*)(xin + (size_t)row * D_MODEL);
#pragma unroll
        for (int i = 0; i < 4; ++i) v[j][i] = xr[lane + 64 * i];
      } else {
        const u32x2* xr = (const u32x2*)((const u16*)(p.ws + OFF_X1B) + (size_t)row * D_MODEL);
#pragma unroll
        for (int i = 0; i < 4; ++i) { const u32x2 w = xr[lane + 64 * i]; v[j][i] = (f32x4){bflo(w.x), bfhi(w.x), bflo(w.y), bfhi(w.y)}; }
      }
    }
    if (layer == 0) asm volatile("" : "+v"(v[0][0]), "+v"(v[0][1]), "+v"(v[0][2]), "+v"(v[0][3]), "+v"(v[1][0]), "+v"(v[1][1]), "+v"(v[1][2]), "+v"(v[1][3]), "+v"(v[2][0]), "+v"(v[2][1]), "+v"(v[2][2]), "+v"(v[2][3]), "+v"(v[3][0]), "+v"(v[3][1]), "+v"(v[3][2]), "+v"(v[3][3]));
#pragma unroll
    for (int j = 0; j < 4; ++j) {
      float a = 0.f;
#pragma unroll
      for (int i = 0; i < 4; ++i) a += v[j][i][0] * v[j][i][0] + v[j][i][1] * v[j][i][1] + v[j][i][2] * v[j][i][2] + v[j][i][3] * v[j][i][3];
      ss[j] = wave_sum(a);
    }
#pragma unroll
    for (int j = 0; j < 4; ++j) {
      const int row = grp * 64 + wid * 16 + it * 4 + j;
      const float r = rsqrtf(ss[j] * (1.f / D_MODEL) + 1e-6f);
#pragma unroll
      for (int i = 0; i < 4; ++i) {
        const int c = (lane + 64 * i) * 4;
        u32x2 w;
        w.x = pack2(v[j][i][0] * r * mul[c] + sh[c], v[j][i][1] * r * mul[c + 1] + sh[c + 1]);
        w.y = pack2(v[j][i][2] * r * mul[c + 2] + sh[c + 2], v[j][i][3] * r * mul[c + 3] + sh[c + 3]);
        *(u32x2*)(H + (size_t)row * 1024 + c) = w;
      }
    }
  }
}

namespace g8 {
constexpr int BM = 256, BK = 64, HALF = 128, HT = HALF * BK;
constexpr int LDS_BYTES = 8 * HT * 2;
DI int lds_byte(int r, int c) { const int st = (r >> 4) * 2 + (c >> 5), rr = r & 15, cc = c & 31, ob = rr * 64 + cc * 2; return st * 1024 + (ob ^ (((ob >> 9) & 1) << 5)); }
DI void stage_rc(int b, int& R, int& C) { const int st = b / 1024, sb = b % 1024, swz = sb ^ (((sb >> 9) & 1) << 5); R = (st >> 1) * 16 + swz / 64; C = (st & 1) * 32 + (swz % 64) / 2; }

DI void kloop(const u16* __restrict__ A, const u16* __restrict__ Bt, int K, int brow, int bcol, unsigned char* smem, f32x4 (&acc)[2][2][4][2]) {
  u16* shm = (u16*)smem;
  const int tid = otid512();
#define SA(b, h) (shm + ((b) * 2 + (h)) * HT)
#define SB(b, h) (shm + (4 + (b) * 2 + (h)) * HT)
#define STAGE(P, BASE, br, kt) do { const u16* _gb = BASE + ((long)(br) * K + (long)(kt) * BK); \
      __builtin_amdgcn_global_load_lds((const unsigned*)(_gb + soff0), (LDSP unsigned*)((LDSP char*)(P) + tid * 16), 16, 0, 0); \
      __builtin_amdgcn_global_load_lds((const unsigned*)(_gb + soff1), (LDSP unsigned*)((LDSP char*)(P) + tid * 16 + 8192), 16, 0, 0); } while (0)
#define LDA(dst, b, h) _Pragma("unroll") for (int m = 0; m < 4; ++m) _Pragma("unroll") for (int k = 0; k < 2; ++k) \
    dst[m][k] = *reinterpret_cast<const bf16x8*>((const char*)SA(b, h) + lds_byte(wr * 64 + m * 16 + fr, k * 32 + fq * 8))
#define LDB(dst, b, h) _Pragma("unroll") for (int n = 0; n < 2; ++n) _Pragma("unroll") for (int k = 0; k < 2; ++k) \
    dst[n][k] = *reinterpret_cast<const bf16x8*>((const char*)SB(b, h) + lds_byte(wc * 32 + n * 16 + fr, k * 32 + fq * 8))
#define MMA(ai, bj, At_, Bt_) do { __builtin_amdgcn_s_setprio(1); \
    _Pragma("unroll") for (int m = 0; m < 4; ++m) _Pragma("unroll") for (int n = 0; n < 2; ++n) _Pragma("unroll") for (int k = 0; k < 2; ++k) \
      acc[ai][bj][m][n] = __builtin_amdgcn_mfma_f32_16x16x32_bf16(Bt_[n][k], At_[m][k], acc[ai][bj][m][n], 0, 0, 0); \
    __builtin_amdgcn_s_setprio(0); } while (0)
#define WAIT_V(n) asm volatile("s_waitcnt vmcnt(" #n ")" ::: "memory")
#define WAIT_L(n) asm volatile("s_waitcnt lgkmcnt(" #n ")" ::: "memory")
#define BAR __builtin_amdgcn_s_barrier()
#define SCHED __builtin_amdgcn_sched_barrier(0)
  const int wid = __builtin_amdgcn_readfirstlane(tid >> 6), lane = tid & 63, wr = wid >> 2, wc = wid & 3, fr = lane & 15, fq = lane >> 4;
#pragma unroll
  for (int a = 0; a < 2; ++a)
#pragma unroll
    for (int b = 0; b < 2; ++b)
#pragma unroll
      for (int m = 0; m < 4; ++m) { acc[a][b][m][0] = (f32x4){0.f, 0.f, 0.f, 0.f}; acc[a][b][m][1] = (f32x4){0.f, 0.f, 0.f, 0.f}; }
  bf16x8 At[4][2], B0[2][2], B1[2][2];
  const int nt = K / BK;
  int soff0, soff1;
  { int r_, c_; stage_rc(tid * 16, r_, c_); soff0 = r_ * K + c_; stage_rc(tid * 16 + 8192, r_, c_); soff1 = r_ * K + c_; }
  STAGE(SB(0, 0), Bt, bcol, 0); STAGE(SA(0, 0), A, brow, 0);
  STAGE(SB(0, 1), Bt, bcol + HALF, 0); STAGE(SA(0, 1), A, brow + HALF, 0);
  if (wr == 1) BAR;
  WAIT_V(4); BAR;
  STAGE(SB(1, 0), Bt, bcol, 1); STAGE(SA(1, 0), A, brow, 1); STAGE(SB(1, 1), Bt, bcol + HALF, 1);
  WAIT_V(6); BAR;
#pragma unroll 1
  for (int t = 0; t < nt - 2; t += 2) {
    asm volatile("" : "+v"(soff0), "+v"(soff1));
    LDB(B0, 0, 0); SCHED; LDA(At, 0, 0); STAGE(SA(1, 1), A, brow + HALF, t + 1);
    WAIT_L(8); BAR; WAIT_L(0); MMA(0, 0, At, B0); BAR; SCHED;
    LDB(B1, 0, 1); STAGE(SB(0, 0), Bt, bcol, t + 2);
    BAR; WAIT_L(0); MMA(0, 1, At, B1); BAR;
    LDA(At, 0, 1); STAGE(SA(0, 0), A, brow, t + 2);
    BAR; WAIT_L(0); MMA(1, 0, At, B0); BAR; SCHED;
    STAGE(SB(0, 1), Bt, bcol + HALF, t + 2);
    WAIT_V(6); BAR; MMA(1, 1, At, B1); BAR;
    LDB(B0, 1, 0); SCHED; LDA(At, 1, 0); STAGE(SA(0, 1), A, brow + HALF, t + 2);
    WAIT_L(8); BAR; WAIT_L(0); MMA(0, 0, At, B0); BAR; SCHED;
    LDB(B1, 1, 1); STAGE(SB(1, 0), Bt, bcol, t + 3);
    BAR; WAIT_L(0); MMA(0, 1, At, B1); BAR;
    LDA(At, 1, 1); STAGE(SA(1, 0), A, brow, t + 3);
    BAR; WAIT_L(0); MMA(1, 0, At, B0); BAR; SCHED;
    STAGE(SB(1, 1), Bt, bcol + HALF, t + 3);
    WAIT_V(6); BAR; MMA(1, 1, At, B1); BAR;
  }
  { LDB(B0, 0, 0); LDA(At, 0, 0); STAGE(SA(1, 1), A, brow + HALF, nt - 1);
    BAR; WAIT_L(0); MMA(0, 0, At, B0); BAR;
    LDB(B1, 0, 1); BAR; WAIT_L(0); MMA(0, 1, At, B1); BAR;
    LDA(At, 0, 1); WAIT_V(4); BAR; WAIT_L(0); MMA(1, 0, At, B0); MMA(1, 1, At, B1); BAR; }
  { LDB(B0, 1, 0); LDA(At, 1, 0); WAIT_V(2); BAR; WAIT_L(0); MMA(0, 0, At, B0); BAR;
    LDB(B1, 1, 1); WAIT_V(0); BAR; WAIT_L(0); MMA(0, 1, At, B1); BAR;
    LDA(At, 1, 1); BAR; WAIT_L(0); MMA(1, 0, At, B0); MMA(1, 1, At, B1); BAR; }
  if (wr == 0) BAR;
#undef SA
#undef SB
#undef STAGE
#undef LDA
#undef LDB
#undef MMA
#undef WAIT_V
#undef WAIT_L
#undef BAR
#undef SCHED
}
DI void tile_map(int wgid, int nM, int nN, int& pm, int& pn) {
  const int nwg = nM * nN, NXCD = 8, WGM = 8;
  { const int q = nwg / NXCD, r = nwg % NXCD, xcd = wgid % NXCD, off = wgid / NXCD; wgid = (xcd < r ? xcd * (q + 1) : r * (q + 1) + (xcd - r) * q) + off; }
  const int nig = WGM * nN, gid = wgid / nig, fm = gid * WGM, gsz = (nM - fm) < WGM ? (nM - fm) : WGM;
  pm = fm + ((wgid % nig) % gsz); pn = (wgid % nig) / gsz;
}
}

DI void gemm_inproj_tile(const Params& p, int layer, int pm, int pn, unsigned char* smem) {
  const int brow = pm * 256, bcol = pn * 256;
  f32x4 acc[2][2][4][2];
  g8::kloop((const u16*)(p.ws + OFF_H), (const u16*)(p.ws + OFF_WINT) + (size_t)layer * NPAD * 1024, 1024, brow, bcol, smem, acc);
  const int tid = otid512(), wid = __builtin_amdgcn_readfirstlane(tid >> 6), lane = tid & 63, wr = wid >> 2, wc = wid & 3, fr = lane & 15, fq = lane >> 4;
  u16* proj = (u16*)(p.ws + OFF_PROJ);
  if (pn == 15 && wc == 0) {
    float* sm = (float*)(p.ws + OFF_SMALL);
#pragma unroll
    for (int ai = 0; ai < 2; ++ai)
#pragma unroll
      for (int m = 0; m < 4; ++m)
#pragma unroll
        for (int n = 0; n < 2; ++n) {
          const int mr = brow + ai * 128 + wr * 64 + m * 16 + fr;
          *(f32x4*)(sm + (size_t)mr * NSMALL + n * 16 + 4 * fq) = acc[ai][1][m][n];
        }
  }
  constexpr int CLD = 264;
  u16* Cs = (u16*)smem;
#pragma unroll
  for (int ai = 0; ai < 2; ++ai) {
    lds_barrier();
#pragma unroll
    for (int bj = 0; bj < 2; ++bj)
#pragma unroll
      for (int m = 0; m < 4; ++m)
#pragma unroll
        for (int n = 0; n < 2; ++n) {
          const f32x4 v = acc[ai][bj][m][n];
          u32x2 w; w.x = pack2(v[0], v[1]); w.y = pack2(v[2], v[3]);
          *(u32x2*)(Cs + (wr * 64 + m * 16 + fr) * CLD + bj * 128 + wc * 32 + n * 16 + 4 * fq) = w;
        }
    lds_barrier();
#pragma unroll
    for (int i = 0; i < 8; ++i) {
      const int id = tid + 512 * i, row = id >> 5, ch = id & 31;
      if (bcol + ch * 8 < NP) *(u32x4*)(proj + (size_t)(brow + ai * 128 + row) * NP + bcol + ch * 8) = *(const u32x4*)(Cs + row * CLD + ch * 8);
    }
  }
  lds_barrier();
}

template <int layer>
DI void gemm_outproj_tile(const Params& p, const float* xin, float* xout, int pm, int pn, unsigned char* smem) {
  const int brow = pm * 256, bcol = pn * 256;
  f32x4 acc[2][2][4][2];
  g8::kloop((const u16*)(p.ws + OFF_H), (const u16*)(p.ws + OFF_WOUTT) + (size_t)layer * 1024 * 1024, 1024, brow, bcol, smem, acc);
  const int tid = otid512(), wid = __builtin_amdgcn_readfirstlane(tid >> 6), lane = tid & 63, wr = wid >> 2, wc = wid & 3, fr = lane & 15, fq = lane >> 4;
  const int b = brow >> 12;
  const float* adap = (const float*)(p.ws + OFF_ADAP);
  constexpr int CLD = 132;
  float* Cs = (float*)smem;
#pragma unroll
  for (int ai = 0; ai < 2; ++ai)
#pragma unroll
    for (int bj = 0; bj < 2; ++bj) {
      lds_barrier();
#pragma unroll
      for (int m = 0; m < 4; ++m)
#pragma unroll
        for (int n = 0; n < 2; ++n) *(f32x4*)(Cs + (wr * 64 + m * 16 + fr) * CLD + wc * 32 + n * 16 + 4 * fq) = acc[ai][bj][m][n];
      lds_barrier();
      const int ch = tid & 31, nc = bcol + bj * 128 + ch * 4;
      f32x4 gt = {0.f, 0.f, 0.f, 0.f};
#pragma unroll
      for (int kc = 0; kc < 8; ++kc) gt += *(const f32x4*)(adap + (((size_t)kc * 2 + layer) * 8 + b) * 3072 + 2048 + nc);
      u16* x1b = (u16*)(p.ws + OFF_X1B);
      f32x4 xv[8];
#pragma unroll
      for (int i = 0; i < 8; ++i) {
        const size_t off = (size_t)(brow + ai * 128 + (tid >> 5) + 16 * i) * 1024 + nc;
        if (layer == 0) xv[i] = *(const f32x4*)(xin + off);
        else { const u32x2 w = *(const u32x2*)(x1b + off); xv[i] = (f32x4){bflo(w.x), bfhi(w.x), bflo(w.y), bfhi(w.y)}; }
      }
#pragma unroll
      for (int i = 0; i < 8; ++i) {
        const int row = (tid >> 5) + 16 * i;
        const size_t off = (size_t)(brow + ai * 128 + row) * 1024 + nc;
        const f32x4 v = xv[i] + gt * *(const f32x4*)(Cs + row * CLD + ch * 4);
        if (layer == 0) { u32x2 w; w.x = pack2(v[0], v[1]); w.y = pack2(v[2], v[3]); *(u32x2*)(x1b + off) = w; }
        else *(f32x4*)(xout + off) = v;
      }
    }
  lds_barrier();
}

constexpr int KLD = 72;
struct KVRegs { u32x4 k[2], v[2]; };
DI void kv_load(const u16* kbase, const u16* vbase, int ldk, int ldv, int key0, KVRegs& r) {
  const int tid = otid();
#pragma unroll
  for (int i = 0; i < 2; ++i) {
    const int id = tid + 256 * i, row = id >> 3, ch = id & 7;
    r.k[i] = *(const u32x4*)(kbase + (size_t)(key0 + row) * ldk + ch * 8);
    r.v[i] = *(const u32x4*)(vbase + (size_t)(key0 + row) * ldv + ch * 8);
  }
}
DI void kv_store(u16* Ks, u16* Vs, const KVRegs& r) {
  const int tid = otid();
#pragma unroll
  for (int i = 0; i < 2; ++i) {
    const int id = tid + 256 * i, row = id >> 3, ch = id & 7;
    *(u32x4*)(Ks + row * KLD + ch * 8) = r.k[i];
    *(u32x4*)(Vs + row * KLD + ch * 8) = r.v[i];
  }
}
constexpr int KVBUF = 2 * 64 * KLD;
template <class UseF, class LoadF, class CompF>
DI void kv_pipeline(int j0, int j1, u16* buf, UseF use, LoadF load, CompF comp) {
  KVRegs kr;
  if (use(j0)) load(j0, kr);
  lds_barrier();
  if (use(j0)) kv_store(buf, buf + 64 * KLD, kr);
  if (j0 + 1 < j1 && use(j0 + 1)) load(j0 + 1, kr);
  lds_barrier();
  for (int j = j0; j < j1; ++j) {
    u16* cur = buf + ((j - j0) & 1) * KVBUF; u16* nxt = buf + (((j - j0) & 1) ^ 1) * KVBUF;
    if (j + 1 < j1 && use(j + 1)) kv_store(nxt, nxt + 64 * KLD, kr);
    if (j + 2 < j1 && use(j + 2)) load(j + 2, kr);
    if (use(j)) comp(j, cur, cur + 64 * KLD);
    lds_barrier();
  }
}
struct AttnAcc { f32x4 o[4][2]; float m[2], l[2]; f32x4 os[2]; int fresh; };
DI void attn_init(AttnAcc& a) {
#pragma unroll
  for (int d = 0; d < 4; ++d) { a.o[d][0] = (f32x4){0.f, 0.f, 0.f, 0.f}; a.o[d][1] = (f32x4){0.f, 0.f, 0.f, 0.f}; }
  a.m[0] = a.m[1] = -1e30f; a.l[0] = a.l[1] = 0.f;
}
template <int NKS>
DI void qk_tile(const u16* Ks, int dofs, const bf16x8 (&qf)[2][NKS], f32x4 (&s)[4][2], int l15, int g) {
#pragma unroll
  for (int kt = 0; kt < 4; ++kt) {
    s[kt][0] = (f32x4){0.f, 0.f, 0.f, 0.f}; s[kt][1] = (f32x4){0.f, 0.f, 0.f, 0.f};
#pragma unroll
    for (int ks = 0; ks < NKS; ++ks) {
      const bf16x8 a = ldfrag(Ks + (kt * 16 + l15) * KLD + dofs + ks * 32 + 8 * g);
      s[kt][0] = mfma16(a, qf[0][ks], s[kt][0]);
      s[kt][1] = mfma16(a, qf[1][ks], s[kt][1]);
    }
  }
}
DI void pv_accum(const bf16x8 (&pf)[2][2], const u16* Vs, f32x4 (&o)[4][2], int l15, int g) {
  const int tq = l15 >> 2, tp = l15 & 3;
#pragma unroll
  for (int kk = 0; kk < 2; ++kk)
#pragma unroll
    for (int d = 0; d < 4; ++d) {
      const bf16x8 vf = cat4(tr_read(Vs + (kk * 32 + 4 * g + tq) * KLD + d * 16 + 4 * tp), tr_read(Vs + (kk * 32 + 16 + 4 * g + tq) * KLD + d * 16 + 4 * tp));
      o[d][0] = mfma16(vf, pf[0][kk], o[d][0]);
      o[d][1] = mfma16(vf, pf[1][kk], o[d][1]);
    }
}
DI void pack_p(const f32x4 (&s)[4][2], bf16x8 (&pf)[2][2]) {
#pragma unroll
  for (int qt = 0; qt < 2; ++qt)
#pragma unroll
    for (int kk = 0; kk < 2; ++kk) {
      u32x4 w;
      w.x = pack2(s[2 * kk][qt][0], s[2 * kk][qt][1]); w.y = pack2(s[2 * kk][qt][2], s[2 * kk][qt][3]);
      w.z = pack2(s[2 * kk + 1][qt][0], s[2 * kk + 1][qt][1]); w.w = pack2(s[2 * kk + 1][qt][2], s[2 * kk + 1][qt][3]);
      pf[qt][kk] = __builtin_bit_cast(bf16x8, w);
    }
}
constexpr float DEFER_THR = 5.f;
template <class VF>
DI void softmax_pv(f32x4 (&s)[4][2], AttnAcc& a, const u16* Vs, float sc, int l15, int g, VF valid) {
  bf16x8 pf[2][2];
  float mxl[2];
#pragma unroll
  for (int qt = 0; qt < 2; ++qt) {
    float mx = -1e30f;
#pragma unroll
    for (int kt = 0; kt < 4; ++kt)
#pragma unroll
      for (int r = 0; r < 4; ++r) { const float v = valid(kt, r, qt) ? s[kt][qt][r] * sc : -1e30f; s[kt][qt][r] = v; mx = fmaxf(mx, v); }
    mxl[qt] = mx;
  }
  if (__any((mxl[0] > a.m[0] + DEFER_THR) || (mxl[1] > a.m[1] + DEFER_THR))) {
#pragma unroll
    for (int qt = 0; qt < 2; ++qt) {
      float mx = mxl[qt];
      mx = fmaxf(mx, __shfl_xor(mx, 16)); mx = fmaxf(mx, __shfl_xor(mx, 32));
      const float mn = fmaxf(a.m[qt], mx), alpha = exp2_(a.m[qt] - mn);
      a.m[qt] = mn; a.l[qt] *= alpha;
#pragma unroll
      for (int d = 0; d < 4; ++d) a.o[d][qt] *= alpha;
    }
  }
#pragma unroll
  for (int qt = 0; qt < 2; ++qt) {
    const float mn = a.m[qt];
    float ls = 0.f;
#pragma unroll
    for (int kt = 0; kt < 4; ++kt)
#pragma unroll
      for (int r = 0; r < 4; ++r) { const float v = s[kt][qt][r]; const float pv = v > -1e29f ? exp2_(v - mn) : 0.f; s[kt][qt][r] = pv; ls += pv; }
    a.l[qt] += ls;
  }
  pack_p(s, pf);
  pv_accum(pf, Vs, a.o, l15, g);
}
DI float group_sum4_(float v) { v += __shfl_xor(v, 16); v += __shfl_xor(v, 32); return v; }
DI bf16x8 scale_frag(bf16x8 f, float sc) {
  u32x4 w = __builtin_bit_cast(u32x4, f);
  w.x = pack2(bflo(w.x) * sc, bfhi(w.x) * sc); w.y = pack2(bflo(w.y) * sc, bfhi(w.y) * sc);
  w.z = pack2(bflo(w.z) * sc, bfhi(w.z) * sc); w.w = pack2(bflo(w.w) * sc, bfhi(w.w) * sc);
  return __builtin_bit_cast(bf16x8, w);
}
DI void attn_init_rel(AttnAcc& a) { attn_init(a); a.m[0] = a.m[1] = 0.f; a.os[0] = (f32x4){0.f, 0.f, 0.f, 0.f}; a.os[1] = (f32x4){0.f, 0.f, 0.f, 0.f}; a.fresh = 1; }
DI void rowsum_accum(const bf16x8 (&pf)[2][2], AttnAcc& a, int l15) {
  const short one = l15 == 0 ? (short)0x3F80 : (short)0;
  const bf16x8 ones = {one, one, one, one, one, one, one, one};
#pragma unroll
  for (int kk = 0; kk < 2; ++kk) { a.os[0] = mfma16(ones, pf[0][kk], a.os[0]); a.os[1] = mfma16(ones, pf[1][kk], a.os[1]); }
}
DI float rel_rowsum(const AttnAcc& a, int qt, int l15) { return __shfl(a.os[qt][0], l15); }
template <int NKS>
DI void qk_tile_rel(const u16* Ks, int dofs, const bf16x8 (&qf)[2][NKS], const AttnAcc& a, f32x4 (&s)[4][2], int l15, int g, bool ok0 = true, bool ok1 = true) {
  const float n0 = ok0 ? -a.m[0] : -1e30f, n1 = ok1 ? -a.m[1] : -1e30f;
#pragma unroll
  for (int kt = 0; kt < 4; ++kt) {
    s[kt][0] = (f32x4){n0, n0, n0, n0}; s[kt][1] = (f32x4){n1, n1, n1, n1};
#pragma unroll
    for (int ks = 0; ks < NKS; ++ks) {
      const bf16x8 k = ldfrag(Ks + (kt * 16 + l15) * KLD + dofs + ks * 32 + 8 * g);
      s[kt][0] = mfma16(k, qf[0][ks], s[kt][0]);
      s[kt][1] = mfma16(k, qf[1][ks], s[kt][1]);
    }
  }
}
template <int MODE, class VF>
DI void softmax_rel(f32x4 (&s)[4][2], AttnAcc& a, bf16x8 (&pf)[2][2], int l15_, VF valid, bool ok0 = true, bool ok1 = true) {
  float mxl[2];
#pragma unroll
  for (int qt = 0; qt < 2; ++qt) {
    float mx = -1e30f;
    const bool okq = qt == 0 ? ok0 : ok1;
#pragma unroll
    for (int kt = 0; kt < 4; ++kt)
#pragma unroll
      for (int r = 0; r < 4; ++r) {
        if (MODE == 1) s[kt][qt][r] = valid(kt, r, qt) ? s[kt][qt][r] : -1e30f;
        if (MODE == 2) s[kt][qt][r] = okq ? s[kt][qt][r] : -1e30f;
        mx = fmaxf(mx, s[kt][qt][r]);
      }
    mxl[qt] = mx;
  }
  if (a.fresh || __any(mxl[0] > DEFER_THR || mxl[1] > DEFER_THR)) {
    bool still = false;
#pragma unroll
    for (int qt = 0; qt < 2; ++qt) {
      float mx = mxl[qt];
      mx = fmaxf(mx, __shfl_xor(mx, 16)); mx = fmaxf(mx, __shfl_xor(mx, 32));
      const bool fresh = rel_rowsum(a, qt, l15_) == 0.f;
      const float dl = mx < -1e29f ? 0.f : (fresh ? mx : fmaxf(mx, 0.f)), alpha = exp2_(-dl);
      still = still || (fresh && mx < -1e29f);
      a.m[qt] += dl; a.os[qt] *= alpha;
#pragma unroll
      for (int d = 0; d < 4; ++d) a.o[d][qt] *= alpha;
#pragma unroll
      for (int kt = 0; kt < 4; ++kt)
#pragma unroll
        for (int r = 0; r < 4; ++r) s[kt][qt][r] -= dl;
    }
    a.fresh = __any(still) ? 1 : 0;
  }
#pragma unroll
  for (int qt = 0; qt < 2; ++qt)
#pragma unroll
    for (int kt = 0; kt < 4; ++kt)
#pragma unroll
      for (int r = 0; r < 4; ++r) s[kt][qt][r] = exp2_(s[kt][qt][r]);
  pack_p(s, pf);
}
DI float group_sum4(float v) { v += __shfl_xor(v, 16); v += __shfl_xor(v, 32); return v; }

constexpr int DSTAGE = 2 * 128 * 64;
DI int fKs(int row) { return (row >> 1) & 7; }
DI int fVs(int row) { return ((row >> 1) & 3) << 1; }
DI void kv_dma128(const u16* kbase, const u16* vbase, int ld, int key0, u16* stage, int tid) {
#pragma unroll
  for (int i = 0; i < 4; ++i) {
    const int id = tid + 256 * i, row = id >> 3, c8 = id & 7;
    __builtin_amdgcn_global_load_lds((const unsigned*)(kbase + (size_t)(key0 + row) * ld + ((c8 ^ fKs(row)) * 8)), (LDSP unsigned*)((LDSP char*)stage + id * 16), 16, 0, 0);
  }
#pragma unroll
  for (int i = 0; i < 4; ++i) {
    const int id = tid + 256 * i, row = id >> 3, c8 = id & 7;
    __builtin_amdgcn_global_load_lds((const unsigned*)(vbase + (size_t)(key0 + row) * ld + ((c8 ^ fVs(row)) * 8)), (LDSP unsigned*)((LDSP char*)(stage + 128 * 64) + id * 16), 16, 0, 0);
  }
}
template <int NKS>
DI void qk_tile_rel_sw(const u16* Kh, int dofs, const bf16x8 (&qf)[2][NKS], const AttnAcc& a, f32x4 (&s)[4][2], int l15, int g) {
  const float n0 = -a.m[0], n1 = -a.m[1];
  const int sw = (l15 >> 1) & 7;
  bf16x8 kf[4][NKS];
#pragma unroll
  for (int kt = 0; kt < 4; ++kt)
#pragma unroll
    for (int ks = 0; ks < NKS; ++ks) kf[kt][ks] = ldfrag(Kh + (kt * 16 + l15) * 64 + ((((dofs >> 3) + ks * 4 + g) ^ sw) * 8));
  if constexpr (NKS == 1) asm volatile("" : "+v"(kf[0][0]), "+v"(kf[1][0]), "+v"(kf[2][0]), "+v"(kf[3][0]));
#pragma unroll
  for (int kt = 0; kt < 4; ++kt) {
    s[kt][0] = (f32x4){n0, n0, n0, n0}; s[kt][1] = (f32x4){n1, n1, n1, n1};
#pragma unroll
    for (int ks = 0; ks < NKS; ++ks) {
      s[kt][0] = mfma16(kf[kt][ks], qf[0][ks], s[kt][0]);
      s[kt][1] = mfma16(kf[kt][ks], qf[1][ks], s[kt][1]);
    }
  }
}
DI void v_frags_sw(const u16* Vh, bf16x8 (&vf)[2][4], int l15, int g) {
  const int tq = l15 >> 2, tp = l15 & 3;
#pragma unroll
  for (int kk = 0; kk < 2; ++kk) {
    const int r0 = kk * 32 + 4 * g + tq, r1 = r0 + 16;
    const int f0 = fVs(r0), f1 = fVs(r1);
#pragma unroll
    for (int d = 0; d < 4; ++d) {
      const int lc = d * 2 + (tp >> 1);
      vf[kk][d] = cat4(tr_read(Vh + r0 * 64 + ((lc ^ f0) * 8) + (tp & 1) * 4), tr_read(Vh + r1 * 64 + ((lc ^ f1) * 8) + (tp & 1) * 4));
    }
  }
}
DI void pv_mma(const bf16x8 (&pf)[2][2], bf16x8 (&vf)[2][4], f32x4 (&o)[4][2]) {
  asm volatile("" : "+v"(vf[0][0]), "+v"(vf[0][1]), "+v"(vf[0][2]), "+v"(vf[0][3]), "+v"(vf[1][0]), "+v"(vf[1][1]), "+v"(vf[1][2]), "+v"(vf[1][3]));
#pragma unroll
  for (int kk = 0; kk < 2; ++kk)
#pragma unroll
    for (int d = 0; d < 4; ++d) {
      o[d][0] = mfma16(vf[kk][d], pf[0][kk], o[d][0]);
      o[d][1] = mfma16(vf[kk][d], pf[1][kk], o[d][1]);
    }
}
DI void diff_attn_task(const Params& p, int layer, int b, int h, int qb, unsigned char* smem) {
  u16* Ks = (u16*)smem; u16* Vs = Ks + 64 * KLD;
  const int tid = otid(), lane = tid & 63, wid = tid >> 6, l15 = lane & 15, g = lane >> 4;
  const u16* proj = (const u16*)(p.ws + OFF_PROJ) + (size_t)b * SEQ * NP;
  const int q0w = qb * 128 + wid * 32;
  const float* lam = p.diff_lam + layer * 128;
  float s01 = 0.f, s23 = 0.f;
  for (int i = 0; i < 32; ++i) { s01 += lam[i] * lam[32 + i]; s23 += lam[64 + i] * lam[96 + i]; }
  const float lam_init = layer == 0 ? 0.2f : 0.35550906759096324f;
  const float lam_full = sgprf(__expf(s01) - __expf(s23) + lam_init);
  const float sc = 0.17677669529663687f * 1.4426950408889634f;
  const int ntile = 2 * qb + 2;
  const u16* vbase = proj + PB_V + h * 64;
  f32x4 res[4][2];
#pragma unroll 1
  for (int c = 0; c < 2; ++c) {
    const u16* kbase = proj + PB_K + h * 64;
    bf16x8 qf[2][1];
#pragma unroll
    for (int qt = 0; qt < 2; ++qt) qf[qt][0] = scale_frag(ldfrag(proj + (size_t)(q0w + qt * 16 + l15) * NP + PB_Q + h * 64 + c * 32 + 8 * g), sc);
    AttnAcc a; attn_init_rel(a);
    const int nst = qb + 1;
    asm volatile("s_waitcnt vmcnt(0)" ::: "memory");
    lds_barrier();
    kv_dma128(kbase, vbase, NP, 0, Ks, tid);
    asm volatile("s_waitcnt vmcnt(0)" ::: "memory");
    lds_barrier();
    for (int js = 0; js < nst; ++js) {
      const u16* st = Ks + (js & 1) * DSTAGE;
      if (js + 1 < nst) kv_dma128(kbase, vbase, NP, (js + 1) * 128, Ks + ((js + 1) & 1) * DSTAGE, tid);
#pragma unroll 1
      for (int hf = 0; hf < 2; ++hf) {
        const int key0 = js * 128 + hf * 64;
        if (key0 <= q0w + 31) {
          f32x4 s[4][2]; bf16x8 pf[2][2];
          auto valid = [&](int kt, int r, int qt) { return key0 + kt * 16 + 4 * g + r <= q0w + qt * 16 + l15; };
          qk_tile_rel_sw<1>(st + hf * 64 * 64, c * 32, qf, a, s, l15, g);
          if (key0 + 63 <= q0w) softmax_rel<0>(s, a, pf, l15, valid); else softmax_rel<1>(s, a, pf, l15, valid);
          bf16x8 vf[2][4];
          v_frags_sw(st + 128 * 64 + hf * 64 * 64, vf, l15, g);
          pv_mma(pf, vf, a.o);
          rowsum_accum(pf, a, l15);
        }
      }
      asm volatile("s_waitcnt vmcnt(0)" ::: "memory");
      lds_barrier();
    }
#pragma unroll
    for (int qt = 0; qt < 2; ++qt) {
      const float lt = rel_rowsum(a, qt, l15);
      const float inv = c == 0 ? 1.f / lt : -lam_full / lt;
#pragma unroll
      for (int d = 0; d < 4; ++d) res[d][qt] = c == 0 ? a.o[d][qt] * inv : res[d][qt] + a.o[d][qt] * inv;
    }
  }
  u16* Y = (u16*)(p.ws + OFF_H);
  const float* ng = p.diff_norm_g + layer * 64;
#pragma unroll
  for (int qt = 0; qt < 2; ++qt) {
    float ss = 0.f;
#pragma unroll
    for (int d = 0; d < 4; ++d) { const f32x4 v = res[d][qt]; ss += v[0] * v[0] + v[1] * v[1] + v[2] * v[2] + v[3] * v[3]; }
    ss = group_sum4(ss);
    const float rn = rsqrtf(ss * (1.f / 64.f) + 1e-6f) * (1.f - lam_init);
    const int t = q0w + qt * 16 + l15;
    const size_t row = (size_t)b * SEQ + t;
#pragma unroll
    for (int d = 0; d < 4; ++d) {
      const int dd = d * 16 + 4 * g;
      const f32x4 v = res[d][qt];
      const u32x2 zz = *(const u32x2*)(proj + (size_t)t * NP + PB_Z + h * 64 + dd);
      const f32x4 gg = *(const f32x4*)(ng + dd);
      u32x2 w;
      w.x = pack2(v[0] * rn * gg[0] * siluf(bflo(zz.x)), v[1] * rn * gg[1] * siluf(bfhi(zz.x)));
      w.y = pack2(v[2] * rn * gg[2] * siluf(bflo(zz.y)), v[3] * rn * gg[3] * siluf(bfhi(zz.y)));
      *(u32x2*)(Y + row * 1024 + Y_B + h * 64 + dd) = w;
    }
  }
}

template <int NKS>
DI void qk_tile1(const u16* Ks, const bf16x8 (&qf)[NKS], f32x4 (&s)[4], int l15, int g) {
#pragma unroll
  for (int kt = 0; kt < 4; ++kt) {
    s[kt] = (f32x4){0.f, 0.f, 0.f, 0.f};
#pragma unroll
    for (int ks = 0; ks < NKS; ++ks) s[kt] = mfma16(ldfrag(Ks + (kt * 16 + l15) * KLD + ks * 32 + 8 * g), qf[ks], s[kt]);
  }
}
DI void pv_accum1(const f32x4 (&s)[4], const u16* Vs, f32x4 (&o)[4], int l15, int g) {
  const int tq = l15 >> 2, tp = l15 & 3;
#pragma unroll
  for (int kk = 0; kk < 2; ++kk) {
    u32x4 w;
    w.x = pack2(s[2 * kk][0], s[2 * kk][1]); w.y = pack2(s[2 * kk][2], s[2 * kk][3]);
    w.z = pack2(s[2 * kk + 1][0], s[2 * kk + 1][1]); w.w = pack2(s[2 * kk + 1][2], s[2 * kk + 1][3]);
    const bf16x8 pf = __builtin_bit_cast(bf16x8, w);
#pragma unroll
    for (int d = 0; d < 4; ++d) {
      const bf16x8 vf = cat4(tr_read(Vs + (kk * 32 + 4 * g + tq) * KLD + d * 16 + 4 * tp), tr_read(Vs + (kk * 32 + 16 + 4 * g + tq) * KLD + d * 16 + 4 * tp));
      o[d] = mfma16(vf, pf, o[d]);
    }
  }
}

constexpr int SEQ_LDS_A = 0, SEQ_LDS_B = 128 * KLD * 2, SEQ_LDS_C = 2 * 128 * KLD * 2, SEQ_LDS_S = 3 * 128 * KLD * 2, SEQ_LDS_F = SEQ_LDS_S + 64 * KLD * 2;
constexpr int SEQ_LDS_HALO = SEQ_LDS_F + 4096;
constexpr int SEQ_LDS_CW = SEQ_LDS_HALO + 2 * 3 * 3 * 64 * 2;
DI float wave_scan_add(float x, int lane) {
#pragma unroll
  for (int o = 1; o < 64; o <<= 1) { const float y = __shfl_up(x, o); if (lane >= o) x += y; }
  return x;
}
DI float wave_scan_max(float x, int lane) {
#pragma unroll
  for (int o = 1; o < 64; o <<= 1) { const float y = __shfl_up(x, o); if (lane >= o) x = fmaxf(x, y); }
  return x;
}

DI void seq_fix_rows(const Params& p, int layer, int r0, int nrows) {
  u16* Y = (u16*)(p.ws + OFF_H);
  const u16* proj = (const u16*)(p.ws + OFF_PROJ);
  const int tid = otid(), lane = tid & 63, wv = tid >> 6;
  const bool ml = lane >= 32;
  const int ch = (lane & 31) * 8;
  const float* ng = ml ? p.ml_norm_g + layer * 64 + (ch & 63) : p.ssm_norm_g + layer * 256 + ch;
  const f32x4 g0 = *(const f32x4*)ng, g1 = *(const f32x4*)(ng + 4);
  for (int rb = wv * 4; rb < nrows; rb += 16) {
    u32x4 yv4[4], zv4[4], ov4[4];
#pragma unroll
    for (int j = 0; j < 4; ++j) {
      const size_t row = (size_t)(r0 + rb + j);
      yv4[j] = *(const u32x4*)(Y + row * 1024 + (ml ? Y_D : Y_C) + ch);
      zv4[j] = *(const u32x4*)(proj + row * NP + (ml ? PD_Z : PC_Z) + ch);
      ov4[j] = *(const u32x4*)(proj + row * NP + PD_O + ch);
    }
    asm volatile("" : "+v"(yv4[0]), "+v"(yv4[1]), "+v"(yv4[2]), "+v"(yv4[3]), "+v"(zv4[0]), "+v"(zv4[1]), "+v"(zv4[2]), "+v"(zv4[3]), "+v"(ov4[0]), "+v"(ov4[1]), "+v"(ov4[2]), "+v"(ov4[3]));
#pragma unroll
    for (int j = 0; j < 4; ++j) {
      const size_t row = (size_t)(r0 + rb + j);
      u16* yp = Y + row * 1024 + (ml ? Y_D : Y_C) + ch;
      const u32x4 yv = yv4[j], zv = zv4[j], ov = ov4[j];
      float v[8] = {bflo(yv.x), bfhi(yv.x), bflo(yv.y), bfhi(yv.y), bflo(yv.z), bfhi(yv.z), bflo(yv.w), bfhi(yv.w)};
      float z[8] = {bflo(zv.x), bfhi(zv.x), bflo(zv.y), bfhi(zv.y), bflo(zv.z), bfhi(zv.z), bflo(zv.w), bfhi(zv.w)};
      float ss = 0.f;
      if (ml) {
        const float o[8] = {bflo(ov.x), bfhi(ov.x), bflo(ov.y), bfhi(ov.y), bflo(ov.z), bfhi(ov.z), bflo(ov.w), bfhi(ov.w)};
#pragma unroll
        for (int i = 0; i < 8; ++i) { v[i] *= sigmoidf_(o[i]); ss += v[i] * v[i]; }
      } else {
#pragma unroll
        for (int i = 0; i < 8; ++i) { v[i] *= siluf(z[i]); ss += v[i] * v[i]; }
      }
      ss += __shfl_xor(ss, 1); ss += __shfl_xor(ss, 2); ss += __shfl_xor(ss, 4);
      const float ss16 = ss + __shfl_xor(ss, 8);
      const float rn = ml ? rsqrtf(ss * (1.f / 64.f) + 1e-6f) : rsqrtf(ss16 * (1.f / 128.f) + 1e-6f);
      float o8[8];
#pragma unroll
      for (int i = 0; i < 8; ++i) { const float gg = i < 4 ? g0[i & 3] : g1[i & 3]; o8[i] = v[i] * rn * gg * (ml ? siluf(z[i]) : 1.f); }
      u32x4 w; w.x = pack2(o8[0], o8[1]); w.y = pack2(o8[2], o8[3]); w.z = pack2(o8[4], o8[5]); w.w = pack2(o8[6], o8[7]);
      *(u32x4*)yp = w;
    }
  }
}


constexpr int SEQ8_LDS_F = SEQ_LDS_S + 64 * KLD * 2;
constexpr int SEQ8_LDS_HALO = SEQ8_LDS_F + 8192;
constexpr int SEQ8_LDS_CW = SEQ8_LDS_HALO + 2 * 3 * 3 * 64 * 2;
DI void stage_conv_w8(float* wl, const float* cw, const float* cb, int chan0, int nchan, int tid) {
  if (tid < 320) { const int j = tid >> 6, cc = tid & 63; wl[tid] = j < 4 ? cw[j * nchan + chan0 + cc] : cb[chan0 + cc]; }
}
DI void scale_rows8(u16* A, const float* rs, int tid) {
  const int ch = (tid & 7) * 8;
#pragma unroll
  for (int i = 0; i < 2; ++i) {
    const int row = (tid >> 3) + 64 * i;
    const float f = rs[row];
    u32x4 v = *(u32x4*)(A + row * KLD + ch);
    v.x = pack2(bflo(v.x) * f, bfhi(v.x) * f); v.y = pack2(bflo(v.y) * f, bfhi(v.y) * f);
    v.z = pack2(bflo(v.z) * f, bfhi(v.z) * f); v.w = pack2(bflo(v.w) * f, bfhi(v.w) * f);
    *(u32x4*)(A + row * KLD + ch) = v;
  }
}
DI void state_update8(const u16* Xs, const u16* Bs, f32x4 (&acc)[2], int w8, int l15, int g) {
  const int tq = l15 >> 2, tp = l15 & 3, pt = w8 >> 1, nt0 = (w8 & 1) * 2;
#pragma unroll
  for (int kk = 0; kk < 4; ++kk) {
    const bf16x8 af = cat4(tr_read(Xs + (kk * 32 + 4 * g + tq) * KLD + pt * 16 + 4 * tp), tr_read(Xs + (kk * 32 + 16 + 4 * g + tq) * KLD + pt * 16 + 4 * tp));
#pragma unroll
    for (int n = 0; n < 2; ++n) {
      const bf16x8 bfr = cat4(tr_read(Bs + (kk * 32 + 4 * g + tq) * KLD + (nt0 + n) * 16 + 4 * tp), tr_read(Bs + (kk * 32 + 16 + 4 * g + tq) * KLD + (nt0 + n) * 16 + 4 * tp));
      acc[n] = mfma16(af, bfr, acc[n]);
    }
  }
}
DI void state_to_lds8(u16* Ss, const f32x4 (&acc)[2], int w8, int l15, int g) {
  const int pt = w8 >> 1, nt0 = (w8 & 1) * 2;
#pragma unroll
  for (int n = 0; n < 2; ++n)
#pragma unroll
    for (int r = 0; r < 4; ++r) Ss[(pt * 16 + 4 * g + r) * KLD + (nt0 + n) * 16 + l15] = f2bf(acc[n][r]);
}

constexpr int SEQ8_LDS_ZERO = SEQ8_LDS_CW + 3 * 320 * 4;
constexpr int SEQ8_LDS_RAW = ((SEQ8_LDS_ZERO + 3 * 128 + 255) / 256) * 256;
DI void raw_dma8(const u16* projb, int col0, int t0, u16* raw, int tid) {
#pragma unroll
  for (int i = 0; i < 2; ++i) {
    const int chunk = tid + 512 * i;
    __builtin_amdgcn_global_load_lds((const unsigned*)(projb + (size_t)(t0 + (chunk >> 3)) * NP + col0 + (chunk & 7) * 8), (LDSP unsigned*)((LDSP char*)raw + chunk * 16), 16, 0, 0);
  }
}
DI void conv_raw8(const u16* raw, const u16* halo, const float* wl, const float* rowscale, float cscale, u16* dst, int tid) {
  const int q = tid >> 3, ch = (tid & 7) * 8;
  u32x4 v[5];
#pragma unroll
  for (int k = 0; k < 5; ++k) { const int r = 2 * q - 3 + k; v[k] = r >= 0 ? *(const u32x4*)(raw + r * 64 + ch) : *(const u32x4*)(halo + (r + 3) * 64 + ch); }
  float w[5][8];
#pragma unroll
  for (int j = 0; j < 5; ++j) { const f32x4 w0 = *(const f32x4*)(wl + j * 64 + ch), w1 = *(const f32x4*)(wl + j * 64 + ch + 4);
    w[j][0] = w0[0]; w[j][1] = w0[1]; w[j][2] = w0[2]; w[j][3] = w0[3]; w[j][4] = w1[0]; w[j][5] = w1[1]; w[j][6] = w1[2]; w[j][7] = w1[3]; }
#pragma unroll
  for (int o = 0; o < 2; ++o) {
    float acc[8];
#pragma unroll
    for (int i = 0; i < 8; ++i) acc[i] = w[4][i];
#pragma unroll
    for (int j = 0; j < 4; ++j) {
      const u32x4 x = v[o + j];
      acc[0] += w[j][0] * bflo(x.x); acc[1] += w[j][1] * bfhi(x.x); acc[2] += w[j][2] * bflo(x.y); acc[3] += w[j][3] * bfhi(x.y);
      acc[4] += w[j][4] * bflo(x.z); acc[5] += w[j][5] * bfhi(x.z); acc[6] += w[j][6] * bflo(x.w); acc[7] += w[j][7] * bfhi(x.w);
    }
    const float rs = (rowscale ? rowscale[2 * q + o] : 1.f) * cscale;
#pragma unroll
    for (int i = 0; i < 8; ++i) acc[i] = siluf(acc[i]) * rs;
    u32x4 ov; ov.x = pack2(acc[0], acc[1]); ov.y = pack2(acc[2], acc[3]); ov.z = pack2(acc[4], acc[5]); ov.w = pack2(acc[6], acc[7]);
    *(u32x4*)(dst + (2 * q + o) * KLD + ch) = ov;
  }
}
DI void save_halo8(const u16* raw, u16* halo, int tid) {
  if (tid < 72) { const int arr = tid / 24, rem = tid % 24; *(u32x4*)(halo + arr * 192 + rem * 8) = *(const u32x4*)(raw + arr * 8192 + 125 * 64 + rem * 8); }
}

DI void ssd_task8(const Params& p, int layer, int b, int h, unsigned char* smem) {
  u16* Cs = (u16*)(smem + SEQ_LDS_A); u16* Bs = (u16*)(smem + SEQ_LDS_B); u16* Xs = (u16*)(smem + SEQ_LDS_C); u16* Ss = (u16*)(smem + SEQ_LDS_S);
  float* fl = (float*)(smem + SEQ8_LDS_F);
  float* dts = fl; float* acs = fl + 128; float* wend = fl + 256; float* tmp = fl + 384;
  u16* halo = (u16*)(smem + SEQ8_LDS_HALO); float* cwl = (float*)(smem + SEQ8_LDS_CW); u16* zero3 = (u16*)(smem + SEQ8_LDS_ZERO);
  u16* raw = (u16*)(smem + SEQ8_LDS_RAW);
  int tid = otid512(), lane = tid & 63, w = tid >> 6, l15 = lane & 15, g = lane >> 4;
  const int gi = h >> 1;
  const u16* projb = (const u16*)(p.ws + OFF_PROJ) + (size_t)b * SEQ * NP;
  const float* smb = (const float*)(p.ws + OFF_SMALL) + (size_t)b * SEQ * NSMALL;
  const float* cw = p.ssm_conv_w + layer * 4 * 512; const float* cb = p.ssm_conv_b + layer * 512;
  u16* Y = (u16*)(p.ws + OFF_H);
  const float a_h = sgprf(-__expf(p.ssm_a_log[layer * 4 + h])), d_h = sgprf(p.ssm_d[layer * 4 + h]), dtb = sgprf(p.ssm_dt_bias[layer * 4 + h]);
  const int colB = PC_XBC + 256 + gi * 64, colC = PC_XBC + 384 + gi * 64, colX = PC_XBC + h * 64;
  f32x4 st[2] = {(f32x4){0.f, 0.f, 0.f, 0.f}, (f32x4){0.f, 0.f, 0.f, 0.f}};
  lds_barrier();
  stage_conv_w8(cwl, cw, cb, 256 + gi * 64, 512, tid);
  stage_conv_w8(cwl + 320, cw, cb, 384 + gi * 64, 512, tid);
  stage_conv_w8(cwl + 640, cw, cb, h * 64, 512, tid);
  if (tid < 96) ((unsigned*)zero3)[tid] = 0u;
  raw_dma8(projb, colB, 0, raw, tid); raw_dma8(projb, colC, 0, raw + 8192, tid); raw_dma8(projb, colX, 0, raw + 16384, tid);
  float dtraw = 0.f;
  if (tid < 128) dtraw = smb[(size_t)tid * NSMALL + SM_DT + h];
#pragma unroll 1
  for (int c = 0; c < 32; ++c) {
    const int t0 = c * 128;
    asm volatile("" : "+v"(tid)); lane = tid & 63; w = tid >> 6; l15 = lane & 15; g = lane >> 4;
    float dtv = 0.f;
    if (tid < 128) { const float xr = dtraw + dtb; dtv = xr > 15.f ? xr : (xr < -15.f ? __expf(xr) : __logf(1.f + __expf(xr))); }
    float cs = wave_scan_add(dtv * a_h, lane);
    if (tid == 63) tmp[0] = cs;
    asm volatile("s_waitcnt vmcnt(0)" ::: "memory");
    lds_barrier();
    if (w == 1) cs += tmp[0];
    if (tid < 128) { dts[tid] = dtv; acs[tid] = cs; }
    if (c + 1 < 32 && tid < 128) dtraw = smb[(size_t)(t0 + 128 + tid) * NSMALL + SM_DT + h];
    lds_barrier();
    {
      const u16* hc = halo + (c & 1) * 576;
      const u16* hB = c == 0 ? zero3 : hc; const u16* hC = c == 0 ? zero3 : hc + 192; const u16* hX = c == 0 ? zero3 : hc + 384;
      conv_raw8(raw, hB, cwl, nullptr, 1.f, Bs, tid);
      conv_raw8(raw + 8192, hC, cwl + 320, nullptr, 1.f, Cs, tid);
      conv_raw8(raw + 16384, hX, cwl + 640, dts, 1.f, Xs, tid);
      save_halo8(raw, halo + ((c + 1) & 1) * 576, tid);
    }
    if (tid < 128) wend[tid] = __expf(acs[127] - acs[tid]);
    state_to_lds8(Ss, st, w, l15, g);
    lds_barrier();
    if (c + 1 < 32) { raw_dma8(projb, colB, t0 + 128, raw, tid); raw_dma8(projb, colC, t0 + 128, raw + 8192, tid); raw_dma8(projb, colX, t0 + 128, raw + 16384, tid); }
    {
      const int tl = 16 * w + l15;
      bf16x8 cf[2];
#pragma unroll
      for (int ks = 0; ks < 2; ++ks) cf[ks] = ldfrag(Cs + tl * KLD + ks * 32 + 8 * g);
      f32x4 y[4];
#pragma unroll
      for (int d = 0; d < 4; ++d) y[d] = (f32x4){0.f, 0.f, 0.f, 0.f};
      const float at = acs[tl];
#pragma unroll 1
      for (int stl = 0; stl < 2; ++stl) {
        if (stl * 64 <= 16 * w + 15) {
          f32x4 sc[4];
          qk_tile1<2>(Bs + stl * 64 * KLD, cf, sc, l15, g);
#pragma unroll
          for (int kt = 0; kt < 4; ++kt) {
            const f32x4 as = *(const f32x4*)(acs + stl * 64 + kt * 16 + 4 * g);
#pragma unroll
            for (int r = 0; r < 4; ++r) {
              const bool ok = stl * 64 + kt * 16 + 4 * g + r <= tl;
              sc[kt][r] = ok ? sc[kt][r] * __expf(at - as[r]) : 0.f;
            }
          }
          pv_accum1(sc, Xs + stl * 64 * KLD, y, l15, g);
        }
      }
      const float ea = __expf(at), dsk = d_h / dts[tl];
      const size_t row = (size_t)b * SEQ + t0 + tl;
#pragma unroll
      for (int d = 0; d < 4; ++d) {
        f32x4 yo = (f32x4){0.f, 0.f, 0.f, 0.f};
#pragma unroll
        for (int ks = 0; ks < 2; ++ks) yo = mfma16(ldfrag(Ss + (d * 16 + l15) * KLD + ks * 32 + 8 * g), cf[ks], yo);
        const u32x2 xv = *(const u32x2*)(Xs + tl * KLD + d * 16 + 4 * g);
        const f32x4 v = y[d] + yo * ea;
        u32x2 o; o.x = pack2(v[0] + dsk * bflo(xv.x), v[1] + dsk * bfhi(xv.x)); o.y = pack2(v[2] + dsk * bflo(xv.y), v[3] + dsk * bfhi(xv.y));
        *(u32x2*)(Y + row * 1024 + Y_C + h * 64 + d * 16 + 4 * g) = o;
      }
    }
    lds_barrier();
    scale_rows8(Xs, wend, tid);
    lds_barrier();
    const float cd = __expf(acs[127]);
    st[0] *= cd; st[1] *= cd;
    state_update8(Xs, Bs, st, w, l15, g);
  }
  asm volatile("s_waitcnt vmcnt(0)" ::: "memory");
}

DI void mlstm_task8(const Params& p, int layer, int b, int h, unsigned char* smem) {
  u16* Qs = (u16*)(smem + SEQ_LDS_A); u16* Ks2 = (u16*)(smem + SEQ_LDS_B); u16* Vs2 = (u16*)(smem + SEQ_LDS_C); u16* Cst = (u16*)(smem + SEQ_LDS_S);
  float* fl = (float*)(smem + SEQ8_LDS_F);
  float* bcs = fl; float* us = fl + 128; float* pms = fl + 256; float* wend = fl + 384; float* nst = fl + 512; float* tmp = fl + 576; float* npart = fl + 640;
  u16* halo = (u16*)(smem + SEQ8_LDS_HALO); float* cwl = (float*)(smem + SEQ8_LDS_CW); u16* zero3 = (u16*)(smem + SEQ8_LDS_ZERO);
  u16* raw = (u16*)(smem + SEQ8_LDS_RAW);
  int tid = otid512(), lane = tid & 63, w = tid >> 6, l15 = lane & 15, g = lane >> 4;
  const u16* projb = (const u16*)(p.ws + OFF_PROJ) + (size_t)b * SEQ * NP;
  const float* smb = (const float*)(p.ws + OFF_SMALL) + (size_t)b * SEQ * NSMALL;
  const float* cw = p.ml_conv_w + layer * 4 * 512; const float* cb = p.ml_conv_b + layer * 512;
  const float ib = sgprf(p.ml_if_b[layer * 8 + h]), fb = sgprf(p.ml_if_b[layer * 8 + 4 + h]);
  u16* Y = (u16*)(p.ws + OFF_H);
  const int colQ = PD_QK + h * 64, colK = PD_QK + 256 + h * 64, colV = PD_V + h * 64;
  f32x4 st[2] = {(f32x4){0.f, 0.f, 0.f, 0.f}, (f32x4){0.f, 0.f, 0.f, 0.f}};
  float m_prev = 0.f;
  lds_barrier();
  if (tid < 64) nst[tid] = 0.f;
  stage_conv_w8(cwl, cw, cb, h * 64, 512, tid);
  stage_conv_w8(cwl + 320, cw, cb, 256 + h * 64, 512, tid);
  if (tid < 96) ((unsigned*)zero3)[tid] = 0u;
  raw_dma8(projb, colQ, 0, raw, tid); raw_dma8(projb, colK, 0, raw + 8192, tid); raw_dma8(projb, colV, 0, raw + 16384, tid);
  float iraw = 0.f, fraw = 0.f;
  if (tid < 128) { iraw = smb[(size_t)tid * NSMALL + SM_IF + h]; fraw = smb[(size_t)tid * NSMALL + SM_IF + 4 + h]; }
#pragma unroll 1
  for (int c = 0; c < 32; ++c) {
    const int t0 = c * 128;
    asm volatile("" : "+v"(tid)); lane = tid & 63; w = tid >> 6; l15 = lane & 15; g = lane >> 4;
    float ip = 0.f, lf = 0.f;
    if (tid < 128) { ip = iraw + ib; const float fp = fraw + fb; lf = fminf(fp, 0.f) - __logf(1.f + __expf(-fabsf(fp))); }
    float bc = wave_scan_add(lf, lane);
    if (tid == 63) tmp[0] = bc;
    asm volatile("s_waitcnt vmcnt(0)" ::: "memory");
    lds_barrier();
    if (w == 1) bc += tmp[0];
    const float u = tid < 128 ? ip - bc : -1e30f;
    float pm = wave_scan_max(u, lane);
    if (tid == 63) tmp[1] = pm;
    if (c + 1 < 32 && tid < 128) { iraw = smb[(size_t)(t0 + 128 + tid) * NSMALL + SM_IF + h]; fraw = smb[(size_t)(t0 + 128 + tid) * NSMALL + SM_IF + 4 + h]; }
    {
      const u16* hc = halo + (c & 1) * 576;
      const u16* hQ = c == 0 ? zero3 : hc; const u16* hK = c == 0 ? zero3 : hc + 192;
      conv_raw8(raw, hQ, cwl, nullptr, 1.f, Qs, tid);
      conv_raw8(raw + 8192, hK, cwl + 320, nullptr, 0.125f, Ks2, tid);
      save_halo8(raw, halo + ((c + 1) & 1) * 576, tid);
#pragma unroll
      for (int i = 0; i < 2; ++i) { const int chunk = tid + 512 * i; *(u32x4*)(Vs2 + (chunk >> 3) * KLD + (chunk & 7) * 8) = *(const u32x4*)(raw + 16384 + chunk * 8); }
    }
    state_to_lds8(Cst, st, w, l15, g);
    lds_barrier();
    if (w == 1) pm = fmaxf(pm, tmp[1]);
    if (tid < 128) { bcs[tid] = bc; us[tid] = u; pms[tid] = pm; }
    if (c + 1 < 32) { raw_dma8(projb, colQ, t0 + 128, raw, tid); raw_dma8(projb, colK, t0 + 128, raw + 8192, tid); raw_dma8(projb, colV, t0 + 128, raw + 16384, tid); }
    lds_barrier();
    const float blast = bcs[127];
    const float m_new = blast + fmaxf(m_prev, pms[127]);
    if (tid < 128) wend[tid] = __expf(blast - m_new + us[tid]);
    {
      const int tl = 16 * w + l15;
      bf16x8 qf[2];
#pragma unroll
      for (int ks = 0; ks < 2; ++ks) qf[ks] = ldfrag(Qs + tl * KLD + ks * 32 + 8 * g);
      f32x4 num[4];
#pragma unroll
      for (int d = 0; d < 4; ++d) num[d] = (f32x4){0.f, 0.f, 0.f, 0.f};
      const float bt = bcs[tl], mt = bt + fmaxf(m_prev, pms[tl]);
      float den = 0.f;
#pragma unroll 1
      for (int stl = 0; stl < 2; ++stl) {
        if (stl * 64 <= 16 * w + 15) {
          f32x4 sc[4];
          qk_tile1<2>(Ks2 + stl * 64 * KLD, qf, sc, l15, g);
#pragma unroll
          for (int kt = 0; kt < 4; ++kt) {
            const f32x4 uu = *(const f32x4*)(us + stl * 64 + kt * 16 + 4 * g);
#pragma unroll
            for (int r = 0; r < 4; ++r) {
              const bool ok = stl * 64 + kt * 16 + 4 * g + r <= tl;
              const float v = ok ? sc[kt][r] * __expf(bt - mt + uu[r]) : 0.f;
              sc[kt][r] = v; den += v;
            }
          }
          pv_accum1(sc, Vs2 + stl * 64 * KLD, num, l15, g);
        }
      }
      const float wi = __expf(bt + m_prev - mt);
      float qn = 0.f;
#pragma unroll
      for (int ks = 0; ks < 2; ++ks)
#pragma unroll
        for (int j = 0; j < 8; ++j) qn += bf2f((u16)qf[ks][j]) * nst[ks * 32 + 8 * g + j];
      qn = group_sum4(qn);
      const float dn = group_sum4(den) + wi * qn;
      const float inv = __builtin_amdgcn_rcpf(fmaxf(fabsf(dn), __expf(-mt)));
      const size_t row = (size_t)b * SEQ + t0 + tl;
#pragma unroll
      for (int d = 0; d < 4; ++d) {
        f32x4 ni = (f32x4){0.f, 0.f, 0.f, 0.f};
#pragma unroll
        for (int ks = 0; ks < 2; ++ks) ni = mfma16(ldfrag(Cst + (d * 16 + l15) * KLD + ks * 32 + 8 * g), qf[ks], ni);
        const f32x4 v = (num[d] + ni * wi) * inv;
        u32x2 o; o.x = pack2(v[0], v[1]); o.y = pack2(v[2], v[3]);
        *(u32x2*)(Y + row * 1024 + Y_D + h * 64 + d * 16 + 4 * g) = o;
      }
    }
    lds_barrier();
    scale_rows8(Ks2, wend, tid);
    lds_barrier();
    const float fprev = __expf(blast + m_prev - m_new);
    st[0] *= fprev; st[1] *= fprev;
    state_update8(Vs2, Ks2, st, w, l15, g);
    {
      const int e = tid & 63, part = tid >> 6;
      float a = 0.f;
#pragma unroll
      for (int s2 = 0; s2 < 16; ++s2) a += bf2f(Ks2[(part * 16 + s2) * KLD + e]);
      npart[part * 64 + e] = a;
    }
    lds_barrier();
    if (tid < 64) {
      float a = nst[tid] * fprev;
#pragma unroll
      for (int pp = 0; pp < 8; ++pp) a += npart[pp * 64 + tid];
      nst[tid] = a;
    }
    m_prev = m_new;
  }
  asm volatile("s_waitcnt vmcnt(0)" ::: "memory");
}

DI void compress_task(const Params& p, int layer, int b, int kv, int rb, unsigned char* smem) {
  constexpr int HLD = 136;
  u16* Hs = (u16*)smem;
  const int tid = otid(), lane = tid & 63, w = tid >> 6, l15 = lane & 15, g = lane >> 4;
  const u16* projb = (const u16*)(p.ws + OFF_PROJ) + (size_t)b * SEQ * NP + (kv ? PA_VC : PA_KC);
  const int mi = layer * 2 + kv;
  const u16* W1T = (const u16*)(p.ws + OFF_W1T) + (size_t)mi * 128 * 2048;
  const u16* W2T = (const u16*)(p.ws + OFF_W2T) + (size_t)mi * 64 * 128;
  const float* bias1 = (const float*)(p.ws + OFF_BIAS1) + mi * 16 * 128;
  f32x4 acc[2][2];
#pragma unroll
  for (int nt = 0; nt < 2; ++nt) { acc[nt][0] = (f32x4){0.f, 0.f, 0.f, 0.f}; acc[nt][1] = (f32x4){0.f, 0.f, 0.f, 0.f}; }
  int tok[2];
#pragma unroll
  for (int mt = 0; mt < 2; ++mt) { int i = rb * 32 + mt * 16 + l15; if (i > 254) i = 254; tok[mt] = 16 * i; }
#pragma unroll 4
  for (int ks = 0; ks < 64; ++ks) {
    const int j = ks >> 1, d0 = (ks & 1) * 32;
    bf16x8 af[2], wf[2];
#pragma unroll
    for (int mt = 0; mt < 2; ++mt) af[mt] = ldfrag(projb + (size_t)(tok[mt] + j) * NP + d0 + 8 * g);
#pragma unroll
    for (int nt = 0; nt < 2; ++nt) wf[nt] = ldfrag(W1T + (size_t)(w * 32 + nt * 16 + l15) * 2048 + ks * 32 + 8 * g);
#pragma unroll
    for (int nt = 0; nt < 2; ++nt)
#pragma unroll
      for (int mt = 0; mt < 2; ++mt) acc[nt][mt] = mfma16(wf[nt], af[mt], acc[nt][mt]);
  }
  lds_barrier();
#pragma unroll
  for (int nt = 0; nt < 2; ++nt) {
    const int n = w * 32 + nt * 16 + 4 * g;
    f32x4 bp[16];
#pragma unroll
    for (int pc = 0; pc < 16; ++pc) bp[pc] = *(const f32x4*)(bias1 + pc * 128 + n);
#pragma unroll
    for (int pc = 0; pc < 16; pc += 4) asm volatile("" : "+v"(bp[pc]), "+v"(bp[pc + 1]), "+v"(bp[pc + 2]), "+v"(bp[pc + 3]));
    f32x4 bb = bp[0];
#pragma unroll
    for (int pc = 1; pc < 16; ++pc) bb += bp[pc];
#pragma unroll
    for (int mt = 0; mt < 2; ++mt) {
      const f32x4 v = acc[nt][mt] + bb;
      u32x2 o; o.x = pack2(siluf(v[0]), siluf(v[1])); o.y = pack2(siluf(v[2]), siluf(v[3]));
      *(u32x2*)(Hs + (mt * 16 + l15) * HLD + n) = o;
    }
  }
  lds_barrier();
  f32x4 acc2[2] = {(f32x4){0.f, 0.f, 0.f, 0.f}, (f32x4){0.f, 0.f, 0.f, 0.f}};
#pragma unroll
  for (int ks = 0; ks < 4; ++ks) {
    const bf16x8 wf = ldfrag(W2T + (size_t)(w * 16 + l15) * 128 + ks * 32 + 8 * g);
#pragma unroll
    for (int mt = 0; mt < 2; ++mt) acc2[mt] = mfma16(wf, ldfrag(Hs + (mt * 16 + l15) * HLD + ks * 32 + 8 * g), acc2[mt]);
  }
  u16* dst = (u16*)(p.ws + (kv ? OFF_VCMP : OFF_KCMP) + (size_t)layer * 512 * 1024) + (size_t)b * 256 * 64;
#pragma unroll
  for (int mt = 0; mt < 2; ++mt) {
    const int i = rb * 32 + mt * 16 + l15;
    u32x2 o; o.x = pack2(acc2[mt][0], acc2[mt][1]); o.y = pack2(acc2[mt][2], acc2[mt][3]);
    if (i > 254) { o.x = 0u; o.y = 0u; }
    *(u32x2*)(dst + (size_t)i * 64 + w * 16 + 4 * g) = o;
  }
}

DI void nsa_task(const Params& p, int layer, int b, int qi, unsigned char* smem) {
  u16* Ks = (u16*)smem; u16* Vs = Ks + 64 * KLD;
  float* T = (float*)(smem + 2 * KVBUF * 2);
  unsigned long long* selm = (unsigned long long*)(smem + 2 * KVBUF * 2 + 4 * 32 * 65 * 4);
  const int tid = otid(), lane = tid & 63, h = tid >> 6, l15 = lane & 15, g = lane >> 4;
  const int q0 = qi * 32;
  const u16* projb = (const u16*)(p.ws + OFF_PROJ) + (size_t)b * SEQ * NP;
  const float* smb = (const float*)(p.ws + OFF_SMALL) + (size_t)b * SEQ * NSMALL;
  const u16* kcmp = (const u16*)(p.ws + OFF_KCMP + (size_t)layer * 512 * 1024) + (size_t)b * 256 * 64;
  const u16* vcmp = (const u16*)(p.ws + OFF_VCMP + (size_t)layer * 512 * 1024) + (size_t)b * 256 * 64;
  bf16x8 qf[2][2];
#pragma unroll
  for (int qt = 0; qt < 2; ++qt)
#pragma unroll
    for (int ks = 0; ks < 2; ++ks) qf[qt][ks] = ldfrag(projb + (size_t)(q0 + qt * 16 + l15) * NP + PA_Q + h * 64 + ks * 32 + 8 * g);
  const float sc = 0.125f * 1.4426950408889634f;
  f32x4 outacc[4][2];
  AttnAcc a;
  const int ntc = (q0 >> 10) + 1;
  attn_init(a);
  lds_barrier();
  for (int i = tid; i < 4 * 32 * 65; i += 256) T[i] = 0.f;
  kv_pipeline(0, ntc, Ks,
    [&](int) { return true; },
    [&](int j, KVRegs& kr) { kv_load(kcmp, vcmp, 64, 64, j * 64, kr); },
    [&](int j, const u16* Kt, const u16* Vt) {
      f32x4 s[4][2];
      auto valid = [&](int kt, int r, int qt) { return 16 * (j * 64 + kt * 16 + 4 * g + r) + 31 <= q0 + qt * 16 + l15; };
      qk_tile<2>(Kt, 0, qf, s, l15, g);
      softmax_pv(s, a, Vt, sc, l15, g, valid);
    });
  float cinv[2];
#pragma unroll
  for (int qt = 0; qt < 2; ++qt) {
    const float lt = group_sum4(a.l[qt]);
    cinv[qt] = lt > 0.f ? 1.f / lt : 0.f;
    const float gt = sigmoidf_(smb[(size_t)(q0 + qt * 16 + l15) * NSMALL + SM_G + h * 3 + 0]) * cinv[qt];
#pragma unroll
    for (int d = 0; d < 4; ++d) outacc[d][qt] = a.o[d][qt] * gt;
  }
  float carry[2] = {0.f, 0.f};
  kv_pipeline(0, ntc, Ks,
    [&](int) { return true; },
    [&](int j, KVRegs& kr) { kv_load(kcmp, vcmp, 64, 64, j * 64, kr); },
    [&](int j, const u16* Kt, const u16*) {
      f32x4 s[4][2];
      qk_tile<2>(Kt, 0, qf, s, l15, g);
#pragma unroll
      for (int qt = 0; qt < 2; ++qt) {
        float prev3 = carry[qt];
#pragma unroll
        for (int kt = 0; kt < 4; ++kt) {
          float pr[4];
#pragma unroll
          for (int r = 0; r < 4; ++r) {
            const bool ok = 16 * (j * 64 + kt * 16 + 4 * g + r) + 31 <= q0 + qt * 16 + l15;
            pr[r] = ok ? exp2_(s[kt][qt][r] * sc - a.m[qt]) * cinv[qt] : 0.f;
          }
          const float below = __shfl_up(pr[3], 16);
          const float wrap = __shfl(prev3, l15 + 48);
          const float nb = g > 0 ? below : wrap;
          T[(h * 32 + qt * 16 + l15) * 65 + j * 16 + kt * 4 + g] = (pr[0] + pr[1]) + (pr[2] + 0.5f * pr[3]) + 0.5f * nb;
          prev3 = pr[3];
        }
        carry[qt] = prev3;
      }
    });
  lds_barrier();
#pragma unroll 1
  for (int qq = 0; qq < 8; ++qq) {
    const int q = h * 8 + qq, t = q0 + q, cur = t >> 6;
    const float imp = ((T[(0 * 32 + q) * 65 + lane] + T[(1 * 32 + q) * 65 + lane]) + T[(2 * 32 + q) * 65 + lane]) + T[(3 * 32 + q) * 65 + lane];
    const bool forced = lane == cur || lane == 0, allowed = lane <= cur, cand = allowed && !forced;
    const int K = cur == 0 ? 15 : 14;
    unsigned long long m;
    if (__popcll(__ballot(cand)) <= K) m = __ballot(allowed);
    else {
      const unsigned key = __float_as_uint(imp);
      unsigned prefix = 0u;
#pragma unroll 1
      for (int bit = 30; bit >= 0; --bit) {
        const unsigned cnd = prefix | (1u << bit);
        if (__popcll(__ballot(cand && key >= cnd)) >= K) prefix = cnd;
      }
      const unsigned long long gt = __ballot(cand && key > prefix), eq = __ballot(cand && key == prefix);
      const int need = K - __popcll(gt);
      const int myrank = __popcll(eq & ((1ull << lane) - 1ull));
      m = gt | __ballot(cand && key == prefix && myrank < need) | __ballot(forced);
    }
    if (lane == 0) selm[q] = m;
  }
  lds_barrier();
  f32x4* park = (f32x4*)T + (h * 8) * 64 + lane;
#pragma unroll
  for (int d = 0; d < 4; ++d) { park[(d * 2 + 0) * 64] = outacc[d][0]; park[(d * 2 + 1) * 64] = outacc[d][1]; }
  unsigned long long mq[2], anym = 0ull;
#pragma unroll
  for (int qt = 0; qt < 2; ++qt) mq[qt] = selm[qt * 16 + l15];
  for (int i = 0; i < 32; ++i) anym |= selm[i];
  const int jhi = (q0 + 31) >> 6;
#pragma unroll
  for (int qt = 0; qt < 2; ++qt)
#pragma unroll
    for (int ks = 0; ks < 2; ++ks) qf[qt][ks] = scale_frag(qf[qt][ks], sc);
  attn_init_rel(a);
  kv_pipeline(0, jhi + 1, Ks,
    [&](int j) { return (bool)((anym >> j) & 1ull); },
    [&](int j, KVRegs& kr) { kv_load(projb + PA_KS, projb + PA_VS, NP, NP, j * 64, kr); },
    [&](int j, const u16* Kt, const u16* Vt) {
      f32x4 s[4][2];
      auto valid = [&](int kt, int r, int qt) { return ((mq[qt] >> j) & 1ull) && (j * 64 + kt * 16 + 4 * g + r <= q0 + qt * 16 + l15); };
      bf16x8 pf[2][2];
      if (j * 64 + 63 <= q0) {
        qk_tile_rel<2>(Kt, 0, qf, a, s, l15, g, (bool)((mq[0] >> j) & 1ull), (bool)((mq[1] >> j) & 1ull));
        softmax_rel<0>(s, a, pf, l15, valid);
      } else {
        qk_tile_rel<2>(Kt, 0, qf, a, s, l15, g);
        softmax_rel<1>(s, a, pf, l15, valid);
      }
      pv_accum(pf, Vt, a.o, l15, g);
      rowsum_accum(pf, a, l15);
    });
#pragma unroll
  for (int qt = 0; qt < 2; ++qt) {
    const float lt = rel_rowsum(a, qt, l15);
    const float gt = sigmoidf_(smb[(size_t)(q0 + qt * 16 + l15) * NSMALL + SM_G + h * 3 + 1]) * (lt > 0.f ? 1.f / lt : 0.f);
#pragma unroll
    for (int d = 0; d < 4; ++d) park[(d * 2 + qt) * 64] += a.o[d][qt] * gt;
  }
  attn_init_rel(a);
  const int jlo = q0 >= 511 ? (q0 - 511) >> 6 : 0;
  kv_pipeline(jlo, jhi + 1, Ks,
    [&](int) { return true; },
    [&](int j, KVRegs& kr) { kv_load(projb + PA_KW, projb + PA_VW, NP, NP, j * 64, kr); },
    [&](int j, const u16* Kt, const u16* Vt) {
      f32x4 s[4][2];
      auto valid = [&](int kt, int r, int qt) { const int key = j * 64 + kt * 16 + 4 * g + r, t = q0 + qt * 16 + l15; return key <= t && key + 512 > t; };
      bf16x8 pf[2][2];
      qk_tile_rel<2>(Kt, 0, qf, a, s, l15, g);
      if (j * 64 + 63 <= q0 && j * 64 + 512 > q0 + 31) softmax_rel<0>(s, a, pf, l15, valid);
      else softmax_rel<1>(s, a, pf, l15, valid);
      pv_accum(pf, Vt, a.o, l15, g);
      rowsum_accum(pf, a, l15);
    });
  u16* Y = (u16*)(p.ws + OFF_H);
  const float* ng = p.nsa_norm_g + layer * 64;
#pragma unroll
  for (int qt = 0; qt < 2; ++qt) {
    const int t = q0 + qt * 16 + l15;
    const float lt = rel_rowsum(a, qt, l15);
    const float gt = sigmoidf_(smb[(size_t)t * NSMALL + SM_G + h * 3 + 2]) * (lt > 0.f ? 1.f / lt : 0.f);
    f32x4 v[4]; float ss = 0.f;
#pragma unroll
    for (int d = 0; d < 4; ++d) { v[d] = park[(d * 2 + qt) * 64] + a.o[d][qt] * gt; ss += v[d][0] * v[d][0] + v[d][1] * v[d][1] + v[d][2] * v[d][2] + v[d][3] * v[d][3]; }
    ss = group_sum4(ss);
    const float rn = rsqrtf(ss * (1.f / 64.f) + 1e-6f);
    const size_t row = (size_t)b * SEQ + t;
#pragma unroll
    for (int d = 0; d < 4; ++d) {
      const int dd = d * 16 + 4 * g;
      const u32x2 zz = *(const u32x2*)(projb + (size_t)t * NP + PA_Z + h * 64 + dd);
      const f32x4 gg = *(const f32x4*)(ng + dd);
      u32x2 o;
      o.x = pack2(v[d][0] * rn * gg[0] * siluf(bflo(zz.x)), v[d][1] * rn * gg[1] * siluf(bfhi(zz.x)));
      o.y = pack2(v[d][2] * rn * gg[2] * siluf(bflo(zz.y)), v[d][3] * rn * gg[3] * siluf(bfhi(zz.y)));
      *(u32x2*)(Y + row * 1024 + Y_A + h * 64 + dd) = o;
    }
  }
}


DI void final_norm_rows(const Params& p, int rbase, int nrows, int gw, int nw, int lane) {
  const float4* gp = (const float4*)p.final_g;
  float4 gg[4];
#pragma unroll
  for (int i = 0; i < 4; ++i) gg[i] = gp[lane + 64 * i];
  for (int row0 = rbase + gw * 4; row0 < rbase + nrows; row0 += nw * 4) {
    f32x4 v[4][4]; float ss[4];
#pragma unroll
    for (int j = 0; j < 4; ++j) {
      const f32x4* xr = (const f32x4*)(p.out + (size_t)(row0 + j) * D_MODEL);
#pragma unroll
      for (int i = 0; i < 4; ++i) v[j][i] = xr[lane + 64 * i];
    }
    asm volatile("" : "+v"(v[0][0]), "+v"(v[0][1]), "+v"(v[0][2]), "+v"(v[0][3]), "+v"(v[1][0]), "+v"(v[1][1]), "+v"(v[1][2]), "+v"(v[1][3]), "+v"(v[2][0]), "+v"(v[2][1]), "+v"(v[2][2]), "+v"(v[2][3]), "+v"(v[3][0]), "+v"(v[3][1]), "+v"(v[3][2]), "+v"(v[3][3]));
#pragma unroll
    for (int j = 0; j < 4; ++j) {
      float a = 0.f;
#pragma unroll
      for (int i = 0; i < 4; ++i) a += v[j][i][0] * v[j][i][0] + v[j][i][1] * v[j][i][1] + v[j][i][2] * v[j][i][2] + v[j][i][3] * v[j][i][3];
      ss[j] = wave_sum(a);
    }
#pragma unroll
    for (int j = 0; j < 4; ++j) {
      float4* xr = (float4*)(p.out + (size_t)(row0 + j) * D_MODEL);
      const float r = rsqrtf(ss[j] * (1.f / D_MODEL) + 1e-6f);
#pragma unroll
      for (int i = 0; i < 4; ++i) { float4 w; w.x = v[j][i][0] * r * gg[i].x; w.y = v[j][i][1] * r * gg[i].y; w.z = v[j][i][2] * r * gg[i].z; w.w = v[j][i][3] * r * gg[i].w; xr[lane + 64 * i] = w; }
    }
  }
}

#define XB_TMO      128
#define XB_XCNT(j)  (256  + 64 * (j))
#define XB_XSUB(j)  (1280 + 64 * (j))
#define XB_XGEN(j)  (2304 + 64 * (j))
#define XB_TOP      3328
#define XB_TOPGEN   3392
#define XCD_BAR_WORDS 3456
#define XB_SPIN_CAP (1u << 23)
DI unsigned xb_ld(unsigned* p)              { return __hip_atomic_load(p, __ATOMIC_RELAXED, __HIP_MEMORY_SCOPE_AGENT); }
DI unsigned xb_add(unsigned* p, unsigned v) { return __hip_atomic_fetch_add(p, v, __ATOMIC_RELAXED, __HIP_MEMORY_SCOPE_AGENT); }
DI unsigned xb_xcc_id() { return (unsigned)__builtin_amdgcn_s_getreg((3 << 11) | 20) & 0xFu; }
#define XB_SPIN(cond, bar) do { unsigned _sp = 0; while (cond) { __builtin_amdgcn_s_sleep(1); \
    if ((++_sp & 255u) == 0u) { if (xb_ld(&(bar)[XB_TMO])) break; if (_sp > XB_SPIN_CAP) { atomicAdd(&(bar)[XB_TMO], 1u); break; } } } } while (0)
struct XcdBarrier { unsigned* bar; unsigned x; volatile LDSP unsigned* st; };
DI XcdBarrier xcd_barrier_post(unsigned* bar, volatile LDSP unsigned* st) {
  XcdBarrier b; b.bar = bar; b.x = xb_xcc_id(); b.st = st;
  if (threadIdx.x == 0) (void)xb_add(&bar[XB_XCNT(b.x)], 1u);
  return b;
}
DI void xcd_barrier_complete(unsigned* bar, unsigned x, unsigned& nloc, unsigned& nx) {
  const unsigned G = gridDim.x * gridDim.y * gridDim.z;
  unsigned sum, cnt, mine, sp = 0u;
  for (;;) {
    sum = 0u; cnt = 0u; mine = 0u;
#pragma unroll
    for (unsigned j = 0; j < 16; ++j) { const unsigned c = xb_ld(&bar[XB_XCNT(j)]); sum += c; cnt += (c > 0u) ? 1u : 0u; mine = (j == x) ? c : mine; }
    if (sum == G) break;
    __builtin_amdgcn_s_sleep(1);
    if ((++sp & 255u) == 0u) { if (xb_ld(&bar[XB_TMO])) break; if (sp > XB_SPIN_CAP) { atomicAdd(&bar[XB_TMO], 1u); break; } }
  }
  nloc = mine > 0u ? mine : 1u; nx = cnt > 0u ? cnt : 1u;
}
DI void xcd_barrier(const XcdBarrier& b) {
  asm volatile("s_waitcnt vmcnt(0)" ::: "memory");
  __syncthreads();
  if (threadIdx.x == 0) {
    unsigned* bar = b.bar;
    __builtin_amdgcn_s_waitcnt(0);
    unsigned nloc = b.st[0], nx = b.st[1];
    if (nloc == 0u) { xcd_barrier_complete(bar, b.x, nloc, nx); b.st[0] = nloc; b.st[1] = nx; }
    const unsigned old = xb_add(&bar[XB_XSUB(b.x)], 1u);
    const unsigned gen = old / nloc;
    if (old + 1u == (gen + 1u) * nloc) {
      __builtin_amdgcn_fence(__ATOMIC_RELEASE, "agent");
      asm volatile("s_waitcnt vmcnt(0)" ::: "memory");
      const unsigned og = xb_add(&bar[XB_TOP], 1u);
      const unsigned tg = og / nx;
      if (og + 1u == (tg + 1u) * nx) xb_add(&bar[XB_TOPGEN], 1u);
      else XB_SPIN(xb_ld(&bar[XB_TOPGEN]) == tg, bar);
      __builtin_amdgcn_fence(__ATOMIC_ACQUIRE, "agent");
      xb_add(&bar[XB_XGEN(b.x)], 1u);
      asm volatile("s_waitcnt vmcnt(0)" ::: "memory");
    } else {
      XB_SPIN(xb_ld(&bar[XB_XGEN(b.x)]) == gen, bar);
      __builtin_amdgcn_fence(__ATOMIC_ACQUIRE, "agent");
      asm volatile("s_waitcnt vmcnt(0)" ::: "memory");
    }
  }
  __syncthreads();
}

constexpr int HALF_LDS = 76 * 1024;
constexpr int SMEM_BYTES = 2 * HALF_LDS;
DI void group_barrier(unsigned* gc, unsigned target) {
  asm volatile("s_waitcnt vmcnt(0)" ::: "memory");
  __syncthreads();
  if (threadIdx.x == 0) {
    __hip_atomic_fetch_add(gc, 1u, __ATOMIC_RELAXED, __HIP_MEMORY_SCOPE_AGENT);
    unsigned sp = 0;
    while (__hip_atomic_load(gc, __ATOMIC_RELAXED, __HIP_MEMORY_SCOPE_AGENT) < target) { __builtin_amdgcn_s_sleep(1); if (++sp > (1u << 24)) break; }
    __builtin_amdgcn_fence(__ATOMIC_ACQUIRE, "agent");
    asm volatile("s_waitcnt vmcnt(0)" ::: "memory");
  }
  __syncthreads();
}
#ifndef STAGGER_US
#define STAGGER_US 0
#endif
__global__ void __launch_bounds__(512, 2) fwd_megakernel(Params p) {
  cg::grid_group grid = cg::this_grid();
  __shared__ __attribute__((aligned(16))) unsigned char smem[SMEM_BYTES];
  const int half = __builtin_amdgcn_readfirstlane(threadIdx.x >> 8);
  unsigned char* hsm = smem + half * HALF_LDS;
  const int G = gridDim.x, bid = blockIdx.x;
  const int slot = bid * 2 + half, NS = 2 * G;
  volatile LDSP unsigned* xst = (volatile LDSP unsigned*)(LDSP unsigned char*)(smem + SMEM_BYTES - 64);
  unsigned* cntp = (unsigned*)(p.ws + OFF_CNT);
  grid.sync();
  const XcdBarrier xb = xcd_barrier_post((unsigned*)(p.ws + OFF_BAR), xst);
  if (threadIdx.x == 0) { xst[0] = 0u; xst[1] = 0u; }
  if (threadIdx.x == 0) xst[4] = __hip_atomic_fetch_add(cntp + 128 + xb.x, 1u, __ATOMIC_RELAXED, __HIP_MEMORY_SCOPE_AGENT);
  {
    constexpr int ADA0 = T0_WIN + T0_WOUT + T0_W1 + T0_W2;
    unsigned* cnt = cntp;
    for (int i = slot; i < ((T0_TOTAL + NS - 1) / NS) * NS; i += NS) {
      const int t = i < 96 ? ADA0 + i : (i - 96 < ADA0 ? i - 96 : i);
      phase0_task(p, t, hsm);
      if (i < 96) {
        asm volatile("s_waitcnt vmcnt(0)" ::: "memory");
        lds_barrier();
        if (otid512() == 0) {
          __builtin_amdgcn_fence(__ATOMIC_RELEASE, "agent");
          asm volatile("s_waitcnt vmcnt(0)" ::: "memory");
          __hip_atomic_fetch_add(cnt + 8, 2u, __ATOMIC_RELAXED, __HIP_MEMORY_SCOPE_AGENT);
        }
      }
    }
    if (otid512() == 0) {
      unsigned sp = 0;
      while (__hip_atomic_load(cnt + 8, __ATOMIC_RELAXED, __HIP_MEMORY_SCOPE_AGENT) < 96u) { __builtin_amdgcn_s_sleep(8); if (++sp > (1u << 22)) break; }
      __builtin_amdgcn_fence(__ATOMIC_ACQUIRE, "agent");
      asm volatile("s_waitcnt vmcnt(0)" ::: "memory");
    }
    lds_barrier();
    for (int t = slot; t < ((NTOK / 64 + NS - 1) / NS) * NS; t += NS) phase1_task(p, 0, p.x, t < NTOK / 64 ? t : NTOK / 64 - 1, hsm);
  }
  xcd_barrier(xb);
  if (threadIdx.x == 0) {
    unsigned nloc = 0, ng = 0, gi = 0;
    for (unsigned j = 0; j < 16; ++j) { const unsigned c = xb_ld(xb.bar + XB_XCNT(j)); if (c) { if (j < xb.x) ++gi; ++ng; } if (j == xb.x) nloc = c; }
    xst[5] = nloc ? nloc : 1u; xst[6] = ng ? ng : 1u; xst[7] = gi;
  }
  __syncthreads();
  const int rank = __builtin_amdgcn_readfirstlane((int)xst[4]), nloc = __builtin_amdgcn_readfirstlane((int)xst[5]), ng = __builtin_amdgcn_readfirstlane((int)xst[6]), gi = __builtin_amdgcn_readfirstlane((int)xst[7]);
  unsigned* gcnt = cntp + 256 + 64 * xb.x;
  unsigned epoch = 0;
#if STAGGER_US
  { const unsigned long long t0 = wall_clock64(); while (wall_clock64() - t0 < (unsigned long long)(STAGGER_US * 100) * (unsigned long long)gi) __builtin_amdgcn_s_sleep(8); }
#endif
  const int lslot = rank * 2 + half, LNS = 2 * nloc;
  for (int bb = gi; bb < BATCH; bb += ng)
  for (int layer = 0; layer < 2; ++layer) {
    Params q = p;
    { size_t zoff = 0; asm volatile("" : "+s"(zoff)); q.ws = p.ws + zoff; }
    const float* xin = layer == 0 ? q.x : q.out;
    if (layer != 0) {
      for (int t = lslot; t < ((64 + LNS - 1) / LNS) * LNS; t += LNS) phase1_task(q, layer, xin, bb * 64 + (t < 64 ? t : 63), hsm);
      group_barrier(gcnt, ++epoch * (unsigned)nloc);
    }
    for (int t = rank; t < 256; t += nloc) { const int r = t >> 5, i = t & 31; gemm_inproj_tile(q, layer, bb * 16 + (i & 7) + 8 * (r & 1), (i >> 3) + 4 * (r >> 1), smem); }
    group_barrier(gcnt, ++epoch * (unsigned)nloc);
    {
      unsigned* cnt = (unsigned*)(q.ws + OFF_CNT);
      unsigned* qcnt = cnt + 32 + layer * 8; unsigned* cdone = cnt + 64 + layer * 8; unsigned* sdone = cnt + 96 + layer * 8;
      int* s_pair = (int*)(smem + SMEM_BYTES - 16);
      for (int sq = rank; sq < 8; sq += nloc) {
        if (sq < 4) ssd_task8(q, layer, bb, sq, smem); else mlstm_task8(q, layer, bb, sq - 4, smem);
        asm volatile("s_waitcnt vmcnt(0)" ::: "memory");
        lds_barrier();
        if (otid512() == 0) {
          __builtin_amdgcn_fence(__ATOMIC_RELEASE, "agent");
          asm volatile("s_waitcnt vmcnt(0)" ::: "memory");
          __hip_atomic_fetch_add(sdone + bb, 1u, __ATOMIC_RELAXED, __HIP_MEMORY_SCOPE_AGENT);
        }
      }
      constexpr int NP_C = 8, NP_D = 64, NP_N = 64, NP_F = 32, NP_ALL = NP_C + NP_D + NP_N + NP_F;
      const int bq = bb;
      for (;;) {
        const int t512 = otid512();
        lds_barrier();
        if (t512 == 0) *s_pair = (int)atomicAdd(qcnt + bq, 1u);
        lds_barrier();
        const int pair = *s_pair;
        if (pair >= NP_ALL) break;
        if (pair < NP_C) {
          const int v = pair * 2 + half;
          compress_task(q, layer, bq, v >> 3, v & 7, hsm);
          asm volatile("s_waitcnt vmcnt(0)" ::: "memory");
          lds_barrier();
          if (t512 == 0) {
            __builtin_amdgcn_fence(__ATOMIC_RELEASE, "agent");
            asm volatile("s_waitcnt vmcnt(0)" ::: "memory");
            __hip_atomic_fetch_add(cdone + bq, 1u, __ATOMIC_RELAXED, __HIP_MEMORY_SCOPE_AGENT);
          }
        } else if (pair < NP_C + NP_D) {
          const int d = pair - NP_C;
          diff_attn_task(q, layer, bq, 2 * (d & 1) + half, 31 - (d >> 1), hsm);
        } else if (pair < NP_C + NP_D + NP_N) {
          if (t512 == 0) {
            while (__hip_atomic_load(cdone + bq, __ATOMIC_RELAXED, __HIP_MEMORY_SCOPE_AGENT) < (unsigned)NP_C) __builtin_amdgcn_s_sleep(16);
            __builtin_amdgcn_fence(__ATOMIC_ACQUIRE, "agent");
            asm volatile("s_waitcnt vmcnt(0)" ::: "memory");
          }
          lds_barrier();
          nsa_task(q, layer, bq, 2 * (63 - (pair - NP_C - NP_D)) + half, hsm);
        } else {
          if (t512 == 0) {
            while (__hip_atomic_load(sdone + bq, __ATOMIC_RELAXED, __HIP_MEMORY_SCOPE_AGENT) < 8u) __builtin_amdgcn_s_sleep(16);
            __builtin_amdgcn_fence(__ATOMIC_ACQUIRE, "agent");
            asm volatile("s_waitcnt vmcnt(0)" ::: "memory");
          }
          lds_barrier();
          seq_fix_rows(q, layer, bq * SEQ + ((pair - NP_C - NP_D - NP_N) * 2 + half) * 64, 64);
        }
      }
    }
    group_barrier(gcnt, ++epoch * (unsigned)nloc);
    if (layer == 0) { for (int t = rank; t < 64; t += nloc) gemm_outproj_tile<0>(q, xin, q.out, bb * 16 + (t & 15), t >> 4, smem); }
    else { for (int t = rank; t < 64; t += nloc) gemm_outproj_tile<1>(q, xin, q.out, bb * 16 + (t & 15), t >> 4, smem); }
    group_barrier(gcnt, ++epoch * (unsigned)nloc);
    if (layer == 1) {
      const int t5 = otid512();
      final_norm_rows(q, bb * SEQ, SEQ, rank * 8 + (t5 >> 6), nloc * 8, t5 & 63);
    }
  }
}

extern "C" void kernel_launch(void* const* d_in, const int* in_sizes, int n_in, void* d_out, int out_size, void* d_ws, size_t ws_size,
                              hipStream_t stream) {
  static int grid_blocks = 0;
  if (!grid_blocks) {
    int dev = 0, cus = 0, per_cu = 0;
    (void)hipGetDevice(&dev);
    (void)hipDeviceGetAttribute(&cus, hipDeviceAttributeMultiprocessorCount, dev);
    (void)hipOccupancyMaxActiveBlocksPerMultiprocessor(&per_cu, fwd_megakernel, 512, 0);
    if (per_cu > 1) per_cu = 1;
    if (per_cu < 1) per_cu = 1;
    grid_blocks = cus * per_cu;
  }
  if (grid_blocks < 64 || (grid_blocks & 3)) { fprintf(stderr, "grid too small: %d\n", grid_blocks); return; }
  if (ws_size < WS_NEEDED) { fprintf(stderr, "workspace too small: %zu < %zu\n", ws_size, WS_NEEDED); return; }
  Params p{};
  const float** pp = (const float**)&p;
  for (int i = 0; i < 26; ++i) pp[i] = (const float*)d_in[i];
  p.out = (float*)d_out; p.ws = (unsigned char*)d_ws;
  (void)hipMemsetAsync((unsigned char*)d_ws + OFF_CNT, 0, 64 * 1024 + XCD_BAR_WORDS * 4, stream);
  void* args[] = {&p};
  hipError_t e = hipLaunchCooperativeKernel((void*)fwd_megakernel, dim3(grid_blocks), dim3(512), args, 0, stream);
  if (e != hipSuccess) fprintf(stderr, "cooperative launch failed: %s (grid %d)\n", hipGetErrorString(e), grid_blocks);
}
```

```cpp
#include <hip/hip_runtime.h>
#include <hip/hip_cooperative_groups.h>
#include <cstdio>
#include <cstdint>
namespace cg = cooperative_groups;

typedef unsigned short u16;
typedef short bf16x8 __attribute__((ext_vector_type(8)));
typedef short s16x4 __attribute__((ext_vector_type(4)));
typedef float f32x4 __attribute__((ext_vector_type(4)));
typedef float f32x2 __attribute__((ext_vector_type(2)));
typedef unsigned u32x4 __attribute__((ext_vector_type(4)));
typedef unsigned u32x2 __attribute__((ext_vector_type(2)));
typedef __bf16 bf16x2_t __attribute__((ext_vector_type(2)));
#define DI __device__ __forceinline__
#define LDSP __attribute__((address_space(3)))

constexpr int D_MODEL = 1024, BATCH = 8, SEQ = 4096, NTOK = BATCH * SEQ;
constexpr int D_IN = 3992;
constexpr int NP = 3968, NPAD = 4096, NSMALL = 32;
constexpr int PA_Q = 0, PA_KC = 256, PA_VC = 320, PA_KS = 384, PA_VS = 448, PA_KW = 512, PA_VW = 576, PA_Z = 640;
constexpr int PB_Q = 896, PB_K = 1152, PB_V = 1408, PB_Z = 1664;
constexpr int PC_Z = 1920, PC_XBC = 2176;
constexpr int PD_QK = 2688, PD_V = 3200, PD_O = 3456, PD_Z = 3712;
constexpr int SM_G = 0, SM_DT = 12, SM_IF = 16;
constexpr int Y_A = 0, Y_B = 256, Y_C = 512, Y_D = 768;

constexpr size_t MiB = 1024 * 1024;
constexpr size_t OFF_WINT = 0;
constexpr size_t OFF_WOUTT = 16 * MiB;
constexpr size_t OFF_W1T = 20 * MiB;
constexpr size_t OFF_W2T = 22 * MiB;
constexpr size_t OFF_BIAS1 = 22 * MiB + 64 * 1024;
constexpr size_t OFF_LAMF = 22 * MiB + 96 * 1024;
constexpr size_t OFF_ADAP = 22 * MiB + 128 * 1024;
constexpr size_t OFF_KCMP = 24 * MiB;
constexpr size_t OFF_VCMP = 24 * MiB + 256 * 1024;
constexpr size_t OFF_BAR = 29 * MiB + 64 * 1024;
constexpr size_t OFF_CNT = 29 * MiB;
constexpr size_t OFF_SMALL = 25 * MiB;
constexpr size_t OFF_SSQ = 29 * MiB;
constexpr size_t OFF_H = 32 * MiB;
constexpr size_t OFF_PROJ = 96 * MiB;
constexpr size_t OFF_X1B = 352 * MiB;
constexpr size_t WS_NEEDED = OFF_X1B + (size_t)NTOK * 1024 * 2;

struct Params {
  const float* x; const float* c; const float* norm_g; const float* ada_w; const float* ada_b;
  const float* w_in; const float* w_out;
  const float* nsa_cmp_pos; const float* nsa_ck_w1; const float* nsa_ck_w2; const float* nsa_cv_w1; const float* nsa_cv_w2; const float* nsa_norm_g;
  const float* diff_lam; const float* diff_norm_g;
  const float* ssm_conv_w; const float* ssm_conv_b; const float* ssm_dt_bias; const float* ssm_a_log; const float* ssm_d; const float* ssm_norm_g;
  const float* ml_conv_w; const float* ml_conv_b; const float* ml_if_b; const float* ml_norm_g; const float* final_g;
  float* out; unsigned char* ws;
};

DI void lds_barrier() { asm volatile("s_waitcnt lgkmcnt(0)" ::: "memory"); __builtin_amdgcn_s_barrier(); asm volatile("" ::: "memory"); }
DI int otid() { int t = threadIdx.x & 255; asm volatile("" : "+v"(t)); return t; }
DI int otid512() { int t = threadIdx.x; asm volatile("" : "+v"(t)); return t; }
DI unsigned pack2(float a, float b) { f32x2 v = {a, b}; bf16x2_t r = __builtin_convertvector(v, bf16x2_t); return __builtin_bit_cast(unsigned, r); }
DI u16 f2bf(float a) { return (u16)(pack2(a, 0.f) & 0xffffu); }
DI float bf2f(u16 h) { return __uint_as_float(((unsigned)h) << 16); }
DI float bflo(unsigned u) { return __uint_as_float(u << 16); }
DI float bfhi(unsigned u) { return __uint_as_float(u & 0xffff0000u); }
DI f32x4 mfma16(bf16x8 a, bf16x8 b, f32x4 c) { return __builtin_amdgcn_mfma_f32_16x16x32_bf16(a, b, c, 0, 0, 0); }
DI float wave_sum(float v) {
#pragma unroll
  for (int o = 32; o > 0; o >>= 1) v += __shfl_xor(v, o);
  return v;
}
DI float siluf(float v) { return v * __builtin_amdgcn_rcpf(1.f + __expf(-v)); }
DI float sigmoidf_(float v) { return __builtin_amdgcn_rcpf(1.f + __expf(-v)); }
DI float exp2_(float v) { return __builtin_amdgcn_exp2f(v); }
DI float sgprf(float v) { return __int_as_float(__builtin_amdgcn_readfirstlane(__float_as_int(v))); }
DI s16x4 tr_read(const u16* p) { return __builtin_amdgcn_ds_read_tr16_b64_v4i16((LDSP s16x4*)p); }
DI bf16x8 cat4(s16x4 a, s16x4 b) { bf16x8 r; r[0] = a[0]; r[1] = a[1]; r[2] = a[2]; r[3] = a[3]; r[4] = b[0]; r[5] = b[1]; r[6] = b[2]; r[7] = b[3]; return r; }
DI bf16x8 ldfrag(const u16* p) { return *(const bf16x8*)p; }

DI int colmap(int n) {
  if (n < 640) return n;
  if (n < 896) return 652 + (n - 640);
  if (n < 1920) return 908 + (n - 896);
  if (n < 2688) return 1932 + (n - 1920);
  if (n < 3456) return 2704 + (n - 2688);
  if (n < 3968) return 3480 + (n - 3456);
  if (n < 3980) return 640 + (n - 3968);
  if (n < 3984) return 2700 + (n - 3980);
  if (n < 3992) return 3472 + (n - 3984);
  return -1;
}

#define PIN4(a) asm volatile("" : "+v"(a[0]), "+v"(a[1]), "+v"(a[2]), "+v"(a[3]))
DI void tconv_tile(const float* __restrict__ src, int ldsrc, int k0, int n0, u16* __restrict__ dst, int ldd, bool use_map, unsigned char* smem) {
  float* tile = (float*)smem;
  const int tid = otid();
  {
    const int c4 = tid & 15, kk0 = tid >> 4; int col = n0 + c4 * 4; if (use_map) col = colmap(col);
    const float* sp = src + (size_t)(k0 + kk0) * ldsrc + (col >= 0 ? col : 0);
    f32x4 v[4];
#pragma unroll
    for (int i = 0; i < 4; ++i) v[i] = *(const f32x4*)(sp + (size_t)(16 * i) * ldsrc);
    PIN4(v);
    lds_barrier();
#pragma unroll
    for (int i = 0; i < 4; ++i) {
      const f32x4 w = col >= 0 ? v[i] : (f32x4){0.f, 0.f, 0.f, 0.f};
      float* tp = tile + (kk0 + 16 * i) * 65 + c4 * 4;
      tp[0] = w[0]; tp[1] = w[1]; tp[2] = w[2]; tp[3] = w[3];
    }
  }
  lds_barrier();
#pragma unroll
  for (int i = 0; i < 2; ++i) {
    const int item = tid + 256 * i, nn = item >> 3, kc = item & 7;
    u32x4 w;
    w.x = pack2(tile[(kc * 8 + 0) * 65 + nn], tile[(kc * 8 + 1) * 65 + nn]);
    w.y = pack2(tile[(kc * 8 + 2) * 65 + nn], tile[(kc * 8 + 3) * 65 + nn]);
    w.z = pack2(tile[(kc * 8 + 4) * 65 + nn], tile[(kc * 8 + 5) * 65 + nn]);
    w.w = pack2(tile[(kc * 8 + 6) * 65 + nn], tile[(kc * 8 + 7) * 65 + nn]);
    *(u32x4*)(dst + (size_t)(n0 + nn) * ldd + k0 + kc * 8) = w;
  }
}

constexpr int T0_WIN = 2 * 16 * 64, T0_WOUT = 2 * 16 * 16, T0_W1 = 4 * 32 * 2, T0_W2 = 4 * 2, T0_ADA = 2 * 12 * 8, T0_B1 = 64;
constexpr int T0_TOTAL = T0_WIN + T0_WOUT + T0_W1 + T0_W2 + T0_ADA + T0_B1;

DI void phase0_task(const Params& p, int t, unsigned char* smem) {
  const int tid = otid();
  if (t >= T0_TOTAL) { lds_barrier(); lds_barrier(); return; }
  if (t < T0_WIN) {
    const int l = t / 1024, r = t % 1024, kt = r / 64, nt = r % 64;
    tconv_tile(p.w_in + (size_t)l * D_MODEL * D_IN, D_IN, kt * 64, nt * 64, (u16*)(p.ws + OFF_WINT) + (size_t)l * NPAD * 1024, 1024, true, smem);
    return;
  }
  t -= T0_WIN;
  if (t < T0_WOUT) {
    const int l = t / 256, r = t % 256, kt = r / 16, nt = r % 16;
    tconv_tile(p.w_out + (size_t)l * 1024 * 1024, 1024, kt * 64, nt * 64, (u16*)(p.ws + OFF_WOUTT) + (size_t)l * 1024 * 1024, 1024, false, smem);
    return;
  }
  t -= T0_WOUT;
  if (t < T0_W1) {
    const int m = t / 64, r = t % 64, kt = r / 2, nt = r % 2, l = m >> 1, kv = m & 1;
    const float* src = (kv ? p.nsa_cv_w1 : p.nsa_ck_w1) + (size_t)l * 2048 * 128;
    tconv_tile(src, 128, kt * 64, nt * 64, (u16*)(p.ws + OFF_W1T) + (size_t)m * 128 * 2048, 2048, false, smem);
    return;
  }
  t -= T0_W1;
  if (t < T0_W2) {
    const int m = t / 2, kt = t % 2, l = m >> 1, kv = m & 1;
    const float* src = (kv ? p.nsa_cv_w2 : p.nsa_ck_w2) + (size_t)l * 128 * 64;
    tconv_tile(src, 64, kt * 64, 0, (u16*)(p.ws + OFF_W2T) + (size_t)m * 64 * 128, 128, false, smem);
    return;
  }
  t -= T0_W2;
  if (t < T0_ADA) {
    const int l = t / 96, r = t % 96, nc = r / 8, kc = r % 8;
    float* cact = (float*)(smem + 20480);
    float* red = (float*)(smem + 24576);
    const int kq = __builtin_amdgcn_readfirstlane(tid >> 6), c4 = tid & 63;
    const float* w = p.ada_w + ((size_t)l * 1024 + kc * 128 + kq) * 3072 + nc * 256 + c4 * 4;
    float cv[4];
#pragma unroll
    for (int i = 0; i < 4; ++i) { const int e = tid + 256 * i; cv[i] = p.c[(e >> 7) * 1024 + kc * 128 + (e & 127)]; }
    f32x4 wv[32];
#pragma unroll
    for (int j = 0; j < 32; ++j) wv[j] = *(const f32x4*)(w + (size_t)(4 * j) * 3072);
    PIN4(cv);
#pragma unroll
    for (int i = 0; i < 4; ++i) cact[tid + 256 * i] = siluf(cv[i]);
#pragma unroll
    for (int j = 0; j < 32; j += 4) asm volatile("" : "+v"(wv[j]), "+v"(wv[j + 1]), "+v"(wv[j + 2]), "+v"(wv[j + 3]));
    lds_barrier();
    f32x4 acc[8];
#pragma unroll
    for (int b = 0; b < 8; ++b) acc[b] = (f32x4){0.f, 0.f, 0.f, 0.f};
#pragma unroll
    for (int j = 0; j < 32; ++j) {
#pragma unroll
      for (int b = 0; b < 8; ++b) acc[b] += cact[b * 128 + kq + 4 * j] * wv[j];
    }
#pragma unroll
    for (int b = 0; b < 8; ++b) *(f32x4*)(red + (kq * 8 + b) * 256 + c4 * 4) = acc[b];
    lds_barrier();
    float* adap = (float*)(p.ws + OFF_ADAP);
    const int n = nc * 256 + tid;
    float bias = p.ada_b[l * 3072 + n];
    asm volatile("" : "+v"(bias));
    bias = kc == 0 ? bias : 0.f;
#pragma unroll
    for (int i = 0; i < 8; ++i) {
      adap[(((size_t)kc * 2 + l) * 8 + i) * 3072 + n] = ((red[(0 * 8 + i) * 256 + tid] + red[(1 * 8 + i) * 256 + tid]) + (red[(2 * 8 + i) * 256 + tid] + red[(3 * 8 + i) * 256 + tid])) + bias;
    }
    return;
  }
  t -= T0_ADA;
  {
    const int m = t >> 4, kc = t & 15, l = m >> 1, kv = m & 1;
    const float* w1 = (kv ? p.nsa_cv_w1 : p.nsa_ck_w1) + (size_t)l * 2048 * 128;
    const float* pos = p.nsa_cmp_pos + (size_t)l * 2048;
    const int n = tid & 127, half = tid >> 7;
    float acc = 0.f;
    const int k0 = kc * 128 + half * 64;
#pragma unroll 1
    for (int kb = 0; kb < 64; kb += 16) {
      float wv[16];
#pragma unroll
      for (int k = 0; k < 16; ++k) wv[k] = w1[(size_t)(k0 + kb + k) * 128 + n];
#pragma unroll
      for (int k = 0; k < 16; k += 4) asm volatile("" : "+v"(wv[k]), "+v"(wv[k + 1]), "+v"(wv[k + 2]), "+v"(wv[k + 3]));
#pragma unroll
      for (int k = 0; k < 16; ++k) acc += pos[k0 + kb + k] * wv[k];
    }
    float* red = (float*)smem;
    lds_barrier();
    red[tid] = acc;
    lds_barrier();
    if (tid < 128) ((float*)(p.ws + OFF_BIAS1))[(m * 16 + kc) * 128 + tid] = red[tid] + red[tid + 128];
  }
}

DI void phase1_task(const Params& p, int layer, const float* xin, int grp, unsigned char* smem) {
  const int tid = otid(), lane = tid & 63, wid = tid >> 6;
  const int b = grp >> 6;
  float* mul = (float*)smem;
  float* sh = mul + 1024;
  const float* adap = (const float*)(p.ws + OFF_ADAP);
  lds_barrier();
  {
    f32x4 a0[8], a1[8];
#pragma unroll
    for (int kc = 0; kc < 8; ++kc) { const float* a = adap + (((size_t)kc * 2 + layer) * 8 + b) * 3072 + 4 * tid; a0[kc] = *(const f32x4*)a; a1[kc] = *(const f32x4*)(a + 1024); }
    f32x4 gv = *(const f32x4*)(p.norm_g + layer * 1024 + 4 * tid);
    asm volatile("" : "+v"(a0[0]), "+v"(a0[1]), "+v"(a0[2]), "+v"(a0[3]), "+v"(a0[4]), "+v"(a0[5]), "+v"(a0[6]), "+v"(a0[7]));
    asm volatile("" : "+v"(a1[0]), "+v"(a1[1]), "+v"(a1[2]), "+v"(a1[3]), "+v"(a1[4]), "+v"(a1[5]), "+v"(a1[6]), "+v"(a1[7]), "+v"(gv));
    f32x4 s0 = a0[0], s1 = a1[0];
#pragma unroll
    for (int kc = 1; kc < 8; ++kc) { s0 += a0[kc]; s1 += a1[kc]; }
    *(f32x4*)(mul + 4 * tid) = gv * (1.f + s1); *(f32x4*)(sh + 4 * tid) = s0;
  }
  lds_barrier();
  u16* H = (u16*)(p.ws + OFF_H);
#pragma unroll 1
  for (int it = 0; it < 4; ++it) {
    f32x4 v[4][4]; float ss[4];
#pragma unroll
    for (int j = 0; j < 4; ++j) {
      const int row = grp * 64 + wid * 16 + it * 4 + j;
      if (layer == 0) {
        const f32x4* xr = (const f32x4*)(xin + (size_t)row * D_MODEL);
#pragma unroll
        for (int i = 0; i < 4; ++i) v[j][i] = xr[lane + 64 * i];
      } else {
        const u32x2* xr = (const u32x2*)((const u16*)(p.ws + OFF_X1B) + (size_t)row * D_MODEL);
#pragma unroll
        for (int i = 0; i < 4; ++i) { const u32x2 w = xr[lane + 64 * i]; v[j][i] = (f32x4){bflo(w.x), bfhi(w.x), bflo(w.y), bfhi(w.y)}; }
      }
    }
    if (layer == 0) asm volatile("" : "+v"(v[0][0]), "+v"(v[0][1]), "+v"(v[0][2]), "+v"(v[0][3]), "+v"(v[1][0]), "+v"(v[1][1]), "+v"(v[1][2]), "+v"(v[1][3]), "+v"(v[2][0]), "+v"(v[2][1]), "+v"(v[2][2]), "+v"(v[2][3]), "+v"(v[3][0]), "+v"(v[3][1]), "+v"(v[3][2]), "+v"(v[3][3]));
#pragma unroll
    for (int j = 0; j < 4; ++j) {
      float a = 0.f;
#pragma unroll
      for (int i = 0; i < 4; ++i) a += v[j][i][0] * v[j][i][0] + v[j][i][1] * v[j][i][1] + v[j][i][2] * v[j][i][2] + v[j][i][3] * v[j][i][3];
      ss[j] = wave_sum(a);
    }
#pragma unroll
    for (int j = 0; j < 4; ++j) {
      const int row = grp * 64 + wid * 16 + it * 4 + j;
      const float r = rsqrtf(ss[j] * (1.f / D_MODEL) + 1e-6f);
#pragma unroll
      for (int i = 0; i < 4; ++i) {
        const int c = (lane + 64 * i) * 4;
        u32x2 w;
        w.x = pack2(v[j][i][0] * r * mul[c] + sh[c], v[j][i][1] * r * mul[c + 1] + sh[c + 1]);
        w.y = pack2(v[j][i][2] * r * mul[c + 2] + sh[c + 2], v[j][i][3] * r * mul[c + 3] + sh[c + 3]);
        *(u32x2*)(H + (size_t)row * 1024 + c) = w;
      }
    }
  }
}

namespace g8 {
constexpr int BM = 256, BK = 64, HALF = 128, HT = HALF * BK;
constexpr int LDS_BYTES = 8 * HT * 2;
DI int lds_byte(int r, int c) { const int st = (r >> 4) * 2 + (c >> 5), rr = r & 15, cc = c & 31, ob = rr * 64 + cc * 2; return st * 1024 + (ob ^ (((ob >> 9) & 1) << 5)); }
DI void stage_rc(int b, int& R, int& C) { const int st = b / 1024, sb = b % 1024, swz = sb ^ (((sb >> 9) & 1) << 5); R = (st >> 1) * 16 + swz / 64; C = (st & 1) * 32 + (swz % 64) / 2; }

DI void kloop(const u16* __restrict__ A, const u16* __restrict__ Bt, int K, int brow, int bcol, unsigned char* smem, f32x4 (&acc)[2][2][4][2]) {
  u16* shm = (u16*)smem;
  const int tid = otid512();
#define SA(b, h) (shm + ((b) * 2 + (h)) * HT)
#define SB(b, h) (shm + (4 + (b) * 2 + (h)) * HT)
#define STAGE(P, BASE, br, kt) do { const u16* _gb = BASE + ((long)(br) * K + (long)(kt) * BK); \
      __builtin_amdgcn_global_load_lds((const unsigned*)(_gb + soff0), (LDSP unsigned*)((LDSP char*)(P) + tid * 16), 16, 0, 0); \
      __builtin_amdgcn_global_load_lds((const unsigned*)(_gb + soff1), (LDSP unsigned*)((LDSP char*)(P) + tid * 16 + 8192), 16, 0, 0); } while (0)
#define LDA(dst, b, h) _Pragma("unroll") for (int m = 0; m < 4; ++m) _Pragma("unroll") for (int k = 0; k < 2; ++k) \
    dst[m][k] = *reinterpret_cast<const bf16x8*>((const char*)SA(b, h) + lds_byte(wr * 64 + m * 16 + fr, k * 32 + fq * 8))
#define LDB(dst, b, h) _Pragma("unroll") for (int n = 0; n < 2; ++n) _Pragma("unroll") for (int k = 0; k < 2; ++k) \
    dst[n][k] = *reinterpret_cast<const bf16x8*>((const char*)SB(b, h) + lds_byte(wc * 32 + n * 16 + fr, k * 32 + fq * 8))
#define MMA(ai, bj, At_, Bt_) do { __builtin_amdgcn_s_setprio(1); \
    _Pragma("unroll") for (int m = 0; m < 4; ++m) _Pragma("unroll") for (int n = 0; n < 2; ++n) _Pragma("unroll") for (int k = 0; k < 2; ++k) \
      acc[ai][bj][m][n] = __builtin_amdgcn_mfma_f32_16x16x32_bf16(Bt_[n][k], At_[m][k], acc[ai][bj][m][n], 0, 0, 0); \
    __builtin_amdgcn_s_setprio(0); } while (0)
#define WAIT_V(n) asm volatile("s_waitcnt vmcnt(" #n ")" ::: "memory")
#define WAIT_L(n) asm volatile("s_waitcnt lgkmcnt(" #n ")" ::: "memory")
#define BAR __builtin_amdgcn_s_barrier()
#define SCHED __builtin_amdgcn_sched_barrier(0)
  const int wid = __builtin_amdgcn_readfirstlane(tid >> 6), lane = tid & 63, wr = wid >> 2, wc = wid & 3, fr = lane & 15, fq = lane >> 4;
#pragma unroll
  for (int a = 0; a < 2; ++a)
#pragma unroll
    for (int b = 0; b < 2; ++b)
#pragma unroll
      for (int m = 0; m < 4; ++m) { acc[a][b][m][0] = (f32x4){0.f, 0.f, 0.f, 0.f}; acc[a][b][m][1] = (f32x4){0.f, 0.f, 0.f, 0.f}; }
  bf16x8 At[4][2], B0[2][2], B1[2][2];
  const int nt = K / BK;
  int soff0, soff1;
  { int r_, c_; stage_rc(tid * 16, r_, c_); soff0 = r_ * K + c_; stage_rc(tid * 16 + 8192, r_, c_); soff1 = r_ * K + c_; }
  STAGE(SB(0, 0), Bt, bcol, 0); STAGE(SA(0, 0), A, brow, 0);
  STAGE(SB(0, 1), Bt, bcol + HALF, 0); STAGE(SA(0, 1), A, brow + HALF, 0);
  if (wr == 1) BAR;
  WAIT_V(4); BAR;
  STAGE(SB(1, 0), Bt, bcol, 1); STAGE(SA(1, 0), A, brow, 1); STAGE(SB(1, 1), Bt, bcol + HALF, 1);
  WAIT_V(6); BAR;
#pragma unroll 1
  for (int t = 0; t < nt - 2; t += 2) {
    asm volatile("" : "+v"(soff0), "+v"(soff1));
    LDB(B0, 0, 0); SCHED; LDA(At, 0, 0); STAGE(SA(1, 1), A, brow + HALF, t + 1);
    WAIT_L(8); BAR; WAIT_L(0); MMA(0, 0, At, B0); BAR; SCHED;
    LDB(B1, 0, 1); STAGE(SB(0, 0), Bt, bcol, t + 2);
    BAR; WAIT_L(0); MMA(0, 1, At, B1); BAR;
    LDA(At, 0, 1); STAGE(SA(0, 0), A, brow, t + 2);
    BAR; WAIT_L(0); MMA(1, 0, At, B0); BAR; SCHED;
    STAGE(SB(0, 1), Bt, bcol + HALF, t + 2);
    WAIT_V(6); BAR; MMA(1, 1, At, B1); BAR;
    LDB(B0, 1, 0); SCHED; LDA(At, 1, 0); STAGE(SA(0, 1), A, brow + HALF, t + 2);
    WAIT_L(8); BAR; WAIT_L(0); MMA(0, 0, At, B0); BAR; SCHED;
    LDB(B1, 1, 1); STAGE(SB(1, 0), Bt, bcol, t + 3);
    BAR; WAIT_L(0); MMA(0, 1, At, B1); BAR;
    LDA(At, 1, 1); STAGE(SA(1, 0), A, brow, t + 3);
    BAR; WAIT_L(0); MMA(1, 0, At, B0); BAR; SCHED;
    STAGE(SB(1, 1), Bt, bcol + HALF, t + 3);
    WAIT_V(6); BAR; MMA(1, 1, At, B1); BAR;
  }
  { LDB(B0, 0, 0); LDA(At, 0, 0); STAGE(SA(1, 1), A, brow + HALF, nt - 1);
    BAR; WAIT_L(0); MMA(0, 0, At, B0); BAR;
    LDB(B1, 0, 1); BAR; WAIT_L(0); MMA(0, 1, At, B1); BAR;
    LDA(At, 0, 1); WAIT_V(4); BAR; WAIT_L(0); MMA(1, 0, At, B0); MMA(1, 1, At, B1); BAR; }
  { LDB(B0, 1, 0); LDA(At, 1, 0); WAIT_V(2); BAR; WAIT_L(0); MMA(0, 0, At, B0); BAR;
    LDB(B1, 1, 1); WAIT_V(0); BAR; WAIT_L(0); MMA(0, 1, At, B1); BAR;
    LDA(At, 1, 1); BAR; WAIT_L(0); MMA(1, 0, At, B0); MMA(1, 1, At, B1); BAR; }
  if (wr == 0) BAR;
#undef SA
#undef SB
#undef STAGE
#undef LDA
#undef LDB
#undef MMA
#undef WAIT_V
#undef WAIT_L
#undef BAR
#undef SCHED
}
DI void tile_map(int wgid, int nM, int nN, int& pm, int& pn) {
  const int nwg = nM * nN, NXCD = 8, WGM = 8;
  { const int q = nwg / NXCD, r = nwg % NXCD, xcd = wgid % NXCD, off = wgid / NXCD; wgid = (xcd < r ? xcd * (q + 1) : r * (q + 1) + (xcd - r) * q) + off; }
  const int nig = WGM * nN, gid = wgid / nig, fm = gid * WGM, gsz = (nM - fm) < WGM ? (nM - fm) : WGM;
  pm = fm + ((wgid % nig) % gsz); pn = (wgid % nig) / gsz;
}
}

DI void gemm_inproj_tile(const Params& p, int layer, int pm, int pn, unsigned char* smem) {
  const int brow = pm * 256, bcol = pn * 256;
  f32x4 acc[2][2][4][2];
  g8::kloop((const u16*)(p.ws + OFF_H), (const u16*)(p.ws + OFF_WINT) + (size_t)layer * NPAD * 1024, 1024, brow, bcol, smem, acc);
  const int tid = otid512(), wid = __builtin_amdgcn_readfirstlane(tid >> 6), lane = tid & 63, wr = wid >> 2, wc = wid & 3, fr = lane & 15, fq = lane >> 4;
  u16* proj = (u16*)(p.ws + OFF_PROJ);
  if (pn == 15 && wc == 0) {
    float* sm = (float*)(p.ws + OFF_SMALL);
#pragma unroll
    for (int ai = 0; ai < 2; ++ai)
#pragma unroll
      for (int m = 0; m < 4; ++m)
#pragma unroll
        for (int n = 0; n < 2; ++n) {
          const int mr = brow + ai * 128 + wr * 64 + m * 16 + fr;
          *(f32x4*)(sm + (size_t)mr * NSMALL + n * 16 + 4 * fq) = acc[ai][1][m][n];
        }
  }
  constexpr int CLD = 264;
  u16* Cs = (u16*)smem;
#pragma unroll
  for (int ai = 0; ai < 2; ++ai) {
    lds_barrier();
#pragma unroll
    for (int bj = 0; bj < 2; ++bj)
#pragma unroll
      for (int m = 0; m < 4; ++m)
#pragma unroll
        for (int n = 0; n < 2; ++n) {
          const f32x4 v = acc[ai][bj][m][n];
          u32x2 w; w.x = pack2(v[0], v[1]); w.y = pack2(v[2], v[3]);
          *(u32x2*)(Cs + (wr * 64 + m * 16 + fr) * CLD + bj * 128 + wc * 32 + n * 16 + 4 * fq) = w;
        }
    lds_barrier();
#pragma unroll
    for (int i = 0; i < 8; ++i) {
      const int id = tid + 512 * i, row = id >> 5, ch = id & 31;
      if (bcol + ch * 8 < NP) *(u32x4*)(proj + (size_t)(brow + ai * 128 + row) * NP + bcol + ch * 8) = *(const u32x4*)(Cs + row * CLD + ch * 8);
    }
  }
  lds_barrier();
}

template <int layer>
DI void gemm_outproj_tile(const Params& p, const float* xin, float* xout, int pm, int pn, unsigned char* smem) {
  const int brow = pm * 256, bcol = pn * 256;
  f32x4 acc[2][2][4][2];
  g8::kloop((const u16*)(p.ws + OFF_H), (const u16*)(p.ws + OFF_WOUTT) + (size_t)layer * 1024 * 1024, 1024, brow, bcol, smem, acc);
  const int tid = otid512(), wid = __builtin_amdgcn_readfirstlane(tid >> 6), lane = tid & 63, wr = wid >> 2, wc = wid & 3, fr = lane & 15, fq = lane >> 4;
  const int b = brow >> 12;
  const float* adap = (const float*)(p.ws + OFF_ADAP);
  constexpr int CLD = 132;
  float* Cs = (float*)smem;
#pragma unroll
  for (int ai = 0; ai < 2; ++ai)
#pragma unroll
    for (int bj = 0; bj < 2; ++bj) {
      lds_barrier();
#pragma unroll
      for (int m = 0; m < 4; ++m)
#pragma unroll
        for (int n = 0; n < 2; ++n) *(f32x4*)(Cs + (wr * 64 + m * 16 + fr) * CLD + wc * 32 + n * 16 + 4 * fq) = acc[ai][bj][m][n];
      lds_barrier();
      const int ch = tid & 31, nc = bcol + bj * 128 + ch * 4;
      f32x4 gt = {0.f, 0.f, 0.f, 0.f};
#pragma unroll
      for (int kc = 0; kc < 8; ++kc) gt += *(const f32x4*)(adap + (((size_t)kc * 2 + layer) * 8 + b) * 3072 + 2048 + nc);
      u16* x1b = (u16*)(p.ws + OFF_X1B);
      f32x4 xv[8];
#pragma unroll
      for (int i = 0; i < 8; ++i) {
        const size_t off = (size_t)(brow + ai * 128 + (tid >> 5) + 16 * i) * 1024 + nc;
        if (layer == 0) xv[i] = *(const f32x4*)(xin + off);
        else { const u32x2 w = *(const u32x2*)(x1b + off); xv[i] = (f32x4){bflo(w.x), bfhi(w.x), bflo(w.y), bfhi(w.y)}; }
      }
#pragma unroll
      for (int i = 0; i < 8; ++i) {
        const int row = (tid >> 5) + 16 * i;
        const size_t off = (size_t)(brow + ai * 128 + row) * 1024 + nc;
        const f32x4 v = xv[i] + gt * *(const f32x4*)(Cs + row * CLD + ch * 4);
        if (layer == 0) { u32x2 w; w.x = pack2(v[0], v[1]); w.y = pack2(v[2], v[3]); *(u32x2*)(x1b + off) = w; }
        else { u32x2 w; w.x = pack2(v[0], v[1]); w.y = pack2(v[2], v[3]); *(u32x2*)(x1b + off) = w; }
      }
    }
  lds_barrier();
}

constexpr int KLD = 72;
struct KVRegs { u32x4 k[2], v[2]; };
DI void kv_load(const u16* kbase, const u16* vbase, int ldk, int ldv, int key0, KVRegs& r) {
  const int tid = otid();
#pragma unroll
  for (int i = 0; i < 2; ++i) {
    const int id = tid + 256 * i, row = id >> 3, ch = id & 7;
    r.k[i] = *(const u32x4*)(kbase + (size_t)(key0 + row) * ldk + ch * 8);
    r.v[i] = *(const u32x4*)(vbase + (size_t)(key0 + row) * ldv + ch * 8);
  }
}
DI void kv_store(u16* Ks, u16* Vs, const KVRegs& r) {
  const int tid = otid();
#pragma unroll
  for (int i = 0; i < 2; ++i) {
    const int id = tid + 256 * i, row = id >> 3, ch = id & 7;
    *(u32x4*)(Ks + row * KLD + ch * 8) = r.k[i];
    *(u32x4*)(Vs + row * KLD + ch * 8) = r.v[i];
  }
}
constexpr int KVBUF = 2 * 64 * KLD;
template <class UseF, class LoadF, class CompF>
DI void kv_pipeline(int j0, int j1, u16* buf, UseF use, LoadF load, CompF comp) {
  KVRegs kr;
  if (use(j0)) load(j0, kr);
  lds_barrier();
  if (use(j0)) kv_store(buf, buf + 64 * KLD, kr);
  if (j0 + 1 < j1 && use(j0 + 1)) load(j0 + 1, kr);
  lds_barrier();
  for (int j = j0; j < j1; ++j) {
    u16* cur = buf + ((j - j0) & 1) * KVBUF; u16* nxt = buf + (((j - j0) & 1) ^ 1) * KVBUF;
    if (j + 1 < j1 && use(j + 1)) kv_store(nxt, nxt + 64 * KLD, kr);
    if (j + 2 < j1 && use(j + 2)) load(j + 2, kr);
    if (use(j)) comp(j, cur, cur + 64 * KLD);
    lds_barrier();
  }
}
template <class UseF, class LoadF, class CompA, class CompB>
DI void kv_pipeline2(int j0, int jsplit, int j1, u16* buf, UseF use, LoadF load, CompA compA, CompB compB) {
  KVRegs kr;
  if (use(j0)) load(j0, kr);
  lds_barrier();
  if (use(j0)) kv_store(buf, buf + 64 * KLD, kr);
  if (j0 + 1 < j1 && use(j0 + 1)) load(j0 + 1, kr);
  lds_barrier();
  int j = j0;
  for (; j < jsplit && j < j1; ++j) {
    u16* cur = buf + ((j - j0) & 1) * KVBUF; u16* nxt = buf + (((j - j0) & 1) ^ 1) * KVBUF;
    if (j + 1 < j1 && use(j + 1)) kv_store(nxt, nxt + 64 * KLD, kr);
    if (j + 2 < j1 && use(j + 2)) load(j + 2, kr);
    if (use(j)) compA(j, cur, cur + 64 * KLD);
    lds_barrier();
  }
  for (; j < j1; ++j) {
    u16* cur = buf + ((j - j0) & 1) * KVBUF; u16* nxt = buf + (((j - j0) & 1) ^ 1) * KVBUF;
    if (j + 1 < j1 && use(j + 1)) kv_store(nxt, nxt + 64 * KLD, kr);
    if (j + 2 < j1 && use(j + 2)) load(j + 2, kr);
    if (use(j)) compB(j, cur, cur + 64 * KLD);
    lds_barrier();
  }
}
struct AttnAcc { f32x4 o[4][2]; float m[2], l[2]; f32x4 os[2]; int fresh; };
DI void attn_init(AttnAcc& a) {
#pragma unroll
  for (int d = 0; d < 4; ++d) { a.o[d][0] = (f32x4){0.f, 0.f, 0.f, 0.f}; a.o[d][1] = (f32x4){0.f, 0.f, 0.f, 0.f}; }
  a.m[0] = a.m[1] = -1e30f; a.l[0] = a.l[1] = 0.f;
}
template <int NKS>
DI void qk_tile(const u16* Ks, int dofs, const bf16x8 (&qf)[2][NKS], f32x4 (&s)[4][2], int l15, int g) {
#pragma unroll
  for (int kt = 0; kt < 4; ++kt) {
    s[kt][0] = (f32x4){0.f, 0.f, 0.f, 0.f}; s[kt][1] = (f32x4){0.f, 0.f, 0.f, 0.f};
#pragma unroll
    for (int ks = 0; ks < NKS; ++ks) {
      const bf16x8 a = ldfrag(Ks + (kt * 16 + l15) * KLD + dofs + ks * 32 + 8 * g);
      s[kt][0] = mfma16(a, qf[0][ks], s[kt][0]);
      s[kt][1] = mfma16(a, qf[1][ks], s[kt][1]);
    }
  }
}
DI void pv_accum(const bf16x8 (&pf)[2][2], const u16* Vs, f32x4 (&o)[4][2], int l15, int g) {
  const int tq = l15 >> 2, tp = l15 & 3;
#pragma unroll
  for (int kk = 0; kk < 2; ++kk)
#pragma unroll
    for (int d = 0; d < 4; ++d) {
      const bf16x8 vf = cat4(tr_read(Vs + (kk * 32 + 4 * g + tq) * KLD + d * 16 + 4 * tp), tr_read(Vs + (kk * 32 + 16 + 4 * g + tq) * KLD + d * 16 + 4 * tp));
      o[d][0] = mfma16(vf, pf[0][kk], o[d][0]);
      o[d][1] = mfma16(vf, pf[1][kk], o[d][1]);
    }
}
DI void pack_p(const f32x4 (&s)[4][2], bf16x8 (&pf)[2][2]) {
#pragma unroll
  for (int qt = 0; qt < 2; ++qt)
#pragma unroll
    for (int kk = 0; kk < 2; ++kk) {
      u32x4 w;
      w.x = pack2(s[2 * kk][qt][0], s[2 * kk][qt][1]); w.y = pack2(s[2 * kk][qt][2], s[2 * kk][qt][3]);
      w.z = pack2(s[2 * kk + 1][qt][0], s[2 * kk + 1][qt][1]); w.w = pack2(s[2 * kk + 1][qt][2], s[2 * kk + 1][qt][3]);
      pf[qt][kk] = __builtin_bit_cast(bf16x8, w);
    }
}
constexpr float DEFER_THR = 20.f;
template <class VF>
DI void softmax_pv(f32x4 (&s)[4][2], AttnAcc& a, const u16* Vs, float sc, int l15, int g, VF valid) {
  bf16x8 pf[2][2];
  float mxl[2];
#pragma unroll
  for (int qt = 0; qt < 2; ++qt) {
    float mx = -1e30f;
#pragma unroll
    for (int kt = 0; kt < 4; ++kt)
#pragma unroll
      for (int r = 0; r < 4; ++r) { const float v = valid(kt, r, qt) ? s[kt][qt][r] * sc : -1e30f; s[kt][qt][r] = v; mx = fmaxf(mx, v); }
    mxl[qt] = mx;
  }
  if (__any((mxl[0] > a.m[0] + DEFER_THR) || (mxl[1] > a.m[1] + DEFER_THR))) {
#pragma unroll
    for (int qt = 0; qt < 2; ++qt) {
      float mx = mxl[qt];
      mx = fmaxf(mx, __shfl_xor(mx, 16)); mx = fmaxf(mx, __shfl_xor(mx, 32));
      const float mn = fmaxf(a.m[qt], mx), alpha = exp2_(a.m[qt] - mn);
      a.m[qt] = mn; a.l[qt] *= alpha;
#pragma unroll
      for (int d = 0; d < 4; ++d) a.o[d][qt] *= alpha;
    }
  }
#pragma unroll
  for (int qt = 0; qt < 2; ++qt) {
    const float mn = a.m[qt];
    float ls = 0.f;
#pragma unroll
    for (int kt = 0; kt < 4; ++kt)
#pragma unroll
      for (int r = 0; r < 4; ++r) { const float v = s[kt][qt][r]; const float pv = v > -1e29f ? exp2_(v - mn) : 0.f; s[kt][qt][r] = pv; ls += pv; }
    a.l[qt] += ls;
  }
  pack_p(s, pf);
  pv_accum(pf, Vs, a.o, l15, g);
}
DI float group_sum4_(float v) { v += __shfl_xor(v, 16); v += __shfl_xor(v, 32); return v; }
DI bf16x8 scale_frag(bf16x8 f, float sc) {
  u32x4 w = __builtin_bit_cast(u32x4, f);
  w.x = pack2(bflo(w.x) * sc, bfhi(w.x) * sc); w.y = pack2(bflo(w.y) * sc, bfhi(w.y) * sc);
  w.z = pack2(bflo(w.z) * sc, bfhi(w.z) * sc); w.w = pack2(bflo(w.w) * sc, bfhi(w.w) * sc);
  return __builtin_bit_cast(bf16x8, w);
}
DI void attn_init_rel(AttnAcc& a) { attn_init(a); a.m[0] = a.m[1] = 0.f; a.os[0] = (f32x4){0.f, 0.f, 0.f, 0.f}; a.os[1] = (f32x4){0.f, 0.f, 0.f, 0.f}; a.fresh = 1; }
DI void rowsum_accum(const bf16x8 (&pf)[2][2], AttnAcc& a, int l15) {
  const short one = l15 == 0 ? (short)0x3F80 : (short)0;
  const bf16x8 ones = {one, one, one, one, one, one, one, one};
#pragma unroll
  for (int kk = 0; kk < 2; ++kk) { a.os[0] = mfma16(ones, pf[0][kk], a.os[0]); a.os[1] = mfma16(ones, pf[1][kk], a.os[1]); }
}
DI float rel_rowsum(const AttnAcc& a, int qt, int l15) { return __shfl(a.os[qt][0], l15); }
template <int NKS>
DI void qk_tile_rel(const u16* Ks, int dofs, const bf16x8 (&qf)[2][NKS], const AttnAcc& a, f32x4 (&s)[4][2], int l15, int g, bool ok0 = true, bool ok1 = true) {
  const float n0 = ok0 ? -a.m[0] : -1e30f, n1 = ok1 ? -a.m[1] : -1e30f;
#pragma unroll
  for (int kt = 0; kt < 4; ++kt) {
    s[kt][0] = (f32x4){n0, n0, n0, n0}; s[kt][1] = (f32x4){n1, n1, n1, n1};
#pragma unroll
    for (int ks = 0; ks < NKS; ++ks) {
      const bf16x8 k = ldfrag(Ks + (kt * 16 + l15) * KLD + dofs + ks * 32 + 8 * g);
      s[kt][0] = mfma16(k, qf[0][ks], s[kt][0]);
      s[kt][1] = mfma16(k, qf[1][ks], s[kt][1]);
    }
  }
}
template <int MODE, class VF>
DI void softmax_rel(f32x4 (&s)[4][2], AttnAcc& a, bf16x8 (&pf)[2][2], int l15_, VF valid, bool ok0 = true, bool ok1 = true) {
  float mxl[2];
#pragma unroll
  for (int qt = 0; qt < 2; ++qt) {
    float mx = -1e30f;
    const bool okq = qt == 0 ? ok0 : ok1;
#pragma unroll
    for (int kt = 0; kt < 4; ++kt)
#pragma unroll
      for (int r = 0; r < 4; ++r) {
        if (MODE == 1) s[kt][qt][r] = valid(kt, r, qt) ? s[kt][qt][r] : -1e30f;
        if (MODE == 2) s[kt][qt][r] = okq ? s[kt][qt][r] : -1e30f;
        mx = fmaxf(mx, s[kt][qt][r]);
      }
    mxl[qt] = mx;
  }
  if (a.fresh || __any(mxl[0] > DEFER_THR || mxl[1] > DEFER_THR)) {
    bool still = false;
#pragma unroll
    for (int qt = 0; qt < 2; ++qt) {
      float mx = mxl[qt];
      mx = fmaxf(mx, __shfl_xor(mx, 16)); mx = fmaxf(mx, __shfl_xor(mx, 32));
      const bool fresh = rel_rowsum(a, qt, l15_) == 0.f;
      const float dl = mx < -1e29f ? 0.f : (fresh ? mx : fmaxf(mx, 0.f)), alpha = exp2_(-dl);
      still = still || (fresh && mx < -1e29f);
      a.m[qt] += dl; a.os[qt] *= alpha;
#pragma unroll
      for (int d = 0; d < 4; ++d) a.o[d][qt] *= alpha;
#pragma unroll
      for (int kt = 0; kt < 4; ++kt)
#pragma unroll
        for (int r = 0; r < 4; ++r) s[kt][qt][r] -= dl;
    }
    a.fresh = __any(still) ? 1 : 0;
  }
#pragma unroll
  for (int qt = 0; qt < 2; ++qt)
#pragma unroll
    for (int kt = 0; kt < 4; ++kt)
#pragma unroll
      for (int r = 0; r < 4; ++r) s[kt][qt][r] = exp2_(s[kt][qt][r]);
  pack_p(s, pf);
}
template <int MODE, class VF>
DI void softmax_fixed(f32x4 (&s)[4][2], bf16x8 (&pf)[2][2], VF valid) {
#pragma unroll
  for (int qt = 0; qt < 2; ++qt)
#pragma unroll
    for (int kt = 0; kt < 4; ++kt)
#pragma unroll
      for (int r = 0; r < 4; ++r) {
        if (MODE == 1) s[kt][qt][r] = valid(kt, r, qt) ? s[kt][qt][r] : -1e30f;
        s[kt][qt][r] = exp2_(s[kt][qt][r]);
      }
  pack_p(s, pf);
}
DI float group_sum4(float v) { v += __shfl_xor(v, 16); v += __shfl_xor(v, 32); return v; }

constexpr int DSTAGE = 2 * 128 * 64;
DI int fKs(int row) { return (row >> 1) & 7; }
DI int fVs(int row) { return ((row >> 1) & 3) << 1; }
DI void kv_dma128(const u16* kbase, const u16* vbase, int ld, int key0, u16* stage, int tid) {
  const char* kb = (const char*)(kbase + (size_t)key0 * ld); const char* vb = (const char*)(vbase + (size_t)key0 * ld);
#pragma unroll
  for (int i = 0; i < 4; ++i) {
    const int id = tid + 256 * i, row = id >> 3, c8 = id & 7;
    const unsigned off = (unsigned)(row * ld + ((c8 ^ fKs(row)) * 8)) * 2u;
    __builtin_amdgcn_global_load_lds((const unsigned*)(kb + off), (LDSP unsigned*)((LDSP char*)stage + id * 16), 16, 0, 0);
  }
#pragma unroll
  for (int i = 0; i < 4; ++i) {
    const int id = tid + 256 * i, row = id >> 3, c8 = id & 7;
    const unsigned off = (unsigned)(row * ld + ((c8 ^ fVs(row)) * 8)) * 2u;
    __builtin_amdgcn_global_load_lds((const unsigned*)(vb + off), (LDSP unsigned*)((LDSP char*)(stage + 128 * 64) + id * 16), 16, 0, 0);
  }
}
template <int NKS>
DI void qk_tile_rel_sw(const u16* Kh, int dofs, const bf16x8 (&qf)[2][NKS], const AttnAcc& a, f32x4 (&s)[4][2], int l15, int g) {
  const float n0 = -a.m[0], n1 = -a.m[1];
  const int sw = (l15 >> 1) & 7;
  bf16x8 kf[4][NKS];
#pragma unroll
  for (int kt = 0; kt < 4; ++kt)
#pragma unroll
    for (int ks = 0; ks < NKS; ++ks) kf[kt][ks] = ldfrag(Kh + (kt * 16 + l15) * 64 + ((((dofs >> 3) + ks * 4 + g) ^ sw) * 8));
  if constexpr (NKS == 1) asm volatile("" : "+v"(kf[0][0]), "+v"(kf[1][0]), "+v"(kf[2][0]), "+v"(kf[3][0]));
#pragma unroll
  for (int kt = 0; kt < 4; ++kt) {
    s[kt][0] = (f32x4){n0, n0, n0, n0}; s[kt][1] = (f32x4){n1, n1, n1, n1};
#pragma unroll
    for (int ks = 0; ks < NKS; ++ks) {
      s[kt][0] = mfma16(kf[kt][ks], qf[0][ks], s[kt][0]);
      s[kt][1] = mfma16(kf[kt][ks], qf[1][ks], s[kt][1]);
    }
  }
}
DI void v_frags_sw(const u16* Vh, bf16x8 (&vf)[2][4], int l15, int g) {
  const int tq = l15 >> 2, tp = l15 & 3;
#pragma unroll
  for (int kk = 0; kk < 2; ++kk) {
    const int r0 = kk * 32 + 4 * g + tq, r1 = r0 + 16;
    const int f0 = fVs(r0), f1 = fVs(r1);
#pragma unroll
    for (int d = 0; d < 4; ++d) {
      const int lc = d * 2 + (tp >> 1);
      vf[kk][d] = cat4(tr_read(Vh + r0 * 64 + ((lc ^ f0) * 8) + (tp & 1) * 4), tr_read(Vh + r1 * 64 + ((lc ^ f1) * 8) + (tp & 1) * 4));
    }
  }
}
DI void pv_mma(const bf16x8 (&pf)[2][2], bf16x8 (&vf)[2][4], f32x4 (&o)[4][2]) {
  asm volatile("" : "+v"(vf[0][0]), "+v"(vf[0][1]), "+v"(vf[0][2]), "+v"(vf[0][3]), "+v"(vf[1][0]), "+v"(vf[1][1]), "+v"(vf[1][2]), "+v"(vf[1][3]));
#pragma unroll
  for (int kk = 0; kk < 2; ++kk)
#pragma unroll
    for (int d = 0; d < 4; ++d) {
      o[d][0] = mfma16(vf[kk][d], pf[0][kk], o[d][0]);
      o[d][1] = mfma16(vf[kk][d], pf[1][kk], o[d][1]);
    }
}
#define FORCE_BAD false
#define FORCE_BAD_NSA false
DI void diff_attn_task(const Params& p, int layer, int b, int h, int qb, unsigned char* smem, volatile LDSP unsigned* bflag) {
  u16* Ks = (u16*)smem;
  const int tid = otid(), lane = tid & 63, wid = tid >> 6, l15 = lane & 15, g = lane >> 4;
  const u16* proj = (const u16*)(p.ws + OFF_PROJ) + (size_t)b * SEQ * NP;
  const int q0w = qb * 128 + wid * 32;
  const float lam_full = sgprf(((const float*)(p.ws + OFF_LAMF))[layer]);
  const float sc = 0.17677669529663687f * 1.4426950408889634f;
  const u16* vbase = proj + PB_V + h * 64;
  const u16* kbase = proj + PB_K + h * 64;
  lds_barrier();
  if (otid512() == 0) *bflag = 0u;
  kv_dma128(kbase, vbase, NP, 0, Ks, tid);
  bf16x8 qf0[2][1], qf1[2][1];
#pragma unroll
  for (int qt = 0; qt < 2; ++qt) {
    qf0[qt][0] = scale_frag(ldfrag(proj + (size_t)(q0w + qt * 16 + l15) * NP + PB_Q + h * 64 + 8 * g), sc);
    qf1[qt][0] = scale_frag(ldfrag(proj + (size_t)(q0w + qt * 16 + l15) * NP + PB_Q + h * 64 + 32 + 8 * g), sc);
  }
  AttnAcc a0, a1;
  bool safe = false;
  for (;;) {
    attn_init_rel(a0); attn_init_rel(a1);
    const int nst = qb + 1;
    if (safe) {
      lds_barrier();
      if (otid512() == 0) *bflag = 0u;
      kv_dma128(kbase, vbase, NP, 0, Ks, tid);
    }
    asm volatile("s_waitcnt vmcnt(0)" ::: "memory");
    lds_barrier();
    for (int js = 0; js < nst; ++js) {
      const u16* st = Ks + (js & 1) * DSTAGE;
      if (js + 1 < nst) kv_dma128(kbase, vbase, NP, (js + 1) * 128, Ks + ((js + 1) & 1) * DSTAGE, tid);
#pragma unroll 1
      for (int hf = 0; hf < 2; ++hf) {
        const int key0 = js * 128 + hf * 64;
        if (key0 <= q0w + 31) {
          f32x4 s[4][2]; bf16x8 pf[2][2];
          auto valid = [&](int kt, int r, int qt) { return key0 + kt * 16 + 4 * g + r <= q0w + qt * 16 + l15; };
          const bool ref = safe || key0 == 0, full = key0 + 63 <= q0w;
          qk_tile_rel_sw<1>(st + hf * 64 * 64, 0, qf0, a0, s, l15, g);
          if (ref) { if (full) softmax_rel<0>(s, a0, pf, l15, valid); else softmax_rel<1>(s, a0, pf, l15, valid); }
          else { if (full) softmax_fixed<0>(s, pf, valid); else softmax_fixed<1>(s, pf, valid); }
          { bf16x8 vf[2][4]; v_frags_sw(st + 128 * 64 + hf * 64 * 64, vf, l15, g); pv_mma(pf, vf, a0.o); }
          rowsum_accum(pf, a0, l15);
          qk_tile_rel_sw<1>(st + hf * 64 * 64, 32, qf1, a1, s, l15, g);
          if (ref) { if (full) softmax_rel<0>(s, a1, pf, l15, valid); else softmax_rel<1>(s, a1, pf, l15, valid); }
          else { if (full) softmax_fixed<0>(s, pf, valid); else softmax_fixed<1>(s, pf, valid); }
          { bf16x8 vf[2][4]; v_frags_sw(st + 128 * 64 + hf * 64 * 64, vf, l15, g); pv_mma(pf, vf, a1.o); }
          rowsum_accum(pf, a1, l15);
        }
      }
      asm volatile("s_waitcnt vmcnt(0)" ::: "memory");
      lds_barrier();
    }
    {
      const float l00 = rel_rowsum(a0, 0, l15), l01 = rel_rowsum(a0, 1, l15), l10 = rel_rowsum(a1, 0, l15), l11 = rel_rowsum(a1, 1, l15);
      const bool bad = FORCE_BAD || !(l00 > 0.f && l00 < 1e38f) || !(l01 > 0.f && l01 < 1e38f) || !(l10 > 0.f && l10 < 1e38f) || !(l11 > 0.f && l11 < 1e38f);
      if (!safe && __any(bad) && lane == 0) *bflag = 1u;
      lds_barrier();
      const bool redo = !safe && *bflag != 0u;
      if (!redo) break;
      safe = true;
    }
  }
  int lay2 = layer; asm volatile("" : "+s"(lay2));
  const float one_m_li = lay2 == 0 ? 0.8f : 1.f - 0.35550906759096324f;
  u16* Y = (u16*)(p.ws + OFF_H);
  const int tidE = otid(), l15E = tidE & 15, gE = (tidE & 63) >> 4, q0wE = qb * 128 + (tidE >> 6) * 32;
  const float* ng = p.diff_norm_g + layer * 64;
  u32x2 zzv[2][4]; f32x4 ggv[4];
#pragma unroll
  for (int d = 0; d < 4; ++d) {
    ggv[d] = *(const f32x4*)(ng + d * 16 + 4 * gE);
#pragma unroll
    for (int qt = 0; qt < 2; ++qt) zzv[qt][d] = *(const u32x2*)(proj + (size_t)(q0wE + qt * 16 + l15E) * NP + PB_Z + h * 64 + d * 16 + 4 * gE);
  }
  asm volatile("" : "+v"(zzv[0][0]), "+v"(zzv[0][1]), "+v"(zzv[0][2]), "+v"(zzv[0][3]), "+v"(zzv[1][0]), "+v"(zzv[1][1]), "+v"(zzv[1][2]), "+v"(zzv[1][3]), "+v"(ggv[0]), "+v"(ggv[1]), "+v"(ggv[2]), "+v"(ggv[3]));
#pragma unroll
  for (int qt = 0; qt < 2; ++qt) {
    const float i0 = 1.f / rel_rowsum(a0, qt, l15E), i1 = -lam_full / rel_rowsum(a1, qt, l15E);
    f32x4 res[4];
    float ss = 0.f;
#pragma unroll
    for (int d = 0; d < 4; ++d) { const f32x4 v = a0.o[d][qt] * i0 + a1.o[d][qt] * i1; res[d] = v; ss += v[0] * v[0] + v[1] * v[1] + v[2] * v[2] + v[3] * v[3]; }
    ss = group_sum4(ss);
    const float rn = rsqrtf(ss * (1.f / 64.f) + 1e-6f) * one_m_li;
    const int t = q0wE + qt * 16 + l15E;
    const size_t row = (size_t)b * SEQ + t;
#pragma unroll
    for (int d = 0; d < 4; ++d) {
      const int dd = d * 16 + 4 * gE;
      const f32x4 v = res[d];
      const u32x2 zz = zzv[qt][d];
      const f32x4 gg = ggv[d];
      u32x2 w;
      w.x = pack2(v[0] * rn * gg[0] * siluf(bflo(zz.x)), v[1] * rn * gg[1] * siluf(bfhi(zz.x)));
      w.y = pack2(v[2] * rn * gg[2] * siluf(bflo(zz.y)), v[3] * rn * gg[3] * siluf(bfhi(zz.y)));
      *(u32x2*)(Y + row * 1024 + Y_B + h * 64 + dd) = w;
    }
  }
}

template <int NKS>
DI void qk_tile1(const u16* Ks, const bf16x8 (&qf)[NKS], f32x4 (&s)[4], int l15, int g) {
#pragma unroll
  for (int kt = 0; kt < 4; ++kt) {
    s[kt] = (f32x4){0.f, 0.f, 0.f, 0.f};
#pragma unroll
    for (int ks = 0; ks < NKS; ++ks) s[kt] = mfma16(ldfrag(Ks + (kt * 16 + l15) * KLD + ks * 32 + 8 * g), qf[ks], s[kt]);
  }
}
DI void pv_accum1(const f32x4 (&s)[4], const u16* Vs, f32x4 (&o)[4], int l15, int g) {
  const int tq = l15 >> 2, tp = l15 & 3;
#pragma unroll
  for (int kk = 0; kk < 2; ++kk) {
    u32x4 w;
    w.x = pack2(s[2 * kk][0], s[2 * kk][1]); w.y = pack2(s[2 * kk][2], s[2 * kk][3]);
    w.z = pack2(s[2 * kk + 1][0], s[2 * kk + 1][1]); w.w = pack2(s[2 * kk + 1][2], s[2 * kk + 1][3]);
    const bf16x8 pf = __builtin_bit_cast(bf16x8, w);
#pragma unroll
    for (int d = 0; d < 4; ++d) {
      const bf16x8 vf = cat4(tr_read(Vs + (kk * 32 + 4 * g + tq) * KLD + d * 16 + 4 * tp), tr_read(Vs + (kk * 32 + 16 + 4 * g + tq) * KLD + d * 16 + 4 * tp));
      o[d] = mfma16(vf, pf, o[d]);
    }
  }
}

constexpr int SEQ_LDS_A = 0, SEQ_LDS_B = 128 * KLD * 2, SEQ_LDS_C = 2 * 128 * KLD * 2, SEQ_LDS_S = 3 * 128 * KLD * 2, SEQ_LDS_F = SEQ_LDS_S + 64 * KLD * 2;
constexpr int SEQ_LDS_HALO = SEQ_LDS_F + 4096;
constexpr int SEQ_LDS_CW = SEQ_LDS_HALO + 2 * 3 * 3 * 64 * 2;
DI float wave_scan_add(float x, int lane) {
#pragma unroll
  for (int o = 1; o < 64; o <<= 1) { const float y = __shfl_up(x, o); if (lane >= o) x += y; }
  return x;
}
DI float wave_scan_max(float x, int lane) {
#pragma unroll
  for (int o = 1; o < 64; o <<= 1) { const float y = __shfl_up(x, o); if (lane >= o) x = fmaxf(x, y); }
  return x;
}

DI void seq_fix_rows(const Params& p, int layer, int r0, int nrows) {
  u16* Y = (u16*)(p.ws + OFF_H);
  const u16* proj = (const u16*)(p.ws + OFF_PROJ);
  const int tid = otid(), lane = tid & 63, wv = tid >> 6;
  const bool ml = (bool)__builtin_amdgcn_readfirstlane(wv & 1);
  const int sub = lane >> 5, ch = (lane & 31) * 8;
  const float* ng = ml ? p.ml_norm_g + layer * 64 + (ch & 63) : p.ssm_norm_g + layer * 256 + ch;
  const f32x4 g0 = *(const f32x4*)ng, g1 = *(const f32x4*)(ng + 4);
  const int ycol = (ml ? Y_D : Y_C) + ch, zcol = (ml ? PD_Z : PC_Z) + ch;
  for (int rb = (wv >> 1) * 8; rb < nrows; rb += 16) {
    u32x4 yv4[4], zv4[4], ov4[4];
#pragma unroll
    for (int j = 0; j < 4; ++j) {
      const size_t row = (size_t)(r0 + rb + 2 * j + sub);
      yv4[j] = *(const u32x4*)(Y + row * 1024 + ycol);
      zv4[j] = *(const u32x4*)(proj + row * NP + zcol);
      ov4[j] = *(const u32x4*)(proj + row * NP + PD_O + ch);
    }
    asm volatile("" : "+v"(yv4[0]), "+v"(yv4[1]), "+v"(yv4[2]), "+v"(yv4[3]), "+v"(zv4[0]), "+v"(zv4[1]), "+v"(zv4[2]), "+v"(zv4[3]), "+v"(ov4[0]), "+v"(ov4[1]), "+v"(ov4[2]), "+v"(ov4[3]));
#pragma unroll
    for (int j = 0; j < 4; ++j) {
      const size_t row = (size_t)(r0 + rb + 2 * j + sub);
      u16* yp = Y + row * 1024 + ycol;
      const u32x4 yv = yv4[j], zv = zv4[j], ov = ov4[j];
      float v[8] = {bflo(yv.x), bfhi(yv.x), bflo(yv.y), bfhi(yv.y), bflo(yv.z), bfhi(yv.z), bflo(yv.w), bfhi(yv.w)};
      float z[8] = {bflo(zv.x), bfhi(zv.x), bflo(zv.y), bfhi(zv.y), bflo(zv.z), bfhi(zv.z), bflo(zv.w), bfhi(zv.w)};
      float ss = 0.f;
      float o8[8];
      if (ml) {
        const float o[8] = {bflo(ov.x), bfhi(ov.x), bflo(ov.y), bfhi(ov.y), bflo(ov.z), bfhi(ov.z), bflo(ov.w), bfhi(ov.w)};
#pragma unroll
        for (int i = 0; i < 8; ++i) { v[i] *= sigmoidf_(o[i]); ss += v[i] * v[i]; }
        ss += __shfl_xor(ss, 1); ss += __shfl_xor(ss, 2); ss += __shfl_xor(ss, 4);
        const float rn = rsqrtf(ss * (1.f / 64.f) + 1e-6f);
#pragma unroll
        for (int i = 0; i < 8; ++i) { const float gg = i < 4 ? g0[i & 3] : g1[i & 3]; o8[i] = v[i] * rn * gg * siluf(z[i]); }
      } else {
#pragma unroll
        for (int i = 0; i < 8; ++i) { v[i] *= siluf(z[i]); ss += v[i] * v[i]; }
        ss += __shfl_xor(ss, 1); ss += __shfl_xor(ss, 2); ss += __shfl_xor(ss, 4); ss += __shfl_xor(ss, 8);
        const float rn = rsqrtf(ss * (1.f / 128.f) + 1e-6f);
#pragma unroll
        for (int i = 0; i < 8; ++i) { const float gg = i < 4 ? g0[i & 3] : g1[i & 3]; o8[i] = v[i] * rn * gg; }
      }
      u32x4 w; w.x = pack2(o8[0], o8[1]); w.y = pack2(o8[2], o8[3]); w.z = pack2(o8[4], o8[5]); w.w = pack2(o8[6], o8[7]);
      *(u32x4*)yp = w;
    }
  }
}


constexpr int SEQ8_LDS_F = SEQ_LDS_S + 64 * KLD * 2;
constexpr int SEQ8_LDS_HALO = SEQ8_LDS_F + 8192;
constexpr int SEQ8_LDS_CW = SEQ8_LDS_HALO + 2 * 3 * 3 * 64 * 2;
DI void stage_conv_w8(float* wl, const float* cw, const float* cb, int chan0, int nchan, int tid) {
  if (tid < 320) { const int j = tid >> 6, cc = tid & 63; wl[tid] = j < 4 ? cw[j * nchan + chan0 + cc] : cb[chan0 + cc]; }
}
DI void scale_rows8(u16* A, const float* rs, int tid) {
  const int ch = (tid & 7) * 8;
#pragma unroll
  for (int i = 0; i < 2; ++i) {
    const int row = (tid >> 3) + 64 * i;
    const float f = rs[row];
    u32x4 v = *(u32x4*)(A + row * KLD + ch);
    v.x = pack2(bflo(v.x) * f, bfhi(v.x) * f); v.y = pack2(bflo(v.y) * f, bfhi(v.y) * f);
    v.z = pack2(bflo(v.z) * f, bfhi(v.z) * f); v.w = pack2(bflo(v.w) * f, bfhi(v.w) * f);
    *(u32x4*)(A + row * KLD + ch) = v;
  }
}
DI void state_update8(const u16* Xs, const u16* Bs, f32x4 (&acc)[2], int w8, int l15, int g) {
  const int tq = l15 >> 2, tp = l15 & 3, pt = w8 >> 1, nt0 = (w8 & 1) * 2;
#pragma unroll
  for (int kk = 0; kk < 4; ++kk) {
    const bf16x8 af = cat4(tr_read(Xs + (kk * 32 + 4 * g + tq) * KLD + pt * 16 + 4 * tp), tr_read(Xs + (kk * 32 + 16 + 4 * g + tq) * KLD + pt * 16 + 4 * tp));
#pragma unroll
    for (int n = 0; n < 2; ++n) {
      const bf16x8 bfr = cat4(tr_read(Bs + (kk * 32 + 4 * g + tq) * KLD + (nt0 + n) * 16 + 4 * tp), tr_read(Bs + (kk * 32 + 16 + 4 * g + tq) * KLD + (nt0 + n) * 16 + 4 * tp));
      acc[n] = mfma16(af, bfr, acc[n]);
    }
  }
}
DI void state_to_lds8(u16* Ss, const f32x4 (&acc)[2], int w8, int l15, int g) {
  const int pt = w8 >> 1, nt0 = (w8 & 1) * 2;
#pragma unroll
  for (int n = 0; n < 2; ++n)
#pragma unroll
    for (int r = 0; r < 4; ++r) Ss[(pt * 16 + 4 * g + r) * KLD + (nt0 + n) * 16 + l15] = f2bf(acc[n][r]);
}

constexpr int SEQ8_LDS_ZERO = SEQ8_LDS_CW + 3 * 320 * 4;
constexpr int SEQ8_LDS_RAW = ((SEQ8_LDS_ZERO + 3 * 128 + 255) / 256) * 256;
DI void raw_dma8(const u16* projb, int col0, int t0, u16* raw, int tid) {
#pragma unroll
  for (int i = 0; i < 2; ++i) {
    const int chunk = tid + 512 * i;
    __builtin_amdgcn_global_load_lds((const unsigned*)(projb + (size_t)(t0 + (chunk >> 3)) * NP + col0 + (chunk & 7) * 8), (LDSP unsigned*)((LDSP char*)raw + chunk * 16), 16, 0, 0);
  }
}
DI void conv_raw8(const u16* raw, const u16* halo, const float* wl, const float* rowscale, float cscale, u16* dst, int tid) {
  const int q = tid >> 3, ch = (tid & 7) * 8;
  u32x4 v[5];
#pragma unroll
  for (int k = 0; k < 5; ++k) { const int r = 2 * q - 3 + k; v[k] = r >= 0 ? *(const u32x4*)(raw + r * 64 + ch) : *(const u32x4*)(halo + (r + 3) * 64 + ch); }
  float w[5][8];
#pragma unroll
  for (int j = 0; j < 5; ++j) { const f32x4 w0 = *(const f32x4*)(wl + j * 64 + ch), w1 = *(const f32x4*)(wl + j * 64 + ch + 4);
    w[j][0] = w0[0]; w[j][1] = w0[1]; w[j][2] = w0[2]; w[j][3] = w0[3]; w[j][4] = w1[0]; w[j][5] = w1[1]; w[j][6] = w1[2]; w[j][7] = w1[3]; }
#pragma unroll
  for (int o = 0; o < 2; ++o) {
    float acc[8];
#pragma unroll
    for (int i = 0; i < 8; ++i) acc[i] = w[4][i];
#pragma unroll
    for (int j = 0; j < 4; ++j) {
      const u32x4 x = v[o + j];
      acc[0] += w[j][0] * bflo(x.x); acc[1] += w[j][1] * bfhi(x.x); acc[2] += w[j][2] * bflo(x.y); acc[3] += w[j][3] * bfhi(x.y);
      acc[4] += w[j][4] * bflo(x.z); acc[5] += w[j][5] * bfhi(x.z); acc[6] += w[j][6] * bflo(x.w); acc[7] += w[j][7] * bfhi(x.w);
    }
    const float rs = (rowscale ? rowscale[2 * q + o] : 1.f) * cscale;
#pragma unroll
    for (int i = 0; i < 8; ++i) acc[i] = siluf(acc[i]) * rs;
    u32x4 ov; ov.x = pack2(acc[0], acc[1]); ov.y = pack2(acc[2], acc[3]); ov.z = pack2(acc[4], acc[5]); ov.w = pack2(acc[6], acc[7]);
    *(u32x4*)(dst + (2 * q + o) * KLD + ch) = ov;
  }
}
DI void save_halo8(const u16* raw, u16* halo, int tid) {
  if (tid < 72) { const int arr = tid / 24, rem = tid % 24; *(u32x4*)(halo + arr * 192 + rem * 8) = *(const u32x4*)(raw + arr * 8192 + 125 * 64 + rem * 8); }
}

DI void ssd_task8(const Params& p, int layer, int b, int h, unsigned char* smem) {
  u16* Cs = (u16*)(smem + SEQ_LDS_A); u16* Bs = (u16*)(smem + SEQ_LDS_B); u16* Xs = (u16*)(smem + SEQ_LDS_C); u16* Ss = (u16*)(smem + SEQ_LDS_S);
  float* fl = (float*)(smem + SEQ8_LDS_F);
  float* dts = fl; float* acs = fl + 128; float* wend = fl + 256; float* tmp = fl + 384;
  u16* halo = (u16*)(smem + SEQ8_LDS_HALO); float* cwl = (float*)(smem + SEQ8_LDS_CW); u16* zero3 = (u16*)(smem + SEQ8_LDS_ZERO);
  u16* raw = (u16*)(smem + SEQ8_LDS_RAW);
  int tid = otid512(), lane = tid & 63, w = tid >> 6, l15 = lane & 15, g = lane >> 4;
  const int gi = h >> 1;
  const u16* projb = (const u16*)(p.ws + OFF_PROJ) + (size_t)b * SEQ * NP;
  const float* smb = (const float*)(p.ws + OFF_SMALL) + (size_t)b * SEQ * NSMALL;
  const float* cw = p.ssm_conv_w + layer * 4 * 512; const float* cb = p.ssm_conv_b + layer * 512;
  u16* Y = (u16*)(p.ws + OFF_H);
  const float a_h = sgprf(-__expf(p.ssm_a_log[layer * 4 + h])), d_h = sgprf(p.ssm_d[layer * 4 + h]), dtb = sgprf(p.ssm_dt_bias[layer * 4 + h]);
  const int colB = PC_XBC + 256 + gi * 64, colC = PC_XBC + 384 + gi * 64, colX = PC_XBC + h * 64;
  f32x4 st[2] = {(f32x4){0.f, 0.f, 0.f, 0.f}, (f32x4){0.f, 0.f, 0.f, 0.f}};
  lds_barrier();
  stage_conv_w8(cwl, cw, cb, 256 + gi * 64, 512, tid);
  stage_conv_w8(cwl + 320, cw, cb, 384 + gi * 64, 512, tid);
  stage_conv_w8(cwl + 640, cw, cb, h * 64, 512, tid);
  if (tid < 96) ((unsigned*)zero3)[tid] = 0u;
  raw_dma8(projb, colB, 0, raw, tid); raw_dma8(projb, colC, 0, raw + 8192, tid); raw_dma8(projb, colX, 0, raw + 16384, tid);
  float dtraw = 0.f;
  if (tid < 128) dtraw = smb[(size_t)tid * NSMALL + SM_DT + h];
#pragma unroll 1
  for (int c = 0; c < 32; ++c) {
    const int t0 = c * 128;
    float dtv = 0.f;
    if (tid < 128) { const float xr = dtraw + dtb; dtv = xr > 15.f ? xr : (xr < -15.f ? __expf(xr) : __logf(1.f + __expf(xr))); }
    float cs = wave_scan_add(dtv * a_h, lane);
    if (tid == 63) tmp[0] = cs;
    asm volatile("s_waitcnt vmcnt(0)" ::: "memory");
    lds_barrier();
    if (w == 1) cs += tmp[0];
    if (tid < 128) { dts[tid] = dtv; acs[tid] = cs; }
    if (c + 1 < 32 && tid < 128) dtraw = smb[(size_t)(t0 + 128 + tid) * NSMALL + SM_DT + h];
    lds_barrier();
    {
      const u16* hc = halo + (c & 1) * 576;
      const u16* hB = c == 0 ? zero3 : hc; const u16* hC = c == 0 ? zero3 : hc + 192; const u16* hX = c == 0 ? zero3 : hc + 384;
      conv_raw8(raw, hB, cwl, nullptr, 1.f, Bs, tid);
      conv_raw8(raw + 8192, hC, cwl + 320, nullptr, 1.f, Cs, tid);
      conv_raw8(raw + 16384, hX, cwl + 640, dts, 1.f, Xs, tid);
      save_halo8(raw, halo + ((c + 1) & 1) * 576, tid);
    }
    if (tid < 128) wend[tid] = __expf(acs[127] - acs[tid]);
    state_to_lds8(Ss, st, w, l15, g);
    lds_barrier();
    if (c + 1 < 32) { raw_dma8(projb, colB, t0 + 128, raw, tid); raw_dma8(projb, colC, t0 + 128, raw + 8192, tid); raw_dma8(projb, colX, t0 + 128, raw + 16384, tid); }
    {
      const int tl = 16 * w + l15;
      bf16x8 cf[2];
#pragma unroll
      for (int ks = 0; ks < 2; ++ks) cf[ks] = ldfrag(Cs + tl * KLD + ks * 32 + 8 * g);
      f32x4 y[4];
#pragma unroll
      for (int d = 0; d < 4; ++d) y[d] = (f32x4){0.f, 0.f, 0.f, 0.f};
      const float at = acs[tl];
#pragma unroll 1
      for (int stl = 0; stl < 2; ++stl) {
        if (stl * 64 <= 16 * w + 15) {
          f32x4 sc[4];
          qk_tile1<2>(Bs + stl * 64 * KLD, cf, sc, l15, g);
#pragma unroll
          for (int kt = 0; kt < 4; ++kt) {
            const f32x4 as = *(const f32x4*)(acs + stl * 64 + kt * 16 + 4 * g);
#pragma unroll
            for (int r = 0; r < 4; ++r) {
              const bool ok = stl * 64 + kt * 16 + 4 * g + r <= tl;
              sc[kt][r] = ok ? sc[kt][r] * __expf(at - as[r]) : 0.f;
            }
          }
          pv_accum1(sc, Xs + stl * 64 * KLD, y, l15, g);
        }
      }
      const float ea = __expf(at), dsk = d_h / dts[tl];
      const size_t row = (size_t)b * SEQ + t0 + tl;
#pragma unroll
      for (int d = 0; d < 4; ++d) {
        f32x4 yo = (f32x4){0.f, 0.f, 0.f, 0.f};
#pragma unroll
        for (int ks = 0; ks < 2; ++ks) yo = mfma16(ldfrag(Ss + (d * 16 + l15) * KLD + ks * 32 + 8 * g), cf[ks], yo);
        const u32x2 xv = *(const u32x2*)(Xs + tl * KLD + d * 16 + 4 * g);
        const f32x4 v = y[d] + yo * ea;
        u32x2 o; o.x = pack2(v[0] + dsk * bflo(xv.x), v[1] + dsk * bfhi(xv.x)); o.y = pack2(v[2] + dsk * bflo(xv.y), v[3] + dsk * bfhi(xv.y));
        *(u32x2*)(Y + row * 1024 + Y_C + h * 64 + d * 16 + 4 * g) = o;
      }
    }
    lds_barrier();
    scale_rows8(Xs, wend, tid);
    lds_barrier();
    const float cd = __expf(acs[127]);
    st[0] *= cd; st[1] *= cd;
    state_update8(Xs, Bs, st, w, l15, g);
  }
  asm volatile("s_waitcnt vmcnt(0)" ::: "memory");
}

DI void mlstm_task8(const Params& p, int layer, int b, int h, unsigned char* smem) {
  u16* Qs = (u16*)(smem + SEQ_LDS_A); u16* Ks2 = (u16*)(smem + SEQ_LDS_B); u16* Vs2 = (u16*)(smem + SEQ_LDS_C); u16* Cst = (u16*)(smem + SEQ_LDS_S);
  float* fl = (float*)(smem + SEQ8_LDS_F);
  float* bcs = fl; float* us = fl + 128; float* pms = fl + 256; float* wend = fl + 384; float* nst = fl + 512; float* tmp = fl + 576; float* npart = fl + 640;
  u16* halo = (u16*)(smem + SEQ8_LDS_HALO); float* cwl = (float*)(smem + SEQ8_LDS_CW); u16* zero3 = (u16*)(smem + SEQ8_LDS_ZERO);
  u16* raw = (u16*)(smem + SEQ8_LDS_RAW);
  int tid = otid512(), lane = tid & 63, w = tid >> 6, l15 = lane & 15, g = lane >> 4;
  const u16* projb = (const u16*)(p.ws + OFF_PROJ) + (size_t)b * SEQ * NP;
  const float* smb = (const float*)(p.ws + OFF_SMALL) + (size_t)b * SEQ * NSMALL;
  const float* cw = p.ml_conv_w + layer * 4 * 512; const float* cb = p.ml_conv_b + layer * 512;
  const float ib = sgprf(p.ml_if_b[layer * 8 + h]), fb = sgprf(p.ml_if_b[layer * 8 + 4 + h]);
  u16* Y = (u16*)(p.ws + OFF_H);
  const int colQ = PD_QK + h * 64, colK = PD_QK + 256 + h * 64, colV = PD_V + h * 64;
  f32x4 st[2] = {(f32x4){0.f, 0.f, 0.f, 0.f}, (f32x4){0.f, 0.f, 0.f, 0.f}};
  float m_prev = 0.f;
  lds_barrier();
  if (tid < 64) nst[tid] = 0.f;
  stage_conv_w8(cwl, cw, cb, h * 64, 512, tid);
  stage_conv_w8(cwl + 320, cw, cb, 256 + h * 64, 512, tid);
  if (tid < 96) ((unsigned*)zero3)[tid] = 0u;
  raw_dma8(projb, colQ, 0, raw, tid); raw_dma8(projb, colK, 0, raw + 8192, tid); raw_dma8(projb, colV, 0, raw + 16384, tid);
  float iraw = 0.f, fraw = 0.f;
  if (tid < 128) { iraw = smb[(size_t)tid * NSMALL + SM_IF + h]; fraw = smb[(size_t)tid * NSMALL + SM_IF + 4 + h]; }
#pragma unroll 1
  for (int c = 0; c < 32; ++c) {
    const int t0 = c * 128;
    float ip = 0.f, lf = 0.f;
    if (tid < 128) { ip = iraw + ib; const float fp = fraw + fb; lf = fminf(fp, 0.f) - __logf(1.f + __expf(-fabsf(fp))); }
    float bc = wave_scan_add(lf, lane);
    if (tid == 63) tmp[0] = bc;
    asm volatile("s_waitcnt vmcnt(0)" ::: "memory");
    lds_barrier();
    if (w == 1) bc += tmp[0];
    const float u = tid < 128 ? ip - bc : -1e30f;
    float pm = wave_scan_max(u, lane);
    if (tid == 63) tmp[1] = pm;
    if (c + 1 < 32 && tid < 128) { iraw = smb[(size_t)(t0 + 128 + tid) * NSMALL + SM_IF + h]; fraw = smb[(size_t)(t0 + 128 + tid) * NSMALL + SM_IF + 4 + h]; }
    {
      const u16* hc = halo + (c & 1) * 576;
      const u16* hQ = c == 0 ? zero3 : hc; const u16* hK = c == 0 ? zero3 : hc + 192;
      conv_raw8(raw, hQ, cwl, nullptr, 1.f, Qs, tid);
      conv_raw8(raw + 8192, hK, cwl + 320, nullptr, 0.125f, Ks2, tid);
      save_halo8(raw, halo + ((c + 1) & 1) * 576, tid);
#pragma unroll
      for (int i = 0; i < 2; ++i) { const int chunk = tid + 512 * i; *(u32x4*)(Vs2 + (chunk >> 3) * KLD + (chunk & 7) * 8) = *(const u32x4*)(raw + 16384 + chunk * 8); }
    }
    state_to_lds8(Cst, st, w, l15, g);
    lds_barrier();
    if (w == 1) pm = fmaxf(pm, tmp[1]);
    if (tid < 128) { bcs[tid] = bc; us[tid] = u; pms[tid] = pm; }
    if (c + 1 < 32) { raw_dma8(projb, colQ, t0 + 128, raw, tid); raw_dma8(projb, colK, t0 + 128, raw + 8192, tid); raw_dma8(projb, colV, t0 + 128, raw + 16384, tid); }
    lds_barrier();
    const float blast = bcs[127];
    const float m_new = blast + fmaxf(m_prev, pms[127]);
    if (tid < 128) wend[tid] = __expf(blast - m_new + us[tid]);
    {
      const int tl = 16 * w + l15;
      bf16x8 qf[2];
#pragma unroll
      for (int ks = 0; ks < 2; ++ks) qf[ks] = ldfrag(Qs + tl * KLD + ks * 32 + 8 * g);
      f32x4 num[4];
#pragma unroll
      for (int d = 0; d < 4; ++d) num[d] = (f32x4){0.f, 0.f, 0.f, 0.f};
      const float bt = bcs[tl], mt = bt + fmaxf(m_prev, pms[tl]);
      float den = 0.f;
#pragma unroll 1
      for (int stl = 0; stl < 2; ++stl) {
        if (stl * 64 <= 16 * w + 15) {
          f32x4 sc[4];
          qk_tile1<2>(Ks2 + stl * 64 * KLD, qf, sc, l15, g);
#pragma unroll
          for (int kt = 0; kt < 4; ++kt) {
            const f32x4 uu = *(const f32x4*)(us + stl * 64 + kt * 16 + 4 * g);
#pragma unroll
            for (int r = 0; r < 4; ++r) {
              const bool ok = stl * 64 + kt * 16 + 4 * g + r <= tl;
              const float v = ok ? sc[kt][r] * __expf(bt - mt + uu[r]) : 0.f;
              sc[kt][r] = v; den += v;
            }
          }
          pv_accum1(sc, Vs2 + stl * 64 * KLD, num, l15, g);
        }
      }
      const float wi = __expf(bt + m_prev - mt);
      float qn = 0.f;
#pragma unroll
      for (int ks = 0; ks < 2; ++ks)
#pragma unroll
        for (int j = 0; j < 8; ++j) qn += bf2f((u16)qf[ks][j]) * nst[ks * 32 + 8 * g + j];
      qn = group_sum4(qn);
      const float dn = group_sum4(den) + wi * qn;
      const float inv = __builtin_amdgcn_rcpf(fmaxf(fabsf(dn), __expf(-mt)));
      const size_t row = (size_t)b * SEQ + t0 + tl;
#pragma unroll
      for (int d = 0; d < 4; ++d) {
        f32x4 ni = (f32x4){0.f, 0.f, 0.f, 0.f};
#pragma unroll
        for (int ks = 0; ks < 2; ++ks) ni = mfma16(ldfrag(Cst + (d * 16 + l15) * KLD + ks * 32 + 8 * g), qf[ks], ni);
        const f32x4 v = (num[d] + ni * wi) * inv;
        u32x2 o; o.x = pack2(v[0], v[1]); o.y = pack2(v[2], v[3]);
        *(u32x2*)(Y + row * 1024 + Y_D + h * 64 + d * 16 + 4 * g) = o;
      }
    }
    lds_barrier();
    scale_rows8(Ks2, wend, tid);
    lds_barrier();
    const float fprev = __expf(blast + m_prev - m_new);
    st[0] *= fprev; st[1] *= fprev;
    state_update8(Vs2, Ks2, st, w, l15, g);
    {
      const int e = tid & 63, part = tid >> 6;
      float a = 0.f;
#pragma unroll
      for (int s2 = 0; s2 < 16; ++s2) a += bf2f(Ks2[(part * 16 + s2) * KLD + e]);
      npart[part * 64 + e] = a;
    }
    lds_barrier();
    if (tid < 64) {
      float a = nst[tid] * fprev;
#pragma unroll
      for (int pp = 0; pp < 8; ++pp) a += npart[pp * 64 + tid];
      nst[tid] = a;
    }
    m_prev = m_new;
  }
  asm volatile("s_waitcnt vmcnt(0)" ::: "memory");
}

DI void compress_task(const Params& p, int layer, int b, int kv, int rb, unsigned char* smem) {
  constexpr int HLD = 136;
  u16* Hs = (u16*)smem;
  const int tid = otid(), lane = tid & 63, w = tid >> 6, l15 = lane & 15, g = lane >> 4;
  const u16* projb = (const u16*)(p.ws + OFF_PROJ) + (size_t)b * SEQ * NP + (kv ? PA_VC : PA_KC);
  const int mi = layer * 2 + kv;
  const u16* W1T = (const u16*)(p.ws + OFF_W1T) + (size_t)mi * 128 * 2048;
  const u16* W2T = (const u16*)(p.ws + OFF_W2T) + (size_t)mi * 64 * 128;
  const float* bias1 = (const float*)(p.ws + OFF_BIAS1) + mi * 16 * 128;
  f32x4 acc[2][2];
#pragma unroll
  for (int nt = 0; nt < 2; ++nt) { acc[nt][0] = (f32x4){0.f, 0.f, 0.f, 0.f}; acc[nt][1] = (f32x4){0.f, 0.f, 0.f, 0.f}; }
  int tok[2];
#pragma unroll
  for (int mt = 0; mt < 2; ++mt) { int i = rb * 32 + mt * 16 + l15; if (i > 254) i = 254; tok[mt] = 16 * i; }
#pragma unroll 4
  for (int ks = 0; ks < 64; ++ks) {
    const int j = ks >> 1, d0 = (ks & 1) * 32;
    bf16x8 af[2], wf[2];
#pragma unroll
    for (int mt = 0; mt < 2; ++mt) af[mt] = ldfrag(projb + (size_t)(tok[mt] + j) * NP + d0 + 8 * g);
#pragma unroll
    for (int nt = 0; nt < 2; ++nt) wf[nt] = ldfrag(W1T + (size_t)(w * 32 + nt * 16 + l15) * 2048 + ks * 32 + 8 * g);
#pragma unroll
    for (int nt = 0; nt < 2; ++nt)
#pragma unroll
      for (int mt = 0; mt < 2; ++mt) acc[nt][mt] = mfma16(wf[nt], af[mt], acc[nt][mt]);
  }
  lds_barrier();
#pragma unroll
  for (int nt = 0; nt < 2; ++nt) {
    const int n = w * 32 + nt * 16 + 4 * g;
    f32x4 bp[16];
#pragma unroll
    for (int pc = 0; pc < 16; ++pc) bp[pc] = *(const f32x4*)(bias1 + pc * 128 + n);
#pragma unroll
    for (int pc = 0; pc < 16; pc += 4) asm volatile("" : "+v"(bp[pc]), "+v"(bp[pc + 1]), "+v"(bp[pc + 2]), "+v"(bp[pc + 3]));
    f32x4 bb = bp[0];
#pragma unroll
    for (int pc = 1; pc < 16; ++pc) bb += bp[pc];
#pragma unroll
    for (int mt = 0; mt < 2; ++mt) {
      const f32x4 v = acc[nt][mt] + bb;
      u32x2 o; o.x = pack2(siluf(v[0]), siluf(v[1])); o.y = pack2(siluf(v[2]), siluf(v[3]));
      *(u32x2*)(Hs + (mt * 16 + l15) * HLD + n) = o;
    }
  }
  lds_barrier();
  f32x4 acc2[2] = {(f32x4){0.f, 0.f, 0.f, 0.f}, (f32x4){0.f, 0.f, 0.f, 0.f}};
#pragma unroll
  for (int ks = 0; ks < 4; ++ks) {
    const bf16x8 wf = ldfrag(W2T + (size_t)(w * 16 + l15) * 128 + ks * 32 + 8 * g);
#pragma unroll
    for (int mt = 0; mt < 2; ++mt) acc2[mt] = mfma16(wf, ldfrag(Hs + (mt * 16 + l15) * HLD + ks * 32 + 8 * g), acc2[mt]);
  }
  u16* dst = (u16*)(p.ws + (kv ? OFF_VCMP : OFF_KCMP) + (size_t)layer * 512 * 1024) + (size_t)b * 256 * 64;
#pragma unroll
  for (int mt = 0; mt < 2; ++mt) {
    const int i = rb * 32 + mt * 16 + l15;
    u32x2 o; o.x = pack2(acc2[mt][0], acc2[mt][1]); o.y = pack2(acc2[mt][2], acc2[mt][3]);
    if (i > 254) { o.x = 0u; o.y = 0u; }
    *(u32x2*)(dst + (size_t)i * 64 + w * 16 + 4 * g) = o;
  }
}

DI void nsa_task(const Params& p, int layer, int b, int qi, unsigned char* smem, volatile LDSP unsigned* bflag) {
  u16* Ks = (u16*)smem; u16* Vs = Ks + 64 * KLD;
  float* T = (float*)(smem + 2 * KVBUF * 2);
  unsigned long long* selm = (unsigned long long*)(smem + 2 * KVBUF * 2 + 4 * 32 * 65 * 4);
  const int tid = otid(), lane = tid & 63, h = tid >> 6, l15 = lane & 15, g = lane >> 4;
  const int q0 = qi * 32;
  const u16* projb = (const u16*)(p.ws + OFF_PROJ) + (size_t)b * SEQ * NP;
  const float* smb = (const float*)(p.ws + OFF_SMALL) + (size_t)b * SEQ * NSMALL;
  const u16* kcmp = (const u16*)(p.ws + OFF_KCMP + (size_t)layer * 512 * 1024) + (size_t)b * 256 * 64;
  const u16* vcmp = (const u16*)(p.ws + OFF_VCMP + (size_t)layer * 512 * 1024) + (size_t)b * 256 * 64;
  bf16x8 qf[2][2];
#pragma unroll
  for (int qt = 0; qt < 2; ++qt)
#pragma unroll
    for (int ks = 0; ks < 2; ++ks) qf[qt][ks] = ldfrag(projb + (size_t)(q0 + qt * 16 + l15) * NP + PA_Q + h * 64 + ks * 32 + 8 * g);
  const float sc = 0.125f * 1.4426950408889634f;
  f32x4 outacc[4][2];
  AttnAcc a;
  const int ntc = (q0 >> 10) + 1;
  attn_init(a);
  lds_barrier();
  for (int i = tid; i < 4 * 32 * 65; i += 256) T[i] = 0.f;
  float* Mrec = (float*)(smem + 2 * KVBUF * 2 + 4 * 32 * 65 * 4 + 256);
  float carry[2] = {0.f, 0.f};
  kv_pipeline(0, ntc, Ks,
    [&](int) { return true; },
    [&](int j, KVRegs& kr) { kv_load(kcmp, vcmp, 64, 64, j * 64, kr); },
    [&](int j, const u16* Kt, const u16* Vt) {
      f32x4 s[4][2];
      auto valid = [&](int kt, int r, int qt) { return 16 * (j * 64 + kt * 16 + 4 * g + r) + 31 <= q0 + qt * 16 + l15; };
      const float mb0 = a.m[0], mb1 = a.m[1];
      qk_tile<2>(Kt, 0, qf, s, l15, g);
      softmax_pv(s, a, Vt, sc, l15, g, valid);
#pragma unroll
      for (int qt = 0; qt < 2; ++qt) {
        float prev3 = carry[qt] * exp2_((qt == 0 ? mb0 : mb1) - a.m[qt]);
#pragma unroll
        for (int kt = 0; kt < 4; ++kt) {
          const f32x4 pr = s[kt][qt];
          const float below = __shfl_up(pr[3], 16);
          const float wrap = __shfl(prev3, l15 + 48);
          const float nb = g > 0 ? below : wrap;
          T[(h * 32 + qt * 16 + l15) * 65 + j * 16 + kt * 4 + g] = (pr[0] + pr[1]) + (pr[2] + 0.5f * pr[3]) + 0.5f * nb;
          prev3 = pr[3];
        }
        carry[qt] = prev3;
        Mrec[(h * 32 + qt * 16 + l15) * 4 + j] = a.m[qt];
      }
    });
  float cinv[2];
#pragma unroll
  for (int qt = 0; qt < 2; ++qt) {
    const float lt = group_sum4(a.l[qt]);
    cinv[qt] = lt > 0.f ? 1.f / lt : 0.f;
    const float gt = sigmoidf_(smb[(size_t)(q0 + qt * 16 + l15) * NSMALL + SM_G + h * 3 + 0]) * cinv[qt];
#pragma unroll
    for (int d = 0; d < 4; ++d) outacc[d][qt] = a.o[d][qt] * gt;
    for (int j = 0; j < ntc; ++j) {
      const float f = exp2_(Mrec[(h * 32 + qt * 16 + l15) * 4 + j] - a.m[qt]) * cinv[qt];
#pragma unroll
      for (int kt = 0; kt < 4; ++kt) T[(h * 32 + qt * 16 + l15) * 65 + j * 16 + kt * 4 + g] *= f;
    }
  }
  lds_barrier();
#pragma unroll 1
  for (int qq = 0; qq < 8; ++qq) {
    const int q = h * 8 + qq, t = q0 + q, cur = t >> 6;
    const float imp = ((T[(0 * 32 + q) * 65 + lane] + T[(1 * 32 + q) * 65 + lane]) + T[(2 * 32 + q) * 65 + lane]) + T[(3 * 32 + q) * 65 + lane];
    const bool forced = lane == cur || lane == 0, allowed = lane <= cur, cand = allowed && !forced;
    const int K = cur == 0 ? 15 : 14;
    unsigned long long m;
    if (__popcll(__ballot(cand)) <= K) m = __ballot(allowed);
    else {
      const unsigned key = __float_as_uint(imp);
      unsigned prefix = 0u;
#pragma unroll 1
      for (int bit = 30; bit >= 0; --bit) {
        const unsigned cnd = prefix | (1u << bit);
        const int cge = __popcll(__ballot(cand && key >= cnd));
        if (cge >= K) prefix = cnd;
        if (cge == K) break;
      }
      const unsigned long long gt = __ballot(cand && key > prefix), eq = __ballot(cand && key == prefix);
      const int need = K - __popcll(gt);
      const int myrank = __popcll(eq & ((1ull << lane) - 1ull));
      m = gt | __ballot(cand && key == prefix && myrank < need) | __ballot(forced);
    }
    if (lane == 0) selm[q] = m;
  }
  lds_barrier();
  f32x4* park = (f32x4*)T + (h * 8) * 64 + lane;
#pragma unroll
  for (int d = 0; d < 4; ++d) { park[(d * 2 + 0) * 64] = outacc[d][0]; park[(d * 2 + 1) * 64] = outacc[d][1]; }
  unsigned long long mq[2], anym = 0ull;
#pragma unroll
  for (int qt = 0; qt < 2; ++qt) mq[qt] = selm[qt * 16 + l15];
  for (int i = 0; i < 32; ++i) anym |= selm[i];
  const int jhi = (q0 + 31) >> 6;
#pragma unroll
  for (int qt = 0; qt < 2; ++qt)
#pragma unroll
    for (int ks = 0; ks < 2; ++ks) qf[qt][ks] = scale_frag(qf[qt][ks], sc);
  for (bool safe = false;;) {
  attn_init_rel(a);
  lds_barrier();
  if (otid512() == 0) *bflag = 0u;
  kv_pipeline2(0, safe ? jhi + 1 : 1, jhi + 1, Ks,
    [&](int j) { return (bool)((anym >> j) & 1ull); },
    [&](int j, KVRegs& kr) { kv_load(projb + PA_KS, projb + PA_VS, NP, NP, j * 64, kr); },
    [&](int j, const u16* Kt, const u16* Vt) {
      f32x4 s[4][2];
      auto valid = [&](int kt, int r, int qt) { return ((mq[qt] >> j) & 1ull) && (j * 64 + kt * 16 + 4 * g + r <= q0 + qt * 16 + l15); };
      bf16x8 pf[2][2];
      if (j * 64 + 63 <= q0) {
        qk_tile_rel<2>(Kt, 0, qf, a, s, l15, g, (bool)((mq[0] >> j) & 1ull), (bool)((mq[1] >> j) & 1ull));
        softmax_rel<0>(s, a, pf, l15, valid);
      } else {
        qk_tile_rel<2>(Kt, 0, qf, a, s, l15, g);
        softmax_rel<1>(s, a, pf, l15, valid);
      }
      pv_accum(pf, Vt, a.o, l15, g);
      rowsum_accum(pf, a, l15);
    },
    [&](int j, const u16* Kt, const u16* Vt) {
      f32x4 s[4][2];
      auto valid = [&](int kt, int r, int qt) { return ((mq[qt] >> j) & 1ull) && (j * 64 + kt * 16 + 4 * g + r <= q0 + qt * 16 + l15); };
      bf16x8 pf[2][2];
      if (j * 64 + 63 <= q0) {
        qk_tile_rel<2>(Kt, 0, qf, a, s, l15, g, (bool)((mq[0] >> j) & 1ull), (bool)((mq[1] >> j) & 1ull));
        softmax_fixed<0>(s, pf, valid);
      } else {
        qk_tile_rel<2>(Kt, 0, qf, a, s, l15, g);
        softmax_fixed<1>(s, pf, valid);
      }
      pv_accum(pf, Vt, a.o, l15, g);
      rowsum_accum(pf, a, l15);
    });
  {
    const float l0 = rel_rowsum(a, 0, l15), l1 = rel_rowsum(a, 1, l15);
    const bool bad = FORCE_BAD_NSA || !(l0 < 1e38f) || !(l1 < 1e38f);
    if (!safe && __any(bad) && lane == 0) *bflag = 1u;
    lds_barrier();
    if (safe || __builtin_amdgcn_readfirstlane(*bflag) == 0u) break;
    safe = true;
  }
  }
#pragma unroll
  for (int qt = 0; qt < 2; ++qt) {
    const float lt = rel_rowsum(a, qt, l15);
    const float gt = sigmoidf_(smb[(size_t)(q0 + qt * 16 + l15) * NSMALL + SM_G + h * 3 + 1]) * (lt > 0.f ? 1.f / lt : 0.f);
#pragma unroll
    for (int d = 0; d < 4; ++d) park[(d * 2 + qt) * 64] += a.o[d][qt] * gt;
  }
  const int jlo = q0 >= 511 ? (q0 - 511) >> 6 : 0;
  for (bool safe = false;;) {
  attn_init_rel(a);
  lds_barrier();
  if (otid512() == 0) *bflag = 0u;
  kv_pipeline2(jlo, safe ? jhi + 1 : jlo + 2, jhi + 1, Ks,
    [&](int) { return true; },
    [&](int j, KVRegs& kr) { kv_load(projb + PA_KW, projb + PA_VW, NP, NP, j * 64, kr); },
    [&](int j, const u16* Kt, const u16* Vt) {
      f32x4 s[4][2];
      auto valid = [&](int kt, int r, int qt) { const int key = j * 64 + kt * 16 + 4 * g + r, t = q0 + qt * 16 + l15; return key <= t && key + 512 > t; };
      bf16x8 pf[2][2];
      qk_tile_rel<2>(Kt, 0, qf, a, s, l15, g);
      if (j * 64 + 63 <= q0 && j * 64 + 512 > q0 + 31) softmax_rel<0>(s, a, pf, l15, valid);
      else softmax_rel<1>(s, a, pf, l15, valid);
      pv_accum(pf, Vt, a.o, l15, g);
      rowsum_accum(pf, a, l15);
    },
    [&](int j, const u16* Kt, const u16* Vt) {
      f32x4 s[4][2];
      auto valid = [&](int kt, int r, int qt) { const int key = j * 64 + kt * 16 + 4 * g + r, t = q0 + qt * 16 + l15; return key <= t && key + 512 > t; };
      bf16x8 pf[2][2];
      qk_tile_rel<2>(Kt, 0, qf, a, s, l15, g);
      if (j * 64 + 63 <= q0 && j * 64 + 512 > q0 + 31) softmax_fixed<0>(s, pf, valid);
      else softmax_fixed<1>(s, pf, valid);
      pv_accum(pf, Vt, a.o, l15, g);
      rowsum_accum(pf, a, l15);
    });
  {
    const float l0 = rel_rowsum(a, 0, l15), l1 = rel_rowsum(a, 1, l15);
    const bool bad = FORCE_BAD_NSA || !(l0 < 1e38f) || !(l1 < 1e38f);
    if (!safe && __any(bad) && lane == 0) *bflag = 1u;
    lds_barrier();
    if (safe || __builtin_amdgcn_readfirstlane(*bflag) == 0u) break;
    safe = true;
  }
  }
  u16* Y = (u16*)(p.ws + OFF_H);
  const float* ng = p.nsa_norm_g + layer * 64;
  u32x2 zzv[2][4]; f32x4 ggv[4];
#pragma unroll
  for (int d = 0; d < 4; ++d) {
    ggv[d] = *(const f32x4*)(ng + d * 16 + 4 * g);
#pragma unroll
    for (int qt = 0; qt < 2; ++qt) zzv[qt][d] = *(const u32x2*)(projb + (size_t)(q0 + qt * 16 + l15) * NP + PA_Z + h * 64 + d * 16 + 4 * g);
  }
  asm volatile("" : "+v"(zzv[0][0]), "+v"(zzv[0][1]), "+v"(zzv[0][2]), "+v"(zzv[0][3]), "+v"(zzv[1][0]), "+v"(zzv[1][1]), "+v"(zzv[1][2]), "+v"(zzv[1][3]), "+v"(ggv[0]), "+v"(ggv[1]), "+v"(ggv[2]), "+v"(ggv[3]));
#pragma unroll
  for (int qt = 0; qt < 2; ++qt) {
    const int t = q0 + qt * 16 + l15;
    const float lt = rel_rowsum(a, qt, l15);
    const float gt = sigmoidf_(smb[(size_t)t * NSMALL + SM_G + h * 3 + 2]) * (lt > 0.f ? 1.f / lt : 0.f);
    f32x4 v[4]; float ss = 0.f;
#pragma unroll
    for (int d = 0; d < 4; ++d) { v[d] = park[(d * 2 + qt) * 64] + a.o[d][qt] * gt; ss += v[d][0] * v[d][0] + v[d][1] * v[d][1] + v[d][2] * v[d][2] + v[d][3] * v[d][3]; }
    ss = group_sum4(ss);
    const float rn = rsqrtf(ss * (1.f / 64.f) + 1e-6f);
    const size_t row = (size_t)b * SEQ + t;
#pragma unroll
    for (int d = 0; d < 4; ++d) {
      const int dd = d * 16 + 4 * g;
      const u32x2 zz = zzv[qt][d];
      const f32x4 gg = ggv[d];
      u32x2 o;
      o.x = pack2(v[d][0] * rn * gg[0] * siluf(bflo(zz.x)), v[d][1] * rn * gg[1] * siluf(bfhi(zz.x)));
      o.y = pack2(v[d][2] * rn * gg[2] * siluf(bflo(zz.y)), v[d][3] * rn * gg[3] * siluf(bfhi(zz.y)));
      *(u32x2*)(Y + row * 1024 + Y_A + h * 64 + dd) = o;
    }
  }
}


DI void final_norm_rows(const Params& p, int rbase, int nrows, int gw, int nw, int lane) {
  const float4* gp = (const float4*)p.final_g;
  float4 gg[4];
#pragma unroll
  for (int i = 0; i < 4; ++i) gg[i] = gp[lane + 64 * i];
  for (int row0 = rbase + gw * 4; row0 < rbase + nrows; row0 += nw * 4) {
    f32x4 v[4][4]; u32x2 raw[4][4]; float ss[4];
#pragma unroll
    for (int j = 0; j < 4; ++j) {
      const u32x2* xr = (const u32x2*)((const u16*)(p.ws + OFF_X1B) + (size_t)(row0 + j) * D_MODEL);
#pragma unroll
      for (int i = 0; i < 4; ++i) raw[j][i] = xr[lane + 64 * i];
    }
    asm volatile("" : "+v"(raw[0][0]), "+v"(raw[0][1]), "+v"(raw[0][2]), "+v"(raw[0][3]), "+v"(raw[1][0]), "+v"(raw[1][1]), "+v"(raw[1][2]), "+v"(raw[1][3]), "+v"(raw[2][0]), "+v"(raw[2][1]), "+v"(raw[2][2]), "+v"(raw[2][3]), "+v"(raw[3][0]), "+v"(raw[3][1]), "+v"(raw[3][2]), "+v"(raw[3][3]));
#pragma unroll
    for (int j = 0; j < 4; ++j)
#pragma unroll
      for (int i = 0; i < 4; ++i) { const u32x2 w = raw[j][i]; v[j][i] = (f32x4){bflo(w.x), bfhi(w.x), bflo(w.y), bfhi(w.y)}; }
#pragma unroll
    for (int j = 0; j < 4; ++j) {
      float a = 0.f;
#pragma unroll
      for (int i = 0; i < 4; ++i) a += v[j][i][0] * v[j][i][0] + v[j][i][1] * v[j][i][1] + v[j][i][2] * v[j][i][2] + v[j][i][3] * v[j][i][3];
      ss[j] = wave_sum(a);
    }
#pragma unroll
    for (int j = 0; j < 4; ++j) {
      float4* xr = (float4*)(p.out + (size_t)(row0 + j) * D_MODEL);
      const float r = rsqrtf(ss[j] * (1.f / D_MODEL) + 1e-6f);
#pragma unroll
      for (int i = 0; i < 4; ++i) { float4 w; w.x = v[j][i][0] * r * gg[i].x; w.y = v[j][i][1] * r * gg[i].y; w.z = v[j][i][2] * r * gg[i].z; w.w = v[j][i][3] * r * gg[i].w; xr[lane + 64 * i] = w; }
    }
  }
}

#define XB_TMO      128
#define XB_XCNT(j)  (256  + 64 * (j))
#define XB_XSUB(j)  (1280 + 64 * (j))
#define XB_XGEN(j)  (2304 + 64 * (j))
#define XB_TOP      3328
#define XB_TOPGEN   3392
#define XCD_BAR_WORDS 3456
#define XB_SPIN_CAP (1u << 23)
DI unsigned xb_ld(unsigned* p)              { return __hip_atomic_load(p, __ATOMIC_RELAXED, __HIP_MEMORY_SCOPE_AGENT); }
DI unsigned xb_add(unsigned* p, unsigned v) { return __hip_atomic_fetch_add(p, v, __ATOMIC_RELAXED, __HIP_MEMORY_SCOPE_AGENT); }
DI unsigned xb_xcc_id() { return (unsigned)__builtin_amdgcn_s_getreg((3 << 11) | 20) & 0xFu; }
#define XB_SPIN(cond, bar) do { unsigned _sp = 0; while (cond) { __builtin_amdgcn_s_sleep(1); \
    if ((++_sp & 255u) == 0u) { if (xb_ld(&(bar)[XB_TMO])) break; if (_sp > XB_SPIN_CAP) { atomicAdd(&(bar)[XB_TMO], 1u); break; } } } } while (0)
struct XcdBarrier { unsigned* bar; unsigned x; volatile LDSP unsigned* st; };
DI XcdBarrier xcd_barrier_post(unsigned* bar, volatile LDSP unsigned* st) {
  XcdBarrier b; b.bar = bar; b.x = xb_xcc_id(); b.st = st;
  if (threadIdx.x == 0) (void)xb_add(&bar[XB_XCNT(b.x)], 1u);
  return b;
}
DI void xcd_barrier_complete(unsigned* bar, unsigned x, unsigned& nloc, unsigned& nx) {
  const unsigned G = gridDim.x * gridDim.y * gridDim.z;
  unsigned sum, cnt, mine, sp = 0u;
  for (;;) {
    sum = 0u; cnt = 0u; mine = 0u;
#pragma unroll
    for (unsigned j = 0; j < 16; ++j) { const unsigned c = xb_ld(&bar[XB_XCNT(j)]); sum += c; cnt += (c > 0u) ? 1u : 0u; mine = (j == x) ? c : mine; }
    if (sum == G) break;
    __builtin_amdgcn_s_sleep(1);
    if ((++sp & 255u) == 0u) { if (xb_ld(&bar[XB_TMO])) break; if (sp > XB_SPIN_CAP) { atomicAdd(&bar[XB_TMO], 1u); break; } }
  }
  nloc = mine > 0u ? mine : 1u; nx = cnt > 0u ? cnt : 1u;
}
DI void xcd_barrier(const XcdBarrier& b) {
  asm volatile("s_waitcnt vmcnt(0)" ::: "memory");
  __syncthreads();
  if (threadIdx.x == 0) {
    unsigned* bar = b.bar;
    __builtin_amdgcn_s_waitcnt(0);
    unsigned nloc = b.st[0], nx = b.st[1];
    if (nloc == 0u) { xcd_barrier_complete(bar, b.x, nloc, nx); b.st[0] = nloc; b.st[1] = nx; }
    const unsigned old = xb_add(&bar[XB_XSUB(b.x)], 1u);
    const unsigned gen = old / nloc;
    if (old + 1u == (gen + 1u) * nloc) {
      __builtin_amdgcn_fence(__ATOMIC_RELEASE, "agent");
      asm volatile("s_waitcnt vmcnt(0)" ::: "memory");
      const unsigned og = xb_add(&bar[XB_TOP], 1u);
      const unsigned tg = og / nx;
      if (og + 1u == (tg + 1u) * nx) xb_add(&bar[XB_TOPGEN], 1u);
      else XB_SPIN(xb_ld(&bar[XB_TOPGEN]) == tg, bar);
      __builtin_amdgcn_fence(__ATOMIC_ACQUIRE, "agent");
      xb_add(&bar[XB_XGEN(b.x)], 1u);
      asm volatile("s_waitcnt vmcnt(0)" ::: "memory");
    } else {
      XB_SPIN(xb_ld(&bar[XB_XGEN(b.x)]) == gen, bar);
      __builtin_amdgcn_fence(__ATOMIC_ACQUIRE, "agent");
      asm volatile("s_waitcnt vmcnt(0)" ::: "memory");
    }
  }
  __syncthreads();
}

constexpr int HALF_LDS = 76 * 1024;
constexpr int SMEM_BYTES = 2 * HALF_LDS;
DI void group_barrier(unsigned* gc, unsigned target) {
  asm volatile("s_waitcnt vmcnt(0)" ::: "memory");
  __syncthreads();
  if (threadIdx.x == 0) {
    __hip_atomic_fetch_add(gc, 1u, __ATOMIC_RELAXED, __HIP_MEMORY_SCOPE_AGENT);
    unsigned sp = 0;
    while (__hip_atomic_load(gc, __ATOMIC_RELAXED, __HIP_MEMORY_SCOPE_AGENT) < target) { __builtin_amdgcn_s_sleep(1); if (++sp > (1u << 24)) break; }
    __builtin_amdgcn_fence(__ATOMIC_ACQUIRE, "agent");
    asm volatile("s_waitcnt vmcnt(0)" ::: "memory");
  }
  __syncthreads();
}
#ifndef STAGGER_US
#define STAGGER_US 0
#endif
__global__ void __launch_bounds__(512, 2) fwd_megakernel(Params p) {
  cg::grid_group grid = cg::this_grid();
  __shared__ __attribute__((aligned(16))) unsigned char smem[SMEM_BYTES];
  const int half = __builtin_amdgcn_readfirstlane(threadIdx.x >> 8);
  unsigned char* hsm = smem + half * HALF_LDS;
  const int G = gridDim.x, bid = blockIdx.x;
  const int slot = bid * 2 + half, NS = 2 * G;
  volatile LDSP unsigned* xst = (volatile LDSP unsigned*)(LDSP unsigned char*)(smem + SMEM_BYTES - 64);
  unsigned* cntp = (unsigned*)(p.ws + OFF_CNT);
  grid.sync();
  const XcdBarrier xb = xcd_barrier_post((unsigned*)(p.ws + OFF_BAR), xst);
  if (threadIdx.x == 0) { xst[0] = 0u; xst[1] = 0u; }
  if (threadIdx.x == 0) xst[4] = __hip_atomic_fetch_add(cntp + 128 + xb.x, 1u, __ATOMIC_RELAXED, __HIP_MEMORY_SCOPE_AGENT);
  if (blockIdx.x == 0 && threadIdx.x < 2) {
    const int l = threadIdx.x;
    const float* lam = p.diff_lam + l * 128;
    float s01 = 0.f, s23 = 0.f;
    for (int i = 0; i < 32; ++i) { s01 += lam[i] * lam[32 + i]; s23 += lam[64 + i] * lam[96 + i]; }
    const float lam_init = l == 0 ? 0.2f : 0.35550906759096324f;
    ((float*)(p.ws + OFF_LAMF))[l] = __expf(s01) - __expf(s23) + lam_init;
  }
  {
    constexpr int ADA0 = T0_WIN + T0_WOUT + T0_W1 + T0_W2;
    unsigned* cnt = cntp;
    for (int i = slot; i < ((T0_TOTAL + NS - 1) / NS) * NS; i += NS) {
      const int t = i < 96 ? ADA0 + i : (i - 96 < ADA0 ? i - 96 : i);
      phase0_task(p, t, hsm);
      if (i < 96) {
        asm volatile("s_waitcnt vmcnt(0)" ::: "memory");
        lds_barrier();
        if (otid512() == 0) {
          __builtin_amdgcn_fence(__ATOMIC_RELEASE, "agent");
          asm volatile("s_waitcnt vmcnt(0)" ::: "memory");
          __hip_atomic_fetch_add(cnt + 8, 2u, __ATOMIC_RELAXED, __HIP_MEMORY_SCOPE_AGENT);
        }
      }
    }
    if (otid512() == 0) {
      unsigned sp = 0;
      while (__hip_atomic_load(cnt + 8, __ATOMIC_RELAXED, __HIP_MEMORY_SCOPE_AGENT) < 96u) { __builtin_amdgcn_s_sleep(8); if (++sp > (1u << 22)) break; }
      __builtin_amdgcn_fence(__ATOMIC_ACQUIRE, "agent");
      asm volatile("s_waitcnt vmcnt(0)" ::: "memory");
    }
    lds_barrier();
    for (int t = slot; t < ((NTOK / 64 + NS - 1) / NS) * NS; t += NS) phase1_task(p, 0, p.x, t < NTOK / 64 ? t : NTOK / 64 - 1, hsm);
  }
  xcd_barrier(xb);
  if (threadIdx.x == 0) {
    unsigned nloc = 0, ng = 0, gi = 0;
    for (unsigned j = 0; j < 16; ++j) { const unsigned c = xb_ld(xb.bar + XB_XCNT(j)); if (c) { if (j < xb.x) ++gi; ++ng; } if (j == xb.x) nloc = c; }
    xst[5] = nloc ? nloc : 1u; xst[6] = ng ? ng : 1u; xst[7] = gi;
  }
  __syncthreads();
  const int rank = __builtin_amdgcn_readfirstlane((int)xst[4]), nloc = __builtin_amdgcn_readfirstlane((int)xst[5]), ng = __builtin_amdgcn_readfirstlane((int)xst[6]), gi = __builtin_amdgcn_readfirstlane((int)xst[7]);
  unsigned* gcnt = cntp + 256 + 64 * xb.x;
  unsigned epoch = 0;
#if STAGGER_US
  { const unsigned long long t0 = wall_clock64(); while (wall_clock64() - t0 < (unsigned long long)(STAGGER_US * 100) * (unsigned long long)gi) __builtin_amdgcn_s_sleep(8); }
#endif
  const int lslot = rank * 2 + half, LNS = 2 * nloc;
  for (int bb = gi; bb < BATCH; bb += ng)
  for (int layer = 0; layer < 2; ++layer) {
    Params q = p;
    { size_t zoff = 0; asm volatile("" : "+s"(zoff)); q.ws = p.ws + zoff; }
    const float* xin = layer == 0 ? q.x : q.out;
    if (layer != 0) {
      for (int t = lslot; t < ((64 + LNS - 1) / LNS) * LNS; t += LNS) phase1_task(q, layer, xin, bb * 64 + (t < 64 ? t : 63), hsm);
      group_barrier(gcnt, ++epoch * (unsigned)nloc);
    }
    for (int t = rank; t < 256; t += nloc) { const int r = t >> 5, i = t & 31; gemm_inproj_tile(q, layer, bb * 16 + (i & 7) + 8 * (r & 1), (i >> 3) + 4 * (r >> 1), smem); }
    group_barrier(gcnt, ++epoch * (unsigned)nloc);
    {
      unsigned* cnt = (unsigned*)(q.ws + OFF_CNT);
      unsigned* qcnt = cnt + 32 + layer * 8; unsigned* cdone = cnt + 64 + layer * 8; unsigned* sdone = cnt + 96 + layer * 8;
      int* s_pair = (int*)(smem + SMEM_BYTES - 16);
      for (int sq = rank; sq < 8; sq += nloc) {
        if (sq < 4) ssd_task8(q, layer, bb, sq, smem); else mlstm_task8(q, layer, bb, sq - 4, smem);
        asm volatile("s_waitcnt vmcnt(0)" ::: "memory");
        lds_barrier();
        if (otid512() == 0) {
          __builtin_amdgcn_fence(__ATOMIC_RELEASE, "agent");
          asm volatile("s_waitcnt vmcnt(0)" ::: "memory");
          __hip_atomic_fetch_add(sdone + bb, 1u, __ATOMIC_RELAXED, __HIP_MEMORY_SCOPE_AGENT);
        }
      }
      constexpr int NP_C = 8, NP_D = 64, NP_N = 64, NP_F = 64, NP_ALL = NP_C + NP_D + NP_N + NP_F;
      const int bq = bb;
      for (;;) {
        const int t512 = otid512();
        lds_barrier();
        if (t512 == 0) *s_pair = (int)atomicAdd(qcnt + bq, 1u);
        lds_barrier();
        const int pair = *s_pair;
        if (pair >= NP_ALL) break;
        if (pair < NP_C) {
          const int v = pair * 2 + half;
          compress_task(q, layer, bq, v >> 3, v & 7, hsm);
          asm volatile("s_waitcnt vmcnt(0)" ::: "memory");
          lds_barrier();
          if (t512 == 0) {
            __builtin_amdgcn_fence(__ATOMIC_RELEASE, "agent");
            asm volatile("s_waitcnt vmcnt(0)" ::: "memory");
            __hip_atomic_fetch_add(cdone + bq, 1u, __ATOMIC_RELAXED, __HIP_MEMORY_SCOPE_AGENT);
          }
        } else if (pair < NP_C + NP_D) {
          const int d = pair - NP_C;
          diff_attn_task(q, layer, bq, 2 * (d & 1) + half, 31 - (d >> 1), hsm, xst + 2);
        } else if (pair < NP_C + NP_D + NP_N) {
          if (t512 == 0) {
            while (__hip_atomic_load(cdone + bq, __ATOMIC_RELAXED, __HIP_MEMORY_SCOPE_AGENT) < (unsigned)NP_C) __builtin_amdgcn_s_sleep(16);
            __builtin_amdgcn_fence(__ATOMIC_ACQUIRE, "agent");
            asm volatile("s_waitcnt vmcnt(0)" ::: "memory");
          }
          lds_barrier();
          nsa_task(q, layer, bq, 2 * (63 - (pair - NP_C - NP_D)) + half, hsm, xst + 2);
        } else {
          if (t512 == 0) {
            while (__hip_atomic_load(sdone + bq, __ATOMIC_RELAXED, __HIP_MEMORY_SCOPE_AGENT) < 8u) __builtin_amdgcn_s_sleep(16);
            __builtin_amdgcn_fence(__ATOMIC_ACQUIRE, "agent");
            asm volatile("s_waitcnt vmcnt(0)" ::: "memory");
          }
          lds_barrier();
          seq_fix_rows(q, layer, bq * SEQ + ((pair - NP_C - NP_D - NP_N) * 2 + half) * 32, 32);
        }
      }
    }
    group_barrier(gcnt, ++epoch * (unsigned)nloc);
    if (layer == 0) { for (int t = rank; t < 64; t += nloc) gemm_outproj_tile<0>(q, xin, q.out, bb * 16 + (t & 7) + 8 * (t >> 5), (t >> 3) & 3, smem); }
    else { for (int t = rank; t < 64; t += nloc) gemm_outproj_tile<1>(q, xin, q.out, bb * 16 + (t & 7) + 8 * (t >> 5), (t >> 3) & 3, smem); }
    group_barrier(gcnt, ++epoch * (unsigned)nloc);
    if (layer == 1) {
      const int t5 = otid512();
      final_norm_rows(q, bb * SEQ, SEQ, rank * 8 + (t5 >> 6), nloc * 8, t5 & 63);
    }
  }
}

extern "C" void kernel_launch(void* const* d_in, const int* in_sizes, int n_in, void* d_out, int out_size, void* d_ws, size_t ws_size,
                              hipStream_t stream) {
  static int grid_blocks = 0;
  if (!grid_blocks) {
    int dev = 0, cus = 0, per_cu = 0;
    (void)hipGetDevice(&dev);
    (void)hipDeviceGetAttribute(&cus, hipDeviceAttributeMultiprocessorCount, dev);
    (void)hipOccupancyMaxActiveBlocksPerMultiprocessor(&per_cu, fwd_megakernel, 512, 0);
    if (per_cu > 1) per_cu = 1;
    if (per_cu < 1) per_cu = 1;
    grid_blocks = cus * per_cu;
  }
  if (grid_blocks < 64 || (grid_blocks & 3)) { fprintf(stderr, "grid too small: %d\n", grid_blocks); return; }
  if (ws_size < WS_NEEDED) { fprintf(stderr, "workspace too small: %zu < %zu\n", ws_size, WS_NEEDED); return; }
  Params p{};
  const float** pp = (const float**)&p;
  for (int i = 0; i < 26; ++i) pp[i] = (const float*)d_in[i];
  p.out = (float*)d_out; p.ws = (unsigned char*)d_ws;
  (void)hipMemsetAsync((unsigned char*)d_ws + OFF_CNT, 0, 64 * 1024 + XCD_BAR_WORDS * 4, stream);
  void* args[] = {&p};
  hipError_t e = hipLaunchCooperativeKernel((void*)fwd_megakernel, dim3(grid_blocks), dim3(512), args, 0, stream);
  if (e != hipSuccess) fprintf(stderr, "cooperative launch failed: %s (grid %d)\n", hipGetErrorString(e), grid_blocks);
}
```
